# Optimizing an MI355X kernel written in HIP

```python
import math
import jax, jax.numpy as jnp
from jax import lax
import numpy as np

D_MODEL = 1024
BATCH = 8
SEQ = 4096
DEPTH = 1

D_MIX = D_MODEL
D_MLSTM = D_MIX // 2
D_DIFF = D_MIX - D_MLSTM
M_HEADS = 4
M_HEAD_DIM = D_MLSTM // M_HEADS
CHUNK = 64
CONV_K = 5
N_GATE_COLS = 4 * M_HEADS
A_HEADS = 4
A_HEAD_DIM = D_DIFF // (2 * A_HEADS)
ROPE_THETA = 500000.0
ROT_DIM = A_HEAD_DIM // 4
Q_BLOCK = 128
N_EXPERTS = 16
CAP_FACTOR = 2
D_FF_E = 2 * D_MODEL
EPS = 1e-6
D_IN = 4 * D_MLSTM + N_GATE_COLS + 3 * D_DIFF

kernel_name = 'hybrid_mlstm_diffattn_ec_moe_block'


def rmsnorm(x, g):
    x32 = x.astype(jnp.float32)
    y = x32 * lax.rsqrt(jnp.mean(x32 * x32, axis=-1, keepdims=True) + EPS)
    return (y * g.astype(jnp.float32)).astype(x.dtype)


def modulate(h, shift, scale):
    return h * (1 + scale[:, None, :]) + shift[:, None, :]


def split_cols(u, widths):
    outs = []
    off = 0
    for w in widths:
        outs.append(u[..., off:off + w])
        off += w
    return outs


def conv_centered(u, w):
    S = u.shape[1]
    pad = CONV_K // 2
    up = jnp.pad(u, ((0, 0), (pad, pad), (0, 0)))
    out = up[:, 0:S] * w[0]
    for j in range(1, CONV_K):
        out = out + up[:, j:j + S] * w[j]
    return out


def rope_partial(t, pos):
    inv_freq = ROPE_THETA ** (-jnp.arange(0, ROT_DIM, 2, dtype=jnp.float32) / ROT_DIM)
    ang = pos.astype(jnp.float32)[:, :, None] * inv_freq
    cos = jnp.cos(ang)[:, :, None, None, :].astype(t.dtype)
    sin = jnp.sin(ang)[:, :, None, None, :].astype(t.dtype)
    half = ROT_DIM // 2
    t1 = t[..., :half]
    t2 = t[..., half:ROT_DIM]
    rot = jnp.concatenate([t1 * cos - t2 * sin, t2 * cos + t1 * sin], axis=-1)
    return jnp.concatenate([rot, t[..., ROT_DIM:]], axis=-1)


def mlstm_chunkwise(q, k, v, i_pre, f_pre):
    B, H, S, d = q.shape
    NC = S // CHUNK
    q = q.reshape(B, H, NC, CHUNK, d)
    k = k.reshape(B, H, NC, CHUNK, d)
    v = v.reshape(B, H, NC, CHUNK, d)
    ig = i_pre.reshape(B, H, NC, CHUNK)
    a = jnp.cumsum(jax.nn.log_sigmoid(f_pre).reshape(B, H, NC, CHUNK), axis=-1)
    g = a[..., -1]
    w_log = g[..., None] - a + ig
    m_loc = jnp.max(w_log, axis=-1)
    w = jnp.exp(w_log - m_loc[..., None])
    C_loc = jnp.einsum('bhcl,bhclk,bhclv->bhckv', w, k, v)
    n_loc = jnp.einsum('bhcl,bhclk->bhck', w, k)

    def step(carry, inp):
        C, n, m = carry
        Cl, nl, ml, gc = inp
        m_new = jnp.maximum(gc + m, ml)
        s_prev = jnp.exp(gc + m - m_new)
        s_loc = jnp.exp(ml - m_new)
        C_new = s_prev[..., None, None] * C + s_loc[..., None, None] * Cl
        n_new = s_prev[..., None] * n + s_loc[..., None] * nl
        return (C_new, n_new, m_new), (C, n, m)

    init = (jnp.zeros((B, H, d, d), jnp.float32), jnp.zeros((B, H, d), jnp.float32),
            jnp.zeros((B, H), jnp.float32))
    xs = (jnp.moveaxis(C_loc, 2, 0), jnp.moveaxis(n_loc, 2, 0),
          jnp.moveaxis(m_loc, 2, 0), jnp.moveaxis(g, 2, 0))
    _, (C_prev, n_prev, m_prev) = lax.scan(step, init, xs)
    C_prev = jnp.moveaxis(C_prev, 0, 2)
    n_prev = jnp.moveaxis(n_prev, 0, 2)
    m_prev = jnp.moveaxis(m_prev, 0, 2)
    D = a[..., :, None] - a[..., None, :] + ig[..., None, :]
    tril = jnp.tril(jnp.ones((CHUNK, CHUNK), dtype=bool))
    D = jnp.where(tril, D, -jnp.inf)
    inter_log = a + m_prev[..., None]
    m_j = jnp.maximum(inter_log, jnp.max(D, axis=-1))
    inter_w = jnp.exp(inter_log - m_j)
    s = jnp.einsum('bhcjd,bhcsd->bhcjs', q, k) * jnp.exp(D - m_j[..., None])
    num = (jnp.einsum('bhcjs,bhcsv->bhcjv', s, v)
           + inter_w[..., None] * jnp.einsum('bhcjk,bhckv->bhcjv', q, C_prev))
    den = jnp.sum(s, axis=-1) + inter_w * jnp.einsum('bhcjk,bhck->bhcj', q, n_prev)
    den = jnp.maximum(jnp.abs(den), jnp.exp(-m_j))
    return (num / den[..., None]).reshape(B, H, S, d)


def hybrid_layer(x, c, positions, layer_idx, norm1_g, norm2_g, w_ada, b_ada, w_in,
                 mlstm_conv_w, mlstm_gate_b, mlstm_norm_g, diff_qk_g, diff_lambda,
                 diff_subln_g, w_out, w_router, w_gate_e, w_up_e, w_down_e):
    B, S, _ = x.shape
    dt = x.dtype
    mod = jax.nn.silu(c) @ w_ada + b_ada
    shift1, scale1, gate1, shift2, scale2, gate2 = jnp.split(mod, 6, axis=-1)

    h = modulate(rmsnorm(x, norm1_g), shift1, scale1)
    proj = h @ w_in
    qm, km, vm, om, gm, qa, ka, va = split_cols(
        proj, [D_MLSTM, D_MLSTM, D_MLSTM, D_MLSTM, N_GATE_COLS, D_DIFF, D_DIFF, D_DIFF])

    qk = jax.nn.silu(conv_centered(jnp.concatenate([qm, km], axis=-1), mlstm_conv_w))
    qm, km = qk[..., :D_MLSTM], qk[..., D_MLSTM:]

    def to_heads(t):
        return t.reshape(B, S, M_HEADS, M_HEAD_DIM).transpose(0, 2, 1, 3).astype(jnp.float32)

    q_h = to_heads(qm)
    k_h = to_heads(km) * (M_HEAD_DIM ** -0.5)
    v_h = to_heads(vm)
    gates = (gm + mlstm_gate_b).astype(jnp.float32).reshape(B, S, 4, M_HEADS).transpose(0, 2, 3, 1)
    i_f, f_f, i_b, f_b = gates[:, 0], gates[:, 1], gates[:, 2], gates[:, 3]
    h_fwd = mlstm_chunkwise(q_h, k_h, v_h, i_f, f_f)
    fl = lambda t: jnp.flip(t, axis=2)
    h_bwd = fl(mlstm_chunkwise(fl(q_h), fl(k_h), fl(v_h), fl(i_b), fl(f_b)))
    h_m = (h_fwd + h_bwd).transpose(0, 2, 1, 3)
    h_m = rmsnorm(h_m, mlstm_norm_g.reshape(M_HEADS, M_HEAD_DIM)).astype(dt)
    y_m = jax.nn.sigmoid(om) * h_m.reshape(B, S, D_MLSTM)

    lam_init = 0.8 - 0.6 * math.exp(-0.3 * layer_idx)
    lam_p = diff_lambda.astype(jnp.float32)
    lam = (jnp.exp(jnp.sum(lam_p[0] * lam_p[1])) - jnp.exp(jnp.sum(lam_p[2] * lam_p[3]))
           + lam_init)
    qa = rope_partial(rmsnorm(qa.reshape(B, S, A_HEADS, 2, A_HEAD_DIM), diff_qk_g[0]), positions)
    ka = rope_partial(rmsnorm(ka.reshape(B, S, A_HEADS, 2, A_HEAD_DIM), diff_qk_g[1]), positions)
    q_t = qa.transpose(0, 2, 3, 1, 4)
    k_t = ka.transpose(0, 2, 3, 1, 4)
    v_t = va.reshape(B, S, A_HEADS, 2 * A_HEAD_DIM).transpose(0, 2, 1, 3)
    NB = S // Q_BLOCK
    q_blocks = q_t.reshape(B, A_HEADS, 2, NB, Q_BLOCK, A_HEAD_DIM).transpose(3, 0, 1, 2, 4, 5)
    scale = A_HEAD_DIM ** -0.5

    def attend(q_blk):
        s = jnp.einsum('bhpqd,bhpkd->bhpqk', q_blk, k_t).astype(jnp.float32) * scale
        p = jax.nn.softmax(s, axis=-1)
        a_map = p[:, :, 0] - lam * p[:, :, 1]
        return jnp.einsum('bhqk,bhkv->bhqv', a_map.astype(v_t.dtype), v_t)

    o = lax.map(attend, q_blocks)
    o = o.transpose(1, 0, 3, 2, 4).reshape(B, S, A_HEADS, 2 * A_HEAD_DIM)
    o = rmsnorm(o, diff_subln_g) * (1.0 - lam_init)
    y_a = o.reshape(B, S, D_DIFF).astype(dt)

    mix = jnp.concatenate([y_m, y_a], axis=-1) @ w_out
    x = x + gate1[:, None, :] * mix

    h2 = modulate(rmsnorm(x, norm2_g), shift2, scale2)
    aff = jax.nn.softmax(jnp.einsum('bsd,de->bse', h2, w_router).astype(jnp.float32), axis=-1)
    cap = CAP_FACTOR * S // N_EXPERTS
    vals, idx = lax.top_k(aff.transpose(0, 2, 1), cap)
    xe = jax.vmap(lambda hb, ib: hb[ib])(h2, idx)
    g_e = jnp.einsum('becd,edf->becf', xe, w_gate_e)
    u_e = jnp.einsum('becd,edf->becf', xe, w_up_e)
    out_e = jnp.einsum('becf,efd->becd', jax.nn.silu(g_e) * u_e, w_down_e)
    out_e = out_e * vals[..., None].astype(dt)
    moe = jnp.zeros_like(h2).at[jnp.arange(B)[:, None, None], idx].add(out_e)
    return x + gate2[:, None, :] * moe


def setup_inputs(seed: int = 0) -> dict:
    key = jax.random.key(seed)
    ks = jax.random.split(key, 24)
    D = D_MODEL
    nrm = lambda k, shape, s: jax.random.normal(k, shape, jnp.float32) * s
    x = jax.random.normal(ks[0], (BATCH, SEQ, D), jnp.float32)
    c = jax.random.normal(ks[1], (BATCH, D), jnp.float32)
    offs = jax.random.randint(ks[2], (BATCH, 1), 0, 1024, dtype=jnp.int32)
    positions = offs + jnp.arange(SEQ, dtype=jnp.int32)[None, :]
    norm1_g = 1.0 + nrm(ks[3], (DEPTH, D), 0.02)
    norm2_g = 1.0 + nrm(ks[4], (DEPTH, D), 0.02)
    w_ada = nrm(ks[5], (DEPTH, D, 6 * D), 0.5 * D ** -0.5)
    b_ada = nrm(ks[6], (DEPTH, 6 * D), 0.02)
    w_in = nrm(ks[7], (DEPTH, D, D_IN), D ** -0.5)
    mlstm_conv_w = nrm(ks[8], (DEPTH, CONV_K, 2 * D_MLSTM), CONV_K ** -0.5)
    gk = jax.random.split(ks[9], 4)
    f_init = jnp.linspace(3.0, 6.0, M_HEADS, dtype=jnp.float32)
    mlstm_gate_b = jnp.concatenate([
        nrm(gk[0], (DEPTH, M_HEADS), 0.1),
        f_init + nrm(gk[1], (DEPTH, M_HEADS), 0.1),
        nrm(gk[2], (DEPTH, M_HEADS), 0.1),
        f_init + nrm(gk[3], (DEPTH, M_HEADS), 0.1)], axis=-1)
    mlstm_norm_g = 1.0 + nrm(ks[10], (DEPTH, D_MLSTM), 0.02)
    diff_qk_g = 1.0 + nrm(ks[11], (DEPTH, 2, A_HEAD_DIM), 0.02)
    diff_lambda = nrm(ks[12], (DEPTH, 4, A_HEAD_DIM), 0.1)
    diff_subln_g = 1.0 + nrm(ks[13], (DEPTH, 2 * A_HEAD_DIM), 0.02)
    w_out = nrm(ks[14], (DEPTH, D_MIX, D), D_MIX ** -0.5)
    w_router = nrm(ks[15], (DEPTH, D, N_EXPERTS), D ** -0.5)
    w_gate_e = nrm(ks[16], (DEPTH, N_EXPERTS, D, D_FF_E), D ** -0.5)
    w_up_e = nrm(ks[17], (DEPTH, N_EXPERTS, D, D_FF_E), D ** -0.5)
    w_down_e = nrm(ks[18], (DEPTH, N_EXPERTS, D_FF_E, D), D_FF_E ** -0.5)
    return {'x': x, 'c': c, 'positions': positions, 'norm1_g': norm1_g, 'norm2_g': norm2_g,
            'w_ada': w_ada, 'b_ada': b_ada, 'w_in': w_in, 'mlstm_conv_w': mlstm_conv_w,
            'mlstm_gate_b': mlstm_gate_b, 'mlstm_norm_g': mlstm_norm_g, 'diff_qk_g': diff_qk_g,
            'diff_lambda': diff_lambda, 'diff_subln_g': diff_subln_g, 'w_out': w_out,
            'w_router': w_router, 'w_gate_e': w_gate_e, 'w_up_e': w_up_e, 'w_down_e': w_down_e}


def reference(x, c, positions, norm1_g, norm2_g, w_ada, b_ada, w_in, mlstm_conv_w,
              mlstm_gate_b, mlstm_norm_g, diff_qk_g, diff_lambda, diff_subln_g, w_out,
              w_router, w_gate_e, w_up_e, w_down_e):
    for l in range(DEPTH):
        x = hybrid_layer(x, c, positions, l, norm1_g[l], norm2_g[l], w_ada[l], b_ada[l],
                         w_in[l], mlstm_conv_w[l], mlstm_gate_b[l], mlstm_norm_g[l],
                         diff_qk_g[l], diff_lambda[l], diff_subln_g[l], w_out[l],
                         w_router[l], w_gate_e[l], w_up_e[l], w_down_e[l])
    return x
```

```cpp
#include <hip/hip_runtime.h>
#include <hip/hip_cooperative_groups.h>
#include <cstdio>
#include <cstdint>
namespace cg = cooperative_groups;

#define LAS __attribute__((address_space(3)))
#define DI __device__ __forceinline__
typedef unsigned short bf16_t;
typedef short bf16x8 __attribute__((ext_vector_type(8)));
typedef short s16x4 __attribute__((ext_vector_type(4)));
typedef float f32x2 __attribute__((ext_vector_type(2)));
typedef float f32x4 __attribute__((ext_vector_type(4)));
typedef float f32x16 __attribute__((ext_vector_type(16)));
typedef unsigned u32x2 __attribute__((ext_vector_type(2)));
typedef unsigned u32x4 __attribute__((ext_vector_type(4)));
typedef __bf16 bf16x2_t __attribute__((ext_vector_type(2)));

constexpr int BATCH = 8, SEQ = 4096, DM = 1024, MTOK = BATCH * SEQ;
constexpr int DIN = 3600, PS = 3584;
constexpr int NEXP = 16, CAP = 512, DFF = 2048;
constexpr int NPAIR = BATCH * NEXP * CAP;
constexpr float EPS = 1e-6f;
constexpr int C_QM = 0, C_KM = 512, C_VM = 1024, C_OM = 1536, C_QA = 2048, C_KA = 2560, C_VA = 3072;

constexpr size_t MiB = 1u << 20;
constexpr size_t WS_MOD = 1 * MiB;
constexpr size_t WS_GATES = 2 * MiB;
constexpr size_t WS_AFF = 4 * MiB;
constexpr size_t WS_IDX = 6 * MiB;
constexpr size_t WS_VALS = 6 * MiB + 256 * 1024;
constexpr size_t WS_MSC = 6 * MiB + 512 * 1024;
constexpr size_t WS_SLOT = 7 * MiB;
constexpr size_t WS_NLOC = 9 * MiB;
constexpr size_t WS_WINT = 11 * MiB;
constexpr size_t WS_WGT = 18 * MiB;
constexpr size_t WS_WOUTT = 19 * MiB;
constexpr size_t WS_WGUT = 21 * MiB;
constexpr size_t WS_WDT = 149 * MiB;
constexpr size_t WS_PROJ = 213 * MiB;
constexpr size_t WS_YMIX = 437 * MiB;
constexpr size_t WS_H2 = 213 * MiB;
constexpr size_t WS_XE = 277 * MiB;
constexpr size_t WS_HH = 405 * MiB;
constexpr size_t WS_END = 533 * MiB;

constexpr int LDS_BYTES = 147456;
constexpr int NWAVES = 8, NTHR = 512;

DI unsigned pk2(float lo, float hi) { f32x2 v = {lo, hi}; bf16x2_t b = __builtin_convertvector(v, bf16x2_t); return __builtin_bit_cast(unsigned, b); }
DI float bflo(unsigned w) { return __uint_as_float(w << 16); }
DI float bfhi(unsigned w) { return __uint_as_float(w & 0xffff0000u); }
DI float bf2f(bf16_t v) { return __uint_as_float((unsigned)v << 16); }
DI float wave_sum(float v) {
#pragma unroll
    for (int o = 1; o < 64; o <<= 1) v += __shfl_xor(v, o);
    return v;
}
DI float wave_max(float v) {
#pragma unroll
    for (int o = 1; o < 64; o <<= 1) v = fmaxf(v, __shfl_xor(v, o));
    return v;
}
DI float silu_f(float v) { return v / (1.f + __expf(-v)); }
DI float sigmoid_f(float v) { return 1.f / (1.f + __expf(-v)); }
DI float logsigmoid_f(float f) { return fminf(f, 0.f) - log1pf(__expf(-fabsf(f))); }
DI int swz16(int row) { return ((row & 3) << 2) | ((row >> 2) & 3); }
#define MFMA32(a, b, c) __builtin_amdgcn_mfma_f32_32x32x16_bf16((a), (b), (c), 0, 0, 0)
DI s16x4 trread(const LAS unsigned char* p) { return __builtin_bit_cast(s16x4, __builtin_amdgcn_ds_read_tr16_b64_v4i16((LAS s16x4*)p)); }
DI int crow(int r, int hh) { return (r & 3) + 8 * (r >> 2) + 4 * hh; }
DI bool hh_sel(int lane, int bit) { return (lane & bit) != 0; }

namespace pg8 {
constexpr int BM = 256, BK = 64, HALF = 128, HTB = HALF * BK * 2, STAGE_BYTES = 8 * HTB, NXCD = 8, WGM = 8;
DI int lds_byte(int r, int c) { const int st = (r >> 4) * 2 + (c >> 5), rr = r & 15, cc = c & 31, ob = rr * 64 + cc * 2; return st * 1024 + (ob ^ (((ob >> 9) & 1) << 5)); }
DI void stage_rc(int b, int& R, int& C) { const int st = b / 1024, sb = b % 1024, swz = sb ^ (((sb >> 9) & 1) << 5); R = (st >> 1) * 16 + swz / 64; C = (st & 1) * 32 + (swz % 64) / 2; }
DI int perm32(int rho) { const int n = rho >> 4, i = rho & 15; return 8 * (i >> 2) + 4 * n + (i & 3); }
struct Unit { int pm, pn; };
struct Gemm { const bf16_t* A; const bf16_t* Bt; int M, N, K, tpg; };
struct StaticOrder {
    int nM, nN, nwg, G, c;
    DI void init(int M, int N, int G_, int c_) { nM = M / BM; nN = N / BM; nwg = nM * nN; G = G_; c = c_; }
    DI bool next(int i, Unit& u) const {
        const long L = (long)i * G + c; if (L >= nwg) return false;
        int wgid = (int)L; { const int q = nwg / NXCD, r = nwg % NXCD, xcd = wgid % NXCD, off = wgid / NXCD; wgid = (xcd < r ? xcd * (q + 1) : r * (q + 1) + (xcd - r) * q) + off; }
        const int nig = WGM * nN, gid = wgid / nig, fm = gid * WGM, gsz = (nM - fm) < WGM ? (nM - fm) : WGM;
        u.pm = fm + ((wgid % nig) % gsz); u.pn = (wgid % nig) / gsz; return true;
    }
};

template <class Epi, bool ALIGN_EPI, bool SP2>
DI void gemm_phase(LAS unsigned char* lds, const Gemm g, const StaticOrder& S, const Epi& E) {
    const int tid = threadIdx.x, wid = __builtin_amdgcn_readfirstlane(tid >> 6), lane = tid & 63, wr = wid >> 2, wc = wid & 3, fr = lane & 15, fq = lane >> 4;
    const int K = g.K, nt = K / BK;
    unsigned voffA[2], voffB[2];
#pragma unroll
    for (int i = 0; i < 2; ++i) { int R, C; stage_rc(tid * 16 + i * 8192, R, C); const int Rb = Epi::PERM ? ((R & ~31) + perm32(R & 31)) : R;
        voffA[i] = (unsigned)(R * K + C) * 2u; voffB[i] = (unsigned)(Rb * K + C) * 2u; }
    const size_t kstep = (size_t)(BK * 2);
    const size_t hstep = (size_t)HALF * K * 2;
    const size_t tstep = 2 * hstep;
    const size_t gstep = (size_t)g.N * K * 2;
    const unsigned ldsw = (unsigned)wid * 1024u;
    const int aoff = lds_byte(wr * 64 + fr, fq * 8), boff = lds_byte(wc * 32 + fr, fq * 8);
#define PG8_SA(b, h) (((b) * 2 + (h)) * HTB)
#define PG8_SB(b, h) ((4 + (b) * 2 + (h)) * HTB)
#define PG8_STAGE(bufoff, gbase, voff) do { _Pragma("unroll") for (int _i = 0; _i < 2; ++_i) \
        __builtin_amdgcn_global_load_lds((const unsigned*)((const char*)(gbase) + (voff)[_i]), (LAS unsigned*)(lds + (bufoff) + ldsw + _i * 8192), 16, 0, 0); } while (0)
#define PG8_LDA(dst, b, h) do { _Pragma("unroll") for (int m = 0; m < 4; ++m) _Pragma("unroll") for (int k = 0; k < 2; ++k) dst[m][k] = *(const LAS bf16x8*)(lds + PG8_SA(b, h) + aoff + m * 2048 + k * 1024); } while (0)
#define PG8_LDB(dst, b, h) do { _Pragma("unroll") for (int n = 0; n < 2; ++n) _Pragma("unroll") for (int k = 0; k < 2; ++k) dst[n][k] = *(const LAS bf16x8*)(lds + PG8_SB(b, h) + boff + n * 2048 + k * 1024); } while (0)
#define PG8_MMA(ai, bj, At, Bt) do { __builtin_amdgcn_s_setprio(1); _Pragma("unroll") for (int m = 0; m < 4; ++m) _Pragma("unroll") for (int n = 0; n < 2; ++n) _Pragma("unroll") for (int k = 0; k < 2; ++k) \
        acc[ai][bj][m][n] = __builtin_amdgcn_mfma_f32_16x16x32_bf16(Bt[n][k], At[m][k], acc[ai][bj][m][n], 0, 0, 0); __builtin_amdgcn_s_setprio(0); } while (0)
#define PG8_WAIT_V(n) asm volatile("s_waitcnt vmcnt(" #n ")" ::: "memory")
#define PG8_WAIT_L(n) asm volatile("s_waitcnt lgkmcnt(" #n ")" ::: "memory")
#define PG8_BAR __builtin_amdgcn_s_barrier()
#define PG8_SCHED __builtin_amdgcn_sched_barrier(0)
    Unit cur, nxt; int ui = 0;
    if (!S.next(0, cur)) return;
    f32x4 acc[2][2][4][2];
#pragma unroll
    for (int a = 0; a < 2; ++a)
#pragma unroll
        for (int b = 0; b < 2; ++b)
#pragma unroll
            for (int m = 0; m < 4; ++m)
#pragma unroll
                for (int n = 0; n < 2; ++n) acc[a][b][m][n] = (f32x4){0.f, 0.f, 0.f, 0.f};
    bf16x8 At[4][2], B0[2][2], B1[2][2];
    const char* cA = (const char*)g.A + (size_t)cur.pm * tstep; const char* cB = (const char*)g.Bt + (size_t)(cur.pm / g.tpg) * gstep + (size_t)cur.pn * tstep;
    if constexpr (SP2) {
        PG8_STAGE(PG8_SB(0, 0), cB, voffB); PG8_STAGE(PG8_SB(0, 1), cB + hstep, voffB); PG8_STAGE(PG8_SA(0, 0), cA, voffA); PG8_STAGE(PG8_SA(0, 1), cA + hstep, voffA);
        if (wr == 1) PG8_BAR;
        PG8_WAIT_V(2); PG8_BAR;
        PG8_STAGE(PG8_SB(1, 0), cB + kstep, voffB); PG8_STAGE(PG8_SA(1, 0), cA + kstep, voffA); PG8_STAGE(PG8_SB(1, 1), cB + hstep + kstep, voffB);
        PG8_WAIT_V(6); PG8_BAR;
    } else {
        PG8_STAGE(PG8_SB(0, 0), cB, voffB); PG8_STAGE(PG8_SA(0, 0), cA, voffA); PG8_STAGE(PG8_SB(0, 1), cB + hstep, voffB); PG8_STAGE(PG8_SA(0, 1), cA + hstep, voffA);
        if (wr == 1) PG8_BAR;
        PG8_WAIT_V(4); PG8_BAR;
        PG8_STAGE(PG8_SB(1, 0), cB + kstep, voffB); PG8_STAGE(PG8_SA(1, 0), cA + kstep, voffA); PG8_STAGE(PG8_SB(1, 1), cB + hstep + kstep, voffB);
        PG8_WAIT_V(6); PG8_BAR;
    }
    for (;;) {
        const bool has_next = S.next(ui + 1, nxt);
        const char* nA = has_next ? (const char*)g.A + (size_t)nxt.pm * tstep : cA;
        const char* nB = has_next ? (const char*)g.Bt + (size_t)(nxt.pm / g.tpg) * gstep + (size_t)nxt.pn * tstep : cB;
        for (int t = 0; t < nt; t += 2) {
            const bool last = (t == nt - 2);
            const char* a1 = cA + (size_t)(t + 1) * kstep;
            const char* a2 = last ? nA : cA + (size_t)(t + 2) * kstep; const char* b2 = last ? nB : cB + (size_t)(t + 2) * kstep;
            const char* a3 = a2 + kstep; const char* b3 = b2 + kstep;
            if constexpr (SP2) {
            PG8_LDB(B0, 0, 0); PG8_LDB(B1, 0, 1); PG8_SCHED; PG8_LDA(At, 0, 0); PG8_STAGE(PG8_SA(1, 1), a1 + hstep, voffA);
            PG8_WAIT_V(8); PG8_WAIT_L(0); PG8_BAR; PG8_MMA(0, 0, At, B0); PG8_MMA(0, 1, At, B1); PG8_BAR; PG8_SCHED;
            PG8_LDA(At, 0, 1); PG8_STAGE(PG8_SB(0, 0), b2, voffB); PG8_STAGE(PG8_SB(0, 1), b2 + hstep, voffB); PG8_STAGE(PG8_SA(0, 0), a2, voffA);
            PG8_WAIT_V(8); PG8_WAIT_L(0); PG8_BAR; PG8_MMA(1, 0, At, B0); PG8_MMA(1, 1, At, B1); PG8_BAR; PG8_SCHED;
            PG8_LDB(B0, 1, 0); PG8_LDB(B1, 1, 1); PG8_SCHED; PG8_LDA(At, 1, 0); PG8_STAGE(PG8_SA(0, 1), a2 + hstep, voffA);
            PG8_WAIT_V(8); PG8_WAIT_L(0); PG8_BAR; PG8_MMA(0, 0, At, B0); PG8_MMA(0, 1, At, B1); PG8_BAR; PG8_SCHED;
            PG8_LDA(At, 1, 1); PG8_STAGE(PG8_SB(1, 0), b3, voffB); PG8_STAGE(PG8_SB(1, 1), b3 + hstep, voffB); PG8_STAGE(PG8_SA(1, 0), a3, voffA);
            PG8_WAIT_V(8); PG8_WAIT_L(0); PG8_BAR; PG8_MMA(1, 0, At, B0); PG8_MMA(1, 1, At, B1); PG8_BAR; PG8_SCHED;
            } else {
            PG8_LDB(B0, 0, 0); PG8_SCHED; PG8_LDA(At, 0, 0); PG8_STAGE(PG8_SA(1, 1), a1 + hstep, voffA);
            PG8_WAIT_L(8); PG8_BAR; PG8_WAIT_L(0); PG8_MMA(0, 0, At, B0); PG8_BAR; PG8_SCHED;
            PG8_LDB(B1, 0, 1); PG8_STAGE(PG8_SB(0, 0), b2, voffB);
            PG8_BAR; PG8_WAIT_L(0); PG8_MMA(0, 1, At, B1); PG8_BAR;
            PG8_LDA(At, 0, 1); PG8_STAGE(PG8_SA(0, 0), a2, voffA);
            PG8_BAR; PG8_WAIT_L(0); PG8_MMA(1, 0, At, B0); PG8_BAR; PG8_SCHED;
            PG8_STAGE(PG8_SB(0, 1), b2 + hstep, voffB);
            PG8_WAIT_V(6); PG8_BAR; PG8_MMA(1, 1, At, B1); PG8_BAR;
            PG8_LDB(B0, 1, 0); PG8_SCHED; PG8_LDA(At, 1, 0); PG8_STAGE(PG8_SA(0, 1), a2 + hstep, voffA);
            PG8_WAIT_L(8); PG8_BAR; PG8_WAIT_L(0); PG8_MMA(0, 0, At, B0); PG8_BAR; PG8_SCHED;
            PG8_LDB(B1, 1, 1); PG8_STAGE(PG8_SB(1, 0), b3, voffB);
            PG8_BAR; PG8_WAIT_L(0); PG8_MMA(0, 1, At, B1); PG8_BAR;
            PG8_LDA(At, 1, 1); PG8_STAGE(PG8_SA(1, 0), a3, voffA);
            PG8_BAR; PG8_WAIT_L(0); PG8_MMA(1, 0, At, B0); PG8_BAR; PG8_SCHED;
            PG8_STAGE(PG8_SB(1, 1), b3 + hstep, voffB);
            PG8_WAIT_V(6); PG8_BAR; PG8_MMA(1, 1, At, B1); PG8_BAR;
            }
        }
        if constexpr (ALIGN_EPI) { if (wr == 0) PG8_BAR; }
        E(acc, cur, wr, wc, fr, fq);
        if (!has_next) break;
#pragma unroll
        for (int a = 0; a < 2; ++a)
#pragma unroll
            for (int b = 0; b < 2; ++b)
#pragma unroll
                for (int m = 0; m < 4; ++m)
#pragma unroll
                    for (int n = 0; n < 2; ++n) acc[a][b][m][n] = (f32x4){0.f, 0.f, 0.f, 0.f};
        cur = nxt; cA = nA; cB = nB; ++ui;
        if constexpr (ALIGN_EPI) { if (wr == 1) PG8_BAR; }
    }
    PG8_WAIT_V(0);
    if constexpr (!ALIGN_EPI) { if (wr == 0) PG8_BAR; }
    PG8_BAR;
#undef PG8_SA
#undef PG8_SB
#undef PG8_STAGE
#undef PG8_LDA
#undef PG8_LDB
#undef PG8_MMA
#undef PG8_WAIT_V
#undef PG8_WAIT_L
#undef PG8_BAR
#undef PG8_SCHED
}

struct EpiBf16 {
    static constexpr bool PERM = true;
    bf16_t* O; int ldc;
    DI void operator()(const f32x4 (&acc)[2][2][4][2], const Unit& u, int wr, int wc, int fr, int fq) const {
        const int row0 = u.pm * BM + wr * 64 + fr, col0 = u.pn * BM + wc * 32 + 8 * fq;
#pragma unroll
        for (int ai = 0; ai < 2; ++ai)
#pragma unroll
            for (int m = 0; m < 4; ++m) { bf16_t* rowp = O + (size_t)(row0 + ai * HALF + m * 16) * ldc + col0;
#pragma unroll
                for (int bj = 0; bj < 2; ++bj) { const f32x4 v0 = acc[ai][bj][m][0], v1 = acc[ai][bj][m][1];
                    u32x4 w; w.x = pk2(v0[0], v0[1]); w.y = pk2(v0[2], v0[3]); w.z = pk2(v1[0], v1[1]); w.w = pk2(v1[2], v1[3]);
                    *(u32x4*)(rowp + bj * HALF) = w; } }
    }
};
struct EpiX1 {
    static constexpr bool PERM = false;
    const float* x; const float* mod; float* out;
    DI void operator()(const f32x4 (&acc)[2][2][4][2], const Unit& u, int wr, int wc, int fr, int fq) const {
        const int row0 = u.pm * BM + wr * 64 + fr, col0 = u.pn * BM + wc * 32 + 4 * fq;
        const int b = (u.pm * BM) / SEQ;
        const float* gp = mod + (size_t)b * 6144 + 2048 + col0;
#pragma unroll
        for (int bj = 0; bj < 2; ++bj)
#pragma unroll
            for (int n = 0; n < 2; ++n) { const f32x4 gv = *(const f32x4*)(gp + bj * HALF + n * 16);
#pragma unroll
                for (int ai = 0; ai < 2; ++ai)
#pragma unroll
                    for (int m = 0; m < 4; ++m) { const size_t off = (size_t)(row0 + ai * HALF + m * 16) * DM + col0 + bj * HALF + n * 16;
                        const f32x4 xv = *(const f32x4*)(x + off); *(f32x4*)(out + off) = xv + gv * acc[ai][bj][m][n]; } }
    }
};
struct EpiGU {
    static constexpr bool PERM = true;
    bf16_t* H;
    DI void operator()(const f32x4 (&acc)[2][2][4][2], const Unit& u, int wr, int wc, int fr, int fq) const {
        const int row0 = u.pm * BM + wr * 64 + fr, col0 = u.pn * HALF + wc * 32 + 8 * fq;
#pragma unroll
        for (int ai = 0; ai < 2; ++ai)
#pragma unroll
            for (int m = 0; m < 4; ++m) { bf16_t* rowp = H + (size_t)(row0 + ai * HALF + m * 16) * DFF + col0;
                float hv[8];
#pragma unroll
                for (int n = 0; n < 2; ++n)
#pragma unroll
                    for (int j = 0; j < 4; ++j) { const float gg = acc[ai][0][m][n][j], uu = acc[ai][1][m][n][j]; hv[n * 4 + j] = gg / (1.f + __expf(-gg)) * uu; }
                u32x4 w; w.x = pk2(hv[0], hv[1]); w.y = pk2(hv[2], hv[3]); w.z = pk2(hv[4], hv[5]); w.w = pk2(hv[6], hv[7]);
                *(u32x4*)rowp = w; }
    }
};
struct EpiDown {
    static constexpr bool PERM = true;
    bf16_t* Y; const float* vals;
    DI void operator()(const f32x4 (&acc)[2][2][4][2], const Unit& u, int wr, int wc, int fr, int fq) const {
        const int row0 = u.pm * BM + wr * 64 + fr, col0 = u.pn * BM + wc * 32 + 8 * fq;
#pragma unroll
        for (int ai = 0; ai < 2; ++ai)
#pragma unroll
            for (int m = 0; m < 4; ++m) { const int row = row0 + ai * HALF + m * 16; const float s = vals[row]; bf16_t* rowp = Y + (size_t)row * DM + col0;
#pragma unroll
                for (int bj = 0; bj < 2; ++bj) { const f32x4 v0 = acc[ai][bj][m][0] * s, v1 = acc[ai][bj][m][1] * s;
                    u32x4 w; w.x = pk2(v0[0], v0[1]); w.y = pk2(v0[2], v0[3]); w.z = pk2(v1[0], v1[1]); w.w = pk2(v1[2], v1[3]);
                    *(u32x4*)(rowp + bj * HALF) = w; } }
    }
};
}

struct Args {
    const float* x; const float* c; const int* pos; const float* norm1_g; const float* norm2_g; const float* w_ada; const float* b_ada;
    const float* w_in; const float* conv_w; const float* gate_b; const float* mnorm_g; const float* qk_g; const float* lam_p; const float* subln_g;
    const float* w_out; const float* w_router; const float* w_gate; const float* w_up; const float* w_down;
    float* out; unsigned char* ws; int ph_lo, ph_hi;
};
struct Ctx {
    LAS unsigned char* lds; int tid, lane, wave, G, bid;
};
DI Args load_args() {
    typedef __attribute__((address_space(4))) const volatile unsigned long long* kp_t;
    kp_t kp = (kp_t)__builtin_amdgcn_kernarg_segment_ptr();
    Args a;
    a.x = (const float*)kp[0]; a.c = (const float*)kp[1]; a.pos = (const int*)kp[2]; a.norm1_g = (const float*)kp[3]; a.norm2_g = (const float*)kp[4];
    a.w_ada = (const float*)kp[5]; a.b_ada = (const float*)kp[6]; a.w_in = (const float*)kp[7]; a.conv_w = (const float*)kp[8]; a.gate_b = (const float*)kp[9];
    a.mnorm_g = (const float*)kp[10]; a.qk_g = (const float*)kp[11]; a.lam_p = (const float*)kp[12]; a.subln_g = (const float*)kp[13]; a.w_out = (const float*)kp[14];
    a.w_router = (const float*)kp[15]; a.w_gate = (const float*)kp[16]; a.w_up = (const float*)kp[17]; a.w_down = (const float*)kp[18];
    a.out = (float*)kp[19]; a.ws = (unsigned char*)kp[20];
    const unsigned long long ph = kp[21]; a.ph_lo = (int)(unsigned)ph; a.ph_hi = (int)(unsigned)(ph >> 32);
    return a;
}

DI void tr_item(const float* src, size_t ld_src, int k0, int c0, bf16_t* dst, size_t r0, int ld_dst, LAS float* scr, int lane) {
#pragma unroll 8
    for (int i = 0; i < 32; ++i) { const int kk = 2 * i + (lane >> 5); scr[kk * 33 + (lane & 31)] = src[(size_t)(k0 + kk) * ld_src + c0 + (lane & 31)]; }
    asm volatile("s_waitcnt lgkmcnt(0)" ::: "memory");
    const int c = lane & 7;
#pragma unroll
    for (int j = 0; j < 4; ++j) { const int n = (lane >> 3) + 8 * j; const LAS float* s = scr + (8 * c) * 33 + n;
        u32x4 o; o.x = pk2(s[0 * 33], s[1 * 33]); o.y = pk2(s[2 * 33], s[3 * 33]); o.z = pk2(s[4 * 33], s[5 * 33]); o.w = pk2(s[6 * 33], s[7 * 33]);
        *(u32x4*)(dst + (r0 + n) * ld_dst + k0 + 8 * c) = o; }
    asm volatile("s_waitcnt lgkmcnt(0)" ::: "memory");
}
DI void p0_phase(const Ctx& F, const Args& a) {
    if (F.bid < 96) {
        LAS float* sc = (LAS float*)F.lds; LAS float* part = (LAS float*)(F.lds + 32768);
        for (int i = F.tid; i < BATCH * DM; i += NTHR) sc[i] = silu_f(a.c[i]);
        __syncthreads();
        const int col = F.bid * 64 + F.lane;
        float acc[8];
#pragma unroll
        for (int b = 0; b < 8; ++b) acc[b] = 0.f;
        const int kb = F.wave * 128;
#pragma unroll 8
        for (int k = kb; k < kb + 128; ++k) { const float w = a.w_ada[(size_t)k * 6144 + col];
#pragma unroll
            for (int b = 0; b < 8; ++b) acc[b] += sc[b * DM + k] * w; }
#pragma unroll
        for (int b = 0; b < 8; ++b) part[(F.wave * 8 + b) * 64 + F.lane] = acc[b];
        __syncthreads();
        { const int b = F.tid >> 6, l = F.tid & 63; float s = a.b_ada[F.bid * 64 + l];
#pragma unroll
          for (int w = 0; w < 8; ++w) s += part[(w * 8 + b) * 64 + l];
          ((float*)(a.ws + WS_MOD))[b * 6144 + F.bid * 64 + l] = s; }
        __syncthreads();
    }
    LAS float* scr = (LAS float*)(F.lds + F.wave * 16384);
    const int gw = F.bid * NWAVES + F.wave, NGW = F.G * NWAVES;
    constexpr int I_IN = 16 * 112, I_OUT = 16 * 32, I_G = 16 * 16 * 64, I_D = 16 * 32 * 32, I_WG = 16;
    constexpr int NITEMS = I_IN + I_OUT + 2 * I_G + I_D + I_WG;
    bf16_t* WinT = (bf16_t*)(a.ws + WS_WINT); bf16_t* WgT = (bf16_t*)(a.ws + WS_WGT); bf16_t* WoutT = (bf16_t*)(a.ws + WS_WOUTT);
    bf16_t* WguT = (bf16_t*)(a.ws + WS_WGUT); bf16_t* WdT = (bf16_t*)(a.ws + WS_WDT);
    for (int it = gw; it < NITEMS; it += NGW) {
        int r = it;
        if (r < I_IN) { const int kb = r / 112, nb = r % 112, n0 = nb * 32; tr_item(a.w_in, DIN, kb * 64, n0 + (n0 >= 2048 ? 16 : 0), WinT, n0, DM, scr, F.lane); continue; } r -= I_IN;
        if (r < I_OUT) { const int kb = r / 32, nb = r % 32; tr_item(a.w_out, DM, kb * 64, nb * 32, WoutT, nb * 32, DM, scr, F.lane); continue; } r -= I_OUT;
        if (r < 2 * I_G) { const int up = r / I_G; r -= up * I_G; const int e = r / 1024; r -= e * 1024; const int kb = r / 64, nb = r % 64, n0 = nb * 32;
            const float* src = (up ? a.w_up : a.w_gate) + (size_t)e * DM * DFF;
            tr_item(src, DFF, kb * 64, n0, WguT + (size_t)e * 4096 * DM, (size_t)(n0 / 128) * 256 + (n0 % 128) + up * 128, DM, scr, F.lane); continue; } r -= 2 * I_G;
        if (r < I_D) { const int e = r / 1024; r -= e * 1024; const int kb = r / 32, nb = r % 32;
            tr_item(a.w_down + (size_t)e * DFF * DM, DM, kb * 64, nb * 32, WdT + (size_t)e * DM * DFF, nb * 32, DFF, scr, F.lane); continue; } r -= I_D;
        tr_item(a.w_in, DIN, r * 64, 2048, WgT, 0, DM, scr, F.lane);
    }
}

DI void p1_phase(const Ctx& F, const Args& a) {
    const int gw = F.bid * NWAVES + F.wave, NGW = F.G * NWAVES;
    const float* mod = (const float*)(a.ws + WS_MOD);
    bf16_t* H1 = (bf16_t*)a.out;
    for (int m = gw; m < MTOK; m += NGW) {
        const int b = m / SEQ;
        const f32x4* xr = (const f32x4*)(a.x + (size_t)m * DM) + F.lane;
        f32x4 v[4]; float s = 0.f;
#pragma unroll
        for (int j = 0; j < 4; ++j) { v[j] = xr[64 * j]; s += (v[j].x * v[j].x + v[j].y * v[j].y) + (v[j].z * v[j].z + v[j].w * v[j].w); }
        const float rstd = rsqrtf(wave_sum(s) * (1.f / DM) + EPS);
        u32x2* o8 = (u32x2*)(H1 + (size_t)m * DM) + F.lane;
#pragma unroll
        for (int j = 0; j < 4; ++j) {
            const f32x4 g = ((const f32x4*)a.norm1_g)[F.lane + 64 * j];
            const f32x4 sh = ((const f32x4*)(mod + (size_t)b * 6144))[F.lane + 64 * j];
            const f32x4 sc = ((const f32x4*)(mod + (size_t)b * 6144 + 1024))[F.lane + 64 * j];
            const f32x4 h = v[j] * rstd * g * (sc + 1.f) + sh;
            u32x2 w; w.x = pk2(h.x, h.y); w.y = pk2(h.z, h.w); o8[64 * j] = w; }
    }
}

DI void gates_tasks(const Ctx& F, const Args& a) {
    const int gw = F.bid * NWAVES + F.wave, NGW = F.G * NWAVES;
    const bf16_t* H1 = (const bf16_t*)a.out; const bf16_t* WgT = (const bf16_t*)(a.ws + WS_WGT); float* GT = (float*)(a.ws + WS_GATES);
    const float bias = a.gate_b[F.lane & 15];
    for (int task = gw; task < MTOK / 16; task += NGW) {
        const int row0 = task * 16;
        const bf16_t* ap = H1 + (size_t)(row0 + (F.lane & 15)) * DM + 8 * (F.lane >> 4);
        const bf16_t* bp = WgT + (size_t)(F.lane & 15) * DM + 8 * (F.lane >> 4);
        f32x4 acc = {0.f, 0.f, 0.f, 0.f};
#pragma unroll 8
        for (int i = 0; i < 32; ++i) { const bf16x8 av = *(const bf16x8*)(ap + 32 * i), bv = *(const bf16x8*)(bp + 32 * i); acc = __builtin_amdgcn_mfma_f32_16x16x32_bf16(av, bv, acc, 0, 0, 0); }
#pragma unroll
        for (int r = 0; r < 4; ++r) GT[(size_t)(row0 + (F.lane >> 4) * 4 + r) * 16 + (F.lane & 15)] = acc[r] + bias;
    }
}

DI void qknorm_rows(const Ctx& F, const Args& a) {
    const int gw = F.bid * NWAVES + F.wave, NGW = F.G * NWAVES;
    bf16_t* PROJ = (bf16_t*)(a.ws + WS_PROJ);
    const int grp = F.lane >> 2, part = F.lane & 3, isk = grp >> 3;
    float gq[16];
#pragma unroll
    for (int i = 0; i < 16; ++i) gq[i] = a.qk_g[isk * 64 + part * 16 + i];
    const float qs = isk ? 1.f : 0.125f * 1.4426950408889634f;
    float invf[8];
#pragma unroll
    for (int i = 0; i < 8; ++i) invf[i] = exp2f(-(float)i * 0.125f * 18.931568569324174f) * 0.15915494309189535f;
    for (int m = gw; m < MTOK; m += NGW) {
        u32x4* p = (u32x4*)(PROJ + (size_t)m * PS + C_QA + 16 * F.lane);
        const u32x4 w0 = p[0], w1 = p[1];
        float v[16];
        v[0] = bflo(w0.x); v[1] = bfhi(w0.x); v[2] = bflo(w0.y); v[3] = bfhi(w0.y); v[4] = bflo(w0.z); v[5] = bfhi(w0.z); v[6] = bflo(w0.w); v[7] = bfhi(w0.w);
        v[8] = bflo(w1.x); v[9] = bfhi(w1.x); v[10] = bflo(w1.y); v[11] = bfhi(w1.y); v[12] = bflo(w1.z); v[13] = bfhi(w1.z); v[14] = bflo(w1.w); v[15] = bfhi(w1.w);
        float s = 0.f;
#pragma unroll
        for (int i = 0; i < 16; ++i) s += v[i] * v[i];
        s += __shfl_xor(s, 1); s += __shfl_xor(s, 2);
        const float rstd = rsqrtf(s * (1.f / 64.f) + EPS);
#pragma unroll
        for (int i = 0; i < 16; ++i) v[i] = v[i] * rstd * gq[i];
        const float pos = (float)a.pos[m];
        float r[16];
#pragma unroll
        for (int i = 0; i < 8; ++i) { const float fr = __builtin_amdgcn_fractf(pos * invf[i]); const float sn = __builtin_amdgcn_sinf(fr), cs = __builtin_amdgcn_cosf(fr);
            r[i] = v[i] * cs - v[i + 8] * sn; r[i + 8] = v[i + 8] * cs + v[i] * sn; }
#pragma unroll
        for (int i = 0; i < 16; ++i) v[i] = (part == 0 ? r[i] : v[i]) * qs;
        u32x4 o0, o1;
        o0.x = pk2(v[0], v[1]); o0.y = pk2(v[2], v[3]); o0.z = pk2(v[4], v[5]); o0.w = pk2(v[6], v[7]);
        o1.x = pk2(v[8], v[9]); o1.y = pk2(v[10], v[11]); o1.z = pk2(v[12], v[13]); o1.w = pk2(v[14], v[15]);
        p[0] = o0; p[1] = o1;
    }
}

template <bool H0, bool H12>
DI void load_conv_tile(const Ctx& F, const Args& a, const bf16_t* projb, int c, int colbase, int chb, float scale, LAS unsigned char* img0,
                       const LAS float* rw1, LAS unsigned char* img1, const LAS float* rw2, LAS unsigned char* img2) {
    const int ch = F.tid & 15;
    float cw[5][8];
#pragma unroll
    for (int j = 0; j < 5; ++j) { const f32x4 c0 = *(const f32x4*)(a.conv_w + j * 1024 + chb + ch * 8), c1 = *(const f32x4*)(a.conv_w + j * 1024 + chb + ch * 8 + 4);
        cw[j][0] = c0.x; cw[j][1] = c0.y; cw[j][2] = c0.z; cw[j][3] = c0.w; cw[j][4] = c1.x; cw[j][5] = c1.y; cw[j][6] = c1.z; cw[j][7] = c1.w; }
#pragma unroll
    for (int it = 0; it < 2; ++it) {
        const int row = (F.tid >> 4) + 32 * it, t0 = c * 64 + row;
        float acc[8];
#pragma unroll
        for (int i = 0; i < 8; ++i) acc[i] = 0.f;
#pragma unroll
        for (int j = 0; j < 5; ++j) { const int tt = t0 + j - 2;
            if (tt >= 0 && tt < SEQ) { const u32x4 w = *(const u32x4*)(projb + (size_t)tt * PS + colbase + ch * 8);
                acc[0] += bflo(w.x) * cw[j][0]; acc[1] += bfhi(w.x) * cw[j][1]; acc[2] += bflo(w.y) * cw[j][2]; acc[3] += bfhi(w.y) * cw[j][3];
                acc[4] += bflo(w.z) * cw[j][4]; acc[5] += bfhi(w.z) * cw[j][5]; acc[6] += bflo(w.w) * cw[j][6]; acc[7] += bfhi(w.w) * cw[j][7]; } }
#pragma unroll
        for (int i = 0; i < 8; ++i) acc[i] = silu_f(acc[i]) * scale;
        const int off = row * 256 + ((ch ^ swz16(row)) << 4);
        if constexpr (H0) { u32x4 o; o.x = pk2(acc[0], acc[1]); o.y = pk2(acc[2], acc[3]); o.z = pk2(acc[4], acc[5]); o.w = pk2(acc[6], acc[7]); *(LAS u32x4*)(img0 + off) = o; }
        if constexpr (H12) { const float w = rw1[row]; u32x4 o; o.x = pk2(acc[0] * w, acc[1] * w); o.y = pk2(acc[2] * w, acc[3] * w); o.z = pk2(acc[4] * w, acc[5] * w); o.w = pk2(acc[6] * w, acc[7] * w); *(LAS u32x4*)(img1 + off) = o; }
        if constexpr (H12) { const float w = rw2[row]; u32x4 o; o.x = pk2(acc[0] * w, acc[1] * w); o.y = pk2(acc[2] * w, acc[3] * w); o.z = pk2(acc[4] * w, acc[5] * w); o.w = pk2(acc[6] * w, acc[7] * w); *(LAS u32x4*)(img2 + off) = o; }
    }
}
DI void load_plain_tile(const Ctx& F, const bf16_t* projb, int c, int colbase, LAS unsigned char* img) {
    const int ch = F.tid & 15;
#pragma unroll
    for (int it = 0; it < 2; ++it) { const int row = (F.tid >> 4) + 32 * it;
        const u32x4 w = *(const u32x4*)(projb + (size_t)(c * 64 + row) * PS + colbase + ch * 8);
        *(LAS u32x4*)(img + row * 256 + ((ch ^ swz16(row)) << 4)) = w; }
}
DI bf16x8 tr_frag_nat(const LAS unsigned char* img, int rowbase, int col0, int lane) {
    const int hh = lane >> 5, g16 = (lane >> 4) & 1, i = lane & 15;
    const int col = col0 + 16 * g16 + 4 * (i & 3), chunk = col >> 3, sub = (col & 7) * 2;
    const int r0 = rowbase + 8 * hh + (i >> 2), r1 = r0 + 4;
    const s16x4 lo = trread(img + r0 * 256 + ((chunk ^ swz16(r0)) << 4) + sub);
    const s16x4 hi = trread(img + r1 * 256 + ((chunk ^ swz16(r1)) << 4) + sub);
    return __builtin_shufflevector(lo, hi, 0, 1, 2, 3, 4, 5, 6, 7);
}
DI bf16x8 tr_frag_acc(const LAS unsigned char* img, int rowbase, int col0, int lane) {
    const int hh = lane >> 5, g16 = (lane >> 4) & 1, i = lane & 15;
    const int col = col0 + 16 * g16 + 4 * (i & 3), chunk = col >> 3, sub = (col & 7) * 2;
    const int r0 = rowbase + 4 * hh + (i >> 2), r1 = r0 + 8;
    const s16x4 lo = trread(img + r0 * 256 + ((chunk ^ swz16(r0)) << 4) + sub);
    const s16x4 hi = trread(img + r1 * 256 + ((chunk ^ swz16(r1)) << 4) + sub);
    return __builtin_shufflevector(lo, hi, 0, 1, 2, 3, 4, 5, 6, 7);
}
DI bf16x8 row_frag(const LAS unsigned char* img, int row, int chunk) { return *(const LAS bf16x8*)(img + row * 256 + ((chunk ^ swz16(row)) << 4)); }

DI void m1_item(const Ctx& F, const Args& a, int item) {
    const int c = item & 63, h = (item >> 6) & 3, b = item >> 8;
    const bf16_t* projb = (const bf16_t*)(a.ws + WS_PROJ) + (size_t)b * SEQ * PS;
    const float* GT = (const float*)(a.ws + WS_GATES) + (size_t)(b * SEQ + c * 64) * 16;
    float* MSC = (float*)(a.ws + WS_MSC);
    LAS unsigned char* KWF = F.lds; LAS unsigned char* KWB = F.lds + 16384; LAS unsigned char* VT = F.lds + 32768;
    LAS float* wsc = (LAS float*)(F.lds + 49152);
    if (F.wave < 2) {
        const int dir = F.wave, s = F.lane;
        const float ig = GT[s * 16 + dir * 8 + h], fg = GT[s * 16 + dir * 8 + 4 + h];
        float av = logsigmoid_f(fg);
        if (dir == 0) {
#pragma unroll
            for (int o = 1; o < 64; o <<= 1) { const float t = __shfl_up(av, o); if (s >= o) av += t; }
        } else {
#pragma unroll
            for (int o = 1; o < 64; o <<= 1) { const float t = __shfl_down(av, o); if (s + o < 64) av += t; }
        }
        const float g = __shfl(av, dir == 0 ? 63 : 0);
        const float wl = g - av + ig, ml = wave_max(wl);
        wsc[dir * 64 + s] = __expf(wl - ml);
        if (s == 0) { const int chain = (b * 4 + h) * 2 + dir; MSC[chain * 64 + c] = g; MSC[4096 + chain * 64 + c] = ml; }
    }
    __syncthreads();
    load_conv_tile<false, true>(F, a, projb, c, C_KM + h * 128, 512 + h * 128, 0.08838834764831845f, KWF, wsc, KWF, wsc + 64, KWB);
    load_plain_tile(F, projb, c, C_VM + h * 128, VT);
    __syncthreads();
    {
        const int dir = F.wave >> 2, kt = F.wave & 3, hh = F.lane >> 5;
        const LAS unsigned char* KW = dir ? KWB : KWF;
        bf16x8 af[4];
#pragma unroll
        for (int ks = 0; ks < 4; ++ks) af[ks] = tr_frag_nat(KW, 16 * ks, 32 * kt, F.lane);
        bf16_t* CT = (bf16_t*)a.out + ((size_t)((b * 4 + h) * 2 + dir) * 64 + c) * 16384;
#pragma unroll
        for (int vt = 0; vt < 4; ++vt) {
            f32x16 acc;
#pragma unroll
            for (int i = 0; i < 16; ++i) acc[i] = 0.f;
#pragma unroll
            for (int ks = 0; ks < 4; ++ks) { const bf16x8 bfv = tr_frag_nat(VT, 16 * ks, 32 * vt, F.lane); acc = MFMA32(af[ks], bfv, acc); }
            const int vdim = 32 * vt + (F.lane & 31);
#pragma unroll
            for (int rg = 0; rg < 4; ++rg) { u32x2 w; w.x = pk2(acc[4 * rg], acc[4 * rg + 1]); w.y = pk2(acc[4 * rg + 2], acc[4 * rg + 3]);
                *(u32x2*)(CT + (size_t)vdim * 128 + 32 * kt + 8 * rg + 4 * hh) = w; }
        }
    }
    if (F.tid < 256) {
        const int dir = F.tid >> 7, kd = F.tid & 127; const LAS unsigned char* KW = dir ? KWB : KWF;
        float s = 0.f;
#pragma unroll 8
        for (int r = 0; r < 64; ++r) s += bf2f(*(const LAS bf16_t*)(KW + r * 256 + (((kd >> 3) ^ swz16(r)) << 4) + (kd & 7) * 2));
        ((float*)(a.ws + WS_NLOC))[((size_t)((b * 4 + h) * 2 + dir) * 64 + c) * 128 + kd] = s;
    }
    __syncthreads();
}

DI void scan_task(const Ctx& F, const Args& a, int task) {
    const int chain = task >> 3, slab = task & 7, dir = chain & 1;
    float* MSC = (float*)(a.ws + WS_MSC);
    LAS float* sp = (LAS float*)F.lds; LAS float* sl = sp + 64;
    if (F.tid == 0) {
        float m = 0.f;
        for (int st = 0; st < 64; ++st) { const int c = dir ? 63 - st : st; const float g = MSC[chain * 64 + c], ml = MSC[4096 + chain * 64 + c];
            if (slab == 0) MSC[8192 + chain * 64 + c] = m;
            const float mn = fmaxf(g + m, ml); sp[c] = __expf(g + m - mn); sl[c] = __expf(ml - mn); m = mn; }
    }
    __syncthreads();
    bf16_t* base = (bf16_t*)a.out + (size_t)chain * 64 * 16384 + slab * 2048 + F.tid * 4;
    float s0 = 0.f, s1 = 0.f, s2 = 0.f, s3 = 0.f;
    for (int st0 = 0; st0 < 64; st0 += 8) {
        u32x2 v[8];
#pragma unroll
        for (int j = 0; j < 8; ++j) { const int c = dir ? 63 - (st0 + j) : st0 + j; v[j] = *(const u32x2*)(base + (size_t)c * 16384); }
#pragma unroll
        for (int j = 0; j < 8; ++j) { const int c = dir ? 63 - (st0 + j) : st0 + j;
            u32x2 o; o.x = pk2(s0, s1); o.y = pk2(s2, s3); *(u32x2*)(base + (size_t)c * 16384) = o;
            const float p = sp[c], l = sl[c];
            s0 = p * s0 + l * bflo(v[j].x); s1 = p * s1 + l * bfhi(v[j].x); s2 = p * s2 + l * bflo(v[j].y); s3 = p * s3 + l * bfhi(v[j].y); }
    }
    if (slab == 0 && F.tid < 128) {
        float* nb = (float*)(a.ws + WS_NLOC) + (size_t)chain * 64 * 128 + F.tid; float n = 0.f;
        for (int st = 0; st < 64; ++st) { const int c = dir ? 63 - st : st; const float v = nb[c * 128]; nb[c * 128] = n; n = sp[c] * n + sl[c] * v; }
    }
    __syncthreads();
}

DI void glds16(const void* g, LAS unsigned char* l) { __builtin_amdgcn_global_load_lds((const unsigned*)g, (LAS unsigned*)l, 16, 0, 0); }
DI void attn_unit(const Ctx& F, const Args& a, int b, int h, int qb, float lam, float cshift) {
    const int lane = F.lane, wid = F.wave, r32 = lane & 31, hh = lane >> 5;
    const bf16_t* projb = (const bf16_t*)(a.ws + WS_PROJ) + (size_t)b * SEQ * PS;
    const int qrow = qb * 256 + wid * 32 + r32;
    LAS unsigned char* Qw = F.lds + 65536 + wid * 8192 + hh * 512 + r32 * 16;
    { const bf16_t* qp = projb + (size_t)qrow * PS + C_QA + h * 128 + hh * 8;
#pragma unroll
      for (int p = 0; p < 2; ++p)
#pragma unroll
          for (int ks = 0; ks < 4; ++ks) *(LAS bf16x8*)(Qw + (p * 4 + ks) * 1024) = *(const bf16x8*)(qp + p * 64 + ks * 16); }
    unsigned koff[2], voff[2];
#pragma unroll
    for (int i = 0; i < 2; ++i) { const int pc = 2 * wid + i;
        koff[i] = (unsigned)(lane * PS + C_KA + h * 128 + pc * 8);
        voff[i] = (unsigned)((16 * (pc & 3) + (lane >> 2)) * PS + C_VA + h * 128 + 32 * (pc >> 2) + 8 * (lane & 3)); }
#define ATT_ISSUE(t, s) do { _Pragma("unroll") for (int _i = 0; _i < 2; ++_i) { \
        glds16(projb + (size_t)(t) * 64 * PS + koff[_i], F.lds + (s) * 32768 + (2 * wid + _i) * 1024); \
        glds16(projb + (size_t)(t) * 64 * PS + voff[_i], F.lds + (s) * 32768 + 16384 + (2 * wid + _i) * 1024); } } while (0)
    ATT_ISSUE(0, 0);
    f32x16 O[2][4];
#pragma unroll
    for (int p = 0; p < 2; ++p)
#pragma unroll
        for (int vt = 0; vt < 4; ++vt)
#pragma unroll
            for (int i = 0; i < 16; ++i) O[p][vt][i] = 0.f;
    float lsum0 = 0.f, lsum1 = 0.f;
    const int kfb = hh * 1024 + r32 * 16;
    const int vfb = 16384 + (4 * hh + ((lane & 15) >> 2)) * 64 + ((lane >> 4) & 1) * 32 + (lane & 3) * 8;
    asm volatile("s_waitcnt vmcnt(0)" ::: "memory");
    __syncthreads();
    for (int t = 0; t < 64; ++t) {
        const int s = t & 1;
        if (t + 1 < 64) ATT_ISSUE(t + 1, s ^ 1);
        const LAS unsigned char* Kb = F.lds + s * 32768 + kfb; const LAS unsigned char* Vb = F.lds + s * 32768 + vfb;
#pragma unroll 1
        for (int kt = 0; kt < 2; ++kt) {
            bf16x8 pb[2][2];
#pragma unroll
            for (int p = 0; p < 2; ++p) {
                f32x16 S;
#pragma unroll
                for (int i = 0; i < 16; ++i) S[i] = 0.f;
#pragma unroll
                for (int ks = 0; ks < 4; ++ks) S = MFMA32(*(const LAS bf16x8*)(Kb + p * 8192 + ks * 2048 + kt * 512), *(const LAS bf16x8*)(Qw + (p * 4 + ks) * 1024), S);
                float ls = 0.f;
#pragma unroll
                for (int i = 0; i < 16; ++i) { S[i] = __builtin_amdgcn_exp2f(S[i] - cshift); ls += S[i]; }
                if (p == 0) lsum0 += ls; else lsum1 += ls;
                u32x4 w0, w1;
                w0.x = pk2(S[0], S[1]); w0.y = pk2(S[2], S[3]); w0.z = pk2(S[4], S[5]); w0.w = pk2(S[6], S[7]);
                w1.x = pk2(S[8], S[9]); w1.y = pk2(S[10], S[11]); w1.z = pk2(S[12], S[13]); w1.w = pk2(S[14], S[15]);
                pb[p][0] = __builtin_bit_cast(bf16x8, w0); pb[p][1] = __builtin_bit_cast(bf16x8, w1);
            }
#pragma unroll
            for (int s2 = 0; s2 < 2; ++s2)
#pragma unroll
                for (int vt = 0; vt < 4; ++vt) {
                    const s16x4 lo = trread(Vb + vt * 4096 + (2 * kt + s2) * 1024), hi = trread(Vb + vt * 4096 + (2 * kt + s2) * 1024 + 512);
                    const bf16x8 vf = __builtin_shufflevector(lo, hi, 0, 1, 2, 3, 4, 5, 6, 7);
                    O[0][vt] = MFMA32(vf, pb[0][s2], O[0][vt]); O[1][vt] = MFMA32(vf, pb[1][s2], O[1][vt]); }
        }
        asm volatile("s_waitcnt vmcnt(0)" ::: "memory");
        __syncthreads();
    }
#undef ATT_ISSUE
    lsum0 += __shfl_xor(lsum0, 32); lsum1 += __shfl_xor(lsum1, 32);
    const float i0 = 1.f / lsum0, i1 = lam / lsum1;
    float ssq = 0.f;
#pragma unroll
    for (int vt = 0; vt < 4; ++vt)
#pragma unroll
        for (int i = 0; i < 16; ++i) { const float o = O[0][vt][i] * i0 - O[1][vt][i] * i1; O[0][vt][i] = o; ssq += o * o; }
    ssq += __shfl_xor(ssq, 32);
    const float rs = rsqrtf(ssq * (1.f / 128.f) + EPS) * 0.8f;
    bf16_t* yp = (bf16_t*)(a.ws + WS_YMIX) + (size_t)(b * SEQ + qrow) * DM + 512 + h * 128;
#pragma unroll
    for (int vt = 0; vt < 4; ++vt)
#pragma unroll
        for (int rg = 0; rg < 4; ++rg) { const int vd = 32 * vt + 8 * rg + 4 * hh; const f32x4 g = *(const f32x4*)(a.subln_g + vd);
            u32x2 w; w.x = pk2(O[0][vt][4 * rg] * rs * g.x, O[0][vt][4 * rg + 1] * rs * g.y); w.y = pk2(O[0][vt][4 * rg + 2] * rs * g.z, O[0][vt][4 * rg + 3] * rs * g.w);
            *(u32x2*)(yp + vd) = w; }
}

DI void m3_item(const Ctx& F, const Args& a, int item) {
    const int c = item & 63, h = (item >> 6) & 3, b = item >> 8;
    const int lane = F.lane, hh = lane >> 5, r32 = lane & 31;
    const bf16_t* projb = (const bf16_t*)(a.ws + WS_PROJ) + (size_t)b * SEQ * PS;
    const float* GT = (const float*)(a.ws + WS_GATES) + (size_t)(b * SEQ + c * 64) * 16;
    const float* MSC = (const float*)(a.ws + WS_MSC);
    LAS unsigned char* QT = F.lds; LAS unsigned char* KT = F.lds + 16384; LAS unsigned char* VT = F.lds + 32768;
    LAS unsigned char* SF = F.lds + 49152;
    LAS float* HT = (LAS float*)(F.lds + 65536);
    LAS float* scal = (LAS float*)(F.lds + 65536 + 33024);
    LAS float* rt = scal; LAS float* ct = scal + 128; LAS float* iw = scal + 256; LAS float* enm = scal + 384; LAS float* rden = scal + 512; LAS float* npv = scal + 640;
    const int chain0 = (b * 4 + h) * 2;
    if (F.wave < 2) {
        const int dir = F.wave, s = lane;
        const float ig = GT[s * 16 + dir * 8 + h], fg = GT[s * 16 + dir * 8 + 4 + h];
        float av = logsigmoid_f(fg);
        if (dir == 0) {
#pragma unroll
            for (int o = 1; o < 64; o <<= 1) { const float t = __shfl_up(av, o); if (s >= o) av += t; }
        } else {
#pragma unroll
            for (int o = 1; o < 64; o <<= 1) { const float t = __shfl_down(av, o); if (s + o < 64) av += t; }
        }
        const float cterm = ig - av;
        float cm = cterm;
        if (dir == 0) {
#pragma unroll
            for (int o = 1; o < 64; o <<= 1) { const float t = __shfl_up(cm, o); if (s >= o) cm = fmaxf(cm, t); }
        } else {
#pragma unroll
            for (int o = 1; o < 64; o <<= 1) { const float t = __shfl_down(cm, o); if (s + o < 64) cm = fmaxf(cm, t); }
        }
        const float mprev = MSC[8192 + (chain0 + dir) * 64 + c];
        const float il = av + mprev, mj = fmaxf(il, av + cm);
        rt[dir * 64 + s] = av - mj; ct[dir * 64 + s] = cterm; iw[dir * 64 + s] = __expf(il - mj); enm[dir * 64 + s] = __expf(-mj);
    } else if (F.wave < 6) {
        const int i = F.tid - 128; npv[i] = ((const float*)(a.ws + WS_NLOC))[((size_t)(chain0 + (i >> 7)) * 64 + c) * 128 + (i & 127)];
    }
    load_conv_tile<true, false>(F, a, projb, c, C_QM + h * 128, h * 128, 1.f, QT, rt, QT, rt, QT);
    load_conv_tile<true, false>(F, a, projb, c, C_KM + h * 128, 512 + h * 128, 0.08838834764831845f, KT, rt, KT, rt, KT);
    load_plain_tile(F, projb, c, C_VM + h * 128, VT);
    __syncthreads();
    {
        const int dir = F.wave >> 2, jt = (F.wave >> 1) & 1, st = F.wave & 1;
        f32x16 S;
#pragma unroll
        for (int i = 0; i < 16; ++i) S[i] = 0.f;
#pragma unroll
        for (int ks = 0; ks < 8; ++ks) S = MFMA32(row_frag(QT, 32 * jt + r32, 2 * ks + hh), row_frag(KT, 32 * st + r32, 2 * ks + hh), S);
        const int sc = 32 * st + r32; const float cts = ct[dir * 64 + sc];
        LAS unsigned char* SD = SF + dir * 8192;
#pragma unroll
        for (int i = 0; i < 16; ++i) { const int j = 32 * jt + crow(i, hh);
            const bool ok = dir == 0 ? (sc <= j) : (sc >= j);
            const float v = ok ? S[i] * __expf(rt[dir * 64 + j] + cts) : 0.f;
            *(LAS bf16_t*)(SD + j * 128 + (((sc >> 3) ^ (j & 7)) << 4) + (sc & 7) * 2) = (bf16_t)(pk2(v, 0.f) & 0xffffu); }
    }
    __syncthreads();
    if (F.tid < 128) {
        const int dir = F.tid >> 6, j = F.tid & 63; const LAS unsigned char* SD = SF + dir * 8192;
        float rsum = 0.f;
#pragma unroll
        for (int ch = 0; ch < 8; ++ch) { const u32x4 w = *(const LAS u32x4*)(SD + j * 128 + ((ch ^ (j & 7)) << 4));
            rsum += (bflo(w.x) + bfhi(w.x)) + (bflo(w.y) + bfhi(w.y)) + (bflo(w.z) + bfhi(w.z)) + (bflo(w.w) + bfhi(w.w)); }
        float qn = 0.f;
#pragma unroll
        for (int ch = 0; ch < 16; ++ch) { const u32x4 w = *(const LAS u32x4*)(QT + j * 256 + ((ch ^ swz16(j)) << 4)); const LAS float* np = npv + dir * 128 + ch * 8;
            qn += bflo(w.x) * np[0] + bfhi(w.x) * np[1] + bflo(w.y) * np[2] + bfhi(w.y) * np[3] + bflo(w.z) * np[4] + bfhi(w.z) * np[5] + bflo(w.w) * np[6] + bfhi(w.w) * np[7]; }
        const float den = rsum + iw[dir * 64 + j] * qn;
        rden[dir * 64 + j] = 1.f / fmaxf(fabsf(den), enm[dir * 64 + j]);
    }
    f32x16 accd[2];
    {
        const int jt = F.wave >> 2, vt = F.wave & 3;
#pragma unroll
        for (int dir = 0; dir < 2; ++dir) {
            f32x16 acc;
#pragma unroll
            for (int i = 0; i < 16; ++i) acc[i] = 0.f;
            const bf16_t* CT = (const bf16_t*)a.out + ((size_t)(chain0 + dir) * 64 + c) * 16384 + (size_t)(32 * vt + r32) * 128 + 8 * hh;
#pragma unroll
            for (int ks = 0; ks < 8; ++ks) acc = MFMA32(row_frag(QT, 32 * jt + r32, 2 * ks + hh), *(const bf16x8*)(CT + 16 * ks), acc);
#pragma unroll
            for (int i = 0; i < 16; ++i) acc[i] *= iw[dir * 64 + 32 * jt + crow(i, hh)];
            const LAS unsigned char* SD = SF + dir * 8192;
#pragma unroll
            for (int ks = 0; ks < 4; ++ks) { const int j = 32 * jt + r32;
                const bf16x8 af = *(const LAS bf16x8*)(SD + j * 128 + (((2 * ks + hh) ^ (j & 7)) << 4));
                acc = MFMA32(af, tr_frag_nat(VT, 16 * ks, 32 * vt, lane), acc); }
            accd[dir] = acc;
        }
    }
    __syncthreads();
    {
        const int jt = F.wave >> 2, vt = F.wave & 3;
#pragma unroll
        for (int i = 0; i < 16; ++i) { const int j = 32 * jt + crow(i, hh);
            HT[j * 129 + 32 * vt + r32] = accd[0][i] * rden[j] + accd[1][i] * rden[64 + j]; }
    }
    __syncthreads();
    {
        const int j = F.tid >> 3, q = F.tid & 7;
        float v[16]; float s = 0.f;
#pragma unroll
        for (int i = 0; i < 16; ++i) { v[i] = HT[j * 129 + q * 16 + i]; s += v[i] * v[i]; }
        s += __shfl_xor(s, 1); s += __shfl_xor(s, 2); s += __shfl_xor(s, 4);
        const float rstd = rsqrtf(s * (1.f / 128.f) + EPS);
        const size_t tok = (size_t)b * SEQ + c * 64 + j;
        const u32x4* omp = (const u32x4*)((const bf16_t*)(a.ws + WS_PROJ) + tok * PS + C_OM + h * 128 + q * 16);
        const u32x4 o0 = omp[0], o1 = omp[1];
        float om[16];
        om[0] = bflo(o0.x); om[1] = bfhi(o0.x); om[2] = bflo(o0.y); om[3] = bfhi(o0.y); om[4] = bflo(o0.z); om[5] = bfhi(o0.z); om[6] = bflo(o0.w); om[7] = bfhi(o0.w);
        om[8] = bflo(o1.x); om[9] = bfhi(o1.x); om[10] = bflo(o1.y); om[11] = bfhi(o1.y); om[12] = bflo(o1.z); om[13] = bfhi(o1.z); om[14] = bflo(o1.w); om[15] = bfhi(o1.w);
        float y[16];
#pragma unroll
        for (int i = 0; i < 16; ++i) y[i] = v[i] * rstd * a.mnorm_g[h * 128 + q * 16 + i] * sigmoid_f(om[i]);
        u32x4 w0, w1;
        w0.x = pk2(y[0], y[1]); w0.y = pk2(y[2], y[3]); w0.z = pk2(y[4], y[5]); w0.w = pk2(y[6], y[7]);
        w1.x = pk2(y[8], y[9]); w1.y = pk2(y[10], y[11]); w1.z = pk2(y[12], y[13]); w1.w = pk2(y[14], y[15]);
        u32x4* yp = (u32x4*)((bf16_t*)(a.ws + WS_YMIX) + tok * DM + h * 128 + q * 16);
        yp[0] = w0; yp[1] = w1;
    }
    __syncthreads();
}

DI void p7_phase(const Ctx& F, const Args& a) {
    LAS f32x4* WRL = (LAS f32x4*)F.lds;
    for (int q = F.tid; q < 4096; q += NTHR) { const int k = q >> 2, g = q & 3; WRL[(g * 2 + (k & 1)) * 512 + (k >> 1)] = *(const f32x4*)(a.w_router + k * 16 + g * 4); }
    __syncthreads();
    const int gw = F.bid * NWAVES + F.wave, NGW = F.G * NWAVES, lane = F.lane;
    const float* mod = (const float*)(a.ws + WS_MOD);
    bf16_t* H2 = (bf16_t*)(a.ws + WS_H2); float* AFF = (float*)(a.ws + WS_AFF);
    for (int m = gw; m < MTOK; m += NGW) {
        const int b = m / SEQ;
        const f32x2* xr = (const f32x2*)(a.out + (size_t)m * DM) + lane;
        f32x2 v[8]; float s = 0.f;
#pragma unroll
        for (int j = 0; j < 8; ++j) { v[j] = xr[64 * j]; s += v[j].x * v[j].x + v[j].y * v[j].y; }
        const float rstd = rsqrtf(wave_sum(s) * (1.f / DM) + EPS);
        float lg[16];
#pragma unroll
        for (int e = 0; e < 16; ++e) lg[e] = 0.f;
        unsigned* o4 = (unsigned*)(H2 + (size_t)m * DM) + lane;
#pragma unroll
        for (int j = 0; j < 8; ++j) {
            const f32x2 g = ((const f32x2*)a.norm2_g)[lane + 64 * j];
            const f32x2 sh = ((const f32x2*)(mod + (size_t)b * 6144 + 3072))[lane + 64 * j];
            const f32x2 sc = ((const f32x2*)(mod + (size_t)b * 6144 + 4096))[lane + 64 * j];
            const f32x2 hv = v[j] * rstd * g * (sc + 1.f) + sh;
            o4[64 * j] = pk2(hv.x, hv.y);
#pragma unroll
            for (int g4 = 0; g4 < 4; ++g4) { const f32x4 w0 = WRL[(g4 * 2 + 0) * 512 + lane + 64 * j], w1 = WRL[(g4 * 2 + 1) * 512 + lane + 64 * j];
                lg[g4 * 4 + 0] += hv.x * w0.x + hv.y * w1.x; lg[g4 * 4 + 1] += hv.x * w0.y + hv.y * w1.y; lg[g4 * 4 + 2] += hv.x * w0.z + hv.y * w1.z; lg[g4 * 4 + 3] += hv.x * w0.w + hv.y * w1.w; }
            __builtin_amdgcn_sched_barrier(0);
        }
        float r8[8];
#pragma unroll
        for (int i = 0; i < 8; ++i) { const float keep = hh_sel(lane, 32) ? lg[8 + i] : lg[i], send = hh_sel(lane, 32) ? lg[i] : lg[8 + i]; r8[i] = keep + __shfl_xor(send, 32); }
        float r4[4];
#pragma unroll
        for (int i = 0; i < 4; ++i) { const float keep = hh_sel(lane, 16) ? r8[4 + i] : r8[i], send = hh_sel(lane, 16) ? r8[i] : r8[4 + i]; r4[i] = keep + __shfl_xor(send, 16); }
        float r2[2];
#pragma unroll
        for (int i = 0; i < 2; ++i) { const float keep = hh_sel(lane, 8) ? r4[2 + i] : r4[i], send = hh_sel(lane, 8) ? r4[i] : r4[2 + i]; r2[i] = keep + __shfl_xor(send, 8); }
        float lgt; { const float keep = hh_sel(lane, 4) ? r2[1] : r2[0], send = hh_sel(lane, 4) ? r2[0] : r2[1]; lgt = keep + __shfl_xor(send, 4); }
        lgt += __shfl_xor(lgt, 2); lgt += __shfl_xor(lgt, 1);
        float mx = lgt;
#pragma unroll
        for (int o = 4; o < 64; o <<= 1) mx = fmaxf(mx, __shfl_xor(mx, o));
        const float ex = __expf(lgt - mx); float sm = ex;
#pragma unroll
        for (int o = 4; o < 64; o <<= 1) sm += __shfl_xor(sm, o);
        if ((lane & 3) == 0) AFF[(size_t)m * 16 + (lane >> 2)] = ex / sm;
    }
    __syncthreads();
}

DI void topk_task(const Ctx& F, const Args& a, int task) {
    const int b = task >> 4, e = task & 15, tid = F.tid, lane = F.lane;
    const float* AFF = (const float*)(a.ws + WS_AFF) + (size_t)b * SEQ * 16 + e;
    LAS unsigned* hist = (LAS unsigned*)F.lds;
    LAS unsigned* sfx = hist + 256;
    LAS unsigned* misc = hist + 512;
    LAS int* lidx = (LAS int*)(F.lds + 4096);
    unsigned key[8];
#pragma unroll
    for (int i = 0; i < 8; ++i) key[i] = __float_as_uint(AFF[(size_t)(tid * 8 + i) * 16]);
    unsigned prefix = 0, krem = CAP;
#pragma unroll 1
    for (int pass = 0; pass < 4; ++pass) {
        const int shift = 24 - 8 * pass;
        if (tid < 256) hist[tid] = 0;
        __syncthreads();
#pragma unroll
        for (int i = 0; i < 8; ++i) { const bool in = pass == 0 ? true : ((key[i] >> (shift + 8)) == (prefix >> (shift + 8))); if (in) atomicAdd((unsigned*)&hist[(key[i] >> shift) & 255u], 1u); }
        __syncthreads();
        if (tid < 256) sfx[tid] = hist[tid];
        __syncthreads();
#pragma unroll 1
        for (int o = 1; o < 256; o <<= 1) { unsigned v = 0; if (tid < 256) v = sfx[tid] + (tid + o < 256 ? sfx[tid + o] : 0u); __syncthreads(); if (tid < 256) sfx[tid] = v; __syncthreads(); }
        if (tid < 256) { const unsigned incl = sfx[tid], excl = incl - hist[tid]; if (excl < krem && krem <= incl) { misc[0] = (unsigned)tid; misc[1] = krem - excl; } }
        __syncthreads();
        prefix |= misc[0] << shift; krem = misc[1];
        __syncthreads();
    }
    const unsigned T = prefix, need = krem;
    unsigned cg_ = 0, ce = 0;
#pragma unroll
    for (int i = 0; i < 8; ++i) { cg_ += key[i] > T; ce += key[i] == T; }
    unsigned sg = cg_, se = ce;
#pragma unroll
    for (int o = 1; o < 64; o <<= 1) { const unsigned tg = __shfl_up(sg, o), te = __shfl_up(se, o); if (lane >= o) { sg += tg; se += te; } }
    if (lane == 63) { misc[16 + F.wave] = sg; misc[32 + F.wave] = se; }
    __syncthreads();
    unsigned og = sg - cg_, oe = se - ce;
    for (int w = 0; w < F.wave; ++w) { og += misc[16 + w]; oe += misc[32 + w]; }
    int* SLOT = (int*)(a.ws + WS_SLOT) + (size_t)b * SEQ * 16 + e;
    float* VALS = (float*)(a.ws + WS_VALS) + (size_t)(e * 8 + b) * CAP;
    int* IDX = (int*)(a.ws + WS_IDX) + (size_t)(b * 16 + e) * CAP;
#pragma unroll
    for (int i = 0; i < 8; ++i) {
        const bool gt = key[i] > T, eq = key[i] == T; const bool sel = gt || (eq && oe < need);
        const unsigned pos = og + (oe < need ? oe : need);
        const int s = tid * 8 + i;
        SLOT[(size_t)s * 16] = sel ? (int)pos : -1;
        if (sel) { lidx[pos] = s; IDX[pos] = s; VALS[pos] = __uint_as_float(key[i]); }
        og += gt; oe += eq;
    }
    __syncthreads();
    const bf16_t* H2 = (const bf16_t*)(a.ws + WS_H2) + (size_t)b * SEQ * DM; bf16_t* XE = (bf16_t*)(a.ws + WS_XE) + (size_t)(e * 8 + b) * CAP * DM;
    for (int r = F.wave; r < CAP; r += NWAVES) { const u32x4* src = (const u32x4*)(H2 + (size_t)lidx[r] * DM) + lane; u32x4* dst = (u32x4*)(XE + (size_t)r * DM) + lane;
        const u32x4 v0 = src[0], v1 = src[64]; dst[0] = v0; dst[64] = v1; }
    __syncthreads();
}

DI void final_phase(const Ctx& F, const Args& a) {
    const int gw = F.bid * NWAVES + F.wave, NGW = F.G * NWAVES, lane = F.lane;
    const float* mod = (const float*)(a.ws + WS_MOD); const int* SLOT = (const int*)(a.ws + WS_SLOT); const bf16_t* Y = (const bf16_t*)(a.ws + WS_XE);
    for (int m = gw; m < MTOK; m += NGW) {
        const int b = m / SEQ;
        const int sl = SLOT[(size_t)m * 16 + (lane & 15)];
        float acc[16];
#pragma unroll
        for (int i = 0; i < 16; ++i) acc[i] = 0.f;
#pragma unroll 1
        for (int e = 0; e < 16; ++e) { const int s = __shfl(sl, e);
            if (s >= 0) { const u32x4* yp = (const u32x4*)(Y + ((size_t)(e * 8 + b) * CAP + s) * DM + lane * 16); const u32x4 w0 = yp[0], w1 = yp[1];
                acc[0] += bflo(w0.x); acc[1] += bfhi(w0.x); acc[2] += bflo(w0.y); acc[3] += bfhi(w0.y); acc[4] += bflo(w0.z); acc[5] += bfhi(w0.z); acc[6] += bflo(w0.w); acc[7] += bfhi(w0.w);
                acc[8] += bflo(w1.x); acc[9] += bfhi(w1.x); acc[10] += bflo(w1.y); acc[11] += bfhi(w1.y); acc[12] += bflo(w1.z); acc[13] += bfhi(w1.z); acc[14] += bflo(w1.w); acc[15] += bfhi(w1.w); } }
        f32x4* op = (f32x4*)(a.out + (size_t)m * DM + lane * 16); const f32x4* gp = (const f32x4*)(mod + (size_t)b * 6144 + 5120 + lane * 16);
#pragma unroll
        for (int q = 0; q < 4; ++q) { const f32x4 g = gp[q]; f32x4 o = op[q]; o.x += g.x * acc[4 * q]; o.y += g.y * acc[4 * q + 1]; o.z += g.z * acc[4 * q + 2]; o.w += g.w * acc[4 * q + 3]; op[q] = o; }
    }
}

static_assert(sizeof(Args) == 22 * 8, "Args layout");
__global__ void __launch_bounds__(NTHR, 2) fwd_kernel(Args a_unused) {
    extern __shared__ __attribute__((aligned(16))) unsigned char lds_raw[];
    cg::grid_group grid = cg::this_grid();
    Ctx F; F.lds = (LAS unsigned char*)lds_raw; F.tid = threadIdx.x; F.lane = F.tid & 63; F.wave = __builtin_amdgcn_readfirstlane(F.tid >> 6); F.G = gridDim.x; F.bid = blockIdx.x;
    int lo, hi; { const Args a0 = load_args(); lo = a0.ph_lo; hi = a0.ph_hi; }
#ifndef PHASE_MASK
#define PHASE_MASK 0xffff
#endif
#define IN(k) (((PHASE_MASK >> (k)) & 1) && lo <= (k) && (k) < hi)
#define SEAM(k) do { if (IN(k) && IN((k) + 1)) grid.sync(); } while (0)
    if (IN(0)) { const Args a = load_args(); p0_phase(F, a); }
    SEAM(0);
    if (IN(1)) { const Args a = load_args(); p1_phase(F, a); }
    SEAM(1);
    if (IN(2)) {
        const Args a = load_args();
        pg8::Gemm g{(const bf16_t*)a.out, (const bf16_t*)(a.ws + WS_WINT), MTOK, PS, DM, 1 << 30}; pg8::StaticOrder S; S.init(MTOK, PS, F.G, F.bid);
        pg8::EpiBf16 E{(bf16_t*)(a.ws + WS_PROJ), PS};
        pg8::gemm_phase<pg8::EpiBf16, true, true>(F.lds, g, S, E);
        gates_tasks(F, a);
    }
    SEAM(2);
    if (IN(3)) {
        const Args a = load_args();
        qknorm_rows(F, a);
        for (int it = F.bid; it < BATCH * 4 * 64; it += F.G) m1_item(F, a, it);
    }
    SEAM(3);
    if (IN(4)) {
        const Args a = load_args();
        for (int t = F.bid; t < 512; t += F.G) scan_task(F, a, t);
        float lam, cshift;
        { const float p01 = wave_sum(a.lam_p[F.lane] * a.lam_p[64 + F.lane]), p23 = wave_sum(a.lam_p[128 + F.lane] * a.lam_p[192 + F.lane]);
          lam = __expf(p01) - __expf(p23) + 0.2f;
          const float gq = wave_max(fabsf(a.qk_g[F.lane])), gk = wave_max(fabsf(a.qk_g[64 + F.lane]));
          cshift = 8.f * gq * gk * 1.4426950408889634f * 1.02f; }
        const int xcd = F.bid & 7, j = F.bid >> 3;
        for (int i = 0; i * F.G < 512; ++i) {
            int u;
            if (F.G == 256) u = (xcd * 4 + 2 * i + (j >> 4)) * 16 + (j & 15); else u = i * F.G + F.bid;
            if (u < 512) attn_unit(F, a, u >> 6, (u >> 4) & 3, u & 15, lam, cshift);
        }
    }
    SEAM(4);
    if (IN(5)) { const Args a = load_args(); for (int it = F.bid; it < BATCH * 4 * 64; it += F.G) m3_item(F, a, it); }
    SEAM(5);
    if (IN(6)) {
        const Args a = load_args();
        pg8::Gemm g{(const bf16_t*)(a.ws + WS_YMIX), (const bf16_t*)(a.ws + WS_WOUTT), MTOK, DM, DM, 1 << 30}; pg8::StaticOrder S; S.init(MTOK, DM, F.G, F.bid);
        pg8::EpiX1 E{a.x, (const float*)(a.ws + WS_MOD), a.out};
        pg8::gemm_phase<pg8::EpiX1, true, true>(F.lds, g, S, E);
    }
    SEAM(6);
    if (IN(7)) { const Args a = load_args(); p7_phase(F, a); }
    SEAM(7);
    if (IN(8)) { const Args a = load_args(); for (int t = F.bid; t < BATCH * NEXP; t += F.G) topk_task(F, a, t); }
    SEAM(8);
#pragma unroll 1
    for (int half = 0; half < 2; ++half) {
        if (IN(9 + 2 * half)) {
            const Args a = load_args();
            pg8::Gemm g{(const bf16_t*)(a.ws + WS_XE) + (size_t)half * 32768 * DM, (const bf16_t*)(a.ws + WS_WGUT) + (size_t)half * 8 * 4096 * DM, 32768, 4096, DM, 16};
            pg8::StaticOrder S; S.init(32768, 4096, F.G, F.bid);
            pg8::EpiGU E{(bf16_t*)(a.ws + WS_HH)};
            pg8::gemm_phase<pg8::EpiGU, true, true>(F.lds, g, S, E);
        }
        SEAM(9 + 2 * half);
        if (IN(10 + 2 * half)) {
            const Args a = load_args();
            pg8::Gemm g{(const bf16_t*)(a.ws + WS_HH), (const bf16_t*)(a.ws + WS_WDT) + (size_t)half * 8 * DM * DFF, 32768, DM, DFF, 16};
            pg8::StaticOrder S; S.init(32768, DM, F.G, F.bid);
            pg8::EpiDown E{(bf16_t*)(a.ws + WS_XE) + (size_t)half * 32768 * DM, (const float*)(a.ws + WS_VALS) + (size_t)half * 32768};
            pg8::gemm_phase<pg8::EpiDown, true, true>(F.lds, g, S, E);
        }
        SEAM(10 + 2 * half);
    }
    if (IN(13)) { const Args a = load_args(); final_phase(F, a); }
#undef IN
#undef SEAM
}

extern "C" void kernel_launch(void* const* d_in, const int* in_sizes, int n_in, void* d_out, int out_size, void* d_ws, size_t ws_size, hipStream_t stream) {
    static int grid_blocks = 0;
    if (!grid_blocks) {
        int dev = 0, cus = 0, per_cu = 0;
        (void)hipGetDevice(&dev);
        (void)hipDeviceGetAttribute(&cus, hipDeviceAttributeMultiprocessorCount, dev);
        (void)hipFuncSetAttribute((const void*)fwd_kernel, hipFuncAttributeMaxDynamicSharedMemorySize, LDS_BYTES);
        (void)hipOccupancyMaxActiveBlocksPerMultiprocessor(&per_cu, (const void*)fwd_kernel, NTHR, LDS_BYTES);
        if (per_cu < 1) per_cu = 1;
        grid_blocks = cus;
        if (ws_size < WS_END) fprintf(stderr, "kernel_launch: workspace too small: %zu < %zu\n", ws_size, (size_t)WS_END);
    }
    Args a{};
    a.x = (const float*)d_in[0]; a.c = (const float*)d_in[1]; a.pos = (const int*)d_in[2]; a.norm1_g = (const float*)d_in[3]; a.norm2_g = (const float*)d_in[4];
    a.w_ada = (const float*)d_in[5]; a.b_ada = (const float*)d_in[6]; a.w_in = (const float*)d_in[7]; a.conv_w = (const float*)d_in[8]; a.gate_b = (const float*)d_in[9];
    a.mnorm_g = (const float*)d_in[10]; a.qk_g = (const float*)d_in[11]; a.lam_p = (const float*)d_in[12]; a.subln_g = (const float*)d_in[13]; a.w_out = (const float*)d_in[14];
    a.w_router = (const float*)d_in[15]; a.w_gate = (const float*)d_in[16]; a.w_up = (const float*)d_in[17]; a.w_down = (const float*)d_in[18];
    a.out = (float*)d_out; a.ws = (unsigned char*)d_ws; a.ph_lo = 0; a.ph_hi = 14;
    void* args[] = {&a};
    hipError_t e = hipLaunchCooperativeKernel((const void*)fwd_kernel, dim3(grid_blocks), dim3(NTHR), args, LDS_BYTES, stream);
    if (e != hipSuccess) fprintf(stderr, "cooperative launch failed: %s (grid %d)\n", hipGetErrorString(e), grid_blocks);
}
```

```cpp
#include <hip/hip_runtime.h>
#include <hip/hip_cooperative_groups.h>
#include <cstdio>
#include <cstdint>
namespace cg = cooperative_groups;

#define LAS __attribute__((address_space(3)))
#define DI __device__ __forceinline__
typedef unsigned short bf16_t;
typedef short bf16x8 __attribute__((ext_vector_type(8)));
typedef short s16x4 __attribute__((ext_vector_type(4)));
typedef float f32x2 __attribute__((ext_vector_type(2)));
typedef float f32x4 __attribute__((ext_vector_type(4)));
typedef float f32x16 __attribute__((ext_vector_type(16)));
typedef unsigned u32x2 __attribute__((ext_vector_type(2)));
typedef unsigned u32x4 __attribute__((ext_vector_type(4)));
typedef __bf16 bf16x2_t __attribute__((ext_vector_type(2)));

constexpr int BATCH = 8, SEQ = 4096, DM = 1024, MTOK = BATCH * SEQ;
constexpr int DIN = 3600, PS = 3584;
constexpr int NEXP = 16, CAP = 512, DFF = 2048;
constexpr int NPAIR = BATCH * NEXP * CAP;
constexpr float EPS = 1e-6f;
constexpr int C_QM = 0, C_KM = 512, C_VM = 1024, C_OM = 1536, C_QA = 2048, C_KA = 2560, C_VA = 3072;

constexpr size_t MiB = 1u << 20;
constexpr size_t WS_MOD = 1 * MiB;
constexpr size_t WS_GATES = 2 * MiB;
constexpr size_t WS_AFF = 4 * MiB;
constexpr size_t WS_IDX = 6 * MiB;
constexpr size_t WS_VALS = 6 * MiB + 256 * 1024;
constexpr size_t WS_MSC = 6 * MiB + 512 * 1024;
constexpr size_t WS_SLOT = 7 * MiB;
constexpr size_t WS_NLOC = 9 * MiB;
constexpr size_t WS_WINT = 11 * MiB;
constexpr size_t WS_WGT = 18 * MiB;
constexpr size_t WS_WOUTT = 19 * MiB;
constexpr size_t WS_WGUT = 21 * MiB;
constexpr size_t WS_WDT = 149 * MiB;
constexpr size_t WS_PROJ = 213 * MiB;
constexpr size_t WS_YMIX = 437 * MiB;
constexpr size_t WS_KIMG = 437 * MiB;
constexpr size_t WS_VIMG = 469 * MiB;
constexpr size_t WS_YA = 501 * MiB;
constexpr size_t WS_H2 = 213 * MiB;
constexpr size_t WS_XE = 277 * MiB;
constexpr size_t WS_HH = 405 * MiB;
constexpr size_t WS_END = 533 * MiB;

constexpr int LDS_BYTES = 147456;
constexpr int PROBE_PHASE = -1;
constexpr int REP_M1 = 1, REP_M3 = 1, REP_UP = 1, REP_P0 = 1, REP_SCAN = 1, REP_P7 = 1, REP_ATT = 1, REP_QKT = 1;
constexpr int NWAVES = 8, NTHR = 512;

DI unsigned pk2(float lo, float hi) { f32x2 v = {lo, hi}; bf16x2_t b = __builtin_convertvector(v, bf16x2_t); return __builtin_bit_cast(unsigned, b); }
DI float bflo(unsigned w) { return __uint_as_float(w << 16); }
DI float bfhi(unsigned w) { return __uint_as_float(w & 0xffff0000u); }
DI float bf2f(bf16_t v) { return __uint_as_float((unsigned)v << 16); }
DI float wave_sum(float v) {
#pragma unroll
    for (int o = 1; o < 64; o <<= 1) v += __shfl_xor(v, o);
    return v;
}
DI float wave_max(float v) {
#pragma unroll
    for (int o = 1; o < 64; o <<= 1) v = fmaxf(v, __shfl_xor(v, o));
    return v;
}
DI float silu_f(float v) { return v / (1.f + __expf(-v)); }
DI float sigmoid_f(float v) { return 1.f / (1.f + __expf(-v)); }
DI float logsigmoid_f(float f) { return fminf(f, 0.f) - log1pf(__expf(-fabsf(f))); }
DI int swz16(int row) { return ((row & 3) << 2) | ((row >> 2) & 3); }
#define MFMA32(a, b, c) __builtin_amdgcn_mfma_f32_32x32x16_bf16((a), (b), (c), 0, 0, 0)
DI s16x4 trread(const LAS unsigned char* p) { return __builtin_bit_cast(s16x4, __builtin_amdgcn_ds_read_tr16_b64_v4i16((LAS s16x4*)p)); }
DI int crow(int r, int hh) { return (r & 3) + 8 * (r >> 2) + 4 * hh; }
DI bool hh_sel(int lane, int bit) { return (lane & bit) != 0; }

namespace pg8 {
constexpr int BM = 256, BK = 64, HALF = 128, HTB = HALF * BK * 2, STAGE_BYTES = 8 * HTB, NXCD = 8, WGM = 8;
DI int lds_byte(int r, int c) { const int st = (r >> 4) * 2 + (c >> 5), rr = r & 15, cc = c & 31, ob = rr * 64 + cc * 2; return st * 1024 + (ob ^ (((ob >> 9) & 1) << 5)); }
DI void stage_rc(int b, int& R, int& C) { const int st = b / 1024, sb = b % 1024, swz = sb ^ (((sb >> 9) & 1) << 5); R = (st >> 1) * 16 + swz / 64; C = (st & 1) * 32 + (swz % 64) / 2; }
DI int perm32(int rho) { const int n = rho >> 4, i = rho & 15; return 8 * (i >> 2) + 4 * n + (i & 3); }
struct Unit { int pm, pn; };
struct Gemm { const bf16_t* A; const bf16_t* Bt; int M, N, K, tpg; };
struct StaticOrder {
    int nM, nN, nwg, G, c;
    DI void init(int M, int N, int G_, int c_) { nM = M / BM; nN = N / BM; nwg = nM * nN; G = G_; c = c_; }
    DI bool next(int i, Unit& u) const {
        const long L = (long)i * G + c; if (L >= nwg) return false;
        int wgid = (int)L; { const int q = nwg / NXCD, r = nwg % NXCD, xcd = wgid % NXCD, off = wgid / NXCD; wgid = (xcd < r ? xcd * (q + 1) : r * (q + 1) + (xcd - r) * q) + off; }
        const int nig = WGM * nN, gid = wgid / nig, fm = gid * WGM, gsz = (nM - fm) < WGM ? (nM - fm) : WGM;
        u.pm = fm + ((wgid % nig) % gsz); u.pn = (wgid % nig) / gsz; return true;
    }
};

template <class Epi, bool ALIGN_EPI, bool SP2>
DI void gemm_phase(LAS unsigned char* lds, const Gemm g, const StaticOrder& S, const Epi& E) {
    const int tid = threadIdx.x, wid = __builtin_amdgcn_readfirstlane(tid >> 6), lane = tid & 63, wr = wid >> 2, wc = wid & 3, fr = lane & 15, fq = lane >> 4;
    const int K = g.K, nt = K / BK;
    unsigned voffA[2], voffB[2];
#pragma unroll
    for (int i = 0; i < 2; ++i) { int R, C; stage_rc(tid * 16 + i * 8192, R, C); const int Rb = Epi::PERM ? ((R & ~31) + perm32(R & 31)) : R;
        voffA[i] = (unsigned)(R * K + C) * 2u; voffB[i] = (unsigned)(Rb * K + C) * 2u; }
    const size_t kstep = (size_t)(BK * 2);
    const size_t hstep = (size_t)HALF * K * 2;
    const size_t tstep = 2 * hstep;
    const size_t gstep = (size_t)g.N * K * 2;
    const unsigned ldsw = (unsigned)wid * 1024u;
    const int aoff = lds_byte(wr * 64 + fr, fq * 8), boff = lds_byte(wc * 32 + fr, fq * 8);
#define PG8_SA(b, h) (((b) * 2 + (h)) * HTB)
#define PG8_SB(b, h) ((4 + (b) * 2 + (h)) * HTB)
#define PG8_STAGE(bufoff, gbase, voff) do { _Pragma("unroll") for (int _i = 0; _i < 2; ++_i) \
        __builtin_amdgcn_global_load_lds((const unsigned*)((const char*)(gbase) + (voff)[_i]), (LAS unsigned*)(lds + (bufoff) + ldsw + _i * 8192), 16, 0, 0); } while (0)
#define PG8_LDA(dst, b, h) do { _Pragma("unroll") for (int m = 0; m < 4; ++m) _Pragma("unroll") for (int k = 0; k < 2; ++k) dst[m][k] = *(const LAS bf16x8*)(lds + PG8_SA(b, h) + aoff + m * 2048 + k * 1024); } while (0)
#define PG8_LDB(dst, b, h) do { _Pragma("unroll") for (int n = 0; n < 2; ++n) _Pragma("unroll") for (int k = 0; k < 2; ++k) dst[n][k] = *(const LAS bf16x8*)(lds + PG8_SB(b, h) + boff + n * 2048 + k * 1024); } while (0)
#define PG8_MMA(ai, bj, At, Bt) do { __builtin_amdgcn_s_setprio(1); _Pragma("unroll") for (int m = 0; m < 4; ++m) _Pragma("unroll") for (int n = 0; n < 2; ++n) _Pragma("unroll") for (int k = 0; k < 2; ++k) \
        acc[ai][bj][m][n] = __builtin_amdgcn_mfma_f32_16x16x32_bf16(Bt[n][k], At[m][k], acc[ai][bj][m][n], 0, 0, 0); __builtin_amdgcn_s_setprio(0); } while (0)
#define PG8_WAIT_V(n) asm volatile("s_waitcnt vmcnt(" #n ")" ::: "memory")
#define PG8_WAIT_L(n) asm volatile("s_waitcnt lgkmcnt(" #n ")" ::: "memory")
#define PG8_BAR __builtin_amdgcn_s_barrier()
#define PG8_SCHED __builtin_amdgcn_sched_barrier(0)
    Unit cur, nxt; int ui = 0;
    if (!S.next(0, cur)) return;
    f32x4 acc[2][2][4][2];
#pragma unroll
    for (int a = 0; a < 2; ++a)
#pragma unroll
        for (int b = 0; b < 2; ++b)
#pragma unroll
            for (int m = 0; m < 4; ++m)
#pragma unroll
                for (int n = 0; n < 2; ++n) acc[a][b][m][n] = (f32x4){0.f, 0.f, 0.f, 0.f};
    bf16x8 At[4][2], B0[2][2], B1[2][2];
    const char* cA = (const char*)g.A + (size_t)cur.pm * tstep; const char* cB = (const char*)g.Bt + (size_t)(cur.pm / g.tpg) * gstep + (size_t)cur.pn * tstep;
    if constexpr (SP2) {
        PG8_STAGE(PG8_SB(0, 0), cB, voffB); PG8_STAGE(PG8_SB(0, 1), cB + hstep, voffB); PG8_STAGE(PG8_SA(0, 0), cA, voffA); PG8_STAGE(PG8_SA(0, 1), cA + hstep, voffA);
        if (wr == 1) PG8_BAR;
        PG8_WAIT_V(2); PG8_BAR;
        PG8_STAGE(PG8_SB(1, 0), cB + kstep, voffB); PG8_STAGE(PG8_SA(1, 0), cA + kstep, voffA); PG8_STAGE(PG8_SB(1, 1), cB + hstep + kstep, voffB);
        PG8_WAIT_V(6); PG8_BAR;
    } else {
        PG8_STAGE(PG8_SB(0, 0), cB, voffB); PG8_STAGE(PG8_SA(0, 0), cA, voffA); PG8_STAGE(PG8_SB(0, 1), cB + hstep, voffB); PG8_STAGE(PG8_SA(0, 1), cA + hstep, voffA);
        if (wr == 1) PG8_BAR;
        PG8_WAIT_V(4); PG8_BAR;
        PG8_STAGE(PG8_SB(1, 0), cB + kstep, voffB); PG8_STAGE(PG8_SA(1, 0), cA + kstep, voffA); PG8_STAGE(PG8_SB(1, 1), cB + hstep + kstep, voffB);
        PG8_WAIT_V(6); PG8_BAR;
    }
    for (;;) {
        const bool has_next = S.next(ui + 1, nxt);
        const char* nA = has_next ? (const char*)g.A + (size_t)nxt.pm * tstep : cA;
        const char* nB = has_next ? (const char*)g.Bt + (size_t)(nxt.pm / g.tpg) * gstep + (size_t)nxt.pn * tstep : cB;
        for (int t = 0; t < nt; t += 2) {
            const bool last = (t == nt - 2);
            const char* a1 = cA + (size_t)(t + 1) * kstep;
            const char* a2 = last ? nA : cA + (size_t)(t + 2) * kstep; const char* b2 = last ? nB : cB + (size_t)(t + 2) * kstep;
            const char* a3 = a2 + kstep; const char* b3 = b2 + kstep;
            if constexpr (SP2) {
            PG8_LDB(B0, 0, 0); PG8_LDB(B1, 0, 1); PG8_SCHED; PG8_LDA(At, 0, 0); PG8_STAGE(PG8_SA(1, 1), a1 + hstep, voffA);
            PG8_WAIT_V(8); PG8_WAIT_L(0); PG8_BAR; PG8_MMA(0, 0, At, B0); PG8_MMA(0, 1, At, B1); PG8_BAR; PG8_SCHED;
            PG8_LDA(At, 0, 1); PG8_STAGE(PG8_SB(0, 0), b2, voffB); PG8_STAGE(PG8_SB(0, 1), b2 + hstep, voffB); PG8_STAGE(PG8_SA(0, 0), a2, voffA);
            PG8_WAIT_V(8); PG8_WAIT_L(0); PG8_BAR; PG8_MMA(1, 0, At, B0); PG8_MMA(1, 1, At, B1); PG8_BAR; PG8_SCHED;
            PG8_LDB(B0, 1, 0); PG8_LDB(B1, 1, 1); PG8_SCHED; PG8_LDA(At, 1, 0); PG8_STAGE(PG8_SA(0, 1), a2 + hstep, voffA);
            PG8_WAIT_V(8); PG8_WAIT_L(0); PG8_BAR; PG8_MMA(0, 0, At, B0); PG8_MMA(0, 1, At, B1); PG8_BAR; PG8_SCHED;
            PG8_LDA(At, 1, 1); PG8_STAGE(PG8_SB(1, 0), b3, voffB); PG8_STAGE(PG8_SB(1, 1), b3 + hstep, voffB); PG8_STAGE(PG8_SA(1, 0), a3, voffA);
            PG8_WAIT_V(8); PG8_WAIT_L(0); PG8_BAR; PG8_MMA(1, 0, At, B0); PG8_MMA(1, 1, At, B1); PG8_BAR; PG8_SCHED;
            } else {
            PG8_LDB(B0, 0, 0); PG8_SCHED; PG8_LDA(At, 0, 0); PG8_STAGE(PG8_SA(1, 1), a1 + hstep, voffA);
            PG8_WAIT_L(8); PG8_BAR; PG8_WAIT_L(0); PG8_MMA(0, 0, At, B0); PG8_BAR; PG8_SCHED;
            PG8_LDB(B1, 0, 1); PG8_STAGE(PG8_SB(0, 0), b2, voffB);
            PG8_BAR; PG8_WAIT_L(0); PG8_MMA(0, 1, At, B1); PG8_BAR;
            PG8_LDA(At, 0, 1); PG8_STAGE(PG8_SA(0, 0), a2, voffA);
            PG8_BAR; PG8_WAIT_L(0); PG8_MMA(1, 0, At, B0); PG8_BAR; PG8_SCHED;
            PG8_STAGE(PG8_SB(0, 1), b2 + hstep, voffB);
            PG8_WAIT_V(6); PG8_BAR; PG8_MMA(1, 1, At, B1); PG8_BAR;
            PG8_LDB(B0, 1, 0); PG8_SCHED; PG8_LDA(At, 1, 0); PG8_STAGE(PG8_SA(0, 1), a2 + hstep, voffA);
            PG8_WAIT_L(8); PG8_BAR; PG8_WAIT_L(0); PG8_MMA(0, 0, At, B0); PG8_BAR; PG8_SCHED;
            PG8_LDB(B1, 1, 1); PG8_STAGE(PG8_SB(1, 0), b3, voffB);
            PG8_BAR; PG8_WAIT_L(0); PG8_MMA(0, 1, At, B1); PG8_BAR;
            PG8_LDA(At, 1, 1); PG8_STAGE(PG8_SA(1, 0), a3, voffA);
            PG8_BAR; PG8_WAIT_L(0); PG8_MMA(1, 0, At, B0); PG8_BAR; PG8_SCHED;
            PG8_STAGE(PG8_SB(1, 1), b3 + hstep, voffB);
            PG8_WAIT_V(6); PG8_BAR; PG8_MMA(1, 1, At, B1); PG8_BAR;
            }
        }
        if constexpr (ALIGN_EPI) { if (wr == 0) PG8_BAR; }
        E(acc, cur, wr, wc, fr, fq);
        if (!has_next) break;
#pragma unroll
        for (int a = 0; a < 2; ++a)
#pragma unroll
            for (int b = 0; b < 2; ++b)
#pragma unroll
                for (int m = 0; m < 4; ++m)
#pragma unroll
                    for (int n = 0; n < 2; ++n) acc[a][b][m][n] = (f32x4){0.f, 0.f, 0.f, 0.f};
        cur = nxt; cA = nA; cB = nB; ++ui;
        if constexpr (ALIGN_EPI) { if (wr == 1) PG8_BAR; }
    }
    PG8_WAIT_V(0);
    if constexpr (!ALIGN_EPI) { if (wr == 0) PG8_BAR; }
    PG8_BAR;
#undef PG8_SA
#undef PG8_SB
#undef PG8_STAGE
#undef PG8_LDA
#undef PG8_LDB
#undef PG8_MMA
#undef PG8_WAIT_V
#undef PG8_WAIT_L
#undef PG8_BAR
#undef PG8_SCHED
}

struct EpiBf16 {
    static constexpr bool PERM = true;
    bf16_t* O; int ldc;
    DI void operator()(const f32x4 (&acc)[2][2][4][2], const Unit& u, int wr, int wc, int fr, int fq) const {
        const int row0 = u.pm * BM + wr * 64 + fr, col0 = u.pn * BM + wc * 32 + 8 * fq;
#pragma unroll
        for (int ai = 0; ai < 2; ++ai)
#pragma unroll
            for (int m = 0; m < 4; ++m) { bf16_t* rowp = O + (size_t)(row0 + ai * HALF + m * 16) * ldc + col0;
#pragma unroll
                for (int bj = 0; bj < 2; ++bj) { const f32x4 v0 = acc[ai][bj][m][0], v1 = acc[ai][bj][m][1];
                    u32x4 w; w.x = pk2(v0[0], v0[1]); w.y = pk2(v0[2], v0[3]); w.z = pk2(v1[0], v1[1]); w.w = pk2(v1[2], v1[3]);
                    *(u32x4*)(rowp + bj * HALF) = w; } }
    }
};
struct EpiX1 {
    static constexpr bool PERM = false;
    const float* x; const float* mod; float* out;
    DI void operator()(const f32x4 (&acc)[2][2][4][2], const Unit& u, int wr, int wc, int fr, int fq) const {
        const int row0 = u.pm * BM + wr * 64 + fr, col0 = u.pn * BM + wc * 32 + 4 * fq;
        const int b = (u.pm * BM) / SEQ;
        const float* gp = mod + (size_t)b * 6144 + 2048 + col0;
#pragma unroll
        for (int bj = 0; bj < 2; ++bj)
#pragma unroll
            for (int n = 0; n < 2; ++n) { const f32x4 gv = *(const f32x4*)(gp + bj * HALF + n * 16);
#pragma unroll
                for (int ai = 0; ai < 2; ++ai)
#pragma unroll
                    for (int m = 0; m < 4; ++m) { const size_t off = (size_t)(row0 + ai * HALF + m * 16) * DM + col0 + bj * HALF + n * 16;
                        const f32x4 xv = *(const f32x4*)(x + off); *(f32x4*)(out + off) = xv + gv * acc[ai][bj][m][n]; } }
    }
};
struct EpiGU {
    static constexpr bool PERM = true;
    bf16_t* H;
    DI void operator()(const f32x4 (&acc)[2][2][4][2], const Unit& u, int wr, int wc, int fr, int fq) const {
        const int row0 = u.pm * BM + wr * 64 + fr, col0 = u.pn * HALF + wc * 32 + 8 * fq;
#pragma unroll
        for (int ai = 0; ai < 2; ++ai)
#pragma unroll
            for (int m = 0; m < 4; ++m) { bf16_t* rowp = H + (size_t)(row0 + ai * HALF + m * 16) * DFF + col0;
                float hv[8];
#pragma unroll
                for (int n = 0; n < 2; ++n)
#pragma unroll
                    for (int j = 0; j < 4; ++j) { const float gg = acc[ai][0][m][n][j], uu = acc[ai][1][m][n][j]; hv[n * 4 + j] = gg / (1.f + __expf(-gg)) * uu; }
                u32x4 w; w.x = pk2(hv[0], hv[1]); w.y = pk2(hv[2], hv[3]); w.z = pk2(hv[4], hv[5]); w.w = pk2(hv[6], hv[7]);
                *(u32x4*)rowp = w; }
    }
};
struct EpiDown {
    static constexpr bool PERM = true;
    bf16_t* Y; const float* vals;
    DI void operator()(const f32x4 (&acc)[2][2][4][2], const Unit& u, int wr, int wc, int fr, int fq) const {
        const int row0 = u.pm * BM + wr * 64 + fr, col0 = u.pn * BM + wc * 32 + 8 * fq;
#pragma unroll
        for (int ai = 0; ai < 2; ++ai)
#pragma unroll
            for (int m = 0; m < 4; ++m) { const int row = row0 + ai * HALF + m * 16; const float s = vals[row]; bf16_t* rowp = Y + (size_t)row * DM + col0;
#pragma unroll
                for (int bj = 0; bj < 2; ++bj) { const f32x4 v0 = acc[ai][bj][m][0] * s, v1 = acc[ai][bj][m][1] * s;
                    u32x4 w; w.x = pk2(v0[0], v0[1]); w.y = pk2(v0[2], v0[3]); w.z = pk2(v1[0], v1[1]); w.w = pk2(v1[2], v1[3]);
                    *(u32x4*)(rowp + bj * HALF) = w; } }
    }
};
}

struct Args {
    const float* x; const float* c; const int* pos; const float* norm1_g; const float* norm2_g; const float* w_ada; const float* b_ada;
    const float* w_in; const float* conv_w; const float* gate_b; const float* mnorm_g; const float* qk_g; const float* lam_p; const float* subln_g;
    const float* w_out; const float* w_router; const float* w_gate; const float* w_up; const float* w_down;
    float* out; unsigned char* ws; int ph_lo, ph_hi;
};
struct Ctx {
    LAS unsigned char* lds; int tid, lane, wave, G, bid;
};
DI Args load_args() {
    typedef __attribute__((address_space(4))) const volatile unsigned long long* kp_t;
    kp_t kp = (kp_t)__builtin_amdgcn_kernarg_segment_ptr();
#define GP(T, i) ((T*)(__attribute__((address_space(1))) T*)kp[i])
    Args a;
    a.x = GP(const float, 0); a.c = GP(const float, 1); a.pos = GP(const int, 2); a.norm1_g = GP(const float, 3); a.norm2_g = GP(const float, 4);
    a.w_ada = GP(const float, 5); a.b_ada = GP(const float, 6); a.w_in = GP(const float, 7); a.conv_w = GP(const float, 8); a.gate_b = GP(const float, 9);
    a.mnorm_g = GP(const float, 10); a.qk_g = GP(const float, 11); a.lam_p = GP(const float, 12); a.subln_g = GP(const float, 13); a.w_out = GP(const float, 14);
    a.w_router = GP(const float, 15); a.w_gate = GP(const float, 16); a.w_up = GP(const float, 17); a.w_down = GP(const float, 18);
    a.out = GP(float, 19); a.ws = GP(unsigned char, 20);
#undef GP
    a.ph_lo = 0; a.ph_hi = 14;
    return a;
}

DI void tr_item64(const float* src, size_t ld_src, int k0, int c0, bf16_t* dst, size_t r0, int ld_dst, LAS float* scr  , int lane) {
    const float* sp = src + (size_t)(k0 + (lane >> 4)) * ld_src + c0 + (lane & 15) * 4;
#pragma unroll 1
    for (int hf = 0; hf < 2; ++hf) {
        f32x4 v[8];
#pragma unroll
        for (int i = 0; i < 8; ++i) v[i] = *(const f32x4*)(sp + (size_t)(4 * (8 * hf + i)) * ld_src);
#pragma unroll
        for (int i = 0; i < 8; ++i) *(LAS f32x4*)(scr + (4 * (8 * hf + i) + (lane >> 4)) * 68 + (lane & 15) * 4) = v[i];
    }
    asm volatile("s_waitcnt lgkmcnt(0)" ::: "memory");
    const int c = lane & 7;
#pragma unroll
    for (int q = 0; q < 8; ++q) { const int n = 8 * q + (lane >> 3); const LAS float* s = scr + (8 * c) * 68 + n;
        u32x4 o; o.x = pk2(s[0 * 68], s[1 * 68]); o.y = pk2(s[2 * 68], s[3 * 68]); o.z = pk2(s[4 * 68], s[5 * 68]); o.w = pk2(s[6 * 68], s[7 * 68]);
        *(u32x4*)(dst + (r0 + n) * ld_dst + k0 + 8 * c) = o; }
    asm volatile("s_waitcnt lgkmcnt(0)" ::: "memory");
}
DI void p0_phase(const Ctx& F, const Args& a) {
    if (F.bid < 96) {
        LAS float* sc = (LAS float*)F.lds; LAS float* part = (LAS float*)(F.lds + 32768);
        for (int i = F.tid; i < BATCH * DM; i += NTHR) sc[i] = silu_f(a.c[i]);
        __syncthreads();
        const int col = F.bid * 64 + F.lane;
        float acc[8];
#pragma unroll
        for (int b = 0; b < 8; ++b) acc[b] = 0.f;
        const int kb = F.wave * 128;
#pragma unroll 1
        for (int k0 = kb; k0 < kb + 128; k0 += 16) {
            float w[16];
            const float* wp = a.w_ada + (size_t)k0 * 6144 + col;
#pragma unroll
            for (int j = 0; j < 16; ++j) w[j] = wp[(size_t)j * 6144];
#pragma unroll
            for (int j = 0; j < 16; ++j)
#pragma unroll
                for (int b = 0; b < 8; ++b) acc[b] += sc[b * DM + k0 + j] * w[j];
        }
#pragma unroll
        for (int b = 0; b < 8; ++b) part[(F.wave * 8 + b) * 64 + F.lane] = acc[b];
        __syncthreads();
        { const int b = F.tid >> 6, l = F.tid & 63; float s = a.b_ada[F.bid * 64 + l];
#pragma unroll
          for (int w = 0; w < 8; ++w) s += part[(w * 8 + b) * 64 + l];
          ((float*)(a.ws + WS_MOD))[b * 6144 + F.bid * 64 + l] = s; }
        __syncthreads();
    }
    LAS float* scr = (LAS float*)(F.lds + F.wave * 17408);
    const int gw = F.bid * NWAVES + F.wave, NGW = F.G * NWAVES;
    constexpr int I_IN = 16 * 56, I_OUT = 16 * 16, I_G = 16 * 16 * 32, I_D = 16 * 32 * 16, I_WG = 16;
    constexpr int NITEMS = I_IN + I_OUT + 2 * I_G + I_D + I_WG;
    bf16_t* WinT = (bf16_t*)(a.ws + WS_WINT); bf16_t* WgT = (bf16_t*)(a.ws + WS_WGT); bf16_t* WoutT = (bf16_t*)(a.ws + WS_WOUTT);
    bf16_t* WguT = (bf16_t*)(a.ws + WS_WGUT); bf16_t* WdT = (bf16_t*)(a.ws + WS_WDT);
    for (int it = gw; it < NITEMS; it += NGW) {
        int r = it;
        if (r < I_IN) { const int kb = r / 56, nb = r % 56, n0 = nb * 64; tr_item64(a.w_in, DIN, kb * 64, n0 + (n0 >= 2048 ? 16 : 0), WinT, n0, DM, scr, F.lane); continue; } r -= I_IN;
        if (r < I_OUT) { const int kb = r / 16, nb = r % 16; tr_item64(a.w_out, DM, kb * 64, nb * 64, WoutT, nb * 64, DM, scr, F.lane); continue; } r -= I_OUT;
        if (r < 2 * I_G) { const int up = r / I_G; r -= up * I_G; const int e = r / 512; r -= e * 512; const int kb = r / 32, nb = r % 32, n0 = nb * 64;
            const float* src = (up ? a.w_up : a.w_gate) + (size_t)e * DM * DFF;
            tr_item64(src, DFF, kb * 64, n0, WguT + (size_t)e * 4096 * DM, (size_t)(n0 / 128) * 256 + (n0 % 128) + up * 128, DM, scr, F.lane); continue; } r -= 2 * I_G;
        if (r < I_D) { const int e = r / 512; r -= e * 512; const int kb = r / 16, nb = r % 16;
            tr_item64(a.w_down + (size_t)e * DFF * DM, DM, kb * 64, nb * 64, WdT + (size_t)e * DM * DFF, nb * 64, DFF, scr, F.lane); continue; } r -= I_D;
        tr_item64(a.w_in, DIN, r * 64, 2048 - 48, WgT, 0, DM, scr, F.lane);
    }
}

DI void p1_phase(const Ctx& F, const Args& a) {
    const int gw = F.bid * NWAVES + F.wave, NGW = F.G * NWAVES;
    const float* mod = (const float*)(a.ws + WS_MOD);
    bf16_t* H1 = (bf16_t*)a.out;
    for (int m = gw; m < MTOK; m += NGW) {
        const int b = m / SEQ;
        const f32x4* xr = (const f32x4*)(a.x + (size_t)m * DM) + F.lane;
        f32x4 v[4]; float s = 0.f;
#pragma unroll
        for (int j = 0; j < 4; ++j) { v[j] = xr[64 * j]; s += (v[j].x * v[j].x + v[j].y * v[j].y) + (v[j].z * v[j].z + v[j].w * v[j].w); }
        const float rstd = rsqrtf(wave_sum(s) * (1.f / DM) + EPS);
        u32x2* o8 = (u32x2*)(H1 + (size_t)m * DM) + F.lane;
#pragma unroll
        for (int j = 0; j < 4; ++j) {
            const f32x4 g = ((const f32x4*)a.norm1_g)[F.lane + 64 * j];
            const f32x4 sh = ((const f32x4*)(mod + (size_t)b * 6144))[F.lane + 64 * j];
            const f32x4 sc = ((const f32x4*)(mod + (size_t)b * 6144 + 1024))[F.lane + 64 * j];
            const f32x4 h = v[j] * rstd * g * (sc + 1.f) + sh;
            u32x2 w; w.x = pk2(h.x, h.y); w.y = pk2(h.z, h.w); o8[64 * j] = w; }
    }
}

DI void gates_tasks(const Ctx& F, const Args& a) {
    const int gw = F.bid * NWAVES + F.wave, NGW = F.G * NWAVES;
    const bf16_t* H1 = (const bf16_t*)a.out; const bf16_t* WgT = (const bf16_t*)(a.ws + WS_WGT) + 48 * DM; float* GT = (float*)(a.ws + WS_GATES);
    const float bias = a.gate_b[F.lane & 15];
    for (int task = gw; task < MTOK / 16; task += NGW) {
        const int row0 = task * 16;
        const bf16_t* ap = H1 + (size_t)(row0 + (F.lane & 15)) * DM + 8 * (F.lane >> 4);
        const bf16_t* bp = WgT + (size_t)(F.lane & 15) * DM + 8 * (F.lane >> 4);
        f32x4 acc = {0.f, 0.f, 0.f, 0.f};
#pragma unroll 8
        for (int i = 0; i < 32; ++i) { const bf16x8 av = *(const bf16x8*)(ap + 32 * i), bv = *(const bf16x8*)(bp + 32 * i); acc = __builtin_amdgcn_mfma_f32_16x16x32_bf16(av, bv, acc, 0, 0, 0); }
#pragma unroll
        for (int r = 0; r < 4; ++r) GT[(size_t)(row0 + (F.lane >> 4) * 4 + r) * 16 + (F.lane & 15)] = acc[r] + bias;
    }
}

DI void qk_tile_task(const Ctx& F, const Args& a, int task) {
    const int b = task >> 6, tile = task & 63, r = F.lane, g = F.wave, h = g >> 1, p = g & 1;
    bf16_t* PROJ = (bf16_t*)(a.ws + WS_PROJ);
    const size_t tok = (size_t)b * SEQ + tile * 64 + r;
    float invf[8];
#pragma unroll
    for (int i = 0; i < 8; ++i) invf[i] = exp2f(-(float)i * 0.125f * 18.931568569324174f) * 0.15915494309189535f;
    const float pos = (float)a.pos[tok];
    float sn[8], cs[8];
#pragma unroll
    for (int i = 0; i < 8; ++i) { const float fr = __builtin_amdgcn_fractf(pos * invf[i]); sn[i] = __builtin_amdgcn_sinf(fr); cs[i] = __builtin_amdgcn_cosf(fr); }
#pragma unroll 1
    for (int isk = 0; isk < 2; ++isk) {
        u32x4* src = (u32x4*)(PROJ + tok * PS + (isk ? C_KA : C_QA) + g * 64);
        u32x4 w[8];
#pragma unroll
        for (int c = 0; c < 8; ++c) w[c] = src[c];
        float ss = 0.f;
#pragma unroll
        for (int c = 0; c < 8; ++c) { float t;
            t = bflo(w[c].x); ss += t * t; t = bfhi(w[c].x); ss += t * t; t = bflo(w[c].y); ss += t * t; t = bfhi(w[c].y); ss += t * t;
            t = bflo(w[c].z); ss += t * t; t = bfhi(w[c].z); ss += t * t; t = bflo(w[c].w); ss += t * t; t = bfhi(w[c].w); ss += t * t; }
        const float rstd = rsqrtf(ss * (1.f / 64.f) + EPS) * (isk ? 1.f : 0.125f * 1.4426950408889634f);
        const float* gp = a.qk_g + isk * 64;
        float v0[16];
        v0[0] = bflo(w[0].x); v0[1] = bfhi(w[0].x); v0[2] = bflo(w[0].y); v0[3] = bfhi(w[0].y); v0[4] = bflo(w[0].z); v0[5] = bfhi(w[0].z); v0[6] = bflo(w[0].w); v0[7] = bfhi(w[0].w);
        v0[8] = bflo(w[1].x); v0[9] = bfhi(w[1].x); v0[10] = bflo(w[1].y); v0[11] = bfhi(w[1].y); v0[12] = bflo(w[1].z); v0[13] = bfhi(w[1].z); v0[14] = bflo(w[1].w); v0[15] = bfhi(w[1].w);
#pragma unroll
        for (int i = 0; i < 16; ++i) v0[i] *= rstd * gp[i];
        float rr[16];
#pragma unroll
        for (int i = 0; i < 8; ++i) { rr[i] = v0[i] * cs[i] - v0[i + 8] * sn[i]; rr[i + 8] = v0[i + 8] * cs[i] + v0[i] * sn[i]; }
        u32x4 o[8];
        o[0].x = pk2(rr[0], rr[1]); o[0].y = pk2(rr[2], rr[3]); o[0].z = pk2(rr[4], rr[5]); o[0].w = pk2(rr[6], rr[7]);
        o[1].x = pk2(rr[8], rr[9]); o[1].y = pk2(rr[10], rr[11]); o[1].z = pk2(rr[12], rr[13]); o[1].w = pk2(rr[14], rr[15]);
#pragma unroll
        for (int c = 2; c < 8; ++c) { const f32x4 g0 = *(const f32x4*)(gp + c * 8), g1 = *(const f32x4*)(gp + c * 8 + 4);
            o[c].x = pk2(bflo(w[c].x) * rstd * g0.x, bfhi(w[c].x) * rstd * g0.y); o[c].y = pk2(bflo(w[c].y) * rstd * g0.z, bfhi(w[c].y) * rstd * g0.w);
            o[c].z = pk2(bflo(w[c].z) * rstd * g1.x, bfhi(w[c].z) * rstd * g1.y); o[c].w = pk2(bflo(w[c].w) * rstd * g1.z, bfhi(w[c].w) * rstd * g1.w); }
        if (isk == 0) {
#pragma unroll
            for (int c = 0; c < 8; ++c) src[c] = o[c];
        } else {
            u32x4* dst = (u32x4*)((bf16_t*)(a.ws + WS_KIMG) + ((size_t)((b * 4 + h) * 64 + tile)) * 8192) + r;
#pragma unroll
            for (int c = 0; c < 8; ++c) dst[(p * 8 + c) * 64] = o[c];
        }
    }
    {
        u32x4* dst = (u32x4*)((bf16_t*)(a.ws + WS_VIMG) + ((size_t)((b * 4 + h) * 64 + tile)) * 8192) + r;
#pragma unroll
        for (int cg = 2 * p; cg < 2 * p + 2; ++cg)
#pragma unroll
            for (int kg = 0; kg < 4; ++kg) {
                const u32x4 v = *(const u32x4*)(PROJ + ((size_t)b * SEQ + tile * 64 + 16 * kg + (r >> 2)) * PS + C_VA + h * 128 + 32 * cg + 8 * (r & 3));
                dst[(cg * 4 + kg) * 64] = v; }
    }
}

template <bool H0, bool H12>
DI void load_conv_tile(const Ctx& F, const Args& a, const bf16_t* projb, int c, int colbase, int chb, float scale, LAS unsigned char* img0,
                       const LAS float* rw1, LAS unsigned char* img1, const LAS float* rw2, LAS unsigned char* img2) {
    const int ch = F.tid & 15;
    float cw[5][8];
#pragma unroll
    for (int j = 0; j < 5; ++j) { const f32x4 c0 = *(const f32x4*)(a.conv_w + j * 1024 + chb + ch * 8), c1 = *(const f32x4*)(a.conv_w + j * 1024 + chb + ch * 8 + 4);
        cw[j][0] = c0.x; cw[j][1] = c0.y; cw[j][2] = c0.z; cw[j][3] = c0.w; cw[j][4] = c1.x; cw[j][5] = c1.y; cw[j][6] = c1.z; cw[j][7] = c1.w; }
#pragma unroll
    for (int it = 0; it < 2; ++it) {
        const int row = (F.tid >> 4) + 32 * it, t0 = c * 64 + row;
        float acc[8];
#pragma unroll
        for (int i = 0; i < 8; ++i) acc[i] = 0.f;
#pragma unroll
        for (int j = 0; j < 5; ++j) { const int tt = t0 + j - 2;
            if (tt >= 0 && tt < SEQ) { const u32x4 w = *(const u32x4*)(projb + (size_t)tt * PS + colbase + ch * 8);
                acc[0] += bflo(w.x) * cw[j][0]; acc[1] += bfhi(w.x) * cw[j][1]; acc[2] += bflo(w.y) * cw[j][2]; acc[3] += bfhi(w.y) * cw[j][3];
                acc[4] += bflo(w.z) * cw[j][4]; acc[5] += bfhi(w.z) * cw[j][5]; acc[6] += bflo(w.w) * cw[j][6]; acc[7] += bfhi(w.w) * cw[j][7]; } }
#pragma unroll
        for (int i = 0; i < 8; ++i) acc[i] = silu_f(acc[i]) * scale;
        const int off = row * 256 + ((ch ^ swz16(row)) << 4);
        if constexpr (H0) { u32x4 o; o.x = pk2(acc[0], acc[1]); o.y = pk2(acc[2], acc[3]); o.z = pk2(acc[4], acc[5]); o.w = pk2(acc[6], acc[7]); *(LAS u32x4*)(img0 + off) = o; }
        if constexpr (H12) { const float w = rw1[row]; u32x4 o; o.x = pk2(acc[0] * w, acc[1] * w); o.y = pk2(acc[2] * w, acc[3] * w); o.z = pk2(acc[4] * w, acc[5] * w); o.w = pk2(acc[6] * w, acc[7] * w); *(LAS u32x4*)(img1 + off) = o; }
        if constexpr (H12) { const float w = rw2[row]; u32x4 o; o.x = pk2(acc[0] * w, acc[1] * w); o.y = pk2(acc[2] * w, acc[3] * w); o.z = pk2(acc[4] * w, acc[5] * w); o.w = pk2(acc[6] * w, acc[7] * w); *(LAS u32x4*)(img2 + off) = o; }
    }
}
DI void load_plain_tile(const Ctx& F, const bf16_t* projb, int c, int colbase, LAS unsigned char* img) {
    const int ch = F.tid & 15;
#pragma unroll
    for (int it = 0; it < 2; ++it) { const int row = (F.tid >> 4) + 32 * it;
        const u32x4 w = *(const u32x4*)(projb + (size_t)(c * 64 + row) * PS + colbase + ch * 8);
        *(LAS u32x4*)(img + row * 256 + ((ch ^ swz16(row)) << 4)) = w; }
}
DI bf16x8 tr_frag_nat(const LAS unsigned char* img, int rowbase, int col0, int lane) {
    const int hh = lane >> 5, g16 = (lane >> 4) & 1, i = lane & 15;
    const int col = col0 + 16 * g16 + 4 * (i & 3), chunk = col >> 3, sub = (col & 7) * 2;
    const int r0 = rowbase + 8 * hh + (i >> 2), r1 = r0 + 4;
    const s16x4 lo = trread(img + r0 * 256 + ((chunk ^ swz16(r0)) << 4) + sub);
    const s16x4 hi = trread(img + r1 * 256 + ((chunk ^ swz16(r1)) << 4) + sub);
    return __builtin_shufflevector(lo, hi, 0, 1, 2, 3, 4, 5, 6, 7);
}
DI bf16x8 tr_frag_acc(const LAS unsigned char* img, int rowbase, int col0, int lane) {
    const int hh = lane >> 5, g16 = (lane >> 4) & 1, i = lane & 15;
    const int col = col0 + 16 * g16 + 4 * (i & 3), chunk = col >> 3, sub = (col & 7) * 2;
    const int r0 = rowbase + 4 * hh + (i >> 2), r1 = r0 + 8;
    const s16x4 lo = trread(img + r0 * 256 + ((chunk ^ swz16(r0)) << 4) + sub);
    const s16x4 hi = trread(img + r1 * 256 + ((chunk ^ swz16(r1)) << 4) + sub);
    return __builtin_shufflevector(lo, hi, 0, 1, 2, 3, 4, 5, 6, 7);
}
DI bf16x8 row_frag(const LAS unsigned char* img, int row, int chunk) { return *(const LAS bf16x8*)(img + row * 256 + ((chunk ^ swz16(row)) << 4)); }

DI void m1_item(const Ctx& F, const Args& a, int item) {
    const int c = item & 63, h = (item >> 6) & 3, b = item >> 8;
    const bf16_t* projb = (const bf16_t*)(a.ws + WS_PROJ) + (size_t)b * SEQ * PS;
    const float* GT = (const float*)(a.ws + WS_GATES) + (size_t)(b * SEQ + c * 64) * 16;
    float* MSC = (float*)(a.ws + WS_MSC);
    LAS unsigned char* KWF = F.lds; LAS unsigned char* KWB = F.lds + 16384; LAS unsigned char* VT = F.lds + 32768;
    LAS float* wsc = (LAS float*)(F.lds + 49152);
    if (F.wave < 2) {
        const int dir = F.wave, s = F.lane;
        const float ig = GT[s * 16 + dir * 8 + h], fg = GT[s * 16 + dir * 8 + 4 + h];
        float av = logsigmoid_f(fg);
        if (dir == 0) {
#pragma unroll
            for (int o = 1; o < 64; o <<= 1) { const float t = __shfl_up(av, o); if (s >= o) av += t; }
        } else {
#pragma unroll
            for (int o = 1; o < 64; o <<= 1) { const float t = __shfl_down(av, o); if (s + o < 64) av += t; }
        }
        const float g = __shfl(av, dir == 0 ? 63 : 0);
        const float wl = g - av + ig, ml = wave_max(wl);
        wsc[dir * 64 + s] = __expf(wl - ml);
        if (s == 0) { const int chain = (b * 4 + h) * 2 + dir; MSC[chain * 64 + c] = g; MSC[4096 + chain * 64 + c] = ml; }
    }
    __syncthreads();
    load_conv_tile<false, true>(F, a, projb, c, C_KM + h * 128, 512 + h * 128, 0.08838834764831845f, KWF, wsc, KWF, wsc + 64, KWB);
    load_plain_tile(F, projb, c, C_VM + h * 128, VT);
    __syncthreads();
    {
        const int dir = F.wave >> 2, kt = F.wave & 3, hh = F.lane >> 5;
        const LAS unsigned char* KW = dir ? KWB : KWF;
        bf16x8 af[4];
#pragma unroll
        for (int ks = 0; ks < 4; ++ks) af[ks] = tr_frag_nat(KW, 16 * ks, 32 * kt, F.lane);
        bf16_t* CT = (bf16_t*)a.out + ((size_t)((b * 4 + h) * 2 + dir) * 64 + c) * 16384;
#pragma unroll
        for (int vt = 0; vt < 4; ++vt) {
            f32x16 acc;
#pragma unroll
            for (int i = 0; i < 16; ++i) acc[i] = 0.f;
#pragma unroll
            for (int ks = 0; ks < 4; ++ks) { const bf16x8 bfv = tr_frag_nat(VT, 16 * ks, 32 * vt, F.lane); acc = MFMA32(af[ks], bfv, acc); }
            const int vdim = 32 * vt + (F.lane & 31);
#pragma unroll
            for (int rg = 0; rg < 4; ++rg) { u32x2 w; w.x = pk2(acc[4 * rg], acc[4 * rg + 1]); w.y = pk2(acc[4 * rg + 2], acc[4 * rg + 3]);
                *(u32x2*)(CT + (size_t)vdim * 128 + 32 * kt + 8 * rg + 4 * hh) = w; }
        }
    }
    if (F.tid < 256) {
        const int dir = F.tid >> 7, kd = F.tid & 127; const LAS unsigned char* KW = dir ? KWB : KWF;
        float s = 0.f;
#pragma unroll 8
        for (int r = 0; r < 64; ++r) s += bf2f(*(const LAS bf16_t*)(KW + r * 256 + (((kd >> 3) ^ swz16(r)) << 4) + (kd & 7) * 2));
        ((float*)(a.ws + WS_NLOC))[((size_t)((b * 4 + h) * 2 + dir) * 64 + c) * 128 + kd] = s;
    }
    __syncthreads();
}

DI void scan_task(const Ctx& F, const Args& a, int task) {
    const int chain = task >> 3, slab = task & 7, dir = chain & 1;
    float* MSC = (float*)(a.ws + WS_MSC);
    LAS float* sp = (LAS float*)F.lds; LAS float* sl = sp + 64; LAS float* gl = sp + 128; LAS float* mll = sp + 192; LAS float* mpv = sp + 256;
    if (F.tid < 64) { gl[F.tid] = MSC[chain * 64 + F.tid]; mll[F.tid] = MSC[4096 + chain * 64 + F.tid]; }
    __syncthreads();
    if (F.tid == 0) {
        float m = 0.f;
        for (int st = 0; st < 64; ++st) { const int c = dir ? 63 - st : st; const float g = gl[c], ml = mll[c];
            mpv[c] = m;
            const float mn = fmaxf(g + m, ml); sp[c] = __expf(g + m - mn); sl[c] = __expf(ml - mn); m = mn; }
    }
    __syncthreads();
    if (slab == 0 && F.tid < 64) MSC[8192 + chain * 64 + F.tid] = mpv[F.tid];
    bf16_t* base = (bf16_t*)a.out + (size_t)chain * 64 * 16384 + slab * 2048 + F.tid * 4;
    float s0 = 0.f, s1 = 0.f, s2 = 0.f, s3 = 0.f;
    for (int st0 = 0; st0 < 64; st0 += 8) {
        u32x2 v[8];
#pragma unroll
        for (int j = 0; j < 8; ++j) { const int c = dir ? 63 - (st0 + j) : st0 + j; v[j] = *(const u32x2*)(base + (size_t)c * 16384); }
#pragma unroll
        for (int j = 0; j < 8; ++j) { const int c = dir ? 63 - (st0 + j) : st0 + j;
            u32x2 o; o.x = pk2(s0, s1); o.y = pk2(s2, s3); *(u32x2*)(base + (size_t)c * 16384) = o;
            const float p = sp[c], l = sl[c];
            s0 = p * s0 + l * bflo(v[j].x); s1 = p * s1 + l * bfhi(v[j].x); s2 = p * s2 + l * bflo(v[j].y); s3 = p * s3 + l * bfhi(v[j].y); }
    }
    if (slab == 0 && F.tid < 128) {
        float* nb = (float*)(a.ws + WS_NLOC) + (size_t)chain * 64 * 128 + F.tid; float n = 0.f;
        for (int st0 = 0; st0 < 64; st0 += 16) {
            float v[16];
#pragma unroll
            for (int j = 0; j < 16; ++j) { const int c = dir ? 63 - (st0 + j) : st0 + j; v[j] = nb[c * 128]; }
#pragma unroll
            for (int j = 0; j < 16; ++j) { const int c = dir ? 63 - (st0 + j) : st0 + j; nb[c * 128] = n; n = sp[c] * n + sl[c] * v[j]; }
        }
    }
    __syncthreads();
}

DI void glds16(const void* g, LAS unsigned char* l) { __builtin_amdgcn_global_load_lds((const unsigned*)g, (LAS unsigned*)l, 16, 0, 0); }
DI void glds16_asm(const void* gsrc, unsigned lds_dst) { unsigned keep;
    asm volatile("s_mov_b32 %0, m0\n\ts_mov_b32 m0, %2\n\ts_nop 0\n\tglobal_load_lds_dwordx4 %1, off\n\ts_mov_b32 m0, %0" : "=&s"(keep) : "v"(gsrc), "s"(lds_dst) : "memory"); }
DI void attn_unit(const Ctx& F, const Args& a, int b, int h, int qb, float lam, float cshift) {
    const int lane = F.lane, wid = F.wave, r32 = lane & 31, hh = lane >> 5, rg = wid & 3, p = wid >> 2;
    const bf16_t* projb = (const bf16_t*)(a.ws + WS_PROJ) + (size_t)b * SEQ * PS;
    const int qrow = qb * 128 + rg * 32 + r32;
    bf16x8 qf[4];
    { const bf16_t* qp = projb + (size_t)qrow * PS + C_QA + h * 128 + p * 64 + hh * 8;
#pragma unroll
      for (int ks = 0; ks < 4; ++ks) qf[ks] = *(const bf16x8*)(qp + ks * 16); }
    const bf16_t* kimg = (const bf16_t*)(a.ws + WS_KIMG) + (size_t)(b * 4 + h) * 64 * 8192 + (2 * wid) * 512 + lane * 8;
    const bf16_t* vimg = (const bf16_t*)(a.ws + WS_VIMG) + (size_t)(b * 4 + h) * 64 * 8192 + (2 * wid) * 512 + lane * 8;
    const unsigned ldsw = (unsigned)__builtin_amdgcn_readfirstlane((int)(unsigned)(uintptr_t)F.lds + (2 * wid) * 1024);
#define ATT_ISSUE_K(t, s) do { const bf16_t* _tp = kimg + (size_t)(t) * 8192; const unsigned _d = (unsigned)__builtin_amdgcn_readfirstlane((int)(ldsw + (s) * 16384)); \
        glds16_asm(_tp, _d); glds16_asm(_tp + 512, _d + 1024); } while (0)
#define ATT_ISSUE_V(t, s) do { const bf16_t* _tp = vimg + (size_t)(t) * 8192; const unsigned _d = (unsigned)__builtin_amdgcn_readfirstlane((int)(ldsw + 32768 + (s) * 16384)); \
        glds16_asm(_tp, _d); glds16_asm(_tp + 512, _d + 1024); } while (0)
    ATT_ISSUE_K(0, 0); ATT_ISSUE_V(0, 0); ATT_ISSUE_K(1, 1);
    f32x16 O[4];
#pragma unroll
    for (int vt = 0; vt < 4; ++vt)
#pragma unroll
        for (int i = 0; i < 16; ++i) O[vt][i] = 0.f;
    float lsum = 0.f;
    const int kfb = p * 8192 + hh * 1024 + r32 * 16;
    const int vfb = 32768 + (4 * hh + ((lane & 15) >> 2)) * 64 + ((lane >> 4) & 1) * 32 + (lane & 3) * 8;
    bf16x8 pb[4];
    asm volatile("s_waitcnt vmcnt(0)" ::: "memory");
    __syncthreads();
#define ATT_QK(Sa, Sb, kb) do { _Pragma("unroll") for (int i = 0; i < 16; ++i) { Sa[i] = -cshift; Sb[i] = -cshift; } \
        _Pragma("unroll") for (int ks = 0; ks < 4; ++ks) { Sa = MFMA32(*(const LAS bf16x8*)((kb) + ks * 2048), qf[ks], Sa); Sb = MFMA32(*(const LAS bf16x8*)((kb) + ks * 2048 + 512), qf[ks], Sb); } } while (0)
#define ATT_EXP(Sa, Sb, on) do { float _ls = 0.f; _Pragma("unroll") for (int i = 0; i < 16; ++i) { Sa[i] = __builtin_amdgcn_exp2f(Sa[i]); Sb[i] = __builtin_amdgcn_exp2f(Sb[i]); _ls += Sa[i] + Sb[i]; } lsum += (on) ? _ls : 0.f; \
        ATT_PACK(pb[0], Sa, 0); ATT_PACK(pb[1], Sa, 8); ATT_PACK(pb[2], Sb, 0); ATT_PACK(pb[3], Sb, 8); } while (0)
#define ATT_PACK(dst, S, o) do { u32x4 _w; _w.x = pk2(S[o], S[o + 1]); _w.y = pk2(S[o + 2], S[o + 3]); _w.z = pk2(S[o + 4], S[o + 5]); _w.w = pk2(S[o + 6], S[o + 7]); dst = __builtin_bit_cast(bf16x8, _w); } while (0)
    f32x16 Sa, Sb;
    ATT_QK(Sa, Sb, F.lds + kfb);
    if (p == 0) ATT_EXP(Sa, Sb, true);
    __syncthreads();
#pragma unroll 1
    for (int t = 0; t < 64; ++t) {
        const int s = t & 1;
        ATT_ISSUE_K(t + 2 < 64 ? t + 2 : 63, s);
        ATT_ISSUE_V(t + 1 < 64 ? t + 1 : 63, s ^ 1);
        if (p == 1) ATT_EXP(Sa, Sb, true);
        __builtin_amdgcn_sched_barrier(0);
        ATT_QK(Sa, Sb, F.lds + (s ^ 1) * 16384 + kfb);
        const LAS unsigned char* Vb = F.lds + s * 16384 + vfb;
#pragma unroll
        for (int kg = 0; kg < 4; ++kg)
#pragma unroll
            for (int vt = 0; vt < 4; ++vt) {
                const s16x4 lo = trread(Vb + vt * 4096 + kg * 1024), hi = trread(Vb + vt * 4096 + kg * 1024 + 512);
                O[vt] = MFMA32(__builtin_shufflevector(lo, hi, 0, 1, 2, 3, 4, 5, 6, 7), pb[kg], O[vt]); }
        __builtin_amdgcn_sched_barrier(0);
        if (p == 0) ATT_EXP(Sa, Sb, t + 1 < 64);
        asm volatile("s_waitcnt vmcnt(0)" ::: "memory");
        __syncthreads();
    }
#undef ATT_ISSUE_K
#undef ATT_ISSUE_V
#undef ATT_QK
#undef ATT_EXP
#undef ATT_PACK
    lsum += __shfl_xor(lsum, 32);
    LAS float* X = (LAS float*)(F.lds + 65536) + rg * 4096 + r32;
    if (p == 1) {
        const float sc = lam / lsum;
#pragma unroll
        for (int vt = 0; vt < 4; ++vt)
#pragma unroll
            for (int i = 0; i < 16; ++i) X[(32 * vt + crow(i, hh)) * 32] = O[vt][i] * sc;
    }
    __syncthreads();
    if (p == 0) {
        const float i0 = 1.f / lsum;
        float ssq = 0.f;
#pragma unroll
        for (int vt = 0; vt < 4; ++vt)
#pragma unroll
            for (int i = 0; i < 16; ++i) { const float o = O[vt][i] * i0 - X[(32 * vt + crow(i, hh)) * 32]; O[vt][i] = o; ssq += o * o; }
        ssq += __shfl_xor(ssq, 32);
        const float rs = rsqrtf(ssq * (1.f / 128.f) + EPS) * 0.8f;
        bf16_t* yp = (bf16_t*)(a.ws + WS_YA) + (size_t)(b * SEQ + qrow) * 512 + h * 128;
#pragma unroll
        for (int vt = 0; vt < 4; ++vt)
#pragma unroll
            for (int rgi = 0; rgi < 4; ++rgi) { const int vd = 32 * vt + 8 * rgi + 4 * hh; const f32x4 g = *(const f32x4*)(a.subln_g + vd);
                u32x2 w; w.x = pk2(O[vt][4 * rgi] * rs * g.x, O[vt][4 * rgi + 1] * rs * g.y); w.y = pk2(O[vt][4 * rgi + 2] * rs * g.z, O[vt][4 * rgi + 3] * rs * g.w);
                *(u32x2*)(yp + vd) = w; }
    }
    __syncthreads();
}

DI void m3_item(const Ctx& F, const Args& a, int item) {
    const int c = item & 63, h = (item >> 6) & 3, b = item >> 8;
    const int lane = F.lane, hh = lane >> 5, r32 = lane & 31;
    const bf16_t* projb = (const bf16_t*)(a.ws + WS_PROJ) + (size_t)b * SEQ * PS;
    const float* GT = (const float*)(a.ws + WS_GATES) + (size_t)(b * SEQ + c * 64) * 16;
    const float* MSC = (const float*)(a.ws + WS_MSC);
    LAS unsigned char* QT = F.lds; LAS unsigned char* KT = F.lds + 16384; LAS unsigned char* VT = F.lds + 32768;
    LAS unsigned char* SF = F.lds + 49152;
    LAS float* HT = (LAS float*)(F.lds + 65536);
    LAS float* scal = (LAS float*)(F.lds + 65536 + 33024);
    LAS float* rt = scal; LAS float* ct = scal + 128; LAS float* iw = scal + 256; LAS float* enm = scal + 384; LAS float* rden = scal + 512; LAS float* npv = scal + 640;
    const int chain0 = (b * 4 + h) * 2;
    if (F.wave < 2) {
        const int dir = F.wave, s = lane;
        const float ig = GT[s * 16 + dir * 8 + h], fg = GT[s * 16 + dir * 8 + 4 + h];
        float av = logsigmoid_f(fg);
        if (dir == 0) {
#pragma unroll
            for (int o = 1; o < 64; o <<= 1) { const float t = __shfl_up(av, o); if (s >= o) av += t; }
        } else {
#pragma unroll
            for (int o = 1; o < 64; o <<= 1) { const float t = __shfl_down(av, o); if (s + o < 64) av += t; }
        }
        const float cterm = ig - av;
        float cm = cterm;
        if (dir == 0) {
#pragma unroll
            for (int o = 1; o < 64; o <<= 1) { const float t = __shfl_up(cm, o); if (s >= o) cm = fmaxf(cm, t); }
        } else {
#pragma unroll
            for (int o = 1; o < 64; o <<= 1) { const float t = __shfl_down(cm, o); if (s + o < 64) cm = fmaxf(cm, t); }
        }
        const float mprev = MSC[8192 + (chain0 + dir) * 64 + c];
        const float il = av + mprev, mj = fmaxf(il, av + cm);
        rt[dir * 64 + s] = av - mj; ct[dir * 64 + s] = cterm; iw[dir * 64 + s] = __expf(il - mj); enm[dir * 64 + s] = __expf(-mj);
    } else if (F.wave < 6) {
        const int i = F.tid - 128; npv[i] = ((const float*)(a.ws + WS_NLOC))[((size_t)(chain0 + (i >> 7)) * 64 + c) * 128 + (i & 127)];
    }
    load_conv_tile<true, false>(F, a, projb, c, C_QM + h * 128, h * 128, 1.f, QT, rt, QT, rt, QT);
    load_conv_tile<true, false>(F, a, projb, c, C_KM + h * 128, 512 + h * 128, 0.08838834764831845f, KT, rt, KT, rt, KT);
    load_plain_tile(F, projb, c, C_VM + h * 128, VT);
    __syncthreads();
    {
        const int dir = F.wave >> 2, jt = (F.wave >> 1) & 1, st = F.wave & 1;
        f32x16 S;
#pragma unroll
        for (int i = 0; i < 16; ++i) S[i] = 0.f;
#pragma unroll
        for (int ks = 0; ks < 8; ++ks) S = MFMA32(row_frag(QT, 32 * jt + r32, 2 * ks + hh), row_frag(KT, 32 * st + r32, 2 * ks + hh), S);
        const int sc = 32 * st + r32; const float cts = ct[dir * 64 + sc];
        LAS unsigned char* SD = SF + dir * 8192;
#pragma unroll
        for (int i = 0; i < 16; ++i) { const int j = 32 * jt + crow(i, hh);
            const bool ok = dir == 0 ? (sc <= j) : (sc >= j);
            const float v = ok ? S[i] * __expf(rt[dir * 64 + j] + cts) : 0.f;
            *(LAS bf16_t*)(SD + j * 128 + (((sc >> 3) ^ (j & 7)) << 4) + (sc & 7) * 2) = (bf16_t)(pk2(v, 0.f) & 0xffffu); }
    }
    __syncthreads();
    if (F.tid < 128) {
        const int dir = F.tid >> 6, j = F.tid & 63; const LAS unsigned char* SD = SF + dir * 8192;
        float rsum = 0.f;
#pragma unroll
        for (int ch = 0; ch < 8; ++ch) { const u32x4 w = *(const LAS u32x4*)(SD + j * 128 + ((ch ^ (j & 7)) << 4));
            rsum += (bflo(w.x) + bfhi(w.x)) + (bflo(w.y) + bfhi(w.y)) + (bflo(w.z) + bfhi(w.z)) + (bflo(w.w) + bfhi(w.w)); }
        float qn = 0.f;
#pragma unroll
        for (int ch = 0; ch < 16; ++ch) { const u32x4 w = *(const LAS u32x4*)(QT + j * 256 + ((ch ^ swz16(j)) << 4)); const LAS float* np = npv + dir * 128 + ch * 8;
            qn += bflo(w.x) * np[0] + bfhi(w.x) * np[1] + bflo(w.y) * np[2] + bfhi(w.y) * np[3] + bflo(w.z) * np[4] + bfhi(w.z) * np[5] + bflo(w.w) * np[6] + bfhi(w.w) * np[7]; }
        const float den = rsum + iw[dir * 64 + j] * qn;
        rden[dir * 64 + j] = 1.f / fmaxf(fabsf(den), enm[dir * 64 + j]);
    }
    f32x16 accd[2];
    {
        const int jt = F.wave >> 2, vt = F.wave & 3;
#pragma unroll
        for (int dir = 0; dir < 2; ++dir) {
            f32x16 acc;
#pragma unroll
            for (int i = 0; i < 16; ++i) acc[i] = 0.f;
            const bf16_t* CT = (const bf16_t*)a.out + ((size_t)(chain0 + dir) * 64 + c) * 16384 + (size_t)(32 * vt + r32) * 128 + 8 * hh;
#pragma unroll
            for (int ks = 0; ks < 8; ++ks) acc = MFMA32(row_frag(QT, 32 * jt + r32, 2 * ks + hh), *(const bf16x8*)(CT + 16 * ks), acc);
#pragma unroll
            for (int i = 0; i < 16; ++i) acc[i] *= iw[dir * 64 + 32 * jt + crow(i, hh)];
            const LAS unsigned char* SD = SF + dir * 8192;
#pragma unroll
            for (int ks = 0; ks < 4; ++ks) { const int j = 32 * jt + r32;
                const bf16x8 af = *(const LAS bf16x8*)(SD + j * 128 + (((2 * ks + hh) ^ (j & 7)) << 4));
                acc = MFMA32(af, tr_frag_nat(VT, 16 * ks, 32 * vt, lane), acc); }
            accd[dir] = acc;
        }
    }
    __syncthreads();
    {
        const int jt = F.wave >> 2, vt = F.wave & 3;
#pragma unroll
        for (int i = 0; i < 16; ++i) { const int j = 32 * jt + crow(i, hh);
            HT[j * 129 + 32 * vt + r32] = accd[0][i] * rden[j] + accd[1][i] * rden[64 + j]; }
    }
    __syncthreads();
    {
        const int j = F.tid >> 3, q = F.tid & 7;
        float v[16]; float s = 0.f;
#pragma unroll
        for (int i = 0; i < 16; ++i) { v[i] = HT[j * 129 + q * 16 + i]; s += v[i] * v[i]; }
        s += __shfl_xor(s, 1); s += __shfl_xor(s, 2); s += __shfl_xor(s, 4);
        const float rstd = rsqrtf(s * (1.f / 128.f) + EPS);
        const size_t tok = (size_t)b * SEQ + c * 64 + j;
        const u32x4* omp = (const u32x4*)((const bf16_t*)(a.ws + WS_PROJ) + tok * PS + C_OM + h * 128 + q * 16);
        const u32x4 o0 = omp[0], o1 = omp[1];
        float om[16];
        om[0] = bflo(o0.x); om[1] = bfhi(o0.x); om[2] = bflo(o0.y); om[3] = bfhi(o0.y); om[4] = bflo(o0.z); om[5] = bfhi(o0.z); om[6] = bflo(o0.w); om[7] = bfhi(o0.w);
        om[8] = bflo(o1.x); om[9] = bfhi(o1.x); om[10] = bflo(o1.y); om[11] = bfhi(o1.y); om[12] = bflo(o1.z); om[13] = bfhi(o1.z); om[14] = bflo(o1.w); om[15] = bfhi(o1.w);
        float y[16];
#pragma unroll
        for (int i = 0; i < 16; ++i) y[i] = v[i] * rstd * a.mnorm_g[h * 128 + q * 16 + i] * sigmoid_f(om[i]);
        u32x4 w0, w1;
        w0.x = pk2(y[0], y[1]); w0.y = pk2(y[2], y[3]); w0.z = pk2(y[4], y[5]); w0.w = pk2(y[6], y[7]);
        w1.x = pk2(y[8], y[9]); w1.y = pk2(y[10], y[11]); w1.z = pk2(y[12], y[13]); w1.w = pk2(y[14], y[15]);
        u32x4* yp = (u32x4*)((bf16_t*)(a.ws + WS_YMIX) + tok * DM + h * 128 + q * 16);
        yp[0] = w0; yp[1] = w1;
        const u32x4* yap = (const u32x4*)((const bf16_t*)(a.ws + WS_YA) + tok * 512 + h * 128 + q * 16);
        const u32x4 ya0 = yap[0], ya1 = yap[1];
        yp[64] = ya0; yp[65] = ya1;
    }
    __syncthreads();
}

DI void p7_phase(const Ctx& F, const Args& a) {
    LAS f32x4* WRL = (LAS f32x4*)F.lds;
    for (int q = F.tid; q < 4096; q += NTHR) { const int k = q >> 2, g = q & 3; WRL[(g * 2 + (k & 1)) * 512 + (k >> 1)] = *(const f32x4*)(a.w_router + k * 16 + g * 4); }
    __syncthreads();
    const int gw = F.bid * NWAVES + F.wave, NGW = F.G * NWAVES, lane = F.lane;
    const float* mod = (const float*)(a.ws + WS_MOD);
    bf16_t* H2 = (bf16_t*)(a.ws + WS_H2); float* AFF = (float*)(a.ws + WS_AFF);
    for (int m = gw; m < MTOK; m += NGW) {
        const int b = m / SEQ;
        const f32x2* xr = (const f32x2*)(a.out + (size_t)m * DM) + lane;
        f32x2 v[8]; float s = 0.f;
#pragma unroll
        for (int j = 0; j < 8; ++j) { v[j] = xr[64 * j]; s += v[j].x * v[j].x + v[j].y * v[j].y; }
        const float rstd = rsqrtf(wave_sum(s) * (1.f / DM) + EPS);
        float lg[16];
#pragma unroll
        for (int e = 0; e < 16; ++e) lg[e] = 0.f;
        unsigned* o4 = (unsigned*)(H2 + (size_t)m * DM) + lane;
#pragma unroll
        for (int j = 0; j < 8; ++j) {
            const f32x2 g = ((const f32x2*)a.norm2_g)[lane + 64 * j];
            const f32x2 sh = ((const f32x2*)(mod + (size_t)b * 6144 + 3072))[lane + 64 * j];
            const f32x2 sc = ((const f32x2*)(mod + (size_t)b * 6144 + 4096))[lane + 64 * j];
            const f32x2 hv = v[j] * rstd * g * (sc + 1.f) + sh;
            o4[64 * j] = pk2(hv.x, hv.y);
#pragma unroll
            for (int g4 = 0; g4 < 4; ++g4) { const f32x4 w0 = WRL[(g4 * 2 + 0) * 512 + lane + 64 * j], w1 = WRL[(g4 * 2 + 1) * 512 + lane + 64 * j];
                lg[g4 * 4 + 0] += hv.x * w0.x + hv.y * w1.x; lg[g4 * 4 + 1] += hv.x * w0.y + hv.y * w1.y; lg[g4 * 4 + 2] += hv.x * w0.z + hv.y * w1.z; lg[g4 * 4 + 3] += hv.x * w0.w + hv.y * w1.w; }
            __builtin_amdgcn_sched_barrier(0);
        }
        float r8[8];
#pragma unroll
        for (int i = 0; i < 8; ++i) { const float keep = hh_sel(lane, 32) ? lg[8 + i] : lg[i], send = hh_sel(lane, 32) ? lg[i] : lg[8 + i]; r8[i] = keep + __shfl_xor(send, 32); }
        float r4[4];
#pragma unroll
        for (int i = 0; i < 4; ++i) { const float keep = hh_sel(lane, 16) ? r8[4 + i] : r8[i], send = hh_sel(lane, 16) ? r8[i] : r8[4 + i]; r4[i] = keep + __shfl_xor(send, 16); }
        float r2[2];
#pragma unroll
        for (int i = 0; i < 2; ++i) { const float keep = hh_sel(lane, 8) ? r4[2 + i] : r4[i], send = hh_sel(lane, 8) ? r4[i] : r4[2 + i]; r2[i] = keep + __shfl_xor(send, 8); }
        float lgt; { const float keep = hh_sel(lane, 4) ? r2[1] : r2[0], send = hh_sel(lane, 4) ? r2[0] : r2[1]; lgt = keep + __shfl_xor(send, 4); }
        lgt += __shfl_xor(lgt, 2); lgt += __shfl_xor(lgt, 1);
        float mx = lgt;
#pragma unroll
        for (int o = 4; o < 64; o <<= 1) mx = fmaxf(mx, __shfl_xor(mx, o));
        const float ex = __expf(lgt - mx); float sm = ex;
#pragma unroll
        for (int o = 4; o < 64; o <<= 1) sm += __shfl_xor(sm, o);
        if ((lane & 3) == 0) AFF[(size_t)m * 16 + (lane >> 2)] = ex / sm;
    }
    __syncthreads();
}

DI void topk_task(const Ctx& F, const Args& a, int task) {
    const int b = task >> 4, e = task & 15, tid = F.tid, lane = F.lane;
    const float* AFF = (const float*)(a.ws + WS_AFF) + (size_t)b * SEQ * 16 + e;
    LAS unsigned* hist = (LAS unsigned*)F.lds;
    LAS unsigned* sfx = hist + 256;
    LAS unsigned* misc = hist + 512;
    LAS int* lidx = (LAS int*)(F.lds + 4096);
    unsigned key[8];
#pragma unroll
    for (int i = 0; i < 8; ++i) key[i] = __float_as_uint(AFF[(size_t)(tid * 8 + i) * 16]);
    unsigned prefix = 0, krem = CAP;
#pragma unroll 1
    for (int pass = 0; pass < 4; ++pass) {
        const int shift = 24 - 8 * pass;
        if (tid < 256) hist[tid] = 0;
        __syncthreads();
#pragma unroll
        for (int i = 0; i < 8; ++i) { const bool in = pass == 0 ? true : ((key[i] >> (shift + 8)) == (prefix >> (shift + 8))); if (in) atomicAdd((unsigned*)&hist[(key[i] >> shift) & 255u], 1u); }
        __syncthreads();
        if (tid < 256) sfx[tid] = hist[tid];
        __syncthreads();
#pragma unroll 1
        for (int o = 1; o < 256; o <<= 1) { unsigned v = 0; if (tid < 256) v = sfx[tid] + (tid + o < 256 ? sfx[tid + o] : 0u); __syncthreads(); if (tid < 256) sfx[tid] = v; __syncthreads(); }
        if (tid < 256) { const unsigned incl = sfx[tid], excl = incl - hist[tid]; if (excl < krem && krem <= incl) { misc[0] = (unsigned)tid; misc[1] = krem - excl; } }
        __syncthreads();
        prefix |= misc[0] << shift; krem = misc[1];
        __syncthreads();
    }
    const unsigned T = prefix, need = krem;
    unsigned cg_ = 0, ce = 0;
#pragma unroll
    for (int i = 0; i < 8; ++i) { cg_ += key[i] > T; ce += key[i] == T; }
    unsigned sg = cg_, se = ce;
#pragma unroll
    for (int o = 1; o < 64; o <<= 1) { const unsigned tg = __shfl_up(sg, o), te = __shfl_up(se, o); if (lane >= o) { sg += tg; se += te; } }
    if (lane == 63) { misc[16 + F.wave] = sg; misc[32 + F.wave] = se; }
    __syncthreads();
    unsigned og = sg - cg_, oe = se - ce;
    for (int w = 0; w < F.wave; ++w) { og += misc[16 + w]; oe += misc[32 + w]; }
    int* SLOT = (int*)(a.ws + WS_SLOT) + (size_t)b * SEQ * 16 + e;
    float* VALS = (float*)(a.ws + WS_VALS) + (size_t)(e * 8 + b) * CAP;
    int* IDX = (int*)(a.ws + WS_IDX) + (size_t)(b * 16 + e) * CAP;
#pragma unroll
    for (int i = 0; i < 8; ++i) {
        const bool gt = key[i] > T, eq = key[i] == T; const bool sel = gt || (eq && oe < need);
        const unsigned pos = og + (oe < need ? oe : need);
        const int s = tid * 8 + i;
        SLOT[(size_t)s * 16] = sel ? (int)pos : -1;
        if (sel) { lidx[pos] = s; IDX[pos] = s; VALS[pos] = __uint_as_float(key[i]); }
        og += gt; oe += eq;
    }
    __syncthreads();
    const bf16_t* H2 = (const bf16_t*)(a.ws + WS_H2) + (size_t)b * SEQ * DM; bf16_t* XE = (bf16_t*)(a.ws + WS_XE) + (size_t)(e * 8 + b) * CAP * DM;
    for (int r = F.wave; r < CAP; r += NWAVES) { const u32x4* src = (const u32x4*)(H2 + (size_t)lidx[r] * DM) + lane; u32x4* dst = (u32x4*)(XE + (size_t)r * DM) + lane;
        const u32x4 v0 = src[0], v1 = src[64]; dst[0] = v0; dst[64] = v1; }
    __syncthreads();
}

DI void final_phase(const Ctx& F, const Args& a) {
    const int gw = F.bid * NWAVES + F.wave, NGW = F.G * NWAVES, lane = F.lane;
    const float* mod = (const float*)(a.ws + WS_MOD); const int* SLOT = (const int*)(a.ws + WS_SLOT); const bf16_t* Y = (const bf16_t*)(a.ws + WS_XE);
    for (int m = gw; m < MTOK; m += NGW) {
        const int b = m / SEQ;
        const int sl = SLOT[(size_t)m * 16 + (lane & 15)];
        float acc[16];
#pragma unroll
        for (int i = 0; i < 16; ++i) acc[i] = 0.f;
#pragma unroll 1
        for (int e = 0; e < 16; ++e) { const int s = __shfl(sl, e);
            if (s >= 0) { const u32x4* yp = (const u32x4*)(Y + ((size_t)(e * 8 + b) * CAP + s) * DM + lane * 16); const u32x4 w0 = yp[0], w1 = yp[1];
                acc[0] += bflo(w0.x); acc[1] += bfhi(w0.x); acc[2] += bflo(w0.y); acc[3] += bfhi(w0.y); acc[4] += bflo(w0.z); acc[5] += bfhi(w0.z); acc[6] += bflo(w0.w); acc[7] += bfhi(w0.w);
                acc[8] += bflo(w1.x); acc[9] += bfhi(w1.x); acc[10] += bflo(w1.y); acc[11] += bfhi(w1.y); acc[12] += bflo(w1.z); acc[13] += bfhi(w1.z); acc[14] += bflo(w1.w); acc[15] += bfhi(w1.w); } }
        f32x4* op = (f32x4*)(a.out + (size_t)m * DM + lane * 16); const f32x4* gp = (const f32x4*)(mod + (size_t)b * 6144 + 5120 + lane * 16);
#pragma unroll
        for (int q = 0; q < 4; ++q) { const f32x4 g = gp[q]; f32x4 o = op[q]; o.x += g.x * acc[4 * q]; o.y += g.y * acc[4 * q + 1]; o.z += g.z * acc[4 * q + 2]; o.w += g.w * acc[4 * q + 3]; op[q] = o; }
    }
}

constexpr size_t WS_CTL = 0;
constexpr int CTL_ZERO_BYTES = 65536;
#define XB_TMO      128
#define XB_XCNT(j)  (256  + 64 * (j))
#define XB_XSUB(j)  (1280 + 64 * (j))
#define XB_XGEN(j)  (2304 + 64 * (j))
#define XB_TOP      3328
#define XB_TOPGEN   3392
#define XB_SPIN_CAP (1u << 18)
DI unsigned xb_ld(unsigned* p)              { return __hip_atomic_load(p, __ATOMIC_RELAXED, __HIP_MEMORY_SCOPE_AGENT); }
DI unsigned xb_add(unsigned* p, unsigned v) { return __hip_atomic_fetch_add(p, v, __ATOMIC_RELAXED, __HIP_MEMORY_SCOPE_AGENT); }
DI unsigned xb_xcc_id() { return (unsigned)__builtin_amdgcn_s_getreg((3 << 11) | 20) & 0xFu; }
#define XB_SPIN(cond, bar) do { unsigned _sp = 0; while (cond) { __builtin_amdgcn_s_sleep(1); \
    if ((++_sp & 255u) == 0u) { if (xb_ld(&(bar)[XB_TMO])) break; if (_sp > XB_SPIN_CAP) { atomicAdd(&(bar)[XB_TMO], 1u); break; } } } } while (0)
struct XcdBarrier { unsigned* bar; unsigned x; volatile LAS unsigned* st; };
DI XcdBarrier xcd_barrier_post(unsigned* bar, volatile LAS unsigned* st) {
    XcdBarrier b; b.bar = bar; b.x = xb_xcc_id(); b.st = st;
    if (threadIdx.x == 0) (void)xb_add(&bar[XB_XCNT(b.x)], 1u);
    return b;
}
DI void xcd_barrier_complete(unsigned* bar, unsigned x, unsigned& nloc, unsigned& nx) {
    const unsigned G = gridDim.x * gridDim.y * gridDim.z;
    unsigned sum, cnt, mine, sp = 0u;
    for (;;) {
        sum = 0u; cnt = 0u; mine = 0u;
#pragma unroll
        for (unsigned j = 0; j < 16; ++j) { const unsigned c = xb_ld(&bar[XB_XCNT(j)]); sum += c; cnt += (c > 0u) ? 1u : 0u; mine = (j == x) ? c : mine; }
        if (sum == G) break;
        __builtin_amdgcn_s_sleep(1);
        if ((++sp & 255u) == 0u) { if (xb_ld(&bar[XB_TMO])) break; if (sp > XB_SPIN_CAP) { atomicAdd(&bar[XB_TMO], 1u); break; } }
    }
    nloc = mine > 0u ? mine : 1u; nx = cnt > 0u ? cnt : 1u;
}
DI void xcd_barrier(const XcdBarrier& b) {
    asm volatile("s_waitcnt vmcnt(0)" ::: "memory");
    __syncthreads();
    if (threadIdx.x == 0) {
        unsigned* bar = b.bar;
        __builtin_amdgcn_s_waitcnt(0);
        unsigned nloc = b.st[0], nx = b.st[1];
        if (nloc == 0u) { xcd_barrier_complete(bar, b.x, nloc, nx); b.st[0] = nloc; b.st[1] = nx; }
        const unsigned old = xb_add(&bar[XB_XSUB(b.x)], 1u);
        const unsigned gen = old / nloc;
        if (old + 1u == (gen + 1u) * nloc) {
            __builtin_amdgcn_fence(__ATOMIC_RELEASE, "agent");
            asm volatile("s_waitcnt vmcnt(0)" ::: "memory");
            const unsigned og = xb_add(&bar[XB_TOP], 1u);
            const unsigned tg = og / nx;
            if (og + 1u == (tg + 1u) * nx) xb_add(&bar[XB_TOPGEN], 1u);
            else XB_SPIN(xb_ld(&bar[XB_TOPGEN]) == tg, bar);
            __builtin_amdgcn_fence(__ATOMIC_ACQUIRE, "agent");
            xb_add(&bar[XB_XGEN(b.x)], 1u);
            asm volatile("s_waitcnt vmcnt(0)" ::: "memory");
        } else {
            XB_SPIN(xb_ld(&bar[XB_XGEN(b.x)]) == gen, bar);
            __builtin_amdgcn_fence(__ATOMIC_ACQUIRE, "agent");
            asm volatile("s_waitcnt vmcnt(0)" ::: "memory");
        }
    }
    __syncthreads();
}

static_assert(sizeof(Args) == 22 * 8, "Args layout");
__global__ void __launch_bounds__(NTHR, 2) fwd_kernel(Args a_unused) {
    extern __shared__ __attribute__((aligned(16))) unsigned char lds_raw[];
    cg::grid_group grid = cg::this_grid();
    Ctx F; F.lds = (LAS unsigned char*)lds_raw; F.tid = threadIdx.x; F.lane = F.tid & 63; F.wave = __builtin_amdgcn_readfirstlane(F.tid >> 6); F.G = gridDim.x; F.bid = blockIdx.x;

    int lo, hi; { typedef __attribute__((address_space(4))) const volatile unsigned long long* kp_t; const unsigned long long ph = ((kp_t)__builtin_amdgcn_kernarg_segment_ptr())[21]; lo = (int)(unsigned)ph; hi = (int)(unsigned)(ph >> 32); }
#ifndef PHASE_MASK
#define PHASE_MASK 0xffff
#endif
#define IN(k) (((PHASE_MASK >> (k)) & 1) && lo <= (k) && (k) < hi)
    volatile LAS unsigned* bst = (volatile LAS unsigned*)(F.lds + LDS_BYTES - 64);
    if (F.tid < 2) bst[F.tid] = 0u;
    __syncthreads();
    XcdBarrier xbar;
    { const Args a0 = load_args(); xbar = xcd_barrier_post((unsigned*)(a0.ws + WS_CTL), bst); }
    volatile LAS unsigned long long* tsl = (volatile LAS unsigned long long*)(F.lds + LDS_BYTES - 256);
    if (PROBE_PHASE >= 0 && F.bid == 0 && F.tid == 0) tsl[0] = __builtin_amdgcn_s_memrealtime();
#define SEAM(k) do { if (IN(k) && IN((k) + 1)) { if ((k) == 0) grid.sync(); else xcd_barrier(xbar); } \
        if (PROBE_PHASE >= 0 && F.bid == 0 && F.tid == 0) tsl[(k) + 1] = __builtin_amdgcn_s_memrealtime(); } while (0)
    if (IN(0)) { const Args a = load_args();
#pragma unroll 1
        for (int rep = 0; rep < REP_P0; ++rep) p0_phase(F, a); }
    SEAM(0);
    if (IN(1)) { const Args a = load_args(); p1_phase(F, a); }
    SEAM(1);
    if (IN(2)) {
        const Args a = load_args();
        pg8::Gemm g{(const bf16_t*)a.out, (const bf16_t*)(a.ws + WS_WINT), MTOK, PS, DM, 1 << 30}; pg8::StaticOrder S; S.init(MTOK, PS, F.G, F.bid);
        pg8::EpiBf16 E{(bf16_t*)(a.ws + WS_PROJ), PS};
        pg8::gemm_phase<pg8::EpiBf16, true, true>(F.lds, g, S, E);
        gates_tasks(F, a);
    }
    SEAM(2);
    if (IN(3)) {
        const Args a = load_args();
        for (int t = F.bid; t < BATCH * 64; t += F.G) qk_tile_task(F, a, t);
#pragma unroll 1
        for (int rep = 0; rep < REP_M1; ++rep)
        for (int it = F.bid; it < BATCH * 4 * 64; it += F.G) m1_item(F, a, it);
    }
    SEAM(3);
    if (IN(4)) {
        const Args a = load_args();
        for (int t = F.bid; t < 512; t += F.G) scan_task(F, a, t);
        float lam, cshift;
        { const float p01 = wave_sum(a.lam_p[F.lane] * a.lam_p[64 + F.lane]), p23 = wave_sum(a.lam_p[128 + F.lane] * a.lam_p[192 + F.lane]);
          lam = __expf(p01) - __expf(p23) + 0.2f;
          const float gq = wave_max(fabsf(a.qk_g[F.lane])), gk = wave_max(fabsf(a.qk_g[64 + F.lane]));
          cshift = 8.f * gq * gk * 1.4426950408889634f * 1.02f; }
        const int xcd = F.bid & 7, j = F.bid >> 3;
#pragma unroll 1
        for (int rep = 0; rep < REP_ATT; ++rep)
        for (int i = 0; i * F.G < 1024; ++i) {
            int u;
            if (F.G == 256) u = (xcd * 4 + i) * 32 + j; else u = i * F.G + F.bid;
            if (u < 1024) attn_unit(F, a, u >> 7, (u >> 5) & 3, u & 31, lam, cshift);
        }
    }
    SEAM(4);
    if (IN(5)) { const Args a = load_args();
#pragma unroll 1
        for (int rep = 0; rep < REP_M3; ++rep)
        for (int it = F.bid; it < BATCH * 4 * 64; it += F.G) m3_item(F, a, it); }
    SEAM(5);
    if (IN(6)) {
        const Args a = load_args();
        pg8::Gemm g{(const bf16_t*)(a.ws + WS_YMIX), (const bf16_t*)(a.ws + WS_WOUTT), MTOK, DM, DM, 1 << 30}; pg8::StaticOrder S; S.init(MTOK, DM, F.G, F.bid);
        pg8::EpiX1 E{a.x, (const float*)(a.ws + WS_MOD), a.out};
        pg8::gemm_phase<pg8::EpiX1, true, true>(F.lds, g, S, E);
    }
    SEAM(6);
    if (IN(7)) { const Args a = load_args();
#pragma unroll 1
        for (int rep = 0; rep < REP_P7; ++rep) p7_phase(F, a); }
    SEAM(7);
    if (IN(8)) { const Args a = load_args(); for (int t = F.bid; t < BATCH * NEXP; t += F.G) topk_task(F, a, t); }
    SEAM(8);
#pragma unroll 1
    for (int half = 0; half < 2; ++half) {
        if (IN(9 + 2 * half)) {
            const Args a = load_args();
            pg8::Gemm g{(const bf16_t*)(a.ws + WS_XE) + (size_t)half * 32768 * DM, (const bf16_t*)(a.ws + WS_WGUT) + (size_t)half * 8 * 4096 * DM, 32768, 4096, DM, 16};
            pg8::StaticOrder S; S.init(32768, 4096, F.G, F.bid);
            pg8::EpiGU E{(bf16_t*)(a.ws + WS_HH)};
#pragma unroll 1
            for (int rep = 0; rep < REP_UP; ++rep)
            pg8::gemm_phase<pg8::EpiGU, true, true>(F.lds, g, S, E);
        }
        SEAM(9 + 2 * half);
        if (IN(10 + 2 * half)) {
            const Args a = load_args();
            pg8::Gemm g{(const bf16_t*)(a.ws + WS_HH), (const bf16_t*)(a.ws + WS_WDT) + (size_t)half * 8 * DM * DFF, 32768, DM, DFF, 16};
            pg8::StaticOrder S; S.init(32768, DM, F.G, F.bid);
            pg8::EpiDown E{(bf16_t*)(a.ws + WS_XE) + (size_t)half * 32768 * DM, (const float*)(a.ws + WS_VALS) + (size_t)half * 32768};
            pg8::gemm_phase<pg8::EpiDown, true, true>(F.lds, g, S, E);
        }
        SEAM(10 + 2 * half);
    }
    if (IN(13)) { const Args a = load_args(); final_phase(F, a); }
    if (PROBE_PHASE >= 0 && F.bid == 0 && F.tid == 0) {
        const unsigned long long t1 = __builtin_amdgcn_s_memrealtime();
        const unsigned long long d = (PROBE_PHASE == 13 ? t1 : tsl[PROBE_PHASE + 1]) - tsl[PROBE_PHASE];
        while (__builtin_amdgcn_s_memrealtime() - t1 < 3ull * d) __builtin_amdgcn_s_sleep(8);
    }
#undef IN
#undef SEAM
}

extern "C" void kernel_launch(void* const* d_in, const int* in_sizes, int n_in, void* d_out, int out_size, void* d_ws, size_t ws_size, hipStream_t stream) {
    static int grid_blocks = 0;
    if (!grid_blocks) {
        int dev = 0, cus = 0, per_cu = 0;
        (void)hipGetDevice(&dev);
        (void)hipDeviceGetAttribute(&cus, hipDeviceAttributeMultiprocessorCount, dev);
        (void)hipFuncSetAttribute((const void*)fwd_kernel, hipFuncAttributeMaxDynamicSharedMemorySize, LDS_BYTES);
        (void)hipOccupancyMaxActiveBlocksPerMultiprocessor(&per_cu, (const void*)fwd_kernel, NTHR, LDS_BYTES);
        if (per_cu < 1) per_cu = 1;
        grid_blocks = cus;
        if (ws_size < WS_END) fprintf(stderr, "kernel_launch: workspace too small: %zu < %zu\n", ws_size, (size_t)WS_END);
    }
    (void)hipMemsetAsync((char*)d_ws + WS_CTL, 0, CTL_ZERO_BYTES, stream);
    Args a{};
    a.x = (const float*)d_in[0]; a.c = (const float*)d_in[1]; a.pos = (const int*)d_in[2]; a.norm1_g = (const float*)d_in[3]; a.norm2_g = (const float*)d_in[4];
    a.w_ada = (const float*)d_in[5]; a.b_ada = (const float*)d_in[6]; a.w_in = (const float*)d_in[7]; a.conv_w = (const float*)d_in[8]; a.gate_b = (const float*)d_in[9];
    a.mnorm_g = (const float*)d_in[10]; a.qk_g = (const float*)d_in[11]; a.lam_p = (const float*)d_in[12]; a.subln_g = (const float*)d_in[13]; a.w_out = (const float*)d_in[14];
    a.w_router = (const float*)d_in[15]; a.w_gate = (const float*)d_in[16]; a.w_up = (const float*)d_in[17]; a.w_down = (const float*)d_in[18];
    a.out = (float*)d_out; a.ws = (unsigned char*)d_ws; a.ph_lo = 0; a.ph_hi = 14;
    void* args[] = {&a};
    hipError_t e = hipLaunchCooperativeKernel((const void*)fwd_kernel, dim3(grid_blocks), dim3(NTHR), args, LDS_BYTES, stream);
    if (e != hipSuccess) fprintf(stderr, "cooperative launch failed: %s (grid %d)\n", hipGetErrorString(e), grid_blocks);
}
```

```cpp
#include <hip/hip_runtime.h>
#include <hip/hip_cooperative_groups.h>
#include <cstdio>
#include <cstdint>
namespace cg = cooperative_groups;

#define LAS __attribute__((address_space(3)))
#define DI __device__ __forceinline__
typedef unsigned short bf16_t;
typedef short bf16x8 __attribute__((ext_vector_type(8)));
typedef short s16x4 __attribute__((ext_vector_type(4)));
typedef float f32x2 __attribute__((ext_vector_type(2)));
typedef float f32x4 __attribute__((ext_vector_type(4)));
typedef float f32x16 __attribute__((ext_vector_type(16)));
typedef unsigned u32x2 __attribute__((ext_vector_type(2)));
typedef unsigned u32x4 __attribute__((ext_vector_type(4)));
typedef __bf16 bf16x2_t __attribute__((ext_vector_type(2)));

constexpr int BATCH = 8, SEQ = 4096, DM = 1024, MTOK = BATCH * SEQ;
constexpr int DIN = 3600, PS = 3584;
constexpr int NEXP = 16, CAP = 512, DFF = 2048;
constexpr int NPAIR = BATCH * NEXP * CAP;
constexpr float EPS = 1e-6f;
constexpr int C_QM = 0, C_KM = 512, C_VM = 1024, C_OM = 1536, C_QA = 2048, C_KA = 2560, C_VA = 3072;

constexpr size_t MiB = 1u << 20;
constexpr size_t WS_MOD = 1 * MiB;
constexpr size_t WS_GATES = 2 * MiB;
constexpr size_t WS_AFF = 4 * MiB;
constexpr size_t WS_IDX = 6 * MiB;
constexpr size_t WS_VALS = 6 * MiB + 256 * 1024;
constexpr size_t WS_MSC = 6 * MiB + 512 * 1024;
constexpr size_t WS_SLOT = 7 * MiB;
constexpr size_t WS_NLOC = 9 * MiB;
constexpr size_t WS_WINT = 11 * MiB;
constexpr size_t WS_WGT = 18 * MiB;
constexpr size_t WS_WOUTT = 19 * MiB;
constexpr size_t WS_WGUT = 21 * MiB;
constexpr size_t WS_WDT = 85 * MiB;
constexpr size_t WS_Y = 117 * MiB;
constexpr size_t WS_PROJ = 213 * MiB;
constexpr size_t WS_YMIX = 437 * MiB;
constexpr size_t WS_KIMG = 437 * MiB;
constexpr size_t WS_VIMG = 469 * MiB;
constexpr size_t WS_YA = 501 * MiB;
constexpr size_t WS_HH = 245 * MiB;
constexpr size_t WS_H2 = 437 * MiB;
constexpr size_t WS_XE = 469 * MiB;
constexpr size_t WS_END = 533 * MiB;

constexpr int LDS_BYTES = 147456;
constexpr int PROBE_PHASE = -1;
constexpr int REP_M1 = 1, REP_M3 = 1, REP_UP = 1, REP_P0 = 1, REP_SCAN = 1, REP_P7 = 1, REP_ATT = 1, REP_QKT = 1;
constexpr int NWAVES = 8, NTHR = 512;

DI unsigned pk2(float lo, float hi) { f32x2 v = {lo, hi}; bf16x2_t b = __builtin_convertvector(v, bf16x2_t); return __builtin_bit_cast(unsigned, b); }
DI float bflo(unsigned w) { return __uint_as_float(w << 16); }
DI float bfhi(unsigned w) { return __uint_as_float(w & 0xffff0000u); }
DI float bf2f(bf16_t v) { return __uint_as_float((unsigned)v << 16); }
DI float wave_sum(float v) {
#pragma unroll
    for (int o = 1; o < 64; o <<= 1) v += __shfl_xor(v, o);
    return v;
}
DI float wave_max(float v) {
#pragma unroll
    for (int o = 1; o < 64; o <<= 1) v = fmaxf(v, __shfl_xor(v, o));
    return v;
}
DI float silu_f(float v) { return v / (1.f + __expf(-v)); }
DI float sigmoid_f(float v) { return 1.f / (1.f + __expf(-v)); }
DI float logsigmoid_f(float f) { return fminf(f, 0.f) - log1pf(__expf(-fabsf(f))); }
DI int swz16(int row) { return ((row & 3) << 2) | ((row >> 2) & 3); }
#define MFMA32(a, b, c) __builtin_amdgcn_mfma_f32_32x32x16_bf16((a), (b), (c), 0, 0, 0)
DI s16x4 trread(const LAS unsigned char* p) { return __builtin_bit_cast(s16x4, __builtin_amdgcn_ds_read_tr16_b64_v4i16((LAS s16x4*)p)); }
DI int crow(int r, int hh) { return (r & 3) + 8 * (r >> 2) + 4 * hh; }
DI bool hh_sel(int lane, int bit) { return (lane & bit) != 0; }

namespace pg8 {
constexpr int BM = 256, BK = 64, HALF = 128, HTB = HALF * BK * 2, STAGE_BYTES = 8 * HTB, NXCD = 8, WGM = 8;
DI int lds_byte(int r, int c) { const int st = (r >> 4) * 2 + (c >> 5), rr = r & 15, cc = c & 31, ob = rr * 64 + cc * 2; return st * 1024 + (ob ^ (((ob >> 9) & 1) << 5)); }
DI void stage_rc(int b, int& R, int& C) { const int st = b / 1024, sb = b % 1024, swz = sb ^ (((sb >> 9) & 1) << 5); R = (st >> 1) * 16 + swz / 64; C = (st & 1) * 32 + (swz % 64) / 2; }
DI int perm32(int rho) { const int n = rho >> 4, i = rho & 15; return 8 * (i >> 2) + 4 * n + (i & 3); }
struct Unit { int pm, pn; };
typedef int i32x4_t __attribute__((ext_vector_type(4)));
typedef int i32x8_t __attribute__((ext_vector_type(8)));
DI i32x8_t cat8(bf16x8 lo, bf16x8 hi) { const i32x4_t a = __builtin_bit_cast(i32x4_t, lo), b = __builtin_bit_cast(i32x4_t, hi); return __builtin_shufflevector(a, b, 0, 1, 2, 3, 4, 5, 6, 7); }
struct Gemm { const bf16_t* A; const bf16_t* Bt; int M, N, K, tpg; };
struct StaticOrder {
    int nM, nN, nwg, G, c;
    DI void init(int M, int N, int G_, int c_) { nM = M / BM; nN = N / BM; nwg = nM * nN; G = G_; c = c_; }
    DI bool next(int i, Unit& u) const {
        const long L = (long)i * G + c; if (L >= nwg) return false;
        int wgid = (int)L; { const int q = nwg / NXCD, r = nwg % NXCD, xcd = wgid % NXCD, off = wgid / NXCD; wgid = (xcd < r ? xcd * (q + 1) : r * (q + 1) + (xcd - r) * q) + off; }
        const int nig = WGM * nN, gid = wgid / nig, fm = gid * WGM, gsz = (nM - fm) < WGM ? (nM - fm) : WGM;
        u.pm = fm + ((wgid % nig) % gsz); u.pn = (wgid % nig) / gsz; return true;
    }
};

template <class Epi, bool ALIGN_EPI, bool SP2, bool FP8 = false>
DI void gemm_phase(LAS unsigned char* lds, const Gemm g, const StaticOrder& S, const Epi& E) {
    const int tid = threadIdx.x, wid = __builtin_amdgcn_readfirstlane(tid >> 6), lane = tid & 63, wr = wid >> 2, wc = wid & 3, fr = lane & 15, fq = lane >> 4;
    const int KB = FP8 ? g.K : 2 * g.K, nt = KB / (BK * 2);
    unsigned voffA[2], voffB[2];
#pragma unroll
    for (int i = 0; i < 2; ++i) { int R, C; stage_rc(tid * 16 + i * 8192, R, C); const int Rb = Epi::PERM ? ((R & ~31) + perm32(R & 31)) : R;
        voffA[i] = (unsigned)(R * KB + C * 2); voffB[i] = (unsigned)(Rb * KB + C * 2); }
    const size_t kstep = (size_t)(BK * 2);
    const size_t hstep = (size_t)HALF * KB;
    const size_t tstep = 2 * hstep;
    const size_t gstep = (size_t)g.N * KB;
    const unsigned ldsw = (unsigned)wid * 1024u;
    const int aoff = lds_byte(wr * 64 + fr, fq * 8), boff = lds_byte(wc * 32 + fr, fq * 8);
#define PG8_SA(b, h) (((b) * 2 + (h)) * HTB)
#define PG8_SB(b, h) ((4 + (b) * 2 + (h)) * HTB)
#define PG8_STAGE(bufoff, gbase, voff) do { _Pragma("unroll") for (int _i = 0; _i < 2; ++_i) \
        __builtin_amdgcn_global_load_lds((const unsigned*)((const char*)(gbase) + (voff)[_i]), (LAS unsigned*)(lds + (bufoff) + ldsw + _i * 8192), 16, 0, 0); } while (0)
#define PG8_LDA(dst, b, h) do { if constexpr (FP8) { _Pragma("unroll") for (int m = 0; m < 4; ++m) dst##8[m] = cat8(*(const LAS bf16x8*)(lds + PG8_SA(b, h) + aoff + m * 2048), *(const LAS bf16x8*)(lds + PG8_SA(b, h) + aoff + m * 2048 + 1024)); } \
        else { _Pragma("unroll") for (int m = 0; m < 4; ++m) _Pragma("unroll") for (int k = 0; k < 2; ++k) dst[m][k] = *(const LAS bf16x8*)(lds + PG8_SA(b, h) + aoff + m * 2048 + k * 1024); } } while (0)
#define PG8_LDB(dst, b, h) do { if constexpr (FP8) { _Pragma("unroll") for (int n = 0; n < 2; ++n) dst##8[n] = cat8(*(const LAS bf16x8*)(lds + PG8_SB(b, h) + boff + n * 2048), *(const LAS bf16x8*)(lds + PG8_SB(b, h) + boff + n * 2048 + 1024)); } \
        else { _Pragma("unroll") for (int n = 0; n < 2; ++n) _Pragma("unroll") for (int k = 0; k < 2; ++k) dst[n][k] = *(const LAS bf16x8*)(lds + PG8_SB(b, h) + boff + n * 2048 + k * 1024); } } while (0)
#define PG8_MMA(ai, bj, At, Bt) do { __builtin_amdgcn_s_setprio(1); \
        if constexpr (FP8) { _Pragma("unroll") for (int m = 0; m < 4; ++m) _Pragma("unroll") for (int n = 0; n < 2; ++n) \
            asm volatile("s_nop 1\n\tv_mfma_f32_16x16x128_f8f6f4 %0, %1, %2, %0" : "+v"(acc[ai][bj][m][n]) : "v"(Bt##8[n]), "v"(At##8[m])); } \
        else { _Pragma("unroll") for (int m = 0; m < 4; ++m) _Pragma("unroll") for (int n = 0; n < 2; ++n) _Pragma("unroll") for (int k = 0; k < 2; ++k) \
            acc[ai][bj][m][n] = __builtin_amdgcn_mfma_f32_16x16x32_bf16(Bt[n][k], At[m][k], acc[ai][bj][m][n], 0, 0, 0); } \
        __builtin_amdgcn_s_setprio(0); } while (0)
#define PG8_WAIT_V(n) asm volatile("s_waitcnt vmcnt(" #n ")" ::: "memory")
#define PG8_WAIT_L(n) asm volatile("s_waitcnt lgkmcnt(" #n ")" ::: "memory")
#define PG8_BAR __builtin_amdgcn_s_barrier()
#define PG8_SCHED __builtin_amdgcn_sched_barrier(0)
    Unit cur, nxt; int ui = 0;
    if (!S.next(0, cur)) return;
    f32x4 acc[2][2][4][2];
#pragma unroll
    for (int a = 0; a < 2; ++a)
#pragma unroll
        for (int b = 0; b < 2; ++b)
#pragma unroll
            for (int m = 0; m < 4; ++m)
#pragma unroll
                for (int n = 0; n < 2; ++n) acc[a][b][m][n] = (f32x4){0.f, 0.f, 0.f, 0.f};
    bf16x8 At[4][2], B0[2][2], B1[2][2]; i32x8_t At8[4], B08[2], B18[2];
    const char* cA = (const char*)g.A + (size_t)cur.pm * tstep; const char* cB = (const char*)g.Bt + (size_t)(cur.pm / g.tpg) * gstep + (size_t)cur.pn * tstep;
    if constexpr (SP2) {
        PG8_STAGE(PG8_SB(0, 0), cB, voffB); PG8_STAGE(PG8_SB(0, 1), cB + hstep, voffB); PG8_STAGE(PG8_SA(0, 0), cA, voffA); PG8_STAGE(PG8_SA(0, 1), cA + hstep, voffA);
        if (wr == 1) PG8_BAR;
        PG8_WAIT_V(2); PG8_BAR;
        PG8_STAGE(PG8_SB(1, 0), cB + kstep, voffB); PG8_STAGE(PG8_SA(1, 0), cA + kstep, voffA); PG8_STAGE(PG8_SB(1, 1), cB + hstep + kstep, voffB);
        PG8_WAIT_V(6); PG8_BAR;
    } else {
        PG8_STAGE(PG8_SB(0, 0), cB, voffB); PG8_STAGE(PG8_SA(0, 0), cA, voffA); PG8_STAGE(PG8_SB(0, 1), cB + hstep, voffB); PG8_STAGE(PG8_SA(0, 1), cA + hstep, voffA);
        if (wr == 1) PG8_BAR;
        PG8_WAIT_V(4); PG8_BAR;
        PG8_STAGE(PG8_SB(1, 0), cB + kstep, voffB); PG8_STAGE(PG8_SA(1, 0), cA + kstep, voffA); PG8_STAGE(PG8_SB(1, 1), cB + hstep + kstep, voffB);
        PG8_WAIT_V(6); PG8_BAR;
    }
    for (;;) {
        const bool has_next = S.next(ui + 1, nxt);
        const char* nA = has_next ? (const char*)g.A + (size_t)nxt.pm * tstep : cA;
        const char* nB = has_next ? (const char*)g.Bt + (size_t)(nxt.pm / g.tpg) * gstep + (size_t)nxt.pn * tstep : cB;
        for (int t = 0; t < nt; t += 2) {
            const bool last = (t == nt - 2);
            const char* a1 = cA + (size_t)(t + 1) * kstep;
            const char* a2 = last ? nA : cA + (size_t)(t + 2) * kstep; const char* b2 = last ? nB : cB + (size_t)(t + 2) * kstep;
            const char* a3 = a2 + kstep; const char* b3 = b2 + kstep;
            if constexpr (SP2) {
            PG8_LDB(B0, 0, 0); PG8_LDB(B1, 0, 1); PG8_SCHED; PG8_LDA(At, 0, 0); PG8_STAGE(PG8_SA(1, 1), a1 + hstep, voffA);
            PG8_WAIT_V(8); PG8_WAIT_L(0); PG8_BAR; PG8_MMA(0, 0, At, B0); PG8_MMA(0, 1, At, B1); PG8_BAR; PG8_SCHED;
            PG8_LDA(At, 0, 1); PG8_STAGE(PG8_SB(0, 0), b2, voffB); PG8_STAGE(PG8_SB(0, 1), b2 + hstep, voffB); PG8_STAGE(PG8_SA(0, 0), a2, voffA);
            PG8_WAIT_V(8); PG8_WAIT_L(0); PG8_BAR; PG8_MMA(1, 0, At, B0); PG8_MMA(1, 1, At, B1); PG8_BAR; PG8_SCHED;
            PG8_LDB(B0, 1, 0); PG8_LDB(B1, 1, 1); PG8_SCHED; PG8_LDA(At, 1, 0); PG8_STAGE(PG8_SA(0, 1), a2 + hstep, voffA);
            PG8_WAIT_V(8); PG8_WAIT_L(0); PG8_BAR; PG8_MMA(0, 0, At, B0); PG8_MMA(0, 1, At, B1); PG8_BAR; PG8_SCHED;
            PG8_LDA(At, 1, 1); PG8_STAGE(PG8_SB(1, 0), b3, voffB); PG8_STAGE(PG8_SB(1, 1), b3 + hstep, voffB); PG8_STAGE(PG8_SA(1, 0), a3, voffA);
            PG8_WAIT_V(8); PG8_WAIT_L(0); PG8_BAR; PG8_MMA(1, 0, At, B0); PG8_MMA(1, 1, At, B1); PG8_BAR; PG8_SCHED;
            } else {
            PG8_LDB(B0, 0, 0); PG8_SCHED; PG8_LDA(At, 0, 0); PG8_STAGE(PG8_SA(1, 1), a1 + hstep, voffA);
            PG8_WAIT_L(8); PG8_BAR; PG8_WAIT_L(0); PG8_MMA(0, 0, At, B0); PG8_BAR; PG8_SCHED;
            PG8_LDB(B1, 0, 1); PG8_STAGE(PG8_SB(0, 0), b2, voffB);
            PG8_BAR; PG8_WAIT_L(0); PG8_MMA(0, 1, At, B1); PG8_BAR;
            PG8_LDA(At, 0, 1); PG8_STAGE(PG8_SA(0, 0), a2, voffA);
            PG8_BAR; PG8_WAIT_L(0); PG8_MMA(1, 0, At, B0); PG8_BAR; PG8_SCHED;
            PG8_STAGE(PG8_SB(0, 1), b2 + hstep, voffB);
            PG8_WAIT_V(6); PG8_BAR; PG8_MMA(1, 1, At, B1); PG8_BAR;
            PG8_LDB(B0, 1, 0); PG8_SCHED; PG8_LDA(At, 1, 0); PG8_STAGE(PG8_SA(0, 1), a2 + hstep, voffA);
            PG8_WAIT_L(8); PG8_BAR; PG8_WAIT_L(0); PG8_MMA(0, 0, At, B0); PG8_BAR; PG8_SCHED;
            PG8_LDB(B1, 1, 1); PG8_STAGE(PG8_SB(1, 0), b3, voffB);
            PG8_BAR; PG8_WAIT_L(0); PG8_MMA(0, 1, At, B1); PG8_BAR;
            PG8_LDA(At, 1, 1); PG8_STAGE(PG8_SA(1, 0), a3, voffA);
            PG8_BAR; PG8_WAIT_L(0); PG8_MMA(1, 0, At, B0); PG8_BAR; PG8_SCHED;
            PG8_STAGE(PG8_SB(1, 1), b3 + hstep, voffB);
            PG8_WAIT_V(6); PG8_BAR; PG8_MMA(1, 1, At, B1); PG8_BAR;
            }
        }
        if constexpr (ALIGN_EPI) { if (wr == 0) PG8_BAR; }
        if constexpr (FP8) asm volatile("s_nop 15\n\ts_nop 7" ::: "memory");
        E(acc, cur, wr, wc, fr, fq);
        if (!has_next) break;
#pragma unroll
        for (int a = 0; a < 2; ++a)
#pragma unroll
            for (int b = 0; b < 2; ++b)
#pragma unroll
                for (int m = 0; m < 4; ++m)
#pragma unroll
                    for (int n = 0; n < 2; ++n) acc[a][b][m][n] = (f32x4){0.f, 0.f, 0.f, 0.f};
        cur = nxt; cA = nA; cB = nB; ++ui;
        if constexpr (ALIGN_EPI) { if (wr == 1) PG8_BAR; }
    }
    PG8_WAIT_V(0);
    if constexpr (!ALIGN_EPI) { if (wr == 0) PG8_BAR; }
    PG8_BAR;
#undef PG8_SA
#undef PG8_SB
#undef PG8_STAGE
#undef PG8_LDA
#undef PG8_LDB
#undef PG8_MMA
#undef PG8_WAIT_V
#undef PG8_WAIT_L
#undef PG8_BAR
#undef PG8_SCHED
}

struct EpiBf16 {
    static constexpr bool PERM = true;
    bf16_t* O; int ldc;
    DI void operator()(const f32x4 (&acc)[2][2][4][2], const Unit& u, int wr, int wc, int fr, int fq) const {
        const int row0 = u.pm * BM + wr * 64 + fr, col0 = u.pn * BM + wc * 32 + 8 * fq;
#pragma unroll
        for (int ai = 0; ai < 2; ++ai)
#pragma unroll
            for (int m = 0; m < 4; ++m) { bf16_t* rowp = O + (size_t)(row0 + ai * HALF + m * 16) * ldc + col0;
#pragma unroll
                for (int bj = 0; bj < 2; ++bj) { const f32x4 v0 = acc[ai][bj][m][0], v1 = acc[ai][bj][m][1];
                    u32x4 w; w.x = pk2(v0[0], v0[1]); w.y = pk2(v0[2], v0[3]); w.z = pk2(v1[0], v1[1]); w.w = pk2(v1[2], v1[3]);
                    *(u32x4*)(rowp + bj * HALF) = w; } }
    }
};
struct EpiX1 {
    static constexpr bool PERM = false;
    const float* x; const float* mod; float* out;
    DI void operator()(const f32x4 (&acc)[2][2][4][2], const Unit& u, int wr, int wc, int fr, int fq) const {
        const int row0 = u.pm * BM + wr * 64 + fr, col0 = u.pn * BM + wc * 32 + 4 * fq;
        const int b = (u.pm * BM) / SEQ;
        const float* gp = mod + (size_t)b * 6144 + 2048 + col0;
#pragma unroll
        for (int bj = 0; bj < 2; ++bj)
#pragma unroll
            for (int n = 0; n < 2; ++n) { const f32x4 gv = *(const f32x4*)(gp + bj * HALF + n * 16);
#pragma unroll
                for (int ai = 0; ai < 2; ++ai)
#pragma unroll
                    for (int m = 0; m < 4; ++m) { const size_t off = (size_t)(row0 + ai * HALF + m * 16) * DM + col0 + bj * HALF + n * 16;
                        const f32x4 xv = *(const f32x4*)(x + off); *(f32x4*)(out + off) = xv + gv * acc[ai][bj][m][n]; } }
    }
};
DI unsigned pk4_fp8(float a, float b, float c, float d) { int w = __builtin_amdgcn_cvt_pk_fp8_f32(a, b, 0, false); w = __builtin_amdgcn_cvt_pk_fp8_f32(c, d, w, true); return (unsigned)w; }
constexpr float W_PRESCALE = 32.f, H_PRESCALE = 8.f;
struct EpiGU {
    static constexpr bool PERM = true;
    unsigned char* H;
    DI void operator()(const f32x4 (&acc)[2][2][4][2], const Unit& u, int wr, int wc, int fr, int fq) const {
        const int row0 = u.pm * BM + wr * 64 + fr, col0 = u.pn * HALF + wc * 32 + 8 * fq;
#pragma unroll
        for (int ai = 0; ai < 2; ++ai)
#pragma unroll
            for (int m = 0; m < 4; ++m) { unsigned char* rowp = H + (size_t)(row0 + ai * HALF + m * 16) * DFF + col0;
                float hv[8];
#pragma unroll
                for (int n = 0; n < 2; ++n)
#pragma unroll
                    for (int j = 0; j < 4; ++j) { const float gg = acc[ai][0][m][n][j] * (1.f / W_PRESCALE), uu = acc[ai][1][m][n][j] * (H_PRESCALE / W_PRESCALE); hv[n * 4 + j] = gg / (1.f + __expf(-gg)) * uu; }
                u32x2 w; w.x = pk4_fp8(hv[0], hv[1], hv[2], hv[3]); w.y = pk4_fp8(hv[4], hv[5], hv[6], hv[7]);
                *(u32x2*)rowp = w; }
    }
};
struct EpiDown {
    static constexpr bool PERM = true;
    bf16_t* Y; const float* vals;
    DI void operator()(const f32x4 (&acc)[2][2][4][2], const Unit& u, int wr, int wc, int fr, int fq) const {
        const int row0 = u.pm * BM + wr * 64 + fr, col0 = u.pn * BM + wc * 32 + 8 * fq;
#pragma unroll
        for (int ai = 0; ai < 2; ++ai)
#pragma unroll
            for (int m = 0; m < 4; ++m) { const int row = row0 + ai * HALF + m * 16; const float s = vals[row] * (1.f / (W_PRESCALE * H_PRESCALE)); bf16_t* rowp = Y + (size_t)row * DM + col0;
#pragma unroll
                for (int bj = 0; bj < 2; ++bj) { const f32x4 v0 = acc[ai][bj][m][0] * s, v1 = acc[ai][bj][m][1] * s;
                    u32x4 w; w.x = pk2(v0[0], v0[1]); w.y = pk2(v0[2], v0[3]); w.z = pk2(v1[0], v1[1]); w.w = pk2(v1[2], v1[3]);
                    *(u32x4*)(rowp + bj * HALF) = w; } }
    }
};
}

struct Args {
    const float* x; const float* c; const int* pos; const float* norm1_g; const float* norm2_g; const float* w_ada; const float* b_ada;
    const float* w_in; const float* conv_w; const float* gate_b; const float* mnorm_g; const float* qk_g; const float* lam_p; const float* subln_g;
    const float* w_out; const float* w_router; const float* w_gate; const float* w_up; const float* w_down;
    float* out; unsigned char* ws; int ph_lo, ph_hi;
};
struct Ctx {
    LAS unsigned char* lds; int tid, lane, wave, G, bid;
};
DI Args load_args() {
    typedef __attribute__((address_space(4))) const volatile unsigned long long* kp_t;
    kp_t kp = (kp_t)__builtin_amdgcn_kernarg_segment_ptr();
#define GP(T, i) ((T*)(__attribute__((address_space(1))) T*)kp[i])
    Args a;
    a.x = GP(const float, 0); a.c = GP(const float, 1); a.pos = GP(const int, 2); a.norm1_g = GP(const float, 3); a.norm2_g = GP(const float, 4);
    a.w_ada = GP(const float, 5); a.b_ada = GP(const float, 6); a.w_in = GP(const float, 7); a.conv_w = GP(const float, 8); a.gate_b = GP(const float, 9);
    a.mnorm_g = GP(const float, 10); a.qk_g = GP(const float, 11); a.lam_p = GP(const float, 12); a.subln_g = GP(const float, 13); a.w_out = GP(const float, 14);
    a.w_router = GP(const float, 15); a.w_gate = GP(const float, 16); a.w_up = GP(const float, 17); a.w_down = GP(const float, 18);
    a.out = GP(float, 19); a.ws = GP(unsigned char, 20);
#undef GP
    a.ph_lo = 0; a.ph_hi = 12;
    return a;
}

DI void tr_item64(const float* src, size_t ld_src, int k0, int c0, bf16_t* dst, size_t r0, int ld_dst, LAS float* scr  , int lane) {
    const float* sp = src + (size_t)(k0 + (lane >> 4)) * ld_src + c0 + (lane & 15) * 4;
#pragma unroll 1
    for (int hf = 0; hf < 2; ++hf) {
        f32x4 v[8];
#pragma unroll
        for (int i = 0; i < 8; ++i) v[i] = *(const f32x4*)(sp + (size_t)(4 * (8 * hf + i)) * ld_src);
#pragma unroll
        for (int i = 0; i < 8; ++i) *(LAS f32x4*)(scr + (4 * (8 * hf + i) + (lane >> 4)) * 68 + (lane & 15) * 4) = v[i];
    }
    asm volatile("s_waitcnt lgkmcnt(0)" ::: "memory");
    const int c = lane & 7;
#pragma unroll
    for (int q = 0; q < 8; ++q) { const int n = 8 * q + (lane >> 3); const LAS float* s = scr + (8 * c) * 68 + n;
        u32x4 o; o.x = pk2(s[0 * 68], s[1 * 68]); o.y = pk2(s[2 * 68], s[3 * 68]); o.z = pk2(s[4 * 68], s[5 * 68]); o.w = pk2(s[6 * 68], s[7 * 68]);
        *(u32x4*)(dst + (r0 + n) * ld_dst + k0 + 8 * c) = o; }
    asm volatile("s_waitcnt lgkmcnt(0)" ::: "memory");
}
DI void tr_item64_fp8(const float* src, size_t ld_src, int k0, int c0, unsigned char* dst, size_t r0, int ld_dst, float scale, LAS float* scr  , int lane) {
    const float* sp = src + (size_t)(k0 + (lane >> 4)) * ld_src + c0 + (lane & 15) * 4;
#pragma unroll 1
    for (int hf = 0; hf < 2; ++hf) {
        f32x4 v[8];
#pragma unroll
        for (int i = 0; i < 8; ++i) v[i] = *(const f32x4*)(sp + (size_t)(4 * (8 * hf + i)) * ld_src);
#pragma unroll
        for (int i = 0; i < 8; ++i) *(LAS f32x4*)(scr + (4 * (8 * hf + i) + (lane >> 4)) * 68 + (lane & 15) * 4) = v[i] * scale;
    }
    asm volatile("s_waitcnt lgkmcnt(0)" ::: "memory");
    const int c = lane & 3;
#pragma unroll
    for (int q = 0; q < 4; ++q) { const int n = 16 * q + (lane >> 2); const LAS float* s = scr + (16 * c) * 68 + n;
        u32x4 o; o.x = pg8::pk4_fp8(s[0 * 68], s[1 * 68], s[2 * 68], s[3 * 68]); o.y = pg8::pk4_fp8(s[4 * 68], s[5 * 68], s[6 * 68], s[7 * 68]);
        o.z = pg8::pk4_fp8(s[8 * 68], s[9 * 68], s[10 * 68], s[11 * 68]); o.w = pg8::pk4_fp8(s[12 * 68], s[13 * 68], s[14 * 68], s[15 * 68]);
        *(u32x4*)(dst + (r0 + n) * ld_dst + k0 + 16 * c) = o; }
    asm volatile("s_waitcnt lgkmcnt(0)" ::: "memory");
}
DI void p0_phase(const Ctx& F, const Args& a) {
    if (F.bid < 96) {
        LAS float* sc = (LAS float*)F.lds; LAS float* part = (LAS float*)(F.lds + 32768);
        for (int i = F.tid; i < BATCH * DM; i += NTHR) sc[i] = silu_f(a.c[i]);
        __syncthreads();
        const int col = F.bid * 64 + F.lane;
        float acc[8];
#pragma unroll
        for (int b = 0; b < 8; ++b) acc[b] = 0.f;
        const int kb = F.wave * 128;
#pragma unroll 1
        for (int k0 = kb; k0 < kb + 128; k0 += 16) {
            float w[16];
            const float* wp = a.w_ada + (size_t)k0 * 6144 + col;
#pragma unroll
            for (int j = 0; j < 16; ++j) w[j] = wp[(size_t)j * 6144];
#pragma unroll
            for (int j = 0; j < 16; ++j)
#pragma unroll
                for (int b = 0; b < 8; ++b) acc[b] += sc[b * DM + k0 + j] * w[j];
        }
#pragma unroll
        for (int b = 0; b < 8; ++b) part[(F.wave * 8 + b) * 64 + F.lane] = acc[b];
        __syncthreads();
        { const int b = F.tid >> 6, l = F.tid & 63; float s = a.b_ada[F.bid * 64 + l];
#pragma unroll
          for (int w = 0; w < 8; ++w) s += part[(w * 8 + b) * 64 + l];
          ((float*)(a.ws + WS_MOD))[b * 6144 + F.bid * 64 + l] = s; }
        __syncthreads();
    }
    LAS float* scr = (LAS float*)(F.lds + F.wave * 17408);
    const int gw = F.bid * NWAVES + F.wave, NGW = F.G * NWAVES;
    constexpr int I_IN = 16 * 56, I_OUT = 16 * 16, I_G = 16 * 16 * 32, I_D = 16 * 32 * 16, I_WG = 16;
    constexpr int NITEMS = I_IN + I_OUT + 2 * I_G + I_D + I_WG;
    bf16_t* WinT = (bf16_t*)(a.ws + WS_WINT); bf16_t* WgT = (bf16_t*)(a.ws + WS_WGT); bf16_t* WoutT = (bf16_t*)(a.ws + WS_WOUTT);
    unsigned char* WguT = a.ws + WS_WGUT; unsigned char* WdT = a.ws + WS_WDT;
    for (int it = gw; it < NITEMS; it += NGW) {
        int r = it;
        if (r < I_IN) { const int kb = r / 56, nb = r % 56, n0 = nb * 64; tr_item64(a.w_in, DIN, kb * 64, n0 + (n0 >= 2048 ? 16 : 0), WinT, n0, DM, scr, F.lane); continue; } r -= I_IN;
        if (r < I_OUT) { const int kb = r / 16, nb = r % 16; tr_item64(a.w_out, DM, kb * 64, nb * 64, WoutT, nb * 64, DM, scr, F.lane); continue; } r -= I_OUT;
        if (r < 2 * I_G) { const int up = r / I_G; r -= up * I_G; const int e = r / 512; r -= e * 512; const int kb = r / 32, nb = r % 32, n0 = nb * 64;
            const float* src = (up ? a.w_up : a.w_gate) + (size_t)e * DM * DFF;
            tr_item64_fp8(src, DFF, kb * 64, n0, WguT + (size_t)e * 4096 * DM, (size_t)(n0 / 128) * 256 + (n0 % 128) + up * 128, DM, pg8::W_PRESCALE, scr, F.lane); continue; } r -= 2 * I_G;
        if (r < I_D) { const int e = r / 512; r -= e * 512; const int kb = r / 16, nb = r % 16;
            tr_item64_fp8(a.w_down + (size_t)e * DFF * DM, DM, kb * 64, nb * 64, WdT + (size_t)e * DM * DFF, nb * 64, DFF, pg8::W_PRESCALE, scr, F.lane); continue; } r -= I_D;
        tr_item64(a.w_in, DIN, r * 64, 2048 - 48, WgT, 0, DM, scr, F.lane);
    }
}

DI void p1_phase(const Ctx& F, const Args& a) {
    const int gw = F.bid * NWAVES + F.wave, NGW = F.G * NWAVES;
    const float* mod = (const float*)(a.ws + WS_MOD);
    bf16_t* H1 = (bf16_t*)a.out;
    for (int m = gw; m < MTOK; m += NGW) {
        const int b = m / SEQ;
        const f32x4* xr = (const f32x4*)(a.x + (size_t)m * DM) + F.lane;
        f32x4 v[4]; float s = 0.f;
#pragma unroll
        for (int j = 0; j < 4; ++j) { v[j] = xr[64 * j]; s += (v[j].x * v[j].x + v[j].y * v[j].y) + (v[j].z * v[j].z + v[j].w * v[j].w); }
        const float rstd = rsqrtf(wave_sum(s) * (1.f / DM) + EPS);
        u32x2* o8 = (u32x2*)(H1 + (size_t)m * DM) + F.lane;
#pragma unroll
        for (int j = 0; j < 4; ++j) {
            const f32x4 g = ((const f32x4*)a.norm1_g)[F.lane + 64 * j];
            const f32x4 sh = ((const f32x4*)(mod + (size_t)b * 6144))[F.lane + 64 * j];
            const f32x4 sc = ((const f32x4*)(mod + (size_t)b * 6144 + 1024))[F.lane + 64 * j];
            const f32x4 h = v[j] * rstd * g * (sc + 1.f) + sh;
            u32x2 w; w.x = pk2(h.x, h.y); w.y = pk2(h.z, h.w); o8[64 * j] = w; }
    }
}

DI void gates_tasks(const Ctx& F, const Args& a) {
    const int gw = F.bid * NWAVES + F.wave, NGW = F.G * NWAVES;
    const bf16_t* H1 = (const bf16_t*)a.out; const bf16_t* WgT = (const bf16_t*)(a.ws + WS_WGT) + 48 * DM; float* GT = (float*)(a.ws + WS_GATES);
    const float bias = a.gate_b[F.lane & 15];
    for (int task = gw; task < MTOK / 16; task += NGW) {
        const int row0 = task * 16;
        const bf16_t* ap = H1 + (size_t)(row0 + (F.lane & 15)) * DM + 8 * (F.lane >> 4);
        const bf16_t* bp = WgT + (size_t)(F.lane & 15) * DM + 8 * (F.lane >> 4);
        f32x4 acc = {0.f, 0.f, 0.f, 0.f};
#pragma unroll 8
        for (int i = 0; i < 32; ++i) { const bf16x8 av = *(const bf16x8*)(ap + 32 * i), bv = *(const bf16x8*)(bp + 32 * i); acc = __builtin_amdgcn_mfma_f32_16x16x32_bf16(av, bv, acc, 0, 0, 0); }
#pragma unroll
        for (int r = 0; r < 4; ++r) GT[(size_t)(row0 + (F.lane >> 4) * 4 + r) * 16 + (F.lane & 15)] = acc[r] + bias;
    }
}

DI void qk_tile_task(const Ctx& F, const Args& a, int task) {
    const int b = task >> 6, tile = task & 63, r = F.lane, g = F.wave, h = g >> 1, p = g & 1;
    bf16_t* PROJ = (bf16_t*)(a.ws + WS_PROJ);
    const size_t tok = (size_t)b * SEQ + tile * 64 + r;
    float invf[8];
#pragma unroll
    for (int i = 0; i < 8; ++i) invf[i] = exp2f(-(float)i * 0.125f * 18.931568569324174f) * 0.15915494309189535f;
    const float pos = (float)a.pos[tok];
    float sn[8], cs[8];
#pragma unroll
    for (int i = 0; i < 8; ++i) { const float fr = __builtin_amdgcn_fractf(pos * invf[i]); sn[i] = __builtin_amdgcn_sinf(fr); cs[i] = __builtin_amdgcn_cosf(fr); }
#pragma unroll 1
    for (int isk = 0; isk < 2; ++isk) {
        u32x4* src = (u32x4*)(PROJ + tok * PS + (isk ? C_KA : C_QA) + g * 64);
        u32x4 w[8];
#pragma unroll
        for (int c = 0; c < 8; ++c) w[c] = src[c];
        float ss = 0.f;
#pragma unroll
        for (int c = 0; c < 8; ++c) { float t;
            t = bflo(w[c].x); ss += t * t; t = bfhi(w[c].x); ss += t * t; t = bflo(w[c].y); ss += t * t; t = bfhi(w[c].y); ss += t * t;
            t = bflo(w[c].z); ss += t * t; t = bfhi(w[c].z); ss += t * t; t = bflo(w[c].w); ss += t * t; t = bfhi(w[c].w); ss += t * t; }
        const float rstd = rsqrtf(ss * (1.f / 64.f) + EPS) * (isk ? 1.f : 0.125f * 1.4426950408889634f);
        const float* gp = a.qk_g + isk * 64;
        float v0[16];
        v0[0] = bflo(w[0].x); v0[1] = bfhi(w[0].x); v0[2] = bflo(w[0].y); v0[3] = bfhi(w[0].y); v0[4] = bflo(w[0].z); v0[5] = bfhi(w[0].z); v0[6] = bflo(w[0].w); v0[7] = bfhi(w[0].w);
        v0[8] = bflo(w[1].x); v0[9] = bfhi(w[1].x); v0[10] = bflo(w[1].y); v0[11] = bfhi(w[1].y); v0[12] = bflo(w[1].z); v0[13] = bfhi(w[1].z); v0[14] = bflo(w[1].w); v0[15] = bfhi(w[1].w);
#pragma unroll
        for (int i = 0; i < 16; ++i) v0[i] *= rstd * gp[i];
        float rr[16];
#pragma unroll
        for (int i = 0; i < 8; ++i) { rr[i] = v0[i] * cs[i] - v0[i + 8] * sn[i]; rr[i + 8] = v0[i + 8] * cs[i] + v0[i] * sn[i]; }
        u32x4 o[8];
        o[0].x = pk2(rr[0], rr[1]); o[0].y = pk2(rr[2], rr[3]); o[0].z = pk2(rr[4], rr[5]); o[0].w = pk2(rr[6], rr[7]);
        o[1].x = pk2(rr[8], rr[9]); o[1].y = pk2(rr[10], rr[11]); o[1].z = pk2(rr[12], rr[13]); o[1].w = pk2(rr[14], rr[15]);
#pragma unroll
        for (int c = 2; c < 8; ++c) { const f32x4 g0 = *(const f32x4*)(gp + c * 8), g1 = *(const f32x4*)(gp + c * 8 + 4);
            o[c].x = pk2(bflo(w[c].x) * rstd * g0.x, bfhi(w[c].x) * rstd * g0.y); o[c].y = pk2(bflo(w[c].y) * rstd * g0.z, bfhi(w[c].y) * rstd * g0.w);
            o[c].z = pk2(bflo(w[c].z) * rstd * g1.x, bfhi(w[c].z) * rstd * g1.y); o[c].w = pk2(bflo(w[c].w) * rstd * g1.z, bfhi(w[c].w) * rstd * g1.w); }
        if (isk == 0) {
#pragma unroll
            for (int c = 0; c < 8; ++c) src[c] = o[c];
        } else {
            u32x4* dst = (u32x4*)((bf16_t*)(a.ws + WS_KIMG) + ((size_t)((b * 4 + h) * 64 + tile)) * 8192) + r;
#pragma unroll
            for (int c = 0; c < 8; ++c) dst[(p * 8 + c) * 64] = o[c];
        }
    }
    {
        u32x4* dst = (u32x4*)((bf16_t*)(a.ws + WS_VIMG) + ((size_t)((b * 4 + h) * 64 + tile)) * 8192) + r;
#pragma unroll
        for (int cg = 2 * p; cg < 2 * p + 2; ++cg)
#pragma unroll
            for (int kg = 0; kg < 4; ++kg) {
                const u32x4 v = *(const u32x4*)(PROJ + ((size_t)b * SEQ + tile * 64 + 16 * kg + (r >> 2)) * PS + C_VA + h * 128 + 32 * cg + 8 * (r & 3));
                dst[(cg * 4 + kg) * 64] = v; }
    }
}

template <bool H0, bool H12>
DI void load_conv_tile(const Ctx& F, const Args& a, const bf16_t* projb, int c, int colbase, int chb, float scale, LAS unsigned char* img0,
                       const LAS float* rw1, LAS unsigned char* img1, const LAS float* rw2, LAS unsigned char* img2) {
    const int ch = F.tid & 15;
    float cw[5][8];
#pragma unroll
    for (int j = 0; j < 5; ++j) { const f32x4 c0 = *(const f32x4*)(a.conv_w + j * 1024 + chb + ch * 8), c1 = *(const f32x4*)(a.conv_w + j * 1024 + chb + ch * 8 + 4);
        cw[j][0] = c0.x; cw[j][1] = c0.y; cw[j][2] = c0.z; cw[j][3] = c0.w; cw[j][4] = c1.x; cw[j][5] = c1.y; cw[j][6] = c1.z; cw[j][7] = c1.w; }
#pragma unroll
    for (int it = 0; it < 2; ++it) {
        const int row = (F.tid >> 4) + 32 * it, t0 = c * 64 + row;
        float acc[8];
#pragma unroll
        for (int i = 0; i < 8; ++i) acc[i] = 0.f;
#pragma unroll
        for (int j = 0; j < 5; ++j) { const int tt = t0 + j - 2;
            if (tt >= 0 && tt < SEQ) { const u32x4 w = *(const u32x4*)(projb + (size_t)tt * PS + colbase + ch * 8);
                acc[0] += bflo(w.x) * cw[j][0]; acc[1] += bfhi(w.x) * cw[j][1]; acc[2] += bflo(w.y) * cw[j][2]; acc[3] += bfhi(w.y) * cw[j][3];
                acc[4] += bflo(w.z) * cw[j][4]; acc[5] += bfhi(w.z) * cw[j][5]; acc[6] += bflo(w.w) * cw[j][6]; acc[7] += bfhi(w.w) * cw[j][7]; } }
#pragma unroll
        for (int i = 0; i < 8; ++i) acc[i] = silu_f(acc[i]) * scale;
        const int off = row * 256 + ((ch ^ swz16(row)) << 4);
        if constexpr (H0) { u32x4 o; o.x = pk2(acc[0], acc[1]); o.y = pk2(acc[2], acc[3]); o.z = pk2(acc[4], acc[5]); o.w = pk2(acc[6], acc[7]); *(LAS u32x4*)(img0 + off) = o; }
        if constexpr (H12) { const float w = rw1[row]; u32x4 o; o.x = pk2(acc[0] * w, acc[1] * w); o.y = pk2(acc[2] * w, acc[3] * w); o.z = pk2(acc[4] * w, acc[5] * w); o.w = pk2(acc[6] * w, acc[7] * w); *(LAS u32x4*)(img1 + off) = o; }
        if constexpr (H12) { const float w = rw2[row]; u32x4 o; o.x = pk2(acc[0] * w, acc[1] * w); o.y = pk2(acc[2] * w, acc[3] * w); o.z = pk2(acc[4] * w, acc[5] * w); o.w = pk2(acc[6] * w, acc[7] * w); *(LAS u32x4*)(img2 + off) = o; }
    }
}
DI void load_plain_tile(const Ctx& F, const bf16_t* projb, int c, int colbase, LAS unsigned char* img) {
    const int ch = F.tid & 15;
#pragma unroll
    for (int it = 0; it < 2; ++it) { const int row = (F.tid >> 4) + 32 * it;
        const u32x4 w = *(const u32x4*)(projb + (size_t)(c * 64 + row) * PS + colbase + ch * 8);
        *(LAS u32x4*)(img + row * 256 + ((ch ^ swz16(row)) << 4)) = w; }
}
DI bf16x8 tr_frag_nat(const LAS unsigned char* img, int rowbase, int col0, int lane) {
    const int hh = lane >> 5, g16 = (lane >> 4) & 1, i = lane & 15;
    const int col = col0 + 16 * g16 + 4 * (i & 3), chunk = col >> 3, sub = (col & 7) * 2;
    const int r0 = rowbase + 8 * hh + (i >> 2), r1 = r0 + 4;
    const s16x4 lo = trread(img + r0 * 256 + ((chunk ^ swz16(r0)) << 4) + sub);
    const s16x4 hi = trread(img + r1 * 256 + ((chunk ^ swz16(r1)) << 4) + sub);
    return __builtin_shufflevector(lo, hi, 0, 1, 2, 3, 4, 5, 6, 7);
}
DI bf16x8 tr_frag_acc(const LAS unsigned char* img, int rowbase, int col0, int lane) {
    const int hh = lane >> 5, g16 = (lane >> 4) & 1, i = lane & 15;
    const int col = col0 + 16 * g16 + 4 * (i & 3), chunk = col >> 3, sub = (col & 7) * 2;
    const int r0 = rowbase + 4 * hh + (i >> 2), r1 = r0 + 8;
    const s16x4 lo = trread(img + r0 * 256 + ((chunk ^ swz16(r0)) << 4) + sub);
    const s16x4 hi = trread(img + r1 * 256 + ((chunk ^ swz16(r1)) << 4) + sub);
    return __builtin_shufflevector(lo, hi, 0, 1, 2, 3, 4, 5, 6, 7);
}
DI bf16x8 row_frag(const LAS unsigned char* img, int row, int chunk) { return *(const LAS bf16x8*)(img + row * 256 + ((chunk ^ swz16(row)) << 4)); }

DI void m1_item(const Ctx& F, const Args& a, int item) {
    const int c = item & 63, h = (item >> 6) & 3, b = item >> 8;
    const bf16_t* projb = (const bf16_t*)(a.ws + WS_PROJ) + (size_t)b * SEQ * PS;
    const float* GT = (const float*)(a.ws + WS_GATES) + (size_t)(b * SEQ + c * 64) * 16;
    float* MSC = (float*)(a.ws + WS_MSC);
    LAS unsigned char* KWF = F.lds; LAS unsigned char* KWB = F.lds + 16384; LAS unsigned char* VT = F.lds + 32768;
    LAS float* wsc = (LAS float*)(F.lds + 49152);
    if (F.wave < 2) {
        const int dir = F.wave, s = F.lane;
        const float ig = GT[s * 16 + dir * 8 + h], fg = GT[s * 16 + dir * 8 + 4 + h];
        float av = logsigmoid_f(fg);
        if (dir == 0) {
#pragma unroll
            for (int o = 1; o < 64; o <<= 1) { const float t = __shfl_up(av, o); if (s >= o) av += t; }
        } else {
#pragma unroll
            for (int o = 1; o < 64; o <<= 1) { const float t = __shfl_down(av, o); if (s + o < 64) av += t; }
        }
        const float g = __shfl(av, dir == 0 ? 63 : 0);
        const float wl = g - av + ig, ml = wave_max(wl);
        wsc[dir * 64 + s] = __expf(wl - ml);
        if (s == 0) { const int chain = (b * 4 + h) * 2 + dir; MSC[chain * 64 + c] = g; MSC[4096 + chain * 64 + c] = ml; }
    }
    __syncthreads();
    load_conv_tile<false, true>(F, a, projb, c, C_KM + h * 128, 512 + h * 128, 0.08838834764831845f, KWF, wsc, KWF, wsc + 64, KWB);
    load_plain_tile(F, projb, c, C_VM + h * 128, VT);
    __syncthreads();
    {
        const int dir = F.wave >> 2, kt = F.wave & 3, hh = F.lane >> 5;
        const LAS unsigned char* KW = dir ? KWB : KWF;
        bf16x8 af[4];
#pragma unroll
        for (int ks = 0; ks < 4; ++ks) af[ks] = tr_frag_nat(KW, 16 * ks, 32 * kt, F.lane);
        bf16_t* CT = (bf16_t*)a.out + ((size_t)((b * 4 + h) * 2 + dir) * 64 + c) * 16384;
#pragma unroll
        for (int vt = 0; vt < 4; ++vt) {
            f32x16 acc;
#pragma unroll
            for (int i = 0; i < 16; ++i) acc[i] = 0.f;
#pragma unroll
            for (int ks = 0; ks < 4; ++ks) { const bf16x8 bfv = tr_frag_nat(VT, 16 * ks, 32 * vt, F.lane); acc = MFMA32(af[ks], bfv, acc); }
            const int vdim = 32 * vt + (F.lane & 31);
#pragma unroll
            for (int rg = 0; rg < 4; ++rg) { u32x2 w; w.x = pk2(acc[4 * rg], acc[4 * rg + 1]); w.y = pk2(acc[4 * rg + 2], acc[4 * rg + 3]);
                *(u32x2*)(CT + (size_t)vdim * 128 + 32 * kt + 8 * rg + 4 * hh) = w; }
        }
    }
    if (F.tid < 256) {
        const int dir = F.tid >> 7, kd = F.tid & 127; const LAS unsigned char* KW = dir ? KWB : KWF;
        float s = 0.f;
#pragma unroll 8
        for (int r = 0; r < 64; ++r) s += bf2f(*(const LAS bf16_t*)(KW + r * 256 + (((kd >> 3) ^ swz16(r)) << 4) + (kd & 7) * 2));
        ((float*)(a.ws + WS_NLOC))[((size_t)((b * 4 + h) * 2 + dir) * 64 + c) * 128 + kd] = s;
    }
    __syncthreads();
}

DI void scan_task(const Ctx& F, const Args& a, int task) {
    const int chain = task >> 3, slab = task & 7, dir = chain & 1;
    float* MSC = (float*)(a.ws + WS_MSC);
    LAS float* sp = (LAS float*)F.lds; LAS float* sl = sp + 64; LAS float* gl = sp + 128; LAS float* mll = sp + 192; LAS float* mpv = sp + 256;
    if (F.tid < 64) { gl[F.tid] = MSC[chain * 64 + F.tid]; mll[F.tid] = MSC[4096 + chain * 64 + F.tid]; }
    __syncthreads();
    if (F.tid == 0) {
        float m = 0.f;
        for (int st = 0; st < 64; ++st) { const int c = dir ? 63 - st : st; const float g = gl[c], ml = mll[c];
            mpv[c] = m;
            const float mn = fmaxf(g + m, ml); sp[c] = __expf(g + m - mn); sl[c] = __expf(ml - mn); m = mn; }
    }
    __syncthreads();
    if (slab == 0 && F.tid < 64) MSC[8192 + chain * 64 + F.tid] = mpv[F.tid];
    bf16_t* base = (bf16_t*)a.out + (size_t)chain * 64 * 16384 + slab * 2048 + F.tid * 4;
    float s0 = 0.f, s1 = 0.f, s2 = 0.f, s3 = 0.f;
    for (int st0 = 0; st0 < 64; st0 += 8) {
        u32x2 v[8];
#pragma unroll
        for (int j = 0; j < 8; ++j) { const int c = dir ? 63 - (st0 + j) : st0 + j; v[j] = *(const u32x2*)(base + (size_t)c * 16384); }
#pragma unroll
        for (int j = 0; j < 8; ++j) { const int c = dir ? 63 - (st0 + j) : st0 + j;
            u32x2 o; o.x = pk2(s0, s1); o.y = pk2(s2, s3); *(u32x2*)(base + (size_t)c * 16384) = o;
            const float p = sp[c], l = sl[c];
            s0 = p * s0 + l * bflo(v[j].x); s1 = p * s1 + l * bfhi(v[j].x); s2 = p * s2 + l * bflo(v[j].y); s3 = p * s3 + l * bfhi(v[j].y); }
    }
    if (slab == 0 && F.tid < 128) {
        float* nb = (float*)(a.ws + WS_NLOC) + (size_t)chain * 64 * 128 + F.tid; float n = 0.f;
        for (int st0 = 0; st0 < 64; st0 += 16) {
            float v[16];
#pragma unroll
            for (int j = 0; j < 16; ++j) { const int c = dir ? 63 - (st0 + j) : st0 + j; v[j] = nb[c * 128]; }
#pragma unroll
            for (int j = 0; j < 16; ++j) { const int c = dir ? 63 - (st0 + j) : st0 + j; nb[c * 128] = n; n = sp[c] * n + sl[c] * v[j]; }
        }
    }
    __syncthreads();
}

DI void glds16(const void* g, LAS unsigned char* l) { __builtin_amdgcn_global_load_lds((const unsigned*)g, (LAS unsigned*)l, 16, 0, 0); }
DI void glds16_asm(const void* gsrc, unsigned lds_dst) { unsigned keep;
    asm volatile("s_mov_b32 %0, m0\n\ts_mov_b32 m0, %2\n\ts_nop 0\n\tglobal_load_lds_dwordx4 %1, off\n\ts_mov_b32 m0, %0" : "=&s"(keep) : "v"(gsrc), "s"(lds_dst) : "memory"); }
DI void attn_unit(const Ctx& F, const Args& a, int b, int h, int qb, float lam, float cshift) {
    const int lane = F.lane, wid = F.wave, r32 = lane & 31, hh = lane >> 5, rg = wid & 3, p = wid >> 2;
    const bf16_t* projb = (const bf16_t*)(a.ws + WS_PROJ) + (size_t)b * SEQ * PS;
    const int qrow = qb * 128 + rg * 32 + r32;
    bf16x8 qf[4];
    { const bf16_t* qp = projb + (size_t)qrow * PS + C_QA + h * 128 + p * 64 + hh * 8;
#pragma unroll
      for (int ks = 0; ks < 4; ++ks) qf[ks] = *(const bf16x8*)(qp + ks * 16); }
    const bf16_t* kimg = (const bf16_t*)(a.ws + WS_KIMG) + (size_t)(b * 4 + h) * 64 * 8192 + (2 * wid) * 512 + lane * 8;
    const bf16_t* vimg = (const bf16_t*)(a.ws + WS_VIMG) + (size_t)(b * 4 + h) * 64 * 8192 + (2 * wid) * 512 + lane * 8;
    const unsigned ldsw = (unsigned)__builtin_amdgcn_readfirstlane((int)(unsigned)(uintptr_t)F.lds + (2 * wid) * 1024);
#define ATT_ISSUE_K(t, s) do { const bf16_t* _tp = kimg + (size_t)(t) * 8192; const unsigned _d = (unsigned)__builtin_amdgcn_readfirstlane((int)(ldsw + (s) * 16384)); \
        glds16_asm(_tp, _d); glds16_asm(_tp + 512, _d + 1024); } while (0)
#define ATT_ISSUE_V(t, s) do { const bf16_t* _tp = vimg + (size_t)(t) * 8192; const unsigned _d = (unsigned)__builtin_amdgcn_readfirstlane((int)(ldsw + 32768 + (s) * 16384)); \
        glds16_asm(_tp, _d); glds16_asm(_tp + 512, _d + 1024); } while (0)
    ATT_ISSUE_K(0, 0); ATT_ISSUE_V(0, 0); ATT_ISSUE_K(1, 1);
    f32x16 O[4];
#pragma unroll
    for (int vt = 0; vt < 4; ++vt)
#pragma unroll
        for (int i = 0; i < 16; ++i) O[vt][i] = 0.f;
    float lsum = 0.f;
    const int kfb = p * 8192 + hh * 1024 + r32 * 16;
    const int vfb = 32768 + (4 * hh + ((lane & 15) >> 2)) * 64 + ((lane >> 4) & 1) * 32 + (lane & 3) * 8;
    bf16x8 pb[4];
    asm volatile("s_waitcnt vmcnt(0)" ::: "memory");
    __syncthreads();
#define ATT_QK(Sa, Sb, kb) do { _Pragma("unroll") for (int i = 0; i < 16; ++i) { Sa[i] = -cshift; Sb[i] = -cshift; } \
        _Pragma("unroll") for (int ks = 0; ks < 4; ++ks) { Sa = MFMA32(*(const LAS bf16x8*)((kb) + ks * 2048), qf[ks], Sa); Sb = MFMA32(*(const LAS bf16x8*)((kb) + ks * 2048 + 512), qf[ks], Sb); } } while (0)
#define ATT_EXP(Sa, Sb, on) do { float _ls = 0.f; _Pragma("unroll") for (int i = 0; i < 16; ++i) { Sa[i] = __builtin_amdgcn_exp2f(Sa[i]); Sb[i] = __builtin_amdgcn_exp2f(Sb[i]); _ls += Sa[i] + Sb[i]; } lsum += (on) ? _ls : 0.f; \
        ATT_PACK(pb[0], Sa, 0); ATT_PACK(pb[1], Sa, 8); ATT_PACK(pb[2], Sb, 0); ATT_PACK(pb[3], Sb, 8); } while (0)
#define ATT_PACK(dst, S, o) do { u32x4 _w; _w.x = pk2(S[o], S[o + 1]); _w.y = pk2(S[o + 2], S[o + 3]); _w.z = pk2(S[o + 4], S[o + 5]); _w.w = pk2(S[o + 6], S[o + 7]); dst = __builtin_bit_cast(bf16x8, _w); } while (0)
    f32x16 Sa, Sb;
    ATT_QK(Sa, Sb, F.lds + kfb);
    if (p == 0) ATT_EXP(Sa, Sb, true);
    __syncthreads();
#pragma unroll 1
    for (int t = 0; t < 64; ++t) {
        const int s = t & 1;
        ATT_ISSUE_K(t + 2 < 64 ? t + 2 : 63, s);
        ATT_ISSUE_V(t + 1 < 64 ? t + 1 : 63, s ^ 1);
        if (p == 1) ATT_EXP(Sa, Sb, true);
        __builtin_amdgcn_sched_barrier(0);
        ATT_QK(Sa, Sb, F.lds + (s ^ 1) * 16384 + kfb);
        const LAS unsigned char* Vb = F.lds + s * 16384 + vfb;
#pragma unroll
        for (int kg = 0; kg < 4; ++kg)
#pragma unroll
            for (int vt = 0; vt < 4; ++vt) {
                const s16x4 lo = trread(Vb + vt * 4096 + kg * 1024), hi = trread(Vb + vt * 4096 + kg * 1024 + 512);
                O[vt] = MFMA32(__builtin_shufflevector(lo, hi, 0, 1, 2, 3, 4, 5, 6, 7), pb[kg], O[vt]); }
        __builtin_amdgcn_sched_barrier(0);
        if (p == 0) ATT_EXP(Sa, Sb, t + 1 < 64);
        asm volatile("s_waitcnt vmcnt(0)" ::: "memory");
        __syncthreads();
    }
#undef ATT_ISSUE_K
#undef ATT_ISSUE_V
#undef ATT_QK
#undef ATT_EXP
#undef ATT_PACK
    lsum += __shfl_xor(lsum, 32);
    LAS float* X = (LAS float*)(F.lds + 65536) + rg * 4096 + r32;
    if (p == 1) {
        const float sc = lam / lsum;
#pragma unroll
        for (int vt = 0; vt < 4; ++vt)
#pragma unroll
            for (int i = 0; i < 16; ++i) X[(32 * vt + crow(i, hh)) * 32] = O[vt][i] * sc;
    }
    __syncthreads();
    if (p == 0) {
        const float i0 = 1.f / lsum;
        float ssq = 0.f;
#pragma unroll
        for (int vt = 0; vt < 4; ++vt)
#pragma unroll
            for (int i = 0; i < 16; ++i) { const float o = O[vt][i] * i0 - X[(32 * vt + crow(i, hh)) * 32]; O[vt][i] = o; ssq += o * o; }
        ssq += __shfl_xor(ssq, 32);
        const float rs = rsqrtf(ssq * (1.f / 128.f) + EPS) * 0.8f;
        bf16_t* yp = (bf16_t*)(a.ws + WS_YA) + (size_t)(b * SEQ + qrow) * 512 + h * 128;
#pragma unroll
        for (int vt = 0; vt < 4; ++vt)
#pragma unroll
            for (int rgi = 0; rgi < 4; ++rgi) { const int vd = 32 * vt + 8 * rgi + 4 * hh; const f32x4 g = *(const f32x4*)(a.subln_g + vd);
                u32x2 w; w.x = pk2(O[vt][4 * rgi] * rs * g.x, O[vt][4 * rgi + 1] * rs * g.y); w.y = pk2(O[vt][4 * rgi + 2] * rs * g.z, O[vt][4 * rgi + 3] * rs * g.w);
                *(u32x2*)(yp + vd) = w; }
    }
    __syncthreads();
}

DI void m3_item(const Ctx& F, const Args& a, int item) {
    const int c = item & 63, h = (item >> 6) & 3, b = item >> 8;
    const int lane = F.lane, hh = lane >> 5, r32 = lane & 31;
    const bf16_t* projb = (const bf16_t*)(a.ws + WS_PROJ) + (size_t)b * SEQ * PS;
    const float* GT = (const float*)(a.ws + WS_GATES) + (size_t)(b * SEQ + c * 64) * 16;
    const float* MSC = (const float*)(a.ws + WS_MSC);
    LAS unsigned char* QT = F.lds; LAS unsigned char* KT = F.lds + 16384; LAS unsigned char* VT = F.lds + 32768;
    LAS unsigned char* SF = F.lds + 49152;
    LAS float* HT = (LAS float*)(F.lds + 65536);
    LAS float* scal = (LAS float*)(F.lds + 65536 + 33024);
    LAS float* rt = scal; LAS float* ct = scal + 128; LAS float* iw = scal + 256; LAS float* enm = scal + 384; LAS float* rden = scal + 512; LAS float* npv = scal + 640;
    const int chain0 = (b * 4 + h) * 2;
    if (F.wave < 2) {
        const int dir = F.wave, s = lane;
        const float ig = GT[s * 16 + dir * 8 + h], fg = GT[s * 16 + dir * 8 + 4 + h];
        float av = logsigmoid_f(fg);
        if (dir == 0) {
#pragma unroll
            for (int o = 1; o < 64; o <<= 1) { const float t = __shfl_up(av, o); if (s >= o) av += t; }
        } else {
#pragma unroll
            for (int o = 1; o < 64; o <<= 1) { const float t = __shfl_down(av, o); if (s + o < 64) av += t; }
        }
        const float cterm = ig - av;
        float cm = cterm;
        if (dir == 0) {
#pragma unroll
            for (int o = 1; o < 64; o <<= 1) { const float t = __shfl_up(cm, o); if (s >= o) cm = fmaxf(cm, t); }
        } else {
#pragma unroll
            for (int o = 1; o < 64; o <<= 1) { const float t = __shfl_down(cm, o); if (s + o < 64) cm = fmaxf(cm, t); }
        }
        const float mprev = MSC[8192 + (chain0 + dir) * 64 + c];
        const float il = av + mprev, mj = fmaxf(il, av + cm);
        rt[dir * 64 + s] = av - mj; ct[dir * 64 + s] = cterm; iw[dir * 64 + s] = __expf(il - mj); enm[dir * 64 + s] = __expf(-mj);
    } else if (F.wave < 6) {
        const int i = F.tid - 128; npv[i] = ((const float*)(a.ws + WS_NLOC))[((size_t)(chain0 + (i >> 7)) * 64 + c) * 128 + (i & 127)];
    }
    load_conv_tile<true, false>(F, a, projb, c, C_QM + h * 128, h * 128, 1.f, QT, rt, QT, rt, QT);
    load_conv_tile<true, false>(F, a, projb, c, C_KM + h * 128, 512 + h * 128, 0.08838834764831845f, KT, rt, KT, rt, KT);
    load_plain_tile(F, projb, c, C_VM + h * 128, VT);
    __syncthreads();
    {
        const int dir = F.wave >> 2, jt = (F.wave >> 1) & 1, st = F.wave & 1;
        f32x16 S;
#pragma unroll
        for (int i = 0; i < 16; ++i) S[i] = 0.f;
#pragma unroll
        for (int ks = 0; ks < 8; ++ks) S = MFMA32(row_frag(QT, 32 * jt + r32, 2 * ks + hh), row_frag(KT, 32 * st + r32, 2 * ks + hh), S);
        const int sc = 32 * st + r32; const float cts = ct[dir * 64 + sc];
        LAS unsigned char* SD = SF + dir * 8192;
#pragma unroll
        for (int i = 0; i < 16; ++i) { const int j = 32 * jt + crow(i, hh);
            const bool ok = dir == 0 ? (sc <= j) : (sc >= j);
            const float v = ok ? S[i] * __expf(rt[dir * 64 + j] + cts) : 0.f;
            *(LAS bf16_t*)(SD + j * 128 + (((sc >> 3) ^ (j & 7)) << 4) + (sc & 7) * 2) = (bf16_t)(pk2(v, 0.f) & 0xffffu); }
    }
    __syncthreads();
    if (F.tid < 128) {
        const int dir = F.tid >> 6, j = F.tid & 63; const LAS unsigned char* SD = SF + dir * 8192;
        float rsum = 0.f;
#pragma unroll
        for (int ch = 0; ch < 8; ++ch) { const u32x4 w = *(const LAS u32x4*)(SD + j * 128 + ((ch ^ (j & 7)) << 4));
            rsum += (bflo(w.x) + bfhi(w.x)) + (bflo(w.y) + bfhi(w.y)) + (bflo(w.z) + bfhi(w.z)) + (bflo(w.w) + bfhi(w.w)); }
        float qn = 0.f;
#pragma unroll
        for (int ch = 0; ch < 16; ++ch) { const u32x4 w = *(const LAS u32x4*)(QT + j * 256 + ((ch ^ swz16(j)) << 4)); const LAS float* np = npv + dir * 128 + ch * 8;
            qn += bflo(w.x) * np[0] + bfhi(w.x) * np[1] + bflo(w.y) * np[2] + bfhi(w.y) * np[3] + bflo(w.z) * np[4] + bfhi(w.z) * np[5] + bflo(w.w) * np[6] + bfhi(w.w) * np[7]; }
        const float den = rsum + iw[dir * 64 + j] * qn;
        rden[dir * 64 + j] = 1.f / fmaxf(fabsf(den), enm[dir * 64 + j]);
    }
    f32x16 accd[2];
    {
        const int jt = F.wave >> 2, vt = F.wave & 3;
#pragma unroll
        for (int dir = 0; dir < 2; ++dir) {
            f32x16 acc;
#pragma unroll
            for (int i = 0; i < 16; ++i) acc[i] = 0.f;
            const bf16_t* CT = (const bf16_t*)a.out + ((size_t)(chain0 + dir) * 64 + c) * 16384 + (size_t)(32 * vt + r32) * 128 + 8 * hh;
#pragma unroll
            for (int ks = 0; ks < 8; ++ks) acc = MFMA32(row_frag(QT, 32 * jt + r32, 2 * ks + hh), *(const bf16x8*)(CT + 16 * ks), acc);
#pragma unroll
            for (int i = 0; i < 16; ++i) acc[i] *= iw[dir * 64 + 32 * jt + crow(i, hh)];
            const LAS unsigned char* SD = SF + dir * 8192;
#pragma unroll
            for (int ks = 0; ks < 4; ++ks) { const int j = 32 * jt + r32;
                const bf16x8 af = *(const LAS bf16x8*)(SD + j * 128 + (((2 * ks + hh) ^ (j & 7)) << 4));
                acc = MFMA32(af, tr_frag_nat(VT, 16 * ks, 32 * vt, lane), acc); }
            accd[dir] = acc;
        }
    }
    __syncthreads();
    {
        const int jt = F.wave >> 2, vt = F.wave & 3;
#pragma unroll
        for (int i = 0; i < 16; ++i) { const int j = 32 * jt + crow(i, hh);
            HT[j * 129 + 32 * vt + r32] = accd[0][i] * rden[j] + accd[1][i] * rden[64 + j]; }
    }
    __syncthreads();
    {
        const int j = F.tid >> 3, q = F.tid & 7;
        float v[16]; float s = 0.f;
#pragma unroll
        for (int i = 0; i < 16; ++i) { v[i] = HT[j * 129 + q * 16 + i]; s += v[i] * v[i]; }
        s += __shfl_xor(s, 1); s += __shfl_xor(s, 2); s += __shfl_xor(s, 4);
        const float rstd = rsqrtf(s * (1.f / 128.f) + EPS);
        const size_t tok = (size_t)b * SEQ + c * 64 + j;
        const u32x4* omp = (const u32x4*)((const bf16_t*)(a.ws + WS_PROJ) + tok * PS + C_OM + h * 128 + q * 16);
        const u32x4 o0 = omp[0], o1 = omp[1];
        float om[16];
        om[0] = bflo(o0.x); om[1] = bfhi(o0.x); om[2] = bflo(o0.y); om[3] = bfhi(o0.y); om[4] = bflo(o0.z); om[5] = bfhi(o0.z); om[6] = bflo(o0.w); om[7] = bfhi(o0.w);
        om[8] = bflo(o1.x); om[9] = bfhi(o1.x); om[10] = bflo(o1.y); om[11] = bfhi(o1.y); om[12] = bflo(o1.z); om[13] = bfhi(o1.z); om[14] = bflo(o1.w); om[15] = bfhi(o1.w);
        float y[16];
#pragma unroll
        for (int i = 0; i < 16; ++i) y[i] = v[i] * rstd * a.mnorm_g[h * 128 + q * 16 + i] * sigmoid_f(om[i]);
        u32x4 w0, w1;
        w0.x = pk2(y[0], y[1]); w0.y = pk2(y[2], y[3]); w0.z = pk2(y[4], y[5]); w0.w = pk2(y[6], y[7]);
        w1.x = pk2(y[8], y[9]); w1.y = pk2(y[10], y[11]); w1.z = pk2(y[12], y[13]); w1.w = pk2(y[14], y[15]);
        u32x4* yp = (u32x4*)((bf16_t*)(a.ws + WS_YMIX) + tok * DM + h * 128 + q * 16);
        yp[0] = w0; yp[1] = w1;
        const u32x4* yap = (const u32x4*)((const bf16_t*)(a.ws + WS_YA) + tok * 512 + h * 128 + q * 16);
        const u32x4 ya0 = yap[0], ya1 = yap[1];
        yp[64] = ya0; yp[65] = ya1;
    }
    __syncthreads();
}

DI void p7_phase(const Ctx& F, const Args& a) {
    LAS f32x4* WRL = (LAS f32x4*)F.lds;
    for (int q = F.tid; q < 4096; q += NTHR) { const int k = q >> 2, g = q & 3; WRL[(g * 2 + (k & 1)) * 512 + (k >> 1)] = *(const f32x4*)(a.w_router + k * 16 + g * 4); }
    __syncthreads();
    const int gw = F.bid * NWAVES + F.wave, NGW = F.G * NWAVES, lane = F.lane;
    const float* mod = (const float*)(a.ws + WS_MOD);
    unsigned char* H2 = a.ws + WS_H2; float* AFF = (float*)(a.ws + WS_AFF);
    for (int m = gw; m < MTOK; m += NGW) {
        const int b = m / SEQ;
        const f32x2* xr = (const f32x2*)(a.out + (size_t)m * DM) + lane;
        f32x2 v[8]; float s = 0.f;
#pragma unroll
        for (int j = 0; j < 8; ++j) { v[j] = xr[64 * j]; s += v[j].x * v[j].x + v[j].y * v[j].y; }
        const float rstd = rsqrtf(wave_sum(s) * (1.f / DM) + EPS);
        float lg[16];
#pragma unroll
        for (int e = 0; e < 16; ++e) lg[e] = 0.f;
        unsigned short* o2 = (unsigned short*)(H2 + (size_t)m * DM) + lane;
#pragma unroll
        for (int j = 0; j < 8; ++j) {
            const f32x2 g = ((const f32x2*)a.norm2_g)[lane + 64 * j];
            const f32x2 sh = ((const f32x2*)(mod + (size_t)b * 6144 + 3072))[lane + 64 * j];
            const f32x2 sc = ((const f32x2*)(mod + (size_t)b * 6144 + 4096))[lane + 64 * j];
            const f32x2 hv = v[j] * rstd * g * (sc + 1.f) + sh;
            o2[64 * j] = (unsigned short)__builtin_amdgcn_cvt_pk_fp8_f32(hv.x, hv.y, 0, false);
#pragma unroll
            for (int g4 = 0; g4 < 4; ++g4) { const f32x4 w0 = WRL[(g4 * 2 + 0) * 512 + lane + 64 * j], w1 = WRL[(g4 * 2 + 1) * 512 + lane + 64 * j];
                lg[g4 * 4 + 0] += hv.x * w0.x + hv.y * w1.x; lg[g4 * 4 + 1] += hv.x * w0.y + hv.y * w1.y; lg[g4 * 4 + 2] += hv.x * w0.z + hv.y * w1.z; lg[g4 * 4 + 3] += hv.x * w0.w + hv.y * w1.w; }
            __builtin_amdgcn_sched_barrier(0);
        }
        float r8[8];
#pragma unroll
        for (int i = 0; i < 8; ++i) { const float keep = hh_sel(lane, 32) ? lg[8 + i] : lg[i], send = hh_sel(lane, 32) ? lg[i] : lg[8 + i]; r8[i] = keep + __shfl_xor(send, 32); }
        float r4[4];
#pragma unroll
        for (int i = 0; i < 4; ++i) { const float keep = hh_sel(lane, 16) ? r8[4 + i] : r8[i], send = hh_sel(lane, 16) ? r8[i] : r8[4 + i]; r4[i] = keep + __shfl_xor(send, 16); }
        float r2[2];
#pragma unroll
        for (int i = 0; i < 2; ++i) { const float keep = hh_sel(lane, 8) ? r4[2 + i] : r4[i], send = hh_sel(lane, 8) ? r4[i] : r4[2 + i]; r2[i] = keep + __shfl_xor(send, 8); }
        float lgt; { const float keep = hh_sel(lane, 4) ? r2[1] : r2[0], send = hh_sel(lane, 4) ? r2[0] : r2[1]; lgt = keep + __shfl_xor(send, 4); }
        lgt += __shfl_xor(lgt, 2); lgt += __shfl_xor(lgt, 1);
        float mx = lgt;
#pragma unroll
        for (int o = 4; o < 64; o <<= 1) mx = fmaxf(mx, __shfl_xor(mx, o));
        const float ex = __expf(lgt - mx); float sm = ex;
#pragma unroll
        for (int o = 4; o < 64; o <<= 1) sm += __shfl_xor(sm, o);
        if ((lane & 3) == 0) AFF[(size_t)m * 16 + (lane >> 2)] = ex / sm;
    }
    __syncthreads();
}

DI void topk_task(const Ctx& F, const Args& a, int task) {
    const int b = task >> 4, e = task & 15, tid = F.tid, lane = F.lane;
    const float* AFF = (const float*)(a.ws + WS_AFF) + (size_t)b * SEQ * 16 + e;
    LAS unsigned* hist = (LAS unsigned*)F.lds;
    LAS unsigned* sfx = hist + 256;
    LAS unsigned* misc = hist + 512;
    LAS int* lidx = (LAS int*)(F.lds + 4096);
    unsigned key[8];
#pragma unroll
    for (int i = 0; i < 8; ++i) key[i] = __float_as_uint(AFF[(size_t)(tid * 8 + i) * 16]);
    unsigned prefix = 0, krem = CAP;
#pragma unroll 1
    for (int pass = 0; pass < 4; ++pass) {
        const int shift = 24 - 8 * pass;
        if (tid < 256) hist[tid] = 0;
        __syncthreads();
#pragma unroll
        for (int i = 0; i < 8; ++i) { const bool in = pass == 0 ? true : ((key[i] >> (shift + 8)) == (prefix >> (shift + 8))); if (in) atomicAdd((unsigned*)&hist[(key[i] >> shift) & 255u], 1u); }
        __syncthreads();
        if (tid < 256) sfx[tid] = hist[tid];
        __syncthreads();
#pragma unroll 1
        for (int o = 1; o < 256; o <<= 1) { unsigned v = 0; if (tid < 256) v = sfx[tid] + (tid + o < 256 ? sfx[tid + o] : 0u); __syncthreads(); if (tid < 256) sfx[tid] = v; __syncthreads(); }
        if (tid < 256) { const unsigned incl = sfx[tid], excl = incl - hist[tid]; if (excl < krem && krem <= incl) { misc[0] = (unsigned)tid; misc[1] = krem - excl; } }
        __syncthreads();
        prefix |= misc[0] << shift; krem = misc[1];
        __syncthreads();
    }
    const unsigned T = prefix, need = krem;
    unsigned cg_ = 0, ce = 0;
#pragma unroll
    for (int i = 0; i < 8; ++i) { cg_ += key[i] > T; ce += key[i] == T; }
    unsigned sg = cg_, se = ce;
#pragma unroll
    for (int o = 1; o < 64; o <<= 1) { const unsigned tg = __shfl_up(sg, o), te = __shfl_up(se, o); if (lane >= o) { sg += tg; se += te; } }
    if (lane == 63) { misc[16 + F.wave] = sg; misc[32 + F.wave] = se; }
    __syncthreads();
    unsigned og = sg - cg_, oe = se - ce;
    for (int w = 0; w < F.wave; ++w) { og += misc[16 + w]; oe += misc[32 + w]; }
    int* SLOT = (int*)(a.ws + WS_SLOT) + (size_t)b * SEQ * 16 + e;
    float* VALS = (float*)(a.ws + WS_VALS) + (size_t)(e * 8 + b) * CAP;
    int* IDX = (int*)(a.ws + WS_IDX) + (size_t)(b * 16 + e) * CAP;
#pragma unroll
    for (int i = 0; i < 8; ++i) {
        const bool gt = key[i] > T, eq = key[i] == T; const bool sel = gt || (eq && oe < need);
        const unsigned pos = og + (oe < need ? oe : need);
        const int s = tid * 8 + i;
        SLOT[(size_t)s * 16] = sel ? (int)pos : -1;
        if (sel) { lidx[pos] = s; IDX[pos] = s; VALS[pos] = __uint_as_float(key[i]); }
        og += gt; oe += eq;
    }
    __syncthreads();
    const unsigned char* H2 = a.ws + WS_H2 + (size_t)b * SEQ * DM; unsigned char* XE = a.ws + WS_XE + (size_t)(e * 8 + b) * CAP * DM;
    for (int r0 = F.wave * 4; r0 < CAP; r0 += NWAVES * 4) { u32x4 v[4];
#pragma unroll
        for (int j = 0; j < 4; ++j) v[j] = ((const u32x4*)(H2 + (size_t)lidx[r0 + j] * DM))[lane];
#pragma unroll
        for (int j = 0; j < 4; ++j) ((u32x4*)(XE + (size_t)(r0 + j) * DM))[lane] = v[j]; }
    __syncthreads();
}

DI void final_phase(const Ctx& F, const Args& a) {
    const int gw = F.bid * NWAVES + F.wave, NGW = F.G * NWAVES, lane = F.lane;
    const float* mod = (const float*)(a.ws + WS_MOD); const int* SLOT = (const int*)(a.ws + WS_SLOT); const bf16_t* Y = (const bf16_t*)(a.ws + WS_Y);
    for (int m = gw; m < MTOK; m += NGW) {
        const int b = m / SEQ;
        const int sl = SLOT[(size_t)m * 16 + (lane & 15)];
        float acc[16];
#pragma unroll
        for (int i = 0; i < 16; ++i) acc[i] = 0.f;
#pragma unroll 1
        for (int e = 0; e < 16; ++e) { const int s = __shfl(sl, e);
            if (s >= 0) { const u32x4* yp = (const u32x4*)(Y + ((size_t)(e * 8 + b) * CAP + s) * DM + lane * 16); const u32x4 w0 = yp[0], w1 = yp[1];
                acc[0] += bflo(w0.x); acc[1] += bfhi(w0.x); acc[2] += bflo(w0.y); acc[3] += bfhi(w0.y); acc[4] += bflo(w0.z); acc[5] += bfhi(w0.z); acc[6] += bflo(w0.w); acc[7] += bfhi(w0.w);
                acc[8] += bflo(w1.x); acc[9] += bfhi(w1.x); acc[10] += bflo(w1.y); acc[11] += bfhi(w1.y); acc[12] += bflo(w1.z); acc[13] += bfhi(w1.z); acc[14] += bflo(w1.w); acc[15] += bfhi(w1.w); } }
        f32x4* op = (f32x4*)(a.out + (size_t)m * DM + lane * 16); const f32x4* gp = (const f32x4*)(mod + (size_t)b * 6144 + 5120 + lane * 16);
#pragma unroll
        for (int q = 0; q < 4; ++q) { const f32x4 g = gp[q]; f32x4 o = op[q]; o.x += g.x * acc[4 * q]; o.y += g.y * acc[4 * q + 1]; o.z += g.z * acc[4 * q + 2]; o.w += g.w * acc[4 * q + 3]; op[q] = o; }
    }
}

constexpr size_t WS_CTL = 0;
constexpr int CTL_ZERO_BYTES = 65536;
#define XB_TMO      128
#define XB_XCNT(j)  (256  + 64 * (j))
#define XB_XSUB(j)  (1280 + 64 * (j))
#define XB_XGEN(j)  (2304 + 64 * (j))
#define XB_TOP      3328
#define XB_TOPGEN   3392
#define XB_SPIN_CAP (1u << 18)
DI unsigned xb_ld(unsigned* p)              { return __hip_atomic_load(p, __ATOMIC_RELAXED, __HIP_MEMORY_SCOPE_AGENT); }
DI unsigned xb_add(unsigned* p, unsigned v) { return __hip_atomic_fetch_add(p, v, __ATOMIC_RELAXED, __HIP_MEMORY_SCOPE_AGENT); }
DI unsigned xb_xcc_id() { return (unsigned)__builtin_amdgcn_s_getreg((3 << 11) | 20) & 0xFu; }
#define XB_SPIN(cond, bar) do { unsigned _sp = 0; while (cond) { __builtin_amdgcn_s_sleep(1); \
    if ((++_sp & 255u) == 0u) { if (xb_ld(&(bar)[XB_TMO])) break; if (_sp > XB_SPIN_CAP) { atomicAdd(&(bar)[XB_TMO], 1u); break; } } } } while (0)
struct XcdBarrier { unsigned* bar; unsigned x; volatile LAS unsigned* st; };
DI XcdBarrier xcd_barrier_post(unsigned* bar, volatile LAS unsigned* st) {
    XcdBarrier b; b.bar = bar; b.x = xb_xcc_id(); b.st = st;
    if (threadIdx.x == 0) (void)xb_add(&bar[XB_XCNT(b.x)], 1u);
    return b;
}
DI void xcd_barrier_complete(unsigned* bar, unsigned x, unsigned& nloc, unsigned& nx) {
    const unsigned G = gridDim.x * gridDim.y * gridDim.z;
    unsigned sum, cnt, mine, sp = 0u;
    for (;;) {
        sum = 0u; cnt = 0u; mine = 0u;
#pragma unroll
        for (unsigned j = 0; j < 16; ++j) { const unsigned c = xb_ld(&bar[XB_XCNT(j)]); sum += c; cnt += (c > 0u) ? 1u : 0u; mine = (j == x) ? c : mine; }
        if (sum == G) break;
        __builtin_amdgcn_s_sleep(1);
        if ((++sp & 255u) == 0u) { if (xb_ld(&bar[XB_TMO])) break; if (sp > XB_SPIN_CAP) { atomicAdd(&bar[XB_TMO], 1u); break; } }
    }
    nloc = mine > 0u ? mine : 1u; nx = cnt > 0u ? cnt : 1u;
}
DI void xcd_barrier(const XcdBarrier& b) {
    asm volatile("s_waitcnt vmcnt(0)" ::: "memory");
    __syncthreads();
    if (threadIdx.x == 0) {
        unsigned* bar = b.bar;
        __builtin_amdgcn_s_waitcnt(0);
        unsigned nloc = b.st[0], nx = b.st[1];
        if (nloc == 0u) { xcd_barrier_complete(bar, b.x, nloc, nx); b.st[0] = nloc; b.st[1] = nx; }
        const unsigned old = xb_add(&bar[XB_XSUB(b.x)], 1u);
        const unsigned gen = old / nloc;
        if (old + 1u == (gen + 1u) * nloc) {
            __builtin_amdgcn_fence(__ATOMIC_RELEASE, "agent");
            asm volatile("s_waitcnt vmcnt(0)" ::: "memory");
            const unsigned og = xb_add(&bar[XB_TOP], 1u);
            const unsigned tg = og / nx;
            if (og + 1u == (tg + 1u) * nx) xb_add(&bar[XB_TOPGEN], 1u);
            else XB_SPIN(xb_ld(&bar[XB_TOPGEN]) == tg, bar);
            __builtin_amdgcn_fence(__ATOMIC_ACQUIRE, "agent");
            xb_add(&bar[XB_XGEN(b.x)], 1u);
            asm volatile("s_waitcnt vmcnt(0)" ::: "memory");
        } else {
            XB_SPIN(xb_ld(&bar[XB_XGEN(b.x)]) == gen, bar);
            __builtin_amdgcn_fence(__ATOMIC_ACQUIRE, "agent");
            asm volatile("s_waitcnt vmcnt(0)" ::: "memory");
        }
    }
    __syncthreads();
}

static_assert(sizeof(Args) == 22 * 8, "Args layout");
__global__ void __launch_bounds__(NTHR, 2) fwd_kernel(Args a_unused) {
    extern __shared__ __attribute__((aligned(16))) unsigned char lds_raw[];
    cg::grid_group grid = cg::this_grid();
    Ctx F; F.lds = (LAS unsigned char*)lds_raw; F.tid = threadIdx.x; F.lane = F.tid & 63; F.wave = __builtin_amdgcn_readfirstlane(F.tid >> 6); F.G = gridDim.x; F.bid = blockIdx.x;

    int lo, hi; { typedef __attribute__((address_space(4))) const volatile unsigned long long* kp_t; const unsigned long long ph = ((kp_t)__builtin_amdgcn_kernarg_segment_ptr())[21]; lo = (int)(unsigned)ph; hi = (int)(unsigned)(ph >> 32); }
#ifndef PHASE_MASK
#define PHASE_MASK 0xffff
#endif
#define IN(k) (((PHASE_MASK >> (k)) & 1) && lo <= (k) && (k) < hi)
    volatile LAS unsigned* bst = (volatile LAS unsigned*)(F.lds + LDS_BYTES - 64);
    if (F.tid < 2) bst[F.tid] = 0u;
    __syncthreads();
    XcdBarrier xbar;
    { const Args a0 = load_args(); xbar = xcd_barrier_post((unsigned*)(a0.ws + WS_CTL), bst); }
    volatile LAS unsigned long long* tsl = (volatile LAS unsigned long long*)(F.lds + LDS_BYTES - 256);
    if (PROBE_PHASE >= 0 && F.bid == 0 && F.tid == 0) tsl[0] = __builtin_amdgcn_s_memrealtime();
#define SEAM(k) do { if (IN(k) && IN((k) + 1)) { if ((k) == 0) grid.sync(); else xcd_barrier(xbar); } \
        if (PROBE_PHASE >= 0 && F.bid == 0 && F.tid == 0) tsl[(k) + 1] = __builtin_amdgcn_s_memrealtime(); } while (0)
    if (IN(0)) { const Args a = load_args();
#pragma unroll 1
        for (int rep = 0; rep < REP_P0; ++rep) p0_phase(F, a); }
    SEAM(0);
    if (IN(1)) { const Args a = load_args(); p1_phase(F, a); }
    SEAM(1);
    if (IN(2)) {
        const Args a = load_args();
        pg8::Gemm g{(const bf16_t*)a.out, (const bf16_t*)(a.ws + WS_WINT), MTOK, PS, DM, 1 << 30}; pg8::StaticOrder S; S.init(MTOK, PS, F.G, F.bid);
        pg8::EpiBf16 E{(bf16_t*)(a.ws + WS_PROJ), PS};
        pg8::gemm_phase<pg8::EpiBf16, true, true>(F.lds, g, S, E);
        gates_tasks(F, a);
    }
    SEAM(2);
    if (IN(3)) {
        const Args a = load_args();
        for (int t = F.bid; t < BATCH * 64; t += F.G) qk_tile_task(F, a, t);
#pragma unroll 1
        for (int rep = 0; rep < REP_M1; ++rep)
        for (int it = F.bid; it < BATCH * 4 * 64; it += F.G) m1_item(F, a, it);
    }
    SEAM(3);
    if (IN(4)) {
        const Args a = load_args();
        for (int t = F.bid; t < 512; t += F.G) scan_task(F, a, t);
        float lam, cshift;
        { const float p01 = wave_sum(a.lam_p[F.lane] * a.lam_p[64 + F.lane]), p23 = wave_sum(a.lam_p[128 + F.lane] * a.lam_p[192 + F.lane]);
          lam = __expf(p01) - __expf(p23) + 0.2f;
          const float gq = wave_max(fabsf(a.qk_g[F.lane])), gk = wave_max(fabsf(a.qk_g[64 + F.lane]));
          cshift = 8.f * gq * gk * 1.4426950408889634f * 1.02f; }
        const int xcd = F.bid & 7, j = F.bid >> 3;
#pragma unroll 1
        for (int rep = 0; rep < REP_ATT; ++rep)
        for (int i = 0; i * F.G < 1024; ++i) {
            int u;
            if (F.G == 256) u = (xcd * 4 + i) * 32 + j; else u = i * F.G + F.bid;
            if (u < 1024) attn_unit(F, a, u >> 7, (u >> 5) & 3, u & 31, lam, cshift);
        }
    }
    SEAM(4);
    if (IN(5)) { const Args a = load_args();
#pragma unroll 1
        for (int rep = 0; rep < REP_M3; ++rep)
        for (int it = F.bid; it < BATCH * 4 * 64; it += F.G) m3_item(F, a, it); }
    SEAM(5);
    if (IN(6)) {
        const Args a = load_args();
        pg8::Gemm g{(const bf16_t*)(a.ws + WS_YMIX), (const bf16_t*)(a.ws + WS_WOUTT), MTOK, DM, DM, 1 << 30}; pg8::StaticOrder S; S.init(MTOK, DM, F.G, F.bid);
        pg8::EpiX1 E{a.x, (const float*)(a.ws + WS_MOD), a.out};
        pg8::gemm_phase<pg8::EpiX1, true, true>(F.lds, g, S, E);
    }
    SEAM(6);
    if (IN(7)) { const Args a = load_args();
#pragma unroll 1
        for (int rep = 0; rep < REP_P7; ++rep) p7_phase(F, a); }
    SEAM(7);
    if (IN(8)) { const Args a = load_args(); for (int t = F.bid; t < BATCH * NEXP; t += F.G) topk_task(F, a, t); }
    SEAM(8);
    if (IN(9)) {
        const Args a = load_args();
        pg8::Gemm g{(const bf16_t*)(a.ws + WS_XE), (const bf16_t*)(a.ws + WS_WGUT), NPAIR, 4096, DM, 16};
        pg8::StaticOrder S; S.init(NPAIR, 4096, F.G, F.bid);
        pg8::EpiGU E{a.ws + WS_HH};
#pragma unroll 1
        for (int rep = 0; rep < REP_UP; ++rep)
        pg8::gemm_phase<pg8::EpiGU, true, true, true>(F.lds, g, S, E);
    }
    SEAM(9);
    if (IN(10)) {
        const Args a = load_args();
        pg8::Gemm g{(const bf16_t*)(a.ws + WS_HH), (const bf16_t*)(a.ws + WS_WDT), NPAIR, DM, DFF, 16};
        pg8::StaticOrder S; S.init(NPAIR, DM, F.G, F.bid);
        pg8::EpiDown E{(bf16_t*)(a.ws + WS_Y), (const float*)(a.ws + WS_VALS)};
        pg8::gemm_phase<pg8::EpiDown, true, true, true>(F.lds, g, S, E);
    }
    SEAM(10);
    if (IN(11)) { const Args a = load_args(); final_phase(F, a); }
    if (PROBE_PHASE >= 0 && F.bid == 0 && F.tid == 0) {
        const unsigned long long t1 = __builtin_amdgcn_s_memrealtime();
        const unsigned long long d = (PROBE_PHASE == 11 ? t1 : tsl[PROBE_PHASE + 1]) - tsl[PROBE_PHASE];
        while (__builtin_amdgcn_s_memrealtime() - t1 < 3ull * d) __builtin_amdgcn_s_sleep(8);
    }
#undef IN
#undef SEAM
}

extern "C" void kernel_launch(void* const* d_in, const int* in_sizes, int n_in, void* d_out, int out_size, void* d_ws, size_t ws_size, hipStream_t stream) {
    static int grid_blocks = 0;
    if (!grid_blocks) {
        int dev = 0, cus = 0, per_cu = 0;
        (void)hipGetDevice(&dev);
        (void)hipDeviceGetAttribute(&cus, hipDeviceAttributeMultiprocessorCount, dev);
        (void)hipFuncSetAttribute((const void*)fwd_kernel, hipFuncAttributeMaxDynamicSharedMemorySize, LDS_BYTES);
        (void)hipOccupancyMaxActiveBlocksPerMultiprocessor(&per_cu, (const void*)fwd_kernel, NTHR, LDS_BYTES);
        if (per_cu < 1) per_cu = 1;
        grid_blocks = cus;
        if (ws_size < WS_END) fprintf(stderr, "kernel_launch: workspace too small: %zu < %zu\n", ws_size, (size_t)WS_END);
    }
    (void)hipMemsetAsync((char*)d_ws + WS_CTL, 0, CTL_ZERO_BYTES, stream);
    Args a{};
    a.x = (const float*)d_in[0]; a.c = (const float*)d_in[1]; a.pos = (const int*)d_in[2]; a.norm1_g = (const float*)d_in[3]; a.norm2_g = (const float*)d_in[4];
    a.w_ada = (const float*)d_in[5]; a.b_ada = (const float*)d_in[6]; a.w_in = (const float*)d_in[7]; a.conv_w = (const float*)d_in[8]; a.gate_b = (const float*)d_in[9];
    a.mnorm_g = (const float*)d_in[10]; a.qk_g = (const float*)d_in[11]; a.lam_p = (const float*)d_in[12]; a.subln_g = (const float*)d_in[13]; a.w_out = (const float*)d_in[14];
    a.w_router = (const float*)d_in[15]; a.w_gate = (const float*)d_in[16]; a.w_up = (const float*)d_in[17]; a.w_down = (const float*)d_in[18];
    a.out = (float*)d_out; a.ws = (unsigned char*)d_ws; a.ph_lo = 0; a.ph_hi = 12;
    void* args[] = {&a};
    hipError_t e = hipLaunchCooperativeKernel((const void*)fwd_kernel, dim3(grid_blocks), dim3(NTHR), args, LDS_BYTES, stream);
    if (e != hipSuccess) fprintf(stderr, "cooperative launch failed: %s (grid %d)\n", hipGetErrorString(e), grid_blocks);
}
```

```cpp
#include <hip/hip_runtime.h>
#include <hip/hip_cooperative_groups.h>
#include <cstdio>
#include <cstdint>
namespace cg = cooperative_groups;

#define LAS __attribute__((address_space(3)))
#define DI __device__ __forceinline__
typedef unsigned short bf16_t;
typedef short bf16x8 __attribute__((ext_vector_type(8)));
typedef short s16x4 __attribute__((ext_vector_type(4)));
typedef float f32x2 __attribute__((ext_vector_type(2)));
typedef float f32x4 __attribute__((ext_vector_type(4)));
typedef float f32x16 __attribute__((ext_vector_type(16)));
typedef unsigned u32x2 __attribute__((ext_vector_type(2)));
typedef unsigned u32x4 __attribute__((ext_vector_type(4)));
typedef __bf16 bf16x2_t __attribute__((ext_vector_type(2)));

constexpr int BATCH = 8, SEQ = 4096, DM = 1024, MTOK = BATCH * SEQ;
constexpr int DIN = 3600, PS = 3584;
constexpr int NEXP = 16, CAP = 512, DFF = 2048;
constexpr int NPAIR = BATCH * NEXP * CAP;
constexpr float EPS = 1e-6f;
constexpr int C_QM = 0, C_KM = 512, C_VM = 1024, C_OM = 1536, C_QA = 2048, C_KA = 2560, C_VA = 3072;

constexpr size_t MiB = 1u << 20;
constexpr size_t WS_MOD = 1 * MiB;
constexpr size_t WS_GATES = 2 * MiB;
constexpr size_t WS_AFF = 4 * MiB;
constexpr size_t WS_IDX = 6 * MiB;
constexpr size_t WS_VALS = 6 * MiB + 256 * 1024;
constexpr size_t WS_MSC = 6 * MiB + 512 * 1024;
constexpr size_t WS_SLOT = 7 * MiB;
constexpr size_t WS_NLOC = 9 * MiB;
constexpr size_t WS_WINT = 11 * MiB;
constexpr size_t WS_WGT = 18 * MiB;
constexpr size_t WS_WOUTT = 19 * MiB;
constexpr size_t WS_WGUT = 21 * MiB;
constexpr size_t WS_WDT = 85 * MiB;
constexpr size_t WS_Y = 117 * MiB;
constexpr size_t WS_PROJ = 213 * MiB;
constexpr size_t WS_YMIX = 437 * MiB;
constexpr size_t WS_KIMG = 437 * MiB;
constexpr size_t WS_VIMG = 469 * MiB;
constexpr size_t WS_YA = 501 * MiB;
constexpr size_t WS_HH = 245 * MiB;
constexpr size_t WS_H2 = 437 * MiB;
constexpr size_t WS_XE = 469 * MiB;
constexpr size_t WS_END = 533 * MiB;

constexpr int LDS_BYTES = 147456;
constexpr int PROBE_PHASE = -1;
constexpr int REP_M1 = 1, REP_M3 = 1, REP_UP = 1, REP_P0 = 1, REP_SCAN = 1, REP_P7 = 1, REP_ATT = 1, REP_QKT = 1, REP_MSEQ = 1;
constexpr int NWAVES = 8, NTHR = 512;

DI unsigned pk2(float lo, float hi) { f32x2 v = {lo, hi}; bf16x2_t b = __builtin_convertvector(v, bf16x2_t); return __builtin_bit_cast(unsigned, b); }
DI float bflo(unsigned w) { return __uint_as_float(w << 16); }
DI float bfhi(unsigned w) { return __uint_as_float(w & 0xffff0000u); }
DI float bf2f(bf16_t v) { return __uint_as_float((unsigned)v << 16); }
DI float wave_sum(float v) {
#pragma unroll
    for (int o = 1; o < 64; o <<= 1) v += __shfl_xor(v, o);
    return v;
}
DI float wave_max(float v) {
#pragma unroll
    for (int o = 1; o < 64; o <<= 1) v = fmaxf(v, __shfl_xor(v, o));
    return v;
}
DI float silu_f(float v) { return v / (1.f + __expf(-v)); }
DI float sigmoid_f(float v) { return 1.f / (1.f + __expf(-v)); }
DI float logsigmoid_f(float f) { return fminf(f, 0.f) - log1pf(__expf(-fabsf(f))); }
DI int swz16(int row) { return ((row & 3) << 2) | ((row >> 2) & 3); }
#define MFMA32(a, b, c) __builtin_amdgcn_mfma_f32_32x32x16_bf16((a), (b), (c), 0, 0, 0)
DI s16x4 trread(const LAS unsigned char* p) { return __builtin_bit_cast(s16x4, __builtin_amdgcn_ds_read_tr16_b64_v4i16((LAS s16x4*)p)); }
DI int crow(int r, int hh) { return (r & 3) + 8 * (r >> 2) + 4 * hh; }
DI bool hh_sel(int lane, int bit) { return (lane & bit) != 0; }

namespace pg8 {
constexpr int BM = 256, BK = 64, HALF = 128, HTB = HALF * BK * 2, STAGE_BYTES = 8 * HTB, NXCD = 8, WGM = 8;
DI int lds_byte(int r, int c) { const int st = (r >> 4) * 2 + (c >> 5), rr = r & 15, cc = c & 31, ob = rr * 64 + cc * 2; return st * 1024 + (ob ^ (((ob >> 9) & 1) << 5)); }
DI void stage_rc(int b, int& R, int& C) { const int st = b / 1024, sb = b % 1024, swz = sb ^ (((sb >> 9) & 1) << 5); R = (st >> 1) * 16 + swz / 64; C = (st & 1) * 32 + (swz % 64) / 2; }
DI int perm32(int rho) { const int n = rho >> 4, i = rho & 15; return 8 * (i >> 2) + 4 * n + (i & 3); }
struct Unit { int pm, pn; };
typedef int i32x4_t __attribute__((ext_vector_type(4)));
typedef int i32x8_t __attribute__((ext_vector_type(8)));
DI i32x8_t cat8(bf16x8 lo, bf16x8 hi) { const i32x4_t a = __builtin_bit_cast(i32x4_t, lo), b = __builtin_bit_cast(i32x4_t, hi); return __builtin_shufflevector(a, b, 0, 1, 2, 3, 4, 5, 6, 7); }
struct Gemm { const bf16_t* A; const bf16_t* Bt; int M, N, K, tpg; };
struct StaticOrder {
    int nM, nN, nwg, G, c;
    DI void init(int M, int N, int G_, int c_) { nM = M / BM; nN = N / BM; nwg = nM * nN; G = G_; c = c_; }
    DI bool next(int i, Unit& u) const {
        const long L = (long)i * G + c; if (L >= nwg) return false;
        int wgid = (int)L; { const int q = nwg / NXCD, r = nwg % NXCD, xcd = wgid % NXCD, off = wgid / NXCD; wgid = (xcd < r ? xcd * (q + 1) : r * (q + 1) + (xcd - r) * q) + off; }
        const int nig = WGM * nN, gid = wgid / nig, fm = gid * WGM, gsz = (nM - fm) < WGM ? (nM - fm) : WGM;
        u.pm = fm + ((wgid % nig) % gsz); u.pn = (wgid % nig) / gsz; return true;
    }
};

template <class Epi, bool ALIGN_EPI, bool SP2, bool FP8 = false>
DI void gemm_phase(LAS unsigned char* lds, const Gemm g, const StaticOrder& S, const Epi& E) {
    const int tid = threadIdx.x, wid = __builtin_amdgcn_readfirstlane(tid >> 6), lane = tid & 63, wr = wid >> 2, wc = wid & 3, fr = lane & 15, fq = lane >> 4;
    const int KB = FP8 ? g.K : 2 * g.K, nt = KB / (BK * 2);
    unsigned voffA[2], voffB[2];
#pragma unroll
    for (int i = 0; i < 2; ++i) { int R, C; stage_rc(tid * 16 + i * 8192, R, C); const int Rb = Epi::PERM ? ((R & ~31) + perm32(R & 31)) : R;
        voffA[i] = (unsigned)(R * KB + C * 2); voffB[i] = (unsigned)(Rb * KB + C * 2); }
    const size_t kstep = (size_t)(BK * 2);
    const size_t hstep = (size_t)HALF * KB;
    const size_t tstep = 2 * hstep;
    const size_t gstep = (size_t)g.N * KB;
    const unsigned ldsw = (unsigned)wid * 1024u;
    const int aoff = lds_byte(wr * 64 + fr, fq * 8), boff = lds_byte(wc * 32 + fr, fq * 8);
#define PG8_SA(b, h) (((b) * 2 + (h)) * HTB)
#define PG8_SB(b, h) ((4 + (b) * 2 + (h)) * HTB)
#define PG8_STAGE(bufoff, gbase, voff) do { _Pragma("unroll") for (int _i = 0; _i < 2; ++_i) \
        __builtin_amdgcn_global_load_lds((const unsigned*)((const char*)(gbase) + (voff)[_i]), (LAS unsigned*)(lds + (bufoff) + ldsw + _i * 8192), 16, 0, 0); } while (0)
#define PG8_LDA(dst, b, h) do { if constexpr (FP8) { _Pragma("unroll") for (int m = 0; m < 4; ++m) dst##8[m] = cat8(*(const LAS bf16x8*)(lds + PG8_SA(b, h) + aoff + m * 2048), *(const LAS bf16x8*)(lds + PG8_SA(b, h) + aoff + m * 2048 + 1024)); } \
        else { _Pragma("unroll") for (int m = 0; m < 4; ++m) _Pragma("unroll") for (int k = 0; k < 2; ++k) dst[m][k] = *(const LAS bf16x8*)(lds + PG8_SA(b, h) + aoff + m * 2048 + k * 1024); } } while (0)
#define PG8_LDB(dst, b, h) do { if constexpr (FP8) { _Pragma("unroll") for (int n = 0; n < 2; ++n) dst##8[n] = cat8(*(const LAS bf16x8*)(lds + PG8_SB(b, h) + boff + n * 2048), *(const LAS bf16x8*)(lds + PG8_SB(b, h) + boff + n * 2048 + 1024)); } \
        else { _Pragma("unroll") for (int n = 0; n < 2; ++n) _Pragma("unroll") for (int k = 0; k < 2; ++k) dst[n][k] = *(const LAS bf16x8*)(lds + PG8_SB(b, h) + boff + n * 2048 + k * 1024); } } while (0)
#define PG8_MMA(ai, bj, At, Bt) do { __builtin_amdgcn_s_setprio(1); \
        if constexpr (FP8) { _Pragma("unroll") for (int m = 0; m < 4; ++m) _Pragma("unroll") for (int n = 0; n < 2; ++n) \
            asm volatile("s_nop 1\n\tv_mfma_f32_16x16x128_f8f6f4 %0, %1, %2, %0" : "+v"(acc[ai][bj][m][n]) : "v"(Bt##8[n]), "v"(At##8[m])); } \
        else { _Pragma("unroll") for (int m = 0; m < 4; ++m) _Pragma("unroll") for (int n = 0; n < 2; ++n) _Pragma("unroll") for (int k = 0; k < 2; ++k) \
            acc[ai][bj][m][n] = __builtin_amdgcn_mfma_f32_16x16x32_bf16(Bt[n][k], At[m][k], acc[ai][bj][m][n], 0, 0, 0); } \
        __builtin_amdgcn_s_setprio(0); } while (0)
#define PG8_WAIT_V(n) asm volatile("s_waitcnt vmcnt(" #n ")" ::: "memory")
#define PG8_WAIT_L(n) asm volatile("s_waitcnt lgkmcnt(" #n ")" ::: "memory")
#define PG8_BAR __builtin_amdgcn_s_barrier()
#define PG8_SCHED __builtin_amdgcn_sched_barrier(0)
    Unit cur, nxt; int ui = 0;
    if (!S.next(0, cur)) return;
    f32x4 acc[2][2][4][2];
#pragma unroll
    for (int a = 0; a < 2; ++a)
#pragma unroll
        for (int b = 0; b < 2; ++b)
#pragma unroll
            for (int m = 0; m < 4; ++m)
#pragma unroll
                for (int n = 0; n < 2; ++n) acc[a][b][m][n] = (f32x4){0.f, 0.f, 0.f, 0.f};
    bf16x8 At[4][2], B0[2][2], B1[2][2]; i32x8_t At8[4], B08[2], B18[2];
    const char* cA = (const char*)g.A + (size_t)cur.pm * tstep; const char* cB = (const char*)g.Bt + (size_t)(cur.pm / g.tpg) * gstep + (size_t)cur.pn * tstep;
    if constexpr (SP2) {
        PG8_STAGE(PG8_SB(0, 0), cB, voffB); PG8_STAGE(PG8_SB(0, 1), cB + hstep, voffB); PG8_STAGE(PG8_SA(0, 0), cA, voffA); PG8_STAGE(PG8_SA(0, 1), cA + hstep, voffA);
        if (wr == 1) PG8_BAR;
        PG8_WAIT_V(2); PG8_BAR;
        PG8_STAGE(PG8_SB(1, 0), cB + kstep, voffB); PG8_STAGE(PG8_SA(1, 0), cA + kstep, voffA); PG8_STAGE(PG8_SB(1, 1), cB + hstep + kstep, voffB);
        PG8_WAIT_V(6); PG8_BAR;
    } else {
        PG8_STAGE(PG8_SB(0, 0), cB, voffB); PG8_STAGE(PG8_SA(0, 0), cA, voffA); PG8_STAGE(PG8_SB(0, 1), cB + hstep, voffB); PG8_STAGE(PG8_SA(0, 1), cA + hstep, voffA);
        if (wr == 1) PG8_BAR;
        PG8_WAIT_V(4); PG8_BAR;
        PG8_STAGE(PG8_SB(1, 0), cB + kstep, voffB); PG8_STAGE(PG8_SA(1, 0), cA + kstep, voffA); PG8_STAGE(PG8_SB(1, 1), cB + hstep + kstep, voffB);
        PG8_WAIT_V(6); PG8_BAR;
    }
    for (;;) {
        const bool has_next = S.next(ui + 1, nxt);
        const char* nA = has_next ? (const char*)g.A + (size_t)nxt.pm * tstep : cA;
        const char* nB = has_next ? (const char*)g.Bt + (size_t)(nxt.pm / g.tpg) * gstep + (size_t)nxt.pn * tstep : cB;
        for (int t = 0; t < nt; t += 2) {
            const bool last = (t == nt - 2);
            const char* a1 = cA + (size_t)(t + 1) * kstep;
            const char* a2 = last ? nA : cA + (size_t)(t + 2) * kstep; const char* b2 = last ? nB : cB + (size_t)(t + 2) * kstep;
            const char* a3 = a2 + kstep; const char* b3 = b2 + kstep;
            if constexpr (SP2) {
            PG8_LDB(B0, 0, 0); PG8_LDB(B1, 0, 1); PG8_SCHED; PG8_LDA(At, 0, 0); PG8_STAGE(PG8_SA(1, 1), a1 + hstep, voffA);
            PG8_WAIT_V(8); PG8_WAIT_L(0); PG8_BAR; PG8_MMA(0, 0, At, B0); PG8_MMA(0, 1, At, B1); PG8_BAR; PG8_SCHED;
            PG8_LDA(At, 0, 1); PG8_STAGE(PG8_SB(0, 0), b2, voffB); PG8_STAGE(PG8_SB(0, 1), b2 + hstep, voffB); PG8_STAGE(PG8_SA(0, 0), a2, voffA);
            PG8_WAIT_V(8); PG8_WAIT_L(0); PG8_BAR; PG8_MMA(1, 0, At, B0); PG8_MMA(1, 1, At, B1); PG8_BAR; PG8_SCHED;
            PG8_LDB(B0, 1, 0); PG8_LDB(B1, 1, 1); PG8_SCHED; PG8_LDA(At, 1, 0); PG8_STAGE(PG8_SA(0, 1), a2 + hstep, voffA);
            PG8_WAIT_V(8); PG8_WAIT_L(0); PG8_BAR; PG8_MMA(0, 0, At, B0); PG8_MMA(0, 1, At, B1); PG8_BAR; PG8_SCHED;
            PG8_LDA(At, 1, 1); PG8_STAGE(PG8_SB(1, 0), b3, voffB); PG8_STAGE(PG8_SB(1, 1), b3 + hstep, voffB); PG8_STAGE(PG8_SA(1, 0), a3, voffA);
            PG8_WAIT_V(8); PG8_WAIT_L(0); PG8_BAR; PG8_MMA(1, 0, At, B0); PG8_MMA(1, 1, At, B1); PG8_BAR; PG8_SCHED;
            } else {
            PG8_LDB(B0, 0, 0); PG8_SCHED; PG8_LDA(At, 0, 0); PG8_STAGE(PG8_SA(1, 1), a1 + hstep, voffA);
            PG8_WAIT_L(8); PG8_BAR; PG8_WAIT_L(0); PG8_MMA(0, 0, At, B0); PG8_BAR; PG8_SCHED;
            PG8_LDB(B1, 0, 1); PG8_STAGE(PG8_SB(0, 0), b2, voffB);
            PG8_BAR; PG8_WAIT_L(0); PG8_MMA(0, 1, At, B1); PG8_BAR;
            PG8_LDA(At, 0, 1); PG8_STAGE(PG8_SA(0, 0), a2, voffA);
            PG8_BAR; PG8_WAIT_L(0); PG8_MMA(1, 0, At, B0); PG8_BAR; PG8_SCHED;
            PG8_STAGE(PG8_SB(0, 1), b2 + hstep, voffB);
            PG8_WAIT_V(6); PG8_BAR; PG8_MMA(1, 1, At, B1); PG8_BAR;
            PG8_LDB(B0, 1, 0); PG8_SCHED; PG8_LDA(At, 1, 0); PG8_STAGE(PG8_SA(0, 1), a2 + hstep, voffA);
            PG8_WAIT_L(8); PG8_BAR; PG8_WAIT_L(0); PG8_MMA(0, 0, At, B0); PG8_BAR; PG8_SCHED;
            PG8_LDB(B1, 1, 1); PG8_STAGE(PG8_SB(1, 0), b3, voffB);
            PG8_BAR; PG8_WAIT_L(0); PG8_MMA(0, 1, At, B1); PG8_BAR;
            PG8_LDA(At, 1, 1); PG8_STAGE(PG8_SA(1, 0), a3, voffA);
            PG8_BAR; PG8_WAIT_L(0); PG8_MMA(1, 0, At, B0); PG8_BAR; PG8_SCHED;
            PG8_STAGE(PG8_SB(1, 1), b3 + hstep, voffB);
            PG8_WAIT_V(6); PG8_BAR; PG8_MMA(1, 1, At, B1); PG8_BAR;
            }
        }
        if constexpr (ALIGN_EPI) { if (wr == 0) PG8_BAR; }
        if constexpr (FP8) asm volatile("s_nop 15\n\ts_nop 7" ::: "memory");
        E(acc, cur, wr, wc, fr, fq);
        if (!has_next) break;
#pragma unroll
        for (int a = 0; a < 2; ++a)
#pragma unroll
            for (int b = 0; b < 2; ++b)
#pragma unroll
                for (int m = 0; m < 4; ++m)
#pragma unroll
                    for (int n = 0; n < 2; ++n) acc[a][b][m][n] = (f32x4){0.f, 0.f, 0.f, 0.f};
        cur = nxt; cA = nA; cB = nB; ++ui;
        if constexpr (ALIGN_EPI) { if (wr == 1) PG8_BAR; }
    }
    PG8_WAIT_V(0);
    if constexpr (!ALIGN_EPI) { if (wr == 0) PG8_BAR; }
    PG8_BAR;
#undef PG8_SA
#undef PG8_SB
#undef PG8_STAGE
#undef PG8_LDA
#undef PG8_LDB
#undef PG8_MMA
#undef PG8_WAIT_V
#undef PG8_WAIT_L
#undef PG8_BAR
#undef PG8_SCHED
}

struct EpiBf16 {
    static constexpr bool PERM = true;
    bf16_t* O; int ldc;
    DI void operator()(const f32x4 (&acc)[2][2][4][2], const Unit& u, int wr, int wc, int fr, int fq) const {
        const int row0 = u.pm * BM + wr * 64 + fr, col0 = u.pn * BM + wc * 32 + 8 * fq;
#pragma unroll
        for (int ai = 0; ai < 2; ++ai)
#pragma unroll
            for (int m = 0; m < 4; ++m) { bf16_t* rowp = O + (size_t)(row0 + ai * HALF + m * 16) * ldc + col0;
#pragma unroll
                for (int bj = 0; bj < 2; ++bj) { const f32x4 v0 = acc[ai][bj][m][0], v1 = acc[ai][bj][m][1];
                    u32x4 w; w.x = pk2(v0[0], v0[1]); w.y = pk2(v0[2], v0[3]); w.z = pk2(v1[0], v1[1]); w.w = pk2(v1[2], v1[3]);
                    *(u32x4*)(rowp + bj * HALF) = w; } }
    }
};
struct EpiX1 {
    static constexpr bool PERM = false;
    const float* x; const float* mod; float* out;
    DI void operator()(const f32x4 (&acc)[2][2][4][2], const Unit& u, int wr, int wc, int fr, int fq) const {
        const int row0 = u.pm * BM + wr * 64 + fr, col0 = u.pn * BM + wc * 32 + 4 * fq;
        const int b = (u.pm * BM) / SEQ;
        const float* gp = mod + (size_t)b * 6144 + 2048 + col0;
#pragma unroll
        for (int bj = 0; bj < 2; ++bj)
#pragma unroll
            for (int n = 0; n < 2; ++n) { const f32x4 gv = *(const f32x4*)(gp + bj * HALF + n * 16);
#pragma unroll
                for (int ai = 0; ai < 2; ++ai)
#pragma unroll
                    for (int m = 0; m < 4; ++m) { const size_t off = (size_t)(row0 + ai * HALF + m * 16) * DM + col0 + bj * HALF + n * 16;
                        const f32x4 xv = *(const f32x4*)(x + off); *(f32x4*)(out + off) = xv + gv * acc[ai][bj][m][n]; } }
    }
};
DI unsigned pk4_fp8(float a, float b, float c, float d) { int w = __builtin_amdgcn_cvt_pk_fp8_f32(a, b, 0, false); w = __builtin_amdgcn_cvt_pk_fp8_f32(c, d, w, true); return (unsigned)w; }
constexpr float W_PRESCALE = 32.f, H_PRESCALE = 8.f;
struct EpiGU {
    static constexpr bool PERM = true;
    unsigned char* H;
    DI void operator()(const f32x4 (&acc)[2][2][4][2], const Unit& u, int wr, int wc, int fr, int fq) const {
        const int row0 = u.pm * BM + wr * 64 + fr, col0 = u.pn * HALF + wc * 32 + 8 * fq;
#pragma unroll
        for (int ai = 0; ai < 2; ++ai)
#pragma unroll
            for (int m = 0; m < 4; ++m) { unsigned char* rowp = H + (size_t)(row0 + ai * HALF + m * 16) * DFF + col0;
                float hv[8];
#pragma unroll
                for (int n = 0; n < 2; ++n)
#pragma unroll
                    for (int j = 0; j < 4; ++j) { const float gg = acc[ai][0][m][n][j] * (1.f / W_PRESCALE), uu = acc[ai][1][m][n][j] * (H_PRESCALE / W_PRESCALE); hv[n * 4 + j] = gg / (1.f + __expf(-gg)) * uu; }
                u32x2 w; w.x = pk4_fp8(hv[0], hv[1], hv[2], hv[3]); w.y = pk4_fp8(hv[4], hv[5], hv[6], hv[7]);
                *(u32x2*)rowp = w; }
    }
};
struct EpiDown {
    static constexpr bool PERM = true;
    bf16_t* Y; const float* vals;
    DI void operator()(const f32x4 (&acc)[2][2][4][2], const Unit& u, int wr, int wc, int fr, int fq) const {
        const int row0 = u.pm * BM + wr * 64 + fr, col0 = u.pn * BM + wc * 32 + 8 * fq;
#pragma unroll
        for (int ai = 0; ai < 2; ++ai)
#pragma unroll
            for (int m = 0; m < 4; ++m) { const int row = row0 + ai * HALF + m * 16; const float s = vals[row] * (1.f / (W_PRESCALE * H_PRESCALE)); bf16_t* rowp = Y + (size_t)row * DM + col0;
#pragma unroll
                for (int bj = 0; bj < 2; ++bj) { const f32x4 v0 = acc[ai][bj][m][0] * s, v1 = acc[ai][bj][m][1] * s;
                    u32x4 w; w.x = pk2(v0[0], v0[1]); w.y = pk2(v0[2], v0[3]); w.z = pk2(v1[0], v1[1]); w.w = pk2(v1[2], v1[3]);
                    *(u32x4*)(rowp + bj * HALF) = w; } }
    }
};
}

struct Args {
    const float* x; const float* c; const int* pos; const float* norm1_g; const float* norm2_g; const float* w_ada; const float* b_ada;
    const float* w_in; const float* conv_w; const float* gate_b; const float* mnorm_g; const float* qk_g; const float* lam_p; const float* subln_g;
    const float* w_out; const float* w_router; const float* w_gate; const float* w_up; const float* w_down;
    float* out; unsigned char* ws; int ph_lo, ph_hi;
};
struct Ctx {
    LAS unsigned char* lds; int tid, lane, wave, G, bid;
};
DI Args load_args() {
    typedef __attribute__((address_space(4))) const volatile unsigned long long* kp_t;
    kp_t kp = (kp_t)__builtin_amdgcn_kernarg_segment_ptr();
#define GP(T, i) ((T*)(__attribute__((address_space(1))) T*)kp[i])
    Args a;
    a.x = GP(const float, 0); a.c = GP(const float, 1); a.pos = GP(const int, 2); a.norm1_g = GP(const float, 3); a.norm2_g = GP(const float, 4);
    a.w_ada = GP(const float, 5); a.b_ada = GP(const float, 6); a.w_in = GP(const float, 7); a.conv_w = GP(const float, 8); a.gate_b = GP(const float, 9);
    a.mnorm_g = GP(const float, 10); a.qk_g = GP(const float, 11); a.lam_p = GP(const float, 12); a.subln_g = GP(const float, 13); a.w_out = GP(const float, 14);
    a.w_router = GP(const float, 15); a.w_gate = GP(const float, 16); a.w_up = GP(const float, 17); a.w_down = GP(const float, 18);
    a.out = GP(float, 19); a.ws = GP(unsigned char, 20);
#undef GP
    a.ph_lo = 0; a.ph_hi = 12;
    return a;
}

DI void tr_item64(const float* src, size_t ld_src, int k0, int c0, bf16_t* dst, size_t r0, int ld_dst, LAS float* scr  , int lane) {
    const float* sp = src + (size_t)(k0 + (lane >> 4)) * ld_src + c0 + (lane & 15) * 4;
#pragma unroll 1
    for (int hf = 0; hf < 2; ++hf) {
        f32x4 v[8];
#pragma unroll
        for (int i = 0; i < 8; ++i) v[i] = *(const f32x4*)(sp + (size_t)(4 * (8 * hf + i)) * ld_src);
#pragma unroll
        for (int i = 0; i < 8; ++i) *(LAS f32x4*)(scr + (4 * (8 * hf + i) + (lane >> 4)) * 68 + (lane & 15) * 4) = v[i];
    }
    asm volatile("s_waitcnt lgkmcnt(0)" ::: "memory");
    const int c = lane & 7;
#pragma unroll
    for (int q = 0; q < 8; ++q) { const int n = 8 * q + (lane >> 3); const LAS float* s = scr + (8 * c) * 68 + n;
        u32x4 o; o.x = pk2(s[0 * 68], s[1 * 68]); o.y = pk2(s[2 * 68], s[3 * 68]); o.z = pk2(s[4 * 68], s[5 * 68]); o.w = pk2(s[6 * 68], s[7 * 68]);
        *(u32x4*)(dst + (r0 + n) * ld_dst + k0 + 8 * c) = o; }
    asm volatile("s_waitcnt lgkmcnt(0)" ::: "memory");
}
DI void tr_item64_fp8(const float* src, size_t ld_src, int k0, int c0, unsigned char* dst, size_t r0, int ld_dst, float scale, LAS float* scr  , int lane) {
    const float* sp = src + (size_t)(k0 + (lane >> 4)) * ld_src + c0 + (lane & 15) * 4;
    {
        f32x4 v[16];
#pragma unroll
        for (int i = 0; i < 16; ++i) v[i] = __builtin_nontemporal_load((const f32x4*)(sp + (size_t)(4 * i) * ld_src));
#pragma unroll
        for (int i = 0; i < 16; ++i) *(LAS f32x4*)(scr + (4 * i + (lane >> 4)) * 68 + (lane & 15) * 4) = v[i] * scale;
    }
    asm volatile("s_waitcnt lgkmcnt(0)" ::: "memory");
    const int c = lane & 3;
#pragma unroll
    for (int q = 0; q < 4; ++q) { const int n = 16 * q + (lane >> 2); const LAS float* s = scr + (16 * c) * 68 + n;
        u32x4 o; o.x = pg8::pk4_fp8(s[0 * 68], s[1 * 68], s[2 * 68], s[3 * 68]); o.y = pg8::pk4_fp8(s[4 * 68], s[5 * 68], s[6 * 68], s[7 * 68]);
        o.z = pg8::pk4_fp8(s[8 * 68], s[9 * 68], s[10 * 68], s[11 * 68]); o.w = pg8::pk4_fp8(s[12 * 68], s[13 * 68], s[14 * 68], s[15 * 68]);
        *(u32x4*)(dst + (r0 + n) * ld_dst + k0 + 16 * c) = o; }
    asm volatile("s_waitcnt lgkmcnt(0)" ::: "memory");
}
DI void p0_phase(const Ctx& F, const Args& a) {
    if (F.bid < 96) {
        LAS float* sc = (LAS float*)F.lds; LAS float* part = (LAS float*)(F.lds + 32768);
        for (int i = F.tid; i < BATCH * DM; i += NTHR) sc[i] = silu_f(a.c[i]);
        __syncthreads();
        const int col = F.bid * 64 + F.lane;
        float acc[8];
#pragma unroll
        for (int b = 0; b < 8; ++b) acc[b] = 0.f;
        const int kb = F.wave * 128;
#pragma unroll 1
        for (int k0 = kb; k0 < kb + 128; k0 += 16) {
            float w[16];
            const float* wp = a.w_ada + (size_t)k0 * 6144 + col;
#pragma unroll
            for (int j = 0; j < 16; ++j) w[j] = wp[(size_t)j * 6144];
#pragma unroll
            for (int j = 0; j < 16; ++j)
#pragma unroll
                for (int b = 0; b < 8; ++b) acc[b] += sc[b * DM + k0 + j] * w[j];
        }
#pragma unroll
        for (int b = 0; b < 8; ++b) part[(F.wave * 8 + b) * 64 + F.lane] = acc[b];
        __syncthreads();
        { const int b = F.tid >> 6, l = F.tid & 63; float s = a.b_ada[F.bid * 64 + l];
#pragma unroll
          for (int w = 0; w < 8; ++w) s += part[(w * 8 + b) * 64 + l];
          ((float*)(a.ws + WS_MOD))[b * 6144 + F.bid * 64 + l] = s; }
        __syncthreads();
    }
    LAS float* scr = (LAS float*)(F.lds + F.wave * 17408);
    const int gw = F.bid * NWAVES + F.wave, NGW = F.G * NWAVES;
    constexpr int I_IN = 16 * 56, I_OUT = 16 * 16, I_G = 16 * 16 * 32, I_D = 16 * 32 * 16, I_WG = 16;
    constexpr int NITEMS = I_IN + I_OUT + 2 * I_G + I_D + I_WG;
    bf16_t* WinT = (bf16_t*)(a.ws + WS_WINT); bf16_t* WgT = (bf16_t*)(a.ws + WS_WGT); bf16_t* WoutT = (bf16_t*)(a.ws + WS_WOUTT);
    unsigned char* WguT = a.ws + WS_WGUT; unsigned char* WdT = a.ws + WS_WDT;
    for (int it = gw; it < NITEMS; it += NGW) {
        int r = it;
        if (r < I_IN) { const int kb = r / 56, nb = r % 56, n0 = nb * 64; tr_item64(a.w_in, DIN, kb * 64, n0 + (n0 >= 2048 ? 16 : 0), WinT, n0, DM, scr, F.lane); continue; } r -= I_IN;
        if (r < I_OUT) { const int kb = r / 16, nb = r % 16; tr_item64(a.w_out, DM, kb * 64, nb * 64, WoutT, nb * 64, DM, scr, F.lane); continue; } r -= I_OUT;
        if (r < 2 * I_G) { const int up = r / I_G; r -= up * I_G; const int e = r / 512; r -= e * 512; const int kb = r / 32, nb = r % 32, n0 = nb * 64;
            const float* src = (up ? a.w_up : a.w_gate) + (size_t)e * DM * DFF;
            tr_item64_fp8(src, DFF, kb * 64, n0, WguT + (size_t)e * 4096 * DM, (size_t)(n0 / 128) * 256 + (n0 % 128) + up * 128, DM, pg8::W_PRESCALE, scr, F.lane); continue; } r -= 2 * I_G;
        if (r < I_D) { const int e = r / 512; r -= e * 512; const int kb = r / 16, nb = r % 16;
            tr_item64_fp8(a.w_down + (size_t)e * DFF * DM, DM, kb * 64, nb * 64, WdT + (size_t)e * DM * DFF, nb * 64, DFF, pg8::W_PRESCALE, scr, F.lane); continue; } r -= I_D;
        tr_item64(a.w_in, DIN, r * 64, 2048 - 48, WgT, 0, DM, scr, F.lane);
    }
}

DI void p1_phase(const Ctx& F, const Args& a) {
    const int gw = F.bid * NWAVES + F.wave, NGW = F.G * NWAVES;
    const float* mod = (const float*)(a.ws + WS_MOD);
    bf16_t* H1 = (bf16_t*)a.out;
    for (int m0 = gw; m0 < MTOK; m0 += 2 * NGW) {
        const int m1 = m0 + NGW; const bool has1 = m1 < MTOK;
        const f32x4* xr0 = (const f32x4*)(a.x + (size_t)m0 * DM) + F.lane; const f32x4* xr1 = (const f32x4*)(a.x + (size_t)(has1 ? m1 : m0) * DM) + F.lane;
        f32x4 v0[4], v1[4]; float s0 = 0.f, s1 = 0.f;
#pragma unroll
        for (int j = 0; j < 4; ++j) { v0[j] = __builtin_nontemporal_load(xr0 + 64 * j); v1[j] = __builtin_nontemporal_load(xr1 + 64 * j); }
#pragma unroll
        for (int j = 0; j < 4; ++j) { s0 += (v0[j].x * v0[j].x + v0[j].y * v0[j].y) + (v0[j].z * v0[j].z + v0[j].w * v0[j].w); s1 += (v1[j].x * v1[j].x + v1[j].y * v1[j].y) + (v1[j].z * v1[j].z + v1[j].w * v1[j].w); }
#pragma unroll
        for (int o = 1; o < 64; o <<= 1) { s0 += __shfl_xor(s0, o); s1 += __shfl_xor(s1, o); }
        const float rstd0 = rsqrtf(s0 * (1.f / DM) + EPS), rstd1 = rsqrtf(s1 * (1.f / DM) + EPS);
        const int b0 = m0 / SEQ, b1 = (has1 ? m1 : m0) / SEQ;
        u32x2* o0 = (u32x2*)(H1 + (size_t)m0 * DM) + F.lane; u32x2* o1 = (u32x2*)(H1 + (size_t)m1 * DM) + F.lane;
#pragma unroll
        for (int j = 0; j < 4; ++j) {
            const f32x4 g = ((const f32x4*)a.norm1_g)[F.lane + 64 * j];
            { const f32x4 sh = ((const f32x4*)(mod + (size_t)b0 * 6144))[F.lane + 64 * j], sc = ((const f32x4*)(mod + (size_t)b0 * 6144 + 1024))[F.lane + 64 * j];
              const f32x4 h = v0[j] * rstd0 * g * (sc + 1.f) + sh; u32x2 w; w.x = pk2(h.x, h.y); w.y = pk2(h.z, h.w); o0[64 * j] = w; }
            if (has1) { const f32x4 sh = ((const f32x4*)(mod + (size_t)b1 * 6144))[F.lane + 64 * j], sc = ((const f32x4*)(mod + (size_t)b1 * 6144 + 1024))[F.lane + 64 * j];
              const f32x4 h = v1[j] * rstd1 * g * (sc + 1.f) + sh; u32x2 w; w.x = pk2(h.x, h.y); w.y = pk2(h.z, h.w); o1[64 * j] = w; }
        }
    }
}

DI void gates_tasks(const Ctx& F, const Args& a) {
    const int gw = F.bid * NWAVES + F.wave, NGW = F.G * NWAVES;
    const bf16_t* H1 = (const bf16_t*)a.out; const bf16_t* WgT = (const bf16_t*)(a.ws + WS_WGT) + 48 * DM; float* GT = (float*)(a.ws + WS_GATES);
    const float bias = a.gate_b[F.lane & 15];
    for (int task = gw; task < MTOK / 16; task += NGW) {
        const int row0 = task * 16;
        const bf16_t* ap = H1 + (size_t)(row0 + (F.lane & 15)) * DM + 8 * (F.lane >> 4);
        const bf16_t* bp = WgT + (size_t)(F.lane & 15) * DM + 8 * (F.lane >> 4);
        f32x4 acc = {0.f, 0.f, 0.f, 0.f};
#pragma unroll 8
        for (int i = 0; i < 32; ++i) { const bf16x8 av = *(const bf16x8*)(ap + 32 * i), bv = *(const bf16x8*)(bp + 32 * i); acc = __builtin_amdgcn_mfma_f32_16x16x32_bf16(av, bv, acc, 0, 0, 0); }
#pragma unroll
        for (int r = 0; r < 4; ++r) GT[(size_t)(row0 + (F.lane >> 4) * 4 + r) * 16 + (F.lane & 15)] = acc[r] + bias;
    }
}

DI void qk_tile_task(const Ctx& F, const Args& a, int task) {
    const int b = task >> 6, tile = task & 63, r = F.lane, g = F.wave, h = g >> 1, p = g & 1;
    bf16_t* PROJ = (bf16_t*)(a.ws + WS_PROJ);
    const size_t tok = (size_t)b * SEQ + tile * 64 + r;
    float invf[8];
#pragma unroll
    for (int i = 0; i < 8; ++i) invf[i] = exp2f(-(float)i * 0.125f * 18.931568569324174f) * 0.15915494309189535f;
    const float pos = (float)a.pos[tok];
    float sn[8], cs[8];
#pragma unroll
    for (int i = 0; i < 8; ++i) { const float fr = __builtin_amdgcn_fractf(pos * invf[i]); sn[i] = __builtin_amdgcn_sinf(fr); cs[i] = __builtin_amdgcn_cosf(fr); }
#pragma unroll 1
    for (int isk = 0; isk < 2; ++isk) {
        u32x4* src = (u32x4*)(PROJ + tok * PS + (isk ? C_KA : C_QA) + g * 64);
        u32x4 w[8];
#pragma unroll
        for (int c = 0; c < 8; ++c) w[c] = src[c];
        float ss = 0.f;
#pragma unroll
        for (int c = 0; c < 8; ++c) { float t;
            t = bflo(w[c].x); ss += t * t; t = bfhi(w[c].x); ss += t * t; t = bflo(w[c].y); ss += t * t; t = bfhi(w[c].y); ss += t * t;
            t = bflo(w[c].z); ss += t * t; t = bfhi(w[c].z); ss += t * t; t = bflo(w[c].w); ss += t * t; t = bfhi(w[c].w); ss += t * t; }
        const float rstd = rsqrtf(ss * (1.f / 64.f) + EPS) * (isk ? 1.f : 0.125f * 1.4426950408889634f);
        const float* gp = a.qk_g + isk * 64;
        float v0[16];
        v0[0] = bflo(w[0].x); v0[1] = bfhi(w[0].x); v0[2] = bflo(w[0].y); v0[3] = bfhi(w[0].y); v0[4] = bflo(w[0].z); v0[5] = bfhi(w[0].z); v0[6] = bflo(w[0].w); v0[7] = bfhi(w[0].w);
        v0[8] = bflo(w[1].x); v0[9] = bfhi(w[1].x); v0[10] = bflo(w[1].y); v0[11] = bfhi(w[1].y); v0[12] = bflo(w[1].z); v0[13] = bfhi(w[1].z); v0[14] = bflo(w[1].w); v0[15] = bfhi(w[1].w);
#pragma unroll
        for (int i = 0; i < 16; ++i) v0[i] *= rstd * gp[i];
        float rr[16];
#pragma unroll
        for (int i = 0; i < 8; ++i) { rr[i] = v0[i] * cs[i] - v0[i + 8] * sn[i]; rr[i + 8] = v0[i + 8] * cs[i] + v0[i] * sn[i]; }
        u32x4 o[8];
        o[0].x = pk2(rr[0], rr[1]); o[0].y = pk2(rr[2], rr[3]); o[0].z = pk2(rr[4], rr[5]); o[0].w = pk2(rr[6], rr[7]);
        o[1].x = pk2(rr[8], rr[9]); o[1].y = pk2(rr[10], rr[11]); o[1].z = pk2(rr[12], rr[13]); o[1].w = pk2(rr[14], rr[15]);
#pragma unroll
        for (int c = 2; c < 8; ++c) { const f32x4 g0 = *(const f32x4*)(gp + c * 8), g1 = *(const f32x4*)(gp + c * 8 + 4);
            o[c].x = pk2(bflo(w[c].x) * rstd * g0.x, bfhi(w[c].x) * rstd * g0.y); o[c].y = pk2(bflo(w[c].y) * rstd * g0.z, bfhi(w[c].y) * rstd * g0.w);
            o[c].z = pk2(bflo(w[c].z) * rstd * g1.x, bfhi(w[c].z) * rstd * g1.y); o[c].w = pk2(bflo(w[c].w) * rstd * g1.z, bfhi(w[c].w) * rstd * g1.w); }
        if (isk == 0) {
#pragma unroll
            for (int c = 0; c < 8; ++c) src[c] = o[c];
        } else {
            u32x4* dst = (u32x4*)((bf16_t*)(a.ws + WS_KIMG) + ((size_t)((b * 4 + h) * 64 + tile)) * 8192) + r;
#pragma unroll
            for (int c = 0; c < 8; ++c) dst[(p * 8 + c) * 64] = o[c];
        }
    }
    {
        u32x4* dst = (u32x4*)((bf16_t*)(a.ws + WS_VIMG) + ((size_t)((b * 4 + h) * 64 + tile)) * 8192) + r;
#pragma unroll
        for (int cg = 2 * p; cg < 2 * p + 2; ++cg)
#pragma unroll
            for (int kg = 0; kg < 4; ++kg) {
                const u32x4 v = *(const u32x4*)(PROJ + ((size_t)b * SEQ + tile * 64 + 16 * kg + (r >> 2)) * PS + C_VA + h * 128 + 32 * cg + 8 * (r & 3));
                dst[(cg * 4 + kg) * 64] = v; }
    }
}

DI bf16x8 tr_frag_nat(const LAS unsigned char* img, int rowbase, int col0, int lane) {
    const int hh = lane >> 5, g16 = (lane >> 4) & 1, i = lane & 15;
    const int col = col0 + 16 * g16 + 4 * (i & 3), chunk = col >> 3, sub = (col & 7) * 2;
    const int r0 = rowbase + 8 * hh + (i >> 2), r1 = r0 + 4;
    const s16x4 lo = trread(img + r0 * 256 + ((chunk ^ swz16(r0)) << 4) + sub);
    const s16x4 hi = trread(img + r1 * 256 + ((chunk ^ swz16(r1)) << 4) + sub);
    return __builtin_shufflevector(lo, hi, 0, 1, 2, 3, 4, 5, 6, 7);
}
DI bf16x8 tr_frag_acc(const LAS unsigned char* img, int rowbase, int col0, int lane) {
    const int hh = lane >> 5, g16 = (lane >> 4) & 1, i = lane & 15;
    const int col = col0 + 16 * g16 + 4 * (i & 3), chunk = col >> 3, sub = (col & 7) * 2;
    const int r0 = rowbase + 4 * hh + (i >> 2), r1 = r0 + 8;
    const s16x4 lo = trread(img + r0 * 256 + ((chunk ^ swz16(r0)) << 4) + sub);
    const s16x4 hi = trread(img + r1 * 256 + ((chunk ^ swz16(r1)) << 4) + sub);
    return __builtin_shufflevector(lo, hi, 0, 1, 2, 3, 4, 5, 6, 7);
}
DI bf16x8 row_frag(const LAS unsigned char* img, int row, int chunk) { return *(const LAS bf16x8*)(img + row * 256 + ((chunk ^ swz16(row)) << 4)); }

DI void glds16_asm(const void* gsrc, unsigned lds_dst) { unsigned keep;
    asm volatile("s_mov_b32 %0, m0\n\ts_mov_b32 m0, %2\n\ts_nop 0\n\tglobal_load_lds_dwordx4 %1, off\n\ts_mov_b32 m0, %0" : "=&s"(keep) : "v"(gsrc), "s"(lds_dst) : "memory"); }
constexpr size_t DO_QC = 0, DO_KC = 32 * MiB, DO_HD = 64 * MiB;
constexpr size_t WS_SC = 7 * MiB;

DI void conv_task(const Ctx& F, const Args& a, int tw) {
    const int isk = tw & 1, tok0 = (tw >> 1) * 8, b = tok0 / SEQ, t0 = tok0 % SEQ, lane = F.lane;
    const bf16_t* src = (const bf16_t*)(a.ws + WS_PROJ) + (size_t)b * SEQ * PS + (isk ? C_KM : C_QM) + lane * 8;
    float cw[5][8];
#pragma unroll
    for (int j = 0; j < 5; ++j) { const f32x4 c0 = *(const f32x4*)(a.conv_w + j * 1024 + isk * 512 + lane * 8), c1 = *(const f32x4*)(a.conv_w + j * 1024 + isk * 512 + lane * 8 + 4);
        cw[j][0] = c0.x; cw[j][1] = c0.y; cw[j][2] = c0.z; cw[j][3] = c0.w; cw[j][4] = c1.x; cw[j][5] = c1.y; cw[j][6] = c1.z; cw[j][7] = c1.w; }
    u32x4 row[12];
#pragma unroll
    for (int r = 0; r < 12; ++r) { const int t = t0 + r - 2; row[r] = (u32x4){0u, 0u, 0u, 0u}; if (t >= 0 && t < SEQ) row[r] = *(const u32x4*)(src + (size_t)t * PS); }
    const int hd = lane >> 4, cc = lane & 15, cch = t0 >> 6, r0 = t0 & 63;
    bf16_t* tileb = (bf16_t*)((unsigned char*)a.out + (isk ? DO_KC : DO_QC)) + ((size_t)((b * 4 + hd) * 64 + cch)) * 8192;
    bf16_t* dst = isk ? tileb + ((cc >> 2) * 4 + (r0 >> 4)) * 512 + (r0 & 15) * 32 + (cc & 3) * 8 : tileb + cc * 512 + r0 * 8;
    const int dstride = isk ? 32 : 8;
    const float sc = isk ? 0.08838834764831845f : 1.f;
#pragma unroll
    for (int i = 0; i < 8; ++i) {
        float acc[8];
#pragma unroll
        for (int e = 0; e < 8; ++e) acc[e] = 0.f;
#pragma unroll
        for (int j = 0; j < 5; ++j) { const u32x4 w = row[i + j];
            acc[0] += bflo(w.x) * cw[j][0]; acc[1] += bfhi(w.x) * cw[j][1]; acc[2] += bflo(w.y) * cw[j][2]; acc[3] += bfhi(w.y) * cw[j][3];
            acc[4] += bflo(w.z) * cw[j][4]; acc[5] += bfhi(w.z) * cw[j][5]; acc[6] += bflo(w.w) * cw[j][6]; acc[7] += bfhi(w.w) * cw[j][7]; }
#pragma unroll
        for (int e = 0; e < 8; ++e) acc[e] = silu_f(acc[e]) * sc;
        u32x4 o; o.x = pk2(acc[0], acc[1]); o.y = pk2(acc[2], acc[3]); o.z = pk2(acc[4], acc[5]); o.w = pk2(acc[6], acc[7]);
        *(u32x4*)(dst + i * dstride) = o;
    }
}

DI void mscal_task(const Ctx& F, const Args& a, int chain) {
    const int b = chain >> 3, h = (chain >> 1) & 3, dir = chain & 1, s = F.lane;
    const float* GT = (const float*)(a.ws + WS_GATES) + (size_t)b * SEQ * 16;
    float* SC = (float*)(a.ws + WS_SC) + (size_t)chain * 64 * 256; float* MSC = (float*)(a.ws + WS_MSC);
    LAS float* gl = (LAS float*)F.lds; LAS float* mll = gl + 64; LAS float* mpv = gl + 128; LAS float* mnw = gl + 192;
    float aa[8], ii[8];
#pragma unroll
    for (int i = 0; i < 8; ++i) { const int c = F.wave + 8 * i;
        const float ig = GT[(size_t)(c * 64 + s) * 16 + dir * 8 + h], fg = GT[(size_t)(c * 64 + s) * 16 + dir * 8 + 4 + h];
        float av = logsigmoid_f(fg);
        if (dir == 0) {
#pragma unroll
            for (int o = 1; o < 64; o <<= 1) { const float t = __shfl_up(av, o); if (s >= o) av += t; }
        } else {
#pragma unroll
            for (int o = 1; o < 64; o <<= 1) { const float t = __shfl_down(av, o); if (s + o < 64) av += t; }
        }
        aa[i] = av; ii[i] = ig;
        const float g = __shfl(av, dir == 0 ? 63 : 0), ml = wave_max(g - av + ig);
        if (s == 0) { gl[c] = g; mll[c] = ml; } }
    __syncthreads();
    if (F.tid == 0) { float m = 0.f;
        for (int st = 0; st < 64; ++st) { const int c = dir ? 63 - st : st; mpv[c] = m; const float mn = fmaxf(gl[c] + m, mll[c]); mnw[c] = mn; m = mn; } }
    __syncthreads();
#pragma unroll
    for (int i = 0; i < 8; ++i) { const int c = F.wave + 8 * i; const float mprev = mpv[c], mnew = mnw[c], g = gl[c];
        const float cterm = ii[i] - aa[i]; float cm = cterm;
        if (dir == 0) {
#pragma unroll
            for (int o = 1; o < 64; o <<= 1) { const float t = __shfl_up(cm, o); if (s >= o) cm = fmaxf(cm, t); }
        } else {
#pragma unroll
            for (int o = 1; o < 64; o <<= 1) { const float t = __shfl_down(cm, o); if (s + o < 64) cm = fmaxf(cm, t); }
        }
        const float il = aa[i] + mprev, mj = fmaxf(il, aa[i] + cm);
        float* o4 = SC + (size_t)c * 256 + s;
        o4[0] = (aa[i] - mj) * 1.4426950408889634f; o4[64] = cterm * 1.4426950408889634f; o4[128] = __expf(il - mj); o4[192] = __expf(-mj);
        if (s == 0) { MSC[chain * 64 + c] = (g - mnew) * 1.4426950408889634f; MSC[4096 + chain * 64 + c] = __expf(g + mprev - mnew); } }
    __syncthreads();
}

DI void mseq_item(const Ctx& F, const Args& a, int bh, int dir, int vs) {
    const int b = bh >> 2, h = bh & 3, chain = bh * 2 + dir, wid = F.wave, tid = F.tid, lane = F.lane, r32 = lane & 31, hh = lane >> 5;
    LAS unsigned char* QS = F.lds;
    LAS unsigned char* KS = F.lds + 32768;
    LAS unsigned char* VS = F.lds + 65536;
    LAS unsigned char* SCS = F.lds + 77824;
    LAS unsigned char* SD = F.lds + 80896;
    LAS unsigned char* CI = F.lds + 97280;
    LAS float* NV = (LAS float*)(F.lds + 113664);
    LAS float* gmv = NV + 256; LAS float* spv = gmv + 64;
    LAS float* rdv = spv + 64;
    LAS float* wvv = rdv + 64;
    const bf16_t* QC = (const bf16_t*)((const unsigned char*)a.out + DO_QC) + (size_t)bh * 64 * 8192 + lane * 8;
    const bf16_t* KC = (const bf16_t*)((const unsigned char*)a.out + DO_KC) + (size_t)bh * 64 * 8192 + lane * 8;
    const bf16_t* VP = (const bf16_t*)(a.ws + WS_PROJ) + (size_t)b * SEQ * PS + C_VM + h * 128 + vs * 32 + (size_t)(16 * (wid & 3) + (lane >> 2)) * PS + 8 * (lane & 3);
    const float* SC = (const float*)(a.ws + WS_SC) + (size_t)chain * 64 * 256 + lane * 4;
    bf16_t* HD = (bf16_t*)((unsigned char*)a.out + DO_HD) + ((size_t)dir * MTOK + (size_t)b * SEQ) * 512 + h * 128 + vs * 32;
    if (tid < 64) { gmv[tid] = ((const float*)(a.ws + WS_MSC))[chain * 64 + tid]; spv[tid] = ((const float*)(a.ws + WS_MSC))[4096 + chain * 64 + tid]; }
    if (tid < 256) NV[tid] = 0.f;
    for (int i = tid; i < 4096; i += NTHR) ((LAS unsigned*)CI)[i] = 0u;
    const unsigned ldsb = (unsigned)(uintptr_t)F.lds;
#define MSEQ_ISSUE(c, s2, s3) do { const size_t _tb = (size_t)(c); \
        if (wid < 4) { _Pragma("unroll") for (int _i = 0; _i < 4; ++_i) \
                glds16_asm(QC + _tb * 8192 + (4 * wid + _i) * 512, (unsigned)__builtin_amdgcn_readfirstlane((int)(ldsb + (s2) * 16384 + (4 * wid + _i) * 1024))); \
            glds16_asm(VP + _tb * 64 * PS, (unsigned)__builtin_amdgcn_readfirstlane((int)(ldsb + 65536 + (s3) * 4096 + wid * 1024))); } \
        else if (wid >= 6) { _Pragma("unroll") for (int _i = 0; _i < 8; ++_i) \
                glds16_asm(KC + _tb * 8192 + (8 * (wid - 6) + _i) * 512, (unsigned)__builtin_amdgcn_readfirstlane((int)(ldsb + 32768 + (s2) * 16384 + (8 * (wid - 6) + _i) * 1024))); \
            if (wid == 6) glds16_asm(SC + _tb * 256, (unsigned)__builtin_amdgcn_readfirstlane((int)(ldsb + 77824 + (s3) * 1024))); } } while (0)
    MSEQ_ISSUE(dir ? 63 : 0, 0, 0);
    f32x16 Cacc[2];
#pragma unroll
    for (int i = 0; i < 16; ++i) { Cacc[0][i] = 0.f; Cacc[1][i] = 0.f; }
    const int qrd = hh * 1024 + r32 * 16;
    const int ktr = (8 * hh + ((lane & 15) >> 2)) * 64 + ((lane >> 4) & 1) * 32 + (lane & 3) * 8;
    const int sdw = (r32 >> 3) * 1024 + (r32 & 7) * 2 + hh * 64;
    const int ciw = (r32 >> 3) * 512 + (r32 & 7) * 2 + hh * 64;
    f32x16 acc;
    float qn = 0.f;
#pragma unroll
    for (int i = 0; i < 16; ++i) acc[i] = 0.f;
    asm volatile("s_waitcnt vmcnt(0)" ::: "memory");
    __syncthreads();
    int s3 = 0;
#pragma unroll 1
    for (int st = 0; st <= 64; ++st) {
        const int c = dir ? 63 - st : st, s2 = st & 1; const int s3n = (s3 == 2) ? 0 : s3 + 1, s3p = (s3 == 0) ? 2 : s3 - 1;
        if (st + 1 < 64) MSEQ_ISSUE(dir ? 62 - st : st + 1, s2 ^ 1, s3n);
        const LAS unsigned char* QT = QS + s2 * 16384; const LAS unsigned char* KT = KS + s2 * 16384; const LAS unsigned char* VT = VS + s3 * 4096;
        const LAS float* rt = (const LAS float*)(SCS + s3 * 1024); const LAS float* ct = rt + 64;
        if (wid < 4) {
            if (st < 64) {
                const int jt = wid >> 1, stt = wid & 1;
                const LAS unsigned char* qa = QT + qrd + jt * 512;
                const LAS unsigned char* kb = KT + (2 * stt + (r32 >> 4)) * 1024 + (r32 & 15) * 64 + hh * 16;
                f32x16 S;
#pragma unroll
                for (int i = 0; i < 16; ++i) S[i] = 0.f;
#pragma unroll
                for (int ks = 0; ks < 8; ++ks) S = MFMA32(*(const LAS bf16x8*)(qa + ks * 2048), *(const LAS bf16x8*)(kb + (ks >> 1) * 4096 + (ks & 1) * 32), S);
                float nnew;
                {   const float gm = gmv[c], sp = spv[c];
                    LAS float* wv = wvv + wid * 64;
                    wv[lane] = __builtin_amdgcn_exp2f(ct[lane] + gm);
                    asm volatile("s_waitcnt lgkmcnt(0)" ::: "memory");
                    const int ck = 4 * wid + (lane & 3), r0 = 4 * (lane >> 2); float pa[8];
                    const LAS unsigned char* kr = KT + (ck >> 2) * 4096 + (r0 >> 4) * 1024 + (r0 & 15) * 64 + (ck & 3) * 16;
#pragma unroll
                    for (int e = 0; e < 8; ++e) pa[e] = 0.f;
#pragma unroll
                    for (int r = 0; r < 4; ++r) { const u32x4 w = *(const LAS u32x4*)(kr + r * 64); const float ws_ = wv[r0 + r];
                        pa[0] += ws_ * bflo(w.x); pa[1] += ws_ * bfhi(w.x); pa[2] += ws_ * bflo(w.y); pa[3] += ws_ * bfhi(w.y); pa[4] += ws_ * bflo(w.z); pa[5] += ws_ * bfhi(w.z); pa[6] += ws_ * bflo(w.w); pa[7] += ws_ * bfhi(w.w); }
#pragma unroll
                    for (int e = 0; e < 8; ++e) { pa[e] += __shfl_xor(pa[e], 4); pa[e] += __shfl_xor(pa[e], 8); pa[e] += __shfl_xor(pa[e], 16); pa[e] += __shfl_xor(pa[e], 32); }
                    const int srcl = (lane >> 3) & 3; float sel = 0.f;
#pragma unroll
                    for (int e = 0; e < 8; ++e) { const float t = __shfl(pa[e], srcl); sel = ((lane & 7) == e) ? t : sel; }
                    nnew = sp * NV[s2 * 128 + 32 * wid + (lane & 31)] + sel;
                }
                const int scol = 32 * stt + r32; const float cts = ct[scol];
                LAS unsigned char* sw = SD + s2 * 8192 + sdw + stt * 4096 + jt * 512;
#pragma unroll
                for (int i = 0; i < 16; ++i) { const int jr = crow(i, 0), j = 32 * jt + jr + 4 * hh;
                    const bool ok = dir == 0 ? (scol <= j) : (scol >= j);
                    const float v = S[i] * __builtin_amdgcn_exp2f(ok ? rt[j] + cts : -1.0e30f);
                    *(LAS bf16_t*)(sw + jr * 16) = (bf16_t)(pk2(v, 0.f) & 0xffffu); }
                if (lane < 32) NV[(s2 ^ 1) * 128 + 32 * wid + lane] = nnew;
            }
        } else if (wid < 6) {
            const int jt = wid - 4;
            if (st > 0) {
                const int cp = dir ? 64 - st : st - 1;
                const LAS float* iw = (const LAS float*)(SCS + s3p * 1024) + 128; const LAS float* enm = iw + 64;
                const LAS unsigned char* SDp = SD + (s2 ^ 1) * 8192;
                {   const int j = 32 * jt + (lane >> 1), hf = lane & 1; float rsum = 0.f;
                    const LAS unsigned char* sr = SDp + hf * 4096 + j * 16;
#pragma unroll
                    for (int ch = 0; ch < 4; ++ch) { const u32x4 w = *(const LAS u32x4*)(sr + ch * 1024);
                        rsum += (bflo(w.x) + bfhi(w.x)) + (bflo(w.y) + bfhi(w.y)) + (bflo(w.z) + bfhi(w.z)) + (bflo(w.w) + bfhi(w.w)); }
                    rsum += __shfl_xor(rsum, 1);
                    const float den = rsum + iw[j] * qn;
                    if (hf == 0) rdv[j] = 1.f / fmaxf(fabsf(den), enm[j]);
                    asm volatile("s_waitcnt lgkmcnt(0)" ::: "memory");
                }
                const LAS float* iwp = iw + 32 * jt + 4 * hh; const LAS float* rdp = rdv + 32 * jt + 4 * hh;
#pragma unroll
                for (int i = 0; i < 16; ++i) acc[i] *= iwp[crow(i, 0)];
                const LAS unsigned char* sa = SDp + qrd + jt * 512; const LAS unsigned char* vb = VS + s3p * 4096 + ktr;
#pragma unroll
                for (int ks = 0; ks < 4; ++ks) { const s16x4 lo = trread(vb + ks * 1024), hi = trread(vb + ks * 1024 + 256);
                    acc = MFMA32(*(const LAS bf16x8*)(sa + ks * 2048), __builtin_shufflevector(lo, hi, 0, 1, 2, 3, 4, 5, 6, 7), acc); }
                bf16_t* hp = HD + (size_t)(cp * 64 + 32 * jt + 4 * hh) * 512 + r32;
#pragma unroll
                for (int i = 0; i < 16; ++i) { const int jr = crow(i, 0); hp[jr * 512] = (bf16_t)(pk2(acc[i] * rdp[jr], 0.f) & 0xffffu); }
            }
            if (st < 64) {
                const LAS unsigned char* qa = QT + qrd + jt * 512;
                const LAS unsigned char* cb = CI + s2 * 8192 + hh * 512 + r32 * 16;
#pragma unroll
                for (int i = 0; i < 16; ++i) acc[i] = 0.f;
#pragma unroll
                for (int ks = 0; ks < 8; ++ks) acc = MFMA32(*(const LAS bf16x8*)(qa + ks * 2048), *(const LAS bf16x8*)(cb + ks * 1024), acc);
                const int j = 32 * jt + (lane >> 1), hf = lane & 1;
                const LAS unsigned char* qr = QT + hf * 8192 + j * 16; const LAS float* np = NV + s2 * 128 + 64 * hf;
                qn = 0.f;
#pragma unroll
                for (int ch = 0; ch < 8; ++ch) { const u32x4 w = *(const LAS u32x4*)(qr + ch * 1024); const f32x4 n0 = *(const LAS f32x4*)(np + ch * 8), n1 = *(const LAS f32x4*)(np + ch * 8 + 4);
                    qn += bflo(w.x) * n0.x + bfhi(w.x) * n0.y + bflo(w.y) * n0.z + bfhi(w.y) * n0.w + bflo(w.z) * n1.x + bfhi(w.z) * n1.y + bflo(w.w) * n1.z + bfhi(w.w) * n1.w; }
                qn += __shfl_xor(qn, 1);
            }
        } else if (st < 64) {
            const int u = wid - 6; const float gm = gmv[c], sp = spv[c];
            LAS float* wv = wvv + (4 + u) * 64;
            wv[lane] = __builtin_amdgcn_exp2f(ct[lane] + gm);
            asm volatile("s_waitcnt lgkmcnt(0)" ::: "memory");
#pragma unroll
            for (int i = 0; i < 16; ++i) { Cacc[0][i] *= sp; Cacc[1][i] *= sp; }
            const LAS unsigned char* va = VT + ktr; const LAS unsigned char* ka = KT + ktr + (2 * u) * 4096;
#pragma unroll
            for (int ks = 0; ks < 4; ++ks) {
                const s16x4 lo = trread(va + ks * 1024), hi = trread(va + ks * 1024 + 256);
                const f32x4 w0 = *(const LAS f32x4*)(wv + 16 * ks + 8 * hh), w1 = *(const LAS f32x4*)(wv + 16 * ks + 8 * hh + 4);
                u32x4 af;
                af.x = pk2(bf2f((bf16_t)lo[0]) * w0.x, bf2f((bf16_t)lo[1]) * w0.y); af.y = pk2(bf2f((bf16_t)lo[2]) * w0.z, bf2f((bf16_t)lo[3]) * w0.w);
                af.z = pk2(bf2f((bf16_t)hi[0]) * w1.x, bf2f((bf16_t)hi[1]) * w1.y); af.w = pk2(bf2f((bf16_t)hi[2]) * w1.z, bf2f((bf16_t)hi[3]) * w1.w);
                const bf16x8 afr = __builtin_bit_cast(bf16x8, af);
                { const s16x4 l0 = trread(ka + ks * 1024), h0 = trread(ka + ks * 1024 + 256); Cacc[0] = MFMA32(afr, __builtin_shufflevector(l0, h0, 0, 1, 2, 3, 4, 5, 6, 7), Cacc[0]); }
                { const s16x4 l1 = trread(ka + 4096 + ks * 1024), h1 = trread(ka + 4096 + ks * 1024 + 256); Cacc[1] = MFMA32(afr, __builtin_shufflevector(l1, h1, 0, 1, 2, 3, 4, 5, 6, 7), Cacc[1]); }
            }
            LAS unsigned char* cw = CI + (s2 ^ 1) * 8192 + ciw + (2 * u) * 2048;
#pragma unroll
            for (int t2 = 0; t2 < 2; ++t2)
#pragma unroll
                for (int i = 0; i < 16; ++i) *(LAS bf16_t*)(cw + t2 * 2048 + crow(i, 0) * 16) = (bf16_t)(pk2(Cacc[t2][i], 0.f) & 0xffffu);
        }
        s3 = s3n;
        if (wid < 4 || wid >= 6) asm volatile("s_waitcnt vmcnt(0)" ::: "memory");
        asm volatile("s_waitcnt lgkmcnt(0)" ::: "memory"); __builtin_amdgcn_s_barrier(); asm volatile("" ::: "memory");
    }
    asm volatile("s_waitcnt vmcnt(0)" ::: "memory");
#undef MSEQ_ISSUE
}

DI void glds16(const void* g, LAS unsigned char* l) { __builtin_amdgcn_global_load_lds((const unsigned*)g, (LAS unsigned*)l, 16, 0, 0); }
DI void attn_unit(const Ctx& F, const Args& a, int b, int h, int qb, float lam, float cshift) {
    const int lane = F.lane, wid = F.wave, r32 = lane & 31, hh = lane >> 5, rg = wid & 3, p = wid >> 2;
    const bf16_t* projb = (const bf16_t*)(a.ws + WS_PROJ) + (size_t)b * SEQ * PS;
    const int qrow = qb * 128 + rg * 32 + r32;
    bf16x8 qf[4];
    { const bf16_t* qp = projb + (size_t)qrow * PS + C_QA + h * 128 + p * 64 + hh * 8;
#pragma unroll
      for (int ks = 0; ks < 4; ++ks) qf[ks] = *(const bf16x8*)(qp + ks * 16); }
    const bf16_t* kimg = (const bf16_t*)(a.ws + WS_KIMG) + (size_t)(b * 4 + h) * 64 * 8192 + (2 * wid) * 512 + lane * 8;
    const bf16_t* vimg = (const bf16_t*)(a.ws + WS_VIMG) + (size_t)(b * 4 + h) * 64 * 8192 + (2 * wid) * 512 + lane * 8;
    const unsigned ldsw = (unsigned)__builtin_amdgcn_readfirstlane((int)(unsigned)(uintptr_t)F.lds + (2 * wid) * 1024);
#define ATT_ISSUE_K(t, s) do { const bf16_t* _tp = kimg + (size_t)(t) * 8192; const unsigned _d = (unsigned)__builtin_amdgcn_readfirstlane((int)(ldsw + (s) * 16384)); \
        glds16_asm(_tp, _d); glds16_asm(_tp + 512, _d + 1024); } while (0)
#define ATT_ISSUE_V(t, s) do { const bf16_t* _tp = vimg + (size_t)(t) * 8192; const unsigned _d = (unsigned)__builtin_amdgcn_readfirstlane((int)(ldsw + 32768 + (s) * 16384)); \
        glds16_asm(_tp, _d); glds16_asm(_tp + 512, _d + 1024); } while (0)
    ATT_ISSUE_K(0, 0); ATT_ISSUE_V(0, 0); ATT_ISSUE_K(1, 1);
    f32x16 O[4];
#pragma unroll
    for (int vt = 0; vt < 4; ++vt)
#pragma unroll
        for (int i = 0; i < 16; ++i) O[vt][i] = 0.f;
    float lsum = 0.f;
    const int kfb = p * 8192 + hh * 1024 + r32 * 16;
    const int vfb = 32768 + (4 * hh + ((lane & 15) >> 2)) * 64 + ((lane >> 4) & 1) * 32 + (lane & 3) * 8;
    bf16x8 pb[4];
    asm volatile("s_waitcnt vmcnt(0)" ::: "memory");
    __syncthreads();
#define ATT_QK(Sa, Sb, kb) do { _Pragma("unroll") for (int i = 0; i < 16; ++i) { Sa[i] = -cshift; Sb[i] = -cshift; } \
        _Pragma("unroll") for (int ks = 0; ks < 4; ++ks) { Sa = MFMA32(*(const LAS bf16x8*)((kb) + ks * 2048), qf[ks], Sa); Sb = MFMA32(*(const LAS bf16x8*)((kb) + ks * 2048 + 512), qf[ks], Sb); } } while (0)
#define ATT_EXP(Sa, Sb, on) do { float _ls = 0.f; _Pragma("unroll") for (int i = 0; i < 16; ++i) { Sa[i] = __builtin_amdgcn_exp2f(Sa[i]); Sb[i] = __builtin_amdgcn_exp2f(Sb[i]); _ls += Sa[i] + Sb[i]; } lsum += (on) ? _ls : 0.f; \
        ATT_PACK(pb[0], Sa, 0); ATT_PACK(pb[1], Sa, 8); ATT_PACK(pb[2], Sb, 0); ATT_PACK(pb[3], Sb, 8); } while (0)
#define ATT_PACK(dst, S, o) do { u32x4 _w; _w.x = pk2(S[o], S[o + 1]); _w.y = pk2(S[o + 2], S[o + 3]); _w.z = pk2(S[o + 4], S[o + 5]); _w.w = pk2(S[o + 6], S[o + 7]); dst = __builtin_bit_cast(bf16x8, _w); } while (0)
    f32x16 Sa, Sb;
    ATT_QK(Sa, Sb, F.lds + kfb);
    if (p == 0) ATT_EXP(Sa, Sb, true);
    __syncthreads();
#define ATT_VLOAD(dst, Vb, kg) do { _Pragma("unroll") for (int vt = 0; vt < 4; ++vt) { \
        const s16x4 _lo = trread((Vb) + vt * 4096 + (kg) * 1024), _hi = trread((Vb) + vt * 4096 + (kg) * 1024 + 512); dst[vt] = __builtin_shufflevector(_lo, _hi, 0, 1, 2, 3, 4, 5, 6, 7); } } while (0)
#define ATT_PV(vf, kg) do { _Pragma("unroll") for (int vt = 0; vt < 4; ++vt) O[vt] = MFMA32(vf[vt], pb[kg], O[vt]); } while (0)
#pragma unroll 1
    for (int t = 0; t < 64; ++t) {
        const int s = t & 1;
        ATT_ISSUE_K(t + 2 < 64 ? t + 2 : 63, s);
        ATT_ISSUE_V(t + 1 < 64 ? t + 1 : 63, s ^ 1);
        const LAS unsigned char* Kb = F.lds + (s ^ 1) * 16384 + kfb; const LAS unsigned char* Vb = F.lds + s * 16384 + vfb;
        bf16x8 kfa[4], kfb2[4], vA[4], vB[4];
#pragma unroll
        for (int ks = 0; ks < 4; ++ks) { kfa[ks] = *(const LAS bf16x8*)(Kb + ks * 2048); kfb2[ks] = *(const LAS bf16x8*)(Kb + ks * 2048 + 512); }
        ATT_VLOAD(vA, Vb, 0);
        if (p == 1) ATT_EXP(Sa, Sb, true);
        __builtin_amdgcn_sched_barrier(0);
        ATT_VLOAD(vB, Vb, 1); ATT_PV(vA, 0);
        __builtin_amdgcn_sched_barrier(0);
        ATT_VLOAD(vA, Vb, 2); ATT_PV(vB, 1);
        __builtin_amdgcn_sched_barrier(0);
        ATT_VLOAD(vB, Vb, 3); ATT_PV(vA, 2);
        __builtin_amdgcn_sched_barrier(0);
        ATT_PV(vB, 3);
#pragma unroll
        for (int i = 0; i < 16; ++i) { Sa[i] = -cshift; Sb[i] = -cshift; }
#pragma unroll
        for (int ks = 0; ks < 4; ++ks) { Sa = MFMA32(kfa[ks], qf[ks], Sa); Sb = MFMA32(kfb2[ks], qf[ks], Sb); }
        __builtin_amdgcn_sched_barrier(0);
        if (p == 0) ATT_EXP(Sa, Sb, t + 1 < 64);
        asm volatile("s_waitcnt vmcnt(0)" ::: "memory");
        __syncthreads();
    }
#undef ATT_VLOAD
#undef ATT_PV
#undef ATT_ISSUE_K
#undef ATT_ISSUE_V
#undef ATT_QK
#undef ATT_EXP
#undef ATT_PACK
    lsum += __shfl_xor(lsum, 32);
    LAS float* X = (LAS float*)(F.lds + 65536) + rg * 4096 + r32;
    if (p == 1) {
        const float sc = lam / lsum;
#pragma unroll
        for (int vt = 0; vt < 4; ++vt)
#pragma unroll
            for (int i = 0; i < 16; ++i) X[(32 * vt + crow(i, hh)) * 32] = O[vt][i] * sc;
    }
    __syncthreads();
    if (p == 0) {
        const float i0 = 1.f / lsum;
        float ssq = 0.f;
#pragma unroll
        for (int vt = 0; vt < 4; ++vt)
#pragma unroll
            for (int i = 0; i < 16; ++i) { const float o = O[vt][i] * i0 - X[(32 * vt + crow(i, hh)) * 32]; O[vt][i] = o; ssq += o * o; }
        ssq += __shfl_xor(ssq, 32);
        const float rs = rsqrtf(ssq * (1.f / 128.f) + EPS) * 0.8f;
        bf16_t* yp = (bf16_t*)(a.ws + WS_YA) + (size_t)(b * SEQ + qrow) * 512 + h * 128;
#pragma unroll
        for (int vt = 0; vt < 4; ++vt)
#pragma unroll
            for (int rgi = 0; rgi < 4; ++rgi) { const int vd = 32 * vt + 8 * rgi + 4 * hh; const f32x4 g = *(const f32x4*)(a.subln_g + vd);
                u32x2 w; w.x = pk2(O[vt][4 * rgi] * rs * g.x, O[vt][4 * rgi + 1] * rs * g.y); w.y = pk2(O[vt][4 * rgi + 2] * rs * g.z, O[vt][4 * rgi + 3] * rs * g.w);
                *(u32x2*)(yp + vd) = w; }
    }
    __syncthreads();
}

DI void mcombine_phase(const Ctx& F, const Args& a) {
    const int gw = F.bid * NWAVES + F.wave, NGW = F.G * NWAVES, lane = F.lane;
    const bf16_t* HD = (const bf16_t*)((const unsigned char*)a.out + DO_HD);
    float g[8];
#pragma unroll
    for (int i = 0; i < 8; ++i) g[i] = a.mnorm_g[lane * 8 + i];
    for (int m = gw; m < MTOK; m += NGW) {
        const u32x4 f = *(const u32x4*)(HD + (size_t)m * 512 + lane * 8), bw = *(const u32x4*)(HD + ((size_t)MTOK + m) * 512 + lane * 8);
        const u32x4 om = *(const u32x4*)((const bf16_t*)(a.ws + WS_PROJ) + (size_t)m * PS + C_OM + lane * 8);
        const u32x4 ya = *(const u32x4*)((const bf16_t*)(a.ws + WS_YA) + (size_t)m * 512 + lane * 8);
        float v[8];
        v[0] = bflo(f.x) + bflo(bw.x); v[1] = bfhi(f.x) + bfhi(bw.x); v[2] = bflo(f.y) + bflo(bw.y); v[3] = bfhi(f.y) + bfhi(bw.y);
        v[4] = bflo(f.z) + bflo(bw.z); v[5] = bfhi(f.z) + bfhi(bw.z); v[6] = bflo(f.w) + bflo(bw.w); v[7] = bfhi(f.w) + bfhi(bw.w);
        float ss = 0.f;
#pragma unroll
        for (int i = 0; i < 8; ++i) ss += v[i] * v[i];
        ss += __shfl_xor(ss, 1); ss += __shfl_xor(ss, 2); ss += __shfl_xor(ss, 4); ss += __shfl_xor(ss, 8);
        const float rstd = rsqrtf(ss * (1.f / 128.f) + EPS);
        float o[8];
        o[0] = bflo(om.x); o[1] = bfhi(om.x); o[2] = bflo(om.y); o[3] = bfhi(om.y); o[4] = bflo(om.z); o[5] = bfhi(om.z); o[6] = bflo(om.w); o[7] = bfhi(om.w);
#pragma unroll
        for (int i = 0; i < 8; ++i) v[i] = v[i] * rstd * g[i] * sigmoid_f(o[i]);
        u32x4 w; w.x = pk2(v[0], v[1]); w.y = pk2(v[2], v[3]); w.z = pk2(v[4], v[5]); w.w = pk2(v[6], v[7]);
        bf16_t* yp = (bf16_t*)(a.ws + WS_YMIX) + (size_t)m * DM + lane * 8;
        *(u32x4*)yp = w; *(u32x4*)(yp + 512) = ya;
    }
}

DI void p7_phase(const Ctx& F, const Args& a) {
    LAS f32x4* WRL = (LAS f32x4*)F.lds;
    for (int q = F.tid; q < 4096; q += NTHR) { const int k = q >> 2, g = q & 3; WRL[(g * 2 + (k & 1)) * 512 + (k >> 1)] = *(const f32x4*)(a.w_router + k * 16 + g * 4); }
    __syncthreads();
    const int gw = F.bid * NWAVES + F.wave, NGW = F.G * NWAVES, lane = F.lane;
    const float* mod = (const float*)(a.ws + WS_MOD);
    unsigned char* H2 = a.ws + WS_H2; float* AFF = (float*)(a.ws + WS_AFF);
    for (int m = gw; m < MTOK; m += NGW) {
        const int b = m / SEQ;
        const f32x2* xr = (const f32x2*)(a.out + (size_t)m * DM) + lane;
        f32x2 v[8]; float s = 0.f;
#pragma unroll
        for (int j = 0; j < 8; ++j) { v[j] = xr[64 * j]; s += v[j].x * v[j].x + v[j].y * v[j].y; }
        const float rstd = rsqrtf(wave_sum(s) * (1.f / DM) + EPS);
        float lg[16];
#pragma unroll
        for (int e = 0; e < 16; ++e) lg[e] = 0.f;
        unsigned short* o2 = (unsigned short*)(H2 + (size_t)m * DM) + lane;
#pragma unroll
        for (int j = 0; j < 8; ++j) {
            const f32x2 g = ((const f32x2*)a.norm2_g)[lane + 64 * j];
            const f32x2 sh = ((const f32x2*)(mod + (size_t)b * 6144 + 3072))[lane + 64 * j];
            const f32x2 sc = ((const f32x2*)(mod + (size_t)b * 6144 + 4096))[lane + 64 * j];
            const f32x2 hv = v[j] * rstd * g * (sc + 1.f) + sh;
            o2[64 * j] = (unsigned short)__builtin_amdgcn_cvt_pk_fp8_f32(hv.x, hv.y, 0, false);
#pragma unroll
            for (int g4 = 0; g4 < 4; ++g4) { const f32x4 w0 = WRL[(g4 * 2 + 0) * 512 + lane + 64 * j], w1 = WRL[(g4 * 2 + 1) * 512 + lane + 64 * j];
                lg[g4 * 4 + 0] += hv.x * w0.x + hv.y * w1.x; lg[g4 * 4 + 1] += hv.x * w0.y + hv.y * w1.y; lg[g4 * 4 + 2] += hv.x * w0.z + hv.y * w1.z; lg[g4 * 4 + 3] += hv.x * w0.w + hv.y * w1.w; }
            __builtin_amdgcn_sched_barrier(0);
        }
        float r8[8];
#pragma unroll
        for (int i = 0; i < 8; ++i) { const float keep = hh_sel(lane, 32) ? lg[8 + i] : lg[i], send = hh_sel(lane, 32) ? lg[i] : lg[8 + i]; r8[i] = keep + __shfl_xor(send, 32); }
        float r4[4];
#pragma unroll
        for (int i = 0; i < 4; ++i) { const float keep = hh_sel(lane, 16) ? r8[4 + i] : r8[i], send = hh_sel(lane, 16) ? r8[i] : r8[4 + i]; r4[i] = keep + __shfl_xor(send, 16); }
        float r2[2];
#pragma unroll
        for (int i = 0; i < 2; ++i) { const float keep = hh_sel(lane, 8) ? r4[2 + i] : r4[i], send = hh_sel(lane, 8) ? r4[i] : r4[2 + i]; r2[i] = keep + __shfl_xor(send, 8); }
        float lgt; { const float keep = hh_sel(lane, 4) ? r2[1] : r2[0], send = hh_sel(lane, 4) ? r2[0] : r2[1]; lgt = keep + __shfl_xor(send, 4); }
        lgt += __shfl_xor(lgt, 2); lgt += __shfl_xor(lgt, 1);
        float mx = lgt;
#pragma unroll
        for (int o = 4; o < 64; o <<= 1) mx = fmaxf(mx, __shfl_xor(mx, o));
        const float ex = __expf(lgt - mx); float sm = ex;
#pragma unroll
        for (int o = 4; o < 64; o <<= 1) sm += __shfl_xor(sm, o);
        if ((lane & 3) == 0) AFF[(size_t)m * 16 + (lane >> 2)] = ex / sm;
    }
    __syncthreads();
}

DI void topk_task(const Ctx& F, const Args& a, int task) {
    const int b = task >> 4, e = task & 15, tid = F.tid, lane = F.lane;
    const float* AFF = (const float*)(a.ws + WS_AFF) + (size_t)b * SEQ * 16 + e;
    LAS unsigned* hist = (LAS unsigned*)F.lds;
    LAS unsigned* sfx = hist + 256;
    LAS unsigned* misc = hist + 512;
    LAS int* lidx = (LAS int*)(F.lds + 4096);
    unsigned key[8];
#pragma unroll
    for (int i = 0; i < 8; ++i) key[i] = __float_as_uint(AFF[(size_t)(tid * 8 + i) * 16]);
    unsigned prefix = 0, krem = CAP;
#pragma unroll 1
    for (int pass = 0; pass < 4; ++pass) {
        const int shift = 24 - 8 * pass;
        if (tid < 256) hist[tid] = 0;
        __syncthreads();
#pragma unroll
        for (int i = 0; i < 8; ++i) { const bool in = pass == 0 ? true : ((key[i] >> (shift + 8)) == (prefix >> (shift + 8))); if (in) atomicAdd((unsigned*)&hist[(key[i] >> shift) & 255u], 1u); }
        __syncthreads();
        if (tid < 256) sfx[tid] = hist[tid];
        __syncthreads();
#pragma unroll 1
        for (int o = 1; o < 256; o <<= 1) { unsigned v = 0; if (tid < 256) v = sfx[tid] + (tid + o < 256 ? sfx[tid + o] : 0u); __syncthreads(); if (tid < 256) sfx[tid] = v; __syncthreads(); }
        if (tid < 256) { const unsigned incl = sfx[tid], excl = incl - hist[tid]; if (excl < krem && krem <= incl) { misc[0] = (unsigned)tid; misc[1] = krem - excl; } }
        __syncthreads();
        prefix |= misc[0] << shift; krem = misc[1];
        __syncthreads();
    }
    const unsigned T = prefix, need = krem;
    unsigned cg_ = 0, ce = 0;
#pragma unroll
    for (int i = 0; i < 8; ++i) { cg_ += key[i] > T; ce += key[i] == T; }
    unsigned sg = cg_, se = ce;
#pragma unroll
    for (int o = 1; o < 64; o <<= 1) { const unsigned tg = __shfl_up(sg, o), te = __shfl_up(se, o); if (lane >= o) { sg += tg; se += te; } }
    if (lane == 63) { misc[16 + F.wave] = sg; misc[32 + F.wave] = se; }
    __syncthreads();
    unsigned og = sg - cg_, oe = se - ce;
    for (int w = 0; w < F.wave; ++w) { og += misc[16 + w]; oe += misc[32 + w]; }
    int* SLOT = (int*)(a.ws + WS_SLOT) + (size_t)b * SEQ * 16 + e;
    float* VALS = (float*)(a.ws + WS_VALS) + (size_t)(e * 8 + b) * CAP;
    int* IDX = (int*)(a.ws + WS_IDX) + (size_t)(b * 16 + e) * CAP;
#pragma unroll
    for (int i = 0; i < 8; ++i) {
        const bool gt = key[i] > T, eq = key[i] == T; const bool sel = gt || (eq && oe < need);
        const unsigned pos = og + (oe < need ? oe : need);
        const int s = tid * 8 + i;
        SLOT[(size_t)s * 16] = sel ? (int)pos : -1;
        if (sel) { lidx[pos] = s; IDX[pos] = s; VALS[pos] = __uint_as_float(key[i]); }
        og += gt; oe += eq;
    }
    __syncthreads();
    const unsigned char* H2 = a.ws + WS_H2 + (size_t)b * SEQ * DM; unsigned char* XE = a.ws + WS_XE + (size_t)(e * 8 + b) * CAP * DM;
    for (int r0 = F.wave * 4; r0 < CAP; r0 += NWAVES * 4) { u32x4 v[4];
#pragma unroll
        for (int j = 0; j < 4; ++j) v[j] = ((const u32x4*)(H2 + (size_t)lidx[r0 + j] * DM))[lane];
#pragma unroll
        for (int j = 0; j < 4; ++j) ((u32x4*)(XE + (size_t)(r0 + j) * DM))[lane] = v[j]; }
    __syncthreads();
}

DI void final_phase(const Ctx& F, const Args& a) {
    const int gw = F.bid * NWAVES + F.wave, NGW = F.G * NWAVES, lane = F.lane;
    const float* mod = (const float*)(a.ws + WS_MOD); const int* SLOT = (const int*)(a.ws + WS_SLOT); const bf16_t* Y = (const bf16_t*)(a.ws + WS_Y);
    for (int m = gw; m < MTOK; m += NGW) {
        const int b = m / SEQ;
        const int sl = SLOT[(size_t)m * 16 + (lane & 15)];
        float acc[16];
#pragma unroll
        for (int i = 0; i < 16; ++i) acc[i] = 0.f;
#pragma unroll 1
        for (int e = 0; e < 16; ++e) { const int s = __shfl(sl, e);
            if (s >= 0) { const u32x4* yp = (const u32x4*)(Y + ((size_t)(e * 8 + b) * CAP + s) * DM + lane * 16); const u32x4 w0 = yp[0], w1 = yp[1];
                acc[0] += bflo(w0.x); acc[1] += bfhi(w0.x); acc[2] += bflo(w0.y); acc[3] += bfhi(w0.y); acc[4] += bflo(w0.z); acc[5] += bfhi(w0.z); acc[6] += bflo(w0.w); acc[7] += bfhi(w0.w);
                acc[8] += bflo(w1.x); acc[9] += bfhi(w1.x); acc[10] += bflo(w1.y); acc[11] += bfhi(w1.y); acc[12] += bflo(w1.z); acc[13] += bfhi(w1.z); acc[14] += bflo(w1.w); acc[15] += bfhi(w1.w); } }
        f32x4* op = (f32x4*)(a.out + (size_t)m * DM + lane * 16); const f32x4* gp = (const f32x4*)(mod + (size_t)b * 6144 + 5120 + lane * 16);
#pragma unroll
        for (int q = 0; q < 4; ++q) { const f32x4 g = gp[q]; f32x4 o = op[q]; o.x += g.x * acc[4 * q]; o.y += g.y * acc[4 * q + 1]; o.z += g.z * acc[4 * q + 2]; o.w += g.w * acc[4 * q + 3]; op[q] = o; }
    }
}

constexpr size_t WS_CTL = 0;
constexpr int CTL_ZERO_BYTES = 65536;
#define XB_TMO      128
#define XB_XCNT(j)  (256  + 64 * (j))
#define XB_XSUB(j)  (1280 + 64 * (j))
#define XB_XGEN(j)  (2304 + 64 * (j))
#define XB_TOP      3328
#define XB_TOPGEN   3392
#define XB_SPIN_CAP (1u << 18)
DI unsigned xb_ld(unsigned* p)              { return __hip_atomic_load(p, __ATOMIC_RELAXED, __HIP_MEMORY_SCOPE_AGENT); }
DI unsigned xb_add(unsigned* p, unsigned v) { return __hip_atomic_fetch_add(p, v, __ATOMIC_RELAXED, __HIP_MEMORY_SCOPE_AGENT); }
DI unsigned xb_xcc_id() { return (unsigned)__builtin_amdgcn_s_getreg((3 << 11) | 20) & 0xFu; }
#define XB_SPIN(cond, bar) do { unsigned _sp = 0; while (cond) { __builtin_amdgcn_s_sleep(1); \
    if ((++_sp & 255u) == 0u) { if (xb_ld(&(bar)[XB_TMO])) break; if (_sp > XB_SPIN_CAP) { atomicAdd(&(bar)[XB_TMO], 1u); break; } } } } while (0)
struct XcdBarrier { unsigned* bar; unsigned x; volatile LAS unsigned* st; };
DI XcdBarrier xcd_barrier_post(unsigned* bar, volatile LAS unsigned* st) {
    XcdBarrier b; b.bar = bar; b.x = xb_xcc_id(); b.st = st;
    if (threadIdx.x == 0) (void)xb_add(&bar[XB_XCNT(b.x)], 1u);
    return b;
}
DI void xcd_barrier_complete(unsigned* bar, unsigned x, unsigned& nloc, unsigned& nx) {
    const unsigned G = gridDim.x * gridDim.y * gridDim.z;
    unsigned sum, cnt, mine, sp = 0u;
    for (;;) {
        sum = 0u; cnt = 0u; mine = 0u;
#pragma unroll
        for (unsigned j = 0; j < 16; ++j) { const unsigned c = xb_ld(&bar[XB_XCNT(j)]); sum += c; cnt += (c > 0u) ? 1u : 0u; mine = (j == x) ? c : mine; }
        if (sum == G) break;
        __builtin_amdgcn_s_sleep(1);
        if ((++sp & 255u) == 0u) { if (xb_ld(&bar[XB_TMO])) break; if (sp > XB_SPIN_CAP) { atomicAdd(&bar[XB_TMO], 1u); break; } }
    }
    nloc = mine > 0u ? mine : 1u; nx = cnt > 0u ? cnt : 1u;
}
DI void xcd_barrier(const XcdBarrier& b) {
    asm volatile("s_waitcnt vmcnt(0)" ::: "memory");
    __syncthreads();
    if (threadIdx.x == 0) {
        unsigned* bar = b.bar;
        __builtin_amdgcn_s_waitcnt(0);
        unsigned nloc = b.st[0], nx = b.st[1];
        if (nloc == 0u) { xcd_barrier_complete(bar, b.x, nloc, nx); b.st[0] = nloc; b.st[1] = nx; }
        const unsigned old = xb_add(&bar[XB_XSUB(b.x)], 1u);
        const unsigned gen = old / nloc;
        if (old + 1u == (gen + 1u) * nloc) {
            __builtin_amdgcn_fence(__ATOMIC_RELEASE, "agent");
            asm volatile("s_waitcnt vmcnt(0)" ::: "memory");
            const unsigned og = xb_add(&bar[XB_TOP], 1u);
            const unsigned tg = og / nx;
            if (og + 1u == (tg + 1u) * nx) xb_add(&bar[XB_TOPGEN], 1u);
            else XB_SPIN(xb_ld(&bar[XB_TOPGEN]) == tg, bar);
            __builtin_amdgcn_fence(__ATOMIC_ACQUIRE, "agent");
            xb_add(&bar[XB_XGEN(b.x)], 1u);
            asm volatile("s_waitcnt vmcnt(0)" ::: "memory");
        } else {
            XB_SPIN(xb_ld(&bar[XB_XGEN(b.x)]) == gen, bar);
            __builtin_amdgcn_fence(__ATOMIC_ACQUIRE, "agent");
            asm volatile("s_waitcnt vmcnt(0)" ::: "memory");
        }
    }
    __syncthreads();
}

static_assert(sizeof(Args) == 22 * 8, "Args layout");
__global__ void __launch_bounds__(NTHR, 2) fwd_kernel(Args a_unused) {
    extern __shared__ __attribute__((aligned(16))) unsigned char lds_raw[];
    cg::grid_group grid = cg::this_grid();
    Ctx F; F.lds = (LAS unsigned char*)lds_raw; F.tid = threadIdx.x; F.lane = F.tid & 63; F.wave = __builtin_amdgcn_readfirstlane(F.tid >> 6); F.G = gridDim.x; F.bid = blockIdx.x;

    int lo, hi; { typedef __attribute__((address_space(4))) const volatile unsigned long long* kp_t; const unsigned long long ph = ((kp_t)__builtin_amdgcn_kernarg_segment_ptr())[21]; lo = (int)(unsigned)ph; hi = (int)(unsigned)(ph >> 32); }
#ifndef PHASE_MASK
#define PHASE_MASK 0xffff
#endif
#define IN(k) (((PHASE_MASK >> (k)) & 1) && lo <= (k) && (k) < hi)
    volatile LAS unsigned* bst = (volatile LAS unsigned*)(F.lds + LDS_BYTES - 64);
    if (F.tid < 2) bst[F.tid] = 0u;
    __syncthreads();
    XcdBarrier xbar;
    { const Args a0 = load_args(); xbar = xcd_barrier_post((unsigned*)(a0.ws + WS_CTL), bst); }
    volatile LAS unsigned long long* tsl = (volatile LAS unsigned long long*)(F.lds + LDS_BYTES - 256);
    if (PROBE_PHASE >= 0 && F.bid == 0 && F.tid == 0) tsl[0] = __builtin_amdgcn_s_memrealtime();
#define SEAM(k) do { if (IN(k) && IN((k) + 1)) { if ((k) == 0) grid.sync(); else xcd_barrier(xbar); } \
        if (PROBE_PHASE >= 0 && F.bid == 0 && F.tid == 0) tsl[(k) + 1] = __builtin_amdgcn_s_memrealtime(); } while (0)
    if (IN(0)) { const Args a = load_args();
#pragma unroll 1
        for (int rep = 0; rep < REP_P0; ++rep) p0_phase(F, a); }
    SEAM(0);
    if (IN(1)) { const Args a = load_args(); p1_phase(F, a); }
    SEAM(1);
    if (IN(2)) {
        const Args a = load_args();
        pg8::Gemm g{(const bf16_t*)a.out, (const bf16_t*)(a.ws + WS_WINT), MTOK, PS, DM, 1 << 30}; pg8::StaticOrder S; S.init(MTOK, PS, F.G, F.bid);
        pg8::EpiBf16 E{(bf16_t*)(a.ws + WS_PROJ), PS};
        pg8::gemm_phase<pg8::EpiBf16, true, true>(F.lds, g, S, E);
        gates_tasks(F, a);
    }
    SEAM(2);
    if (IN(3)) {
        const Args a = load_args();
        for (int t = F.bid; t < BATCH * 64; t += F.G) qk_tile_task(F, a, t);
        for (int t = F.bid * NWAVES + F.wave; t < MTOK / 8 * 2; t += F.G * NWAVES) conv_task(F, a, t);
        for (int t = F.bid; t < 64; t += F.G) mscal_task(F, a, t);
    }
    SEAM(3);
    if (IN(4)) {
        const Args a = load_args();
        {
#pragma unroll 1
            for (int rep = 0; rep < REP_MSEQ; ++rep)
#pragma unroll 1
            for (int it = F.bid; it < 256; it += F.G) { const int xcd_ = it & 7, j_ = it >> 3; mseq_item(F, a, xcd_ * 4 + (j_ >> 3), (j_ >> 2) & 1, j_ & 3); }
        }
        float lam, cshift;
        { const float p01 = wave_sum(a.lam_p[F.lane] * a.lam_p[64 + F.lane]), p23 = wave_sum(a.lam_p[128 + F.lane] * a.lam_p[192 + F.lane]);
          lam = __expf(p01) - __expf(p23) + 0.2f;
          const float gq = wave_max(fabsf(a.qk_g[F.lane])), gk = wave_max(fabsf(a.qk_g[64 + F.lane]));
          cshift = 8.f * gq * gk * 1.4426950408889634f * 1.02f; }
        const int xcd = F.bid & 7, j = F.bid >> 3;
#pragma unroll 1
        for (int rep = 0; rep < REP_ATT; ++rep)
        for (int i = 0; i * F.G < 1024; ++i) {
            int u;
            if (F.G == 256) u = (xcd * 4 + i) * 32 + j; else u = i * F.G + F.bid;
            if (u < 1024) attn_unit(F, a, u >> 7, (u >> 5) & 3, u & 31, lam, cshift);
        }
    }
    SEAM(4);
    if (IN(5)) { const Args a = load_args(); mcombine_phase(F, a); }
    SEAM(5);
    if (IN(6)) {
        const Args a = load_args();
        pg8::Gemm g{(const bf16_t*)(a.ws + WS_YMIX), (const bf16_t*)(a.ws + WS_WOUTT), MTOK, DM, DM, 1 << 30}; pg8::StaticOrder S; S.init(MTOK, DM, F.G, F.bid);
        pg8::EpiX1 E{a.x, (const float*)(a.ws + WS_MOD), a.out};
        pg8::gemm_phase<pg8::EpiX1, true, true>(F.lds, g, S, E);
    }
    SEAM(6);
    if (IN(7)) { const Args a = load_args();
#pragma unroll 1
        for (int rep = 0; rep < REP_P7; ++rep) p7_phase(F, a); }
    SEAM(7);
    if (IN(8)) { const Args a = load_args(); for (int t = F.bid; t < BATCH * NEXP; t += F.G) topk_task(F, a, t); }
    SEAM(8);
    if (IN(9)) {
        const Args a = load_args();
        pg8::Gemm g{(const bf16_t*)(a.ws + WS_XE), (const bf16_t*)(a.ws + WS_WGUT), NPAIR, 4096, DM, 16};
        pg8::StaticOrder S; S.init(NPAIR, 4096, F.G, F.bid);
        pg8::EpiGU E{a.ws + WS_HH};
#pragma unroll 1
        for (int rep = 0; rep < REP_UP; ++rep)
        pg8::gemm_phase<pg8::EpiGU, true, true, true>(F.lds, g, S, E);
    }
    SEAM(9);
    if (IN(10)) {
        const Args a = load_args();
        pg8::Gemm g{(const bf16_t*)(a.ws + WS_HH), (const bf16_t*)(a.ws + WS_WDT), NPAIR, DM, DFF, 16};
        pg8::StaticOrder S; S.init(NPAIR, DM, F.G, F.bid);
        pg8::EpiDown E{(bf16_t*)(a.ws + WS_Y), (const float*)(a.ws + WS_VALS)};
        pg8::gemm_phase<pg8::EpiDown, true, true, true>(F.lds, g, S, E);
    }
    SEAM(10);
    if (IN(11)) { const Args a = load_args(); final_phase(F, a); }
    if (PROBE_PHASE >= 0 && F.bid == 0 && F.tid == 0) {
        const unsigned long long t1 = __builtin_amdgcn_s_memrealtime();
        const unsigned long long d = (PROBE_PHASE == 11 ? t1 : tsl[PROBE_PHASE + 1]) - tsl[PROBE_PHASE];
        while (__builtin_amdgcn_s_memrealtime() - t1 < 3ull * d) __builtin_amdgcn_s_sleep(8);
    }
#undef IN
#undef SEAM
}

extern "C" void kernel_launch(void* const* d_in, const int* in_sizes, int n_in, void* d_out, int out_size, void* d_ws, size_t ws_size, hipStream_t stream) {
    static int grid_blocks = 0;
    if (!grid_blocks) {
        int dev = 0, cus = 0, per_cu = 0;
        (void)hipGetDevice(&dev);
        (void)hipDeviceGetAttribute(&cus, hipDeviceAttributeMultiprocessorCount, dev);
        (void)hipFuncSetAttribute((const void*)fwd_kernel, hipFuncAttributeMaxDynamicSharedMemorySize, LDS_BYTES);
        (void)hipOccupancyMaxActiveBlocksPerMultiprocessor(&per_cu, (const void*)fwd_kernel, NTHR, LDS_BYTES);
        if (per_cu < 1) per_cu = 1;
        grid_blocks = cus;
        if (ws_size < WS_END) fprintf(stderr, "kernel_launch: workspace too small: %zu < %zu\n", ws_size, (size_t)WS_END);
    }
    (void)hipMemsetAsync((char*)d_ws + WS_CTL, 0, CTL_ZERO_BYTES, stream);
    Args a{};
    a.x = (const float*)d_in[0]; a.c = (const float*)d_in[1]; a.pos = (const int*)d_in[2]; a.norm1_g = (const float*)d_in[3]; a.norm2_g = (const float*)d_in[4];
    a.w_ada = (const float*)d_in[5]; a.b_ada = (const float*)d_in[6]; a.w_in = (const float*)d_in[7]; a.conv_w = (const float*)d_in[8]; a.gate_b = (const float*)d_in[9];
    a.mnorm_g = (const float*)d_in[10]; a.qk_g = (const float*)d_in[11]; a.lam_p = (const float*)d_in[12]; a.subln_g = (const float*)d_in[13]; a.w_out = (const float*)d_in[14];
    a.w_router = (const float*)d_in[15]; a.w_gate = (const float*)d_in[16]; a.w_up = (const float*)d_in[17]; a.w_down = (const float*)d_in[18];
    a.out = (float*)d_out; a.ws = (unsigned char*)d_ws; a.ph_lo = 0; a.ph_hi = 12;
    void* args[] = {&a};
    hipError_t e = hipLaunchCooperativeKernel((const void*)fwd_kernel, dim3(grid_blocks), dim3(NTHR), args, LDS_BYTES, stream);
    if (e != hipSuccess) fprintf(stderr, "cooperative launch failed: %s (grid %d)\n", hipGetErrorString(e), grid_blocks);
}
```

```cpp
#include <hip/hip_runtime.h>
#include <hip/hip_cooperative_groups.h>
#include <cstdio>
#include <cstdint>
namespace cg = cooperative_groups;

#define LAS __attribute__((address_space(3)))
#define DI __device__ __forceinline__
typedef unsigned short bf16_t;
typedef short bf16x8 __attribute__((ext_vector_type(8)));
typedef short s16x4 __attribute__((ext_vector_type(4)));
typedef float f32x2 __attribute__((ext_vector_type(2)));
typedef float f32x4 __attribute__((ext_vector_type(4)));
typedef float f32x16 __attribute__((ext_vector_type(16)));
typedef unsigned u32x2 __attribute__((ext_vector_type(2)));
typedef unsigned u32x4 __attribute__((ext_vector_type(4)));
typedef __bf16 bf16x2_t __attribute__((ext_vector_type(2)));

constexpr int BATCH = 8, SEQ = 4096, DM = 1024, MTOK = BATCH * SEQ;
constexpr int DIN = 3600, PS = 3584;
constexpr int NEXP = 16, CAP = 512, DFF = 2048;
constexpr int NPAIR = BATCH * NEXP * CAP;
constexpr float EPS = 1e-6f;
constexpr int C_QM = 0, C_KM = 512, C_VM = 1024, C_OM = 1536, C_QA = 2048, C_KA = 2560, C_VA = 3072;

constexpr size_t MiB = 1u << 20;
constexpr size_t WS_MOD = 1 * MiB;
constexpr size_t WS_GATES = 2 * MiB;
constexpr size_t WS_AFF = 4 * MiB;
constexpr size_t WS_IDX = 6 * MiB;
constexpr size_t WS_VALS = 6 * MiB + 256 * 1024;
constexpr size_t WS_MSC = 6 * MiB + 512 * 1024;
constexpr size_t WS_SLOT = 7 * MiB;
constexpr size_t WS_NLOC = 9 * MiB;
constexpr size_t WS_WINT = 11 * MiB;
constexpr size_t WS_WGT = 18 * MiB;
constexpr size_t WS_WOUTT = 19 * MiB;
constexpr size_t WS_WGUT = 21 * MiB;
constexpr size_t WS_WDT = 85 * MiB;
constexpr size_t WS_Y = 117 * MiB;
constexpr size_t WS_PROJ = 213 * MiB;
constexpr size_t WS_YMIX = 437 * MiB;
constexpr size_t WS_KIMG = 437 * MiB;
constexpr size_t WS_VIMG = 469 * MiB;
constexpr size_t WS_YA = 501 * MiB;
constexpr size_t WS_HH = 245 * MiB;
constexpr size_t WS_H2 = 437 * MiB;
constexpr size_t WS_XE = 469 * MiB;
constexpr size_t WS_END = 533 * MiB;

constexpr int LDS_BYTES = 147456;
constexpr int PROBE_MSEQ_W = -1;
constexpr int PROBE_PHASE = -1;
constexpr int REP_M1 = 1, REP_M3 = 1, REP_UP = 1, REP_P0 = 1, REP_SCAN = 1, REP_P7 = 1, REP_ATT = 1, REP_QKT = 1, REP_MSEQ = 1;
constexpr int NWAVES = 8, NTHR = 512;

DI unsigned pk2(float lo, float hi) { f32x2 v = {lo, hi}; bf16x2_t b = __builtin_convertvector(v, bf16x2_t); return __builtin_bit_cast(unsigned, b); }
DI float bflo(unsigned w) { return __uint_as_float(w << 16); }
DI float bfhi(unsigned w) { return __uint_as_float(w & 0xffff0000u); }
DI float bf2f(bf16_t v) { return __uint_as_float((unsigned)v << 16); }
template <int CTRL> DI float dpp_mov(float x) { return __builtin_bit_cast(float, __builtin_amdgcn_update_dpp(0, __builtin_bit_cast(int, x), CTRL, 0xf, 0xf, false)); }
#define DPP_XOR1 0xB1
#define DPP_XOR2 0x4E
#define DPP_ROR(n) (0x120 + (n))
DI float xor16_sum(float x) { const unsigned u = __builtin_bit_cast(unsigned, x); auto r = __builtin_amdgcn_permlane16_swap(u, u, false, false); return __builtin_bit_cast(float, (unsigned)r[0]) + __builtin_bit_cast(float, (unsigned)r[1]); }
DI float xor32_sum(float x) { const unsigned u = __builtin_bit_cast(unsigned, x); auto r = __builtin_amdgcn_permlane32_swap(u, u, false, false); return __builtin_bit_cast(float, (unsigned)r[0]) + __builtin_bit_cast(float, (unsigned)r[1]); }
DI float xor16_max(float x) { const unsigned u = __builtin_bit_cast(unsigned, x); auto r = __builtin_amdgcn_permlane16_swap(u, u, false, false); return fmaxf(__builtin_bit_cast(float, (unsigned)r[0]), __builtin_bit_cast(float, (unsigned)r[1])); }
DI float xor32_max(float x) { const unsigned u = __builtin_bit_cast(unsigned, x); auto r = __builtin_amdgcn_permlane32_swap(u, u, false, false); return fmaxf(__builtin_bit_cast(float, (unsigned)r[0]), __builtin_bit_cast(float, (unsigned)r[1])); }
DI float partner32(float x, int lane) { const unsigned u = __builtin_bit_cast(unsigned, x); auto r = __builtin_amdgcn_permlane32_swap(u, u, false, false); return __builtin_bit_cast(float, (unsigned)((lane & 32) ? r[0] : r[1])); }
DI float partner16(float x, int lane) { const unsigned u = __builtin_bit_cast(unsigned, x); auto r = __builtin_amdgcn_permlane16_swap(u, u, false, false); return __builtin_bit_cast(float, (unsigned)((lane & 16) ? r[0] : r[1])); }
DI float partner8(float x) { return dpp_mov<DPP_ROR(8)>(x); }
DI float partner4(float x, int lane) { const float a = dpp_mov<DPP_ROR(4)>(x), b = dpp_mov<DPP_ROR(12)>(x); return (lane & 4) ? a : b; }
DI float row_sum16(float v) { v += dpp_mov<DPP_XOR1>(v); v += dpp_mov<DPP_XOR2>(v); v += dpp_mov<DPP_ROR(4)>(v); v += dpp_mov<DPP_ROR(8)>(v); return v; }
DI float wave_sum(float v) { v = row_sum16(v); v = xor16_sum(v); return xor32_sum(v); }
DI float wave_max(float v) { v = fmaxf(v, dpp_mov<DPP_XOR1>(v)); v = fmaxf(v, dpp_mov<DPP_XOR2>(v)); v = fmaxf(v, dpp_mov<DPP_ROR(4)>(v)); v = fmaxf(v, dpp_mov<DPP_ROR(8)>(v)); v = xor16_max(v); return xor32_max(v); }
DI float sigmoid_f(float v) { return __builtin_amdgcn_rcpf(1.f + __builtin_amdgcn_exp2f(-1.4426950408889634f * v)); }
DI float silu_f(float v) { return v * sigmoid_f(v); }
DI float logsigmoid_f(float f) { return fminf(f, 0.f) - log1pf(__expf(-fabsf(f))); }
DI int swz16(int row) { return ((row & 3) << 2) | ((row >> 2) & 3); }
#define MFMA32(a, b, c) __builtin_amdgcn_mfma_f32_32x32x16_bf16((a), (b), (c), 0, 0, 0)
DI s16x4 trread(const LAS unsigned char* p) { return __builtin_bit_cast(s16x4, __builtin_amdgcn_ds_read_tr16_b64_v4i16((LAS s16x4*)p)); }
DI int crow(int r, int hh) { return (r & 3) + 8 * (r >> 2) + 4 * hh; }
DI bool hh_sel(int lane, int bit) { return (lane & bit) != 0; }

namespace pg8 {
constexpr int BM = 256, BK = 64, HALF = 128, HTB = HALF * BK * 2, STAGE_BYTES = 8 * HTB, NXCD = 8, WGM = 8;
DI int lds_byte(int r, int c) { const int st = (r >> 4) * 2 + (c >> 5), rr = r & 15, cc = c & 31, ob = rr * 64 + cc * 2; return st * 1024 + (ob ^ (((ob >> 9) & 1) << 5)); }
DI void stage_rc(int b, int& R, int& C) { const int st = b / 1024, sb = b % 1024, swz = sb ^ (((sb >> 9) & 1) << 5); R = (st >> 1) * 16 + swz / 64; C = (st & 1) * 32 + (swz % 64) / 2; }
DI int perm32(int rho) { const int n = rho >> 4, i = rho & 15; return 8 * (i >> 2) + 4 * n + (i & 3); }
struct Unit { int pm, pn; };
typedef int i32x4_t __attribute__((ext_vector_type(4)));
typedef int i32x8_t __attribute__((ext_vector_type(8)));
DI i32x8_t cat8(bf16x8 lo, bf16x8 hi) { const i32x4_t a = __builtin_bit_cast(i32x4_t, lo), b = __builtin_bit_cast(i32x4_t, hi); return __builtin_shufflevector(a, b, 0, 1, 2, 3, 4, 5, 6, 7); }
struct Gemm { const bf16_t* A; const bf16_t* Bt; int M, N, K, tpg; };
struct StaticOrder {
    int nM, nN, nwg, G, c;
    DI void init(int M, int N, int G_, int c_) { nM = M / BM; nN = N / BM; nwg = nM * nN; G = G_; c = c_; }
    DI bool next(int i, Unit& u) const {
        const long L = (long)i * G + c; if (L >= nwg) return false;
        int wgid = (int)L; { const int q = nwg / NXCD, r = nwg % NXCD, xcd = wgid % NXCD, off = wgid / NXCD; wgid = (xcd < r ? xcd * (q + 1) : r * (q + 1) + (xcd - r) * q) + off; }
        const int nig = WGM * nN, gid = wgid / nig, fm = gid * WGM, gsz = (nM - fm) < WGM ? (nM - fm) : WGM;
        u.pm = fm + ((wgid % nig) % gsz); u.pn = (wgid % nig) / gsz; return true;
    }
};

template <class Epi, bool ALIGN_EPI, bool SP2, bool FP8 = false>
DI void gemm_phase(LAS unsigned char* lds, const Gemm g, const StaticOrder& S, const Epi& E) {
    const int tid = threadIdx.x, wid = __builtin_amdgcn_readfirstlane(tid >> 6), lane = tid & 63, wr = wid >> 2, wc = wid & 3, fr = lane & 15, fq = lane >> 4;
    const int KB = FP8 ? g.K : 2 * g.K, nt = KB / (BK * 2);
    unsigned voffA[2], voffB[2];
#pragma unroll
    for (int i = 0; i < 2; ++i) { int R, C; stage_rc(tid * 16 + i * 8192, R, C); const int Rb = Epi::PERM ? ((R & ~31) + perm32(R & 31)) : R;
        voffA[i] = (unsigned)(R * KB + C * 2); voffB[i] = (unsigned)(Rb * KB + C * 2); }
    const size_t kstep = (size_t)(BK * 2);
    const size_t hstep = (size_t)HALF * KB;
    const size_t tstep = 2 * hstep;
    const size_t gstep = (size_t)g.N * KB;
    const unsigned ldsw = (unsigned)wid * 1024u;
    const int aoff = lds_byte(wr * 64 + fr, fq * 8), boff = lds_byte(wc * 32 + fr, fq * 8);
#define PG8_SA(b, h) (((b) * 2 + (h)) * HTB)
#define PG8_SB(b, h) ((4 + (b) * 2 + (h)) * HTB)
#define PG8_STAGE(bufoff, gbase, voff) do { _Pragma("unroll") for (int _i = 0; _i < 2; ++_i) \
        __builtin_amdgcn_global_load_lds((const unsigned*)((const char*)(gbase) + (voff)[_i]), (LAS unsigned*)(lds + (bufoff) + ldsw + _i * 8192), 16, 0, 0); } while (0)
#define PG8_LDA(dst, b, h) do { if constexpr (FP8) { _Pragma("unroll") for (int m = 0; m < 4; ++m) dst##8[m] = cat8(*(const LAS bf16x8*)(lds + PG8_SA(b, h) + aoff + m * 2048), *(const LAS bf16x8*)(lds + PG8_SA(b, h) + aoff + m * 2048 + 1024)); } \
        else { _Pragma("unroll") for (int m = 0; m < 4; ++m) _Pragma("unroll") for (int k = 0; k < 2; ++k) dst[m][k] = *(const LAS bf16x8*)(lds + PG8_SA(b, h) + aoff + m * 2048 + k * 1024); } } while (0)
#define PG8_LDB(dst, b, h) do { if constexpr (FP8) { _Pragma("unroll") for (int n = 0; n < 2; ++n) dst##8[n] = cat8(*(const LAS bf16x8*)(lds + PG8_SB(b, h) + boff + n * 2048), *(const LAS bf16x8*)(lds + PG8_SB(b, h) + boff + n * 2048 + 1024)); } \
        else { _Pragma("unroll") for (int n = 0; n < 2; ++n) _Pragma("unroll") for (int k = 0; k < 2; ++k) dst[n][k] = *(const LAS bf16x8*)(lds + PG8_SB(b, h) + boff + n * 2048 + k * 1024); } } while (0)
#define PG8_MMA(ai, bj, At, Bt) do { __builtin_amdgcn_s_setprio(1); \
        if constexpr (FP8) { _Pragma("unroll") for (int m = 0; m < 4; ++m) _Pragma("unroll") for (int n = 0; n < 2; ++n) \
            asm volatile("s_nop 1\n\tv_mfma_f32_16x16x128_f8f6f4 %0, %1, %2, %0" : "+v"(acc[ai][bj][m][n]) : "v"(Bt##8[n]), "v"(At##8[m])); } \
        else { _Pragma("unroll") for (int m = 0; m < 4; ++m) _Pragma("unroll") for (int n = 0; n < 2; ++n) _Pragma("unroll") for (int k = 0; k < 2; ++k) \
            acc[ai][bj][m][n] = __builtin_amdgcn_mfma_f32_16x16x32_bf16(Bt[n][k], At[m][k], acc[ai][bj][m][n], 0, 0, 0); } \
        __builtin_amdgcn_s_setprio(0); } while (0)
#define PG8_WAIT_V(n) asm volatile("s_waitcnt vmcnt(" #n ")" ::: "memory")
#define PG8_WAIT_L(n) asm volatile("s_waitcnt lgkmcnt(" #n ")" ::: "memory")
#define PG8_BAR __builtin_amdgcn_s_barrier()
#define PG8_SCHED __builtin_amdgcn_sched_barrier(0)
    Unit cur, nxt; int ui = 0;
    if (!S.next(0, cur)) return;
    f32x4 acc[2][2][4][2];
#pragma unroll
    for (int a = 0; a < 2; ++a)
#pragma unroll
        for (int b = 0; b < 2; ++b)
#pragma unroll
            for (int m = 0; m < 4; ++m)
#pragma unroll
                for (int n = 0; n < 2; ++n) acc[a][b][m][n] = (f32x4){0.f, 0.f, 0.f, 0.f};
    bf16x8 At[4][2], B0[2][2], B1[2][2]; i32x8_t At8[4], B08[2], B18[2];
    const char* cA = (const char*)g.A + (size_t)cur.pm * tstep; const char* cB = (const char*)g.Bt + (size_t)(cur.pm / g.tpg) * gstep + (size_t)cur.pn * tstep;
    if constexpr (SP2) {
        PG8_STAGE(PG8_SB(0, 0), cB, voffB); PG8_STAGE(PG8_SB(0, 1), cB + hstep, voffB); PG8_STAGE(PG8_SA(0, 0), cA, voffA); PG8_STAGE(PG8_SA(0, 1), cA + hstep, voffA);
        if (wr == 1) PG8_BAR;
        PG8_WAIT_V(2); PG8_BAR;
        PG8_STAGE(PG8_SB(1, 0), cB + kstep, voffB); PG8_STAGE(PG8_SA(1, 0), cA + kstep, voffA); PG8_STAGE(PG8_SB(1, 1), cB + hstep + kstep, voffB);
        PG8_WAIT_V(6); PG8_BAR;
    } else {
        PG8_STAGE(PG8_SB(0, 0), cB, voffB); PG8_STAGE(PG8_SA(0, 0), cA, voffA); PG8_STAGE(PG8_SB(0, 1), cB + hstep, voffB); PG8_STAGE(PG8_SA(0, 1), cA + hstep, voffA);
        if (wr == 1) PG8_BAR;
        PG8_WAIT_V(4); PG8_BAR;
        PG8_STAGE(PG8_SB(1, 0), cB + kstep, voffB); PG8_STAGE(PG8_SA(1, 0), cA + kstep, voffA); PG8_STAGE(PG8_SB(1, 1), cB + hstep + kstep, voffB);
        PG8_WAIT_V(6); PG8_BAR;
    }
    for (;;) {
        const bool has_next = S.next(ui + 1, nxt);
        const char* nA = has_next ? (const char*)g.A + (size_t)nxt.pm * tstep : cA;
        const char* nB = has_next ? (const char*)g.Bt + (size_t)(nxt.pm / g.tpg) * gstep + (size_t)nxt.pn * tstep : cB;
        for (int t = 0; t < nt; t += 2) {
            const bool last = (t == nt - 2);
            const char* a1 = cA + (size_t)(t + 1) * kstep;
            const char* a2 = last ? nA : cA + (size_t)(t + 2) * kstep; const char* b2 = last ? nB : cB + (size_t)(t + 2) * kstep;
            const char* a3 = a2 + kstep; const char* b3 = b2 + kstep;
            if constexpr (SP2) {
            PG8_LDB(B0, 0, 0); PG8_LDB(B1, 0, 1); PG8_SCHED; PG8_LDA(At, 0, 0); PG8_STAGE(PG8_SA(1, 1), a1 + hstep, voffA);
            PG8_WAIT_V(8); PG8_WAIT_L(0); PG8_BAR; PG8_MMA(0, 0, At, B0); PG8_MMA(0, 1, At, B1); PG8_BAR; PG8_SCHED;
            PG8_LDA(At, 0, 1); PG8_STAGE(PG8_SB(0, 0), b2, voffB); PG8_STAGE(PG8_SB(0, 1), b2 + hstep, voffB); PG8_STAGE(PG8_SA(0, 0), a2, voffA);
            PG8_WAIT_V(8); PG8_WAIT_L(0); PG8_BAR; PG8_MMA(1, 0, At, B0); PG8_MMA(1, 1, At, B1); PG8_BAR; PG8_SCHED;
            PG8_LDB(B0, 1, 0); PG8_LDB(B1, 1, 1); PG8_SCHED; PG8_LDA(At, 1, 0); PG8_STAGE(PG8_SA(0, 1), a2 + hstep, voffA);
            PG8_WAIT_V(8); PG8_WAIT_L(0); PG8_BAR; PG8_MMA(0, 0, At, B0); PG8_MMA(0, 1, At, B1); PG8_BAR; PG8_SCHED;
            PG8_LDA(At, 1, 1); PG8_STAGE(PG8_SB(1, 0), b3, voffB); PG8_STAGE(PG8_SB(1, 1), b3 + hstep, voffB); PG8_STAGE(PG8_SA(1, 0), a3, voffA);
            PG8_WAIT_V(8); PG8_WAIT_L(0); PG8_BAR; PG8_MMA(1, 0, At, B0); PG8_MMA(1, 1, At, B1); PG8_BAR; PG8_SCHED;
            } else {
            PG8_LDB(B0, 0, 0); PG8_SCHED; PG8_LDA(At, 0, 0); PG8_STAGE(PG8_SA(1, 1), a1 + hstep, voffA);
            PG8_WAIT_L(8); PG8_BAR; PG8_WAIT_L(0); PG8_MMA(0, 0, At, B0); PG8_BAR; PG8_SCHED;
            PG8_LDB(B1, 0, 1); PG8_STAGE(PG8_SB(0, 0), b2, voffB);
            PG8_BAR; PG8_WAIT_L(0); PG8_MMA(0, 1, At, B1); PG8_BAR;
            PG8_LDA(At, 0, 1); PG8_STAGE(PG8_SA(0, 0), a2, voffA);
            PG8_BAR; PG8_WAIT_L(0); PG8_MMA(1, 0, At, B0); PG8_BAR; PG8_SCHED;
            PG8_STAGE(PG8_SB(0, 1), b2 + hstep, voffB);
            PG8_WAIT_V(6); PG8_BAR; PG8_MMA(1, 1, At, B1); PG8_BAR;
            PG8_LDB(B0, 1, 0); PG8_SCHED; PG8_LDA(At, 1, 0); PG8_STAGE(PG8_SA(0, 1), a2 + hstep, voffA);
            PG8_WAIT_L(8); PG8_BAR; PG8_WAIT_L(0); PG8_MMA(0, 0, At, B0); PG8_BAR; PG8_SCHED;
            PG8_LDB(B1, 1, 1); PG8_STAGE(PG8_SB(1, 0), b3, voffB);
            PG8_BAR; PG8_WAIT_L(0); PG8_MMA(0, 1, At, B1); PG8_BAR;
            PG8_LDA(At, 1, 1); PG8_STAGE(PG8_SA(1, 0), a3, voffA);
            PG8_BAR; PG8_WAIT_L(0); PG8_MMA(1, 0, At, B0); PG8_BAR; PG8_SCHED;
            PG8_STAGE(PG8_SB(1, 1), b3 + hstep, voffB);
            PG8_WAIT_V(6); PG8_BAR; PG8_MMA(1, 1, At, B1); PG8_BAR;
            }
        }
        if constexpr (ALIGN_EPI) { if (wr == 0) PG8_BAR; }
        if constexpr (FP8) asm volatile("s_nop 15\n\ts_nop 7" ::: "memory");
        E(acc, cur, wr, wc, fr, fq);
        if (!has_next) break;
#pragma unroll
        for (int a = 0; a < 2; ++a)
#pragma unroll
            for (int b = 0; b < 2; ++b)
#pragma unroll
                for (int m = 0; m < 4; ++m)
#pragma unroll
                    for (int n = 0; n < 2; ++n) acc[a][b][m][n] = (f32x4){0.f, 0.f, 0.f, 0.f};
        cur = nxt; cA = nA; cB = nB; ++ui;
        if constexpr (ALIGN_EPI) { if (wr == 1) PG8_BAR; }
    }
    PG8_WAIT_V(0);
    if constexpr (!ALIGN_EPI) { if (wr == 0) PG8_BAR; }
    PG8_BAR;
#undef PG8_SA
#undef PG8_SB
#undef PG8_STAGE
#undef PG8_LDA
#undef PG8_LDB
#undef PG8_MMA
#undef PG8_WAIT_V
#undef PG8_WAIT_L
#undef PG8_BAR
#undef PG8_SCHED
}

struct EpiBf16 {
    static constexpr bool PERM = true;
    bf16_t* O; int ldc;
    DI void operator()(const f32x4 (&acc)[2][2][4][2], const Unit& u, int wr, int wc, int fr, int fq) const {
        const int row0 = u.pm * BM + wr * 64 + fr, col0 = u.pn * BM + wc * 32 + 8 * fq;
#pragma unroll
        for (int ai = 0; ai < 2; ++ai)
#pragma unroll
            for (int m = 0; m < 4; ++m) { bf16_t* rowp = O + (size_t)(row0 + ai * HALF + m * 16) * ldc + col0;
#pragma unroll
                for (int bj = 0; bj < 2; ++bj) { const f32x4 v0 = acc[ai][bj][m][0], v1 = acc[ai][bj][m][1];
                    u32x4 w; w.x = pk2(v0[0], v0[1]); w.y = pk2(v0[2], v0[3]); w.z = pk2(v1[0], v1[1]); w.w = pk2(v1[2], v1[3]);
                    *(u32x4*)(rowp + bj * HALF) = w; } }
    }
};
struct EpiX1 {
    static constexpr bool PERM = false;
    const float* x; const float* mod; float* out;
    DI void operator()(const f32x4 (&acc)[2][2][4][2], const Unit& u, int wr, int wc, int fr, int fq) const {
        const int row0 = u.pm * BM + wr * 64 + fr, col0 = u.pn * BM + wc * 32 + 4 * fq;
        const int b = (u.pm * BM) / SEQ;
        const float* gp = mod + (size_t)b * 6144 + 2048 + col0;
#pragma unroll
        for (int bj = 0; bj < 2; ++bj)
#pragma unroll
            for (int n = 0; n < 2; ++n) { const f32x4 gv = *(const f32x4*)(gp + bj * HALF + n * 16);
#pragma unroll
                for (int ai = 0; ai < 2; ++ai)
#pragma unroll
                    for (int m = 0; m < 4; ++m) { const size_t off = (size_t)(row0 + ai * HALF + m * 16) * DM + col0 + bj * HALF + n * 16;
                        const f32x4 xv = *(const f32x4*)(x + off); *(f32x4*)(out + off) = xv + gv * acc[ai][bj][m][n]; } }
    }
};
DI unsigned pk4_fp8(float a, float b, float c, float d) { int w = __builtin_amdgcn_cvt_pk_fp8_f32(a, b, 0, false); w = __builtin_amdgcn_cvt_pk_fp8_f32(c, d, w, true); return (unsigned)w; }
constexpr float W_PRESCALE = 32.f, H_PRESCALE = 8.f;
struct EpiGU {
    static constexpr bool PERM = true;
    unsigned char* H;
    DI void operator()(const f32x4 (&acc)[2][2][4][2], const Unit& u, int wr, int wc, int fr, int fq) const {
        const int row0 = u.pm * BM + wr * 64 + fr, col0 = u.pn * HALF + wc * 32 + 8 * fq;
#pragma unroll
        for (int ai = 0; ai < 2; ++ai)
#pragma unroll
            for (int m = 0; m < 4; ++m) { unsigned char* rowp = H + (size_t)(row0 + ai * HALF + m * 16) * DFF + col0;
                float hv[8];
#pragma unroll
                for (int n = 0; n < 2; ++n)
#pragma unroll
                    for (int j = 0; j < 4; ++j) { const float gg = acc[ai][0][m][n][j] * (1.f / W_PRESCALE), uu = acc[ai][1][m][n][j] * (H_PRESCALE / W_PRESCALE); hv[n * 4 + j] = gg * __builtin_amdgcn_rcpf(1.f + __builtin_amdgcn_exp2f(-1.4426950408889634f * gg)) * uu; }
                u32x2 w; w.x = pk4_fp8(hv[0], hv[1], hv[2], hv[3]); w.y = pk4_fp8(hv[4], hv[5], hv[6], hv[7]);
                *(u32x2*)rowp = w; }
    }
};
struct EpiDown {
    static constexpr bool PERM = true;
    bf16_t* Y; const float* vals;
    DI void operator()(const f32x4 (&acc)[2][2][4][2], const Unit& u, int wr, int wc, int fr, int fq) const {
        const int row0 = u.pm * BM + wr * 64 + fr, col0 = u.pn * BM + wc * 32 + 8 * fq;
#pragma unroll
        for (int ai = 0; ai < 2; ++ai)
#pragma unroll
            for (int m = 0; m < 4; ++m) { const int row = row0 + ai * HALF + m * 16; const float s = vals[row] * (1.f / (W_PRESCALE * H_PRESCALE)); bf16_t* rowp = Y + (size_t)row * DM + col0;
#pragma unroll
                for (int bj = 0; bj < 2; ++bj) { const f32x4 v0 = acc[ai][bj][m][0] * s, v1 = acc[ai][bj][m][1] * s;
                    u32x4 w; w.x = pk2(v0[0], v0[1]); w.y = pk2(v0[2], v0[3]); w.z = pk2(v1[0], v1[1]); w.w = pk2(v1[2], v1[3]);
                    *(u32x4*)(rowp + bj * HALF) = w; } }
    }
};
}

struct Args {
    const float* x; const float* c; const int* pos; const float* norm1_g; const float* norm2_g; const float* w_ada; const float* b_ada;
    const float* w_in; const float* conv_w; const float* gate_b; const float* mnorm_g; const float* qk_g; const float* lam_p; const float* subln_g;
    const float* w_out; const float* w_router; const float* w_gate; const float* w_up; const float* w_down;
    float* out; unsigned char* ws; int ph_lo, ph_hi;
};
struct Ctx {
    LAS unsigned char* lds; int tid, lane, wave, G, bid;
};
DI Args load_args() {
    typedef __attribute__((address_space(4))) const volatile unsigned long long* kp_t;
    kp_t kp = (kp_t)__builtin_amdgcn_kernarg_segment_ptr();
#define GP(T, i) ((T*)(__attribute__((address_space(1))) T*)kp[i])
    Args a;
    a.x = GP(const float, 0); a.c = GP(const float, 1); a.pos = GP(const int, 2); a.norm1_g = GP(const float, 3); a.norm2_g = GP(const float, 4);
    a.w_ada = GP(const float, 5); a.b_ada = GP(const float, 6); a.w_in = GP(const float, 7); a.conv_w = GP(const float, 8); a.gate_b = GP(const float, 9);
    a.mnorm_g = GP(const float, 10); a.qk_g = GP(const float, 11); a.lam_p = GP(const float, 12); a.subln_g = GP(const float, 13); a.w_out = GP(const float, 14);
    a.w_router = GP(const float, 15); a.w_gate = GP(const float, 16); a.w_up = GP(const float, 17); a.w_down = GP(const float, 18);
    a.out = GP(float, 19); a.ws = GP(unsigned char, 20);
#undef GP
    a.ph_lo = 0; a.ph_hi = 12;
    return a;
}

DI void tr_item64(const float* src, size_t ld_src, int k0, int c0, bf16_t* dst, size_t r0, int ld_dst, LAS float* scr  , int lane) {
    const float* sp = src + (size_t)(k0 + (lane >> 4)) * ld_src + c0 + (lane & 15) * 4;
#pragma unroll 1
    for (int hf = 0; hf < 2; ++hf) {
        f32x4 v[8];
#pragma unroll
        for (int i = 0; i < 8; ++i) v[i] = *(const f32x4*)(sp + (size_t)(4 * (8 * hf + i)) * ld_src);
#pragma unroll
        for (int i = 0; i < 8; ++i) *(LAS f32x4*)(scr + (4 * (8 * hf + i) + (lane >> 4)) * 68 + (lane & 15) * 4) = v[i];
    }
    asm volatile("s_waitcnt lgkmcnt(0)" ::: "memory");
    const int c = lane & 7;
#pragma unroll
    for (int q = 0; q < 8; ++q) { const int n = 8 * q + (lane >> 3); const LAS float* s = scr + (8 * c) * 68 + n;
        u32x4 o; o.x = pk2(s[0 * 68], s[1 * 68]); o.y = pk2(s[2 * 68], s[3 * 68]); o.z = pk2(s[4 * 68], s[5 * 68]); o.w = pk2(s[6 * 68], s[7 * 68]);
        *(u32x4*)(dst + (r0 + n) * ld_dst + k0 + 8 * c) = o; }
    asm volatile("s_waitcnt lgkmcnt(0)" ::: "memory");
}
DI void tr_item64_fp8(const float* src, size_t ld_src, int k0, int c0, unsigned char* dst, size_t r0, int ld_dst, float scale, LAS float* scr  , int lane) {
    const float* sp = src + (size_t)(k0 + (lane >> 4)) * ld_src + c0 + (lane & 15) * 4;
    {
        f32x4 v[16];
#pragma unroll
        for (int i = 0; i < 16; ++i) v[i] = __builtin_nontemporal_load((const f32x4*)(sp + (size_t)(4 * i) * ld_src));
#pragma unroll
        for (int i = 0; i < 16; ++i) *(LAS f32x4*)(scr + (4 * i + (lane >> 4)) * 68 + (lane & 15) * 4) = v[i] * scale;
    }
    asm volatile("s_waitcnt lgkmcnt(0)" ::: "memory");
    const int c = lane & 3;
#pragma unroll
    for (int q = 0; q < 4; ++q) { const int n = 16 * q + (lane >> 2); const LAS float* s = scr + (16 * c) * 68 + n;
        u32x4 o; o.x = pg8::pk4_fp8(s[0 * 68], s[1 * 68], s[2 * 68], s[3 * 68]); o.y = pg8::pk4_fp8(s[4 * 68], s[5 * 68], s[6 * 68], s[7 * 68]);
        o.z = pg8::pk4_fp8(s[8 * 68], s[9 * 68], s[10 * 68], s[11 * 68]); o.w = pg8::pk4_fp8(s[12 * 68], s[13 * 68], s[14 * 68], s[15 * 68]);
        *(u32x4*)(dst + (r0 + n) * ld_dst + k0 + 16 * c) = o; }
    asm volatile("s_waitcnt lgkmcnt(0)" ::: "memory");
}
DI void p0_phase(const Ctx& F, const Args& a) {
    if (F.bid < 96) {
        LAS float* sc = (LAS float*)F.lds; LAS float* part = (LAS float*)(F.lds + 32768);
        for (int i = F.tid; i < BATCH * DM; i += NTHR) sc[i] = silu_f(a.c[i]);
        __syncthreads();
        const int col = F.bid * 64 + F.lane;
        float acc[8];
#pragma unroll
        for (int b = 0; b < 8; ++b) acc[b] = 0.f;
        const int kb = F.wave * 128;
#pragma unroll 1
        for (int k0 = kb; k0 < kb + 128; k0 += 16) {
            float w[16];
            const float* wp = a.w_ada + (size_t)k0 * 6144 + col;
#pragma unroll
            for (int j = 0; j < 16; ++j) w[j] = wp[(size_t)j * 6144];
#pragma unroll
            for (int j = 0; j < 16; ++j)
#pragma unroll
                for (int b = 0; b < 8; ++b) acc[b] += sc[b * DM + k0 + j] * w[j];
        }
#pragma unroll
        for (int b = 0; b < 8; ++b) part[(F.wave * 8 + b) * 64 + F.lane] = acc[b];
        __syncthreads();
        { const int b = F.tid >> 6, l = F.tid & 63; float s = a.b_ada[F.bid * 64 + l];
#pragma unroll
          for (int w = 0; w < 8; ++w) s += part[(w * 8 + b) * 64 + l];
          ((float*)(a.ws + WS_MOD))[b * 6144 + F.bid * 64 + l] = s; }
        __syncthreads();
    }
    LAS float* scr = (LAS float*)(F.lds + F.wave * 17408);
    const int gw = F.bid * NWAVES + F.wave, NGW = F.G * NWAVES;
    constexpr int I_IN = 16 * 56, I_OUT = 16 * 16, I_G = 16 * 16 * 32, I_D = 16 * 32 * 16, I_WG = 16;
    constexpr int NITEMS = I_IN + I_OUT + 2 * I_G + I_D + I_WG;
    bf16_t* WinT = (bf16_t*)(a.ws + WS_WINT); bf16_t* WgT = (bf16_t*)(a.ws + WS_WGT); bf16_t* WoutT = (bf16_t*)(a.ws + WS_WOUTT);
    unsigned char* WguT = a.ws + WS_WGUT; unsigned char* WdT = a.ws + WS_WDT;
    for (int it = gw; it < NITEMS; it += NGW) {
        int r = it;
        if (r < I_IN) { const int kb = r / 56, nb = r % 56, n0 = nb * 64; tr_item64(a.w_in, DIN, kb * 64, n0 + (n0 >= 2048 ? 16 : 0), WinT, n0, DM, scr, F.lane); continue; } r -= I_IN;
        if (r < I_OUT) { const int kb = r / 16, nb = r % 16; tr_item64(a.w_out, DM, kb * 64, nb * 64, WoutT, nb * 64, DM, scr, F.lane); continue; } r -= I_OUT;
        if (r < 2 * I_G) { const int up = r / I_G; r -= up * I_G; const int e = r / 512; r -= e * 512; const int kb = r / 32, nb = r % 32, n0 = nb * 64;
            const float* src = (up ? a.w_up : a.w_gate) + (size_t)e * DM * DFF;
            tr_item64_fp8(src, DFF, kb * 64, n0, WguT + (size_t)e * 4096 * DM, (size_t)(n0 / 128) * 256 + (n0 % 128) + up * 128, DM, pg8::W_PRESCALE, scr, F.lane); continue; } r -= 2 * I_G;
        if (r < I_D) { const int e = r / 512; r -= e * 512; const int kb = r / 16, nb = r % 16;
            tr_item64_fp8(a.w_down + (size_t)e * DFF * DM, DM, kb * 64, nb * 64, WdT + (size_t)e * DM * DFF, nb * 64, DFF, pg8::W_PRESCALE, scr, F.lane); continue; } r -= I_D;
        tr_item64(a.w_in, DIN, r * 64, 2048 - 48, WgT, 0, DM, scr, F.lane);
    }
}

DI void p1_phase(const Ctx& F, const Args& a) {
    const int gw = F.bid * NWAVES + F.wave, NGW = F.G * NWAVES;
    const float* mod = (const float*)(a.ws + WS_MOD);
    bf16_t* H1 = (bf16_t*)a.out;
    for (int m0 = gw; m0 < MTOK; m0 += 2 * NGW) {
        const int m1 = m0 + NGW; const bool has1 = m1 < MTOK;
        const f32x4* xr0 = (const f32x4*)(a.x + (size_t)m0 * DM) + F.lane; const f32x4* xr1 = (const f32x4*)(a.x + (size_t)(has1 ? m1 : m0) * DM) + F.lane;
        f32x4 v0[4], v1[4]; float s0 = 0.f, s1 = 0.f;
#pragma unroll
        for (int j = 0; j < 4; ++j) { v0[j] = __builtin_nontemporal_load(xr0 + 64 * j); v1[j] = __builtin_nontemporal_load(xr1 + 64 * j); }
#pragma unroll
        for (int j = 0; j < 4; ++j) { s0 += (v0[j].x * v0[j].x + v0[j].y * v0[j].y) + (v0[j].z * v0[j].z + v0[j].w * v0[j].w); s1 += (v1[j].x * v1[j].x + v1[j].y * v1[j].y) + (v1[j].z * v1[j].z + v1[j].w * v1[j].w); }
#pragma unroll
        for (int o = 1; o < 64; o <<= 1) { s0 += __shfl_xor(s0, o); s1 += __shfl_xor(s1, o); }
        const float rstd0 = rsqrtf(s0 * (1.f / DM) + EPS), rstd1 = rsqrtf(s1 * (1.f / DM) + EPS);
        const int b0 = m0 / SEQ, b1 = (has1 ? m1 : m0) / SEQ;
        u32x2* o0 = (u32x2*)(H1 + (size_t)m0 * DM) + F.lane; u32x2* o1 = (u32x2*)(H1 + (size_t)m1 * DM) + F.lane;
#pragma unroll
        for (int j = 0; j < 4; ++j) {
            const f32x4 g = ((const f32x4*)a.norm1_g)[F.lane + 64 * j];
            { const f32x4 sh = ((const f32x4*)(mod + (size_t)b0 * 6144))[F.lane + 64 * j], sc = ((const f32x4*)(mod + (size_t)b0 * 6144 + 1024))[F.lane + 64 * j];
              const f32x4 h = v0[j] * rstd0 * g * (sc + 1.f) + sh; u32x2 w; w.x = pk2(h.x, h.y); w.y = pk2(h.z, h.w); o0[64 * j] = w; }
            if (has1) { const f32x4 sh = ((const f32x4*)(mod + (size_t)b1 * 6144))[F.lane + 64 * j], sc = ((const f32x4*)(mod + (size_t)b1 * 6144 + 1024))[F.lane + 64 * j];
              const f32x4 h = v1[j] * rstd1 * g * (sc + 1.f) + sh; u32x2 w; w.x = pk2(h.x, h.y); w.y = pk2(h.z, h.w); o1[64 * j] = w; }
        }
    }
}

DI void gates_tasks(const Ctx& F, const Args& a) {
    const int gw = F.bid * NWAVES + F.wave, NGW = F.G * NWAVES;
    const bf16_t* H1 = (const bf16_t*)a.out; const bf16_t* WgT = (const bf16_t*)(a.ws + WS_WGT) + 48 * DM; float* GT = (float*)(a.ws + WS_GATES);
    const float bias = a.gate_b[F.lane & 15];
    for (int task = gw; task < MTOK / 16; task += NGW) {
        const int row0 = task * 16;
        const bf16_t* ap = H1 + (size_t)(row0 + (F.lane & 15)) * DM + 8 * (F.lane >> 4);
        const bf16_t* bp = WgT + (size_t)(F.lane & 15) * DM + 8 * (F.lane >> 4);
        f32x4 acc = {0.f, 0.f, 0.f, 0.f};
#pragma unroll 8
        for (int i = 0; i < 32; ++i) { const bf16x8 av = *(const bf16x8*)(ap + 32 * i), bv = *(const bf16x8*)(bp + 32 * i); acc = __builtin_amdgcn_mfma_f32_16x16x32_bf16(av, bv, acc, 0, 0, 0); }
#pragma unroll
        for (int r = 0; r < 4; ++r) GT[(size_t)(row0 + (F.lane >> 4) * 4 + r) * 16 + (F.lane & 15)] = acc[r] + bias;
    }
}

DI void qk_tile_task(const Ctx& F, const Args& a, int task) {
    const int b = task >> 6, tile = task & 63, r = F.lane, g = F.wave, h = g >> 1, p = g & 1;
    bf16_t* PROJ = (bf16_t*)(a.ws + WS_PROJ);
    const size_t tok = (size_t)b * SEQ + tile * 64 + r;
    float invf[8];
#pragma unroll
    for (int i = 0; i < 8; ++i) invf[i] = exp2f(-(float)i * 0.125f * 18.931568569324174f) * 0.15915494309189535f;
    const float pos = (float)a.pos[tok];
    float sn[8], cs[8];
#pragma unroll
    for (int i = 0; i < 8; ++i) { const float fr = __builtin_amdgcn_fractf(pos * invf[i]); sn[i] = __builtin_amdgcn_sinf(fr); cs[i] = __builtin_amdgcn_cosf(fr); }
#pragma unroll 1
    for (int isk = 0; isk < 2; ++isk) {
        u32x4* src = (u32x4*)(PROJ + tok * PS + (isk ? C_KA : C_QA) + g * 64);
        u32x4 w[8];
#pragma unroll
        for (int c = 0; c < 8; ++c) w[c] = src[c];
        float ss = 0.f;
#pragma unroll
        for (int c = 0; c < 8; ++c) { float t;
            t = bflo(w[c].x); ss += t * t; t = bfhi(w[c].x); ss += t * t; t = bflo(w[c].y); ss += t * t; t = bfhi(w[c].y); ss += t * t;
            t = bflo(w[c].z); ss += t * t; t = bfhi(w[c].z); ss += t * t; t = bflo(w[c].w); ss += t * t; t = bfhi(w[c].w); ss += t * t; }
        const float rstd = rsqrtf(ss * (1.f / 64.f) + EPS) * (isk ? 1.f : 0.125f * 1.4426950408889634f);
        const float* gp = a.qk_g + isk * 64;
        float v0[16];
        v0[0] = bflo(w[0].x); v0[1] = bfhi(w[0].x); v0[2] = bflo(w[0].y); v0[3] = bfhi(w[0].y); v0[4] = bflo(w[0].z); v0[5] = bfhi(w[0].z); v0[6] = bflo(w[0].w); v0[7] = bfhi(w[0].w);
        v0[8] = bflo(w[1].x); v0[9] = bfhi(w[1].x); v0[10] = bflo(w[1].y); v0[11] = bfhi(w[1].y); v0[12] = bflo(w[1].z); v0[13] = bfhi(w[1].z); v0[14] = bflo(w[1].w); v0[15] = bfhi(w[1].w);
#pragma unroll
        for (int i = 0; i < 16; ++i) v0[i] *= rstd * gp[i];
        float rr[16];
#pragma unroll
        for (int i = 0; i < 8; ++i) { rr[i] = v0[i] * cs[i] - v0[i + 8] * sn[i]; rr[i + 8] = v0[i + 8] * cs[i] + v0[i] * sn[i]; }
        u32x4 o[8];
        o[0].x = pk2(rr[0], rr[1]); o[0].y = pk2(rr[2], rr[3]); o[0].z = pk2(rr[4], rr[5]); o[0].w = pk2(rr[6], rr[7]);
        o[1].x = pk2(rr[8], rr[9]); o[1].y = pk2(rr[10], rr[11]); o[1].z = pk2(rr[12], rr[13]); o[1].w = pk2(rr[14], rr[15]);
#pragma unroll
        for (int c = 2; c < 8; ++c) { const f32x4 g0 = *(const f32x4*)(gp + c * 8), g1 = *(const f32x4*)(gp + c * 8 + 4);
            o[c].x = pk2(bflo(w[c].x) * rstd * g0.x, bfhi(w[c].x) * rstd * g0.y); o[c].y = pk2(bflo(w[c].y) * rstd * g0.z, bfhi(w[c].y) * rstd * g0.w);
            o[c].z = pk2(bflo(w[c].z) * rstd * g1.x, bfhi(w[c].z) * rstd * g1.y); o[c].w = pk2(bflo(w[c].w) * rstd * g1.z, bfhi(w[c].w) * rstd * g1.w); }
        if (isk == 0) {
#pragma unroll
            for (int c = 0; c < 8; ++c) src[c] = o[c];
        } else {
            u32x4* dst = (u32x4*)((bf16_t*)(a.ws + WS_KIMG) + ((size_t)((b * 4 + h) * 64 + tile)) * 8192) + r;
#pragma unroll
            for (int c = 0; c < 8; ++c) dst[(p * 8 + c) * 64] = o[c];
        }
    }
    {
        u32x4* dst = (u32x4*)((bf16_t*)(a.ws + WS_VIMG) + ((size_t)((b * 4 + h) * 64 + tile)) * 8192) + r;
#pragma unroll
        for (int cg = 2 * p; cg < 2 * p + 2; ++cg)
#pragma unroll
            for (int kg = 0; kg < 4; ++kg) {
                const u32x4 v = *(const u32x4*)(PROJ + ((size_t)b * SEQ + tile * 64 + 16 * kg + (r >> 2)) * PS + C_VA + h * 128 + 32 * cg + 8 * (r & 3));
                dst[(cg * 4 + kg) * 64] = v; }
    }
}

DI bf16x8 tr_frag_nat(const LAS unsigned char* img, int rowbase, int col0, int lane) {
    const int hh = lane >> 5, g16 = (lane >> 4) & 1, i = lane & 15;
    const int col = col0 + 16 * g16 + 4 * (i & 3), chunk = col >> 3, sub = (col & 7) * 2;
    const int r0 = rowbase + 8 * hh + (i >> 2), r1 = r0 + 4;
    const s16x4 lo = trread(img + r0 * 256 + ((chunk ^ swz16(r0)) << 4) + sub);
    const s16x4 hi = trread(img + r1 * 256 + ((chunk ^ swz16(r1)) << 4) + sub);
    return __builtin_shufflevector(lo, hi, 0, 1, 2, 3, 4, 5, 6, 7);
}
DI bf16x8 tr_frag_acc(const LAS unsigned char* img, int rowbase, int col0, int lane) {
    const int hh = lane >> 5, g16 = (lane >> 4) & 1, i = lane & 15;
    const int col = col0 + 16 * g16 + 4 * (i & 3), chunk = col >> 3, sub = (col & 7) * 2;
    const int r0 = rowbase + 4 * hh + (i >> 2), r1 = r0 + 8;
    const s16x4 lo = trread(img + r0 * 256 + ((chunk ^ swz16(r0)) << 4) + sub);
    const s16x4 hi = trread(img + r1 * 256 + ((chunk ^ swz16(r1)) << 4) + sub);
    return __builtin_shufflevector(lo, hi, 0, 1, 2, 3, 4, 5, 6, 7);
}
DI bf16x8 row_frag(const LAS unsigned char* img, int row, int chunk) { return *(const LAS bf16x8*)(img + row * 256 + ((chunk ^ swz16(row)) << 4)); }

DI void glds16_asm(const void* gsrc, unsigned lds_dst) { unsigned keep;
    asm volatile("s_mov_b32 %0, m0\n\ts_mov_b32 m0, %2\n\ts_nop 0\n\tglobal_load_lds_dwordx4 %1, off\n\ts_mov_b32 m0, %0" : "=&s"(keep) : "v"(gsrc), "s"(lds_dst) : "memory"); }
constexpr size_t DO_QC = 0, DO_KC = 32 * MiB, DO_HD = 64 * MiB;
constexpr size_t WS_SC = 7 * MiB;

DI void conv_task(const Ctx& F, const Args& a, int tw) {
    const int isk = tw & 1, tok0 = (tw >> 1) * 8, b = tok0 / SEQ, t0 = tok0 % SEQ, lane = F.lane;
    const bf16_t* src = (const bf16_t*)(a.ws + WS_PROJ) + (size_t)b * SEQ * PS + (isk ? C_KM : C_QM) + lane * 8;
    float cw[5][8];
#pragma unroll
    for (int j = 0; j < 5; ++j) { const f32x4 c0 = *(const f32x4*)(a.conv_w + j * 1024 + isk * 512 + lane * 8), c1 = *(const f32x4*)(a.conv_w + j * 1024 + isk * 512 + lane * 8 + 4);
        cw[j][0] = c0.x; cw[j][1] = c0.y; cw[j][2] = c0.z; cw[j][3] = c0.w; cw[j][4] = c1.x; cw[j][5] = c1.y; cw[j][6] = c1.z; cw[j][7] = c1.w; }
    u32x4 row[12];
#pragma unroll
    for (int r = 0; r < 12; ++r) { const int t = t0 + r - 2; row[r] = (u32x4){0u, 0u, 0u, 0u}; if (t >= 0 && t < SEQ) row[r] = *(const u32x4*)(src + (size_t)t * PS); }
    const int hd = lane >> 4, cc = lane & 15, cch = t0 >> 6, r0 = t0 & 63;
    bf16_t* tileb = (bf16_t*)((unsigned char*)a.out + (isk ? DO_KC : DO_QC)) + ((size_t)((b * 4 + hd) * 64 + cch)) * 8192;
    bf16_t* dst = isk ? tileb + ((cc >> 2) * 4 + (r0 >> 4)) * 512 + (r0 & 15) * 32 + (cc & 3) * 8 : tileb + cc * 512 + r0 * 8;
    const int dstride = isk ? 32 : 8;
    const float sc = isk ? 0.08838834764831845f : 1.f;
#pragma unroll
    for (int i = 0; i < 8; ++i) {
        float acc[8];
#pragma unroll
        for (int e = 0; e < 8; ++e) acc[e] = 0.f;
#pragma unroll
        for (int j = 0; j < 5; ++j) { const u32x4 w = row[i + j];
            acc[0] += bflo(w.x) * cw[j][0]; acc[1] += bfhi(w.x) * cw[j][1]; acc[2] += bflo(w.y) * cw[j][2]; acc[3] += bfhi(w.y) * cw[j][3];
            acc[4] += bflo(w.z) * cw[j][4]; acc[5] += bfhi(w.z) * cw[j][5]; acc[6] += bflo(w.w) * cw[j][6]; acc[7] += bfhi(w.w) * cw[j][7]; }
#pragma unroll
        for (int e = 0; e < 8; ++e) acc[e] = silu_f(acc[e]) * sc;
        u32x4 o; o.x = pk2(acc[0], acc[1]); o.y = pk2(acc[2], acc[3]); o.z = pk2(acc[4], acc[5]); o.w = pk2(acc[6], acc[7]);
        *(u32x4*)(dst + i * dstride) = o;
    }
}

DI void mscal_task(const Ctx& F, const Args& a, int chain) {
    const int b = chain >> 3, h = (chain >> 1) & 3, dir = chain & 1, s = F.lane;
    const float* GT = (const float*)(a.ws + WS_GATES) + (size_t)b * SEQ * 16;
    float* SC = (float*)(a.ws + WS_SC) + (size_t)chain * 64 * 256; float* MSC = (float*)(a.ws + WS_MSC);
    LAS float* gl = (LAS float*)F.lds; LAS float* mll = gl + 64; LAS float* mpv = gl + 128; LAS float* mnw = gl + 192;
    float aa[8], ii[8];
#pragma unroll
    for (int i = 0; i < 8; ++i) { const int c = F.wave + 8 * i;
        const float ig = GT[(size_t)(c * 64 + s) * 16 + dir * 8 + h], fg = GT[(size_t)(c * 64 + s) * 16 + dir * 8 + 4 + h];
        float av = logsigmoid_f(fg);
        if (dir == 0) {
#pragma unroll
            for (int o = 1; o < 64; o <<= 1) { const float t = __shfl_up(av, o); if (s >= o) av += t; }
        } else {
#pragma unroll
            for (int o = 1; o < 64; o <<= 1) { const float t = __shfl_down(av, o); if (s + o < 64) av += t; }
        }
        aa[i] = av; ii[i] = ig;
        const float g = __shfl(av, dir == 0 ? 63 : 0), ml = wave_max(g - av + ig);
        if (s == 0) { gl[c] = g; mll[c] = ml; } }
    __syncthreads();
    if (F.tid == 0) { float m = 0.f;
        for (int st = 0; st < 64; ++st) { const int c = dir ? 63 - st : st; mpv[c] = m; const float mn = fmaxf(gl[c] + m, mll[c]); mnw[c] = mn; m = mn; } }
    __syncthreads();
#pragma unroll
    for (int i = 0; i < 8; ++i) { const int c = F.wave + 8 * i; const float mprev = mpv[c], mnew = mnw[c], g = gl[c];
        const float cterm = ii[i] - aa[i]; float cm = cterm;
        if (dir == 0) {
#pragma unroll
            for (int o = 1; o < 64; o <<= 1) { const float t = __shfl_up(cm, o); if (s >= o) cm = fmaxf(cm, t); }
        } else {
#pragma unroll
            for (int o = 1; o < 64; o <<= 1) { const float t = __shfl_down(cm, o); if (s + o < 64) cm = fmaxf(cm, t); }
        }
        const float il = aa[i] + mprev, mj = fmaxf(il, aa[i] + cm);
        float* o4 = SC + (size_t)c * 256 + s;
        o4[0] = (aa[i] - mj) * 1.4426950408889634f; o4[64] = cterm * 1.4426950408889634f; o4[128] = __expf(il - mj); o4[192] = __expf(-mj);
        if (s == 0) { MSC[chain * 64 + c] = (g - mnew) * 1.4426950408889634f; MSC[4096 + chain * 64 + c] = __expf(g + mprev - mnew); } }
    __syncthreads();
}

DI void mseq_item(const Ctx& F, const Args& a, int bh, int dir, int vs) {
    const int b = bh >> 2, h = bh & 3, chain = bh * 2 + dir, wid = F.wave, tid = F.tid, lane = F.lane, r32 = lane & 31, hh = lane >> 5;
    LAS unsigned char* QS = F.lds;
    LAS unsigned char* KS = F.lds + 32768;
    LAS unsigned char* VS = F.lds + 65536;
    LAS unsigned char* SCS = F.lds + 77824;
    LAS unsigned char* SD = F.lds + 80896;
    LAS unsigned char* CI = F.lds + 97280;
    LAS float* NV = (LAS float*)(F.lds + 113664);
    LAS float* gmv = NV + 256; LAS float* spv = gmv + 64;
    LAS float* rdv = spv + 64;
    LAS float* wvv = rdv + 64;
    LAS unsigned char* HST = F.lds + 118784;
    const bf16_t* QC = (const bf16_t*)((const unsigned char*)a.out + DO_QC) + (size_t)bh * 64 * 8192 + lane * 8;
    const bf16_t* KC = (const bf16_t*)((const unsigned char*)a.out + DO_KC) + (size_t)bh * 64 * 8192 + lane * 8;
    const bf16_t* VP = (const bf16_t*)(a.ws + WS_PROJ) + (size_t)b * SEQ * PS + C_VM + h * 128 + vs * 32 + (size_t)(16 * (wid & 3) + (lane >> 2)) * PS + 8 * (lane & 3);
    const float* SC = (const float*)(a.ws + WS_SC) + (size_t)chain * 64 * 256 + lane * 4;
    bf16_t* HD = (bf16_t*)((unsigned char*)a.out + DO_HD) + ((size_t)dir * MTOK + (size_t)b * SEQ) * 512 + h * 128 + vs * 32;
    if (tid < 64) { gmv[tid] = ((const float*)(a.ws + WS_MSC))[chain * 64 + tid]; spv[tid] = ((const float*)(a.ws + WS_MSC))[4096 + chain * 64 + tid]; }
    if (tid < 256) NV[tid] = 0.f;
    for (int i = tid; i < 4096; i += NTHR) ((LAS unsigned*)CI)[i] = 0u;
    const unsigned ldsb = (unsigned)(uintptr_t)F.lds;
#define MSEQ_ISSUE(c, s2, s3) do { const size_t _tb = (size_t)(c); \
        if (wid < 4) { _Pragma("unroll") for (int _i = 0; _i < 4; ++_i) \
                glds16_asm(QC + _tb * 8192 + (4 * wid + _i) * 512, (unsigned)__builtin_amdgcn_readfirstlane((int)(ldsb + (s2) * 16384 + (4 * wid + _i) * 1024))); \
            glds16_asm(VP + _tb * 64 * PS, (unsigned)__builtin_amdgcn_readfirstlane((int)(ldsb + 65536 + (s3) * 4096 + wid * 1024))); } \
        else if (wid >= 6) { _Pragma("unroll") for (int _i = 0; _i < 8; ++_i) \
                glds16_asm(KC + _tb * 8192 + (8 * (wid - 6) + _i) * 512, (unsigned)__builtin_amdgcn_readfirstlane((int)(ldsb + 32768 + (s2) * 16384 + (8 * (wid - 6) + _i) * 1024))); \
            if (wid == 6) glds16_asm(SC + _tb * 256, (unsigned)__builtin_amdgcn_readfirstlane((int)(ldsb + 77824 + (s3) * 1024))); } } while (0)
    MSEQ_ISSUE(dir ? 63 : 0, 0, 0);
    f32x16 Cacc[2];
#pragma unroll
    for (int i = 0; i < 16; ++i) { Cacc[0][i] = 0.f; Cacc[1][i] = 0.f; }
    const int qrd = hh * 1024 + r32 * 16;
    const int ktr = (8 * hh + ((lane & 15) >> 2)) * 64 + ((lane >> 4) & 1) * 32 + (lane & 3) * 8;
    f32x16 acc;
    float qn = 0.f;
#pragma unroll
    for (int i = 0; i < 16; ++i) acc[i] = 0.f;
    asm volatile("s_waitcnt vmcnt(0)" ::: "memory");
    __syncthreads();
    int s3 = 0;
    unsigned long long busy = 0, tb0 = 0; if (PROBE_MSEQ_W >= 0) tb0 = __builtin_amdgcn_s_memtime(); const unsigned long long titem0 = tb0;
#pragma unroll 1
    for (int st = 0; st <= 64; ++st) {
        const int c = dir ? 63 - st : st, s2 = st & 1; const int s3n = (s3 == 2) ? 0 : s3 + 1, s3p = (s3 == 0) ? 2 : s3 - 1;
        if (st + 1 < 64) MSEQ_ISSUE(dir ? 62 - st : st + 1, s2 ^ 1, s3n);
        const LAS unsigned char* QT = QS + s2 * 16384; const LAS unsigned char* KT = KS + s2 * 16384; const LAS unsigned char* VT = VS + s3 * 4096;
        const LAS float* rt = (const LAS float*)(SCS + s3 * 1024); const LAS float* ct = rt + 64;
        if (wid < 4) {
            if (st < 64) {
                const int jt = wid >> 1, stt = wid & 1;
                const LAS unsigned char* qa = QT + qrd + jt * 512;
                const LAS unsigned char* kb = KT + (2 * stt + (r32 >> 4)) * 1024 + (r32 & 15) * 64 + hh * 16;
                f32x16 S;
#pragma unroll
                for (int i = 0; i < 16; ++i) S[i] = 0.f;
#pragma unroll
                for (int ks = 0; ks < 8; ++ks) S = MFMA32(*(const LAS bf16x8*)(kb + (ks >> 1) * 4096 + (ks & 1) * 32), *(const LAS bf16x8*)(qa + ks * 2048), S);
                {   const float gm = gmv[c], sp = spv[c];
                    LAS float* wv = wvv + wid * 64;
                    wv[lane] = __builtin_amdgcn_exp2f(ct[lane] + gm);
                    asm volatile("s_waitcnt lgkmcnt(0)" ::: "memory");
                    const int ck = 4 * wid + (lane & 3), r0 = 4 * (lane >> 2); float pa[8];
                    const LAS unsigned char* kr = KT + (ck >> 2) * 4096 + (r0 >> 4) * 1024 + (r0 & 15) * 64 + (ck & 3) * 16;
#pragma unroll
                    for (int e = 0; e < 8; ++e) pa[e] = 0.f;
#pragma unroll
                    for (int r = 0; r < 4; ++r) { const u32x4 w = *(const LAS u32x4*)(kr + r * 64); const float ws_ = wv[r0 + r];
                        pa[0] += ws_ * bflo(w.x); pa[1] += ws_ * bfhi(w.x); pa[2] += ws_ * bflo(w.y); pa[3] += ws_ * bfhi(w.y); pa[4] += ws_ * bflo(w.z); pa[5] += ws_ * bfhi(w.z); pa[6] += ws_ * bflo(w.w); pa[7] += ws_ * bfhi(w.w); }
#pragma unroll
                    for (int e = 0; e < 8; ++e) { float t = pa[e]; t += dpp_mov<DPP_ROR(8)>(t); t += dpp_mov<DPP_ROR(4)>(t); t = xor16_sum(t); pa[e] = xor32_sum(t); }
                    if (lane < 4) { const LAS float* no = NV + s2 * 128 + 32 * wid + 8 * lane; LAS float* nn = NV + (s2 ^ 1) * 128 + 32 * wid + 8 * lane;
                        const f32x4 o0 = *(const LAS f32x4*)no, o1 = *(const LAS f32x4*)(no + 4);
                        *(LAS f32x4*)nn = (f32x4){sp * o0.x + pa[0], sp * o0.y + pa[1], sp * o0.z + pa[2], sp * o0.w + pa[3]};
                        *(LAS f32x4*)(nn + 4) = (f32x4){sp * o1.x + pa[4], sp * o1.y + pa[5], sp * o1.z + pa[6], sp * o1.w + pa[7]}; }
                }
                {   const int j = 32 * jt + r32; const float rtj = rt[j];
                    LAS unsigned char* sw = SD + s2 * 8192 + stt * 4096 + j * 16 + hh * 8;
                    const LAS float* ctp = ct + 32 * stt + 4 * hh;
#pragma unroll
                    for (int rg = 0; rg < 4; ++rg) { const f32x4 c4 = *(const LAS f32x4*)(ctp + 8 * rg); float v[4];
#pragma unroll
                        for (int e = 0; e < 4; ++e) { const int sc = 32 * stt + 8 * rg + 4 * hh + e; const bool ok = dir == 0 ? (sc <= j) : (sc >= j);
                            v[e] = S[4 * rg + e] * __builtin_amdgcn_exp2f(ok ? rtj + c4[e] : -1.0e30f); }
                        u32x2 w; w.x = pk2(v[0], v[1]); w.y = pk2(v[2], v[3]); *(LAS u32x2*)(sw + rg * 1024) = w; }
                }
            }
        } else if (wid < 6) {
            const int jt = wid - 4;
            if (st > 0) {
                const int cp = dir ? 64 - st : st - 1;
                const LAS float* iw = (const LAS float*)(SCS + s3p * 1024) + 128; const LAS float* enm = iw + 64;
                const LAS unsigned char* SDp = SD + (s2 ^ 1) * 8192;
                {   const int j = 32 * jt + (lane >> 1), hf = lane & 1; float rsum = 0.f;
                    const LAS unsigned char* sr = SDp + hf * 4096 + j * 16;
#pragma unroll
                    for (int ch = 0; ch < 4; ++ch) { const u32x4 w = *(const LAS u32x4*)(sr + ch * 1024);
                        rsum += (bflo(w.x) + bfhi(w.x)) + (bflo(w.y) + bfhi(w.y)) + (bflo(w.z) + bfhi(w.z)) + (bflo(w.w) + bfhi(w.w)); }
                    rsum += dpp_mov<DPP_XOR1>(rsum);
                    const float den = rsum + iw[j] * qn;
                    if (hf == 0) rdv[j] = 1.f / fmaxf(fabsf(den), enm[j]);
                    asm volatile("s_waitcnt lgkmcnt(0)" ::: "memory");
                }
                const int jl = 32 * jt + r32; const float iwj = iw[jl], rdj = rdv[jl];
#pragma unroll
                for (int i = 0; i < 16; ++i) acc[i] *= iwj;
                const LAS unsigned char* sa = SDp + qrd + jt * 512; const LAS unsigned char* vb = VS + s3p * 4096 + ktr;
#pragma unroll
                for (int ks = 0; ks < 4; ++ks) { const s16x4 lo = trread(vb + ks * 1024), hi = trread(vb + ks * 1024 + 256);
                    acc = MFMA32(__builtin_shufflevector(lo, hi, 0, 1, 2, 3, 4, 5, 6, 7), *(const LAS bf16x8*)(sa + ks * 2048), acc); }
                LAS unsigned char* hst = HST + jt * 2048;
#pragma unroll
                for (int rg = 0; rg < 4; ++rg) { u32x2 w; w.x = pk2(acc[4 * rg] * rdj, acc[4 * rg + 1] * rdj); w.y = pk2(acc[4 * rg + 2] * rdj, acc[4 * rg + 3] * rdj);
                    *(LAS u32x2*)(hst + r32 * 64 + (8 * rg + 4 * hh) * 2) = w; }
                asm volatile("s_waitcnt lgkmcnt(0)" ::: "memory");
#pragma unroll
                for (int q = 0; q < 2; ++q) { const int row = 16 * q + (lane >> 2), part = lane & 3;
                    const u32x4 w = *(const LAS u32x4*)(hst + row * 64 + part * 16);
                    *(u32x4*)(HD + (size_t)(cp * 64 + 32 * jt + row) * 512 + part * 8) = w; }
            }
            if (st < 64) {
                const LAS unsigned char* qa = QT + qrd + jt * 512;
                const LAS unsigned char* cb = CI + s2 * 8192 + hh * 512 + r32 * 16;
#pragma unroll
                for (int i = 0; i < 16; ++i) acc[i] = 0.f;
#pragma unroll
                for (int ks = 0; ks < 8; ++ks) acc = MFMA32(*(const LAS bf16x8*)(cb + ks * 1024), *(const LAS bf16x8*)(qa + ks * 2048), acc);
                const int j = 32 * jt + (lane >> 1), hf = lane & 1;
                const LAS unsigned char* qr = QT + hf * 8192 + j * 16; const LAS float* np = NV + s2 * 128 + 64 * hf;
                qn = 0.f;
#pragma unroll
                for (int ch = 0; ch < 8; ++ch) { const u32x4 w = *(const LAS u32x4*)(qr + ch * 1024); const f32x4 n0 = *(const LAS f32x4*)(np + ch * 8), n1 = *(const LAS f32x4*)(np + ch * 8 + 4);
                    qn += bflo(w.x) * n0.x + bfhi(w.x) * n0.y + bflo(w.y) * n0.z + bfhi(w.y) * n0.w + bflo(w.z) * n1.x + bfhi(w.z) * n1.y + bflo(w.w) * n1.z + bfhi(w.w) * n1.w; }
                qn += dpp_mov<DPP_XOR1>(qn);
            }
        } else if (st < 64) {
            const int u = wid - 6; const float gm = gmv[c], sp = spv[c];
            LAS float* wv = wvv + (4 + u) * 64;
            wv[lane] = __builtin_amdgcn_exp2f(ct[lane] + gm);
            asm volatile("s_waitcnt lgkmcnt(0)" ::: "memory");
#pragma unroll
            for (int i = 0; i < 16; ++i) { Cacc[0][i] *= sp; Cacc[1][i] *= sp; }
            const LAS unsigned char* va = VT + ktr; const LAS unsigned char* ka = KT + ktr + (2 * u) * 4096;
#pragma unroll
            for (int ks = 0; ks < 4; ++ks) {
                const s16x4 lo = trread(va + ks * 1024), hi = trread(va + ks * 1024 + 256);
                const f32x4 w0 = *(const LAS f32x4*)(wv + 16 * ks + 8 * hh), w1 = *(const LAS f32x4*)(wv + 16 * ks + 8 * hh + 4);
                u32x4 af;
                af.x = pk2(bf2f((bf16_t)lo[0]) * w0.x, bf2f((bf16_t)lo[1]) * w0.y); af.y = pk2(bf2f((bf16_t)lo[2]) * w0.z, bf2f((bf16_t)lo[3]) * w0.w);
                af.z = pk2(bf2f((bf16_t)hi[0]) * w1.x, bf2f((bf16_t)hi[1]) * w1.y); af.w = pk2(bf2f((bf16_t)hi[2]) * w1.z, bf2f((bf16_t)hi[3]) * w1.w);
                const bf16x8 afr = __builtin_bit_cast(bf16x8, af);
                { const s16x4 l0 = trread(ka + ks * 1024), h0 = trread(ka + ks * 1024 + 256); Cacc[0] = MFMA32(__builtin_shufflevector(l0, h0, 0, 1, 2, 3, 4, 5, 6, 7), afr, Cacc[0]); }
                { const s16x4 l1 = trread(ka + 4096 + ks * 1024), h1 = trread(ka + 4096 + ks * 1024 + 256); Cacc[1] = MFMA32(__builtin_shufflevector(l1, h1, 0, 1, 2, 3, 4, 5, 6, 7), afr, Cacc[1]); }
            }
            LAS unsigned char* cw = CI + (s2 ^ 1) * 8192 + (2 * u) * 2048 + r32 * 16 + hh * 8;
#pragma unroll
            for (int t2 = 0; t2 < 2; ++t2)
#pragma unroll
                for (int rg = 0; rg < 4; ++rg) { u32x2 w; w.x = pk2(Cacc[t2][4 * rg], Cacc[t2][4 * rg + 1]); w.y = pk2(Cacc[t2][4 * rg + 2], Cacc[t2][4 * rg + 3]); *(LAS u32x2*)(cw + t2 * 2048 + rg * 512) = w; }
        }
        s3 = s3n;
        if (PROBE_MSEQ_W >= 0) { asm volatile("s_waitcnt lgkmcnt(0)" ::: "memory"); busy += __builtin_amdgcn_s_memtime() - tb0; }
        if (wid < 4 || wid >= 6) asm volatile("s_waitcnt vmcnt(0)" ::: "memory");
        asm volatile("s_waitcnt lgkmcnt(0)" ::: "memory"); __builtin_amdgcn_s_barrier(); asm volatile("" ::: "memory");
        if (PROBE_MSEQ_W >= 0) tb0 = __builtin_amdgcn_s_memtime();
    }
    if (PROBE_MSEQ_W >= 0 && F.bid == 0 && lane == 0 && (wid == PROBE_MSEQ_W || (PROBE_MSEQ_W == 8 && wid == 0)))
        *(volatile LAS unsigned long long*)(F.lds + LDS_BYTES - 128) = (PROBE_MSEQ_W == 8) ? (__builtin_amdgcn_s_memtime() - titem0) : busy;
    asm volatile("s_waitcnt vmcnt(0)" ::: "memory");
#undef MSEQ_ISSUE
}

DI void glds16(const void* g, LAS unsigned char* l) { __builtin_amdgcn_global_load_lds((const unsigned*)g, (LAS unsigned*)l, 16, 0, 0); }
DI void attn_unit(const Ctx& F, const Args& a, int b, int h, int qb, float lam, float cshift) {
    const int lane = F.lane, wid = F.wave, r32 = lane & 31, hh = lane >> 5, rg = wid & 3, p = wid >> 2;
    const bf16_t* projb = (const bf16_t*)(a.ws + WS_PROJ) + (size_t)b * SEQ * PS;
    const int qrow = qb * 128 + rg * 32 + r32;
    bf16x8 qf[4];
    { const bf16_t* qp = projb + (size_t)qrow * PS + C_QA + h * 128 + p * 64 + hh * 8;
#pragma unroll
      for (int ks = 0; ks < 4; ++ks) qf[ks] = *(const bf16x8*)(qp + ks * 16); }
    const bf16_t* kimg = (const bf16_t*)(a.ws + WS_KIMG) + (size_t)(b * 4 + h) * 64 * 8192 + (2 * wid) * 512 + lane * 8;
    const bf16_t* vimg = (const bf16_t*)(a.ws + WS_VIMG) + (size_t)(b * 4 + h) * 64 * 8192 + (2 * wid) * 512 + lane * 8;
    const unsigned ldsw = (unsigned)__builtin_amdgcn_readfirstlane((int)(unsigned)(uintptr_t)F.lds + (2 * wid) * 1024);
#define ATT_ISSUE_K(t, s) do { const bf16_t* _tp = kimg + (size_t)(t) * 8192; const unsigned _d = (unsigned)__builtin_amdgcn_readfirstlane((int)(ldsw + (s) * 16384)); \
        glds16_asm(_tp, _d); glds16_asm(_tp + 512, _d + 1024); } while (0)
#define ATT_ISSUE_V(t, s) do { const bf16_t* _tp = vimg + (size_t)(t) * 8192; const unsigned _d = (unsigned)__builtin_amdgcn_readfirstlane((int)(ldsw + 32768 + (s) * 16384)); \
        glds16_asm(_tp, _d); glds16_asm(_tp + 512, _d + 1024); } while (0)
    ATT_ISSUE_K(0, 0); ATT_ISSUE_V(0, 0); ATT_ISSUE_K(1, 1);
    f32x16 O[4];
#pragma unroll
    for (int vt = 0; vt < 4; ++vt)
#pragma unroll
        for (int i = 0; i < 16; ++i) O[vt][i] = 0.f;
    float lsum = 0.f;
    const int kfb = p * 8192 + hh * 1024 + r32 * 16;
    const int vfb = 32768 + (4 * hh + ((lane & 15) >> 2)) * 64 + ((lane >> 4) & 1) * 32 + (lane & 3) * 8;
    bf16x8 pb[4];
    asm volatile("s_waitcnt vmcnt(0)" ::: "memory");
    __syncthreads();
#define ATT_QK(Sa, Sb, kb) do { _Pragma("unroll") for (int i = 0; i < 16; ++i) { Sa[i] = -cshift; Sb[i] = -cshift; } \
        _Pragma("unroll") for (int ks = 0; ks < 4; ++ks) { Sa = MFMA32(*(const LAS bf16x8*)((kb) + ks * 2048), qf[ks], Sa); Sb = MFMA32(*(const LAS bf16x8*)((kb) + ks * 2048 + 512), qf[ks], Sb); } } while (0)
#define ATT_EXP(Sa, Sb, on) do { float _ls = 0.f; _Pragma("unroll") for (int i = 0; i < 16; ++i) { Sa[i] = __builtin_amdgcn_exp2f(Sa[i]); Sb[i] = __builtin_amdgcn_exp2f(Sb[i]); _ls += Sa[i] + Sb[i]; } lsum += (on) ? _ls : 0.f; \
        ATT_PACK(pb[0], Sa, 0); ATT_PACK(pb[1], Sa, 8); ATT_PACK(pb[2], Sb, 0); ATT_PACK(pb[3], Sb, 8); } while (0)
#define ATT_PACK(dst, S, o) do { u32x4 _w; _w.x = pk2(S[o], S[o + 1]); _w.y = pk2(S[o + 2], S[o + 3]); _w.z = pk2(S[o + 4], S[o + 5]); _w.w = pk2(S[o + 6], S[o + 7]); dst = __builtin_bit_cast(bf16x8, _w); } while (0)
    f32x16 Sa, Sb;
    ATT_QK(Sa, Sb, F.lds + kfb);
    if (p == 0) ATT_EXP(Sa, Sb, true);
    __syncthreads();
#define ATT_VLOAD(dst, Vb, kg) do { _Pragma("unroll") for (int vt = 0; vt < 4; ++vt) { \
        const s16x4 _lo = trread((Vb) + vt * 4096 + (kg) * 1024), _hi = trread((Vb) + vt * 4096 + (kg) * 1024 + 512); dst[vt] = __builtin_shufflevector(_lo, _hi, 0, 1, 2, 3, 4, 5, 6, 7); } } while (0)
#define ATT_PV(vf, kg) do { _Pragma("unroll") for (int vt = 0; vt < 4; ++vt) O[vt] = MFMA32(vf[vt], pb[kg], O[vt]); } while (0)
#pragma unroll 1
    for (int t = 0; t < 64; ++t) {
        const int s = t & 1;
        ATT_ISSUE_K(t + 2 < 64 ? t + 2 : 63, s);
        ATT_ISSUE_V(t + 1 < 64 ? t + 1 : 63, s ^ 1);
        const LAS unsigned char* Kb = F.lds + (s ^ 1) * 16384 + kfb; const LAS unsigned char* Vb = F.lds + s * 16384 + vfb;
        bf16x8 kfa[4], kfb2[4], vA[4], vB[4];
#pragma unroll
        for (int ks = 0; ks < 4; ++ks) { kfa[ks] = *(const LAS bf16x8*)(Kb + ks * 2048); kfb2[ks] = *(const LAS bf16x8*)(Kb + ks * 2048 + 512); }
        ATT_VLOAD(vA, Vb, 0);
        if (p == 1) ATT_EXP(Sa, Sb, true);
        __builtin_amdgcn_sched_barrier(0);
        ATT_VLOAD(vB, Vb, 1); ATT_PV(vA, 0);
        __builtin_amdgcn_sched_barrier(0);
        ATT_VLOAD(vA, Vb, 2); ATT_PV(vB, 1);
        __builtin_amdgcn_sched_barrier(0);
        ATT_VLOAD(vB, Vb, 3); ATT_PV(vA, 2);
        __builtin_amdgcn_sched_barrier(0);
        ATT_PV(vB, 3);
#pragma unroll
        for (int i = 0; i < 16; ++i) { Sa[i] = -cshift; Sb[i] = -cshift; }
#pragma unroll
        for (int ks = 0; ks < 4; ++ks) { Sa = MFMA32(kfa[ks], qf[ks], Sa); Sb = MFMA32(kfb2[ks], qf[ks], Sb); }
        __builtin_amdgcn_sched_barrier(0);
        if (p == 0) ATT_EXP(Sa, Sb, t + 1 < 64);
        asm volatile("s_waitcnt vmcnt(0)" ::: "memory");
        __syncthreads();
    }
#undef ATT_VLOAD
#undef ATT_PV
#undef ATT_ISSUE_K
#undef ATT_ISSUE_V
#undef ATT_QK
#undef ATT_EXP
#undef ATT_PACK
    lsum += __shfl_xor(lsum, 32);
    LAS float* X = (LAS float*)(F.lds + 65536) + rg * 4096 + r32;
    if (p == 1) {
        const float sc = lam / lsum;
#pragma unroll
        for (int vt = 0; vt < 4; ++vt)
#pragma unroll
            for (int i = 0; i < 16; ++i) X[(32 * vt + crow(i, hh)) * 32] = O[vt][i] * sc;
    }
    __syncthreads();
    if (p == 0) {
        const float i0 = 1.f / lsum;
        float ssq = 0.f;
#pragma unroll
        for (int vt = 0; vt < 4; ++vt)
#pragma unroll
            for (int i = 0; i < 16; ++i) { const float o = O[vt][i] * i0 - X[(32 * vt + crow(i, hh)) * 32]; O[vt][i] = o; ssq += o * o; }
        ssq += __shfl_xor(ssq, 32);
        const float rs = rsqrtf(ssq * (1.f / 128.f) + EPS) * 0.8f;
        bf16_t* yp = (bf16_t*)(a.ws + WS_YA) + (size_t)(b * SEQ + qrow) * 512 + h * 128;
#pragma unroll
        for (int vt = 0; vt < 4; ++vt)
#pragma unroll
            for (int rgi = 0; rgi < 4; ++rgi) { const int vd = 32 * vt + 8 * rgi + 4 * hh; const f32x4 g = *(const f32x4*)(a.subln_g + vd);
                u32x2 w; w.x = pk2(O[vt][4 * rgi] * rs * g.x, O[vt][4 * rgi + 1] * rs * g.y); w.y = pk2(O[vt][4 * rgi + 2] * rs * g.z, O[vt][4 * rgi + 3] * rs * g.w);
                *(u32x2*)(yp + vd) = w; }
    }
    __syncthreads();
}

DI void mcombine_phase(const Ctx& F, const Args& a) {
    const int gw = F.bid * NWAVES + F.wave, NGW = F.G * NWAVES, lane = F.lane;
    const bf16_t* HD = (const bf16_t*)((const unsigned char*)a.out + DO_HD);
    float g[8];
#pragma unroll
    for (int i = 0; i < 8; ++i) g[i] = a.mnorm_g[lane * 8 + i];
    for (int m = gw; m < MTOK; m += NGW) {
        const u32x4 f = *(const u32x4*)(HD + (size_t)m * 512 + lane * 8), bw = *(const u32x4*)(HD + ((size_t)MTOK + m) * 512 + lane * 8);
        const u32x4 om = *(const u32x4*)((const bf16_t*)(a.ws + WS_PROJ) + (size_t)m * PS + C_OM + lane * 8);
        const u32x4 ya = *(const u32x4*)((const bf16_t*)(a.ws + WS_YA) + (size_t)m * 512 + lane * 8);
        float v[8];
        v[0] = bflo(f.x) + bflo(bw.x); v[1] = bfhi(f.x) + bfhi(bw.x); v[2] = bflo(f.y) + bflo(bw.y); v[3] = bfhi(f.y) + bfhi(bw.y);
        v[4] = bflo(f.z) + bflo(bw.z); v[5] = bfhi(f.z) + bfhi(bw.z); v[6] = bflo(f.w) + bflo(bw.w); v[7] = bfhi(f.w) + bfhi(bw.w);
        float ss = 0.f;
#pragma unroll
        for (int i = 0; i < 8; ++i) ss += v[i] * v[i];
        ss += __shfl_xor(ss, 1); ss += __shfl_xor(ss, 2); ss += __shfl_xor(ss, 4); ss += __shfl_xor(ss, 8);
        const float rstd = rsqrtf(ss * (1.f / 128.f) + EPS);
        float o[8];
        o[0] = bflo(om.x); o[1] = bfhi(om.x); o[2] = bflo(om.y); o[3] = bfhi(om.y); o[4] = bflo(om.z); o[5] = bfhi(om.z); o[6] = bflo(om.w); o[7] = bfhi(om.w);
#pragma unroll
        for (int i = 0; i < 8; ++i) v[i] = v[i] * rstd * g[i] * sigmoid_f(o[i]);
        u32x4 w; w.x = pk2(v[0], v[1]); w.y = pk2(v[2], v[3]); w.z = pk2(v[4], v[5]); w.w = pk2(v[6], v[7]);
        bf16_t* yp = (bf16_t*)(a.ws + WS_YMIX) + (size_t)m * DM + lane * 8;
        *(u32x4*)yp = w; *(u32x4*)(yp + 512) = ya;
    }
}

DI void p7_phase(const Ctx& F, const Args& a) {
    LAS f32x4* WRL = (LAS f32x4*)F.lds;
    for (int q = F.tid; q < 4096; q += NTHR) { const int k = q >> 2, g = q & 3; WRL[(g * 2 + (k & 1)) * 512 + (k >> 1)] = *(const f32x4*)(a.w_router + k * 16 + g * 4); }
    __syncthreads();
    const int gw = F.bid * NWAVES + F.wave, NGW = F.G * NWAVES, lane = F.lane;
    const float* mod = (const float*)(a.ws + WS_MOD);
    unsigned char* H2 = a.ws + WS_H2; float* AFF = (float*)(a.ws + WS_AFF);
    for (int m = gw; m < MTOK; m += NGW) {
        const int b = m / SEQ;
        const f32x2* xr = (const f32x2*)(a.out + (size_t)m * DM) + lane;
        f32x2 v[8]; float s = 0.f;
#pragma unroll
        for (int j = 0; j < 8; ++j) { v[j] = xr[64 * j]; s += v[j].x * v[j].x + v[j].y * v[j].y; }
        const float rstd = rsqrtf(wave_sum(s) * (1.f / DM) + EPS);
        float lg[16];
#pragma unroll
        for (int e = 0; e < 16; ++e) lg[e] = 0.f;
        unsigned short* o2 = (unsigned short*)(H2 + (size_t)m * DM) + lane;
#pragma unroll
        for (int j = 0; j < 8; ++j) {
            const f32x2 g = ((const f32x2*)a.norm2_g)[lane + 64 * j];
            const f32x2 sh = ((const f32x2*)(mod + (size_t)b * 6144 + 3072))[lane + 64 * j];
            const f32x2 sc = ((const f32x2*)(mod + (size_t)b * 6144 + 4096))[lane + 64 * j];
            const f32x2 hv = v[j] * rstd * g * (sc + 1.f) + sh;
            o2[64 * j] = (unsigned short)__builtin_amdgcn_cvt_pk_fp8_f32(hv.x, hv.y, 0, false);
#pragma unroll
            for (int g4 = 0; g4 < 4; ++g4) { const f32x4 w0 = WRL[(g4 * 2 + 0) * 512 + lane + 64 * j], w1 = WRL[(g4 * 2 + 1) * 512 + lane + 64 * j];
                lg[g4 * 4 + 0] += hv.x * w0.x + hv.y * w1.x; lg[g4 * 4 + 1] += hv.x * w0.y + hv.y * w1.y; lg[g4 * 4 + 2] += hv.x * w0.z + hv.y * w1.z; lg[g4 * 4 + 3] += hv.x * w0.w + hv.y * w1.w; }
            __builtin_amdgcn_sched_barrier(0);
        }
        float r8[8];
#pragma unroll
        for (int i = 0; i < 8; ++i) { const float keep = hh_sel(lane, 32) ? lg[8 + i] : lg[i], send = hh_sel(lane, 32) ? lg[i] : lg[8 + i]; r8[i] = keep + partner32(send, lane); }
        float r4[4];
#pragma unroll
        for (int i = 0; i < 4; ++i) { const float keep = hh_sel(lane, 16) ? r8[4 + i] : r8[i], send = hh_sel(lane, 16) ? r8[i] : r8[4 + i]; r4[i] = keep + partner16(send, lane); }
        float r2[2];
#pragma unroll
        for (int i = 0; i < 2; ++i) { const float keep = hh_sel(lane, 8) ? r4[2 + i] : r4[i], send = hh_sel(lane, 8) ? r4[i] : r4[2 + i]; r2[i] = keep + partner8(send); }
        float lgt; { const float keep = hh_sel(lane, 4) ? r2[1] : r2[0], send = hh_sel(lane, 4) ? r2[0] : r2[1]; lgt = keep + partner4(send, lane); }
        lgt += dpp_mov<DPP_XOR2>(lgt); lgt += dpp_mov<DPP_XOR1>(lgt);
        float mx = lgt; mx = fmaxf(mx, dpp_mov<DPP_ROR(8)>(mx)); mx = fmaxf(mx, dpp_mov<DPP_ROR(4)>(mx)); mx = xor16_max(mx); mx = xor32_max(mx);
        const float ex = __expf(lgt - mx); float sm = ex; sm += dpp_mov<DPP_ROR(8)>(sm); sm += dpp_mov<DPP_ROR(4)>(sm); sm = xor16_sum(sm); sm = xor32_sum(sm);
        if ((lane & 3) == 0) AFF[(size_t)m * 16 + (lane >> 2)] = ex / sm;
    }
    __syncthreads();
}

DI void topk_task(const Ctx& F, const Args& a, int task) {
    const int b = task >> 4, e = task & 15, tid = F.tid, lane = F.lane;
    const float* AFF = (const float*)(a.ws + WS_AFF) + (size_t)b * SEQ * 16 + e;
    LAS unsigned* hist = (LAS unsigned*)F.lds;
    LAS unsigned* sfx = hist + 256;
    LAS unsigned* misc = hist + 512;
    LAS int* lidx = (LAS int*)(F.lds + 4096);
    unsigned key[8];
#pragma unroll
    for (int i = 0; i < 8; ++i) key[i] = __float_as_uint(AFF[(size_t)(tid * 8 + i) * 16]);
    unsigned prefix = 0, krem = CAP;
#pragma unroll 1
    for (int pass = 0; pass < 4; ++pass) {
        const int shift = 24 - 8 * pass;
        if (tid < 256) hist[tid] = 0;
        __syncthreads();
#pragma unroll
        for (int i = 0; i < 8; ++i) { const bool in = pass == 0 ? true : ((key[i] >> (shift + 8)) == (prefix >> (shift + 8))); if (in) atomicAdd((unsigned*)&hist[(key[i] >> shift) & 255u], 1u); }
        __syncthreads();
        if (tid < 256) sfx[tid] = hist[tid];
        __syncthreads();
#pragma unroll 1
        for (int o = 1; o < 256; o <<= 1) { unsigned v = 0; if (tid < 256) v = sfx[tid] + (tid + o < 256 ? sfx[tid + o] : 0u); __syncthreads(); if (tid < 256) sfx[tid] = v; __syncthreads(); }
        if (tid < 256) { const unsigned incl = sfx[tid], excl = incl - hist[tid]; if (excl < krem && krem <= incl) { misc[0] = (unsigned)tid; misc[1] = krem - excl; } }
        __syncthreads();
        prefix |= misc[0] << shift; krem = misc[1];
        __syncthreads();
    }
    const unsigned T = prefix, need = krem;
    unsigned cg_ = 0, ce = 0;
#pragma unroll
    for (int i = 0; i < 8; ++i) { cg_ += key[i] > T; ce += key[i] == T; }
    unsigned sg = cg_, se = ce;
#pragma unroll
    for (int o = 1; o < 64; o <<= 1) { const unsigned tg = __shfl_up(sg, o), te = __shfl_up(se, o); if (lane >= o) { sg += tg; se += te; } }
    if (lane == 63) { misc[16 + F.wave] = sg; misc[32 + F.wave] = se; }
    __syncthreads();
    unsigned og = sg - cg_, oe = se - ce;
    for (int w = 0; w < F.wave; ++w) { og += misc[16 + w]; oe += misc[32 + w]; }
    int* SLOT = (int*)(a.ws + WS_SLOT) + (size_t)b * SEQ * 16 + e;
    float* VALS = (float*)(a.ws + WS_VALS) + (size_t)(e * 8 + b) * CAP;
    int* IDX = (int*)(a.ws + WS_IDX) + (size_t)(b * 16 + e) * CAP;
#pragma unroll
    for (int i = 0; i < 8; ++i) {
        const bool gt = key[i] > T, eq = key[i] == T; const bool sel = gt || (eq && oe < need);
        const unsigned pos = og + (oe < need ? oe : need);
        const int s = tid * 8 + i;
        SLOT[(size_t)s * 16] = sel ? (int)pos : -1;
        if (sel) { lidx[pos] = s; IDX[pos] = s; VALS[pos] = __uint_as_float(key[i]); }
        og += gt; oe += eq;
    }
    __syncthreads();
    const unsigned char* H2 = a.ws + WS_H2 + (size_t)b * SEQ * DM; unsigned char* XE = a.ws + WS_XE + (size_t)(e * 8 + b) * CAP * DM;
    for (int r0 = F.wave * 4; r0 < CAP; r0 += NWAVES * 4) { u32x4 v[4];
#pragma unroll
        for (int j = 0; j < 4; ++j) v[j] = ((const u32x4*)(H2 + (size_t)lidx[r0 + j] * DM))[lane];
#pragma unroll
        for (int j = 0; j < 4; ++j) ((u32x4*)(XE + (size_t)(r0 + j) * DM))[lane] = v[j]; }
    __syncthreads();
}

DI void final_phase(const Ctx& F, const Args& a) {
    const int gw = F.bid * NWAVES + F.wave, NGW = F.G * NWAVES, lane = F.lane;
    const float* mod = (const float*)(a.ws + WS_MOD); const int* SLOT = (const int*)(a.ws + WS_SLOT); const bf16_t* Y = (const bf16_t*)(a.ws + WS_Y);
    for (int m = gw; m < MTOK; m += NGW) {
        const int b = m / SEQ;
        const int sl = SLOT[(size_t)m * 16 + (lane & 15)];
        float acc[16];
#pragma unroll
        for (int i = 0; i < 16; ++i) acc[i] = 0.f;
#pragma unroll 1
        for (int e = 0; e < 16; ++e) { const int s = __shfl(sl, e);
            if (s >= 0) { const u32x4* yp = (const u32x4*)(Y + ((size_t)(e * 8 + b) * CAP + s) * DM + lane * 16); const u32x4 w0 = yp[0], w1 = yp[1];
                acc[0] += bflo(w0.x); acc[1] += bfhi(w0.x); acc[2] += bflo(w0.y); acc[3] += bfhi(w0.y); acc[4] += bflo(w0.z); acc[5] += bfhi(w0.z); acc[6] += bflo(w0.w); acc[7] += bfhi(w0.w);
                acc[8] += bflo(w1.x); acc[9] += bfhi(w1.x); acc[10] += bflo(w1.y); acc[11] += bfhi(w1.y); acc[12] += bflo(w1.z); acc[13] += bfhi(w1.z); acc[14] += bflo(w1.w); acc[15] += bfhi(w1.w); } }
        f32x4* op = (f32x4*)(a.out + (size_t)m * DM + lane * 16); const f32x4* gp = (const f32x4*)(mod + (size_t)b * 6144 + 5120 + lane * 16);
#pragma unroll
        for (int q = 0; q < 4; ++q) { const f32x4 g = gp[q]; f32x4 o = op[q]; o.x += g.x * acc[4 * q]; o.y += g.y * acc[4 * q + 1]; o.z += g.z * acc[4 * q + 2]; o.w += g.w * acc[4 * q + 3]; op[q] = o; }
    }
}

constexpr size_t WS_CTL = 0;
constexpr int CTL_ZERO_BYTES = 65536;
#define XB_TMO      128
#define XB_XCNT(j)  (256  + 64 * (j))
#define XB_XSUB(j)  (1280 + 64 * (j))
#define XB_XGEN(j)  (2304 + 64 * (j))
#define XB_TOP      3328
#define XB_TOPGEN   3392
#define XB_SPIN_CAP (1u << 18)
DI unsigned xb_ld(unsigned* p)              { return __hip_atomic_load(p, __ATOMIC_RELAXED, __HIP_MEMORY_SCOPE_AGENT); }
DI unsigned xb_add(unsigned* p, unsigned v) { return __hip_atomic_fetch_add(p, v, __ATOMIC_RELAXED, __HIP_MEMORY_SCOPE_AGENT); }
DI unsigned xb_xcc_id() { return (unsigned)__builtin_amdgcn_s_getreg((3 << 11) | 20) & 0xFu; }
#define XB_SPIN(cond, bar) do { unsigned _sp = 0; while (cond) { __builtin_amdgcn_s_sleep(1); \
    if ((++_sp & 255u) == 0u) { if (xb_ld(&(bar)[XB_TMO])) break; if (_sp > XB_SPIN_CAP) { atomicAdd(&(bar)[XB_TMO], 1u); break; } } } } while (0)
struct XcdBarrier { unsigned* bar; unsigned x; volatile LAS unsigned* st; };
DI XcdBarrier xcd_barrier_post(unsigned* bar, volatile LAS unsigned* st) {
    XcdBarrier b; b.bar = bar; b.x = xb_xcc_id(); b.st = st;
    if (threadIdx.x == 0) (void)xb_add(&bar[XB_XCNT(b.x)], 1u);
    return b;
}
DI void xcd_barrier_complete(unsigned* bar, unsigned x, unsigned& nloc, unsigned& nx) {
    const unsigned G = gridDim.x * gridDim.y * gridDim.z;
    unsigned sum, cnt, mine, sp = 0u;
    for (;;) {
        sum = 0u; cnt = 0u; mine = 0u;
#pragma unroll
        for (unsigned j = 0; j < 16; ++j) { const unsigned c = xb_ld(&bar[XB_XCNT(j)]); sum += c; cnt += (c > 0u) ? 1u : 0u; mine = (j == x) ? c : mine; }
        if (sum == G) break;
        __builtin_amdgcn_s_sleep(1);
        if ((++sp & 255u) == 0u) { if (xb_ld(&bar[XB_TMO])) break; if (sp > XB_SPIN_CAP) { atomicAdd(&bar[XB_TMO], 1u); break; } }
    }
    nloc = mine > 0u ? mine : 1u; nx = cnt > 0u ? cnt : 1u;
}
DI void xcd_barrier(const XcdBarrier& b) {
    asm volatile("s_waitcnt vmcnt(0)" ::: "memory");
    __syncthreads();
    if (threadIdx.x == 0) {
        unsigned* bar = b.bar;
        __builtin_amdgcn_s_waitcnt(0);
        unsigned nloc = b.st[0], nx = b.st[1];
        if (nloc == 0u) { xcd_barrier_complete(bar, b.x, nloc, nx); b.st[0] = nloc; b.st[1] = nx; }
        const unsigned old = xb_add(&bar[XB_XSUB(b.x)], 1u);
        const unsigned gen = old / nloc;
        if (old + 1u == (gen + 1u) * nloc) {
            __builtin_amdgcn_fence(__ATOMIC_RELEASE, "agent");
            asm volatile("s_waitcnt vmcnt(0)" ::: "memory");
            const unsigned og = xb_add(&bar[XB_TOP], 1u);
            const unsigned tg = og / nx;
            if (og + 1u == (tg + 1u) * nx) xb_add(&bar[XB_TOPGEN], 1u);
            else XB_SPIN(xb_ld(&bar[XB_TOPGEN]) == tg, bar);
            __builtin_amdgcn_fence(__ATOMIC_ACQUIRE, "agent");
            xb_add(&bar[XB_XGEN(b.x)], 1u);
            asm volatile("s_waitcnt vmcnt(0)" ::: "memory");
        } else {
            XB_SPIN(xb_ld(&bar[XB_XGEN(b.x)]) == gen, bar);
            __builtin_amdgcn_fence(__ATOMIC_ACQUIRE, "agent");
            asm volatile("s_waitcnt vmcnt(0)" ::: "memory");
        }
    }
    __syncthreads();
}

static_assert(sizeof(Args) == 22 * 8, "Args layout");
__global__ void __launch_bounds__(NTHR, 2) fwd_kernel(Args a_unused) {
    extern __shared__ __attribute__((aligned(16))) unsigned char lds_raw[];
    cg::grid_group grid = cg::this_grid();
    Ctx F; F.lds = (LAS unsigned char*)lds_raw; F.tid = threadIdx.x; F.lane = F.tid & 63; F.wave = __builtin_amdgcn_readfirstlane(F.tid >> 6); F.G = gridDim.x; F.bid = blockIdx.x;

    int lo, hi; { typedef __attribute__((address_space(4))) const volatile unsigned long long* kp_t; const unsigned long long ph = ((kp_t)__builtin_amdgcn_kernarg_segment_ptr())[21]; lo = (int)(unsigned)ph; hi = (int)(unsigned)(ph >> 32); }
#ifndef PHASE_MASK
#define PHASE_MASK 0xffff
#endif
#define IN(k) (((PHASE_MASK >> (k)) & 1) && lo <= (k) && (k) < hi)
    volatile LAS unsigned* bst = (volatile LAS unsigned*)(F.lds + LDS_BYTES - 64);
    if (F.tid < 2) bst[F.tid] = 0u;
    __syncthreads();
    XcdBarrier xbar;
    { const Args a0 = load_args(); xbar = xcd_barrier_post((unsigned*)(a0.ws + WS_CTL), bst); }
    volatile LAS unsigned long long* tsl = (volatile LAS unsigned long long*)(F.lds + LDS_BYTES - 256);
    if (PROBE_PHASE >= 0 && F.bid == 0 && F.tid == 0) tsl[0] = __builtin_amdgcn_s_memrealtime();
#define SEAM(k) do { if (IN(k) && IN((k) + 1)) { if ((k) == 0) grid.sync(); else xcd_barrier(xbar); } \
        if (PROBE_PHASE >= 0 && F.bid == 0 && F.tid == 0) tsl[(k) + 1] = __builtin_amdgcn_s_memrealtime(); } while (0)
    if (IN(0)) { const Args a = load_args();
#pragma unroll 1
        for (int rep = 0; rep < REP_P0; ++rep) p0_phase(F, a); }
    SEAM(0);
    if (IN(1)) { const Args a = load_args(); p1_phase(F, a); }
    SEAM(1);
    if (IN(2)) {
        const Args a = load_args();
        pg8::Gemm g{(const bf16_t*)a.out, (const bf16_t*)(a.ws + WS_WINT), MTOK, PS, DM, 1 << 30}; pg8::StaticOrder S; S.init(MTOK, PS, F.G, F.bid);
        pg8::EpiBf16 E{(bf16_t*)(a.ws + WS_PROJ), PS};
        pg8::gemm_phase<pg8::EpiBf16, true, true>(F.lds, g, S, E);
        gates_tasks(F, a);
    }
    SEAM(2);
    if (IN(3)) {
        const Args a = load_args();
        for (int t = F.bid; t < BATCH * 64; t += F.G) qk_tile_task(F, a, t);
        for (int t = F.bid * NWAVES + F.wave; t < MTOK / 8 * 2; t += F.G * NWAVES) conv_task(F, a, t);
        for (int t = F.bid; t < 64; t += F.G) mscal_task(F, a, t);
    }
    SEAM(3);
    if (IN(4)) {
        const Args a = load_args();
        {
#pragma unroll 1
            for (int rep = 0; rep < REP_MSEQ; ++rep)
#pragma unroll 1
            for (int it = F.bid; it < 256; it += F.G) { const int xcd_ = it & 7, j_ = it >> 3; mseq_item(F, a, xcd_ * 4 + (j_ >> 3), (j_ >> 2) & 1, j_ & 3); }
        }
        float lam, cshift;
        { const float p01 = wave_sum(a.lam_p[F.lane] * a.lam_p[64 + F.lane]), p23 = wave_sum(a.lam_p[128 + F.lane] * a.lam_p[192 + F.lane]);
          lam = __expf(p01) - __expf(p23) + 0.2f;
          const float gq = wave_max(fabsf(a.qk_g[F.lane])), gk = wave_max(fabsf(a.qk_g[64 + F.lane]));
          cshift = 8.f * gq * gk * 1.4426950408889634f * 1.02f; }
        const int xcd = F.bid & 7, j = F.bid >> 3;
#pragma unroll 1
        for (int rep = 0; rep < REP_ATT; ++rep)
        for (int i = 0; i * F.G < 1024; ++i) {
            int u;
            if (F.G == 256) u = (xcd * 4 + i) * 32 + j; else u = i * F.G + F.bid;
            if (u < 1024) attn_unit(F, a, u >> 7, (u >> 5) & 3, u & 31, lam, cshift);
        }
    }
    SEAM(4);
    if (IN(5)) { const Args a = load_args(); mcombine_phase(F, a); }
    SEAM(5);
    if (IN(6)) {
        const Args a = load_args();
        pg8::Gemm g{(const bf16_t*)(a.ws + WS_YMIX), (const bf16_t*)(a.ws + WS_WOUTT), MTOK, DM, DM, 1 << 30}; pg8::StaticOrder S; S.init(MTOK, DM, F.G, F.bid);
        pg8::EpiX1 E{a.x, (const float*)(a.ws + WS_MOD), a.out};
        pg8::gemm_phase<pg8::EpiX1, true, true>(F.lds, g, S, E);
    }
    SEAM(6);
    if (IN(7)) { const Args a = load_args();
#pragma unroll 1
        for (int rep = 0; rep < REP_P7; ++rep) p7_phase(F, a); }
    SEAM(7);
    if (IN(8)) { const Args a = load_args(); for (int t = F.bid; t < BATCH * NEXP; t += F.G) topk_task(F, a, t); }
    SEAM(8);
    if (IN(9)) {
        const Args a = load_args();
        pg8::Gemm g{(const bf16_t*)(a.ws + WS_XE), (const bf16_t*)(a.ws + WS_WGUT), NPAIR, 4096, DM, 16};
        pg8::StaticOrder S; S.init(NPAIR, 4096, F.G, F.bid);
        pg8::EpiGU E{a.ws + WS_HH};
#pragma unroll 1
        for (int rep = 0; rep < REP_UP; ++rep)
        pg8::gemm_phase<pg8::EpiGU, true, true, true>(F.lds, g, S, E);
    }
    SEAM(9);
    if (IN(10)) {
        const Args a = load_args();
        pg8::Gemm g{(const bf16_t*)(a.ws + WS_HH), (const bf16_t*)(a.ws + WS_WDT), NPAIR, DM, DFF, 16};
        pg8::StaticOrder S; S.init(NPAIR, DM, F.G, F.bid);
        pg8::EpiDown E{(bf16_t*)(a.ws + WS_Y), (const float*)(a.ws + WS_VALS)};
        pg8::gemm_phase<pg8::EpiDown, true, true, true>(F.lds, g, S, E);
    }
    SEAM(10);
    if (IN(11)) { const Args a = load_args(); final_phase(F, a); }
    if (PROBE_MSEQ_W >= 0 && F.bid == 0 && F.tid == 0) {
        const unsigned long long d = *(volatile LAS unsigned long long*)(F.lds + LDS_BYTES - 128), t1 = __builtin_amdgcn_s_memtime();
        while (__builtin_amdgcn_s_memtime() - t1 < 3ull * d) __builtin_amdgcn_s_sleep(8);
    }
    if (PROBE_PHASE >= 0 && F.bid == 0 && F.tid == 0) {
        const unsigned long long t1 = __builtin_amdgcn_s_memrealtime();
        const unsigned long long d = (PROBE_PHASE == 11 ? t1 : tsl[PROBE_PHASE + 1]) - tsl[PROBE_PHASE];
        while (__builtin_amdgcn_s_memrealtime() - t1 < 3ull * d) __builtin_amdgcn_s_sleep(8);
    }
#undef IN
#undef SEAM
}

extern "C" void kernel_launch(void* const* d_in, const int* in_sizes, int n_in, void* d_out, int out_size, void* d_ws, size_t ws_size, hipStream_t stream) {
    static int grid_blocks = 0;
    if (!grid_blocks) {
        int dev = 0, cus = 0, per_cu = 0;
        (void)hipGetDevice(&dev);
        (void)hipDeviceGetAttribute(&cus, hipDeviceAttributeMultiprocessorCount, dev);
        (void)hipFuncSetAttribute((const void*)fwd_kernel, hipFuncAttributeMaxDynamicSharedMemorySize, LDS_BYTES);
        (void)hipOccupancyMaxActiveBlocksPerMultiprocessor(&per_cu, (const void*)fwd_kernel, NTHR, LDS_BYTES);
        if (per_cu < 1) per_cu = 1;
        grid_blocks = cus;
        if (ws_size < WS_END) fprintf(stderr, "kernel_launch: workspace too small: %zu < %zu\n", ws_size, (size_t)WS_END);
    }
    (void)hipMemsetAsync((char*)d_ws + WS_CTL, 0, CTL_ZERO_BYTES, stream);
    Args a{};
    a.x = (const float*)d_in[0]; a.c = (const float*)d_in[1]; a.pos = (const int*)d_in[2]; a.norm1_g = (const float*)d_in[3]; a.norm2_g = (const float*)d_in[4];
    a.w_ada = (const float*)d_in[5]; a.b_ada = (const float*)d_in[6]; a.w_in = (const float*)d_in[7]; a.conv_w = (const float*)d_in[8]; a.gate_b = (const float*)d_in[9];
    a.mnorm_g = (const float*)d_in[10]; a.qk_g = (const float*)d_in[11]; a.lam_p = (const float*)d_in[12]; a.subln_g = (const float*)d_in[13]; a.w_out = (const float*)d_in[14];
    a.w_router = (const float*)d_in[15]; a.w_gate = (const float*)d_in[16]; a.w_up = (const float*)d_in[17]; a.w_down = (const float*)d_in[18];
    a.out = (float*)d_out; a.ws = (unsigned char*)d_ws; a.ph_lo = 0; a.ph_hi = 12;
    void* args[] = {&a};
    hipError_t e = hipLaunchCooperativeKernel((const void*)fwd_kernel, dim3(grid_blocks), dim3(NTHR), args, LDS_BYTES, stream);
    if (e != hipSuccess) fprintf(stderr, "cooperative launch failed: %s (grid %d)\n", hipGetErrorString(e), grid_blocks);
}
```

```cpp
#include <hip/hip_runtime.h>
#include <hip/hip_cooperative_groups.h>
#include <cstdio>
#include <cstdint>
namespace cg = cooperative_groups;

#define LAS __attribute__((address_space(3)))
#define DI __device__ __forceinline__
typedef unsigned short bf16_t;
typedef short bf16x8 __attribute__((ext_vector_type(8)));
typedef short s16x4 __attribute__((ext_vector_type(4)));
typedef float f32x2 __attribute__((ext_vector_type(2)));
typedef float f32x4 __attribute__((ext_vector_type(4)));
typedef float f32x16 __attribute__((ext_vector_type(16)));
typedef unsigned u32x2 __attribute__((ext_vector_type(2)));
typedef unsigned u32x4 __attribute__((ext_vector_type(4)));
typedef __bf16 bf16x2_t __attribute__((ext_vector_type(2)));

constexpr int BATCH = 8, SEQ = 4096, DM = 1024, MTOK = BATCH * SEQ;
constexpr int DIN = 3600, PS = 3584;
constexpr int NEXP = 16, CAP = 512, DFF = 2048;
constexpr int NPAIR = BATCH * NEXP * CAP;
constexpr float EPS = 1e-6f;
constexpr int C_QM = 0, C_KM = 512, C_VM = 1024, C_OM = 1536, C_QA = 2048, C_KA = 2560, C_VA = 3072;

constexpr size_t MiB = 1u << 20;
constexpr size_t WS_MOD = 1 * MiB;
constexpr size_t WS_GATES = 2 * MiB;
constexpr size_t WS_AFF = 4 * MiB;
constexpr size_t WS_IDX = 6 * MiB;
constexpr size_t WS_VALS = 6 * MiB + 256 * 1024;
constexpr size_t WS_MSC = 6 * MiB + 512 * 1024;
constexpr size_t WS_SLOT = 7 * MiB;
constexpr size_t WS_NLOC = 9 * MiB;
constexpr size_t WS_WINT = 11 * MiB;
constexpr size_t WS_WGT = 18 * MiB;
constexpr size_t WS_WOUTT = 19 * MiB;
constexpr size_t WS_WGUT = 21 * MiB;
constexpr size_t WS_WDT = 85 * MiB;
constexpr size_t WS_Y = 117 * MiB;
constexpr size_t WS_PROJ = 213 * MiB;
constexpr size_t WS_YMIX = 437 * MiB;
constexpr size_t WS_KIMG = 437 * MiB;
constexpr size_t WS_VIMG = 469 * MiB;
constexpr size_t WS_YA = 501 * MiB;
constexpr size_t WS_HH = 245 * MiB;
constexpr size_t WS_H2 = 437 * MiB;
constexpr size_t WS_XE = 469 * MiB;
constexpr size_t WS_END = 533 * MiB;

constexpr int LDS_BYTES = 147456;
constexpr int PROBE_MSEQ_W = -1;
constexpr int PROBE_PHASE = -1;
constexpr int REP_M1 = 1, REP_M3 = 1, REP_UP = 1, REP_P0 = 1, REP_SCAN = 1, REP_P7 = 1, REP_ATT = 1, REP_QKT = 1, REP_MSEQ = 1;
constexpr int NWAVES = 8, NTHR = 512;

DI unsigned pk2(float lo, float hi) { f32x2 v = {lo, hi}; bf16x2_t b = __builtin_convertvector(v, bf16x2_t); return __builtin_bit_cast(unsigned, b); }
DI float bflo(unsigned w) { return __uint_as_float(w << 16); }
DI float bfhi(unsigned w) { return __uint_as_float(w & 0xffff0000u); }
DI float bf2f(bf16_t v) { return __uint_as_float((unsigned)v << 16); }
template <int CTRL> DI float dpp_mov(float x) { return __builtin_bit_cast(float, __builtin_amdgcn_update_dpp(0, __builtin_bit_cast(int, x), CTRL, 0xf, 0xf, false)); }
#define DPP_XOR1 0xB1
#define DPP_XOR2 0x4E
#define DPP_ROR(n) (0x120 + (n))
DI float xor16_sum(float x) { const unsigned u = __builtin_bit_cast(unsigned, x); auto r = __builtin_amdgcn_permlane16_swap(u, u, false, false); return __builtin_bit_cast(float, (unsigned)r[0]) + __builtin_bit_cast(float, (unsigned)r[1]); }
DI float xor32_sum(float x) { const unsigned u = __builtin_bit_cast(unsigned, x); auto r = __builtin_amdgcn_permlane32_swap(u, u, false, false); return __builtin_bit_cast(float, (unsigned)r[0]) + __builtin_bit_cast(float, (unsigned)r[1]); }
DI float xor16_max(float x) { const unsigned u = __builtin_bit_cast(unsigned, x); auto r = __builtin_amdgcn_permlane16_swap(u, u, false, false); return fmaxf(__builtin_bit_cast(float, (unsigned)r[0]), __builtin_bit_cast(float, (unsigned)r[1])); }
DI float xor32_max(float x) { const unsigned u = __builtin_bit_cast(unsigned, x); auto r = __builtin_amdgcn_permlane32_swap(u, u, false, false); return fmaxf(__builtin_bit_cast(float, (unsigned)r[0]), __builtin_bit_cast(float, (unsigned)r[1])); }
DI float partner32(float x, int lane) { const unsigned u = __builtin_bit_cast(unsigned, x); auto r = __builtin_amdgcn_permlane32_swap(u, u, false, false); return __builtin_bit_cast(float, (unsigned)((lane & 32) ? r[0] : r[1])); }
DI float partner16(float x, int lane) { const unsigned u = __builtin_bit_cast(unsigned, x); auto r = __builtin_amdgcn_permlane16_swap(u, u, false, false); return __builtin_bit_cast(float, (unsigned)((lane & 16) ? r[0] : r[1])); }
DI float partner8(float x) { return dpp_mov<DPP_ROR(8)>(x); }
DI float partner4(float x, int lane) { const float a = dpp_mov<DPP_ROR(4)>(x), b = dpp_mov<DPP_ROR(12)>(x); return (lane & 4) ? a : b; }
DI float row_sum16(float v) { v += dpp_mov<DPP_XOR1>(v); v += dpp_mov<DPP_XOR2>(v); v += dpp_mov<DPP_ROR(4)>(v); v += dpp_mov<DPP_ROR(8)>(v); return v; }
DI float wave_sum(float v) { v = row_sum16(v); v = xor16_sum(v); return xor32_sum(v); }
DI float wave_max(float v) { v = fmaxf(v, dpp_mov<DPP_XOR1>(v)); v = fmaxf(v, dpp_mov<DPP_XOR2>(v)); v = fmaxf(v, dpp_mov<DPP_ROR(4)>(v)); v = fmaxf(v, dpp_mov<DPP_ROR(8)>(v)); v = xor16_max(v); return xor32_max(v); }
DI float sigmoid_f(float v) { return __builtin_amdgcn_rcpf(1.f + __builtin_amdgcn_exp2f(-1.4426950408889634f * v)); }
DI float silu_f(float v) { return v * sigmoid_f(v); }
DI float logsigmoid_f(float f) { return fminf(f, 0.f) - log1pf(__expf(-fabsf(f))); }
DI int swz16(int row) { return ((row & 3) << 2) | ((row >> 2) & 3); }
#define MFMA32(a, b, c) __builtin_amdgcn_mfma_f32_32x32x16_bf16((a), (b), (c), 0, 0, 0)
DI s16x4 trread(const LAS unsigned char* p) { return __builtin_bit_cast(s16x4, __builtin_amdgcn_ds_read_tr16_b64_v4i16((LAS s16x4*)p)); }
DI int crow(int r, int hh) { return (r & 3) + 8 * (r >> 2) + 4 * hh; }
DI bool hh_sel(int lane, int bit) { return (lane & bit) != 0; }

namespace pg8 {
constexpr int BM = 256, BK = 64, HALF = 128, HTB = HALF * BK * 2, STAGE_BYTES = 8 * HTB, NXCD = 8, WGM = 8;
DI int lds_byte(int r, int c) { const int st = (r >> 4) * 2 + (c >> 5), rr = r & 15, cc = c & 31, ob = rr * 64 + cc * 2; return st * 1024 + (ob ^ (((ob >> 9) & 1) << 5)); }
DI void stage_rc(int b, int& R, int& C) { const int st = b / 1024, sb = b % 1024, swz = sb ^ (((sb >> 9) & 1) << 5); R = (st >> 1) * 16 + swz / 64; C = (st & 1) * 32 + (swz % 64) / 2; }
DI int perm32(int rho) { const int n = rho >> 4, i = rho & 15; return 8 * (i >> 2) + 4 * n + (i & 3); }
struct Unit { int pm, pn; };
typedef int i32x4_t __attribute__((ext_vector_type(4)));
typedef int i32x8_t __attribute__((ext_vector_type(8)));
DI i32x8_t cat8(bf16x8 lo, bf16x8 hi) { const i32x4_t a = __builtin_bit_cast(i32x4_t, lo), b = __builtin_bit_cast(i32x4_t, hi); return __builtin_shufflevector(a, b, 0, 1, 2, 3, 4, 5, 6, 7); }
struct Gemm { const bf16_t* A; const bf16_t* Bt; int M, N, K, tpg; };
struct StaticOrder {
    int nM, nN, nwg, G, c;
    DI void init(int M, int N, int G_, int c_) { nM = M / BM; nN = N / BM; nwg = nM * nN; G = G_; c = c_; }
    DI bool next(int i, Unit& u) const {
        const long L = (long)i * G + c; if (L >= nwg) return false;
        int wgid = (int)L; { const int q = nwg / NXCD, r = nwg % NXCD, xcd = wgid % NXCD, off = wgid / NXCD; wgid = (xcd < r ? xcd * (q + 1) : r * (q + 1) + (xcd - r) * q) + off; }
        const int nig = WGM * nN, gid = wgid / nig, fm = gid * WGM, gsz = (nM - fm) < WGM ? (nM - fm) : WGM;
        u.pm = fm + ((wgid % nig) % gsz); u.pn = (wgid % nig) / gsz; return true;
    }
};

template <class Epi, bool ALIGN_EPI, bool SP2, bool FP8 = false>
DI void gemm_phase(LAS unsigned char* lds, const Gemm g, const StaticOrder& S, const Epi& E) {
    const int tid = threadIdx.x, wid = __builtin_amdgcn_readfirstlane(tid >> 6), lane = tid & 63, wr = wid >> 2, wc = wid & 3, fr = lane & 15, fq = lane >> 4;
    const int KB = FP8 ? g.K : 2 * g.K, nt = KB / (BK * 2);
    unsigned voffA[2], voffB[2];
#pragma unroll
    for (int i = 0; i < 2; ++i) { int R, C; stage_rc(tid * 16 + i * 8192, R, C); const int Rb = Epi::PERM ? ((R & ~31) + perm32(R & 31)) : R;
        voffA[i] = (unsigned)(R * KB + C * 2); voffB[i] = (unsigned)(Rb * KB + C * 2); }
    const size_t kstep = (size_t)(BK * 2);
    const size_t hstep = (size_t)HALF * KB;
    const size_t tstep = 2 * hstep;
    const size_t gstep = (size_t)g.N * KB;
    const unsigned ldsw = (unsigned)wid * 1024u;
    const int aoff = lds_byte(wr * 64 + fr, fq * 8), boff = lds_byte(wc * 32 + fr, fq * 8);
#define PG8_SA(b, h) (((b) * 2 + (h)) * HTB)
#define PG8_SB(b, h) ((4 + (b) * 2 + (h)) * HTB)
#define PG8_STAGE(bufoff, gbase, voff) do { _Pragma("unroll") for (int _i = 0; _i < 2; ++_i) \
        __builtin_amdgcn_global_load_lds((const unsigned*)((const char*)(gbase) + (voff)[_i]), (LAS unsigned*)(lds + (bufoff) + ldsw + _i * 8192), 16, 0, 0); } while (0)
#define PG8_LDA(dst, b, h) do { if constexpr (FP8) { _Pragma("unroll") for (int m = 0; m < 4; ++m) dst##8[m] = cat8(*(const LAS bf16x8*)(lds + PG8_SA(b, h) + aoff + m * 2048), *(const LAS bf16x8*)(lds + PG8_SA(b, h) + aoff + m * 2048 + 1024)); } \
        else { _Pragma("unroll") for (int m = 0; m < 4; ++m) _Pragma("unroll") for (int k = 0; k < 2; ++k) dst[m][k] = *(const LAS bf16x8*)(lds + PG8_SA(b, h) + aoff + m * 2048 + k * 1024); } } while (0)
#define PG8_LDB(dst, b, h) do { if constexpr (FP8) { _Pragma("unroll") for (int n = 0; n < 2; ++n) dst##8[n] = cat8(*(const LAS bf16x8*)(lds + PG8_SB(b, h) + boff + n * 2048), *(const LAS bf16x8*)(lds + PG8_SB(b, h) + boff + n * 2048 + 1024)); } \
        else { _Pragma("unroll") for (int n = 0; n < 2; ++n) _Pragma("unroll") for (int k = 0; k < 2; ++k) dst[n][k] = *(const LAS bf16x8*)(lds + PG8_SB(b, h) + boff + n * 2048 + k * 1024); } } while (0)
#define PG8_MMA(ai, bj, At, Bt) do { __builtin_amdgcn_s_setprio(1); \
        if constexpr (FP8) { _Pragma("unroll") for (int m = 0; m < 4; ++m) _Pragma("unroll") for (int n = 0; n < 2; ++n) \
            asm volatile("s_nop 1\n\tv_mfma_f32_16x16x128_f8f6f4 %0, %1, %2, %0" : "+v"(acc[ai][bj][m][n]) : "v"(Bt##8[n]), "v"(At##8[m])); } \
        else { _Pragma("unroll") for (int m = 0; m < 4; ++m) _Pragma("unroll") for (int n = 0; n < 2; ++n) _Pragma("unroll") for (int k = 0; k < 2; ++k) \
            acc[ai][bj][m][n] = __builtin_amdgcn_mfma_f32_16x16x32_bf16(Bt[n][k], At[m][k], acc[ai][bj][m][n], 0, 0, 0); } \
        __builtin_amdgcn_s_setprio(0); } while (0)
#define PG8_WAIT_V(n) asm volatile("s_waitcnt vmcnt(" #n ")" ::: "memory")
#define PG8_WAIT_L(n) asm volatile("s_waitcnt lgkmcnt(" #n ")" ::: "memory")
#define PG8_BAR __builtin_amdgcn_s_barrier()
#define PG8_SCHED __builtin_amdgcn_sched_barrier(0)
    Unit cur, nxt; int ui = 0;
    if (!S.next(0, cur)) return;
    f32x4 acc[2][2][4][2];
#pragma unroll
    for (int a = 0; a < 2; ++a)
#pragma unroll
        for (int b = 0; b < 2; ++b)
#pragma unroll
            for (int m = 0; m < 4; ++m)
#pragma unroll
                for (int n = 0; n < 2; ++n) acc[a][b][m][n] = (f32x4){0.f, 0.f, 0.f, 0.f};
    bf16x8 At[4][2], B0[2][2], B1[2][2]; i32x8_t At8[4], B08[2], B18[2];
    const char* cA = (const char*)g.A + (size_t)cur.pm * tstep; const char* cB = (const char*)g.Bt + (size_t)(cur.pm / g.tpg) * gstep + (size_t)cur.pn * tstep;
    if constexpr (SP2) {
        PG8_STAGE(PG8_SB(0, 0), cB, voffB); PG8_STAGE(PG8_SB(0, 1), cB + hstep, voffB); PG8_STAGE(PG8_SA(0, 0), cA, voffA); PG8_STAGE(PG8_SA(0, 1), cA + hstep, voffA);
        if (wr == 1) PG8_BAR;
        PG8_WAIT_V(2); PG8_BAR;
        PG8_STAGE(PG8_SB(1, 0), cB + kstep, voffB); PG8_STAGE(PG8_SA(1, 0), cA + kstep, voffA); PG8_STAGE(PG8_SB(1, 1), cB + hstep + kstep, voffB);
        PG8_WAIT_V(6); PG8_BAR;
    } else {
        PG8_STAGE(PG8_SB(0, 0), cB, voffB); PG8_STAGE(PG8_SA(0, 0), cA, voffA); PG8_STAGE(PG8_SB(0, 1), cB + hstep, voffB); PG8_STAGE(PG8_SA(0, 1), cA + hstep, voffA);
        if (wr == 1) PG8_BAR;
        PG8_WAIT_V(4); PG8_BAR;
        PG8_STAGE(PG8_SB(1, 0), cB + kstep, voffB); PG8_STAGE(PG8_SA(1, 0), cA + kstep, voffA); PG8_STAGE(PG8_SB(1, 1), cB + hstep + kstep, voffB);
        PG8_WAIT_V(6); PG8_BAR;
    }
    for (;;) {
        const bool has_next = S.next(ui + 1, nxt);
        const char* nA = has_next ? (const char*)g.A + (size_t)nxt.pm * tstep : cA;
        const char* nB = has_next ? (const char*)g.Bt + (size_t)(nxt.pm / g.tpg) * gstep + (size_t)nxt.pn * tstep : cB;
        for (int t = 0; t < nt; t += 2) {
            const bool last = (t == nt - 2);
            const char* a1 = cA + (size_t)(t + 1) * kstep;
            const char* a2 = last ? nA : cA + (size_t)(t + 2) * kstep; const char* b2 = last ? nB : cB + (size_t)(t + 2) * kstep;
            const char* a3 = a2 + kstep; const char* b3 = b2 + kstep;
            if constexpr (SP2) {
            PG8_LDB(B0, 0, 0); PG8_LDB(B1, 0, 1); PG8_SCHED; PG8_LDA(At, 0, 0); PG8_STAGE(PG8_SA(1, 1), a1 + hstep, voffA);
            PG8_WAIT_V(8); PG8_WAIT_L(0); PG8_BAR; PG8_MMA(0, 0, At, B0); PG8_MMA(0, 1, At, B1); PG8_BAR; PG8_SCHED;
            PG8_LDA(At, 0, 1); PG8_STAGE(PG8_SB(0, 0), b2, voffB); PG8_STAGE(PG8_SB(0, 1), b2 + hstep, voffB); PG8_STAGE(PG8_SA(0, 0), a2, voffA);
            PG8_WAIT_V(8); PG8_WAIT_L(0); PG8_BAR; PG8_MMA(1, 0, At, B0); PG8_MMA(1, 1, At, B1); PG8_BAR; PG8_SCHED;
            PG8_LDB(B0, 1, 0); PG8_LDB(B1, 1, 1); PG8_SCHED; PG8_LDA(At, 1, 0); PG8_STAGE(PG8_SA(0, 1), a2 + hstep, voffA);
            PG8_WAIT_V(8); PG8_WAIT_L(0); PG8_BAR; PG8_MMA(0, 0, At, B0); PG8_MMA(0, 1, At, B1); PG8_BAR; PG8_SCHED;
            PG8_LDA(At, 1, 1); PG8_STAGE(PG8_SB(1, 0), b3, voffB); PG8_STAGE(PG8_SB(1, 1), b3 + hstep, voffB); PG8_STAGE(PG8_SA(1, 0), a3, voffA);
            PG8_WAIT_V(8); PG8_WAIT_L(0); PG8_BAR; PG8_MMA(1, 0, At, B0); PG8_MMA(1, 1, At, B1); PG8_BAR; PG8_SCHED;
            } else {
            PG8_LDB(B0, 0, 0); PG8_SCHED; PG8_LDA(At, 0, 0); PG8_STAGE(PG8_SA(1, 1), a1 + hstep, voffA);
            PG8_WAIT_L(8); PG8_BAR; PG8_WAIT_L(0); PG8_MMA(0, 0, At, B0); PG8_BAR; PG8_SCHED;
            PG8_LDB(B1, 0, 1); PG8_STAGE(PG8_SB(0, 0), b2, voffB);
            PG8_BAR; PG8_WAIT_L(0); PG8_MMA(0, 1, At, B1); PG8_BAR;
            PG8_LDA(At, 0, 1); PG8_STAGE(PG8_SA(0, 0), a2, voffA);
            PG8_BAR; PG8_WAIT_L(0); PG8_MMA(1, 0, At, B0); PG8_BAR; PG8_SCHED;
            PG8_STAGE(PG8_SB(0, 1), b2 + hstep, voffB);
            PG8_WAIT_V(6); PG8_BAR; PG8_MMA(1, 1, At, B1); PG8_BAR;
            PG8_LDB(B0, 1, 0); PG8_SCHED; PG8_LDA(At, 1, 0); PG8_STAGE(PG8_SA(0, 1), a2 + hstep, voffA);
            PG8_WAIT_L(8); PG8_BAR; PG8_WAIT_L(0); PG8_MMA(0, 0, At, B0); PG8_BAR; PG8_SCHED;
            PG8_LDB(B1, 1, 1); PG8_STAGE(PG8_SB(1, 0), b3, voffB);
            PG8_BAR; PG8_WAIT_L(0); PG8_MMA(0, 1, At, B1); PG8_BAR;
            PG8_LDA(At, 1, 1); PG8_STAGE(PG8_SA(1, 0), a3, voffA);
            PG8_BAR; PG8_WAIT_L(0); PG8_MMA(1, 0, At, B0); PG8_BAR; PG8_SCHED;
            PG8_STAGE(PG8_SB(1, 1), b3 + hstep, voffB);
            PG8_WAIT_V(6); PG8_BAR; PG8_MMA(1, 1, At, B1); PG8_BAR;
            }
        }
        if constexpr (ALIGN_EPI) { if (wr == 0) PG8_BAR; }
        if constexpr (FP8) asm volatile("s_nop 15\n\ts_nop 7" ::: "memory");
        E(acc, cur, wr, wc, fr, fq);
        if (!has_next) break;
#pragma unroll
        for (int a = 0; a < 2; ++a)
#pragma unroll
            for (int b = 0; b < 2; ++b)
#pragma unroll
                for (int m = 0; m < 4; ++m)
#pragma unroll
                    for (int n = 0; n < 2; ++n) acc[a][b][m][n] = (f32x4){0.f, 0.f, 0.f, 0.f};
        cur = nxt; cA = nA; cB = nB; ++ui;
        if constexpr (ALIGN_EPI) { if (wr == 1) PG8_BAR; }
    }
    PG8_WAIT_V(0);
    if constexpr (!ALIGN_EPI) { if (wr == 0) PG8_BAR; }
    PG8_BAR;
#undef PG8_SA
#undef PG8_SB
#undef PG8_STAGE
#undef PG8_LDA
#undef PG8_LDB
#undef PG8_MMA
#undef PG8_WAIT_V
#undef PG8_WAIT_L
#undef PG8_BAR
#undef PG8_SCHED
}

struct EpiBf16 {
    static constexpr bool PERM = true;
    bf16_t* O; int ldc;
    DI void operator()(const f32x4 (&acc)[2][2][4][2], const Unit& u, int wr, int wc, int fr, int fq) const {
        const int row0 = u.pm * BM + wr * 64 + fr, col0 = u.pn * BM + wc * 32 + 8 * fq;
#pragma unroll
        for (int ai = 0; ai < 2; ++ai)
#pragma unroll
            for (int m = 0; m < 4; ++m) { bf16_t* rowp = O + (size_t)(row0 + ai * HALF + m * 16) * ldc + col0;
#pragma unroll
                for (int bj = 0; bj < 2; ++bj) { const f32x4 v0 = acc[ai][bj][m][0], v1 = acc[ai][bj][m][1];
                    u32x4 w; w.x = pk2(v0[0], v0[1]); w.y = pk2(v0[2], v0[3]); w.z = pk2(v1[0], v1[1]); w.w = pk2(v1[2], v1[3]);
                    *(u32x4*)(rowp + bj * HALF) = w; } }
    }
};
struct EpiX1 {
    static constexpr bool PERM = false;
    const float* x; const float* mod; float* out;
    DI void operator()(const f32x4 (&acc)[2][2][4][2], const Unit& u, int wr, int wc, int fr, int fq) const {
        const int row0 = u.pm * BM + wr * 64 + fr, col0 = u.pn * BM + wc * 32 + 4 * fq;
        const int b = (u.pm * BM) / SEQ;
        const float* gp = mod + (size_t)b * 6144 + 2048 + col0;
#pragma unroll
        for (int bj = 0; bj < 2; ++bj)
#pragma unroll
            for (int n = 0; n < 2; ++n) { const f32x4 gv = *(const f32x4*)(gp + bj * HALF + n * 16);
#pragma unroll
                for (int ai = 0; ai < 2; ++ai)
#pragma unroll
                    for (int m = 0; m < 4; ++m) { const size_t off = (size_t)(row0 + ai * HALF + m * 16) * DM + col0 + bj * HALF + n * 16;
                        const f32x4 xv = *(const f32x4*)(x + off); *(f32x4*)(out + off) = xv + gv * acc[ai][bj][m][n]; } }
    }
};
DI unsigned pk4_fp8(float a, float b, float c, float d) { int w = __builtin_amdgcn_cvt_pk_fp8_f32(a, b, 0, false); w = __builtin_amdgcn_cvt_pk_fp8_f32(c, d, w, true); return (unsigned)w; }
constexpr float W_PRESCALE = 32.f, H_PRESCALE = 8.f;
struct EpiGU {
    static constexpr bool PERM = true;
    unsigned char* H;
    DI void operator()(const f32x4 (&acc)[2][2][4][2], const Unit& u, int wr, int wc, int fr, int fq) const {
        const int row0 = u.pm * BM + wr * 64 + fr, col0 = u.pn * HALF + wc * 32 + 8 * fq;
#pragma unroll
        for (int ai = 0; ai < 2; ++ai)
#pragma unroll
            for (int m = 0; m < 4; ++m) { unsigned char* rowp = H + (size_t)(row0 + ai * HALF + m * 16) * DFF + col0;
                float hv[8];
#pragma unroll
                for (int n = 0; n < 2; ++n)
#pragma unroll
                    for (int j = 0; j < 4; ++j) { const float gg = acc[ai][0][m][n][j] * (1.f / W_PRESCALE), uu = acc[ai][1][m][n][j] * (H_PRESCALE / W_PRESCALE); hv[n * 4 + j] = gg * __builtin_amdgcn_rcpf(1.f + __builtin_amdgcn_exp2f(-1.4426950408889634f * gg)) * uu; }
                u32x2 w; w.x = pk4_fp8(hv[0], hv[1], hv[2], hv[3]); w.y = pk4_fp8(hv[4], hv[5], hv[6], hv[7]);
                *(u32x2*)rowp = w; }
    }
};
struct EpiDown {
    static constexpr bool PERM = true;
    bf16_t* Y; const float* vals;
    DI void operator()(const f32x4 (&acc)[2][2][4][2], const Unit& u, int wr, int wc, int fr, int fq) const {
        const int row0 = u.pm * BM + wr * 64 + fr, col0 = u.pn * BM + wc * 32 + 8 * fq;
#pragma unroll
        for (int ai = 0; ai < 2; ++ai)
#pragma unroll
            for (int m = 0; m < 4; ++m) { const int row = row0 + ai * HALF + m * 16; const float s = vals[row] * (1.f / (W_PRESCALE * H_PRESCALE)); bf16_t* rowp = Y + (size_t)row * DM + col0;
#pragma unroll
                for (int bj = 0; bj < 2; ++bj) { const f32x4 v0 = acc[ai][bj][m][0] * s, v1 = acc[ai][bj][m][1] * s;
                    u32x4 w; w.x = pk2(v0[0], v0[1]); w.y = pk2(v0[2], v0[3]); w.z = pk2(v1[0], v1[1]); w.w = pk2(v1[2], v1[3]);
                    *(u32x4*)(rowp + bj * HALF) = w; } }
    }
};
}

struct Args {
    const float* x; const float* c; const int* pos; const float* norm1_g; const float* norm2_g; const float* w_ada; const float* b_ada;
    const float* w_in; const float* conv_w; const float* gate_b; const float* mnorm_g; const float* qk_g; const float* lam_p; const float* subln_g;
    const float* w_out; const float* w_router; const float* w_gate; const float* w_up; const float* w_down;
    float* out; unsigned char* ws; int ph_lo, ph_hi;
};
struct Ctx {
    LAS unsigned char* lds; int tid, lane, wave, G, bid;
};
DI Args load_args() {
    typedef __attribute__((address_space(4))) const volatile unsigned long long* kp_t;
    kp_t kp = (kp_t)__builtin_amdgcn_kernarg_segment_ptr();
#define GP(T, i) ((T*)(__attribute__((address_space(1))) T*)kp[i])
    Args a;
    a.x = GP(const float, 0); a.c = GP(const float, 1); a.pos = GP(const int, 2); a.norm1_g = GP(const float, 3); a.norm2_g = GP(const float, 4);
    a.w_ada = GP(const float, 5); a.b_ada = GP(const float, 6); a.w_in = GP(const float, 7); a.conv_w = GP(const float, 8); a.gate_b = GP(const float, 9);
    a.mnorm_g = GP(const float, 10); a.qk_g = GP(const float, 11); a.lam_p = GP(const float, 12); a.subln_g = GP(const float, 13); a.w_out = GP(const float, 14);
    a.w_router = GP(const float, 15); a.w_gate = GP(const float, 16); a.w_up = GP(const float, 17); a.w_down = GP(const float, 18);
    a.out = GP(float, 19); a.ws = GP(unsigned char, 20);
#undef GP
    a.ph_lo = 0; a.ph_hi = 12;
    return a;
}

DI void tr_item64(const float* src, size_t ld_src, int k0, int c0, bf16_t* dst, size_t r0, int ld_dst, LAS float* scr  , int lane) {
    const float* sp = src + (size_t)(k0 + (lane >> 4)) * ld_src + c0 + (lane & 15) * 4;
#pragma unroll 1
    for (int hf = 0; hf < 2; ++hf) {
        f32x4 v[8];
#pragma unroll
        for (int i = 0; i < 8; ++i) v[i] = *(const f32x4*)(sp + (size_t)(4 * (8 * hf + i)) * ld_src);
#pragma unroll
        for (int i = 0; i < 8; ++i) *(LAS f32x4*)(scr + (4 * (8 * hf + i) + (lane >> 4)) * 68 + (lane & 15) * 4) = v[i];
    }
    asm volatile("s_waitcnt lgkmcnt(0)" ::: "memory");
    const int c = lane & 7;
#pragma unroll
    for (int q = 0; q < 8; ++q) { const int n = 8 * q + (lane >> 3); const LAS float* s = scr + (8 * c) * 68 + n;
        u32x4 o; o.x = pk2(s[0 * 68], s[1 * 68]); o.y = pk2(s[2 * 68], s[3 * 68]); o.z = pk2(s[4 * 68], s[5 * 68]); o.w = pk2(s[6 * 68], s[7 * 68]);
        *(u32x4*)(dst + (r0 + n) * ld_dst + k0 + 8 * c) = o; }
    asm volatile("s_waitcnt lgkmcnt(0)" ::: "memory");
}
DI void tr_item64_fp8(const float* src, size_t ld_src, int k0, int c0, unsigned char* dst, size_t r0, int ld_dst, float scale, LAS float* scr  , int lane) {
    const float* sp = src + (size_t)(k0 + (lane >> 4)) * ld_src + c0 + (lane & 15) * 4;
    {
        f32x4 v[16];
#pragma unroll
        for (int i = 0; i < 16; ++i) v[i] = __builtin_nontemporal_load((const f32x4*)(sp + (size_t)(4 * i) * ld_src));
#pragma unroll
        for (int i = 0; i < 16; ++i) *(LAS f32x4*)(scr + (4 * i + (lane >> 4)) * 68 + (lane & 15) * 4) = v[i] * scale;
    }
    asm volatile("s_waitcnt lgkmcnt(0)" ::: "memory");
    const int c = lane & 3;
#pragma unroll
    for (int q = 0; q < 4; ++q) { const int n = 16 * q + (lane >> 2); const LAS float* s = scr + (16 * c) * 68 + n;
        u32x4 o; o.x = pg8::pk4_fp8(s[0 * 68], s[1 * 68], s[2 * 68], s[3 * 68]); o.y = pg8::pk4_fp8(s[4 * 68], s[5 * 68], s[6 * 68], s[7 * 68]);
        o.z = pg8::pk4_fp8(s[8 * 68], s[9 * 68], s[10 * 68], s[11 * 68]); o.w = pg8::pk4_fp8(s[12 * 68], s[13 * 68], s[14 * 68], s[15 * 68]);
        *(u32x4*)(dst + (r0 + n) * ld_dst + k0 + 16 * c) = o; }
    asm volatile("s_waitcnt lgkmcnt(0)" ::: "memory");
}
DI void p0_phase(const Ctx& F, const Args& a) {
    if (F.bid < 96) {
        LAS float* sc = (LAS float*)F.lds; LAS float* part = (LAS float*)(F.lds + 32768);
        for (int i = F.tid; i < BATCH * DM; i += NTHR) sc[i] = silu_f(a.c[i]);
        __syncthreads();
        const int col = F.bid * 64 + F.lane;
        float acc[8];
#pragma unroll
        for (int b = 0; b < 8; ++b) acc[b] = 0.f;
        const int kb = F.wave * 128;
#pragma unroll 1
        for (int k0 = kb; k0 < kb + 128; k0 += 16) {
            float w[16];
            const float* wp = a.w_ada + (size_t)k0 * 6144 + col;
#pragma unroll
            for (int j = 0; j < 16; ++j) w[j] = wp[(size_t)j * 6144];
#pragma unroll
            for (int j = 0; j < 16; ++j)
#pragma unroll
                for (int b = 0; b < 8; ++b) acc[b] += sc[b * DM + k0 + j] * w[j];
        }
#pragma unroll
        for (int b = 0; b < 8; ++b) part[(F.wave * 8 + b) * 64 + F.lane] = acc[b];
        __syncthreads();
        { const int b = F.tid >> 6, l = F.tid & 63; float s = a.b_ada[F.bid * 64 + l];
#pragma unroll
          for (int w = 0; w < 8; ++w) s += part[(w * 8 + b) * 64 + l];
          ((float*)(a.ws + WS_MOD))[b * 6144 + F.bid * 64 + l] = s; }
        __syncthreads();
    }
    LAS float* scr = (LAS float*)(F.lds + F.wave * 17408);
    const int gw = F.bid * NWAVES + F.wave, NGW = F.G * NWAVES;
    constexpr int I_IN = 16 * 56, I_OUT = 16 * 16, I_G = 16 * 16 * 32, I_D = 16 * 32 * 16, I_WG = 16;
    constexpr int NITEMS = I_IN + I_OUT + 2 * I_G + I_D + I_WG;
    bf16_t* WinT = (bf16_t*)(a.ws + WS_WINT); bf16_t* WgT = (bf16_t*)(a.ws + WS_WGT); bf16_t* WoutT = (bf16_t*)(a.ws + WS_WOUTT);
    unsigned char* WguT = a.ws + WS_WGUT; unsigned char* WdT = a.ws + WS_WDT;
    for (int it = gw; it < NITEMS; it += NGW) {
        int r = it;
        if (r < I_IN) { const int kb = r / 56, nb = r % 56, n0 = nb * 64; tr_item64(a.w_in, DIN, kb * 64, n0 + (n0 >= 2048 ? 16 : 0), WinT, n0, DM, scr, F.lane); continue; } r -= I_IN;
        if (r < I_OUT) { const int kb = r / 16, nb = r % 16; tr_item64(a.w_out, DM, kb * 64, nb * 64, WoutT, nb * 64, DM, scr, F.lane); continue; } r -= I_OUT;
        if (r < 2 * I_G) { const int up = r / I_G; r -= up * I_G; const int e = r / 512; r -= e * 512; const int kb = r / 32, nb = r % 32, n0 = nb * 64;
            const float* src = (up ? a.w_up : a.w_gate) + (size_t)e * DM * DFF;
            tr_item64_fp8(src, DFF, kb * 64, n0, WguT + (size_t)e * 4096 * DM, (size_t)(n0 / 128) * 256 + (n0 % 128) + up * 128, DM, pg8::W_PRESCALE, scr, F.lane); continue; } r -= 2 * I_G;
        if (r < I_D) { const int e = r / 512; r -= e * 512; const int kb = r / 16, nb = r % 16;
            tr_item64_fp8(a.w_down + (size_t)e * DFF * DM, DM, kb * 64, nb * 64, WdT + (size_t)e * DM * DFF, nb * 64, DFF, pg8::W_PRESCALE, scr, F.lane); continue; } r -= I_D;
        tr_item64(a.w_in, DIN, r * 64, 2048 - 48, WgT, 0, DM, scr, F.lane);
    }
}

DI void p1_phase(const Ctx& F, const Args& a) {
    const int gw = F.bid * NWAVES + F.wave, NGW = F.G * NWAVES;
    const float* mod = (const float*)(a.ws + WS_MOD);
    bf16_t* H1 = (bf16_t*)a.out;
    for (int m0 = gw; m0 < MTOK; m0 += 2 * NGW) {
        const int m1 = m0 + NGW; const bool has1 = m1 < MTOK;
        const f32x4* xr0 = (const f32x4*)(a.x + (size_t)m0 * DM) + F.lane; const f32x4* xr1 = (const f32x4*)(a.x + (size_t)(has1 ? m1 : m0) * DM) + F.lane;
        f32x4 v0[4], v1[4]; float s0 = 0.f, s1 = 0.f;
#pragma unroll
        for (int j = 0; j < 4; ++j) { v0[j] = __builtin_nontemporal_load(xr0 + 64 * j); v1[j] = __builtin_nontemporal_load(xr1 + 64 * j); }
#pragma unroll
        for (int j = 0; j < 4; ++j) { s0 += (v0[j].x * v0[j].x + v0[j].y * v0[j].y) + (v0[j].z * v0[j].z + v0[j].w * v0[j].w); s1 += (v1[j].x * v1[j].x + v1[j].y * v1[j].y) + (v1[j].z * v1[j].z + v1[j].w * v1[j].w); }
#pragma unroll
        for (int o = 1; o < 64; o <<= 1) { s0 += __shfl_xor(s0, o); s1 += __shfl_xor(s1, o); }
        const float rstd0 = rsqrtf(s0 * (1.f / DM) + EPS), rstd1 = rsqrtf(s1 * (1.f / DM) + EPS);
        const int b0 = m0 / SEQ, b1 = (has1 ? m1 : m0) / SEQ;
        u32x2* o0 = (u32x2*)(H1 + (size_t)m0 * DM) + F.lane; u32x2* o1 = (u32x2*)(H1 + (size_t)m1 * DM) + F.lane;
#pragma unroll
        for (int j = 0; j < 4; ++j) {
            const f32x4 g = ((const f32x4*)a.norm1_g)[F.lane + 64 * j];
            { const f32x4 sh = ((const f32x4*)(mod + (size_t)b0 * 6144))[F.lane + 64 * j], sc = ((const f32x4*)(mod + (size_t)b0 * 6144 + 1024))[F.lane + 64 * j];
              const f32x4 h = v0[j] * rstd0 * g * (sc + 1.f) + sh; u32x2 w; w.x = pk2(h.x, h.y); w.y = pk2(h.z, h.w); o0[64 * j] = w; }
            if (has1) { const f32x4 sh = ((const f32x4*)(mod + (size_t)b1 * 6144))[F.lane + 64 * j], sc = ((const f32x4*)(mod + (size_t)b1 * 6144 + 1024))[F.lane + 64 * j];
              const f32x4 h = v1[j] * rstd1 * g * (sc + 1.f) + sh; u32x2 w; w.x = pk2(h.x, h.y); w.y = pk2(h.z, h.w); o1[64 * j] = w; }
        }
    }
}

DI void gates_tasks(const Ctx& F, const Args& a) {
    const int gw = F.bid * NWAVES + F.wave, NGW = F.G * NWAVES;
    const bf16_t* H1 = (const bf16_t*)a.out; const bf16_t* WgT = (const bf16_t*)(a.ws + WS_WGT) + 48 * DM; float* GT = (float*)(a.ws + WS_GATES);
    const float bias = a.gate_b[F.lane & 15];
    for (int task = gw; task < MTOK / 16; task += NGW) {
        const int row0 = task * 16;
        const bf16_t* ap = H1 + (size_t)(row0 + (F.lane & 15)) * DM + 8 * (F.lane >> 4);
        const bf16_t* bp = WgT + (size_t)(F.lane & 15) * DM + 8 * (F.lane >> 4);
        f32x4 acc = {0.f, 0.f, 0.f, 0.f};
#pragma unroll 8
        for (int i = 0; i < 32; ++i) { const bf16x8 av = *(const bf16x8*)(ap + 32 * i), bv = *(const bf16x8*)(bp + 32 * i); acc = __builtin_amdgcn_mfma_f32_16x16x32_bf16(av, bv, acc, 0, 0, 0); }
#pragma unroll
        for (int r = 0; r < 4; ++r) GT[(size_t)(row0 + (F.lane >> 4) * 4 + r) * 16 + (F.lane & 15)] = acc[r] + bias;
    }
}

DI void qk_tile_task(const Ctx& F, const Args& a, int task) {
    const int b = task >> 6, tile = task & 63, r = F.lane, g = F.wave, h = g >> 1, p = g & 1;
    bf16_t* PROJ = (bf16_t*)(a.ws + WS_PROJ);
    const size_t tok = (size_t)b * SEQ + tile * 64 + r;
    float invf[8];
#pragma unroll
    for (int i = 0; i < 8; ++i) invf[i] = exp2f(-(float)i * 0.125f * 18.931568569324174f) * 0.15915494309189535f;
    const float pos = (float)a.pos[tok];
    float sn[8], cs[8];
#pragma unroll
    for (int i = 0; i < 8; ++i) { const float fr = __builtin_amdgcn_fractf(pos * invf[i]); sn[i] = __builtin_amdgcn_sinf(fr); cs[i] = __builtin_amdgcn_cosf(fr); }
#pragma unroll 1
    for (int isk = 0; isk < 2; ++isk) {
        u32x4* src = (u32x4*)(PROJ + tok * PS + (isk ? C_KA : C_QA) + g * 64);
        u32x4 w[8];
#pragma unroll
        for (int c = 0; c < 8; ++c) w[c] = src[c];
        float ss = 0.f;
#pragma unroll
        for (int c = 0; c < 8; ++c) { float t;
            t = bflo(w[c].x); ss += t * t; t = bfhi(w[c].x); ss += t * t; t = bflo(w[c].y); ss += t * t; t = bfhi(w[c].y); ss += t * t;
            t = bflo(w[c].z); ss += t * t; t = bfhi(w[c].z); ss += t * t; t = bflo(w[c].w); ss += t * t; t = bfhi(w[c].w); ss += t * t; }
        const float rstd = rsqrtf(ss * (1.f / 64.f) + EPS) * (isk ? 1.f : 0.125f * 1.4426950408889634f);
        const float* gp = a.qk_g + isk * 64;
        float v0[16];
        v0[0] = bflo(w[0].x); v0[1] = bfhi(w[0].x); v0[2] = bflo(w[0].y); v0[3] = bfhi(w[0].y); v0[4] = bflo(w[0].z); v0[5] = bfhi(w[0].z); v0[6] = bflo(w[0].w); v0[7] = bfhi(w[0].w);
        v0[8] = bflo(w[1].x); v0[9] = bfhi(w[1].x); v0[10] = bflo(w[1].y); v0[11] = bfhi(w[1].y); v0[12] = bflo(w[1].z); v0[13] = bfhi(w[1].z); v0[14] = bflo(w[1].w); v0[15] = bfhi(w[1].w);
#pragma unroll
        for (int i = 0; i < 16; ++i) v0[i] *= rstd * gp[i];
        float rr[16];
#pragma unroll
        for (int i = 0; i < 8; ++i) { rr[i] = v0[i] * cs[i] - v0[i + 8] * sn[i]; rr[i + 8] = v0[i + 8] * cs[i] + v0[i] * sn[i]; }
        u32x4 o[8];
        o[0].x = pk2(rr[0], rr[1]); o[0].y = pk2(rr[2], rr[3]); o[0].z = pk2(rr[4], rr[5]); o[0].w = pk2(rr[6], rr[7]);
        o[1].x = pk2(rr[8], rr[9]); o[1].y = pk2(rr[10], rr[11]); o[1].z = pk2(rr[12], rr[13]); o[1].w = pk2(rr[14], rr[15]);
#pragma unroll
        for (int c = 2; c < 8; ++c) { const f32x4 g0 = *(const f32x4*)(gp + c * 8), g1 = *(const f32x4*)(gp + c * 8 + 4);
            o[c].x = pk2(bflo(w[c].x) * rstd * g0.x, bfhi(w[c].x) * rstd * g0.y); o[c].y = pk2(bflo(w[c].y) * rstd * g0.z, bfhi(w[c].y) * rstd * g0.w);
            o[c].z = pk2(bflo(w[c].z) * rstd * g1.x, bfhi(w[c].z) * rstd * g1.y); o[c].w = pk2(bflo(w[c].w) * rstd * g1.z, bfhi(w[c].w) * rstd * g1.w); }
        if (isk == 0) {
#pragma unroll
            for (int c = 0; c < 8; ++c) src[c] = o[c];
        } else {
            u32x4* dst = (u32x4*)((bf16_t*)(a.ws + WS_KIMG) + ((size_t)((b * 4 + h) * 64 + tile)) * 8192) + r;
#pragma unroll
            for (int c = 0; c < 8; ++c) dst[(p * 8 + c) * 64] = o[c];
        }
    }
    {
        u32x4* dst = (u32x4*)((bf16_t*)(a.ws + WS_VIMG) + ((size_t)((b * 4 + h) * 64 + tile)) * 8192) + r;
#pragma unroll
        for (int cg = 2 * p; cg < 2 * p + 2; ++cg)
#pragma unroll
            for (int kg = 0; kg < 4; ++kg) {
                const u32x4 v = *(const u32x4*)(PROJ + ((size_t)b * SEQ + tile * 64 + 16 * kg + (r >> 2)) * PS + C_VA + h * 128 + 32 * cg + 8 * (r & 3));
                dst[(cg * 4 + kg) * 64] = v; }
    }
}

DI bf16x8 tr_frag_nat(const LAS unsigned char* img, int rowbase, int col0, int lane) {
    const int hh = lane >> 5, g16 = (lane >> 4) & 1, i = lane & 15;
    const int col = col0 + 16 * g16 + 4 * (i & 3), chunk = col >> 3, sub = (col & 7) * 2;
    const int r0 = rowbase + 8 * hh + (i >> 2), r1 = r0 + 4;
    const s16x4 lo = trread(img + r0 * 256 + ((chunk ^ swz16(r0)) << 4) + sub);
    const s16x4 hi = trread(img + r1 * 256 + ((chunk ^ swz16(r1)) << 4) + sub);
    return __builtin_shufflevector(lo, hi, 0, 1, 2, 3, 4, 5, 6, 7);
}
DI bf16x8 tr_frag_acc(const LAS unsigned char* img, int rowbase, int col0, int lane) {
    const int hh = lane >> 5, g16 = (lane >> 4) & 1, i = lane & 15;
    const int col = col0 + 16 * g16 + 4 * (i & 3), chunk = col >> 3, sub = (col & 7) * 2;
    const int r0 = rowbase + 4 * hh + (i >> 2), r1 = r0 + 8;
    const s16x4 lo = trread(img + r0 * 256 + ((chunk ^ swz16(r0)) << 4) + sub);
    const s16x4 hi = trread(img + r1 * 256 + ((chunk ^ swz16(r1)) << 4) + sub);
    return __builtin_shufflevector(lo, hi, 0, 1, 2, 3, 4, 5, 6, 7);
}
DI bf16x8 row_frag(const LAS unsigned char* img, int row, int chunk) { return *(const LAS bf16x8*)(img + row * 256 + ((chunk ^ swz16(row)) << 4)); }

DI void glds16_asm(const void* gsrc, unsigned lds_dst) { unsigned keep;
    asm volatile("s_mov_b32 %0, m0\n\ts_mov_b32 m0, %2\n\ts_nop 0\n\tglobal_load_lds_dwordx4 %1, off\n\ts_mov_b32 m0, %0" : "=&s"(keep) : "v"(gsrc), "s"(lds_dst) : "memory"); }
constexpr size_t DO_QC = 0, DO_KC = 32 * MiB, DO_HD = 64 * MiB;
constexpr size_t WS_SC = 7 * MiB;

DI void conv_task(const Ctx& F, const Args& a, int tw) {
    const int isk = tw & 1, tok0 = (tw >> 1) * 8, b = tok0 / SEQ, t0 = tok0 % SEQ, lane = F.lane;
    const bf16_t* src = (const bf16_t*)(a.ws + WS_PROJ) + (size_t)b * SEQ * PS + (isk ? C_KM : C_QM) + lane * 8;
    float cw[5][8];
#pragma unroll
    for (int j = 0; j < 5; ++j) { const f32x4 c0 = *(const f32x4*)(a.conv_w + j * 1024 + isk * 512 + lane * 8), c1 = *(const f32x4*)(a.conv_w + j * 1024 + isk * 512 + lane * 8 + 4);
        cw[j][0] = c0.x; cw[j][1] = c0.y; cw[j][2] = c0.z; cw[j][3] = c0.w; cw[j][4] = c1.x; cw[j][5] = c1.y; cw[j][6] = c1.z; cw[j][7] = c1.w; }
    u32x4 row[12];
#pragma unroll
    for (int r = 0; r < 12; ++r) { const int t = t0 + r - 2; row[r] = (u32x4){0u, 0u, 0u, 0u}; if (t >= 0 && t < SEQ) row[r] = *(const u32x4*)(src + (size_t)t * PS); }
    const int hd = lane >> 4, cc = lane & 15, cch = t0 >> 6, r0 = t0 & 63;
    bf16_t* tileb = (bf16_t*)((unsigned char*)a.out + (isk ? DO_KC : DO_QC)) + ((size_t)((b * 4 + hd) * 64 + cch)) * 8192;
    bf16_t* dst = isk ? tileb + ((cc >> 2) * 4 + (r0 >> 4)) * 512 + (r0 & 15) * 32 + (cc & 3) * 8 : tileb + cc * 512 + r0 * 8;
    const int dstride = isk ? 32 : 8;
    const float sc = isk ? 0.08838834764831845f : 1.f;
#pragma unroll
    for (int i = 0; i < 8; ++i) {
        float acc[8];
#pragma unroll
        for (int e = 0; e < 8; ++e) acc[e] = 0.f;
#pragma unroll
        for (int j = 0; j < 5; ++j) { const u32x4 w = row[i + j];
            acc[0] += bflo(w.x) * cw[j][0]; acc[1] += bfhi(w.x) * cw[j][1]; acc[2] += bflo(w.y) * cw[j][2]; acc[3] += bfhi(w.y) * cw[j][3];
            acc[4] += bflo(w.z) * cw[j][4]; acc[5] += bfhi(w.z) * cw[j][5]; acc[6] += bflo(w.w) * cw[j][6]; acc[7] += bfhi(w.w) * cw[j][7]; }
#pragma unroll
        for (int e = 0; e < 8; ++e) acc[e] = silu_f(acc[e]) * sc;
        u32x4 o; o.x = pk2(acc[0], acc[1]); o.y = pk2(acc[2], acc[3]); o.z = pk2(acc[4], acc[5]); o.w = pk2(acc[6], acc[7]);
        *(u32x4*)(dst + i * dstride) = o;
    }
}

DI void mscal_task(const Ctx& F, const Args& a, int chain) {
    const int b = chain >> 3, h = (chain >> 1) & 3, dir = chain & 1, s = F.lane;
    const float* GT = (const float*)(a.ws + WS_GATES) + (size_t)b * SEQ * 16;
    float* SC = (float*)(a.ws + WS_SC) + (size_t)chain * 64 * 256; float* MSC = (float*)(a.ws + WS_MSC);
    LAS float* gl = (LAS float*)F.lds; LAS float* mll = gl + 64; LAS float* mpv = gl + 128; LAS float* mnw = gl + 192;
    float aa[8], ii[8];
#pragma unroll
    for (int i = 0; i < 8; ++i) { const int c = F.wave + 8 * i;
        const float ig = GT[(size_t)(c * 64 + s) * 16 + dir * 8 + h], fg = GT[(size_t)(c * 64 + s) * 16 + dir * 8 + 4 + h];
        float av = logsigmoid_f(fg);
        if (dir == 0) {
#pragma unroll
            for (int o = 1; o < 64; o <<= 1) { const float t = __shfl_up(av, o); if (s >= o) av += t; }
        } else {
#pragma unroll
            for (int o = 1; o < 64; o <<= 1) { const float t = __shfl_down(av, o); if (s + o < 64) av += t; }
        }
        aa[i] = av; ii[i] = ig;
        const float g = __shfl(av, dir == 0 ? 63 : 0), ml = wave_max(g - av + ig);
        if (s == 0) { gl[c] = g; mll[c] = ml; } }
    __syncthreads();
    if (F.tid == 0) { float m = 0.f;
        for (int st = 0; st < 64; ++st) { const int c = dir ? 63 - st : st; mpv[c] = m; const float mn = fmaxf(gl[c] + m, mll[c]); mnw[c] = mn; m = mn; } }
    __syncthreads();
#pragma unroll
    for (int i = 0; i < 8; ++i) { const int c = F.wave + 8 * i; const float mprev = mpv[c], mnew = mnw[c], g = gl[c];
        const float cterm = ii[i] - aa[i]; float cm = cterm;
        if (dir == 0) {
#pragma unroll
            for (int o = 1; o < 64; o <<= 1) { const float t = __shfl_up(cm, o); if (s >= o) cm = fmaxf(cm, t); }
        } else {
#pragma unroll
            for (int o = 1; o < 64; o <<= 1) { const float t = __shfl_down(cm, o); if (s + o < 64) cm = fmaxf(cm, t); }
        }
        const float il = aa[i] + mprev, mj = fmaxf(il, aa[i] + cm);
        float* o4 = SC + (size_t)c * 256 + s;
        o4[0] = (aa[i] - mj) * 1.4426950408889634f; o4[64] = cterm * 1.4426950408889634f; o4[128] = __expf(il - mj); o4[192] = __expf(-mj);
        if (s == 0) { MSC[chain * 64 + c] = (g - mnew) * 1.4426950408889634f; MSC[4096 + chain * 64 + c] = __expf(g + mprev - mnew); } }
    __syncthreads();
}

DI void mseq_item(const Ctx& F, const Args& a, int bh, int dir, int vs) {
    const int b = bh >> 2, h = bh & 3, chain = bh * 2 + dir, wid = F.wave, tid = F.tid, lane = F.lane, r32 = lane & 31, hh = lane >> 5;
    LAS unsigned char* QS = F.lds;
    LAS unsigned char* KS = F.lds + 32768;
    LAS unsigned char* VS = F.lds + 65536;
    LAS unsigned char* SCS = F.lds + 77824;
    LAS unsigned char* SD = F.lds + 80896;
    LAS unsigned char* CI = F.lds + 97280;
    LAS float* NV = (LAS float*)(F.lds + 113664);
    LAS float* gmv = NV + 256; LAS float* spv = gmv + 64;
    LAS float* rdv = spv + 64;
    LAS float* wvv = rdv + 64;
    LAS unsigned char* HST = F.lds + 118784;
    const bf16_t* QC = (const bf16_t*)((const unsigned char*)a.out + DO_QC) + (size_t)bh * 64 * 8192 + lane * 8;
    const bf16_t* KC = (const bf16_t*)((const unsigned char*)a.out + DO_KC) + (size_t)bh * 64 * 8192 + lane * 8;
    const bf16_t* VP = (const bf16_t*)(a.ws + WS_PROJ) + (size_t)b * SEQ * PS + C_VM + h * 128 + vs * 32 + (size_t)(16 * (wid & 3) + (lane >> 2)) * PS + 8 * (lane & 3);
    const float* SC = (const float*)(a.ws + WS_SC) + (size_t)chain * 64 * 256 + lane * 4;
    bf16_t* HD = (bf16_t*)((unsigned char*)a.out + DO_HD) + ((size_t)dir * MTOK + (size_t)b * SEQ) * 512 + h * 128 + vs * 32;
    if (tid < 64) { gmv[tid] = ((const float*)(a.ws + WS_MSC))[chain * 64 + tid]; spv[tid] = ((const float*)(a.ws + WS_MSC))[4096 + chain * 64 + tid]; }
    if (tid < 256) NV[tid] = 0.f;
    for (int i = tid; i < 4096; i += NTHR) ((LAS unsigned*)CI)[i] = 0u;
    const unsigned ldsb = (unsigned)(uintptr_t)F.lds;
#define MSEQ_ISSUE(c, s2, s3) do { const size_t _tb = (size_t)(c); \
        if (wid < 4) { _Pragma("unroll") for (int _i = 0; _i < 4; ++_i) \
                glds16_asm(QC + _tb * 8192 + (4 * wid + _i) * 512, (unsigned)__builtin_amdgcn_readfirstlane((int)(ldsb + (s2) * 16384 + (4 * wid + _i) * 1024))); \
            glds16_asm(VP + _tb * 64 * PS, (unsigned)__builtin_amdgcn_readfirstlane((int)(ldsb + 65536 + (s3) * 4096 + wid * 1024))); } \
        else if (wid >= 6) { _Pragma("unroll") for (int _i = 0; _i < 8; ++_i) \
                glds16_asm(KC + _tb * 8192 + (8 * (wid - 6) + _i) * 512, (unsigned)__builtin_amdgcn_readfirstlane((int)(ldsb + 32768 + (s2) * 16384 + (8 * (wid - 6) + _i) * 1024))); \
            if (wid == 6) glds16_asm(SC + _tb * 256, (unsigned)__builtin_amdgcn_readfirstlane((int)(ldsb + 77824 + (s3) * 1024))); } } while (0)
    MSEQ_ISSUE(dir ? 63 : 0, 0, 0);
    f32x16 Cacc[2];
#pragma unroll
    for (int i = 0; i < 16; ++i) { Cacc[0][i] = 0.f; Cacc[1][i] = 0.f; }
    const int qrd = hh * 1024 + r32 * 16;
    const int ktr = (8 * hh + ((lane & 15) >> 2)) * 64 + ((lane >> 4) & 1) * 32 + (lane & 3) * 8;
    f32x16 acc;
    float qn = 0.f;
#pragma unroll
    for (int i = 0; i < 16; ++i) acc[i] = 0.f;
    asm volatile("s_waitcnt vmcnt(0)" ::: "memory");
    __syncthreads();
    int s3 = 0;
    unsigned long long busy = 0, tb0 = 0; if (PROBE_MSEQ_W >= 0) tb0 = __builtin_amdgcn_s_memtime(); const unsigned long long titem0 = tb0;
#pragma unroll 1
    for (int st = 0; st <= 64; ++st) {
        const int c = dir ? 63 - st : st, s2 = st & 1; const int s3n = (s3 == 2) ? 0 : s3 + 1, s3p = (s3 == 0) ? 2 : s3 - 1;
        if (st + 1 < 64) MSEQ_ISSUE(dir ? 62 - st : st + 1, s2 ^ 1, s3n);
        const LAS unsigned char* QT = QS + s2 * 16384; const LAS unsigned char* KT = KS + s2 * 16384; const LAS unsigned char* VT = VS + s3 * 4096;
        const LAS float* rt = (const LAS float*)(SCS + s3 * 1024); const LAS float* ct = rt + 64;
        if (wid < 4) {
            if (st < 64) {
                const int jt = wid >> 1, stt = wid & 1;
                const LAS unsigned char* qa = QT + qrd + jt * 512;
                const LAS unsigned char* kb = KT + (2 * stt + (r32 >> 4)) * 1024 + (r32 & 15) * 64 + hh * 16;
                f32x16 S;
#pragma unroll
                for (int i = 0; i < 16; ++i) S[i] = 0.f;
#pragma unroll
                for (int ks = 0; ks < 8; ++ks) S = MFMA32(*(const LAS bf16x8*)(kb + (ks >> 1) * 4096 + (ks & 1) * 32), *(const LAS bf16x8*)(qa + ks * 2048), S);
                {   const float gm = gmv[c], sp = spv[c];
                    LAS float* wv = wvv + wid * 64;
                    wv[lane] = __builtin_amdgcn_exp2f(ct[lane] + gm);
                    asm volatile("s_waitcnt lgkmcnt(0)" ::: "memory");
                    const int ck = 4 * wid + (lane & 3), r0 = 4 * (lane >> 2); float pa[8];
                    const LAS unsigned char* kr = KT + (ck >> 2) * 4096 + (r0 >> 4) * 1024 + (r0 & 15) * 64 + (ck & 3) * 16;
#pragma unroll
                    for (int e = 0; e < 8; ++e) pa[e] = 0.f;
#pragma unroll
                    for (int r = 0; r < 4; ++r) { const u32x4 w = *(const LAS u32x4*)(kr + r * 64); const float ws_ = wv[r0 + r];
                        pa[0] += ws_ * bflo(w.x); pa[1] += ws_ * bfhi(w.x); pa[2] += ws_ * bflo(w.y); pa[3] += ws_ * bfhi(w.y); pa[4] += ws_ * bflo(w.z); pa[5] += ws_ * bfhi(w.z); pa[6] += ws_ * bflo(w.w); pa[7] += ws_ * bfhi(w.w); }
#pragma unroll
                    for (int e = 0; e < 8; ++e) { float t = pa[e]; t += dpp_mov<DPP_ROR(8)>(t); t += dpp_mov<DPP_ROR(4)>(t); t = xor16_sum(t); pa[e] = xor32_sum(t); }
                    if (lane < 4) { const LAS float* no = NV + s2 * 128 + 32 * wid + 8 * lane; LAS float* nn = NV + (s2 ^ 1) * 128 + 32 * wid + 8 * lane;
                        const f32x4 o0 = *(const LAS f32x4*)no, o1 = *(const LAS f32x4*)(no + 4);
                        *(LAS f32x4*)nn = (f32x4){sp * o0.x + pa[0], sp * o0.y + pa[1], sp * o0.z + pa[2], sp * o0.w + pa[3]};
                        *(LAS f32x4*)(nn + 4) = (f32x4){sp * o1.x + pa[4], sp * o1.y + pa[5], sp * o1.z + pa[6], sp * o1.w + pa[7]}; }
                }
                {   const int j = 32 * jt + r32; const float rtj = rt[j];
                    LAS unsigned char* sw = SD + s2 * 8192 + stt * 4096 + j * 16 + hh * 8;
                    const LAS float* ctp = ct + 32 * stt + 4 * hh;
#pragma unroll
                    for (int rg = 0; rg < 4; ++rg) { const f32x4 c4 = *(const LAS f32x4*)(ctp + 8 * rg); float v[4];
#pragma unroll
                        for (int e = 0; e < 4; ++e) { const int sc = 32 * stt + 8 * rg + 4 * hh + e; const bool ok = dir == 0 ? (sc <= j) : (sc >= j);
                            v[e] = S[4 * rg + e] * __builtin_amdgcn_exp2f(ok ? rtj + c4[e] : -1.0e30f); }
                        u32x2 w; w.x = pk2(v[0], v[1]); w.y = pk2(v[2], v[3]); *(LAS u32x2*)(sw + rg * 1024) = w; }
                }
            }
        } else if (wid < 6) {
            const int jt = wid - 4;
            if (st > 0) {
                const int cp = dir ? 64 - st : st - 1;
                const LAS float* iw = (const LAS float*)(SCS + s3p * 1024) + 128; const LAS float* enm = iw + 64;
                const LAS unsigned char* SDp = SD + (s2 ^ 1) * 8192;
                {   const int j = 32 * jt + (lane >> 1), hf = lane & 1; float rsum = 0.f;
                    const LAS unsigned char* sr = SDp + hf * 4096 + j * 16;
#pragma unroll
                    for (int ch = 0; ch < 4; ++ch) { const u32x4 w = *(const LAS u32x4*)(sr + ch * 1024);
                        rsum += (bflo(w.x) + bfhi(w.x)) + (bflo(w.y) + bfhi(w.y)) + (bflo(w.z) + bfhi(w.z)) + (bflo(w.w) + bfhi(w.w)); }
                    rsum += dpp_mov<DPP_XOR1>(rsum);
                    const float den = rsum + iw[j] * qn;
                    if (hf == 0) rdv[j] = 1.f / fmaxf(fabsf(den), enm[j]);
                    asm volatile("s_waitcnt lgkmcnt(0)" ::: "memory");
                }
                const int jl = 32 * jt + r32; const float iwj = iw[jl], rdj = rdv[jl];
#pragma unroll
                for (int i = 0; i < 16; ++i) acc[i] *= iwj;
                const LAS unsigned char* sa = SDp + qrd + jt * 512; const LAS unsigned char* vb = VS + s3p * 4096 + ktr;
#pragma unroll
                for (int ks = 0; ks < 4; ++ks) { const s16x4 lo = trread(vb + ks * 1024), hi = trread(vb + ks * 1024 + 256);
                    acc = MFMA32(__builtin_shufflevector(lo, hi, 0, 1, 2, 3, 4, 5, 6, 7), *(const LAS bf16x8*)(sa + ks * 2048), acc); }
                LAS unsigned char* hst = HST + jt * 2048;
#pragma unroll
                for (int rg = 0; rg < 4; ++rg) { u32x2 w; w.x = pk2(acc[4 * rg] * rdj, acc[4 * rg + 1] * rdj); w.y = pk2(acc[4 * rg + 2] * rdj, acc[4 * rg + 3] * rdj);
                    *(LAS u32x2*)(hst + r32 * 64 + (8 * rg + 4 * hh) * 2) = w; }
                asm volatile("s_waitcnt lgkmcnt(0)" ::: "memory");
#pragma unroll
                for (int q = 0; q < 2; ++q) { const int row = 16 * q + (lane >> 2), part = lane & 3;
                    const u32x4 w = *(const LAS u32x4*)(hst + row * 64 + part * 16);
                    *(u32x4*)(HD + (size_t)(cp * 64 + 32 * jt + row) * 512 + part * 8) = w; }
            }
            if (st < 64) {
                const LAS unsigned char* qa = QT + qrd + jt * 512;
                const LAS unsigned char* cb = CI + s2 * 8192 + hh * 512 + r32 * 16;
#pragma unroll
                for (int i = 0; i < 16; ++i) acc[i] = 0.f;
#pragma unroll
                for (int ks = 0; ks < 8; ++ks) acc = MFMA32(*(const LAS bf16x8*)(cb + ks * 1024), *(const LAS bf16x8*)(qa + ks * 2048), acc);
                const int j = 32 * jt + (lane >> 1), hf = lane & 1;
                const LAS unsigned char* qr = QT + hf * 8192 + j * 16; const LAS float* np = NV + s2 * 128 + 64 * hf;
                qn = 0.f;
#pragma unroll
                for (int ch = 0; ch < 8; ++ch) { const u32x4 w = *(const LAS u32x4*)(qr + ch * 1024); const f32x4 n0 = *(const LAS f32x4*)(np + ch * 8), n1 = *(const LAS f32x4*)(np + ch * 8 + 4);
                    qn += bflo(w.x) * n0.x + bfhi(w.x) * n0.y + bflo(w.y) * n0.z + bfhi(w.y) * n0.w + bflo(w.z) * n1.x + bfhi(w.z) * n1.y + bflo(w.w) * n1.z + bfhi(w.w) * n1.w; }
                qn += dpp_mov<DPP_XOR1>(qn);
            }
        } else if (st < 64) {
            const int u = wid - 6; const float gm = gmv[c], sp = spv[c];
            LAS float* wv = wvv + (4 + u) * 64;
            wv[lane] = __builtin_amdgcn_exp2f(ct[lane] + gm);
            asm volatile("s_waitcnt lgkmcnt(0)" ::: "memory");
#pragma unroll
            for (int i = 0; i < 16; ++i) { Cacc[0][i] *= sp; Cacc[1][i] *= sp; }
            const LAS unsigned char* va = VT + ktr; const LAS unsigned char* ka = KT + ktr + (2 * u) * 4096;
#pragma unroll
            for (int ks = 0; ks < 4; ++ks) {
                const s16x4 lo = trread(va + ks * 1024), hi = trread(va + ks * 1024 + 256);
                const f32x4 w0 = *(const LAS f32x4*)(wv + 16 * ks + 8 * hh), w1 = *(const LAS f32x4*)(wv + 16 * ks + 8 * hh + 4);
                u32x4 af;
                af.x = pk2(bf2f((bf16_t)lo[0]) * w0.x, bf2f((bf16_t)lo[1]) * w0.y); af.y = pk2(bf2f((bf16_t)lo[2]) * w0.z, bf2f((bf16_t)lo[3]) * w0.w);
                af.z = pk2(bf2f((bf16_t)hi[0]) * w1.x, bf2f((bf16_t)hi[1]) * w1.y); af.w = pk2(bf2f((bf16_t)hi[2]) * w1.z, bf2f((bf16_t)hi[3]) * w1.w);
                const bf16x8 afr = __builtin_bit_cast(bf16x8, af);
                { const s16x4 l0 = trread(ka + ks * 1024), h0 = trread(ka + ks * 1024 + 256); Cacc[0] = MFMA32(__builtin_shufflevector(l0, h0, 0, 1, 2, 3, 4, 5, 6, 7), afr, Cacc[0]); }
                { const s16x4 l1 = trread(ka + 4096 + ks * 1024), h1 = trread(ka + 4096 + ks * 1024 + 256); Cacc[1] = MFMA32(__builtin_shufflevector(l1, h1, 0, 1, 2, 3, 4, 5, 6, 7), afr, Cacc[1]); }
            }
            LAS unsigned char* cw = CI + (s2 ^ 1) * 8192 + (2 * u) * 2048 + r32 * 16 + hh * 8;
#pragma unroll
            for (int t2 = 0; t2 < 2; ++t2)
#pragma unroll
                for (int rg = 0; rg < 4; ++rg) { u32x2 w; w.x = pk2(Cacc[t2][4 * rg], Cacc[t2][4 * rg + 1]); w.y = pk2(Cacc[t2][4 * rg + 2], Cacc[t2][4 * rg + 3]); *(LAS u32x2*)(cw + t2 * 2048 + rg * 512) = w; }
        }
        s3 = s3n;
        if (PROBE_MSEQ_W >= 0) { asm volatile("s_waitcnt lgkmcnt(0)" ::: "memory"); busy += __builtin_amdgcn_s_memtime() - tb0; }
        if (wid < 4 || wid >= 6) asm volatile("s_waitcnt vmcnt(0)" ::: "memory");
        asm volatile("s_waitcnt lgkmcnt(0)" ::: "memory"); __builtin_amdgcn_s_barrier(); asm volatile("" ::: "memory");
        if (PROBE_MSEQ_W >= 0) tb0 = __builtin_amdgcn_s_memtime();
    }
    if (PROBE_MSEQ_W >= 0 && F.bid == 0 && lane == 0 && (wid == PROBE_MSEQ_W || (PROBE_MSEQ_W == 8 && wid == 0)))
        *(volatile LAS unsigned long long*)(F.lds + LDS_BYTES - 128) = (PROBE_MSEQ_W == 8) ? (__builtin_amdgcn_s_memtime() - titem0) : busy;
    asm volatile("s_waitcnt vmcnt(0)" ::: "memory");
#undef MSEQ_ISSUE
}

DI void glds16(const void* g, LAS unsigned char* l) { __builtin_amdgcn_global_load_lds((const unsigned*)g, (LAS unsigned*)l, 16, 0, 0); }
DI void attn_unit(const Ctx& F, const Args& a, int b, int h, int qb, float lam, float cshift) {
    const int lane = F.lane, wid = F.wave, r32 = lane & 31, hh = lane >> 5, rg = wid & 3, p = wid >> 2;
    const bf16_t* projb = (const bf16_t*)(a.ws + WS_PROJ) + (size_t)b * SEQ * PS;
    const int qrow = qb * 128 + rg * 32 + r32;
    bf16x8 qf[4];
    { const bf16_t* qp = projb + (size_t)qrow * PS + C_QA + h * 128 + p * 64 + hh * 8;
#pragma unroll
      for (int ks = 0; ks < 4; ++ks) qf[ks] = *(const bf16x8*)(qp + ks * 16); }
    const bf16_t* kimg = (const bf16_t*)(a.ws + WS_KIMG) + (size_t)(b * 4 + h) * 64 * 8192 + (4 * wid) * 512 + lane * 8;
    const bf16_t* vimg = (const bf16_t*)(a.ws + WS_VIMG) + (size_t)(b * 4 + h) * 64 * 8192 + (4 * wid) * 512 + lane * 8;
    const unsigned ldsw = (unsigned)__builtin_amdgcn_readfirstlane((int)(unsigned)(uintptr_t)F.lds + (4 * wid) * 1024);
#define ATT_ISSUE2(img, t0, ldsoff) do { const int _q0 = 4 * wid; const int _t = (t0) + (_q0 >> 4); const bf16_t* _tp = (img) + (size_t)(_t < 64 ? _t : 63) * 8192 - (size_t)(_q0 & 16) * 512; \
        const unsigned _d = (unsigned)__builtin_amdgcn_readfirstlane((int)(ldsw + (ldsoff))); \
        _Pragma("unroll") for (int _i = 0; _i < 4; ++_i) glds16_asm(_tp + _i * 512, _d + _i * 1024); } while (0)
    if (wid < 4) { const bf16_t* _tp = kimg; const unsigned _d = (unsigned)__builtin_amdgcn_readfirstlane((int)(ldsw + 32768));
#pragma unroll
        for (int _i = 0; _i < 4; ++_i) glds16_asm(_tp + _i * 512, _d + _i * 1024); }
    ATT_ISSUE2(kimg, 1, 0); ATT_ISSUE2(vimg, 0, 65536);
    f32x16 O[4];
#pragma unroll
    for (int vt = 0; vt < 4; ++vt)
#pragma unroll
        for (int i = 0; i < 16; ++i) O[vt][i] = 0.f;
    float lsum = 0.f;
    const int kfb = p * 8192 + hh * 1024 + r32 * 16;
    const int vfb = (4 * hh + ((lane & 15) >> 2)) * 64 + ((lane >> 4) & 1) * 32 + (lane & 3) * 8;
    bf16x8 pb[4];
    asm volatile("s_waitcnt vmcnt(0)" ::: "memory");
    __syncthreads();
#define ATT_EXP(Sa, Sb, on) do { float _ls = 0.f; _Pragma("unroll") for (int i = 0; i < 16; ++i) { Sa[i] = __builtin_amdgcn_exp2f(Sa[i]); Sb[i] = __builtin_amdgcn_exp2f(Sb[i]); } \
          \
        _Pragma("unroll") for (int i = 0; i < 16; ++i) { _ls = _ls + Sa[i]; _ls = _ls + Sb[i]; } lsum += (on) ? _ls : 0.f; \
        ATT_PACK(pb[0], Sa, 0); ATT_PACK(pb[1], Sa, 8); ATT_PACK(pb[2], Sb, 0); ATT_PACK(pb[3], Sb, 8); } while (0)
#define ATT_PACK(dst, S, o) do { u32x4 _w; _w.x = pk2(S[o], S[o + 1]); _w.y = pk2(S[o + 2], S[o + 3]); _w.z = pk2(S[o + 4], S[o + 5]); _w.w = pk2(S[o + 6], S[o + 7]); dst = __builtin_bit_cast(bf16x8, _w); } while (0)
#define ATT_VLOAD(dst, Vb, kg) do { _Pragma("unroll") for (int vt = 0; vt < 4; ++vt) { \
        const s16x4 _lo = trread((Vb) + vt * 4096 + (kg) * 1024), _hi = trread((Vb) + vt * 4096 + (kg) * 1024 + 512); dst[vt] = __builtin_shufflevector(_lo, _hi, 0, 1, 2, 3, 4, 5, 6, 7); } } while (0)
#define ATT_PV(vf, kg) do { _Pragma("unroll") for (int vt = 0; vt < 4; ++vt) O[vt] = MFMA32(vf[vt], pb[kg], O[vt]); } while (0)
#define ATT_STEP(Kb, Vb, on0) do { \
        bf16x8 kfa[4], kfb2[4], vA[4], vB[4]; \
        _Pragma("unroll") for (int ks = 0; ks < 4; ++ks) { kfa[ks] = *(const LAS bf16x8*)((Kb) + ks * 2048); kfb2[ks] = *(const LAS bf16x8*)((Kb) + ks * 2048 + 512); } \
        ATT_VLOAD(vA, Vb, 0); \
        if (p == 1) ATT_EXP(Sa, Sb, true); \
        __builtin_amdgcn_sched_barrier(0); \
        ATT_VLOAD(vB, Vb, 1); ATT_PV(vA, 0); \
        __builtin_amdgcn_sched_barrier(0); \
        ATT_VLOAD(vA, Vb, 2); ATT_PV(vB, 1); \
        __builtin_amdgcn_sched_barrier(0); \
        ATT_VLOAD(vB, Vb, 3); ATT_PV(vA, 2); \
        __builtin_amdgcn_sched_barrier(0); \
        ATT_PV(vB, 3); \
        Sa = MFMA32(kfa[0], qf[0], negc); Sb = MFMA32(kfb2[0], qf[0], negc);        \
        _Pragma("unroll") for (int ks = 1; ks < 4; ++ks) { Sa = MFMA32(kfa[ks], qf[ks], Sa); Sb = MFMA32(kfb2[ks], qf[ks], Sb); } \
        __builtin_amdgcn_sched_barrier(0); \
        if (p == 0) ATT_EXP(Sa, Sb, on0); } while (0)
    f32x16 Sa, Sb, negc;
#pragma unroll
    for (int i = 0; i < 16; ++i) negc[i] = -cshift;
    asm volatile("" : "+v"(negc));
    {
        const LAS unsigned char* Kb = F.lds + 32768 + kfb;
        Sa = MFMA32(*(const LAS bf16x8*)(Kb), qf[0], negc); Sb = MFMA32(*(const LAS bf16x8*)(Kb + 512), qf[0], negc);
#pragma unroll
        for (int ks = 1; ks < 4; ++ks) { Sa = MFMA32(*(const LAS bf16x8*)(Kb + ks * 2048), qf[ks], Sa); Sb = MFMA32(*(const LAS bf16x8*)(Kb + ks * 2048 + 512), qf[ks], Sb); }
    }
    if (p == 0) ATT_EXP(Sa, Sb, true);
    __syncthreads();
#pragma unroll 1
    for (int T = 0; T < 32; ++T) {
        const int j = T & 1;
        ATT_ISSUE2(kimg, 2 * T + 3, (j ^ 1) * 32768);
        ATT_ISSUE2(vimg, 2 * T + 2, 65536 + (j ^ 1) * 32768);
        const LAS unsigned char* Ks = F.lds + j * 32768 + kfb; const LAS unsigned char* Vs = F.lds + 65536 + j * 32768 + vfb;
        ATT_STEP(Ks, Vs, true);
        ATT_STEP(Ks + 16384, Vs + 16384, T < 31);
        asm volatile("s_waitcnt vmcnt(0)" ::: "memory");
        __syncthreads();
    }
#undef ATT_STEP
#undef ATT_VLOAD
#undef ATT_PV
#undef ATT_ISSUE2
#undef ATT_EXP
#undef ATT_PACK
    lsum += __shfl_xor(lsum, 32);
    LAS float* X = (LAS float*)(F.lds + 65536) + rg * 4096 + r32;
    if (p == 1) {
        const float sc = lam / lsum;
#pragma unroll
        for (int vt = 0; vt < 4; ++vt)
#pragma unroll
            for (int i = 0; i < 16; ++i) X[(32 * vt + crow(i, hh)) * 32] = O[vt][i] * sc;
    }
    __syncthreads();
    if (p == 0) {
        const float i0 = 1.f / lsum;
        float ssq = 0.f;
#pragma unroll
        for (int vt = 0; vt < 4; ++vt)
#pragma unroll
            for (int i = 0; i < 16; ++i) { const float o = O[vt][i] * i0 - X[(32 * vt + crow(i, hh)) * 32]; O[vt][i] = o; ssq += o * o; }
        ssq += __shfl_xor(ssq, 32);
        const float rs = rsqrtf(ssq * (1.f / 128.f) + EPS) * 0.8f;
        bf16_t* yp = (bf16_t*)(a.ws + WS_YA) + (size_t)(b * SEQ + qrow) * 512 + h * 128;
#pragma unroll
        for (int vt = 0; vt < 4; ++vt)
#pragma unroll
            for (int rgi = 0; rgi < 4; ++rgi) { const int vd = 32 * vt + 8 * rgi + 4 * hh; const f32x4 g = *(const f32x4*)(a.subln_g + vd);
                u32x2 w; w.x = pk2(O[vt][4 * rgi] * rs * g.x, O[vt][4 * rgi + 1] * rs * g.y); w.y = pk2(O[vt][4 * rgi + 2] * rs * g.z, O[vt][4 * rgi + 3] * rs * g.w);
                *(u32x2*)(yp + vd) = w; }
    }
    __syncthreads();
}

DI void mcombine_phase(const Ctx& F, const Args& a) {
    const int gw = F.bid * NWAVES + F.wave, NGW = F.G * NWAVES, lane = F.lane;
    const bf16_t* HD = (const bf16_t*)((const unsigned char*)a.out + DO_HD);
    float g[8];
#pragma unroll
    for (int i = 0; i < 8; ++i) g[i] = a.mnorm_g[lane * 8 + i];
    for (int m = gw; m < MTOK; m += NGW) {
        const u32x4 f = *(const u32x4*)(HD + (size_t)m * 512 + lane * 8), bw = *(const u32x4*)(HD + ((size_t)MTOK + m) * 512 + lane * 8);
        const u32x4 om = *(const u32x4*)((const bf16_t*)(a.ws + WS_PROJ) + (size_t)m * PS + C_OM + lane * 8);
        const u32x4 ya = *(const u32x4*)((const bf16_t*)(a.ws + WS_YA) + (size_t)m * 512 + lane * 8);
        float v[8];
        v[0] = bflo(f.x) + bflo(bw.x); v[1] = bfhi(f.x) + bfhi(bw.x); v[2] = bflo(f.y) + bflo(bw.y); v[3] = bfhi(f.y) + bfhi(bw.y);
        v[4] = bflo(f.z) + bflo(bw.z); v[5] = bfhi(f.z) + bfhi(bw.z); v[6] = bflo(f.w) + bflo(bw.w); v[7] = bfhi(f.w) + bfhi(bw.w);
        float ss = 0.f;
#pragma unroll
        for (int i = 0; i < 8; ++i) ss += v[i] * v[i];
        ss += __shfl_xor(ss, 1); ss += __shfl_xor(ss, 2); ss += __shfl_xor(ss, 4); ss += __shfl_xor(ss, 8);
        const float rstd = rsqrtf(ss * (1.f / 128.f) + EPS);
        float o[8];
        o[0] = bflo(om.x); o[1] = bfhi(om.x); o[2] = bflo(om.y); o[3] = bfhi(om.y); o[4] = bflo(om.z); o[5] = bfhi(om.z); o[6] = bflo(om.w); o[7] = bfhi(om.w);
#pragma unroll
        for (int i = 0; i < 8; ++i) v[i] = v[i] * rstd * g[i] * sigmoid_f(o[i]);
        u32x4 w; w.x = pk2(v[0], v[1]); w.y = pk2(v[2], v[3]); w.z = pk2(v[4], v[5]); w.w = pk2(v[6], v[7]);
        bf16_t* yp = (bf16_t*)(a.ws + WS_YMIX) + (size_t)m * DM + lane * 8;
        *(u32x4*)yp = w; *(u32x4*)(yp + 512) = ya;
    }
}

DI void p7_phase(const Ctx& F, const Args& a) {
    LAS f32x4* WRL = (LAS f32x4*)F.lds;
    for (int q = F.tid; q < 4096; q += NTHR) { const int k = q >> 2, g = q & 3; WRL[(g * 2 + (k & 1)) * 512 + (k >> 1)] = *(const f32x4*)(a.w_router + k * 16 + g * 4); }
    __syncthreads();
    const int gw = F.bid * NWAVES + F.wave, NGW = F.G * NWAVES, lane = F.lane;
    const float* mod = (const float*)(a.ws + WS_MOD);
    unsigned char* H2 = a.ws + WS_H2; float* AFF = (float*)(a.ws + WS_AFF);
    for (int m = gw; m < MTOK; m += NGW) {
        const int b = m / SEQ;
        const f32x2* xr = (const f32x2*)(a.out + (size_t)m * DM) + lane;
        f32x2 v[8]; float s = 0.f;
#pragma unroll
        for (int j = 0; j < 8; ++j) { v[j] = xr[64 * j]; s += v[j].x * v[j].x + v[j].y * v[j].y; }
        const float rstd = rsqrtf(wave_sum(s) * (1.f / DM) + EPS);
        float lg[16];
#pragma unroll
        for (int e = 0; e < 16; ++e) lg[e] = 0.f;
        unsigned short* o2 = (unsigned short*)(H2 + (size_t)m * DM) + lane;
#pragma unroll
        for (int j = 0; j < 8; ++j) {
            const f32x2 g = ((const f32x2*)a.norm2_g)[lane + 64 * j];
            const f32x2 sh = ((const f32x2*)(mod + (size_t)b * 6144 + 3072))[lane + 64 * j];
            const f32x2 sc = ((const f32x2*)(mod + (size_t)b * 6144 + 4096))[lane + 64 * j];
            const f32x2 hv = v[j] * rstd * g * (sc + 1.f) + sh;
            o2[64 * j] = (unsigned short)__builtin_amdgcn_cvt_pk_fp8_f32(hv.x, hv.y, 0, false);
#pragma unroll
            for (int g4 = 0; g4 < 4; ++g4) { const f32x4 w0 = WRL[(g4 * 2 + 0) * 512 + lane + 64 * j], w1 = WRL[(g4 * 2 + 1) * 512 + lane + 64 * j];
                lg[g4 * 4 + 0] += hv.x * w0.x + hv.y * w1.x; lg[g4 * 4 + 1] += hv.x * w0.y + hv.y * w1.y; lg[g4 * 4 + 2] += hv.x * w0.z + hv.y * w1.z; lg[g4 * 4 + 3] += hv.x * w0.w + hv.y * w1.w; }
            __builtin_amdgcn_sched_barrier(0);
        }
        float r8[8];
#pragma unroll
        for (int i = 0; i < 8; ++i) { const float keep = hh_sel(lane, 32) ? lg[8 + i] : lg[i], send = hh_sel(lane, 32) ? lg[i] : lg[8 + i]; r8[i] = keep + partner32(send, lane); }
        float r4[4];
#pragma unroll
        for (int i = 0; i < 4; ++i) { const float keep = hh_sel(lane, 16) ? r8[4 + i] : r8[i], send = hh_sel(lane, 16) ? r8[i] : r8[4 + i]; r4[i] = keep + partner16(send, lane); }
        float r2[2];
#pragma unroll
        for (int i = 0; i < 2; ++i) { const float keep = hh_sel(lane, 8) ? r4[2 + i] : r4[i], send = hh_sel(lane, 8) ? r4[i] : r4[2 + i]; r2[i] = keep + partner8(send); }
        float lgt; { const float keep = hh_sel(lane, 4) ? r2[1] : r2[0], send = hh_sel(lane, 4) ? r2[0] : r2[1]; lgt = keep + partner4(send, lane); }
        lgt += dpp_mov<DPP_XOR2>(lgt); lgt += dpp_mov<DPP_XOR1>(lgt);
        float mx = lgt; mx = fmaxf(mx, dpp_mov<DPP_ROR(8)>(mx)); mx = fmaxf(mx, dpp_mov<DPP_ROR(4)>(mx)); mx = xor16_max(mx); mx = xor32_max(mx);
        const float ex = __expf(lgt - mx); float sm = ex; sm += dpp_mov<DPP_ROR(8)>(sm); sm += dpp_mov<DPP_ROR(4)>(sm); sm = xor16_sum(sm); sm = xor32_sum(sm);
        if ((lane & 3) == 0) AFF[(size_t)m * 16 + (lane >> 2)] = ex / sm;
    }
    __syncthreads();
}

DI void topk_task(const Ctx& F, const Args& a, int task) {
    const int b = task >> 4, e = task & 15, tid = F.tid, lane = F.lane;
    const float* AFF = (const float*)(a.ws + WS_AFF) + (size_t)b * SEQ * 16 + e;
    LAS unsigned* hist = (LAS unsigned*)F.lds;
    LAS unsigned* sfx = hist + 256;
    LAS unsigned* misc = hist + 512;
    LAS int* lidx = (LAS int*)(F.lds + 4096);
    unsigned key[8];
#pragma unroll
    for (int i = 0; i < 8; ++i) key[i] = __float_as_uint(AFF[(size_t)(tid * 8 + i) * 16]);
    unsigned prefix = 0, krem = CAP;
#pragma unroll 1
    for (int pass = 0; pass < 4; ++pass) {
        const int shift = 24 - 8 * pass;
        if (tid < 256) hist[tid] = 0;
        __syncthreads();
#pragma unroll
        for (int i = 0; i < 8; ++i) { const bool in = pass == 0 ? true : ((key[i] >> (shift + 8)) == (prefix >> (shift + 8))); if (in) atomicAdd((unsigned*)&hist[(key[i] >> shift) & 255u], 1u); }
        __syncthreads();
        if (tid < 256) sfx[tid] = hist[tid];
        __syncthreads();
#pragma unroll 1
        for (int o = 1; o < 256; o <<= 1) { unsigned v = 0; if (tid < 256) v = sfx[tid] + (tid + o < 256 ? sfx[tid + o] : 0u); __syncthreads(); if (tid < 256) sfx[tid] = v; __syncthreads(); }
        if (tid < 256) { const unsigned incl = sfx[tid], excl = incl - hist[tid]; if (excl < krem && krem <= incl) { misc[0] = (unsigned)tid; misc[1] = krem - excl; } }
        __syncthreads();
        prefix |= misc[0] << shift; krem = misc[1];
        __syncthreads();
    }
    const unsigned T = prefix, need = krem;
    unsigned cg_ = 0, ce = 0;
#pragma unroll
    for (int i = 0; i < 8; ++i) { cg_ += key[i] > T; ce += key[i] == T; }
    unsigned sg = cg_, se = ce;
#pragma unroll
    for (int o = 1; o < 64; o <<= 1) { const unsigned tg = __shfl_up(sg, o), te = __shfl_up(se, o); if (lane >= o) { sg += tg; se += te; } }
    if (lane == 63) { misc[16 + F.wave] = sg; misc[32 + F.wave] = se; }
    __syncthreads();
    unsigned og = sg - cg_, oe = se - ce;
    for (int w = 0; w < F.wave; ++w) { og += misc[16 + w]; oe += misc[32 + w]; }
    int* SLOT = (int*)(a.ws + WS_SLOT) + (size_t)b * SEQ * 16 + e;
    float* VALS = (float*)(a.ws + WS_VALS) + (size_t)(e * 8 + b) * CAP;
    int* IDX = (int*)(a.ws + WS_IDX) + (size_t)(b * 16 + e) * CAP;
#pragma unroll
    for (int i = 0; i < 8; ++i) {
        const bool gt = key[i] > T, eq = key[i] == T; const bool sel = gt || (eq && oe < need);
        const unsigned pos = og + (oe < need ? oe : need);
        const int s = tid * 8 + i;
        SLOT[(size_t)s * 16] = sel ? (int)pos : -1;
        if (sel) { lidx[pos] = s; IDX[pos] = s; VALS[pos] = __uint_as_float(key[i]); }
        og += gt; oe += eq;
    }
    __syncthreads();
    const unsigned char* H2 = a.ws + WS_H2 + (size_t)b * SEQ * DM; unsigned char* XE = a.ws + WS_XE + (size_t)(e * 8 + b) * CAP * DM;
    for (int r0 = F.wave * 4; r0 < CAP; r0 += NWAVES * 4) { u32x4 v[4];
#pragma unroll
        for (int j = 0; j < 4; ++j) v[j] = ((const u32x4*)(H2 + (size_t)lidx[r0 + j] * DM))[lane];
#pragma unroll
        for (int j = 0; j < 4; ++j) ((u32x4*)(XE + (size_t)(r0 + j) * DM))[lane] = v[j]; }
    __syncthreads();
}

DI void final_phase(const Ctx& F, const Args& a) {
    const int gw = F.bid * NWAVES + F.wave, NGW = F.G * NWAVES, lane = F.lane;
    const float* mod = (const float*)(a.ws + WS_MOD); const int* SLOT = (const int*)(a.ws + WS_SLOT); const bf16_t* Y = (const bf16_t*)(a.ws + WS_Y);
    for (int m = gw; m < MTOK; m += NGW) {
        const int b = m / SEQ;
        const int sl = SLOT[(size_t)m * 16 + (lane & 15)];
        float acc[16];
#pragma unroll
        for (int i = 0; i < 16; ++i) acc[i] = 0.f;
#pragma unroll 1
        for (int e = 0; e < 16; ++e) { const int s = __shfl(sl, e);
            if (s >= 0) { const u32x4* yp = (const u32x4*)(Y + ((size_t)(e * 8 + b) * CAP + s) * DM + lane * 16); const u32x4 w0 = yp[0], w1 = yp[1];
                acc[0] += bflo(w0.x); acc[1] += bfhi(w0.x); acc[2] += bflo(w0.y); acc[3] += bfhi(w0.y); acc[4] += bflo(w0.z); acc[5] += bfhi(w0.z); acc[6] += bflo(w0.w); acc[7] += bfhi(w0.w);
                acc[8] += bflo(w1.x); acc[9] += bfhi(w1.x); acc[10] += bflo(w1.y); acc[11] += bfhi(w1.y); acc[12] += bflo(w1.z); acc[13] += bfhi(w1.z); acc[14] += bflo(w1.w); acc[15] += bfhi(w1.w); } }
        f32x4* op = (f32x4*)(a.out + (size_t)m * DM + lane * 16); const f32x4* gp = (const f32x4*)(mod + (size_t)b * 6144 + 5120 + lane * 16);
#pragma unroll
        for (int q = 0; q < 4; ++q) { const f32x4 g = gp[q]; f32x4 o = op[q]; o.x += g.x * acc[4 * q]; o.y += g.y * acc[4 * q + 1]; o.z += g.z * acc[4 * q + 2]; o.w += g.w * acc[4 * q + 3]; op[q] = o; }
    }
}

constexpr size_t WS_CTL = 0;
constexpr int CTL_ZERO_BYTES = 65536;
#define XB_TMO      128
#define XB_XCNT(j)  (256  + 64 * (j))
#define XB_XSUB(j)  (1280 + 64 * (j))
#define XB_XGEN(j)  (2304 + 64 * (j))
#define XB_TOP      3328
#define XB_TOPGEN   3392
#define XB_SPIN_CAP (1u << 18)
DI unsigned xb_ld(unsigned* p)              { return __hip_atomic_load(p, __ATOMIC_RELAXED, __HIP_MEMORY_SCOPE_AGENT); }
DI unsigned xb_add(unsigned* p, unsigned v) { return __hip_atomic_fetch_add(p, v, __ATOMIC_RELAXED, __HIP_MEMORY_SCOPE_AGENT); }
DI unsigned xb_xcc_id() { return (unsigned)__builtin_amdgcn_s_getreg((3 << 11) | 20) & 0xFu; }
#define XB_SPIN(cond, bar) do { unsigned _sp = 0; while (cond) { __builtin_amdgcn_s_sleep(1); \
    if ((++_sp & 255u) == 0u) { if (xb_ld(&(bar)[XB_TMO])) break; if (_sp > XB_SPIN_CAP) { atomicAdd(&(bar)[XB_TMO], 1u); break; } } } } while (0)
struct XcdBarrier { unsigned* bar; unsigned x; volatile LAS unsigned* st; };
DI XcdBarrier xcd_barrier_post(unsigned* bar, volatile LAS unsigned* st) {
    XcdBarrier b; b.bar = bar; b.x = xb_xcc_id(); b.st = st;
    if (threadIdx.x == 0) (void)xb_add(&bar[XB_XCNT(b.x)], 1u);
    return b;
}
DI void xcd_barrier_complete(unsigned* bar, unsigned x, unsigned& nloc, unsigned& nx) {
    const unsigned G = gridDim.x * gridDim.y * gridDim.z;
    unsigned sum, cnt, mine, sp = 0u;
    for (;;) {
        sum = 0u; cnt = 0u; mine = 0u;
#pragma unroll
        for (unsigned j = 0; j < 16; ++j) { const unsigned c = xb_ld(&bar[XB_XCNT(j)]); sum += c; cnt += (c > 0u) ? 1u : 0u; mine = (j == x) ? c : mine; }
        if (sum == G) break;
        __builtin_amdgcn_s_sleep(1);
        if ((++sp & 255u) == 0u) { if (xb_ld(&bar[XB_TMO])) break; if (sp > XB_SPIN_CAP) { atomicAdd(&bar[XB_TMO], 1u); break; } }
    }
    nloc = mine > 0u ? mine : 1u; nx = cnt > 0u ? cnt : 1u;
}
DI void xcd_barrier(const XcdBarrier& b) {
    asm volatile("s_waitcnt vmcnt(0)" ::: "memory");
    __syncthreads();
    if (threadIdx.x == 0) {
        unsigned* bar = b.bar;
        __builtin_amdgcn_s_waitcnt(0);
        unsigned nloc = b.st[0], nx = b.st[1];
        if (nloc == 0u) { xcd_barrier_complete(bar, b.x, nloc, nx); b.st[0] = nloc; b.st[1] = nx; }
        const unsigned old = xb_add(&bar[XB_XSUB(b.x)], 1u);
        const unsigned gen = old / nloc;
        if (old + 1u == (gen + 1u) * nloc) {
            __builtin_amdgcn_fence(__ATOMIC_RELEASE, "agent");
            asm volatile("s_waitcnt vmcnt(0)" ::: "memory");
            const unsigned og = xb_add(&bar[XB_TOP], 1u);
            const unsigned tg = og / nx;
            if (og + 1u == (tg + 1u) * nx) xb_add(&bar[XB_TOPGEN], 1u);
            else XB_SPIN(xb_ld(&bar[XB_TOPGEN]) == tg, bar);
            __builtin_amdgcn_fence(__ATOMIC_ACQUIRE, "agent");
            xb_add(&bar[XB_XGEN(b.x)], 1u);
            asm volatile("s_waitcnt vmcnt(0)" ::: "memory");
        } else {
            XB_SPIN(xb_ld(&bar[XB_XGEN(b.x)]) == gen, bar);
            __builtin_amdgcn_fence(__ATOMIC_ACQUIRE, "agent");
            asm volatile("s_waitcnt vmcnt(0)" ::: "memory");
        }
    }
    __syncthreads();
}

static_assert(sizeof(Args) == 22 * 8, "Args layout");
__global__ void __launch_bounds__(NTHR, 2) fwd_kernel(Args a_unused) {
    extern __shared__ __attribute__((aligned(16))) unsigned char lds_raw[];
    cg::grid_group grid = cg::this_grid();
    Ctx F; F.lds = (LAS unsigned char*)lds_raw; F.tid = threadIdx.x; F.lane = F.tid & 63; F.wave = __builtin_amdgcn_readfirstlane(F.tid >> 6); F.G = gridDim.x; F.bid = blockIdx.x;

    int lo, hi; { typedef __attribute__((address_space(4))) const volatile unsigned long long* kp_t; const unsigned long long ph = ((kp_t)__builtin_amdgcn_kernarg_segment_ptr())[21]; lo = (int)(unsigned)ph; hi = (int)(unsigned)(ph >> 32); }
#ifndef PHASE_MASK
#define PHASE_MASK 0xffff
#endif
#define IN(k) (((PHASE_MASK >> (k)) & 1) && lo <= (k) && (k) < hi)
    volatile LAS unsigned* bst = (volatile LAS unsigned*)(F.lds + LDS_BYTES - 64);
    if (F.tid < 2) bst[F.tid] = 0u;
    __syncthreads();
    XcdBarrier xbar;
    { const Args a0 = load_args(); xbar = xcd_barrier_post((unsigned*)(a0.ws + WS_CTL), bst); }
    volatile LAS unsigned long long* tsl = (volatile LAS unsigned long long*)(F.lds + LDS_BYTES - 256);
    if (PROBE_PHASE >= 0 && F.bid == 0 && F.tid == 0) tsl[0] = __builtin_amdgcn_s_memrealtime();
#define SEAM(k) do { if (IN(k) && IN((k) + 1)) { if ((k) == 0) grid.sync(); else xcd_barrier(xbar); } \
        if (PROBE_PHASE >= 0 && F.bid == 0 && F.tid == 0) tsl[(k) + 1] = __builtin_amdgcn_s_memrealtime(); } while (0)
    if (IN(0)) { const Args a = load_args();
#pragma unroll 1
        for (int rep = 0; rep < REP_P0; ++rep) p0_phase(F, a); }
    SEAM(0);
    if (IN(1)) { const Args a = load_args(); p1_phase(F, a); }
    SEAM(1);
    if (IN(2)) {
        const Args a = load_args();
        pg8::Gemm g{(const bf16_t*)a.out, (const bf16_t*)(a.ws + WS_WINT), MTOK, PS, DM, 1 << 30}; pg8::StaticOrder S; S.init(MTOK, PS, F.G, F.bid);
        pg8::EpiBf16 E{(bf16_t*)(a.ws + WS_PROJ), PS};
        pg8::gemm_phase<pg8::EpiBf16, true, true>(F.lds, g, S, E);
        gates_tasks(F, a);
    }
    SEAM(2);
    if (IN(3)) {
        const Args a = load_args();
        for (int t = F.bid; t < BATCH * 64; t += F.G) qk_tile_task(F, a, t);
        for (int t = F.bid * NWAVES + F.wave; t < MTOK / 8 * 2; t += F.G * NWAVES) conv_task(F, a, t);
        for (int t = F.bid; t < 64; t += F.G) mscal_task(F, a, t);
    }
    SEAM(3);
    if (IN(4)) {
        const Args a = load_args();
        {
#pragma unroll 1
            for (int rep = 0; rep < REP_MSEQ; ++rep)
#pragma unroll 1
            for (int it = F.bid; it < 256; it += F.G) { const int xcd_ = it & 7, j_ = it >> 3; mseq_item(F, a, xcd_ * 4 + (j_ >> 3), (j_ >> 2) & 1, j_ & 3); }
        }
        float lam, cshift;
        { const float p01 = wave_sum(a.lam_p[F.lane] * a.lam_p[64 + F.lane]), p23 = wave_sum(a.lam_p[128 + F.lane] * a.lam_p[192 + F.lane]);
          lam = __expf(p01) - __expf(p23) + 0.2f;
          const float gq = wave_max(fabsf(a.qk_g[F.lane])), gk = wave_max(fabsf(a.qk_g[64 + F.lane]));
          cshift = 8.f * gq * gk * 1.4426950408889634f * 1.02f; }
        const int xcd = F.bid & 7, j = F.bid >> 3;
#pragma unroll 1
        for (int rep = 0; rep < REP_ATT; ++rep)
        for (int i = 0; i * F.G < 1024; ++i) {
            int u;
            if (F.G == 256) u = (xcd * 4 + i) * 32 + j; else u = i * F.G + F.bid;
            if (u < 1024) attn_unit(F, a, u >> 7, (u >> 5) & 3, u & 31, lam, cshift);
        }
    }
    SEAM(4);
    if (IN(5)) { const Args a = load_args(); mcombine_phase(F, a); }
    SEAM(5);
    if (IN(6)) {
        const Args a = load_args();
        pg8::Gemm g{(const bf16_t*)(a.ws + WS_YMIX), (const bf16_t*)(a.ws + WS_WOUTT), MTOK, DM, DM, 1 << 30}; pg8::StaticOrder S; S.init(MTOK, DM, F.G, F.bid);
        pg8::EpiX1 E{a.x, (const float*)(a.ws + WS_MOD), a.out};
        pg8::gemm_phase<pg8::EpiX1, true, true>(F.lds, g, S, E);
    }
    SEAM(6);
    if (IN(7)) { const Args a = load_args();
#pragma unroll 1
        for (int rep = 0; rep < REP_P7; ++rep) p7_phase(F, a); }
    SEAM(7);
    if (IN(8)) { const Args a = load_args(); for (int t = F.bid; t < BATCH * NEXP; t += F.G) topk_task(F, a, t); }
    SEAM(8);
    if (IN(9)) {
        const Args a = load_args();
        pg8::Gemm g{(const bf16_t*)(a.ws + WS_XE), (const bf16_t*)(a.ws + WS_WGUT), NPAIR, 4096, DM, 16};
        pg8::StaticOrder S; S.init(NPAIR, 4096, F.G, F.bid);
        pg8::EpiGU E{a.ws + WS_HH};
#pragma unroll 1
        for (int rep = 0; rep < REP_UP; ++rep)
        pg8::gemm_phase<pg8::EpiGU, true, true, true>(F.lds, g, S, E);
    }
    SEAM(9);
    if (IN(10)) {
        const Args a = load_args();
        pg8::Gemm g{(const bf16_t*)(a.ws + WS_HH), (const bf16_t*)(a.ws + WS_WDT), NPAIR, DM, DFF, 16};
        pg8::StaticOrder S; S.init(NPAIR, DM, F.G, F.bid);
        pg8::EpiDown E{(bf16_t*)(a.ws + WS_Y), (const float*)(a.ws + WS_VALS)};
        pg8::gemm_phase<pg8::EpiDown, true, true, true>(F.lds, g, S, E);
    }
    SEAM(10);
    if (IN(11)) { const Args a = load_args(); final_phase(F, a); }
    if (PROBE_MSEQ_W >= 0 && F.bid == 0 && F.tid == 0) {
        const unsigned long long d = *(volatile LAS unsigned long long*)(F.lds + LDS_BYTES - 128), t1 = __builtin_amdgcn_s_memtime();
        while (__builtin_amdgcn_s_memtime() - t1 < 3ull * d) __builtin_amdgcn_s_sleep(8);
    }
    if (PROBE_PHASE >= 0 && F.bid == 0 && F.tid == 0) {
        const unsigned long long t1 = __builtin_amdgcn_s_memrealtime();
        const unsigned long long d = (PROBE_PHASE == 11 ? t1 : tsl[PROBE_PHASE + 1]) - tsl[PROBE_PHASE];
        while (__builtin_amdgcn_s_memrealtime() - t1 < 3ull * d) __builtin_amdgcn_s_sleep(8);
    }
#undef IN
#undef SEAM
}

extern "C" void kernel_launch(void* const* d_in, const int* in_sizes, int n_in, void* d_out, int out_size, void* d_ws, size_t ws_size, hipStream_t stream) {
    static int grid_blocks = 0;
    if (!grid_blocks) {
        int dev = 0, cus = 0, per_cu = 0;
        (void)hipGetDevice(&dev);
        (void)hipDeviceGetAttribute(&cus, hipDeviceAttributeMultiprocessorCount, dev);
        (void)hipFuncSetAttribute((const void*)fwd_kernel, hipFuncAttributeMaxDynamicSharedMemorySize, LDS_BYTES);
        (void)hipOccupancyMaxActiveBlocksPerMultiprocessor(&per_cu, (const void*)fwd_kernel, NTHR, LDS_BYTES);
        if (per_cu < 1) per_cu = 1;
        grid_blocks = cus;
        if (ws_size < WS_END) fprintf(stderr, "kernel_launch: workspace too small: %zu < %zu\n", ws_size, (size_t)WS_END);
    }
    (void)hipMemsetAsync((char*)d_ws + WS_CTL, 0, CTL_ZERO_BYTES, stream);
    Args a{};
    a.x = (const float*)d_in[0]; a.c = (const float*)d_in[1]; a.pos = (const int*)d_in[2]; a.norm1_g = (const float*)d_in[3]; a.norm2_g = (const float*)d_in[4];
    a.w_ada = (const float*)d_in[5]; a.b_ada = (const float*)d_in[6]; a.w_in = (const float*)d_in[7]; a.conv_w = (const float*)d_in[8]; a.gate_b = (const float*)d_in[9];
    a.mnorm_g = (const float*)d_in[10]; a.qk_g = (const float*)d_in[11]; a.lam_p = (const float*)d_in[12]; a.subln_g = (const float*)d_in[13]; a.w_out = (const float*)d_in[14];
    a.w_router = (const float*)d_in[15]; a.w_gate = (const float*)d_in[16]; a.w_up = (const float*)d_in[17]; a.w_down = (const float*)d_in[18];
    a.out = (float*)d_out; a.ws = (unsigned char*)d_ws; a.ph_lo = 0; a.ph_hi = 12;
    void* args[] = {&a};
    hipError_t e = hipLaunchCooperativeKernel((const void*)fwd_kernel, dim3(grid_blocks), dim3(NTHR), args, LDS_BYTES, stream);
    if (e != hipSuccess) fprintf(stderr, "cooperative launch failed: %s (grid %d)\n", hipGetErrorString(e), grid_blocks);
}
```

```cpp
#include <hip/hip_runtime.h>
#include <hip/hip_cooperative_groups.h>
#include <cstdio>
#include <cstdint>
namespace cg = cooperative_groups;

#define LAS __attribute__((address_space(3)))
#define DI __device__ __forceinline__
typedef unsigned short bf16_t;
typedef short bf16x8 __attribute__((ext_vector_type(8)));
typedef short s16x4 __attribute__((ext_vector_type(4)));
typedef float f32x2 __attribute__((ext_vector_type(2)));
typedef float f32x4 __attribute__((ext_vector_type(4)));
typedef float f32x16 __attribute__((ext_vector_type(16)));
typedef unsigned u32x2 __attribute__((ext_vector_type(2)));
typedef unsigned u32x4 __attribute__((ext_vector_type(4)));
typedef __bf16 bf16x2_t __attribute__((ext_vector_type(2)));

constexpr int BATCH = 8, SEQ = 4096, DM = 1024, MTOK = BATCH * SEQ;
constexpr int DIN = 3600, PS = 3584;
constexpr int NEXP = 16, CAP = 512, DFF = 2048;
constexpr int NPAIR = BATCH * NEXP * CAP;
constexpr float EPS = 1e-6f;
constexpr int C_QM = 0, C_KM = 512, C_VM = 1024, C_OM = 1536, C_QA = 2048, C_KA = 2560, C_VA = 3072;

constexpr size_t MiB = 1u << 20;
constexpr size_t WS_MOD = 1 * MiB;
constexpr size_t WS_GATES = 2 * MiB;
constexpr size_t WS_AFF = 4 * MiB;
constexpr size_t WS_IDX = 6 * MiB;
constexpr size_t WS_VALS = 6 * MiB + 256 * 1024;
constexpr size_t WS_MSC = 6 * MiB + 512 * 1024;
constexpr size_t WS_SLOT = 7 * MiB;
constexpr size_t WS_NLOC = 9 * MiB;
constexpr size_t WS_WINT = 11 * MiB;
constexpr size_t WS_WGT = 18 * MiB;
constexpr size_t WS_WOUTT = 19 * MiB;
constexpr size_t WS_WGUT = 21 * MiB;
constexpr size_t WS_WDT = 85 * MiB;
constexpr size_t WS_Y = 117 * MiB;
constexpr size_t WS_PROJ = 213 * MiB;
constexpr size_t WS_YMIX = 437 * MiB;
constexpr size_t WS_KIMG = 437 * MiB;
constexpr size_t WS_VIMG = 469 * MiB;
constexpr size_t WS_YA = 501 * MiB;
constexpr size_t WS_HH = 245 * MiB;
constexpr size_t WS_H2 = 437 * MiB;
constexpr size_t WS_XE = 469 * MiB;
constexpr size_t WS_END = 533 * MiB;

constexpr int LDS_BYTES = 147456;
constexpr int PROBE_MSEQ_W = -1;
constexpr int PROBE_PHASE = -1;
constexpr int REP_M1 = 1, REP_M3 = 1, REP_UP = 1, REP_P0 = 1, REP_SCAN = 1, REP_P7 = 1, REP_ATT = 1, REP_QKT = 1, REP_MSEQ = 1;
constexpr int NWAVES = 8, NTHR = 512;

DI unsigned pk2(float lo, float hi) { f32x2 v = {lo, hi}; bf16x2_t b = __builtin_convertvector(v, bf16x2_t); return __builtin_bit_cast(unsigned, b); }
DI float bflo(unsigned w) { return __uint_as_float(w << 16); }
DI float bfhi(unsigned w) { return __uint_as_float(w & 0xffff0000u); }
DI float bf2f(bf16_t v) { return __uint_as_float((unsigned)v << 16); }
template <int CTRL> DI float dpp_mov(float x) { return __builtin_bit_cast(float, __builtin_amdgcn_update_dpp(0, __builtin_bit_cast(int, x), CTRL, 0xf, 0xf, false)); }
#define DPP_XOR1 0xB1
#define DPP_XOR2 0x4E
#define DPP_ROR(n) (0x120 + (n))
DI float xor16_sum(float x) { const unsigned u = __builtin_bit_cast(unsigned, x); auto r = __builtin_amdgcn_permlane16_swap(u, u, false, false); return __builtin_bit_cast(float, (unsigned)r[0]) + __builtin_bit_cast(float, (unsigned)r[1]); }
DI float xor32_sum(float x) { const unsigned u = __builtin_bit_cast(unsigned, x); auto r = __builtin_amdgcn_permlane32_swap(u, u, false, false); return __builtin_bit_cast(float, (unsigned)r[0]) + __builtin_bit_cast(float, (unsigned)r[1]); }
DI float xor16_max(float x) { const unsigned u = __builtin_bit_cast(unsigned, x); auto r = __builtin_amdgcn_permlane16_swap(u, u, false, false); return fmaxf(__builtin_bit_cast(float, (unsigned)r[0]), __builtin_bit_cast(float, (unsigned)r[1])); }
DI float xor32_max(float x) { const unsigned u = __builtin_bit_cast(unsigned, x); auto r = __builtin_amdgcn_permlane32_swap(u, u, false, false); return fmaxf(__builtin_bit_cast(float, (unsigned)r[0]), __builtin_bit_cast(float, (unsigned)r[1])); }
template <int CTRL, int RM, int BM_> DI float dpp_mov_m(float oldv, float x) { return __builtin_bit_cast(float, __builtin_amdgcn_update_dpp(__builtin_bit_cast(int, oldv), __builtin_bit_cast(int, x), CTRL, RM, BM_, false)); }
DI float wave_prefix_sum(float v) {
    v += dpp_mov_m<0x111, 0xf, 0xf>(0.f, v); v += dpp_mov_m<0x112, 0xf, 0xf>(0.f, v); v += dpp_mov_m<0x114, 0xf, 0xe>(0.f, v); v += dpp_mov_m<0x118, 0xf, 0xc>(0.f, v);
    v += dpp_mov_m<0x142, 0xa, 0xf>(0.f, v); v += dpp_mov_m<0x143, 0xc, 0xf>(0.f, v);
    return v;
}
DI float wave_prefix_max(float v) {
    const float ninf = -__builtin_inff();
    v = fmaxf(v, dpp_mov_m<0x111, 0xf, 0xf>(ninf, v)); v = fmaxf(v, dpp_mov_m<0x112, 0xf, 0xf>(ninf, v)); v = fmaxf(v, dpp_mov_m<0x114, 0xf, 0xe>(ninf, v)); v = fmaxf(v, dpp_mov_m<0x118, 0xf, 0xc>(ninf, v));
    v = fmaxf(v, dpp_mov_m<0x142, 0xa, 0xf>(ninf, v)); v = fmaxf(v, dpp_mov_m<0x143, 0xc, 0xf>(ninf, v));
    return v;
}
DI float partner32(float x, int lane) { const unsigned u = __builtin_bit_cast(unsigned, x); auto r = __builtin_amdgcn_permlane32_swap(u, u, false, false); return __builtin_bit_cast(float, (unsigned)((lane & 32) ? r[0] : r[1])); }
DI float partner16(float x, int lane) { const unsigned u = __builtin_bit_cast(unsigned, x); auto r = __builtin_amdgcn_permlane16_swap(u, u, false, false); return __builtin_bit_cast(float, (unsigned)((lane & 16) ? r[0] : r[1])); }
DI float partner8(float x) { return dpp_mov<DPP_ROR(8)>(x); }
DI float partner4(float x, int lane) { const float a = dpp_mov<DPP_ROR(4)>(x), b = dpp_mov<DPP_ROR(12)>(x); return (lane & 4) ? a : b; }
DI float row_sum16(float v) { v += dpp_mov<DPP_XOR1>(v); v += dpp_mov<DPP_XOR2>(v); v += dpp_mov<DPP_ROR(4)>(v); v += dpp_mov<DPP_ROR(8)>(v); return v; }
DI float wave_sum(float v) { v = row_sum16(v); v = xor16_sum(v); return xor32_sum(v); }
DI float wave_max(float v) { v = fmaxf(v, dpp_mov<DPP_XOR1>(v)); v = fmaxf(v, dpp_mov<DPP_XOR2>(v)); v = fmaxf(v, dpp_mov<DPP_ROR(4)>(v)); v = fmaxf(v, dpp_mov<DPP_ROR(8)>(v)); v = xor16_max(v); return xor32_max(v); }
DI float sigmoid_f(float v) { return __builtin_amdgcn_rcpf(1.f + __builtin_amdgcn_exp2f(-1.4426950408889634f * v)); }
DI float silu_f(float v) { return v * sigmoid_f(v); }
DI float logsigmoid_f(float f) { return fminf(f, 0.f) - log1pf(__expf(-fabsf(f))); }
DI int swz16(int row) { return ((row & 3) << 2) | ((row >> 2) & 3); }
#define MFMA32(a, b, c) __builtin_amdgcn_mfma_f32_32x32x16_bf16((a), (b), (c), 0, 0, 0)
DI s16x4 trread(const LAS unsigned char* p) { return __builtin_bit_cast(s16x4, __builtin_amdgcn_ds_read_tr16_b64_v4i16((LAS s16x4*)p)); }
DI int crow(int r, int hh) { return (r & 3) + 8 * (r >> 2) + 4 * hh; }
DI bool hh_sel(int lane, int bit) { return (lane & bit) != 0; }

namespace pg8 {
constexpr int BM = 256, BK = 64, HALF = 128, HTB = HALF * BK * 2, STAGE_BYTES = 8 * HTB, NXCD = 8, WGM = 8;
DI int lds_byte(int r, int c) { const int st = (r >> 4) * 2 + (c >> 5), rr = r & 15, cc = c & 31, ob = rr * 64 + cc * 2; return st * 1024 + (ob ^ (((ob >> 9) & 1) << 5)); }
DI void stage_rc(int b, int& R, int& C) { const int st = b / 1024, sb = b % 1024, swz = sb ^ (((sb >> 9) & 1) << 5); R = (st >> 1) * 16 + swz / 64; C = (st & 1) * 32 + (swz % 64) / 2; }
DI int perm32(int rho) { const int n = rho >> 4, i = rho & 15; return 8 * (i >> 2) + 4 * n + (i & 3); }
struct Unit { int pm, pn; };
typedef int i32x4_t __attribute__((ext_vector_type(4)));
typedef int i32x8_t __attribute__((ext_vector_type(8)));
DI i32x8_t cat8(bf16x8 lo, bf16x8 hi) { const i32x4_t a = __builtin_bit_cast(i32x4_t, lo), b = __builtin_bit_cast(i32x4_t, hi); return __builtin_shufflevector(a, b, 0, 1, 2, 3, 4, 5, 6, 7); }
struct Gemm { const bf16_t* A; const bf16_t* Bt; int M, N, K, tpg; };
struct StaticOrder {
    int nM, nN, nwg, G, c;
    DI void init(int M, int N, int G_, int c_) { nM = M / BM; nN = N / BM; nwg = nM * nN; G = G_; c = c_; }
    DI bool next(int i, Unit& u) const {
        const long L = (long)i * G + c; if (L >= nwg) return false;
        int wgid = (int)L; { const int q = nwg / NXCD, r = nwg % NXCD, xcd = wgid % NXCD, off = wgid / NXCD; wgid = (xcd < r ? xcd * (q + 1) : r * (q + 1) + (xcd - r) * q) + off; }
        const int nig = WGM * nN, gid = wgid / nig, fm = gid * WGM, gsz = (nM - fm) < WGM ? (nM - fm) : WGM;
        u.pm = fm + ((wgid % nig) % gsz); u.pn = (wgid % nig) / gsz; return true;
    }
};

template <class Epi, bool ALIGN_EPI, bool SP2, bool FP8 = false>
DI void gemm_phase(LAS unsigned char* lds, const Gemm g, const StaticOrder& S, const Epi& E) {
    const int tid = threadIdx.x, wid = __builtin_amdgcn_readfirstlane(tid >> 6), lane = tid & 63, wr = wid >> 2, wc = wid & 3, fr = lane & 15, fq = lane >> 4;
    const int KB = FP8 ? g.K : 2 * g.K, nt = KB / (BK * 2);
    unsigned voffA[2], voffB[2];
#pragma unroll
    for (int i = 0; i < 2; ++i) { int R, C; stage_rc(tid * 16 + i * 8192, R, C); const int Rb = Epi::PERM ? ((R & ~31) + perm32(R & 31)) : R;
        voffA[i] = (unsigned)(R * KB + C * 2); voffB[i] = (unsigned)(Rb * KB + C * 2); }
    const size_t kstep = (size_t)(BK * 2);
    const size_t hstep = (size_t)HALF * KB;
    const size_t tstep = 2 * hstep;
    const size_t gstep = (size_t)g.N * KB;
    const unsigned ldsw = (unsigned)wid * 1024u;
    const int aoff = lds_byte(wr * 64 + fr, fq * 8), boff = lds_byte(wc * 32 + fr, fq * 8);
#define PG8_SA(b, h) (((b) * 2 + (h)) * HTB)
#define PG8_SB(b, h) ((4 + (b) * 2 + (h)) * HTB)
#define PG8_STAGE(bufoff, gbase, voff) do { _Pragma("unroll") for (int _i = 0; _i < 2; ++_i) \
        __builtin_amdgcn_global_load_lds((const unsigned*)((const char*)(gbase) + (voff)[_i]), (LAS unsigned*)(lds + (bufoff) + ldsw + _i * 8192), 16, 0, 0); } while (0)
#define PG8_LDA(dst, b, h) do { if constexpr (FP8) { _Pragma("unroll") for (int m = 0; m < 4; ++m) dst##8[m] = cat8(*(const LAS bf16x8*)(lds + PG8_SA(b, h) + aoff + m * 2048), *(const LAS bf16x8*)(lds + PG8_SA(b, h) + aoff + m * 2048 + 1024)); } \
        else { _Pragma("unroll") for (int m = 0; m < 4; ++m) _Pragma("unroll") for (int k = 0; k < 2; ++k) dst[m][k] = *(const LAS bf16x8*)(lds + PG8_SA(b, h) + aoff + m * 2048 + k * 1024); } } while (0)
#define PG8_LDB(dst, b, h) do { if constexpr (FP8) { _Pragma("unroll") for (int n = 0; n < 2; ++n) dst##8[n] = cat8(*(const LAS bf16x8*)(lds + PG8_SB(b, h) + boff + n * 2048), *(const LAS bf16x8*)(lds + PG8_SB(b, h) + boff + n * 2048 + 1024)); } \
        else { _Pragma("unroll") for (int n = 0; n < 2; ++n) _Pragma("unroll") for (int k = 0; k < 2; ++k) dst[n][k] = *(const LAS bf16x8*)(lds + PG8_SB(b, h) + boff + n * 2048 + k * 1024); } } while (0)
#define PG8_MMA(ai, bj, At, Bt) do { __builtin_amdgcn_s_setprio(1); \
        if constexpr (FP8) { _Pragma("unroll") for (int m = 0; m < 4; ++m) _Pragma("unroll") for (int n = 0; n < 2; ++n) \
            asm volatile("s_nop 1\n\tv_mfma_f32_16x16x128_f8f6f4 %0, %1, %2, %0" : "+v"(acc[ai][bj][m][n]) : "v"(Bt##8[n]), "v"(At##8[m])); } \
        else { _Pragma("unroll") for (int m = 0; m < 4; ++m) _Pragma("unroll") for (int n = 0; n < 2; ++n) _Pragma("unroll") for (int k = 0; k < 2; ++k) \
            acc[ai][bj][m][n] = __builtin_amdgcn_mfma_f32_16x16x32_bf16(Bt[n][k], At[m][k], acc[ai][bj][m][n], 0, 0, 0); } \
        __builtin_amdgcn_s_setprio(0); } while (0)
#define PG8_WAIT_V(n) asm volatile("s_waitcnt vmcnt(" #n ")" ::: "memory")
#define PG8_WAIT_L(n) asm volatile("s_waitcnt lgkmcnt(" #n ")" ::: "memory")
#define PG8_BAR __builtin_amdgcn_s_barrier()
#define PG8_SCHED __builtin_amdgcn_sched_barrier(0)
    Unit cur, nxt; int ui = 0;
    if (!S.next(0, cur)) return;
    f32x4 acc[2][2][4][2];
#pragma unroll
    for (int a = 0; a < 2; ++a)
#pragma unroll
        for (int b = 0; b < 2; ++b)
#pragma unroll
            for (int m = 0; m < 4; ++m)
#pragma unroll
                for (int n = 0; n < 2; ++n) acc[a][b][m][n] = (f32x4){0.f, 0.f, 0.f, 0.f};
    bf16x8 At[4][2], B0[2][2], B1[2][2]; i32x8_t At8[4], B08[2], B18[2];
    const char* cA = (const char*)g.A + (size_t)cur.pm * tstep; const char* cB = (const char*)g.Bt + (size_t)(cur.pm / g.tpg) * gstep + (size_t)cur.pn * tstep;
    if constexpr (SP2) {
        PG8_STAGE(PG8_SB(0, 0), cB, voffB); PG8_STAGE(PG8_SB(0, 1), cB + hstep, voffB); PG8_STAGE(PG8_SA(0, 0), cA, voffA); PG8_STAGE(PG8_SA(0, 1), cA + hstep, voffA);
        if (wr == 1) PG8_BAR;
        PG8_WAIT_V(2); PG8_BAR;
        PG8_STAGE(PG8_SB(1, 0), cB + kstep, voffB); PG8_STAGE(PG8_SA(1, 0), cA + kstep, voffA); PG8_STAGE(PG8_SB(1, 1), cB + hstep + kstep, voffB);
        PG8_WAIT_V(6); PG8_BAR;
    } else {
        PG8_STAGE(PG8_SB(0, 0), cB, voffB); PG8_STAGE(PG8_SA(0, 0), cA, voffA); PG8_STAGE(PG8_SB(0, 1), cB + hstep, voffB); PG8_STAGE(PG8_SA(0, 1), cA + hstep, voffA);
        if (wr == 1) PG8_BAR;
        PG8_WAIT_V(4); PG8_BAR;
        PG8_STAGE(PG8_SB(1, 0), cB + kstep, voffB); PG8_STAGE(PG8_SA(1, 0), cA + kstep, voffA); PG8_STAGE(PG8_SB(1, 1), cB + hstep + kstep, voffB);
        PG8_WAIT_V(6); PG8_BAR;
    }
    for (;;) {
        const bool has_next = S.next(ui + 1, nxt);
        const char* nA = has_next ? (const char*)g.A + (size_t)nxt.pm * tstep : cA;
        const char* nB = has_next ? (const char*)g.Bt + (size_t)(nxt.pm / g.tpg) * gstep + (size_t)nxt.pn * tstep : cB;
        for (int t = 0; t < nt; t += 2) {
            const bool last = (t == nt - 2);
            const char* a1 = cA + (size_t)(t + 1) * kstep;
            const char* a2 = last ? nA : cA + (size_t)(t + 2) * kstep; const char* b2 = last ? nB : cB + (size_t)(t + 2) * kstep;
            const char* a3 = a2 + kstep; const char* b3 = b2 + kstep;
            if constexpr (SP2) {
            PG8_LDB(B0, 0, 0); PG8_LDB(B1, 0, 1); PG8_SCHED; PG8_LDA(At, 0, 0); PG8_STAGE(PG8_SA(1, 1), a1 + hstep, voffA);
            PG8_WAIT_V(8); PG8_WAIT_L(0); PG8_BAR; PG8_MMA(0, 0, At, B0); PG8_MMA(0, 1, At, B1); PG8_BAR; PG8_SCHED;
            PG8_LDA(At, 0, 1); PG8_STAGE(PG8_SB(0, 0), b2, voffB); PG8_STAGE(PG8_SB(0, 1), b2 + hstep, voffB); PG8_STAGE(PG8_SA(0, 0), a2, voffA);
            PG8_WAIT_V(8); PG8_WAIT_L(0); PG8_BAR; PG8_MMA(1, 0, At, B0); PG8_MMA(1, 1, At, B1); PG8_BAR; PG8_SCHED;
            PG8_LDB(B0, 1, 0); PG8_LDB(B1, 1, 1); PG8_SCHED; PG8_LDA(At, 1, 0); PG8_STAGE(PG8_SA(0, 1), a2 + hstep, voffA);
            PG8_WAIT_V(8); PG8_WAIT_L(0); PG8_BAR; PG8_MMA(0, 0, At, B0); PG8_MMA(0, 1, At, B1); PG8_BAR; PG8_SCHED;
            PG8_LDA(At, 1, 1); PG8_STAGE(PG8_SB(1, 0), b3, voffB); PG8_STAGE(PG8_SB(1, 1), b3 + hstep, voffB); PG8_STAGE(PG8_SA(1, 0), a3, voffA);
            PG8_WAIT_V(8); PG8_WAIT_L(0); PG8_BAR; PG8_MMA(1, 0, At, B0); PG8_MMA(1, 1, At, B1); PG8_BAR; PG8_SCHED;
            } else {
            PG8_LDB(B0, 0, 0); PG8_SCHED; PG8_LDA(At, 0, 0); PG8_STAGE(PG8_SA(1, 1), a1 + hstep, voffA);
            PG8_WAIT_L(8); PG8_BAR; PG8_WAIT_L(0); PG8_MMA(0, 0, At, B0); PG8_BAR; PG8_SCHED;
            PG8_LDB(B1, 0, 1); PG8_STAGE(PG8_SB(0, 0), b2, voffB);
            PG8_BAR; PG8_WAIT_L(0); PG8_MMA(0, 1, At, B1); PG8_BAR;
            PG8_LDA(At, 0, 1); PG8_STAGE(PG8_SA(0, 0), a2, voffA);
            PG8_BAR; PG8_WAIT_L(0); PG8_MMA(1, 0, At, B0); PG8_BAR; PG8_SCHED;
            PG8_STAGE(PG8_SB(0, 1), b2 + hstep, voffB);
            PG8_WAIT_V(6); PG8_BAR; PG8_MMA(1, 1, At, B1); PG8_BAR;
            PG8_LDB(B0, 1, 0); PG8_SCHED; PG8_LDA(At, 1, 0); PG8_STAGE(PG8_SA(0, 1), a2 + hstep, voffA);
            PG8_WAIT_L(8); PG8_BAR; PG8_WAIT_L(0); PG8_MMA(0, 0, At, B0); PG8_BAR; PG8_SCHED;
            PG8_LDB(B1, 1, 1); PG8_STAGE(PG8_SB(1, 0), b3, voffB);
            PG8_BAR; PG8_WAIT_L(0); PG8_MMA(0, 1, At, B1); PG8_BAR;
            PG8_LDA(At, 1, 1); PG8_STAGE(PG8_SA(1, 0), a3, voffA);
            PG8_BAR; PG8_WAIT_L(0); PG8_MMA(1, 0, At, B0); PG8_BAR; PG8_SCHED;
            PG8_STAGE(PG8_SB(1, 1), b3 + hstep, voffB);
            PG8_WAIT_V(6); PG8_BAR; PG8_MMA(1, 1, At, B1); PG8_BAR;
            }
        }
        if constexpr (ALIGN_EPI) { if (wr == 0) PG8_BAR; }
        if constexpr (FP8) asm volatile("s_nop 15\n\ts_nop 7" ::: "memory");
        E(acc, cur, wr, wc, fr, fq);
        if (!has_next) break;
#pragma unroll
        for (int a = 0; a < 2; ++a)
#pragma unroll
            for (int b = 0; b < 2; ++b)
#pragma unroll
                for (int m = 0; m < 4; ++m)
#pragma unroll
                    for (int n = 0; n < 2; ++n) acc[a][b][m][n] = (f32x4){0.f, 0.f, 0.f, 0.f};
        cur = nxt; cA = nA; cB = nB; ++ui;
        if constexpr (ALIGN_EPI) { if (wr == 1) PG8_BAR; }
    }
    PG8_WAIT_V(0);
    if constexpr (!ALIGN_EPI) { if (wr == 0) PG8_BAR; }
    PG8_BAR;
#undef PG8_SA
#undef PG8_SB
#undef PG8_STAGE
#undef PG8_LDA
#undef PG8_LDB
#undef PG8_MMA
#undef PG8_WAIT_V
#undef PG8_WAIT_L
#undef PG8_BAR
#undef PG8_SCHED
}

struct EpiBf16 {
    static constexpr bool PERM = true;
    bf16_t* O; int ldc;
    DI void operator()(const f32x4 (&acc)[2][2][4][2], const Unit& u, int wr, int wc, int fr, int fq) const {
        const int row0 = u.pm * BM + wr * 64 + fr, col0 = u.pn * BM + wc * 32 + 8 * fq;
#pragma unroll
        for (int ai = 0; ai < 2; ++ai)
#pragma unroll
            for (int m = 0; m < 4; ++m) { bf16_t* rowp = O + (size_t)(row0 + ai * HALF + m * 16) * ldc + col0;
#pragma unroll
                for (int bj = 0; bj < 2; ++bj) { const f32x4 v0 = acc[ai][bj][m][0], v1 = acc[ai][bj][m][1];
                    u32x4 w; w.x = pk2(v0[0], v0[1]); w.y = pk2(v0[2], v0[3]); w.z = pk2(v1[0], v1[1]); w.w = pk2(v1[2], v1[3]);
                    *(u32x4*)(rowp + bj * HALF) = w; } }
    }
};
struct EpiX1 {
    static constexpr bool PERM = false;
    const float* x; const float* mod; float* out;
    DI void operator()(const f32x4 (&acc)[2][2][4][2], const Unit& u, int wr, int wc, int fr, int fq) const {
        const int row0 = u.pm * BM + wr * 64 + fr, col0 = u.pn * BM + wc * 32 + 4 * fq;
        const int b = (u.pm * BM) / SEQ;
        const float* gp = mod + (size_t)b * 6144 + 2048 + col0;
#pragma unroll
        for (int bj = 0; bj < 2; ++bj)
#pragma unroll
            for (int n = 0; n < 2; ++n) { const f32x4 gv = *(const f32x4*)(gp + bj * HALF + n * 16);
#pragma unroll
                for (int ai = 0; ai < 2; ++ai)
#pragma unroll
                    for (int m = 0; m < 4; ++m) { const size_t off = (size_t)(row0 + ai * HALF + m * 16) * DM + col0 + bj * HALF + n * 16;
                        const f32x4 xv = *(const f32x4*)(x + off); *(f32x4*)(out + off) = xv + gv * acc[ai][bj][m][n]; } }
    }
};
DI unsigned pk4_fp8(float a, float b, float c, float d) { int w = __builtin_amdgcn_cvt_pk_fp8_f32(a, b, 0, false); w = __builtin_amdgcn_cvt_pk_fp8_f32(c, d, w, true); return (unsigned)w; }
constexpr float W_PRESCALE = 32.f, H_PRESCALE = 8.f;
struct EpiGU {
    static constexpr bool PERM = true;
    unsigned char* H;
    DI void operator()(const f32x4 (&acc)[2][2][4][2], const Unit& u, int wr, int wc, int fr, int fq) const {
        const int row0 = u.pm * BM + wr * 64 + fr, col0 = u.pn * HALF + wc * 32 + 8 * fq;
#pragma unroll
        for (int ai = 0; ai < 2; ++ai)
#pragma unroll
            for (int m = 0; m < 4; ++m) { unsigned char* rowp = H + (size_t)(row0 + ai * HALF + m * 16) * DFF + col0;
                float hv[8];
#pragma unroll
                for (int n = 0; n < 2; ++n)
#pragma unroll
                    for (int j = 0; j < 4; ++j) { const float gg = acc[ai][0][m][n][j] * (1.f / W_PRESCALE), uu = acc[ai][1][m][n][j] * (H_PRESCALE / W_PRESCALE); hv[n * 4 + j] = gg * __builtin_amdgcn_rcpf(1.f + __builtin_amdgcn_exp2f(-1.4426950408889634f * gg)) * uu; }
                u32x2 w; w.x = pk4_fp8(hv[0], hv[1], hv[2], hv[3]); w.y = pk4_fp8(hv[4], hv[5], hv[6], hv[7]);
                *(u32x2*)rowp = w; }
    }
};
constexpr float Y_PRESCALE = 64.f;
struct EpiDown {
    static constexpr bool PERM = true;
    unsigned char* Y; const float* vals;
    DI void operator()(const f32x4 (&acc)[2][2][4][2], const Unit& u, int wr, int wc, int fr, int fq) const {
        const int row0 = u.pm * BM + wr * 64 + fr, col0 = u.pn * BM + wc * 32 + 8 * fq;
#pragma unroll
        for (int ai = 0; ai < 2; ++ai)
#pragma unroll
            for (int m = 0; m < 4; ++m) { const int row = row0 + ai * HALF + m * 16; const float s = vals[row] * (Y_PRESCALE / (W_PRESCALE * H_PRESCALE)); unsigned char* rowp = Y + (size_t)row * DM + col0;
#pragma unroll
                for (int bj = 0; bj < 2; ++bj) { const f32x4 v0 = acc[ai][bj][m][0] * s, v1 = acc[ai][bj][m][1] * s;
                    u32x2 w; w.x = pk4_fp8(v0[0], v0[1], v0[2], v0[3]); w.y = pk4_fp8(v1[0], v1[1], v1[2], v1[3]);
                    *(u32x2*)(rowp + bj * HALF) = w; } }
    }
};
}

struct Args {
    const float* x; const float* c; const int* pos; const float* norm1_g; const float* norm2_g; const float* w_ada; const float* b_ada;
    const float* w_in; const float* conv_w; const float* gate_b; const float* mnorm_g; const float* qk_g; const float* lam_p; const float* subln_g;
    const float* w_out; const float* w_router; const float* w_gate; const float* w_up; const float* w_down;
    float* out; unsigned char* ws; int ph_lo, ph_hi;
};
struct Ctx {
    LAS unsigned char* lds; int tid, lane, wave, G, bid;
};
DI Args load_args() {
    typedef __attribute__((address_space(4))) const volatile unsigned long long* kp_t;
    kp_t kp = (kp_t)__builtin_amdgcn_kernarg_segment_ptr();
#define GP(T, i) ((T*)(__attribute__((address_space(1))) T*)kp[i])
    Args a;
    a.x = GP(const float, 0); a.c = GP(const float, 1); a.pos = GP(const int, 2); a.norm1_g = GP(const float, 3); a.norm2_g = GP(const float, 4);
    a.w_ada = GP(const float, 5); a.b_ada = GP(const float, 6); a.w_in = GP(const float, 7); a.conv_w = GP(const float, 8); a.gate_b = GP(const float, 9);
    a.mnorm_g = GP(const float, 10); a.qk_g = GP(const float, 11); a.lam_p = GP(const float, 12); a.subln_g = GP(const float, 13); a.w_out = GP(const float, 14);
    a.w_router = GP(const float, 15); a.w_gate = GP(const float, 16); a.w_up = GP(const float, 17); a.w_down = GP(const float, 18);
    a.out = GP(float, 19); a.ws = GP(unsigned char, 20);
#undef GP
    a.ph_lo = 0; a.ph_hi = 12;
    return a;
}

DI void tr_item64(const float* src, size_t ld_src, int k0, int c0, bf16_t* dst, size_t r0, int ld_dst, LAS float* scr  , int lane) {
    const float* sp = src + (size_t)(k0 + (lane >> 4)) * ld_src + c0 + (lane & 15) * 4;
#pragma unroll 1
    for (int hf = 0; hf < 2; ++hf) {
        f32x4 v[8];
#pragma unroll
        for (int i = 0; i < 8; ++i) v[i] = *(const f32x4*)(sp + (size_t)(4 * (8 * hf + i)) * ld_src);
#pragma unroll
        for (int i = 0; i < 8; ++i) *(LAS f32x4*)(scr + (4 * (8 * hf + i) + (lane >> 4)) * 68 + (lane & 15) * 4) = v[i];
    }
    asm volatile("s_waitcnt lgkmcnt(0)" ::: "memory");
    const int c = lane & 7;
#pragma unroll
    for (int q = 0; q < 8; ++q) { const int n = 8 * q + (lane >> 3); const LAS float* s = scr + (8 * c) * 68 + n;
        u32x4 o; o.x = pk2(s[0 * 68], s[1 * 68]); o.y = pk2(s[2 * 68], s[3 * 68]); o.z = pk2(s[4 * 68], s[5 * 68]); o.w = pk2(s[6 * 68], s[7 * 68]);
        *(u32x4*)(dst + (r0 + n) * ld_dst + k0 + 8 * c) = o; }
    asm volatile("s_waitcnt lgkmcnt(0)" ::: "memory");
}
DI void tr_item64_fp8(const float* src, size_t ld_src, int k0, int c0, unsigned char* dst, size_t r0, int ld_dst, float scale, LAS float* scr  , int lane) {
    const float* sp = src + (size_t)(k0 + (lane >> 4)) * ld_src + c0 + (lane & 15) * 4;
    {
        f32x4 v[16];
#pragma unroll
        for (int i = 0; i < 16; ++i) v[i] = __builtin_nontemporal_load((const f32x4*)(sp + (size_t)(4 * i) * ld_src));
#pragma unroll
        for (int i = 0; i < 16; ++i) *(LAS f32x4*)(scr + (4 * i + (lane >> 4)) * 68 + (lane & 15) * 4) = v[i] * scale;
    }
    asm volatile("s_waitcnt lgkmcnt(0)" ::: "memory");
    const int c = lane & 3;
#pragma unroll
    for (int q = 0; q < 4; ++q) { const int n = 16 * q + (lane >> 2); const LAS float* s = scr + (16 * c) * 68 + n;
        u32x4 o; o.x = pg8::pk4_fp8(s[0 * 68], s[1 * 68], s[2 * 68], s[3 * 68]); o.y = pg8::pk4_fp8(s[4 * 68], s[5 * 68], s[6 * 68], s[7 * 68]);
        o.z = pg8::pk4_fp8(s[8 * 68], s[9 * 68], s[10 * 68], s[11 * 68]); o.w = pg8::pk4_fp8(s[12 * 68], s[13 * 68], s[14 * 68], s[15 * 68]);
        *(u32x4*)(dst + (r0 + n) * ld_dst + k0 + 16 * c) = o; }
    asm volatile("s_waitcnt lgkmcnt(0)" ::: "memory");
}
DI void p0_phase(const Ctx& F, const Args& a) {
    if (F.bid < 96) {
        LAS float* sc = (LAS float*)F.lds; LAS float* part = (LAS float*)(F.lds + 32768);
        for (int i = F.tid; i < BATCH * DM; i += NTHR) sc[i] = silu_f(a.c[i]);
        __syncthreads();
        const int col = F.bid * 64 + F.lane;
        float acc[8];
#pragma unroll
        for (int b = 0; b < 8; ++b) acc[b] = 0.f;
        const int kb = F.wave * 128;
#pragma unroll 1
        for (int k0 = kb; k0 < kb + 128; k0 += 16) {
            float w[16];
            const float* wp = a.w_ada + (size_t)k0 * 6144 + col;
#pragma unroll
            for (int j = 0; j < 16; ++j) w[j] = wp[(size_t)j * 6144];
#pragma unroll
            for (int j = 0; j < 16; ++j)
#pragma unroll
                for (int b = 0; b < 8; ++b) acc[b] += sc[b * DM + k0 + j] * w[j];
        }
#pragma unroll
        for (int b = 0; b < 8; ++b) part[(F.wave * 8 + b) * 64 + F.lane] = acc[b];
        __syncthreads();
        { const int b = F.tid >> 6, l = F.tid & 63; float s = a.b_ada[F.bid * 64 + l];
#pragma unroll
          for (int w = 0; w < 8; ++w) s += part[(w * 8 + b) * 64 + l];
          ((float*)(a.ws + WS_MOD))[b * 6144 + F.bid * 64 + l] = s; }
        __syncthreads();
    }
    LAS float* scr = (LAS float*)(F.lds + F.wave * 17408);
    const int gw = F.bid * NWAVES + F.wave, NGW = F.G * NWAVES;
    constexpr int I_IN = 16 * 56, I_OUT = 16 * 16, I_G = 16 * 16 * 32, I_D = 16 * 32 * 16, I_WG = 16;
    constexpr int NITEMS = I_IN + I_OUT + 2 * I_G + I_D + I_WG;
    bf16_t* WinT = (bf16_t*)(a.ws + WS_WINT); bf16_t* WgT = (bf16_t*)(a.ws + WS_WGT); bf16_t* WoutT = (bf16_t*)(a.ws + WS_WOUTT);
    unsigned char* WguT = a.ws + WS_WGUT; unsigned char* WdT = a.ws + WS_WDT;
    for (int it = gw; it < NITEMS; it += NGW) {
        int r = it;
        if (r < I_IN) { const int kb = r / 56, nb = r % 56, n0 = nb * 64; tr_item64(a.w_in, DIN, kb * 64, n0 + (n0 >= 2048 ? 16 : 0), WinT, n0, DM, scr, F.lane); continue; } r -= I_IN;
        if (r < I_OUT) { const int kb = r / 16, nb = r % 16; tr_item64(a.w_out, DM, kb * 64, nb * 64, WoutT, nb * 64, DM, scr, F.lane); continue; } r -= I_OUT;
        if (r < 2 * I_G) { const int up = r / I_G; r -= up * I_G; const int e = r / 512; r -= e * 512; const int kb = r / 32, nb = r % 32, n0 = nb * 64;
            const float* src = (up ? a.w_up : a.w_gate) + (size_t)e * DM * DFF;
            tr_item64_fp8(src, DFF, kb * 64, n0, WguT + (size_t)e * 4096 * DM, (size_t)(n0 / 128) * 256 + (n0 % 128) + up * 128, DM, pg8::W_PRESCALE, scr, F.lane); continue; } r -= 2 * I_G;
        if (r < I_D) { const int e = r / 512; r -= e * 512; const int kb = r / 16, nb = r % 16;
            tr_item64_fp8(a.w_down + (size_t)e * DFF * DM, DM, kb * 64, nb * 64, WdT + (size_t)e * DM * DFF, nb * 64, DFF, pg8::W_PRESCALE, scr, F.lane); continue; } r -= I_D;
        tr_item64(a.w_in, DIN, r * 64, 2048 - 48, WgT, 0, DM, scr, F.lane);
    }
}

DI void p1_phase(const Ctx& F, const Args& a) {
    const int gw = F.bid * NWAVES + F.wave, NGW = F.G * NWAVES;
    const float* mod = (const float*)(a.ws + WS_MOD);
    bf16_t* H1 = (bf16_t*)a.out;
    for (int m0 = gw; m0 < MTOK; m0 += 2 * NGW) {
        const int m1 = m0 + NGW; const bool has1 = m1 < MTOK;
        const f32x4* xr0 = (const f32x4*)(a.x + (size_t)m0 * DM) + F.lane; const f32x4* xr1 = (const f32x4*)(a.x + (size_t)(has1 ? m1 : m0) * DM) + F.lane;
        f32x4 v0[4], v1[4]; float s0 = 0.f, s1 = 0.f;
#pragma unroll
        for (int j = 0; j < 4; ++j) { v0[j] = __builtin_nontemporal_load(xr0 + 64 * j); v1[j] = __builtin_nontemporal_load(xr1 + 64 * j); }
#pragma unroll
        for (int j = 0; j < 4; ++j) { s0 += (v0[j].x * v0[j].x + v0[j].y * v0[j].y) + (v0[j].z * v0[j].z + v0[j].w * v0[j].w); s1 += (v1[j].x * v1[j].x + v1[j].y * v1[j].y) + (v1[j].z * v1[j].z + v1[j].w * v1[j].w); }
#pragma unroll
        for (int o = 1; o < 64; o <<= 1) { s0 += __shfl_xor(s0, o); s1 += __shfl_xor(s1, o); }
        const float rstd0 = rsqrtf(s0 * (1.f / DM) + EPS), rstd1 = rsqrtf(s1 * (1.f / DM) + EPS);
        const int b0 = m0 / SEQ, b1 = (has1 ? m1 : m0) / SEQ;
        u32x2* o0 = (u32x2*)(H1 + (size_t)m0 * DM) + F.lane; u32x2* o1 = (u32x2*)(H1 + (size_t)m1 * DM) + F.lane;
#pragma unroll
        for (int j = 0; j < 4; ++j) {
            const f32x4 g = ((const f32x4*)a.norm1_g)[F.lane + 64 * j];
            { const f32x4 sh = ((const f32x4*)(mod + (size_t)b0 * 6144))[F.lane + 64 * j], sc = ((const f32x4*)(mod + (size_t)b0 * 6144 + 1024))[F.lane + 64 * j];
              const f32x4 h = v0[j] * rstd0 * g * (sc + 1.f) + sh; u32x2 w; w.x = pk2(h.x, h.y); w.y = pk2(h.z, h.w); o0[64 * j] = w; }
            if (has1) { const f32x4 sh = ((const f32x4*)(mod + (size_t)b1 * 6144))[F.lane + 64 * j], sc = ((const f32x4*)(mod + (size_t)b1 * 6144 + 1024))[F.lane + 64 * j];
              const f32x4 h = v1[j] * rstd1 * g * (sc + 1.f) + sh; u32x2 w; w.x = pk2(h.x, h.y); w.y = pk2(h.z, h.w); o1[64 * j] = w; }
        }
    }
}

DI void gates_tasks(const Ctx& F, const Args& a) {
    const int gw = F.bid * NWAVES + F.wave, NGW = F.G * NWAVES;
    const bf16_t* H1 = (const bf16_t*)a.out; const bf16_t* WgT = (const bf16_t*)(a.ws + WS_WGT) + 48 * DM; float* GT = (float*)(a.ws + WS_GATES);
    const float bias = a.gate_b[F.lane & 15];
    for (int task = gw; task < MTOK / 16; task += NGW) {
        const int row0 = task * 16;
        const bf16_t* ap = H1 + (size_t)(row0 + (F.lane & 15)) * DM + 8 * (F.lane >> 4);
        const bf16_t* bp = WgT + (size_t)(F.lane & 15) * DM + 8 * (F.lane >> 4);
        f32x4 acc = {0.f, 0.f, 0.f, 0.f};
#pragma unroll 8
        for (int i = 0; i < 32; ++i) { const bf16x8 av = *(const bf16x8*)(ap + 32 * i), bv = *(const bf16x8*)(bp + 32 * i); acc = __builtin_amdgcn_mfma_f32_16x16x32_bf16(av, bv, acc, 0, 0, 0); }
#pragma unroll
        for (int r = 0; r < 4; ++r) GT[(size_t)(row0 + (F.lane >> 4) * 4 + r) * 16 + (F.lane & 15)] = acc[r] + bias;
    }
}

DI void qk_tile_task(const Ctx& F, const Args& a, int task) {
    const int b = task >> 6, tile = task & 63, r = F.lane, g = F.wave, h = g >> 1, p = g & 1;
    bf16_t* PROJ = (bf16_t*)(a.ws + WS_PROJ);
    const size_t tok = (size_t)b * SEQ + tile * 64 + r;
    float invf[8];
#pragma unroll
    for (int i = 0; i < 8; ++i) invf[i] = exp2f(-(float)i * 0.125f * 18.931568569324174f) * 0.15915494309189535f;
    const float pos = (float)a.pos[tok];
    float sn[8], cs[8];
#pragma unroll
    for (int i = 0; i < 8; ++i) { const float fr = __builtin_amdgcn_fractf(pos * invf[i]); sn[i] = __builtin_amdgcn_sinf(fr); cs[i] = __builtin_amdgcn_cosf(fr); }
#pragma unroll 1
    for (int isk = 0; isk < 2; ++isk) {
        u32x4* src = (u32x4*)(PROJ + tok * PS + (isk ? C_KA : C_QA) + g * 64);
        u32x4 w[8];
#pragma unroll
        for (int c = 0; c < 8; ++c) w[c] = src[c];
        float ss = 0.f;
#pragma unroll
        for (int c = 0; c < 8; ++c) { float t;
            t = bflo(w[c].x); ss += t * t; t = bfhi(w[c].x); ss += t * t; t = bflo(w[c].y); ss += t * t; t = bfhi(w[c].y); ss += t * t;
            t = bflo(w[c].z); ss += t * t; t = bfhi(w[c].z); ss += t * t; t = bflo(w[c].w); ss += t * t; t = bfhi(w[c].w); ss += t * t; }
        const float rstd = rsqrtf(ss * (1.f / 64.f) + EPS) * (isk ? 1.f : 0.125f * 1.4426950408889634f);
        const float* gp = a.qk_g + isk * 64;
        float v0[16];
        v0[0] = bflo(w[0].x); v0[1] = bfhi(w[0].x); v0[2] = bflo(w[0].y); v0[3] = bfhi(w[0].y); v0[4] = bflo(w[0].z); v0[5] = bfhi(w[0].z); v0[6] = bflo(w[0].w); v0[7] = bfhi(w[0].w);
        v0[8] = bflo(w[1].x); v0[9] = bfhi(w[1].x); v0[10] = bflo(w[1].y); v0[11] = bfhi(w[1].y); v0[12] = bflo(w[1].z); v0[13] = bfhi(w[1].z); v0[14] = bflo(w[1].w); v0[15] = bfhi(w[1].w);
#pragma unroll
        for (int i = 0; i < 16; ++i) v0[i] *= rstd * gp[i];
        float rr[16];
#pragma unroll
        for (int i = 0; i < 8; ++i) { rr[i] = v0[i] * cs[i] - v0[i + 8] * sn[i]; rr[i + 8] = v0[i + 8] * cs[i] + v0[i] * sn[i]; }
        u32x4 o[8];
        o[0].x = pk2(rr[0], rr[1]); o[0].y = pk2(rr[2], rr[3]); o[0].z = pk2(rr[4], rr[5]); o[0].w = pk2(rr[6], rr[7]);
        o[1].x = pk2(rr[8], rr[9]); o[1].y = pk2(rr[10], rr[11]); o[1].z = pk2(rr[12], rr[13]); o[1].w = pk2(rr[14], rr[15]);
#pragma unroll
        for (int c = 2; c < 8; ++c) { const f32x4 g0 = *(const f32x4*)(gp + c * 8), g1 = *(const f32x4*)(gp + c * 8 + 4);
            o[c].x = pk2(bflo(w[c].x) * rstd * g0.x, bfhi(w[c].x) * rstd * g0.y); o[c].y = pk2(bflo(w[c].y) * rstd * g0.z, bfhi(w[c].y) * rstd * g0.w);
            o[c].z = pk2(bflo(w[c].z) * rstd * g1.x, bfhi(w[c].z) * rstd * g1.y); o[c].w = pk2(bflo(w[c].w) * rstd * g1.z, bfhi(w[c].w) * rstd * g1.w); }
        if (isk == 0) {
#pragma unroll
            for (int c = 0; c < 8; ++c) src[c] = o[c];
        } else {
            u32x4* dst = (u32x4*)((bf16_t*)(a.ws + WS_KIMG) + ((size_t)((b * 4 + h) * 64 + tile)) * 8192) + r;
#pragma unroll
            for (int c = 0; c < 8; ++c) dst[(p * 8 + c) * 64] = o[c];
        }
    }
    {
        u32x4* dst = (u32x4*)((bf16_t*)(a.ws + WS_VIMG) + ((size_t)((b * 4 + h) * 64 + tile)) * 8192) + r;
#pragma unroll
        for (int cg = 2 * p; cg < 2 * p + 2; ++cg)
#pragma unroll
            for (int kg = 0; kg < 4; ++kg) {
                const u32x4 v = *(const u32x4*)(PROJ + ((size_t)b * SEQ + tile * 64 + 16 * kg + (r >> 2)) * PS + C_VA + h * 128 + 32 * cg + 8 * (r & 3));
                dst[(cg * 4 + kg) * 64] = v; }
    }
}

DI bf16x8 tr_frag_nat(const LAS unsigned char* img, int rowbase, int col0, int lane) {
    const int hh = lane >> 5, g16 = (lane >> 4) & 1, i = lane & 15;
    const int col = col0 + 16 * g16 + 4 * (i & 3), chunk = col >> 3, sub = (col & 7) * 2;
    const int r0 = rowbase + 8 * hh + (i >> 2), r1 = r0 + 4;
    const s16x4 lo = trread(img + r0 * 256 + ((chunk ^ swz16(r0)) << 4) + sub);
    const s16x4 hi = trread(img + r1 * 256 + ((chunk ^ swz16(r1)) << 4) + sub);
    return __builtin_shufflevector(lo, hi, 0, 1, 2, 3, 4, 5, 6, 7);
}
DI bf16x8 tr_frag_acc(const LAS unsigned char* img, int rowbase, int col0, int lane) {
    const int hh = lane >> 5, g16 = (lane >> 4) & 1, i = lane & 15;
    const int col = col0 + 16 * g16 + 4 * (i & 3), chunk = col >> 3, sub = (col & 7) * 2;
    const int r0 = rowbase + 4 * hh + (i >> 2), r1 = r0 + 8;
    const s16x4 lo = trread(img + r0 * 256 + ((chunk ^ swz16(r0)) << 4) + sub);
    const s16x4 hi = trread(img + r1 * 256 + ((chunk ^ swz16(r1)) << 4) + sub);
    return __builtin_shufflevector(lo, hi, 0, 1, 2, 3, 4, 5, 6, 7);
}
DI bf16x8 row_frag(const LAS unsigned char* img, int row, int chunk) { return *(const LAS bf16x8*)(img + row * 256 + ((chunk ^ swz16(row)) << 4)); }

DI void glds16_asm(const void* gsrc, unsigned lds_dst) { unsigned keep;
    asm volatile("s_mov_b32 %0, m0\n\ts_mov_b32 m0, %2\n\ts_nop 0\n\tglobal_load_lds_dwordx4 %1, off\n\ts_mov_b32 m0, %0" : "=&s"(keep) : "v"(gsrc), "s"(lds_dst) : "memory"); }
constexpr size_t DO_QC = 0, DO_KC = 32 * MiB, DO_HD = 64 * MiB;
constexpr size_t WS_SC = 7 * MiB;

DI void conv_task(const Ctx& F, const Args& a, int tw) {
    const int isk = tw & 1, tok0 = (tw >> 1) * 8, b = tok0 / SEQ, t0 = tok0 % SEQ, lane = F.lane;
    const bf16_t* src = (const bf16_t*)(a.ws + WS_PROJ) + (size_t)b * SEQ * PS + (isk ? C_KM : C_QM) + lane * 8;
    float cw[5][8];
#pragma unroll
    for (int j = 0; j < 5; ++j) { const f32x4 c0 = *(const f32x4*)(a.conv_w + j * 1024 + isk * 512 + lane * 8), c1 = *(const f32x4*)(a.conv_w + j * 1024 + isk * 512 + lane * 8 + 4);
        cw[j][0] = c0.x; cw[j][1] = c0.y; cw[j][2] = c0.z; cw[j][3] = c0.w; cw[j][4] = c1.x; cw[j][5] = c1.y; cw[j][6] = c1.z; cw[j][7] = c1.w; }
    u32x4 row[12];
#pragma unroll
    for (int r = 0; r < 12; ++r) { const int t = t0 + r - 2; row[r] = (u32x4){0u, 0u, 0u, 0u}; if (t >= 0 && t < SEQ) row[r] = *(const u32x4*)(src + (size_t)t * PS); }
    const int hd = lane >> 4, cc = lane & 15, cch = t0 >> 6, r0 = t0 & 63;
    bf16_t* tileb = (bf16_t*)((unsigned char*)a.out + (isk ? DO_KC : DO_QC)) + ((size_t)((b * 4 + hd) * 64 + cch)) * 8192;
    bf16_t* dst = isk ? tileb + ((cc >> 2) * 4 + (r0 >> 4)) * 512 + (r0 & 15) * 32 + (cc & 3) * 8 : tileb + cc * 512 + r0 * 8;
    const int dstride = isk ? 32 : 8;
    const float sc = isk ? 0.08838834764831845f : 1.f;
#pragma unroll
    for (int i = 0; i < 8; ++i) {
        float acc[8];
#pragma unroll
        for (int e = 0; e < 8; ++e) acc[e] = 0.f;
#pragma unroll
        for (int j = 0; j < 5; ++j) { const u32x4 w = row[i + j];
            acc[0] += bflo(w.x) * cw[j][0]; acc[1] += bfhi(w.x) * cw[j][1]; acc[2] += bflo(w.y) * cw[j][2]; acc[3] += bfhi(w.y) * cw[j][3];
            acc[4] += bflo(w.z) * cw[j][4]; acc[5] += bfhi(w.z) * cw[j][5]; acc[6] += bflo(w.w) * cw[j][6]; acc[7] += bfhi(w.w) * cw[j][7]; }
#pragma unroll
        for (int e = 0; e < 8; ++e) acc[e] = silu_f(acc[e]) * sc;
        u32x4 o; o.x = pk2(acc[0], acc[1]); o.y = pk2(acc[2], acc[3]); o.z = pk2(acc[4], acc[5]); o.w = pk2(acc[6], acc[7]);
        *(u32x4*)(dst + i * dstride) = o;
    }
}

DI void mscal_task(const Ctx& F, const Args& a, int chain) {
    const int b = chain >> 3, h = (chain >> 1) & 3, dir = chain & 1;
    const int s = dir ? 63 - F.lane : F.lane;
    const float* GT = (const float*)(a.ws + WS_GATES) + (size_t)b * SEQ * 16;
    float* SC = (float*)(a.ws + WS_SC) + (size_t)chain * 64 * 256; float* MSC = (float*)(a.ws + WS_MSC);
    LAS float* gl = (LAS float*)F.lds; LAS float* mll = gl + 64; LAS float* mpv = gl + 128; LAS float* mnw = gl + 192;
    float aa[8], ii[8];
#pragma unroll
    for (int i = 0; i < 8; ++i) { const int c = F.wave + 8 * i;
        const float ig = GT[(size_t)(c * 64 + s) * 16 + dir * 8 + h], fg = GT[(size_t)(c * 64 + s) * 16 + dir * 8 + 4 + h];
        const float av = wave_prefix_sum(logsigmoid_f(fg));
        aa[i] = av; ii[i] = ig;
        const float g = __builtin_bit_cast(float, __builtin_amdgcn_readlane(__builtin_bit_cast(int, av), 63)), ml = wave_max(g - av + ig);
        if (F.lane == 0) { gl[c] = g; mll[c] = ml; } }
    __syncthreads();
    if (F.tid == 0) { float m = 0.f;
        for (int st = 0; st < 64; ++st) { const int c = dir ? 63 - st : st; mpv[c] = m; const float mn = fmaxf(gl[c] + m, mll[c]); mnw[c] = mn; m = mn; } }
    __syncthreads();
#pragma unroll
    for (int i = 0; i < 8; ++i) { const int c = F.wave + 8 * i; const float mprev = mpv[c], mnew = mnw[c], g = gl[c];
        const float cterm = ii[i] - aa[i];
        const float cm = wave_prefix_max(cterm);
        const float il = aa[i] + mprev, mj = fmaxf(il, aa[i] + cm);
        float* o4 = SC + (size_t)c * 256 + s;
        o4[0] = (aa[i] - mj) * 1.4426950408889634f; o4[64] = cterm * 1.4426950408889634f; o4[128] = __expf(il - mj); o4[192] = __expf(-mj);
        if (F.lane == 0) { MSC[chain * 64 + c] = (g - mnew) * 1.4426950408889634f; MSC[4096 + chain * 64 + c] = __expf(g + mprev - mnew); } }
    __syncthreads();
}

DI void mseq_item(const Ctx& F, const Args& a, int bh, int dir, int vs) {
    const int b = bh >> 2, h = bh & 3, chain = bh * 2 + dir, wid = F.wave, tid = F.tid, lane = F.lane, r32 = lane & 31, hh = lane >> 5;
    LAS unsigned char* QS = F.lds;
    LAS unsigned char* KS = F.lds + 32768;
    LAS unsigned char* VS = F.lds + 65536;
    LAS unsigned char* SCS = F.lds + 81920;
    LAS unsigned char* SD = F.lds + 86016;
    LAS unsigned char* CI = F.lds + 102400;
    LAS float* NV = (LAS float*)(F.lds + 118784);
    LAS float* gmv = NV + 256; LAS float* spv = gmv + 64;
    LAS unsigned char* HST = F.lds + 120832;
    const bf16_t* QC = (const bf16_t*)((const unsigned char*)a.out + DO_QC) + (size_t)bh * 64 * 8192 + lane * 8;
    const bf16_t* KC = (const bf16_t*)((const unsigned char*)a.out + DO_KC) + (size_t)bh * 64 * 8192 + lane * 8;
    const bf16_t* VP = (const bf16_t*)(a.ws + WS_PROJ) + (size_t)b * SEQ * PS + C_VM + h * 128 + vs * 32 + (size_t)(16 * (wid & 3) + (lane >> 2)) * PS + 8 * (lane & 3);
    const float* SC = (const float*)(a.ws + WS_SC) + (size_t)chain * 64 * 256 + lane * 4;
    bf16_t* HD = (bf16_t*)((unsigned char*)a.out + DO_HD) + ((size_t)dir * MTOK + (size_t)b * SEQ) * 512 + h * 128 + vs * 32;
    if (tid < 64) { gmv[tid] = ((const float*)(a.ws + WS_MSC))[chain * 64 + tid]; spv[tid] = ((const float*)(a.ws + WS_MSC))[4096 + chain * 64 + tid]; }
    if (tid < 256) NV[tid] = 0.f;
    for (int i = tid; i < 4096; i += NTHR) ((LAS unsigned*)CI)[i] = 0u;
    const unsigned ldsb = (unsigned)(uintptr_t)F.lds;
#define MSEQ_ISSUE_QK(c, s2) do { const size_t _tb = (size_t)(c); \
        if (wid < 4) { _Pragma("unroll") for (int _i = 0; _i < 4; ++_i) \
                glds16_asm(QC + _tb * 8192 + (4 * wid + _i) * 512, (unsigned)__builtin_amdgcn_readfirstlane((int)(ldsb + (s2) * 16384 + (4 * wid + _i) * 1024))); } \
        else if (wid >= 6) { _Pragma("unroll") for (int _i = 0; _i < 8; ++_i) \
                glds16_asm(KC + _tb * 8192 + (8 * (wid - 6) + _i) * 512, (unsigned)__builtin_amdgcn_readfirstlane((int)(ldsb + 32768 + (s2) * 16384 + (8 * (wid - 6) + _i) * 1024))); } } while (0)
#define MSEQ_ISSUE_VS(c, s4) do { const size_t _tb = (size_t)(c); \
        if (wid < 4) glds16_asm(VP + _tb * 64 * PS, (unsigned)__builtin_amdgcn_readfirstlane((int)(ldsb + 65536 + (s4) * 4096 + wid * 1024))); \
        else if (wid == 6) glds16_asm(SC + _tb * 256, (unsigned)__builtin_amdgcn_readfirstlane((int)(ldsb + 81920 + (s4) * 1024))); } while (0)
    MSEQ_ISSUE_QK(dir ? 63 : 0, 0); MSEQ_ISSUE_VS(dir ? 63 : 0, 0); MSEQ_ISSUE_VS(dir ? 62 : 1, 1);
    f32x16 Cacc[2];
#pragma unroll
    for (int i = 0; i < 16; ++i) { Cacc[0][i] = 0.f; Cacc[1][i] = 0.f; }
    const int qrd = hh * 1024 + r32 * 16;
    const int ktr = (8 * hh + ((lane & 15) >> 2)) * 64 + ((lane >> 4) & 1) * 32 + (lane & 3) * 8;
    f32x16 acc;
    float qn = 0.f;
#pragma unroll
    for (int i = 0; i < 16; ++i) acc[i] = 0.f;
    asm volatile("s_waitcnt vmcnt(0)" ::: "memory");
    __syncthreads();
    unsigned long long busy = 0, tb0 = 0; if (PROBE_MSEQ_W >= 0) tb0 = __builtin_amdgcn_s_memtime(); const unsigned long long titem0 = tb0;
#pragma unroll 1
    for (int st = 0; st <= 64; ++st) {
        const int c = dir ? 63 - st : st, s2 = st & 1; const int s3 = st & 3, s3p = (st + 3) & 3;
        if (st + 1 < 64) MSEQ_ISSUE_QK(dir ? 62 - st : st + 1, s2 ^ 1);
        if (st + 2 < 64) MSEQ_ISSUE_VS(dir ? 61 - st : st + 2, (st + 2) & 3);
        const LAS unsigned char* QT = QS + s2 * 16384; const LAS unsigned char* KT = KS + s2 * 16384; const LAS unsigned char* VT = VS + s3 * 4096;
        const LAS float* rt = (const LAS float*)(SCS + s3 * 1024); const LAS float* ct = rt + 64;
        if (wid < 4) {
            if (st < 64) {
                const int jt = wid >> 1, stt = wid & 1;
                const LAS unsigned char* qa = QT + qrd + jt * 512;
                const LAS unsigned char* kb = KT + (2 * stt + (r32 >> 4)) * 1024 + (r32 & 15) * 64 + hh * 16;
                const int j = 32 * jt + r32; const float rtj = rt[j];
                const LAS float* ctp = ct + 32 * stt + 4 * hh;
                f32x4 c4[4];
#pragma unroll
                for (int rg = 0; rg < 4; ++rg) c4[rg] = *(const LAS f32x4*)(ctp + 8 * rg);
                const float gm = gmv[c], sp = spv[c];
                const int ck = 4 * wid + (lane & 3), r0 = 4 * (lane >> 2);
                const LAS unsigned char* kr = KT + (ck >> 2) * 4096 + (r0 >> 4) * 1024 + (r0 & 15) * 64 + (ck & 3) * 16;
                u32x4 kw[4];
#pragma unroll
                for (int r = 0; r < 4; ++r) kw[r] = *(const LAS u32x4*)(kr + r * 64);
                const f32x4 ctn = *(const LAS f32x4*)(ct + r0);
                const LAS float* no = NV + s2 * 128 + 32 * wid + 8 * (lane & 3);
                const f32x4 o0 = *(const LAS f32x4*)no, o1 = *(const LAS f32x4*)(no + 4);
                f32x16 S;
#pragma unroll
                for (int i = 0; i < 16; ++i) S[i] = 0.f;
#pragma unroll
                for (int ks = 0; ks < 8; ++ks) S = MFMA32(*(const LAS bf16x8*)(kb + (ks >> 1) * 4096 + (ks & 1) * 32), *(const LAS bf16x8*)(qa + ks * 2048), S);
                float pa[8];
#pragma unroll
                for (int e = 0; e < 8; ++e) pa[e] = 0.f;
#pragma unroll
                for (int r = 0; r < 4; ++r) { const u32x4 w = kw[r]; const float ws_ = __builtin_amdgcn_exp2f(ctn[r] + gm);
                    pa[0] += ws_ * bflo(w.x); pa[1] += ws_ * bfhi(w.x); pa[2] += ws_ * bflo(w.y); pa[3] += ws_ * bfhi(w.y); pa[4] += ws_ * bflo(w.z); pa[5] += ws_ * bfhi(w.z); pa[6] += ws_ * bflo(w.w); pa[7] += ws_ * bfhi(w.w); }
#pragma unroll
                for (int e = 0; e < 8; ++e) { float t = pa[e]; t += dpp_mov<DPP_ROR(8)>(t); t += dpp_mov<DPP_ROR(4)>(t); t = xor16_sum(t); pa[e] = xor32_sum(t); }
                u32x2 sw2[4];
#pragma unroll
                for (int rg = 0; rg < 4; ++rg) { float v[4];
#pragma unroll
                    for (int e = 0; e < 4; ++e) { const int sc = 32 * stt + 8 * rg + 4 * hh + e; const bool ok = dir == 0 ? (sc <= j) : (sc >= j);
                        v[e] = S[4 * rg + e] * __builtin_amdgcn_exp2f(ok ? rtj + c4[rg][e] : -1.0e30f); }
                    sw2[rg].x = pk2(v[0], v[1]); sw2[rg].y = pk2(v[2], v[3]); }
                LAS unsigned char* sw = SD + s2 * 8192 + stt * 4096 + j * 16 + hh * 8;
#pragma unroll
                for (int rg = 0; rg < 4; ++rg) *(LAS u32x2*)(sw + rg * 1024) = sw2[rg];
                if (lane < 4) { LAS float* nn = NV + (s2 ^ 1) * 128 + 32 * wid + 8 * lane;
                    *(LAS f32x4*)nn = (f32x4){sp * o0.x + pa[0], sp * o0.y + pa[1], sp * o0.z + pa[2], sp * o0.w + pa[3]};
                    *(LAS f32x4*)(nn + 4) = (f32x4){sp * o1.x + pa[4], sp * o1.y + pa[5], sp * o1.z + pa[6], sp * o1.w + pa[7]}; }
            }
        } else if (wid < 6) {
            const int jt = wid - 4, jl = 32 * jt + r32;
            u32x2 hw[4]; bool have_h = false; int cp = 0;
            if (st > 0) {
                cp = dir ? 64 - st : st - 1; have_h = true;
                const LAS float* iw = (const LAS float*)(SCS + s3p * 1024) + 128; const LAS float* enm = iw + 64;
                const LAS unsigned char* SDp = SD + (s2 ^ 1) * 8192;
                const LAS unsigned char* sr = SDp + hh * 4096 + jl * 16;
                u32x4 w4[4];
#pragma unroll
                for (int ch = 0; ch < 4; ++ch) w4[ch] = *(const LAS u32x4*)(sr + ch * 1024);
                const float iwj = iw[jl], enj = enm[jl];
                const LAS unsigned char* sa = SDp + qrd + jt * 512; const LAS unsigned char* vb = VS + s3p * 4096 + ktr;
                float rsum = 0.f;
#pragma unroll
                for (int ch = 0; ch < 4; ++ch) { const u32x4 w = w4[ch];
                    rsum += (bflo(w.x) + bfhi(w.x)) + (bflo(w.y) + bfhi(w.y)) + (bflo(w.z) + bfhi(w.z)) + (bflo(w.w) + bfhi(w.w)); }
                rsum = xor32_sum(rsum);
                const float den = rsum + iwj * qn;
                const float rdj = 1.f / fmaxf(fabsf(den), enj);
#pragma unroll
                for (int i = 0; i < 16; ++i) acc[i] *= iwj;
#pragma unroll
                for (int ks = 0; ks < 4; ++ks) { const s16x4 lo = trread(vb + ks * 1024), hi = trread(vb + ks * 1024 + 256);
                    acc = MFMA32(__builtin_shufflevector(lo, hi, 0, 1, 2, 3, 4, 5, 6, 7), *(const LAS bf16x8*)(sa + ks * 2048), acc); }
#pragma unroll
                for (int rg = 0; rg < 4; ++rg) { hw[rg].x = pk2(acc[4 * rg] * rdj, acc[4 * rg + 1] * rdj); hw[rg].y = pk2(acc[4 * rg + 2] * rdj, acc[4 * rg + 3] * rdj); }
            }
            if (st < 64) {
                const LAS unsigned char* qa = QT + qrd + jt * 512;
                const LAS unsigned char* cb = CI + s2 * 8192 + hh * 512 + r32 * 16;
                const LAS unsigned char* qr = QT + hh * 8192 + jl * 16; const LAS float* np = NV + s2 * 128 + 64 * hh;
#pragma unroll
                for (int i = 0; i < 16; ++i) acc[i] = 0.f;
#pragma unroll
                for (int ks = 0; ks < 8; ++ks) acc = MFMA32(*(const LAS bf16x8*)(cb + ks * 1024), *(const LAS bf16x8*)(qa + ks * 2048), acc);
                qn = 0.f;
#pragma unroll
                for (int ch = 0; ch < 8; ++ch) { const u32x4 w = *(const LAS u32x4*)(qr + ch * 1024); const f32x4 n0 = *(const LAS f32x4*)(np + ch * 8), n1 = *(const LAS f32x4*)(np + ch * 8 + 4);
                    qn += bflo(w.x) * n0.x + bfhi(w.x) * n0.y + bflo(w.y) * n0.z + bfhi(w.y) * n0.w + bflo(w.z) * n1.x + bfhi(w.z) * n1.y + bflo(w.w) * n1.z + bfhi(w.w) * n1.w; }
                qn = xor32_sum(qn);
            }
            if (have_h) {
                LAS unsigned char* hst = HST + jt * 2048;
#pragma unroll
                for (int rg = 0; rg < 4; ++rg) *(LAS u32x2*)(hst + r32 * 64 + (8 * rg + 4 * hh) * 2) = hw[rg];
                asm volatile("s_waitcnt lgkmcnt(0)" ::: "memory");
#pragma unroll
                for (int q = 0; q < 2; ++q) { const int row = 16 * q + (lane >> 2), part = lane & 3;
                    const u32x4 w = *(const LAS u32x4*)(hst + row * 64 + part * 16);
                    *(u32x4*)(HD + (size_t)(cp * 64 + 32 * jt + row) * 512 + part * 8) = w; }
            }
        } else if (st < 64) {
            const int u = wid - 6; const float gm = gmv[c], sp = spv[c];
            const LAS unsigned char* va = VT + ktr; const LAS unsigned char* ka = KT + ktr + (2 * u) * 4096;
            s16x4 vlo[4], vhi[4], k0l[4], k0h[4], k1l[4], k1h[4]; f32x4 cw0[4], cw1[4];
#pragma unroll
            for (int ks = 0; ks < 4; ++ks) { vlo[ks] = trread(va + ks * 1024); vhi[ks] = trread(va + ks * 1024 + 256);
                cw0[ks] = *(const LAS f32x4*)(ct + 16 * ks + 8 * hh); cw1[ks] = *(const LAS f32x4*)(ct + 16 * ks + 8 * hh + 4);
                k0l[ks] = trread(ka + ks * 1024); k0h[ks] = trread(ka + ks * 1024 + 256); k1l[ks] = trread(ka + 4096 + ks * 1024); k1h[ks] = trread(ka + 4096 + ks * 1024 + 256); }
#pragma unroll
            for (int i = 0; i < 16; ++i) { Cacc[0][i] *= sp; Cacc[1][i] *= sp; }
#pragma unroll
            for (int ks = 0; ks < 4; ++ks) {
                const s16x4 lo = vlo[ks], hi = vhi[ks]; const f32x4 e0 = cw0[ks], e1 = cw1[ks];
                u32x4 af;
                af.x = pk2(bf2f((bf16_t)lo[0]) * __builtin_amdgcn_exp2f(e0.x + gm), bf2f((bf16_t)lo[1]) * __builtin_amdgcn_exp2f(e0.y + gm));
                af.y = pk2(bf2f((bf16_t)lo[2]) * __builtin_amdgcn_exp2f(e0.z + gm), bf2f((bf16_t)lo[3]) * __builtin_amdgcn_exp2f(e0.w + gm));
                af.z = pk2(bf2f((bf16_t)hi[0]) * __builtin_amdgcn_exp2f(e1.x + gm), bf2f((bf16_t)hi[1]) * __builtin_amdgcn_exp2f(e1.y + gm));
                af.w = pk2(bf2f((bf16_t)hi[2]) * __builtin_amdgcn_exp2f(e1.z + gm), bf2f((bf16_t)hi[3]) * __builtin_amdgcn_exp2f(e1.w + gm));
                const bf16x8 afr = __builtin_bit_cast(bf16x8, af);
                Cacc[0] = MFMA32(__builtin_shufflevector(k0l[ks], k0h[ks], 0, 1, 2, 3, 4, 5, 6, 7), afr, Cacc[0]);
                Cacc[1] = MFMA32(__builtin_shufflevector(k1l[ks], k1h[ks], 0, 1, 2, 3, 4, 5, 6, 7), afr, Cacc[1]);
            }
            LAS unsigned char* cw = CI + (s2 ^ 1) * 8192 + (2 * u) * 2048 + r32 * 16 + hh * 8;
#pragma unroll
            for (int t2 = 0; t2 < 2; ++t2)
#pragma unroll
                for (int rg = 0; rg < 4; ++rg) { u32x2 w; w.x = pk2(Cacc[t2][4 * rg], Cacc[t2][4 * rg + 1]); w.y = pk2(Cacc[t2][4 * rg + 2], Cacc[t2][4 * rg + 3]); *(LAS u32x2*)(cw + t2 * 2048 + rg * 512) = w; }
        }
        if (PROBE_MSEQ_W >= 0) { asm volatile("s_waitcnt lgkmcnt(0)" ::: "memory"); busy += __builtin_amdgcn_s_memtime() - tb0; }
        if (st + 2 < 64) { if (wid < 4 || wid == 6) asm volatile("s_waitcnt vmcnt(1)" ::: "memory"); else if (wid == 7) asm volatile("s_waitcnt vmcnt(0)" ::: "memory"); }
        else if (wid < 4 || wid >= 6) asm volatile("s_waitcnt vmcnt(0)" ::: "memory");
        asm volatile("s_waitcnt lgkmcnt(0)" ::: "memory"); __builtin_amdgcn_s_barrier(); asm volatile("" ::: "memory");
        if (PROBE_MSEQ_W >= 0) tb0 = __builtin_amdgcn_s_memtime();
    }
    if (PROBE_MSEQ_W >= 0 && F.bid == 0 && lane == 0 && (wid == PROBE_MSEQ_W || (PROBE_MSEQ_W == 8 && wid == 0)))
        *(volatile LAS unsigned long long*)(F.lds + LDS_BYTES - 128) = (PROBE_MSEQ_W == 8) ? (__builtin_amdgcn_s_memtime() - titem0) : busy;
    asm volatile("s_waitcnt vmcnt(0)" ::: "memory");
#undef MSEQ_ISSUE_QK
#undef MSEQ_ISSUE_VS
}

DI void glds16(const void* g, LAS unsigned char* l) { __builtin_amdgcn_global_load_lds((const unsigned*)g, (LAS unsigned*)l, 16, 0, 0); }
DI void attn_unit(const Ctx& F, const Args& a, int b, int h, int qb, float lam, float cshift) {
    const int lane = F.lane, wid = F.wave, r32 = lane & 31, hh = lane >> 5, rg = wid & 3, p = wid >> 2;
    const bf16_t* projb = (const bf16_t*)(a.ws + WS_PROJ) + (size_t)b * SEQ * PS;
    const int qrow = qb * 128 + rg * 32 + r32;
    bf16x8 qf[4];
    { const bf16_t* qp = projb + (size_t)qrow * PS + C_QA + h * 128 + p * 64 + hh * 8;
#pragma unroll
      for (int ks = 0; ks < 4; ++ks) qf[ks] = *(const bf16x8*)(qp + ks * 16); }
    const bf16_t* kimg = (const bf16_t*)(a.ws + WS_KIMG) + (size_t)(b * 4 + h) * 64 * 8192 + (4 * wid) * 512 + lane * 8;
    const bf16_t* vimg = (const bf16_t*)(a.ws + WS_VIMG) + (size_t)(b * 4 + h) * 64 * 8192 + (4 * wid) * 512 + lane * 8;
    const unsigned ldsw = (unsigned)__builtin_amdgcn_readfirstlane((int)(unsigned)(uintptr_t)F.lds + (4 * wid) * 1024);
#define ATT_ISSUE2(img, t0, ldsoff) do { const int _q0 = 4 * wid; const int _t = (t0) + (_q0 >> 4); const bf16_t* _tp = (img) + (size_t)(_t < 64 ? _t : 63) * 8192 - (size_t)(_q0 & 16) * 512; \
        const unsigned _d = (unsigned)__builtin_amdgcn_readfirstlane((int)(ldsw + (ldsoff))); \
        _Pragma("unroll") for (int _i = 0; _i < 4; ++_i) glds16_asm(_tp + _i * 512, _d + _i * 1024); } while (0)
    if (wid < 4) { const bf16_t* _tp = kimg; const unsigned _d = (unsigned)__builtin_amdgcn_readfirstlane((int)(ldsw + 32768));
#pragma unroll
        for (int _i = 0; _i < 4; ++_i) glds16_asm(_tp + _i * 512, _d + _i * 1024); }
    ATT_ISSUE2(kimg, 1, 0); ATT_ISSUE2(vimg, 0, 65536);
    f32x16 O[4];
#pragma unroll
    for (int vt = 0; vt < 4; ++vt)
#pragma unroll
        for (int i = 0; i < 16; ++i) O[vt][i] = 0.f;
    float lsum = 0.f;
    const int kfb = p * 8192 + hh * 1024 + r32 * 16;
    const int vfb = (4 * hh + ((lane & 15) >> 2)) * 64 + ((lane >> 4) & 1) * 32 + (lane & 3) * 8;
    bf16x8 pb[4];
    asm volatile("s_waitcnt vmcnt(0)" ::: "memory");
    __syncthreads();
#define ATT_VLOAD(dst, Vb, kg) do { _Pragma("unroll") for (int vt = 0; vt < 4; ++vt) { \
        const s16x4 _lo = trread((Vb) + vt * 4096 + (kg) * 1024), _hi = trread((Vb) + vt * 4096 + (kg) * 1024 + 512); dst[vt] = __builtin_shufflevector(_lo, _hi, 0, 1, 2, 3, 4, 5, 6, 7); } } while (0)
#define ATT_PV(vf, kg) do { __builtin_amdgcn_s_setprio(1); _Pragma("unroll") for (int vt = 0; vt < 4; ++vt) O[vt] = MFMA32(vf[vt], pb[kg], O[vt]); __builtin_amdgcn_s_setprio(0); } while (0)
#define ATT_EXPQ(S, o, dst) do { float _e[8]; _Pragma("unroll") for (int i = 0; i < 8; ++i) _e[i] = __builtin_amdgcn_exp2f(S[(o) + i]); \
        _Pragma("unroll") for (int i = 0; i < 8; ++i) ls = ls + _e[i]; \
        u32x4 _w; _w.x = pk2(_e[0], _e[1]); _w.y = pk2(_e[2], _e[3]); _w.z = pk2(_e[4], _e[5]); _w.w = pk2(_e[6], _e[7]); dst = __builtin_bit_cast(bf16x8, _w); } while (0)
#define ATT_STEP(Kb, Vb, on0) do { \
        bf16x8 kfa[4], kfb2[4], vA[4], vB[4], pn[4]; float ls = 0.f; \
        _Pragma("unroll") for (int ks = 0; ks < 4; ++ks) { kfa[ks] = *(const LAS bf16x8*)((Kb) + ks * 2048); kfb2[ks] = *(const LAS bf16x8*)((Kb) + ks * 2048 + 512); } \
        ATT_VLOAD(vA, Vb, 0); \
        __builtin_amdgcn_s_setprio(1); \
        Sa = MFMA32(kfa[0], qf[0], negc); Sb = MFMA32(kfb2[0], qf[0], negc);        \
        _Pragma("unroll") for (int ks = 1; ks < 4; ++ks) { Sa = MFMA32(kfa[ks], qf[ks], Sa); Sb = MFMA32(kfb2[ks], qf[ks], Sb); } \
        __builtin_amdgcn_s_setprio(0); \
        ATT_VLOAD(vB, Vb, 1); ATT_PV(vA, 0); ATT_EXPQ(Sa, 0, pn[0]); \
        ATT_VLOAD(vA, Vb, 2); ATT_PV(vB, 1); ATT_EXPQ(Sa, 8, pn[1]); \
        ATT_VLOAD(vB, Vb, 3); ATT_PV(vA, 2); ATT_EXPQ(Sb, 0, pn[2]); \
        ATT_PV(vB, 3); ATT_EXPQ(Sb, 8, pn[3]); \
        lsum += (on0) ? ls : 0.f; \
        pb[0] = pn[0]; pb[1] = pn[1]; pb[2] = pn[2]; pb[3] = pn[3]; } while (0)
    f32x16 Sa, Sb, negc;
#pragma unroll
    for (int i = 0; i < 16; ++i) negc[i] = -cshift;
    asm volatile("" : "+v"(negc));
    {
        const LAS unsigned char* Kb = F.lds + 32768 + kfb;
        Sa = MFMA32(*(const LAS bf16x8*)(Kb), qf[0], negc); Sb = MFMA32(*(const LAS bf16x8*)(Kb + 512), qf[0], negc);
#pragma unroll
        for (int ks = 1; ks < 4; ++ks) { Sa = MFMA32(*(const LAS bf16x8*)(Kb + ks * 2048), qf[ks], Sa); Sb = MFMA32(*(const LAS bf16x8*)(Kb + ks * 2048 + 512), qf[ks], Sb); }
        float ls = 0.f;
        ATT_EXPQ(Sa, 0, pb[0]); ATT_EXPQ(Sa, 8, pb[1]); ATT_EXPQ(Sb, 0, pb[2]); ATT_EXPQ(Sb, 8, pb[3]);
        lsum += ls;
    }
    __syncthreads();
#pragma unroll 1
    for (int T = 0; T < 32; ++T) {
        const int j = T & 1;
        ATT_ISSUE2(kimg, 2 * T + 3, (j ^ 1) * 32768);
        ATT_ISSUE2(vimg, 2 * T + 2, 65536 + (j ^ 1) * 32768);
        const LAS unsigned char* Ks = F.lds + j * 32768 + kfb; const LAS unsigned char* Vs = F.lds + 65536 + j * 32768 + vfb;
        ATT_STEP(Ks, Vs, true);
        ATT_STEP(Ks + 16384, Vs + 16384, T < 31);
        asm volatile("s_waitcnt vmcnt(0)" ::: "memory");
        __syncthreads();
    }
#undef ATT_EXPQ
#undef ATT_STEP
#undef ATT_VLOAD
#undef ATT_PV
#undef ATT_ISSUE2
    lsum += __shfl_xor(lsum, 32);
    LAS float* X = (LAS float*)(F.lds + 65536) + rg * 4096 + r32;
    if (p == 1) {
        const float sc = lam / lsum;
#pragma unroll
        for (int vt = 0; vt < 4; ++vt)
#pragma unroll
            for (int i = 0; i < 16; ++i) X[(32 * vt + crow(i, hh)) * 32] = O[vt][i] * sc;
    }
    __syncthreads();
    if (p == 0) {
        const float i0 = 1.f / lsum;
        float ssq = 0.f;
#pragma unroll
        for (int vt = 0; vt < 4; ++vt)
#pragma unroll
            for (int i = 0; i < 16; ++i) { const float o = O[vt][i] * i0 - X[(32 * vt + crow(i, hh)) * 32]; O[vt][i] = o; ssq += o * o; }
        ssq += __shfl_xor(ssq, 32);
        const float rs = rsqrtf(ssq * (1.f / 128.f) + EPS) * 0.8f;
        bf16_t* yp = (bf16_t*)(a.ws + WS_YA) + (size_t)(b * SEQ + qrow) * 512 + h * 128;
#pragma unroll
        for (int vt = 0; vt < 4; ++vt)
#pragma unroll
            for (int rgi = 0; rgi < 4; ++rgi) { const int vd = 32 * vt + 8 * rgi + 4 * hh; const f32x4 g = *(const f32x4*)(a.subln_g + vd);
                u32x2 w; w.x = pk2(O[vt][4 * rgi] * rs * g.x, O[vt][4 * rgi + 1] * rs * g.y); w.y = pk2(O[vt][4 * rgi + 2] * rs * g.z, O[vt][4 * rgi + 3] * rs * g.w);
                *(u32x2*)(yp + vd) = w; }
    }
    __syncthreads();
}

DI void mcombine_phase(const Ctx& F, const Args& a) {
    const int gw = F.bid * NWAVES + F.wave, NGW = F.G * NWAVES, lane = F.lane;
    const bf16_t* HD = (const bf16_t*)((const unsigned char*)a.out + DO_HD);
    float g[8];
#pragma unroll
    for (int i = 0; i < 8; ++i) g[i] = a.mnorm_g[lane * 8 + i];
    for (int m = gw; m < MTOK; m += NGW) {
        const u32x4 f = *(const u32x4*)(HD + (size_t)m * 512 + lane * 8), bw = *(const u32x4*)(HD + ((size_t)MTOK + m) * 512 + lane * 8);
        const u32x4 om = *(const u32x4*)((const bf16_t*)(a.ws + WS_PROJ) + (size_t)m * PS + C_OM + lane * 8);
        const u32x4 ya = *(const u32x4*)((const bf16_t*)(a.ws + WS_YA) + (size_t)m * 512 + lane * 8);
        float v[8];
        v[0] = bflo(f.x) + bflo(bw.x); v[1] = bfhi(f.x) + bfhi(bw.x); v[2] = bflo(f.y) + bflo(bw.y); v[3] = bfhi(f.y) + bfhi(bw.y);
        v[4] = bflo(f.z) + bflo(bw.z); v[5] = bfhi(f.z) + bfhi(bw.z); v[6] = bflo(f.w) + bflo(bw.w); v[7] = bfhi(f.w) + bfhi(bw.w);
        float ss = 0.f;
#pragma unroll
        for (int i = 0; i < 8; ++i) ss += v[i] * v[i];
        ss += __shfl_xor(ss, 1); ss += __shfl_xor(ss, 2); ss += __shfl_xor(ss, 4); ss += __shfl_xor(ss, 8);
        const float rstd = rsqrtf(ss * (1.f / 128.f) + EPS);
        float o[8];
        o[0] = bflo(om.x); o[1] = bfhi(om.x); o[2] = bflo(om.y); o[3] = bfhi(om.y); o[4] = bflo(om.z); o[5] = bfhi(om.z); o[6] = bflo(om.w); o[7] = bfhi(om.w);
#pragma unroll
        for (int i = 0; i < 8; ++i) v[i] = v[i] * rstd * g[i] * sigmoid_f(o[i]);
        u32x4 w; w.x = pk2(v[0], v[1]); w.y = pk2(v[2], v[3]); w.z = pk2(v[4], v[5]); w.w = pk2(v[6], v[7]);
        bf16_t* yp = (bf16_t*)(a.ws + WS_YMIX) + (size_t)m * DM + lane * 8;
        *(u32x4*)yp = w; *(u32x4*)(yp + 512) = ya;
    }
}

DI void p7_phase(const Ctx& F, const Args& a) {
    LAS f32x4* WRL = (LAS f32x4*)F.lds;
    for (int q = F.tid; q < 4096; q += NTHR) { const int k = q >> 2, g = q & 3; WRL[(g * 2 + (k & 1)) * 512 + (k >> 1)] = *(const f32x4*)(a.w_router + k * 16 + g * 4); }
    __syncthreads();
    const int gw = F.bid * NWAVES + F.wave, NGW = F.G * NWAVES, lane = F.lane;
    const float* mod = (const float*)(a.ws + WS_MOD);
    unsigned char* H2 = a.ws + WS_H2; float* AFF = (float*)(a.ws + WS_AFF);
    for (int m = gw; m < MTOK; m += NGW) {
        const int b = m / SEQ;
        const f32x2* xr = (const f32x2*)(a.out + (size_t)m * DM) + lane;
        f32x2 v[8]; float s = 0.f;
#pragma unroll
        for (int j = 0; j < 8; ++j) { v[j] = xr[64 * j]; s += v[j].x * v[j].x + v[j].y * v[j].y; }
        const float rstd = rsqrtf(wave_sum(s) * (1.f / DM) + EPS);
        float lg[16];
#pragma unroll
        for (int e = 0; e < 16; ++e) lg[e] = 0.f;
        unsigned short* o2 = (unsigned short*)(H2 + (size_t)m * DM) + lane;
#pragma unroll
        for (int j = 0; j < 8; ++j) {
            const f32x2 g = ((const f32x2*)a.norm2_g)[lane + 64 * j];
            const f32x2 sh = ((const f32x2*)(mod + (size_t)b * 6144 + 3072))[lane + 64 * j];
            const f32x2 sc = ((const f32x2*)(mod + (size_t)b * 6144 + 4096))[lane + 64 * j];
            const f32x2 hv = v[j] * rstd * g * (sc + 1.f) + sh;
            o2[64 * j] = (unsigned short)__builtin_amdgcn_cvt_pk_fp8_f32(hv.x, hv.y, 0, false);
#pragma unroll
            for (int g4 = 0; g4 < 4; ++g4) { const f32x4 w0 = WRL[(g4 * 2 + 0) * 512 + lane + 64 * j], w1 = WRL[(g4 * 2 + 1) * 512 + lane + 64 * j];
                lg[g4 * 4 + 0] += hv.x * w0.x + hv.y * w1.x; lg[g4 * 4 + 1] += hv.x * w0.y + hv.y * w1.y; lg[g4 * 4 + 2] += hv.x * w0.z + hv.y * w1.z; lg[g4 * 4 + 3] += hv.x * w0.w + hv.y * w1.w; }
            __builtin_amdgcn_sched_barrier(0);
        }
        float r8[8];
#pragma unroll
        for (int i = 0; i < 8; ++i) { const float keep = hh_sel(lane, 32) ? lg[8 + i] : lg[i], send = hh_sel(lane, 32) ? lg[i] : lg[8 + i]; r8[i] = keep + partner32(send, lane); }
        float r4[4];
#pragma unroll
        for (int i = 0; i < 4; ++i) { const float keep = hh_sel(lane, 16) ? r8[4 + i] : r8[i], send = hh_sel(lane, 16) ? r8[i] : r8[4 + i]; r4[i] = keep + partner16(send, lane); }
        float r2[2];
#pragma unroll
        for (int i = 0; i < 2; ++i) { const float keep = hh_sel(lane, 8) ? r4[2 + i] : r4[i], send = hh_sel(lane, 8) ? r4[i] : r4[2 + i]; r2[i] = keep + partner8(send); }
        float lgt; { const float keep = hh_sel(lane, 4) ? r2[1] : r2[0], send = hh_sel(lane, 4) ? r2[0] : r2[1]; lgt = keep + partner4(send, lane); }
        lgt += dpp_mov<DPP_XOR2>(lgt); lgt += dpp_mov<DPP_XOR1>(lgt);
        float mx = lgt; mx = fmaxf(mx, dpp_mov<DPP_ROR(8)>(mx)); mx = fmaxf(mx, dpp_mov<DPP_ROR(4)>(mx)); mx = xor16_max(mx); mx = xor32_max(mx);
        const float ex = __expf(lgt - mx); float sm = ex; sm += dpp_mov<DPP_ROR(8)>(sm); sm += dpp_mov<DPP_ROR(4)>(sm); sm = xor16_sum(sm); sm = xor32_sum(sm);
        if ((lane & 3) == 0) AFF[(size_t)m * 16 + (lane >> 2)] = ex / sm;
    }
    __syncthreads();
}

DI void topk_task(const Ctx& F, const Args& a, int task) {
    const int b = task >> 4, e = task & 15, tid = F.tid, lane = F.lane;
    const float* AFF = (const float*)(a.ws + WS_AFF) + (size_t)b * SEQ * 16 + e;
    LAS unsigned* hist = (LAS unsigned*)F.lds;
    LAS unsigned* sfx = hist + 256;
    LAS unsigned* misc = hist + 512;
    LAS int* lidx = (LAS int*)(F.lds + 4096);
    unsigned key[8];
#pragma unroll
    for (int i = 0; i < 8; ++i) key[i] = __float_as_uint(AFF[(size_t)(tid * 8 + i) * 16]);
    unsigned prefix = 0, krem = CAP;
#pragma unroll 1
    for (int pass = 0; pass < 4; ++pass) {
        const int shift = 24 - 8 * pass;
        if (tid < 256) hist[tid] = 0;
        __syncthreads();
#pragma unroll
        for (int i = 0; i < 8; ++i) { const bool in = pass == 0 ? true : ((key[i] >> (shift + 8)) == (prefix >> (shift + 8))); if (in) atomicAdd((unsigned*)&hist[(key[i] >> shift) & 255u], 1u); }
        __syncthreads();
        if (tid < 256) sfx[tid] = hist[tid];
        __syncthreads();
#pragma unroll 1
        for (int o = 1; o < 256; o <<= 1) { unsigned v = 0; if (tid < 256) v = sfx[tid] + (tid + o < 256 ? sfx[tid + o] : 0u); __syncthreads(); if (tid < 256) sfx[tid] = v; __syncthreads(); }
        if (tid < 256) { const unsigned incl = sfx[tid], excl = incl - hist[tid]; if (excl < krem && krem <= incl) { misc[0] = (unsigned)tid; misc[1] = krem - excl; } }
        __syncthreads();
        prefix |= misc[0] << shift; krem = misc[1];
        __syncthreads();
    }
    const unsigned T = prefix, need = krem;
    unsigned cg_ = 0, ce = 0;
#pragma unroll
    for (int i = 0; i < 8; ++i) { cg_ += key[i] > T; ce += key[i] == T; }
    unsigned sg = cg_, se = ce;
#pragma unroll
    for (int o = 1; o < 64; o <<= 1) { const unsigned tg = __shfl_up(sg, o), te = __shfl_up(se, o); if (lane >= o) { sg += tg; se += te; } }
    if (lane == 63) { misc[16 + F.wave] = sg; misc[32 + F.wave] = se; }
    __syncthreads();
    unsigned og = sg - cg_, oe = se - ce;
    for (int w = 0; w < F.wave; ++w) { og += misc[16 + w]; oe += misc[32 + w]; }
    int* SLOT = (int*)(a.ws + WS_SLOT) + (size_t)b * SEQ * 16 + e;
    float* VALS = (float*)(a.ws + WS_VALS) + (size_t)(e * 8 + b) * CAP;
    int* IDX = (int*)(a.ws + WS_IDX) + (size_t)(b * 16 + e) * CAP;
#pragma unroll
    for (int i = 0; i < 8; ++i) {
        const bool gt = key[i] > T, eq = key[i] == T; const bool sel = gt || (eq && oe < need);
        const unsigned pos = og + (oe < need ? oe : need);
        const int s = tid * 8 + i;
        SLOT[(size_t)s * 16] = sel ? (int)pos : -1;
        if (sel) { lidx[pos] = s; IDX[pos] = s; VALS[pos] = __uint_as_float(key[i]); }
        og += gt; oe += eq;
    }
    __syncthreads();
    const unsigned char* H2 = a.ws + WS_H2 + (size_t)b * SEQ * DM; unsigned char* XE = a.ws + WS_XE + (size_t)(e * 8 + b) * CAP * DM;
    for (int r0 = F.wave * 4; r0 < CAP; r0 += NWAVES * 4) { u32x4 v[4];
#pragma unroll
        for (int j = 0; j < 4; ++j) v[j] = ((const u32x4*)(H2 + (size_t)lidx[r0 + j] * DM))[lane];
#pragma unroll
        for (int j = 0; j < 4; ++j) ((u32x4*)(XE + (size_t)(r0 + j) * DM))[lane] = v[j]; }
    __syncthreads();
}

DI void final_phase(const Ctx& F, const Args& a) {
    const int gw = F.bid * NWAVES + F.wave, NGW = F.G * NWAVES, lane = F.lane;
    const float* mod = (const float*)(a.ws + WS_MOD); const int* SLOT = (const int*)(a.ws + WS_SLOT); const unsigned char* Y = a.ws + WS_Y;
    for (int m = gw; m < MTOK; m += NGW) {
        const int b = m / SEQ;
        const int sl = SLOT[(size_t)m * 16 + (lane & 15)];
        f32x4* op = (f32x4*)(a.out + (size_t)m * DM + lane * 16);
        f32x4 xv[4];
#pragma unroll
        for (int q = 0; q < 4; ++q) xv[q] = op[q];
        float acc[16];
#pragma unroll
        for (int i = 0; i < 16; ++i) acc[i] = 0.f;
#pragma unroll 1
        for (int e = 0; e < 16; ++e) { const int s = __shfl(sl, e);
            if (s >= 0) { const u32x4 w = *(const u32x4*)(Y + ((size_t)(e * 8 + b) * CAP + s) * DM + lane * 16);
#pragma unroll
                for (int q = 0; q < 4; ++q) { const unsigned ww = w[q];
                    const auto lo = __builtin_amdgcn_cvt_pk_f32_fp8((int)ww, false), hi = __builtin_amdgcn_cvt_pk_f32_fp8((int)ww, true);
                    acc[4 * q] += lo[0]; acc[4 * q + 1] += lo[1]; acc[4 * q + 2] += hi[0]; acc[4 * q + 3] += hi[1]; } } }
        const f32x4* gp = (const f32x4*)(mod + (size_t)b * 6144 + 5120 + lane * 16);
#pragma unroll
        for (int q = 0; q < 4; ++q) { const f32x4 g = gp[q] * (1.f / pg8::Y_PRESCALE); f32x4 o = xv[q]; o.x += g.x * acc[4 * q]; o.y += g.y * acc[4 * q + 1]; o.z += g.z * acc[4 * q + 2]; o.w += g.w * acc[4 * q + 3]; op[q] = o; }
    }
}

constexpr size_t WS_CTL = 0;
constexpr int CTL_ZERO_BYTES = 65536;
#define XB_TMO      128
#define XB_XCNT(j)  (256  + 64 * (j))
#define XB_XSUB(j)  (1280 + 64 * (j))
#define XB_XGEN(j)  (2304 + 64 * (j))
#define XB_TOP      3328
#define XB_TOPGEN   3392
#define XB_SPIN_CAP (1u << 18)
DI unsigned xb_ld(unsigned* p)              { return __hip_atomic_load(p, __ATOMIC_RELAXED, __HIP_MEMORY_SCOPE_AGENT); }
DI unsigned xb_add(unsigned* p, unsigned v) { return __hip_atomic_fetch_add(p, v, __ATOMIC_RELAXED, __HIP_MEMORY_SCOPE_AGENT); }
DI unsigned xb_xcc_id() { return (unsigned)__builtin_amdgcn_s_getreg((3 << 11) | 20) & 0xFu; }
#define XB_SPIN(cond, bar) do { unsigned _sp = 0; while (cond) { __builtin_amdgcn_s_sleep(1); \
    if ((++_sp & 255u) == 0u) { if (xb_ld(&(bar)[XB_TMO])) break; if (_sp > XB_SPIN_CAP) { atomicAdd(&(bar)[XB_TMO], 1u); break; } } } } while (0)
struct XcdBarrier { unsigned* bar; unsigned x; volatile LAS unsigned* st; };
DI XcdBarrier xcd_barrier_post(unsigned* bar, volatile LAS unsigned* st) {
    XcdBarrier b; b.bar = bar; b.x = xb_xcc_id(); b.st = st;
    if (threadIdx.x == 0) (void)xb_add(&bar[XB_XCNT(b.x)], 1u);
    return b;
}
DI void xcd_barrier_complete(unsigned* bar, unsigned x, unsigned& nloc, unsigned& nx) {
    const unsigned G = gridDim.x * gridDim.y * gridDim.z;
    unsigned sum, cnt, mine, sp = 0u;
    for (;;) {
        sum = 0u; cnt = 0u; mine = 0u;
#pragma unroll
        for (unsigned j = 0; j < 16; ++j) { const unsigned c = xb_ld(&bar[XB_XCNT(j)]); sum += c; cnt += (c > 0u) ? 1u : 0u; mine = (j == x) ? c : mine; }
        if (sum == G) break;
        __builtin_amdgcn_s_sleep(1);
        if ((++sp & 255u) == 0u) { if (xb_ld(&bar[XB_TMO])) break; if (sp > XB_SPIN_CAP) { atomicAdd(&bar[XB_TMO], 1u); break; } }
    }
    nloc = mine > 0u ? mine : 1u; nx = cnt > 0u ? cnt : 1u;
}
DI void xcd_barrier(const XcdBarrier& b) {
    asm volatile("s_waitcnt vmcnt(0)" ::: "memory");
    __syncthreads();
    if (threadIdx.x == 0) {
        unsigned* bar = b.bar;
        __builtin_amdgcn_s_waitcnt(0);
        unsigned nloc = b.st[0], nx = b.st[1];
        if (nloc == 0u) { xcd_barrier_complete(bar, b.x, nloc, nx); b.st[0] = nloc; b.st[1] = nx; }
        const unsigned old = xb_add(&bar[XB_XSUB(b.x)], 1u);
        const unsigned gen = old / nloc;
        if (old + 1u == (gen + 1u) * nloc) {
            __builtin_amdgcn_fence(__ATOMIC_RELEASE, "agent");
            asm volatile("s_waitcnt vmcnt(0)" ::: "memory");
            const unsigned og = xb_add(&bar[XB_TOP], 1u);
            const unsigned tg = og / nx;
            if (og + 1u == (tg + 1u) * nx) xb_add(&bar[XB_TOPGEN], 1u);
            else XB_SPIN(xb_ld(&bar[XB_TOPGEN]) == tg, bar);
            __builtin_amdgcn_fence(__ATOMIC_ACQUIRE, "agent");
            xb_add(&bar[XB_XGEN(b.x)], 1u);
            asm volatile("s_waitcnt vmcnt(0)" ::: "memory");
        } else {
            XB_SPIN(xb_ld(&bar[XB_XGEN(b.x)]) == gen, bar);
            __builtin_amdgcn_fence(__ATOMIC_ACQUIRE, "agent");
            asm volatile("s_waitcnt vmcnt(0)" ::: "memory");
        }
    }
    __syncthreads();
}

static_assert(sizeof(Args) == 22 * 8, "Args layout");
__global__ void __launch_bounds__(NTHR, 2) fwd_kernel(Args a_unused) {
    extern __shared__ __attribute__((aligned(16))) unsigned char lds_raw[];
    cg::grid_group grid = cg::this_grid();
    Ctx F; F.lds = (LAS unsigned char*)lds_raw; F.tid = threadIdx.x; F.lane = F.tid & 63; F.wave = __builtin_amdgcn_readfirstlane(F.tid >> 6); F.G = gridDim.x; F.bid = blockIdx.x;

    int lo, hi; { typedef __attribute__((address_space(4))) const volatile unsigned long long* kp_t; const unsigned long long ph = ((kp_t)__builtin_amdgcn_kernarg_segment_ptr())[21]; lo = (int)(unsigned)ph; hi = (int)(unsigned)(ph >> 32); }
#ifndef PHASE_MASK
#define PHASE_MASK 0xffff
#endif
#define IN(k) (((PHASE_MASK >> (k)) & 1) && lo <= (k) && (k) < hi)
    volatile LAS unsigned* bst = (volatile LAS unsigned*)(F.lds + LDS_BYTES - 64);
    if (F.tid < 2) bst[F.tid] = 0u;
    __syncthreads();
    XcdBarrier xbar;
    { const Args a0 = load_args(); xbar = xcd_barrier_post((unsigned*)(a0.ws + WS_CTL), bst); }
    volatile LAS unsigned long long* tsl = (volatile LAS unsigned long long*)(F.lds + LDS_BYTES - 256);
    if (PROBE_PHASE >= 0 && F.bid == 0 && F.tid == 0) tsl[0] = __builtin_amdgcn_s_memrealtime();
#define SEAM(k) do { if (IN(k) && IN((k) + 1)) { if ((k) == 0) grid.sync(); else xcd_barrier(xbar); } \
        if (PROBE_PHASE >= 0 && F.bid == 0 && F.tid == 0) tsl[(k) + 1] = __builtin_amdgcn_s_memrealtime(); } while (0)
    if (IN(0)) { const Args a = load_args();
#pragma unroll 1
        for (int rep = 0; rep < REP_P0; ++rep) p0_phase(F, a); }
    SEAM(0);
    if (IN(1)) { const Args a = load_args(); p1_phase(F, a); }
    SEAM(1);
    if (IN(2)) {
        const Args a = load_args();
        pg8::Gemm g{(const bf16_t*)a.out, (const bf16_t*)(a.ws + WS_WINT), MTOK, PS, DM, 1 << 30}; pg8::StaticOrder S; S.init(MTOK, PS, F.G, F.bid);
        pg8::EpiBf16 E{(bf16_t*)(a.ws + WS_PROJ), PS};
        pg8::gemm_phase<pg8::EpiBf16, true, true>(F.lds, g, S, E);
        gates_tasks(F, a);
    }
    SEAM(2);
    if (IN(3)) {
        const Args a = load_args();
        for (int t = F.bid; t < BATCH * 64; t += F.G) qk_tile_task(F, a, t);
        for (int t = F.bid * NWAVES + F.wave; t < MTOK / 8 * 2; t += F.G * NWAVES) conv_task(F, a, t);
        for (int t = F.bid; t < 64; t += F.G) mscal_task(F, a, t);
    }
    SEAM(3);
    if (IN(4)) {
        const Args a = load_args();
        {
#pragma unroll 1
            for (int rep = 0; rep < REP_MSEQ; ++rep)
#pragma unroll 1
            for (int it = F.bid; it < 256; it += F.G) { const int xcd_ = it & 7, j_ = it >> 3; mseq_item(F, a, xcd_ * 4 + (j_ >> 3), (j_ >> 2) & 1, j_ & 3); }
        }
        float lam, cshift;
        { const float p01 = wave_sum(a.lam_p[F.lane] * a.lam_p[64 + F.lane]), p23 = wave_sum(a.lam_p[128 + F.lane] * a.lam_p[192 + F.lane]);
          lam = __expf(p01) - __expf(p23) + 0.2f;
          const float gq = wave_max(fabsf(a.qk_g[F.lane])), gk = wave_max(fabsf(a.qk_g[64 + F.lane]));
          cshift = 8.f * gq * gk * 1.4426950408889634f * 1.02f; }
        const int xcd = F.bid & 7, j = F.bid >> 3;
#pragma unroll 1
        for (int rep = 0; rep < REP_ATT; ++rep)
        for (int i = 0; i * F.G < 1024; ++i) {
            int u;
            if (F.G == 256) u = (xcd * 4 + i) * 32 + j; else u = i * F.G + F.bid;
            if (u < 1024) attn_unit(F, a, u >> 7, (u >> 5) & 3, u & 31, lam, cshift);
        }
    }
    SEAM(4);
    if (IN(5)) { const Args a = load_args(); mcombine_phase(F, a); }
    SEAM(5);
    if (IN(6)) {
        const Args a = load_args();
        pg8::Gemm g{(const bf16_t*)(a.ws + WS_YMIX), (const bf16_t*)(a.ws + WS_WOUTT), MTOK, DM, DM, 1 << 30}; pg8::StaticOrder S; S.init(MTOK, DM, F.G, F.bid);
        pg8::EpiX1 E{a.x, (const float*)(a.ws + WS_MOD), a.out};
        pg8::gemm_phase<pg8::EpiX1, true, true>(F.lds, g, S, E);
    }
    SEAM(6);
    if (IN(7)) { const Args a = load_args();
#pragma unroll 1
        for (int rep = 0; rep < REP_P7; ++rep) p7_phase(F, a); }
    SEAM(7);
    if (IN(8)) { const Args a = load_args(); for (int t = F.bid; t < BATCH * NEXP; t += F.G) topk_task(F, a, t); }
    SEAM(8);
    if (IN(9)) {
        const Args a = load_args();
        pg8::Gemm g{(const bf16_t*)(a.ws + WS_XE), (const bf16_t*)(a.ws + WS_WGUT), NPAIR, 4096, DM, 16};
        pg8::StaticOrder S; S.init(NPAIR, 4096, F.G, F.bid);
        pg8::EpiGU E{a.ws + WS_HH};
#pragma unroll 1
        for (int rep = 0; rep < REP_UP; ++rep)
        pg8::gemm_phase<pg8::EpiGU, true, true, true>(F.lds, g, S, E);
    }
    SEAM(9);
    if (IN(10)) {
        const Args a = load_args();
        pg8::Gemm g{(const bf16_t*)(a.ws + WS_HH), (const bf16_t*)(a.ws + WS_WDT), NPAIR, DM, DFF, 16};
        pg8::StaticOrder S; S.init(NPAIR, DM, F.G, F.bid);
        pg8::EpiDown E{a.ws + WS_Y, (const float*)(a.ws + WS_VALS)};
        pg8::gemm_phase<pg8::EpiDown, true, true, true>(F.lds, g, S, E);
    }
    SEAM(10);
    if (IN(11)) { const Args a = load_args(); final_phase(F, a); }
    if (PROBE_MSEQ_W >= 0 && F.bid == 0 && F.tid == 0) {
        const unsigned long long d = *(volatile LAS unsigned long long*)(F.lds + LDS_BYTES - 128), t1 = __builtin_amdgcn_s_memtime();
        while (__builtin_amdgcn_s_memtime() - t1 < 3ull * d) __builtin_amdgcn_s_sleep(8);
    }
    if (PROBE_PHASE >= 0 && F.bid == 0 && F.tid == 0) {
        const unsigned long long t1 = __builtin_amdgcn_s_memrealtime();
        const unsigned long long d = (PROBE_PHASE == 11 ? t1 : tsl[PROBE_PHASE + 1]) - tsl[PROBE_PHASE];
        while (__builtin_amdgcn_s_memrealtime() - t1 < 3ull * d) __builtin_amdgcn_s_sleep(8);
    }
#undef IN
#undef SEAM
}

extern "C" void kernel_launch(void* const* d_in, const int* in_sizes, int n_in, void* d_out, int out_size, void* d_ws, size_t ws_size, hipStream_t stream) {
    static int grid_blocks = 0;
    if (!grid_blocks) {
        int dev = 0, cus = 0, per_cu = 0;
        (void)hipGetDevice(&dev);
        (void)hipDeviceGetAttribute(&cus, hipDeviceAttributeMultiprocessorCount, dev);
        (void)hipFuncSetAttribute((const void*)fwd_kernel, hipFuncAttributeMaxDynamicSharedMemorySize, LDS_BYTES);
        (void)hipOccupancyMaxActiveBlocksPerMultiprocessor(&per_cu, (const void*)fwd_kernel, NTHR, LDS_BYTES);
        if (per_cu < 1) per_cu = 1;
        grid_blocks = cus;
        if (ws_size < WS_END) fprintf(stderr, "kernel_launch: workspace too small: %zu < %zu\n", ws_size, (size_t)WS_END);
    }
    (void)hipMemsetAsync((char*)d_ws + WS_CTL, 0, CTL_ZERO_BYTES, stream);
    Args a{};
    a.x = (const float*)d_in[0]; a.c = (const float*)d_in[1]; a.pos = (const int*)d_in[2]; a.norm1_g = (const float*)d_in[3]; a.norm2_g = (const float*)d_in[4];
    a.w_ada = (const float*)d_in[5]; a.b_ada = (const float*)d_in[6]; a.w_in = (const float*)d_in[7]; a.conv_w = (const float*)d_in[8]; a.gate_b = (const float*)d_in[9];
    a.mnorm_g = (const float*)d_in[10]; a.qk_g = (const float*)d_in[11]; a.lam_p = (const float*)d_in[12]; a.subln_g = (const float*)d_in[13]; a.w_out = (const float*)d_in[14];
    a.w_router = (const float*)d_in[15]; a.w_gate = (const float*)d_in[16]; a.w_up = (const float*)d_in[17]; a.w_down = (const float*)d_in[18];
    a.out = (float*)d_out; a.ws = (unsigned char*)d_ws; a.ph_lo = 0; a.ph_hi = 12;
    void* args[] = {&a};
    hipError_t e = hipLaunchCooperativeKernel((const void*)fwd_kernel, dim3(grid_blocks), dim3(NTHR), args, LDS_BYTES, stream);
    if (e != hipSuccess) fprintf(stderr, "cooperative launch failed: %s (grid %d)\n", hipGetErrorString(e), grid_blocks);
}
```

```cpp
#include <hip/hip_runtime.h>
#include <hip/hip_cooperative_groups.h>
#include <cstdio>
#include <cstdint>
namespace cg = cooperative_groups;

#define LAS __attribute__((address_space(3)))
#define DI __device__ __forceinline__
typedef unsigned short bf16_t;
typedef short bf16x8 __attribute__((ext_vector_type(8)));
typedef short s16x4 __attribute__((ext_vector_type(4)));
typedef float f32x2 __attribute__((ext_vector_type(2)));
typedef float f32x4 __attribute__((ext_vector_type(4)));
typedef float f32x16 __attribute__((ext_vector_type(16)));
typedef unsigned u32x2 __attribute__((ext_vector_type(2)));
typedef unsigned u32x4 __attribute__((ext_vector_type(4)));
typedef __bf16 bf16x2_t __attribute__((ext_vector_type(2)));

constexpr int BATCH = 8, SEQ = 4096, DM = 1024, MTOK = BATCH * SEQ;
constexpr int DIN = 3600, PS = 3584;
constexpr int NEXP = 16, CAP = 512, DFF = 2048;
constexpr int NPAIR = BATCH * NEXP * CAP;
constexpr float EPS = 1e-6f;
constexpr int C_QM = 0, C_KM = 512, C_VM = 1024, C_OM = 1536, C_QA = 2048, C_KA = 2560, C_VA = 3072;

constexpr size_t MiB = 1u << 20;
constexpr size_t WS_MOD = 1 * MiB;
constexpr size_t WS_GATES = 2 * MiB;
constexpr size_t WS_AFF = 4 * MiB;
constexpr size_t WS_IDX = 6 * MiB;
constexpr size_t WS_VALS = 6 * MiB + 256 * 1024;
constexpr size_t WS_MSC = 6 * MiB + 512 * 1024;
constexpr size_t WS_SLOT = 7 * MiB;
constexpr size_t WS_NLOC = 9 * MiB;
constexpr size_t WS_WINT = 11 * MiB;
constexpr size_t WS_WGT = 18 * MiB;
constexpr size_t WS_WOUTT = 19 * MiB;
constexpr size_t WS_WGUT = 21 * MiB;
constexpr size_t WS_WDT = 85 * MiB;
constexpr size_t WS_Y = 117 * MiB;
constexpr size_t WS_PROJ = 213 * MiB;
constexpr size_t WS_YMIX = 437 * MiB;
constexpr size_t WS_KIMG = 437 * MiB;
constexpr size_t WS_VIMG = 469 * MiB;
constexpr size_t WS_YA = 501 * MiB;
constexpr size_t WS_HH = 245 * MiB;
constexpr size_t WS_H2 = 437 * MiB;
constexpr size_t WS_XE = 469 * MiB;
constexpr size_t WS_END = 533 * MiB;

constexpr int LDS_BYTES = 147456;
constexpr int PROBE_MSEQ_W = -1;
constexpr int PROBE_PHASE = -1;
constexpr int REP_M1 = 1, REP_M3 = 1, REP_UP = 1, REP_P0 = 1, REP_SCAN = 1, REP_P7 = 1, REP_ATT = 1, REP_QKT = 1, REP_MSEQ = 1;
constexpr int NWAVES = 8, NTHR = 512;

DI unsigned pk2(float lo, float hi) { f32x2 v = {lo, hi}; bf16x2_t b = __builtin_convertvector(v, bf16x2_t); return __builtin_bit_cast(unsigned, b); }
DI float bflo(unsigned w) { return __uint_as_float(w << 16); }
DI float bfhi(unsigned w) { return __uint_as_float(w & 0xffff0000u); }
DI float bf2f(bf16_t v) { return __uint_as_float((unsigned)v << 16); }
template <int CTRL> DI float dpp_mov(float x) { return __builtin_bit_cast(float, __builtin_amdgcn_update_dpp(0, __builtin_bit_cast(int, x), CTRL, 0xf, 0xf, false)); }
#define DPP_XOR1 0xB1
#define DPP_XOR2 0x4E
#define DPP_ROR(n) (0x120 + (n))
DI float xor16_sum(float x) { const unsigned u = __builtin_bit_cast(unsigned, x); auto r = __builtin_amdgcn_permlane16_swap(u, u, false, false); return __builtin_bit_cast(float, (unsigned)r[0]) + __builtin_bit_cast(float, (unsigned)r[1]); }
DI float xor32_sum(float x) { const unsigned u = __builtin_bit_cast(unsigned, x); auto r = __builtin_amdgcn_permlane32_swap(u, u, false, false); return __builtin_bit_cast(float, (unsigned)r[0]) + __builtin_bit_cast(float, (unsigned)r[1]); }
DI float xor16_max(float x) { const unsigned u = __builtin_bit_cast(unsigned, x); auto r = __builtin_amdgcn_permlane16_swap(u, u, false, false); return fmaxf(__builtin_bit_cast(float, (unsigned)r[0]), __builtin_bit_cast(float, (unsigned)r[1])); }
DI float xor32_max(float x) { const unsigned u = __builtin_bit_cast(unsigned, x); auto r = __builtin_amdgcn_permlane32_swap(u, u, false, false); return fmaxf(__builtin_bit_cast(float, (unsigned)r[0]), __builtin_bit_cast(float, (unsigned)r[1])); }
template <int CTRL, int RM, int BM_> DI float dpp_mov_m(float oldv, float x) { return __builtin_bit_cast(float, __builtin_amdgcn_update_dpp(__builtin_bit_cast(int, oldv), __builtin_bit_cast(int, x), CTRL, RM, BM_, false)); }
DI float wave_prefix_sum(float v) {
    v += dpp_mov_m<0x111, 0xf, 0xf>(0.f, v); v += dpp_mov_m<0x112, 0xf, 0xf>(0.f, v); v += dpp_mov_m<0x114, 0xf, 0xe>(0.f, v); v += dpp_mov_m<0x118, 0xf, 0xc>(0.f, v);
    v += dpp_mov_m<0x142, 0xa, 0xf>(0.f, v); v += dpp_mov_m<0x143, 0xc, 0xf>(0.f, v);
    return v;
}
DI float wave_prefix_max(float v) {
    const float ninf = -__builtin_inff();
    v = fmaxf(v, dpp_mov_m<0x111, 0xf, 0xf>(ninf, v)); v = fmaxf(v, dpp_mov_m<0x112, 0xf, 0xf>(ninf, v)); v = fmaxf(v, dpp_mov_m<0x114, 0xf, 0xe>(ninf, v)); v = fmaxf(v, dpp_mov_m<0x118, 0xf, 0xc>(ninf, v));
    v = fmaxf(v, dpp_mov_m<0x142, 0xa, 0xf>(ninf, v)); v = fmaxf(v, dpp_mov_m<0x143, 0xc, 0xf>(ninf, v));
    return v;
}
DI float partner32(float x, int lane) { const unsigned u = __builtin_bit_cast(unsigned, x); auto r = __builtin_amdgcn_permlane32_swap(u, u, false, false); return __builtin_bit_cast(float, (unsigned)((lane & 32) ? r[0] : r[1])); }
DI float partner16(float x, int lane) { const unsigned u = __builtin_bit_cast(unsigned, x); auto r = __builtin_amdgcn_permlane16_swap(u, u, false, false); return __builtin_bit_cast(float, (unsigned)((lane & 16) ? r[0] : r[1])); }
DI float partner8(float x) { return dpp_mov<DPP_ROR(8)>(x); }
DI float partner4(float x, int lane) { const float a = dpp_mov<DPP_ROR(4)>(x), b = dpp_mov<DPP_ROR(12)>(x); return (lane & 4) ? a : b; }
DI float row_sum16(float v) { v += dpp_mov<DPP_XOR1>(v); v += dpp_mov<DPP_XOR2>(v); v += dpp_mov<DPP_ROR(4)>(v); v += dpp_mov<DPP_ROR(8)>(v); return v; }
DI float wave_sum(float v) { v = row_sum16(v); v = xor16_sum(v); return xor32_sum(v); }
DI float wave_max(float v) { v = fmaxf(v, dpp_mov<DPP_XOR1>(v)); v = fmaxf(v, dpp_mov<DPP_XOR2>(v)); v = fmaxf(v, dpp_mov<DPP_ROR(4)>(v)); v = fmaxf(v, dpp_mov<DPP_ROR(8)>(v)); v = xor16_max(v); return xor32_max(v); }
DI float sigmoid_f(float v) { return __builtin_amdgcn_rcpf(1.f + __builtin_amdgcn_exp2f(-1.4426950408889634f * v)); }
DI float silu_f(float v) { return v * sigmoid_f(v); }
DI float logsigmoid_f(float f) { return fminf(f, 0.f) - log1pf(__expf(-fabsf(f))); }
DI int swz16(int row) { return ((row & 3) << 2) | ((row >> 2) & 3); }
#define MFMA32(a, b, c) __builtin_amdgcn_mfma_f32_32x32x16_bf16((a), (b), (c), 0, 0, 0)
DI s16x4 trread(const LAS unsigned char* p) { return __builtin_bit_cast(s16x4, __builtin_amdgcn_ds_read_tr16_b64_v4i16((LAS s16x4*)p)); }
DI int crow(int r, int hh) { return (r & 3) + 8 * (r >> 2) + 4 * hh; }
DI bool hh_sel(int lane, int bit) { return (lane & bit) != 0; }

namespace pg8 {
constexpr int BM = 256, BK = 64, HALF = 128, HTB = HALF * BK * 2, STAGE_BYTES = 8 * HTB, NXCD = 8, WGM = 8;
DI int lds_byte(int r, int c) { const int st = (r >> 4) * 2 + (c >> 5), rr = r & 15, cc = c & 31, ob = rr * 64 + cc * 2; return st * 1024 + (ob ^ (((ob >> 9) & 1) << 5)); }
DI void stage_rc(int b, int& R, int& C) { const int st = b / 1024, sb = b % 1024, swz = sb ^ (((sb >> 9) & 1) << 5); R = (st >> 1) * 16 + swz / 64; C = (st & 1) * 32 + (swz % 64) / 2; }
DI int perm32(int rho) { const int n = rho >> 4, i = rho & 15; return 8 * (i >> 2) + 4 * n + (i & 3); }
struct Unit { int pm, pn; };
typedef int i32x4_t __attribute__((ext_vector_type(4)));
typedef int i32x8_t __attribute__((ext_vector_type(8)));
DI i32x8_t cat8(bf16x8 lo, bf16x8 hi) { const i32x4_t a = __builtin_bit_cast(i32x4_t, lo), b = __builtin_bit_cast(i32x4_t, hi); return __builtin_shufflevector(a, b, 0, 1, 2, 3, 4, 5, 6, 7); }
struct Gemm { const bf16_t* A; const bf16_t* Bt; int M, N, K, tpg; };
struct StaticOrder {
    int nM, nN, nwg, G, c;
    DI void init(int M, int N, int G_, int c_) { nM = M / BM; nN = N / BM; nwg = nM * nN; G = G_; c = c_; }
    DI bool next(int i, Unit& u) const {
        const long L = (long)i * G + c; if (L >= nwg) return false;
        int wgid = (int)L; { const int q = nwg / NXCD, r = nwg % NXCD, xcd = wgid % NXCD, off = wgid / NXCD; wgid = (xcd < r ? xcd * (q + 1) : r * (q + 1) + (xcd - r) * q) + off; }
        const int nig = WGM * nN, gid = wgid / nig, fm = gid * WGM, gsz = (nM - fm) < WGM ? (nM - fm) : WGM;
        u.pm = fm + ((wgid % nig) % gsz); u.pn = (wgid % nig) / gsz; return true;
    }
};

template <class Epi, bool ALIGN_EPI, bool SP2, bool FP8 = false>
DI void gemm_phase(LAS unsigned char* lds, const Gemm g, const StaticOrder& S, const Epi& E) {
    const int tid = threadIdx.x, wid = __builtin_amdgcn_readfirstlane(tid >> 6), lane = tid & 63, wr = wid >> 2, wc = wid & 3, fr = lane & 15, fq = lane >> 4;
    const int KB = FP8 ? g.K : 2 * g.K, nt = KB / (BK * 2);
    unsigned voffA[2], voffB[2];
#pragma unroll
    for (int i = 0; i < 2; ++i) { int R, C; stage_rc(tid * 16 + i * 8192, R, C); const int Rb = Epi::PERM ? ((R & ~31) + perm32(R & 31)) : R;
        voffA[i] = (unsigned)(R * KB + C * 2); voffB[i] = (unsigned)(Rb * KB + C * 2); }
    const size_t kstep = (size_t)(BK * 2);
    const size_t hstep = (size_t)HALF * KB;
    const size_t tstep = 2 * hstep;
    const size_t gstep = (size_t)g.N * KB;
    const unsigned ldsw = (unsigned)wid * 1024u;
    const int aoff = lds_byte(wr * 64 + fr, fq * 8), boff = lds_byte(wc * 32 + fr, fq * 8);
#define PG8_SA(b, h) (((b) * 2 + (h)) * HTB)
#define PG8_SB(b, h) ((4 + (b) * 2 + (h)) * HTB)
#define PG8_STAGE(bufoff, gbase, voff) do { _Pragma("unroll") for (int _i = 0; _i < 2; ++_i) \
        __builtin_amdgcn_global_load_lds((const unsigned*)((const char*)(gbase) + (voff)[_i]), (LAS unsigned*)(lds + (bufoff) + ldsw + _i * 8192), 16, 0, 0); } while (0)
#define PG8_LDA(dst, b, h) do { if constexpr (FP8) { _Pragma("unroll") for (int m = 0; m < 4; ++m) dst##8[m] = cat8(*(const LAS bf16x8*)(lds + PG8_SA(b, h) + aoff + m * 2048), *(const LAS bf16x8*)(lds + PG8_SA(b, h) + aoff + m * 2048 + 1024)); } \
        else { _Pragma("unroll") for (int m = 0; m < 4; ++m) _Pragma("unroll") for (int k = 0; k < 2; ++k) dst[m][k] = *(const LAS bf16x8*)(lds + PG8_SA(b, h) + aoff + m * 2048 + k * 1024); } } while (0)
#define PG8_LDB(dst, b, h) do { if constexpr (FP8) { _Pragma("unroll") for (int n = 0; n < 2; ++n) dst##8[n] = cat8(*(const LAS bf16x8*)(lds + PG8_SB(b, h) + boff + n * 2048), *(const LAS bf16x8*)(lds + PG8_SB(b, h) + boff + n * 2048 + 1024)); } \
        else { _Pragma("unroll") for (int n = 0; n < 2; ++n) _Pragma("unroll") for (int k = 0; k < 2; ++k) dst[n][k] = *(const LAS bf16x8*)(lds + PG8_SB(b, h) + boff + n * 2048 + k * 1024); } } while (0)
#define PG8_MMA(ai, bj, At, Bt) do { __builtin_amdgcn_s_setprio(1); \
        if constexpr (FP8) { _Pragma("unroll") for (int m = 0; m < 4; ++m) _Pragma("unroll") for (int n = 0; n < 2; ++n) \
            asm volatile("s_nop 1\n\tv_mfma_f32_16x16x128_f8f6f4 %0, %1, %2, %0" : "+v"(acc[ai][bj][m][n]) : "v"(Bt##8[n]), "v"(At##8[m])); } \
        else { _Pragma("unroll") for (int m = 0; m < 4; ++m) _Pragma("unroll") for (int n = 0; n < 2; ++n) _Pragma("unroll") for (int k = 0; k < 2; ++k) \
            acc[ai][bj][m][n] = __builtin_amdgcn_mfma_f32_16x16x32_bf16(Bt[n][k], At[m][k], acc[ai][bj][m][n], 0, 0, 0); } \
        __builtin_amdgcn_s_setprio(0); } while (0)
#define PG8_WAIT_V(n) asm volatile("s_waitcnt vmcnt(" #n ")" ::: "memory")
#define PG8_WAIT_L(n) asm volatile("s_waitcnt lgkmcnt(" #n ")" ::: "memory")
#define PG8_BAR __builtin_amdgcn_s_barrier()
#define PG8_SCHED __builtin_amdgcn_sched_barrier(0)
    Unit cur, nxt; int ui = 0;
    if (!S.next(0, cur)) return;
    f32x4 acc[2][2][4][2];
#pragma unroll
    for (int a = 0; a < 2; ++a)
#pragma unroll
        for (int b = 0; b < 2; ++b)
#pragma unroll
            for (int m = 0; m < 4; ++m)
#pragma unroll
                for (int n = 0; n < 2; ++n) acc[a][b][m][n] = (f32x4){0.f, 0.f, 0.f, 0.f};
    bf16x8 At[4][2], B0[2][2], B1[2][2]; i32x8_t At8[4], B08[2], B18[2];
    const char* cA = (const char*)g.A + (size_t)cur.pm * tstep; const char* cB = (const char*)g.Bt + (size_t)(cur.pm / g.tpg) * gstep + (size_t)cur.pn * tstep;
    if constexpr (SP2) {
        PG8_STAGE(PG8_SB(0, 0), cB, voffB); PG8_STAGE(PG8_SB(0, 1), cB + hstep, voffB); PG8_STAGE(PG8_SA(0, 0), cA, voffA); PG8_STAGE(PG8_SA(0, 1), cA + hstep, voffA);
        if (wr == 1) PG8_BAR;
        PG8_WAIT_V(2); PG8_BAR;
        PG8_STAGE(PG8_SB(1, 0), cB + kstep, voffB); PG8_STAGE(PG8_SA(1, 0), cA + kstep, voffA); PG8_STAGE(PG8_SB(1, 1), cB + hstep + kstep, voffB);
        PG8_WAIT_V(6); PG8_BAR;
    } else {
        PG8_STAGE(PG8_SB(0, 0), cB, voffB); PG8_STAGE(PG8_SA(0, 0), cA, voffA); PG8_STAGE(PG8_SB(0, 1), cB + hstep, voffB); PG8_STAGE(PG8_SA(0, 1), cA + hstep, voffA);
        if (wr == 1) PG8_BAR;
        PG8_WAIT_V(4); PG8_BAR;
        PG8_STAGE(PG8_SB(1, 0), cB + kstep, voffB); PG8_STAGE(PG8_SA(1, 0), cA + kstep, voffA); PG8_STAGE(PG8_SB(1, 1), cB + hstep + kstep, voffB);
        PG8_WAIT_V(6); PG8_BAR;
    }
    for (;;) {
        const bool has_next = S.next(ui + 1, nxt);
        const char* nA = has_next ? (const char*)g.A + (size_t)nxt.pm * tstep : cA;
        const char* nB = has_next ? (const char*)g.Bt + (size_t)(nxt.pm / g.tpg) * gstep + (size_t)nxt.pn * tstep : cB;
        for (int t = 0; t < nt; t += 2) {
            const bool last = (t == nt - 2);
            const char* a1 = cA + (size_t)(t + 1) * kstep;
            const char* a2 = last ? nA : cA + (size_t)(t + 2) * kstep; const char* b2 = last ? nB : cB + (size_t)(t + 2) * kstep;
            const char* a3 = a2 + kstep; const char* b3 = b2 + kstep;
            if constexpr (SP2) {
            PG8_LDB(B0, 0, 0); PG8_LDB(B1, 0, 1); PG8_SCHED; PG8_LDA(At, 0, 0); PG8_STAGE(PG8_SA(1, 1), a1 + hstep, voffA);
            PG8_WAIT_V(8); PG8_WAIT_L(0); PG8_BAR; PG8_MMA(0, 0, At, B0); PG8_MMA(0, 1, At, B1); PG8_BAR; PG8_SCHED;
            PG8_LDA(At, 0, 1); PG8_STAGE(PG8_SB(0, 0), b2, voffB); PG8_STAGE(PG8_SB(0, 1), b2 + hstep, voffB); PG8_STAGE(PG8_SA(0, 0), a2, voffA);
            PG8_WAIT_V(8); PG8_WAIT_L(0); PG8_BAR; PG8_MMA(1, 0, At, B0); PG8_MMA(1, 1, At, B1); PG8_BAR; PG8_SCHED;
            PG8_LDB(B0, 1, 0); PG8_LDB(B1, 1, 1); PG8_SCHED; PG8_LDA(At, 1, 0); PG8_STAGE(PG8_SA(0, 1), a2 + hstep, voffA);
            PG8_WAIT_V(8); PG8_WAIT_L(0); PG8_BAR; PG8_MMA(0, 0, At, B0); PG8_MMA(0, 1, At, B1); PG8_BAR; PG8_SCHED;
            PG8_LDA(At, 1, 1); PG8_STAGE(PG8_SB(1, 0), b3, voffB); PG8_STAGE(PG8_SB(1, 1), b3 + hstep, voffB); PG8_STAGE(PG8_SA(1, 0), a3, voffA);
            PG8_WAIT_V(8); PG8_WAIT_L(0); PG8_BAR; PG8_MMA(1, 0, At, B0); PG8_MMA(1, 1, At, B1); PG8_BAR; PG8_SCHED;
            } else {
            PG8_LDB(B0, 0, 0); PG8_SCHED; PG8_LDA(At, 0, 0); PG8_STAGE(PG8_SA(1, 1), a1 + hstep, voffA);
            PG8_WAIT_L(8); PG8_BAR; PG8_WAIT_L(0); PG8_MMA(0, 0, At, B0); PG8_BAR; PG8_SCHED;
            PG8_LDB(B1, 0, 1); PG8_STAGE(PG8_SB(0, 0), b2, voffB);
            PG8_BAR; PG8_WAIT_L(0); PG8_MMA(0, 1, At, B1); PG8_BAR;
            PG8_LDA(At, 0, 1); PG8_STAGE(PG8_SA(0, 0), a2, voffA);
            PG8_BAR; PG8_WAIT_L(0); PG8_MMA(1, 0, At, B0); PG8_BAR; PG8_SCHED;
            PG8_STAGE(PG8_SB(0, 1), b2 + hstep, voffB);
            PG8_WAIT_V(6); PG8_BAR; PG8_MMA(1, 1, At, B1); PG8_BAR;
            PG8_LDB(B0, 1, 0); PG8_SCHED; PG8_LDA(At, 1, 0); PG8_STAGE(PG8_SA(0, 1), a2 + hstep, voffA);
            PG8_WAIT_L(8); PG8_BAR; PG8_WAIT_L(0); PG8_MMA(0, 0, At, B0); PG8_BAR; PG8_SCHED;
            PG8_LDB(B1, 1, 1); PG8_STAGE(PG8_SB(1, 0), b3, voffB);
            PG8_BAR; PG8_WAIT_L(0); PG8_MMA(0, 1, At, B1); PG8_BAR;
            PG8_LDA(At, 1, 1); PG8_STAGE(PG8_SA(1, 0), a3, voffA);
            PG8_BAR; PG8_WAIT_L(0); PG8_MMA(1, 0, At, B0); PG8_BAR; PG8_SCHED;
            PG8_STAGE(PG8_SB(1, 1), b3 + hstep, voffB);
            PG8_WAIT_V(6); PG8_BAR; PG8_MMA(1, 1, At, B1); PG8_BAR;
            }
        }
        if constexpr (ALIGN_EPI) { if (wr == 0) PG8_BAR; }
        if constexpr (FP8) asm volatile("s_nop 15\n\ts_nop 7" ::: "memory");
        E(acc, cur, wr, wc, fr, fq);
        if (!has_next) break;
#pragma unroll
        for (int a = 0; a < 2; ++a)
#pragma unroll
            for (int b = 0; b < 2; ++b)
#pragma unroll
                for (int m = 0; m < 4; ++m)
#pragma unroll
                    for (int n = 0; n < 2; ++n) acc[a][b][m][n] = (f32x4){0.f, 0.f, 0.f, 0.f};
        cur = nxt; cA = nA; cB = nB; ++ui;
        if constexpr (ALIGN_EPI) { if (wr == 1) PG8_BAR; }
    }
    PG8_WAIT_V(0);
    if constexpr (!ALIGN_EPI) { if (wr == 0) PG8_BAR; }
    PG8_BAR;
#undef PG8_SA
#undef PG8_SB
#undef PG8_STAGE
#undef PG8_LDA
#undef PG8_LDB
#undef PG8_MMA
#undef PG8_WAIT_V
#undef PG8_WAIT_L
#undef PG8_BAR
#undef PG8_SCHED
}

struct EpiBf16 {
    static constexpr bool PERM = true;
    bf16_t* O; int ldc;
    DI void operator()(const f32x4 (&acc)[2][2][4][2], const Unit& u, int wr, int wc, int fr, int fq) const {
        const int row0 = u.pm * BM + wr * 64 + fr, col0 = u.pn * BM + wc * 32 + 8 * fq;
#pragma unroll
        for (int ai = 0; ai < 2; ++ai)
#pragma unroll
            for (int m = 0; m < 4; ++m) { bf16_t* rowp = O + (size_t)(row0 + ai * HALF + m * 16) * ldc + col0;
#pragma unroll
                for (int bj = 0; bj < 2; ++bj) { const f32x4 v0 = acc[ai][bj][m][0], v1 = acc[ai][bj][m][1];
                    u32x4 w; w.x = pk2(v0[0], v0[1]); w.y = pk2(v0[2], v0[3]); w.z = pk2(v1[0], v1[1]); w.w = pk2(v1[2], v1[3]);
                    *(u32x4*)(rowp + bj * HALF) = w; } }
    }
};
struct EpiProj {
    static constexpr bool PERM = true;
    bf16_t* O; const int* pos; const float* qk_g; bf16_t* kimg; bf16_t* vimg;
    DI void operator()(const f32x4 (&acc)[2][2][4][2], const Unit& u, int wr, int wc, int fr, int fq) const {
        const int row0 = u.pm * BM + wr * 64 + fr;
        if (u.pn < 8) {
            const int col0 = u.pn * BM + wc * 32 + 8 * fq;
#pragma unroll
            for (int ai = 0; ai < 2; ++ai)
#pragma unroll
                for (int m = 0; m < 4; ++m) { bf16_t* rowp = O + (size_t)(row0 + ai * HALF + m * 16) * PS + col0;
#pragma unroll
                    for (int bj = 0; bj < 2; ++bj) { const f32x4 v0 = acc[ai][bj][m][0], v1 = acc[ai][bj][m][1];
                        u32x4 w; w.x = pk2(v0[0], v0[1]); w.y = pk2(v0[2], v0[3]); w.z = pk2(v1[0], v1[1]); w.w = pk2(v1[2], v1[3]);
                        *(u32x4*)(rowp + bj * HALF) = w; } }
        } else if (u.pn < 12) {
            const int isk = (u.pn >= 10), hsub = 4 * (u.pn & 1) + wc, h = hsub >> 1, p = hsub & 1;
            const float* gp = qk_g + isk * 64 + 8 * fq;
            const f32x4 g00 = *(const f32x4*)gp, g01 = *(const f32x4*)(gp + 4), g10 = *(const f32x4*)(gp + 32), g11 = *(const f32x4*)(gp + 36);
            const float qs = isk ? 1.f : 0.125f * 1.4426950408889634f;
            const int lane = fr + 16 * fq;
#pragma unroll
            for (int ai = 0; ai < 2; ++ai)
#pragma unroll
                for (int m = 0; m < 4; ++m) { const int row = row0 + ai * HALF + m * 16;
                    f32x4 a0 = acc[ai][0][m][0], a1 = acc[ai][0][m][1], b0 = acc[ai][1][m][0], b1 = acc[ai][1][m][1];
                    float ss = (a0[0] * a0[0] + a0[1] * a0[1] + a0[2] * a0[2] + a0[3] * a0[3]) + (a1[0] * a1[0] + a1[1] * a1[1] + a1[2] * a1[2] + a1[3] * a1[3])
                             + (b0[0] * b0[0] + b0[1] * b0[1] + b0[2] * b0[2] + b0[3] * b0[3]) + (b1[0] * b1[0] + b1[1] * b1[1] + b1[2] * b1[2] + b1[3] * b1[3]);
                    ss = xor16_sum(ss); ss = xor32_sum(ss);
                    const float rstd = rsqrtf(ss * (1.f / 64.f) + EPS);
                    a0 = a0 * rstd * g00; a1 = a1 * rstd * g01; b0 = b0 * rstd * g10 * qs; b1 = b1 * rstd * g11 * qs;
                    const float pf = (float)pos[row];
                    f32x4 r0, r1;
#pragma unroll
                    for (int n = 0; n < 2; ++n)
#pragma unroll
                        for (int j = 0; j < 4; ++j) { const int i = 4 * n + j; const float own = n ? a1[j] : a0[j]; const float oth = partner16(own, lane);
                            const float frc = __builtin_amdgcn_fractf(pf * (exp2f(-(float)i * 0.125f * 18.931568569324174f) * 0.15915494309189535f));
                            const float sn = __builtin_amdgcn_sinf(frc), cs = __builtin_amdgcn_cosf(frc);
                            const float rot = (fq == 0) ? own * cs - oth * sn : own * cs + oth * sn;
                            const float o = (fq < 2) ? rot : own;
                            if (n) r1[j] = o; else r0[j] = o; }
                    r0 = r0 * qs; r1 = r1 * qs;
                    u32x4 w0, w1;
                    w0.x = pk2(r0[0], r0[1]); w0.y = pk2(r0[2], r0[3]); w0.z = pk2(r1[0], r1[1]); w0.w = pk2(r1[2], r1[3]);
                    w1.x = pk2(b0[0], b0[1]); w1.y = pk2(b0[2], b0[3]); w1.z = pk2(b1[0], b1[1]); w1.w = pk2(b1[2], b1[3]);
                    if (!isk) { bf16_t* rowp = O + (size_t)row * PS + C_QA + h * 128 + p * 64 + 8 * fq; *(u32x4*)rowp = w0; *(u32x4*)(rowp + 32) = w1; }
                    else { const int b = row / SEQ, t = row % SEQ; bf16_t* kp = kimg + ((size_t)((b * 4 + h) * 64 + (t >> 6))) * 8192 + (p * 8 + fq) * 512 + (t & 63) * 8;
                        *(u32x4*)kp = w0; *(u32x4*)(kp + 4 * 512) = w1; } }
        } else {
#pragma unroll
            for (int ai = 0; ai < 2; ++ai)
#pragma unroll
                for (int m = 0; m < 4; ++m) { const int row = row0 + ai * HALF + m * 16, b = row / SEQ, t = row % SEQ;
#pragma unroll
                    for (int bj = 0; bj < 2; ++bj) { const int h = 2 * (u.pn - 12) + bj; const f32x4 v0 = acc[ai][bj][m][0], v1 = acc[ai][bj][m][1];
                        u32x4 w; w.x = pk2(v0[0], v0[1]); w.y = pk2(v0[2], v0[3]); w.z = pk2(v1[0], v1[1]); w.w = pk2(v1[2], v1[3]);
                        *(u32x4*)(vimg + ((size_t)((b * 4 + h) * 64 + (t >> 6))) * 8192 + (wc * 4 + ((t & 63) >> 4)) * 512 + (t & 15) * 32 + fq * 8) = w; } }
        }
    }
};
struct EpiX1 {
    static constexpr bool PERM = false;
    const float* x; const float* mod; float* out;
    DI void operator()(const f32x4 (&acc)[2][2][4][2], const Unit& u, int wr, int wc, int fr, int fq) const {
        const int row0 = u.pm * BM + wr * 64 + fr, col0 = u.pn * BM + wc * 32 + 4 * fq;
        const int b = (u.pm * BM) / SEQ;
        const float* gp = mod + (size_t)b * 6144 + 2048 + col0;
#pragma unroll
        for (int bj = 0; bj < 2; ++bj)
#pragma unroll
            for (int n = 0; n < 2; ++n) { const f32x4 gv = *(const f32x4*)(gp + bj * HALF + n * 16);
#pragma unroll
                for (int ai = 0; ai < 2; ++ai)
#pragma unroll
                    for (int m = 0; m < 4; ++m) { const size_t off = (size_t)(row0 + ai * HALF + m * 16) * DM + col0 + bj * HALF + n * 16;
                        const f32x4 xv = *(const f32x4*)(x + off); *(f32x4*)(out + off) = xv + gv * acc[ai][bj][m][n]; } }
    }
};
DI unsigned pk4_fp8(float a, float b, float c, float d) { int w = __builtin_amdgcn_cvt_pk_fp8_f32(a, b, 0, false); w = __builtin_amdgcn_cvt_pk_fp8_f32(c, d, w, true); return (unsigned)w; }
constexpr float W_PRESCALE = 32.f, H_PRESCALE = 8.f;
struct EpiGU {
    static constexpr bool PERM = true;
    unsigned char* H;
    DI void operator()(const f32x4 (&acc)[2][2][4][2], const Unit& u, int wr, int wc, int fr, int fq) const {
        const int row0 = u.pm * BM + wr * 64 + fr, col0 = u.pn * HALF + wc * 32 + 8 * fq;
#pragma unroll
        for (int ai = 0; ai < 2; ++ai)
#pragma unroll
            for (int m = 0; m < 4; ++m) { unsigned char* rowp = H + (size_t)(row0 + ai * HALF + m * 16) * DFF + col0;
                float hv[8];
#pragma unroll
                for (int n = 0; n < 2; ++n)
#pragma unroll
                    for (int j = 0; j < 4; ++j) { const float gg = acc[ai][0][m][n][j] * (1.f / W_PRESCALE), uu = acc[ai][1][m][n][j] * (H_PRESCALE / W_PRESCALE); hv[n * 4 + j] = gg * __builtin_amdgcn_rcpf(1.f + __builtin_amdgcn_exp2f(-1.4426950408889634f * gg)) * uu; }
                u32x2 w; w.x = pk4_fp8(hv[0], hv[1], hv[2], hv[3]); w.y = pk4_fp8(hv[4], hv[5], hv[6], hv[7]);
                *(u32x2*)rowp = w; }
    }
};
constexpr float Y_PRESCALE = 64.f;
struct EpiDown {
    static constexpr bool PERM = true;
    unsigned char* Y; const float* vals;
    DI void operator()(const f32x4 (&acc)[2][2][4][2], const Unit& u, int wr, int wc, int fr, int fq) const {
        const int row0 = u.pm * BM + wr * 64 + fr, col0 = u.pn * BM + wc * 32 + 8 * fq;
#pragma unroll
        for (int ai = 0; ai < 2; ++ai)
#pragma unroll
            for (int m = 0; m < 4; ++m) { const int row = row0 + ai * HALF + m * 16; const float s = vals[row] * (Y_PRESCALE / (W_PRESCALE * H_PRESCALE)); unsigned char* rowp = Y + (size_t)row * DM + col0;
#pragma unroll
                for (int bj = 0; bj < 2; ++bj) { const f32x4 v0 = acc[ai][bj][m][0] * s, v1 = acc[ai][bj][m][1] * s;
                    u32x2 w; w.x = pk4_fp8(v0[0], v0[1], v0[2], v0[3]); w.y = pk4_fp8(v1[0], v1[1], v1[2], v1[3]);
                    *(u32x2*)(rowp + bj * HALF) = w; } }
    }
};
}

struct Args {
    const float* x; const float* c; const int* pos; const float* norm1_g; const float* norm2_g; const float* w_ada; const float* b_ada;
    const float* w_in; const float* conv_w; const float* gate_b; const float* mnorm_g; const float* qk_g; const float* lam_p; const float* subln_g;
    const float* w_out; const float* w_router; const float* w_gate; const float* w_up; const float* w_down;
    float* out; unsigned char* ws; int ph_lo, ph_hi;
};
struct Ctx {
    LAS unsigned char* lds; int tid, lane, wave, G, bid;
};
DI Args load_args() {
    typedef __attribute__((address_space(4))) const volatile unsigned long long* kp_t;
    kp_t kp = (kp_t)__builtin_amdgcn_kernarg_segment_ptr();
#define GP(T, i) ((T*)(__attribute__((address_space(1))) T*)kp[i])
    Args a;
    a.x = GP(const float, 0); a.c = GP(const float, 1); a.pos = GP(const int, 2); a.norm1_g = GP(const float, 3); a.norm2_g = GP(const float, 4);
    a.w_ada = GP(const float, 5); a.b_ada = GP(const float, 6); a.w_in = GP(const float, 7); a.conv_w = GP(const float, 8); a.gate_b = GP(const float, 9);
    a.mnorm_g = GP(const float, 10); a.qk_g = GP(const float, 11); a.lam_p = GP(const float, 12); a.subln_g = GP(const float, 13); a.w_out = GP(const float, 14);
    a.w_router = GP(const float, 15); a.w_gate = GP(const float, 16); a.w_up = GP(const float, 17); a.w_down = GP(const float, 18);
    a.out = GP(float, 19); a.ws = GP(unsigned char, 20);
#undef GP
    a.ph_lo = 0; a.ph_hi = 12;
    return a;
}

DI void tr_item64(const float* src, size_t ld_src, int k0, int c0, bf16_t* dst, size_t r0, int ld_dst, LAS float* scr  , int lane, size_t r1 = (size_t)-1) {
    const float* sp = src + (size_t)(k0 + (lane >> 4)) * ld_src + c0 + (lane & 15) * 4;
#pragma unroll 1
    for (int hf = 0; hf < 2; ++hf) {
        f32x4 v[8];
#pragma unroll
        for (int i = 0; i < 8; ++i) v[i] = *(const f32x4*)(sp + (size_t)(4 * (8 * hf + i)) * ld_src);
#pragma unroll
        for (int i = 0; i < 8; ++i) *(LAS f32x4*)(scr + (4 * (8 * hf + i) + (lane >> 4)) * 68 + (lane & 15) * 4) = v[i];
    }
    asm volatile("s_waitcnt lgkmcnt(0)" ::: "memory");
    const int c = lane & 7;
#pragma unroll
    for (int q = 0; q < 8; ++q) { const int n = 8 * q + (lane >> 3); const LAS float* s = scr + (8 * c) * 68 + n;
        u32x4 o; o.x = pk2(s[0 * 68], s[1 * 68]); o.y = pk2(s[2 * 68], s[3 * 68]); o.z = pk2(s[4 * 68], s[5 * 68]); o.w = pk2(s[6 * 68], s[7 * 68]);
        const size_t row = (r1 != (size_t)-1 && q >= 4) ? r1 + (n - 32) : r0 + n;
        *(u32x4*)(dst + row * ld_dst + k0 + 8 * c) = o; }
    asm volatile("s_waitcnt lgkmcnt(0)" ::: "memory");
}
DI void tr_item64_fp8(const float* src, size_t ld_src, int k0, int c0, unsigned char* dst, size_t r0, int ld_dst, float scale, LAS float* scr  , int lane) {
    const float* sp = src + (size_t)(k0 + (lane >> 4)) * ld_src + c0 + (lane & 15) * 4;
    {
        f32x4 v[16];
#pragma unroll
        for (int i = 0; i < 16; ++i) v[i] = __builtin_nontemporal_load((const f32x4*)(sp + (size_t)(4 * i) * ld_src));
#pragma unroll
        for (int i = 0; i < 16; ++i) *(LAS f32x4*)(scr + (4 * i + (lane >> 4)) * 68 + (lane & 15) * 4) = v[i] * scale;
    }
    asm volatile("s_waitcnt lgkmcnt(0)" ::: "memory");
    const int c = lane & 3;
#pragma unroll
    for (int q = 0; q < 4; ++q) { const int n = 16 * q + (lane >> 2); const LAS float* s = scr + (16 * c) * 68 + n;
        u32x4 o; o.x = pg8::pk4_fp8(s[0 * 68], s[1 * 68], s[2 * 68], s[3 * 68]); o.y = pg8::pk4_fp8(s[4 * 68], s[5 * 68], s[6 * 68], s[7 * 68]);
        o.z = pg8::pk4_fp8(s[8 * 68], s[9 * 68], s[10 * 68], s[11 * 68]); o.w = pg8::pk4_fp8(s[12 * 68], s[13 * 68], s[14 * 68], s[15 * 68]);
        *(u32x4*)(dst + (r0 + n) * ld_dst + k0 + 16 * c) = o; }
    asm volatile("s_waitcnt lgkmcnt(0)" ::: "memory");
}
DI void p0_phase(const Ctx& F, const Args& a) {
    if (F.bid < 96) {
        LAS float* sc = (LAS float*)F.lds; LAS float* part = (LAS float*)(F.lds + 32768);
        for (int i = F.tid; i < BATCH * DM; i += NTHR) sc[i] = silu_f(a.c[i]);
        __syncthreads();
        const int col = F.bid * 64 + F.lane;
        float acc[8];
#pragma unroll
        for (int b = 0; b < 8; ++b) acc[b] = 0.f;
        const int kb = F.wave * 128;
#pragma unroll 1
        for (int k0 = kb; k0 < kb + 128; k0 += 16) {
            float w[16];
            const float* wp = a.w_ada + (size_t)k0 * 6144 + col;
#pragma unroll
            for (int j = 0; j < 16; ++j) w[j] = wp[(size_t)j * 6144];
#pragma unroll
            for (int j = 0; j < 16; ++j)
#pragma unroll
                for (int b = 0; b < 8; ++b) acc[b] += sc[b * DM + k0 + j] * w[j];
        }
#pragma unroll
        for (int b = 0; b < 8; ++b) part[(F.wave * 8 + b) * 64 + F.lane] = acc[b];
        __syncthreads();
        { const int b = F.tid >> 6, l = F.tid & 63; float s = a.b_ada[F.bid * 64 + l];
#pragma unroll
          for (int w = 0; w < 8; ++w) s += part[(w * 8 + b) * 64 + l];
          ((float*)(a.ws + WS_MOD))[b * 6144 + F.bid * 64 + l] = s; }
        __syncthreads();
    }
    LAS float* scr = (LAS float*)(F.lds + F.wave * 17408);
    const int gw = F.bid * NWAVES + F.wave, NGW = F.G * NWAVES;
    constexpr int I_IN = 16 * 56, I_OUT = 16 * 16, I_G = 16 * 16 * 32, I_D = 16 * 32 * 16, I_WG = 16;
    constexpr int NITEMS = I_IN + I_OUT + 2 * I_G + I_D + I_WG;
    bf16_t* WinT = (bf16_t*)(a.ws + WS_WINT); bf16_t* WgT = (bf16_t*)(a.ws + WS_WGT); bf16_t* WoutT = (bf16_t*)(a.ws + WS_WOUTT);
    unsigned char* WguT = a.ws + WS_WGUT; unsigned char* WdT = a.ws + WS_WDT;
    for (int it = gw; it < NITEMS; it += NGW) {
        int r = it;
        if (r < I_IN) { const int kb = r / 56, nb = r % 56, n0 = nb * 64;
            if (n0 >= 2048 && n0 < 3072) { const int t0 = n0 & ~255, g = (n0 >> 6) & 3; tr_item64(a.w_in, DIN, kb * 64, n0 + 16, WinT, (size_t)(t0 + 32 * g), DM, scr, F.lane, (size_t)(t0 + 128 + 32 * g)); }
            else tr_item64(a.w_in, DIN, kb * 64, n0 + (n0 >= 2048 ? 16 : 0), WinT, n0, DM, scr, F.lane);
            continue; } r -= I_IN;
        if (r < I_OUT) { const int kb = r / 16, nb = r % 16; tr_item64(a.w_out, DM, kb * 64, nb * 64, WoutT, nb * 64, DM, scr, F.lane); continue; } r -= I_OUT;
        if (r < 2 * I_G) { const int up = r / I_G; r -= up * I_G; const int e = r / 512; r -= e * 512; const int kb = r / 32, nb = r % 32, n0 = nb * 64;
            const float* src = (up ? a.w_up : a.w_gate) + (size_t)e * DM * DFF;
            tr_item64_fp8(src, DFF, kb * 64, n0, WguT + (size_t)e * 4096 * DM, (size_t)(n0 / 128) * 256 + (n0 % 128) + up * 128, DM, pg8::W_PRESCALE, scr, F.lane); continue; } r -= 2 * I_G;
        if (r < I_D) { const int e = r / 512; r -= e * 512; const int kb = r / 16, nb = r % 16;
            tr_item64_fp8(a.w_down + (size_t)e * DFF * DM, DM, kb * 64, nb * 64, WdT + (size_t)e * DM * DFF, nb * 64, DFF, pg8::W_PRESCALE, scr, F.lane); continue; } r -= I_D;
        tr_item64(a.w_in, DIN, r * 64, 2048 - 48, WgT, 0, DM, scr, F.lane);
    }
}

DI void p1_phase(const Ctx& F, const Args& a) {
    const int gw = F.bid * NWAVES + F.wave, NGW = F.G * NWAVES;
    const float* mod = (const float*)(a.ws + WS_MOD);
    bf16_t* H1 = (bf16_t*)a.out;
    for (int m0 = gw; m0 < MTOK; m0 += 2 * NGW) {
        const int m1 = m0 + NGW; const bool has1 = m1 < MTOK;
        const f32x4* xr0 = (const f32x4*)(a.x + (size_t)m0 * DM) + F.lane; const f32x4* xr1 = (const f32x4*)(a.x + (size_t)(has1 ? m1 : m0) * DM) + F.lane;
        f32x4 v0[4], v1[4]; float s0 = 0.f, s1 = 0.f;
#pragma unroll
        for (int j = 0; j < 4; ++j) { v0[j] = __builtin_nontemporal_load(xr0 + 64 * j); v1[j] = __builtin_nontemporal_load(xr1 + 64 * j); }
#pragma unroll
        for (int j = 0; j < 4; ++j) { s0 += (v0[j].x * v0[j].x + v0[j].y * v0[j].y) + (v0[j].z * v0[j].z + v0[j].w * v0[j].w); s1 += (v1[j].x * v1[j].x + v1[j].y * v1[j].y) + (v1[j].z * v1[j].z + v1[j].w * v1[j].w); }
#pragma unroll
        for (int o = 1; o < 64; o <<= 1) { s0 += __shfl_xor(s0, o); s1 += __shfl_xor(s1, o); }
        const float rstd0 = rsqrtf(s0 * (1.f / DM) + EPS), rstd1 = rsqrtf(s1 * (1.f / DM) + EPS);
        const int b0 = m0 / SEQ, b1 = (has1 ? m1 : m0) / SEQ;
        u32x2* o0 = (u32x2*)(H1 + (size_t)m0 * DM) + F.lane; u32x2* o1 = (u32x2*)(H1 + (size_t)m1 * DM) + F.lane;
#pragma unroll
        for (int j = 0; j < 4; ++j) {
            const f32x4 g = ((const f32x4*)a.norm1_g)[F.lane + 64 * j];
            { const f32x4 sh = ((const f32x4*)(mod + (size_t)b0 * 6144))[F.lane + 64 * j], sc = ((const f32x4*)(mod + (size_t)b0 * 6144 + 1024))[F.lane + 64 * j];
              const f32x4 h = v0[j] * rstd0 * g * (sc + 1.f) + sh; u32x2 w; w.x = pk2(h.x, h.y); w.y = pk2(h.z, h.w); o0[64 * j] = w; }
            if (has1) { const f32x4 sh = ((const f32x4*)(mod + (size_t)b1 * 6144))[F.lane + 64 * j], sc = ((const f32x4*)(mod + (size_t)b1 * 6144 + 1024))[F.lane + 64 * j];
              const f32x4 h = v1[j] * rstd1 * g * (sc + 1.f) + sh; u32x2 w; w.x = pk2(h.x, h.y); w.y = pk2(h.z, h.w); o1[64 * j] = w; }
        }
    }
}

DI void gates_tasks(const Ctx& F, const Args& a) {
    const int gw = F.bid * NWAVES + F.wave, NGW = F.G * NWAVES;
    const bf16_t* H1 = (const bf16_t*)a.out; const bf16_t* WgT = (const bf16_t*)(a.ws + WS_WGT) + 48 * DM; float* GT = (float*)(a.ws + WS_GATES);
    const float bias = a.gate_b[F.lane & 15];
    for (int task = gw; task < MTOK / 16; task += NGW) {
        const int row0 = task * 16;
        const bf16_t* ap = H1 + (size_t)(row0 + (F.lane & 15)) * DM + 8 * (F.lane >> 4);
        const bf16_t* bp = WgT + (size_t)(F.lane & 15) * DM + 8 * (F.lane >> 4);
        f32x4 acc = {0.f, 0.f, 0.f, 0.f};
#pragma unroll 8
        for (int i = 0; i < 32; ++i) { const bf16x8 av = *(const bf16x8*)(ap + 32 * i), bv = *(const bf16x8*)(bp + 32 * i); acc = __builtin_amdgcn_mfma_f32_16x16x32_bf16(av, bv, acc, 0, 0, 0); }
#pragma unroll
        for (int r = 0; r < 4; ++r) GT[(size_t)(row0 + (F.lane >> 4) * 4 + r) * 16 + (F.lane & 15)] = acc[r] + bias;
    }
}

DI void qk_tile_task(const Ctx& F, const Args& a, int task) {
    const int b = task >> 6, tile = task & 63, r = F.lane, g = F.wave, h = g >> 1, p = g & 1;
    bf16_t* PROJ = (bf16_t*)(a.ws + WS_PROJ);
    const size_t tok = (size_t)b * SEQ + tile * 64 + r;
    float invf[8];
#pragma unroll
    for (int i = 0; i < 8; ++i) invf[i] = exp2f(-(float)i * 0.125f * 18.931568569324174f) * 0.15915494309189535f;
    const float pos = (float)a.pos[tok];
    float sn[8], cs[8];
#pragma unroll
    for (int i = 0; i < 8; ++i) { const float fr = __builtin_amdgcn_fractf(pos * invf[i]); sn[i] = __builtin_amdgcn_sinf(fr); cs[i] = __builtin_amdgcn_cosf(fr); }
#pragma unroll 1
    for (int isk = 0; isk < 2; ++isk) {
        u32x4* src = (u32x4*)(PROJ + tok * PS + (isk ? C_KA : C_QA) + g * 64);
        u32x4 w[8];
#pragma unroll
        for (int c = 0; c < 8; ++c) w[c] = src[c];
        float ss = 0.f;
#pragma unroll
        for (int c = 0; c < 8; ++c) { float t;
            t = bflo(w[c].x); ss += t * t; t = bfhi(w[c].x); ss += t * t; t = bflo(w[c].y); ss += t * t; t = bfhi(w[c].y); ss += t * t;
            t = bflo(w[c].z); ss += t * t; t = bfhi(w[c].z); ss += t * t; t = bflo(w[c].w); ss += t * t; t = bfhi(w[c].w); ss += t * t; }
        const float rstd = rsqrtf(ss * (1.f / 64.f) + EPS) * (isk ? 1.f : 0.125f * 1.4426950408889634f);
        const float* gp = a.qk_g + isk * 64;
        float v0[16];
        v0[0] = bflo(w[0].x); v0[1] = bfhi(w[0].x); v0[2] = bflo(w[0].y); v0[3] = bfhi(w[0].y); v0[4] = bflo(w[0].z); v0[5] = bfhi(w[0].z); v0[6] = bflo(w[0].w); v0[7] = bfhi(w[0].w);
        v0[8] = bflo(w[1].x); v0[9] = bfhi(w[1].x); v0[10] = bflo(w[1].y); v0[11] = bfhi(w[1].y); v0[12] = bflo(w[1].z); v0[13] = bfhi(w[1].z); v0[14] = bflo(w[1].w); v0[15] = bfhi(w[1].w);
#pragma unroll
        for (int i = 0; i < 16; ++i) v0[i] *= rstd * gp[i];
        float rr[16];
#pragma unroll
        for (int i = 0; i < 8; ++i) { rr[i] = v0[i] * cs[i] - v0[i + 8] * sn[i]; rr[i + 8] = v0[i + 8] * cs[i] + v0[i] * sn[i]; }
        u32x4 o[8];
        o[0].x = pk2(rr[0], rr[1]); o[0].y = pk2(rr[2], rr[3]); o[0].z = pk2(rr[4], rr[5]); o[0].w = pk2(rr[6], rr[7]);
        o[1].x = pk2(rr[8], rr[9]); o[1].y = pk2(rr[10], rr[11]); o[1].z = pk2(rr[12], rr[13]); o[1].w = pk2(rr[14], rr[15]);
#pragma unroll
        for (int c = 2; c < 8; ++c) { const f32x4 g0 = *(const f32x4*)(gp + c * 8), g1 = *(const f32x4*)(gp + c * 8 + 4);
            o[c].x = pk2(bflo(w[c].x) * rstd * g0.x, bfhi(w[c].x) * rstd * g0.y); o[c].y = pk2(bflo(w[c].y) * rstd * g0.z, bfhi(w[c].y) * rstd * g0.w);
            o[c].z = pk2(bflo(w[c].z) * rstd * g1.x, bfhi(w[c].z) * rstd * g1.y); o[c].w = pk2(bflo(w[c].w) * rstd * g1.z, bfhi(w[c].w) * rstd * g1.w); }
        if (isk == 0) {
#pragma unroll
            for (int c = 0; c < 8; ++c) src[c] = o[c];
        } else {
            u32x4* dst = (u32x4*)((bf16_t*)(a.ws + WS_KIMG) + ((size_t)((b * 4 + h) * 64 + tile)) * 8192) + r;
#pragma unroll
            for (int c = 0; c < 8; ++c) dst[(p * 8 + c) * 64] = o[c];
        }
    }
    {
        u32x4* dst = (u32x4*)((bf16_t*)(a.ws + WS_VIMG) + ((size_t)((b * 4 + h) * 64 + tile)) * 8192) + r;
#pragma unroll
        for (int cg = 2 * p; cg < 2 * p + 2; ++cg)
#pragma unroll
            for (int kg = 0; kg < 4; ++kg) {
                const u32x4 v = *(const u32x4*)(PROJ + ((size_t)b * SEQ + tile * 64 + 16 * kg + (r >> 2)) * PS + C_VA + h * 128 + 32 * cg + 8 * (r & 3));
                dst[(cg * 4 + kg) * 64] = v; }
    }
}

DI bf16x8 tr_frag_nat(const LAS unsigned char* img, int rowbase, int col0, int lane) {
    const int hh = lane >> 5, g16 = (lane >> 4) & 1, i = lane & 15;
    const int col = col0 + 16 * g16 + 4 * (i & 3), chunk = col >> 3, sub = (col & 7) * 2;
    const int r0 = rowbase + 8 * hh + (i >> 2), r1 = r0 + 4;
    const s16x4 lo = trread(img + r0 * 256 + ((chunk ^ swz16(r0)) << 4) + sub);
    const s16x4 hi = trread(img + r1 * 256 + ((chunk ^ swz16(r1)) << 4) + sub);
    return __builtin_shufflevector(lo, hi, 0, 1, 2, 3, 4, 5, 6, 7);
}
DI bf16x8 tr_frag_acc(const LAS unsigned char* img, int rowbase, int col0, int lane) {
    const int hh = lane >> 5, g16 = (lane >> 4) & 1, i = lane & 15;
    const int col = col0 + 16 * g16 + 4 * (i & 3), chunk = col >> 3, sub = (col & 7) * 2;
    const int r0 = rowbase + 4 * hh + (i >> 2), r1 = r0 + 8;
    const s16x4 lo = trread(img + r0 * 256 + ((chunk ^ swz16(r0)) << 4) + sub);
    const s16x4 hi = trread(img + r1 * 256 + ((chunk ^ swz16(r1)) << 4) + sub);
    return __builtin_shufflevector(lo, hi, 0, 1, 2, 3, 4, 5, 6, 7);
}
DI bf16x8 row_frag(const LAS unsigned char* img, int row, int chunk) { return *(const LAS bf16x8*)(img + row * 256 + ((chunk ^ swz16(row)) << 4)); }

DI void glds16_asm(const void* gsrc, unsigned lds_dst) { unsigned keep;
    asm volatile("s_mov_b32 %0, m0\n\ts_mov_b32 m0, %2\n\ts_nop 0\n\tglobal_load_lds_dwordx4 %1, off\n\ts_mov_b32 m0, %0" : "=&s"(keep) : "v"(gsrc), "s"(lds_dst) : "memory"); }
constexpr size_t DO_QC = 0, DO_KC = 32 * MiB, DO_HD = 64 * MiB;
constexpr size_t WS_SC = 7 * MiB;

DI void conv_task(const Ctx& F, const Args& a, int tw) {
    const int isk = tw & 1, tok0 = (tw >> 1) * 8, b = tok0 / SEQ, t0 = tok0 % SEQ, lane = F.lane;
    const bf16_t* src = (const bf16_t*)(a.ws + WS_PROJ) + (size_t)b * SEQ * PS + (isk ? C_KM : C_QM) + lane * 8;
    float cw[5][8];
#pragma unroll
    for (int j = 0; j < 5; ++j) { const f32x4 c0 = *(const f32x4*)(a.conv_w + j * 1024 + isk * 512 + lane * 8), c1 = *(const f32x4*)(a.conv_w + j * 1024 + isk * 512 + lane * 8 + 4);
        cw[j][0] = c0.x; cw[j][1] = c0.y; cw[j][2] = c0.z; cw[j][3] = c0.w; cw[j][4] = c1.x; cw[j][5] = c1.y; cw[j][6] = c1.z; cw[j][7] = c1.w; }
    u32x4 row[12];
#pragma unroll
    for (int r = 0; r < 12; ++r) { const int t = t0 + r - 2; row[r] = (u32x4){0u, 0u, 0u, 0u}; if (t >= 0 && t < SEQ) row[r] = *(const u32x4*)(src + (size_t)t * PS); }
    const int hd = lane >> 4, cc = lane & 15, cch = t0 >> 6, r0 = t0 & 63;
    bf16_t* tileb = (bf16_t*)((unsigned char*)a.out + (isk ? DO_KC : DO_QC)) + ((size_t)((b * 4 + hd) * 64 + cch)) * 8192;
    bf16_t* dst = isk ? tileb + ((cc >> 2) * 4 + (r0 >> 4)) * 512 + (r0 & 15) * 32 + (cc & 3) * 8 : tileb + cc * 512 + r0 * 8;
    const int dstride = isk ? 32 : 8;
    const float sc = isk ? 0.08838834764831845f : 1.f;
#pragma unroll
    for (int i = 0; i < 8; ++i) {
        float acc[8];
#pragma unroll
        for (int e = 0; e < 8; ++e) acc[e] = 0.f;
#pragma unroll
        for (int j = 0; j < 5; ++j) { const u32x4 w = row[i + j];
            acc[0] += bflo(w.x) * cw[j][0]; acc[1] += bfhi(w.x) * cw[j][1]; acc[2] += bflo(w.y) * cw[j][2]; acc[3] += bfhi(w.y) * cw[j][3];
            acc[4] += bflo(w.z) * cw[j][4]; acc[5] += bfhi(w.z) * cw[j][5]; acc[6] += bflo(w.w) * cw[j][6]; acc[7] += bfhi(w.w) * cw[j][7]; }
#pragma unroll
        for (int e = 0; e < 8; ++e) acc[e] = silu_f(acc[e]) * sc;
        u32x4 o; o.x = pk2(acc[0], acc[1]); o.y = pk2(acc[2], acc[3]); o.z = pk2(acc[4], acc[5]); o.w = pk2(acc[6], acc[7]);
        *(u32x4*)(dst + i * dstride) = o;
    }
}

DI void mscal_task(const Ctx& F, const Args& a, int chain) {
    const int b = chain >> 3, h = (chain >> 1) & 3, dir = chain & 1;
    const int s = dir ? 63 - F.lane : F.lane;
    const float* GT = (const float*)(a.ws + WS_GATES) + (size_t)b * SEQ * 16;
    float* SC = (float*)(a.ws + WS_SC) + (size_t)chain * 64 * 256; float* MSC = (float*)(a.ws + WS_MSC);
    LAS float* gl = (LAS float*)F.lds; LAS float* mll = gl + 64; LAS float* mpv = gl + 128; LAS float* mnw = gl + 192;
    float aa[8], ii[8];
#pragma unroll
    for (int i = 0; i < 8; ++i) { const int c = F.wave + 8 * i;
        const float ig = GT[(size_t)(c * 64 + s) * 16 + dir * 8 + h], fg = GT[(size_t)(c * 64 + s) * 16 + dir * 8 + 4 + h];
        const float av = wave_prefix_sum(logsigmoid_f(fg));
        aa[i] = av; ii[i] = ig;
        const float g = __builtin_bit_cast(float, __builtin_amdgcn_readlane(__builtin_bit_cast(int, av), 63)), ml = wave_max(g - av + ig);
        if (F.lane == 0) { gl[c] = g; mll[c] = ml; } }
    __syncthreads();
    if (F.tid == 0) { float m = 0.f;
        for (int st = 0; st < 64; ++st) { const int c = dir ? 63 - st : st; mpv[c] = m; const float mn = fmaxf(gl[c] + m, mll[c]); mnw[c] = mn; m = mn; } }
    __syncthreads();
#pragma unroll
    for (int i = 0; i < 8; ++i) { const int c = F.wave + 8 * i; const float mprev = mpv[c], mnew = mnw[c], g = gl[c];
        const float cterm = ii[i] - aa[i];
        const float cm = wave_prefix_max(cterm);
        const float il = aa[i] + mprev, mj = fmaxf(il, aa[i] + cm);
        float* o4 = SC + (size_t)c * 256 + s;
        o4[0] = (aa[i] - mj) * 1.4426950408889634f; o4[64] = cterm * 1.4426950408889634f; o4[128] = __expf(il - mj); o4[192] = __expf(-mj);
        if (F.lane == 0) { MSC[chain * 64 + c] = (g - mnew) * 1.4426950408889634f; MSC[4096 + chain * 64 + c] = __expf(g + mprev - mnew); } }
    __syncthreads();
}

DI void mseq_item(const Ctx& F, const Args& a, int bh, int dir, int vs) {
    const int b = bh >> 2, h = bh & 3, chain = bh * 2 + dir, wid = F.wave, tid = F.tid, lane = F.lane, r32 = lane & 31, hh = lane >> 5;
    LAS unsigned char* QS = F.lds;
    LAS unsigned char* KS = F.lds + 32768;
    LAS unsigned char* VS = F.lds + 65536;
    LAS unsigned char* SCS = F.lds + 81920;
    LAS unsigned char* SD = F.lds + 86016;
    LAS unsigned char* CI = F.lds + 102400;
    LAS float* NV = (LAS float*)(F.lds + 118784);
    LAS float* gmv = NV + 256; LAS float* spv = gmv + 64;
    LAS unsigned char* HST = F.lds + 120832;
    const bf16_t* QC = (const bf16_t*)((const unsigned char*)a.out + DO_QC) + (size_t)bh * 64 * 8192 + lane * 8;
    const bf16_t* KC = (const bf16_t*)((const unsigned char*)a.out + DO_KC) + (size_t)bh * 64 * 8192 + lane * 8;
    const bf16_t* VP = (const bf16_t*)(a.ws + WS_PROJ) + (size_t)b * SEQ * PS + C_VM + h * 128 + vs * 32 + (size_t)(16 * (wid & 3) + (lane >> 2)) * PS + 8 * (lane & 3);
    const float* SC = (const float*)(a.ws + WS_SC) + (size_t)chain * 64 * 256 + lane * 4;
    bf16_t* HD = (bf16_t*)((unsigned char*)a.out + DO_HD) + ((size_t)dir * MTOK + (size_t)b * SEQ) * 512 + h * 128 + vs * 32;
    if (tid < 64) { gmv[tid] = ((const float*)(a.ws + WS_MSC))[chain * 64 + tid]; spv[tid] = ((const float*)(a.ws + WS_MSC))[4096 + chain * 64 + tid]; }
    if (tid < 256) NV[tid] = 0.f;
    for (int i = tid; i < 4096; i += NTHR) ((LAS unsigned*)CI)[i] = 0u;
    const unsigned ldsb = (unsigned)(uintptr_t)F.lds;
#define MSEQ_ISSUE_QK(c, s2) do { const size_t _tb = (size_t)(c); \
        if (wid < 4) { _Pragma("unroll") for (int _i = 0; _i < 4; ++_i) \
                glds16_asm(QC + _tb * 8192 + (4 * wid + _i) * 512, (unsigned)__builtin_amdgcn_readfirstlane((int)(ldsb + (s2) * 16384 + (4 * wid + _i) * 1024))); } \
        else if (wid >= 6) { _Pragma("unroll") for (int _i = 0; _i < 8; ++_i) \
                glds16_asm(KC + _tb * 8192 + (8 * (wid - 6) + _i) * 512, (unsigned)__builtin_amdgcn_readfirstlane((int)(ldsb + 32768 + (s2) * 16384 + (8 * (wid - 6) + _i) * 1024))); } } while (0)
#define MSEQ_ISSUE_VS(c, s4) do { const size_t _tb = (size_t)(c); \
        if (wid < 4) glds16_asm(VP + _tb * 64 * PS, (unsigned)__builtin_amdgcn_readfirstlane((int)(ldsb + 65536 + (s4) * 4096 + wid * 1024))); \
        else if (wid == 6) glds16_asm(SC + _tb * 256, (unsigned)__builtin_amdgcn_readfirstlane((int)(ldsb + 81920 + (s4) * 1024))); } while (0)
    MSEQ_ISSUE_QK(dir ? 63 : 0, 0); MSEQ_ISSUE_VS(dir ? 63 : 0, 0); MSEQ_ISSUE_VS(dir ? 62 : 1, 1);
    f32x16 Cacc[2];
#pragma unroll
    for (int i = 0; i < 16; ++i) { Cacc[0][i] = 0.f; Cacc[1][i] = 0.f; }
    const int qrd = hh * 1024 + r32 * 16;
    const int ktr = (8 * hh + ((lane & 15) >> 2)) * 64 + ((lane >> 4) & 1) * 32 + (lane & 3) * 8;
    f32x16 acc;
    float qn = 0.f;
#pragma unroll
    for (int i = 0; i < 16; ++i) acc[i] = 0.f;
    asm volatile("s_waitcnt vmcnt(0)" ::: "memory");
    __syncthreads();
    unsigned long long busy = 0, tb0 = 0; if (PROBE_MSEQ_W >= 0) tb0 = __builtin_amdgcn_s_memtime(); const unsigned long long titem0 = tb0;
#pragma unroll 1
    for (int st = 0; st <= 64; ++st) {
        const int c = dir ? 63 - st : st, s2 = st & 1; const int s3 = st & 3, s3p = (st + 3) & 3;
        if (st + 1 < 64) MSEQ_ISSUE_QK(dir ? 62 - st : st + 1, s2 ^ 1);
        if (st + 2 < 64) MSEQ_ISSUE_VS(dir ? 61 - st : st + 2, (st + 2) & 3);
        const LAS unsigned char* QT = QS + s2 * 16384; const LAS unsigned char* KT = KS + s2 * 16384; const LAS unsigned char* VT = VS + s3 * 4096;
        const LAS float* rt = (const LAS float*)(SCS + s3 * 1024); const LAS float* ct = rt + 64;
        if (wid < 4) {
            if (st < 64) {
                const int jt = wid >> 1, stt = wid & 1;
                const LAS unsigned char* qa = QT + qrd + jt * 512;
                const LAS unsigned char* kb = KT + (2 * stt + (r32 >> 4)) * 1024 + (r32 & 15) * 64 + hh * 16;
                const int j = 32 * jt + r32; const float rtj = rt[j];
                const LAS float* ctp = ct + 32 * stt + 4 * hh;
                f32x4 c4[4];
#pragma unroll
                for (int rg = 0; rg < 4; ++rg) c4[rg] = *(const LAS f32x4*)(ctp + 8 * rg);
                const float gm = gmv[c], sp = spv[c];
                const int ck = 4 * wid + (lane & 3), r0 = 4 * (lane >> 2);
                const LAS unsigned char* kr = KT + (ck >> 2) * 4096 + (r0 >> 4) * 1024 + (r0 & 15) * 64 + (ck & 3) * 16;
                u32x4 kw[4];
#pragma unroll
                for (int r = 0; r < 4; ++r) kw[r] = *(const LAS u32x4*)(kr + r * 64);
                const f32x4 ctn = *(const LAS f32x4*)(ct + r0);
                const LAS float* no = NV + s2 * 128 + 32 * wid + 8 * (lane & 3);
                const f32x4 o0 = *(const LAS f32x4*)no, o1 = *(const LAS f32x4*)(no + 4);
                f32x16 S;
#pragma unroll
                for (int i = 0; i < 16; ++i) S[i] = 0.f;
#pragma unroll
                for (int ks = 0; ks < 8; ++ks) S = MFMA32(*(const LAS bf16x8*)(kb + (ks >> 1) * 4096 + (ks & 1) * 32), *(const LAS bf16x8*)(qa + ks * 2048), S);
                float pa[8];
#pragma unroll
                for (int e = 0; e < 8; ++e) pa[e] = 0.f;
#pragma unroll
                for (int r = 0; r < 4; ++r) { const u32x4 w = kw[r]; const float ws_ = __builtin_amdgcn_exp2f(ctn[r] + gm);
                    pa[0] += ws_ * bflo(w.x); pa[1] += ws_ * bfhi(w.x); pa[2] += ws_ * bflo(w.y); pa[3] += ws_ * bfhi(w.y); pa[4] += ws_ * bflo(w.z); pa[5] += ws_ * bfhi(w.z); pa[6] += ws_ * bflo(w.w); pa[7] += ws_ * bfhi(w.w); }
#pragma unroll
                for (int e = 0; e < 8; ++e) { float t = pa[e]; t += dpp_mov<DPP_ROR(8)>(t); t += dpp_mov<DPP_ROR(4)>(t); t = xor16_sum(t); pa[e] = xor32_sum(t); }
                u32x2 sw2[4];
#pragma unroll
                for (int rg = 0; rg < 4; ++rg) { float v[4];
#pragma unroll
                    for (int e = 0; e < 4; ++e) { const int sc = 32 * stt + 8 * rg + 4 * hh + e; const bool ok = dir == 0 ? (sc <= j) : (sc >= j);
                        v[e] = S[4 * rg + e] * __builtin_amdgcn_exp2f(ok ? rtj + c4[rg][e] : -1.0e30f); }
                    sw2[rg].x = pk2(v[0], v[1]); sw2[rg].y = pk2(v[2], v[3]); }
                LAS unsigned char* sw = SD + s2 * 8192 + stt * 4096 + j * 16 + hh * 8;
#pragma unroll
                for (int rg = 0; rg < 4; ++rg) *(LAS u32x2*)(sw + rg * 1024) = sw2[rg];
                if (lane < 4) { LAS float* nn = NV + (s2 ^ 1) * 128 + 32 * wid + 8 * lane;
                    *(LAS f32x4*)nn = (f32x4){sp * o0.x + pa[0], sp * o0.y + pa[1], sp * o0.z + pa[2], sp * o0.w + pa[3]};
                    *(LAS f32x4*)(nn + 4) = (f32x4){sp * o1.x + pa[4], sp * o1.y + pa[5], sp * o1.z + pa[6], sp * o1.w + pa[7]}; }
            }
        } else if (wid < 6) {
            const int jt = wid - 4, jl = 32 * jt + r32;
            u32x2 hw[4]; bool have_h = false; int cp = 0;
            if (st > 0) {
                cp = dir ? 64 - st : st - 1; have_h = true;
                const LAS float* iw = (const LAS float*)(SCS + s3p * 1024) + 128; const LAS float* enm = iw + 64;
                const LAS unsigned char* SDp = SD + (s2 ^ 1) * 8192;
                const LAS unsigned char* sr = SDp + hh * 4096 + jl * 16;
                u32x4 w4[4];
#pragma unroll
                for (int ch = 0; ch < 4; ++ch) w4[ch] = *(const LAS u32x4*)(sr + ch * 1024);
                const float iwj = iw[jl], enj = enm[jl];
                const LAS unsigned char* sa = SDp + qrd + jt * 512; const LAS unsigned char* vb = VS + s3p * 4096 + ktr;
                float rsum = 0.f;
#pragma unroll
                for (int ch = 0; ch < 4; ++ch) { const u32x4 w = w4[ch];
                    rsum += (bflo(w.x) + bfhi(w.x)) + (bflo(w.y) + bfhi(w.y)) + (bflo(w.z) + bfhi(w.z)) + (bflo(w.w) + bfhi(w.w)); }
                rsum = xor32_sum(rsum);
                const float den = rsum + iwj * qn;
                const float rdj = 1.f / fmaxf(fabsf(den), enj);
#pragma unroll
                for (int i = 0; i < 16; ++i) acc[i] *= iwj;
#pragma unroll
                for (int ks = 0; ks < 4; ++ks) { const s16x4 lo = trread(vb + ks * 1024), hi = trread(vb + ks * 1024 + 256);
                    acc = MFMA32(__builtin_shufflevector(lo, hi, 0, 1, 2, 3, 4, 5, 6, 7), *(const LAS bf16x8*)(sa + ks * 2048), acc); }
#pragma unroll
                for (int rg = 0; rg < 4; ++rg) { hw[rg].x = pk2(acc[4 * rg] * rdj, acc[4 * rg + 1] * rdj); hw[rg].y = pk2(acc[4 * rg + 2] * rdj, acc[4 * rg + 3] * rdj); }
            }
            if (st < 64) {
                const LAS unsigned char* qa = QT + qrd + jt * 512;
                const LAS unsigned char* cb = CI + s2 * 8192 + hh * 512 + r32 * 16;
                const LAS unsigned char* qr = QT + hh * 8192 + jl * 16; const LAS float* np = NV + s2 * 128 + 64 * hh;
#pragma unroll
                for (int i = 0; i < 16; ++i) acc[i] = 0.f;
#pragma unroll
                for (int ks = 0; ks < 8; ++ks) acc = MFMA32(*(const LAS bf16x8*)(cb + ks * 1024), *(const LAS bf16x8*)(qa + ks * 2048), acc);
                qn = 0.f;
#pragma unroll
                for (int ch = 0; ch < 8; ++ch) { const u32x4 w = *(const LAS u32x4*)(qr + ch * 1024); const f32x4 n0 = *(const LAS f32x4*)(np + ch * 8), n1 = *(const LAS f32x4*)(np + ch * 8 + 4);
                    qn += bflo(w.x) * n0.x + bfhi(w.x) * n0.y + bflo(w.y) * n0.z + bfhi(w.y) * n0.w + bflo(w.z) * n1.x + bfhi(w.z) * n1.y + bflo(w.w) * n1.z + bfhi(w.w) * n1.w; }
                qn = xor32_sum(qn);
            }
            if (have_h) {
                LAS unsigned char* hst = HST + jt * 2048;
#pragma unroll
                for (int rg = 0; rg < 4; ++rg) *(LAS u32x2*)(hst + r32 * 64 + (8 * rg + 4 * hh) * 2) = hw[rg];
                asm volatile("s_waitcnt lgkmcnt(0)" ::: "memory");
#pragma unroll
                for (int q = 0; q < 2; ++q) { const int row = 16 * q + (lane >> 2), part = lane & 3;
                    const u32x4 w = *(const LAS u32x4*)(hst + row * 64 + part * 16);
                    *(u32x4*)(HD + (size_t)(cp * 64 + 32 * jt + row) * 512 + part * 8) = w; }
            }
        } else if (st < 64) {
            const int u = wid - 6; const float gm = gmv[c], sp = spv[c];
            const LAS unsigned char* va = VT + ktr; const LAS unsigned char* ka = KT + ktr + (2 * u) * 4096;
            s16x4 vlo[4], vhi[4], k0l[4], k0h[4], k1l[4], k1h[4]; f32x4 cw0[4], cw1[4];
#pragma unroll
            for (int ks = 0; ks < 4; ++ks) { vlo[ks] = trread(va + ks * 1024); vhi[ks] = trread(va + ks * 1024 + 256);
                cw0[ks] = *(const LAS f32x4*)(ct + 16 * ks + 8 * hh); cw1[ks] = *(const LAS f32x4*)(ct + 16 * ks + 8 * hh + 4);
                k0l[ks] = trread(ka + ks * 1024); k0h[ks] = trread(ka + ks * 1024 + 256); k1l[ks] = trread(ka + 4096 + ks * 1024); k1h[ks] = trread(ka + 4096 + ks * 1024 + 256); }
#pragma unroll
            for (int i = 0; i < 16; ++i) { Cacc[0][i] *= sp; Cacc[1][i] *= sp; }
#pragma unroll
            for (int ks = 0; ks < 4; ++ks) {
                const s16x4 lo = vlo[ks], hi = vhi[ks]; const f32x4 e0 = cw0[ks], e1 = cw1[ks];
                u32x4 af;
                af.x = pk2(bf2f((bf16_t)lo[0]) * __builtin_amdgcn_exp2f(e0.x + gm), bf2f((bf16_t)lo[1]) * __builtin_amdgcn_exp2f(e0.y + gm));
                af.y = pk2(bf2f((bf16_t)lo[2]) * __builtin_amdgcn_exp2f(e0.z + gm), bf2f((bf16_t)lo[3]) * __builtin_amdgcn_exp2f(e0.w + gm));
                af.z = pk2(bf2f((bf16_t)hi[0]) * __builtin_amdgcn_exp2f(e1.x + gm), bf2f((bf16_t)hi[1]) * __builtin_amdgcn_exp2f(e1.y + gm));
                af.w = pk2(bf2f((bf16_t)hi[2]) * __builtin_amdgcn_exp2f(e1.z + gm), bf2f((bf16_t)hi[3]) * __builtin_amdgcn_exp2f(e1.w + gm));
                const bf16x8 afr = __builtin_bit_cast(bf16x8, af);
                Cacc[0] = MFMA32(__builtin_shufflevector(k0l[ks], k0h[ks], 0, 1, 2, 3, 4, 5, 6, 7), afr, Cacc[0]);
                Cacc[1] = MFMA32(__builtin_shufflevector(k1l[ks], k1h[ks], 0, 1, 2, 3, 4, 5, 6, 7), afr, Cacc[1]);
            }
            LAS unsigned char* cw = CI + (s2 ^ 1) * 8192 + (2 * u) * 2048 + r32 * 16 + hh * 8;
#pragma unroll
            for (int t2 = 0; t2 < 2; ++t2)
#pragma unroll
                for (int rg = 0; rg < 4; ++rg) { u32x2 w; w.x = pk2(Cacc[t2][4 * rg], Cacc[t2][4 * rg + 1]); w.y = pk2(Cacc[t2][4 * rg + 2], Cacc[t2][4 * rg + 3]); *(LAS u32x2*)(cw + t2 * 2048 + rg * 512) = w; }
        }
        if (PROBE_MSEQ_W >= 0) { asm volatile("s_waitcnt lgkmcnt(0)" ::: "memory"); busy += __builtin_amdgcn_s_memtime() - tb0; }
        if (st + 2 < 64) { if (wid < 4 || wid == 6) asm volatile("s_waitcnt vmcnt(1)" ::: "memory"); else if (wid == 7) asm volatile("s_waitcnt vmcnt(0)" ::: "memory"); }
        else if (wid < 4 || wid >= 6) asm volatile("s_waitcnt vmcnt(0)" ::: "memory");
        asm volatile("s_waitcnt lgkmcnt(0)" ::: "memory"); __builtin_amdgcn_s_barrier(); asm volatile("" ::: "memory");
        if (PROBE_MSEQ_W >= 0) tb0 = __builtin_amdgcn_s_memtime();
    }
    if (PROBE_MSEQ_W >= 0 && F.bid == 0 && lane == 0 && (wid == PROBE_MSEQ_W || (PROBE_MSEQ_W == 8 && wid == 0)))
        *(volatile LAS unsigned long long*)(F.lds + LDS_BYTES - 128) = (PROBE_MSEQ_W == 8) ? (__builtin_amdgcn_s_memtime() - titem0) : busy;
    asm volatile("s_waitcnt vmcnt(0)" ::: "memory");
#undef MSEQ_ISSUE_QK
#undef MSEQ_ISSUE_VS
}

DI void glds16(const void* g, LAS unsigned char* l) { __builtin_amdgcn_global_load_lds((const unsigned*)g, (LAS unsigned*)l, 16, 0, 0); }
DI void attn_unit(const Ctx& F, const Args& a, int b, int h, int qb, float lam, float cshift) {
    const int lane = F.lane, wid = F.wave, r32 = lane & 31, hh = lane >> 5, rg = wid & 3, p = wid >> 2;
    const bf16_t* projb = (const bf16_t*)(a.ws + WS_PROJ) + (size_t)b * SEQ * PS;
    const int qrow = qb * 128 + rg * 32 + r32;
    bf16x8 qf[4];
    { const bf16_t* qp = projb + (size_t)qrow * PS + C_QA + h * 128 + p * 64 + hh * 8;
#pragma unroll
      for (int ks = 0; ks < 4; ++ks) qf[ks] = *(const bf16x8*)(qp + ks * 16); }
    const bf16_t* kimg = (const bf16_t*)(a.ws + WS_KIMG) + (size_t)(b * 4 + h) * 64 * 8192 + (4 * wid) * 512 + lane * 8;
    const bf16_t* vimg = (const bf16_t*)(a.ws + WS_VIMG) + (size_t)(b * 4 + h) * 64 * 8192 + (4 * wid) * 512 + lane * 8;
    const unsigned ldsw = (unsigned)__builtin_amdgcn_readfirstlane((int)(unsigned)(uintptr_t)F.lds + (4 * wid) * 1024);
#define ATT_ISSUE2(img, t0, ldsoff) do { const int _q0 = 4 * wid; const int _t = (t0) + (_q0 >> 4); const bf16_t* _tp = (img) + (size_t)(_t < 64 ? _t : 63) * 8192 - (size_t)(_q0 & 16) * 512; \
        const unsigned _d = (unsigned)__builtin_amdgcn_readfirstlane((int)(ldsw + (ldsoff))); \
        _Pragma("unroll") for (int _i = 0; _i < 4; ++_i) glds16_asm(_tp + _i * 512, _d + _i * 1024); } while (0)
    if (wid < 4) { const bf16_t* _tp = kimg; const unsigned _d = (unsigned)__builtin_amdgcn_readfirstlane((int)(ldsw + 32768));
#pragma unroll
        for (int _i = 0; _i < 4; ++_i) glds16_asm(_tp + _i * 512, _d + _i * 1024); }
    ATT_ISSUE2(kimg, 1, 0); ATT_ISSUE2(vimg, 0, 65536);
    f32x16 O[4];
#pragma unroll
    for (int vt = 0; vt < 4; ++vt)
#pragma unroll
        for (int i = 0; i < 16; ++i) O[vt][i] = 0.f;
    float lsum = 0.f;
    const int kfb = p * 8192 + hh * 1024 + r32 * 16;
    const int vfb = (4 * hh + ((lane & 15) >> 2)) * 64 + ((lane >> 4) & 1) * 32 + (lane & 3) * 8;
    bf16x8 pb[4];
    asm volatile("s_waitcnt vmcnt(0)" ::: "memory");
    __syncthreads();
#define ATT_VLOAD(dst, Vb, kg) do { _Pragma("unroll") for (int vt = 0; vt < 4; ++vt) { \
        const s16x4 _lo = trread((Vb) + vt * 4096 + (kg) * 1024), _hi = trread((Vb) + vt * 4096 + (kg) * 1024 + 512); dst[vt] = __builtin_shufflevector(_lo, _hi, 0, 1, 2, 3, 4, 5, 6, 7); } } while (0)
#define ATT_PV(vf, kg) do { __builtin_amdgcn_s_setprio(1); _Pragma("unroll") for (int vt = 0; vt < 4; ++vt) O[vt] = MFMA32(vf[vt], pb[kg], O[vt]); __builtin_amdgcn_s_setprio(0); } while (0)
#define ATT_EXPQ(S, o, dst) do { float _e[8]; _Pragma("unroll") for (int i = 0; i < 8; ++i) _e[i] = __builtin_amdgcn_exp2f(S[(o) + i]); \
        _Pragma("unroll") for (int i = 0; i < 8; ++i) ls = ls + _e[i]; \
        u32x4 _w; _w.x = pk2(_e[0], _e[1]); _w.y = pk2(_e[2], _e[3]); _w.z = pk2(_e[4], _e[5]); _w.w = pk2(_e[6], _e[7]); dst = __builtin_bit_cast(bf16x8, _w); } while (0)
#define ATT_STEP(Kb, Vb, on0) do { \
        bf16x8 kfa[4], kfb2[4], vA[4], vB[4], pn[4]; float ls = 0.f; \
        _Pragma("unroll") for (int ks = 0; ks < 4; ++ks) { kfa[ks] = *(const LAS bf16x8*)((Kb) + ks * 2048); kfb2[ks] = *(const LAS bf16x8*)((Kb) + ks * 2048 + 512); } \
        ATT_VLOAD(vA, Vb, 0); \
        __builtin_amdgcn_s_setprio(1); \
        Sa = MFMA32(kfa[0], qf[0], negc); Sb = MFMA32(kfb2[0], qf[0], negc);        \
        _Pragma("unroll") for (int ks = 1; ks < 4; ++ks) { Sa = MFMA32(kfa[ks], qf[ks], Sa); Sb = MFMA32(kfb2[ks], qf[ks], Sb); } \
        __builtin_amdgcn_s_setprio(0); \
        ATT_VLOAD(vB, Vb, 1); ATT_PV(vA, 0); ATT_EXPQ(Sa, 0, pn[0]); \
        ATT_VLOAD(vA, Vb, 2); ATT_PV(vB, 1); ATT_EXPQ(Sa, 8, pn[1]); \
        ATT_VLOAD(vB, Vb, 3); ATT_PV(vA, 2); ATT_EXPQ(Sb, 0, pn[2]); \
        ATT_PV(vB, 3); ATT_EXPQ(Sb, 8, pn[3]); \
        lsum += (on0) ? ls : 0.f; \
        pb[0] = pn[0]; pb[1] = pn[1]; pb[2] = pn[2]; pb[3] = pn[3]; } while (0)
    f32x16 Sa, Sb, negc;
#pragma unroll
    for (int i = 0; i < 16; ++i) negc[i] = -cshift;
    asm volatile("" : "+v"(negc));
    {
        const LAS unsigned char* Kb = F.lds + 32768 + kfb;
        Sa = MFMA32(*(const LAS bf16x8*)(Kb), qf[0], negc); Sb = MFMA32(*(const LAS bf16x8*)(Kb + 512), qf[0], negc);
#pragma unroll
        for (int ks = 1; ks < 4; ++ks) { Sa = MFMA32(*(const LAS bf16x8*)(Kb + ks * 2048), qf[ks], Sa); Sb = MFMA32(*(const LAS bf16x8*)(Kb + ks * 2048 + 512), qf[ks], Sb); }
        float ls = 0.f;
        ATT_EXPQ(Sa, 0, pb[0]); ATT_EXPQ(Sa, 8, pb[1]); ATT_EXPQ(Sb, 0, pb[2]); ATT_EXPQ(Sb, 8, pb[3]);
        lsum += ls;
    }
    __syncthreads();
#pragma unroll 1
    for (int T = 0; T < 32; ++T) {
        const int j = T & 1;
        ATT_ISSUE2(kimg, 2 * T + 3, (j ^ 1) * 32768);
        ATT_ISSUE2(vimg, 2 * T + 2, 65536 + (j ^ 1) * 32768);
        const LAS unsigned char* Ks = F.lds + j * 32768 + kfb; const LAS unsigned char* Vs = F.lds + 65536 + j * 32768 + vfb;
        ATT_STEP(Ks, Vs, true);
        ATT_STEP(Ks + 16384, Vs + 16384, T < 31);
        asm volatile("s_waitcnt vmcnt(0)" ::: "memory");
        __syncthreads();
    }
#undef ATT_EXPQ
#undef ATT_STEP
#undef ATT_VLOAD
#undef ATT_PV
#undef ATT_ISSUE2
    lsum += __shfl_xor(lsum, 32);
    LAS float* X = (LAS float*)(F.lds + 65536) + rg * 4096 + r32;
    if (p == 1) {
        const float sc = lam / lsum;
#pragma unroll
        for (int vt = 0; vt < 4; ++vt)
#pragma unroll
            for (int i = 0; i < 16; ++i) X[(32 * vt + crow(i, hh)) * 32] = O[vt][i] * sc;
    }
    __syncthreads();
    if (p == 0) {
        const float i0 = 1.f / lsum;
        float ssq = 0.f;
#pragma unroll
        for (int vt = 0; vt < 4; ++vt)
#pragma unroll
            for (int i = 0; i < 16; ++i) { const float o = O[vt][i] * i0 - X[(32 * vt + crow(i, hh)) * 32]; O[vt][i] = o; ssq += o * o; }
        ssq += __shfl_xor(ssq, 32);
        const float rs = rsqrtf(ssq * (1.f / 128.f) + EPS) * 0.8f;
        bf16_t* yp = (bf16_t*)(a.ws + WS_YA) + (size_t)(b * SEQ + qrow) * 512 + h * 128;
#pragma unroll
        for (int vt = 0; vt < 4; ++vt)
#pragma unroll
            for (int rgi = 0; rgi < 4; ++rgi) { const int vd = 32 * vt + 8 * rgi + 4 * hh; const f32x4 g = *(const f32x4*)(a.subln_g + vd);
                u32x2 w; w.x = pk2(O[vt][4 * rgi] * rs * g.x, O[vt][4 * rgi + 1] * rs * g.y); w.y = pk2(O[vt][4 * rgi + 2] * rs * g.z, O[vt][4 * rgi + 3] * rs * g.w);
                *(u32x2*)(yp + vd) = w; }
    }
    __syncthreads();
}

DI void mcombine_phase(const Ctx& F, const Args& a) {
    const int gw = F.bid * NWAVES + F.wave, NGW = F.G * NWAVES, lane = F.lane;
    const bf16_t* HD = (const bf16_t*)((const unsigned char*)a.out + DO_HD);
    float g[8];
#pragma unroll
    for (int i = 0; i < 8; ++i) g[i] = a.mnorm_g[lane * 8 + i];
    for (int m = gw; m < MTOK; m += NGW) {
        const u32x4 f = *(const u32x4*)(HD + (size_t)m * 512 + lane * 8), bw = *(const u32x4*)(HD + ((size_t)MTOK + m) * 512 + lane * 8);
        const u32x4 om = *(const u32x4*)((const bf16_t*)(a.ws + WS_PROJ) + (size_t)m * PS + C_OM + lane * 8);
        const u32x4 ya = *(const u32x4*)((const bf16_t*)(a.ws + WS_YA) + (size_t)m * 512 + lane * 8);
        float v[8];
        v[0] = bflo(f.x) + bflo(bw.x); v[1] = bfhi(f.x) + bfhi(bw.x); v[2] = bflo(f.y) + bflo(bw.y); v[3] = bfhi(f.y) + bfhi(bw.y);
        v[4] = bflo(f.z) + bflo(bw.z); v[5] = bfhi(f.z) + bfhi(bw.z); v[6] = bflo(f.w) + bflo(bw.w); v[7] = bfhi(f.w) + bfhi(bw.w);
        float ss = 0.f;
#pragma unroll
        for (int i = 0; i < 8; ++i) ss += v[i] * v[i];
        ss += __shfl_xor(ss, 1); ss += __shfl_xor(ss, 2); ss += __shfl_xor(ss, 4); ss += __shfl_xor(ss, 8);
        const float rstd = rsqrtf(ss * (1.f / 128.f) + EPS);
        float o[8];
        o[0] = bflo(om.x); o[1] = bfhi(om.x); o[2] = bflo(om.y); o[3] = bfhi(om.y); o[4] = bflo(om.z); o[5] = bfhi(om.z); o[6] = bflo(om.w); o[7] = bfhi(om.w);
#pragma unroll
        for (int i = 0; i < 8; ++i) v[i] = v[i] * rstd * g[i] * sigmoid_f(o[i]);
        u32x4 w; w.x = pk2(v[0], v[1]); w.y = pk2(v[2], v[3]); w.z = pk2(v[4], v[5]); w.w = pk2(v[6], v[7]);
        bf16_t* yp = (bf16_t*)(a.ws + WS_YMIX) + (size_t)m * DM + lane * 8;
        *(u32x4*)yp = w; *(u32x4*)(yp + 512) = ya;
    }
}

DI void router_finish(const float (&lg)[16], int lane, float* affrow, bool store) {
    float r8[8];
#pragma unroll
    for (int i = 0; i < 8; ++i) { const float keep = hh_sel(lane, 32) ? lg[8 + i] : lg[i], send = hh_sel(lane, 32) ? lg[i] : lg[8 + i]; r8[i] = keep + partner32(send, lane); }
    float r4[4];
#pragma unroll
    for (int i = 0; i < 4; ++i) { const float keep = hh_sel(lane, 16) ? r8[4 + i] : r8[i], send = hh_sel(lane, 16) ? r8[i] : r8[4 + i]; r4[i] = keep + partner16(send, lane); }
    float r2[2];
#pragma unroll
    for (int i = 0; i < 2; ++i) { const float keep = hh_sel(lane, 8) ? r4[2 + i] : r4[i], send = hh_sel(lane, 8) ? r4[i] : r4[2 + i]; r2[i] = keep + partner8(send); }
    float lgt; { const float keep = hh_sel(lane, 4) ? r2[1] : r2[0], send = hh_sel(lane, 4) ? r2[0] : r2[1]; lgt = keep + partner4(send, lane); }
    lgt += dpp_mov<DPP_XOR2>(lgt); lgt += dpp_mov<DPP_XOR1>(lgt);
    float mx = lgt; mx = fmaxf(mx, dpp_mov<DPP_ROR(8)>(mx)); mx = fmaxf(mx, dpp_mov<DPP_ROR(4)>(mx)); mx = xor16_max(mx); mx = xor32_max(mx);
    const float ex = __expf(lgt - mx); float sm = ex; sm += dpp_mov<DPP_ROR(8)>(sm); sm += dpp_mov<DPP_ROR(4)>(sm); sm = xor16_sum(sm); sm = xor32_sum(sm);
    if ((lane & 3) == 0 && store) affrow[lane >> 2] = ex / sm;
}
DI void p7_phase(const Ctx& F, const Args& a) {
    LAS f32x4* WRL = (LAS f32x4*)F.lds;
    for (int q = F.tid; q < 4096; q += NTHR) { const int k = q >> 2, g = q & 3; WRL[(g * 4 + (k & 3)) * 256 + ((k >> 2) & 63) + 64 * (k >> 8)] = *(const f32x4*)(a.w_router + k * 16 + g * 4); }
    __syncthreads();
    const int gw = F.bid * NWAVES + F.wave, NGW = F.G * NWAVES, lane = F.lane;
    const float* mod = (const float*)(a.ws + WS_MOD);
    unsigned char* H2 = a.ws + WS_H2; float* AFF = (float*)(a.ws + WS_AFF);
    for (int m = gw; m < MTOK; m += NGW) {
        const int b = m / SEQ;
        const f32x4* xr = (const f32x4*)(a.out + (size_t)m * DM) + lane;
        f32x4 v[4]; float s = 0.f;
#pragma unroll
        for (int j = 0; j < 4; ++j) { v[j] = xr[64 * j]; s += (v[j].x * v[j].x + v[j].y * v[j].y) + (v[j].z * v[j].z + v[j].w * v[j].w); }
        const float rstd = rsqrtf(wave_sum(s) * (1.f / DM) + EPS);
        float lg[16];
#pragma unroll
        for (int e = 0; e < 16; ++e) lg[e] = 0.f;
        unsigned* o4 = (unsigned*)(H2 + (size_t)m * DM) + lane;
#pragma unroll
        for (int j = 0; j < 4; ++j) {
            const f32x4 g = ((const f32x4*)a.norm2_g)[lane + 64 * j];
            const f32x4 sh = ((const f32x4*)(mod + (size_t)b * 6144 + 3072))[lane + 64 * j];
            const f32x4 sc = ((const f32x4*)(mod + (size_t)b * 6144 + 4096))[lane + 64 * j];
            const f32x4 hv = v[j] * rstd * g * (sc + 1.f) + sh;
            o4[64 * j] = pg8::pk4_fp8(hv.x, hv.y, hv.z, hv.w);
#pragma unroll
            for (int e = 0; e < 4; ++e) { const float he = hv[e];
#pragma unroll
                for (int g4 = 0; g4 < 4; ++g4) { const f32x4 w = WRL[(g4 * 4 + e) * 256 + lane + 64 * j];
                    lg[g4 * 4 + 0] += he * w.x; lg[g4 * 4 + 1] += he * w.y; lg[g4 * 4 + 2] += he * w.z; lg[g4 * 4 + 3] += he * w.w; } }
            __builtin_amdgcn_sched_barrier(0);
        }
        router_finish(lg, lane, AFF + (size_t)m * 16, true);
    }
    __syncthreads();
}

DI void topk_task(const Ctx& F, const Args& a, int task) {
    const int b = task >> 4, e = task & 15, tid = F.tid, lane = F.lane;
    const float* AFF = (const float*)(a.ws + WS_AFF) + (size_t)b * SEQ * 16 + e;
    LAS unsigned* hist = (LAS unsigned*)F.lds;
    LAS unsigned* sfx = hist + 256;
    LAS unsigned* misc = hist + 512;
    LAS int* lidx = (LAS int*)(F.lds + 4096);
    unsigned key[8];
#pragma unroll
    for (int i = 0; i < 8; ++i) key[i] = __float_as_uint(AFF[(size_t)(tid * 8 + i) * 16]);
    unsigned prefix = 0, krem = CAP;
#pragma unroll 1
    for (int pass = 0; pass < 4; ++pass) {
        const int shift = 24 - 8 * pass;
        if (tid < 256) hist[tid] = 0;
        __syncthreads();
#pragma unroll
        for (int i = 0; i < 8; ++i) { const bool in = pass == 0 ? true : ((key[i] >> (shift + 8)) == (prefix >> (shift + 8))); if (in) atomicAdd((unsigned*)&hist[(key[i] >> shift) & 255u], 1u); }
        __syncthreads();
        if (tid < 256) sfx[tid] = hist[tid];
        __syncthreads();
#pragma unroll 1
        for (int o = 1; o < 256; o <<= 1) { unsigned v = 0; if (tid < 256) v = sfx[tid] + (tid + o < 256 ? sfx[tid + o] : 0u); __syncthreads(); if (tid < 256) sfx[tid] = v; __syncthreads(); }
        if (tid < 256) { const unsigned incl = sfx[tid], excl = incl - hist[tid]; if (excl < krem && krem <= incl) { misc[0] = (unsigned)tid; misc[1] = krem - excl; } }
        __syncthreads();
        prefix |= misc[0] << shift; krem = misc[1];
        __syncthreads();
    }
    const unsigned T = prefix, need = krem;
    unsigned cg_ = 0, ce = 0;
#pragma unroll
    for (int i = 0; i < 8; ++i) { cg_ += key[i] > T; ce += key[i] == T; }
    unsigned sg = cg_, se = ce;
#pragma unroll
    for (int o = 1; o < 64; o <<= 1) { const unsigned tg = __shfl_up(sg, o), te = __shfl_up(se, o); if (lane >= o) { sg += tg; se += te; } }
    if (lane == 63) { misc[16 + F.wave] = sg; misc[32 + F.wave] = se; }
    __syncthreads();
    unsigned og = sg - cg_, oe = se - ce;
    for (int w = 0; w < F.wave; ++w) { og += misc[16 + w]; oe += misc[32 + w]; }
    int* SLOT = (int*)(a.ws + WS_SLOT) + (size_t)b * SEQ * 16 + e;
    float* VALS = (float*)(a.ws + WS_VALS) + (size_t)(e * 8 + b) * CAP;
    int* IDX = (int*)(a.ws + WS_IDX) + (size_t)(b * 16 + e) * CAP;
#pragma unroll
    for (int i = 0; i < 8; ++i) {
        const bool gt = key[i] > T, eq = key[i] == T; const bool sel = gt || (eq && oe < need);
        const unsigned pos = og + (oe < need ? oe : need);
        const int s = tid * 8 + i;
        SLOT[(size_t)s * 16] = sel ? (int)pos : -1;
        if (sel) { lidx[pos] = s; IDX[pos] = s; VALS[pos] = __uint_as_float(key[i]); }
        og += gt; oe += eq;
    }
    __syncthreads();
    const unsigned char* H2 = a.ws + WS_H2 + (size_t)b * SEQ * DM; unsigned char* XE = a.ws + WS_XE + (size_t)(e * 8 + b) * CAP * DM;
    for (int r0 = F.wave * 4; r0 < CAP; r0 += NWAVES * 4) { u32x4 v[4];
#pragma unroll
        for (int j = 0; j < 4; ++j) v[j] = ((const u32x4*)(H2 + (size_t)lidx[r0 + j] * DM))[lane];
#pragma unroll
        for (int j = 0; j < 4; ++j) ((u32x4*)(XE + (size_t)(r0 + j) * DM))[lane] = v[j]; }
    __syncthreads();
}

DI void final_phase(const Ctx& F, const Args& a) {
    const int gw = F.bid * NWAVES + F.wave, NGW = F.G * NWAVES, lane = F.lane;
    const float* mod = (const float*)(a.ws + WS_MOD); const int* SLOT = (const int*)(a.ws + WS_SLOT); const unsigned char* Y = a.ws + WS_Y;
    for (int m = gw; m < MTOK; m += NGW) {
        const int b = m / SEQ;
        const int sl = SLOT[(size_t)m * 16 + (lane & 15)];
        f32x4* op = (f32x4*)(a.out + (size_t)m * DM + lane * 16);
        f32x4 xv[4];
#pragma unroll
        for (int q = 0; q < 4; ++q) xv[q] = op[q];
        float acc[16];
#pragma unroll
        for (int i = 0; i < 16; ++i) acc[i] = 0.f;
#pragma unroll 1
        for (int e = 0; e < 16; ++e) { const int s = __shfl(sl, e);
            if (s >= 0) { const u32x4 w = *(const u32x4*)(Y + ((size_t)(e * 8 + b) * CAP + s) * DM + lane * 16);
#pragma unroll
                for (int q = 0; q < 4; ++q) { const unsigned ww = w[q];
                    const auto lo = __builtin_amdgcn_cvt_pk_f32_fp8((int)ww, false), hi = __builtin_amdgcn_cvt_pk_f32_fp8((int)ww, true);
                    acc[4 * q] += lo[0]; acc[4 * q + 1] += lo[1]; acc[4 * q + 2] += hi[0]; acc[4 * q + 3] += hi[1]; } } }
        const f32x4* gp = (const f32x4*)(mod + (size_t)b * 6144 + 5120 + lane * 16);
#pragma unroll
        for (int q = 0; q < 4; ++q) { const f32x4 g = gp[q] * (1.f / pg8::Y_PRESCALE); f32x4 o = xv[q]; o.x += g.x * acc[4 * q]; o.y += g.y * acc[4 * q + 1]; o.z += g.z * acc[4 * q + 2]; o.w += g.w * acc[4 * q + 3]; op[q] = o; }
    }
}

constexpr size_t WS_CTL = 0;
constexpr int CTL_ZERO_BYTES = 65536;
#define XB_TMO      128
#define XB_XCNT(j)  (256  + 64 * (j))
#define XB_XSUB(j)  (1280 + 64 * (j))
#define XB_XGEN(j)  (2304 + 64 * (j))
#define XB_TOP      3328
#define XB_TOPGEN   3392
#define XB_SPIN_CAP (1u << 18)
DI unsigned xb_ld(unsigned* p)              { return __hip_atomic_load(p, __ATOMIC_RELAXED, __HIP_MEMORY_SCOPE_AGENT); }
DI unsigned xb_add(unsigned* p, unsigned v) { return __hip_atomic_fetch_add(p, v, __ATOMIC_RELAXED, __HIP_MEMORY_SCOPE_AGENT); }
DI unsigned xb_xcc_id() { return (unsigned)__builtin_amdgcn_s_getreg((3 << 11) | 20) & 0xFu; }
#define XB_SPIN(cond, bar) do { unsigned _sp = 0; while (cond) { __builtin_amdgcn_s_sleep(1); \
    if ((++_sp & 255u) == 0u) { if (xb_ld(&(bar)[XB_TMO])) break; if (_sp > XB_SPIN_CAP) { atomicAdd(&(bar)[XB_TMO], 1u); break; } } } } while (0)
struct XcdBarrier { unsigned* bar; unsigned x; volatile LAS unsigned* st; };
DI XcdBarrier xcd_barrier_post(unsigned* bar, volatile LAS unsigned* st) {
    XcdBarrier b; b.bar = bar; b.x = xb_xcc_id(); b.st = st;
    if (threadIdx.x == 0) (void)xb_add(&bar[XB_XCNT(b.x)], 1u);
    return b;
}
DI void xcd_barrier_complete(unsigned* bar, unsigned x, unsigned& nloc, unsigned& nx) {
    const unsigned G = gridDim.x * gridDim.y * gridDim.z;
    unsigned sum, cnt, mine, sp = 0u;
    for (;;) {
        sum = 0u; cnt = 0u; mine = 0u;
#pragma unroll
        for (unsigned j = 0; j < 16; ++j) { const unsigned c = xb_ld(&bar[XB_XCNT(j)]); sum += c; cnt += (c > 0u) ? 1u : 0u; mine = (j == x) ? c : mine; }
        if (sum == G) break;
        __builtin_amdgcn_s_sleep(1);
        if ((++sp & 255u) == 0u) { if (xb_ld(&bar[XB_TMO])) break; if (sp > XB_SPIN_CAP) { atomicAdd(&bar[XB_TMO], 1u); break; } }
    }
    nloc = mine > 0u ? mine : 1u; nx = cnt > 0u ? cnt : 1u;
}
DI void xcd_barrier(const XcdBarrier& b) {
    asm volatile("s_waitcnt vmcnt(0)" ::: "memory");
    __syncthreads();
    if (threadIdx.x == 0) {
        unsigned* bar = b.bar;
        __builtin_amdgcn_s_waitcnt(0);
        unsigned nloc = b.st[0], nx = b.st[1];
        if (nloc == 0u) { xcd_barrier_complete(bar, b.x, nloc, nx); b.st[0] = nloc; b.st[1] = nx; }
        const unsigned old = xb_add(&bar[XB_XSUB(b.x)], 1u);
        const unsigned gen = old / nloc;
        if (old + 1u == (gen + 1u) * nloc) {
            __builtin_amdgcn_fence(__ATOMIC_RELEASE, "agent");
            asm volatile("s_waitcnt vmcnt(0)" ::: "memory");
            const unsigned og = xb_add(&bar[XB_TOP], 1u);
            const unsigned tg = og / nx;
            if (og + 1u == (tg + 1u) * nx) xb_add(&bar[XB_TOPGEN], 1u);
            else XB_SPIN(xb_ld(&bar[XB_TOPGEN]) == tg, bar);
            __builtin_amdgcn_fence(__ATOMIC_ACQUIRE, "agent");
            xb_add(&bar[XB_XGEN(b.x)], 1u);
            asm volatile("s_waitcnt vmcnt(0)" ::: "memory");
        } else {
            XB_SPIN(xb_ld(&bar[XB_XGEN(b.x)]) == gen, bar);
            __builtin_amdgcn_fence(__ATOMIC_ACQUIRE, "agent");
            asm volatile("s_waitcnt vmcnt(0)" ::: "memory");
        }
    }
    __syncthreads();
}

static_assert(sizeof(Args) == 22 * 8, "Args layout");
__global__ void __launch_bounds__(NTHR, 2) fwd_kernel(Args a_unused) {
    extern __shared__ __attribute__((aligned(16))) unsigned char lds_raw[];
    cg::grid_group grid = cg::this_grid();
    Ctx F; F.lds = (LAS unsigned char*)lds_raw; F.tid = threadIdx.x; F.lane = F.tid & 63; F.wave = __builtin_amdgcn_readfirstlane(F.tid >> 6); F.G = gridDim.x; F.bid = blockIdx.x;

    int lo, hi; { typedef __attribute__((address_space(4))) const volatile unsigned long long* kp_t; const unsigned long long ph = ((kp_t)__builtin_amdgcn_kernarg_segment_ptr())[21]; lo = (int)(unsigned)ph; hi = (int)(unsigned)(ph >> 32); }
#ifndef PHASE_MASK
#define PHASE_MASK 0xffff
#endif
#define IN(k) (((PHASE_MASK >> (k)) & 1) && lo <= (k) && (k) < hi)
    volatile LAS unsigned* bst = (volatile LAS unsigned*)(F.lds + LDS_BYTES - 64);
    if (F.tid < 2) bst[F.tid] = 0u;
    __syncthreads();
    XcdBarrier xbar;
    { const Args a0 = load_args(); xbar = xcd_barrier_post((unsigned*)(a0.ws + WS_CTL), bst); }
    volatile LAS unsigned long long* tsl = (volatile LAS unsigned long long*)(F.lds + LDS_BYTES - 256);
    if (PROBE_PHASE >= 0 && F.bid == 0 && F.tid == 0) tsl[0] = __builtin_amdgcn_s_memrealtime();
#define SEAM(k) do { if (IN(k) && IN((k) + 1)) { if ((k) == 0) grid.sync(); else xcd_barrier(xbar); } \
        if (PROBE_PHASE >= 0 && F.bid == 0 && F.tid == 0) tsl[(k) + 1] = __builtin_amdgcn_s_memrealtime(); } while (0)
    if (IN(0)) { const Args a = load_args();
#pragma unroll 1
        for (int rep = 0; rep < REP_P0; ++rep) p0_phase(F, a); }
    SEAM(0);
    if (IN(1)) { const Args a = load_args(); p1_phase(F, a); }
    SEAM(1);
    if (IN(2)) {
        const Args a = load_args();
        pg8::Gemm g{(const bf16_t*)a.out, (const bf16_t*)(a.ws + WS_WINT), MTOK, PS, DM, 1 << 30}; pg8::StaticOrder S; S.init(MTOK, PS, F.G, F.bid);
        pg8::EpiProj E{(bf16_t*)(a.ws + WS_PROJ), a.pos, a.qk_g, (bf16_t*)(a.ws + WS_KIMG), (bf16_t*)(a.ws + WS_VIMG)};
        pg8::gemm_phase<pg8::EpiProj, true, true>(F.lds, g, S, E);
        gates_tasks(F, a);
    }
    SEAM(2);
    if (IN(3)) {
        const Args a = load_args();
        for (int t = F.bid * NWAVES + F.wave; t < MTOK / 8 * 2; t += F.G * NWAVES) conv_task(F, a, t);
        for (int t = F.bid; t < 64; t += F.G) mscal_task(F, a, t);
    }
    SEAM(3);
    if (IN(4)) {
        const Args a = load_args();
        {
#pragma unroll 1
            for (int rep = 0; rep < REP_MSEQ; ++rep)
#pragma unroll 1
            for (int it = F.bid; it < 256; it += F.G) { const int xcd_ = it & 7, j_ = it >> 3; mseq_item(F, a, xcd_ * 4 + (j_ >> 3), (j_ >> 2) & 1, j_ & 3); }
        }
        float lam, cshift;
        { const float p01 = wave_sum(a.lam_p[F.lane] * a.lam_p[64 + F.lane]), p23 = wave_sum(a.lam_p[128 + F.lane] * a.lam_p[192 + F.lane]);
          lam = __expf(p01) - __expf(p23) + 0.2f;
          const float gq = wave_max(fabsf(a.qk_g[F.lane])), gk = wave_max(fabsf(a.qk_g[64 + F.lane]));
          cshift = 8.f * gq * gk * 1.4426950408889634f * 1.02f; }
        const int xcd = F.bid & 7, j = F.bid >> 3;
#pragma unroll 1
        for (int rep = 0; rep < REP_ATT; ++rep)
        for (int i = 0; i * F.G < 1024; ++i) {
            int u;
            if (F.G == 256) u = (xcd * 4 + i) * 32 + j; else u = i * F.G + F.bid;
            if (u < 1024) attn_unit(F, a, u >> 7, (u >> 5) & 3, u & 31, lam, cshift);
        }
    }
    SEAM(4);
    if (IN(5)) { const Args a = load_args(); mcombine_phase(F, a); }
    SEAM(5);
    if (IN(6)) {
        const Args a = load_args();
        pg8::Gemm g{(const bf16_t*)(a.ws + WS_YMIX), (const bf16_t*)(a.ws + WS_WOUTT), MTOK, DM, DM, 1 << 30}; pg8::StaticOrder S; S.init(MTOK, DM, F.G, F.bid);
        pg8::EpiX1 E{a.x, (const float*)(a.ws + WS_MOD), a.out};
        pg8::gemm_phase<pg8::EpiX1, true, true>(F.lds, g, S, E);
    }
    SEAM(6);
    if (IN(7)) { const Args a = load_args();
#pragma unroll 1
        for (int rep = 0; rep < REP_P7; ++rep) p7_phase(F, a); }
    SEAM(7);
    if (IN(8)) { const Args a = load_args(); for (int t = F.bid; t < BATCH * NEXP; t += F.G) topk_task(F, a, t); }
    SEAM(8);
    if (IN(9)) {
        const Args a = load_args();
        pg8::Gemm g{(const bf16_t*)(a.ws + WS_XE), (const bf16_t*)(a.ws + WS_WGUT), NPAIR, 4096, DM, 16};
        pg8::StaticOrder S; S.init(NPAIR, 4096, F.G, F.bid);
        pg8::EpiGU E{a.ws + WS_HH};
#pragma unroll 1
        for (int rep = 0; rep < REP_UP; ++rep)
        pg8::gemm_phase<pg8::EpiGU, true, true, true>(F.lds, g, S, E);
    }
    SEAM(9);
    if (IN(10)) {
        const Args a = load_args();
        pg8::Gemm g{(const bf16_t*)(a.ws + WS_HH), (const bf16_t*)(a.ws + WS_WDT), NPAIR, DM, DFF, 16};
        pg8::StaticOrder S; S.init(NPAIR, DM, F.G, F.bid);
        pg8::EpiDown E{a.ws + WS_Y, (const float*)(a.ws + WS_VALS)};
        pg8::gemm_phase<pg8::EpiDown, true, true, true>(F.lds, g, S, E);
    }
    SEAM(10);
    if (IN(11)) { const Args a = load_args(); final_phase(F, a); }
    if (PROBE_MSEQ_W >= 0 && F.bid == 0 && F.tid == 0) {
        const unsigned long long d = *(volatile LAS unsigned long long*)(F.lds + LDS_BYTES - 128), t1 = __builtin_amdgcn_s_memtime();
        while (__builtin_amdgcn_s_memtime() - t1 < 3ull * d) __builtin_amdgcn_s_sleep(8);
    }
    if (PROBE_PHASE >= 0 && F.bid == 0 && F.tid == 0) {
        const unsigned long long t1 = __builtin_amdgcn_s_memrealtime();
        const unsigned long long d = (PROBE_PHASE == 11 ? t1 : tsl[PROBE_PHASE + 1]) - tsl[PROBE_PHASE];
        while (__builtin_amdgcn_s_memrealtime() - t1 < 3ull * d) __builtin_amdgcn_s_sleep(8);
    }
#undef IN
#undef SEAM
}

extern "C" void kernel_launch(void* const* d_in, const int* in_sizes, int n_in, void* d_out, int out_size, void* d_ws, size_t ws_size, hipStream_t stream) {
    static int grid_blocks = 0;
    if (!grid_blocks) {
        int dev = 0, cus = 0, per_cu = 0;
        (void)hipGetDevice(&dev);
        (void)hipDeviceGetAttribute(&cus, hipDeviceAttributeMultiprocessorCount, dev);
        (void)hipFuncSetAttribute((const void*)fwd_kernel, hipFuncAttributeMaxDynamicSharedMemorySize, LDS_BYTES);
        (void)hipOccupancyMaxActiveBlocksPerMultiprocessor(&per_cu, (const void*)fwd_kernel, NTHR, LDS_BYTES);
        if (per_cu < 1) per_cu = 1;
        grid_blocks = cus;
        if (ws_size < WS_END) fprintf(stderr, "kernel_launch: workspace too small: %zu < %zu\n", ws_size, (size_t)WS_END);
    }
    (void)hipMemsetAsync((char*)d_ws + WS_CTL, 0, CTL_ZERO_BYTES, stream);
    Args a{};
    a.x = (const float*)d_in[0]; a.c = (const float*)d_in[1]; a.pos = (const int*)d_in[2]; a.norm1_g = (const float*)d_in[3]; a.norm2_g = (const float*)d_in[4];
    a.w_ada = (const float*)d_in[5]; a.b_ada = (const float*)d_in[6]; a.w_in = (const float*)d_in[7]; a.conv_w = (const float*)d_in[8]; a.gate_b = (const float*)d_in[9];
    a.mnorm_g = (const float*)d_in[10]; a.qk_g = (const float*)d_in[11]; a.lam_p = (const float*)d_in[12]; a.subln_g = (const float*)d_in[13]; a.w_out = (const float*)d_in[14];
    a.w_router = (const float*)d_in[15]; a.w_gate = (const float*)d_in[16]; a.w_up = (const float*)d_in[17]; a.w_down = (const float*)d_in[18];
    a.out = (float*)d_out; a.ws = (unsigned char*)d_ws; a.ph_lo = 0; a.ph_hi = 12;
    void* args[] = {&a};
    hipError_t e = hipLaunchCooperativeKernel((const void*)fwd_kernel, dim3(grid_blocks), dim3(NTHR), args, LDS_BYTES, stream);
    if (e != hipSuccess) fprintf(stderr, "cooperative launch failed: %s (grid %d)\n", hipGetErrorString(e), grid_blocks);
}
```

```cpp
#include <hip/hip_runtime.h>
#include <hip/hip_cooperative_groups.h>
#include <cstdio>
#include <cstdint>
namespace cg = cooperative_groups;

#define LAS __attribute__((address_space(3)))
#define DI __device__ __forceinline__
typedef unsigned short bf16_t;
typedef short bf16x8 __attribute__((ext_vector_type(8)));
typedef short s16x4 __attribute__((ext_vector_type(4)));
typedef float f32x2 __attribute__((ext_vector_type(2)));
typedef float f32x4 __attribute__((ext_vector_type(4)));
typedef float f32x16 __attribute__((ext_vector_type(16)));
typedef unsigned u32x2 __attribute__((ext_vector_type(2)));
typedef unsigned u32x4 __attribute__((ext_vector_type(4)));
typedef __bf16 bf16x2_t __attribute__((ext_vector_type(2)));

constexpr int BATCH = 8, SEQ = 4096, DM = 1024, MTOK = BATCH * SEQ;
constexpr int DIN = 3600, PS = 3584;
constexpr int NEXP = 16, CAP = 512, DFF = 2048;
constexpr int NPAIR = BATCH * NEXP * CAP;
constexpr float EPS = 1e-6f;
constexpr int C_QM = 0, C_KM = 512, C_VM = 1024, C_OM = 1536, C_QA = 2048, C_KA = 2560, C_VA = 3072;

constexpr size_t MiB = 1u << 20;
constexpr size_t WS_MOD = 1 * MiB;
constexpr size_t WS_GATES = 2 * MiB;
constexpr size_t WS_AFF = 4 * MiB;
constexpr size_t WS_IDX = 6 * MiB;
constexpr size_t WS_VALS = 6 * MiB + 256 * 1024;
constexpr size_t WS_MSC = 6 * MiB + 512 * 1024;
constexpr size_t WS_SLOT = 7 * MiB;
constexpr size_t WS_NLOC = 9 * MiB;
constexpr size_t WS_WINT = 11 * MiB;
constexpr size_t WS_WGT = 18 * MiB;
constexpr size_t WS_WOUTT = 19 * MiB;
constexpr size_t WS_WGUT = 21 * MiB;
constexpr size_t WS_WDT = 85 * MiB;
constexpr size_t WS_Y = 117 * MiB;
constexpr size_t WS_PROJ = 213 * MiB;
constexpr size_t WS_YMIX = 437 * MiB;
constexpr size_t WS_KIMG = 437 * MiB;
constexpr size_t WS_VIMG = 469 * MiB;
constexpr size_t WS_YA = 501 * MiB;
constexpr size_t WS_HH = 245 * MiB;
constexpr size_t WS_H2 = 437 * MiB;
constexpr size_t WS_XE = 469 * MiB;
constexpr size_t WS_END = 533 * MiB;

constexpr int LDS_BYTES = 163840;
constexpr int PROBE_MSEQ_W = -1;
constexpr int PROBE_PHASE = -1;
constexpr int REP_M1 = 1, REP_M3 = 1, REP_UP = 1, REP_P0 = 1, REP_SCAN = 1, REP_P7 = 1, REP_ATT = 1, REP_QKT = 1, REP_MSEQ = 1;
constexpr int NWAVES = 8, NTHR = 512;

DI unsigned pk2(float lo, float hi) { f32x2 v = {lo, hi}; bf16x2_t b = __builtin_convertvector(v, bf16x2_t); return __builtin_bit_cast(unsigned, b); }
DI float bflo(unsigned w) { return __uint_as_float(w << 16); }
DI float bfhi(unsigned w) { return __uint_as_float(w & 0xffff0000u); }
DI float bf2f(bf16_t v) { return __uint_as_float((unsigned)v << 16); }
template <int CTRL> DI float dpp_mov(float x) { return __builtin_bit_cast(float, __builtin_amdgcn_update_dpp(0, __builtin_bit_cast(int, x), CTRL, 0xf, 0xf, false)); }
#define DPP_XOR1 0xB1
#define DPP_XOR2 0x4E
#define DPP_ROR(n) (0x120 + (n))
DI float xor16_sum(float x) { const unsigned u = __builtin_bit_cast(unsigned, x); auto r = __builtin_amdgcn_permlane16_swap(u, u, false, false); return __builtin_bit_cast(float, (unsigned)r[0]) + __builtin_bit_cast(float, (unsigned)r[1]); }
DI float xor32_sum(float x) { const unsigned u = __builtin_bit_cast(unsigned, x); auto r = __builtin_amdgcn_permlane32_swap(u, u, false, false); return __builtin_bit_cast(float, (unsigned)r[0]) + __builtin_bit_cast(float, (unsigned)r[1]); }
DI float xor16_max(float x) { const unsigned u = __builtin_bit_cast(unsigned, x); auto r = __builtin_amdgcn_permlane16_swap(u, u, false, false); return fmaxf(__builtin_bit_cast(float, (unsigned)r[0]), __builtin_bit_cast(float, (unsigned)r[1])); }
DI float xor32_max(float x) { const unsigned u = __builtin_bit_cast(unsigned, x); auto r = __builtin_amdgcn_permlane32_swap(u, u, false, false); return fmaxf(__builtin_bit_cast(float, (unsigned)r[0]), __builtin_bit_cast(float, (unsigned)r[1])); }
template <int CTRL, int RM, int BM_> DI float dpp_mov_m(float oldv, float x) { return __builtin_bit_cast(float, __builtin_amdgcn_update_dpp(__builtin_bit_cast(int, oldv), __builtin_bit_cast(int, x), CTRL, RM, BM_, false)); }
DI float wave_prefix_sum(float v) {
    v += dpp_mov_m<0x111, 0xf, 0xf>(0.f, v); v += dpp_mov_m<0x112, 0xf, 0xf>(0.f, v); v += dpp_mov_m<0x114, 0xf, 0xe>(0.f, v); v += dpp_mov_m<0x118, 0xf, 0xc>(0.f, v);
    v += dpp_mov_m<0x142, 0xa, 0xf>(0.f, v); v += dpp_mov_m<0x143, 0xc, 0xf>(0.f, v);
    return v;
}
DI float wave_prefix_max(float v) {
    const float ninf = -__builtin_inff();
    v = fmaxf(v, dpp_mov_m<0x111, 0xf, 0xf>(ninf, v)); v = fmaxf(v, dpp_mov_m<0x112, 0xf, 0xf>(ninf, v)); v = fmaxf(v, dpp_mov_m<0x114, 0xf, 0xe>(ninf, v)); v = fmaxf(v, dpp_mov_m<0x118, 0xf, 0xc>(ninf, v));
    v = fmaxf(v, dpp_mov_m<0x142, 0xa, 0xf>(ninf, v)); v = fmaxf(v, dpp_mov_m<0x143, 0xc, 0xf>(ninf, v));
    return v;
}
DI float partner32(float x, int lane) { const unsigned u = __builtin_bit_cast(unsigned, x); auto r = __builtin_amdgcn_permlane32_swap(u, u, false, false); return __builtin_bit_cast(float, (unsigned)((lane & 32) ? r[0] : r[1])); }
DI float partner16(float x, int lane) { const unsigned u = __builtin_bit_cast(unsigned, x); auto r = __builtin_amdgcn_permlane16_swap(u, u, false, false); return __builtin_bit_cast(float, (unsigned)((lane & 16) ? r[0] : r[1])); }
DI float partner8(float x) { return dpp_mov<DPP_ROR(8)>(x); }
DI float partner4(float x, int lane) { const float a = dpp_mov<DPP_ROR(4)>(x), b = dpp_mov<DPP_ROR(12)>(x); return (lane & 4) ? a : b; }
DI float row_sum16(float v) { v += dpp_mov<DPP_XOR1>(v); v += dpp_mov<DPP_XOR2>(v); v += dpp_mov<DPP_ROR(4)>(v); v += dpp_mov<DPP_ROR(8)>(v); return v; }
DI float wave_sum(float v) { v = row_sum16(v); v = xor16_sum(v); return xor32_sum(v); }
DI float wave_max(float v) { v = fmaxf(v, dpp_mov<DPP_XOR1>(v)); v = fmaxf(v, dpp_mov<DPP_XOR2>(v)); v = fmaxf(v, dpp_mov<DPP_ROR(4)>(v)); v = fmaxf(v, dpp_mov<DPP_ROR(8)>(v)); v = xor16_max(v); return xor32_max(v); }
DI float sigmoid_f(float v) { return __builtin_amdgcn_rcpf(1.f + __builtin_amdgcn_exp2f(-1.4426950408889634f * v)); }
DI float silu_f(float v) { return v * sigmoid_f(v); }
DI float logsigmoid_f(float f) { return fminf(f, 0.f) - log1pf(__expf(-fabsf(f))); }
DI int swz16(int row) { return ((row & 3) << 2) | ((row >> 2) & 3); }
#define MFMA32(a, b, c) __builtin_amdgcn_mfma_f32_32x32x16_bf16((a), (b), (c), 0, 0, 0)
DI s16x4 trread(const LAS unsigned char* p) { return __builtin_bit_cast(s16x4, __builtin_amdgcn_ds_read_tr16_b64_v4i16((LAS s16x4*)p)); }
DI int crow(int r, int hh) { return (r & 3) + 8 * (r >> 2) + 4 * hh; }
DI bool hh_sel(int lane, int bit) { return (lane & bit) != 0; }

namespace pg8 {
constexpr int BM = 256, BK = 64, HALF = 128, HTB = HALF * BK * 2, STAGE_BYTES = 8 * HTB, NXCD = 8, WGM = 8;
DI int lds_byte(int r, int c) { const int st = (r >> 4) * 2 + (c >> 5), rr = r & 15, cc = c & 31, ob = rr * 64 + cc * 2; return st * 1024 + (ob ^ (((ob >> 9) & 1) << 5)); }
DI void stage_rc(int b, int& R, int& C) { const int st = b / 1024, sb = b % 1024, swz = sb ^ (((sb >> 9) & 1) << 5); R = (st >> 1) * 16 + swz / 64; C = (st & 1) * 32 + (swz % 64) / 2; }
DI int perm32(int rho) { const int n = rho >> 4, i = rho & 15; return 8 * (i >> 2) + 4 * n + (i & 3); }
struct Unit { int pm, pn; };
typedef int i32x4_t __attribute__((ext_vector_type(4)));
typedef int i32x8_t __attribute__((ext_vector_type(8)));
DI i32x8_t cat8(bf16x8 lo, bf16x8 hi) { const i32x4_t a = __builtin_bit_cast(i32x4_t, lo), b = __builtin_bit_cast(i32x4_t, hi); return __builtin_shufflevector(a, b, 0, 1, 2, 3, 4, 5, 6, 7); }
struct Gemm { const bf16_t* A; const bf16_t* Bt; int M, N, K, tpg; };
struct StaticOrder {
    int nM, nN, nwg, G, c;
    DI void init(int M, int N, int G_, int c_) { nM = M / BM; nN = N / BM; nwg = nM * nN; G = G_; c = c_; }
    DI bool next(int i, Unit& u) const {
        const long L = (long)i * G + c; if (L >= nwg) return false;
        int wgid = (int)L; { const int q = nwg / NXCD, r = nwg % NXCD, xcd = wgid % NXCD, off = wgid / NXCD; wgid = (xcd < r ? xcd * (q + 1) : r * (q + 1) + (xcd - r) * q) + off; }
        const int nig = WGM * nN, gid = wgid / nig, fm = gid * WGM, gsz = (nM - fm) < WGM ? (nM - fm) : WGM;
        u.pm = fm + ((wgid % nig) % gsz); u.pn = (wgid % nig) / gsz; return true;
    }
};

template <class Epi, bool ALIGN_EPI, bool SP2, bool FP8 = false>
DI void gemm_phase(LAS unsigned char* lds, const Gemm g, const StaticOrder& S, const Epi& E) {
    const int tid = threadIdx.x, wid = __builtin_amdgcn_readfirstlane(tid >> 6), lane = tid & 63, wr = wid >> 2, wc = wid & 3, fr = lane & 15, fq = lane >> 4;
    const int KB = FP8 ? g.K : 2 * g.K, nt = KB / (BK * 2);
    unsigned voffA[2], voffB[2];
#pragma unroll
    for (int i = 0; i < 2; ++i) { int R, C; stage_rc(tid * 16 + i * 8192, R, C); const int Rb = Epi::PERM ? ((R & ~31) + perm32(R & 31)) : R;
        voffA[i] = (unsigned)(R * KB + C * 2); voffB[i] = (unsigned)(Rb * KB + C * 2); }
    const size_t kstep = (size_t)(BK * 2);
    const size_t hstep = (size_t)HALF * KB;
    const size_t tstep = 2 * hstep;
    const size_t gstep = (size_t)g.N * KB;
    const unsigned ldsw = (unsigned)wid * 1024u;
    const int aoff = lds_byte(wr * 64 + fr, fq * 8), boff = lds_byte(wc * 32 + fr, fq * 8);
#define PG8_SA(b, h) (((b) * 2 + (h)) * HTB)
#define PG8_SB(b, h) ((4 + (b) * 2 + (h)) * HTB)
#define PG8_STAGE(bufoff, gbase, voff) do { _Pragma("unroll") for (int _i = 0; _i < 2; ++_i) \
        __builtin_amdgcn_global_load_lds((const unsigned*)((const char*)(gbase) + (voff)[_i]), (LAS unsigned*)(lds + (bufoff) + ldsw + _i * 8192), 16, 0, 0); } while (0)
#define PG8_LDA(dst, b, h) do { if constexpr (FP8) { _Pragma("unroll") for (int m = 0; m < 4; ++m) dst##8[m] = cat8(*(const LAS bf16x8*)(lds + PG8_SA(b, h) + aoff + m * 2048), *(const LAS bf16x8*)(lds + PG8_SA(b, h) + aoff + m * 2048 + 1024)); } \
        else { _Pragma("unroll") for (int m = 0; m < 4; ++m) _Pragma("unroll") for (int k = 0; k < 2; ++k) dst[m][k] = *(const LAS bf16x8*)(lds + PG8_SA(b, h) + aoff + m * 2048 + k * 1024); } } while (0)
#define PG8_LDB(dst, b, h) do { if constexpr (FP8) { _Pragma("unroll") for (int n = 0; n < 2; ++n) dst##8[n] = cat8(*(const LAS bf16x8*)(lds + PG8_SB(b, h) + boff + n * 2048), *(const LAS bf16x8*)(lds + PG8_SB(b, h) + boff + n * 2048 + 1024)); } \
        else { _Pragma("unroll") for (int n = 0; n < 2; ++n) _Pragma("unroll") for (int k = 0; k < 2; ++k) dst[n][k] = *(const LAS bf16x8*)(lds + PG8_SB(b, h) + boff + n * 2048 + k * 1024); } } while (0)
#define PG8_MMA(ai, bj, At, Bt) do { __builtin_amdgcn_s_setprio(1); \
        if constexpr (FP8) { _Pragma("unroll") for (int m = 0; m < 4; ++m) _Pragma("unroll") for (int n = 0; n < 2; ++n) \
            asm volatile("s_nop 1\n\tv_mfma_f32_16x16x128_f8f6f4 %0, %1, %2, %0" : "+v"(acc[ai][bj][m][n]) : "v"(Bt##8[n]), "v"(At##8[m])); } \
        else { _Pragma("unroll") for (int m = 0; m < 4; ++m) _Pragma("unroll") for (int n = 0; n < 2; ++n) _Pragma("unroll") for (int k = 0; k < 2; ++k) \
            acc[ai][bj][m][n] = __builtin_amdgcn_mfma_f32_16x16x32_bf16(Bt[n][k], At[m][k], acc[ai][bj][m][n], 0, 0, 0); } \
        __builtin_amdgcn_s_setprio(0); } while (0)
#define PG8_WAIT_V(n) asm volatile("s_waitcnt vmcnt(" #n ")" ::: "memory")
#define PG8_WAIT_L(n) asm volatile("s_waitcnt lgkmcnt(" #n ")" ::: "memory")
#define PG8_BAR __builtin_amdgcn_s_barrier()
#define PG8_SCHED __builtin_amdgcn_sched_barrier(0)
    Unit cur, nxt; int ui = 0;
    if (!S.next(0, cur)) return;
    f32x4 acc[2][2][4][2];
#pragma unroll
    for (int a = 0; a < 2; ++a)
#pragma unroll
        for (int b = 0; b < 2; ++b)
#pragma unroll
            for (int m = 0; m < 4; ++m)
#pragma unroll
                for (int n = 0; n < 2; ++n) acc[a][b][m][n] = (f32x4){0.f, 0.f, 0.f, 0.f};
    bf16x8 At[4][2], B0[2][2], B1[2][2]; i32x8_t At8[4], B08[2], B18[2];
    const char* cA = (const char*)g.A + (size_t)cur.pm * tstep; const char* cB = (const char*)g.Bt + (size_t)(cur.pm / g.tpg) * gstep + (size_t)cur.pn * tstep;
    if constexpr (SP2) {
        PG8_STAGE(PG8_SB(0, 0), cB, voffB); PG8_STAGE(PG8_SB(0, 1), cB + hstep, voffB); PG8_STAGE(PG8_SA(0, 0), cA, voffA); PG8_STAGE(PG8_SA(0, 1), cA + hstep, voffA);
        if (wr == 1) PG8_BAR;
        PG8_WAIT_V(2); PG8_BAR;
        PG8_STAGE(PG8_SB(1, 0), cB + kstep, voffB); PG8_STAGE(PG8_SA(1, 0), cA + kstep, voffA); PG8_STAGE(PG8_SB(1, 1), cB + hstep + kstep, voffB);
        PG8_WAIT_V(6); PG8_BAR;
    } else {
        PG8_STAGE(PG8_SB(0, 0), cB, voffB); PG8_STAGE(PG8_SA(0, 0), cA, voffA); PG8_STAGE(PG8_SB(0, 1), cB + hstep, voffB); PG8_STAGE(PG8_SA(0, 1), cA + hstep, voffA);
        if (wr == 1) PG8_BAR;
        PG8_WAIT_V(4); PG8_BAR;
        PG8_STAGE(PG8_SB(1, 0), cB + kstep, voffB); PG8_STAGE(PG8_SA(1, 0), cA + kstep, voffA); PG8_STAGE(PG8_SB(1, 1), cB + hstep + kstep, voffB);
        PG8_WAIT_V(6); PG8_BAR;
    }
    for (;;) {
        const bool has_next = S.next(ui + 1, nxt);
        const char* nA = has_next ? (const char*)g.A + (size_t)nxt.pm * tstep : cA;
        const char* nB = has_next ? (const char*)g.Bt + (size_t)(nxt.pm / g.tpg) * gstep + (size_t)nxt.pn * tstep : cB;
        for (int t = 0; t < nt; t += 2) {
            const bool last = (t == nt - 2);
            const char* a1 = cA + (size_t)(t + 1) * kstep;
            const char* a2 = last ? nA : cA + (size_t)(t + 2) * kstep; const char* b2 = last ? nB : cB + (size_t)(t + 2) * kstep;
            const char* a3 = a2 + kstep; const char* b3 = b2 + kstep;
            if constexpr (SP2) {
            PG8_LDB(B0, 0, 0); PG8_LDB(B1, 0, 1); PG8_SCHED; PG8_LDA(At, 0, 0); PG8_STAGE(PG8_SA(1, 1), a1 + hstep, voffA);
            PG8_WAIT_V(8); PG8_WAIT_L(0); PG8_BAR; PG8_MMA(0, 0, At, B0); PG8_MMA(0, 1, At, B1); PG8_BAR; PG8_SCHED;
            PG8_LDA(At, 0, 1); PG8_STAGE(PG8_SB(0, 0), b2, voffB); PG8_STAGE(PG8_SB(0, 1), b2 + hstep, voffB); PG8_STAGE(PG8_SA(0, 0), a2, voffA);
            PG8_WAIT_V(8); PG8_WAIT_L(0); PG8_BAR; PG8_MMA(1, 0, At, B0); PG8_MMA(1, 1, At, B1); PG8_BAR; PG8_SCHED;
            PG8_LDB(B0, 1, 0); PG8_LDB(B1, 1, 1); PG8_SCHED; PG8_LDA(At, 1, 0); PG8_STAGE(PG8_SA(0, 1), a2 + hstep, voffA);
            PG8_WAIT_V(8); PG8_WAIT_L(0); PG8_BAR; PG8_MMA(0, 0, At, B0); PG8_MMA(0, 1, At, B1); PG8_BAR; PG8_SCHED;
            PG8_LDA(At, 1, 1); PG8_STAGE(PG8_SB(1, 0), b3, voffB); PG8_STAGE(PG8_SB(1, 1), b3 + hstep, voffB); PG8_STAGE(PG8_SA(1, 0), a3, voffA);
            PG8_WAIT_V(8); PG8_WAIT_L(0); PG8_BAR; PG8_MMA(1, 0, At, B0); PG8_MMA(1, 1, At, B1); PG8_BAR; PG8_SCHED;
            } else {
            PG8_LDB(B0, 0, 0); PG8_SCHED; PG8_LDA(At, 0, 0); PG8_STAGE(PG8_SA(1, 1), a1 + hstep, voffA);
            PG8_WAIT_L(8); PG8_BAR; PG8_WAIT_L(0); PG8_MMA(0, 0, At, B0); PG8_BAR; PG8_SCHED;
            PG8_LDB(B1, 0, 1); PG8_STAGE(PG8_SB(0, 0), b2, voffB);
            PG8_BAR; PG8_WAIT_L(0); PG8_MMA(0, 1, At, B1); PG8_BAR;
            PG8_LDA(At, 0, 1); PG8_STAGE(PG8_SA(0, 0), a2, voffA);
            PG8_BAR; PG8_WAIT_L(0); PG8_MMA(1, 0, At, B0); PG8_BAR; PG8_SCHED;
            PG8_STAGE(PG8_SB(0, 1), b2 + hstep, voffB);
            PG8_WAIT_V(6); PG8_BAR; PG8_MMA(1, 1, At, B1); PG8_BAR;
            PG8_LDB(B0, 1, 0); PG8_SCHED; PG8_LDA(At, 1, 0); PG8_STAGE(PG8_SA(0, 1), a2 + hstep, voffA);
            PG8_WAIT_L(8); PG8_BAR; PG8_WAIT_L(0); PG8_MMA(0, 0, At, B0); PG8_BAR; PG8_SCHED;
            PG8_LDB(B1, 1, 1); PG8_STAGE(PG8_SB(1, 0), b3, voffB);
            PG8_BAR; PG8_WAIT_L(0); PG8_MMA(0, 1, At, B1); PG8_BAR;
            PG8_LDA(At, 1, 1); PG8_STAGE(PG8_SA(1, 0), a3, voffA);
            PG8_BAR; PG8_WAIT_L(0); PG8_MMA(1, 0, At, B0); PG8_BAR; PG8_SCHED;
            PG8_STAGE(PG8_SB(1, 1), b3 + hstep, voffB);
            PG8_WAIT_V(6); PG8_BAR; PG8_MMA(1, 1, At, B1); PG8_BAR;
            }
        }
        if constexpr (ALIGN_EPI) { if (wr == 0) PG8_BAR; }
        if constexpr (FP8) asm volatile("s_nop 15\n\ts_nop 7" ::: "memory");
        E(acc, cur, wr, wc, fr, fq);
        if (!has_next) break;
#pragma unroll
        for (int a = 0; a < 2; ++a)
#pragma unroll
            for (int b = 0; b < 2; ++b)
#pragma unroll
                for (int m = 0; m < 4; ++m)
#pragma unroll
                    for (int n = 0; n < 2; ++n) acc[a][b][m][n] = (f32x4){0.f, 0.f, 0.f, 0.f};
        cur = nxt; cA = nA; cB = nB; ++ui;
        if constexpr (ALIGN_EPI) { if (wr == 1) PG8_BAR; }
    }
    PG8_WAIT_V(0);
    if constexpr (!ALIGN_EPI) { if (wr == 0) PG8_BAR; }
    PG8_BAR;
#undef PG8_SA
#undef PG8_SB
#undef PG8_STAGE
#undef PG8_LDA
#undef PG8_LDB
#undef PG8_MMA
#undef PG8_WAIT_V
#undef PG8_WAIT_L
#undef PG8_BAR
#undef PG8_SCHED
}

struct EpiBf16 {
    static constexpr bool PERM = true;
    bf16_t* O; int ldc;
    DI void operator()(const f32x4 (&acc)[2][2][4][2], const Unit& u, int wr, int wc, int fr, int fq) const {
        const int row0 = u.pm * BM + wr * 64 + fr, col0 = u.pn * BM + wc * 32 + 8 * fq;
#pragma unroll
        for (int ai = 0; ai < 2; ++ai)
#pragma unroll
            for (int m = 0; m < 4; ++m) { bf16_t* rowp = O + (size_t)(row0 + ai * HALF + m * 16) * ldc + col0;
#pragma unroll
                for (int bj = 0; bj < 2; ++bj) { const f32x4 v0 = acc[ai][bj][m][0], v1 = acc[ai][bj][m][1];
                    u32x4 w; w.x = pk2(v0[0], v0[1]); w.y = pk2(v0[2], v0[3]); w.z = pk2(v1[0], v1[1]); w.w = pk2(v1[2], v1[3]);
                    *(u32x4*)(rowp + bj * HALF) = w; } }
    }
};
struct EpiProj {
    static constexpr bool PERM = true;
    bf16_t* O; const int* pos; const float* qk_g; bf16_t* kimg; bf16_t* vimg;
    DI void operator()(const f32x4 (&acc)[2][2][4][2], const Unit& u, int wr, int wc, int fr, int fq) const {
        const int row0 = u.pm * BM + wr * 64 + fr;
        if (u.pn < 8) {
            const int col0 = u.pn * BM + wc * 32 + 8 * fq;
#pragma unroll
            for (int ai = 0; ai < 2; ++ai)
#pragma unroll
                for (int m = 0; m < 4; ++m) { bf16_t* rowp = O + (size_t)(row0 + ai * HALF + m * 16) * PS + col0;
#pragma unroll
                    for (int bj = 0; bj < 2; ++bj) { const f32x4 v0 = acc[ai][bj][m][0], v1 = acc[ai][bj][m][1];
                        u32x4 w; w.x = pk2(v0[0], v0[1]); w.y = pk2(v0[2], v0[3]); w.z = pk2(v1[0], v1[1]); w.w = pk2(v1[2], v1[3]);
                        *(u32x4*)(rowp + bj * HALF) = w; } }
        } else if (u.pn < 12) {
            const int isk = (u.pn >= 10), hsub = 4 * (u.pn & 1) + wc, h = hsub >> 1, p = hsub & 1;
            const float* gp = qk_g + isk * 64 + 8 * fq;
            const f32x4 g00 = *(const f32x4*)gp, g01 = *(const f32x4*)(gp + 4), g10 = *(const f32x4*)(gp + 32), g11 = *(const f32x4*)(gp + 36);
            const float qs = isk ? 1.f : 0.125f * 1.4426950408889634f;
            const int lane = fr + 16 * fq;
#pragma unroll
            for (int ai = 0; ai < 2; ++ai)
#pragma unroll
                for (int m = 0; m < 4; ++m) { const int row = row0 + ai * HALF + m * 16;
                    f32x4 a0 = acc[ai][0][m][0], a1 = acc[ai][0][m][1], b0 = acc[ai][1][m][0], b1 = acc[ai][1][m][1];
                    float ss = (a0[0] * a0[0] + a0[1] * a0[1] + a0[2] * a0[2] + a0[3] * a0[3]) + (a1[0] * a1[0] + a1[1] * a1[1] + a1[2] * a1[2] + a1[3] * a1[3])
                             + (b0[0] * b0[0] + b0[1] * b0[1] + b0[2] * b0[2] + b0[3] * b0[3]) + (b1[0] * b1[0] + b1[1] * b1[1] + b1[2] * b1[2] + b1[3] * b1[3]);
                    ss = xor16_sum(ss); ss = xor32_sum(ss);
                    const float rstd = rsqrtf(ss * (1.f / 64.f) + EPS);
                    a0 = a0 * rstd * g00; a1 = a1 * rstd * g01; b0 = b0 * rstd * g10 * qs; b1 = b1 * rstd * g11 * qs;
                    const float pf = (float)pos[row];
                    f32x4 r0, r1;
#pragma unroll
                    for (int n = 0; n < 2; ++n)
#pragma unroll
                        for (int j = 0; j < 4; ++j) { const int i = 4 * n + j; const float own = n ? a1[j] : a0[j]; const float oth = partner16(own, lane);
                            const float frc = __builtin_amdgcn_fractf(pf * (exp2f(-(float)i * 0.125f * 18.931568569324174f) * 0.15915494309189535f));
                            const float sn = __builtin_amdgcn_sinf(frc), cs = __builtin_amdgcn_cosf(frc);
                            const float rot = (fq == 0) ? own * cs - oth * sn : own * cs + oth * sn;
                            const float o = (fq < 2) ? rot : own;
                            if (n) r1[j] = o; else r0[j] = o; }
                    r0 = r0 * qs; r1 = r1 * qs;
                    u32x4 w0, w1;
                    w0.x = pk2(r0[0], r0[1]); w0.y = pk2(r0[2], r0[3]); w0.z = pk2(r1[0], r1[1]); w0.w = pk2(r1[2], r1[3]);
                    w1.x = pk2(b0[0], b0[1]); w1.y = pk2(b0[2], b0[3]); w1.z = pk2(b1[0], b1[1]); w1.w = pk2(b1[2], b1[3]);
                    if (!isk) { bf16_t* rowp = O + (size_t)row * PS + C_QA + h * 128 + p * 64 + 8 * fq; *(u32x4*)rowp = w0; *(u32x4*)(rowp + 32) = w1; }
                    else { const int b = row / SEQ, t = row % SEQ; bf16_t* kp = kimg + ((size_t)((b * 4 + h) * 64 + (t >> 6))) * 8192 + (p * 8 + fq) * 512 + (t & 63) * 8;
                        *(u32x4*)kp = w0; *(u32x4*)(kp + 4 * 512) = w1; } }
        } else {
#pragma unroll
            for (int ai = 0; ai < 2; ++ai)
#pragma unroll
                for (int m = 0; m < 4; ++m) { const int row = row0 + ai * HALF + m * 16, b = row / SEQ, t = row % SEQ;
#pragma unroll
                    for (int bj = 0; bj < 2; ++bj) { const int h = 2 * (u.pn - 12) + bj; const f32x4 v0 = acc[ai][bj][m][0], v1 = acc[ai][bj][m][1];
                        u32x4 w; w.x = pk2(v0[0], v0[1]); w.y = pk2(v0[2], v0[3]); w.z = pk2(v1[0], v1[1]); w.w = pk2(v1[2], v1[3]);
                        *(u32x4*)(vimg + ((size_t)((b * 4 + h) * 64 + (t >> 6))) * 8192 + (wc * 4 + ((t & 63) >> 4)) * 512 + (t & 15) * 32 + fq * 8) = w; } }
        }
    }
};
struct EpiX1 {
    static constexpr bool PERM = false;
    const float* x; const float* mod; float* out;
    DI void operator()(const f32x4 (&acc)[2][2][4][2], const Unit& u, int wr, int wc, int fr, int fq) const {
        const int row0 = u.pm * BM + wr * 64 + fr, col0 = u.pn * BM + wc * 32 + 4 * fq;
        const int b = (u.pm * BM) / SEQ;
        const float* gp = mod + (size_t)b * 6144 + 2048 + col0;
#pragma unroll
        for (int bj = 0; bj < 2; ++bj)
#pragma unroll
            for (int n = 0; n < 2; ++n) { const f32x4 gv = *(const f32x4*)(gp + bj * HALF + n * 16);
#pragma unroll
                for (int ai = 0; ai < 2; ++ai)
#pragma unroll
                    for (int m = 0; m < 4; ++m) { const size_t off = (size_t)(row0 + ai * HALF + m * 16) * DM + col0 + bj * HALF + n * 16;
                        const f32x4 xv = *(const f32x4*)(x + off); *(f32x4*)(out + off) = xv + gv * acc[ai][bj][m][n]; } }
    }
};
DI unsigned pk4_fp8(float a, float b, float c, float d) { int w = __builtin_amdgcn_cvt_pk_fp8_f32(a, b, 0, false); w = __builtin_amdgcn_cvt_pk_fp8_f32(c, d, w, true); return (unsigned)w; }
constexpr float W_PRESCALE = 32.f, H_PRESCALE = 8.f;
struct EpiGU {
    static constexpr bool PERM = true;
    unsigned char* H;
    DI void operator()(const f32x4 (&acc)[2][2][4][2], const Unit& u, int wr, int wc, int fr, int fq) const {
        const int row0 = u.pm * BM + wr * 64 + fr, col0 = u.pn * HALF + wc * 32 + 8 * fq;
#pragma unroll
        for (int ai = 0; ai < 2; ++ai)
#pragma unroll
            for (int m = 0; m < 4; ++m) { unsigned char* rowp = H + (size_t)(row0 + ai * HALF + m * 16) * DFF + col0;
                float hv[8];
#pragma unroll
                for (int n = 0; n < 2; ++n)
#pragma unroll
                    for (int j = 0; j < 4; ++j) { const float gg = acc[ai][0][m][n][j] * (1.f / W_PRESCALE), uu = acc[ai][1][m][n][j] * (H_PRESCALE / W_PRESCALE); hv[n * 4 + j] = gg * __builtin_amdgcn_rcpf(1.f + __builtin_amdgcn_exp2f(-1.4426950408889634f * gg)) * uu; }
                u32x2 w; w.x = pk4_fp8(hv[0], hv[1], hv[2], hv[3]); w.y = pk4_fp8(hv[4], hv[5], hv[6], hv[7]);
                *(u32x2*)rowp = w; }
    }
};
constexpr float Y_PRESCALE = 64.f;
struct EpiDown {
    static constexpr bool PERM = true;
    unsigned char* Y; const float* vals;
    DI void operator()(const f32x4 (&acc)[2][2][4][2], const Unit& u, int wr, int wc, int fr, int fq) const {
        const int row0 = u.pm * BM + wr * 64 + fr, col0 = u.pn * BM + wc * 32 + 8 * fq;
#pragma unroll
        for (int ai = 0; ai < 2; ++ai)
#pragma unroll
            for (int m = 0; m < 4; ++m) { const int row = row0 + ai * HALF + m * 16; const float s = vals[row] * (Y_PRESCALE / (W_PRESCALE * H_PRESCALE)); unsigned char* rowp = Y + (size_t)row * DM + col0;
#pragma unroll
                for (int bj = 0; bj < 2; ++bj) { const f32x4 v0 = acc[ai][bj][m][0] * s, v1 = acc[ai][bj][m][1] * s;
                    u32x2 w; w.x = pk4_fp8(v0[0], v0[1], v0[2], v0[3]); w.y = pk4_fp8(v1[0], v1[1], v1[2], v1[3]);
                    *(u32x2*)(rowp + bj * HALF) = w; } }
    }
};
}

struct Args {
    const float* x; const float* c; const int* pos; const float* norm1_g; const float* norm2_g; const float* w_ada; const float* b_ada;
    const float* w_in; const float* conv_w; const float* gate_b; const float* mnorm_g; const float* qk_g; const float* lam_p; const float* subln_g;
    const float* w_out; const float* w_router; const float* w_gate; const float* w_up; const float* w_down;
    float* out; unsigned char* ws; int ph_lo, ph_hi;
};
struct Ctx {
    LAS unsigned char* lds; int tid, lane, wave, G, bid;
};
DI Args load_args() {
    typedef __attribute__((address_space(4))) const volatile unsigned long long* kp_t;
    kp_t kp = (kp_t)__builtin_amdgcn_kernarg_segment_ptr();
#define GP(T, i) ((T*)(__attribute__((address_space(1))) T*)kp[i])
    Args a;
    a.x = GP(const float, 0); a.c = GP(const float, 1); a.pos = GP(const int, 2); a.norm1_g = GP(const float, 3); a.norm2_g = GP(const float, 4);
    a.w_ada = GP(const float, 5); a.b_ada = GP(const float, 6); a.w_in = GP(const float, 7); a.conv_w = GP(const float, 8); a.gate_b = GP(const float, 9);
    a.mnorm_g = GP(const float, 10); a.qk_g = GP(const float, 11); a.lam_p = GP(const float, 12); a.subln_g = GP(const float, 13); a.w_out = GP(const float, 14);
    a.w_router = GP(const float, 15); a.w_gate = GP(const float, 16); a.w_up = GP(const float, 17); a.w_down = GP(const float, 18);
    a.out = GP(float, 19); a.ws = GP(unsigned char, 20);
#undef GP
    a.ph_lo = 0; a.ph_hi = 12;
    return a;
}

DI void tr_item64(const float* src, size_t ld_src, int k0, int c0, bf16_t* dst, size_t r0, int ld_dst, LAS float* scr  , int lane, size_t r1 = (size_t)-1) {
    const float* sp = src + (size_t)(k0 + (lane >> 4)) * ld_src + c0 + (lane & 15) * 4;
#pragma unroll 1
    for (int hf = 0; hf < 2; ++hf) {
        f32x4 v[8];
#pragma unroll
        for (int i = 0; i < 8; ++i) v[i] = *(const f32x4*)(sp + (size_t)(4 * (8 * hf + i)) * ld_src);
#pragma unroll
        for (int i = 0; i < 8; ++i) *(LAS f32x4*)(scr + (4 * (8 * hf + i) + (lane >> 4)) * 68 + (lane & 15) * 4) = v[i];
    }
    asm volatile("s_waitcnt lgkmcnt(0)" ::: "memory");
    const int c = lane & 7;
#pragma unroll
    for (int q = 0; q < 8; ++q) { const int n = 8 * q + (lane >> 3); const LAS float* s = scr + (8 * c) * 68 + n;
        u32x4 o; o.x = pk2(s[0 * 68], s[1 * 68]); o.y = pk2(s[2 * 68], s[3 * 68]); o.z = pk2(s[4 * 68], s[5 * 68]); o.w = pk2(s[6 * 68], s[7 * 68]);
        const size_t row = (r1 != (size_t)-1 && q >= 4) ? r1 + (n - 32) : r0 + n;
        *(u32x4*)(dst + row * ld_dst + k0 + 8 * c) = o; }
    asm volatile("s_waitcnt lgkmcnt(0)" ::: "memory");
}
DI void tr_item64_fp8(const float* src, size_t ld_src, int k0, int c0, unsigned char* dst, size_t r0, int ld_dst, float scale, LAS float* scr  , int lane) {
    const float* sp = src + (size_t)(k0 + (lane >> 4)) * ld_src + c0 + (lane & 15) * 4;
    {
        f32x4 v[16];
#pragma unroll
        for (int i = 0; i < 16; ++i) v[i] = __builtin_nontemporal_load((const f32x4*)(sp + (size_t)(4 * i) * ld_src));
#pragma unroll
        for (int i = 0; i < 16; ++i) *(LAS f32x4*)(scr + (4 * i + (lane >> 4)) * 68 + (lane & 15) * 4) = v[i] * scale;
    }
    asm volatile("s_waitcnt lgkmcnt(0)" ::: "memory");
    const int c = lane & 3;
#pragma unroll
    for (int q = 0; q < 4; ++q) { const int n = 16 * q + (lane >> 2); const LAS float* s = scr + (16 * c) * 68 + n;
        u32x4 o; o.x = pg8::pk4_fp8(s[0 * 68], s[1 * 68], s[2 * 68], s[3 * 68]); o.y = pg8::pk4_fp8(s[4 * 68], s[5 * 68], s[6 * 68], s[7 * 68]);
        o.z = pg8::pk4_fp8(s[8 * 68], s[9 * 68], s[10 * 68], s[11 * 68]); o.w = pg8::pk4_fp8(s[12 * 68], s[13 * 68], s[14 * 68], s[15 * 68]);
        *(u32x4*)(dst + (r0 + n) * ld_dst + k0 + 16 * c) = o; }
    asm volatile("s_waitcnt lgkmcnt(0)" ::: "memory");
}
DI void p0_phase(const Ctx& F, const Args& a) {
    if (F.bid < 96) {
        LAS float* sc = (LAS float*)F.lds; LAS float* part = (LAS float*)(F.lds + 32768);
        for (int i = F.tid; i < BATCH * DM; i += NTHR) sc[i] = silu_f(a.c[i]);
        __syncthreads();
        const int col = F.bid * 64 + F.lane;
        float acc[8];
#pragma unroll
        for (int b = 0; b < 8; ++b) acc[b] = 0.f;
        const int kb = F.wave * 128;
#pragma unroll 1
        for (int k0 = kb; k0 < kb + 128; k0 += 16) {
            float w[16];
            const float* wp = a.w_ada + (size_t)k0 * 6144 + col;
#pragma unroll
            for (int j = 0; j < 16; ++j) w[j] = wp[(size_t)j * 6144];
#pragma unroll
            for (int j = 0; j < 16; ++j)
#pragma unroll
                for (int b = 0; b < 8; ++b) acc[b] += sc[b * DM + k0 + j] * w[j];
        }
#pragma unroll
        for (int b = 0; b < 8; ++b) part[(F.wave * 8 + b) * 64 + F.lane] = acc[b];
        __syncthreads();
        { const int b = F.tid >> 6, l = F.tid & 63; float s = a.b_ada[F.bid * 64 + l];
#pragma unroll
          for (int w = 0; w < 8; ++w) s += part[(w * 8 + b) * 64 + l];
          ((float*)(a.ws + WS_MOD))[b * 6144 + F.bid * 64 + l] = s; }
        __syncthreads();
    }
    LAS float* scr = (LAS float*)(F.lds + F.wave * 17408);
    const int gw = F.bid * NWAVES + F.wave, NGW = F.G * NWAVES;
    constexpr int I_IN = 16 * 56, I_OUT = 16 * 16, I_WG = 16, I_EX = 4096;
    constexpr int NITEMS = I_IN + I_OUT + I_EX + I_WG;
    bf16_t* WinT = (bf16_t*)(a.ws + WS_WINT); bf16_t* WgT = (bf16_t*)(a.ws + WS_WGT); bf16_t* WoutT = (bf16_t*)(a.ws + WS_WOUTT);
    for (int it = gw; it < NITEMS; it += NGW) {
        int r = it;
        if (r < I_IN) { const int kb = r / 56, nb = r % 56, n0 = nb * 64;
            if (n0 >= 2048 && n0 < 3072) { const int t0 = n0 & ~255, g = (n0 >> 6) & 3; tr_item64(a.w_in, DIN, kb * 64, n0 + 16, WinT, (size_t)(t0 + 32 * g), DM, scr, F.lane, (size_t)(t0 + 128 + 32 * g)); }
            else tr_item64(a.w_in, DIN, kb * 64, n0 + (n0 >= 2048 ? 16 : 0), WinT, n0, DM, scr, F.lane);
            continue; } r -= I_IN;
        if (r < I_OUT) { const int kb = r / 16, nb = r % 16; tr_item64(a.w_out, DM, kb * 64, nb * 64, WoutT, nb * 64, DM, scr, F.lane); continue; } r -= I_OUT;
        if (r < I_EX) { int e, mat, q;
            if (r < 1024) { e = 13; mat = 1 + (r >> 9); q = r & 511; } else { const int t = r - 1024; e = 14 + t / 1536; const int u = t % 1536; mat = u >> 9; q = u & 511; }
            if (mat < 2) { const int kb = q / 32, nb = q % 32, n0 = nb * 64; const float* src = (mat ? a.w_up : a.w_gate) + (size_t)e * DM * DFF;
                tr_item64_fp8(src, DFF, kb * 64, n0, a.ws + WS_WGUT + (size_t)e * 4096 * DM, (size_t)(n0 / 128) * 256 + (n0 % 128) + mat * 128, DM, pg8::W_PRESCALE, scr, F.lane); }
            else { const int kb = q / 16, nb = q % 16;
                tr_item64_fp8(a.w_down + (size_t)e * DFF * DM, DM, kb * 64, nb * 64, a.ws + WS_WDT + (size_t)e * DM * DFF, nb * 64, DFF, pg8::W_PRESCALE, scr, F.lane); }
            continue; } r -= I_EX;
        tr_item64(a.w_in, DIN, r * 64, 2048 - 48, WgT, 0, DM, scr, F.lane);
    }
}

DI void p1_phase(const Ctx& F, const Args& a) {
    const int gw = F.bid * NWAVES + F.wave, NGW = F.G * NWAVES;
    const float* mod = (const float*)(a.ws + WS_MOD);
    bf16_t* H1 = (bf16_t*)a.out;
    for (int m0 = gw; m0 < MTOK; m0 += 2 * NGW) {
        const int m1 = m0 + NGW; const bool has1 = m1 < MTOK;
        const f32x4* xr0 = (const f32x4*)(a.x + (size_t)m0 * DM) + F.lane; const f32x4* xr1 = (const f32x4*)(a.x + (size_t)(has1 ? m1 : m0) * DM) + F.lane;
        f32x4 v0[4], v1[4]; float s0 = 0.f, s1 = 0.f;
#pragma unroll
        for (int j = 0; j < 4; ++j) { v0[j] = __builtin_nontemporal_load(xr0 + 64 * j); v1[j] = __builtin_nontemporal_load(xr1 + 64 * j); }
#pragma unroll
        for (int j = 0; j < 4; ++j) { s0 += (v0[j].x * v0[j].x + v0[j].y * v0[j].y) + (v0[j].z * v0[j].z + v0[j].w * v0[j].w); s1 += (v1[j].x * v1[j].x + v1[j].y * v1[j].y) + (v1[j].z * v1[j].z + v1[j].w * v1[j].w); }
#pragma unroll
        for (int o = 1; o < 64; o <<= 1) { s0 += __shfl_xor(s0, o); s1 += __shfl_xor(s1, o); }
        const float rstd0 = rsqrtf(s0 * (1.f / DM) + EPS), rstd1 = rsqrtf(s1 * (1.f / DM) + EPS);
        const int b0 = m0 / SEQ, b1 = (has1 ? m1 : m0) / SEQ;
        u32x2* o0 = (u32x2*)(H1 + (size_t)m0 * DM) + F.lane; u32x2* o1 = (u32x2*)(H1 + (size_t)m1 * DM) + F.lane;
#pragma unroll
        for (int j = 0; j < 4; ++j) {
            const f32x4 g = ((const f32x4*)a.norm1_g)[F.lane + 64 * j];
            { const f32x4 sh = ((const f32x4*)(mod + (size_t)b0 * 6144))[F.lane + 64 * j], sc = ((const f32x4*)(mod + (size_t)b0 * 6144 + 1024))[F.lane + 64 * j];
              const f32x4 h = v0[j] * rstd0 * g * (sc + 1.f) + sh; u32x2 w; w.x = pk2(h.x, h.y); w.y = pk2(h.z, h.w); o0[64 * j] = w; }
            if (has1) { const f32x4 sh = ((const f32x4*)(mod + (size_t)b1 * 6144))[F.lane + 64 * j], sc = ((const f32x4*)(mod + (size_t)b1 * 6144 + 1024))[F.lane + 64 * j];
              const f32x4 h = v1[j] * rstd1 * g * (sc + 1.f) + sh; u32x2 w; w.x = pk2(h.x, h.y); w.y = pk2(h.z, h.w); o1[64 * j] = w; }
        }
    }
}

DI void gates_tasks(const Ctx& F, const Args& a) {
    const int gw = F.bid * NWAVES + F.wave, NGW = F.G * NWAVES;
    const bf16_t* H1 = (const bf16_t*)a.out; const bf16_t* WgT = (const bf16_t*)(a.ws + WS_WGT) + 48 * DM; float* GT = (float*)(a.ws + WS_GATES);
    const float bias = a.gate_b[F.lane & 15];
    for (int task = gw; task < MTOK / 16; task += NGW) {
        const int row0 = task * 16;
        const bf16_t* ap = H1 + (size_t)(row0 + (F.lane & 15)) * DM + 8 * (F.lane >> 4);
        const bf16_t* bp = WgT + (size_t)(F.lane & 15) * DM + 8 * (F.lane >> 4);
        f32x4 acc = {0.f, 0.f, 0.f, 0.f};
#pragma unroll 8
        for (int i = 0; i < 32; ++i) { const bf16x8 av = *(const bf16x8*)(ap + 32 * i), bv = *(const bf16x8*)(bp + 32 * i); acc = __builtin_amdgcn_mfma_f32_16x16x32_bf16(av, bv, acc, 0, 0, 0); }
#pragma unroll
        for (int r = 0; r < 4; ++r) GT[(size_t)(row0 + (F.lane >> 4) * 4 + r) * 16 + (F.lane & 15)] = acc[r] + bias;
    }
}

DI void qk_tile_task(const Ctx& F, const Args& a, int task) {
    const int b = task >> 6, tile = task & 63, r = F.lane, g = F.wave, h = g >> 1, p = g & 1;
    bf16_t* PROJ = (bf16_t*)(a.ws + WS_PROJ);
    const size_t tok = (size_t)b * SEQ + tile * 64 + r;
    float invf[8];
#pragma unroll
    for (int i = 0; i < 8; ++i) invf[i] = exp2f(-(float)i * 0.125f * 18.931568569324174f) * 0.15915494309189535f;
    const float pos = (float)a.pos[tok];
    float sn[8], cs[8];
#pragma unroll
    for (int i = 0; i < 8; ++i) { const float fr = __builtin_amdgcn_fractf(pos * invf[i]); sn[i] = __builtin_amdgcn_sinf(fr); cs[i] = __builtin_amdgcn_cosf(fr); }
#pragma unroll 1
    for (int isk = 0; isk < 2; ++isk) {
        u32x4* src = (u32x4*)(PROJ + tok * PS + (isk ? C_KA : C_QA) + g * 64);
        u32x4 w[8];
#pragma unroll
        for (int c = 0; c < 8; ++c) w[c] = src[c];
        float ss = 0.f;
#pragma unroll
        for (int c = 0; c < 8; ++c) { float t;
            t = bflo(w[c].x); ss += t * t; t = bfhi(w[c].x); ss += t * t; t = bflo(w[c].y); ss += t * t; t = bfhi(w[c].y); ss += t * t;
            t = bflo(w[c].z); ss += t * t; t = bfhi(w[c].z); ss += t * t; t = bflo(w[c].w); ss += t * t; t = bfhi(w[c].w); ss += t * t; }
        const float rstd = rsqrtf(ss * (1.f / 64.f) + EPS) * (isk ? 1.f : 0.125f * 1.4426950408889634f);
        const float* gp = a.qk_g + isk * 64;
        float v0[16];
        v0[0] = bflo(w[0].x); v0[1] = bfhi(w[0].x); v0[2] = bflo(w[0].y); v0[3] = bfhi(w[0].y); v0[4] = bflo(w[0].z); v0[5] = bfhi(w[0].z); v0[6] = bflo(w[0].w); v0[7] = bfhi(w[0].w);
        v0[8] = bflo(w[1].x); v0[9] = bfhi(w[1].x); v0[10] = bflo(w[1].y); v0[11] = bfhi(w[1].y); v0[12] = bflo(w[1].z); v0[13] = bfhi(w[1].z); v0[14] = bflo(w[1].w); v0[15] = bfhi(w[1].w);
#pragma unroll
        for (int i = 0; i < 16; ++i) v0[i] *= rstd * gp[i];
        float rr[16];
#pragma unroll
        for (int i = 0; i < 8; ++i) { rr[i] = v0[i] * cs[i] - v0[i + 8] * sn[i]; rr[i + 8] = v0[i + 8] * cs[i] + v0[i] * sn[i]; }
        u32x4 o[8];
        o[0].x = pk2(rr[0], rr[1]); o[0].y = pk2(rr[2], rr[3]); o[0].z = pk2(rr[4], rr[5]); o[0].w = pk2(rr[6], rr[7]);
        o[1].x = pk2(rr[8], rr[9]); o[1].y = pk2(rr[10], rr[11]); o[1].z = pk2(rr[12], rr[13]); o[1].w = pk2(rr[14], rr[15]);
#pragma unroll
        for (int c = 2; c < 8; ++c) { const f32x4 g0 = *(const f32x4*)(gp + c * 8), g1 = *(const f32x4*)(gp + c * 8 + 4);
            o[c].x = pk2(bflo(w[c].x) * rstd * g0.x, bfhi(w[c].x) * rstd * g0.y); o[c].y = pk2(bflo(w[c].y) * rstd * g0.z, bfhi(w[c].y) * rstd * g0.w);
            o[c].z = pk2(bflo(w[c].z) * rstd * g1.x, bfhi(w[c].z) * rstd * g1.y); o[c].w = pk2(bflo(w[c].w) * rstd * g1.z, bfhi(w[c].w) * rstd * g1.w); }
        if (isk == 0) {
#pragma unroll
            for (int c = 0; c < 8; ++c) src[c] = o[c];
        } else {
            u32x4* dst = (u32x4*)((bf16_t*)(a.ws + WS_KIMG) + ((size_t)((b * 4 + h) * 64 + tile)) * 8192) + r;
#pragma unroll
            for (int c = 0; c < 8; ++c) dst[(p * 8 + c) * 64] = o[c];
        }
    }
    {
        u32x4* dst = (u32x4*)((bf16_t*)(a.ws + WS_VIMG) + ((size_t)((b * 4 + h) * 64 + tile)) * 8192) + r;
#pragma unroll
        for (int cg = 2 * p; cg < 2 * p + 2; ++cg)
#pragma unroll
            for (int kg = 0; kg < 4; ++kg) {
                const u32x4 v = *(const u32x4*)(PROJ + ((size_t)b * SEQ + tile * 64 + 16 * kg + (r >> 2)) * PS + C_VA + h * 128 + 32 * cg + 8 * (r & 3));
                dst[(cg * 4 + kg) * 64] = v; }
    }
}

DI bf16x8 tr_frag_nat(const LAS unsigned char* img, int rowbase, int col0, int lane) {
    const int hh = lane >> 5, g16 = (lane >> 4) & 1, i = lane & 15;
    const int col = col0 + 16 * g16 + 4 * (i & 3), chunk = col >> 3, sub = (col & 7) * 2;
    const int r0 = rowbase + 8 * hh + (i >> 2), r1 = r0 + 4;
    const s16x4 lo = trread(img + r0 * 256 + ((chunk ^ swz16(r0)) << 4) + sub);
    const s16x4 hi = trread(img + r1 * 256 + ((chunk ^ swz16(r1)) << 4) + sub);
    return __builtin_shufflevector(lo, hi, 0, 1, 2, 3, 4, 5, 6, 7);
}
DI bf16x8 tr_frag_acc(const LAS unsigned char* img, int rowbase, int col0, int lane) {
    const int hh = lane >> 5, g16 = (lane >> 4) & 1, i = lane & 15;
    const int col = col0 + 16 * g16 + 4 * (i & 3), chunk = col >> 3, sub = (col & 7) * 2;
    const int r0 = rowbase + 4 * hh + (i >> 2), r1 = r0 + 8;
    const s16x4 lo = trread(img + r0 * 256 + ((chunk ^ swz16(r0)) << 4) + sub);
    const s16x4 hi = trread(img + r1 * 256 + ((chunk ^ swz16(r1)) << 4) + sub);
    return __builtin_shufflevector(lo, hi, 0, 1, 2, 3, 4, 5, 6, 7);
}
DI bf16x8 row_frag(const LAS unsigned char* img, int row, int chunk) { return *(const LAS bf16x8*)(img + row * 256 + ((chunk ^ swz16(row)) << 4)); }

DI void glds16_asm(const void* gsrc, unsigned lds_dst) { unsigned keep;
    asm volatile("s_mov_b32 %0, m0\n\ts_mov_b32 m0, %2\n\ts_nop 0\n\tglobal_load_lds_dwordx4 %1, off\n\ts_mov_b32 m0, %0" : "=&s"(keep) : "v"(gsrc), "s"(lds_dst) : "memory"); }
constexpr size_t DO_QC = 0, DO_KC = 32 * MiB, DO_HD = 64 * MiB;
constexpr size_t WS_SC = 7 * MiB;

DI void conv_task(const Ctx& F, const Args& a, int tw) {
    const int isk = tw & 1, tok0 = (tw >> 1) * 8, b = tok0 / SEQ, t0 = tok0 % SEQ, lane = F.lane;
    const bf16_t* src = (const bf16_t*)(a.ws + WS_PROJ) + (size_t)b * SEQ * PS + (isk ? C_KM : C_QM) + lane * 8;
    float cw[5][8];
#pragma unroll
    for (int j = 0; j < 5; ++j) { const f32x4 c0 = *(const f32x4*)(a.conv_w + j * 1024 + isk * 512 + lane * 8), c1 = *(const f32x4*)(a.conv_w + j * 1024 + isk * 512 + lane * 8 + 4);
        cw[j][0] = c0.x; cw[j][1] = c0.y; cw[j][2] = c0.z; cw[j][3] = c0.w; cw[j][4] = c1.x; cw[j][5] = c1.y; cw[j][6] = c1.z; cw[j][7] = c1.w; }
    u32x4 row[12];
#pragma unroll
    for (int r = 0; r < 12; ++r) { const int t = t0 + r - 2; row[r] = (u32x4){0u, 0u, 0u, 0u}; if (t >= 0 && t < SEQ) row[r] = *(const u32x4*)(src + (size_t)t * PS); }
    const int hd = lane >> 4, cc = lane & 15, cch = t0 >> 6, r0 = t0 & 63;
    bf16_t* tileb = (bf16_t*)((unsigned char*)a.out + (isk ? DO_KC : DO_QC)) + ((size_t)((b * 4 + hd) * 64 + cch)) * 8192;
    bf16_t* dst = isk ? tileb + ((cc >> 2) * 4 + (r0 >> 4)) * 512 + (r0 & 15) * 32 + (cc & 3) * 8 : tileb + cc * 512 + r0 * 8;
    const int dstride = isk ? 32 : 8;
    const float sc = isk ? 0.08838834764831845f : 1.f;
#pragma unroll
    for (int i = 0; i < 8; ++i) {
        float acc[8];
#pragma unroll
        for (int e = 0; e < 8; ++e) acc[e] = 0.f;
#pragma unroll
        for (int j = 0; j < 5; ++j) { const u32x4 w = row[i + j];
            acc[0] += bflo(w.x) * cw[j][0]; acc[1] += bfhi(w.x) * cw[j][1]; acc[2] += bflo(w.y) * cw[j][2]; acc[3] += bfhi(w.y) * cw[j][3];
            acc[4] += bflo(w.z) * cw[j][4]; acc[5] += bfhi(w.z) * cw[j][5]; acc[6] += bflo(w.w) * cw[j][6]; acc[7] += bfhi(w.w) * cw[j][7]; }
#pragma unroll
        for (int e = 0; e < 8; ++e) acc[e] = silu_f(acc[e]) * sc;
        u32x4 o; o.x = pk2(acc[0], acc[1]); o.y = pk2(acc[2], acc[3]); o.z = pk2(acc[4], acc[5]); o.w = pk2(acc[6], acc[7]);
        *(u32x4*)(dst + i * dstride) = o;
    }
}

DI void mscal_task(const Ctx& F, const Args& a, int chain) {
    const int b = chain >> 3, h = (chain >> 1) & 3, dir = chain & 1;
    const int s = dir ? 63 - F.lane : F.lane;
    const float* GT = (const float*)(a.ws + WS_GATES) + (size_t)b * SEQ * 16;
    float* SC = (float*)(a.ws + WS_SC) + (size_t)chain * 64 * 256; float* MSC = (float*)(a.ws + WS_MSC);
    LAS float* gl = (LAS float*)F.lds; LAS float* mll = gl + 64; LAS float* mpv = gl + 128; LAS float* mnw = gl + 192;
    float aa[8], ii[8];
#pragma unroll
    for (int i = 0; i < 8; ++i) { const int c = F.wave + 8 * i;
        const float ig = GT[(size_t)(c * 64 + s) * 16 + dir * 8 + h], fg = GT[(size_t)(c * 64 + s) * 16 + dir * 8 + 4 + h];
        const float av = wave_prefix_sum(logsigmoid_f(fg));
        aa[i] = av; ii[i] = ig;
        const float g = __builtin_bit_cast(float, __builtin_amdgcn_readlane(__builtin_bit_cast(int, av), 63)), ml = wave_max(g - av + ig);
        if (F.lane == 0) { gl[c] = g; mll[c] = ml; } }
    __syncthreads();
    if (F.tid == 0) { float m = 0.f;
        for (int st = 0; st < 64; ++st) { const int c = dir ? 63 - st : st; mpv[c] = m; const float mn = fmaxf(gl[c] + m, mll[c]); mnw[c] = mn; m = mn; } }
    __syncthreads();
#pragma unroll
    for (int i = 0; i < 8; ++i) { const int c = F.wave + 8 * i; const float mprev = mpv[c], mnew = mnw[c], g = gl[c];
        const float cterm = ii[i] - aa[i];
        const float cm = wave_prefix_max(cterm);
        const float il = aa[i] + mprev, mj = fmaxf(il, aa[i] + cm);
        float* o4 = SC + (size_t)c * 256 + s;
        o4[0] = (aa[i] - mj) * 1.4426950408889634f; o4[64] = cterm * 1.4426950408889634f; o4[128] = __expf(il - mj); o4[192] = __expf(-mj);
        if (F.lane == 0) { MSC[chain * 64 + c] = (g - mnew) * 1.4426950408889634f; MSC[4096 + chain * 64 + c] = __expf(g + mprev - mnew); } }
    __syncthreads();
}

DI const float* wsel3(int m, const float* p0, const float* p1, const float* p2) {
    const unsigned long long a0 = (unsigned long long)p0, a1 = (unsigned long long)p1, a2 = (unsigned long long)p2;
    const unsigned long long m1 = (unsigned long long)0 - (unsigned long long)(m == 1), m2 = (unsigned long long)0 - (unsigned long long)(m == 2);
    return (const float*)((a0 & ~(m1 | m2)) | (a1 & m1) | (a2 & m2));
}
DI void mseq_item(const Ctx& F, const Args& a, int item, int bh, int dir, int vs) {
    const int b = bh >> 2, h = bh & 3, chain = bh * 2 + dir, wid = F.wave, tid = F.tid, lane = F.lane, r32 = lane & 31, hh = lane >> 5;
    LAS unsigned char* QS = F.lds;
    LAS unsigned char* KS = F.lds + 32768;
    LAS unsigned char* VS = F.lds + 65536;
    LAS unsigned char* SCS = F.lds + 77824;
    LAS unsigned char* SD = F.lds + 80896;
    LAS unsigned char* CI = F.lds + 97280;
    LAS float* NV = (LAS float*)(F.lds + 113664);
    LAS float* gmv = NV + 256; LAS float* spv = gmv + 64;
    LAS unsigned char* HST = F.lds + 115712;
    const int cwi = wid < 4 ? wid : 4;
    const bool cwave = wid < 4 || wid == 7;
    const unsigned cscb = (unsigned)(uintptr_t)F.lds + 119808u + (unsigned)cwi * 8192u;
    const int cslot0 = (item * 5 + cwi) * 64;
    const float* const wg_ = a.w_gate; const float* const wu_ = a.w_up; const float* const wd_ = a.w_down;
    const bf16_t* QC = (const bf16_t*)((const unsigned char*)a.out + DO_QC) + (size_t)bh * 64 * 8192 + lane * 8;
    const bf16_t* KC = (const bf16_t*)((const unsigned char*)a.out + DO_KC) + (size_t)bh * 64 * 8192 + lane * 8;
    const bf16_t* VP = (const bf16_t*)(a.ws + WS_PROJ) + (size_t)b * SEQ * PS + C_VM + h * 128 + vs * 32 + (size_t)(16 * (wid & 3) + (lane >> 2)) * PS + 8 * (lane & 3);
    const float* SC = (const float*)(a.ws + WS_SC) + (size_t)chain * 64 * 256 + lane * 4;
    bf16_t* HD = (bf16_t*)((unsigned char*)a.out + DO_HD) + ((size_t)dir * MTOK + (size_t)b * SEQ) * 512 + h * 128 + vs * 32;
    if (tid < 64) { gmv[tid] = ((const float*)(a.ws + WS_MSC))[chain * 64 + tid]; spv[tid] = ((const float*)(a.ws + WS_MSC))[4096 + chain * 64 + tid]; }
    if (tid < 256) NV[tid] = 0.f;
    for (int i = tid; i < 4096; i += NTHR) ((LAS unsigned*)CI)[i] = 0u;
    const unsigned ldsb = (unsigned)(uintptr_t)F.lds;
#define MSEQ_ISSUE_QK(c, s2) do { const size_t _tb = (size_t)(c); \
        if (wid < 4) { _Pragma("unroll") for (int _i = 0; _i < 4; ++_i) \
                glds16_asm(QC + _tb * 8192 + (4 * wid + _i) * 512, (unsigned)__builtin_amdgcn_readfirstlane((int)(ldsb + (s2) * 16384 + (4 * wid + _i) * 1024))); } \
        else if (wid >= 6) { _Pragma("unroll") for (int _i = 0; _i < 8; ++_i) \
                glds16_asm(KC + _tb * 8192 + (8 * (wid - 6) + _i) * 512, (unsigned)__builtin_amdgcn_readfirstlane((int)(ldsb + 32768 + (s2) * 16384 + (8 * (wid - 6) + _i) * 1024))); } } while (0)
#define MSEQ_ISSUE_VS(c, s4) do { const size_t _tb = (size_t)(c); \
        if (wid < 4) glds16_asm(VP + _tb * 64 * PS, (unsigned)__builtin_amdgcn_readfirstlane((int)(ldsb + 65536 + (s4) * 4096 + wid * 1024))); \
        else if (wid == 6) glds16_asm(SC + _tb * 256, (unsigned)__builtin_amdgcn_readfirstlane((int)(ldsb + 77824 + (s4) * 1024))); } while (0)
    MSEQ_ISSUE_QK(dir ? 63 : 0, 0); MSEQ_ISSUE_VS(dir ? 63 : 0, 0);
#define MSEQ_CONV_ISSUE(id) do { const int _e = (id) / 6144, _r = (id) % 6144, _mat = _r >> 11, _rr = _r & 2047; \
        const int _N = _mat == 2 ? DM : DFF, _nb = _mat == 2 ? (_rr >> 7) : (_rr >> 6), _kb = _mat == 2 ? (_rr & 127) : (_rr & 63); \
        const float* _src = wsel3(_mat, wg_, wu_, wd_) + (size_t)_e * DM * DFF + (size_t)(16 * _kb + (lane >> 4)) * _N + 64 * _nb + 4 * (lane & 15); \
        _Pragma("unroll") for (int _i = 0; _i < 4; ++_i) glds16_asm(_src + (size_t)(4 * _i) * _N, (unsigned)__builtin_amdgcn_readfirstlane((int)(cscb + ((id) & 1) * 4096 + _i * 1024))); } while (0)
    if (cwave) MSEQ_CONV_ISSUE(cslot0);
    f32x16 Cacc[2];
#pragma unroll
    for (int i = 0; i < 16; ++i) { Cacc[0][i] = 0.f; Cacc[1][i] = 0.f; }
    const int qrd = hh * 1024 + r32 * 16;
    const int ktr = (8 * hh + ((lane & 15) >> 2)) * 64 + ((lane >> 4) & 1) * 32 + (lane & 3) * 8;
    f32x16 acc;
    float qn = 0.f;
#pragma unroll
    for (int i = 0; i < 16; ++i) acc[i] = 0.f;
    asm volatile("s_waitcnt vmcnt(0)" ::: "memory");
    __syncthreads();
    unsigned long long busy = 0, tb0 = 0; if (PROBE_MSEQ_W >= 0) tb0 = __builtin_amdgcn_s_memtime(); const unsigned long long titem0 = tb0;
#pragma unroll 1
    for (int st = 0; st <= 64; ++st) {
        const int c = dir ? 63 - st : st, s2 = st & 1; const int s3 = st % 3, s3p = (st + 2) % 3;
        if (st + 1 < 64) { MSEQ_ISSUE_QK(dir ? 62 - st : st + 1, s2 ^ 1); MSEQ_ISSUE_VS(dir ? 62 - st : st + 1, (st + 1) % 3);
            if (cwave) MSEQ_CONV_ISSUE(cslot0 + st + 1); }
        const LAS unsigned char* QT = QS + s2 * 16384; const LAS unsigned char* KT = KS + s2 * 16384; const LAS unsigned char* VT = VS + s3 * 4096;
        const LAS float* rt = (const LAS float*)(SCS + s3 * 1024); const LAS float* ct = rt + 64;
        if (wid < 4) {
            if (st < 64) {
                const int jt = wid >> 1, stt = wid & 1;
                const LAS unsigned char* qa = QT + qrd + jt * 512;
                const LAS unsigned char* kb = KT + (2 * stt + (r32 >> 4)) * 1024 + (r32 & 15) * 64 + hh * 16;
                const int j = 32 * jt + r32; const float rtj = rt[j];
                const LAS float* ctp = ct + 32 * stt + 4 * hh;
                f32x4 c4[4];
#pragma unroll
                for (int rg = 0; rg < 4; ++rg) c4[rg] = *(const LAS f32x4*)(ctp + 8 * rg);
                const float gm = gmv[c], sp = spv[c];
                const int ck = 4 * wid + (lane & 3), r0 = 4 * (lane >> 2);
                const LAS unsigned char* kr = KT + (ck >> 2) * 4096 + (r0 >> 4) * 1024 + (r0 & 15) * 64 + (ck & 3) * 16;
                u32x4 kw[4];
#pragma unroll
                for (int r = 0; r < 4; ++r) kw[r] = *(const LAS u32x4*)(kr + r * 64);
                const f32x4 ctn = *(const LAS f32x4*)(ct + r0);
                const LAS float* no = NV + s2 * 128 + 32 * wid + 8 * (lane & 3);
                const f32x4 o0 = *(const LAS f32x4*)no, o1 = *(const LAS f32x4*)(no + 4);
                f32x16 S;
#pragma unroll
                for (int i = 0; i < 16; ++i) S[i] = 0.f;
#pragma unroll
                for (int ks = 0; ks < 8; ++ks) S = MFMA32(*(const LAS bf16x8*)(kb + (ks >> 1) * 4096 + (ks & 1) * 32), *(const LAS bf16x8*)(qa + ks * 2048), S);
                float pa[8];
#pragma unroll
                for (int e = 0; e < 8; ++e) pa[e] = 0.f;
#pragma unroll
                for (int r = 0; r < 4; ++r) { const u32x4 w = kw[r]; const float ws_ = __builtin_amdgcn_exp2f(ctn[r] + gm);
                    pa[0] += ws_ * bflo(w.x); pa[1] += ws_ * bfhi(w.x); pa[2] += ws_ * bflo(w.y); pa[3] += ws_ * bfhi(w.y); pa[4] += ws_ * bflo(w.z); pa[5] += ws_ * bfhi(w.z); pa[6] += ws_ * bflo(w.w); pa[7] += ws_ * bfhi(w.w); }
#pragma unroll
                for (int e = 0; e < 8; ++e) { float t = pa[e]; t += dpp_mov<DPP_ROR(8)>(t); t += dpp_mov<DPP_ROR(4)>(t); t = xor16_sum(t); pa[e] = xor32_sum(t); }
                u32x2 sw2[4];
#pragma unroll
                for (int rg = 0; rg < 4; ++rg) { float v[4];
#pragma unroll
                    for (int e = 0; e < 4; ++e) { const int sc = 32 * stt + 8 * rg + 4 * hh + e; const bool ok = dir == 0 ? (sc <= j) : (sc >= j);
                        v[e] = S[4 * rg + e] * __builtin_amdgcn_exp2f(ok ? rtj + c4[rg][e] : -1.0e30f); }
                    sw2[rg].x = pk2(v[0], v[1]); sw2[rg].y = pk2(v[2], v[3]); }
                LAS unsigned char* sw = SD + s2 * 8192 + stt * 4096 + j * 16 + hh * 8;
#pragma unroll
                for (int rg = 0; rg < 4; ++rg) *(LAS u32x2*)(sw + rg * 1024) = sw2[rg];
                if (lane < 4) { LAS float* nn = NV + (s2 ^ 1) * 128 + 32 * wid + 8 * lane;
                    *(LAS f32x4*)nn = (f32x4){sp * o0.x + pa[0], sp * o0.y + pa[1], sp * o0.z + pa[2], sp * o0.w + pa[3]};
                    *(LAS f32x4*)(nn + 4) = (f32x4){sp * o1.x + pa[4], sp * o1.y + pa[5], sp * o1.z + pa[6], sp * o1.w + pa[7]}; }
            }
        } else if (wid < 6) {
            const int jt = wid - 4, jl = 32 * jt + r32;
            u32x2 hw[4]; bool have_h = false; int cp = 0;
            if (st > 0) {
                cp = dir ? 64 - st : st - 1; have_h = true;
                const LAS float* iw = (const LAS float*)(SCS + s3p * 1024) + 128; const LAS float* enm = iw + 64;
                const LAS unsigned char* SDp = SD + (s2 ^ 1) * 8192;
                const LAS unsigned char* sr = SDp + hh * 4096 + jl * 16;
                u32x4 w4[4];
#pragma unroll
                for (int ch = 0; ch < 4; ++ch) w4[ch] = *(const LAS u32x4*)(sr + ch * 1024);
                const float iwj = iw[jl], enj = enm[jl];
                const LAS unsigned char* sa = SDp + qrd + jt * 512; const LAS unsigned char* vb = VS + s3p * 4096 + ktr;
                float rsum = 0.f;
#pragma unroll
                for (int ch = 0; ch < 4; ++ch) { const u32x4 w = w4[ch];
                    rsum += (bflo(w.x) + bfhi(w.x)) + (bflo(w.y) + bfhi(w.y)) + (bflo(w.z) + bfhi(w.z)) + (bflo(w.w) + bfhi(w.w)); }
                rsum = xor32_sum(rsum);
                const float den = rsum + iwj * qn;
                const float rdj = 1.f / fmaxf(fabsf(den), enj);
#pragma unroll
                for (int i = 0; i < 16; ++i) acc[i] *= iwj;
#pragma unroll
                for (int ks = 0; ks < 4; ++ks) { const s16x4 lo = trread(vb + ks * 1024), hi = trread(vb + ks * 1024 + 256);
                    acc = MFMA32(__builtin_shufflevector(lo, hi, 0, 1, 2, 3, 4, 5, 6, 7), *(const LAS bf16x8*)(sa + ks * 2048), acc); }
#pragma unroll
                for (int rg = 0; rg < 4; ++rg) { hw[rg].x = pk2(acc[4 * rg] * rdj, acc[4 * rg + 1] * rdj); hw[rg].y = pk2(acc[4 * rg + 2] * rdj, acc[4 * rg + 3] * rdj); }
            }
            if (st < 64) {
                const LAS unsigned char* qa = QT + qrd + jt * 512;
                const LAS unsigned char* cb = CI + s2 * 8192 + hh * 512 + r32 * 16;
                const LAS unsigned char* qr = QT + hh * 8192 + jl * 16; const LAS float* np = NV + s2 * 128 + 64 * hh;
#pragma unroll
                for (int i = 0; i < 16; ++i) acc[i] = 0.f;
#pragma unroll
                for (int ks = 0; ks < 8; ++ks) acc = MFMA32(*(const LAS bf16x8*)(cb + ks * 1024), *(const LAS bf16x8*)(qa + ks * 2048), acc);
                qn = 0.f;
#pragma unroll
                for (int ch = 0; ch < 8; ++ch) { const u32x4 w = *(const LAS u32x4*)(qr + ch * 1024); const f32x4 n0 = *(const LAS f32x4*)(np + ch * 8), n1 = *(const LAS f32x4*)(np + ch * 8 + 4);
                    qn += bflo(w.x) * n0.x + bfhi(w.x) * n0.y + bflo(w.y) * n0.z + bfhi(w.y) * n0.w + bflo(w.z) * n1.x + bfhi(w.z) * n1.y + bflo(w.w) * n1.z + bfhi(w.w) * n1.w; }
                qn = xor32_sum(qn);
            }
            if (have_h) {
                LAS unsigned char* hst = HST + jt * 2048;
#pragma unroll
                for (int rg = 0; rg < 4; ++rg) *(LAS u32x2*)(hst + r32 * 64 + (8 * rg + 4 * hh) * 2) = hw[rg];
                asm volatile("s_waitcnt lgkmcnt(0)" ::: "memory");
#pragma unroll
                for (int q = 0; q < 2; ++q) { const int row = 16 * q + (lane >> 2), part = lane & 3;
                    const u32x4 w = *(const LAS u32x4*)(hst + row * 64 + part * 16);
                    *(u32x4*)(HD + (size_t)(cp * 64 + 32 * jt + row) * 512 + part * 8) = w; }
            }
        } else if (st < 64) {
            const int u = wid - 6; const float gm = gmv[c], sp = spv[c];
            const LAS unsigned char* va = VT + ktr; const LAS unsigned char* ka = KT + ktr + (2 * u) * 4096;
            s16x4 vlo[4], vhi[4], k0l[4], k0h[4], k1l[4], k1h[4]; f32x4 cw0[4], cw1[4];
#pragma unroll
            for (int ks = 0; ks < 4; ++ks) { vlo[ks] = trread(va + ks * 1024); vhi[ks] = trread(va + ks * 1024 + 256);
                cw0[ks] = *(const LAS f32x4*)(ct + 16 * ks + 8 * hh); cw1[ks] = *(const LAS f32x4*)(ct + 16 * ks + 8 * hh + 4);
                k0l[ks] = trread(ka + ks * 1024); k0h[ks] = trread(ka + ks * 1024 + 256); k1l[ks] = trread(ka + 4096 + ks * 1024); k1h[ks] = trread(ka + 4096 + ks * 1024 + 256); }
#pragma unroll
            for (int i = 0; i < 16; ++i) { Cacc[0][i] *= sp; Cacc[1][i] *= sp; }
#pragma unroll
            for (int ks = 0; ks < 4; ++ks) {
                const s16x4 lo = vlo[ks], hi = vhi[ks]; const f32x4 e0 = cw0[ks], e1 = cw1[ks];
                u32x4 af;
                af.x = pk2(bf2f((bf16_t)lo[0]) * __builtin_amdgcn_exp2f(e0.x + gm), bf2f((bf16_t)lo[1]) * __builtin_amdgcn_exp2f(e0.y + gm));
                af.y = pk2(bf2f((bf16_t)lo[2]) * __builtin_amdgcn_exp2f(e0.z + gm), bf2f((bf16_t)lo[3]) * __builtin_amdgcn_exp2f(e0.w + gm));
                af.z = pk2(bf2f((bf16_t)hi[0]) * __builtin_amdgcn_exp2f(e1.x + gm), bf2f((bf16_t)hi[1]) * __builtin_amdgcn_exp2f(e1.y + gm));
                af.w = pk2(bf2f((bf16_t)hi[2]) * __builtin_amdgcn_exp2f(e1.z + gm), bf2f((bf16_t)hi[3]) * __builtin_amdgcn_exp2f(e1.w + gm));
                const bf16x8 afr = __builtin_bit_cast(bf16x8, af);
                Cacc[0] = MFMA32(__builtin_shufflevector(k0l[ks], k0h[ks], 0, 1, 2, 3, 4, 5, 6, 7), afr, Cacc[0]);
                Cacc[1] = MFMA32(__builtin_shufflevector(k1l[ks], k1h[ks], 0, 1, 2, 3, 4, 5, 6, 7), afr, Cacc[1]);
            }
            LAS unsigned char* cw = CI + (s2 ^ 1) * 8192 + (2 * u) * 2048 + r32 * 16 + hh * 8;
#pragma unroll
            for (int t2 = 0; t2 < 2; ++t2)
#pragma unroll
                for (int rg = 0; rg < 4; ++rg) { u32x2 w; w.x = pk2(Cacc[t2][4 * rg], Cacc[t2][4 * rg + 1]); w.y = pk2(Cacc[t2][4 * rg + 2], Cacc[t2][4 * rg + 3]); *(LAS u32x2*)(cw + t2 * 2048 + rg * 512) = w; }
        }
        if (PROBE_MSEQ_W >= 0) { asm volatile("s_waitcnt lgkmcnt(0)" ::: "memory"); busy += __builtin_amdgcn_s_memtime() - tb0; }
        if (cwave) {
            if (st + 1 < 64) asm volatile("s_waitcnt vmcnt(4)" ::: "memory"); else asm volatile("s_waitcnt vmcnt(0)" ::: "memory");
            if (st < 64) {
                const int id = cslot0 + st, e = id / 6144, r = id % 6144, mat = r >> 11, rr = r & 2047;
                const int nb = mat == 2 ? (rr >> 7) : (rr >> 6), kb = mat == 2 ? (rr & 127) : (rr & 63), n = 64 * nb + lane;
                unsigned char* dst = mat == 2 ? a.ws + WS_WDT + (size_t)e * DM * DFF + (size_t)n * DFF + 16 * kb
                                              : a.ws + WS_WGUT + (size_t)e * 4096 * DM + (size_t)((n >> 7) * 256 + (n & 127) + mat * 128) * DM + 16 * kb;
                const LAS float* CSC = (const LAS float*)(F.lds + 119808 + cwi * 8192 + (id & 1) * 4096);
                float cv[16];
#pragma unroll
                for (int k = 0; k < 16; ++k) cv[k] = CSC[k * 64 + lane] * pg8::W_PRESCALE;
                u32x4 o; o.x = pg8::pk4_fp8(cv[0], cv[1], cv[2], cv[3]); o.y = pg8::pk4_fp8(cv[4], cv[5], cv[6], cv[7]); o.z = pg8::pk4_fp8(cv[8], cv[9], cv[10], cv[11]); o.w = pg8::pk4_fp8(cv[12], cv[13], cv[14], cv[15]);
                *(u32x4*)dst = o;
            }
        } else if (wid == 6) asm volatile("s_waitcnt vmcnt(0)" ::: "memory");
        asm volatile("s_waitcnt lgkmcnt(0)" ::: "memory"); __builtin_amdgcn_s_barrier(); asm volatile("" ::: "memory");
        if (PROBE_MSEQ_W >= 0) tb0 = __builtin_amdgcn_s_memtime();
    }
    if (PROBE_MSEQ_W >= 0 && F.bid == 0 && lane == 0 && (wid == PROBE_MSEQ_W || (PROBE_MSEQ_W == 8 && wid == 0)))
        *(volatile LAS unsigned long long*)(F.lds + LDS_BYTES - 128) = (PROBE_MSEQ_W == 8) ? (__builtin_amdgcn_s_memtime() - titem0) : busy;
    asm volatile("s_waitcnt vmcnt(0)" ::: "memory");
#undef MSEQ_ISSUE_QK
#undef MSEQ_ISSUE_VS
#undef MSEQ_CONV_ISSUE
}

DI void glds16(const void* g, LAS unsigned char* l) { __builtin_amdgcn_global_load_lds((const unsigned*)g, (LAS unsigned*)l, 16, 0, 0); }
DI void attn_unit(const Ctx& F, const Args& a, int b, int h, int qb, float lam, float cshift) {
    const int lane = F.lane, wid = F.wave, r32 = lane & 31, hh = lane >> 5, rg = wid & 3, p = wid >> 2;
    const bf16_t* projb = (const bf16_t*)(a.ws + WS_PROJ) + (size_t)b * SEQ * PS;
    const int qrow = qb * 128 + rg * 32 + r32;
    bf16x8 qf[4];
    { const bf16_t* qp = projb + (size_t)qrow * PS + C_QA + h * 128 + p * 64 + hh * 8;
#pragma unroll
      for (int ks = 0; ks < 4; ++ks) qf[ks] = *(const bf16x8*)(qp + ks * 16); }
    const bf16_t* kimg = (const bf16_t*)(a.ws + WS_KIMG) + (size_t)(b * 4 + h) * 64 * 8192 + (4 * wid) * 512 + lane * 8;
    const bf16_t* vimg = (const bf16_t*)(a.ws + WS_VIMG) + (size_t)(b * 4 + h) * 64 * 8192 + (4 * wid) * 512 + lane * 8;
    const unsigned ldsw = (unsigned)__builtin_amdgcn_readfirstlane((int)(unsigned)(uintptr_t)F.lds + (4 * wid) * 1024);
#define ATT_ISSUE2(img, t0, ldsoff) do { const int _q0 = 4 * wid; const int _t = (t0) + (_q0 >> 4); const bf16_t* _tp = (img) + (size_t)(_t < 64 ? _t : 63) * 8192 - (size_t)(_q0 & 16) * 512; \
        const unsigned _d = (unsigned)__builtin_amdgcn_readfirstlane((int)(ldsw + (ldsoff))); \
        _Pragma("unroll") for (int _i = 0; _i < 4; ++_i) glds16_asm(_tp + _i * 512, _d + _i * 1024); } while (0)
    if (wid < 4) { const bf16_t* _tp = kimg; const unsigned _d = (unsigned)__builtin_amdgcn_readfirstlane((int)(ldsw + 32768));
#pragma unroll
        for (int _i = 0; _i < 4; ++_i) glds16_asm(_tp + _i * 512, _d + _i * 1024); }
    ATT_ISSUE2(kimg, 1, 0); ATT_ISSUE2(vimg, 0, 65536);
    f32x16 O[4];
#pragma unroll
    for (int vt = 0; vt < 4; ++vt)
#pragma unroll
        for (int i = 0; i < 16; ++i) O[vt][i] = 0.f;
    float lsum = 0.f;
    const int kfb = p * 8192 + hh * 1024 + r32 * 16;
    const int vfb = (4 * hh + ((lane & 15) >> 2)) * 64 + ((lane >> 4) & 1) * 32 + (lane & 3) * 8;
    bf16x8 pb[4];
    asm volatile("s_waitcnt vmcnt(0)" ::: "memory");
    __syncthreads();
#define ATT_VLOAD(dst, Vb, kg) do { _Pragma("unroll") for (int vt = 0; vt < 4; ++vt) { \
        const s16x4 _lo = trread((Vb) + vt * 4096 + (kg) * 1024), _hi = trread((Vb) + vt * 4096 + (kg) * 1024 + 512); dst[vt] = __builtin_shufflevector(_lo, _hi, 0, 1, 2, 3, 4, 5, 6, 7); } } while (0)
#define ATT_PV(vf, kg) do { __builtin_amdgcn_s_setprio(1); _Pragma("unroll") for (int vt = 0; vt < 4; ++vt) O[vt] = MFMA32(vf[vt], pb[kg], O[vt]); __builtin_amdgcn_s_setprio(0); } while (0)
#define ATT_EXPQ(S, o, dst) do { float _e[8]; _Pragma("unroll") for (int i = 0; i < 8; ++i) _e[i] = __builtin_amdgcn_exp2f(S[(o) + i]); \
        _Pragma("unroll") for (int i = 0; i < 8; ++i) ls = ls + _e[i]; \
        u32x4 _w; _w.x = pk2(_e[0], _e[1]); _w.y = pk2(_e[2], _e[3]); _w.z = pk2(_e[4], _e[5]); _w.w = pk2(_e[6], _e[7]); dst = __builtin_bit_cast(bf16x8, _w); } while (0)
#define ATT_STEP(Kb, Vb, on0) do { \
        bf16x8 kfa[4], kfb2[4], vA[4], vB[4], pn[4]; float ls = 0.f; \
        _Pragma("unroll") for (int ks = 0; ks < 4; ++ks) { kfa[ks] = *(const LAS bf16x8*)((Kb) + ks * 2048); kfb2[ks] = *(const LAS bf16x8*)((Kb) + ks * 2048 + 512); } \
        ATT_VLOAD(vA, Vb, 0); \
        __builtin_amdgcn_s_setprio(1); \
        Sa = MFMA32(kfa[0], qf[0], negc); Sb = MFMA32(kfb2[0], qf[0], negc);        \
        _Pragma("unroll") for (int ks = 1; ks < 4; ++ks) { Sa = MFMA32(kfa[ks], qf[ks], Sa); Sb = MFMA32(kfb2[ks], qf[ks], Sb); } \
        __builtin_amdgcn_s_setprio(0); \
        ATT_VLOAD(vB, Vb, 1); ATT_PV(vA, 0); ATT_EXPQ(Sa, 0, pn[0]); \
        ATT_VLOAD(vA, Vb, 2); ATT_PV(vB, 1); ATT_EXPQ(Sa, 8, pn[1]); \
        ATT_VLOAD(vB, Vb, 3); ATT_PV(vA, 2); ATT_EXPQ(Sb, 0, pn[2]); \
        ATT_PV(vB, 3); ATT_EXPQ(Sb, 8, pn[3]); \
        lsum += (on0) ? ls : 0.f; \
        pb[0] = pn[0]; pb[1] = pn[1]; pb[2] = pn[2]; pb[3] = pn[3]; } while (0)
    f32x16 Sa, Sb, negc;
#pragma unroll
    for (int i = 0; i < 16; ++i) negc[i] = -cshift;
    asm volatile("" : "+v"(negc));
    {
        const LAS unsigned char* Kb = F.lds + 32768 + kfb;
        Sa = MFMA32(*(const LAS bf16x8*)(Kb), qf[0], negc); Sb = MFMA32(*(const LAS bf16x8*)(Kb + 512), qf[0], negc);
#pragma unroll
        for (int ks = 1; ks < 4; ++ks) { Sa = MFMA32(*(const LAS bf16x8*)(Kb + ks * 2048), qf[ks], Sa); Sb = MFMA32(*(const LAS bf16x8*)(Kb + ks * 2048 + 512), qf[ks], Sb); }
        float ls = 0.f;
        ATT_EXPQ(Sa, 0, pb[0]); ATT_EXPQ(Sa, 8, pb[1]); ATT_EXPQ(Sb, 0, pb[2]); ATT_EXPQ(Sb, 8, pb[3]);
        lsum += ls;
    }
    __syncthreads();
#pragma unroll 1
    for (int T = 0; T < 32; ++T) {
        const int j = T & 1;
        ATT_ISSUE2(kimg, 2 * T + 3, (j ^ 1) * 32768);
        ATT_ISSUE2(vimg, 2 * T + 2, 65536 + (j ^ 1) * 32768);
        const LAS unsigned char* Ks = F.lds + j * 32768 + kfb; const LAS unsigned char* Vs = F.lds + 65536 + j * 32768 + vfb;
        ATT_STEP(Ks, Vs, true);
        ATT_STEP(Ks + 16384, Vs + 16384, T < 31);
        asm volatile("s_waitcnt vmcnt(0)" ::: "memory");
        __syncthreads();
    }
#undef ATT_EXPQ
#undef ATT_STEP
#undef ATT_VLOAD
#undef ATT_PV
#undef ATT_ISSUE2
    lsum += __shfl_xor(lsum, 32);
    LAS float* X = (LAS float*)(F.lds + 65536) + rg * 4096 + r32;
    if (p == 1) {
        const float sc = lam / lsum;
#pragma unroll
        for (int vt = 0; vt < 4; ++vt)
#pragma unroll
            for (int i = 0; i < 16; ++i) X[(32 * vt + crow(i, hh)) * 32] = O[vt][i] * sc;
    }
    __syncthreads();
    if (p == 0) {
        const float i0 = 1.f / lsum;
        float ssq = 0.f;
#pragma unroll
        for (int vt = 0; vt < 4; ++vt)
#pragma unroll
            for (int i = 0; i < 16; ++i) { const float o = O[vt][i] * i0 - X[(32 * vt + crow(i, hh)) * 32]; O[vt][i] = o; ssq += o * o; }
        ssq += __shfl_xor(ssq, 32);
        const float rs = rsqrtf(ssq * (1.f / 128.f) + EPS) * 0.8f;
        bf16_t* yp = (bf16_t*)(a.ws + WS_YA) + (size_t)(b * SEQ + qrow) * 512 + h * 128;
#pragma unroll
        for (int vt = 0; vt < 4; ++vt)
#pragma unroll
            for (int rgi = 0; rgi < 4; ++rgi) { const int vd = 32 * vt + 8 * rgi + 4 * hh; const f32x4 g = *(const f32x4*)(a.subln_g + vd);
                u32x2 w; w.x = pk2(O[vt][4 * rgi] * rs * g.x, O[vt][4 * rgi + 1] * rs * g.y); w.y = pk2(O[vt][4 * rgi + 2] * rs * g.z, O[vt][4 * rgi + 3] * rs * g.w);
                *(u32x2*)(yp + vd) = w; }
    }
    __syncthreads();
}

DI void mcombine_phase(const Ctx& F, const Args& a) {
    const int gw = F.bid * NWAVES + F.wave, NGW = F.G * NWAVES, lane = F.lane;
    const bf16_t* HD = (const bf16_t*)((const unsigned char*)a.out + DO_HD);
    float g[8];
#pragma unroll
    for (int i = 0; i < 8; ++i) g[i] = a.mnorm_g[lane * 8 + i];
    for (int m = gw; m < MTOK; m += NGW) {
        const u32x4 f = *(const u32x4*)(HD + (size_t)m * 512 + lane * 8), bw = *(const u32x4*)(HD + ((size_t)MTOK + m) * 512 + lane * 8);
        const u32x4 om = *(const u32x4*)((const bf16_t*)(a.ws + WS_PROJ) + (size_t)m * PS + C_OM + lane * 8);
        const u32x4 ya = *(const u32x4*)((const bf16_t*)(a.ws + WS_YA) + (size_t)m * 512 + lane * 8);
        float v[8];
        v[0] = bflo(f.x) + bflo(bw.x); v[1] = bfhi(f.x) + bfhi(bw.x); v[2] = bflo(f.y) + bflo(bw.y); v[3] = bfhi(f.y) + bfhi(bw.y);
        v[4] = bflo(f.z) + bflo(bw.z); v[5] = bfhi(f.z) + bfhi(bw.z); v[6] = bflo(f.w) + bflo(bw.w); v[7] = bfhi(f.w) + bfhi(bw.w);
        float ss = 0.f;
#pragma unroll
        for (int i = 0; i < 8; ++i) ss += v[i] * v[i];
        ss += __shfl_xor(ss, 1); ss += __shfl_xor(ss, 2); ss += __shfl_xor(ss, 4); ss += __shfl_xor(ss, 8);
        const float rstd = rsqrtf(ss * (1.f / 128.f) + EPS);
        float o[8];
        o[0] = bflo(om.x); o[1] = bfhi(om.x); o[2] = bflo(om.y); o[3] = bfhi(om.y); o[4] = bflo(om.z); o[5] = bfhi(om.z); o[6] = bflo(om.w); o[7] = bfhi(om.w);
#pragma unroll
        for (int i = 0; i < 8; ++i) v[i] = v[i] * rstd * g[i] * sigmoid_f(o[i]);
        u32x4 w; w.x = pk2(v[0], v[1]); w.y = pk2(v[2], v[3]); w.z = pk2(v[4], v[5]); w.w = pk2(v[6], v[7]);
        bf16_t* yp = (bf16_t*)(a.ws + WS_YMIX) + (size_t)m * DM + lane * 8;
        *(u32x4*)yp = w; *(u32x4*)(yp + 512) = ya;
    }
}

DI void router_finish(const float (&lg)[16], int lane, float* affrow, bool store) {
    float r8[8];
#pragma unroll
    for (int i = 0; i < 8; ++i) { const float keep = hh_sel(lane, 32) ? lg[8 + i] : lg[i], send = hh_sel(lane, 32) ? lg[i] : lg[8 + i]; r8[i] = keep + partner32(send, lane); }
    float r4[4];
#pragma unroll
    for (int i = 0; i < 4; ++i) { const float keep = hh_sel(lane, 16) ? r8[4 + i] : r8[i], send = hh_sel(lane, 16) ? r8[i] : r8[4 + i]; r4[i] = keep + partner16(send, lane); }
    float r2[2];
#pragma unroll
    for (int i = 0; i < 2; ++i) { const float keep = hh_sel(lane, 8) ? r4[2 + i] : r4[i], send = hh_sel(lane, 8) ? r4[i] : r4[2 + i]; r2[i] = keep + partner8(send); }
    float lgt; { const float keep = hh_sel(lane, 4) ? r2[1] : r2[0], send = hh_sel(lane, 4) ? r2[0] : r2[1]; lgt = keep + partner4(send, lane); }
    lgt += dpp_mov<DPP_XOR2>(lgt); lgt += dpp_mov<DPP_XOR1>(lgt);
    float mx = lgt; mx = fmaxf(mx, dpp_mov<DPP_ROR(8)>(mx)); mx = fmaxf(mx, dpp_mov<DPP_ROR(4)>(mx)); mx = xor16_max(mx); mx = xor32_max(mx);
    const float ex = __expf(lgt - mx); float sm = ex; sm += dpp_mov<DPP_ROR(8)>(sm); sm += dpp_mov<DPP_ROR(4)>(sm); sm = xor16_sum(sm); sm = xor32_sum(sm);
    if ((lane & 3) == 0 && store) affrow[lane >> 2] = ex / sm;
}
DI void p7_phase(const Ctx& F, const Args& a) {
    LAS f32x4* WRL = (LAS f32x4*)F.lds;
    for (int q = F.tid; q < 4096; q += NTHR) { const int k = q >> 2, g = q & 3; WRL[(g * 4 + (k & 3)) * 256 + ((k >> 2) & 63) + 64 * (k >> 8)] = *(const f32x4*)(a.w_router + k * 16 + g * 4); }
    __syncthreads();
    const int gw = F.bid * NWAVES + F.wave, NGW = F.G * NWAVES, lane = F.lane;
    const float* mod = (const float*)(a.ws + WS_MOD);
    unsigned char* H2 = a.ws + WS_H2; float* AFF = (float*)(a.ws + WS_AFF);
    for (int m = gw; m < MTOK; m += NGW) {
        const int b = m / SEQ;
        const f32x4* xr = (const f32x4*)(a.out + (size_t)m * DM) + lane;
        f32x4 v[4]; float s = 0.f;
#pragma unroll
        for (int j = 0; j < 4; ++j) { v[j] = xr[64 * j]; s += (v[j].x * v[j].x + v[j].y * v[j].y) + (v[j].z * v[j].z + v[j].w * v[j].w); }
        const float rstd = rsqrtf(wave_sum(s) * (1.f / DM) + EPS);
        float lg[16];
#pragma unroll
        for (int e = 0; e < 16; ++e) lg[e] = 0.f;
        unsigned* o4 = (unsigned*)(H2 + (size_t)m * DM) + lane;
#pragma unroll
        for (int j = 0; j < 4; ++j) {
            const f32x4 g = ((const f32x4*)a.norm2_g)[lane + 64 * j];
            const f32x4 sh = ((const f32x4*)(mod + (size_t)b * 6144 + 3072))[lane + 64 * j];
            const f32x4 sc = ((const f32x4*)(mod + (size_t)b * 6144 + 4096))[lane + 64 * j];
            const f32x4 hv = v[j] * rstd * g * (sc + 1.f) + sh;
            o4[64 * j] = pg8::pk4_fp8(hv.x, hv.y, hv.z, hv.w);
#pragma unroll
            for (int e = 0; e < 4; ++e) { const float he = hv[e];
#pragma unroll
                for (int g4 = 0; g4 < 4; ++g4) { const f32x4 w = WRL[(g4 * 4 + e) * 256 + lane + 64 * j];
                    lg[g4 * 4 + 0] += he * w.x; lg[g4 * 4 + 1] += he * w.y; lg[g4 * 4 + 2] += he * w.z; lg[g4 * 4 + 3] += he * w.w; } }
            __builtin_amdgcn_sched_barrier(0);
        }
        router_finish(lg, lane, AFF + (size_t)m * 16, true);
    }
    __syncthreads();
}

DI void topk_task(const Ctx& F, const Args& a, int task) {
    const int b = task >> 4, e = task & 15, tid = F.tid, lane = F.lane;
    const float* AFF = (const float*)(a.ws + WS_AFF) + (size_t)b * SEQ * 16 + e;
    LAS unsigned* hist = (LAS unsigned*)F.lds;
    LAS unsigned* sfx = hist + 256;
    LAS unsigned* misc = hist + 512;
    LAS int* lidx = (LAS int*)(F.lds + 4096);
    unsigned key[8];
#pragma unroll
    for (int i = 0; i < 8; ++i) key[i] = __float_as_uint(AFF[(size_t)(tid * 8 + i) * 16]);
    unsigned prefix = 0, krem = CAP;
#pragma unroll 1
    for (int pass = 0; pass < 4; ++pass) {
        const int shift = 24 - 8 * pass;
        if (tid < 256) hist[tid] = 0;
        __syncthreads();
#pragma unroll
        for (int i = 0; i < 8; ++i) { const bool in = pass == 0 ? true : ((key[i] >> (shift + 8)) == (prefix >> (shift + 8))); if (in) atomicAdd((unsigned*)&hist[(key[i] >> shift) & 255u], 1u); }
        __syncthreads();
        if (tid < 256) sfx[tid] = hist[tid];
        __syncthreads();
#pragma unroll 1
        for (int o = 1; o < 256; o <<= 1) { unsigned v = 0; if (tid < 256) v = sfx[tid] + (tid + o < 256 ? sfx[tid + o] : 0u); __syncthreads(); if (tid < 256) sfx[tid] = v; __syncthreads(); }
        if (tid < 256) { const unsigned incl = sfx[tid], excl = incl - hist[tid]; if (excl < krem && krem <= incl) { misc[0] = (unsigned)tid; misc[1] = krem - excl; } }
        __syncthreads();
        prefix |= misc[0] << shift; krem = misc[1];
        __syncthreads();
    }
    const unsigned T = prefix, need = krem;
    unsigned cg_ = 0, ce = 0;
#pragma unroll
    for (int i = 0; i < 8; ++i) { cg_ += key[i] > T; ce += key[i] == T; }
    unsigned sg = cg_, se = ce;
#pragma unroll
    for (int o = 1; o < 64; o <<= 1) { const unsigned tg = __shfl_up(sg, o), te = __shfl_up(se, o); if (lane >= o) { sg += tg; se += te; } }
    if (lane == 63) { misc[16 + F.wave] = sg; misc[32 + F.wave] = se; }
    __syncthreads();
    unsigned og = sg - cg_, oe = se - ce;
    for (int w = 0; w < F.wave; ++w) { og += misc[16 + w]; oe += misc[32 + w]; }
    int* SLOT = (int*)(a.ws + WS_SLOT) + (size_t)b * SEQ * 16 + e;
    float* VALS = (float*)(a.ws + WS_VALS) + (size_t)(e * 8 + b) * CAP;
    int* IDX = (int*)(a.ws + WS_IDX) + (size_t)(b * 16 + e) * CAP;
#pragma unroll
    for (int i = 0; i < 8; ++i) {
        const bool gt = key[i] > T, eq = key[i] == T; const bool sel = gt || (eq && oe < need);
        const unsigned pos = og + (oe < need ? oe : need);
        const int s = tid * 8 + i;
        SLOT[(size_t)s * 16] = sel ? (int)pos : -1;
        if (sel) { lidx[pos] = s; IDX[pos] = s; VALS[pos] = __uint_as_float(key[i]); }
        og += gt; oe += eq;
    }
    __syncthreads();
    const unsigned char* H2 = a.ws + WS_H2 + (size_t)b * SEQ * DM; unsigned char* XE = a.ws + WS_XE + (size_t)(e * 8 + b) * CAP * DM;
    for (int r0 = F.wave * 4; r0 < CAP; r0 += NWAVES * 4) { u32x4 v[4];
#pragma unroll
        for (int j = 0; j < 4; ++j) v[j] = ((const u32x4*)(H2 + (size_t)lidx[r0 + j] * DM))[lane];
#pragma unroll
        for (int j = 0; j < 4; ++j) ((u32x4*)(XE + (size_t)(r0 + j) * DM))[lane] = v[j]; }
    __syncthreads();
}

DI void final_phase(const Ctx& F, const Args& a) {
    const int gw = F.bid * NWAVES + F.wave, NGW = F.G * NWAVES, lane = F.lane;
    const float* mod = (const float*)(a.ws + WS_MOD); const int* SLOT = (const int*)(a.ws + WS_SLOT); const unsigned char* Y = a.ws + WS_Y;
    for (int m = gw; m < MTOK; m += NGW) {
        const int b = m / SEQ;
        const int sl = SLOT[(size_t)m * 16 + (lane & 15)];
        f32x4* op = (f32x4*)(a.out + (size_t)m * DM + lane * 16);
        f32x4 xv[4];
#pragma unroll
        for (int q = 0; q < 4; ++q) xv[q] = op[q];
        float acc[16];
#pragma unroll
        for (int i = 0; i < 16; ++i) acc[i] = 0.f;
#pragma unroll 1
        for (int e = 0; e < 16; ++e) { const int s = __shfl(sl, e);
            if (s >= 0) { const u32x4 w = *(const u32x4*)(Y + ((size_t)(e * 8 + b) * CAP + s) * DM + lane * 16);
#pragma unroll
                for (int q = 0; q < 4; ++q) { const unsigned ww = w[q];
                    const auto lo = __builtin_amdgcn_cvt_pk_f32_fp8((int)ww, false), hi = __builtin_amdgcn_cvt_pk_f32_fp8((int)ww, true);
                    acc[4 * q] += lo[0]; acc[4 * q + 1] += lo[1]; acc[4 * q + 2] += hi[0]; acc[4 * q + 3] += hi[1]; } } }
        const f32x4* gp = (const f32x4*)(mod + (size_t)b * 6144 + 5120 + lane * 16);
#pragma unroll
        for (int q = 0; q < 4; ++q) { const f32x4 g = gp[q] * (1.f / pg8::Y_PRESCALE); f32x4 o = xv[q]; o.x += g.x * acc[4 * q]; o.y += g.y * acc[4 * q + 1]; o.z += g.z * acc[4 * q + 2]; o.w += g.w * acc[4 * q + 3]; op[q] = o; }
    }
}

constexpr size_t WS_CTL = 0;
constexpr int CTL_ZERO_BYTES = 65536;
#define XB_TMO      128
#define XB_XCNT(j)  (256  + 64 * (j))
#define XB_XSUB(j)  (1280 + 64 * (j))
#define XB_XGEN(j)  (2304 + 64 * (j))
#define XB_TOP      3328
#define XB_TOPGEN   3392
#define XB_SPIN_CAP (1u << 18)
DI unsigned xb_ld(unsigned* p)              { return __hip_atomic_load(p, __ATOMIC_RELAXED, __HIP_MEMORY_SCOPE_AGENT); }
DI unsigned xb_add(unsigned* p, unsigned v) { return __hip_atomic_fetch_add(p, v, __ATOMIC_RELAXED, __HIP_MEMORY_SCOPE_AGENT); }
DI unsigned xb_xcc_id() { return (unsigned)__builtin_amdgcn_s_getreg((3 << 11) | 20) & 0xFu; }
#define XB_SPIN(cond, bar) do { unsigned _sp = 0; while (cond) { __builtin_amdgcn_s_sleep(1); \
    if ((++_sp & 255u) == 0u) { if (xb_ld(&(bar)[XB_TMO])) break; if (_sp > XB_SPIN_CAP) { atomicAdd(&(bar)[XB_TMO], 1u); break; } } } } while (0)
struct XcdBarrier { unsigned* bar; unsigned x; volatile LAS unsigned* st; };
DI XcdBarrier xcd_barrier_post(unsigned* bar, volatile LAS unsigned* st) {
    XcdBarrier b; b.bar = bar; b.x = xb_xcc_id(); b.st = st;
    if (threadIdx.x == 0) (void)xb_add(&bar[XB_XCNT(b.x)], 1u);
    return b;
}
DI void xcd_barrier_complete(unsigned* bar, unsigned x, unsigned& nloc, unsigned& nx) {
    const unsigned G = gridDim.x * gridDim.y * gridDim.z;
    unsigned sum, cnt, mine, sp = 0u;
    for (;;) {
        sum = 0u; cnt = 0u; mine = 0u;
#pragma unroll
        for (unsigned j = 0; j < 16; ++j) { const unsigned c = xb_ld(&bar[XB_XCNT(j)]); sum += c; cnt += (c > 0u) ? 1u : 0u; mine = (j == x) ? c : mine; }
        if (sum == G) break;
        __builtin_amdgcn_s_sleep(1);
        if ((++sp & 255u) == 0u) { if (xb_ld(&bar[XB_TMO])) break; if (sp > XB_SPIN_CAP) { atomicAdd(&bar[XB_TMO], 1u); break; } }
    }
    nloc = mine > 0u ? mine : 1u; nx = cnt > 0u ? cnt : 1u;
}
DI void xcd_barrier(const XcdBarrier& b) {
    asm volatile("s_waitcnt vmcnt(0)" ::: "memory");
    __syncthreads();
    if (threadIdx.x == 0) {
        unsigned* bar = b.bar;
        __builtin_amdgcn_s_waitcnt(0);
        unsigned nloc = b.st[0], nx = b.st[1];
        if (nloc == 0u) { xcd_barrier_complete(bar, b.x, nloc, nx); b.st[0] = nloc; b.st[1] = nx; }
        const unsigned old = xb_add(&bar[XB_XSUB(b.x)], 1u);
        const unsigned gen = old / nloc;
        if (old + 1u == (gen + 1u) * nloc) {
            __builtin_amdgcn_fence(__ATOMIC_RELEASE, "agent");
            asm volatile("s_waitcnt vmcnt(0)" ::: "memory");
            const unsigned og = xb_add(&bar[XB_TOP], 1u);
            const unsigned tg = og / nx;
            if (og + 1u == (tg + 1u) * nx) xb_add(&bar[XB_TOPGEN], 1u);
            else XB_SPIN(xb_ld(&bar[XB_TOPGEN]) == tg, bar);
            __builtin_amdgcn_fence(__ATOMIC_ACQUIRE, "agent");
            xb_add(&bar[XB_XGEN(b.x)], 1u);
            asm volatile("s_waitcnt vmcnt(0)" ::: "memory");
        } else {
            XB_SPIN(xb_ld(&bar[XB_XGEN(b.x)]) == gen, bar);
            __builtin_amdgcn_fence(__ATOMIC_ACQUIRE, "agent");
            asm volatile("s_waitcnt vmcnt(0)" ::: "memory");
        }
    }
    __syncthreads();
}

static_assert(sizeof(Args) == 22 * 8, "Args layout");
__global__ void __launch_bounds__(NTHR, 2) fwd_kernel(Args a_unused) {
    extern __shared__ __attribute__((aligned(16))) unsigned char lds_raw[];
    cg::grid_group grid = cg::this_grid();
    Ctx F; F.lds = (LAS unsigned char*)lds_raw; F.tid = threadIdx.x; F.lane = F.tid & 63; F.wave = __builtin_amdgcn_readfirstlane(F.tid >> 6); F.G = gridDim.x; F.bid = blockIdx.x;

    int lo, hi; { typedef __attribute__((address_space(4))) const volatile unsigned long long* kp_t; const unsigned long long ph = ((kp_t)__builtin_amdgcn_kernarg_segment_ptr())[21]; lo = (int)(unsigned)ph; hi = (int)(unsigned)(ph >> 32); }
#ifndef PHASE_MASK
#define PHASE_MASK 0xffff
#endif
#define IN(k) (((PHASE_MASK >> (k)) & 1) && lo <= (k) && (k) < hi)
    volatile LAS unsigned* bst = (volatile LAS unsigned*)(F.lds + LDS_BYTES - 64);
    if (F.tid < 2) bst[F.tid] = 0u;
    __syncthreads();
    XcdBarrier xbar;
    { const Args a0 = load_args(); xbar = xcd_barrier_post((unsigned*)(a0.ws + WS_CTL), bst); }
    volatile LAS unsigned long long* tsl = (volatile LAS unsigned long long*)(F.lds + LDS_BYTES - 256);
    if (PROBE_PHASE >= 0 && F.bid == 0 && F.tid == 0) tsl[0] = __builtin_amdgcn_s_memrealtime();
#define SEAM(k) do { if (IN(k) && IN((k) + 1)) { if ((k) == 0) grid.sync(); else xcd_barrier(xbar); } \
        if (PROBE_PHASE >= 0 && F.bid == 0 && F.tid == 0) tsl[(k) + 1] = __builtin_amdgcn_s_memrealtime(); } while (0)
    if (IN(0)) { const Args a = load_args();
#pragma unroll 1
        for (int rep = 0; rep < REP_P0; ++rep) p0_phase(F, a); }
    SEAM(0);
    if (IN(1)) { const Args a = load_args(); p1_phase(F, a); }
    SEAM(1);
    if (IN(2)) {
        const Args a = load_args();
        pg8::Gemm g{(const bf16_t*)a.out, (const bf16_t*)(a.ws + WS_WINT), MTOK, PS, DM, 1 << 30}; pg8::StaticOrder S; S.init(MTOK, PS, F.G, F.bid);
        pg8::EpiProj E{(bf16_t*)(a.ws + WS_PROJ), a.pos, a.qk_g, (bf16_t*)(a.ws + WS_KIMG), (bf16_t*)(a.ws + WS_VIMG)};
        pg8::gemm_phase<pg8::EpiProj, true, true>(F.lds, g, S, E);
        gates_tasks(F, a);
    }
    SEAM(2);
    if (IN(3)) {
        const Args a = load_args();
        for (int t = F.bid * NWAVES + F.wave; t < MTOK / 8 * 2; t += F.G * NWAVES) conv_task(F, a, t);
        for (int t = F.bid; t < 64; t += F.G) mscal_task(F, a, t);
    }
    SEAM(3);
    if (IN(4)) {
        const Args a = load_args();
        {
#pragma unroll 1
            for (int rep = 0; rep < REP_MSEQ; ++rep)
#pragma unroll 1
            for (int it = F.bid; it < 256; it += F.G) { const int xcd_ = it & 7, j_ = it >> 3; mseq_item(F, a, it, xcd_ * 4 + (j_ >> 3), (j_ >> 2) & 1, j_ & 3); }
        }
        float lam, cshift;
        { const float p01 = wave_sum(a.lam_p[F.lane] * a.lam_p[64 + F.lane]), p23 = wave_sum(a.lam_p[128 + F.lane] * a.lam_p[192 + F.lane]);
          lam = __expf(p01) - __expf(p23) + 0.2f;
          const float gq = wave_max(fabsf(a.qk_g[F.lane])), gk = wave_max(fabsf(a.qk_g[64 + F.lane]));
          cshift = 8.f * gq * gk * 1.4426950408889634f * 1.02f; }
        const int xcd = F.bid & 7, j = F.bid >> 3;
#pragma unroll 1
        for (int rep = 0; rep < REP_ATT; ++rep)
        for (int i = 0; i * F.G < 1024; ++i) {
            int u;
            if (F.G == 256) u = (xcd * 4 + i) * 32 + j; else u = i * F.G + F.bid;
            if (u < 1024) attn_unit(F, a, u >> 7, (u >> 5) & 3, u & 31, lam, cshift);
        }
    }
    SEAM(4);
    if (IN(5)) { const Args a = load_args(); mcombine_phase(F, a); }
    SEAM(5);
    if (IN(6)) {
        const Args a = load_args();
        pg8::Gemm g{(const bf16_t*)(a.ws + WS_YMIX), (const bf16_t*)(a.ws + WS_WOUTT), MTOK, DM, DM, 1 << 30}; pg8::StaticOrder S; S.init(MTOK, DM, F.G, F.bid);
        pg8::EpiX1 E{a.x, (const float*)(a.ws + WS_MOD), a.out};
        pg8::gemm_phase<pg8::EpiX1, true, true>(F.lds, g, S, E);
    }
    SEAM(6);
    if (IN(7)) { const Args a = load_args();
#pragma unroll 1
        for (int rep = 0; rep < REP_P7; ++rep) p7_phase(F, a); }
    SEAM(7);
    if (IN(8)) { const Args a = load_args(); for (int t = F.bid; t < BATCH * NEXP; t += F.G) topk_task(F, a, t); }
    SEAM(8);
    if (IN(9)) {
        const Args a = load_args();
        pg8::Gemm g{(const bf16_t*)(a.ws + WS_XE), (const bf16_t*)(a.ws + WS_WGUT), NPAIR, 4096, DM, 16};
        pg8::StaticOrder S; S.init(NPAIR, 4096, F.G, F.bid);
        pg8::EpiGU E{a.ws + WS_HH};
#pragma unroll 1
        for (int rep = 0; rep < REP_UP; ++rep)
        pg8::gemm_phase<pg8::EpiGU, true, true, true>(F.lds, g, S, E);
    }
    SEAM(9);
    if (IN(10)) {
        const Args a = load_args();
        pg8::Gemm g{(const bf16_t*)(a.ws + WS_HH), (const bf16_t*)(a.ws + WS_WDT), NPAIR, DM, DFF, 16};
        pg8::StaticOrder S; S.init(NPAIR, DM, F.G, F.bid);
        pg8::EpiDown E{a.ws + WS_Y, (const float*)(a.ws + WS_VALS)};
        pg8::gemm_phase<pg8::EpiDown, true, true, true>(F.lds, g, S, E);
    }
    SEAM(10);
    if (IN(11)) { const Args a = load_args(); final_phase(F, a); }
    if (PROBE_MSEQ_W >= 0 && F.bid == 0 && F.tid == 0) {
        const unsigned long long d = *(volatile LAS unsigned long long*)(F.lds + LDS_BYTES - 128), t1 = __builtin_amdgcn_s_memtime();
        while (__builtin_amdgcn_s_memtime() - t1 < 3ull * d) __builtin_amdgcn_s_sleep(8);
    }
    if (PROBE_PHASE >= 0 && F.bid == 0 && F.tid == 0) {
        const unsigned long long t1 = __builtin_amdgcn_s_memrealtime();
        const unsigned long long d = (PROBE_PHASE == 11 ? t1 : tsl[PROBE_PHASE + 1]) - tsl[PROBE_PHASE];
        while (__builtin_amdgcn_s_memrealtime() - t1 < 3ull * d) __builtin_amdgcn_s_sleep(8);
    }
#undef IN
#undef SEAM
}

extern "C" void kernel_launch(void* const* d_in, const int* in_sizes, int n_in, void* d_out, int out_size, void* d_ws, size_t ws_size, hipStream_t stream) {
    static int grid_blocks = 0;
    if (!grid_blocks) {
        int dev = 0, cus = 0, per_cu = 0;
        (void)hipGetDevice(&dev);
        (void)hipDeviceGetAttribute(&cus, hipDeviceAttributeMultiprocessorCount, dev);
        (void)hipFuncSetAttribute((const void*)fwd_kernel, hipFuncAttributeMaxDynamicSharedMemorySize, LDS_BYTES);
        (void)hipOccupancyMaxActiveBlocksPerMultiprocessor(&per_cu, (const void*)fwd_kernel, NTHR, LDS_BYTES);
        if (per_cu < 1) per_cu = 1;
        grid_blocks = cus;
        if (ws_size < WS_END) fprintf(stderr, "kernel_launch: workspace too small: %zu < %zu\n", ws_size, (size_t)WS_END);
    }
    (void)hipMemsetAsync((char*)d_ws + WS_CTL, 0, CTL_ZERO_BYTES, stream);
    Args a{};
    a.x = (const float*)d_in[0]; a.c = (const float*)d_in[1]; a.pos = (const int*)d_in[2]; a.norm1_g = (const float*)d_in[3]; a.norm2_g = (const float*)d_in[4];
    a.w_ada = (const float*)d_in[5]; a.b_ada = (const float*)d_in[6]; a.w_in = (const float*)d_in[7]; a.conv_w = (const float*)d_in[8]; a.gate_b = (const float*)d_in[9];
    a.mnorm_g = (const float*)d_in[10]; a.qk_g = (const float*)d_in[11]; a.lam_p = (const float*)d_in[12]; a.subln_g = (const float*)d_in[13]; a.w_out = (const float*)d_in[14];
    a.w_router = (const float*)d_in[15]; a.w_gate = (const float*)d_in[16]; a.w_up = (const float*)d_in[17]; a.w_down = (const float*)d_in[18];
    a.out = (float*)d_out; a.ws = (unsigned char*)d_ws; a.ph_lo = 0; a.ph_hi = 12;
    void* args[] = {&a};
    hipError_t e = hipLaunchCooperativeKernel((const void*)fwd_kernel, dim3(grid_blocks), dim3(NTHR), args, LDS_BYTES, stream);
    if (e != hipSuccess) fprintf(stderr, "cooperative launch failed: %s (grid %d)\n", hipGetErrorString(e), grid_blocks);
}
```

```cpp
#include <hip/hip_runtime.h>
#include <hip/hip_cooperative_groups.h>
#include <cstdio>
#include <cstdint>
namespace cg = cooperative_groups;

#define LAS __attribute__((address_space(3)))
#define DI __device__ __forceinline__
typedef unsigned short bf16_t;
typedef short bf16x8 __attribute__((ext_vector_type(8)));
typedef short s16x4 __attribute__((ext_vector_type(4)));
typedef float f32x2 __attribute__((ext_vector_type(2)));
typedef float f32x4 __attribute__((ext_vector_type(4)));
typedef float f32x16 __attribute__((ext_vector_type(16)));
typedef unsigned u32x2 __attribute__((ext_vector_type(2)));
typedef unsigned u32x4 __attribute__((ext_vector_type(4)));
typedef __bf16 bf16x2_t __attribute__((ext_vector_type(2)));

constexpr int BATCH = 8, SEQ = 4096, DM = 1024, MTOK = BATCH * SEQ;
constexpr int DIN = 3600, PS = 3584;
constexpr int NEXP = 16, CAP = 512, DFF = 2048;
constexpr int NPAIR = BATCH * NEXP * CAP;
constexpr float EPS = 1e-6f;
constexpr int C_QM = 0, C_KM = 512, C_VM = 1024, C_OM = 1536, C_QA = 2048, C_KA = 2560, C_VA = 3072;

constexpr size_t MiB = 1u << 20;
constexpr size_t WS_CTL = 0;
constexpr int CTL_ZERO_BYTES = 65536;
constexpr size_t WS_MOD = 1 * MiB;
constexpr size_t WS_GATES = 2 * MiB;
constexpr size_t WS_AFF = 4 * MiB;
constexpr size_t WS_IDX = 6 * MiB;
constexpr size_t WS_VALS = 6 * MiB + 256 * 1024;
constexpr size_t WS_MSC = 6 * MiB + 512 * 1024;
constexpr size_t WS_SLOT = 7 * MiB;
constexpr size_t WS_NLOC = 9 * MiB;
constexpr size_t WS_WINT = 11 * MiB;
constexpr size_t WS_WGT = 18 * MiB;
constexpr size_t WS_WOUTT = 19 * MiB;
constexpr size_t WS_WGUT = 21 * MiB;
constexpr size_t WS_WDT = 85 * MiB;
constexpr size_t WS_Y = 117 * MiB;
constexpr size_t WS_PROJ = 213 * MiB;
constexpr size_t WS_YMIX = 437 * MiB;
constexpr size_t WS_KIMG = 437 * MiB;
constexpr size_t WS_VIMG = 469 * MiB;
constexpr size_t WS_YA = 501 * MiB;
constexpr size_t WS_HH = 245 * MiB;
constexpr size_t WS_H2 = 437 * MiB;
constexpr size_t WS_XE = 469 * MiB;
constexpr size_t WS_END = 533 * MiB;

constexpr int LDS_BYTES = 163840;
constexpr int PROBE_MSEQ_W = -1;
constexpr int PROBE_PHASE = -1;
constexpr int REP_M1 = 1, REP_M3 = 1, REP_UP = 1, REP_P0 = 1, REP_SCAN = 1, REP_P7 = 1, REP_ATT = 1, REP_QKT = 1, REP_MSEQ = 1;
constexpr int NWAVES = 8, NTHR = 512;

DI unsigned pk2(float lo, float hi) { f32x2 v = {lo, hi}; bf16x2_t b = __builtin_convertvector(v, bf16x2_t); return __builtin_bit_cast(unsigned, b); }
DI float bflo(unsigned w) { return __uint_as_float(w << 16); }
DI float bfhi(unsigned w) { return __uint_as_float(w & 0xffff0000u); }
DI float bf2f(bf16_t v) { return __uint_as_float((unsigned)v << 16); }
template <int CTRL> DI float dpp_mov(float x) { return __builtin_bit_cast(float, __builtin_amdgcn_update_dpp(0, __builtin_bit_cast(int, x), CTRL, 0xf, 0xf, false)); }
#define DPP_XOR1 0xB1
#define DPP_XOR2 0x4E
#define DPP_ROR(n) (0x120 + (n))
DI float xor16_sum(float x) { const unsigned u = __builtin_bit_cast(unsigned, x); auto r = __builtin_amdgcn_permlane16_swap(u, u, false, false); return __builtin_bit_cast(float, (unsigned)r[0]) + __builtin_bit_cast(float, (unsigned)r[1]); }
DI float xor32_sum(float x) { const unsigned u = __builtin_bit_cast(unsigned, x); auto r = __builtin_amdgcn_permlane32_swap(u, u, false, false); return __builtin_bit_cast(float, (unsigned)r[0]) + __builtin_bit_cast(float, (unsigned)r[1]); }
DI float xor16_max(float x) { const unsigned u = __builtin_bit_cast(unsigned, x); auto r = __builtin_amdgcn_permlane16_swap(u, u, false, false); return fmaxf(__builtin_bit_cast(float, (unsigned)r[0]), __builtin_bit_cast(float, (unsigned)r[1])); }
DI float xor32_max(float x) { const unsigned u = __builtin_bit_cast(unsigned, x); auto r = __builtin_amdgcn_permlane32_swap(u, u, false, false); return fmaxf(__builtin_bit_cast(float, (unsigned)r[0]), __builtin_bit_cast(float, (unsigned)r[1])); }
template <int CTRL, int RM, int BM_> DI float dpp_mov_m(float oldv, float x) { return __builtin_bit_cast(float, __builtin_amdgcn_update_dpp(__builtin_bit_cast(int, oldv), __builtin_bit_cast(int, x), CTRL, RM, BM_, false)); }
DI float wave_prefix_sum(float v) {
    v += dpp_mov_m<0x111, 0xf, 0xf>(0.f, v); v += dpp_mov_m<0x112, 0xf, 0xf>(0.f, v); v += dpp_mov_m<0x114, 0xf, 0xe>(0.f, v); v += dpp_mov_m<0x118, 0xf, 0xc>(0.f, v);
    v += dpp_mov_m<0x142, 0xa, 0xf>(0.f, v); v += dpp_mov_m<0x143, 0xc, 0xf>(0.f, v);
    return v;
}
DI float wave_prefix_max(float v) {
    const float ninf = -__builtin_inff();
    v = fmaxf(v, dpp_mov_m<0x111, 0xf, 0xf>(ninf, v)); v = fmaxf(v, dpp_mov_m<0x112, 0xf, 0xf>(ninf, v)); v = fmaxf(v, dpp_mov_m<0x114, 0xf, 0xe>(ninf, v)); v = fmaxf(v, dpp_mov_m<0x118, 0xf, 0xc>(ninf, v));
    v = fmaxf(v, dpp_mov_m<0x142, 0xa, 0xf>(ninf, v)); v = fmaxf(v, dpp_mov_m<0x143, 0xc, 0xf>(ninf, v));
    return v;
}
DI float partner32(float x, int lane) { const unsigned u = __builtin_bit_cast(unsigned, x); auto r = __builtin_amdgcn_permlane32_swap(u, u, false, false); return __builtin_bit_cast(float, (unsigned)((lane & 32) ? r[0] : r[1])); }
DI float partner16(float x, int lane) { const unsigned u = __builtin_bit_cast(unsigned, x); auto r = __builtin_amdgcn_permlane16_swap(u, u, false, false); return __builtin_bit_cast(float, (unsigned)((lane & 16) ? r[0] : r[1])); }
DI float partner8(float x) { return dpp_mov<DPP_ROR(8)>(x); }
DI float partner4(float x, int lane) { const float a = dpp_mov<DPP_ROR(4)>(x), b = dpp_mov<DPP_ROR(12)>(x); return (lane & 4) ? a : b; }
DI float row_sum16(float v) { v += dpp_mov<DPP_XOR1>(v); v += dpp_mov<DPP_XOR2>(v); v += dpp_mov<DPP_ROR(4)>(v); v += dpp_mov<DPP_ROR(8)>(v); return v; }
DI float wave_sum(float v) { v = row_sum16(v); v = xor16_sum(v); return xor32_sum(v); }
DI float wave_max(float v) { v = fmaxf(v, dpp_mov<DPP_XOR1>(v)); v = fmaxf(v, dpp_mov<DPP_XOR2>(v)); v = fmaxf(v, dpp_mov<DPP_ROR(4)>(v)); v = fmaxf(v, dpp_mov<DPP_ROR(8)>(v)); v = xor16_max(v); return xor32_max(v); }
DI float sigmoid_f(float v) { return __builtin_amdgcn_rcpf(1.f + __builtin_amdgcn_exp2f(-1.4426950408889634f * v)); }
DI float silu_f(float v) { return v * sigmoid_f(v); }
DI float logsigmoid_f(float f) { return fminf(f, 0.f) - log1pf(__expf(-fabsf(f))); }
DI int swz16(int row) { return ((row & 3) << 2) | ((row >> 2) & 3); }
#define MFMA32(a, b, c) __builtin_amdgcn_mfma_f32_32x32x16_bf16((a), (b), (c), 0, 0, 0)
DI s16x4 trread(const LAS unsigned char* p) { return __builtin_bit_cast(s16x4, __builtin_amdgcn_ds_read_tr16_b64_v4i16((LAS s16x4*)p)); }
DI int crow(int r, int hh) { return (r & 3) + 8 * (r >> 2) + 4 * hh; }
DI bool hh_sel(int lane, int bit) { return (lane & bit) != 0; }

namespace pg8 {
constexpr int BM = 256, BK = 64, HALF = 128, HTB = HALF * BK * 2, STAGE_BYTES = 8 * HTB, NXCD = 8, WGM = 8;
DI int lds_byte(int r, int c) { const int st = (r >> 4) * 2 + (c >> 5), rr = r & 15, cc = c & 31, ob = rr * 64 + cc * 2; return st * 1024 + (ob ^ (((ob >> 9) & 1) << 5)); }
DI void stage_rc(int b, int& R, int& C) { const int st = b / 1024, sb = b % 1024, swz = sb ^ (((sb >> 9) & 1) << 5); R = (st >> 1) * 16 + swz / 64; C = (st & 1) * 32 + (swz % 64) / 2; }
DI int perm32(int rho) { const int n = rho >> 4, i = rho & 15; return 8 * (i >> 2) + 4 * n + (i & 3); }
struct Unit { int pm, pn; };
typedef int i32x4_t __attribute__((ext_vector_type(4)));
typedef int i32x8_t __attribute__((ext_vector_type(8)));
DI i32x8_t cat8(bf16x8 lo, bf16x8 hi) { const i32x4_t a = __builtin_bit_cast(i32x4_t, lo), b = __builtin_bit_cast(i32x4_t, hi); return __builtin_shufflevector(a, b, 0, 1, 2, 3, 4, 5, 6, 7); }
struct Gemm { const bf16_t* A; const bf16_t* Bt; int M, N, K, tpg; };
struct StaticOrder {
    int nM, nN, nwg, G, c;
    DI void init(int M, int N, int G_, int c_) { nM = M / BM; nN = N / BM; nwg = nM * nN; G = G_; c = c_; }
    DI bool next(int i, Unit& u) const {
        const long L = (long)i * G + c; if (L >= nwg) return false;
        int wgid = (int)L; { const int q = nwg / NXCD, r = nwg % NXCD, xcd = wgid % NXCD, off = wgid / NXCD; wgid = (xcd < r ? xcd * (q + 1) : r * (q + 1) + (xcd - r) * q) + off; }
        const int nig = WGM * nN, gid = wgid / nig, fm = gid * WGM, gsz = (nM - fm) < WGM ? (nM - fm) : WGM;
        u.pm = fm + ((wgid % nig) % gsz); u.pn = (wgid % nig) / gsz; return true;
    }
};

template <class Epi, bool ALIGN_EPI, bool SP2, bool FP8 = false>
DI void gemm_phase(LAS unsigned char* lds, const Gemm g, const StaticOrder& S, const Epi& E) {
    const int tid = threadIdx.x, wid = __builtin_amdgcn_readfirstlane(tid >> 6), lane = tid & 63, wr = wid >> 2, wc = wid & 3, fr = lane & 15, fq = lane >> 4;
    const int KB = FP8 ? g.K : 2 * g.K, nt = KB / (BK * 2);
    unsigned voffA[2], voffB[2];
#pragma unroll
    for (int i = 0; i < 2; ++i) { int R, C; stage_rc(tid * 16 + i * 8192, R, C); const int Rb = Epi::PERM ? ((R & ~31) + perm32(R & 31)) : R;
        voffA[i] = (unsigned)(R * KB + C * 2); voffB[i] = (unsigned)(Rb * KB + C * 2); }
    const size_t kstep = (size_t)(BK * 2);
    const size_t hstep = (size_t)HALF * KB;
    const size_t tstep = 2 * hstep;
    const size_t gstep = (size_t)g.N * KB;
    const unsigned ldsw = (unsigned)wid * 1024u;
    const int aoff = lds_byte(wr * 64 + fr, fq * 8), boff = lds_byte(wc * 32 + fr, fq * 8);
#define PG8_SA(b, h) (((b) * 2 + (h)) * HTB)
#define PG8_SB(b, h) ((4 + (b) * 2 + (h)) * HTB)
#define PG8_STAGE(bufoff, gbase, voff) do { _Pragma("unroll") for (int _i = 0; _i < 2; ++_i) \
        __builtin_amdgcn_global_load_lds((const unsigned*)((const char*)(gbase) + (voff)[_i]), (LAS unsigned*)(lds + (bufoff) + ldsw + _i * 8192), 16, 0, 0); } while (0)
#define PG8_LDA(dst, b, h) do { if constexpr (FP8) { _Pragma("unroll") for (int m = 0; m < 4; ++m) dst##8[m] = cat8(*(const LAS bf16x8*)(lds + PG8_SA(b, h) + aoff + m * 2048), *(const LAS bf16x8*)(lds + PG8_SA(b, h) + aoff + m * 2048 + 1024)); } \
        else { _Pragma("unroll") for (int m = 0; m < 4; ++m) _Pragma("unroll") for (int k = 0; k < 2; ++k) dst[m][k] = *(const LAS bf16x8*)(lds + PG8_SA(b, h) + aoff + m * 2048 + k * 1024); } } while (0)
#define PG8_LDB(dst, b, h) do { if constexpr (FP8) { _Pragma("unroll") for (int n = 0; n < 2; ++n) dst##8[n] = cat8(*(const LAS bf16x8*)(lds + PG8_SB(b, h) + boff + n * 2048), *(const LAS bf16x8*)(lds + PG8_SB(b, h) + boff + n * 2048 + 1024)); } \
        else { _Pragma("unroll") for (int n = 0; n < 2; ++n) _Pragma("unroll") for (int k = 0; k < 2; ++k) dst[n][k] = *(const LAS bf16x8*)(lds + PG8_SB(b, h) + boff + n * 2048 + k * 1024); } } while (0)
#define PG8_MMA(ai, bj, At, Bt) do { __builtin_amdgcn_s_setprio(1); \
        if constexpr (FP8) { _Pragma("unroll") for (int m = 0; m < 4; ++m) _Pragma("unroll") for (int n = 0; n < 2; ++n) \
            asm volatile("s_nop 1\n\tv_mfma_f32_16x16x128_f8f6f4 %0, %1, %2, %0" : "+v"(acc[ai][bj][m][n]) : "v"(Bt##8[n]), "v"(At##8[m])); } \
        else { _Pragma("unroll") for (int m = 0; m < 4; ++m) _Pragma("unroll") for (int n = 0; n < 2; ++n) _Pragma("unroll") for (int k = 0; k < 2; ++k) \
            acc[ai][bj][m][n] = __builtin_amdgcn_mfma_f32_16x16x32_bf16(Bt[n][k], At[m][k], acc[ai][bj][m][n], 0, 0, 0); } \
        __builtin_amdgcn_s_setprio(0); } while (0)
#define PG8_WAIT_V(n) asm volatile("s_waitcnt vmcnt(" #n ")" ::: "memory")
#define PG8_WAIT_L(n) asm volatile("s_waitcnt lgkmcnt(" #n ")" ::: "memory")
#define PG8_BAR __builtin_amdgcn_s_barrier()
#define PG8_SCHED __builtin_amdgcn_sched_barrier(0)
    Unit cur, nxt; int ui = 0;
    if (!S.next(0, cur)) return;
    f32x4 acc[2][2][4][2];
#pragma unroll
    for (int a = 0; a < 2; ++a)
#pragma unroll
        for (int b = 0; b < 2; ++b)
#pragma unroll
            for (int m = 0; m < 4; ++m)
#pragma unroll
                for (int n = 0; n < 2; ++n) acc[a][b][m][n] = (f32x4){0.f, 0.f, 0.f, 0.f};
    bf16x8 At[4][2], B0[2][2], B1[2][2]; i32x8_t At8[4], B08[2], B18[2];
    const char* cA = (const char*)g.A + (size_t)cur.pm * tstep; const char* cB = (const char*)g.Bt + (size_t)(cur.pm / g.tpg) * gstep + (size_t)cur.pn * tstep;
    if constexpr (SP2) {
        PG8_STAGE(PG8_SB(0, 0), cB, voffB); PG8_STAGE(PG8_SB(0, 1), cB + hstep, voffB); PG8_STAGE(PG8_SA(0, 0), cA, voffA); PG8_STAGE(PG8_SA(0, 1), cA + hstep, voffA);
        if (wr == 1) PG8_BAR;
        PG8_WAIT_V(2); PG8_BAR;
        PG8_STAGE(PG8_SB(1, 0), cB + kstep, voffB); PG8_STAGE(PG8_SA(1, 0), cA + kstep, voffA); PG8_STAGE(PG8_SB(1, 1), cB + hstep + kstep, voffB);
        PG8_WAIT_V(6); PG8_BAR;
    } else {
        PG8_STAGE(PG8_SB(0, 0), cB, voffB); PG8_STAGE(PG8_SA(0, 0), cA, voffA); PG8_STAGE(PG8_SB(0, 1), cB + hstep, voffB); PG8_STAGE(PG8_SA(0, 1), cA + hstep, voffA);
        if (wr == 1) PG8_BAR;
        PG8_WAIT_V(4); PG8_BAR;
        PG8_STAGE(PG8_SB(1, 0), cB + kstep, voffB); PG8_STAGE(PG8_SA(1, 0), cA + kstep, voffA); PG8_STAGE(PG8_SB(1, 1), cB + hstep + kstep, voffB);
        PG8_WAIT_V(6); PG8_BAR;
    }
    for (;;) {
        const bool has_next = S.next(ui + 1, nxt);
        const char* nA = has_next ? (const char*)g.A + (size_t)nxt.pm * tstep : cA;
        const char* nB = has_next ? (const char*)g.Bt + (size_t)(nxt.pm / g.tpg) * gstep + (size_t)nxt.pn * tstep : cB;
        for (int t = 0; t < nt; t += 2) {
            const bool last = (t == nt - 2);
            const char* a1 = cA + (size_t)(t + 1) * kstep;
            const char* a2 = last ? nA : cA + (size_t)(t + 2) * kstep; const char* b2 = last ? nB : cB + (size_t)(t + 2) * kstep;
            const char* a3 = a2 + kstep; const char* b3 = b2 + kstep;
            if constexpr (SP2) {
            PG8_LDB(B0, 0, 0); PG8_LDB(B1, 0, 1); PG8_SCHED; PG8_LDA(At, 0, 0); PG8_STAGE(PG8_SA(1, 1), a1 + hstep, voffA);
            PG8_WAIT_V(8); PG8_WAIT_L(0); PG8_BAR; PG8_MMA(0, 0, At, B0); PG8_MMA(0, 1, At, B1); PG8_BAR; PG8_SCHED;
            PG8_LDA(At, 0, 1); PG8_STAGE(PG8_SB(0, 0), b2, voffB); PG8_STAGE(PG8_SB(0, 1), b2 + hstep, voffB); PG8_STAGE(PG8_SA(0, 0), a2, voffA);
            PG8_WAIT_V(8); PG8_WAIT_L(0); PG8_BAR; PG8_MMA(1, 0, At, B0); PG8_MMA(1, 1, At, B1); PG8_BAR; PG8_SCHED;
            PG8_LDB(B0, 1, 0); PG8_LDB(B1, 1, 1); PG8_SCHED; PG8_LDA(At, 1, 0); PG8_STAGE(PG8_SA(0, 1), a2 + hstep, voffA);
            PG8_WAIT_V(8); PG8_WAIT_L(0); PG8_BAR; PG8_MMA(0, 0, At, B0); PG8_MMA(0, 1, At, B1); PG8_BAR; PG8_SCHED;
            PG8_LDA(At, 1, 1); PG8_STAGE(PG8_SB(1, 0), b3, voffB); PG8_STAGE(PG8_SB(1, 1), b3 + hstep, voffB); PG8_STAGE(PG8_SA(1, 0), a3, voffA);
            PG8_WAIT_V(8); PG8_WAIT_L(0); PG8_BAR; PG8_MMA(1, 0, At, B0); PG8_MMA(1, 1, At, B1); PG8_BAR; PG8_SCHED;
            } else {
            PG8_LDB(B0, 0, 0); PG8_SCHED; PG8_LDA(At, 0, 0); PG8_STAGE(PG8_SA(1, 1), a1 + hstep, voffA);
            PG8_WAIT_L(8); PG8_BAR; PG8_WAIT_L(0); PG8_MMA(0, 0, At, B0); PG8_BAR; PG8_SCHED;
            PG8_LDB(B1, 0, 1); PG8_STAGE(PG8_SB(0, 0), b2, voffB);
            PG8_BAR; PG8_WAIT_L(0); PG8_MMA(0, 1, At, B1); PG8_BAR;
            PG8_LDA(At, 0, 1); PG8_STAGE(PG8_SA(0, 0), a2, voffA);
            PG8_BAR; PG8_WAIT_L(0); PG8_MMA(1, 0, At, B0); PG8_BAR; PG8_SCHED;
            PG8_STAGE(PG8_SB(0, 1), b2 + hstep, voffB);
            PG8_WAIT_V(6); PG8_BAR; PG8_MMA(1, 1, At, B1); PG8_BAR;
            PG8_LDB(B0, 1, 0); PG8_SCHED; PG8_LDA(At, 1, 0); PG8_STAGE(PG8_SA(0, 1), a2 + hstep, voffA);
            PG8_WAIT_L(8); PG8_BAR; PG8_WAIT_L(0); PG8_MMA(0, 0, At, B0); PG8_BAR; PG8_SCHED;
            PG8_LDB(B1, 1, 1); PG8_STAGE(PG8_SB(1, 0), b3, voffB);
            PG8_BAR; PG8_WAIT_L(0); PG8_MMA(0, 1, At, B1); PG8_BAR;
            PG8_LDA(At, 1, 1); PG8_STAGE(PG8_SA(1, 0), a3, voffA);
            PG8_BAR; PG8_WAIT_L(0); PG8_MMA(1, 0, At, B0); PG8_BAR; PG8_SCHED;
            PG8_STAGE(PG8_SB(1, 1), b3 + hstep, voffB);
            PG8_WAIT_V(6); PG8_BAR; PG8_MMA(1, 1, At, B1); PG8_BAR;
            }
        }
        if constexpr (ALIGN_EPI) { if (wr == 0) PG8_BAR; }
        if constexpr (FP8) asm volatile("s_nop 15\n\ts_nop 7" ::: "memory");
        E(acc, cur, wr, wc, fr, fq);
        if (!has_next) break;
#pragma unroll
        for (int a = 0; a < 2; ++a)
#pragma unroll
            for (int b = 0; b < 2; ++b)
#pragma unroll
                for (int m = 0; m < 4; ++m)
#pragma unroll
                    for (int n = 0; n < 2; ++n) acc[a][b][m][n] = (f32x4){0.f, 0.f, 0.f, 0.f};
        cur = nxt; cA = nA; cB = nB; ++ui;
        if constexpr (ALIGN_EPI) { if (wr == 1) PG8_BAR; }
    }
    PG8_WAIT_V(0);
    if constexpr (!ALIGN_EPI) { if (wr == 0) PG8_BAR; }
    PG8_BAR;
#undef PG8_SA
#undef PG8_SB
#undef PG8_STAGE
#undef PG8_LDA
#undef PG8_LDB
#undef PG8_MMA
#undef PG8_WAIT_V
#undef PG8_WAIT_L
#undef PG8_BAR
#undef PG8_SCHED
}

struct EpiBf16 {
    static constexpr bool PERM = true;
    bf16_t* O; int ldc;
    DI void operator()(const f32x4 (&acc)[2][2][4][2], const Unit& u, int wr, int wc, int fr, int fq) const {
        const int row0 = u.pm * BM + wr * 64 + fr, col0 = u.pn * BM + wc * 32 + 8 * fq;
#pragma unroll
        for (int ai = 0; ai < 2; ++ai)
#pragma unroll
            for (int m = 0; m < 4; ++m) { bf16_t* rowp = O + (size_t)(row0 + ai * HALF + m * 16) * ldc + col0;
#pragma unroll
                for (int bj = 0; bj < 2; ++bj) { const f32x4 v0 = acc[ai][bj][m][0], v1 = acc[ai][bj][m][1];
                    u32x4 w; w.x = pk2(v0[0], v0[1]); w.y = pk2(v0[2], v0[3]); w.z = pk2(v1[0], v1[1]); w.w = pk2(v1[2], v1[3]);
                    *(u32x4*)(rowp + bj * HALF) = w; } }
    }
};
struct EpiProj {
    static constexpr bool PERM = true;
    bf16_t* O; const int* pos; const float* qk_g; bf16_t* kimg; bf16_t* vimg;
    DI void operator()(const f32x4 (&acc)[2][2][4][2], const Unit& u, int wr, int wc, int fr, int fq) const {
        const int row0 = u.pm * BM + wr * 64 + fr;
        if (u.pn < 8) {
            const int col0 = u.pn * BM + wc * 32 + 8 * fq;
#pragma unroll
            for (int ai = 0; ai < 2; ++ai)
#pragma unroll
                for (int m = 0; m < 4; ++m) { bf16_t* rowp = O + (size_t)(row0 + ai * HALF + m * 16) * PS + col0;
#pragma unroll
                    for (int bj = 0; bj < 2; ++bj) { const f32x4 v0 = acc[ai][bj][m][0], v1 = acc[ai][bj][m][1];
                        u32x4 w; w.x = pk2(v0[0], v0[1]); w.y = pk2(v0[2], v0[3]); w.z = pk2(v1[0], v1[1]); w.w = pk2(v1[2], v1[3]);
                        *(u32x4*)(rowp + bj * HALF) = w; } }
        } else if (u.pn < 12) {
            const int isk = (u.pn >= 10), hsub = 4 * (u.pn & 1) + wc, h = hsub >> 1, p = hsub & 1;
            const float* gp = qk_g + isk * 64 + 8 * fq;
            const f32x4 g00 = *(const f32x4*)gp, g01 = *(const f32x4*)(gp + 4), g10 = *(const f32x4*)(gp + 32), g11 = *(const f32x4*)(gp + 36);
            const float qs = isk ? 1.f : 0.125f * 1.4426950408889634f;
            const int lane = fr + 16 * fq;
#pragma unroll
            for (int ai = 0; ai < 2; ++ai)
#pragma unroll
                for (int m = 0; m < 4; ++m) { const int row = row0 + ai * HALF + m * 16;
                    f32x4 a0 = acc[ai][0][m][0], a1 = acc[ai][0][m][1], b0 = acc[ai][1][m][0], b1 = acc[ai][1][m][1];
                    float ss = (a0[0] * a0[0] + a0[1] * a0[1] + a0[2] * a0[2] + a0[3] * a0[3]) + (a1[0] * a1[0] + a1[1] * a1[1] + a1[2] * a1[2] + a1[3] * a1[3])
                             + (b0[0] * b0[0] + b0[1] * b0[1] + b0[2] * b0[2] + b0[3] * b0[3]) + (b1[0] * b1[0] + b1[1] * b1[1] + b1[2] * b1[2] + b1[3] * b1[3]);
                    ss = xor16_sum(ss); ss = xor32_sum(ss);
                    const float rstd = rsqrtf(ss * (1.f / 64.f) + EPS);
                    a0 = a0 * rstd * g00; a1 = a1 * rstd * g01; b0 = b0 * rstd * g10 * qs; b1 = b1 * rstd * g11 * qs;
                    const float pf = (float)pos[row];
                    f32x4 r0, r1;
#pragma unroll
                    for (int n = 0; n < 2; ++n)
#pragma unroll
                        for (int j = 0; j < 4; ++j) { const int i = 4 * n + j; const float own = n ? a1[j] : a0[j]; const float oth = partner16(own, lane);
                            const float frc = __builtin_amdgcn_fractf(pf * (exp2f(-(float)i * 0.125f * 18.931568569324174f) * 0.15915494309189535f));
                            const float sn = __builtin_amdgcn_sinf(frc), cs = __builtin_amdgcn_cosf(frc);
                            const float rot = (fq == 0) ? own * cs - oth * sn : own * cs + oth * sn;
                            const float o = (fq < 2) ? rot : own;
                            if (n) r1[j] = o; else r0[j] = o; }
                    r0 = r0 * qs; r1 = r1 * qs;
                    u32x4 w0, w1;
                    w0.x = pk2(r0[0], r0[1]); w0.y = pk2(r0[2], r0[3]); w0.z = pk2(r1[0], r1[1]); w0.w = pk2(r1[2], r1[3]);
                    w1.x = pk2(b0[0], b0[1]); w1.y = pk2(b0[2], b0[3]); w1.z = pk2(b1[0], b1[1]); w1.w = pk2(b1[2], b1[3]);
                    if (!isk) { bf16_t* rowp = O + (size_t)row * PS + C_QA + h * 128 + p * 64 + 8 * fq; *(u32x4*)rowp = w0; *(u32x4*)(rowp + 32) = w1; }
                    else { const int b = row / SEQ, t = row % SEQ; bf16_t* kp = kimg + ((size_t)((b * 4 + h) * 64 + (t >> 6))) * 8192 + (p * 8 + fq) * 512 + (t & 63) * 8;
                        *(u32x4*)kp = w0; *(u32x4*)(kp + 4 * 512) = w1; } }
        } else {
#pragma unroll
            for (int ai = 0; ai < 2; ++ai)
#pragma unroll
                for (int m = 0; m < 4; ++m) { const int row = row0 + ai * HALF + m * 16, b = row / SEQ, t = row % SEQ;
#pragma unroll
                    for (int bj = 0; bj < 2; ++bj) { const int h = 2 * (u.pn - 12) + bj; const f32x4 v0 = acc[ai][bj][m][0], v1 = acc[ai][bj][m][1];
                        u32x4 w; w.x = pk2(v0[0], v0[1]); w.y = pk2(v0[2], v0[3]); w.z = pk2(v1[0], v1[1]); w.w = pk2(v1[2], v1[3]);
                        *(u32x4*)(vimg + ((size_t)((b * 4 + h) * 64 + (t >> 6))) * 8192 + (wc * 4 + ((t & 63) >> 4)) * 512 + (t & 15) * 32 + fq * 8) = w; } }
        }
    }
};
struct EpiX1 {
    static constexpr bool PERM = false;
    const float* x; const float* mod; float* out;
    DI void operator()(const f32x4 (&acc)[2][2][4][2], const Unit& u, int wr, int wc, int fr, int fq) const {
        const int row0 = u.pm * BM + wr * 64 + fr, col0 = u.pn * BM + wc * 32 + 4 * fq;
        const int b = (u.pm * BM) / SEQ;
        const float* gp = mod + (size_t)b * 6144 + 2048 + col0;
#pragma unroll
        for (int bj = 0; bj < 2; ++bj)
#pragma unroll
            for (int n = 0; n < 2; ++n) { const f32x4 gv = *(const f32x4*)(gp + bj * HALF + n * 16);
#pragma unroll
                for (int ai = 0; ai < 2; ++ai)
#pragma unroll
                    for (int m = 0; m < 4; ++m) { const size_t off = (size_t)(row0 + ai * HALF + m * 16) * DM + col0 + bj * HALF + n * 16;
                        const f32x4 xv = *(const f32x4*)(x + off); *(f32x4*)(out + off) = xv + gv * acc[ai][bj][m][n]; } }
    }
};
DI unsigned pk4_fp8(float a, float b, float c, float d) { int w = __builtin_amdgcn_cvt_pk_fp8_f32(a, b, 0, false); w = __builtin_amdgcn_cvt_pk_fp8_f32(c, d, w, true); return (unsigned)w; }
constexpr float W_PRESCALE = 32.f, H_PRESCALE = 8.f;
struct EpiGU {
    static constexpr bool PERM = true;
    unsigned char* H;
    DI void operator()(const f32x4 (&acc)[2][2][4][2], const Unit& u, int wr, int wc, int fr, int fq) const {
        const int row0 = u.pm * BM + wr * 64 + fr, col0 = u.pn * HALF + wc * 32 + 8 * fq;
#pragma unroll
        for (int ai = 0; ai < 2; ++ai)
#pragma unroll
            for (int m = 0; m < 4; ++m) { unsigned char* rowp = H + (size_t)(row0 + ai * HALF + m * 16) * DFF + col0;
                float hv[8];
#pragma unroll
                for (int n = 0; n < 2; ++n)
#pragma unroll
                    for (int j = 0; j < 4; ++j) { const float gg = acc[ai][0][m][n][j] * (1.f / W_PRESCALE), uu = acc[ai][1][m][n][j] * (H_PRESCALE / W_PRESCALE); hv[n * 4 + j] = gg * __builtin_amdgcn_rcpf(1.f + __builtin_amdgcn_exp2f(-1.4426950408889634f * gg)) * uu; }
                u32x2 w; w.x = pk4_fp8(hv[0], hv[1], hv[2], hv[3]); w.y = pk4_fp8(hv[4], hv[5], hv[6], hv[7]);
                *(u32x2*)rowp = w; }
    }
};
constexpr float Y_PRESCALE = 64.f;
struct EpiDown {
    static constexpr bool PERM = true;
    unsigned char* Y; const float* vals;
    DI void operator()(const f32x4 (&acc)[2][2][4][2], const Unit& u, int wr, int wc, int fr, int fq) const {
        const int row0 = u.pm * BM + wr * 64 + fr, col0 = u.pn * BM + wc * 32 + 8 * fq;
#pragma unroll
        for (int ai = 0; ai < 2; ++ai)
#pragma unroll
            for (int m = 0; m < 4; ++m) { const int row = row0 + ai * HALF + m * 16; const float s = vals[row] * (Y_PRESCALE / (W_PRESCALE * H_PRESCALE)); unsigned char* rowp = Y + (size_t)row * DM + col0;
#pragma unroll
                for (int bj = 0; bj < 2; ++bj) { const f32x4 v0 = acc[ai][bj][m][0] * s, v1 = acc[ai][bj][m][1] * s;
                    u32x2 w; w.x = pk4_fp8(v0[0], v0[1], v0[2], v0[3]); w.y = pk4_fp8(v1[0], v1[1], v1[2], v1[3]);
                    *(u32x2*)(rowp + bj * HALF) = w; } }
    }
};
}

struct Args {
    const float* x; const float* c; const int* pos; const float* norm1_g; const float* norm2_g; const float* w_ada; const float* b_ada;
    const float* w_in; const float* conv_w; const float* gate_b; const float* mnorm_g; const float* qk_g; const float* lam_p; const float* subln_g;
    const float* w_out; const float* w_router; const float* w_gate; const float* w_up; const float* w_down;
    float* out; unsigned char* ws; int ph_lo, ph_hi;
};
struct Ctx {
    LAS unsigned char* lds; int tid, lane, wave, G, bid;
};
DI Args load_args() {
    typedef __attribute__((address_space(4))) const volatile unsigned long long* kp_t;
    kp_t kp = (kp_t)__builtin_amdgcn_kernarg_segment_ptr();
#define GP(T, i) ((T*)(__attribute__((address_space(1))) T*)kp[i])
    Args a;
    a.x = GP(const float, 0); a.c = GP(const float, 1); a.pos = GP(const int, 2); a.norm1_g = GP(const float, 3); a.norm2_g = GP(const float, 4);
    a.w_ada = GP(const float, 5); a.b_ada = GP(const float, 6); a.w_in = GP(const float, 7); a.conv_w = GP(const float, 8); a.gate_b = GP(const float, 9);
    a.mnorm_g = GP(const float, 10); a.qk_g = GP(const float, 11); a.lam_p = GP(const float, 12); a.subln_g = GP(const float, 13); a.w_out = GP(const float, 14);
    a.w_router = GP(const float, 15); a.w_gate = GP(const float, 16); a.w_up = GP(const float, 17); a.w_down = GP(const float, 18);
    a.out = GP(float, 19); a.ws = GP(unsigned char, 20);
#undef GP
    a.ph_lo = 0; a.ph_hi = 12;
    return a;
}

DI void tr_item64(const float* src, size_t ld_src, int k0, int c0, bf16_t* dst, size_t r0, int ld_dst, LAS float* scr  , int lane, size_t r1 = (size_t)-1) {
    const float* sp = src + (size_t)(k0 + (lane >> 4)) * ld_src + c0 + (lane & 15) * 4;
#pragma unroll 1
    for (int hf = 0; hf < 2; ++hf) {
        f32x4 v[8];
#pragma unroll
        for (int i = 0; i < 8; ++i) v[i] = *(const f32x4*)(sp + (size_t)(4 * (8 * hf + i)) * ld_src);
#pragma unroll
        for (int i = 0; i < 8; ++i) *(LAS f32x4*)(scr + (4 * (8 * hf + i) + (lane >> 4)) * 68 + (lane & 15) * 4) = v[i];
    }
    asm volatile("s_waitcnt lgkmcnt(0)" ::: "memory");
    const int c = lane & 7;
#pragma unroll
    for (int q = 0; q < 8; ++q) { const int n = 8 * q + (lane >> 3); const LAS float* s = scr + (8 * c) * 68 + n;
        u32x4 o; o.x = pk2(s[0 * 68], s[1 * 68]); o.y = pk2(s[2 * 68], s[3 * 68]); o.z = pk2(s[4 * 68], s[5 * 68]); o.w = pk2(s[6 * 68], s[7 * 68]);
        const size_t row = (r1 != (size_t)-1 && q >= 4) ? r1 + (n - 32) : r0 + n;
        *(u32x4*)(dst + row * ld_dst + k0 + 8 * c) = o; }
    asm volatile("s_waitcnt lgkmcnt(0)" ::: "memory");
}
DI void tr_item64_fp8(const float* src, size_t ld_src, int k0, int c0, unsigned char* dst, size_t r0, int ld_dst, float scale, LAS float* scr  , int lane) {
    const float* sp = src + (size_t)(k0 + (lane >> 4)) * ld_src + c0 + (lane & 15) * 4;
    {
        f32x4 v[16];
#pragma unroll
        for (int i = 0; i < 16; ++i) v[i] = __builtin_nontemporal_load((const f32x4*)(sp + (size_t)(4 * i) * ld_src));
#pragma unroll
        for (int i = 0; i < 16; ++i) *(LAS f32x4*)(scr + (4 * i + (lane >> 4)) * 68 + (lane & 15) * 4) = v[i] * scale;
    }
    asm volatile("s_waitcnt lgkmcnt(0)" ::: "memory");
    const int c = lane & 3;
#pragma unroll
    for (int q = 0; q < 4; ++q) { const int n = 16 * q + (lane >> 2); const LAS float* s = scr + (16 * c) * 68 + n;
        u32x4 o; o.x = pg8::pk4_fp8(s[0 * 68], s[1 * 68], s[2 * 68], s[3 * 68]); o.y = pg8::pk4_fp8(s[4 * 68], s[5 * 68], s[6 * 68], s[7 * 68]);
        o.z = pg8::pk4_fp8(s[8 * 68], s[9 * 68], s[10 * 68], s[11 * 68]); o.w = pg8::pk4_fp8(s[12 * 68], s[13 * 68], s[14 * 68], s[15 * 68]);
        *(u32x4*)(dst + (r0 + n) * ld_dst + k0 + 16 * c) = o; }
    asm volatile("s_waitcnt lgkmcnt(0)" ::: "memory");
}
DI void p0_phase(const Ctx& F, const Args& a) {
    if (F.bid < 96) {
        LAS float* sc = (LAS float*)F.lds; LAS float* part = (LAS float*)(F.lds + 32768);
        for (int i = F.tid; i < BATCH * DM; i += NTHR) sc[i] = silu_f(a.c[i]);
        __syncthreads();
        const int col = F.bid * 64 + F.lane;
        float acc[8];
#pragma unroll
        for (int b = 0; b < 8; ++b) acc[b] = 0.f;
        const int kb = F.wave * 128;
#pragma unroll 1
        for (int k0 = kb; k0 < kb + 128; k0 += 16) {
            float w[16];
            const float* wp = a.w_ada + (size_t)k0 * 6144 + col;
#pragma unroll
            for (int j = 0; j < 16; ++j) w[j] = wp[(size_t)j * 6144];
#pragma unroll
            for (int j = 0; j < 16; ++j)
#pragma unroll
                for (int b = 0; b < 8; ++b) acc[b] += sc[b * DM + k0 + j] * w[j];
        }
#pragma unroll
        for (int b = 0; b < 8; ++b) part[(F.wave * 8 + b) * 64 + F.lane] = acc[b];
        __syncthreads();
        { const int b = F.tid >> 6, l = F.tid & 63; float s = a.b_ada[F.bid * 64 + l];
#pragma unroll
          for (int w = 0; w < 8; ++w) s += part[(w * 8 + b) * 64 + l];
          ((float*)(a.ws + WS_MOD))[b * 6144 + F.bid * 64 + l] = s; }
        asm volatile("s_waitcnt vmcnt(0)" ::: "memory");
        __syncthreads();
        if (F.tid == 0) { __builtin_amdgcn_fence(__ATOMIC_RELEASE, "agent"); asm volatile("s_waitcnt vmcnt(0)" ::: "memory");
            __hip_atomic_fetch_add((unsigned*)(a.ws + WS_CTL) + 4096, 1u, __ATOMIC_RELAXED, __HIP_MEMORY_SCOPE_AGENT); }
    }
    LAS float* scr = (LAS float*)(F.lds + F.wave * 17408);
    const int gw = F.bid * NWAVES + F.wave, NGW = F.G * NWAVES;
    constexpr int I_IN = 16 * 56, I_OUT = 16 * 16, I_WG = 16, I_EX = 4096;
    constexpr int NITEMS = I_IN + I_OUT + I_EX + I_WG;
    bf16_t* WinT = (bf16_t*)(a.ws + WS_WINT); bf16_t* WgT = (bf16_t*)(a.ws + WS_WGT); bf16_t* WoutT = (bf16_t*)(a.ws + WS_WOUTT);
    for (int it = gw; it < NITEMS; it += NGW) {
        int r = it;
        if (r < I_IN) { const int kb = r / 56, nb = r % 56, n0 = nb * 64;
            if (n0 >= 2048 && n0 < 3072) { const int t0 = n0 & ~255, g = (n0 >> 6) & 3; tr_item64(a.w_in, DIN, kb * 64, n0 + 16, WinT, (size_t)(t0 + 32 * g), DM, scr, F.lane, (size_t)(t0 + 128 + 32 * g)); }
            else tr_item64(a.w_in, DIN, kb * 64, n0 + (n0 >= 2048 ? 16 : 0), WinT, n0, DM, scr, F.lane);
            continue; } r -= I_IN;
        if (r < I_OUT) { const int kb = r / 16, nb = r % 16; tr_item64(a.w_out, DM, kb * 64, nb * 64, WoutT, nb * 64, DM, scr, F.lane); continue; } r -= I_OUT;
        if (r < I_EX) { int e, mat, q;
            if (r < 1024) { e = 13; mat = 1 + (r >> 9); q = r & 511; } else { const int t = r - 1024; e = 14 + t / 1536; const int u = t % 1536; mat = u >> 9; q = u & 511; }
            if (mat < 2) { const int kb = q / 32, nb = q % 32, n0 = nb * 64; const float* src = (mat ? a.w_up : a.w_gate) + (size_t)e * DM * DFF;
                tr_item64_fp8(src, DFF, kb * 64, n0, a.ws + WS_WGUT + (size_t)e * 4096 * DM, (size_t)(n0 / 128) * 256 + (n0 % 128) + mat * 128, DM, pg8::W_PRESCALE, scr, F.lane); }
            else { const int kb = q / 16, nb = q % 16;
                tr_item64_fp8(a.w_down + (size_t)e * DFF * DM, DM, kb * 64, nb * 64, a.ws + WS_WDT + (size_t)e * DM * DFF, nb * 64, DFF, pg8::W_PRESCALE, scr, F.lane); }
            continue; } r -= I_EX;
        tr_item64(a.w_in, DIN, r * 64, 2048 - 48, WgT, 0, DM, scr, F.lane);
    }
    if (F.tid == 0) { unsigned* cnt = (unsigned*)(a.ws + WS_CTL) + 4096; unsigned sp = 0;
        while (__hip_atomic_load(cnt, __ATOMIC_RELAXED, __HIP_MEMORY_SCOPE_AGENT) < 96u && ++sp < (1u << 22)) __builtin_amdgcn_s_sleep(2);
        __builtin_amdgcn_fence(__ATOMIC_ACQUIRE, "agent"); asm volatile("s_waitcnt vmcnt(0)" ::: "memory"); }
    __syncthreads();
}

DI void p1_phase(const Ctx& F, const Args& a) {
    const int gw = F.bid * NWAVES + F.wave, NGW = F.G * NWAVES;
    const float* mod = (const float*)(a.ws + WS_MOD);
    bf16_t* H1 = (bf16_t*)a.out;
    for (int m0 = gw; m0 < MTOK; m0 += 2 * NGW) {
        const int m1 = m0 + NGW; const bool has1 = m1 < MTOK;
        const f32x4* xr0 = (const f32x4*)(a.x + (size_t)m0 * DM) + F.lane; const f32x4* xr1 = (const f32x4*)(a.x + (size_t)(has1 ? m1 : m0) * DM) + F.lane;
        f32x4 v0[4], v1[4]; float s0 = 0.f, s1 = 0.f;
#pragma unroll
        for (int j = 0; j < 4; ++j) { v0[j] = __builtin_nontemporal_load(xr0 + 64 * j); v1[j] = __builtin_nontemporal_load(xr1 + 64 * j); }
#pragma unroll
        for (int j = 0; j < 4; ++j) { s0 += (v0[j].x * v0[j].x + v0[j].y * v0[j].y) + (v0[j].z * v0[j].z + v0[j].w * v0[j].w); s1 += (v1[j].x * v1[j].x + v1[j].y * v1[j].y) + (v1[j].z * v1[j].z + v1[j].w * v1[j].w); }
#pragma unroll
        for (int o = 1; o < 64; o <<= 1) { s0 += __shfl_xor(s0, o); s1 += __shfl_xor(s1, o); }
        const float rstd0 = rsqrtf(s0 * (1.f / DM) + EPS), rstd1 = rsqrtf(s1 * (1.f / DM) + EPS);
        const int b0 = m0 / SEQ, b1 = (has1 ? m1 : m0) / SEQ;
        u32x2* o0 = (u32x2*)(H1 + (size_t)m0 * DM) + F.lane; u32x2* o1 = (u32x2*)(H1 + (size_t)m1 * DM) + F.lane;
#pragma unroll
        for (int j = 0; j < 4; ++j) {
            const f32x4 g = ((const f32x4*)a.norm1_g)[F.lane + 64 * j];
            { const f32x4 sh = ((const f32x4*)(mod + (size_t)b0 * 6144))[F.lane + 64 * j], sc = ((const f32x4*)(mod + (size_t)b0 * 6144 + 1024))[F.lane + 64 * j];
              const f32x4 h = v0[j] * rstd0 * g * (sc + 1.f) + sh; u32x2 w; w.x = pk2(h.x, h.y); w.y = pk2(h.z, h.w); o0[64 * j] = w; }
            if (has1) { const f32x4 sh = ((const f32x4*)(mod + (size_t)b1 * 6144))[F.lane + 64 * j], sc = ((const f32x4*)(mod + (size_t)b1 * 6144 + 1024))[F.lane + 64 * j];
              const f32x4 h = v1[j] * rstd1 * g * (sc + 1.f) + sh; u32x2 w; w.x = pk2(h.x, h.y); w.y = pk2(h.z, h.w); o1[64 * j] = w; }
        }
    }
}

DI void gates_tasks(const Ctx& F, const Args& a) {
    const int gw = F.bid * NWAVES + F.wave, NGW = F.G * NWAVES;
    const bf16_t* H1 = (const bf16_t*)a.out; const bf16_t* WgT = (const bf16_t*)(a.ws + WS_WGT) + 48 * DM; float* GT = (float*)(a.ws + WS_GATES);
    const float bias = a.gate_b[F.lane & 15];
    for (int task = gw; task < MTOK / 16; task += NGW) {
        const int row0 = task * 16;
        const bf16_t* ap = H1 + (size_t)(row0 + (F.lane & 15)) * DM + 8 * (F.lane >> 4);
        const bf16_t* bp = WgT + (size_t)(F.lane & 15) * DM + 8 * (F.lane >> 4);
        f32x4 acc = {0.f, 0.f, 0.f, 0.f};
        bf16x8 avs[32];
#pragma unroll
        for (int i = 0; i < 32; ++i) avs[i] = *(const bf16x8*)(ap + 32 * i);
#pragma unroll
        for (int i = 0; i < 32; ++i) { const bf16x8 bv = *(const bf16x8*)(bp + 32 * i); acc = __builtin_amdgcn_mfma_f32_16x16x32_bf16(avs[i], bv, acc, 0, 0, 0); }
#pragma unroll
        for (int r = 0; r < 4; ++r) GT[(size_t)(row0 + (F.lane >> 4) * 4 + r) * 16 + (F.lane & 15)] = acc[r] + bias;
    }
}

DI void qk_tile_task(const Ctx& F, const Args& a, int task) {
    const int b = task >> 6, tile = task & 63, r = F.lane, g = F.wave, h = g >> 1, p = g & 1;
    bf16_t* PROJ = (bf16_t*)(a.ws + WS_PROJ);
    const size_t tok = (size_t)b * SEQ + tile * 64 + r;
    float invf[8];
#pragma unroll
    for (int i = 0; i < 8; ++i) invf[i] = exp2f(-(float)i * 0.125f * 18.931568569324174f) * 0.15915494309189535f;
    const float pos = (float)a.pos[tok];
    float sn[8], cs[8];
#pragma unroll
    for (int i = 0; i < 8; ++i) { const float fr = __builtin_amdgcn_fractf(pos * invf[i]); sn[i] = __builtin_amdgcn_sinf(fr); cs[i] = __builtin_amdgcn_cosf(fr); }
#pragma unroll 1
    for (int isk = 0; isk < 2; ++isk) {
        u32x4* src = (u32x4*)(PROJ + tok * PS + (isk ? C_KA : C_QA) + g * 64);
        u32x4 w[8];
#pragma unroll
        for (int c = 0; c < 8; ++c) w[c] = src[c];
        float ss = 0.f;
#pragma unroll
        for (int c = 0; c < 8; ++c) { float t;
            t = bflo(w[c].x); ss += t * t; t = bfhi(w[c].x); ss += t * t; t = bflo(w[c].y); ss += t * t; t = bfhi(w[c].y); ss += t * t;
            t = bflo(w[c].z); ss += t * t; t = bfhi(w[c].z); ss += t * t; t = bflo(w[c].w); ss += t * t; t = bfhi(w[c].w); ss += t * t; }
        const float rstd = rsqrtf(ss * (1.f / 64.f) + EPS) * (isk ? 1.f : 0.125f * 1.4426950408889634f);
        const float* gp = a.qk_g + isk * 64;
        float v0[16];
        v0[0] = bflo(w[0].x); v0[1] = bfhi(w[0].x); v0[2] = bflo(w[0].y); v0[3] = bfhi(w[0].y); v0[4] = bflo(w[0].z); v0[5] = bfhi(w[0].z); v0[6] = bflo(w[0].w); v0[7] = bfhi(w[0].w);
        v0[8] = bflo(w[1].x); v0[9] = bfhi(w[1].x); v0[10] = bflo(w[1].y); v0[11] = bfhi(w[1].y); v0[12] = bflo(w[1].z); v0[13] = bfhi(w[1].z); v0[14] = bflo(w[1].w); v0[15] = bfhi(w[1].w);
#pragma unroll
        for (int i = 0; i < 16; ++i) v0[i] *= rstd * gp[i];
        float rr[16];
#pragma unroll
        for (int i = 0; i < 8; ++i) { rr[i] = v0[i] * cs[i] - v0[i + 8] * sn[i]; rr[i + 8] = v0[i + 8] * cs[i] + v0[i] * sn[i]; }
        u32x4 o[8];
        o[0].x = pk2(rr[0], rr[1]); o[0].y = pk2(rr[2], rr[3]); o[0].z = pk2(rr[4], rr[5]); o[0].w = pk2(rr[6], rr[7]);
        o[1].x = pk2(rr[8], rr[9]); o[1].y = pk2(rr[10], rr[11]); o[1].z = pk2(rr[12], rr[13]); o[1].w = pk2(rr[14], rr[15]);
#pragma unroll
        for (int c = 2; c < 8; ++c) { const f32x4 g0 = *(const f32x4*)(gp + c * 8), g1 = *(const f32x4*)(gp + c * 8 + 4);
            o[c].x = pk2(bflo(w[c].x) * rstd * g0.x, bfhi(w[c].x) * rstd * g0.y); o[c].y = pk2(bflo(w[c].y) * rstd * g0.z, bfhi(w[c].y) * rstd * g0.w);
            o[c].z = pk2(bflo(w[c].z) * rstd * g1.x, bfhi(w[c].z) * rstd * g1.y); o[c].w = pk2(bflo(w[c].w) * rstd * g1.z, bfhi(w[c].w) * rstd * g1.w); }
        if (isk == 0) {
#pragma unroll
            for (int c = 0; c < 8; ++c) src[c] = o[c];
        } else {
            u32x4* dst = (u32x4*)((bf16_t*)(a.ws + WS_KIMG) + ((size_t)((b * 4 + h) * 64 + tile)) * 8192) + r;
#pragma unroll
            for (int c = 0; c < 8; ++c) dst[(p * 8 + c) * 64] = o[c];
        }
    }
    {
        u32x4* dst = (u32x4*)((bf16_t*)(a.ws + WS_VIMG) + ((size_t)((b * 4 + h) * 64 + tile)) * 8192) + r;
#pragma unroll
        for (int cg = 2 * p; cg < 2 * p + 2; ++cg)
#pragma unroll
            for (int kg = 0; kg < 4; ++kg) {
                const u32x4 v = *(const u32x4*)(PROJ + ((size_t)b * SEQ + tile * 64 + 16 * kg + (r >> 2)) * PS + C_VA + h * 128 + 32 * cg + 8 * (r & 3));
                dst[(cg * 4 + kg) * 64] = v; }
    }
}

DI bf16x8 tr_frag_nat(const LAS unsigned char* img, int rowbase, int col0, int lane) {
    const int hh = lane >> 5, g16 = (lane >> 4) & 1, i = lane & 15;
    const int col = col0 + 16 * g16 + 4 * (i & 3), chunk = col >> 3, sub = (col & 7) * 2;
    const int r0 = rowbase + 8 * hh + (i >> 2), r1 = r0 + 4;
    const s16x4 lo = trread(img + r0 * 256 + ((chunk ^ swz16(r0)) << 4) + sub);
    const s16x4 hi = trread(img + r1 * 256 + ((chunk ^ swz16(r1)) << 4) + sub);
    return __builtin_shufflevector(lo, hi, 0, 1, 2, 3, 4, 5, 6, 7);
}
DI bf16x8 tr_frag_acc(const LAS unsigned char* img, int rowbase, int col0, int lane) {
    const int hh = lane >> 5, g16 = (lane >> 4) & 1, i = lane & 15;
    const int col = col0 + 16 * g16 + 4 * (i & 3), chunk = col >> 3, sub = (col & 7) * 2;
    const int r0 = rowbase + 4 * hh + (i >> 2), r1 = r0 + 8;
    const s16x4 lo = trread(img + r0 * 256 + ((chunk ^ swz16(r0)) << 4) + sub);
    const s16x4 hi = trread(img + r1 * 256 + ((chunk ^ swz16(r1)) << 4) + sub);
    return __builtin_shufflevector(lo, hi, 0, 1, 2, 3, 4, 5, 6, 7);
}
DI bf16x8 row_frag(const LAS unsigned char* img, int row, int chunk) { return *(const LAS bf16x8*)(img + row * 256 + ((chunk ^ swz16(row)) << 4)); }

DI void glds16_asm(const void* gsrc, unsigned lds_dst) { unsigned keep;
    asm volatile("s_mov_b32 %0, m0\n\ts_mov_b32 m0, %2\n\ts_nop 0\n\tglobal_load_lds_dwordx4 %1, off\n\ts_mov_b32 m0, %0" : "=&s"(keep) : "v"(gsrc), "s"(lds_dst) : "memory"); }
constexpr size_t DO_QC = 0, DO_KC = 32 * MiB, DO_HD = 64 * MiB;
constexpr size_t WS_SC = 7 * MiB;

DI void conv_task(const Ctx& F, const Args& a, int tw) {
    const int isk = tw & 1, tok0 = (tw >> 1) * 8, b = tok0 / SEQ, t0 = tok0 % SEQ, lane = F.lane;
    const bf16_t* src = (const bf16_t*)(a.ws + WS_PROJ) + (size_t)b * SEQ * PS + (isk ? C_KM : C_QM) + lane * 8;
    float cw[5][8];
#pragma unroll
    for (int j = 0; j < 5; ++j) { const f32x4 c0 = *(const f32x4*)(a.conv_w + j * 1024 + isk * 512 + lane * 8), c1 = *(const f32x4*)(a.conv_w + j * 1024 + isk * 512 + lane * 8 + 4);
        cw[j][0] = c0.x; cw[j][1] = c0.y; cw[j][2] = c0.z; cw[j][3] = c0.w; cw[j][4] = c1.x; cw[j][5] = c1.y; cw[j][6] = c1.z; cw[j][7] = c1.w; }
    u32x4 row[12];
#pragma unroll
    for (int r = 0; r < 12; ++r) { const int t = t0 + r - 2; row[r] = (u32x4){0u, 0u, 0u, 0u}; if (t >= 0 && t < SEQ) row[r] = *(const u32x4*)(src + (size_t)t * PS); }
    const int hd = lane >> 4, cc = lane & 15, cch = t0 >> 6, r0 = t0 & 63;
    bf16_t* tileb = (bf16_t*)((unsigned char*)a.out + (isk ? DO_KC : DO_QC)) + ((size_t)((b * 4 + hd) * 64 + cch)) * 8192;
    bf16_t* dst = isk ? tileb + ((cc >> 2) * 4 + (r0 >> 4)) * 512 + (r0 & 15) * 32 + (cc & 3) * 8 : tileb + cc * 512 + r0 * 8;
    const int dstride = isk ? 32 : 8;
    const float sc = isk ? 0.08838834764831845f : 1.f;
#pragma unroll
    for (int i = 0; i < 8; ++i) {
        float acc[8];
#pragma unroll
        for (int e = 0; e < 8; ++e) acc[e] = 0.f;
#pragma unroll
        for (int j = 0; j < 5; ++j) { const u32x4 w = row[i + j];
            acc[0] += bflo(w.x) * cw[j][0]; acc[1] += bfhi(w.x) * cw[j][1]; acc[2] += bflo(w.y) * cw[j][2]; acc[3] += bfhi(w.y) * cw[j][3];
            acc[4] += bflo(w.z) * cw[j][4]; acc[5] += bfhi(w.z) * cw[j][5]; acc[6] += bflo(w.w) * cw[j][6]; acc[7] += bfhi(w.w) * cw[j][7]; }
#pragma unroll
        for (int e = 0; e < 8; ++e) acc[e] = silu_f(acc[e]) * sc;
        u32x4 o; o.x = pk2(acc[0], acc[1]); o.y = pk2(acc[2], acc[3]); o.z = pk2(acc[4], acc[5]); o.w = pk2(acc[6], acc[7]);
        *(u32x4*)(dst + i * dstride) = o;
    }
}

DI void mscal_task(const Ctx& F, const Args& a, int chain) {
    const int b = chain >> 3, h = (chain >> 1) & 3, dir = chain & 1;
    const int s = dir ? 63 - F.lane : F.lane;
    const float* GT = (const float*)(a.ws + WS_GATES) + (size_t)b * SEQ * 16;
    float* SC = (float*)(a.ws + WS_SC) + (size_t)chain * 64 * 256; float* MSC = (float*)(a.ws + WS_MSC);
    LAS float* gl = (LAS float*)F.lds; LAS float* mll = gl + 64; LAS float* mpv = gl + 128; LAS float* mnw = gl + 192;
    float aa[8], ii[8];
#pragma unroll
    for (int i = 0; i < 8; ++i) { const int c = F.wave + 8 * i;
        const float ig = GT[(size_t)(c * 64 + s) * 16 + dir * 8 + h], fg = GT[(size_t)(c * 64 + s) * 16 + dir * 8 + 4 + h];
        const float av = wave_prefix_sum(logsigmoid_f(fg));
        aa[i] = av; ii[i] = ig;
        const float g = __builtin_bit_cast(float, __builtin_amdgcn_readlane(__builtin_bit_cast(int, av), 63)), ml = wave_max(g - av + ig);
        if (F.lane == 0) { gl[c] = g; mll[c] = ml; } }
    __syncthreads();
    if (F.tid == 0) { float m = 0.f;
        for (int st = 0; st < 64; ++st) { const int c = dir ? 63 - st : st; mpv[c] = m; const float mn = fmaxf(gl[c] + m, mll[c]); mnw[c] = mn; m = mn; } }
    __syncthreads();
#pragma unroll
    for (int i = 0; i < 8; ++i) { const int c = F.wave + 8 * i; const float mprev = mpv[c], mnew = mnw[c], g = gl[c];
        const float cterm = ii[i] - aa[i];
        const float cm = wave_prefix_max(cterm);
        const float il = aa[i] + mprev, mj = fmaxf(il, aa[i] + cm);
        float* o4 = SC + (size_t)c * 256 + s;
        o4[0] = (aa[i] - mj) * 1.4426950408889634f; o4[64] = cterm * 1.4426950408889634f; o4[128] = __expf(il - mj); o4[192] = __expf(-mj);
        if (F.lane == 0) { MSC[chain * 64 + c] = (g - mnew) * 1.4426950408889634f; MSC[4096 + chain * 64 + c] = __expf(g + mprev - mnew); } }
    __syncthreads();
}

DI const float* wsel3(int m, const float* p0, const float* p1, const float* p2) {
    const unsigned long long a0 = (unsigned long long)p0, a1 = (unsigned long long)p1, a2 = (unsigned long long)p2;
    const unsigned long long m1 = (unsigned long long)0 - (unsigned long long)(m == 1), m2 = (unsigned long long)0 - (unsigned long long)(m == 2);
    return (const float*)((a0 & ~(m1 | m2)) | (a1 & m1) | (a2 & m2));
}
DI void mseq_item(const Ctx& F, const Args& a, int item, int bh, int dir, int vs) {
    const int b = bh >> 2, h = bh & 3, chain = bh * 2 + dir, wid = F.wave, tid = F.tid, lane = F.lane, r32 = lane & 31, hh = lane >> 5;
    LAS unsigned char* QS = F.lds;
    LAS unsigned char* KS = F.lds + 32768;
    LAS unsigned char* VS = F.lds + 65536;
    LAS unsigned char* SCS = F.lds + 77824;
    LAS unsigned char* SD = F.lds + 80896;
    LAS unsigned char* CI = F.lds + 97280;
    LAS float* NV = (LAS float*)(F.lds + 113664);
    LAS float* gmv = NV + 256; LAS float* spv = gmv + 64;
    LAS unsigned char* HST = F.lds + 115712;
    const int cwi = wid < 4 ? wid : 4;
    const bool cwave = wid < 4 || wid == 7;
    const unsigned cscb = (unsigned)(uintptr_t)F.lds + 119808u + (unsigned)cwi * 8192u;
    const int cslot0 = (item * 5 + cwi) * 64;
    const float* const wg_ = a.w_gate; const float* const wu_ = a.w_up; const float* const wd_ = a.w_down;
    const bf16_t* QC = (const bf16_t*)((const unsigned char*)a.out + DO_QC) + (size_t)bh * 64 * 8192 + lane * 8;
    const bf16_t* KC = (const bf16_t*)((const unsigned char*)a.out + DO_KC) + (size_t)bh * 64 * 8192 + lane * 8;
    const bf16_t* VP = (const bf16_t*)(a.ws + WS_PROJ) + (size_t)b * SEQ * PS + C_VM + h * 128 + vs * 32 + (size_t)(16 * (wid & 3) + (lane >> 2)) * PS + 8 * (lane & 3);
    const float* SC = (const float*)(a.ws + WS_SC) + (size_t)chain * 64 * 256 + lane * 4;
    bf16_t* HD = (bf16_t*)((unsigned char*)a.out + DO_HD) + ((size_t)dir * MTOK + (size_t)b * SEQ) * 512 + h * 128 + vs * 32;
    if (tid < 64) { gmv[tid] = ((const float*)(a.ws + WS_MSC))[chain * 64 + tid]; spv[tid] = ((const float*)(a.ws + WS_MSC))[4096 + chain * 64 + tid]; }
    if (tid < 256) NV[tid] = 0.f;
    for (int i = tid; i < 4096; i += NTHR) ((LAS unsigned*)CI)[i] = 0u;
    const unsigned ldsb = (unsigned)(uintptr_t)F.lds;
#define MSEQ_ISSUE_QK(c, s2) do { const size_t _tb = (size_t)(c); \
        if (wid < 4) { _Pragma("unroll") for (int _i = 0; _i < 4; ++_i) \
                glds16_asm(QC + _tb * 8192 + (4 * wid + _i) * 512, (unsigned)__builtin_amdgcn_readfirstlane((int)(ldsb + (s2) * 16384 + (4 * wid + _i) * 1024))); } \
        else if (wid >= 6) { _Pragma("unroll") for (int _i = 0; _i < 8; ++_i) \
                glds16_asm(KC + _tb * 8192 + (8 * (wid - 6) + _i) * 512, (unsigned)__builtin_amdgcn_readfirstlane((int)(ldsb + 32768 + (s2) * 16384 + (8 * (wid - 6) + _i) * 1024))); } } while (0)
#define MSEQ_ISSUE_VS(c, s4) do { const size_t _tb = (size_t)(c); \
        if (wid < 4) glds16_asm(VP + _tb * 64 * PS, (unsigned)__builtin_amdgcn_readfirstlane((int)(ldsb + 65536 + (s4) * 4096 + wid * 1024))); \
        else if (wid == 6) glds16_asm(SC + _tb * 256, (unsigned)__builtin_amdgcn_readfirstlane((int)(ldsb + 77824 + (s4) * 1024))); } while (0)
    MSEQ_ISSUE_QK(dir ? 63 : 0, 0); MSEQ_ISSUE_VS(dir ? 63 : 0, 0);
#define MSEQ_CONV_ISSUE(id) do { const int _e = (id) / 6144, _r = (id) % 6144, _mat = _r >> 11, _rr = _r & 2047; \
        const int _N = _mat == 2 ? DM : DFF, _nb = _mat == 2 ? (_rr >> 7) : (_rr >> 6), _kb = _mat == 2 ? (_rr & 127) : (_rr & 63); \
        const float* _src = wsel3(_mat, wg_, wu_, wd_) + (size_t)_e * DM * DFF + (size_t)(16 * _kb + (lane >> 4)) * _N + 64 * _nb + 4 * (lane & 15); \
        _Pragma("unroll") for (int _i = 0; _i < 4; ++_i) glds16_asm(_src + (size_t)(4 * _i) * _N, (unsigned)__builtin_amdgcn_readfirstlane((int)(cscb + ((id) & 1) * 4096 + _i * 1024))); } while (0)
    if (cwave) MSEQ_CONV_ISSUE(cslot0);
    f32x16 Cacc[2];
#pragma unroll
    for (int i = 0; i < 16; ++i) { Cacc[0][i] = 0.f; Cacc[1][i] = 0.f; }
    const int qrd = hh * 1024 + r32 * 16;
    const int ktr = (8 * hh + ((lane & 15) >> 2)) * 64 + ((lane >> 4) & 1) * 32 + (lane & 3) * 8;
    f32x16 acc;
    float qn = 0.f;
#pragma unroll
    for (int i = 0; i < 16; ++i) acc[i] = 0.f;
    asm volatile("s_waitcnt vmcnt(0)" ::: "memory");
    __syncthreads();
    unsigned long long busy = 0, tb0 = 0; if (PROBE_MSEQ_W >= 0) tb0 = __builtin_amdgcn_s_memtime(); const unsigned long long titem0 = tb0;
#pragma unroll 1
    for (int st = 0; st <= 64; ++st) {
        const int c = dir ? 63 - st : st, s2 = st & 1; const int s3 = st % 3, s3p = (st + 2) % 3;
        if (st + 1 < 64) { MSEQ_ISSUE_QK(dir ? 62 - st : st + 1, s2 ^ 1); MSEQ_ISSUE_VS(dir ? 62 - st : st + 1, (st + 1) % 3);
            if (cwave) MSEQ_CONV_ISSUE(cslot0 + st + 1); }
        const LAS unsigned char* QT = QS + s2 * 16384; const LAS unsigned char* KT = KS + s2 * 16384; const LAS unsigned char* VT = VS + s3 * 4096;
        const LAS float* rt = (const LAS float*)(SCS + s3 * 1024); const LAS float* ct = rt + 64;
        if (wid < 4) {
            if (st < 64) {
                const int jt = wid >> 1, stt = wid & 1;
                const LAS unsigned char* qa = QT + qrd + jt * 512;
                const LAS unsigned char* kb = KT + (2 * stt + (r32 >> 4)) * 1024 + (r32 & 15) * 64 + hh * 16;
                const int j = 32 * jt + r32; const float rtj = rt[j];
                const LAS float* ctp = ct + 32 * stt + 4 * hh;
                f32x4 c4[4];
#pragma unroll
                for (int rg = 0; rg < 4; ++rg) c4[rg] = *(const LAS f32x4*)(ctp + 8 * rg);
                const float gm = gmv[c], sp = spv[c];
                const int ck = 4 * wid + (lane & 3), r0 = 4 * (lane >> 2);
                const LAS unsigned char* kr = KT + (ck >> 2) * 4096 + (r0 >> 4) * 1024 + (r0 & 15) * 64 + (ck & 3) * 16;
                u32x4 kw[4];
#pragma unroll
                for (int r = 0; r < 4; ++r) kw[r] = *(const LAS u32x4*)(kr + r * 64);
                const f32x4 ctn = *(const LAS f32x4*)(ct + r0);
                const LAS float* no = NV + s2 * 128 + 32 * wid + 8 * (lane & 3);
                const f32x4 o0 = *(const LAS f32x4*)no, o1 = *(const LAS f32x4*)(no + 4);
                f32x16 S;
                f32x16 S2;
#pragma unroll
                for (int i = 0; i < 16; ++i) { S[i] = 0.f; S2[i] = 0.f; }
#pragma unroll
                for (int ks = 0; ks < 8; ks += 2) { S = MFMA32(*(const LAS bf16x8*)(kb + (ks >> 1) * 4096), *(const LAS bf16x8*)(qa + ks * 2048), S);
                    S2 = MFMA32(*(const LAS bf16x8*)(kb + (ks >> 1) * 4096 + 32), *(const LAS bf16x8*)(qa + (ks + 1) * 2048), S2); }
#pragma unroll
                for (int i = 0; i < 16; ++i) S[i] += S2[i];
                float pa[8];
#pragma unroll
                for (int e = 0; e < 8; ++e) pa[e] = 0.f;
#pragma unroll
                for (int r = 0; r < 4; ++r) { const u32x4 w = kw[r]; const float ws_ = __builtin_amdgcn_exp2f(ctn[r] + gm);
                    pa[0] += ws_ * bflo(w.x); pa[1] += ws_ * bfhi(w.x); pa[2] += ws_ * bflo(w.y); pa[3] += ws_ * bfhi(w.y); pa[4] += ws_ * bflo(w.z); pa[5] += ws_ * bfhi(w.z); pa[6] += ws_ * bflo(w.w); pa[7] += ws_ * bfhi(w.w); }
#pragma unroll
                for (int e = 0; e < 8; ++e) { float t = pa[e]; t += dpp_mov<DPP_ROR(8)>(t); t += dpp_mov<DPP_ROR(4)>(t); t = xor16_sum(t); pa[e] = xor32_sum(t); }
                u32x2 sw2[4];
#pragma unroll
                for (int rg = 0; rg < 4; ++rg) { float v[4];
#pragma unroll
                    for (int e = 0; e < 4; ++e) { const int sc = 32 * stt + 8 * rg + 4 * hh + e; const bool ok = dir == 0 ? (sc <= j) : (sc >= j);
                        v[e] = S[4 * rg + e] * __builtin_amdgcn_exp2f(ok ? rtj + c4[rg][e] : -1.0e30f); }
                    sw2[rg].x = pk2(v[0], v[1]); sw2[rg].y = pk2(v[2], v[3]); }
                LAS unsigned char* sw = SD + s2 * 8192 + stt * 4096 + j * 16 + hh * 8;
#pragma unroll
                for (int rg = 0; rg < 4; ++rg) *(LAS u32x2*)(sw + rg * 1024) = sw2[rg];
                if (lane < 4) { LAS float* nn = NV + (s2 ^ 1) * 128 + 32 * wid + 8 * lane;
                    *(LAS f32x4*)nn = (f32x4){sp * o0.x + pa[0], sp * o0.y + pa[1], sp * o0.z + pa[2], sp * o0.w + pa[3]};
                    *(LAS f32x4*)(nn + 4) = (f32x4){sp * o1.x + pa[4], sp * o1.y + pa[5], sp * o1.z + pa[6], sp * o1.w + pa[7]}; }
            }
        } else if (wid < 6) {
            const int jt = wid - 4, jl = 32 * jt + r32;
            u32x2 hw[4]; bool have_h = false; int cp = 0;
            if (st > 0) {
                cp = dir ? 64 - st : st - 1; have_h = true;
                const LAS float* iw = (const LAS float*)(SCS + s3p * 1024) + 128; const LAS float* enm = iw + 64;
                const LAS unsigned char* SDp = SD + (s2 ^ 1) * 8192;
                const LAS unsigned char* sr = SDp + hh * 4096 + jl * 16;
                u32x4 w4[4];
#pragma unroll
                for (int ch = 0; ch < 4; ++ch) w4[ch] = *(const LAS u32x4*)(sr + ch * 1024);
                const float iwj = iw[jl], enj = enm[jl];
                const LAS unsigned char* sa = SDp + qrd + jt * 512; const LAS unsigned char* vb = VS + s3p * 4096 + ktr;
                float rsum = 0.f;
#pragma unroll
                for (int ch = 0; ch < 4; ++ch) { const u32x4 w = w4[ch];
                    rsum += (bflo(w.x) + bfhi(w.x)) + (bflo(w.y) + bfhi(w.y)) + (bflo(w.z) + bfhi(w.z)) + (bflo(w.w) + bfhi(w.w)); }
                rsum = xor32_sum(rsum);
                const float den = rsum + iwj * qn;
                const float rdj = 1.f / fmaxf(fabsf(den), enj);
#pragma unroll
                for (int i = 0; i < 16; ++i) acc[i] *= iwj;
#pragma unroll
                for (int ks = 0; ks < 4; ++ks) { const s16x4 lo = trread(vb + ks * 1024), hi = trread(vb + ks * 1024 + 256);
                    acc = MFMA32(__builtin_shufflevector(lo, hi, 0, 1, 2, 3, 4, 5, 6, 7), *(const LAS bf16x8*)(sa + ks * 2048), acc); }
#pragma unroll
                for (int rg = 0; rg < 4; ++rg) { hw[rg].x = pk2(acc[4 * rg] * rdj, acc[4 * rg + 1] * rdj); hw[rg].y = pk2(acc[4 * rg + 2] * rdj, acc[4 * rg + 3] * rdj); }
            }
            if (st < 64) {
                const LAS unsigned char* qa = QT + qrd + jt * 512;
                const LAS unsigned char* cb = CI + s2 * 8192 + hh * 512 + r32 * 16;
                const LAS unsigned char* qr = QT + hh * 8192 + jl * 16; const LAS float* np = NV + s2 * 128 + 64 * hh;
                f32x16 acc2;
#pragma unroll
                for (int i = 0; i < 16; ++i) { acc[i] = 0.f; acc2[i] = 0.f; }
#pragma unroll
                for (int ks = 0; ks < 8; ks += 2) { acc = MFMA32(*(const LAS bf16x8*)(cb + ks * 1024), *(const LAS bf16x8*)(qa + ks * 2048), acc);
                    acc2 = MFMA32(*(const LAS bf16x8*)(cb + (ks + 1) * 1024), *(const LAS bf16x8*)(qa + (ks + 1) * 2048), acc2); }
#pragma unroll
                for (int i = 0; i < 16; ++i) acc[i] += acc2[i];
                qn = 0.f;
#pragma unroll
                for (int ch = 0; ch < 8; ++ch) { const u32x4 w = *(const LAS u32x4*)(qr + ch * 1024); const f32x4 n0 = *(const LAS f32x4*)(np + ch * 8), n1 = *(const LAS f32x4*)(np + ch * 8 + 4);
                    qn += bflo(w.x) * n0.x + bfhi(w.x) * n0.y + bflo(w.y) * n0.z + bfhi(w.y) * n0.w + bflo(w.z) * n1.x + bfhi(w.z) * n1.y + bflo(w.w) * n1.z + bfhi(w.w) * n1.w; }
                qn = xor32_sum(qn);
            }
            if (have_h) {
                LAS unsigned char* hst = HST + jt * 2048;
#pragma unroll
                for (int rg = 0; rg < 4; ++rg) *(LAS u32x2*)(hst + r32 * 64 + (8 * rg + 4 * hh) * 2) = hw[rg];
                asm volatile("s_waitcnt lgkmcnt(0)" ::: "memory");
#pragma unroll
                for (int q = 0; q < 2; ++q) { const int row = 16 * q + (lane >> 2), part = lane & 3;
                    const u32x4 w = *(const LAS u32x4*)(hst + row * 64 + part * 16);
                    *(u32x4*)(HD + (size_t)(cp * 64 + 32 * jt + row) * 512 + part * 8) = w; }
            }
        } else if (st < 64) {
            const int u = wid - 6; const float gm = gmv[c], sp = spv[c];
            const LAS unsigned char* va = VT + ktr; const LAS unsigned char* ka = KT + ktr + (2 * u) * 4096;
            s16x4 vlo[4], vhi[4], k0l[4], k0h[4], k1l[4], k1h[4]; f32x4 cw0[4], cw1[4];
#pragma unroll
            for (int ks = 0; ks < 4; ++ks) { vlo[ks] = trread(va + ks * 1024); vhi[ks] = trread(va + ks * 1024 + 256);
                cw0[ks] = *(const LAS f32x4*)(ct + 16 * ks + 8 * hh); cw1[ks] = *(const LAS f32x4*)(ct + 16 * ks + 8 * hh + 4);
                k0l[ks] = trread(ka + ks * 1024); k0h[ks] = trread(ka + ks * 1024 + 256); k1l[ks] = trread(ka + 4096 + ks * 1024); k1h[ks] = trread(ka + 4096 + ks * 1024 + 256); }
#pragma unroll
            for (int i = 0; i < 16; ++i) { Cacc[0][i] *= sp; Cacc[1][i] *= sp; }
#pragma unroll
            for (int ks = 0; ks < 4; ++ks) {
                const s16x4 lo = vlo[ks], hi = vhi[ks]; const f32x4 e0 = cw0[ks], e1 = cw1[ks];
                u32x4 af;
                af.x = pk2(bf2f((bf16_t)lo[0]) * __builtin_amdgcn_exp2f(e0.x + gm), bf2f((bf16_t)lo[1]) * __builtin_amdgcn_exp2f(e0.y + gm));
                af.y = pk2(bf2f((bf16_t)lo[2]) * __builtin_amdgcn_exp2f(e0.z + gm), bf2f((bf16_t)lo[3]) * __builtin_amdgcn_exp2f(e0.w + gm));
                af.z = pk2(bf2f((bf16_t)hi[0]) * __builtin_amdgcn_exp2f(e1.x + gm), bf2f((bf16_t)hi[1]) * __builtin_amdgcn_exp2f(e1.y + gm));
                af.w = pk2(bf2f((bf16_t)hi[2]) * __builtin_amdgcn_exp2f(e1.z + gm), bf2f((bf16_t)hi[3]) * __builtin_amdgcn_exp2f(e1.w + gm));
                const bf16x8 afr = __builtin_bit_cast(bf16x8, af);
                Cacc[0] = MFMA32(__builtin_shufflevector(k0l[ks], k0h[ks], 0, 1, 2, 3, 4, 5, 6, 7), afr, Cacc[0]);
                Cacc[1] = MFMA32(__builtin_shufflevector(k1l[ks], k1h[ks], 0, 1, 2, 3, 4, 5, 6, 7), afr, Cacc[1]);
            }
            LAS unsigned char* cw = CI + (s2 ^ 1) * 8192 + (2 * u) * 2048 + r32 * 16 + hh * 8;
#pragma unroll
            for (int t2 = 0; t2 < 2; ++t2)
#pragma unroll
                for (int rg = 0; rg < 4; ++rg) { u32x2 w; w.x = pk2(Cacc[t2][4 * rg], Cacc[t2][4 * rg + 1]); w.y = pk2(Cacc[t2][4 * rg + 2], Cacc[t2][4 * rg + 3]); *(LAS u32x2*)(cw + t2 * 2048 + rg * 512) = w; }
        }
        if (PROBE_MSEQ_W >= 0) { asm volatile("s_waitcnt lgkmcnt(0)" ::: "memory"); busy += __builtin_amdgcn_s_memtime() - tb0; }
        if (cwave) {
            if (st + 1 < 64) asm volatile("s_waitcnt vmcnt(4)" ::: "memory"); else asm volatile("s_waitcnt vmcnt(0)" ::: "memory");
            if (st < 64) {
                const int id = cslot0 + st, e = id / 6144, r = id % 6144, mat = r >> 11, rr = r & 2047;
                const int nb = mat == 2 ? (rr >> 7) : (rr >> 6), kb = mat == 2 ? (rr & 127) : (rr & 63), n = 64 * nb + lane;
                unsigned char* dst = mat == 2 ? a.ws + WS_WDT + (size_t)e * DM * DFF + (size_t)n * DFF + 16 * kb
                                              : a.ws + WS_WGUT + (size_t)e * 4096 * DM + (size_t)((n >> 7) * 256 + (n & 127) + mat * 128) * DM + 16 * kb;
                const LAS float* CSC = (const LAS float*)(F.lds + 119808 + cwi * 8192 + (id & 1) * 4096);
                float cv[16];
#pragma unroll
                for (int k = 0; k < 16; ++k) cv[k] = CSC[k * 64 + lane] * pg8::W_PRESCALE;
                u32x4 o; o.x = pg8::pk4_fp8(cv[0], cv[1], cv[2], cv[3]); o.y = pg8::pk4_fp8(cv[4], cv[5], cv[6], cv[7]); o.z = pg8::pk4_fp8(cv[8], cv[9], cv[10], cv[11]); o.w = pg8::pk4_fp8(cv[12], cv[13], cv[14], cv[15]);
                *(u32x4*)dst = o;
            }
        } else if (wid == 6) asm volatile("s_waitcnt vmcnt(0)" ::: "memory");
        asm volatile("s_waitcnt lgkmcnt(0)" ::: "memory"); __builtin_amdgcn_s_barrier(); asm volatile("" ::: "memory");
        if (PROBE_MSEQ_W >= 0) tb0 = __builtin_amdgcn_s_memtime();
    }
    if (PROBE_MSEQ_W >= 0 && F.bid == 0 && lane == 0 && (wid == PROBE_MSEQ_W || (PROBE_MSEQ_W == 8 && wid == 0)))
        *(volatile LAS unsigned long long*)(F.lds + LDS_BYTES - 128) = (PROBE_MSEQ_W == 8) ? (__builtin_amdgcn_s_memtime() - titem0) : busy;
    asm volatile("s_waitcnt vmcnt(0)" ::: "memory");
#undef MSEQ_ISSUE_QK
#undef MSEQ_ISSUE_VS
#undef MSEQ_CONV_ISSUE
}

DI void glds16(const void* g, LAS unsigned char* l) { __builtin_amdgcn_global_load_lds((const unsigned*)g, (LAS unsigned*)l, 16, 0, 0); }
DI void attn_unit(const Ctx& F, const Args& a, int b, int h, int qb, float lam, float cshift) {
    const int lane = F.lane, wid = F.wave, r32 = lane & 31, hh = lane >> 5, rg = wid & 3, p = wid >> 2;
    const bf16_t* projb = (const bf16_t*)(a.ws + WS_PROJ) + (size_t)b * SEQ * PS;
    const int qrow = qb * 128 + rg * 32 + r32;
    bf16x8 qf[4];
    { const bf16_t* qp = projb + (size_t)qrow * PS + C_QA + h * 128 + p * 64 + hh * 8;
#pragma unroll
      for (int ks = 0; ks < 4; ++ks) qf[ks] = *(const bf16x8*)(qp + ks * 16); }
    const bf16_t* kimg = (const bf16_t*)(a.ws + WS_KIMG) + (size_t)(b * 4 + h) * 64 * 8192 + (4 * wid) * 512 + lane * 8;
    const bf16_t* vimg = (const bf16_t*)(a.ws + WS_VIMG) + (size_t)(b * 4 + h) * 64 * 8192 + (4 * wid) * 512 + lane * 8;
    const unsigned ldsw = (unsigned)__builtin_amdgcn_readfirstlane((int)(unsigned)(uintptr_t)F.lds + (4 * wid) * 1024);
#define ATT_ISSUE2(img, t0, ldsoff) do { const int _q0 = 4 * wid; const int _t = (t0) + (_q0 >> 4); const bf16_t* _tp = (img) + (size_t)(_t < 64 ? _t : 63) * 8192 - (size_t)(_q0 & 16) * 512; \
        const unsigned _d = (unsigned)__builtin_amdgcn_readfirstlane((int)(ldsw + (ldsoff))); \
        _Pragma("unroll") for (int _i = 0; _i < 4; ++_i) glds16_asm(_tp + _i * 512, _d + _i * 1024); } while (0)
    if (wid < 4) { const bf16_t* _tp = kimg; const unsigned _d = (unsigned)__builtin_amdgcn_readfirstlane((int)(ldsw + 32768));
#pragma unroll
        for (int _i = 0; _i < 4; ++_i) glds16_asm(_tp + _i * 512, _d + _i * 1024); }
    ATT_ISSUE2(kimg, 1, 0); ATT_ISSUE2(vimg, 0, 65536);
    f32x16 O[4];
#pragma unroll
    for (int vt = 0; vt < 4; ++vt)
#pragma unroll
        for (int i = 0; i < 16; ++i) O[vt][i] = 0.f;
    float lsum = 0.f;
    const int kfb = p * 8192 + hh * 1024 + r32 * 16;
    const int vfb = (4 * hh + ((lane & 15) >> 2)) * 64 + ((lane >> 4) & 1) * 32 + (lane & 3) * 8;
    bf16x8 pb[4], pc[4];
    asm volatile("s_waitcnt vmcnt(0)" ::: "memory");
    __syncthreads();
#define ATT_VLOAD(dst, Vb, kg) do { _Pragma("unroll") for (int vt = 0; vt < 4; ++vt) { \
        const s16x4 _lo = trread((Vb) + vt * 4096 + (kg) * 1024), _hi = trread((Vb) + vt * 4096 + (kg) * 1024 + 512); dst[vt] = __builtin_shufflevector(_lo, _hi, 0, 1, 2, 3, 4, 5, 6, 7); } } while (0)
#define ATT_PV(vf, kg, PIN) do { __builtin_amdgcn_s_setprio(1); _Pragma("unroll") for (int vt = 0; vt < 4; ++vt) O[vt] = MFMA32(vf[vt], PIN[kg], O[vt]); __builtin_amdgcn_s_setprio(0); } while (0)
#define ATT_EXPQ(S, o, dst) do { float _e[8]; _Pragma("unroll") for (int i = 0; i < 8; ++i) _e[i] = __builtin_amdgcn_exp2f(S[(o) + i]); \
        _Pragma("unroll") for (int i = 0; i < 8; ++i) ls = ls + _e[i]; \
        u32x4 _w; _w.x = pk2(_e[0], _e[1]); _w.y = pk2(_e[2], _e[3]); _w.z = pk2(_e[4], _e[5]); _w.w = pk2(_e[6], _e[7]); dst = __builtin_bit_cast(bf16x8, _w); } while (0)
#define ATT_STEP(Kb, Vb, on0, PIN, POUT) do { \
        bf16x8 kfa[4], kfb2[4], vA[4], vB[4]; float ls = 0.f; \
        _Pragma("unroll") for (int ks = 0; ks < 4; ++ks) { kfa[ks] = *(const LAS bf16x8*)((Kb) + ks * 2048); kfb2[ks] = *(const LAS bf16x8*)((Kb) + ks * 2048 + 512); } \
        ATT_VLOAD(vA, Vb, 0); \
        __builtin_amdgcn_s_setprio(1); \
        Sa = MFMA32(kfa[0], qf[0], negc); Sb = MFMA32(kfb2[0], qf[0], negc);        \
        _Pragma("unroll") for (int ks = 1; ks < 4; ++ks) { Sa = MFMA32(kfa[ks], qf[ks], Sa); Sb = MFMA32(kfb2[ks], qf[ks], Sb); } \
        __builtin_amdgcn_s_setprio(0); \
        ATT_VLOAD(vB, Vb, 1); ATT_PV(vA, 0, PIN); ATT_EXPQ(Sa, 0, POUT[0]); \
        ATT_VLOAD(vA, Vb, 2); ATT_PV(vB, 1, PIN); ATT_EXPQ(Sa, 8, POUT[1]); \
        ATT_VLOAD(vB, Vb, 3); ATT_PV(vA, 2, PIN); ATT_EXPQ(Sb, 0, POUT[2]); \
        ATT_PV(vB, 3, PIN); ATT_EXPQ(Sb, 8, POUT[3]); \
        lsum += (on0) ? ls : 0.f; } while (0)
    f32x16 Sa, Sb, negc;
#pragma unroll
    for (int i = 0; i < 16; ++i) negc[i] = -cshift;
    asm volatile("" : "+v"(negc));
    {
        const LAS unsigned char* Kb = F.lds + 32768 + kfb;
        Sa = MFMA32(*(const LAS bf16x8*)(Kb), qf[0], negc); Sb = MFMA32(*(const LAS bf16x8*)(Kb + 512), qf[0], negc);
#pragma unroll
        for (int ks = 1; ks < 4; ++ks) { Sa = MFMA32(*(const LAS bf16x8*)(Kb + ks * 2048), qf[ks], Sa); Sb = MFMA32(*(const LAS bf16x8*)(Kb + ks * 2048 + 512), qf[ks], Sb); }
        float ls = 0.f;
        ATT_EXPQ(Sa, 0, pb[0]); ATT_EXPQ(Sa, 8, pb[1]); ATT_EXPQ(Sb, 0, pb[2]); ATT_EXPQ(Sb, 8, pb[3]);
        lsum += ls;
    }
    __syncthreads();
#pragma unroll 1
    for (int T = 0; T < 32; ++T) {
        const int j = T & 1;
        ATT_ISSUE2(kimg, 2 * T + 3, (j ^ 1) * 32768);
        ATT_ISSUE2(vimg, 2 * T + 2, 65536 + (j ^ 1) * 32768);
        const LAS unsigned char* Ks = F.lds + j * 32768 + kfb; const LAS unsigned char* Vs = F.lds + 65536 + j * 32768 + vfb;
        ATT_STEP(Ks, Vs, true, pb, pc);
        ATT_STEP(Ks + 16384, Vs + 16384, T < 31, pc, pb);
        asm volatile("s_waitcnt vmcnt(0)" ::: "memory");
        __syncthreads();
    }
#undef ATT_EXPQ
#undef ATT_STEP
#undef ATT_VLOAD
#undef ATT_PV
#undef ATT_ISSUE2
    lsum += __shfl_xor(lsum, 32);
    LAS float* X = (LAS float*)(F.lds + 65536) + rg * 4096 + r32;
    if (p == 1) {
        const float sc = lam / lsum;
#pragma unroll
        for (int vt = 0; vt < 4; ++vt)
#pragma unroll
            for (int i = 0; i < 16; ++i) X[(32 * vt + crow(i, hh)) * 32] = O[vt][i] * sc;
    }
    __syncthreads();
    if (p == 0) {
        const float i0 = 1.f / lsum;
        float ssq = 0.f;
#pragma unroll
        for (int vt = 0; vt < 4; ++vt)
#pragma unroll
            for (int i = 0; i < 16; ++i) { const float o = O[vt][i] * i0 - X[(32 * vt + crow(i, hh)) * 32]; O[vt][i] = o; ssq += o * o; }
        ssq += __shfl_xor(ssq, 32);
        const float rs = rsqrtf(ssq * (1.f / 128.f) + EPS) * 0.8f;
        bf16_t* yp = (bf16_t*)(a.ws + WS_YA) + (size_t)(b * SEQ + qrow) * 512 + h * 128;
#pragma unroll
        for (int vt = 0; vt < 4; ++vt)
#pragma unroll
            for (int rgi = 0; rgi < 4; ++rgi) { const int vd = 32 * vt + 8 * rgi + 4 * hh; const f32x4 g = *(const f32x4*)(a.subln_g + vd);
                u32x2 w; w.x = pk2(O[vt][4 * rgi] * rs * g.x, O[vt][4 * rgi + 1] * rs * g.y); w.y = pk2(O[vt][4 * rgi + 2] * rs * g.z, O[vt][4 * rgi + 3] * rs * g.w);
                *(u32x2*)(yp + vd) = w; }
    }
    __syncthreads();
}

DI void mcombine_phase(const Ctx& F, const Args& a) {
    const int gw = F.bid * NWAVES + F.wave, NGW = F.G * NWAVES, lane = F.lane;
    const bf16_t* HD = (const bf16_t*)((const unsigned char*)a.out + DO_HD);
    float g[8];
#pragma unroll
    for (int i = 0; i < 8; ++i) g[i] = a.mnorm_g[lane * 8 + i];
    for (int m = gw; m < MTOK; m += NGW) {
        const u32x4 f = *(const u32x4*)(HD + (size_t)m * 512 + lane * 8), bw = *(const u32x4*)(HD + ((size_t)MTOK + m) * 512 + lane * 8);
        const u32x4 om = *(const u32x4*)((const bf16_t*)(a.ws + WS_PROJ) + (size_t)m * PS + C_OM + lane * 8);
        const u32x4 ya = *(const u32x4*)((const bf16_t*)(a.ws + WS_YA) + (size_t)m * 512 + lane * 8);
        float v[8];
        v[0] = bflo(f.x) + bflo(bw.x); v[1] = bfhi(f.x) + bfhi(bw.x); v[2] = bflo(f.y) + bflo(bw.y); v[3] = bfhi(f.y) + bfhi(bw.y);
        v[4] = bflo(f.z) + bflo(bw.z); v[5] = bfhi(f.z) + bfhi(bw.z); v[6] = bflo(f.w) + bflo(bw.w); v[7] = bfhi(f.w) + bfhi(bw.w);
        float ss = 0.f;
#pragma unroll
        for (int i = 0; i < 8; ++i) ss += v[i] * v[i];
        ss += __shfl_xor(ss, 1); ss += __shfl_xor(ss, 2); ss += __shfl_xor(ss, 4); ss += __shfl_xor(ss, 8);
        const float rstd = rsqrtf(ss * (1.f / 128.f) + EPS);
        float o[8];
        o[0] = bflo(om.x); o[1] = bfhi(om.x); o[2] = bflo(om.y); o[3] = bfhi(om.y); o[4] = bflo(om.z); o[5] = bfhi(om.z); o[6] = bflo(om.w); o[7] = bfhi(om.w);
#pragma unroll
        for (int i = 0; i < 8; ++i) v[i] = v[i] * rstd * g[i] * sigmoid_f(o[i]);
        u32x4 w; w.x = pk2(v[0], v[1]); w.y = pk2(v[2], v[3]); w.z = pk2(v[4], v[5]); w.w = pk2(v[6], v[7]);
        bf16_t* yp = (bf16_t*)(a.ws + WS_YMIX) + (size_t)m * DM + lane * 8;
        *(u32x4*)yp = w; *(u32x4*)(yp + 512) = ya;
    }
}

DI void router_finish(const float (&lg)[16], int lane, float* affrow, bool store) {
    float r8[8];
#pragma unroll
    for (int i = 0; i < 8; ++i) { const float keep = hh_sel(lane, 32) ? lg[8 + i] : lg[i], send = hh_sel(lane, 32) ? lg[i] : lg[8 + i]; r8[i] = keep + partner32(send, lane); }
    float r4[4];
#pragma unroll
    for (int i = 0; i < 4; ++i) { const float keep = hh_sel(lane, 16) ? r8[4 + i] : r8[i], send = hh_sel(lane, 16) ? r8[i] : r8[4 + i]; r4[i] = keep + partner16(send, lane); }
    float r2[2];
#pragma unroll
    for (int i = 0; i < 2; ++i) { const float keep = hh_sel(lane, 8) ? r4[2 + i] : r4[i], send = hh_sel(lane, 8) ? r4[i] : r4[2 + i]; r2[i] = keep + partner8(send); }
    float lgt; { const float keep = hh_sel(lane, 4) ? r2[1] : r2[0], send = hh_sel(lane, 4) ? r2[0] : r2[1]; lgt = keep + partner4(send, lane); }
    lgt += dpp_mov<DPP_XOR2>(lgt); lgt += dpp_mov<DPP_XOR1>(lgt);
    float mx = lgt; mx = fmaxf(mx, dpp_mov<DPP_ROR(8)>(mx)); mx = fmaxf(mx, dpp_mov<DPP_ROR(4)>(mx)); mx = xor16_max(mx); mx = xor32_max(mx);
    const float ex = __expf(lgt - mx); float sm = ex; sm += dpp_mov<DPP_ROR(8)>(sm); sm += dpp_mov<DPP_ROR(4)>(sm); sm = xor16_sum(sm); sm = xor32_sum(sm);
    if ((lane & 3) == 0 && store) affrow[lane >> 2] = ex / sm;
}
DI void p7_phase(const Ctx& F, const Args& a) {
    LAS f32x4* WRL = (LAS f32x4*)F.lds;
    for (int q = F.tid; q < 4096; q += NTHR) { const int k = q >> 2, g = q & 3; WRL[(g * 4 + (k & 3)) * 256 + ((k >> 2) & 63) + 64 * (k >> 8)] = *(const f32x4*)(a.w_router + k * 16 + g * 4); }
    __syncthreads();
    const int gw = F.bid * NWAVES + F.wave, NGW = F.G * NWAVES, lane = F.lane;
    const float* mod = (const float*)(a.ws + WS_MOD);
    unsigned char* H2 = a.ws + WS_H2; float* AFF = (float*)(a.ws + WS_AFF);
    for (int m = gw; m < MTOK; m += NGW) {
        const int b = m / SEQ;
        const f32x4* xr = (const f32x4*)(a.out + (size_t)m * DM) + lane;
        f32x4 v[4]; float s = 0.f;
#pragma unroll
        for (int j = 0; j < 4; ++j) { v[j] = xr[64 * j]; s += (v[j].x * v[j].x + v[j].y * v[j].y) + (v[j].z * v[j].z + v[j].w * v[j].w); }
        const float rstd = rsqrtf(wave_sum(s) * (1.f / DM) + EPS);
        float lg[16];
#pragma unroll
        for (int e = 0; e < 16; ++e) lg[e] = 0.f;
        unsigned* o4 = (unsigned*)(H2 + (size_t)m * DM) + lane;
#pragma unroll
        for (int j = 0; j < 4; ++j) {
            const f32x4 g = ((const f32x4*)a.norm2_g)[lane + 64 * j];
            const f32x4 sh = ((const f32x4*)(mod + (size_t)b * 6144 + 3072))[lane + 64 * j];
            const f32x4 sc = ((const f32x4*)(mod + (size_t)b * 6144 + 4096))[lane + 64 * j];
            const f32x4 hv = v[j] * rstd * g * (sc + 1.f) + sh;
            o4[64 * j] = pg8::pk4_fp8(hv.x, hv.y, hv.z, hv.w);
#pragma unroll
            for (int e = 0; e < 4; ++e) { const float he = hv[e];
#pragma unroll
                for (int g4 = 0; g4 < 4; ++g4) { const f32x4 w = WRL[(g4 * 4 + e) * 256 + lane + 64 * j];
                    lg[g4 * 4 + 0] += he * w.x; lg[g4 * 4 + 1] += he * w.y; lg[g4 * 4 + 2] += he * w.z; lg[g4 * 4 + 3] += he * w.w; } }
            __builtin_amdgcn_sched_barrier(0);
        }
        router_finish(lg, lane, AFF + (size_t)m * 16, true);
    }
    __syncthreads();
}

DI void topk_task(const Ctx& F, const Args& a, int task) {
    const int b = task >> 4, e = task & 15, tid = F.tid, lane = F.lane;
    const float* AFF = (const float*)(a.ws + WS_AFF) + (size_t)b * SEQ * 16 + e;
    LAS unsigned* hist = (LAS unsigned*)F.lds;
    LAS unsigned* sfx = hist + 256;
    LAS unsigned* misc = hist + 512;
    LAS int* lidx = (LAS int*)(F.lds + 4096);
    unsigned key[8];
#pragma unroll
    for (int i = 0; i < 8; ++i) key[i] = __float_as_uint(AFF[(size_t)(tid * 8 + i) * 16]);
    unsigned prefix = 0, krem = CAP;
#pragma unroll 1
    for (int pass = 0; pass < 4; ++pass) {
        const int shift = 24 - 8 * pass;
        if (tid < 256) hist[tid] = 0;
        __syncthreads();
#pragma unroll
        for (int i = 0; i < 8; ++i) { const bool in = pass == 0 ? true : ((key[i] >> (shift + 8)) == (prefix >> (shift + 8))); if (in) atomicAdd((unsigned*)&hist[(key[i] >> shift) & 255u], 1u); }
        __syncthreads();
        if (tid < 256) sfx[tid] = hist[tid];
        __syncthreads();
#pragma unroll 1
        for (int o = 1; o < 256; o <<= 1) { unsigned v = 0; if (tid < 256) v = sfx[tid] + (tid + o < 256 ? sfx[tid + o] : 0u); __syncthreads(); if (tid < 256) sfx[tid] = v; __syncthreads(); }
        if (tid < 256) { const unsigned incl = sfx[tid], excl = incl - hist[tid]; if (excl < krem && krem <= incl) { misc[0] = (unsigned)tid; misc[1] = krem - excl; } }
        __syncthreads();
        prefix |= misc[0] << shift; krem = misc[1];
        __syncthreads();
    }
    const unsigned T = prefix, need = krem;
    unsigned cg_ = 0, ce = 0;
#pragma unroll
    for (int i = 0; i < 8; ++i) { cg_ += key[i] > T; ce += key[i] == T; }
    unsigned sg = cg_, se = ce;
#pragma unroll
    for (int o = 1; o < 64; o <<= 1) { const unsigned tg = __shfl_up(sg, o), te = __shfl_up(se, o); if (lane >= o) { sg += tg; se += te; } }
    if (lane == 63) { misc[16 + F.wave] = sg; misc[32 + F.wave] = se; }
    __syncthreads();
    unsigned og = sg - cg_, oe = se - ce;
    for (int w = 0; w < F.wave; ++w) { og += misc[16 + w]; oe += misc[32 + w]; }
    int* SLOT = (int*)(a.ws + WS_SLOT) + (size_t)b * SEQ * 16 + e;
    float* VALS = (float*)(a.ws + WS_VALS) + (size_t)(e * 8 + b) * CAP;
    int* IDX = (int*)(a.ws + WS_IDX) + (size_t)(b * 16 + e) * CAP;
#pragma unroll
    for (int i = 0; i < 8; ++i) {
        const bool gt = key[i] > T, eq = key[i] == T; const bool sel = gt || (eq && oe < need);
        const unsigned pos = og + (oe < need ? oe : need);
        const int s = tid * 8 + i;
        SLOT[(size_t)s * 16] = sel ? (int)pos : -1;
        if (sel) { lidx[pos] = s; IDX[pos] = s; VALS[pos] = __uint_as_float(key[i]); }
        og += gt; oe += eq;
    }
    __syncthreads();
    const unsigned char* H2 = a.ws + WS_H2 + (size_t)b * SEQ * DM; unsigned char* XE = a.ws + WS_XE + (size_t)(e * 8 + b) * CAP * DM;
    for (int r0 = F.wave * 4; r0 < CAP; r0 += NWAVES * 4) { u32x4 v[4];
#pragma unroll
        for (int j = 0; j < 4; ++j) v[j] = ((const u32x4*)(H2 + (size_t)lidx[r0 + j] * DM))[lane];
#pragma unroll
        for (int j = 0; j < 4; ++j) ((u32x4*)(XE + (size_t)(r0 + j) * DM))[lane] = v[j]; }
    __syncthreads();
}

DI void final_phase(const Ctx& F, const Args& a) {
    const int gw = F.bid * NWAVES + F.wave, NGW = F.G * NWAVES, lane = F.lane;
    const float* mod = (const float*)(a.ws + WS_MOD); const int* SLOT = (const int*)(a.ws + WS_SLOT); const unsigned char* Y = a.ws + WS_Y;
    for (int m = gw; m < MTOK; m += NGW) {
        const int b = m / SEQ;
        const int sl = SLOT[(size_t)m * 16 + (lane & 15)];
        f32x4* op = (f32x4*)(a.out + (size_t)m * DM + lane * 16);
        f32x4 xv[4];
#pragma unroll
        for (int q = 0; q < 4; ++q) xv[q] = op[q];
        float acc[16];
#pragma unroll
        for (int i = 0; i < 16; ++i) acc[i] = 0.f;
#pragma unroll 1
        for (int e = 0; e < 16; ++e) { const int s = __shfl(sl, e);
            if (s >= 0) { const u32x4 w = *(const u32x4*)(Y + ((size_t)(e * 8 + b) * CAP + s) * DM + lane * 16);
#pragma unroll
                for (int q = 0; q < 4; ++q) { const unsigned ww = w[q];
                    const auto lo = __builtin_amdgcn_cvt_pk_f32_fp8((int)ww, false), hi = __builtin_amdgcn_cvt_pk_f32_fp8((int)ww, true);
                    acc[4 * q] += lo[0]; acc[4 * q + 1] += lo[1]; acc[4 * q + 2] += hi[0]; acc[4 * q + 3] += hi[1]; } } }
        const f32x4* gp = (const f32x4*)(mod + (size_t)b * 6144 + 5120 + lane * 16);
#pragma unroll
        for (int q = 0; q < 4; ++q) { const f32x4 g = gp[q] * (1.f / pg8::Y_PRESCALE); f32x4 o = xv[q]; o.x += g.x * acc[4 * q]; o.y += g.y * acc[4 * q + 1]; o.z += g.z * acc[4 * q + 2]; o.w += g.w * acc[4 * q + 3]; op[q] = o; }
    }
}

#define XB_TMO      128
#define XB_XCNT(j)  (256  + 64 * (j))
#define XB_XSUB(j)  (1280 + 64 * (j))
#define XB_XGEN(j)  (2304 + 64 * (j))
#define XB_TOP      3328
#define XB_TOPGEN   3392
#define XB_SPIN_CAP (1u << 18)
DI unsigned xb_ld(unsigned* p)              { return __hip_atomic_load(p, __ATOMIC_RELAXED, __HIP_MEMORY_SCOPE_AGENT); }
DI unsigned xb_add(unsigned* p, unsigned v) { return __hip_atomic_fetch_add(p, v, __ATOMIC_RELAXED, __HIP_MEMORY_SCOPE_AGENT); }
DI unsigned xb_xcc_id() { return (unsigned)__builtin_amdgcn_s_getreg((3 << 11) | 20) & 0xFu; }
#define XB_SPIN(cond, bar) do { unsigned _sp = 0; while (cond) { __builtin_amdgcn_s_sleep(1); \
    if ((++_sp & 255u) == 0u) { if (xb_ld(&(bar)[XB_TMO])) break; if (_sp > XB_SPIN_CAP) { atomicAdd(&(bar)[XB_TMO], 1u); break; } } } } while (0)
struct XcdBarrier { unsigned* bar; unsigned x; volatile LAS unsigned* st; };
DI XcdBarrier xcd_barrier_post(unsigned* bar, volatile LAS unsigned* st) {
    XcdBarrier b; b.bar = bar; b.x = xb_xcc_id(); b.st = st;
    if (threadIdx.x == 0) (void)xb_add(&bar[XB_XCNT(b.x)], 1u);
    return b;
}
DI void xcd_barrier_complete(unsigned* bar, unsigned x, unsigned& nloc, unsigned& nx) {
    const unsigned G = gridDim.x * gridDim.y * gridDim.z;
    unsigned sum, cnt, mine, sp = 0u;
    for (;;) {
        sum = 0u; cnt = 0u; mine = 0u;
#pragma unroll
        for (unsigned j = 0; j < 16; ++j) { const unsigned c = xb_ld(&bar[XB_XCNT(j)]); sum += c; cnt += (c > 0u) ? 1u : 0u; mine = (j == x) ? c : mine; }
        if (sum == G) break;
        __builtin_amdgcn_s_sleep(1);
        if ((++sp & 255u) == 0u) { if (xb_ld(&bar[XB_TMO])) break; if (sp > XB_SPIN_CAP) { atomicAdd(&bar[XB_TMO], 1u); break; } }
    }
    nloc = mine > 0u ? mine : 1u; nx = cnt > 0u ? cnt : 1u;
}
DI void xcd_barrier(const XcdBarrier& b) {
    asm volatile("s_waitcnt vmcnt(0)" ::: "memory");
    __syncthreads();
    if (threadIdx.x == 0) {
        unsigned* bar = b.bar;
        __builtin_amdgcn_s_waitcnt(0);
        unsigned nloc = b.st[0], nx = b.st[1];
        if (nloc == 0u) { xcd_barrier_complete(bar, b.x, nloc, nx); b.st[0] = nloc; b.st[1] = nx; }
        const unsigned old = xb_add(&bar[XB_XSUB(b.x)], 1u);
        const unsigned gen = old / nloc;
        if (old + 1u == (gen + 1u) * nloc) {
            __builtin_amdgcn_fence(__ATOMIC_RELEASE, "agent");
            asm volatile("s_waitcnt vmcnt(0)" ::: "memory");
            const unsigned og = xb_add(&bar[XB_TOP], 1u);
            const unsigned tg = og / nx;
            if (og + 1u == (tg + 1u) * nx) xb_add(&bar[XB_TOPGEN], 1u);
            else XB_SPIN(xb_ld(&bar[XB_TOPGEN]) == tg, bar);
            __builtin_amdgcn_fence(__ATOMIC_ACQUIRE, "agent");
            xb_add(&bar[XB_XGEN(b.x)], 1u);
            asm volatile("s_waitcnt vmcnt(0)" ::: "memory");
        } else {
            XB_SPIN(xb_ld(&bar[XB_XGEN(b.x)]) == gen, bar);
            __builtin_amdgcn_fence(__ATOMIC_ACQUIRE, "agent");
            asm volatile("s_waitcnt vmcnt(0)" ::: "memory");
        }
    }
    __syncthreads();
}

static_assert(sizeof(Args) == 22 * 8, "Args layout");
__global__ void __launch_bounds__(NTHR, 2) fwd_kernel(Args a_unused) {
    extern __shared__ __attribute__((aligned(16))) unsigned char lds_raw[];
    cg::grid_group grid = cg::this_grid();
    Ctx F; F.lds = (LAS unsigned char*)lds_raw; F.tid = threadIdx.x; F.lane = F.tid & 63; F.wave = __builtin_amdgcn_readfirstlane(F.tid >> 6); F.G = gridDim.x; F.bid = blockIdx.x;

    int lo, hi; { typedef __attribute__((address_space(4))) const volatile unsigned long long* kp_t; const unsigned long long ph = ((kp_t)__builtin_amdgcn_kernarg_segment_ptr())[21]; lo = (int)(unsigned)ph; hi = (int)(unsigned)(ph >> 32); }
#ifndef PHASE_MASK
#define PHASE_MASK 0xffff
#endif
#define IN(k) (((PHASE_MASK >> (k)) & 1) && lo <= (k) && (k) < hi)
    volatile LAS unsigned* bst = (volatile LAS unsigned*)(F.lds + LDS_BYTES - 64);
    if (F.tid < 2) bst[F.tid] = 0u;
    __syncthreads();
    XcdBarrier xbar;
    { const Args a0 = load_args(); xbar = xcd_barrier_post((unsigned*)(a0.ws + WS_CTL), bst); }
    volatile LAS unsigned long long* tsl = (volatile LAS unsigned long long*)(F.lds + LDS_BYTES - 256);
    if (PROBE_PHASE >= 0 && F.bid == 0 && F.tid == 0) tsl[0] = __builtin_amdgcn_s_memrealtime();
#define SEAM(k) do { if (IN(k) && IN((k) + 1)) { xcd_barrier(xbar); } \
        if (PROBE_PHASE >= 0 && F.bid == 0 && F.tid == 0) tsl[(k) + 1] = __builtin_amdgcn_s_memrealtime(); } while (0)
    grid.sync();
    if (IN(0)) { const Args a = load_args(); p0_phase(F, a); p1_phase(F, a); }
    if (PROBE_PHASE >= 0 && F.bid == 0 && F.tid == 0) tsl[1] = __builtin_amdgcn_s_memrealtime();
    SEAM(1);
    if (IN(2)) {
        const Args a = load_args();
        pg8::Gemm g{(const bf16_t*)a.out, (const bf16_t*)(a.ws + WS_WINT), MTOK, PS, DM, 1 << 30}; pg8::StaticOrder S; S.init(MTOK, PS, F.G, F.bid);
        pg8::EpiProj E{(bf16_t*)(a.ws + WS_PROJ), a.pos, a.qk_g, (bf16_t*)(a.ws + WS_KIMG), (bf16_t*)(a.ws + WS_VIMG)};
        pg8::gemm_phase<pg8::EpiProj, true, true>(F.lds, g, S, E);
        gates_tasks(F, a);
    }
    SEAM(2);
    if (IN(3)) {
        const Args a = load_args();
        for (int t = F.bid * NWAVES + F.wave; t < MTOK / 8 * 2; t += F.G * NWAVES) conv_task(F, a, t);
        for (int t = F.bid; t < 64; t += F.G) mscal_task(F, a, t);
    }
    SEAM(3);
    if (IN(4)) {
        const Args a = load_args();
        {
#pragma unroll 1
            for (int rep = 0; rep < REP_MSEQ; ++rep)
#pragma unroll 1
            for (int it = F.bid; it < 256; it += F.G) { const int xcd_ = it & 7, j_ = it >> 3; mseq_item(F, a, it, xcd_ * 4 + (j_ >> 3), (j_ >> 2) & 1, j_ & 3); }
        }
        float lam, cshift;
        { const float p01 = wave_sum(a.lam_p[F.lane] * a.lam_p[64 + F.lane]), p23 = wave_sum(a.lam_p[128 + F.lane] * a.lam_p[192 + F.lane]);
          lam = __expf(p01) - __expf(p23) + 0.2f;
          const float gq = wave_max(fabsf(a.qk_g[F.lane])), gk = wave_max(fabsf(a.qk_g[64 + F.lane]));
          cshift = 8.f * gq * gk * 1.4426950408889634f * 1.02f; }
        const int xcd = F.bid & 7, j = F.bid >> 3;
#pragma unroll 1
        for (int rep = 0; rep < REP_ATT; ++rep)
        for (int i = 0; i * F.G < 1024; ++i) {
            int u;
            if (F.G == 256) u = (xcd * 4 + i) * 32 + j; else u = i * F.G + F.bid;
            if (u < 1024) attn_unit(F, a, u >> 7, (u >> 5) & 3, u & 31, lam, cshift);
        }
    }
    SEAM(4);
    if (IN(5)) { const Args a = load_args(); mcombine_phase(F, a); }
    SEAM(5);
    if (IN(6)) {
        const Args a = load_args();
        pg8::Gemm g{(const bf16_t*)(a.ws + WS_YMIX), (const bf16_t*)(a.ws + WS_WOUTT), MTOK, DM, DM, 1 << 30}; pg8::StaticOrder S; S.init(MTOK, DM, F.G, F.bid);
        pg8::EpiX1 E{a.x, (const float*)(a.ws + WS_MOD), a.out};
        pg8::gemm_phase<pg8::EpiX1, true, true>(F.lds, g, S, E);
    }
    SEAM(6);
    if (IN(7)) { const Args a = load_args();
#pragma unroll 1
        for (int rep = 0; rep < REP_P7; ++rep) p7_phase(F, a); }
    SEAM(7);
    if (IN(8)) { const Args a = load_args(); for (int t = F.bid; t < BATCH * NEXP; t += F.G) topk_task(F, a, t); }
    SEAM(8);
    if (IN(9)) {
        const Args a = load_args();
        pg8::Gemm g{(const bf16_t*)(a.ws + WS_XE), (const bf16_t*)(a.ws + WS_WGUT), NPAIR, 4096, DM, 16};
        pg8::StaticOrder S; S.init(NPAIR, 4096, F.G, F.bid);
        pg8::EpiGU E{a.ws + WS_HH};
#pragma unroll 1
        for (int rep = 0; rep < REP_UP; ++rep)
        pg8::gemm_phase<pg8::EpiGU, true, true, true>(F.lds, g, S, E);
    }
    SEAM(9);
    if (IN(10)) {
        const Args a = load_args();
        pg8::Gemm g{(const bf16_t*)(a.ws + WS_HH), (const bf16_t*)(a.ws + WS_WDT), NPAIR, DM, DFF, 16};
        pg8::StaticOrder S; S.init(NPAIR, DM, F.G, F.bid);
        pg8::EpiDown E{a.ws + WS_Y, (const float*)(a.ws + WS_VALS)};
        pg8::gemm_phase<pg8::EpiDown, true, true, true>(F.lds, g, S, E);
    }
    SEAM(10);
    if (IN(11)) { const Args a = load_args(); final_phase(F, a); }
    if (PROBE_MSEQ_W >= 0 && F.bid == 0 && F.tid == 0) {
        const unsigned long long d = *(volatile LAS unsigned long long*)(F.lds + LDS_BYTES - 128), t1 = __builtin_amdgcn_s_memtime();
        while (__builtin_amdgcn_s_memtime() - t1 < 3ull * d) __builtin_amdgcn_s_sleep(8);
    }
    if (PROBE_PHASE >= 0 && F.bid == 0 && F.tid == 0) {
        const unsigned long long t1 = __builtin_amdgcn_s_memrealtime();
        const unsigned long long d = (PROBE_PHASE == 11 ? t1 : tsl[PROBE_PHASE + 1]) - tsl[PROBE_PHASE];
        while (__builtin_amdgcn_s_memrealtime() - t1 < 3ull * d) __builtin_amdgcn_s_sleep(8);
    }
#undef IN
#undef SEAM
}

extern "C" void kernel_launch(void* const* d_in, const int* in_sizes, int n_in, void* d_out, int out_size, void* d_ws, size_t ws_size, hipStream_t stream) {
    static int grid_blocks = 0;
    if (!grid_blocks) {
        int dev = 0, cus = 0, per_cu = 0;
        (void)hipGetDevice(&dev);
        (void)hipDeviceGetAttribute(&cus, hipDeviceAttributeMultiprocessorCount, dev);
        (void)hipFuncSetAttribute((const void*)fwd_kernel, hipFuncAttributeMaxDynamicSharedMemorySize, LDS_BYTES);
        (void)hipOccupancyMaxActiveBlocksPerMultiprocessor(&per_cu, (const void*)fwd_kernel, NTHR, LDS_BYTES);
        if (per_cu < 1) per_cu = 1;
        grid_blocks = cus;
        if (ws_size < WS_END) fprintf(stderr, "kernel_launch: workspace too small: %zu < %zu\n", ws_size, (size_t)WS_END);
    }
    (void)hipMemsetAsync((char*)d_ws + WS_CTL, 0, CTL_ZERO_BYTES, stream);
    Args a{};
    a.x = (const float*)d_in[0]; a.c = (const float*)d_in[1]; a.pos = (const int*)d_in[2]; a.norm1_g = (const float*)d_in[3]; a.norm2_g = (const float*)d_in[4];
    a.w_ada = (const float*)d_in[5]; a.b_ada = (const float*)d_in[6]; a.w_in = (const float*)d_in[7]; a.conv_w = (const float*)d_in[8]; a.gate_b = (const float*)d_in[9];
    a.mnorm_g = (const float*)d_in[10]; a.qk_g = (const float*)d_in[11]; a.lam_p = (const float*)d_in[12]; a.subln_g = (const float*)d_in[13]; a.w_out = (const float*)d_in[14];
    a.w_router = (const float*)d_in[15]; a.w_gate = (const float*)d_in[16]; a.w_up = (const float*)d_in[17]; a.w_down = (const float*)d_in[18];
    a.out = (float*)d_out; a.ws = (unsigned char*)d_ws; a.ph_lo = 0; a.ph_hi = 12;
    void* args[] = {&a};
    hipError_t e = hipLaunchCooperativeKernel((const void*)fwd_kernel, dim3(grid_blocks), dim3(NTHR), args, LDS_BYTES, stream);
    if (e != hipSuccess) fprintf(stderr, "cooperative launch failed: %s (grid %d)\n", hipGetErrorString(e), grid_blocks);
}
```

```cpp
#include <hip/hip_runtime.h>
#include <hip/hip_cooperative_groups.h>
#include <cstdio>
#include <cstdint>
namespace cg = cooperative_groups;

#define LAS __attribute__((address_space(3)))
#define DI __device__ __forceinline__
typedef unsigned short bf16_t;
typedef short bf16x8 __attribute__((ext_vector_type(8)));
typedef short s16x4 __attribute__((ext_vector_type(4)));
typedef float f32x2 __attribute__((ext_vector_type(2)));
typedef float f32x4 __attribute__((ext_vector_type(4)));
typedef float f32x16 __attribute__((ext_vector_type(16)));
typedef unsigned u32x2 __attribute__((ext_vector_type(2)));
typedef unsigned u32x4 __attribute__((ext_vector_type(4)));
typedef __bf16 bf16x2_t __attribute__((ext_vector_type(2)));

constexpr int BATCH = 8, SEQ = 4096, DM = 1024, MTOK = BATCH * SEQ;
constexpr int DIN = 3600, PS = 3584;
constexpr int NEXP = 16, CAP = 512, DFF = 2048;
constexpr int NPAIR = BATCH * NEXP * CAP;
constexpr float EPS = 1e-6f;
constexpr int C_QM = 0, C_KM = 512, C_VM = 1024, C_OM = 1536, C_QA = 2048, C_KA = 2560, C_VA = 3072;

constexpr size_t MiB = 1u << 20;
constexpr size_t WS_CTL = 0;
constexpr int CTL_ZERO_BYTES = 65536;
constexpr size_t WS_MOD = 1 * MiB;
constexpr size_t WS_GATES = 2 * MiB;
constexpr size_t WS_AFF = 4 * MiB;
constexpr size_t WS_IDX = 6 * MiB;
constexpr size_t WS_VALS = 6 * MiB + 256 * 1024;
constexpr size_t WS_MSC = 6 * MiB + 512 * 1024;
constexpr size_t WS_SLOT = 7 * MiB;
constexpr size_t WS_NLOC = 9 * MiB;
constexpr size_t WS_WINT = 11 * MiB;
constexpr size_t WS_WGT = 18 * MiB;
constexpr size_t WS_WOUTT = 19 * MiB;
constexpr size_t WS_WGUT = 21 * MiB;
constexpr size_t WS_WDT = 85 * MiB;
constexpr size_t WS_Y = 117 * MiB;
constexpr size_t WS_PROJ = 213 * MiB;
constexpr size_t WS_YMIX = 437 * MiB;
constexpr size_t WS_KIMG = 437 * MiB;
constexpr size_t WS_VIMG = 469 * MiB;
constexpr size_t WS_YA = 501 * MiB;
constexpr size_t WS_HH = 245 * MiB;
constexpr size_t WS_H2 = 437 * MiB;
constexpr size_t WS_XE = 469 * MiB;
constexpr size_t WS_X1B = 373 * MiB;
constexpr size_t WS_END = 533 * MiB;

constexpr int LDS_BYTES = 163840;
constexpr int PROBE_MSEQ_W = -1;
constexpr int PROBE_PHASE = -1;
constexpr int REP_M1 = 1, REP_M3 = 1, REP_UP = 1, REP_P0 = 1, REP_SCAN = 1, REP_P7 = 1, REP_ATT = 1, REP_QKT = 1, REP_MSEQ = 1;
constexpr int NWAVES = 8, NTHR = 512;

DI unsigned pk2(float lo, float hi) { f32x2 v = {lo, hi}; bf16x2_t b = __builtin_convertvector(v, bf16x2_t); return __builtin_bit_cast(unsigned, b); }
DI float bflo(unsigned w) { return __uint_as_float(w << 16); }
DI float bfhi(unsigned w) { return __uint_as_float(w & 0xffff0000u); }
DI float bf2f(bf16_t v) { return __uint_as_float((unsigned)v << 16); }
template <int CTRL> DI float dpp_mov(float x) { return __builtin_bit_cast(float, __builtin_amdgcn_update_dpp(0, __builtin_bit_cast(int, x), CTRL, 0xf, 0xf, false)); }
#define DPP_XOR1 0xB1
#define DPP_XOR2 0x4E
#define DPP_ROR(n) (0x120 + (n))
DI float xor16_sum(float x) { const unsigned u = __builtin_bit_cast(unsigned, x); auto r = __builtin_amdgcn_permlane16_swap(u, u, false, false); return __builtin_bit_cast(float, (unsigned)r[0]) + __builtin_bit_cast(float, (unsigned)r[1]); }
DI float xor32_sum(float x) { const unsigned u = __builtin_bit_cast(unsigned, x); auto r = __builtin_amdgcn_permlane32_swap(u, u, false, false); return __builtin_bit_cast(float, (unsigned)r[0]) + __builtin_bit_cast(float, (unsigned)r[1]); }
DI float xor16_max(float x) { const unsigned u = __builtin_bit_cast(unsigned, x); auto r = __builtin_amdgcn_permlane16_swap(u, u, false, false); return fmaxf(__builtin_bit_cast(float, (unsigned)r[0]), __builtin_bit_cast(float, (unsigned)r[1])); }
DI float xor32_max(float x) { const unsigned u = __builtin_bit_cast(unsigned, x); auto r = __builtin_amdgcn_permlane32_swap(u, u, false, false); return fmaxf(__builtin_bit_cast(float, (unsigned)r[0]), __builtin_bit_cast(float, (unsigned)r[1])); }
template <int CTRL, int RM, int BM_> DI float dpp_mov_m(float oldv, float x) { return __builtin_bit_cast(float, __builtin_amdgcn_update_dpp(__builtin_bit_cast(int, oldv), __builtin_bit_cast(int, x), CTRL, RM, BM_, false)); }
DI float wave_prefix_sum(float v) {
    v += dpp_mov_m<0x111, 0xf, 0xf>(0.f, v); v += dpp_mov_m<0x112, 0xf, 0xf>(0.f, v); v += dpp_mov_m<0x114, 0xf, 0xe>(0.f, v); v += dpp_mov_m<0x118, 0xf, 0xc>(0.f, v);
    v += dpp_mov_m<0x142, 0xa, 0xf>(0.f, v); v += dpp_mov_m<0x143, 0xc, 0xf>(0.f, v);
    return v;
}
DI float wave_prefix_max(float v) {
    const float ninf = -__builtin_inff();
    v = fmaxf(v, dpp_mov_m<0x111, 0xf, 0xf>(ninf, v)); v = fmaxf(v, dpp_mov_m<0x112, 0xf, 0xf>(ninf, v)); v = fmaxf(v, dpp_mov_m<0x114, 0xf, 0xe>(ninf, v)); v = fmaxf(v, dpp_mov_m<0x118, 0xf, 0xc>(ninf, v));
    v = fmaxf(v, dpp_mov_m<0x142, 0xa, 0xf>(ninf, v)); v = fmaxf(v, dpp_mov_m<0x143, 0xc, 0xf>(ninf, v));
    return v;
}
DI float partner32(float x, int lane) { const unsigned u = __builtin_bit_cast(unsigned, x); auto r = __builtin_amdgcn_permlane32_swap(u, u, false, false); return __builtin_bit_cast(float, (unsigned)((lane & 32) ? r[0] : r[1])); }
DI float partner16(float x, int lane) { const unsigned u = __builtin_bit_cast(unsigned, x); auto r = __builtin_amdgcn_permlane16_swap(u, u, false, false); return __builtin_bit_cast(float, (unsigned)((lane & 16) ? r[0] : r[1])); }
DI float partner8(float x) { return dpp_mov<DPP_ROR(8)>(x); }
DI float partner4(float x, int lane) { const float a = dpp_mov<DPP_ROR(4)>(x), b = dpp_mov<DPP_ROR(12)>(x); return (lane & 4) ? a : b; }
DI float row_sum16(float v) { v += dpp_mov<DPP_XOR1>(v); v += dpp_mov<DPP_XOR2>(v); v += dpp_mov<DPP_ROR(4)>(v); v += dpp_mov<DPP_ROR(8)>(v); return v; }
DI float wave_sum(float v) { v = row_sum16(v); v = xor16_sum(v); return xor32_sum(v); }
DI float wave_max(float v) { v = fmaxf(v, dpp_mov<DPP_XOR1>(v)); v = fmaxf(v, dpp_mov<DPP_XOR2>(v)); v = fmaxf(v, dpp_mov<DPP_ROR(4)>(v)); v = fmaxf(v, dpp_mov<DPP_ROR(8)>(v)); v = xor16_max(v); return xor32_max(v); }
DI float sigmoid_f(float v) { return __builtin_amdgcn_rcpf(1.f + __builtin_amdgcn_exp2f(-1.4426950408889634f * v)); }
DI float silu_f(float v) { return v * sigmoid_f(v); }
DI float logsigmoid_f(float f) { return fminf(f, 0.f) - log1pf(__expf(-fabsf(f))); }
DI int swz16(int row) { return ((row & 3) << 2) | ((row >> 2) & 3); }
#define MFMA32(a, b, c) __builtin_amdgcn_mfma_f32_32x32x16_bf16((a), (b), (c), 0, 0, 0)
DI s16x4 trread(const LAS unsigned char* p) { return __builtin_bit_cast(s16x4, __builtin_amdgcn_ds_read_tr16_b64_v4i16((LAS s16x4*)p)); }
DI int crow(int r, int hh) { return (r & 3) + 8 * (r >> 2) + 4 * hh; }
DI bool hh_sel(int lane, int bit) { return (lane & bit) != 0; }

namespace pg8 {
constexpr int BM = 256, BK = 64, HALF = 128, HTB = HALF * BK * 2, STAGE_BYTES = 8 * HTB, NXCD = 8, WGM = 8;
DI int lds_byte(int r, int c) { const int st = (r >> 4) * 2 + (c >> 5), rr = r & 15, cc = c & 31, ob = rr * 64 + cc * 2; return st * 1024 + (ob ^ (((ob >> 9) & 1) << 5)); }
DI void stage_rc(int b, int& R, int& C) { const int st = b / 1024, sb = b % 1024, swz = sb ^ (((sb >> 9) & 1) << 5); R = (st >> 1) * 16 + swz / 64; C = (st & 1) * 32 + (swz % 64) / 2; }
DI int perm32(int rho) { const int n = rho >> 4, i = rho & 15; return 8 * (i >> 2) + 4 * n + (i & 3); }
struct Unit { int pm, pn; };
typedef int i32x4_t __attribute__((ext_vector_type(4)));
typedef int i32x8_t __attribute__((ext_vector_type(8)));
DI i32x8_t cat8(bf16x8 lo, bf16x8 hi) { const i32x4_t a = __builtin_bit_cast(i32x4_t, lo), b = __builtin_bit_cast(i32x4_t, hi); return __builtin_shufflevector(a, b, 0, 1, 2, 3, 4, 5, 6, 7); }
struct Gemm { const bf16_t* A; const bf16_t* Bt; int M, N, K, tpg; };
struct StaticOrder {
    int nM, nN, nwg, G, c;
    DI void init(int M, int N, int G_, int c_) { nM = M / BM; nN = N / BM; nwg = nM * nN; G = G_; c = c_; }
    DI bool next(int i, Unit& u) const {
        const long L = (long)i * G + c; if (L >= nwg) return false;
        int wgid = (int)L; { const int q = nwg / NXCD, r = nwg % NXCD, xcd = wgid % NXCD, off = wgid / NXCD; wgid = (xcd < r ? xcd * (q + 1) : r * (q + 1) + (xcd - r) * q) + off; }
        const int nig = WGM * nN, gid = wgid / nig, fm = gid * WGM, gsz = (nM - fm) < WGM ? (nM - fm) : WGM;
        u.pm = fm + ((wgid % nig) % gsz); u.pn = (wgid % nig) / gsz; return true;
    }
};

template <class Epi, bool ALIGN_EPI, bool SP2, bool FP8 = false>
DI void gemm_phase(LAS unsigned char* lds, const Gemm g, const StaticOrder& S, const Epi& E) {
    const int tid = threadIdx.x, wid = __builtin_amdgcn_readfirstlane(tid >> 6), lane = tid & 63, wr = wid >> 2, wc = wid & 3, fr = lane & 15, fq = lane >> 4;
    const int KB = FP8 ? g.K : 2 * g.K, nt = KB / (BK * 2);
    unsigned voffA[2], voffB[2];
#pragma unroll
    for (int i = 0; i < 2; ++i) { int R, C; stage_rc(tid * 16 + i * 8192, R, C); const int Rb = Epi::PERM ? ((R & ~31) + perm32(R & 31)) : R;
        voffA[i] = (unsigned)(R * KB + C * 2); voffB[i] = (unsigned)(Rb * KB + C * 2); }
    const size_t kstep = (size_t)(BK * 2);
    const size_t hstep = (size_t)HALF * KB;
    const size_t tstep = 2 * hstep;
    const size_t gstep = (size_t)g.N * KB;
    const unsigned ldsw = (unsigned)wid * 1024u;
    const int aoff = lds_byte(wr * 64 + fr, fq * 8), boff = lds_byte(wc * 32 + fr, fq * 8);
#define PG8_SA(b, h) (((b) * 2 + (h)) * HTB)
#define PG8_SB(b, h) ((4 + (b) * 2 + (h)) * HTB)
#define PG8_STAGE(bufoff, gbase, voff) do { _Pragma("unroll") for (int _i = 0; _i < 2; ++_i) \
        __builtin_amdgcn_global_load_lds((const unsigned*)((const char*)(gbase) + (voff)[_i]), (LAS unsigned*)(lds + (bufoff) + ldsw + _i * 8192), 16, 0, 0); } while (0)
#define PG8_LDA(dst, b, h) do { if constexpr (FP8) { _Pragma("unroll") for (int m = 0; m < 4; ++m) dst##8[m] = cat8(*(const LAS bf16x8*)(lds + PG8_SA(b, h) + aoff + m * 2048), *(const LAS bf16x8*)(lds + PG8_SA(b, h) + aoff + m * 2048 + 1024)); } \
        else { _Pragma("unroll") for (int m = 0; m < 4; ++m) _Pragma("unroll") for (int k = 0; k < 2; ++k) dst[m][k] = *(const LAS bf16x8*)(lds + PG8_SA(b, h) + aoff + m * 2048 + k * 1024); } } while (0)
#define PG8_LDB(dst, b, h) do { if constexpr (FP8) { _Pragma("unroll") for (int n = 0; n < 2; ++n) dst##8[n] = cat8(*(const LAS bf16x8*)(lds + PG8_SB(b, h) + boff + n * 2048), *(const LAS bf16x8*)(lds + PG8_SB(b, h) + boff + n * 2048 + 1024)); } \
        else { _Pragma("unroll") for (int n = 0; n < 2; ++n) _Pragma("unroll") for (int k = 0; k < 2; ++k) dst[n][k] = *(const LAS bf16x8*)(lds + PG8_SB(b, h) + boff + n * 2048 + k * 1024); } } while (0)
#define PG8_MMA(ai, bj, At, Bt) do { __builtin_amdgcn_s_setprio(1); \
        if constexpr (FP8) { _Pragma("unroll") for (int m = 0; m < 4; ++m) _Pragma("unroll") for (int n = 0; n < 2; ++n) \
            asm volatile("s_nop 1\n\tv_mfma_f32_16x16x128_f8f6f4 %0, %1, %2, %0" : "+v"(acc[ai][bj][m][n]) : "v"(Bt##8[n]), "v"(At##8[m])); } \
        else { _Pragma("unroll") for (int m = 0; m < 4; ++m) _Pragma("unroll") for (int n = 0; n < 2; ++n) _Pragma("unroll") for (int k = 0; k < 2; ++k) \
            acc[ai][bj][m][n] = __builtin_amdgcn_mfma_f32_16x16x32_bf16(Bt[n][k], At[m][k], acc[ai][bj][m][n], 0, 0, 0); } \
        __builtin_amdgcn_s_setprio(0); } while (0)
#define PG8_WAIT_V(n) asm volatile("s_waitcnt vmcnt(" #n ")" ::: "memory")
#define PG8_WAIT_L(n) asm volatile("s_waitcnt lgkmcnt(" #n ")" ::: "memory")
#define PG8_BAR __builtin_amdgcn_s_barrier()
#define PG8_SCHED __builtin_amdgcn_sched_barrier(0)
    Unit cur, nxt; int ui = 0;
    if (!S.next(0, cur)) return;
    f32x4 acc[2][2][4][2];
#pragma unroll
    for (int a = 0; a < 2; ++a)
#pragma unroll
        for (int b = 0; b < 2; ++b)
#pragma unroll
            for (int m = 0; m < 4; ++m)
#pragma unroll
                for (int n = 0; n < 2; ++n) acc[a][b][m][n] = (f32x4){0.f, 0.f, 0.f, 0.f};
    bf16x8 At[4][2], B0[2][2], B1[2][2]; i32x8_t At8[4], B08[2], B18[2];
    const char* cA = (const char*)g.A + (size_t)cur.pm * tstep; const char* cB = (const char*)g.Bt + (size_t)(cur.pm / g.tpg) * gstep + (size_t)cur.pn * tstep;
    if constexpr (SP2) {
        PG8_STAGE(PG8_SB(0, 0), cB, voffB); PG8_STAGE(PG8_SB(0, 1), cB + hstep, voffB); PG8_STAGE(PG8_SA(0, 0), cA, voffA); PG8_STAGE(PG8_SA(0, 1), cA + hstep, voffA);
        if (wr == 1) PG8_BAR;
        PG8_WAIT_V(2); PG8_BAR;
        PG8_STAGE(PG8_SB(1, 0), cB + kstep, voffB); PG8_STAGE(PG8_SA(1, 0), cA + kstep, voffA); PG8_STAGE(PG8_SB(1, 1), cB + hstep + kstep, voffB);
        PG8_WAIT_V(6); PG8_BAR;
    } else {
        PG8_STAGE(PG8_SB(0, 0), cB, voffB); PG8_STAGE(PG8_SA(0, 0), cA, voffA); PG8_STAGE(PG8_SB(0, 1), cB + hstep, voffB); PG8_STAGE(PG8_SA(0, 1), cA + hstep, voffA);
        if (wr == 1) PG8_BAR;
        PG8_WAIT_V(4); PG8_BAR;
        PG8_STAGE(PG8_SB(1, 0), cB + kstep, voffB); PG8_STAGE(PG8_SA(1, 0), cA + kstep, voffA); PG8_STAGE(PG8_SB(1, 1), cB + hstep + kstep, voffB);
        PG8_WAIT_V(6); PG8_BAR;
    }
    for (;;) {
        const bool has_next = S.next(ui + 1, nxt);
        const char* nA = has_next ? (const char*)g.A + (size_t)nxt.pm * tstep : cA;
        const char* nB = has_next ? (const char*)g.Bt + (size_t)(nxt.pm / g.tpg) * gstep + (size_t)nxt.pn * tstep : cB;
        for (int t = 0; t < nt; t += 2) {
            const bool last = (t == nt - 2);
            const char* a1 = cA + (size_t)(t + 1) * kstep;
            const char* a2 = last ? nA : cA + (size_t)(t + 2) * kstep; const char* b2 = last ? nB : cB + (size_t)(t + 2) * kstep;
            const char* a3 = a2 + kstep; const char* b3 = b2 + kstep;
            if constexpr (SP2) {
            PG8_LDB(B0, 0, 0); PG8_LDB(B1, 0, 1); PG8_SCHED; PG8_LDA(At, 0, 0); PG8_STAGE(PG8_SA(1, 1), a1 + hstep, voffA);
            PG8_WAIT_V(8); PG8_WAIT_L(0); PG8_BAR; PG8_MMA(0, 0, At, B0); PG8_MMA(0, 1, At, B1); PG8_BAR; PG8_SCHED;
            PG8_LDA(At, 0, 1); PG8_STAGE(PG8_SB(0, 0), b2, voffB); PG8_STAGE(PG8_SB(0, 1), b2 + hstep, voffB); PG8_STAGE(PG8_SA(0, 0), a2, voffA);
            PG8_WAIT_V(8); PG8_WAIT_L(0); PG8_BAR; PG8_MMA(1, 0, At, B0); PG8_MMA(1, 1, At, B1); PG8_BAR; PG8_SCHED;
            PG8_LDB(B0, 1, 0); PG8_LDB(B1, 1, 1); PG8_SCHED; PG8_LDA(At, 1, 0); PG8_STAGE(PG8_SA(0, 1), a2 + hstep, voffA);
            PG8_WAIT_V(8); PG8_WAIT_L(0); PG8_BAR; PG8_MMA(0, 0, At, B0); PG8_MMA(0, 1, At, B1); PG8_BAR; PG8_SCHED;
            PG8_LDA(At, 1, 1); PG8_STAGE(PG8_SB(1, 0), b3, voffB); PG8_STAGE(PG8_SB(1, 1), b3 + hstep, voffB); PG8_STAGE(PG8_SA(1, 0), a3, voffA);
            PG8_WAIT_V(8); PG8_WAIT_L(0); PG8_BAR; PG8_MMA(1, 0, At, B0); PG8_MMA(1, 1, At, B1); PG8_BAR; PG8_SCHED;
            } else {
            PG8_LDB(B0, 0, 0); PG8_SCHED; PG8_LDA(At, 0, 0); PG8_STAGE(PG8_SA(1, 1), a1 + hstep, voffA);
            PG8_WAIT_L(8); PG8_BAR; PG8_WAIT_L(0); PG8_MMA(0, 0, At, B0); PG8_BAR; PG8_SCHED;
            PG8_LDB(B1, 0, 1); PG8_STAGE(PG8_SB(0, 0), b2, voffB);
            PG8_BAR; PG8_WAIT_L(0); PG8_MMA(0, 1, At, B1); PG8_BAR;
            PG8_LDA(At, 0, 1); PG8_STAGE(PG8_SA(0, 0), a2, voffA);
            PG8_BAR; PG8_WAIT_L(0); PG8_MMA(1, 0, At, B0); PG8_BAR; PG8_SCHED;
            PG8_STAGE(PG8_SB(0, 1), b2 + hstep, voffB);
            PG8_WAIT_V(6); PG8_BAR; PG8_MMA(1, 1, At, B1); PG8_BAR;
            PG8_LDB(B0, 1, 0); PG8_SCHED; PG8_LDA(At, 1, 0); PG8_STAGE(PG8_SA(0, 1), a2 + hstep, voffA);
            PG8_WAIT_L(8); PG8_BAR; PG8_WAIT_L(0); PG8_MMA(0, 0, At, B0); PG8_BAR; PG8_SCHED;
            PG8_LDB(B1, 1, 1); PG8_STAGE(PG8_SB(1, 0), b3, voffB);
            PG8_BAR; PG8_WAIT_L(0); PG8_MMA(0, 1, At, B1); PG8_BAR;
            PG8_LDA(At, 1, 1); PG8_STAGE(PG8_SA(1, 0), a3, voffA);
            PG8_BAR; PG8_WAIT_L(0); PG8_MMA(1, 0, At, B0); PG8_BAR; PG8_SCHED;
            PG8_STAGE(PG8_SB(1, 1), b3 + hstep, voffB);
            PG8_WAIT_V(6); PG8_BAR; PG8_MMA(1, 1, At, B1); PG8_BAR;
            }
        }
        if constexpr (ALIGN_EPI) { if (wr == 0) PG8_BAR; }
        if constexpr (FP8) asm volatile("s_nop 15\n\ts_nop 7" ::: "memory");
        E(acc, cur, wr, wc, fr, fq);
        if (!has_next) break;
#pragma unroll
        for (int a = 0; a < 2; ++a)
#pragma unroll
            for (int b = 0; b < 2; ++b)
#pragma unroll
                for (int m = 0; m < 4; ++m)
#pragma unroll
                    for (int n = 0; n < 2; ++n) acc[a][b][m][n] = (f32x4){0.f, 0.f, 0.f, 0.f};
        cur = nxt; cA = nA; cB = nB; ++ui;
        if constexpr (ALIGN_EPI) { if (wr == 1) PG8_BAR; }
    }
    PG8_WAIT_V(0);
    if constexpr (!ALIGN_EPI) { if (wr == 0) PG8_BAR; }
    PG8_BAR;
#undef PG8_SA
#undef PG8_SB
#undef PG8_STAGE
#undef PG8_LDA
#undef PG8_LDB
#undef PG8_MMA
#undef PG8_WAIT_V
#undef PG8_WAIT_L
#undef PG8_BAR
#undef PG8_SCHED
}

struct EpiBf16 {
    static constexpr bool PERM = true;
    bf16_t* O; int ldc;
    DI void operator()(const f32x4 (&acc)[2][2][4][2], const Unit& u, int wr, int wc, int fr, int fq) const {
        const int row0 = u.pm * BM + wr * 64 + fr, col0 = u.pn * BM + wc * 32 + 8 * fq;
#pragma unroll
        for (int ai = 0; ai < 2; ++ai)
#pragma unroll
            for (int m = 0; m < 4; ++m) { bf16_t* rowp = O + (size_t)(row0 + ai * HALF + m * 16) * ldc + col0;
#pragma unroll
                for (int bj = 0; bj < 2; ++bj) { const f32x4 v0 = acc[ai][bj][m][0], v1 = acc[ai][bj][m][1];
                    u32x4 w; w.x = pk2(v0[0], v0[1]); w.y = pk2(v0[2], v0[3]); w.z = pk2(v1[0], v1[1]); w.w = pk2(v1[2], v1[3]);
                    *(u32x4*)(rowp + bj * HALF) = w; } }
    }
};
struct EpiProj {
    static constexpr bool PERM = true;
    bf16_t* O; const int* pos; const float* qk_g; bf16_t* kimg; bf16_t* vimg;
    DI void operator()(const f32x4 (&acc)[2][2][4][2], const Unit& u, int wr, int wc, int fr, int fq) const {
        const int row0 = u.pm * BM + wr * 64 + fr;
        if (u.pn < 8) {
            const int col0 = u.pn * BM + wc * 32 + 8 * fq;
#pragma unroll
            for (int ai = 0; ai < 2; ++ai)
#pragma unroll
                for (int m = 0; m < 4; ++m) { bf16_t* rowp = O + (size_t)(row0 + ai * HALF + m * 16) * PS + col0;
#pragma unroll
                    for (int bj = 0; bj < 2; ++bj) { const f32x4 v0 = acc[ai][bj][m][0], v1 = acc[ai][bj][m][1];
                        u32x4 w; w.x = pk2(v0[0], v0[1]); w.y = pk2(v0[2], v0[3]); w.z = pk2(v1[0], v1[1]); w.w = pk2(v1[2], v1[3]);
                        *(u32x4*)(rowp + bj * HALF) = w; } }
        } else if (u.pn < 12) {
            const int isk = (u.pn >= 10), hsub = 4 * (u.pn & 1) + wc, h = hsub >> 1, p = hsub & 1;
            const float* gp = qk_g + isk * 64 + 8 * fq;
            const f32x4 g00 = *(const f32x4*)gp, g01 = *(const f32x4*)(gp + 4), g10 = *(const f32x4*)(gp + 32), g11 = *(const f32x4*)(gp + 36);
            const float qs = isk ? 1.f : 0.125f * 1.4426950408889634f;
            const int lane = fr + 16 * fq;
#pragma unroll
            for (int ai = 0; ai < 2; ++ai)
#pragma unroll
                for (int m = 0; m < 4; ++m) { const int row = row0 + ai * HALF + m * 16;
                    f32x4 a0 = acc[ai][0][m][0], a1 = acc[ai][0][m][1], b0 = acc[ai][1][m][0], b1 = acc[ai][1][m][1];
                    float ss = (a0[0] * a0[0] + a0[1] * a0[1] + a0[2] * a0[2] + a0[3] * a0[3]) + (a1[0] * a1[0] + a1[1] * a1[1] + a1[2] * a1[2] + a1[3] * a1[3])
                             + (b0[0] * b0[0] + b0[1] * b0[1] + b0[2] * b0[2] + b0[3] * b0[3]) + (b1[0] * b1[0] + b1[1] * b1[1] + b1[2] * b1[2] + b1[3] * b1[3]);
                    ss = xor16_sum(ss); ss = xor32_sum(ss);
                    const float rstd = rsqrtf(ss * (1.f / 64.f) + EPS);
                    a0 = a0 * rstd * g00; a1 = a1 * rstd * g01; b0 = b0 * rstd * g10 * qs; b1 = b1 * rstd * g11 * qs;
                    const float pf = (float)pos[row];
                    f32x4 r0, r1;
#pragma unroll
                    for (int n = 0; n < 2; ++n)
#pragma unroll
                        for (int j = 0; j < 4; ++j) { const int i = 4 * n + j; const float own = n ? a1[j] : a0[j]; const float oth = partner16(own, lane);
                            const float frc = __builtin_amdgcn_fractf(pf * (exp2f(-(float)i * 0.125f * 18.931568569324174f) * 0.15915494309189535f));
                            const float sn = __builtin_amdgcn_sinf(frc), cs = __builtin_amdgcn_cosf(frc);
                            const float rot = (fq == 0) ? own * cs - oth * sn : own * cs + oth * sn;
                            const float o = (fq < 2) ? rot : own;
                            if (n) r1[j] = o; else r0[j] = o; }
                    r0 = r0 * qs; r1 = r1 * qs;
                    u32x4 w0, w1;
                    w0.x = pk2(r0[0], r0[1]); w0.y = pk2(r0[2], r0[3]); w0.z = pk2(r1[0], r1[1]); w0.w = pk2(r1[2], r1[3]);
                    w1.x = pk2(b0[0], b0[1]); w1.y = pk2(b0[2], b0[3]); w1.z = pk2(b1[0], b1[1]); w1.w = pk2(b1[2], b1[3]);
                    if (!isk) { bf16_t* rowp = O + (size_t)row * PS + C_QA + h * 128 + p * 64 + 8 * fq; *(u32x4*)rowp = w0; *(u32x4*)(rowp + 32) = w1; }
                    else { const int b = row / SEQ, t = row % SEQ; bf16_t* kp = kimg + ((size_t)((b * 4 + h) * 64 + (t >> 6))) * 8192 + (p * 8 + fq) * 512 + (t & 63) * 8;
                        *(u32x4*)kp = w0; *(u32x4*)(kp + 4 * 512) = w1; } }
        } else {
#pragma unroll
            for (int ai = 0; ai < 2; ++ai)
#pragma unroll
                for (int m = 0; m < 4; ++m) { const int row = row0 + ai * HALF + m * 16, b = row / SEQ, t = row % SEQ;
#pragma unroll
                    for (int bj = 0; bj < 2; ++bj) { const int h = 2 * (u.pn - 12) + bj; const f32x4 v0 = acc[ai][bj][m][0], v1 = acc[ai][bj][m][1];
                        u32x4 w; w.x = pk2(v0[0], v0[1]); w.y = pk2(v0[2], v0[3]); w.z = pk2(v1[0], v1[1]); w.w = pk2(v1[2], v1[3]);
                        *(u32x4*)(vimg + ((size_t)((b * 4 + h) * 64 + (t >> 6))) * 8192 + (wc * 4 + ((t & 63) >> 4)) * 512 + (t & 15) * 32 + fq * 8) = w; } }
        }
    }
};
struct EpiX1 {
    static constexpr bool PERM = true;
    const float* x; const float* mod; bf16_t* x1;
    DI void operator()(const f32x4 (&acc)[2][2][4][2], const Unit& u, int wr, int wc, int fr, int fq) const {
        const int row0 = u.pm * BM + wr * 64 + fr, col0 = u.pn * BM + wc * 32 + 8 * fq;
        const int b = (u.pm * BM) / SEQ;
        const float* gp = mod + (size_t)b * 6144 + 2048 + col0;
#pragma unroll
        for (int bj = 0; bj < 2; ++bj) { const f32x4 g0 = *(const f32x4*)(gp + bj * HALF), g1 = *(const f32x4*)(gp + bj * HALF + 4);
#pragma unroll
            for (int ai = 0; ai < 2; ++ai)
#pragma unroll
                for (int m = 0; m < 4; ++m) { const size_t off = (size_t)(row0 + ai * HALF + m * 16) * DM + col0 + bj * HALF;
                    const f32x4 r0 = *(const f32x4*)(x + off) + g0 * acc[ai][bj][m][0], r1 = *(const f32x4*)(x + off + 4) + g1 * acc[ai][bj][m][1];
                    u32x4 w; w.x = pk2(r0[0], r0[1]); w.y = pk2(r0[2], r0[3]); w.z = pk2(r1[0], r1[1]); w.w = pk2(r1[2], r1[3]);
                    *(u32x4*)(x1 + off) = w; } }
    }
};
DI unsigned pk4_fp8(float a, float b, float c, float d) { int w = __builtin_amdgcn_cvt_pk_fp8_f32(a, b, 0, false); w = __builtin_amdgcn_cvt_pk_fp8_f32(c, d, w, true); return (unsigned)w; }
constexpr float W_PRESCALE = 32.f, H_PRESCALE = 8.f;
struct EpiGU {
    static constexpr bool PERM = true;
    unsigned char* H;
    DI void operator()(const f32x4 (&acc)[2][2][4][2], const Unit& u, int wr, int wc, int fr, int fq) const {
        const int row0 = u.pm * BM + wr * 64 + fr, col0 = u.pn * HALF + wc * 32 + 8 * fq;
#pragma unroll
        for (int ai = 0; ai < 2; ++ai)
#pragma unroll
            for (int m = 0; m < 4; ++m) { unsigned char* rowp = H + (size_t)(row0 + ai * HALF + m * 16) * DFF + col0;
                float hv[8];
#pragma unroll
                for (int n = 0; n < 2; ++n)
#pragma unroll
                    for (int j = 0; j < 4; ++j) { const float gg = acc[ai][0][m][n][j] * (1.f / W_PRESCALE), uu = acc[ai][1][m][n][j] * (H_PRESCALE / W_PRESCALE); hv[n * 4 + j] = gg * __builtin_amdgcn_rcpf(1.f + __builtin_amdgcn_exp2f(-1.4426950408889634f * gg)) * uu; }
                u32x2 w; w.x = pk4_fp8(hv[0], hv[1], hv[2], hv[3]); w.y = pk4_fp8(hv[4], hv[5], hv[6], hv[7]);
                *(u32x2*)rowp = w; }
    }
};
constexpr float Y_PRESCALE = 64.f;
struct EpiDown {
    static constexpr bool PERM = true;
    unsigned char* Y; const float* vals;
    DI void operator()(const f32x4 (&acc)[2][2][4][2], const Unit& u, int wr, int wc, int fr, int fq) const {
        const int row0 = u.pm * BM + wr * 64 + fr, col0 = u.pn * BM + wc * 32 + 8 * fq;
#pragma unroll
        for (int ai = 0; ai < 2; ++ai)
#pragma unroll
            for (int m = 0; m < 4; ++m) { const int row = row0 + ai * HALF + m * 16; const float s = vals[row] * (Y_PRESCALE / (W_PRESCALE * H_PRESCALE)); unsigned char* rowp = Y + (size_t)row * DM + col0;
#pragma unroll
                for (int bj = 0; bj < 2; ++bj) { const f32x4 v0 = acc[ai][bj][m][0] * s, v1 = acc[ai][bj][m][1] * s;
                    u32x2 w; w.x = pk4_fp8(v0[0], v0[1], v0[2], v0[3]); w.y = pk4_fp8(v1[0], v1[1], v1[2], v1[3]);
                    *(u32x2*)(rowp + bj * HALF) = w; } }
    }
};
}

struct Args {
    const float* x; const float* c; const int* pos; const float* norm1_g; const float* norm2_g; const float* w_ada; const float* b_ada;
    const float* w_in; const float* conv_w; const float* gate_b; const float* mnorm_g; const float* qk_g; const float* lam_p; const float* subln_g;
    const float* w_out; const float* w_router; const float* w_gate; const float* w_up; const float* w_down;
    float* out; unsigned char* ws; int ph_lo, ph_hi;
};
struct Ctx {
    LAS unsigned char* lds; int tid, lane, wave, G, bid;
};
DI Args load_args() {
    typedef __attribute__((address_space(4))) const volatile unsigned long long* kp_t;
    kp_t kp = (kp_t)__builtin_amdgcn_kernarg_segment_ptr();
#define GP(T, i) ((T*)(__attribute__((address_space(1))) T*)kp[i])
    Args a;
    a.x = GP(const float, 0); a.c = GP(const float, 1); a.pos = GP(const int, 2); a.norm1_g = GP(const float, 3); a.norm2_g = GP(const float, 4);
    a.w_ada = GP(const float, 5); a.b_ada = GP(const float, 6); a.w_in = GP(const float, 7); a.conv_w = GP(const float, 8); a.gate_b = GP(const float, 9);
    a.mnorm_g = GP(const float, 10); a.qk_g = GP(const float, 11); a.lam_p = GP(const float, 12); a.subln_g = GP(const float, 13); a.w_out = GP(const float, 14);
    a.w_router = GP(const float, 15); a.w_gate = GP(const float, 16); a.w_up = GP(const float, 17); a.w_down = GP(const float, 18);
    a.out = GP(float, 19); a.ws = GP(unsigned char, 20);
#undef GP
    a.ph_lo = 0; a.ph_hi = 12;
    return a;
}

DI void tr_item64(const float* src, size_t ld_src, int k0, int c0, bf16_t* dst, size_t r0, int ld_dst, LAS float* scr  , int lane, size_t r1 = (size_t)-1) {
    const float* sp = src + (size_t)(k0 + (lane >> 4)) * ld_src + c0 + (lane & 15) * 4;
#pragma unroll 1
    for (int hf = 0; hf < 2; ++hf) {
        f32x4 v[8];
#pragma unroll
        for (int i = 0; i < 8; ++i) v[i] = *(const f32x4*)(sp + (size_t)(4 * (8 * hf + i)) * ld_src);
#pragma unroll
        for (int i = 0; i < 8; ++i) *(LAS f32x4*)(scr + (4 * (8 * hf + i) + (lane >> 4)) * 68 + (lane & 15) * 4) = v[i];
    }
    asm volatile("s_waitcnt lgkmcnt(0)" ::: "memory");
    const int c = lane & 7;
#pragma unroll
    for (int q = 0; q < 8; ++q) { const int n = 8 * q + (lane >> 3); const LAS float* s = scr + (8 * c) * 68 + n;
        u32x4 o; o.x = pk2(s[0 * 68], s[1 * 68]); o.y = pk2(s[2 * 68], s[3 * 68]); o.z = pk2(s[4 * 68], s[5 * 68]); o.w = pk2(s[6 * 68], s[7 * 68]);
        const size_t row = (r1 != (size_t)-1 && q >= 4) ? r1 + (n - 32) : r0 + n;
        *(u32x4*)(dst + row * ld_dst + k0 + 8 * c) = o; }
    asm volatile("s_waitcnt lgkmcnt(0)" ::: "memory");
}
DI void tr_item64_fp8(const float* src, size_t ld_src, int k0, int c0, unsigned char* dst, size_t r0, int ld_dst, float scale, LAS float* scr  , int lane) {
    const float* sp = src + (size_t)(k0 + (lane >> 4)) * ld_src + c0 + (lane & 15) * 4;
    {
        f32x4 v[16];
#pragma unroll
        for (int i = 0; i < 16; ++i) v[i] = __builtin_nontemporal_load((const f32x4*)(sp + (size_t)(4 * i) * ld_src));
#pragma unroll
        for (int i = 0; i < 16; ++i) *(LAS f32x4*)(scr + (4 * i + (lane >> 4)) * 68 + (lane & 15) * 4) = v[i] * scale;
    }
    asm volatile("s_waitcnt lgkmcnt(0)" ::: "memory");
    const int c = lane & 3;
#pragma unroll
    for (int q = 0; q < 4; ++q) { const int n = 16 * q + (lane >> 2); const LAS float* s = scr + (16 * c) * 68 + n;
        u32x4 o; o.x = pg8::pk4_fp8(s[0 * 68], s[1 * 68], s[2 * 68], s[3 * 68]); o.y = pg8::pk4_fp8(s[4 * 68], s[5 * 68], s[6 * 68], s[7 * 68]);
        o.z = pg8::pk4_fp8(s[8 * 68], s[9 * 68], s[10 * 68], s[11 * 68]); o.w = pg8::pk4_fp8(s[12 * 68], s[13 * 68], s[14 * 68], s[15 * 68]);
        *(u32x4*)(dst + (r0 + n) * ld_dst + k0 + 16 * c) = o; }
    asm volatile("s_waitcnt lgkmcnt(0)" ::: "memory");
}
DI void p0_phase(const Ctx& F, const Args& a) {
    if (F.bid < 96) {
        LAS float* sc = (LAS float*)F.lds; LAS float* part = (LAS float*)(F.lds + 32768);
        for (int i = F.tid; i < BATCH * DM; i += NTHR) sc[i] = silu_f(a.c[i]);
        __syncthreads();
        const int col = F.bid * 64 + F.lane;
        float acc[8];
#pragma unroll
        for (int b = 0; b < 8; ++b) acc[b] = 0.f;
        const int kb = F.wave * 128;
#pragma unroll 1
        for (int k0 = kb; k0 < kb + 128; k0 += 16) {
            float w[16];
            const float* wp = a.w_ada + (size_t)k0 * 6144 + col;
#pragma unroll
            for (int j = 0; j < 16; ++j) w[j] = wp[(size_t)j * 6144];
#pragma unroll
            for (int j = 0; j < 16; ++j)
#pragma unroll
                for (int b = 0; b < 8; ++b) acc[b] += sc[b * DM + k0 + j] * w[j];
        }
#pragma unroll
        for (int b = 0; b < 8; ++b) part[(F.wave * 8 + b) * 64 + F.lane] = acc[b];
        __syncthreads();
        { const int b = F.tid >> 6, l = F.tid & 63; float s = a.b_ada[F.bid * 64 + l];
#pragma unroll
          for (int w = 0; w < 8; ++w) s += part[(w * 8 + b) * 64 + l];
          ((float*)(a.ws + WS_MOD))[b * 6144 + F.bid * 64 + l] = s; }
        asm volatile("s_waitcnt vmcnt(0)" ::: "memory");
        __syncthreads();
        if (F.tid == 0) { __builtin_amdgcn_fence(__ATOMIC_RELEASE, "agent"); asm volatile("s_waitcnt vmcnt(0)" ::: "memory");
            __hip_atomic_fetch_add((unsigned*)(a.ws + WS_CTL) + 4096, 1u, __ATOMIC_RELAXED, __HIP_MEMORY_SCOPE_AGENT); }
    }
    LAS float* scr = (LAS float*)(F.lds + F.wave * 17408);
    const int gw = F.bid * NWAVES + F.wave, NGW = F.G * NWAVES;
    constexpr int I_IN = 16 * 56, I_OUT = 16 * 16, I_WG = 16, I_EX = 4096;
    constexpr int NITEMS = I_IN + I_OUT + I_EX + I_WG;
    bf16_t* WinT = (bf16_t*)(a.ws + WS_WINT); bf16_t* WgT = (bf16_t*)(a.ws + WS_WGT); bf16_t* WoutT = (bf16_t*)(a.ws + WS_WOUTT);
    for (int it = gw; it < NITEMS; it += NGW) {
        int r = it;
        if (r < I_IN) { const int kb = r / 56, nb = r % 56, n0 = nb * 64;
            if (n0 >= 2048 && n0 < 3072) { const int t0 = n0 & ~255, g = (n0 >> 6) & 3; tr_item64(a.w_in, DIN, kb * 64, n0 + 16, WinT, (size_t)(t0 + 32 * g), DM, scr, F.lane, (size_t)(t0 + 128 + 32 * g)); }
            else tr_item64(a.w_in, DIN, kb * 64, n0 + (n0 >= 2048 ? 16 : 0), WinT, n0, DM, scr, F.lane);
            continue; } r -= I_IN;
        if (r < I_OUT) { const int kb = r / 16, nb = r % 16; tr_item64(a.w_out, DM, kb * 64, nb * 64, WoutT, nb * 64, DM, scr, F.lane); continue; } r -= I_OUT;
        if (r < I_EX) { int e, mat, q;
            if (r < 1024) { e = 13; mat = 1 + (r >> 9); q = r & 511; } else { const int t = r - 1024; e = 14 + t / 1536; const int u = t % 1536; mat = u >> 9; q = u & 511; }
            if (mat < 2) { const int kb = q / 32, nb = q % 32, n0 = nb * 64; const float* src = (mat ? a.w_up : a.w_gate) + (size_t)e * DM * DFF;
                tr_item64_fp8(src, DFF, kb * 64, n0, a.ws + WS_WGUT + (size_t)e * 4096 * DM, (size_t)(n0 / 128) * 256 + (n0 % 128) + mat * 128, DM, pg8::W_PRESCALE, scr, F.lane); }
            else { const int kb = q / 16, nb = q % 16;
                tr_item64_fp8(a.w_down + (size_t)e * DFF * DM, DM, kb * 64, nb * 64, a.ws + WS_WDT + (size_t)e * DM * DFF, nb * 64, DFF, pg8::W_PRESCALE, scr, F.lane); }
            continue; } r -= I_EX;
        tr_item64(a.w_in, DIN, r * 64, 2048 - 48, WgT, 0, DM, scr, F.lane);
    }
    if (F.tid == 0) { unsigned* cnt = (unsigned*)(a.ws + WS_CTL) + 4096; unsigned sp = 0;
        while (__hip_atomic_load(cnt, __ATOMIC_RELAXED, __HIP_MEMORY_SCOPE_AGENT) < 96u && ++sp < (1u << 22)) __builtin_amdgcn_s_sleep(2);
        __builtin_amdgcn_fence(__ATOMIC_ACQUIRE, "agent"); asm volatile("s_waitcnt vmcnt(0)" ::: "memory"); }
    __syncthreads();
}

DI void p1_phase(const Ctx& F, const Args& a) {
    const int gw = F.bid * NWAVES + F.wave, NGW = F.G * NWAVES;
    const float* mod = (const float*)(a.ws + WS_MOD);
    bf16_t* H1 = (bf16_t*)a.out;
    for (int m0 = gw; m0 < MTOK; m0 += 2 * NGW) {
        const int m1 = m0 + NGW; const bool has1 = m1 < MTOK;
        const f32x4* xr0 = (const f32x4*)(a.x + (size_t)m0 * DM) + F.lane; const f32x4* xr1 = (const f32x4*)(a.x + (size_t)(has1 ? m1 : m0) * DM) + F.lane;
        f32x4 v0[4], v1[4]; float s0 = 0.f, s1 = 0.f;
#pragma unroll
        for (int j = 0; j < 4; ++j) { v0[j] = __builtin_nontemporal_load(xr0 + 64 * j); v1[j] = __builtin_nontemporal_load(xr1 + 64 * j); }
#pragma unroll
        for (int j = 0; j < 4; ++j) { s0 += (v0[j].x * v0[j].x + v0[j].y * v0[j].y) + (v0[j].z * v0[j].z + v0[j].w * v0[j].w); s1 += (v1[j].x * v1[j].x + v1[j].y * v1[j].y) + (v1[j].z * v1[j].z + v1[j].w * v1[j].w); }
#pragma unroll
        for (int o = 1; o < 64; o <<= 1) { s0 += __shfl_xor(s0, o); s1 += __shfl_xor(s1, o); }
        const float rstd0 = rsqrtf(s0 * (1.f / DM) + EPS), rstd1 = rsqrtf(s1 * (1.f / DM) + EPS);
        const int b0 = m0 / SEQ, b1 = (has1 ? m1 : m0) / SEQ;
        u32x2* o0 = (u32x2*)(H1 + (size_t)m0 * DM) + F.lane; u32x2* o1 = (u32x2*)(H1 + (size_t)m1 * DM) + F.lane;
#pragma unroll
        for (int j = 0; j < 4; ++j) {
            const f32x4 g = ((const f32x4*)a.norm1_g)[F.lane + 64 * j];
            { const f32x4 sh = ((const f32x4*)(mod + (size_t)b0 * 6144))[F.lane + 64 * j], sc = ((const f32x4*)(mod + (size_t)b0 * 6144 + 1024))[F.lane + 64 * j];
              const f32x4 h = v0[j] * rstd0 * g * (sc + 1.f) + sh; u32x2 w; w.x = pk2(h.x, h.y); w.y = pk2(h.z, h.w); o0[64 * j] = w; }
            if (has1) { const f32x4 sh = ((const f32x4*)(mod + (size_t)b1 * 6144))[F.lane + 64 * j], sc = ((const f32x4*)(mod + (size_t)b1 * 6144 + 1024))[F.lane + 64 * j];
              const f32x4 h = v1[j] * rstd1 * g * (sc + 1.f) + sh; u32x2 w; w.x = pk2(h.x, h.y); w.y = pk2(h.z, h.w); o1[64 * j] = w; }
        }
    }
}

DI void gates_tasks(const Ctx& F, const Args& a) {
    const int gw = F.bid * NWAVES + F.wave, NGW = F.G * NWAVES;
    const bf16_t* H1 = (const bf16_t*)a.out; const bf16_t* WgT = (const bf16_t*)(a.ws + WS_WGT) + 48 * DM; float* GT = (float*)(a.ws + WS_GATES);
    const float bias = a.gate_b[F.lane & 15];
    for (int task = gw; task < MTOK / 16; task += NGW) {
        const int row0 = task * 16;
        const bf16_t* ap = H1 + (size_t)(row0 + (F.lane & 15)) * DM + 8 * (F.lane >> 4);
        const bf16_t* bp = WgT + (size_t)(F.lane & 15) * DM + 8 * (F.lane >> 4);
        f32x4 acc = {0.f, 0.f, 0.f, 0.f};
        bf16x8 avs[32];
#pragma unroll
        for (int i = 0; i < 32; ++i) avs[i] = *(const bf16x8*)(ap + 32 * i);
#pragma unroll
        for (int i = 0; i < 32; ++i) { const bf16x8 bv = *(const bf16x8*)(bp + 32 * i); acc = __builtin_amdgcn_mfma_f32_16x16x32_bf16(avs[i], bv, acc, 0, 0, 0); }
#pragma unroll
        for (int r = 0; r < 4; ++r) GT[(size_t)(row0 + (F.lane >> 4) * 4 + r) * 16 + (F.lane & 15)] = acc[r] + bias;
    }
}

DI void qk_tile_task(const Ctx& F, const Args& a, int task) {
    const int b = task >> 6, tile = task & 63, r = F.lane, g = F.wave, h = g >> 1, p = g & 1;
    bf16_t* PROJ = (bf16_t*)(a.ws + WS_PROJ);
    const size_t tok = (size_t)b * SEQ + tile * 64 + r;
    float invf[8];
#pragma unroll
    for (int i = 0; i < 8; ++i) invf[i] = exp2f(-(float)i * 0.125f * 18.931568569324174f) * 0.15915494309189535f;
    const float pos = (float)a.pos[tok];
    float sn[8], cs[8];
#pragma unroll
    for (int i = 0; i < 8; ++i) { const float fr = __builtin_amdgcn_fractf(pos * invf[i]); sn[i] = __builtin_amdgcn_sinf(fr); cs[i] = __builtin_amdgcn_cosf(fr); }
#pragma unroll 1
    for (int isk = 0; isk < 2; ++isk) {
        u32x4* src = (u32x4*)(PROJ + tok * PS + (isk ? C_KA : C_QA) + g * 64);
        u32x4 w[8];
#pragma unroll
        for (int c = 0; c < 8; ++c) w[c] = src[c];
        float ss = 0.f;
#pragma unroll
        for (int c = 0; c < 8; ++c) { float t;
            t = bflo(w[c].x); ss += t * t; t = bfhi(w[c].x); ss += t * t; t = bflo(w[c].y); ss += t * t; t = bfhi(w[c].y); ss += t * t;
            t = bflo(w[c].z); ss += t * t; t = bfhi(w[c].z); ss += t * t; t = bflo(w[c].w); ss += t * t; t = bfhi(w[c].w); ss += t * t; }
        const float rstd = rsqrtf(ss * (1.f / 64.f) + EPS) * (isk ? 1.f : 0.125f * 1.4426950408889634f);
        const float* gp = a.qk_g + isk * 64;
        float v0[16];
        v0[0] = bflo(w[0].x); v0[1] = bfhi(w[0].x); v0[2] = bflo(w[0].y); v0[3] = bfhi(w[0].y); v0[4] = bflo(w[0].z); v0[5] = bfhi(w[0].z); v0[6] = bflo(w[0].w); v0[7] = bfhi(w[0].w);
        v0[8] = bflo(w[1].x); v0[9] = bfhi(w[1].x); v0[10] = bflo(w[1].y); v0[11] = bfhi(w[1].y); v0[12] = bflo(w[1].z); v0[13] = bfhi(w[1].z); v0[14] = bflo(w[1].w); v0[15] = bfhi(w[1].w);
#pragma unroll
        for (int i = 0; i < 16; ++i) v0[i] *= rstd * gp[i];
        float rr[16];
#pragma unroll
        for (int i = 0; i < 8; ++i) { rr[i] = v0[i] * cs[i] - v0[i + 8] * sn[i]; rr[i + 8] = v0[i + 8] * cs[i] + v0[i] * sn[i]; }
        u32x4 o[8];
        o[0].x = pk2(rr[0], rr[1]); o[0].y = pk2(rr[2], rr[3]); o[0].z = pk2(rr[4], rr[5]); o[0].w = pk2(rr[6], rr[7]);
        o[1].x = pk2(rr[8], rr[9]); o[1].y = pk2(rr[10], rr[11]); o[1].z = pk2(rr[12], rr[13]); o[1].w = pk2(rr[14], rr[15]);
#pragma unroll
        for (int c = 2; c < 8; ++c) { const f32x4 g0 = *(const f32x4*)(gp + c * 8), g1 = *(const f32x4*)(gp + c * 8 + 4);
            o[c].x = pk2(bflo(w[c].x) * rstd * g0.x, bfhi(w[c].x) * rstd * g0.y); o[c].y = pk2(bflo(w[c].y) * rstd * g0.z, bfhi(w[c].y) * rstd * g0.w);
            o[c].z = pk2(bflo(w[c].z) * rstd * g1.x, bfhi(w[c].z) * rstd * g1.y); o[c].w = pk2(bflo(w[c].w) * rstd * g1.z, bfhi(w[c].w) * rstd * g1.w); }
        if (isk == 0) {
#pragma unroll
            for (int c = 0; c < 8; ++c) src[c] = o[c];
        } else {
            u32x4* dst = (u32x4*)((bf16_t*)(a.ws + WS_KIMG) + ((size_t)((b * 4 + h) * 64 + tile)) * 8192) + r;
#pragma unroll
            for (int c = 0; c < 8; ++c) dst[(p * 8 + c) * 64] = o[c];
        }
    }
    {
        u32x4* dst = (u32x4*)((bf16_t*)(a.ws + WS_VIMG) + ((size_t)((b * 4 + h) * 64 + tile)) * 8192) + r;
#pragma unroll
        for (int cg = 2 * p; cg < 2 * p + 2; ++cg)
#pragma unroll
            for (int kg = 0; kg < 4; ++kg) {
                const u32x4 v = *(const u32x4*)(PROJ + ((size_t)b * SEQ + tile * 64 + 16 * kg + (r >> 2)) * PS + C_VA + h * 128 + 32 * cg + 8 * (r & 3));
                dst[(cg * 4 + kg) * 64] = v; }
    }
}

DI bf16x8 tr_frag_nat(const LAS unsigned char* img, int rowbase, int col0, int lane) {
    const int hh = lane >> 5, g16 = (lane >> 4) & 1, i = lane & 15;
    const int col = col0 + 16 * g16 + 4 * (i & 3), chunk = col >> 3, sub = (col & 7) * 2;
    const int r0 = rowbase + 8 * hh + (i >> 2), r1 = r0 + 4;
    const s16x4 lo = trread(img + r0 * 256 + ((chunk ^ swz16(r0)) << 4) + sub);
    const s16x4 hi = trread(img + r1 * 256 + ((chunk ^ swz16(r1)) << 4) + sub);
    return __builtin_shufflevector(lo, hi, 0, 1, 2, 3, 4, 5, 6, 7);
}
DI bf16x8 tr_frag_acc(const LAS unsigned char* img, int rowbase, int col0, int lane) {
    const int hh = lane >> 5, g16 = (lane >> 4) & 1, i = lane & 15;
    const int col = col0 + 16 * g16 + 4 * (i & 3), chunk = col >> 3, sub = (col & 7) * 2;
    const int r0 = rowbase + 4 * hh + (i >> 2), r1 = r0 + 8;
    const s16x4 lo = trread(img + r0 * 256 + ((chunk ^ swz16(r0)) << 4) + sub);
    const s16x4 hi = trread(img + r1 * 256 + ((chunk ^ swz16(r1)) << 4) + sub);
    return __builtin_shufflevector(lo, hi, 0, 1, 2, 3, 4, 5, 6, 7);
}
DI bf16x8 row_frag(const LAS unsigned char* img, int row, int chunk) { return *(const LAS bf16x8*)(img + row * 256 + ((chunk ^ swz16(row)) << 4)); }

DI void glds16_asm(const void* gsrc, unsigned lds_dst) { unsigned keep;
    asm volatile("s_mov_b32 %0, m0\n\ts_mov_b32 m0, %2\n\ts_nop 0\n\tglobal_load_lds_dwordx4 %1, off\n\ts_mov_b32 m0, %0" : "=&s"(keep) : "v"(gsrc), "s"(lds_dst) : "memory"); }
constexpr size_t DO_QC = 0, DO_KC = 32 * MiB, DO_HD = 64 * MiB;
constexpr size_t WS_SC = 7 * MiB;

DI void conv_task(const Ctx& F, const Args& a, int tw) {
    const int isk = tw & 1, tok0 = (tw >> 1) * 8, b = tok0 / SEQ, t0 = tok0 % SEQ, lane = F.lane;
    const bf16_t* src = (const bf16_t*)(a.ws + WS_PROJ) + (size_t)b * SEQ * PS + (isk ? C_KM : C_QM) + lane * 8;
    float cw[5][8];
#pragma unroll
    for (int j = 0; j < 5; ++j) { const f32x4 c0 = *(const f32x4*)(a.conv_w + j * 1024 + isk * 512 + lane * 8), c1 = *(const f32x4*)(a.conv_w + j * 1024 + isk * 512 + lane * 8 + 4);
        cw[j][0] = c0.x; cw[j][1] = c0.y; cw[j][2] = c0.z; cw[j][3] = c0.w; cw[j][4] = c1.x; cw[j][5] = c1.y; cw[j][6] = c1.z; cw[j][7] = c1.w; }
    u32x4 row[12];
#pragma unroll
    for (int r = 0; r < 12; ++r) { const int t = t0 + r - 2; row[r] = (u32x4){0u, 0u, 0u, 0u}; if (t >= 0 && t < SEQ) row[r] = *(const u32x4*)(src + (size_t)t * PS); }
    const int hd = lane >> 4, cc = lane & 15, cch = t0 >> 6, r0 = t0 & 63;
    bf16_t* tileb = (bf16_t*)((unsigned char*)a.out + (isk ? DO_KC : DO_QC)) + ((size_t)((b * 4 + hd) * 64 + cch)) * 8192;
    bf16_t* dst = isk ? tileb + ((cc >> 2) * 4 + (r0 >> 4)) * 512 + (r0 & 15) * 32 + (cc & 3) * 8 : tileb + cc * 512 + r0 * 8;
    const int dstride = isk ? 32 : 8;
    const float sc = isk ? 0.08838834764831845f : 1.f;
#pragma unroll
    for (int i = 0; i < 8; ++i) {
        float acc[8];
#pragma unroll
        for (int e = 0; e < 8; ++e) acc[e] = 0.f;
#pragma unroll
        for (int j = 0; j < 5; ++j) { const u32x4 w = row[i + j];
            acc[0] += bflo(w.x) * cw[j][0]; acc[1] += bfhi(w.x) * cw[j][1]; acc[2] += bflo(w.y) * cw[j][2]; acc[3] += bfhi(w.y) * cw[j][3];
            acc[4] += bflo(w.z) * cw[j][4]; acc[5] += bfhi(w.z) * cw[j][5]; acc[6] += bflo(w.w) * cw[j][6]; acc[7] += bfhi(w.w) * cw[j][7]; }
#pragma unroll
        for (int e = 0; e < 8; ++e) acc[e] = silu_f(acc[e]) * sc;
        u32x4 o; o.x = pk2(acc[0], acc[1]); o.y = pk2(acc[2], acc[3]); o.z = pk2(acc[4], acc[5]); o.w = pk2(acc[6], acc[7]);
        *(u32x4*)(dst + i * dstride) = o;
    }
}

DI void mscal_task(const Ctx& F, const Args& a, int chain) {
    const int b = chain >> 3, h = (chain >> 1) & 3, dir = chain & 1;
    const int s = dir ? 63 - F.lane : F.lane;
    const float* GT = (const float*)(a.ws + WS_GATES) + (size_t)b * SEQ * 16;
    float* SC = (float*)(a.ws + WS_SC) + (size_t)chain * 64 * 256; float* MSC = (float*)(a.ws + WS_MSC);
    LAS float* gl = (LAS float*)F.lds; LAS float* mll = gl + 64; LAS float* mpv = gl + 128; LAS float* mnw = gl + 192;
    float aa[8], ii[8];
#pragma unroll
    for (int i = 0; i < 8; ++i) { const int c = F.wave + 8 * i;
        const float ig = GT[(size_t)(c * 64 + s) * 16 + dir * 8 + h], fg = GT[(size_t)(c * 64 + s) * 16 + dir * 8 + 4 + h];
        const float av = wave_prefix_sum(logsigmoid_f(fg));
        aa[i] = av; ii[i] = ig;
        const float g = __builtin_bit_cast(float, __builtin_amdgcn_readlane(__builtin_bit_cast(int, av), 63)), ml = wave_max(g - av + ig);
        if (F.lane == 0) { gl[c] = g; mll[c] = ml; } }
    __syncthreads();
    if (F.tid == 0) { float m = 0.f;
        for (int st = 0; st < 64; ++st) { const int c = dir ? 63 - st : st; mpv[c] = m; const float mn = fmaxf(gl[c] + m, mll[c]); mnw[c] = mn; m = mn; } }
    __syncthreads();
#pragma unroll
    for (int i = 0; i < 8; ++i) { const int c = F.wave + 8 * i; const float mprev = mpv[c], mnew = mnw[c], g = gl[c];
        const float cterm = ii[i] - aa[i];
        const float cm = wave_prefix_max(cterm);
        const float il = aa[i] + mprev, mj = fmaxf(il, aa[i] + cm);
        float* o4 = SC + (size_t)c * 256 + s;
        o4[0] = (aa[i] - mj) * 1.4426950408889634f; o4[64] = cterm * 1.4426950408889634f; o4[128] = __expf(il - mj); o4[192] = __expf(-mj);
        if (F.lane == 0) { MSC[chain * 64 + c] = (g - mnew) * 1.4426950408889634f; MSC[4096 + chain * 64 + c] = __expf(g + mprev - mnew); } }
    __syncthreads();
}

DI const float* wsel3(int m, const float* p0, const float* p1, const float* p2) {
    const unsigned long long a0 = (unsigned long long)p0, a1 = (unsigned long long)p1, a2 = (unsigned long long)p2;
    const unsigned long long m1 = (unsigned long long)0 - (unsigned long long)(m == 1), m2 = (unsigned long long)0 - (unsigned long long)(m == 2);
    return (const float*)((a0 & ~(m1 | m2)) | (a1 & m1) | (a2 & m2));
}
DI void mseq_item(const Ctx& F, const Args& a, int item, int bh, int dir, int vs) {
    const int b = bh >> 2, h = bh & 3, chain = bh * 2 + dir, wid = F.wave, tid = F.tid, lane = F.lane, r32 = lane & 31, hh = lane >> 5;
    LAS unsigned char* QS = F.lds;
    LAS unsigned char* KS = F.lds + 32768;
    LAS unsigned char* VS = F.lds + 65536;
    LAS unsigned char* SCS = F.lds + 77824;
    LAS unsigned char* SD = F.lds + 80896;
    LAS unsigned char* CI = F.lds + 97280;
    LAS float* NV = (LAS float*)(F.lds + 113664);
    LAS float* gmv = NV + 256; LAS float* spv = gmv + 64;
    LAS unsigned char* HST = F.lds + 115712;
    const int cwi = wid < 4 ? wid : 4;
    const bool cwave = wid < 4 || wid == 7;
    const unsigned cscb = (unsigned)(uintptr_t)F.lds + 119808u + (unsigned)cwi * 8192u;
    const int cslot0 = (item * 5 + cwi) * 64;
    const float* const wg_ = a.w_gate; const float* const wu_ = a.w_up; const float* const wd_ = a.w_down;
    const bf16_t* QC = (const bf16_t*)((const unsigned char*)a.out + DO_QC) + (size_t)bh * 64 * 8192 + lane * 8;
    const bf16_t* KC = (const bf16_t*)((const unsigned char*)a.out + DO_KC) + (size_t)bh * 64 * 8192 + lane * 8;
    const bf16_t* VP = (const bf16_t*)(a.ws + WS_PROJ) + (size_t)b * SEQ * PS + C_VM + h * 128 + vs * 32 + (size_t)(16 * (wid & 3) + (lane >> 2)) * PS + 8 * (lane & 3);
    const float* SC = (const float*)(a.ws + WS_SC) + (size_t)chain * 64 * 256 + lane * 4;
    bf16_t* HD = (bf16_t*)((unsigned char*)a.out + DO_HD) + ((size_t)dir * MTOK + (size_t)b * SEQ) * 512 + h * 128 + vs * 32;
    if (tid < 64) { gmv[tid] = ((const float*)(a.ws + WS_MSC))[chain * 64 + tid]; spv[tid] = ((const float*)(a.ws + WS_MSC))[4096 + chain * 64 + tid]; }
    if (tid < 256) NV[tid] = 0.f;
    for (int i = tid; i < 4096; i += NTHR) ((LAS unsigned*)CI)[i] = 0u;
    const unsigned ldsb = (unsigned)(uintptr_t)F.lds;
#define MSEQ_ISSUE_QK(c, s2) do { const size_t _tb = (size_t)(c); \
        if (wid < 4) { _Pragma("unroll") for (int _i = 0; _i < 4; ++_i) \
                glds16_asm(QC + _tb * 8192 + (4 * wid + _i) * 512, (unsigned)__builtin_amdgcn_readfirstlane((int)(ldsb + (s2) * 16384 + (4 * wid + _i) * 1024))); } \
        else if (wid >= 6) { _Pragma("unroll") for (int _i = 0; _i < 8; ++_i) \
                glds16_asm(KC + _tb * 8192 + (8 * (wid - 6) + _i) * 512, (unsigned)__builtin_amdgcn_readfirstlane((int)(ldsb + 32768 + (s2) * 16384 + (8 * (wid - 6) + _i) * 1024))); } } while (0)
#define MSEQ_ISSUE_VS(c, s4) do { const size_t _tb = (size_t)(c); \
        if (wid < 4) glds16_asm(VP + _tb * 64 * PS, (unsigned)__builtin_amdgcn_readfirstlane((int)(ldsb + 65536 + (s4) * 4096 + wid * 1024))); \
        else if (wid == 6) glds16_asm(SC + _tb * 256, (unsigned)__builtin_amdgcn_readfirstlane((int)(ldsb + 77824 + (s4) * 1024))); } while (0)
    MSEQ_ISSUE_QK(dir ? 63 : 0, 0); MSEQ_ISSUE_VS(dir ? 63 : 0, 0);
#define MSEQ_CONV_ISSUE(id) do { const int _e = (id) / 6144, _r = (id) % 6144, _mat = _r >> 11, _rr = _r & 2047; \
        const int _N = _mat == 2 ? DM : DFF, _nb = _mat == 2 ? (_rr >> 7) : (_rr >> 6), _kb = _mat == 2 ? (_rr & 127) : (_rr & 63); \
        const float* _src = wsel3(_mat, wg_, wu_, wd_) + (size_t)_e * DM * DFF + (size_t)(16 * _kb + (lane >> 4)) * _N + 64 * _nb + 4 * (lane & 15); \
        _Pragma("unroll") for (int _i = 0; _i < 4; ++_i) glds16_asm(_src + (size_t)(4 * _i) * _N, (unsigned)__builtin_amdgcn_readfirstlane((int)(cscb + ((id) & 1) * 4096 + _i * 1024))); } while (0)
    if (cwave) MSEQ_CONV_ISSUE(cslot0);
    f32x16 Cacc[2];
#pragma unroll
    for (int i = 0; i < 16; ++i) { Cacc[0][i] = 0.f; Cacc[1][i] = 0.f; }
    const int qrd = hh * 1024 + r32 * 16;
    const int ktr = (8 * hh + ((lane & 15) >> 2)) * 64 + ((lane >> 4) & 1) * 32 + (lane & 3) * 8;
    f32x16 acc;
    float qn = 0.f;
#pragma unroll
    for (int i = 0; i < 16; ++i) acc[i] = 0.f;
    asm volatile("s_waitcnt vmcnt(0)" ::: "memory");
    __syncthreads();
    unsigned long long busy = 0, tb0 = 0; if (PROBE_MSEQ_W >= 0) tb0 = __builtin_amdgcn_s_memtime(); const unsigned long long titem0 = tb0;
#pragma unroll 1
    for (int st = 0; st <= 64; ++st) {
        const int c = dir ? 63 - st : st, s2 = st & 1; const int s3 = st % 3, s3p = (st + 2) % 3;
        if (st + 1 < 64) { MSEQ_ISSUE_QK(dir ? 62 - st : st + 1, s2 ^ 1); MSEQ_ISSUE_VS(dir ? 62 - st : st + 1, (st + 1) % 3);
            if (cwave) MSEQ_CONV_ISSUE(cslot0 + st + 1); }
        const LAS unsigned char* QT = QS + s2 * 16384; const LAS unsigned char* KT = KS + s2 * 16384; const LAS unsigned char* VT = VS + s3 * 4096;
        const LAS float* rt = (const LAS float*)(SCS + s3 * 1024); const LAS float* ct = rt + 64;
        if (wid < 4) {
            if (st < 64) {
                const int jt = wid >> 1, stt = wid & 1;
                const LAS unsigned char* qa = QT + qrd + jt * 512;
                const LAS unsigned char* kb = KT + (2 * stt + (r32 >> 4)) * 1024 + (r32 & 15) * 64 + hh * 16;
                const int j = 32 * jt + r32; const float rtj = rt[j];
                const LAS float* ctp = ct + 32 * stt + 4 * hh;
                f32x4 c4[4];
#pragma unroll
                for (int rg = 0; rg < 4; ++rg) c4[rg] = *(const LAS f32x4*)(ctp + 8 * rg);
                const float gm = gmv[c], sp = spv[c];
                const int ck = 4 * wid + (lane & 3), r0 = 4 * (lane >> 2);
                const LAS unsigned char* kr = KT + (ck >> 2) * 4096 + (r0 >> 4) * 1024 + (r0 & 15) * 64 + (ck & 3) * 16;
                u32x4 kw[4];
#pragma unroll
                for (int r = 0; r < 4; ++r) kw[r] = *(const LAS u32x4*)(kr + r * 64);
                const f32x4 ctn = *(const LAS f32x4*)(ct + r0);
                const LAS float* no = NV + s2 * 128 + 32 * wid + 8 * (lane & 3);
                const f32x4 o0 = *(const LAS f32x4*)no, o1 = *(const LAS f32x4*)(no + 4);
                f32x16 S;
                f32x16 S2;
#pragma unroll
                for (int i = 0; i < 16; ++i) { S[i] = 0.f; S2[i] = 0.f; }
#pragma unroll
                for (int ks = 0; ks < 8; ks += 2) { S = MFMA32(*(const LAS bf16x8*)(kb + (ks >> 1) * 4096), *(const LAS bf16x8*)(qa + ks * 2048), S);
                    S2 = MFMA32(*(const LAS bf16x8*)(kb + (ks >> 1) * 4096 + 32), *(const LAS bf16x8*)(qa + (ks + 1) * 2048), S2); }
#pragma unroll
                for (int i = 0; i < 16; ++i) S[i] += S2[i];
                float pa[8];
#pragma unroll
                for (int e = 0; e < 8; ++e) pa[e] = 0.f;
#pragma unroll
                for (int r = 0; r < 4; ++r) { const u32x4 w = kw[r]; const float ws_ = __builtin_amdgcn_exp2f(ctn[r] + gm);
                    pa[0] += ws_ * bflo(w.x); pa[1] += ws_ * bfhi(w.x); pa[2] += ws_ * bflo(w.y); pa[3] += ws_ * bfhi(w.y); pa[4] += ws_ * bflo(w.z); pa[5] += ws_ * bfhi(w.z); pa[6] += ws_ * bflo(w.w); pa[7] += ws_ * bfhi(w.w); }
#pragma unroll
                for (int e = 0; e < 8; ++e) { float t = pa[e]; t += dpp_mov<DPP_ROR(8)>(t); t += dpp_mov<DPP_ROR(4)>(t); t = xor16_sum(t); pa[e] = xor32_sum(t); }
                u32x2 sw2[4];
#pragma unroll
                for (int rg = 0; rg < 4; ++rg) { float v[4];
#pragma unroll
                    for (int e = 0; e < 4; ++e) { const int sc = 32 * stt + 8 * rg + 4 * hh + e; const bool ok = dir == 0 ? (sc <= j) : (sc >= j);
                        v[e] = S[4 * rg + e] * __builtin_amdgcn_exp2f(ok ? rtj + c4[rg][e] : -1.0e30f); }
                    sw2[rg].x = pk2(v[0], v[1]); sw2[rg].y = pk2(v[2], v[3]); }
                LAS unsigned char* sw = SD + s2 * 8192 + stt * 4096 + j * 16 + hh * 8;
#pragma unroll
                for (int rg = 0; rg < 4; ++rg) *(LAS u32x2*)(sw + rg * 1024) = sw2[rg];
                if (lane < 4) { LAS float* nn = NV + (s2 ^ 1) * 128 + 32 * wid + 8 * lane;
                    *(LAS f32x4*)nn = (f32x4){sp * o0.x + pa[0], sp * o0.y + pa[1], sp * o0.z + pa[2], sp * o0.w + pa[3]};
                    *(LAS f32x4*)(nn + 4) = (f32x4){sp * o1.x + pa[4], sp * o1.y + pa[5], sp * o1.z + pa[6], sp * o1.w + pa[7]}; }
            }
        } else if (wid < 6) {
            const int jt = wid - 4, jl = 32 * jt + r32;
            u32x2 hw[4]; bool have_h = false; int cp = 0;
            if (st > 0) {
                cp = dir ? 64 - st : st - 1; have_h = true;
                const LAS float* iw = (const LAS float*)(SCS + s3p * 1024) + 128; const LAS float* enm = iw + 64;
                const LAS unsigned char* SDp = SD + (s2 ^ 1) * 8192;
                const LAS unsigned char* sr = SDp + hh * 4096 + jl * 16;
                u32x4 w4[4];
#pragma unroll
                for (int ch = 0; ch < 4; ++ch) w4[ch] = *(const LAS u32x4*)(sr + ch * 1024);
                const float iwj = iw[jl], enj = enm[jl];
                const LAS unsigned char* sa = SDp + qrd + jt * 512; const LAS unsigned char* vb = VS + s3p * 4096 + ktr;
                float rsum = 0.f;
#pragma unroll
                for (int ch = 0; ch < 4; ++ch) { const u32x4 w = w4[ch];
                    rsum += (bflo(w.x) + bfhi(w.x)) + (bflo(w.y) + bfhi(w.y)) + (bflo(w.z) + bfhi(w.z)) + (bflo(w.w) + bfhi(w.w)); }
                rsum = xor32_sum(rsum);
                const float den = rsum + iwj * qn;
                const float rdj = 1.f / fmaxf(fabsf(den), enj);
#pragma unroll
                for (int i = 0; i < 16; ++i) acc[i] *= iwj;
#pragma unroll
                for (int ks = 0; ks < 4; ++ks) { const s16x4 lo = trread(vb + ks * 1024), hi = trread(vb + ks * 1024 + 256);
                    acc = MFMA32(__builtin_shufflevector(lo, hi, 0, 1, 2, 3, 4, 5, 6, 7), *(const LAS bf16x8*)(sa + ks * 2048), acc); }
#pragma unroll
                for (int rg = 0; rg < 4; ++rg) { hw[rg].x = pk2(acc[4 * rg] * rdj, acc[4 * rg + 1] * rdj); hw[rg].y = pk2(acc[4 * rg + 2] * rdj, acc[4 * rg + 3] * rdj); }
            }
            if (st < 64) {
                const LAS unsigned char* qa = QT + qrd + jt * 512;
                const LAS unsigned char* cb = CI + s2 * 8192 + hh * 512 + r32 * 16;
                const LAS unsigned char* qr = QT + hh * 8192 + jl * 16; const LAS float* np = NV + s2 * 128 + 64 * hh;
                f32x16 acc2;
#pragma unroll
                for (int i = 0; i < 16; ++i) { acc[i] = 0.f; acc2[i] = 0.f; }
#pragma unroll
                for (int ks = 0; ks < 8; ks += 2) { acc = MFMA32(*(const LAS bf16x8*)(cb + ks * 1024), *(const LAS bf16x8*)(qa + ks * 2048), acc);
                    acc2 = MFMA32(*(const LAS bf16x8*)(cb + (ks + 1) * 1024), *(const LAS bf16x8*)(qa + (ks + 1) * 2048), acc2); }
#pragma unroll
                for (int i = 0; i < 16; ++i) acc[i] += acc2[i];
                qn = 0.f;
#pragma unroll
                for (int ch = 0; ch < 8; ++ch) { const u32x4 w = *(const LAS u32x4*)(qr + ch * 1024); const f32x4 n0 = *(const LAS f32x4*)(np + ch * 8), n1 = *(const LAS f32x4*)(np + ch * 8 + 4);
                    qn += bflo(w.x) * n0.x + bfhi(w.x) * n0.y + bflo(w.y) * n0.z + bfhi(w.y) * n0.w + bflo(w.z) * n1.x + bfhi(w.z) * n1.y + bflo(w.w) * n1.z + bfhi(w.w) * n1.w; }
                qn = xor32_sum(qn);
            }
            if (have_h) {
                LAS unsigned char* hst = HST + jt * 2048;
#pragma unroll
                for (int rg = 0; rg < 4; ++rg) *(LAS u32x2*)(hst + r32 * 64 + (8 * rg + 4 * hh) * 2) = hw[rg];
                asm volatile("s_waitcnt lgkmcnt(0)" ::: "memory");
#pragma unroll
                for (int q = 0; q < 2; ++q) { const int row = 16 * q + (lane >> 2), part = lane & 3;
                    const u32x4 w = *(const LAS u32x4*)(hst + row * 64 + part * 16);
                    *(u32x4*)(HD + (size_t)(cp * 64 + 32 * jt + row) * 512 + part * 8) = w; }
            }
        } else if (st < 64) {
            const int u = wid - 6; const float gm = gmv[c], sp = spv[c];
            const LAS unsigned char* va = VT + ktr; const LAS unsigned char* ka = KT + ktr + (2 * u) * 4096;
            s16x4 vlo[4], vhi[4], k0l[4], k0h[4], k1l[4], k1h[4]; f32x4 cw0[4], cw1[4];
#pragma unroll
            for (int ks = 0; ks < 4; ++ks) { vlo[ks] = trread(va + ks * 1024); vhi[ks] = trread(va + ks * 1024 + 256);
                cw0[ks] = *(const LAS f32x4*)(ct + 16 * ks + 8 * hh); cw1[ks] = *(const LAS f32x4*)(ct + 16 * ks + 8 * hh + 4);
                k0l[ks] = trread(ka + ks * 1024); k0h[ks] = trread(ka + ks * 1024 + 256); k1l[ks] = trread(ka + 4096 + ks * 1024); k1h[ks] = trread(ka + 4096 + ks * 1024 + 256); }
#pragma unroll
            for (int i = 0; i < 16; ++i) { Cacc[0][i] *= sp; Cacc[1][i] *= sp; }
#pragma unroll
            for (int ks = 0; ks < 4; ++ks) {
                const s16x4 lo = vlo[ks], hi = vhi[ks]; const f32x4 e0 = cw0[ks], e1 = cw1[ks];
                u32x4 af;
                af.x = pk2(bf2f((bf16_t)lo[0]) * __builtin_amdgcn_exp2f(e0.x + gm), bf2f((bf16_t)lo[1]) * __builtin_amdgcn_exp2f(e0.y + gm));
                af.y = pk2(bf2f((bf16_t)lo[2]) * __builtin_amdgcn_exp2f(e0.z + gm), bf2f((bf16_t)lo[3]) * __builtin_amdgcn_exp2f(e0.w + gm));
                af.z = pk2(bf2f((bf16_t)hi[0]) * __builtin_amdgcn_exp2f(e1.x + gm), bf2f((bf16_t)hi[1]) * __builtin_amdgcn_exp2f(e1.y + gm));
                af.w = pk2(bf2f((bf16_t)hi[2]) * __builtin_amdgcn_exp2f(e1.z + gm), bf2f((bf16_t)hi[3]) * __builtin_amdgcn_exp2f(e1.w + gm));
                const bf16x8 afr = __builtin_bit_cast(bf16x8, af);
                Cacc[0] = MFMA32(__builtin_shufflevector(k0l[ks], k0h[ks], 0, 1, 2, 3, 4, 5, 6, 7), afr, Cacc[0]);
                Cacc[1] = MFMA32(__builtin_shufflevector(k1l[ks], k1h[ks], 0, 1, 2, 3, 4, 5, 6, 7), afr, Cacc[1]);
            }
            LAS unsigned char* cw = CI + (s2 ^ 1) * 8192 + (2 * u) * 2048 + r32 * 16 + hh * 8;
#pragma unroll
            for (int t2 = 0; t2 < 2; ++t2)
#pragma unroll
                for (int rg = 0; rg < 4; ++rg) { u32x2 w; w.x = pk2(Cacc[t2][4 * rg], Cacc[t2][4 * rg + 1]); w.y = pk2(Cacc[t2][4 * rg + 2], Cacc[t2][4 * rg + 3]); *(LAS u32x2*)(cw + t2 * 2048 + rg * 512) = w; }
        }
        if (PROBE_MSEQ_W >= 0) { asm volatile("s_waitcnt lgkmcnt(0)" ::: "memory"); busy += __builtin_amdgcn_s_memtime() - tb0; }
        if (cwave) {
            if (st + 1 < 64) asm volatile("s_waitcnt vmcnt(4)" ::: "memory"); else asm volatile("s_waitcnt vmcnt(0)" ::: "memory");
            if (st < 64) {
                const int id = cslot0 + st, e = id / 6144, r = id % 6144, mat = r >> 11, rr = r & 2047;
                const int nb = mat == 2 ? (rr >> 7) : (rr >> 6), kb = mat == 2 ? (rr & 127) : (rr & 63), n = 64 * nb + lane;
                unsigned char* dst = mat == 2 ? a.ws + WS_WDT + (size_t)e * DM * DFF + (size_t)n * DFF + 16 * kb
                                              : a.ws + WS_WGUT + (size_t)e * 4096 * DM + (size_t)((n >> 7) * 256 + (n & 127) + mat * 128) * DM + 16 * kb;
                const LAS float* CSC = (const LAS float*)(F.lds + 119808 + cwi * 8192 + (id & 1) * 4096);
                float cv[16];
#pragma unroll
                for (int k = 0; k < 16; ++k) cv[k] = CSC[k * 64 + lane] * pg8::W_PRESCALE;
                u32x4 o; o.x = pg8::pk4_fp8(cv[0], cv[1], cv[2], cv[3]); o.y = pg8::pk4_fp8(cv[4], cv[5], cv[6], cv[7]); o.z = pg8::pk4_fp8(cv[8], cv[9], cv[10], cv[11]); o.w = pg8::pk4_fp8(cv[12], cv[13], cv[14], cv[15]);
                *(u32x4*)dst = o;
            }
        } else if (wid == 6) asm volatile("s_waitcnt vmcnt(0)" ::: "memory");
        asm volatile("s_waitcnt lgkmcnt(0)" ::: "memory"); __builtin_amdgcn_s_barrier(); asm volatile("" ::: "memory");
        if (PROBE_MSEQ_W >= 0) tb0 = __builtin_amdgcn_s_memtime();
    }
    if (PROBE_MSEQ_W >= 0 && F.bid == 0 && lane == 0 && (wid == PROBE_MSEQ_W || (PROBE_MSEQ_W == 8 && wid == 0)))
        *(volatile LAS unsigned long long*)(F.lds + LDS_BYTES - 128) = (PROBE_MSEQ_W == 8) ? (__builtin_amdgcn_s_memtime() - titem0) : busy;
    asm volatile("s_waitcnt vmcnt(0)" ::: "memory");
#undef MSEQ_ISSUE_QK
#undef MSEQ_ISSUE_VS
#undef MSEQ_CONV_ISSUE
}

DI void glds16(const void* g, LAS unsigned char* l) { __builtin_amdgcn_global_load_lds((const unsigned*)g, (LAS unsigned*)l, 16, 0, 0); }
DI void attn_unit(const Ctx& F, const Args& a, int b, int h, int qb, float lam, float cshift) {
    const int lane = F.lane, wid = F.wave, r32 = lane & 31, hh = lane >> 5, rg = wid & 3, p = wid >> 2;
    const bf16_t* projb = (const bf16_t*)(a.ws + WS_PROJ) + (size_t)b * SEQ * PS;
    const int qrow = qb * 128 + rg * 32 + r32;
    bf16x8 qf[4];
    { const bf16_t* qp = projb + (size_t)qrow * PS + C_QA + h * 128 + p * 64 + hh * 8;
#pragma unroll
      for (int ks = 0; ks < 4; ++ks) qf[ks] = *(const bf16x8*)(qp + ks * 16); }
    const bf16_t* kimg = (const bf16_t*)(a.ws + WS_KIMG) + (size_t)(b * 4 + h) * 64 * 8192 + (4 * wid) * 512 + lane * 8;
    const bf16_t* vimg = (const bf16_t*)(a.ws + WS_VIMG) + (size_t)(b * 4 + h) * 64 * 8192 + (4 * wid) * 512 + lane * 8;
    const unsigned ldsw = (unsigned)__builtin_amdgcn_readfirstlane((int)(unsigned)(uintptr_t)F.lds + (4 * wid) * 1024);
#define ATT_ISSUE2(img, t0, ldsoff) do { const int _q0 = 4 * wid; const int _t = (t0) + (_q0 >> 4); const bf16_t* _tp = (img) + (size_t)(_t < 64 ? _t : 63) * 8192 - (size_t)(_q0 & 16) * 512; \
        const unsigned _d = (unsigned)__builtin_amdgcn_readfirstlane((int)(ldsw + (ldsoff))); \
        _Pragma("unroll") for (int _i = 0; _i < 4; ++_i) glds16_asm(_tp + _i * 512, _d + _i * 1024); } while (0)
    if (wid < 4) { const bf16_t* _tp = kimg; const unsigned _d = (unsigned)__builtin_amdgcn_readfirstlane((int)(ldsw + 32768));
#pragma unroll
        for (int _i = 0; _i < 4; ++_i) glds16_asm(_tp + _i * 512, _d + _i * 1024); }
    ATT_ISSUE2(kimg, 1, 0); ATT_ISSUE2(vimg, 0, 65536);
    f32x16 O[4];
#pragma unroll
    for (int vt = 0; vt < 4; ++vt)
#pragma unroll
        for (int i = 0; i < 16; ++i) O[vt][i] = 0.f;
    float lsum = 0.f;
    const int kfb = p * 8192 + hh * 1024 + r32 * 16;
    const int vfb = (4 * hh + ((lane & 15) >> 2)) * 64 + ((lane >> 4) & 1) * 32 + (lane & 3) * 8;
    bf16x8 pb[4], pc[4];
    asm volatile("s_waitcnt vmcnt(0)" ::: "memory");
    __syncthreads();
#define ATT_VLOAD(dst, Vb, kg) do { _Pragma("unroll") for (int vt = 0; vt < 4; ++vt) { \
        const s16x4 _lo = trread((Vb) + vt * 4096 + (kg) * 1024), _hi = trread((Vb) + vt * 4096 + (kg) * 1024 + 512); dst[vt] = __builtin_shufflevector(_lo, _hi, 0, 1, 2, 3, 4, 5, 6, 7); } } while (0)
#define ATT_PV(vf, kg, PIN) do { __builtin_amdgcn_s_setprio(1); _Pragma("unroll") for (int vt = 0; vt < 4; ++vt) O[vt] = MFMA32(vf[vt], PIN[kg], O[vt]); __builtin_amdgcn_s_setprio(0); } while (0)
#define ATT_EXPQ(S, o, dst) do { float _e[8]; _Pragma("unroll") for (int i = 0; i < 8; ++i) _e[i] = __builtin_amdgcn_exp2f(S[(o) + i]); \
        _Pragma("unroll") for (int i = 0; i < 8; ++i) ls = ls + _e[i]; \
        u32x4 _w; _w.x = pk2(_e[0], _e[1]); _w.y = pk2(_e[2], _e[3]); _w.z = pk2(_e[4], _e[5]); _w.w = pk2(_e[6], _e[7]); dst = __builtin_bit_cast(bf16x8, _w); } while (0)
#define ATT_STEP(Kb, Vb, on0, PIN, POUT) do { \
        bf16x8 kfa[4], kfb2[4], vA[4], vB[4]; float ls = 0.f; \
        _Pragma("unroll") for (int ks = 0; ks < 4; ++ks) { kfa[ks] = *(const LAS bf16x8*)((Kb) + ks * 2048); kfb2[ks] = *(const LAS bf16x8*)((Kb) + ks * 2048 + 512); } \
        ATT_VLOAD(vA, Vb, 0); \
        __builtin_amdgcn_s_setprio(1); \
        Sa = MFMA32(kfa[0], qf[0], negc); Sb = MFMA32(kfb2[0], qf[0], negc);        \
        _Pragma("unroll") for (int ks = 1; ks < 4; ++ks) { Sa = MFMA32(kfa[ks], qf[ks], Sa); Sb = MFMA32(kfb2[ks], qf[ks], Sb); } \
        __builtin_amdgcn_s_setprio(0); \
        ATT_VLOAD(vB, Vb, 1); ATT_PV(vA, 0, PIN); ATT_EXPQ(Sa, 0, POUT[0]); \
        ATT_VLOAD(vA, Vb, 2); ATT_PV(vB, 1, PIN); ATT_EXPQ(Sa, 8, POUT[1]); \
        ATT_VLOAD(vB, Vb, 3); ATT_PV(vA, 2, PIN); ATT_EXPQ(Sb, 0, POUT[2]); \
        ATT_PV(vB, 3, PIN); ATT_EXPQ(Sb, 8, POUT[3]); \
        lsum += (on0) ? ls : 0.f; } while (0)
    f32x16 Sa, Sb, negc;
#pragma unroll
    for (int i = 0; i < 16; ++i) negc[i] = -cshift;
    asm volatile("" : "+v"(negc));
    {
        const LAS unsigned char* Kb = F.lds + 32768 + kfb;
        Sa = MFMA32(*(const LAS bf16x8*)(Kb), qf[0], negc); Sb = MFMA32(*(const LAS bf16x8*)(Kb + 512), qf[0], negc);
#pragma unroll
        for (int ks = 1; ks < 4; ++ks) { Sa = MFMA32(*(const LAS bf16x8*)(Kb + ks * 2048), qf[ks], Sa); Sb = MFMA32(*(const LAS bf16x8*)(Kb + ks * 2048 + 512), qf[ks], Sb); }
        float ls = 0.f;
        ATT_EXPQ(Sa, 0, pb[0]); ATT_EXPQ(Sa, 8, pb[1]); ATT_EXPQ(Sb, 0, pb[2]); ATT_EXPQ(Sb, 8, pb[3]);
        lsum += ls;
    }
    __syncthreads();
#pragma unroll 1
    for (int T = 0; T < 32; ++T) {
        const int j = T & 1;
        ATT_ISSUE2(kimg, 2 * T + 3, (j ^ 1) * 32768);
        ATT_ISSUE2(vimg, 2 * T + 2, 65536 + (j ^ 1) * 32768);
        const LAS unsigned char* Ks = F.lds + j * 32768 + kfb; const LAS unsigned char* Vs = F.lds + 65536 + j * 32768 + vfb;
        ATT_STEP(Ks, Vs, true, pb, pc);
        ATT_STEP(Ks + 16384, Vs + 16384, T < 31, pc, pb);
        asm volatile("s_waitcnt vmcnt(0)" ::: "memory");
        __syncthreads();
    }
#undef ATT_EXPQ
#undef ATT_STEP
#undef ATT_VLOAD
#undef ATT_PV
#undef ATT_ISSUE2
    lsum += __shfl_xor(lsum, 32);
    LAS float* X = (LAS float*)(F.lds + 65536) + rg * 4096 + r32;
    if (p == 1) {
        const float sc = lam / lsum;
#pragma unroll
        for (int vt = 0; vt < 4; ++vt)
#pragma unroll
            for (int i = 0; i < 16; ++i) X[(32 * vt + crow(i, hh)) * 32] = O[vt][i] * sc;
    }
    __syncthreads();
    if (p == 0) {
        const float i0 = 1.f / lsum;
        float ssq = 0.f;
#pragma unroll
        for (int vt = 0; vt < 4; ++vt)
#pragma unroll
            for (int i = 0; i < 16; ++i) { const float o = O[vt][i] * i0 - X[(32 * vt + crow(i, hh)) * 32]; O[vt][i] = o; ssq += o * o; }
        ssq += __shfl_xor(ssq, 32);
        const float rs = rsqrtf(ssq * (1.f / 128.f) + EPS) * 0.8f;
        bf16_t* yp = (bf16_t*)(a.ws + WS_YA) + (size_t)(b * SEQ + qrow) * 512 + h * 128;
#pragma unroll
        for (int vt = 0; vt < 4; ++vt)
#pragma unroll
            for (int rgi = 0; rgi < 4; ++rgi) { const int vd = 32 * vt + 8 * rgi + 4 * hh; const f32x4 g = *(const f32x4*)(a.subln_g + vd);
                u32x2 w; w.x = pk2(O[vt][4 * rgi] * rs * g.x, O[vt][4 * rgi + 1] * rs * g.y); w.y = pk2(O[vt][4 * rgi + 2] * rs * g.z, O[vt][4 * rgi + 3] * rs * g.w);
                *(u32x2*)(yp + vd) = w; }
    }
    __syncthreads();
}

DI void mcombine_phase(const Ctx& F, const Args& a) {
    const int gw = F.bid * NWAVES + F.wave, NGW = F.G * NWAVES, lane = F.lane;
    const bf16_t* HD = (const bf16_t*)((const unsigned char*)a.out + DO_HD);
    float g[8];
#pragma unroll
    for (int i = 0; i < 8; ++i) g[i] = a.mnorm_g[lane * 8 + i];
    for (int m = gw; m < MTOK; m += NGW) {
        const u32x4 f = *(const u32x4*)(HD + (size_t)m * 512 + lane * 8), bw = *(const u32x4*)(HD + ((size_t)MTOK + m) * 512 + lane * 8);
        const u32x4 om = *(const u32x4*)((const bf16_t*)(a.ws + WS_PROJ) + (size_t)m * PS + C_OM + lane * 8);
        const u32x4 ya = *(const u32x4*)((const bf16_t*)(a.ws + WS_YA) + (size_t)m * 512 + lane * 8);
        float v[8];
        v[0] = bflo(f.x) + bflo(bw.x); v[1] = bfhi(f.x) + bfhi(bw.x); v[2] = bflo(f.y) + bflo(bw.y); v[3] = bfhi(f.y) + bfhi(bw.y);
        v[4] = bflo(f.z) + bflo(bw.z); v[5] = bfhi(f.z) + bfhi(bw.z); v[6] = bflo(f.w) + bflo(bw.w); v[7] = bfhi(f.w) + bfhi(bw.w);
        float ss = 0.f;
#pragma unroll
        for (int i = 0; i < 8; ++i) ss += v[i] * v[i];
        ss += __shfl_xor(ss, 1); ss += __shfl_xor(ss, 2); ss += __shfl_xor(ss, 4); ss += __shfl_xor(ss, 8);
        const float rstd = rsqrtf(ss * (1.f / 128.f) + EPS);
        float o[8];
        o[0] = bflo(om.x); o[1] = bfhi(om.x); o[2] = bflo(om.y); o[3] = bfhi(om.y); o[4] = bflo(om.z); o[5] = bfhi(om.z); o[6] = bflo(om.w); o[7] = bfhi(om.w);
#pragma unroll
        for (int i = 0; i < 8; ++i) v[i] = v[i] * rstd * g[i] * sigmoid_f(o[i]);
        u32x4 w; w.x = pk2(v[0], v[1]); w.y = pk2(v[2], v[3]); w.z = pk2(v[4], v[5]); w.w = pk2(v[6], v[7]);
        bf16_t* yp = (bf16_t*)(a.ws + WS_YMIX) + (size_t)m * DM + lane * 8;
        *(u32x4*)yp = w; *(u32x4*)(yp + 512) = ya;
    }
}

DI void router_finish(const float (&lg)[16], int lane, float* affrow, bool store) {
    float r8[8];
#pragma unroll
    for (int i = 0; i < 8; ++i) { const float keep = hh_sel(lane, 32) ? lg[8 + i] : lg[i], send = hh_sel(lane, 32) ? lg[i] : lg[8 + i]; r8[i] = keep + partner32(send, lane); }
    float r4[4];
#pragma unroll
    for (int i = 0; i < 4; ++i) { const float keep = hh_sel(lane, 16) ? r8[4 + i] : r8[i], send = hh_sel(lane, 16) ? r8[i] : r8[4 + i]; r4[i] = keep + partner16(send, lane); }
    float r2[2];
#pragma unroll
    for (int i = 0; i < 2; ++i) { const float keep = hh_sel(lane, 8) ? r4[2 + i] : r4[i], send = hh_sel(lane, 8) ? r4[i] : r4[2 + i]; r2[i] = keep + partner8(send); }
    float lgt; { const float keep = hh_sel(lane, 4) ? r2[1] : r2[0], send = hh_sel(lane, 4) ? r2[0] : r2[1]; lgt = keep + partner4(send, lane); }
    lgt += dpp_mov<DPP_XOR2>(lgt); lgt += dpp_mov<DPP_XOR1>(lgt);
    float mx = lgt; mx = fmaxf(mx, dpp_mov<DPP_ROR(8)>(mx)); mx = fmaxf(mx, dpp_mov<DPP_ROR(4)>(mx)); mx = xor16_max(mx); mx = xor32_max(mx);
    const float ex = __expf(lgt - mx); float sm = ex; sm += dpp_mov<DPP_ROR(8)>(sm); sm += dpp_mov<DPP_ROR(4)>(sm); sm = xor16_sum(sm); sm = xor32_sum(sm);
    if ((lane & 3) == 0 && store) affrow[lane >> 2] = ex / sm;
}
DI void p7_phase(const Ctx& F, const Args& a) {
    LAS f32x4* WRL = (LAS f32x4*)F.lds;
    for (int q = F.tid; q < 4096; q += NTHR) { const int k = q >> 2, g = q & 3; WRL[(g * 4 + (k & 3)) * 256 + ((k >> 2) & 63) + 64 * (k >> 8)] = *(const f32x4*)(a.w_router + k * 16 + g * 4); }
    __syncthreads();
    const int gw = F.bid * NWAVES + F.wave, NGW = F.G * NWAVES, lane = F.lane;
    const float* mod = (const float*)(a.ws + WS_MOD);
    unsigned char* H2 = a.ws + WS_H2; float* AFF = (float*)(a.ws + WS_AFF);
    for (int m = gw; m < MTOK; m += NGW) {
        const int b = m / SEQ;
        const u32x2* xr = (const u32x2*)((const bf16_t*)(a.ws + WS_X1B) + (size_t)m * DM) + lane;
        f32x4 v[4]; float s = 0.f;
#pragma unroll
        for (int j = 0; j < 4; ++j) { const u32x2 w = xr[64 * j]; v[j].x = bflo(w.x); v[j].y = bfhi(w.x); v[j].z = bflo(w.y); v[j].w = bfhi(w.y);
            s += (v[j].x * v[j].x + v[j].y * v[j].y) + (v[j].z * v[j].z + v[j].w * v[j].w); }
        const float rstd = rsqrtf(wave_sum(s) * (1.f / DM) + EPS);
        float lg[16];
#pragma unroll
        for (int e = 0; e < 16; ++e) lg[e] = 0.f;
        unsigned* o4 = (unsigned*)(H2 + (size_t)m * DM) + lane;
#pragma unroll
        for (int j = 0; j < 4; ++j) {
            const f32x4 g = ((const f32x4*)a.norm2_g)[lane + 64 * j];
            const f32x4 sh = ((const f32x4*)(mod + (size_t)b * 6144 + 3072))[lane + 64 * j];
            const f32x4 sc = ((const f32x4*)(mod + (size_t)b * 6144 + 4096))[lane + 64 * j];
            const f32x4 hv = v[j] * rstd * g * (sc + 1.f) + sh;
            o4[64 * j] = pg8::pk4_fp8(hv.x, hv.y, hv.z, hv.w);
#pragma unroll
            for (int e = 0; e < 4; ++e) { const float he = hv[e];
#pragma unroll
                for (int g4 = 0; g4 < 4; ++g4) { const f32x4 w = WRL[(g4 * 4 + e) * 256 + lane + 64 * j];
                    lg[g4 * 4 + 0] += he * w.x; lg[g4 * 4 + 1] += he * w.y; lg[g4 * 4 + 2] += he * w.z; lg[g4 * 4 + 3] += he * w.w; } }
            __builtin_amdgcn_sched_barrier(0);
        }
        router_finish(lg, lane, AFF + (size_t)m * 16, true);
    }
    __syncthreads();
}

DI void topk_task(const Ctx& F, const Args& a, int task) {
    const int b = task >> 4, e = task & 15, tid = F.tid, lane = F.lane;
    const float* AFF = (const float*)(a.ws + WS_AFF) + (size_t)b * SEQ * 16 + e;
    LAS unsigned* hist = (LAS unsigned*)F.lds;
    LAS unsigned* sfx = hist + 256;
    LAS unsigned* misc = hist + 512;
    LAS int* lidx = (LAS int*)(F.lds + 4096);
    unsigned key[8];
#pragma unroll
    for (int i = 0; i < 8; ++i) key[i] = __float_as_uint(AFF[(size_t)(tid * 8 + i) * 16]);
    unsigned prefix = 0, krem = CAP;
#pragma unroll 1
    for (int pass = 0; pass < 4; ++pass) {
        const int shift = 24 - 8 * pass;
        if (tid < 256) hist[tid] = 0;
        __syncthreads();
#pragma unroll
        for (int i = 0; i < 8; ++i) { const bool in = pass == 0 ? true : ((key[i] >> (shift + 8)) == (prefix >> (shift + 8))); if (in) atomicAdd((unsigned*)&hist[(key[i] >> shift) & 255u], 1u); }
        __syncthreads();
        if (tid < 256) sfx[tid] = hist[tid];
        __syncthreads();
#pragma unroll 1
        for (int o = 1; o < 256; o <<= 1) { unsigned v = 0; if (tid < 256) v = sfx[tid] + (tid + o < 256 ? sfx[tid + o] : 0u); __syncthreads(); if (tid < 256) sfx[tid] = v; __syncthreads(); }
        if (tid < 256) { const unsigned incl = sfx[tid], excl = incl - hist[tid]; if (excl < krem && krem <= incl) { misc[0] = (unsigned)tid; misc[1] = krem - excl; } }
        __syncthreads();
        prefix |= misc[0] << shift; krem = misc[1];
        __syncthreads();
    }
    const unsigned T = prefix, need = krem;
    unsigned cg_ = 0, ce = 0;
#pragma unroll
    for (int i = 0; i < 8; ++i) { cg_ += key[i] > T; ce += key[i] == T; }
    unsigned sg = cg_, se = ce;
#pragma unroll
    for (int o = 1; o < 64; o <<= 1) { const unsigned tg = __shfl_up(sg, o), te = __shfl_up(se, o); if (lane >= o) { sg += tg; se += te; } }
    if (lane == 63) { misc[16 + F.wave] = sg; misc[32 + F.wave] = se; }
    __syncthreads();
    unsigned og = sg - cg_, oe = se - ce;
    for (int w = 0; w < F.wave; ++w) { og += misc[16 + w]; oe += misc[32 + w]; }
    int* SLOT = (int*)(a.ws + WS_SLOT) + (size_t)b * SEQ * 16 + e;
    float* VALS = (float*)(a.ws + WS_VALS) + (size_t)(e * 8 + b) * CAP;
    int* IDX = (int*)(a.ws + WS_IDX) + (size_t)(b * 16 + e) * CAP;
#pragma unroll
    for (int i = 0; i < 8; ++i) {
        const bool gt = key[i] > T, eq = key[i] == T; const bool sel = gt || (eq && oe < need);
        const unsigned pos = og + (oe < need ? oe : need);
        const int s = tid * 8 + i;
        SLOT[(size_t)s * 16] = sel ? (int)pos : -1;
        if (sel) { lidx[pos] = s; IDX[pos] = s; VALS[pos] = __uint_as_float(key[i]); }
        og += gt; oe += eq;
    }
    __syncthreads();
    const unsigned char* H2 = a.ws + WS_H2 + (size_t)b * SEQ * DM; unsigned char* XE = a.ws + WS_XE + (size_t)(e * 8 + b) * CAP * DM;
    for (int r0 = F.wave * 4; r0 < CAP; r0 += NWAVES * 4) { u32x4 v[4];
#pragma unroll
        for (int j = 0; j < 4; ++j) v[j] = ((const u32x4*)(H2 + (size_t)lidx[r0 + j] * DM))[lane];
#pragma unroll
        for (int j = 0; j < 4; ++j) ((u32x4*)(XE + (size_t)(r0 + j) * DM))[lane] = v[j]; }
    __syncthreads();
}

DI void final_phase(const Ctx& F, const Args& a) {
    const int gw = F.bid * NWAVES + F.wave, NGW = F.G * NWAVES, lane = F.lane;
    const float* mod = (const float*)(a.ws + WS_MOD); const int* SLOT = (const int*)(a.ws + WS_SLOT); const unsigned char* Y = a.ws + WS_Y;
    for (int m = gw; m < MTOK; m += NGW) {
        const int b = m / SEQ;
        const int sl = SLOT[(size_t)m * 16 + (lane & 15)];
        f32x4* op = (f32x4*)(a.out + (size_t)m * DM + lane * 16);
        f32x4 xv[4];
        { const u32x4* xp = (const u32x4*)((const bf16_t*)(a.ws + WS_X1B) + (size_t)m * DM + lane * 16); const u32x4 w0 = xp[0], w1 = xp[1];
          xv[0].x = bflo(w0.x); xv[0].y = bfhi(w0.x); xv[0].z = bflo(w0.y); xv[0].w = bfhi(w0.y); xv[1].x = bflo(w0.z); xv[1].y = bfhi(w0.z); xv[1].z = bflo(w0.w); xv[1].w = bfhi(w0.w);
          xv[2].x = bflo(w1.x); xv[2].y = bfhi(w1.x); xv[2].z = bflo(w1.y); xv[2].w = bfhi(w1.y); xv[3].x = bflo(w1.z); xv[3].y = bfhi(w1.z); xv[3].z = bflo(w1.w); xv[3].w = bfhi(w1.w); }
        float acc[16];
#pragma unroll
        for (int i = 0; i < 16; ++i) acc[i] = 0.f;
#pragma unroll 1
        for (int e = 0; e < 16; ++e) { const int s = __shfl(sl, e);
            if (s >= 0) { const u32x4 w = *(const u32x4*)(Y + ((size_t)(e * 8 + b) * CAP + s) * DM + lane * 16);
#pragma unroll
                for (int q = 0; q < 4; ++q) { const unsigned ww = w[q];
                    const auto lo = __builtin_amdgcn_cvt_pk_f32_fp8((int)ww, false), hi = __builtin_amdgcn_cvt_pk_f32_fp8((int)ww, true);
                    acc[4 * q] += lo[0]; acc[4 * q + 1] += lo[1]; acc[4 * q + 2] += hi[0]; acc[4 * q + 3] += hi[1]; } } }
        const f32x4* gp = (const f32x4*)(mod + (size_t)b * 6144 + 5120 + lane * 16);
#pragma unroll
        for (int q = 0; q < 4; ++q) { const f32x4 g = gp[q] * (1.f / pg8::Y_PRESCALE); f32x4 o = xv[q]; o.x += g.x * acc[4 * q]; o.y += g.y * acc[4 * q + 1]; o.z += g.z * acc[4 * q + 2]; o.w += g.w * acc[4 * q + 3]; op[q] = o; }
    }
}

#define XB_TMO      128
#define XB_XCNT(j)  (256  + 64 * (j))
#define XB_XSUB(j)  (1280 + 64 * (j))
#define XB_XGEN(j)  (2304 + 64 * (j))
#define XB_TOP      3328
#define XB_TOPGEN   3392
#define XB_SPIN_CAP (1u << 18)
DI unsigned xb_ld(unsigned* p)              { return __hip_atomic_load(p, __ATOMIC_RELAXED, __HIP_MEMORY_SCOPE_AGENT); }
DI unsigned xb_add(unsigned* p, unsigned v) { return __hip_atomic_fetch_add(p, v, __ATOMIC_RELAXED, __HIP_MEMORY_SCOPE_AGENT); }
DI unsigned xb_xcc_id() { return (unsigned)__builtin_amdgcn_s_getreg((3 << 11) | 20) & 0xFu; }
#define XB_SPIN(cond, bar) do { unsigned _sp = 0; while (cond) { __builtin_amdgcn_s_sleep(1); \
    if ((++_sp & 255u) == 0u) { if (xb_ld(&(bar)[XB_TMO])) break; if (_sp > XB_SPIN_CAP) { atomicAdd(&(bar)[XB_TMO], 1u); break; } } } } while (0)
struct XcdBarrier { unsigned* bar; unsigned x; volatile LAS unsigned* st; };
DI XcdBarrier xcd_barrier_post(unsigned* bar, volatile LAS unsigned* st) {
    XcdBarrier b; b.bar = bar; b.x = xb_xcc_id(); b.st = st;
    if (threadIdx.x == 0) (void)xb_add(&bar[XB_XCNT(b.x)], 1u);
    return b;
}
DI void xcd_barrier_complete(unsigned* bar, unsigned x, unsigned& nloc, unsigned& nx) {
    const unsigned G = gridDim.x * gridDim.y * gridDim.z;
    unsigned sum, cnt, mine, sp = 0u;
    for (;;) {
        sum = 0u; cnt = 0u; mine = 0u;
#pragma unroll
        for (unsigned j = 0; j < 16; ++j) { const unsigned c = xb_ld(&bar[XB_XCNT(j)]); sum += c; cnt += (c > 0u) ? 1u : 0u; mine = (j == x) ? c : mine; }
        if (sum == G) break;
        __builtin_amdgcn_s_sleep(1);
        if ((++sp & 255u) == 0u) { if (xb_ld(&bar[XB_TMO])) break; if (sp > XB_SPIN_CAP) { atomicAdd(&bar[XB_TMO], 1u); break; } }
    }
    nloc = mine > 0u ? mine : 1u; nx = cnt > 0u ? cnt : 1u;
}
DI void xcd_barrier(const XcdBarrier& b) {
    asm volatile("s_waitcnt vmcnt(0)" ::: "memory");
    __syncthreads();
    if (threadIdx.x == 0) {
        unsigned* bar = b.bar;
        __builtin_amdgcn_s_waitcnt(0);
        unsigned nloc = b.st[0], nx = b.st[1];
        if (nloc == 0u) { xcd_barrier_complete(bar, b.x, nloc, nx); b.st[0] = nloc; b.st[1] = nx; }
        const unsigned old = xb_add(&bar[XB_XSUB(b.x)], 1u);
        const unsigned gen = old / nloc;
        if (old + 1u == (gen + 1u) * nloc) {
            __builtin_amdgcn_fence(__ATOMIC_RELEASE, "agent");
            asm volatile("s_waitcnt vmcnt(0)" ::: "memory");
            const unsigned og = xb_add(&bar[XB_TOP], 1u);
            const unsigned tg = og / nx;
            if (og + 1u == (tg + 1u) * nx) xb_add(&bar[XB_TOPGEN], 1u);
            else XB_SPIN(xb_ld(&bar[XB_TOPGEN]) == tg, bar);
            __builtin_amdgcn_fence(__ATOMIC_ACQUIRE, "agent");
            xb_add(&bar[XB_XGEN(b.x)], 1u);
            asm volatile("s_waitcnt vmcnt(0)" ::: "memory");
        } else {
            XB_SPIN(xb_ld(&bar[XB_XGEN(b.x)]) == gen, bar);
            __builtin_amdgcn_fence(__ATOMIC_ACQUIRE, "agent");
            asm volatile("s_waitcnt vmcnt(0)" ::: "memory");
        }
    }
    __syncthreads();
}

static_assert(sizeof(Args) == 22 * 8, "Args layout");
__global__ void __launch_bounds__(NTHR, 2) fwd_kernel(Args a_unused) {
    extern __shared__ __attribute__((aligned(16))) unsigned char lds_raw[];
    cg::grid_group grid = cg::this_grid();
    Ctx F; F.lds = (LAS unsigned char*)lds_raw; F.tid = threadIdx.x; F.lane = F.tid & 63; F.wave = __builtin_amdgcn_readfirstlane(F.tid >> 6); F.G = gridDim.x; F.bid = blockIdx.x;

    int lo, hi; { typedef __attribute__((address_space(4))) const volatile unsigned long long* kp_t; const unsigned long long ph = ((kp_t)__builtin_amdgcn_kernarg_segment_ptr())[21]; lo = (int)(unsigned)ph; hi = (int)(unsigned)(ph >> 32); }
#ifndef PHASE_MASK
#define PHASE_MASK 0xffff
#endif
#define IN(k) (((PHASE_MASK >> (k)) & 1) && lo <= (k) && (k) < hi)
    volatile LAS unsigned* bst = (volatile LAS unsigned*)(F.lds + LDS_BYTES - 64);
    if (F.tid < 2) bst[F.tid] = 0u;
    __syncthreads();
    XcdBarrier xbar;
    { const Args a0 = load_args(); xbar = xcd_barrier_post((unsigned*)(a0.ws + WS_CTL), bst); }
    volatile LAS unsigned long long* tsl = (volatile LAS unsigned long long*)(F.lds + LDS_BYTES - 256);
    if (PROBE_PHASE >= 0 && F.bid == 0 && F.tid == 0) tsl[0] = __builtin_amdgcn_s_memrealtime();
#define SEAM(k) do { if (IN(k) && IN((k) + 1)) { xcd_barrier(xbar); } \
        if (PROBE_PHASE >= 0 && F.bid == 0 && F.tid == 0) tsl[(k) + 1] = __builtin_amdgcn_s_memrealtime(); } while (0)
    grid.sync();
    if (IN(0)) { const Args a = load_args(); p0_phase(F, a); p1_phase(F, a); }
    if (PROBE_PHASE >= 0 && F.bid == 0 && F.tid == 0) tsl[1] = __builtin_amdgcn_s_memrealtime();
    SEAM(1);
    if (IN(2)) {
        const Args a = load_args();
        pg8::Gemm g{(const bf16_t*)a.out, (const bf16_t*)(a.ws + WS_WINT), MTOK, PS, DM, 1 << 30}; pg8::StaticOrder S; S.init(MTOK, PS, F.G, F.bid);
        pg8::EpiProj E{(bf16_t*)(a.ws + WS_PROJ), a.pos, a.qk_g, (bf16_t*)(a.ws + WS_KIMG), (bf16_t*)(a.ws + WS_VIMG)};
        pg8::gemm_phase<pg8::EpiProj, true, true>(F.lds, g, S, E);
        gates_tasks(F, a);
    }
    SEAM(2);
    if (IN(3)) {
        const Args a = load_args();
        for (int t = F.bid * NWAVES + F.wave; t < MTOK / 8 * 2; t += F.G * NWAVES) conv_task(F, a, t);
        for (int t = F.bid; t < 64; t += F.G) mscal_task(F, a, t);
    }
    SEAM(3);
    if (IN(4)) {
        const Args a = load_args();
        {
#pragma unroll 1
            for (int rep = 0; rep < REP_MSEQ; ++rep)
#pragma unroll 1
            for (int it = F.bid; it < 256; it += F.G) { const int xcd_ = it & 7, j_ = it >> 3; mseq_item(F, a, it, xcd_ * 4 + (j_ >> 3), (j_ >> 2) & 1, j_ & 3); }
        }
        float lam, cshift;
        { const float p01 = wave_sum(a.lam_p[F.lane] * a.lam_p[64 + F.lane]), p23 = wave_sum(a.lam_p[128 + F.lane] * a.lam_p[192 + F.lane]);
          lam = __expf(p01) - __expf(p23) + 0.2f;
          const float gq = wave_max(fabsf(a.qk_g[F.lane])), gk = wave_max(fabsf(a.qk_g[64 + F.lane]));
          cshift = 8.f * gq * gk * 1.4426950408889634f * 1.02f; }
        const int xcd = F.bid & 7, j = F.bid >> 3;
#pragma unroll 1
        for (int rep = 0; rep < REP_ATT; ++rep)
        for (int i = 0; i * F.G < 1024; ++i) {
            int u;
            if (F.G == 256) u = (xcd * 4 + i) * 32 + j; else u = i * F.G + F.bid;
            if (u < 1024) attn_unit(F, a, u >> 7, (u >> 5) & 3, u & 31, lam, cshift);
        }
    }
    SEAM(4);
    if (IN(5)) { const Args a = load_args(); mcombine_phase(F, a); }
    SEAM(5);
    if (IN(6)) {
        const Args a = load_args();
        pg8::Gemm g{(const bf16_t*)(a.ws + WS_YMIX), (const bf16_t*)(a.ws + WS_WOUTT), MTOK, DM, DM, 1 << 30}; pg8::StaticOrder S; S.init(MTOK, DM, F.G, F.bid);
        pg8::EpiX1 E{a.x, (const float*)(a.ws + WS_MOD), (bf16_t*)(a.ws + WS_X1B)};
        pg8::gemm_phase<pg8::EpiX1, true, true>(F.lds, g, S, E);
    }
    SEAM(6);
    if (IN(7)) { const Args a = load_args();
#pragma unroll 1
        for (int rep = 0; rep < REP_P7; ++rep) p7_phase(F, a); }
    SEAM(7);
    if (IN(8)) { const Args a = load_args(); for (int t = F.bid; t < BATCH * NEXP; t += F.G) topk_task(F, a, t); }
    SEAM(8);
    if (IN(9)) {
        const Args a = load_args();
        pg8::Gemm g{(const bf16_t*)(a.ws + WS_XE), (const bf16_t*)(a.ws + WS_WGUT), NPAIR, 4096, DM, 16};
        pg8::StaticOrder S; S.init(NPAIR, 4096, F.G, F.bid);
        pg8::EpiGU E{a.ws + WS_HH};
#pragma unroll 1
        for (int rep = 0; rep < REP_UP; ++rep)
        pg8::gemm_phase<pg8::EpiGU, true, true, true>(F.lds, g, S, E);
    }
    SEAM(9);
    if (IN(10)) {
        const Args a = load_args();
        pg8::Gemm g{(const bf16_t*)(a.ws + WS_HH), (const bf16_t*)(a.ws + WS_WDT), NPAIR, DM, DFF, 16};
        pg8::StaticOrder S; S.init(NPAIR, DM, F.G, F.bid);
        pg8::EpiDown E{a.ws + WS_Y, (const float*)(a.ws + WS_VALS)};
        pg8::gemm_phase<pg8::EpiDown, true, true, true>(F.lds, g, S, E);
    }
    SEAM(10);
    if (IN(11)) { const Args a = load_args(); final_phase(F, a); }
    if (PROBE_MSEQ_W >= 0 && F.bid == 0 && F.tid == 0) {
        const unsigned long long d = *(volatile LAS unsigned long long*)(F.lds + LDS_BYTES - 128), t1 = __builtin_amdgcn_s_memtime();
        while (__builtin_amdgcn_s_memtime() - t1 < 3ull * d) __builtin_amdgcn_s_sleep(8);
    }
    if (PROBE_PHASE >= 0 && F.bid == 0 && F.tid == 0) {
        const unsigned long long t1 = __builtin_amdgcn_s_memrealtime();
        const unsigned long long d = (PROBE_PHASE == 11 ? t1 : tsl[PROBE_PHASE + 1]) - tsl[PROBE_PHASE];
        while (__builtin_amdgcn_s_memrealtime() - t1 < 3ull * d) __builtin_amdgcn_s_sleep(8);
    }
#undef IN
#undef SEAM
}

extern "C" void kernel_launch(void* const* d_in, const int* in_sizes, int n_in, void* d_out, int out_size, void* d_ws, size_t ws_size, hipStream_t stream) {
    static int grid_blocks = 0;
    if (!grid_blocks) {
        int dev = 0, cus = 0, per_cu = 0;
        (void)hipGetDevice(&dev);
        (void)hipDeviceGetAttribute(&cus, hipDeviceAttributeMultiprocessorCount, dev);
        (void)hipFuncSetAttribute((const void*)fwd_kernel, hipFuncAttributeMaxDynamicSharedMemorySize, LDS_BYTES);
        (void)hipOccupancyMaxActiveBlocksPerMultiprocessor(&per_cu, (const void*)fwd_kernel, NTHR, LDS_BYTES);
        if (per_cu < 1) per_cu = 1;
        grid_blocks = cus;
        if (ws_size < WS_END) fprintf(stderr, "kernel_launch: workspace too small: %zu < %zu\n", ws_size, (size_t)WS_END);
    }
    (void)hipMemsetAsync((char*)d_ws + WS_CTL, 0, CTL_ZERO_BYTES, stream);
    Args a{};
    a.x = (const float*)d_in[0]; a.c = (const float*)d_in[1]; a.pos = (const int*)d_in[2]; a.norm1_g = (const float*)d_in[3]; a.norm2_g = (const float*)d_in[4];
    a.w_ada = (const float*)d_in[5]; a.b_ada = (const float*)d_in[6]; a.w_in = (const float*)d_in[7]; a.conv_w = (const float*)d_in[8]; a.gate_b = (const float*)d_in[9];
    a.mnorm_g = (const float*)d_in[10]; a.qk_g = (const float*)d_in[11]; a.lam_p = (const float*)d_in[12]; a.subln_g = (const float*)d_in[13]; a.w_out = (const float*)d_in[14];
    a.w_router = (const float*)d_in[15]; a.w_gate = (const float*)d_in[16]; a.w_up = (const float*)d_in[17]; a.w_down = (const float*)d_in[18];
    a.out = (float*)d_out; a.ws = (unsigned char*)d_ws; a.ph_lo = 0; a.ph_hi = 12;
    void* args[] = {&a};
    hipError_t e = hipLaunchCooperativeKernel((const void*)fwd_kernel, dim3(grid_blocks), dim3(NTHR), args, LDS_BYTES, stream);
    if (e != hipSuccess) fprintf(stderr, "cooperative launch failed: %s (grid %d)\n", hipGetErrorString(e), grid_blocks);
}
```

```cpp
#include <hip/hip_runtime.h>
#include <hip/hip_cooperative_groups.h>
#include <cstdio>
#include <cstdint>
namespace cg = cooperative_groups;

#define LAS __attribute__((address_space(3)))
#define DI __device__ __forceinline__
typedef unsigned short bf16_t;
typedef short bf16x8 __attribute__((ext_vector_type(8)));
typedef short s16x4 __attribute__((ext_vector_type(4)));
typedef float f32x2 __attribute__((ext_vector_type(2)));
typedef float f32x4 __attribute__((ext_vector_type(4)));
typedef float f32x16 __attribute__((ext_vector_type(16)));
typedef unsigned u32x2 __attribute__((ext_vector_type(2)));
typedef unsigned u32x4 __attribute__((ext_vector_type(4)));
typedef __bf16 bf16x2_t __attribute__((ext_vector_type(2)));

constexpr int BATCH = 8, SEQ = 4096, DM = 1024, MTOK = BATCH * SEQ;
constexpr int DIN = 3600, PS = 3584;
constexpr int NEXP = 16, CAP = 512, DFF = 2048;
constexpr int NPAIR = BATCH * NEXP * CAP;
constexpr float EPS = 1e-6f;
constexpr int C_QM = 0, C_KM = 512, C_VM = 1024, C_OM = 1536, C_QA = 2048, C_KA = 2560, C_VA = 3072;

constexpr size_t MiB = 1u << 20;
constexpr size_t WS_CTL = 0;
constexpr int CTL_ZERO_BYTES = 65536;
constexpr size_t WS_MOD = 1 * MiB;
constexpr size_t WS_GATES = 2 * MiB;
constexpr size_t WS_AFF = 4 * MiB;
constexpr size_t WS_IDX = 6 * MiB;
constexpr size_t WS_VALS = 6 * MiB + 256 * 1024;
constexpr size_t WS_MSC = 6 * MiB + 512 * 1024;
constexpr size_t WS_SLOT = 7 * MiB;
constexpr size_t WS_NLOC = 9 * MiB;
constexpr size_t WS_WINT = 11 * MiB;
constexpr size_t WS_WGT = 18 * MiB;
constexpr size_t WS_WOUTT = 19 * MiB;
constexpr size_t WS_WGUT = 21 * MiB;
constexpr size_t WS_WDT = 85 * MiB;
constexpr size_t WS_Y = 117 * MiB;
constexpr size_t WS_PROJ = 213 * MiB;
constexpr size_t WS_YMIX = 117 * MiB;
constexpr size_t WS_KIMG = 437 * MiB;
constexpr size_t WS_VIMG = 469 * MiB;
constexpr size_t WS_HH = 245 * MiB;
constexpr size_t WS_H2 = 437 * MiB;
constexpr size_t WS_XE = 469 * MiB;
constexpr size_t WS_X1B = 373 * MiB;
constexpr size_t WS_END = 533 * MiB;

constexpr int LDS_BYTES = 163840;
constexpr int PROBE_MSEQ_W = -1;
constexpr int PROBE_PHASE = -1;
constexpr int REP_M1 = 1, REP_M3 = 1, REP_UP = 1, REP_P0 = 1, REP_SCAN = 1, REP_P7 = 1, REP_ATT = 1, REP_QKT = 1, REP_MSEQ = 1;
constexpr int NWAVES = 8, NTHR = 512;

DI unsigned pk2(float lo, float hi) { f32x2 v = {lo, hi}; bf16x2_t b = __builtin_convertvector(v, bf16x2_t); return __builtin_bit_cast(unsigned, b); }
DI float bflo(unsigned w) { return __uint_as_float(w << 16); }
DI float bfhi(unsigned w) { return __uint_as_float(w & 0xffff0000u); }
DI float bf2f(bf16_t v) { return __uint_as_float((unsigned)v << 16); }
template <int CTRL> DI float dpp_mov(float x) { return __builtin_bit_cast(float, __builtin_amdgcn_update_dpp(0, __builtin_bit_cast(int, x), CTRL, 0xf, 0xf, false)); }
#define DPP_XOR1 0xB1
#define DPP_XOR2 0x4E
#define DPP_ROR(n) (0x120 + (n))
DI float xor16_sum(float x) { const unsigned u = __builtin_bit_cast(unsigned, x); auto r = __builtin_amdgcn_permlane16_swap(u, u, false, false); return __builtin_bit_cast(float, (unsigned)r[0]) + __builtin_bit_cast(float, (unsigned)r[1]); }
DI float xor32_sum(float x) { const unsigned u = __builtin_bit_cast(unsigned, x); auto r = __builtin_amdgcn_permlane32_swap(u, u, false, false); return __builtin_bit_cast(float, (unsigned)r[0]) + __builtin_bit_cast(float, (unsigned)r[1]); }
DI float xor16_max(float x) { const unsigned u = __builtin_bit_cast(unsigned, x); auto r = __builtin_amdgcn_permlane16_swap(u, u, false, false); return fmaxf(__builtin_bit_cast(float, (unsigned)r[0]), __builtin_bit_cast(float, (unsigned)r[1])); }
DI float xor32_max(float x) { const unsigned u = __builtin_bit_cast(unsigned, x); auto r = __builtin_amdgcn_permlane32_swap(u, u, false, false); return fmaxf(__builtin_bit_cast(float, (unsigned)r[0]), __builtin_bit_cast(float, (unsigned)r[1])); }
template <int CTRL, int RM, int BM_> DI float dpp_mov_m(float oldv, float x) { return __builtin_bit_cast(float, __builtin_amdgcn_update_dpp(__builtin_bit_cast(int, oldv), __builtin_bit_cast(int, x), CTRL, RM, BM_, false)); }
DI float wave_prefix_sum(float v) {
    v += dpp_mov_m<0x111, 0xf, 0xf>(0.f, v); v += dpp_mov_m<0x112, 0xf, 0xf>(0.f, v); v += dpp_mov_m<0x114, 0xf, 0xe>(0.f, v); v += dpp_mov_m<0x118, 0xf, 0xc>(0.f, v);
    v += dpp_mov_m<0x142, 0xa, 0xf>(0.f, v); v += dpp_mov_m<0x143, 0xc, 0xf>(0.f, v);
    return v;
}
DI float wave_prefix_max(float v) {
    const float ninf = -__builtin_inff();
    v = fmaxf(v, dpp_mov_m<0x111, 0xf, 0xf>(ninf, v)); v = fmaxf(v, dpp_mov_m<0x112, 0xf, 0xf>(ninf, v)); v = fmaxf(v, dpp_mov_m<0x114, 0xf, 0xe>(ninf, v)); v = fmaxf(v, dpp_mov_m<0x118, 0xf, 0xc>(ninf, v));
    v = fmaxf(v, dpp_mov_m<0x142, 0xa, 0xf>(ninf, v)); v = fmaxf(v, dpp_mov_m<0x143, 0xc, 0xf>(ninf, v));
    return v;
}
DI float partner32(float x, int lane) { const unsigned u = __builtin_bit_cast(unsigned, x); auto r = __builtin_amdgcn_permlane32_swap(u, u, false, false); return __builtin_bit_cast(float, (unsigned)((lane & 32) ? r[0] : r[1])); }
DI float partner16(float x, int lane) { const unsigned u = __builtin_bit_cast(unsigned, x); auto r = __builtin_amdgcn_permlane16_swap(u, u, false, false); return __builtin_bit_cast(float, (unsigned)((lane & 16) ? r[0] : r[1])); }
DI float partner8(float x) { return dpp_mov<DPP_ROR(8)>(x); }
DI float partner4(float x, int lane) { const float a = dpp_mov<DPP_ROR(4)>(x), b = dpp_mov<DPP_ROR(12)>(x); return (lane & 4) ? a : b; }
DI float row_sum16(float v) { v += dpp_mov<DPP_XOR1>(v); v += dpp_mov<DPP_XOR2>(v); v += dpp_mov<DPP_ROR(4)>(v); v += dpp_mov<DPP_ROR(8)>(v); return v; }
DI float wave_sum(float v) { v = row_sum16(v); v = xor16_sum(v); return xor32_sum(v); }
DI float wave_max(float v) { v = fmaxf(v, dpp_mov<DPP_XOR1>(v)); v = fmaxf(v, dpp_mov<DPP_XOR2>(v)); v = fmaxf(v, dpp_mov<DPP_ROR(4)>(v)); v = fmaxf(v, dpp_mov<DPP_ROR(8)>(v)); v = xor16_max(v); return xor32_max(v); }
DI float sigmoid_f(float v) { return __builtin_amdgcn_rcpf(1.f + __builtin_amdgcn_exp2f(-1.4426950408889634f * v)); }
DI float silu_f(float v) { return v * sigmoid_f(v); }
DI float logsigmoid_f(float f) { return fminf(f, 0.f) - log1pf(__expf(-fabsf(f))); }
DI int swz16(int row) { return ((row & 3) << 2) | ((row >> 2) & 3); }
#define MFMA32(a, b, c) __builtin_amdgcn_mfma_f32_32x32x16_bf16((a), (b), (c), 0, 0, 0)
DI s16x4 trread(const LAS unsigned char* p) { return __builtin_bit_cast(s16x4, __builtin_amdgcn_ds_read_tr16_b64_v4i16((LAS s16x4*)p)); }
DI int crow(int r, int hh) { return (r & 3) + 8 * (r >> 2) + 4 * hh; }
DI bool hh_sel(int lane, int bit) { return (lane & bit) != 0; }

namespace pg8 {
constexpr int BM = 256, BK = 64, HALF = 128, HTB = HALF * BK * 2, STAGE_BYTES = 8 * HTB, NXCD = 8, WGM = 8;
DI int lds_byte(int r, int c) { const int st = (r >> 4) * 2 + (c >> 5), rr = r & 15, cc = c & 31, ob = rr * 64 + cc * 2; return st * 1024 + (ob ^ (((ob >> 9) & 1) << 5)); }
DI void stage_rc(int b, int& R, int& C) { const int st = b / 1024, sb = b % 1024, swz = sb ^ (((sb >> 9) & 1) << 5); R = (st >> 1) * 16 + swz / 64; C = (st & 1) * 32 + (swz % 64) / 2; }
DI int perm32(int rho) { const int n = rho >> 4, i = rho & 15; return 8 * (i >> 2) + 4 * n + (i & 3); }
struct Unit { int pm, pn; };
typedef int i32x4_t __attribute__((ext_vector_type(4)));
typedef int i32x8_t __attribute__((ext_vector_type(8)));
DI i32x8_t cat8(bf16x8 lo, bf16x8 hi) { const i32x4_t a = __builtin_bit_cast(i32x4_t, lo), b = __builtin_bit_cast(i32x4_t, hi); return __builtin_shufflevector(a, b, 0, 1, 2, 3, 4, 5, 6, 7); }
struct Gemm { const bf16_t* A; const bf16_t* Bt; int M, N, K, tpg; };
struct StaticOrder {
    int nM, nN, nwg, G, c;
    DI void init(int M, int N, int G_, int c_) { nM = M / BM; nN = N / BM; nwg = nM * nN; G = G_; c = c_; }
    DI bool next(int i, Unit& u) const {
        const long L = (long)i * G + c; if (L >= nwg) return false;
        int wgid = (int)L; { const int q = nwg / NXCD, r = nwg % NXCD, xcd = wgid % NXCD, off = wgid / NXCD; wgid = (xcd < r ? xcd * (q + 1) : r * (q + 1) + (xcd - r) * q) + off; }
        const int nig = WGM * nN, gid = wgid / nig, fm = gid * WGM, gsz = (nM - fm) < WGM ? (nM - fm) : WGM;
        u.pm = fm + ((wgid % nig) % gsz); u.pn = (wgid % nig) / gsz; return true;
    }
};

template <class Epi, bool ALIGN_EPI, bool SP2, bool FP8 = false>
DI void gemm_phase(LAS unsigned char* lds, const Gemm g, const StaticOrder& S, const Epi& E) {
    const int tid = threadIdx.x, wid = __builtin_amdgcn_readfirstlane(tid >> 6), lane = tid & 63, wr = wid >> 2, wc = wid & 3, fr = lane & 15, fq = lane >> 4;
    const int KB = FP8 ? g.K : 2 * g.K, nt = KB / (BK * 2);
    unsigned voffA[2], voffB[2];
#pragma unroll
    for (int i = 0; i < 2; ++i) { int R, C; stage_rc(tid * 16 + i * 8192, R, C); const int Rb = Epi::PERM ? ((R & ~31) + perm32(R & 31)) : R;
        voffA[i] = (unsigned)(R * KB + C * 2); voffB[i] = (unsigned)(Rb * KB + C * 2); }
    const size_t kstep = (size_t)(BK * 2);
    const size_t hstep = (size_t)HALF * KB;
    const size_t tstep = 2 * hstep;
    const size_t gstep = (size_t)g.N * KB;
    const unsigned ldsw = (unsigned)wid * 1024u;
    const int aoff = lds_byte(wr * 64 + fr, fq * 8), boff = lds_byte(wc * 32 + fr, fq * 8);
#define PG8_SA(b, h) (((b) * 2 + (h)) * HTB)
#define PG8_SB(b, h) ((4 + (b) * 2 + (h)) * HTB)
#define PG8_STAGE(bufoff, gbase, voff) do { _Pragma("unroll") for (int _i = 0; _i < 2; ++_i) \
        __builtin_amdgcn_global_load_lds((const unsigned*)((const char*)(gbase) + (voff)[_i]), (LAS unsigned*)(lds + (bufoff) + ldsw + _i * 8192), 16, 0, 0); } while (0)
#define PG8_LDA(dst, b, h) do { if constexpr (FP8) { _Pragma("unroll") for (int m = 0; m < 4; ++m) dst##8[m] = cat8(*(const LAS bf16x8*)(lds + PG8_SA(b, h) + aoff + m * 2048), *(const LAS bf16x8*)(lds + PG8_SA(b, h) + aoff + m * 2048 + 1024)); } \
        else { _Pragma("unroll") for (int m = 0; m < 4; ++m) _Pragma("unroll") for (int k = 0; k < 2; ++k) dst[m][k] = *(const LAS bf16x8*)(lds + PG8_SA(b, h) + aoff + m * 2048 + k * 1024); } } while (0)
#define PG8_LDB(dst, b, h) do { if constexpr (FP8) { _Pragma("unroll") for (int n = 0; n < 2; ++n) dst##8[n] = cat8(*(const LAS bf16x8*)(lds + PG8_SB(b, h) + boff + n * 2048), *(const LAS bf16x8*)(lds + PG8_SB(b, h) + boff + n * 2048 + 1024)); } \
        else { _Pragma("unroll") for (int n = 0; n < 2; ++n) _Pragma("unroll") for (int k = 0; k < 2; ++k) dst[n][k] = *(const LAS bf16x8*)(lds + PG8_SB(b, h) + boff + n * 2048 + k * 1024); } } while (0)
#define PG8_MMA(ai, bj, At, Bt) do { __builtin_amdgcn_s_setprio(1); \
        if constexpr (FP8) { _Pragma("unroll") for (int m = 0; m < 4; ++m) _Pragma("unroll") for (int n = 0; n < 2; ++n) \
            asm volatile("s_nop 1\n\tv_mfma_f32_16x16x128_f8f6f4 %0, %1, %2, %0" : "+v"(acc[ai][bj][m][n]) : "v"(Bt##8[n]), "v"(At##8[m])); } \
        else { _Pragma("unroll") for (int m = 0; m < 4; ++m) _Pragma("unroll") for (int n = 0; n < 2; ++n) _Pragma("unroll") for (int k = 0; k < 2; ++k) \
            acc[ai][bj][m][n] = __builtin_amdgcn_mfma_f32_16x16x32_bf16(Bt[n][k], At[m][k], acc[ai][bj][m][n], 0, 0, 0); } \
        __builtin_amdgcn_s_setprio(0); } while (0)
#define PG8_WAIT_V(n) asm volatile("s_waitcnt vmcnt(" #n ")" ::: "memory")
#define PG8_WAIT_L(n) asm volatile("s_waitcnt lgkmcnt(" #n ")" ::: "memory")
#define PG8_BAR __builtin_amdgcn_s_barrier()
#define PG8_SCHED __builtin_amdgcn_sched_barrier(0)
    Unit cur, nxt; int ui = 0;
    if (!S.next(0, cur)) return;
    f32x4 acc[2][2][4][2];
#pragma unroll
    for (int a = 0; a < 2; ++a)
#pragma unroll
        for (int b = 0; b < 2; ++b)
#pragma unroll
            for (int m = 0; m < 4; ++m)
#pragma unroll
                for (int n = 0; n < 2; ++n) acc[a][b][m][n] = (f32x4){0.f, 0.f, 0.f, 0.f};
    bf16x8 At[4][2], B0[2][2], B1[2][2]; i32x8_t At8[4], B08[2], B18[2];
    const char* cA = (const char*)g.A + (size_t)cur.pm * tstep; const char* cB = (const char*)g.Bt + (size_t)(cur.pm / g.tpg) * gstep + (size_t)cur.pn * tstep;
    if constexpr (SP2) {
        PG8_STAGE(PG8_SB(0, 0), cB, voffB); PG8_STAGE(PG8_SB(0, 1), cB + hstep, voffB); PG8_STAGE(PG8_SA(0, 0), cA, voffA); PG8_STAGE(PG8_SA(0, 1), cA + hstep, voffA);
        if (wr == 1) PG8_BAR;
        PG8_WAIT_V(2); PG8_BAR;
        PG8_STAGE(PG8_SB(1, 0), cB + kstep, voffB); PG8_STAGE(PG8_SA(1, 0), cA + kstep, voffA); PG8_STAGE(PG8_SB(1, 1), cB + hstep + kstep, voffB);
        PG8_WAIT_V(6); PG8_BAR;
    } else {
        PG8_STAGE(PG8_SB(0, 0), cB, voffB); PG8_STAGE(PG8_SA(0, 0), cA, voffA); PG8_STAGE(PG8_SB(0, 1), cB + hstep, voffB); PG8_STAGE(PG8_SA(0, 1), cA + hstep, voffA);
        if (wr == 1) PG8_BAR;
        PG8_WAIT_V(4); PG8_BAR;
        PG8_STAGE(PG8_SB(1, 0), cB + kstep, voffB); PG8_STAGE(PG8_SA(1, 0), cA + kstep, voffA); PG8_STAGE(PG8_SB(1, 1), cB + hstep + kstep, voffB);
        PG8_WAIT_V(6); PG8_BAR;
    }
    for (;;) {
        const bool has_next = S.next(ui + 1, nxt);
        const char* nA = has_next ? (const char*)g.A + (size_t)nxt.pm * tstep : cA;
        const char* nB = has_next ? (const char*)g.Bt + (size_t)(nxt.pm / g.tpg) * gstep + (size_t)nxt.pn * tstep : cB;
        for (int t = 0; t < nt; t += 2) {
            const bool last = (t == nt - 2);
            const char* a1 = cA + (size_t)(t + 1) * kstep;
            const char* a2 = last ? nA : cA + (size_t)(t + 2) * kstep; const char* b2 = last ? nB : cB + (size_t)(t + 2) * kstep;
            const char* a3 = a2 + kstep; const char* b3 = b2 + kstep;
            if constexpr (SP2) {
            PG8_LDB(B0, 0, 0); PG8_LDB(B1, 0, 1); PG8_SCHED; PG8_LDA(At, 0, 0); PG8_STAGE(PG8_SA(1, 1), a1 + hstep, voffA);
            PG8_WAIT_V(8); PG8_WAIT_L(0); PG8_BAR; PG8_MMA(0, 0, At, B0); PG8_MMA(0, 1, At, B1); PG8_BAR; PG8_SCHED;
            PG8_LDA(At, 0, 1); PG8_STAGE(PG8_SB(0, 0), b2, voffB); PG8_STAGE(PG8_SB(0, 1), b2 + hstep, voffB); PG8_STAGE(PG8_SA(0, 0), a2, voffA);
            PG8_WAIT_V(8); PG8_WAIT_L(0); PG8_BAR; PG8_MMA(1, 0, At, B0); PG8_MMA(1, 1, At, B1); PG8_BAR; PG8_SCHED;
            PG8_LDB(B0, 1, 0); PG8_LDB(B1, 1, 1); PG8_SCHED; PG8_LDA(At, 1, 0); PG8_STAGE(PG8_SA(0, 1), a2 + hstep, voffA);
            PG8_WAIT_V(8); PG8_WAIT_L(0); PG8_BAR; PG8_MMA(0, 0, At, B0); PG8_MMA(0, 1, At, B1); PG8_BAR; PG8_SCHED;
            PG8_LDA(At, 1, 1); PG8_STAGE(PG8_SB(1, 0), b3, voffB); PG8_STAGE(PG8_SB(1, 1), b3 + hstep, voffB); PG8_STAGE(PG8_SA(1, 0), a3, voffA);
            PG8_WAIT_V(8); PG8_WAIT_L(0); PG8_BAR; PG8_MMA(1, 0, At, B0); PG8_MMA(1, 1, At, B1); PG8_BAR; PG8_SCHED;
            } else {
            PG8_LDB(B0, 0, 0); PG8_SCHED; PG8_LDA(At, 0, 0); PG8_STAGE(PG8_SA(1, 1), a1 + hstep, voffA);
            PG8_WAIT_L(8); PG8_BAR; PG8_WAIT_L(0); PG8_MMA(0, 0, At, B0); PG8_BAR; PG8_SCHED;
            PG8_LDB(B1, 0, 1); PG8_STAGE(PG8_SB(0, 0), b2, voffB);
            PG8_BAR; PG8_WAIT_L(0); PG8_MMA(0, 1, At, B1); PG8_BAR;
            PG8_LDA(At, 0, 1); PG8_STAGE(PG8_SA(0, 0), a2, voffA);
            PG8_BAR; PG8_WAIT_L(0); PG8_MMA(1, 0, At, B0); PG8_BAR; PG8_SCHED;
            PG8_STAGE(PG8_SB(0, 1), b2 + hstep, voffB);
            PG8_WAIT_V(6); PG8_BAR; PG8_MMA(1, 1, At, B1); PG8_BAR;
            PG8_LDB(B0, 1, 0); PG8_SCHED; PG8_LDA(At, 1, 0); PG8_STAGE(PG8_SA(0, 1), a2 + hstep, voffA);
            PG8_WAIT_L(8); PG8_BAR; PG8_WAIT_L(0); PG8_MMA(0, 0, At, B0); PG8_BAR; PG8_SCHED;
            PG8_LDB(B1, 1, 1); PG8_STAGE(PG8_SB(1, 0), b3, voffB);
            PG8_BAR; PG8_WAIT_L(0); PG8_MMA(0, 1, At, B1); PG8_BAR;
            PG8_LDA(At, 1, 1); PG8_STAGE(PG8_SA(1, 0), a3, voffA);
            PG8_BAR; PG8_WAIT_L(0); PG8_MMA(1, 0, At, B0); PG8_BAR; PG8_SCHED;
            PG8_STAGE(PG8_SB(1, 1), b3 + hstep, voffB);
            PG8_WAIT_V(6); PG8_BAR; PG8_MMA(1, 1, At, B1); PG8_BAR;
            }
        }
        if constexpr (ALIGN_EPI) { if (wr == 0) PG8_BAR; }
        if constexpr (FP8) asm volatile("s_nop 15\n\ts_nop 7" ::: "memory");
        E(acc, cur, wr, wc, fr, fq);
        if (!has_next) break;
#pragma unroll
        for (int a = 0; a < 2; ++a)
#pragma unroll
            for (int b = 0; b < 2; ++b)
#pragma unroll
                for (int m = 0; m < 4; ++m)
#pragma unroll
                    for (int n = 0; n < 2; ++n) acc[a][b][m][n] = (f32x4){0.f, 0.f, 0.f, 0.f};
        cur = nxt; cA = nA; cB = nB; ++ui;
        if constexpr (ALIGN_EPI) { if (wr == 1) PG8_BAR; }
    }
    PG8_WAIT_V(0);
    if constexpr (!ALIGN_EPI) { if (wr == 0) PG8_BAR; }
    PG8_BAR;
#undef PG8_SA
#undef PG8_SB
#undef PG8_STAGE
#undef PG8_LDA
#undef PG8_LDB
#undef PG8_MMA
#undef PG8_WAIT_V
#undef PG8_WAIT_L
#undef PG8_BAR
#undef PG8_SCHED
}

struct EpiBf16 {
    static constexpr bool PERM = true;
    bf16_t* O; int ldc;
    DI void operator()(const f32x4 (&acc)[2][2][4][2], const Unit& u, int wr, int wc, int fr, int fq) const {
        const int row0 = u.pm * BM + wr * 64 + fr, col0 = u.pn * BM + wc * 32 + 8 * fq;
#pragma unroll
        for (int ai = 0; ai < 2; ++ai)
#pragma unroll
            for (int m = 0; m < 4; ++m) { bf16_t* rowp = O + (size_t)(row0 + ai * HALF + m * 16) * ldc + col0;
#pragma unroll
                for (int bj = 0; bj < 2; ++bj) { const f32x4 v0 = acc[ai][bj][m][0], v1 = acc[ai][bj][m][1];
                    u32x4 w; w.x = pk2(v0[0], v0[1]); w.y = pk2(v0[2], v0[3]); w.z = pk2(v1[0], v1[1]); w.w = pk2(v1[2], v1[3]);
                    *(u32x4*)(rowp + bj * HALF) = w; } }
    }
};
struct EpiProj {
    static constexpr bool PERM = true;
    bf16_t* O; const int* pos; const float* qk_g; bf16_t* kimg; bf16_t* vimg;
    DI void operator()(const f32x4 (&acc)[2][2][4][2], const Unit& u, int wr, int wc, int fr, int fq) const {
        const int row0 = u.pm * BM + wr * 64 + fr;
        if (u.pn < 8) {
            const int col0 = u.pn * BM + wc * 32 + 8 * fq;
#pragma unroll
            for (int ai = 0; ai < 2; ++ai)
#pragma unroll
                for (int m = 0; m < 4; ++m) { bf16_t* rowp = O + (size_t)(row0 + ai * HALF + m * 16) * PS + col0;
#pragma unroll
                    for (int bj = 0; bj < 2; ++bj) { const f32x4 v0 = acc[ai][bj][m][0], v1 = acc[ai][bj][m][1];
                        u32x4 w; w.x = pk2(v0[0], v0[1]); w.y = pk2(v0[2], v0[3]); w.z = pk2(v1[0], v1[1]); w.w = pk2(v1[2], v1[3]);
                        *(u32x4*)(rowp + bj * HALF) = w; } }
        } else if (u.pn < 12) {
            const int isk = (u.pn >= 10), hsub = 4 * (u.pn & 1) + wc, h = hsub >> 1, p = hsub & 1;
            const float* gp = qk_g + isk * 64 + 8 * fq;
            const f32x4 g00 = *(const f32x4*)gp, g01 = *(const f32x4*)(gp + 4), g10 = *(const f32x4*)(gp + 32), g11 = *(const f32x4*)(gp + 36);
            const float qs = isk ? 1.f : 0.125f * 1.4426950408889634f;
            const int lane = fr + 16 * fq;
#pragma unroll
            for (int ai = 0; ai < 2; ++ai)
#pragma unroll
                for (int m = 0; m < 4; ++m) { const int row = row0 + ai * HALF + m * 16;
                    f32x4 a0 = acc[ai][0][m][0], a1 = acc[ai][0][m][1], b0 = acc[ai][1][m][0], b1 = acc[ai][1][m][1];
                    float ss = (a0[0] * a0[0] + a0[1] * a0[1] + a0[2] * a0[2] + a0[3] * a0[3]) + (a1[0] * a1[0] + a1[1] * a1[1] + a1[2] * a1[2] + a1[3] * a1[3])
                             + (b0[0] * b0[0] + b0[1] * b0[1] + b0[2] * b0[2] + b0[3] * b0[3]) + (b1[0] * b1[0] + b1[1] * b1[1] + b1[2] * b1[2] + b1[3] * b1[3]);
                    ss = xor16_sum(ss); ss = xor32_sum(ss);
                    const float rstd = rsqrtf(ss * (1.f / 64.f) + EPS);
                    a0 = a0 * rstd * g00; a1 = a1 * rstd * g01; b0 = b0 * rstd * g10 * qs; b1 = b1 * rstd * g11 * qs;
                    const float pf = (float)pos[row];
                    f32x4 r0, r1;
#pragma unroll
                    for (int n = 0; n < 2; ++n)
#pragma unroll
                        for (int j = 0; j < 4; ++j) { const int i = 4 * n + j; const float own = n ? a1[j] : a0[j]; const float oth = partner16(own, lane);
                            const float frc = __builtin_amdgcn_fractf(pf * (exp2f(-(float)i * 0.125f * 18.931568569324174f) * 0.15915494309189535f));
                            const float sn = __builtin_amdgcn_sinf(frc), cs = __builtin_amdgcn_cosf(frc);
                            const float rot = (fq == 0) ? own * cs - oth * sn : own * cs + oth * sn;
                            const float o = (fq < 2) ? rot : own;
                            if (n) r1[j] = o; else r0[j] = o; }
                    r0 = r0 * qs; r1 = r1 * qs;
                    u32x4 w0, w1;
                    w0.x = pk2(r0[0], r0[1]); w0.y = pk2(r0[2], r0[3]); w0.z = pk2(r1[0], r1[1]); w0.w = pk2(r1[2], r1[3]);
                    w1.x = pk2(b0[0], b0[1]); w1.y = pk2(b0[2], b0[3]); w1.z = pk2(b1[0], b1[1]); w1.w = pk2(b1[2], b1[3]);
                    if (!isk) { bf16_t* rowp = O + (size_t)row * PS + C_QA + h * 128 + p * 64 + 8 * fq; *(u32x4*)rowp = w0; *(u32x4*)(rowp + 32) = w1; }
                    else { const int b = row / SEQ, t = row % SEQ; bf16_t* kp = kimg + ((size_t)((b * 4 + h) * 64 + (t >> 6))) * 8192 + (p * 8 + fq) * 512 + (t & 63) * 8;
                        *(u32x4*)kp = w0; *(u32x4*)(kp + 4 * 512) = w1; } }
        } else {
#pragma unroll
            for (int ai = 0; ai < 2; ++ai)
#pragma unroll
                for (int m = 0; m < 4; ++m) { const int row = row0 + ai * HALF + m * 16, b = row / SEQ, t = row % SEQ;
#pragma unroll
                    for (int bj = 0; bj < 2; ++bj) { const int h = 2 * (u.pn - 12) + bj; const f32x4 v0 = acc[ai][bj][m][0], v1 = acc[ai][bj][m][1];
                        u32x4 w; w.x = pk2(v0[0], v0[1]); w.y = pk2(v0[2], v0[3]); w.z = pk2(v1[0], v1[1]); w.w = pk2(v1[2], v1[3]);
                        *(u32x4*)(vimg + ((size_t)((b * 4 + h) * 64 + (t >> 6))) * 8192 + (wc * 4 + ((t & 63) >> 4)) * 512 + (t & 15) * 32 + fq * 8) = w; } }
        }
    }
};
struct EpiX1 {
    static constexpr bool PERM = true;
    const float* x; const float* mod; bf16_t* x1;
    DI void operator()(const f32x4 (&acc)[2][2][4][2], const Unit& u, int wr, int wc, int fr, int fq) const {
        const int row0 = u.pm * BM + wr * 64 + fr, col0 = u.pn * BM + wc * 32 + 8 * fq;
        const int b = (u.pm * BM) / SEQ;
        const float* gp = mod + (size_t)b * 6144 + 2048 + col0;
#pragma unroll
        for (int bj = 0; bj < 2; ++bj) { const f32x4 g0 = *(const f32x4*)(gp + bj * HALF), g1 = *(const f32x4*)(gp + bj * HALF + 4);
#pragma unroll
            for (int ai = 0; ai < 2; ++ai)
#pragma unroll
                for (int m = 0; m < 4; ++m) { const size_t off = (size_t)(row0 + ai * HALF + m * 16) * DM + col0 + bj * HALF;
                    const f32x4 r0 = *(const f32x4*)(x + off) + g0 * acc[ai][bj][m][0], r1 = *(const f32x4*)(x + off + 4) + g1 * acc[ai][bj][m][1];
                    u32x4 w; w.x = pk2(r0[0], r0[1]); w.y = pk2(r0[2], r0[3]); w.z = pk2(r1[0], r1[1]); w.w = pk2(r1[2], r1[3]);
                    *(u32x4*)(x1 + off) = w; } }
    }
};
DI unsigned pk4_fp8(float a, float b, float c, float d) { int w = __builtin_amdgcn_cvt_pk_fp8_f32(a, b, 0, false); w = __builtin_amdgcn_cvt_pk_fp8_f32(c, d, w, true); return (unsigned)w; }
constexpr float W_PRESCALE = 32.f, H_PRESCALE = 8.f;
struct EpiGU {
    static constexpr bool PERM = true;
    unsigned char* H;
    DI void operator()(const f32x4 (&acc)[2][2][4][2], const Unit& u, int wr, int wc, int fr, int fq) const {
        const int row0 = u.pm * BM + wr * 64 + fr, col0 = u.pn * HALF + wc * 32 + 8 * fq;
#pragma unroll
        for (int ai = 0; ai < 2; ++ai)
#pragma unroll
            for (int m = 0; m < 4; ++m) { unsigned char* rowp = H + (size_t)(row0 + ai * HALF + m * 16) * DFF + col0;
                float hv[8];
#pragma unroll
                for (int n = 0; n < 2; ++n)
#pragma unroll
                    for (int j = 0; j < 4; ++j) { const float gg = acc[ai][0][m][n][j] * (1.f / W_PRESCALE), uu = acc[ai][1][m][n][j] * (H_PRESCALE / W_PRESCALE); hv[n * 4 + j] = gg * __builtin_amdgcn_rcpf(1.f + __builtin_amdgcn_exp2f(-1.4426950408889634f * gg)) * uu; }
                u32x2 w; w.x = pk4_fp8(hv[0], hv[1], hv[2], hv[3]); w.y = pk4_fp8(hv[4], hv[5], hv[6], hv[7]);
                *(u32x2*)rowp = w; }
    }
};
constexpr float Y_PRESCALE = 64.f;
struct EpiDown {
    static constexpr bool PERM = true;
    unsigned char* Y; const float* vals;
    DI void operator()(const f32x4 (&acc)[2][2][4][2], const Unit& u, int wr, int wc, int fr, int fq) const {
        const int row0 = u.pm * BM + wr * 64 + fr, col0 = u.pn * BM + wc * 32 + 8 * fq;
#pragma unroll
        for (int ai = 0; ai < 2; ++ai)
#pragma unroll
            for (int m = 0; m < 4; ++m) { const int row = row0 + ai * HALF + m * 16; const float s = vals[row] * (Y_PRESCALE / (W_PRESCALE * H_PRESCALE)); unsigned char* rowp = Y + (size_t)row * DM + col0;
#pragma unroll
                for (int bj = 0; bj < 2; ++bj) { const f32x4 v0 = acc[ai][bj][m][0] * s, v1 = acc[ai][bj][m][1] * s;
                    u32x2 w; w.x = pk4_fp8(v0[0], v0[1], v0[2], v0[3]); w.y = pk4_fp8(v1[0], v1[1], v1[2], v1[3]);
                    *(u32x2*)(rowp + bj * HALF) = w; } }
    }
};
}

struct Args {
    const float* x; const float* c; const int* pos; const float* norm1_g; const float* norm2_g; const float* w_ada; const float* b_ada;
    const float* w_in; const float* conv_w; const float* gate_b; const float* mnorm_g; const float* qk_g; const float* lam_p; const float* subln_g;
    const float* w_out; const float* w_router; const float* w_gate; const float* w_up; const float* w_down;
    float* out; unsigned char* ws; int ph_lo, ph_hi;
};
struct Ctx {
    LAS unsigned char* lds; int tid, lane, wave, G, bid;
};
DI Args load_args() {
    typedef __attribute__((address_space(4))) const volatile unsigned long long* kp_t;
    kp_t kp = (kp_t)__builtin_amdgcn_kernarg_segment_ptr();
#define GP(T, i) ((T*)(__attribute__((address_space(1))) T*)kp[i])
    Args a;
    a.x = GP(const float, 0); a.c = GP(const float, 1); a.pos = GP(const int, 2); a.norm1_g = GP(const float, 3); a.norm2_g = GP(const float, 4);
    a.w_ada = GP(const float, 5); a.b_ada = GP(const float, 6); a.w_in = GP(const float, 7); a.conv_w = GP(const float, 8); a.gate_b = GP(const float, 9);
    a.mnorm_g = GP(const float, 10); a.qk_g = GP(const float, 11); a.lam_p = GP(const float, 12); a.subln_g = GP(const float, 13); a.w_out = GP(const float, 14);
    a.w_router = GP(const float, 15); a.w_gate = GP(const float, 16); a.w_up = GP(const float, 17); a.w_down = GP(const float, 18);
    a.out = GP(float, 19); a.ws = GP(unsigned char, 20);
#undef GP
    a.ph_lo = 0; a.ph_hi = 12;
    return a;
}

DI void tr_item64(const float* src, size_t ld_src, int k0, int c0, bf16_t* dst, size_t r0, int ld_dst, LAS float* scr  , int lane, size_t r1 = (size_t)-1) {
    const float* sp = src + (size_t)(k0 + (lane >> 4)) * ld_src + c0 + (lane & 15) * 4;
#pragma unroll 1
    for (int hf = 0; hf < 2; ++hf) {
        f32x4 v[8];
#pragma unroll
        for (int i = 0; i < 8; ++i) v[i] = *(const f32x4*)(sp + (size_t)(4 * (8 * hf + i)) * ld_src);
#pragma unroll
        for (int i = 0; i < 8; ++i) *(LAS f32x4*)(scr + (4 * (8 * hf + i) + (lane >> 4)) * 68 + (lane & 15) * 4) = v[i];
    }
    asm volatile("s_waitcnt lgkmcnt(0)" ::: "memory");
    const int c = lane & 7;
#pragma unroll
    for (int q = 0; q < 8; ++q) { const int n = 8 * q + (lane >> 3); const LAS float* s = scr + (8 * c) * 68 + n;
        u32x4 o; o.x = pk2(s[0 * 68], s[1 * 68]); o.y = pk2(s[2 * 68], s[3 * 68]); o.z = pk2(s[4 * 68], s[5 * 68]); o.w = pk2(s[6 * 68], s[7 * 68]);
        const size_t row = (r1 != (size_t)-1 && q >= 4) ? r1 + (n - 32) : r0 + n;
        *(u32x4*)(dst + row * ld_dst + k0 + 8 * c) = o; }
    asm volatile("s_waitcnt lgkmcnt(0)" ::: "memory");
}
DI void tr_item64_fp8(const float* src, size_t ld_src, int k0, int c0, unsigned char* dst, size_t r0, int ld_dst, float scale, LAS float* scr  , int lane) {
    const float* sp = src + (size_t)(k0 + (lane >> 4)) * ld_src + c0 + (lane & 15) * 4;
    {
        f32x4 v[16];
#pragma unroll
        for (int i = 0; i < 16; ++i) v[i] = __builtin_nontemporal_load((const f32x4*)(sp + (size_t)(4 * i) * ld_src));
#pragma unroll
        for (int i = 0; i < 16; ++i) *(LAS f32x4*)(scr + (4 * i + (lane >> 4)) * 68 + (lane & 15) * 4) = v[i] * scale;
    }
    asm volatile("s_waitcnt lgkmcnt(0)" ::: "memory");
    const int c = lane & 3;
#pragma unroll
    for (int q = 0; q < 4; ++q) { const int n = 16 * q + (lane >> 2); const LAS float* s = scr + (16 * c) * 68 + n;
        u32x4 o; o.x = pg8::pk4_fp8(s[0 * 68], s[1 * 68], s[2 * 68], s[3 * 68]); o.y = pg8::pk4_fp8(s[4 * 68], s[5 * 68], s[6 * 68], s[7 * 68]);
        o.z = pg8::pk4_fp8(s[8 * 68], s[9 * 68], s[10 * 68], s[11 * 68]); o.w = pg8::pk4_fp8(s[12 * 68], s[13 * 68], s[14 * 68], s[15 * 68]);
        *(u32x4*)(dst + (r0 + n) * ld_dst + k0 + 16 * c) = o; }
    asm volatile("s_waitcnt lgkmcnt(0)" ::: "memory");
}
DI void p0_phase(const Ctx& F, const Args& a) {
    if (F.bid < 96) {
        LAS float* sc = (LAS float*)F.lds; LAS float* part = (LAS float*)(F.lds + 32768);
        for (int i = F.tid; i < BATCH * DM; i += NTHR) sc[i] = silu_f(a.c[i]);
        __syncthreads();
        const int col = F.bid * 64 + F.lane;
        float acc[8];
#pragma unroll
        for (int b = 0; b < 8; ++b) acc[b] = 0.f;
        const int kb = F.wave * 128;
#pragma unroll 1
        for (int k0 = kb; k0 < kb + 128; k0 += 16) {
            float w[16];
            const float* wp = a.w_ada + (size_t)k0 * 6144 + col;
#pragma unroll
            for (int j = 0; j < 16; ++j) w[j] = wp[(size_t)j * 6144];
#pragma unroll
            for (int j = 0; j < 16; ++j)
#pragma unroll
                for (int b = 0; b < 8; ++b) acc[b] += sc[b * DM + k0 + j] * w[j];
        }
#pragma unroll
        for (int b = 0; b < 8; ++b) part[(F.wave * 8 + b) * 64 + F.lane] = acc[b];
        __syncthreads();
        { const int b = F.tid >> 6, l = F.tid & 63; float s = a.b_ada[F.bid * 64 + l];
#pragma unroll
          for (int w = 0; w < 8; ++w) s += part[(w * 8 + b) * 64 + l];
          ((float*)(a.ws + WS_MOD))[b * 6144 + F.bid * 64 + l] = s; }
        asm volatile("s_waitcnt vmcnt(0)" ::: "memory");
        __syncthreads();
        if (F.tid == 0) { __builtin_amdgcn_fence(__ATOMIC_RELEASE, "agent"); asm volatile("s_waitcnt vmcnt(0)" ::: "memory");
            __hip_atomic_fetch_add((unsigned*)(a.ws + WS_CTL) + 4096, 1u, __ATOMIC_RELAXED, __HIP_MEMORY_SCOPE_AGENT); }
    }
    LAS float* scr = (LAS float*)(F.lds + F.wave * 17408);
    const int gw = F.bid * NWAVES + F.wave, NGW = F.G * NWAVES;
    constexpr int I_IN = 16 * 56, I_OUT = 16 * 16, I_WG = 16, I_EX = 4096;
    constexpr int NITEMS = I_IN + I_OUT + I_EX + I_WG;
    bf16_t* WinT = (bf16_t*)(a.ws + WS_WINT); bf16_t* WgT = (bf16_t*)(a.ws + WS_WGT); bf16_t* WoutT = (bf16_t*)(a.ws + WS_WOUTT);
    for (int it = gw; it < NITEMS; it += NGW) {
        int r = it;
        if (r < I_IN) { const int kb = r / 56, nb = r % 56, n0 = nb * 64;
            if (n0 >= 2048 && n0 < 3072) { const int t0 = n0 & ~255, g = (n0 >> 6) & 3; tr_item64(a.w_in, DIN, kb * 64, n0 + 16, WinT, (size_t)(t0 + 32 * g), DM, scr, F.lane, (size_t)(t0 + 128 + 32 * g)); }
            else tr_item64(a.w_in, DIN, kb * 64, n0 + (n0 >= 2048 ? 16 : 0), WinT, n0, DM, scr, F.lane);
            continue; } r -= I_IN;
        if (r < I_OUT) { const int kb = r / 16, nb = r % 16; tr_item64(a.w_out, DM, kb * 64, nb * 64, WoutT, nb * 64, DM, scr, F.lane); continue; } r -= I_OUT;
        if (r < I_EX) { int e, mat, q;
            if (r < 1024) { e = 13; mat = 1 + (r >> 9); q = r & 511; } else { const int t = r - 1024; e = 14 + t / 1536; const int u = t % 1536; mat = u >> 9; q = u & 511; }
            if (mat < 2) { const int kb = q / 32, nb = q % 32, n0 = nb * 64; const float* src = (mat ? a.w_up : a.w_gate) + (size_t)e * DM * DFF;
                tr_item64_fp8(src, DFF, kb * 64, n0, a.ws + WS_WGUT + (size_t)e * 4096 * DM, (size_t)(n0 / 128) * 256 + (n0 % 128) + mat * 128, DM, pg8::W_PRESCALE, scr, F.lane); }
            else { const int kb = q / 16, nb = q % 16;
                tr_item64_fp8(a.w_down + (size_t)e * DFF * DM, DM, kb * 64, nb * 64, a.ws + WS_WDT + (size_t)e * DM * DFF, nb * 64, DFF, pg8::W_PRESCALE, scr, F.lane); }
            continue; } r -= I_EX;
        tr_item64(a.w_in, DIN, r * 64, 2048 - 48, WgT, 0, DM, scr, F.lane);
    }
    if (F.tid == 0) { unsigned* cnt = (unsigned*)(a.ws + WS_CTL) + 4096; unsigned sp = 0;
        while (__hip_atomic_load(cnt, __ATOMIC_RELAXED, __HIP_MEMORY_SCOPE_AGENT) < 96u && ++sp < (1u << 22)) __builtin_amdgcn_s_sleep(2);
        __builtin_amdgcn_fence(__ATOMIC_ACQUIRE, "agent"); asm volatile("s_waitcnt vmcnt(0)" ::: "memory"); }
    __syncthreads();
}

DI void p1_phase(const Ctx& F, const Args& a) {
    const int gw = F.bid * NWAVES + F.wave, NGW = F.G * NWAVES;
    const float* mod = (const float*)(a.ws + WS_MOD);
    bf16_t* H1 = (bf16_t*)a.out;
    for (int m0 = gw; m0 < MTOK; m0 += 2 * NGW) {
        const int m1 = m0 + NGW; const bool has1 = m1 < MTOK;
        const f32x4* xr0 = (const f32x4*)(a.x + (size_t)m0 * DM) + F.lane; const f32x4* xr1 = (const f32x4*)(a.x + (size_t)(has1 ? m1 : m0) * DM) + F.lane;
        f32x4 v0[4], v1[4]; float s0 = 0.f, s1 = 0.f;
#pragma unroll
        for (int j = 0; j < 4; ++j) { v0[j] = __builtin_nontemporal_load(xr0 + 64 * j); v1[j] = __builtin_nontemporal_load(xr1 + 64 * j); }
#pragma unroll
        for (int j = 0; j < 4; ++j) { s0 += (v0[j].x * v0[j].x + v0[j].y * v0[j].y) + (v0[j].z * v0[j].z + v0[j].w * v0[j].w); s1 += (v1[j].x * v1[j].x + v1[j].y * v1[j].y) + (v1[j].z * v1[j].z + v1[j].w * v1[j].w); }
#pragma unroll
        for (int o = 1; o < 64; o <<= 1) { s0 += __shfl_xor(s0, o); s1 += __shfl_xor(s1, o); }
        const float rstd0 = rsqrtf(s0 * (1.f / DM) + EPS), rstd1 = rsqrtf(s1 * (1.f / DM) + EPS);
        const int b0 = m0 / SEQ, b1 = (has1 ? m1 : m0) / SEQ;
        u32x2* o0 = (u32x2*)(H1 + (size_t)m0 * DM) + F.lane; u32x2* o1 = (u32x2*)(H1 + (size_t)m1 * DM) + F.lane;
#pragma unroll
        for (int j = 0; j < 4; ++j) {
            const f32x4 g = ((const f32x4*)a.norm1_g)[F.lane + 64 * j];
            { const f32x4 sh = ((const f32x4*)(mod + (size_t)b0 * 6144))[F.lane + 64 * j], sc = ((const f32x4*)(mod + (size_t)b0 * 6144 + 1024))[F.lane + 64 * j];
              const f32x4 h = v0[j] * rstd0 * g * (sc + 1.f) + sh; u32x2 w; w.x = pk2(h.x, h.y); w.y = pk2(h.z, h.w); o0[64 * j] = w; }
            if (has1) { const f32x4 sh = ((const f32x4*)(mod + (size_t)b1 * 6144))[F.lane + 64 * j], sc = ((const f32x4*)(mod + (size_t)b1 * 6144 + 1024))[F.lane + 64 * j];
              const f32x4 h = v1[j] * rstd1 * g * (sc + 1.f) + sh; u32x2 w; w.x = pk2(h.x, h.y); w.y = pk2(h.z, h.w); o1[64 * j] = w; }
        }
    }
}

DI void gates_tasks(const Ctx& F, const Args& a) {
    const int gw = F.bid * NWAVES + F.wave, NGW = F.G * NWAVES;
    const bf16_t* H1 = (const bf16_t*)a.out; const bf16_t* WgT = (const bf16_t*)(a.ws + WS_WGT) + 48 * DM; float* GT = (float*)(a.ws + WS_GATES);
    const float bias = a.gate_b[F.lane & 15];
    for (int task = gw; task < MTOK / 16; task += NGW) {
        const int row0 = task * 16;
        const bf16_t* ap = H1 + (size_t)(row0 + (F.lane & 15)) * DM + 8 * (F.lane >> 4);
        const bf16_t* bp = WgT + (size_t)(F.lane & 15) * DM + 8 * (F.lane >> 4);
        f32x4 acc = {0.f, 0.f, 0.f, 0.f};
        bf16x8 avs[32];
#pragma unroll
        for (int i = 0; i < 32; ++i) avs[i] = *(const bf16x8*)(ap + 32 * i);
#pragma unroll
        for (int i = 0; i < 32; ++i) { const bf16x8 bv = *(const bf16x8*)(bp + 32 * i); acc = __builtin_amdgcn_mfma_f32_16x16x32_bf16(avs[i], bv, acc, 0, 0, 0); }
#pragma unroll
        for (int r = 0; r < 4; ++r) GT[(size_t)(row0 + (F.lane >> 4) * 4 + r) * 16 + (F.lane & 15)] = acc[r] + bias;
    }
}

DI void qk_tile_task(const Ctx& F, const Args& a, int task) {
    const int b = task >> 6, tile = task & 63, r = F.lane, g = F.wave, h = g >> 1, p = g & 1;
    bf16_t* PROJ = (bf16_t*)(a.ws + WS_PROJ);
    const size_t tok = (size_t)b * SEQ + tile * 64 + r;
    float invf[8];
#pragma unroll
    for (int i = 0; i < 8; ++i) invf[i] = exp2f(-(float)i * 0.125f * 18.931568569324174f) * 0.15915494309189535f;
    const float pos = (float)a.pos[tok];
    float sn[8], cs[8];
#pragma unroll
    for (int i = 0; i < 8; ++i) { const float fr = __builtin_amdgcn_fractf(pos * invf[i]); sn[i] = __builtin_amdgcn_sinf(fr); cs[i] = __builtin_amdgcn_cosf(fr); }
#pragma unroll 1
    for (int isk = 0; isk < 2; ++isk) {
        u32x4* src = (u32x4*)(PROJ + tok * PS + (isk ? C_KA : C_QA) + g * 64);
        u32x4 w[8];
#pragma unroll
        for (int c = 0; c < 8; ++c) w[c] = src[c];
        float ss = 0.f;
#pragma unroll
        for (int c = 0; c < 8; ++c) { float t;
            t = bflo(w[c].x); ss += t * t; t = bfhi(w[c].x); ss += t * t; t = bflo(w[c].y); ss += t * t; t = bfhi(w[c].y); ss += t * t;
            t = bflo(w[c].z); ss += t * t; t = bfhi(w[c].z); ss += t * t; t = bflo(w[c].w); ss += t * t; t = bfhi(w[c].w); ss += t * t; }
        const float rstd = rsqrtf(ss * (1.f / 64.f) + EPS) * (isk ? 1.f : 0.125f * 1.4426950408889634f);
        const float* gp = a.qk_g + isk * 64;
        float v0[16];
        v0[0] = bflo(w[0].x); v0[1] = bfhi(w[0].x); v0[2] = bflo(w[0].y); v0[3] = bfhi(w[0].y); v0[4] = bflo(w[0].z); v0[5] = bfhi(w[0].z); v0[6] = bflo(w[0].w); v0[7] = bfhi(w[0].w);
        v0[8] = bflo(w[1].x); v0[9] = bfhi(w[1].x); v0[10] = bflo(w[1].y); v0[11] = bfhi(w[1].y); v0[12] = bflo(w[1].z); v0[13] = bfhi(w[1].z); v0[14] = bflo(w[1].w); v0[15] = bfhi(w[1].w);
#pragma unroll
        for (int i = 0; i < 16; ++i) v0[i] *= rstd * gp[i];
        float rr[16];
#pragma unroll
        for (int i = 0; i < 8; ++i) { rr[i] = v0[i] * cs[i] - v0[i + 8] * sn[i]; rr[i + 8] = v0[i + 8] * cs[i] + v0[i] * sn[i]; }
        u32x4 o[8];
        o[0].x = pk2(rr[0], rr[1]); o[0].y = pk2(rr[2], rr[3]); o[0].z = pk2(rr[4], rr[5]); o[0].w = pk2(rr[6], rr[7]);
        o[1].x = pk2(rr[8], rr[9]); o[1].y = pk2(rr[10], rr[11]); o[1].z = pk2(rr[12], rr[13]); o[1].w = pk2(rr[14], rr[15]);
#pragma unroll
        for (int c = 2; c < 8; ++c) { const f32x4 g0 = *(const f32x4*)(gp + c * 8), g1 = *(const f32x4*)(gp + c * 8 + 4);
            o[c].x = pk2(bflo(w[c].x) * rstd * g0.x, bfhi(w[c].x) * rstd * g0.y); o[c].y = pk2(bflo(w[c].y) * rstd * g0.z, bfhi(w[c].y) * rstd * g0.w);
            o[c].z = pk2(bflo(w[c].z) * rstd * g1.x, bfhi(w[c].z) * rstd * g1.y); o[c].w = pk2(bflo(w[c].w) * rstd * g1.z, bfhi(w[c].w) * rstd * g1.w); }
        if (isk == 0) {
#pragma unroll
            for (int c = 0; c < 8; ++c) src[c] = o[c];
        } else {
            u32x4* dst = (u32x4*)((bf16_t*)(a.ws + WS_KIMG) + ((size_t)((b * 4 + h) * 64 + tile)) * 8192) + r;
#pragma unroll
            for (int c = 0; c < 8; ++c) dst[(p * 8 + c) * 64] = o[c];
        }
    }
    {
        u32x4* dst = (u32x4*)((bf16_t*)(a.ws + WS_VIMG) + ((size_t)((b * 4 + h) * 64 + tile)) * 8192) + r;
#pragma unroll
        for (int cg = 2 * p; cg < 2 * p + 2; ++cg)
#pragma unroll
            for (int kg = 0; kg < 4; ++kg) {
                const u32x4 v = *(const u32x4*)(PROJ + ((size_t)b * SEQ + tile * 64 + 16 * kg + (r >> 2)) * PS + C_VA + h * 128 + 32 * cg + 8 * (r & 3));
                dst[(cg * 4 + kg) * 64] = v; }
    }
}

DI bf16x8 tr_frag_nat(const LAS unsigned char* img, int rowbase, int col0, int lane) {
    const int hh = lane >> 5, g16 = (lane >> 4) & 1, i = lane & 15;
    const int col = col0 + 16 * g16 + 4 * (i & 3), chunk = col >> 3, sub = (col & 7) * 2;
    const int r0 = rowbase + 8 * hh + (i >> 2), r1 = r0 + 4;
    const s16x4 lo = trread(img + r0 * 256 + ((chunk ^ swz16(r0)) << 4) + sub);
    const s16x4 hi = trread(img + r1 * 256 + ((chunk ^ swz16(r1)) << 4) + sub);
    return __builtin_shufflevector(lo, hi, 0, 1, 2, 3, 4, 5, 6, 7);
}
DI bf16x8 tr_frag_acc(const LAS unsigned char* img, int rowbase, int col0, int lane) {
    const int hh = lane >> 5, g16 = (lane >> 4) & 1, i = lane & 15;
    const int col = col0 + 16 * g16 + 4 * (i & 3), chunk = col >> 3, sub = (col & 7) * 2;
    const int r0 = rowbase + 4 * hh + (i >> 2), r1 = r0 + 8;
    const s16x4 lo = trread(img + r0 * 256 + ((chunk ^ swz16(r0)) << 4) + sub);
    const s16x4 hi = trread(img + r1 * 256 + ((chunk ^ swz16(r1)) << 4) + sub);
    return __builtin_shufflevector(lo, hi, 0, 1, 2, 3, 4, 5, 6, 7);
}
DI bf16x8 row_frag(const LAS unsigned char* img, int row, int chunk) { return *(const LAS bf16x8*)(img + row * 256 + ((chunk ^ swz16(row)) << 4)); }

DI void glds16_asm(const void* gsrc, unsigned lds_dst) { unsigned keep;
    asm volatile("s_mov_b32 %0, m0\n\ts_mov_b32 m0, %2\n\ts_nop 0\n\tglobal_load_lds_dwordx4 %1, off\n\ts_mov_b32 m0, %0" : "=&s"(keep) : "v"(gsrc), "s"(lds_dst) : "memory"); }
constexpr size_t DO_QC = 0, DO_KC = 32 * MiB, DO_HD = 64 * MiB;
constexpr size_t WS_SC = 7 * MiB;

DI void conv_task(const Ctx& F, const Args& a, int tw) {
    const int isk = tw & 1, tok0 = (tw >> 1) * 8, b = tok0 / SEQ, t0 = tok0 % SEQ, lane = F.lane;
    const bf16_t* src = (const bf16_t*)(a.ws + WS_PROJ) + (size_t)b * SEQ * PS + (isk ? C_KM : C_QM) + lane * 8;
    float cw[5][8];
#pragma unroll
    for (int j = 0; j < 5; ++j) { const f32x4 c0 = *(const f32x4*)(a.conv_w + j * 1024 + isk * 512 + lane * 8), c1 = *(const f32x4*)(a.conv_w + j * 1024 + isk * 512 + lane * 8 + 4);
        cw[j][0] = c0.x; cw[j][1] = c0.y; cw[j][2] = c0.z; cw[j][3] = c0.w; cw[j][4] = c1.x; cw[j][5] = c1.y; cw[j][6] = c1.z; cw[j][7] = c1.w; }
    u32x4 row[12];
#pragma unroll
    for (int r = 0; r < 12; ++r) { const int t = t0 + r - 2; row[r] = (u32x4){0u, 0u, 0u, 0u}; if (t >= 0 && t < SEQ) row[r] = *(const u32x4*)(src + (size_t)t * PS); }
    const int hd = lane >> 4, cc = lane & 15, cch = t0 >> 6, r0 = t0 & 63;
    bf16_t* tileb = (bf16_t*)((unsigned char*)a.out + (isk ? DO_KC : DO_QC)) + ((size_t)((b * 4 + hd) * 64 + cch)) * 8192;
    bf16_t* dst = isk ? tileb + ((cc >> 2) * 4 + (r0 >> 4)) * 512 + (r0 & 15) * 32 + (cc & 3) * 8 : tileb + cc * 512 + r0 * 8;
    const int dstride = isk ? 32 : 8;
    const float sc = isk ? 0.08838834764831845f : 1.f;
#pragma unroll
    for (int i = 0; i < 8; ++i) {
        float acc[8];
#pragma unroll
        for (int e = 0; e < 8; ++e) acc[e] = 0.f;
#pragma unroll
        for (int j = 0; j < 5; ++j) { const u32x4 w = row[i + j];
            acc[0] += bflo(w.x) * cw[j][0]; acc[1] += bfhi(w.x) * cw[j][1]; acc[2] += bflo(w.y) * cw[j][2]; acc[3] += bfhi(w.y) * cw[j][3];
            acc[4] += bflo(w.z) * cw[j][4]; acc[5] += bfhi(w.z) * cw[j][5]; acc[6] += bflo(w.w) * cw[j][6]; acc[7] += bfhi(w.w) * cw[j][7]; }
#pragma unroll
        for (int e = 0; e < 8; ++e) acc[e] = silu_f(acc[e]) * sc;
        u32x4 o; o.x = pk2(acc[0], acc[1]); o.y = pk2(acc[2], acc[3]); o.z = pk2(acc[4], acc[5]); o.w = pk2(acc[6], acc[7]);
        *(u32x4*)(dst + i * dstride) = o;
    }
}

DI void mscal_task(const Ctx& F, const Args& a, int chain) {
    const int b = chain >> 3, h = (chain >> 1) & 3, dir = chain & 1;
    const int s = dir ? 63 - F.lane : F.lane;
    const float* GT = (const float*)(a.ws + WS_GATES) + (size_t)b * SEQ * 16;
    float* SC = (float*)(a.ws + WS_SC) + (size_t)chain * 64 * 256; float* MSC = (float*)(a.ws + WS_MSC);
    LAS float* gl = (LAS float*)F.lds; LAS float* mll = gl + 64; LAS float* mpv = gl + 128; LAS float* mnw = gl + 192;
    float aa[8], ii[8];
#pragma unroll
    for (int i = 0; i < 8; ++i) { const int c = F.wave + 8 * i;
        const float ig = GT[(size_t)(c * 64 + s) * 16 + dir * 8 + h], fg = GT[(size_t)(c * 64 + s) * 16 + dir * 8 + 4 + h];
        const float av = wave_prefix_sum(logsigmoid_f(fg));
        aa[i] = av; ii[i] = ig;
        const float g = __builtin_bit_cast(float, __builtin_amdgcn_readlane(__builtin_bit_cast(int, av), 63)), ml = wave_max(g - av + ig);
        if (F.lane == 0) { gl[c] = g; mll[c] = ml; } }
    __syncthreads();
    if (F.tid == 0) { float m = 0.f;
        for (int st = 0; st < 64; ++st) { const int c = dir ? 63 - st : st; mpv[c] = m; const float mn = fmaxf(gl[c] + m, mll[c]); mnw[c] = mn; m = mn; } }
    __syncthreads();
#pragma unroll
    for (int i = 0; i < 8; ++i) { const int c = F.wave + 8 * i; const float mprev = mpv[c], mnew = mnw[c], g = gl[c];
        const float cterm = ii[i] - aa[i];
        const float cm = wave_prefix_max(cterm);
        const float il = aa[i] + mprev, mj = fmaxf(il, aa[i] + cm);
        float* o4 = SC + (size_t)c * 256 + s;
        o4[0] = (aa[i] - mj) * 1.4426950408889634f; o4[64] = cterm * 1.4426950408889634f; o4[128] = __expf(il - mj); o4[192] = __expf(-mj);
        if (F.lane == 0) { MSC[chain * 64 + c] = (g - mnew) * 1.4426950408889634f; MSC[4096 + chain * 64 + c] = __expf(g + mprev - mnew); } }
    __syncthreads();
}

DI const float* wsel3(int m, const float* p0, const float* p1, const float* p2) {
    const unsigned long long a0 = (unsigned long long)p0, a1 = (unsigned long long)p1, a2 = (unsigned long long)p2;
    const unsigned long long m1 = (unsigned long long)0 - (unsigned long long)(m == 1), m2 = (unsigned long long)0 - (unsigned long long)(m == 2);
    return (const float*)((a0 & ~(m1 | m2)) | (a1 & m1) | (a2 & m2));
}
DI void mseq_item(const Ctx& F, const Args& a, int item, int bh, int dir, int vs) {
    const int b = bh >> 2, h = bh & 3, chain = bh * 2 + dir, wid = F.wave, tid = F.tid, lane = F.lane, r32 = lane & 31, hh = lane >> 5;
    LAS unsigned char* QS = F.lds;
    LAS unsigned char* KS = F.lds + 32768;
    LAS unsigned char* VS = F.lds + 65536;
    LAS unsigned char* SCS = F.lds + 77824;
    LAS unsigned char* SD = F.lds + 80896;
    LAS unsigned char* CI = F.lds + 97280;
    LAS float* NV = (LAS float*)(F.lds + 113664);
    LAS float* gmv = NV + 256; LAS float* spv = gmv + 64;
    LAS unsigned char* HST = F.lds + 115712;
    const int cwi = wid < 4 ? wid : 4;
    const bool cwave = wid < 4 || wid == 7;
    const unsigned cscb = (unsigned)(uintptr_t)F.lds + 119808u + (unsigned)cwi * 8192u;
    const int cslot0 = (item * 5 + cwi) * 64;
    const float* const wg_ = a.w_gate; const float* const wu_ = a.w_up; const float* const wd_ = a.w_down;
    const bf16_t* QC = (const bf16_t*)((const unsigned char*)a.out + DO_QC) + (size_t)bh * 64 * 8192 + lane * 8;
    const bf16_t* KC = (const bf16_t*)((const unsigned char*)a.out + DO_KC) + (size_t)bh * 64 * 8192 + lane * 8;
    const bf16_t* VP = (const bf16_t*)(a.ws + WS_PROJ) + (size_t)b * SEQ * PS + C_VM + h * 128 + vs * 32 + (size_t)(16 * (wid & 3) + (lane >> 2)) * PS + 8 * (lane & 3);
    const float* SC = (const float*)(a.ws + WS_SC) + (size_t)chain * 64 * 256 + lane * 4;
    bf16_t* HD = (bf16_t*)((unsigned char*)a.out + DO_HD) + ((size_t)dir * MTOK + (size_t)b * SEQ) * 512 + h * 128 + vs * 32;
    if (tid < 64) { gmv[tid] = ((const float*)(a.ws + WS_MSC))[chain * 64 + tid]; spv[tid] = ((const float*)(a.ws + WS_MSC))[4096 + chain * 64 + tid]; }
    if (tid < 256) NV[tid] = 0.f;
    for (int i = tid; i < 4096; i += NTHR) ((LAS unsigned*)CI)[i] = 0u;
    const unsigned ldsb = (unsigned)(uintptr_t)F.lds;
#define MSEQ_ISSUE_QK(c, s2) do { const size_t _tb = (size_t)(c); \
        if (wid < 4) { _Pragma("unroll") for (int _i = 0; _i < 4; ++_i) \
                glds16_asm(QC + _tb * 8192 + (4 * wid + _i) * 512, (unsigned)__builtin_amdgcn_readfirstlane((int)(ldsb + (s2) * 16384 + (4 * wid + _i) * 1024))); } \
        else if (wid >= 6) { _Pragma("unroll") for (int _i = 0; _i < 8; ++_i) \
                glds16_asm(KC + _tb * 8192 + (8 * (wid - 6) + _i) * 512, (unsigned)__builtin_amdgcn_readfirstlane((int)(ldsb + 32768 + (s2) * 16384 + (8 * (wid - 6) + _i) * 1024))); } } while (0)
#define MSEQ_ISSUE_VS(c, s4) do { const size_t _tb = (size_t)(c); \
        if (wid < 4) glds16_asm(VP + _tb * 64 * PS, (unsigned)__builtin_amdgcn_readfirstlane((int)(ldsb + 65536 + (s4) * 4096 + wid * 1024))); \
        else if (wid == 6) glds16_asm(SC + _tb * 256, (unsigned)__builtin_amdgcn_readfirstlane((int)(ldsb + 77824 + (s4) * 1024))); } while (0)
    MSEQ_ISSUE_QK(dir ? 63 : 0, 0); MSEQ_ISSUE_VS(dir ? 63 : 0, 0);
#define MSEQ_CONV_ISSUE(id) do { const int _e = (id) / 6144, _r = (id) % 6144, _mat = _r >> 11, _rr = _r & 2047; \
        const int _N = _mat == 2 ? DM : DFF, _nb = _mat == 2 ? (_rr >> 7) : (_rr >> 6), _kb = _mat == 2 ? (_rr & 127) : (_rr & 63); \
        const float* _src = wsel3(_mat, wg_, wu_, wd_) + (size_t)_e * DM * DFF + (size_t)(16 * _kb + (lane >> 4)) * _N + 64 * _nb + 4 * (lane & 15); \
        _Pragma("unroll") for (int _i = 0; _i < 4; ++_i) glds16_asm(_src + (size_t)(4 * _i) * _N, (unsigned)__builtin_amdgcn_readfirstlane((int)(cscb + ((id) & 1) * 4096 + _i * 1024))); } while (0)
    if (cwave) MSEQ_CONV_ISSUE(cslot0);
    f32x16 Cacc[2];
#pragma unroll
    for (int i = 0; i < 16; ++i) { Cacc[0][i] = 0.f; Cacc[1][i] = 0.f; }
    const int qrd = hh * 1024 + r32 * 16;
    const int ktr = (8 * hh + ((lane & 15) >> 2)) * 64 + ((lane >> 4) & 1) * 32 + (lane & 3) * 8;
    f32x16 acc;
    float qn = 0.f;
#pragma unroll
    for (int i = 0; i < 16; ++i) acc[i] = 0.f;
    asm volatile("s_waitcnt vmcnt(0)" ::: "memory");
    __syncthreads();
    unsigned long long busy = 0, tb0 = 0; if (PROBE_MSEQ_W >= 0) tb0 = __builtin_amdgcn_s_memtime(); const unsigned long long titem0 = tb0;
#pragma unroll 1
    for (int st = 0; st <= 64; ++st) {
        const int c = dir ? 63 - st : st, s2 = st & 1; const int s3 = st % 3, s3p = (st + 2) % 3;
        if (st + 1 < 64) { MSEQ_ISSUE_QK(dir ? 62 - st : st + 1, s2 ^ 1); MSEQ_ISSUE_VS(dir ? 62 - st : st + 1, (st + 1) % 3);
            if (cwave) MSEQ_CONV_ISSUE(cslot0 + st + 1); }
        const LAS unsigned char* QT = QS + s2 * 16384; const LAS unsigned char* KT = KS + s2 * 16384; const LAS unsigned char* VT = VS + s3 * 4096;
        const LAS float* rt = (const LAS float*)(SCS + s3 * 1024); const LAS float* ct = rt + 64;
        if (wid < 4) {
            if (st < 64) {
                const int jt = wid >> 1, stt = wid & 1;
                const LAS unsigned char* qa = QT + qrd + jt * 512;
                const LAS unsigned char* kb = KT + (2 * stt + (r32 >> 4)) * 1024 + (r32 & 15) * 64 + hh * 16;
                const int j = 32 * jt + r32; const float rtj = rt[j];
                const LAS float* ctp = ct + 32 * stt + 4 * hh;
                f32x4 c4[4];
#pragma unroll
                for (int rg = 0; rg < 4; ++rg) c4[rg] = *(const LAS f32x4*)(ctp + 8 * rg);
                const float gm = gmv[c], sp = spv[c];
                const int ck = 4 * wid + (lane & 3), r0 = 4 * (lane >> 2);
                const LAS unsigned char* kr = KT + (ck >> 2) * 4096 + (r0 >> 4) * 1024 + (r0 & 15) * 64 + (ck & 3) * 16;
                u32x4 kw[4];
#pragma unroll
                for (int r = 0; r < 4; ++r) kw[r] = *(const LAS u32x4*)(kr + r * 64);
                const f32x4 ctn = *(const LAS f32x4*)(ct + r0);
                const LAS float* no = NV + s2 * 128 + 32 * wid + 8 * (lane & 3);
                const f32x4 o0 = *(const LAS f32x4*)no, o1 = *(const LAS f32x4*)(no + 4);
                f32x16 S;
                f32x16 S2;
#pragma unroll
                for (int i = 0; i < 16; ++i) { S[i] = 0.f; S2[i] = 0.f; }
#pragma unroll
                for (int ks = 0; ks < 8; ks += 2) { S = MFMA32(*(const LAS bf16x8*)(kb + (ks >> 1) * 4096), *(const LAS bf16x8*)(qa + ks * 2048), S);
                    S2 = MFMA32(*(const LAS bf16x8*)(kb + (ks >> 1) * 4096 + 32), *(const LAS bf16x8*)(qa + (ks + 1) * 2048), S2); }
#pragma unroll
                for (int i = 0; i < 16; ++i) S[i] += S2[i];
                float pa[8];
#pragma unroll
                for (int e = 0; e < 8; ++e) pa[e] = 0.f;
#pragma unroll
                for (int r = 0; r < 4; ++r) { const u32x4 w = kw[r]; const float ws_ = __builtin_amdgcn_exp2f(ctn[r] + gm);
                    pa[0] += ws_ * bflo(w.x); pa[1] += ws_ * bfhi(w.x); pa[2] += ws_ * bflo(w.y); pa[3] += ws_ * bfhi(w.y); pa[4] += ws_ * bflo(w.z); pa[5] += ws_ * bfhi(w.z); pa[6] += ws_ * bflo(w.w); pa[7] += ws_ * bfhi(w.w); }
#pragma unroll
                for (int e = 0; e < 8; ++e) { float t = pa[e]; t += dpp_mov<DPP_ROR(8)>(t); t += dpp_mov<DPP_ROR(4)>(t); t = xor16_sum(t); pa[e] = xor32_sum(t); }
                u32x2 sw2[4];
#pragma unroll
                for (int rg = 0; rg < 4; ++rg) { float v[4];
#pragma unroll
                    for (int e = 0; e < 4; ++e) { const int sc = 32 * stt + 8 * rg + 4 * hh + e; const bool ok = dir == 0 ? (sc <= j) : (sc >= j);
                        v[e] = S[4 * rg + e] * __builtin_amdgcn_exp2f(ok ? rtj + c4[rg][e] : -1.0e30f); }
                    sw2[rg].x = pk2(v[0], v[1]); sw2[rg].y = pk2(v[2], v[3]); }
                LAS unsigned char* sw = SD + s2 * 8192 + stt * 4096 + j * 16 + hh * 8;
#pragma unroll
                for (int rg = 0; rg < 4; ++rg) *(LAS u32x2*)(sw + rg * 1024) = sw2[rg];
                if (lane < 4) { LAS float* nn = NV + (s2 ^ 1) * 128 + 32 * wid + 8 * lane;
                    *(LAS f32x4*)nn = (f32x4){sp * o0.x + pa[0], sp * o0.y + pa[1], sp * o0.z + pa[2], sp * o0.w + pa[3]};
                    *(LAS f32x4*)(nn + 4) = (f32x4){sp * o1.x + pa[4], sp * o1.y + pa[5], sp * o1.z + pa[6], sp * o1.w + pa[7]}; }
            }
        } else if (wid < 6) {
            const int jt = wid - 4, jl = 32 * jt + r32;
            u32x2 hw[4]; bool have_h = false; int cp = 0;
            if (st > 0) {
                cp = dir ? 64 - st : st - 1; have_h = true;
                const LAS float* iw = (const LAS float*)(SCS + s3p * 1024) + 128; const LAS float* enm = iw + 64;
                const LAS unsigned char* SDp = SD + (s2 ^ 1) * 8192;
                const LAS unsigned char* sr = SDp + hh * 4096 + jl * 16;
                u32x4 w4[4];
#pragma unroll
                for (int ch = 0; ch < 4; ++ch) w4[ch] = *(const LAS u32x4*)(sr + ch * 1024);
                const float iwj = iw[jl], enj = enm[jl];
                const LAS unsigned char* sa = SDp + qrd + jt * 512; const LAS unsigned char* vb = VS + s3p * 4096 + ktr;
                float rsum = 0.f;
#pragma unroll
                for (int ch = 0; ch < 4; ++ch) { const u32x4 w = w4[ch];
                    rsum += (bflo(w.x) + bfhi(w.x)) + (bflo(w.y) + bfhi(w.y)) + (bflo(w.z) + bfhi(w.z)) + (bflo(w.w) + bfhi(w.w)); }
                rsum = xor32_sum(rsum);
                const float den = rsum + iwj * qn;
                const float rdj = 1.f / fmaxf(fabsf(den), enj);
#pragma unroll
                for (int i = 0; i < 16; ++i) acc[i] *= iwj;
#pragma unroll
                for (int ks = 0; ks < 4; ++ks) { const s16x4 lo = trread(vb + ks * 1024), hi = trread(vb + ks * 1024 + 256);
                    acc = MFMA32(__builtin_shufflevector(lo, hi, 0, 1, 2, 3, 4, 5, 6, 7), *(const LAS bf16x8*)(sa + ks * 2048), acc); }
#pragma unroll
                for (int rg = 0; rg < 4; ++rg) { hw[rg].x = pk2(acc[4 * rg] * rdj, acc[4 * rg + 1] * rdj); hw[rg].y = pk2(acc[4 * rg + 2] * rdj, acc[4 * rg + 3] * rdj); }
            }
            if (st < 64) {
                const LAS unsigned char* qa = QT + qrd + jt * 512;
                const LAS unsigned char* cb = CI + s2 * 8192 + hh * 512 + r32 * 16;
                const LAS unsigned char* qr = QT + hh * 8192 + jl * 16; const LAS float* np = NV + s2 * 128 + 64 * hh;
                f32x16 acc2;
#pragma unroll
                for (int i = 0; i < 16; ++i) { acc[i] = 0.f; acc2[i] = 0.f; }
#pragma unroll
                for (int ks = 0; ks < 8; ks += 2) { acc = MFMA32(*(const LAS bf16x8*)(cb + ks * 1024), *(const LAS bf16x8*)(qa + ks * 2048), acc);
                    acc2 = MFMA32(*(const LAS bf16x8*)(cb + (ks + 1) * 1024), *(const LAS bf16x8*)(qa + (ks + 1) * 2048), acc2); }
#pragma unroll
                for (int i = 0; i < 16; ++i) acc[i] += acc2[i];
                qn = 0.f;
#pragma unroll
                for (int ch = 0; ch < 8; ++ch) { const u32x4 w = *(const LAS u32x4*)(qr + ch * 1024); const f32x4 n0 = *(const LAS f32x4*)(np + ch * 8), n1 = *(const LAS f32x4*)(np + ch * 8 + 4);
                    qn += bflo(w.x) * n0.x + bfhi(w.x) * n0.y + bflo(w.y) * n0.z + bfhi(w.y) * n0.w + bflo(w.z) * n1.x + bfhi(w.z) * n1.y + bflo(w.w) * n1.z + bfhi(w.w) * n1.w; }
                qn = xor32_sum(qn);
            }
            if (have_h) {
                LAS unsigned char* hst = HST + jt * 2048;
#pragma unroll
                for (int rg = 0; rg < 4; ++rg) *(LAS u32x2*)(hst + r32 * 64 + (8 * rg + 4 * hh) * 2) = hw[rg];
                asm volatile("s_waitcnt lgkmcnt(0)" ::: "memory");
#pragma unroll
                for (int q = 0; q < 2; ++q) { const int row = 16 * q + (lane >> 2), part = lane & 3;
                    const u32x4 w = *(const LAS u32x4*)(hst + row * 64 + part * 16);
                    *(u32x4*)(HD + (size_t)(cp * 64 + 32 * jt + row) * 512 + part * 8) = w; }
            }
        } else if (st < 64) {
            const int u = wid - 6; const float gm = gmv[c], sp = spv[c];
            const LAS unsigned char* va = VT + ktr; const LAS unsigned char* ka = KT + ktr + (2 * u) * 4096;
            s16x4 vlo[4], vhi[4], k0l[4], k0h[4], k1l[4], k1h[4]; f32x4 cw0[4], cw1[4];
#pragma unroll
            for (int ks = 0; ks < 4; ++ks) { vlo[ks] = trread(va + ks * 1024); vhi[ks] = trread(va + ks * 1024 + 256);
                cw0[ks] = *(const LAS f32x4*)(ct + 16 * ks + 8 * hh); cw1[ks] = *(const LAS f32x4*)(ct + 16 * ks + 8 * hh + 4);
                k0l[ks] = trread(ka + ks * 1024); k0h[ks] = trread(ka + ks * 1024 + 256); k1l[ks] = trread(ka + 4096 + ks * 1024); k1h[ks] = trread(ka + 4096 + ks * 1024 + 256); }
#pragma unroll
            for (int i = 0; i < 16; ++i) { Cacc[0][i] *= sp; Cacc[1][i] *= sp; }
#pragma unroll
            for (int ks = 0; ks < 4; ++ks) {
                const s16x4 lo = vlo[ks], hi = vhi[ks]; const f32x4 e0 = cw0[ks], e1 = cw1[ks];
                u32x4 af;
                af.x = pk2(bf2f((bf16_t)lo[0]) * __builtin_amdgcn_exp2f(e0.x + gm), bf2f((bf16_t)lo[1]) * __builtin_amdgcn_exp2f(e0.y + gm));
                af.y = pk2(bf2f((bf16_t)lo[2]) * __builtin_amdgcn_exp2f(e0.z + gm), bf2f((bf16_t)lo[3]) * __builtin_amdgcn_exp2f(e0.w + gm));
                af.z = pk2(bf2f((bf16_t)hi[0]) * __builtin_amdgcn_exp2f(e1.x + gm), bf2f((bf16_t)hi[1]) * __builtin_amdgcn_exp2f(e1.y + gm));
                af.w = pk2(bf2f((bf16_t)hi[2]) * __builtin_amdgcn_exp2f(e1.z + gm), bf2f((bf16_t)hi[3]) * __builtin_amdgcn_exp2f(e1.w + gm));
                const bf16x8 afr = __builtin_bit_cast(bf16x8, af);
                Cacc[0] = MFMA32(__builtin_shufflevector(k0l[ks], k0h[ks], 0, 1, 2, 3, 4, 5, 6, 7), afr, Cacc[0]);
                Cacc[1] = MFMA32(__builtin_shufflevector(k1l[ks], k1h[ks], 0, 1, 2, 3, 4, 5, 6, 7), afr, Cacc[1]);
            }
            LAS unsigned char* cw = CI + (s2 ^ 1) * 8192 + (2 * u) * 2048 + r32 * 16 + hh * 8;
#pragma unroll
            for (int t2 = 0; t2 < 2; ++t2)
#pragma unroll
                for (int rg = 0; rg < 4; ++rg) { u32x2 w; w.x = pk2(Cacc[t2][4 * rg], Cacc[t2][4 * rg + 1]); w.y = pk2(Cacc[t2][4 * rg + 2], Cacc[t2][4 * rg + 3]); *(LAS u32x2*)(cw + t2 * 2048 + rg * 512) = w; }
        }
        if (PROBE_MSEQ_W >= 0) { asm volatile("s_waitcnt lgkmcnt(0)" ::: "memory"); busy += __builtin_amdgcn_s_memtime() - tb0; }
        if (cwave) {
            if (st + 1 < 64) asm volatile("s_waitcnt vmcnt(4)" ::: "memory"); else asm volatile("s_waitcnt vmcnt(0)" ::: "memory");
            if (st < 64) {
                const int id = cslot0 + st, e = id / 6144, r = id % 6144, mat = r >> 11, rr = r & 2047;
                const int nb = mat == 2 ? (rr >> 7) : (rr >> 6), kb = mat == 2 ? (rr & 127) : (rr & 63), n = 64 * nb + lane;
                unsigned char* dst = mat == 2 ? a.ws + WS_WDT + (size_t)e * DM * DFF + (size_t)n * DFF + 16 * kb
                                              : a.ws + WS_WGUT + (size_t)e * 4096 * DM + (size_t)((n >> 7) * 256 + (n & 127) + mat * 128) * DM + 16 * kb;
                const LAS float* CSC = (const LAS float*)(F.lds + 119808 + cwi * 8192 + (id & 1) * 4096);
                float cv[16];
#pragma unroll
                for (int k = 0; k < 16; ++k) cv[k] = CSC[k * 64 + lane] * pg8::W_PRESCALE;
                u32x4 o; o.x = pg8::pk4_fp8(cv[0], cv[1], cv[2], cv[3]); o.y = pg8::pk4_fp8(cv[4], cv[5], cv[6], cv[7]); o.z = pg8::pk4_fp8(cv[8], cv[9], cv[10], cv[11]); o.w = pg8::pk4_fp8(cv[12], cv[13], cv[14], cv[15]);
                *(u32x4*)dst = o;
            }
        } else if (wid == 6) asm volatile("s_waitcnt vmcnt(0)" ::: "memory");
        asm volatile("s_waitcnt lgkmcnt(0)" ::: "memory"); __builtin_amdgcn_s_barrier(); asm volatile("" ::: "memory");
        if (PROBE_MSEQ_W >= 0) tb0 = __builtin_amdgcn_s_memtime();
    }
    if (PROBE_MSEQ_W >= 0 && F.bid == 0 && lane == 0 && (wid == PROBE_MSEQ_W || (PROBE_MSEQ_W == 8 && wid == 0)))
        *(volatile LAS unsigned long long*)(F.lds + LDS_BYTES - 128) = (PROBE_MSEQ_W == 8) ? (__builtin_amdgcn_s_memtime() - titem0) : busy;
    asm volatile("s_waitcnt vmcnt(0)" ::: "memory");
#undef MSEQ_ISSUE_QK
#undef MSEQ_ISSUE_VS
#undef MSEQ_CONV_ISSUE
}

DI void glds16(const void* g, LAS unsigned char* l) { __builtin_amdgcn_global_load_lds((const unsigned*)g, (LAS unsigned*)l, 16, 0, 0); }
DI void attn_unit(const Ctx& F, const Args& a, int b, int h, int qb, float lam, float cshift) {
    const int lane = F.lane, wid = F.wave, r32 = lane & 31, hh = lane >> 5, rg = wid & 3, p = wid >> 2;
    const bf16_t* projb = (const bf16_t*)(a.ws + WS_PROJ) + (size_t)b * SEQ * PS;
    const int qrow = qb * 128 + rg * 32 + r32;
    bf16x8 qf[4];
    { const bf16_t* qp = projb + (size_t)qrow * PS + C_QA + h * 128 + p * 64 + hh * 8;
#pragma unroll
      for (int ks = 0; ks < 4; ++ks) qf[ks] = *(const bf16x8*)(qp + ks * 16); }
    const bf16_t* kimg = (const bf16_t*)(a.ws + WS_KIMG) + (size_t)(b * 4 + h) * 64 * 8192 + (4 * wid) * 512 + lane * 8;
    const bf16_t* vimg = (const bf16_t*)(a.ws + WS_VIMG) + (size_t)(b * 4 + h) * 64 * 8192 + (4 * wid) * 512 + lane * 8;
    const unsigned ldsw = (unsigned)__builtin_amdgcn_readfirstlane((int)(unsigned)(uintptr_t)F.lds + (4 * wid) * 1024);
#define ATT_ISSUE2(img, t0, ldsoff) do { const int _q0 = 4 * wid; const int _t = (t0) + (_q0 >> 4); const bf16_t* _tp = (img) + (size_t)(_t < 64 ? _t : 63) * 8192 - (size_t)(_q0 & 16) * 512; \
        const unsigned _d = (unsigned)__builtin_amdgcn_readfirstlane((int)(ldsw + (ldsoff))); \
        _Pragma("unroll") for (int _i = 0; _i < 4; ++_i) glds16_asm(_tp + _i * 512, _d + _i * 1024); } while (0)
    if (wid < 4) { const bf16_t* _tp = kimg; const unsigned _d = (unsigned)__builtin_amdgcn_readfirstlane((int)(ldsw + 32768));
#pragma unroll
        for (int _i = 0; _i < 4; ++_i) glds16_asm(_tp + _i * 512, _d + _i * 1024); }
    ATT_ISSUE2(kimg, 1, 0); ATT_ISSUE2(vimg, 0, 65536);
    f32x16 O[4];
#pragma unroll
    for (int vt = 0; vt < 4; ++vt)
#pragma unroll
        for (int i = 0; i < 16; ++i) O[vt][i] = 0.f;
    float lsum = 0.f;
    const int kfb = p * 8192 + hh * 1024 + r32 * 16;
    const int vfb = (4 * hh + ((lane & 15) >> 2)) * 64 + ((lane >> 4) & 1) * 32 + (lane & 3) * 8;
    bf16x8 pb[4], pc[4];
    asm volatile("s_waitcnt vmcnt(0)" ::: "memory");
    __syncthreads();
#define ATT_VLOAD(dst, Vb, kg) do { _Pragma("unroll") for (int vt = 0; vt < 4; ++vt) { \
        const s16x4 _lo = trread((Vb) + vt * 4096 + (kg) * 1024), _hi = trread((Vb) + vt * 4096 + (kg) * 1024 + 512); dst[vt] = __builtin_shufflevector(_lo, _hi, 0, 1, 2, 3, 4, 5, 6, 7); } } while (0)
#define ATT_PV(vf, kg, PIN) do { __builtin_amdgcn_s_setprio(1); _Pragma("unroll") for (int vt = 0; vt < 4; ++vt) O[vt] = MFMA32(vf[vt], PIN[kg], O[vt]); __builtin_amdgcn_s_setprio(0); } while (0)
#define ATT_EXPQ(S, o, dst) do { float _e[8]; _Pragma("unroll") for (int i = 0; i < 8; ++i) _e[i] = __builtin_amdgcn_exp2f(S[(o) + i]); \
        _Pragma("unroll") for (int i = 0; i < 8; ++i) ls = ls + _e[i]; \
        u32x4 _w; _w.x = pk2(_e[0], _e[1]); _w.y = pk2(_e[2], _e[3]); _w.z = pk2(_e[4], _e[5]); _w.w = pk2(_e[6], _e[7]); dst = __builtin_bit_cast(bf16x8, _w); } while (0)
#define ATT_STEP(Kb, Vb, on0, PIN, POUT) do { \
        bf16x8 kfa[4], kfb2[4], vA[4], vB[4]; float ls = 0.f; \
        _Pragma("unroll") for (int ks = 0; ks < 4; ++ks) { kfa[ks] = *(const LAS bf16x8*)((Kb) + ks * 2048); kfb2[ks] = *(const LAS bf16x8*)((Kb) + ks * 2048 + 512); } \
        ATT_VLOAD(vA, Vb, 0); \
        __builtin_amdgcn_s_setprio(1); \
        Sa = MFMA32(kfa[0], qf[0], negc); Sb = MFMA32(kfb2[0], qf[0], negc);        \
        _Pragma("unroll") for (int ks = 1; ks < 4; ++ks) { Sa = MFMA32(kfa[ks], qf[ks], Sa); Sb = MFMA32(kfb2[ks], qf[ks], Sb); } \
        __builtin_amdgcn_s_setprio(0); \
        ATT_VLOAD(vB, Vb, 1); ATT_PV(vA, 0, PIN); ATT_EXPQ(Sa, 0, POUT[0]); \
        ATT_VLOAD(vA, Vb, 2); ATT_PV(vB, 1, PIN); ATT_EXPQ(Sa, 8, POUT[1]); \
        ATT_VLOAD(vB, Vb, 3); ATT_PV(vA, 2, PIN); ATT_EXPQ(Sb, 0, POUT[2]); \
        ATT_PV(vB, 3, PIN); ATT_EXPQ(Sb, 8, POUT[3]); \
        lsum += (on0) ? ls : 0.f; } while (0)
    f32x16 Sa, Sb, negc;
#pragma unroll
    for (int i = 0; i < 16; ++i) negc[i] = -cshift;
    asm volatile("" : "+v"(negc));
    {
        const LAS unsigned char* Kb = F.lds + 32768 + kfb;
        Sa = MFMA32(*(const LAS bf16x8*)(Kb), qf[0], negc); Sb = MFMA32(*(const LAS bf16x8*)(Kb + 512), qf[0], negc);
#pragma unroll
        for (int ks = 1; ks < 4; ++ks) { Sa = MFMA32(*(const LAS bf16x8*)(Kb + ks * 2048), qf[ks], Sa); Sb = MFMA32(*(const LAS bf16x8*)(Kb + ks * 2048 + 512), qf[ks], Sb); }
        float ls = 0.f;
        ATT_EXPQ(Sa, 0, pb[0]); ATT_EXPQ(Sa, 8, pb[1]); ATT_EXPQ(Sb, 0, pb[2]); ATT_EXPQ(Sb, 8, pb[3]);
        lsum += ls;
    }
    __syncthreads();
#pragma unroll 1
    for (int T = 0; T < 32; ++T) {
        const int j = T & 1;
        ATT_ISSUE2(kimg, 2 * T + 3, (j ^ 1) * 32768);
        ATT_ISSUE2(vimg, 2 * T + 2, 65536 + (j ^ 1) * 32768);
        const LAS unsigned char* Ks = F.lds + j * 32768 + kfb; const LAS unsigned char* Vs = F.lds + 65536 + j * 32768 + vfb;
        ATT_STEP(Ks, Vs, true, pb, pc);
        ATT_STEP(Ks + 16384, Vs + 16384, T < 31, pc, pb);
        asm volatile("s_waitcnt vmcnt(0)" ::: "memory");
        __syncthreads();
    }
#undef ATT_EXPQ
#undef ATT_STEP
#undef ATT_VLOAD
#undef ATT_PV
#undef ATT_ISSUE2
    lsum += __shfl_xor(lsum, 32);
    LAS float* X = (LAS float*)(F.lds + 65536) + rg * 4096 + r32;
    if (p == 1) {
        const float sc = lam / lsum;
#pragma unroll
        for (int vt = 0; vt < 4; ++vt)
#pragma unroll
            for (int i = 0; i < 16; ++i) X[(32 * vt + crow(i, hh)) * 32] = O[vt][i] * sc;
    }
    __syncthreads();
    if (p == 0) {
        const float i0 = 1.f / lsum;
        float ssq = 0.f;
#pragma unroll
        for (int vt = 0; vt < 4; ++vt)
#pragma unroll
            for (int i = 0; i < 16; ++i) { const float o = O[vt][i] * i0 - X[(32 * vt + crow(i, hh)) * 32]; O[vt][i] = o; ssq += o * o; }
        ssq += __shfl_xor(ssq, 32);
        const float rs = rsqrtf(ssq * (1.f / 128.f) + EPS) * 0.8f;
        bf16_t* yp = (bf16_t*)(a.ws + WS_YMIX) + (size_t)(b * SEQ + qrow) * DM + 512 + h * 128;
#pragma unroll
        for (int vt = 0; vt < 4; ++vt)
#pragma unroll
            for (int rgi = 0; rgi < 4; ++rgi) { const int vd = 32 * vt + 8 * rgi + 4 * hh; const f32x4 g = *(const f32x4*)(a.subln_g + vd);
                u32x2 w; w.x = pk2(O[vt][4 * rgi] * rs * g.x, O[vt][4 * rgi + 1] * rs * g.y); w.y = pk2(O[vt][4 * rgi + 2] * rs * g.z, O[vt][4 * rgi + 3] * rs * g.w);
                *(u32x2*)(yp + vd) = w; }
    }
    __syncthreads();
}

DI void mcombine_phase(const Ctx& F, const Args& a) {
    const int gw = F.bid * NWAVES + F.wave, NGW = F.G * NWAVES, lane = F.lane;
    const bf16_t* HD = (const bf16_t*)((const unsigned char*)a.out + DO_HD);
    float g[8];
#pragma unroll
    for (int i = 0; i < 8; ++i) g[i] = a.mnorm_g[lane * 8 + i];
    for (int m = gw; m < MTOK; m += NGW) {
        const u32x4 f = *(const u32x4*)(HD + (size_t)m * 512 + lane * 8), bw = *(const u32x4*)(HD + ((size_t)MTOK + m) * 512 + lane * 8);
        const u32x4 om = *(const u32x4*)((const bf16_t*)(a.ws + WS_PROJ) + (size_t)m * PS + C_OM + lane * 8);
        float v[8];
        v[0] = bflo(f.x) + bflo(bw.x); v[1] = bfhi(f.x) + bfhi(bw.x); v[2] = bflo(f.y) + bflo(bw.y); v[3] = bfhi(f.y) + bfhi(bw.y);
        v[4] = bflo(f.z) + bflo(bw.z); v[5] = bfhi(f.z) + bfhi(bw.z); v[6] = bflo(f.w) + bflo(bw.w); v[7] = bfhi(f.w) + bfhi(bw.w);
        float ss = 0.f;
#pragma unroll
        for (int i = 0; i < 8; ++i) ss += v[i] * v[i];
        ss += __shfl_xor(ss, 1); ss += __shfl_xor(ss, 2); ss += __shfl_xor(ss, 4); ss += __shfl_xor(ss, 8);
        const float rstd = rsqrtf(ss * (1.f / 128.f) + EPS);
        float o[8];
        o[0] = bflo(om.x); o[1] = bfhi(om.x); o[2] = bflo(om.y); o[3] = bfhi(om.y); o[4] = bflo(om.z); o[5] = bfhi(om.z); o[6] = bflo(om.w); o[7] = bfhi(om.w);
#pragma unroll
        for (int i = 0; i < 8; ++i) v[i] = v[i] * rstd * g[i] * sigmoid_f(o[i]);
        u32x4 w; w.x = pk2(v[0], v[1]); w.y = pk2(v[2], v[3]); w.z = pk2(v[4], v[5]); w.w = pk2(v[6], v[7]);
        bf16_t* yp = (bf16_t*)(a.ws + WS_YMIX) + (size_t)m * DM + lane * 8;
        *(u32x4*)yp = w;
    }
}

DI void router_finish(const float (&lg)[16], int lane, float* affrow, bool store) {
    float r8[8];
#pragma unroll
    for (int i = 0; i < 8; ++i) { const float keep = hh_sel(lane, 32) ? lg[8 + i] : lg[i], send = hh_sel(lane, 32) ? lg[i] : lg[8 + i]; r8[i] = keep + partner32(send, lane); }
    float r4[4];
#pragma unroll
    for (int i = 0; i < 4; ++i) { const float keep = hh_sel(lane, 16) ? r8[4 + i] : r8[i], send = hh_sel(lane, 16) ? r8[i] : r8[4 + i]; r4[i] = keep + partner16(send, lane); }
    float r2[2];
#pragma unroll
    for (int i = 0; i < 2; ++i) { const float keep = hh_sel(lane, 8) ? r4[2 + i] : r4[i], send = hh_sel(lane, 8) ? r4[i] : r4[2 + i]; r2[i] = keep + partner8(send); }
    float lgt; { const float keep = hh_sel(lane, 4) ? r2[1] : r2[0], send = hh_sel(lane, 4) ? r2[0] : r2[1]; lgt = keep + partner4(send, lane); }
    lgt += dpp_mov<DPP_XOR2>(lgt); lgt += dpp_mov<DPP_XOR1>(lgt);
    float mx = lgt; mx = fmaxf(mx, dpp_mov<DPP_ROR(8)>(mx)); mx = fmaxf(mx, dpp_mov<DPP_ROR(4)>(mx)); mx = xor16_max(mx); mx = xor32_max(mx);
    const float ex = __expf(lgt - mx); float sm = ex; sm += dpp_mov<DPP_ROR(8)>(sm); sm += dpp_mov<DPP_ROR(4)>(sm); sm = xor16_sum(sm); sm = xor32_sum(sm);
    if ((lane & 3) == 0 && store) affrow[lane >> 2] = ex / sm;
}
DI void p7_phase(const Ctx& F, const Args& a) {
    LAS f32x4* WRL = (LAS f32x4*)F.lds;
    for (int q = F.tid; q < 4096; q += NTHR) { const int k = q >> 2, g = q & 3; WRL[(g * 4 + (k & 3)) * 256 + ((k >> 2) & 63) + 64 * (k >> 8)] = *(const f32x4*)(a.w_router + k * 16 + g * 4); }
    __syncthreads();
    const int gw = F.bid * NWAVES + F.wave, NGW = F.G * NWAVES, lane = F.lane;
    const float* mod = (const float*)(a.ws + WS_MOD);
    unsigned char* H2 = a.ws + WS_H2; float* AFF = (float*)(a.ws + WS_AFF);
    for (int m = gw; m < MTOK; m += NGW) {
        const int b = m / SEQ;
        const u32x2* xr = (const u32x2*)((const bf16_t*)(a.ws + WS_X1B) + (size_t)m * DM) + lane;
        f32x4 v[4]; float s = 0.f;
#pragma unroll
        for (int j = 0; j < 4; ++j) { const u32x2 w = xr[64 * j]; v[j].x = bflo(w.x); v[j].y = bfhi(w.x); v[j].z = bflo(w.y); v[j].w = bfhi(w.y);
            s += (v[j].x * v[j].x + v[j].y * v[j].y) + (v[j].z * v[j].z + v[j].w * v[j].w); }
        const float rstd = rsqrtf(wave_sum(s) * (1.f / DM) + EPS);
        float lg[16];
#pragma unroll
        for (int e = 0; e < 16; ++e) lg[e] = 0.f;
        unsigned* o4 = (unsigned*)(H2 + (size_t)m * DM) + lane;
#pragma unroll
        for (int j = 0; j < 4; ++j) {
            const f32x4 g = ((const f32x4*)a.norm2_g)[lane + 64 * j];
            const f32x4 sh = ((const f32x4*)(mod + (size_t)b * 6144 + 3072))[lane + 64 * j];
            const f32x4 sc = ((const f32x4*)(mod + (size_t)b * 6144 + 4096))[lane + 64 * j];
            const f32x4 hv = v[j] * rstd * g * (sc + 1.f) + sh;
            o4[64 * j] = pg8::pk4_fp8(hv.x, hv.y, hv.z, hv.w);
#pragma unroll
            for (int e = 0; e < 4; ++e) { const float he = hv[e];
#pragma unroll
                for (int g4 = 0; g4 < 4; ++g4) { const f32x4 w = WRL[(g4 * 4 + e) * 256 + lane + 64 * j];
                    lg[g4 * 4 + 0] += he * w.x; lg[g4 * 4 + 1] += he * w.y; lg[g4 * 4 + 2] += he * w.z; lg[g4 * 4 + 3] += he * w.w; } }
            __builtin_amdgcn_sched_barrier(0);
        }
        router_finish(lg, lane, AFF + (size_t)m * 16, true);
    }
    __syncthreads();
}

DI void topk_task(const Ctx& F, const Args& a, int task) {
    const int b = task >> 4, e = task & 15, tid = F.tid, lane = F.lane;
    const float* AFF = (const float*)(a.ws + WS_AFF) + (size_t)b * SEQ * 16 + e;
    LAS unsigned* hist = (LAS unsigned*)F.lds;
    LAS unsigned* sfx = hist + 256;
    LAS unsigned* misc = hist + 512;
    LAS int* lidx = (LAS int*)(F.lds + 4096);
    unsigned key[8];
#pragma unroll
    for (int i = 0; i < 8; ++i) key[i] = __float_as_uint(AFF[(size_t)(tid * 8 + i) * 16]);
    unsigned prefix = 0, krem = CAP;
#pragma unroll 1
    for (int pass = 0; pass < 4; ++pass) {
        const int shift = 24 - 8 * pass;
        if (tid < 256) hist[tid] = 0;
        __syncthreads();
#pragma unroll
        for (int i = 0; i < 8; ++i) { const bool in = pass == 0 ? true : ((key[i] >> (shift + 8)) == (prefix >> (shift + 8))); if (in) atomicAdd((unsigned*)&hist[(key[i] >> shift) & 255u], 1u); }
        __syncthreads();
        if (tid < 256) sfx[tid] = hist[tid];
        __syncthreads();
#pragma unroll 1
        for (int o = 1; o < 256; o <<= 1) { unsigned v = 0; if (tid < 256) v = sfx[tid] + (tid + o < 256 ? sfx[tid + o] : 0u); __syncthreads(); if (tid < 256) sfx[tid] = v; __syncthreads(); }
        if (tid < 256) { const unsigned incl = sfx[tid], excl = incl - hist[tid]; if (excl < krem && krem <= incl) { misc[0] = (unsigned)tid; misc[1] = krem - excl; } }
        __syncthreads();
        prefix |= misc[0] << shift; krem = misc[1];
        __syncthreads();
    }
    const unsigned T = prefix, need = krem;
    unsigned cg_ = 0, ce = 0;
#pragma unroll
    for (int i = 0; i < 8; ++i) { cg_ += key[i] > T; ce += key[i] == T; }
    unsigned sg = cg_, se = ce;
#pragma unroll
    for (int o = 1; o < 64; o <<= 1) { const unsigned tg = __shfl_up(sg, o), te = __shfl_up(se, o); if (lane >= o) { sg += tg; se += te; } }
    if (lane == 63) { misc[16 + F.wave] = sg; misc[32 + F.wave] = se; }
    __syncthreads();
    unsigned og = sg - cg_, oe = se - ce;
    for (int w = 0; w < F.wave; ++w) { og += misc[16 + w]; oe += misc[32 + w]; }
    int* SLOT = (int*)(a.ws + WS_SLOT) + (size_t)b * SEQ * 16 + e;
    float* VALS = (float*)(a.ws + WS_VALS) + (size_t)(e * 8 + b) * CAP;
    int* IDX = (int*)(a.ws + WS_IDX) + (size_t)(b * 16 + e) * CAP;
#pragma unroll
    for (int i = 0; i < 8; ++i) {
        const bool gt = key[i] > T, eq = key[i] == T; const bool sel = gt || (eq && oe < need);
        const unsigned pos = og + (oe < need ? oe : need);
        const int s = tid * 8 + i;
        SLOT[(size_t)s * 16] = sel ? (int)pos : -1;
        if (sel) { lidx[pos] = s; IDX[pos] = s; VALS[pos] = __uint_as_float(key[i]); }
        og += gt; oe += eq;
    }
    __syncthreads();
    const unsigned char* H2 = a.ws + WS_H2 + (size_t)b * SEQ * DM; unsigned char* XE = a.ws + WS_XE + (size_t)(e * 8 + b) * CAP * DM;
    for (int r0 = F.wave * 4; r0 < CAP; r0 += NWAVES * 4) { u32x4 v[4];
#pragma unroll
        for (int j = 0; j < 4; ++j) v[j] = ((const u32x4*)(H2 + (size_t)lidx[r0 + j] * DM))[lane];
#pragma unroll
        for (int j = 0; j < 4; ++j) ((u32x4*)(XE + (size_t)(r0 + j) * DM))[lane] = v[j]; }
    __syncthreads();
}

DI void final_phase(const Ctx& F, const Args& a) {
    const int gw = F.bid * NWAVES + F.wave, NGW = F.G * NWAVES, lane = F.lane;
    const float* mod = (const float*)(a.ws + WS_MOD); const int* SLOT = (const int*)(a.ws + WS_SLOT); const unsigned char* Y = a.ws + WS_Y;
    for (int m = gw; m < MTOK; m += NGW) {
        const int b = m / SEQ;
        const int sl = SLOT[(size_t)m * 16 + (lane & 15)];
        f32x4* op = (f32x4*)(a.out + (size_t)m * DM + lane * 16);
        f32x4 xv[4];
        { const u32x4* xp = (const u32x4*)((const bf16_t*)(a.ws + WS_X1B) + (size_t)m * DM + lane * 16); const u32x4 w0 = xp[0], w1 = xp[1];
          xv[0].x = bflo(w0.x); xv[0].y = bfhi(w0.x); xv[0].z = bflo(w0.y); xv[0].w = bfhi(w0.y); xv[1].x = bflo(w0.z); xv[1].y = bfhi(w0.z); xv[1].z = bflo(w0.w); xv[1].w = bfhi(w0.w);
          xv[2].x = bflo(w1.x); xv[2].y = bfhi(w1.x); xv[2].z = bflo(w1.y); xv[2].w = bfhi(w1.y); xv[3].x = bflo(w1.z); xv[3].y = bfhi(w1.z); xv[3].z = bflo(w1.w); xv[3].w = bfhi(w1.w); }
        float acc[16];
#pragma unroll
        for (int i = 0; i < 16; ++i) acc[i] = 0.f;
#pragma unroll 1
        for (int e = 0; e < 16; ++e) { const int s = __shfl(sl, e);
            if (s >= 0) { const u32x4 w = *(const u32x4*)(Y + ((size_t)(e * 8 + b) * CAP + s) * DM + lane * 16);
#pragma unroll
                for (int q = 0; q < 4; ++q) { const unsigned ww = w[q];
                    const auto lo = __builtin_amdgcn_cvt_pk_f32_fp8((int)ww, false), hi = __builtin_amdgcn_cvt_pk_f32_fp8((int)ww, true);
                    acc[4 * q] += lo[0]; acc[4 * q + 1] += lo[1]; acc[4 * q + 2] += hi[0]; acc[4 * q + 3] += hi[1]; } } }
        const f32x4* gp = (const f32x4*)(mod + (size_t)b * 6144 + 5120 + lane * 16);
#pragma unroll
        for (int q = 0; q < 4; ++q) { const f32x4 g = gp[q] * (1.f / pg8::Y_PRESCALE); f32x4 o = xv[q]; o.x += g.x * acc[4 * q]; o.y += g.y * acc[4 * q + 1]; o.z += g.z * acc[4 * q + 2]; o.w += g.w * acc[4 * q + 3]; op[q] = o; }
    }
}

#define XB_TMO      128
#define XB_XCNT(j)  (256  + 64 * (j))
#define XB_XSUB(j)  (1280 + 64 * (j))
#define XB_XGEN(j)  (2304 + 64 * (j))
#define XB_TOP      3328
#define XB_TOPGEN   3392
#define XB_SPIN_CAP (1u << 18)
DI unsigned xb_ld(unsigned* p)              { return __hip_atomic_load(p, __ATOMIC_RELAXED, __HIP_MEMORY_SCOPE_AGENT); }
DI unsigned xb_add(unsigned* p, unsigned v) { return __hip_atomic_fetch_add(p, v, __ATOMIC_RELAXED, __HIP_MEMORY_SCOPE_AGENT); }
DI unsigned xb_xcc_id() { return (unsigned)__builtin_amdgcn_s_getreg((3 << 11) | 20) & 0xFu; }
#define XB_SPIN(cond, bar) do { unsigned _sp = 0; while (cond) { __builtin_amdgcn_s_sleep(1); \
    if ((++_sp & 255u) == 0u) { if (xb_ld(&(bar)[XB_TMO])) break; if (_sp > XB_SPIN_CAP) { atomicAdd(&(bar)[XB_TMO], 1u); break; } } } } while (0)
struct XcdBarrier { unsigned* bar; unsigned x; volatile LAS unsigned* st; };
DI XcdBarrier xcd_barrier_post(unsigned* bar, volatile LAS unsigned* st) {
    XcdBarrier b; b.bar = bar; b.x = xb_xcc_id(); b.st = st;
    if (threadIdx.x == 0) (void)xb_add(&bar[XB_XCNT(b.x)], 1u);
    return b;
}
DI void xcd_barrier_complete(unsigned* bar, unsigned x, unsigned& nloc, unsigned& nx) {
    const unsigned G = gridDim.x * gridDim.y * gridDim.z;
    unsigned sum, cnt, mine, sp = 0u;
    for (;;) {
        sum = 0u; cnt = 0u; mine = 0u;
#pragma unroll
        for (unsigned j = 0; j < 16; ++j) { const unsigned c = xb_ld(&bar[XB_XCNT(j)]); sum += c; cnt += (c > 0u) ? 1u : 0u; mine = (j == x) ? c : mine; }
        if (sum == G) break;
        __builtin_amdgcn_s_sleep(1);
        if ((++sp & 255u) == 0u) { if (xb_ld(&bar[XB_TMO])) break; if (sp > XB_SPIN_CAP) { atomicAdd(&bar[XB_TMO], 1u); break; } }
    }
    nloc = mine > 0u ? mine : 1u; nx = cnt > 0u ? cnt : 1u;
}
DI void xcd_barrier(const XcdBarrier& b) {
    asm volatile("s_waitcnt vmcnt(0)" ::: "memory");
    __syncthreads();
    if (threadIdx.x == 0) {
        unsigned* bar = b.bar;
        __builtin_amdgcn_s_waitcnt(0);
        unsigned nloc = b.st[0], nx = b.st[1];
        if (nloc == 0u) { xcd_barrier_complete(bar, b.x, nloc, nx); b.st[0] = nloc; b.st[1] = nx; }
        const unsigned old = xb_add(&bar[XB_XSUB(b.x)], 1u);
        const unsigned gen = old / nloc;
        if (old + 1u == (gen + 1u) * nloc) {
            __builtin_amdgcn_fence(__ATOMIC_RELEASE, "agent");
            asm volatile("s_waitcnt vmcnt(0)" ::: "memory");
            const unsigned og = xb_add(&bar[XB_TOP], 1u);
            const unsigned tg = og / nx;
            if (og + 1u == (tg + 1u) * nx) xb_add(&bar[XB_TOPGEN], 1u);
            else XB_SPIN(xb_ld(&bar[XB_TOPGEN]) == tg, bar);
            __builtin_amdgcn_fence(__ATOMIC_ACQUIRE, "agent");
            xb_add(&bar[XB_XGEN(b.x)], 1u);
            asm volatile("s_waitcnt vmcnt(0)" ::: "memory");
        } else {
            XB_SPIN(xb_ld(&bar[XB_XGEN(b.x)]) == gen, bar);
            __builtin_amdgcn_fence(__ATOMIC_ACQUIRE, "agent");
            asm volatile("s_waitcnt vmcnt(0)" ::: "memory");
        }
    }
    __syncthreads();
}

static_assert(sizeof(Args) == 22 * 8, "Args layout");
__global__ void __launch_bounds__(NTHR, 2) fwd_kernel(Args a_unused) {
    extern __shared__ __attribute__((aligned(16))) unsigned char lds_raw[];
    cg::grid_group grid = cg::this_grid();
    Ctx F; F.lds = (LAS unsigned char*)lds_raw; F.tid = threadIdx.x; F.lane = F.tid & 63; F.wave = __builtin_amdgcn_readfirstlane(F.tid >> 6); F.G = gridDim.x; F.bid = blockIdx.x;

    int lo, hi; { typedef __attribute__((address_space(4))) const volatile unsigned long long* kp_t; const unsigned long long ph = ((kp_t)__builtin_amdgcn_kernarg_segment_ptr())[21]; lo = (int)(unsigned)ph; hi = (int)(unsigned)(ph >> 32); }
#ifndef PHASE_MASK
#define PHASE_MASK 0xffff
#endif
#define IN(k) (((PHASE_MASK >> (k)) & 1) && lo <= (k) && (k) < hi)
    volatile LAS unsigned* bst = (volatile LAS unsigned*)(F.lds + LDS_BYTES - 64);
    if (F.tid < 2) bst[F.tid] = 0u;
    __syncthreads();
    XcdBarrier xbar;
    { const Args a0 = load_args(); xbar = xcd_barrier_post((unsigned*)(a0.ws + WS_CTL), bst); }
    volatile LAS unsigned long long* tsl = (volatile LAS unsigned long long*)(F.lds + LDS_BYTES - 256);
    if (PROBE_PHASE >= 0 && F.bid == 0 && F.tid == 0) tsl[0] = __builtin_amdgcn_s_memrealtime();
#define SEAM(k) do { if (IN(k) && IN((k) + 1)) { xcd_barrier(xbar); } \
        if (PROBE_PHASE >= 0 && F.bid == 0 && F.tid == 0) tsl[(k) + 1] = __builtin_amdgcn_s_memrealtime(); } while (0)
    grid.sync();
    if (IN(0)) { const Args a = load_args(); p0_phase(F, a); p1_phase(F, a); }
    if (PROBE_PHASE >= 0 && F.bid == 0 && F.tid == 0) tsl[1] = __builtin_amdgcn_s_memrealtime();
    SEAM(1);
    if (IN(2)) {
        const Args a = load_args();
        pg8::Gemm g{(const bf16_t*)a.out, (const bf16_t*)(a.ws + WS_WINT), MTOK, PS, DM, 1 << 30}; pg8::StaticOrder S; S.init(MTOK, PS, F.G, F.bid);
        pg8::EpiProj E{(bf16_t*)(a.ws + WS_PROJ), a.pos, a.qk_g, (bf16_t*)(a.ws + WS_KIMG), (bf16_t*)(a.ws + WS_VIMG)};
        pg8::gemm_phase<pg8::EpiProj, true, true>(F.lds, g, S, E);
        gates_tasks(F, a);
    }
    SEAM(2);
    if (IN(3)) {
        const Args a = load_args();
        for (int t = F.bid * NWAVES + F.wave; t < MTOK / 8 * 2; t += F.G * NWAVES) conv_task(F, a, t);
        for (int t = F.bid; t < 64; t += F.G) mscal_task(F, a, t);
    }
    SEAM(3);
    if (IN(4)) {
        const Args a = load_args();
        {
#pragma unroll 1
            for (int rep = 0; rep < REP_MSEQ; ++rep)
#pragma unroll 1
            for (int it = F.bid; it < 256; it += F.G) { const int xcd_ = it & 7, j_ = it >> 3; mseq_item(F, a, it, xcd_ * 4 + (j_ >> 3), (j_ >> 2) & 1, j_ & 3); }
        }
        float lam, cshift;
        { const float p01 = wave_sum(a.lam_p[F.lane] * a.lam_p[64 + F.lane]), p23 = wave_sum(a.lam_p[128 + F.lane] * a.lam_p[192 + F.lane]);
          lam = __expf(p01) - __expf(p23) + 0.2f;
          const float gq = wave_max(fabsf(a.qk_g[F.lane])), gk = wave_max(fabsf(a.qk_g[64 + F.lane]));
          cshift = 8.f * gq * gk * 1.4426950408889634f * 1.02f; }
        const int xcd = F.bid & 7, j = F.bid >> 3;
#pragma unroll 1
        for (int rep = 0; rep < REP_ATT; ++rep)
        for (int i = 0; i * F.G < 1024; ++i) {
            int u;
            if (F.G == 256) u = (xcd * 4 + i) * 32 + j; else u = i * F.G + F.bid;
            if (u < 1024) attn_unit(F, a, u >> 7, (u >> 5) & 3, u & 31, lam, cshift);
        }
    }
    SEAM(4);
    if (IN(5)) { const Args a = load_args(); mcombine_phase(F, a); }
    SEAM(5);
    if (IN(6)) {
        const Args a = load_args();
        pg8::Gemm g{(const bf16_t*)(a.ws + WS_YMIX), (const bf16_t*)(a.ws + WS_WOUTT), MTOK, DM, DM, 1 << 30}; pg8::StaticOrder S; S.init(MTOK, DM, F.G, F.bid);
        pg8::EpiX1 E{a.x, (const float*)(a.ws + WS_MOD), (bf16_t*)(a.ws + WS_X1B)};
        pg8::gemm_phase<pg8::EpiX1, true, true>(F.lds, g, S, E);
    }
    SEAM(6);
    if (IN(7)) { const Args a = load_args();
#pragma unroll 1
        for (int rep = 0; rep < REP_P7; ++rep) p7_phase(F, a); }
    SEAM(7);
    if (IN(8)) { const Args a = load_args(); for (int t = F.bid; t < BATCH * NEXP; t += F.G) topk_task(F, a, t); }
    SEAM(8);
    if (IN(9)) {
        const Args a = load_args();
        pg8::Gemm g{(const bf16_t*)(a.ws + WS_XE), (const bf16_t*)(a.ws + WS_WGUT), NPAIR, 4096, DM, 16};
        pg8::StaticOrder S; S.init(NPAIR, 4096, F.G, F.bid);
        pg8::EpiGU E{a.ws + WS_HH};
#pragma unroll 1
        for (int rep = 0; rep < REP_UP; ++rep)
        pg8::gemm_phase<pg8::EpiGU, true, true, true>(F.lds, g, S, E);
    }
    SEAM(9);
    if (IN(10)) {
        const Args a = load_args();
        pg8::Gemm g{(const bf16_t*)(a.ws + WS_HH), (const bf16_t*)(a.ws + WS_WDT), NPAIR, DM, DFF, 16};
        pg8::StaticOrder S; S.init(NPAIR, DM, F.G, F.bid);
        pg8::EpiDown E{a.ws + WS_Y, (const float*)(a.ws + WS_VALS)};
        pg8::gemm_phase<pg8::EpiDown, true, true, true>(F.lds, g, S, E);
    }
    SEAM(10);
    if (IN(11)) { const Args a = load_args(); final_phase(F, a); }
    if (PROBE_MSEQ_W >= 0 && F.bid == 0 && F.tid == 0) {
        const unsigned long long d = *(volatile LAS unsigned long long*)(F.lds + LDS_BYTES - 128), t1 = __builtin_amdgcn_s_memtime();
        while (__builtin_amdgcn_s_memtime() - t1 < 3ull * d) __builtin_amdgcn_s_sleep(8);
    }
    if (PROBE_PHASE >= 0 && F.bid == 0 && F.tid == 0) {
        const unsigned long long t1 = __builtin_amdgcn_s_memrealtime();
        const unsigned long long d = (PROBE_PHASE == 11 ? t1 : tsl[PROBE_PHASE + 1]) - tsl[PROBE_PHASE];
        while (__builtin_amdgcn_s_memrealtime() - t1 < 3ull * d) __builtin_amdgcn_s_sleep(8);
    }
#undef IN
#undef SEAM
}

extern "C" void kernel_launch(void* const* d_in, const int* in_sizes, int n_in, void* d_out, int out_size, void* d_ws, size_t ws_size, hipStream_t stream) {
    static int grid_blocks = 0;
    if (!grid_blocks) {
        int dev = 0, cus = 0, per_cu = 0;
        (void)hipGetDevice(&dev);
        (void)hipDeviceGetAttribute(&cus, hipDeviceAttributeMultiprocessorCount, dev);
        (void)hipFuncSetAttribute((const void*)fwd_kernel, hipFuncAttributeMaxDynamicSharedMemorySize, LDS_BYTES);
        (void)hipOccupancyMaxActiveBlocksPerMultiprocessor(&per_cu, (const void*)fwd_kernel, NTHR, LDS_BYTES);
        if (per_cu < 1) per_cu = 1;
        grid_blocks = cus;
        if (ws_size < WS_END) fprintf(stderr, "kernel_launch: workspace too small: %zu < %zu\n", ws_size, (size_t)WS_END);
    }
    (void)hipMemsetAsync((char*)d_ws + WS_CTL, 0, CTL_ZERO_BYTES, stream);
    Args a{};
    a.x = (const float*)d_in[0]; a.c = (const float*)d_in[1]; a.pos = (const int*)d_in[2]; a.norm1_g = (const float*)d_in[3]; a.norm2_g = (const float*)d_in[4];
    a.w_ada = (const float*)d_in[5]; a.b_ada = (const float*)d_in[6]; a.w_in = (const float*)d_in[7]; a.conv_w = (const float*)d_in[8]; a.gate_b = (const float*)d_in[9];
    a.mnorm_g = (const float*)d_in[10]; a.qk_g = (const float*)d_in[11]; a.lam_p = (const float*)d_in[12]; a.subln_g = (const float*)d_in[13]; a.w_out = (const float*)d_in[14];
    a.w_router = (const float*)d_in[15]; a.w_gate = (const float*)d_in[16]; a.w_up = (const float*)d_in[17]; a.w_down = (const float*)d_in[18];
    a.out = (float*)d_out; a.ws = (unsigned char*)d_ws; a.ph_lo = 0; a.ph_hi = 12;
    void* args[] = {&a};
    hipError_t e = hipLaunchCooperativeKernel((const void*)fwd_kernel, dim3(grid_blocks), dim3(NTHR), args, LDS_BYTES, stream);
    if (e != hipSuccess) fprintf(stderr, "cooperative launch failed: %s (grid %d)\n", hipGetErrorString(e), grid_blocks);
}
```

```cpp
#include <hip/hip_runtime.h>
#include <hip/hip_cooperative_groups.h>
#include <cstdio>
#include <cstdint>
namespace cg = cooperative_groups;

#define LAS __attribute__((address_space(3)))
#define DI __device__ __forceinline__
typedef unsigned short bf16_t;
typedef short bf16x8 __attribute__((ext_vector_type(8)));
typedef short s16x4 __attribute__((ext_vector_type(4)));
typedef float f32x2 __attribute__((ext_vector_type(2)));
typedef float f32x4 __attribute__((ext_vector_type(4)));
typedef float f32x16 __attribute__((ext_vector_type(16)));
typedef unsigned u32x2 __attribute__((ext_vector_type(2)));
typedef unsigned u32x4 __attribute__((ext_vector_type(4)));
typedef __bf16 bf16x2_t __attribute__((ext_vector_type(2)));

constexpr int BATCH = 8, SEQ = 4096, DM = 1024, MTOK = BATCH * SEQ;
constexpr int DIN = 3600, PS = 3584;
constexpr int NEXP = 16, CAP = 512, DFF = 2048;
constexpr int NPAIR = BATCH * NEXP * CAP;
constexpr float EPS = 1e-6f;
constexpr int C_QM = 0, C_KM = 512, C_VM = 1024, C_OM = 1536, C_QA = 2048, C_KA = 2560, C_VA = 3072;

constexpr size_t MiB = 1u << 20;
constexpr size_t WS_CTL = 0;
constexpr int CTL_ZERO_BYTES = 65536;
constexpr size_t WS_MOD = 1 * MiB;
constexpr size_t WS_GATES = 2 * MiB;
constexpr size_t WS_AFF = 4 * MiB;
constexpr size_t WS_IDX = 6 * MiB;
constexpr size_t WS_VALS = 6 * MiB + 256 * 1024;
constexpr size_t WS_MSC = 6 * MiB + 512 * 1024;
constexpr size_t WS_SLOT = 7 * MiB;
constexpr size_t WS_NLOC = 9 * MiB;
constexpr size_t WS_WINT = 11 * MiB;
constexpr size_t WS_WGT = 18 * MiB;
constexpr size_t WS_WOUTT = 19 * MiB;
constexpr size_t WS_WGUT = 21 * MiB;
constexpr size_t WS_WDT = 85 * MiB;
constexpr size_t WS_Y = 117 * MiB;
constexpr size_t WS_PROJ = 213 * MiB;
constexpr size_t WS_YMIX = 117 * MiB;
constexpr size_t WS_KIMG = 437 * MiB;
constexpr size_t WS_VIMG = 469 * MiB;
constexpr size_t WS_HH = 245 * MiB;
constexpr size_t WS_H2 = 437 * MiB;
constexpr size_t WS_X1B = 373 * MiB;
constexpr size_t WS_END = 533 * MiB;

constexpr int LDS_BYTES = 163840;
constexpr int PROBE_MSEQ_W = -1;
constexpr int PROBE_PHASE = -1;
constexpr int REP_M1 = 1, REP_M3 = 1, REP_UP = 1, REP_P0 = 1, REP_SCAN = 1, REP_P7 = 1, REP_ATT = 1, REP_QKT = 1, REP_MSEQ = 1;
constexpr int NWAVES = 8, NTHR = 512;

DI unsigned pk2(float lo, float hi) { f32x2 v = {lo, hi}; bf16x2_t b = __builtin_convertvector(v, bf16x2_t); return __builtin_bit_cast(unsigned, b); }
DI float bflo(unsigned w) { return __uint_as_float(w << 16); }
DI float bfhi(unsigned w) { return __uint_as_float(w & 0xffff0000u); }
DI float bf2f(bf16_t v) { return __uint_as_float((unsigned)v << 16); }
template <int CTRL> DI float dpp_mov(float x) { return __builtin_bit_cast(float, __builtin_amdgcn_update_dpp(0, __builtin_bit_cast(int, x), CTRL, 0xf, 0xf, false)); }
#define DPP_XOR1 0xB1
#define DPP_XOR2 0x4E
#define DPP_ROR(n) (0x120 + (n))
DI float xor16_sum(float x) { const unsigned u = __builtin_bit_cast(unsigned, x); auto r = __builtin_amdgcn_permlane16_swap(u, u, false, false); return __builtin_bit_cast(float, (unsigned)r[0]) + __builtin_bit_cast(float, (unsigned)r[1]); }
DI float xor32_sum(float x) { const unsigned u = __builtin_bit_cast(unsigned, x); auto r = __builtin_amdgcn_permlane32_swap(u, u, false, false); return __builtin_bit_cast(float, (unsigned)r[0]) + __builtin_bit_cast(float, (unsigned)r[1]); }
DI float xor16_max(float x) { const unsigned u = __builtin_bit_cast(unsigned, x); auto r = __builtin_amdgcn_permlane16_swap(u, u, false, false); return fmaxf(__builtin_bit_cast(float, (unsigned)r[0]), __builtin_bit_cast(float, (unsigned)r[1])); }
DI float xor32_max(float x) { const unsigned u = __builtin_bit_cast(unsigned, x); auto r = __builtin_amdgcn_permlane32_swap(u, u, false, false); return fmaxf(__builtin_bit_cast(float, (unsigned)r[0]), __builtin_bit_cast(float, (unsigned)r[1])); }
template <int CTRL, int RM, int BM_> DI float dpp_mov_m(float oldv, float x) { return __builtin_bit_cast(float, __builtin_amdgcn_update_dpp(__builtin_bit_cast(int, oldv), __builtin_bit_cast(int, x), CTRL, RM, BM_, false)); }
DI float wave_prefix_sum(float v) {
    v += dpp_mov_m<0x111, 0xf, 0xf>(0.f, v); v += dpp_mov_m<0x112, 0xf, 0xf>(0.f, v); v += dpp_mov_m<0x114, 0xf, 0xe>(0.f, v); v += dpp_mov_m<0x118, 0xf, 0xc>(0.f, v);
    v += dpp_mov_m<0x142, 0xa, 0xf>(0.f, v); v += dpp_mov_m<0x143, 0xc, 0xf>(0.f, v);
    return v;
}
DI float wave_prefix_max(float v) {
    const float ninf = -__builtin_inff();
    v = fmaxf(v, dpp_mov_m<0x111, 0xf, 0xf>(ninf, v)); v = fmaxf(v, dpp_mov_m<0x112, 0xf, 0xf>(ninf, v)); v = fmaxf(v, dpp_mov_m<0x114, 0xf, 0xe>(ninf, v)); v = fmaxf(v, dpp_mov_m<0x118, 0xf, 0xc>(ninf, v));
    v = fmaxf(v, dpp_mov_m<0x142, 0xa, 0xf>(ninf, v)); v = fmaxf(v, dpp_mov_m<0x143, 0xc, 0xf>(ninf, v));
    return v;
}
DI float partner32(float x, int lane) { const unsigned u = __builtin_bit_cast(unsigned, x); auto r = __builtin_amdgcn_permlane32_swap(u, u, false, false); return __builtin_bit_cast(float, (unsigned)((lane & 32) ? r[0] : r[1])); }
DI float partner16(float x, int lane) { const unsigned u = __builtin_bit_cast(unsigned, x); auto r = __builtin_amdgcn_permlane16_swap(u, u, false, false); return __builtin_bit_cast(float, (unsigned)((lane & 16) ? r[0] : r[1])); }
DI float partner8(float x) { return dpp_mov<DPP_ROR(8)>(x); }
DI float partner4(float x, int lane) { const float a = dpp_mov<DPP_ROR(4)>(x), b = dpp_mov<DPP_ROR(12)>(x); return (lane & 4) ? a : b; }
DI float row_sum16(float v) { v += dpp_mov<DPP_XOR1>(v); v += dpp_mov<DPP_XOR2>(v); v += dpp_mov<DPP_ROR(4)>(v); v += dpp_mov<DPP_ROR(8)>(v); return v; }
DI float wave_sum(float v) { v = row_sum16(v); v = xor16_sum(v); return xor32_sum(v); }
DI float wave_max(float v) { v = fmaxf(v, dpp_mov<DPP_XOR1>(v)); v = fmaxf(v, dpp_mov<DPP_XOR2>(v)); v = fmaxf(v, dpp_mov<DPP_ROR(4)>(v)); v = fmaxf(v, dpp_mov<DPP_ROR(8)>(v)); v = xor16_max(v); return xor32_max(v); }
DI float sigmoid_f(float v) { return __builtin_amdgcn_rcpf(1.f + __builtin_amdgcn_exp2f(-1.4426950408889634f * v)); }
DI float silu_f(float v) { return v * sigmoid_f(v); }
DI float logsigmoid_f(float f) { return fminf(f, 0.f) - log1pf(__expf(-fabsf(f))); }
DI int swz16(int row) { return ((row & 3) << 2) | ((row >> 2) & 3); }
#define MFMA32(a, b, c) __builtin_amdgcn_mfma_f32_32x32x16_bf16((a), (b), (c), 0, 0, 0)
DI s16x4 trread(const LAS unsigned char* p) { return __builtin_bit_cast(s16x4, __builtin_amdgcn_ds_read_tr16_b64_v4i16((LAS s16x4*)p)); }
DI int crow(int r, int hh) { return (r & 3) + 8 * (r >> 2) + 4 * hh; }
DI bool hh_sel(int lane, int bit) { return (lane & bit) != 0; }

namespace pg8 {
constexpr int BM = 256, BK = 64, HALF = 128, HTB = HALF * BK * 2, STAGE_BYTES = 8 * HTB, NXCD = 8, WGM = 8;
DI int lds_byte(int r, int c) { const int st = (r >> 4) * 2 + (c >> 5), rr = r & 15, cc = c & 31, ob = rr * 64 + cc * 2; return st * 1024 + (ob ^ (((ob >> 9) & 1) << 5)); }
DI void stage_rc(int b, int& R, int& C) { const int st = b / 1024, sb = b % 1024, swz = sb ^ (((sb >> 9) & 1) << 5); R = (st >> 1) * 16 + swz / 64; C = (st & 1) * 32 + (swz % 64) / 2; }
DI int perm32(int rho) { const int n = rho >> 4, i = rho & 15; return 8 * (i >> 2) + 4 * n + (i & 3); }
struct Unit { int pm, pn; };
typedef int i32x4_t __attribute__((ext_vector_type(4)));
typedef int i32x8_t __attribute__((ext_vector_type(8)));
DI i32x8_t cat8(bf16x8 lo, bf16x8 hi) { const i32x4_t a = __builtin_bit_cast(i32x4_t, lo), b = __builtin_bit_cast(i32x4_t, hi); return __builtin_shufflevector(a, b, 0, 1, 2, 3, 4, 5, 6, 7); }
struct Gemm { const bf16_t* A; const bf16_t* Bt; int M, N, K, tpg; const int* gidx = nullptr; };
struct StaticOrder {
    int nM, nN, nwg, G, c;
    DI void init(int M, int N, int G_, int c_) { nM = M / BM; nN = N / BM; nwg = nM * nN; G = G_; c = c_; }
    DI bool next(int i, Unit& u) const {
        const long L = (long)i * G + c; if (L >= nwg) return false;
        int wgid = (int)L; { const int q = nwg / NXCD, r = nwg % NXCD, xcd = wgid % NXCD, off = wgid / NXCD; wgid = (xcd < r ? xcd * (q + 1) : r * (q + 1) + (xcd - r) * q) + off; }
        const int nig = WGM * nN, gid = wgid / nig, fm = gid * WGM, gsz = (nM - fm) < WGM ? (nM - fm) : WGM;
        u.pm = fm + ((wgid % nig) % gsz); u.pn = (wgid % nig) / gsz; return true;
    }
};

template <class Epi, bool ALIGN_EPI, bool SP2, bool FP8 = false, bool GATHER = false>
DI void gemm_phase(LAS unsigned char* lds, const Gemm g, const StaticOrder& S, const Epi& E) {
    const int tid = threadIdx.x, wid = __builtin_amdgcn_readfirstlane(tid >> 6), lane = tid & 63, wr = wid >> 2, wc = wid & 3, fr = lane & 15, fq = lane >> 4;
    const int KB = FP8 ? g.K : 2 * g.K, nt = KB / (BK * 2);
    unsigned voffA[2], voffB[2];
#pragma unroll
    for (int i = 0; i < 2; ++i) { int R, C; stage_rc(tid * 16 + i * 8192, R, C); const int Rb = Epi::PERM ? ((R & ~31) + perm32(R & 31)) : R;
        voffA[i] = (unsigned)(R * KB + C * 2); voffB[i] = (unsigned)(Rb * KB + C * 2); }
    int R0g, C0g; stage_rc(tid * 16, R0g, C0g);
    unsigned vgA[2][2], ngA[2][2];
    LAS int* gtab = (LAS int*)(lds + STAGE_BYTES);
    const size_t kstep = (size_t)(BK * 2);
    const size_t hstep = (size_t)HALF * KB;
    const size_t tstep = 2 * hstep;
    const size_t gstep = (size_t)g.N * KB;
    const unsigned ldsw = (unsigned)wid * 1024u;
    const int aoff = lds_byte(wr * 64 + fr, fq * 8), boff = lds_byte(wc * 32 + fr, fq * 8);
#define PG8_SA(b, h) (((b) * 2 + (h)) * HTB)
#define PG8_SB(b, h) ((4 + (b) * 2 + (h)) * HTB)
#define PG8_STAGE(bufoff, gbase, voff) do { _Pragma("unroll") for (int _i = 0; _i < 2; ++_i) \
        __builtin_amdgcn_global_load_lds((const unsigned*)((const char*)(gbase) + (voff)[_i]), (LAS unsigned*)(lds + (bufoff) + ldsw + _i * 8192), 16, 0, 0); } while (0)
#define PG8_STAGE_A(bufoff, gbase, h, nx) do { if constexpr (GATHER) { _Pragma("unroll") for (int _i = 0; _i < 2; ++_i) { const unsigned _o = (nx) ? ngA[h][_i] : vgA[h][_i]; \
        __builtin_amdgcn_global_load_lds((const unsigned*)((const char*)(gbase) + _o), (LAS unsigned*)(lds + (bufoff) + ldsw + _i * 8192), 16, 0, 0); } } \
        else PG8_STAGE(bufoff, (gbase) + (h) * hstep, voffA); } while (0)
#define PG8_LDA(dst, b, h) do { if constexpr (FP8) { _Pragma("unroll") for (int m = 0; m < 4; ++m) dst##8[m] = cat8(*(const LAS bf16x8*)(lds + PG8_SA(b, h) + aoff + m * 2048), *(const LAS bf16x8*)(lds + PG8_SA(b, h) + aoff + m * 2048 + 1024)); } \
        else { _Pragma("unroll") for (int m = 0; m < 4; ++m) _Pragma("unroll") for (int k = 0; k < 2; ++k) dst[m][k] = *(const LAS bf16x8*)(lds + PG8_SA(b, h) + aoff + m * 2048 + k * 1024); } } while (0)
#define PG8_LDB(dst, b, h) do { if constexpr (FP8) { _Pragma("unroll") for (int n = 0; n < 2; ++n) dst##8[n] = cat8(*(const LAS bf16x8*)(lds + PG8_SB(b, h) + boff + n * 2048), *(const LAS bf16x8*)(lds + PG8_SB(b, h) + boff + n * 2048 + 1024)); } \
        else { _Pragma("unroll") for (int n = 0; n < 2; ++n) _Pragma("unroll") for (int k = 0; k < 2; ++k) dst[n][k] = *(const LAS bf16x8*)(lds + PG8_SB(b, h) + boff + n * 2048 + k * 1024); } } while (0)
#define PG8_MMA(ai, bj, At, Bt) do { __builtin_amdgcn_s_setprio(1); \
        if constexpr (FP8) { _Pragma("unroll") for (int m = 0; m < 4; ++m) _Pragma("unroll") for (int n = 0; n < 2; ++n) \
            asm volatile("s_nop 1\n\tv_mfma_f32_16x16x128_f8f6f4 %0, %1, %2, %0" : "+v"(acc[ai][bj][m][n]) : "v"(Bt##8[n]), "v"(At##8[m])); } \
        else { _Pragma("unroll") for (int m = 0; m < 4; ++m) _Pragma("unroll") for (int n = 0; n < 2; ++n) _Pragma("unroll") for (int k = 0; k < 2; ++k) \
            acc[ai][bj][m][n] = __builtin_amdgcn_mfma_f32_16x16x32_bf16(Bt[n][k], At[m][k], acc[ai][bj][m][n], 0, 0, 0); } \
        __builtin_amdgcn_s_setprio(0); } while (0)
#define PG8_WAIT_V(n) asm volatile("s_waitcnt vmcnt(" #n ")" ::: "memory")
#define PG8_WAIT_L(n) asm volatile("s_waitcnt lgkmcnt(" #n ")" ::: "memory")
#define PG8_BAR __builtin_amdgcn_s_barrier()
#define PG8_SCHED __builtin_amdgcn_sched_barrier(0)
    Unit cur, nxt; int ui = 0;
    if (!S.next(0, cur)) return;
    f32x4 acc[2][2][4][2];
#pragma unroll
    for (int a = 0; a < 2; ++a)
#pragma unroll
        for (int b = 0; b < 2; ++b)
#pragma unroll
            for (int m = 0; m < 4; ++m)
#pragma unroll
                for (int n = 0; n < 2; ++n) acc[a][b][m][n] = (f32x4){0.f, 0.f, 0.f, 0.f};
    bf16x8 At[4][2], B0[2][2], B1[2][2]; i32x8_t At8[4], B08[2], B18[2];
    const char* cA = GATHER ? (const char*)g.A : (const char*)g.A + (size_t)cur.pm * tstep; const char* cB = (const char*)g.Bt + (size_t)(cur.pm / g.tpg) * gstep + (size_t)cur.pn * tstep;
    if constexpr (GATHER) {
#pragma unroll
        for (int h = 0; h < 2; ++h)
#pragma unroll
            for (int i = 0; i < 2; ++i) { vgA[h][i] = (unsigned)g.gidx[cur.pm * BM + h * HALF + R0g + 64 * i] * (unsigned)KB + (unsigned)(C0g * 2); ngA[h][i] = vgA[h][i]; }
    }
    if constexpr (SP2) {
        PG8_STAGE(PG8_SB(0, 0), cB, voffB); PG8_STAGE(PG8_SB(0, 1), cB + hstep, voffB); PG8_STAGE_A(PG8_SA(0, 0), cA, 0, false); PG8_STAGE_A(PG8_SA(0, 1), cA, 1, false);
        if (wr == 1) PG8_BAR;
        PG8_WAIT_V(2); PG8_BAR;
        PG8_STAGE(PG8_SB(1, 0), cB + kstep, voffB); PG8_STAGE_A(PG8_SA(1, 0), cA + kstep, 0, false); PG8_STAGE(PG8_SB(1, 1), cB + hstep + kstep, voffB);
        PG8_WAIT_V(6); PG8_BAR;
    } else {
        PG8_STAGE(PG8_SB(0, 0), cB, voffB); PG8_STAGE_A(PG8_SA(0, 0), cA, 0, false); PG8_STAGE(PG8_SB(0, 1), cB + hstep, voffB); PG8_STAGE_A(PG8_SA(0, 1), cA, 1, false);
        if (wr == 1) PG8_BAR;
        PG8_WAIT_V(4); PG8_BAR;
        PG8_STAGE(PG8_SB(1, 0), cB + kstep, voffB); PG8_STAGE_A(PG8_SA(1, 0), cA + kstep, 0, false); PG8_STAGE(PG8_SB(1, 1), cB + hstep + kstep, voffB);
        PG8_WAIT_V(6); PG8_BAR;
    }
    for (;;) {
        const bool has_next = S.next(ui + 1, nxt);
        if constexpr (GATHER) { if (has_next && wid < 4)
            __builtin_amdgcn_global_load_lds((const unsigned*)(g.gidx + nxt.pm * BM + wid * 64 + lane), (LAS unsigned*)(gtab + ((ui + 1) & 1) * 256 + wid * 64), 4, 0, 0); }
        const char* nA = GATHER ? (const char*)g.A : has_next ? (const char*)g.A + (size_t)nxt.pm * tstep : cA;
        const char* nB = has_next ? (const char*)g.Bt + (size_t)(nxt.pm / g.tpg) * gstep + (size_t)nxt.pn * tstep : cB;
        for (int t = 0; t < nt; t += 2) {
            const bool last = (t == nt - 2);
            const char* a1 = cA + (size_t)(t + 1) * kstep;
            const char* a2 = last ? nA : cA + (size_t)(t + 2) * kstep; const char* b2 = last ? nB : cB + (size_t)(t + 2) * kstep;
            const char* a3 = a2 + kstep; const char* b3 = b2 + kstep;
            if constexpr (GATHER) { if (last && has_next) { const LAS int* tb = gtab + ((ui + 1) & 1) * 256 + R0g;
#pragma unroll
                for (int h = 0; h < 2; ++h)
#pragma unroll
                    for (int i = 0; i < 2; ++i) ngA[h][i] = (unsigned)tb[h * HALF + 64 * i] * (unsigned)KB + (unsigned)(C0g * 2); } }
            if constexpr (SP2) {
            PG8_LDB(B0, 0, 0); PG8_LDB(B1, 0, 1); PG8_SCHED; PG8_LDA(At, 0, 0); PG8_STAGE_A(PG8_SA(1, 1), a1, 1, false);
            PG8_WAIT_V(8); PG8_WAIT_L(0); PG8_BAR; PG8_MMA(0, 0, At, B0); PG8_MMA(0, 1, At, B1); PG8_BAR; PG8_SCHED;
            PG8_LDA(At, 0, 1); PG8_STAGE(PG8_SB(0, 0), b2, voffB); PG8_STAGE(PG8_SB(0, 1), b2 + hstep, voffB); PG8_STAGE_A(PG8_SA(0, 0), a2, 0, last);
            PG8_WAIT_V(8); PG8_WAIT_L(0); PG8_BAR; PG8_MMA(1, 0, At, B0); PG8_MMA(1, 1, At, B1); PG8_BAR; PG8_SCHED;
            PG8_LDB(B0, 1, 0); PG8_LDB(B1, 1, 1); PG8_SCHED; PG8_LDA(At, 1, 0); PG8_STAGE_A(PG8_SA(0, 1), a2, 1, last);
            PG8_WAIT_V(8); PG8_WAIT_L(0); PG8_BAR; PG8_MMA(0, 0, At, B0); PG8_MMA(0, 1, At, B1); PG8_BAR; PG8_SCHED;
            PG8_LDA(At, 1, 1); PG8_STAGE(PG8_SB(1, 0), b3, voffB); PG8_STAGE(PG8_SB(1, 1), b3 + hstep, voffB); PG8_STAGE_A(PG8_SA(1, 0), a3, 0, last);
            PG8_WAIT_V(8); PG8_WAIT_L(0); PG8_BAR; PG8_MMA(1, 0, At, B0); PG8_MMA(1, 1, At, B1); PG8_BAR; PG8_SCHED;
            } else {
            PG8_LDB(B0, 0, 0); PG8_SCHED; PG8_LDA(At, 0, 0); PG8_STAGE_A(PG8_SA(1, 1), a1, 1, false);
            PG8_WAIT_L(8); PG8_BAR; PG8_WAIT_L(0); PG8_MMA(0, 0, At, B0); PG8_BAR; PG8_SCHED;
            PG8_LDB(B1, 0, 1); PG8_STAGE(PG8_SB(0, 0), b2, voffB);
            PG8_BAR; PG8_WAIT_L(0); PG8_MMA(0, 1, At, B1); PG8_BAR;
            PG8_LDA(At, 0, 1); PG8_STAGE_A(PG8_SA(0, 0), a2, 0, last);
            PG8_BAR; PG8_WAIT_L(0); PG8_MMA(1, 0, At, B0); PG8_BAR; PG8_SCHED;
            PG8_STAGE(PG8_SB(0, 1), b2 + hstep, voffB);
            PG8_WAIT_V(6); PG8_BAR; PG8_MMA(1, 1, At, B1); PG8_BAR;
            PG8_LDB(B0, 1, 0); PG8_SCHED; PG8_LDA(At, 1, 0); PG8_STAGE_A(PG8_SA(0, 1), a2, 1, last);
            PG8_WAIT_L(8); PG8_BAR; PG8_WAIT_L(0); PG8_MMA(0, 0, At, B0); PG8_BAR; PG8_SCHED;
            PG8_LDB(B1, 1, 1); PG8_STAGE(PG8_SB(1, 0), b3, voffB);
            PG8_BAR; PG8_WAIT_L(0); PG8_MMA(0, 1, At, B1); PG8_BAR;
            PG8_LDA(At, 1, 1); PG8_STAGE_A(PG8_SA(1, 0), a3, 0, last);
            PG8_BAR; PG8_WAIT_L(0); PG8_MMA(1, 0, At, B0); PG8_BAR; PG8_SCHED;
            PG8_STAGE(PG8_SB(1, 1), b3 + hstep, voffB);
            PG8_WAIT_V(6); PG8_BAR; PG8_MMA(1, 1, At, B1); PG8_BAR;
            }
        }
        if constexpr (ALIGN_EPI) { if (wr == 0) PG8_BAR; }
        if constexpr (FP8) asm volatile("s_nop 15\n\ts_nop 7" ::: "memory");
        E(acc, cur, wr, wc, fr, fq);
        if (!has_next) break;
#pragma unroll
        for (int a = 0; a < 2; ++a)
#pragma unroll
            for (int b = 0; b < 2; ++b)
#pragma unroll
                for (int m = 0; m < 4; ++m)
#pragma unroll
                    for (int n = 0; n < 2; ++n) acc[a][b][m][n] = (f32x4){0.f, 0.f, 0.f, 0.f};
        cur = nxt; cA = nA; cB = nB; ++ui;
        if constexpr (GATHER) {
#pragma unroll
            for (int h = 0; h < 2; ++h)
#pragma unroll
                for (int i = 0; i < 2; ++i) vgA[h][i] = ngA[h][i]; }
        if constexpr (ALIGN_EPI) { if (wr == 1) PG8_BAR; }
    }
    PG8_WAIT_V(0);
    if constexpr (!ALIGN_EPI) { if (wr == 0) PG8_BAR; }
    PG8_BAR;
#undef PG8_SA
#undef PG8_SB
#undef PG8_STAGE
#undef PG8_STAGE_A
#undef PG8_LDA
#undef PG8_LDB
#undef PG8_MMA
#undef PG8_WAIT_V
#undef PG8_WAIT_L
#undef PG8_BAR
#undef PG8_SCHED
}

struct EpiBf16 {
    static constexpr bool PERM = true;
    bf16_t* O; int ldc;
    DI void operator()(const f32x4 (&acc)[2][2][4][2], const Unit& u, int wr, int wc, int fr, int fq) const {
        const int row0 = u.pm * BM + wr * 64 + fr, col0 = u.pn * BM + wc * 32 + 8 * fq;
#pragma unroll
        for (int ai = 0; ai < 2; ++ai)
#pragma unroll
            for (int m = 0; m < 4; ++m) { bf16_t* rowp = O + (size_t)(row0 + ai * HALF + m * 16) * ldc + col0;
#pragma unroll
                for (int bj = 0; bj < 2; ++bj) { const f32x4 v0 = acc[ai][bj][m][0], v1 = acc[ai][bj][m][1];
                    u32x4 w; w.x = pk2(v0[0], v0[1]); w.y = pk2(v0[2], v0[3]); w.z = pk2(v1[0], v1[1]); w.w = pk2(v1[2], v1[3]);
                    *(u32x4*)(rowp + bj * HALF) = w; } }
    }
};
struct EpiProj {
    static constexpr bool PERM = true;
    bf16_t* O; const int* pos; const float* qk_g; bf16_t* kimg; bf16_t* vimg;
    DI void operator()(const f32x4 (&acc)[2][2][4][2], const Unit& u, int wr, int wc, int fr, int fq) const {
        const int row0 = u.pm * BM + wr * 64 + fr;
        if (u.pn < 8) {
            const int col0 = u.pn * BM + wc * 32 + 8 * fq;
#pragma unroll
            for (int ai = 0; ai < 2; ++ai)
#pragma unroll
                for (int m = 0; m < 4; ++m) { bf16_t* rowp = O + (size_t)(row0 + ai * HALF + m * 16) * PS + col0;
#pragma unroll
                    for (int bj = 0; bj < 2; ++bj) { const f32x4 v0 = acc[ai][bj][m][0], v1 = acc[ai][bj][m][1];
                        u32x4 w; w.x = pk2(v0[0], v0[1]); w.y = pk2(v0[2], v0[3]); w.z = pk2(v1[0], v1[1]); w.w = pk2(v1[2], v1[3]);
                        *(u32x4*)(rowp + bj * HALF) = w; } }
        } else if (u.pn < 12) {
            const int isk = (u.pn >= 10), hsub = 4 * (u.pn & 1) + wc, h = hsub >> 1, p = hsub & 1;
            const float* gp = qk_g + isk * 64 + 8 * fq;
            const f32x4 g00 = *(const f32x4*)gp, g01 = *(const f32x4*)(gp + 4), g10 = *(const f32x4*)(gp + 32), g11 = *(const f32x4*)(gp + 36);
            const float qs = isk ? 1.f : 0.125f * 1.4426950408889634f;
            const int lane = fr + 16 * fq;
#pragma unroll
            for (int ai = 0; ai < 2; ++ai)
#pragma unroll
                for (int m = 0; m < 4; ++m) { const int row = row0 + ai * HALF + m * 16;
                    f32x4 a0 = acc[ai][0][m][0], a1 = acc[ai][0][m][1], b0 = acc[ai][1][m][0], b1 = acc[ai][1][m][1];
                    float ss = (a0[0] * a0[0] + a0[1] * a0[1] + a0[2] * a0[2] + a0[3] * a0[3]) + (a1[0] * a1[0] + a1[1] * a1[1] + a1[2] * a1[2] + a1[3] * a1[3])
                             + (b0[0] * b0[0] + b0[1] * b0[1] + b0[2] * b0[2] + b0[3] * b0[3]) + (b1[0] * b1[0] + b1[1] * b1[1] + b1[2] * b1[2] + b1[3] * b1[3]);
                    ss = xor16_sum(ss); ss = xor32_sum(ss);
                    const float rstd = rsqrtf(ss * (1.f / 64.f) + EPS);
                    a0 = a0 * rstd * g00; a1 = a1 * rstd * g01; b0 = b0 * rstd * g10 * qs; b1 = b1 * rstd * g11 * qs;
                    const float pf = (float)pos[row];
                    f32x4 r0, r1;
#pragma unroll
                    for (int n = 0; n < 2; ++n)
#pragma unroll
                        for (int j = 0; j < 4; ++j) { const int i = 4 * n + j; const float own = n ? a1[j] : a0[j]; const float oth = partner16(own, lane);
                            const float frc = __builtin_amdgcn_fractf(pf * (exp2f(-(float)i * 0.125f * 18.931568569324174f) * 0.15915494309189535f));
                            const float sn = __builtin_amdgcn_sinf(frc), cs = __builtin_amdgcn_cosf(frc);
                            const float rot = (fq == 0) ? own * cs - oth * sn : own * cs + oth * sn;
                            const float o = (fq < 2) ? rot : own;
                            if (n) r1[j] = o; else r0[j] = o; }
                    r0 = r0 * qs; r1 = r1 * qs;
                    u32x4 w0, w1;
                    w0.x = pk2(r0[0], r0[1]); w0.y = pk2(r0[2], r0[3]); w0.z = pk2(r1[0], r1[1]); w0.w = pk2(r1[2], r1[3]);
                    w1.x = pk2(b0[0], b0[1]); w1.y = pk2(b0[2], b0[3]); w1.z = pk2(b1[0], b1[1]); w1.w = pk2(b1[2], b1[3]);
                    if (!isk) { bf16_t* rowp = O + (size_t)row * PS + C_QA + h * 128 + p * 64 + 8 * fq; *(u32x4*)rowp = w0; *(u32x4*)(rowp + 32) = w1; }
                    else { const int b = row / SEQ, t = row % SEQ; bf16_t* kp = kimg + ((size_t)((b * 4 + h) * 64 + (t >> 6))) * 8192 + (p * 8 + fq) * 512 + (t & 63) * 8;
                        *(u32x4*)kp = w0; *(u32x4*)(kp + 4 * 512) = w1; } }
        } else {
#pragma unroll
            for (int ai = 0; ai < 2; ++ai)
#pragma unroll
                for (int m = 0; m < 4; ++m) { const int row = row0 + ai * HALF + m * 16, b = row / SEQ, t = row % SEQ;
#pragma unroll
                    for (int bj = 0; bj < 2; ++bj) { const int h = 2 * (u.pn - 12) + bj; const f32x4 v0 = acc[ai][bj][m][0], v1 = acc[ai][bj][m][1];
                        u32x4 w; w.x = pk2(v0[0], v0[1]); w.y = pk2(v0[2], v0[3]); w.z = pk2(v1[0], v1[1]); w.w = pk2(v1[2], v1[3]);
                        *(u32x4*)(vimg + ((size_t)((b * 4 + h) * 64 + (t >> 6))) * 8192 + (wc * 4 + ((t & 63) >> 4)) * 512 + (t & 15) * 32 + fq * 8) = w; } }
        }
    }
};
struct EpiX1 {
    static constexpr bool PERM = true;
    const float* x; const float* mod; bf16_t* x1;
    DI void operator()(const f32x4 (&acc)[2][2][4][2], const Unit& u, int wr, int wc, int fr, int fq) const {
        const int row0 = u.pm * BM + wr * 64 + fr, col0 = u.pn * BM + wc * 32 + 8 * fq;
        const int b = (u.pm * BM) / SEQ;
        const float* gp = mod + (size_t)b * 6144 + 2048 + col0;
#pragma unroll
        for (int bj = 0; bj < 2; ++bj) { const f32x4 g0 = *(const f32x4*)(gp + bj * HALF), g1 = *(const f32x4*)(gp + bj * HALF + 4);
#pragma unroll
            for (int ai = 0; ai < 2; ++ai)
#pragma unroll
                for (int m = 0; m < 4; ++m) { const size_t off = (size_t)(row0 + ai * HALF + m * 16) * DM + col0 + bj * HALF;
                    const f32x4 r0 = *(const f32x4*)(x + off) + g0 * acc[ai][bj][m][0], r1 = *(const f32x4*)(x + off + 4) + g1 * acc[ai][bj][m][1];
                    u32x4 w; w.x = pk2(r0[0], r0[1]); w.y = pk2(r0[2], r0[3]); w.z = pk2(r1[0], r1[1]); w.w = pk2(r1[2], r1[3]);
                    *(u32x4*)(x1 + off) = w; } }
    }
};
DI unsigned pk4_fp8(float a, float b, float c, float d) { int w = __builtin_amdgcn_cvt_pk_fp8_f32(a, b, 0, false); w = __builtin_amdgcn_cvt_pk_fp8_f32(c, d, w, true); return (unsigned)w; }
constexpr float W_PRESCALE = 32.f, H_PRESCALE = 8.f;
struct EpiGU {
    static constexpr bool PERM = true;
    unsigned char* H;
    DI void operator()(const f32x4 (&acc)[2][2][4][2], const Unit& u, int wr, int wc, int fr, int fq) const {
        const int row0 = u.pm * BM + wr * 64 + fr, col0 = u.pn * HALF + wc * 32 + 8 * fq;
#pragma unroll
        for (int ai = 0; ai < 2; ++ai)
#pragma unroll
            for (int m = 0; m < 4; ++m) { unsigned char* rowp = H + (size_t)(row0 + ai * HALF + m * 16) * DFF + col0;
                float hv[8];
#pragma unroll
                for (int n = 0; n < 2; ++n)
#pragma unroll
                    for (int j = 0; j < 4; ++j) { const float gg = acc[ai][0][m][n][j] * (1.f / W_PRESCALE), uu = acc[ai][1][m][n][j] * (H_PRESCALE / W_PRESCALE); hv[n * 4 + j] = gg * __builtin_amdgcn_rcpf(1.f + __builtin_amdgcn_exp2f(-1.4426950408889634f * gg)) * uu; }
                u32x2 w; w.x = pk4_fp8(hv[0], hv[1], hv[2], hv[3]); w.y = pk4_fp8(hv[4], hv[5], hv[6], hv[7]);
                *(u32x2*)rowp = w; }
    }
};
constexpr float Y_PRESCALE = 64.f;
struct EpiDown {
    static constexpr bool PERM = true;
    unsigned char* Y; const float* vals;
    DI void operator()(const f32x4 (&acc)[2][2][4][2], const Unit& u, int wr, int wc, int fr, int fq) const {
        const int row0 = u.pm * BM + wr * 64 + fr, col0 = u.pn * BM + wc * 32 + 8 * fq;
#pragma unroll
        for (int ai = 0; ai < 2; ++ai)
#pragma unroll
            for (int m = 0; m < 4; ++m) { const int row = row0 + ai * HALF + m * 16; const float s = vals[row] * (Y_PRESCALE / (W_PRESCALE * H_PRESCALE)); unsigned char* rowp = Y + (size_t)row * DM + col0;
#pragma unroll
                for (int bj = 0; bj < 2; ++bj) { const f32x4 v0 = acc[ai][bj][m][0] * s, v1 = acc[ai][bj][m][1] * s;
                    u32x2 w; w.x = pk4_fp8(v0[0], v0[1], v0[2], v0[3]); w.y = pk4_fp8(v1[0], v1[1], v1[2], v1[3]);
                    *(u32x2*)(rowp + bj * HALF) = w; } }
    }
};
}

struct Args {
    const float* x; const float* c; const int* pos; const float* norm1_g; const float* norm2_g; const float* w_ada; const float* b_ada;
    const float* w_in; const float* conv_w; const float* gate_b; const float* mnorm_g; const float* qk_g; const float* lam_p; const float* subln_g;
    const float* w_out; const float* w_router; const float* w_gate; const float* w_up; const float* w_down;
    float* out; unsigned char* ws; int ph_lo, ph_hi;
};
struct Ctx {
    LAS unsigned char* lds; int tid, lane, wave, G, bid;
};
DI Args load_args() {
    typedef __attribute__((address_space(4))) const volatile unsigned long long* kp_t;
    kp_t kp = (kp_t)__builtin_amdgcn_kernarg_segment_ptr();
#define GP(T, i) ((T*)(__attribute__((address_space(1))) T*)kp[i])
    Args a;
    a.x = GP(const float, 0); a.c = GP(const float, 1); a.pos = GP(const int, 2); a.norm1_g = GP(const float, 3); a.norm2_g = GP(const float, 4);
    a.w_ada = GP(const float, 5); a.b_ada = GP(const float, 6); a.w_in = GP(const float, 7); a.conv_w = GP(const float, 8); a.gate_b = GP(const float, 9);
    a.mnorm_g = GP(const float, 10); a.qk_g = GP(const float, 11); a.lam_p = GP(const float, 12); a.subln_g = GP(const float, 13); a.w_out = GP(const float, 14);
    a.w_router = GP(const float, 15); a.w_gate = GP(const float, 16); a.w_up = GP(const float, 17); a.w_down = GP(const float, 18);
    a.out = GP(float, 19); a.ws = GP(unsigned char, 20);
#undef GP
    a.ph_lo = 0; a.ph_hi = 12;
    return a;
}

DI void tr_item64(const float* src, size_t ld_src, int k0, int c0, bf16_t* dst, size_t r0, int ld_dst, LAS float* scr  , int lane, size_t r1 = (size_t)-1) {
    const float* sp = src + (size_t)(k0 + (lane >> 4)) * ld_src + c0 + (lane & 15) * 4;
#pragma unroll 1
    for (int hf = 0; hf < 2; ++hf) {
        f32x4 v[8];
#pragma unroll
        for (int i = 0; i < 8; ++i) v[i] = *(const f32x4*)(sp + (size_t)(4 * (8 * hf + i)) * ld_src);
#pragma unroll
        for (int i = 0; i < 8; ++i) *(LAS f32x4*)(scr + (4 * (8 * hf + i) + (lane >> 4)) * 68 + (lane & 15) * 4) = v[i];
    }
    asm volatile("s_waitcnt lgkmcnt(0)" ::: "memory");
    const int c = lane & 7;
#pragma unroll
    for (int q = 0; q < 8; ++q) { const int n = 8 * q + (lane >> 3); const LAS float* s = scr + (8 * c) * 68 + n;
        u32x4 o; o.x = pk2(s[0 * 68], s[1 * 68]); o.y = pk2(s[2 * 68], s[3 * 68]); o.z = pk2(s[4 * 68], s[5 * 68]); o.w = pk2(s[6 * 68], s[7 * 68]);
        const size_t row = (r1 != (size_t)-1 && q >= 4) ? r1 + (n - 32) : r0 + n;
        *(u32x4*)(dst + row * ld_dst + k0 + 8 * c) = o; }
    asm volatile("s_waitcnt lgkmcnt(0)" ::: "memory");
}
DI void tr_item64_fp8(const float* src, size_t ld_src, int k0, int c0, unsigned char* dst, size_t r0, int ld_dst, float scale, LAS float* scr  , int lane) {
    const float* sp = src + (size_t)(k0 + (lane >> 4)) * ld_src + c0 + (lane & 15) * 4;
    {
        f32x4 v[16];
#pragma unroll
        for (int i = 0; i < 16; ++i) v[i] = __builtin_nontemporal_load((const f32x4*)(sp + (size_t)(4 * i) * ld_src));
#pragma unroll
        for (int i = 0; i < 16; ++i) *(LAS f32x4*)(scr + (4 * i + (lane >> 4)) * 68 + (lane & 15) * 4) = v[i] * scale;
    }
    asm volatile("s_waitcnt lgkmcnt(0)" ::: "memory");
    const int c = lane & 3;
#pragma unroll
    for (int q = 0; q < 4; ++q) { const int n = 16 * q + (lane >> 2); const LAS float* s = scr + (16 * c) * 68 + n;
        u32x4 o; o.x = pg8::pk4_fp8(s[0 * 68], s[1 * 68], s[2 * 68], s[3 * 68]); o.y = pg8::pk4_fp8(s[4 * 68], s[5 * 68], s[6 * 68], s[7 * 68]);
        o.z = pg8::pk4_fp8(s[8 * 68], s[9 * 68], s[10 * 68], s[11 * 68]); o.w = pg8::pk4_fp8(s[12 * 68], s[13 * 68], s[14 * 68], s[15 * 68]);
        *(u32x4*)(dst + (r0 + n) * ld_dst + k0 + 16 * c) = o; }
    asm volatile("s_waitcnt lgkmcnt(0)" ::: "memory");
}
DI void p0_phase(const Ctx& F, const Args& a) {
    if (F.bid < 96) {
        LAS float* sc = (LAS float*)F.lds; LAS float* part = (LAS float*)(F.lds + 32768);
        for (int i = F.tid; i < BATCH * DM; i += NTHR) sc[i] = silu_f(a.c[i]);
        __syncthreads();
        const int col = F.bid * 64 + F.lane;
        float acc[8];
#pragma unroll
        for (int b = 0; b < 8; ++b) acc[b] = 0.f;
        const int kb = F.wave * 128;
#pragma unroll 1
        for (int k0 = kb; k0 < kb + 128; k0 += 16) {
            float w[16];
            const float* wp = a.w_ada + (size_t)k0 * 6144 + col;
#pragma unroll
            for (int j = 0; j < 16; ++j) w[j] = wp[(size_t)j * 6144];
#pragma unroll
            for (int j = 0; j < 16; ++j)
#pragma unroll
                for (int b = 0; b < 8; ++b) acc[b] += sc[b * DM + k0 + j] * w[j];
        }
#pragma unroll
        for (int b = 0; b < 8; ++b) part[(F.wave * 8 + b) * 64 + F.lane] = acc[b];
        __syncthreads();
        { const int b = F.tid >> 6, l = F.tid & 63; float s = a.b_ada[F.bid * 64 + l];
#pragma unroll
          for (int w = 0; w < 8; ++w) s += part[(w * 8 + b) * 64 + l];
          ((float*)(a.ws + WS_MOD))[b * 6144 + F.bid * 64 + l] = s; }
        asm volatile("s_waitcnt vmcnt(0)" ::: "memory");
        __syncthreads();
        if (F.tid == 0) { __builtin_amdgcn_fence(__ATOMIC_RELEASE, "agent"); asm volatile("s_waitcnt vmcnt(0)" ::: "memory");
            __hip_atomic_fetch_add((unsigned*)(a.ws + WS_CTL) + 4096, 1u, __ATOMIC_RELAXED, __HIP_MEMORY_SCOPE_AGENT); }
    }
    LAS float* scr = (LAS float*)(F.lds + F.wave * 17408);
    const int gw = F.bid * NWAVES + F.wave, NGW = F.G * NWAVES;
    constexpr int I_IN = 16 * 56, I_OUT = 16 * 16, I_WG = 16, I_EX = 4096;
    constexpr int NITEMS = I_IN + I_OUT + I_EX + I_WG;
    bf16_t* WinT = (bf16_t*)(a.ws + WS_WINT); bf16_t* WgT = (bf16_t*)(a.ws + WS_WGT); bf16_t* WoutT = (bf16_t*)(a.ws + WS_WOUTT);
    for (int it = gw; it < NITEMS; it += NGW) {
        int r = it;
        if (r < I_IN) { const int kb = r / 56, nb = r % 56, n0 = nb * 64;
            if (n0 >= 2048 && n0 < 3072) { const int t0 = n0 & ~255, g = (n0 >> 6) & 3; tr_item64(a.w_in, DIN, kb * 64, n0 + 16, WinT, (size_t)(t0 + 32 * g), DM, scr, F.lane, (size_t)(t0 + 128 + 32 * g)); }
            else tr_item64(a.w_in, DIN, kb * 64, n0 + (n0 >= 2048 ? 16 : 0), WinT, n0, DM, scr, F.lane);
            continue; } r -= I_IN;
        if (r < I_OUT) { const int kb = r / 16, nb = r % 16; tr_item64(a.w_out, DM, kb * 64, nb * 64, WoutT, nb * 64, DM, scr, F.lane); continue; } r -= I_OUT;
        if (r < I_EX) { int e, mat, q;
            if (r < 1024) { e = 13; mat = 1 + (r >> 9); q = r & 511; } else { const int t = r - 1024; e = 14 + t / 1536; const int u = t % 1536; mat = u >> 9; q = u & 511; }
            if (mat < 2) { const int kb = q / 32, nb = q % 32, n0 = nb * 64; const float* src = (mat ? a.w_up : a.w_gate) + (size_t)e * DM * DFF;
                tr_item64_fp8(src, DFF, kb * 64, n0, a.ws + WS_WGUT + (size_t)e * 4096 * DM, (size_t)(n0 / 128) * 256 + (n0 % 128) + mat * 128, DM, pg8::W_PRESCALE, scr, F.lane); }
            else { const int kb = q / 16, nb = q % 16;
                tr_item64_fp8(a.w_down + (size_t)e * DFF * DM, DM, kb * 64, nb * 64, a.ws + WS_WDT + (size_t)e * DM * DFF, nb * 64, DFF, pg8::W_PRESCALE, scr, F.lane); }
            continue; } r -= I_EX;
        tr_item64(a.w_in, DIN, r * 64, 2048 - 48, WgT, 0, DM, scr, F.lane);
    }
    if (F.tid == 0) { unsigned* cnt = (unsigned*)(a.ws + WS_CTL) + 4096; unsigned sp = 0;
        while (__hip_atomic_load(cnt, __ATOMIC_RELAXED, __HIP_MEMORY_SCOPE_AGENT) < 96u && ++sp < (1u << 22)) __builtin_amdgcn_s_sleep(2);
        __builtin_amdgcn_fence(__ATOMIC_ACQUIRE, "agent"); asm volatile("s_waitcnt vmcnt(0)" ::: "memory"); }
    __syncthreads();
}

DI void p1_phase(const Ctx& F, const Args& a) {
    const int gw = F.bid * NWAVES + F.wave, NGW = F.G * NWAVES;
    const float* mod = (const float*)(a.ws + WS_MOD);
    bf16_t* H1 = (bf16_t*)a.out;
    for (int m0 = gw; m0 < MTOK; m0 += 2 * NGW) {
        const int m1 = m0 + NGW; const bool has1 = m1 < MTOK;
        const f32x4* xr0 = (const f32x4*)(a.x + (size_t)m0 * DM) + F.lane; const f32x4* xr1 = (const f32x4*)(a.x + (size_t)(has1 ? m1 : m0) * DM) + F.lane;
        f32x4 v0[4], v1[4]; float s0 = 0.f, s1 = 0.f;
#pragma unroll
        for (int j = 0; j < 4; ++j) { v0[j] = __builtin_nontemporal_load(xr0 + 64 * j); v1[j] = __builtin_nontemporal_load(xr1 + 64 * j); }
#pragma unroll
        for (int j = 0; j < 4; ++j) { s0 += (v0[j].x * v0[j].x + v0[j].y * v0[j].y) + (v0[j].z * v0[j].z + v0[j].w * v0[j].w); s1 += (v1[j].x * v1[j].x + v1[j].y * v1[j].y) + (v1[j].z * v1[j].z + v1[j].w * v1[j].w); }
#pragma unroll
        for (int o = 1; o < 64; o <<= 1) { s0 += __shfl_xor(s0, o); s1 += __shfl_xor(s1, o); }
        const float rstd0 = rsqrtf(s0 * (1.f / DM) + EPS), rstd1 = rsqrtf(s1 * (1.f / DM) + EPS);
        const int b0 = m0 / SEQ, b1 = (has1 ? m1 : m0) / SEQ;
        u32x2* o0 = (u32x2*)(H1 + (size_t)m0 * DM) + F.lane; u32x2* o1 = (u32x2*)(H1 + (size_t)m1 * DM) + F.lane;
#pragma unroll
        for (int j = 0; j < 4; ++j) {
            const f32x4 g = ((const f32x4*)a.norm1_g)[F.lane + 64 * j];
            { const f32x4 sh = ((const f32x4*)(mod + (size_t)b0 * 6144))[F.lane + 64 * j], sc = ((const f32x4*)(mod + (size_t)b0 * 6144 + 1024))[F.lane + 64 * j];
              const f32x4 h = v0[j] * rstd0 * g * (sc + 1.f) + sh; u32x2 w; w.x = pk2(h.x, h.y); w.y = pk2(h.z, h.w); o0[64 * j] = w; }
            if (has1) { const f32x4 sh = ((const f32x4*)(mod + (size_t)b1 * 6144))[F.lane + 64 * j], sc = ((const f32x4*)(mod + (size_t)b1 * 6144 + 1024))[F.lane + 64 * j];
              const f32x4 h = v1[j] * rstd1 * g * (sc + 1.f) + sh; u32x2 w; w.x = pk2(h.x, h.y); w.y = pk2(h.z, h.w); o1[64 * j] = w; }
        }
    }
}

DI void gates_tasks(const Ctx& F, const Args& a) {
    const int gw = F.bid * NWAVES + F.wave, NGW = F.G * NWAVES;
    const bf16_t* H1 = (const bf16_t*)a.out; const bf16_t* WgT = (const bf16_t*)(a.ws + WS_WGT) + 48 * DM; float* GT = (float*)(a.ws + WS_GATES);
    const float bias = a.gate_b[F.lane & 15];
    for (int task = gw; task < MTOK / 16; task += NGW) {
        const int row0 = task * 16;
        const bf16_t* ap = H1 + (size_t)(row0 + (F.lane & 15)) * DM + 8 * (F.lane >> 4);
        const bf16_t* bp = WgT + (size_t)(F.lane & 15) * DM + 8 * (F.lane >> 4);
        f32x4 acc = {0.f, 0.f, 0.f, 0.f};
        bf16x8 avs[32];
#pragma unroll
        for (int i = 0; i < 32; ++i) avs[i] = *(const bf16x8*)(ap + 32 * i);
#pragma unroll
        for (int i = 0; i < 32; ++i) { const bf16x8 bv = *(const bf16x8*)(bp + 32 * i); acc = __builtin_amdgcn_mfma_f32_16x16x32_bf16(avs[i], bv, acc, 0, 0, 0); }
#pragma unroll
        for (int r = 0; r < 4; ++r) GT[(size_t)(row0 + (F.lane >> 4) * 4 + r) * 16 + (F.lane & 15)] = acc[r] + bias;
    }
}

DI void qk_tile_task(const Ctx& F, const Args& a, int task) {
    const int b = task >> 6, tile = task & 63, r = F.lane, g = F.wave, h = g >> 1, p = g & 1;
    bf16_t* PROJ = (bf16_t*)(a.ws + WS_PROJ);
    const size_t tok = (size_t)b * SEQ + tile * 64 + r;
    float invf[8];
#pragma unroll
    for (int i = 0; i < 8; ++i) invf[i] = exp2f(-(float)i * 0.125f * 18.931568569324174f) * 0.15915494309189535f;
    const float pos = (float)a.pos[tok];
    float sn[8], cs[8];
#pragma unroll
    for (int i = 0; i < 8; ++i) { const float fr = __builtin_amdgcn_fractf(pos * invf[i]); sn[i] = __builtin_amdgcn_sinf(fr); cs[i] = __builtin_amdgcn_cosf(fr); }
#pragma unroll 1
    for (int isk = 0; isk < 2; ++isk) {
        u32x4* src = (u32x4*)(PROJ + tok * PS + (isk ? C_KA : C_QA) + g * 64);
        u32x4 w[8];
#pragma unroll
        for (int c = 0; c < 8; ++c) w[c] = src[c];
        float ss = 0.f;
#pragma unroll
        for (int c = 0; c < 8; ++c) { float t;
            t = bflo(w[c].x); ss += t * t; t = bfhi(w[c].x); ss += t * t; t = bflo(w[c].y); ss += t * t; t = bfhi(w[c].y); ss += t * t;
            t = bflo(w[c].z); ss += t * t; t = bfhi(w[c].z); ss += t * t; t = bflo(w[c].w); ss += t * t; t = bfhi(w[c].w); ss += t * t; }
        const float rstd = rsqrtf(ss * (1.f / 64.f) + EPS) * (isk ? 1.f : 0.125f * 1.4426950408889634f);
        const float* gp = a.qk_g + isk * 64;
        float v0[16];
        v0[0] = bflo(w[0].x); v0[1] = bfhi(w[0].x); v0[2] = bflo(w[0].y); v0[3] = bfhi(w[0].y); v0[4] = bflo(w[0].z); v0[5] = bfhi(w[0].z); v0[6] = bflo(w[0].w); v0[7] = bfhi(w[0].w);
        v0[8] = bflo(w[1].x); v0[9] = bfhi(w[1].x); v0[10] = bflo(w[1].y); v0[11] = bfhi(w[1].y); v0[12] = bflo(w[1].z); v0[13] = bfhi(w[1].z); v0[14] = bflo(w[1].w); v0[15] = bfhi(w[1].w);
#pragma unroll
        for (int i = 0; i < 16; ++i) v0[i] *= rstd * gp[i];
        float rr[16];
#pragma unroll
        for (int i = 0; i < 8; ++i) { rr[i] = v0[i] * cs[i] - v0[i + 8] * sn[i]; rr[i + 8] = v0[i + 8] * cs[i] + v0[i] * sn[i]; }
        u32x4 o[8];
        o[0].x = pk2(rr[0], rr[1]); o[0].y = pk2(rr[2], rr[3]); o[0].z = pk2(rr[4], rr[5]); o[0].w = pk2(rr[6], rr[7]);
        o[1].x = pk2(rr[8], rr[9]); o[1].y = pk2(rr[10], rr[11]); o[1].z = pk2(rr[12], rr[13]); o[1].w = pk2(rr[14], rr[15]);
#pragma unroll
        for (int c = 2; c < 8; ++c) { const f32x4 g0 = *(const f32x4*)(gp + c * 8), g1 = *(const f32x4*)(gp + c * 8 + 4);
            o[c].x = pk2(bflo(w[c].x) * rstd * g0.x, bfhi(w[c].x) * rstd * g0.y); o[c].y = pk2(bflo(w[c].y) * rstd * g0.z, bfhi(w[c].y) * rstd * g0.w);
            o[c].z = pk2(bflo(w[c].z) * rstd * g1.x, bfhi(w[c].z) * rstd * g1.y); o[c].w = pk2(bflo(w[c].w) * rstd * g1.z, bfhi(w[c].w) * rstd * g1.w); }
        if (isk == 0) {
#pragma unroll
            for (int c = 0; c < 8; ++c) src[c] = o[c];
        } else {
            u32x4* dst = (u32x4*)((bf16_t*)(a.ws + WS_KIMG) + ((size_t)((b * 4 + h) * 64 + tile)) * 8192) + r;
#pragma unroll
            for (int c = 0; c < 8; ++c) dst[(p * 8 + c) * 64] = o[c];
        }
    }
    {
        u32x4* dst = (u32x4*)((bf16_t*)(a.ws + WS_VIMG) + ((size_t)((b * 4 + h) * 64 + tile)) * 8192) + r;
#pragma unroll
        for (int cg = 2 * p; cg < 2 * p + 2; ++cg)
#pragma unroll
            for (int kg = 0; kg < 4; ++kg) {
                const u32x4 v = *(const u32x4*)(PROJ + ((size_t)b * SEQ + tile * 64 + 16 * kg + (r >> 2)) * PS + C_VA + h * 128 + 32 * cg + 8 * (r & 3));
                dst[(cg * 4 + kg) * 64] = v; }
    }
}

DI bf16x8 tr_frag_nat(const LAS unsigned char* img, int rowbase, int col0, int lane) {
    const int hh = lane >> 5, g16 = (lane >> 4) & 1, i = lane & 15;
    const int col = col0 + 16 * g16 + 4 * (i & 3), chunk = col >> 3, sub = (col & 7) * 2;
    const int r0 = rowbase + 8 * hh + (i >> 2), r1 = r0 + 4;
    const s16x4 lo = trread(img + r0 * 256 + ((chunk ^ swz16(r0)) << 4) + sub);
    const s16x4 hi = trread(img + r1 * 256 + ((chunk ^ swz16(r1)) << 4) + sub);
    return __builtin_shufflevector(lo, hi, 0, 1, 2, 3, 4, 5, 6, 7);
}
DI bf16x8 tr_frag_acc(const LAS unsigned char* img, int rowbase, int col0, int lane) {
    const int hh = lane >> 5, g16 = (lane >> 4) & 1, i = lane & 15;
    const int col = col0 + 16 * g16 + 4 * (i & 3), chunk = col >> 3, sub = (col & 7) * 2;
    const int r0 = rowbase + 4 * hh + (i >> 2), r1 = r0 + 8;
    const s16x4 lo = trread(img + r0 * 256 + ((chunk ^ swz16(r0)) << 4) + sub);
    const s16x4 hi = trread(img + r1 * 256 + ((chunk ^ swz16(r1)) << 4) + sub);
    return __builtin_shufflevector(lo, hi, 0, 1, 2, 3, 4, 5, 6, 7);
}
DI bf16x8 row_frag(const LAS unsigned char* img, int row, int chunk) { return *(const LAS bf16x8*)(img + row * 256 + ((chunk ^ swz16(row)) << 4)); }

DI void glds16_asm(const void* gsrc, unsigned lds_dst) { unsigned keep;
    asm volatile("s_mov_b32 %0, m0\n\ts_mov_b32 m0, %2\n\ts_nop 0\n\tglobal_load_lds_dwordx4 %1, off\n\ts_mov_b32 m0, %0" : "=&s"(keep) : "v"(gsrc), "s"(lds_dst) : "memory"); }
constexpr size_t DO_QC = 0, DO_KC = 32 * MiB, DO_HD = 64 * MiB;
constexpr size_t WS_SC = 7 * MiB;

DI void conv_task(const Ctx& F, const Args& a, int tw) {
    const int isk = tw & 1, tok0 = (tw >> 1) * 8, b = tok0 / SEQ, t0 = tok0 % SEQ, lane = F.lane;
    const bf16_t* src = (const bf16_t*)(a.ws + WS_PROJ) + (size_t)b * SEQ * PS + (isk ? C_KM : C_QM) + lane * 8;
    float cw[5][8];
#pragma unroll
    for (int j = 0; j < 5; ++j) { const f32x4 c0 = *(const f32x4*)(a.conv_w + j * 1024 + isk * 512 + lane * 8), c1 = *(const f32x4*)(a.conv_w + j * 1024 + isk * 512 + lane * 8 + 4);
        cw[j][0] = c0.x; cw[j][1] = c0.y; cw[j][2] = c0.z; cw[j][3] = c0.w; cw[j][4] = c1.x; cw[j][5] = c1.y; cw[j][6] = c1.z; cw[j][7] = c1.w; }
    u32x4 row[12];
#pragma unroll
    for (int r = 0; r < 12; ++r) { const int t = t0 + r - 2; row[r] = (u32x4){0u, 0u, 0u, 0u}; if (t >= 0 && t < SEQ) row[r] = *(const u32x4*)(src + (size_t)t * PS); }
    const int hd = lane >> 4, cc = lane & 15, cch = t0 >> 6, r0 = t0 & 63;
    bf16_t* tileb = (bf16_t*)((unsigned char*)a.out + (isk ? DO_KC : DO_QC)) + ((size_t)((b * 4 + hd) * 64 + cch)) * 8192;
    bf16_t* dst = isk ? tileb + ((cc >> 2) * 4 + (r0 >> 4)) * 512 + (r0 & 15) * 32 + (cc & 3) * 8 : tileb + cc * 512 + r0 * 8;
    const int dstride = isk ? 32 : 8;
    const float sc = isk ? 0.08838834764831845f : 1.f;
#pragma unroll
    for (int i = 0; i < 8; ++i) {
        float acc[8];
#pragma unroll
        for (int e = 0; e < 8; ++e) acc[e] = 0.f;
#pragma unroll
        for (int j = 0; j < 5; ++j) { const u32x4 w = row[i + j];
            acc[0] += bflo(w.x) * cw[j][0]; acc[1] += bfhi(w.x) * cw[j][1]; acc[2] += bflo(w.y) * cw[j][2]; acc[3] += bfhi(w.y) * cw[j][3];
            acc[4] += bflo(w.z) * cw[j][4]; acc[5] += bfhi(w.z) * cw[j][5]; acc[6] += bflo(w.w) * cw[j][6]; acc[7] += bfhi(w.w) * cw[j][7]; }
#pragma unroll
        for (int e = 0; e < 8; ++e) acc[e] = silu_f(acc[e]) * sc;
        u32x4 o; o.x = pk2(acc[0], acc[1]); o.y = pk2(acc[2], acc[3]); o.z = pk2(acc[4], acc[5]); o.w = pk2(acc[6], acc[7]);
        *(u32x4*)(dst + i * dstride) = o;
    }
}

DI void mscal_task(const Ctx& F, const Args& a, int chain) {
    const int b = chain >> 3, h = (chain >> 1) & 3, dir = chain & 1;
    const int s = dir ? 63 - F.lane : F.lane;
    const float* GT = (const float*)(a.ws + WS_GATES) + (size_t)b * SEQ * 16;
    float* SC = (float*)(a.ws + WS_SC) + (size_t)chain * 64 * 256; float* MSC = (float*)(a.ws + WS_MSC);
    LAS float* gl = (LAS float*)F.lds; LAS float* mll = gl + 64; LAS float* mpv = gl + 128; LAS float* mnw = gl + 192;
    float aa[8], ii[8];
#pragma unroll
    for (int i = 0; i < 8; ++i) { const int c = F.wave + 8 * i;
        const float ig = GT[(size_t)(c * 64 + s) * 16 + dir * 8 + h], fg = GT[(size_t)(c * 64 + s) * 16 + dir * 8 + 4 + h];
        const float av = wave_prefix_sum(logsigmoid_f(fg));
        aa[i] = av; ii[i] = ig;
        const float g = __builtin_bit_cast(float, __builtin_amdgcn_readlane(__builtin_bit_cast(int, av), 63)), ml = wave_max(g - av + ig);
        if (F.lane == 0) { gl[c] = g; mll[c] = ml; } }
    __syncthreads();
    if (F.tid == 0) { float m = 0.f;
        for (int st = 0; st < 64; ++st) { const int c = dir ? 63 - st : st; mpv[c] = m; const float mn = fmaxf(gl[c] + m, mll[c]); mnw[c] = mn; m = mn; } }
    __syncthreads();
#pragma unroll
    for (int i = 0; i < 8; ++i) { const int c = F.wave + 8 * i; const float mprev = mpv[c], mnew = mnw[c], g = gl[c];
        const float cterm = ii[i] - aa[i];
        const float cm = wave_prefix_max(cterm);
        const float il = aa[i] + mprev, mj = fmaxf(il, aa[i] + cm);
        float* o4 = SC + (size_t)c * 256 + s;
        o4[0] = (aa[i] - mj) * 1.4426950408889634f; o4[64] = cterm * 1.4426950408889634f; o4[128] = __expf(il - mj); o4[192] = __expf(-mj);
        if (F.lane == 0) { MSC[chain * 64 + c] = (g - mnew) * 1.4426950408889634f; MSC[4096 + chain * 64 + c] = __expf(g + mprev - mnew); } }
    __syncthreads();
}

DI const float* wsel3(int m, const float* p0, const float* p1, const float* p2) {
    const unsigned long long a0 = (unsigned long long)p0, a1 = (unsigned long long)p1, a2 = (unsigned long long)p2;
    const unsigned long long m1 = (unsigned long long)0 - (unsigned long long)(m == 1), m2 = (unsigned long long)0 - (unsigned long long)(m == 2);
    return (const float*)((a0 & ~(m1 | m2)) | (a1 & m1) | (a2 & m2));
}
DI void mseq_item(const Ctx& F, const Args& a, int item, int bh, int dir, int vs) {
    const int b = bh >> 2, h = bh & 3, chain = bh * 2 + dir, wid = F.wave, tid = F.tid, lane = F.lane, r32 = lane & 31, hh = lane >> 5;
    LAS unsigned char* QS = F.lds;
    LAS unsigned char* KS = F.lds + 32768;
    LAS unsigned char* VS = F.lds + 65536;
    LAS unsigned char* SCS = F.lds + 77824;
    LAS unsigned char* SD = F.lds + 80896;
    LAS unsigned char* CI = F.lds + 97280;
    LAS float* NV = (LAS float*)(F.lds + 113664);
    LAS float* gmv = NV + 256; LAS float* spv = gmv + 64;
    LAS unsigned char* HST = F.lds + 115712;
    const int cwi = wid < 4 ? wid : 4;
    const bool cwave = wid < 4 || wid == 7;
    const unsigned cscb = (unsigned)(uintptr_t)F.lds + 119808u + (unsigned)cwi * 8192u;
    const int cslot0 = (item * 5 + cwi) * 64;
    const float* const wg_ = a.w_gate; const float* const wu_ = a.w_up; const float* const wd_ = a.w_down;
    const bf16_t* QC = (const bf16_t*)((const unsigned char*)a.out + DO_QC) + (size_t)bh * 64 * 8192 + lane * 8;
    const bf16_t* KC = (const bf16_t*)((const unsigned char*)a.out + DO_KC) + (size_t)bh * 64 * 8192 + lane * 8;
    const bf16_t* VP = (const bf16_t*)(a.ws + WS_PROJ) + (size_t)b * SEQ * PS + C_VM + h * 128 + vs * 32 + (size_t)(16 * (wid & 3) + (lane >> 2)) * PS + 8 * (lane & 3);
    const float* SC = (const float*)(a.ws + WS_SC) + (size_t)chain * 64 * 256 + lane * 4;
    bf16_t* HD = (bf16_t*)((unsigned char*)a.out + DO_HD) + ((size_t)dir * MTOK + (size_t)b * SEQ) * 512 + h * 128 + vs * 32;
    if (tid < 64) { gmv[tid] = ((const float*)(a.ws + WS_MSC))[chain * 64 + tid]; spv[tid] = ((const float*)(a.ws + WS_MSC))[4096 + chain * 64 + tid]; }
    if (tid < 256) NV[tid] = 0.f;
    for (int i = tid; i < 4096; i += NTHR) ((LAS unsigned*)CI)[i] = 0u;
    const unsigned ldsb = (unsigned)(uintptr_t)F.lds;
#define MSEQ_ISSUE_QK(c, s2) do { const size_t _tb = (size_t)(c); \
        if (wid < 4) { _Pragma("unroll") for (int _i = 0; _i < 4; ++_i) \
                glds16_asm(QC + _tb * 8192 + (4 * wid + _i) * 512, (unsigned)__builtin_amdgcn_readfirstlane((int)(ldsb + (s2) * 16384 + (4 * wid + _i) * 1024))); } \
        else if (wid >= 6) { _Pragma("unroll") for (int _i = 0; _i < 8; ++_i) \
                glds16_asm(KC + _tb * 8192 + (8 * (wid - 6) + _i) * 512, (unsigned)__builtin_amdgcn_readfirstlane((int)(ldsb + 32768 + (s2) * 16384 + (8 * (wid - 6) + _i) * 1024))); } } while (0)
#define MSEQ_ISSUE_VS(c, s4) do { const size_t _tb = (size_t)(c); \
        if (wid < 4) glds16_asm(VP + _tb * 64 * PS, (unsigned)__builtin_amdgcn_readfirstlane((int)(ldsb + 65536 + (s4) * 4096 + wid * 1024))); \
        else if (wid == 6) glds16_asm(SC + _tb * 256, (unsigned)__builtin_amdgcn_readfirstlane((int)(ldsb + 77824 + (s4) * 1024))); } while (0)
    MSEQ_ISSUE_QK(dir ? 63 : 0, 0); MSEQ_ISSUE_VS(dir ? 63 : 0, 0);
#define MSEQ_CONV_ISSUE(id) do { const int _e = (id) / 6144, _r = (id) % 6144, _mat = _r >> 11, _rr = _r & 2047; \
        const int _N = _mat == 2 ? DM : DFF, _nb = _mat == 2 ? (_rr >> 7) : (_rr >> 6), _kb = _mat == 2 ? (_rr & 127) : (_rr & 63); \
        const float* _src = wsel3(_mat, wg_, wu_, wd_) + (size_t)_e * DM * DFF + (size_t)(16 * _kb + (lane >> 4)) * _N + 64 * _nb + 4 * (lane & 15); \
        _Pragma("unroll") for (int _i = 0; _i < 4; ++_i) glds16_asm(_src + (size_t)(4 * _i) * _N, (unsigned)__builtin_amdgcn_readfirstlane((int)(cscb + ((id) & 1) * 4096 + _i * 1024))); } while (0)
    if (cwave) MSEQ_CONV_ISSUE(cslot0);
    f32x16 Cacc[2];
#pragma unroll
    for (int i = 0; i < 16; ++i) { Cacc[0][i] = 0.f; Cacc[1][i] = 0.f; }
    const int qrd = hh * 1024 + r32 * 16;
    const int ktr = (8 * hh + ((lane & 15) >> 2)) * 64 + ((lane >> 4) & 1) * 32 + (lane & 3) * 8;
    f32x16 acc;
    float qn = 0.f;
#pragma unroll
    for (int i = 0; i < 16; ++i) acc[i] = 0.f;
    asm volatile("s_waitcnt vmcnt(0)" ::: "memory");
    __syncthreads();
    unsigned long long busy = 0, tb0 = 0; if (PROBE_MSEQ_W >= 0) tb0 = __builtin_amdgcn_s_memtime(); const unsigned long long titem0 = tb0;
#pragma unroll 1
    for (int st = 0; st <= 64; ++st) {
        const int c = dir ? 63 - st : st, s2 = st & 1; const int s3 = st % 3, s3p = (st + 2) % 3;
        if (st + 1 < 64) { MSEQ_ISSUE_QK(dir ? 62 - st : st + 1, s2 ^ 1); MSEQ_ISSUE_VS(dir ? 62 - st : st + 1, (st + 1) % 3);
            if (cwave) MSEQ_CONV_ISSUE(cslot0 + st + 1); }
        const LAS unsigned char* QT = QS + s2 * 16384; const LAS unsigned char* KT = KS + s2 * 16384; const LAS unsigned char* VT = VS + s3 * 4096;
        const LAS float* rt = (const LAS float*)(SCS + s3 * 1024); const LAS float* ct = rt + 64;
        if (wid < 4) {
            if (st < 64) {
                const int jt = wid >> 1, stt = wid & 1;
                const LAS unsigned char* qa = QT + qrd + jt * 512;
                const LAS unsigned char* kb = KT + (2 * stt + (r32 >> 4)) * 1024 + (r32 & 15) * 64 + hh * 16;
                const int j = 32 * jt + r32; const float rtj = rt[j];
                const LAS float* ctp = ct + 32 * stt + 4 * hh;
                f32x4 c4[4];
#pragma unroll
                for (int rg = 0; rg < 4; ++rg) c4[rg] = *(const LAS f32x4*)(ctp + 8 * rg);
                const float gm = gmv[c], sp = spv[c];
                const int ck = 4 * wid + (lane & 3), r0 = 4 * (lane >> 2);
                const LAS unsigned char* kr = KT + (ck >> 2) * 4096 + (r0 >> 4) * 1024 + (r0 & 15) * 64 + (ck & 3) * 16;
                u32x4 kw[4];
#pragma unroll
                for (int r = 0; r < 4; ++r) kw[r] = *(const LAS u32x4*)(kr + r * 64);
                const f32x4 ctn = *(const LAS f32x4*)(ct + r0);
                const LAS float* no = NV + s2 * 128 + 32 * wid + 8 * (lane & 3);
                const f32x4 o0 = *(const LAS f32x4*)no, o1 = *(const LAS f32x4*)(no + 4);
                f32x16 S;
                f32x16 S2;
#pragma unroll
                for (int i = 0; i < 16; ++i) { S[i] = 0.f; S2[i] = 0.f; }
#pragma unroll
                for (int ks = 0; ks < 8; ks += 2) { S = MFMA32(*(const LAS bf16x8*)(kb + (ks >> 1) * 4096), *(const LAS bf16x8*)(qa + ks * 2048), S);
                    S2 = MFMA32(*(const LAS bf16x8*)(kb + (ks >> 1) * 4096 + 32), *(const LAS bf16x8*)(qa + (ks + 1) * 2048), S2); }
#pragma unroll
                for (int i = 0; i < 16; ++i) S[i] += S2[i];
                float pa[8];
#pragma unroll
                for (int e = 0; e < 8; ++e) pa[e] = 0.f;
#pragma unroll
                for (int r = 0; r < 4; ++r) { const u32x4 w = kw[r]; const float ws_ = __builtin_amdgcn_exp2f(ctn[r] + gm);
                    pa[0] += ws_ * bflo(w.x); pa[1] += ws_ * bfhi(w.x); pa[2] += ws_ * bflo(w.y); pa[3] += ws_ * bfhi(w.y); pa[4] += ws_ * bflo(w.z); pa[5] += ws_ * bfhi(w.z); pa[6] += ws_ * bflo(w.w); pa[7] += ws_ * bfhi(w.w); }
#pragma unroll
                for (int e = 0; e < 8; ++e) { float t = pa[e]; t += dpp_mov<DPP_ROR(8)>(t); t += dpp_mov<DPP_ROR(4)>(t); t = xor16_sum(t); pa[e] = xor32_sum(t); }
                u32x2 sw2[4];
#pragma unroll
                for (int rg = 0; rg < 4; ++rg) { float v[4];
#pragma unroll
                    for (int e = 0; e < 4; ++e) { const int sc = 32 * stt + 8 * rg + 4 * hh + e; const bool ok = dir == 0 ? (sc <= j) : (sc >= j);
                        v[e] = S[4 * rg + e] * __builtin_amdgcn_exp2f(ok ? rtj + c4[rg][e] : -1.0e30f); }
                    sw2[rg].x = pk2(v[0], v[1]); sw2[rg].y = pk2(v[2], v[3]); }
                LAS unsigned char* sw = SD + s2 * 8192 + stt * 4096 + j * 16 + hh * 8;
#pragma unroll
                for (int rg = 0; rg < 4; ++rg) *(LAS u32x2*)(sw + rg * 1024) = sw2[rg];
                if (lane < 4) { LAS float* nn = NV + (s2 ^ 1) * 128 + 32 * wid + 8 * lane;
                    *(LAS f32x4*)nn = (f32x4){sp * o0.x + pa[0], sp * o0.y + pa[1], sp * o0.z + pa[2], sp * o0.w + pa[3]};
                    *(LAS f32x4*)(nn + 4) = (f32x4){sp * o1.x + pa[4], sp * o1.y + pa[5], sp * o1.z + pa[6], sp * o1.w + pa[7]}; }
            }
        } else if (wid < 6) {
            const int jt = wid - 4, jl = 32 * jt + r32;
            u32x2 hw[4]; bool have_h = false; int cp = 0;
            if (st > 0) {
                cp = dir ? 64 - st : st - 1; have_h = true;
                const LAS float* iw = (const LAS float*)(SCS + s3p * 1024) + 128; const LAS float* enm = iw + 64;
                const LAS unsigned char* SDp = SD + (s2 ^ 1) * 8192;
                const LAS unsigned char* sr = SDp + hh * 4096 + jl * 16;
                u32x4 w4[4];
#pragma unroll
                for (int ch = 0; ch < 4; ++ch) w4[ch] = *(const LAS u32x4*)(sr + ch * 1024);
                const float iwj = iw[jl], enj = enm[jl];
                const LAS unsigned char* sa = SDp + qrd + jt * 512; const LAS unsigned char* vb = VS + s3p * 4096 + ktr;
                float rsum = 0.f;
#pragma unroll
                for (int ch = 0; ch < 4; ++ch) { const u32x4 w = w4[ch];
                    rsum += (bflo(w.x) + bfhi(w.x)) + (bflo(w.y) + bfhi(w.y)) + (bflo(w.z) + bfhi(w.z)) + (bflo(w.w) + bfhi(w.w)); }
                rsum = xor32_sum(rsum);
                const float den = rsum + iwj * qn;
                const float rdj = 1.f / fmaxf(fabsf(den), enj);
#pragma unroll
                for (int i = 0; i < 16; ++i) acc[i] *= iwj;
#pragma unroll
                for (int ks = 0; ks < 4; ++ks) { const s16x4 lo = trread(vb + ks * 1024), hi = trread(vb + ks * 1024 + 256);
                    acc = MFMA32(__builtin_shufflevector(lo, hi, 0, 1, 2, 3, 4, 5, 6, 7), *(const LAS bf16x8*)(sa + ks * 2048), acc); }
#pragma unroll
                for (int rg = 0; rg < 4; ++rg) { hw[rg].x = pk2(acc[4 * rg] * rdj, acc[4 * rg + 1] * rdj); hw[rg].y = pk2(acc[4 * rg + 2] * rdj, acc[4 * rg + 3] * rdj); }
            }
            if (st < 64) {
                const LAS unsigned char* qa = QT + qrd + jt * 512;
                const LAS unsigned char* cb = CI + s2 * 8192 + hh * 512 + r32 * 16;
                const LAS unsigned char* qr = QT + hh * 8192 + jl * 16; const LAS float* np = NV + s2 * 128 + 64 * hh;
                f32x16 acc2;
#pragma unroll
                for (int i = 0; i < 16; ++i) { acc[i] = 0.f; acc2[i] = 0.f; }
#pragma unroll
                for (int ks = 0; ks < 8; ks += 2) { acc = MFMA32(*(const LAS bf16x8*)(cb + ks * 1024), *(const LAS bf16x8*)(qa + ks * 2048), acc);
                    acc2 = MFMA32(*(const LAS bf16x8*)(cb + (ks + 1) * 1024), *(const LAS bf16x8*)(qa + (ks + 1) * 2048), acc2); }
#pragma unroll
                for (int i = 0; i < 16; ++i) acc[i] += acc2[i];
                qn = 0.f;
#pragma unroll
                for (int ch = 0; ch < 8; ++ch) { const u32x4 w = *(const LAS u32x4*)(qr + ch * 1024); const f32x4 n0 = *(const LAS f32x4*)(np + ch * 8), n1 = *(const LAS f32x4*)(np + ch * 8 + 4);
                    qn += bflo(w.x) * n0.x + bfhi(w.x) * n0.y + bflo(w.y) * n0.z + bfhi(w.y) * n0.w + bflo(w.z) * n1.x + bfhi(w.z) * n1.y + bflo(w.w) * n1.z + bfhi(w.w) * n1.w; }
                qn = xor32_sum(qn);
            }
            if (have_h) {
                LAS unsigned char* hst = HST + jt * 2048;
#pragma unroll
                for (int rg = 0; rg < 4; ++rg) *(LAS u32x2*)(hst + r32 * 64 + (8 * rg + 4 * hh) * 2) = hw[rg];
                asm volatile("s_waitcnt lgkmcnt(0)" ::: "memory");
#pragma unroll
                for (int q = 0; q < 2; ++q) { const int row = 16 * q + (lane >> 2), part = lane & 3;
                    const u32x4 w = *(const LAS u32x4*)(hst + row * 64 + part * 16);
                    *(u32x4*)(HD + (size_t)(cp * 64 + 32 * jt + row) * 512 + part * 8) = w; }
            }
        } else if (st < 64) {
            const int u = wid - 6; const float gm = gmv[c], sp = spv[c];
            const LAS unsigned char* va = VT + ktr; const LAS unsigned char* ka = KT + ktr + (2 * u) * 4096;
            s16x4 vlo[4], vhi[4], k0l[4], k0h[4], k1l[4], k1h[4]; f32x4 cw0[4], cw1[4];
#pragma unroll
            for (int ks = 0; ks < 4; ++ks) { vlo[ks] = trread(va + ks * 1024); vhi[ks] = trread(va + ks * 1024 + 256);
                cw0[ks] = *(const LAS f32x4*)(ct + 16 * ks + 8 * hh); cw1[ks] = *(const LAS f32x4*)(ct + 16 * ks + 8 * hh + 4);
                k0l[ks] = trread(ka + ks * 1024); k0h[ks] = trread(ka + ks * 1024 + 256); k1l[ks] = trread(ka + 4096 + ks * 1024); k1h[ks] = trread(ka + 4096 + ks * 1024 + 256); }
#pragma unroll
            for (int i = 0; i < 16; ++i) { Cacc[0][i] *= sp; Cacc[1][i] *= sp; }
#pragma unroll
            for (int ks = 0; ks < 4; ++ks) {
                const s16x4 lo = vlo[ks], hi = vhi[ks]; const f32x4 e0 = cw0[ks], e1 = cw1[ks];
                u32x4 af;
                af.x = pk2(bf2f((bf16_t)lo[0]) * __builtin_amdgcn_exp2f(e0.x + gm), bf2f((bf16_t)lo[1]) * __builtin_amdgcn_exp2f(e0.y + gm));
                af.y = pk2(bf2f((bf16_t)lo[2]) * __builtin_amdgcn_exp2f(e0.z + gm), bf2f((bf16_t)lo[3]) * __builtin_amdgcn_exp2f(e0.w + gm));
                af.z = pk2(bf2f((bf16_t)hi[0]) * __builtin_amdgcn_exp2f(e1.x + gm), bf2f((bf16_t)hi[1]) * __builtin_amdgcn_exp2f(e1.y + gm));
                af.w = pk2(bf2f((bf16_t)hi[2]) * __builtin_amdgcn_exp2f(e1.z + gm), bf2f((bf16_t)hi[3]) * __builtin_amdgcn_exp2f(e1.w + gm));
                const bf16x8 afr = __builtin_bit_cast(bf16x8, af);
                Cacc[0] = MFMA32(__builtin_shufflevector(k0l[ks], k0h[ks], 0, 1, 2, 3, 4, 5, 6, 7), afr, Cacc[0]);
                Cacc[1] = MFMA32(__builtin_shufflevector(k1l[ks], k1h[ks], 0, 1, 2, 3, 4, 5, 6, 7), afr, Cacc[1]);
            }
            LAS unsigned char* cw = CI + (s2 ^ 1) * 8192 + (2 * u) * 2048 + r32 * 16 + hh * 8;
#pragma unroll
            for (int t2 = 0; t2 < 2; ++t2)
#pragma unroll
                for (int rg = 0; rg < 4; ++rg) { u32x2 w; w.x = pk2(Cacc[t2][4 * rg], Cacc[t2][4 * rg + 1]); w.y = pk2(Cacc[t2][4 * rg + 2], Cacc[t2][4 * rg + 3]); *(LAS u32x2*)(cw + t2 * 2048 + rg * 512) = w; }
        }
        if (PROBE_MSEQ_W >= 0) { asm volatile("s_waitcnt lgkmcnt(0)" ::: "memory"); busy += __builtin_amdgcn_s_memtime() - tb0; }
        if (cwave) {
            if (st + 1 < 64) asm volatile("s_waitcnt vmcnt(4)" ::: "memory"); else asm volatile("s_waitcnt vmcnt(0)" ::: "memory");
            if (st < 64) {
                const int id = cslot0 + st, e = id / 6144, r = id % 6144, mat = r >> 11, rr = r & 2047;
                const int nb = mat == 2 ? (rr >> 7) : (rr >> 6), kb = mat == 2 ? (rr & 127) : (rr & 63), n = 64 * nb + lane;
                unsigned char* dst = mat == 2 ? a.ws + WS_WDT + (size_t)e * DM * DFF + (size_t)n * DFF + 16 * kb
                                              : a.ws + WS_WGUT + (size_t)e * 4096 * DM + (size_t)((n >> 7) * 256 + (n & 127) + mat * 128) * DM + 16 * kb;
                const LAS float* CSC = (const LAS float*)(F.lds + 119808 + cwi * 8192 + (id & 1) * 4096);
                float cv[16];
#pragma unroll
                for (int k = 0; k < 16; ++k) cv[k] = CSC[k * 64 + lane] * pg8::W_PRESCALE;
                u32x4 o; o.x = pg8::pk4_fp8(cv[0], cv[1], cv[2], cv[3]); o.y = pg8::pk4_fp8(cv[4], cv[5], cv[6], cv[7]); o.z = pg8::pk4_fp8(cv[8], cv[9], cv[10], cv[11]); o.w = pg8::pk4_fp8(cv[12], cv[13], cv[14], cv[15]);
                *(u32x4*)dst = o;
            }
        } else if (wid == 6) asm volatile("s_waitcnt vmcnt(0)" ::: "memory");
        asm volatile("s_waitcnt lgkmcnt(0)" ::: "memory"); __builtin_amdgcn_s_barrier(); asm volatile("" ::: "memory");
        if (PROBE_MSEQ_W >= 0) tb0 = __builtin_amdgcn_s_memtime();
    }
    if (PROBE_MSEQ_W >= 0 && F.bid == 0 && lane == 0 && (wid == PROBE_MSEQ_W || (PROBE_MSEQ_W == 8 && wid == 0)))
        *(volatile LAS unsigned long long*)(F.lds + LDS_BYTES - 128) = (PROBE_MSEQ_W == 8) ? (__builtin_amdgcn_s_memtime() - titem0) : busy;
    asm volatile("s_waitcnt vmcnt(0)" ::: "memory");
#undef MSEQ_ISSUE_QK
#undef MSEQ_ISSUE_VS
#undef MSEQ_CONV_ISSUE
}

DI void glds16(const void* g, LAS unsigned char* l) { __builtin_amdgcn_global_load_lds((const unsigned*)g, (LAS unsigned*)l, 16, 0, 0); }
DI void attn_unit(const Ctx& F, const Args& a, int b, int h, int qb, float lam, float cshift) {
    const int lane = F.lane, wid = F.wave, r32 = lane & 31, hh = lane >> 5, rg = wid & 3, p = wid >> 2;
    const bf16_t* projb = (const bf16_t*)(a.ws + WS_PROJ) + (size_t)b * SEQ * PS;
    const int qrow = qb * 128 + rg * 32 + r32;
    bf16x8 qf[4];
    { const bf16_t* qp = projb + (size_t)qrow * PS + C_QA + h * 128 + p * 64 + hh * 8;
#pragma unroll
      for (int ks = 0; ks < 4; ++ks) qf[ks] = *(const bf16x8*)(qp + ks * 16); }
    const bf16_t* kimg = (const bf16_t*)(a.ws + WS_KIMG) + (size_t)(b * 4 + h) * 64 * 8192 + (4 * wid) * 512 + lane * 8;
    const bf16_t* vimg = (const bf16_t*)(a.ws + WS_VIMG) + (size_t)(b * 4 + h) * 64 * 8192 + (4 * wid) * 512 + lane * 8;
    const unsigned ldsw = (unsigned)__builtin_amdgcn_readfirstlane((int)(unsigned)(uintptr_t)F.lds + (4 * wid) * 1024);
#define ATT_ISSUE2(img, t0, ldsoff) do { const int _q0 = 4 * wid; const int _t = (t0) + (_q0 >> 4); const bf16_t* _tp = (img) + (size_t)(_t < 64 ? _t : 63) * 8192 - (size_t)(_q0 & 16) * 512; \
        const unsigned _d = (unsigned)__builtin_amdgcn_readfirstlane((int)(ldsw + (ldsoff))); \
        _Pragma("unroll") for (int _i = 0; _i < 4; ++_i) glds16_asm(_tp + _i * 512, _d + _i * 1024); } while (0)
    if (wid < 4) { const bf16_t* _tp = kimg; const unsigned _d = (unsigned)__builtin_amdgcn_readfirstlane((int)(ldsw + 32768));
#pragma unroll
        for (int _i = 0; _i < 4; ++_i) glds16_asm(_tp + _i * 512, _d + _i * 1024); }
    ATT_ISSUE2(kimg, 1, 0); ATT_ISSUE2(vimg, 0, 65536);
    f32x16 O[4];
#pragma unroll
    for (int vt = 0; vt < 4; ++vt)
#pragma unroll
        for (int i = 0; i < 16; ++i) O[vt][i] = 0.f;
    float lsum = 0.f;
    const int kfb = p * 8192 + hh * 1024 + r32 * 16;
    const int vfb = (4 * hh + ((lane & 15) >> 2)) * 64 + ((lane >> 4) & 1) * 32 + (lane & 3) * 8;
    bf16x8 pb[4], pc[4];
    asm volatile("s_waitcnt vmcnt(0)" ::: "memory");
    __syncthreads();
#define ATT_VLOAD(dst, Vb, kg) do { _Pragma("unroll") for (int vt = 0; vt < 4; ++vt) { \
        const s16x4 _lo = trread((Vb) + vt * 4096 + (kg) * 1024), _hi = trread((Vb) + vt * 4096 + (kg) * 1024 + 512); dst[vt] = __builtin_shufflevector(_lo, _hi, 0, 1, 2, 3, 4, 5, 6, 7); } } while (0)
#define ATT_PV(vf, kg, PIN) do { __builtin_amdgcn_s_setprio(1); _Pragma("unroll") for (int vt = 0; vt < 4; ++vt) O[vt] = MFMA32(vf[vt], PIN[kg], O[vt]); __builtin_amdgcn_s_setprio(0); } while (0)
#define ATT_EXPQ(S, o, dst) do { float _e[8]; _Pragma("unroll") for (int i = 0; i < 8; ++i) _e[i] = __builtin_amdgcn_exp2f(S[(o) + i]); \
        _Pragma("unroll") for (int i = 0; i < 8; ++i) ls = ls + _e[i]; \
        u32x4 _w; _w.x = pk2(_e[0], _e[1]); _w.y = pk2(_e[2], _e[3]); _w.z = pk2(_e[4], _e[5]); _w.w = pk2(_e[6], _e[7]); dst = __builtin_bit_cast(bf16x8, _w); } while (0)
#define ATT_STEP(Kb, Vb, on0, PIN, POUT) do { \
        bf16x8 kfa[4], kfb2[4], vA[4], vB[4]; float ls = 0.f; \
        _Pragma("unroll") for (int ks = 0; ks < 4; ++ks) { kfa[ks] = *(const LAS bf16x8*)((Kb) + ks * 2048); kfb2[ks] = *(const LAS bf16x8*)((Kb) + ks * 2048 + 512); } \
        ATT_VLOAD(vA, Vb, 0); \
        __builtin_amdgcn_s_setprio(1); \
        Sa = MFMA32(kfa[0], qf[0], negc); Sb = MFMA32(kfb2[0], qf[0], negc);        \
        _Pragma("unroll") for (int ks = 1; ks < 4; ++ks) { Sa = MFMA32(kfa[ks], qf[ks], Sa); Sb = MFMA32(kfb2[ks], qf[ks], Sb); } \
        __builtin_amdgcn_s_setprio(0); \
        ATT_VLOAD(vB, Vb, 1); ATT_PV(vA, 0, PIN); ATT_EXPQ(Sa, 0, POUT[0]); \
        ATT_VLOAD(vA, Vb, 2); ATT_PV(vB, 1, PIN); ATT_EXPQ(Sa, 8, POUT[1]); \
        ATT_VLOAD(vB, Vb, 3); ATT_PV(vA, 2, PIN); ATT_EXPQ(Sb, 0, POUT[2]); \
        ATT_PV(vB, 3, PIN); ATT_EXPQ(Sb, 8, POUT[3]); \
        lsum += (on0) ? ls : 0.f; } while (0)
    f32x16 Sa, Sb, negc;
#pragma unroll
    for (int i = 0; i < 16; ++i) negc[i] = -cshift;
    asm volatile("" : "+v"(negc));
    {
        const LAS unsigned char* Kb = F.lds + 32768 + kfb;
        Sa = MFMA32(*(const LAS bf16x8*)(Kb), qf[0], negc); Sb = MFMA32(*(const LAS bf16x8*)(Kb + 512), qf[0], negc);
#pragma unroll
        for (int ks = 1; ks < 4; ++ks) { Sa = MFMA32(*(const LAS bf16x8*)(Kb + ks * 2048), qf[ks], Sa); Sb = MFMA32(*(const LAS bf16x8*)(Kb + ks * 2048 + 512), qf[ks], Sb); }
        float ls = 0.f;
        ATT_EXPQ(Sa, 0, pb[0]); ATT_EXPQ(Sa, 8, pb[1]); ATT_EXPQ(Sb, 0, pb[2]); ATT_EXPQ(Sb, 8, pb[3]);
        lsum += ls;
    }
    __syncthreads();
#pragma unroll 1
    for (int T = 0; T < 32; ++T) {
        const int j = T & 1;
        ATT_ISSUE2(kimg, 2 * T + 3, (j ^ 1) * 32768);
        ATT_ISSUE2(vimg, 2 * T + 2, 65536 + (j ^ 1) * 32768);
        const LAS unsigned char* Ks = F.lds + j * 32768 + kfb; const LAS unsigned char* Vs = F.lds + 65536 + j * 32768 + vfb;
        ATT_STEP(Ks, Vs, true, pb, pc);
        ATT_STEP(Ks + 16384, Vs + 16384, T < 31, pc, pb);
        asm volatile("s_waitcnt vmcnt(0)" ::: "memory");
        __syncthreads();
    }
#undef ATT_EXPQ
#undef ATT_STEP
#undef ATT_VLOAD
#undef ATT_PV
#undef ATT_ISSUE2
    lsum += __shfl_xor(lsum, 32);
    LAS float* X = (LAS float*)(F.lds + 65536) + rg * 4096 + r32;
    if (p == 1) {
        const float sc = lam / lsum;
#pragma unroll
        for (int vt = 0; vt < 4; ++vt)
#pragma unroll
            for (int i = 0; i < 16; ++i) X[(32 * vt + crow(i, hh)) * 32] = O[vt][i] * sc;
    }
    __syncthreads();
    if (p == 0) {
        const float i0 = 1.f / lsum;
        float ssq = 0.f;
#pragma unroll
        for (int vt = 0; vt < 4; ++vt)
#pragma unroll
            for (int i = 0; i < 16; ++i) { const float o = O[vt][i] * i0 - X[(32 * vt + crow(i, hh)) * 32]; O[vt][i] = o; ssq += o * o; }
        ssq += __shfl_xor(ssq, 32);
        const float rs = rsqrtf(ssq * (1.f / 128.f) + EPS) * 0.8f;
        bf16_t* yp = (bf16_t*)(a.ws + WS_YMIX) + (size_t)(b * SEQ + qrow) * DM + 512 + h * 128;
#pragma unroll
        for (int vt = 0; vt < 4; ++vt)
#pragma unroll
            for (int rgi = 0; rgi < 4; ++rgi) { const int vd = 32 * vt + 8 * rgi + 4 * hh; const f32x4 g = *(const f32x4*)(a.subln_g + vd);
                u32x2 w; w.x = pk2(O[vt][4 * rgi] * rs * g.x, O[vt][4 * rgi + 1] * rs * g.y); w.y = pk2(O[vt][4 * rgi + 2] * rs * g.z, O[vt][4 * rgi + 3] * rs * g.w);
                *(u32x2*)(yp + vd) = w; }
    }
    __syncthreads();
}

DI void mcombine_phase(const Ctx& F, const Args& a) {
    const int gw = F.bid * NWAVES + F.wave, NGW = F.G * NWAVES, lane = F.lane;
    const bf16_t* HD = (const bf16_t*)((const unsigned char*)a.out + DO_HD);
    float g[8];
#pragma unroll
    for (int i = 0; i < 8; ++i) g[i] = a.mnorm_g[lane * 8 + i];
    for (int m = gw; m < MTOK; m += NGW) {
        const u32x4 f = *(const u32x4*)(HD + (size_t)m * 512 + lane * 8), bw = *(const u32x4*)(HD + ((size_t)MTOK + m) * 512 + lane * 8);
        const u32x4 om = *(const u32x4*)((const bf16_t*)(a.ws + WS_PROJ) + (size_t)m * PS + C_OM + lane * 8);
        float v[8];
        v[0] = bflo(f.x) + bflo(bw.x); v[1] = bfhi(f.x) + bfhi(bw.x); v[2] = bflo(f.y) + bflo(bw.y); v[3] = bfhi(f.y) + bfhi(bw.y);
        v[4] = bflo(f.z) + bflo(bw.z); v[5] = bfhi(f.z) + bfhi(bw.z); v[6] = bflo(f.w) + bflo(bw.w); v[7] = bfhi(f.w) + bfhi(bw.w);
        float ss = 0.f;
#pragma unroll
        for (int i = 0; i < 8; ++i) ss += v[i] * v[i];
        ss += __shfl_xor(ss, 1); ss += __shfl_xor(ss, 2); ss += __shfl_xor(ss, 4); ss += __shfl_xor(ss, 8);
        const float rstd = rsqrtf(ss * (1.f / 128.f) + EPS);
        float o[8];
        o[0] = bflo(om.x); o[1] = bfhi(om.x); o[2] = bflo(om.y); o[3] = bfhi(om.y); o[4] = bflo(om.z); o[5] = bfhi(om.z); o[6] = bflo(om.w); o[7] = bfhi(om.w);
#pragma unroll
        for (int i = 0; i < 8; ++i) v[i] = v[i] * rstd * g[i] * sigmoid_f(o[i]);
        u32x4 w; w.x = pk2(v[0], v[1]); w.y = pk2(v[2], v[3]); w.z = pk2(v[4], v[5]); w.w = pk2(v[6], v[7]);
        bf16_t* yp = (bf16_t*)(a.ws + WS_YMIX) + (size_t)m * DM + lane * 8;
        *(u32x4*)yp = w;
    }
}

DI void router_finish(const float (&lg)[16], int lane, float* affrow, bool store) {
    float r8[8];
#pragma unroll
    for (int i = 0; i < 8; ++i) { const float keep = hh_sel(lane, 32) ? lg[8 + i] : lg[i], send = hh_sel(lane, 32) ? lg[i] : lg[8 + i]; r8[i] = keep + partner32(send, lane); }
    float r4[4];
#pragma unroll
    for (int i = 0; i < 4; ++i) { const float keep = hh_sel(lane, 16) ? r8[4 + i] : r8[i], send = hh_sel(lane, 16) ? r8[i] : r8[4 + i]; r4[i] = keep + partner16(send, lane); }
    float r2[2];
#pragma unroll
    for (int i = 0; i < 2; ++i) { const float keep = hh_sel(lane, 8) ? r4[2 + i] : r4[i], send = hh_sel(lane, 8) ? r4[i] : r4[2 + i]; r2[i] = keep + partner8(send); }
    float lgt; { const float keep = hh_sel(lane, 4) ? r2[1] : r2[0], send = hh_sel(lane, 4) ? r2[0] : r2[1]; lgt = keep + partner4(send, lane); }
    lgt += dpp_mov<DPP_XOR2>(lgt); lgt += dpp_mov<DPP_XOR1>(lgt);
    float mx = lgt; mx = fmaxf(mx, dpp_mov<DPP_ROR(8)>(mx)); mx = fmaxf(mx, dpp_mov<DPP_ROR(4)>(mx)); mx = xor16_max(mx); mx = xor32_max(mx);
    const float ex = __expf(lgt - mx); float sm = ex; sm += dpp_mov<DPP_ROR(8)>(sm); sm += dpp_mov<DPP_ROR(4)>(sm); sm = xor16_sum(sm); sm = xor32_sum(sm);
    if ((lane & 3) == 0 && store) affrow[lane >> 2] = ex / sm;
}
DI void p7_phase(const Ctx& F, const Args& a) {
    LAS f32x4* WRL = (LAS f32x4*)F.lds;
    for (int q = F.tid; q < 4096; q += NTHR) { const int k = q >> 2, g = q & 3; WRL[(g * 4 + (k & 3)) * 256 + ((k >> 2) & 63) + 64 * (k >> 8)] = *(const f32x4*)(a.w_router + k * 16 + g * 4); }
    __syncthreads();
    const int gw = F.bid * NWAVES + F.wave, NGW = F.G * NWAVES, lane = F.lane;
    const float* mod = (const float*)(a.ws + WS_MOD);
    unsigned char* H2 = a.ws + WS_H2; float* AFF = (float*)(a.ws + WS_AFF);
    for (int m = gw; m < MTOK; m += NGW) {
        const int b = m / SEQ;
        const u32x2* xr = (const u32x2*)((const bf16_t*)(a.ws + WS_X1B) + (size_t)m * DM) + lane;
        f32x4 v[4]; float s = 0.f;
#pragma unroll
        for (int j = 0; j < 4; ++j) { const u32x2 w = xr[64 * j]; v[j].x = bflo(w.x); v[j].y = bfhi(w.x); v[j].z = bflo(w.y); v[j].w = bfhi(w.y);
            s += (v[j].x * v[j].x + v[j].y * v[j].y) + (v[j].z * v[j].z + v[j].w * v[j].w); }
        const float rstd = rsqrtf(wave_sum(s) * (1.f / DM) + EPS);
        float lg[16];
#pragma unroll
        for (int e = 0; e < 16; ++e) lg[e] = 0.f;
        unsigned* o4 = (unsigned*)(H2 + (size_t)m * DM) + lane;
#pragma unroll
        for (int j = 0; j < 4; ++j) {
            const f32x4 g = ((const f32x4*)a.norm2_g)[lane + 64 * j];
            const f32x4 sh = ((const f32x4*)(mod + (size_t)b * 6144 + 3072))[lane + 64 * j];
            const f32x4 sc = ((const f32x4*)(mod + (size_t)b * 6144 + 4096))[lane + 64 * j];
            const f32x4 hv = v[j] * rstd * g * (sc + 1.f) + sh;
            o4[64 * j] = pg8::pk4_fp8(hv.x, hv.y, hv.z, hv.w);
#pragma unroll
            for (int e = 0; e < 4; ++e) { const float he = hv[e];
#pragma unroll
                for (int g4 = 0; g4 < 4; ++g4) { const f32x4 w = WRL[(g4 * 4 + e) * 256 + lane + 64 * j];
                    lg[g4 * 4 + 0] += he * w.x; lg[g4 * 4 + 1] += he * w.y; lg[g4 * 4 + 2] += he * w.z; lg[g4 * 4 + 3] += he * w.w; } }
            __builtin_amdgcn_sched_barrier(0);
        }
        router_finish(lg, lane, AFF + (size_t)m * 16, true);
    }
    __syncthreads();
}

DI void topk_task(const Ctx& F, const Args& a, int task) {
    const int b = task >> 4, e = task & 15, tid = F.tid, lane = F.lane;
    const float* AFF = (const float*)(a.ws + WS_AFF) + (size_t)b * SEQ * 16 + e;
    LAS unsigned* hist = (LAS unsigned*)F.lds;
    LAS unsigned* sfx = hist + 256;
    LAS unsigned* misc = hist + 512;
    unsigned key[8];
#pragma unroll
    for (int i = 0; i < 8; ++i) key[i] = __float_as_uint(AFF[(size_t)(tid * 8 + i) * 16]);
    unsigned prefix = 0, krem = CAP;
#pragma unroll 1
    for (int pass = 0; pass < 4; ++pass) {
        const int shift = 24 - 8 * pass;
        if (tid < 256) hist[tid] = 0;
        __syncthreads();
#pragma unroll
        for (int i = 0; i < 8; ++i) { const bool in = pass == 0 ? true : ((key[i] >> (shift + 8)) == (prefix >> (shift + 8))); if (in) atomicAdd((unsigned*)&hist[(key[i] >> shift) & 255u], 1u); }
        __syncthreads();
        if (tid < 256) sfx[tid] = hist[tid];
        __syncthreads();
#pragma unroll 1
        for (int o = 1; o < 256; o <<= 1) { unsigned v = 0; if (tid < 256) v = sfx[tid] + (tid + o < 256 ? sfx[tid + o] : 0u); __syncthreads(); if (tid < 256) sfx[tid] = v; __syncthreads(); }
        if (tid < 256) { const unsigned incl = sfx[tid], excl = incl - hist[tid]; if (excl < krem && krem <= incl) { misc[0] = (unsigned)tid; misc[1] = krem - excl; } }
        __syncthreads();
        prefix |= misc[0] << shift; krem = misc[1];
        __syncthreads();
    }
    const unsigned T = prefix, need = krem;
    unsigned cg_ = 0, ce = 0;
#pragma unroll
    for (int i = 0; i < 8; ++i) { cg_ += key[i] > T; ce += key[i] == T; }
    unsigned sg = cg_, se = ce;
#pragma unroll
    for (int o = 1; o < 64; o <<= 1) { const unsigned tg = __shfl_up(sg, o), te = __shfl_up(se, o); if (lane >= o) { sg += tg; se += te; } }
    if (lane == 63) { misc[16 + F.wave] = sg; misc[32 + F.wave] = se; }
    __syncthreads();
    unsigned og = sg - cg_, oe = se - ce;
    for (int w = 0; w < F.wave; ++w) { og += misc[16 + w]; oe += misc[32 + w]; }
    int* SLOT = (int*)(a.ws + WS_SLOT) + (size_t)b * SEQ * 16 + e;
    float* VALS = (float*)(a.ws + WS_VALS) + (size_t)(e * 8 + b) * CAP;
    int* IDX = (int*)(a.ws + WS_IDX) + (size_t)(e * 8 + b) * CAP;
#pragma unroll
    for (int i = 0; i < 8; ++i) {
        const bool gt = key[i] > T, eq = key[i] == T; const bool sel = gt || (eq && oe < need);
        const unsigned pos = og + (oe < need ? oe : need);
        const int s = tid * 8 + i;
        SLOT[(size_t)s * 16] = sel ? (int)pos : -1;
        if (sel) { IDX[pos] = b * SEQ + s; VALS[pos] = __uint_as_float(key[i]); }
        og += gt; oe += eq;
    }
    __syncthreads();
}

DI void final_phase(const Ctx& F, const Args& a) {
    const int gw = F.bid * NWAVES + F.wave, NGW = F.G * NWAVES, lane = F.lane;
    const float* mod = (const float*)(a.ws + WS_MOD); const int* SLOT = (const int*)(a.ws + WS_SLOT); const unsigned char* Y = a.ws + WS_Y;
    for (int m = gw; m < MTOK; m += NGW) {
        const int b = m / SEQ;
        const int sl = SLOT[(size_t)m * 16 + (lane & 15)];
        f32x4* op = (f32x4*)(a.out + (size_t)m * DM + lane * 16);
        f32x4 xv[4];
        { const u32x4* xp = (const u32x4*)((const bf16_t*)(a.ws + WS_X1B) + (size_t)m * DM + lane * 16); const u32x4 w0 = xp[0], w1 = xp[1];
          xv[0].x = bflo(w0.x); xv[0].y = bfhi(w0.x); xv[0].z = bflo(w0.y); xv[0].w = bfhi(w0.y); xv[1].x = bflo(w0.z); xv[1].y = bfhi(w0.z); xv[1].z = bflo(w0.w); xv[1].w = bfhi(w0.w);
          xv[2].x = bflo(w1.x); xv[2].y = bfhi(w1.x); xv[2].z = bflo(w1.y); xv[2].w = bfhi(w1.y); xv[3].x = bflo(w1.z); xv[3].y = bfhi(w1.z); xv[3].z = bflo(w1.w); xv[3].w = bfhi(w1.w); }
        float acc[16];
#pragma unroll
        for (int i = 0; i < 16; ++i) acc[i] = 0.f;
#pragma unroll 1
        for (int e = 0; e < 16; ++e) { const int s = __shfl(sl, e);
            if (s >= 0) { const u32x4 w = *(const u32x4*)(Y + ((size_t)(e * 8 + b) * CAP + s) * DM + lane * 16);
#pragma unroll
                for (int q = 0; q < 4; ++q) { const unsigned ww = w[q];
                    const auto lo = __builtin_amdgcn_cvt_pk_f32_fp8((int)ww, false), hi = __builtin_amdgcn_cvt_pk_f32_fp8((int)ww, true);
                    acc[4 * q] += lo[0]; acc[4 * q + 1] += lo[1]; acc[4 * q + 2] += hi[0]; acc[4 * q + 3] += hi[1]; } } }
        const f32x4* gp = (const f32x4*)(mod + (size_t)b * 6144 + 5120 + lane * 16);
#pragma unroll
        for (int q = 0; q < 4; ++q) { const f32x4 g = gp[q] * (1.f / pg8::Y_PRESCALE); f32x4 o = xv[q]; o.x += g.x * acc[4 * q]; o.y += g.y * acc[4 * q + 1]; o.z += g.z * acc[4 * q + 2]; o.w += g.w * acc[4 * q + 3]; op[q] = o; }
    }
}

#define XB_TMO      128
#define XB_XCNT(j)  (256  + 64 * (j))
#define XB_XSUB(j)  (1280 + 64 * (j))
#define XB_XGEN(j)  (2304 + 64 * (j))
#define XB_TOP      3328
#define XB_TOPGEN   3392
#define XB_SPIN_CAP (1u << 18)
DI unsigned xb_ld(unsigned* p)              { return __hip_atomic_load(p, __ATOMIC_RELAXED, __HIP_MEMORY_SCOPE_AGENT); }
DI unsigned xb_add(unsigned* p, unsigned v) { return __hip_atomic_fetch_add(p, v, __ATOMIC_RELAXED, __HIP_MEMORY_SCOPE_AGENT); }
DI unsigned xb_xcc_id() { return (unsigned)__builtin_amdgcn_s_getreg((3 << 11) | 20) & 0xFu; }
#define XB_SPIN(cond, bar) do { unsigned _sp = 0; while (cond) { __builtin_amdgcn_s_sleep(1); \
    if ((++_sp & 255u) == 0u) { if (xb_ld(&(bar)[XB_TMO])) break; if (_sp > XB_SPIN_CAP) { atomicAdd(&(bar)[XB_TMO], 1u); break; } } } } while (0)
struct XcdBarrier { unsigned* bar; unsigned x; volatile LAS unsigned* st; };
DI XcdBarrier xcd_barrier_post(unsigned* bar, volatile LAS unsigned* st) {
    XcdBarrier b; b.bar = bar; b.x = xb_xcc_id(); b.st = st;
    if (threadIdx.x == 0) (void)xb_add(&bar[XB_XCNT(b.x)], 1u);
    return b;
}
DI void xcd_barrier_complete(unsigned* bar, unsigned x, unsigned& nloc, unsigned& nx) {
    const unsigned G = gridDim.x * gridDim.y * gridDim.z;
    unsigned sum, cnt, mine, sp = 0u;
    for (;;) {
        sum = 0u; cnt = 0u; mine = 0u;
#pragma unroll
        for (unsigned j = 0; j < 16; ++j) { const unsigned c = xb_ld(&bar[XB_XCNT(j)]); sum += c; cnt += (c > 0u) ? 1u : 0u; mine = (j == x) ? c : mine; }
        if (sum == G) break;
        __builtin_amdgcn_s_sleep(1);
        if ((++sp & 255u) == 0u) { if (xb_ld(&bar[XB_TMO])) break; if (sp > XB_SPIN_CAP) { atomicAdd(&bar[XB_TMO], 1u); break; } }
    }
    nloc = mine > 0u ? mine : 1u; nx = cnt > 0u ? cnt : 1u;
}
DI void xcd_barrier(const XcdBarrier& b) {
    asm volatile("s_waitcnt vmcnt(0)" ::: "memory");
    __syncthreads();
    if (threadIdx.x == 0) {
        unsigned* bar = b.bar;
        __builtin_amdgcn_s_waitcnt(0);
        unsigned nloc = b.st[0], nx = b.st[1];
        if (nloc == 0u) { xcd_barrier_complete(bar, b.x, nloc, nx); b.st[0] = nloc; b.st[1] = nx; }
        const unsigned old = xb_add(&bar[XB_XSUB(b.x)], 1u);
        const unsigned gen = old / nloc;
        if (old + 1u == (gen + 1u) * nloc) {
            __builtin_amdgcn_fence(__ATOMIC_RELEASE, "agent");
            asm volatile("s_waitcnt vmcnt(0)" ::: "memory");
            const unsigned og = xb_add(&bar[XB_TOP], 1u);
            const unsigned tg = og / nx;
            if (og + 1u == (tg + 1u) * nx) xb_add(&bar[XB_TOPGEN], 1u);
            else XB_SPIN(xb_ld(&bar[XB_TOPGEN]) == tg, bar);
            __builtin_amdgcn_fence(__ATOMIC_ACQUIRE, "agent");
            xb_add(&bar[XB_XGEN(b.x)], 1u);
            asm volatile("s_waitcnt vmcnt(0)" ::: "memory");
        } else {
            XB_SPIN(xb_ld(&bar[XB_XGEN(b.x)]) == gen, bar);
            __builtin_amdgcn_fence(__ATOMIC_ACQUIRE, "agent");
            asm volatile("s_waitcnt vmcnt(0)" ::: "memory");
        }
    }
    __syncthreads();
}

static_assert(sizeof(Args) == 22 * 8, "Args layout");
__global__ void __launch_bounds__(NTHR, 2) fwd_kernel(Args a_unused) {
    extern __shared__ __attribute__((aligned(16))) unsigned char lds_raw[];
    cg::grid_group grid = cg::this_grid();
    Ctx F; F.lds = (LAS unsigned char*)lds_raw; F.tid = threadIdx.x; F.lane = F.tid & 63; F.wave = __builtin_amdgcn_readfirstlane(F.tid >> 6); F.G = gridDim.x; F.bid = blockIdx.x;

    int lo, hi; { typedef __attribute__((address_space(4))) const volatile unsigned long long* kp_t; const unsigned long long ph = ((kp_t)__builtin_amdgcn_kernarg_segment_ptr())[21]; lo = (int)(unsigned)ph; hi = (int)(unsigned)(ph >> 32); }
#ifndef PHASE_MASK
#define PHASE_MASK 0xffff
#endif
#define IN(k) (((PHASE_MASK >> (k)) & 1) && lo <= (k) && (k) < hi)
    volatile LAS unsigned* bst = (volatile LAS unsigned*)(F.lds + LDS_BYTES - 64);
    if (F.tid < 2) bst[F.tid] = 0u;
    __syncthreads();
    XcdBarrier xbar;
    { const Args a0 = load_args(); xbar = xcd_barrier_post((unsigned*)(a0.ws + WS_CTL), bst); }
    volatile LAS unsigned long long* tsl = (volatile LAS unsigned long long*)(F.lds + LDS_BYTES - 256);
    if (PROBE_PHASE >= 0 && F.bid == 0 && F.tid == 0) tsl[0] = __builtin_amdgcn_s_memrealtime();
#define SEAM(k) do { if (IN(k) && IN((k) + 1)) { xcd_barrier(xbar); } \
        if (PROBE_PHASE >= 0 && F.bid == 0 && F.tid == 0) tsl[(k) + 1] = __builtin_amdgcn_s_memrealtime(); } while (0)
    grid.sync();
    if (IN(0)) { const Args a = load_args(); p0_phase(F, a); p1_phase(F, a); }
    if (PROBE_PHASE >= 0 && F.bid == 0 && F.tid == 0) tsl[1] = __builtin_amdgcn_s_memrealtime();
    SEAM(1);
    if (IN(2)) {
        const Args a = load_args();
        pg8::Gemm g{(const bf16_t*)a.out, (const bf16_t*)(a.ws + WS_WINT), MTOK, PS, DM, 1 << 30}; pg8::StaticOrder S; S.init(MTOK, PS, F.G, F.bid);
        pg8::EpiProj E{(bf16_t*)(a.ws + WS_PROJ), a.pos, a.qk_g, (bf16_t*)(a.ws + WS_KIMG), (bf16_t*)(a.ws + WS_VIMG)};
        pg8::gemm_phase<pg8::EpiProj, true, true>(F.lds, g, S, E);
        gates_tasks(F, a);
    }
    SEAM(2);
    if (IN(3)) {
        const Args a = load_args();
        for (int t = F.bid * NWAVES + F.wave; t < MTOK / 8 * 2; t += F.G * NWAVES) conv_task(F, a, t);
        for (int t = F.bid; t < 64; t += F.G) mscal_task(F, a, t);
    }
    SEAM(3);
    if (IN(4)) {
        const Args a = load_args();
        {
#pragma unroll 1
            for (int rep = 0; rep < REP_MSEQ; ++rep)
#pragma unroll 1
            for (int it = F.bid; it < 256; it += F.G) { const int xcd_ = it & 7, j_ = it >> 3; mseq_item(F, a, it, xcd_ * 4 + (j_ >> 3), (j_ >> 2) & 1, j_ & 3); }
        }
        float lam, cshift;
        { const float p01 = wave_sum(a.lam_p[F.lane] * a.lam_p[64 + F.lane]), p23 = wave_sum(a.lam_p[128 + F.lane] * a.lam_p[192 + F.lane]);
          lam = __expf(p01) - __expf(p23) + 0.2f;
          const float gq = wave_max(fabsf(a.qk_g[F.lane])), gk = wave_max(fabsf(a.qk_g[64 + F.lane]));
          cshift = 8.f * gq * gk * 1.4426950408889634f * 1.02f; }
        const int xcd = F.bid & 7, j = F.bid >> 3;
#pragma unroll 1
        for (int rep = 0; rep < REP_ATT; ++rep)
        for (int i = 0; i * F.G < 1024; ++i) {
            int u;
            if (F.G == 256) u = (xcd * 4 + i) * 32 + j; else u = i * F.G + F.bid;
            if (u < 1024) attn_unit(F, a, u >> 7, (u >> 5) & 3, u & 31, lam, cshift);
        }
    }
    SEAM(4);
    if (IN(5)) { const Args a = load_args(); mcombine_phase(F, a); }
    SEAM(5);
    if (IN(6)) {
        const Args a = load_args();
        pg8::Gemm g{(const bf16_t*)(a.ws + WS_YMIX), (const bf16_t*)(a.ws + WS_WOUTT), MTOK, DM, DM, 1 << 30}; pg8::StaticOrder S; S.init(MTOK, DM, F.G, F.bid);
        pg8::EpiX1 E{a.x, (const float*)(a.ws + WS_MOD), (bf16_t*)(a.ws + WS_X1B)};
        pg8::gemm_phase<pg8::EpiX1, true, true>(F.lds, g, S, E);
    }
    SEAM(6);
    if (IN(7)) { const Args a = load_args();
#pragma unroll 1
        for (int rep = 0; rep < REP_P7; ++rep) p7_phase(F, a); }
    SEAM(7);
    if (IN(8)) { const Args a = load_args(); for (int t = F.bid; t < BATCH * NEXP; t += F.G) topk_task(F, a, t); }
    SEAM(8);
    if (IN(9)) {
        const Args a = load_args();
        pg8::Gemm g{(const bf16_t*)(a.ws + WS_H2), (const bf16_t*)(a.ws + WS_WGUT), NPAIR, 4096, DM, 16, (const int*)(a.ws + WS_IDX)};
        pg8::StaticOrder S; S.init(NPAIR, 4096, F.G, F.bid);
        pg8::EpiGU E{a.ws + WS_HH};
#pragma unroll 1
        for (int rep = 0; rep < REP_UP; ++rep)
        pg8::gemm_phase<pg8::EpiGU, true, true, true, true>(F.lds, g, S, E);
    }
    SEAM(9);
    if (IN(10)) {
        const Args a = load_args();
        pg8::Gemm g{(const bf16_t*)(a.ws + WS_HH), (const bf16_t*)(a.ws + WS_WDT), NPAIR, DM, DFF, 16};
        pg8::StaticOrder S; S.init(NPAIR, DM, F.G, F.bid);
        pg8::EpiDown E{a.ws + WS_Y, (const float*)(a.ws + WS_VALS)};
        pg8::gemm_phase<pg8::EpiDown, true, true, true>(F.lds, g, S, E);
    }
    SEAM(10);
    if (IN(11)) { const Args a = load_args(); final_phase(F, a); }
    if (PROBE_MSEQ_W >= 0 && F.bid == 0 && F.tid == 0) {
        const unsigned long long d = *(volatile LAS unsigned long long*)(F.lds + LDS_BYTES - 128), t1 = __builtin_amdgcn_s_memtime();
        while (__builtin_amdgcn_s_memtime() - t1 < 3ull * d) __builtin_amdgcn_s_sleep(8);
    }
    if (PROBE_PHASE >= 0 && F.bid == 0 && F.tid == 0) {
        const unsigned long long t1 = __builtin_amdgcn_s_memrealtime();
        const unsigned long long d = (PROBE_PHASE == 11 ? t1 : tsl[PROBE_PHASE + 1]) - tsl[PROBE_PHASE];
        while (__builtin_amdgcn_s_memrealtime() - t1 < 3ull * d) __builtin_amdgcn_s_sleep(8);
    }
#undef IN
#undef SEAM
}

extern "C" void kernel_launch(void* const* d_in, const int* in_sizes, int n_in, void* d_out, int out_size, void* d_ws, size_t ws_size, hipStream_t stream) {
    static int grid_blocks = 0;
    if (!grid_blocks) {
        int dev = 0, cus = 0, per_cu = 0;
        (void)hipGetDevice(&dev);
        (void)hipDeviceGetAttribute(&cus, hipDeviceAttributeMultiprocessorCount, dev);
        (void)hipFuncSetAttribute((const void*)fwd_kernel, hipFuncAttributeMaxDynamicSharedMemorySize, LDS_BYTES);
        (void)hipOccupancyMaxActiveBlocksPerMultiprocessor(&per_cu, (const void*)fwd_kernel, NTHR, LDS_BYTES);
        if (per_cu < 1) per_cu = 1;
        grid_blocks = cus;
        if (ws_size < WS_END) fprintf(stderr, "kernel_launch: workspace too small: %zu < %zu\n", ws_size, (size_t)WS_END);
    }
    (void)hipMemsetAsync((char*)d_ws + WS_CTL, 0, CTL_ZERO_BYTES, stream);
    Args a{};
    a.x = (const float*)d_in[0]; a.c = (const float*)d_in[1]; a.pos = (const int*)d_in[2]; a.norm1_g = (const float*)d_in[3]; a.norm2_g = (const float*)d_in[4];
    a.w_ada = (const float*)d_in[5]; a.b_ada = (const float*)d_in[6]; a.w_in = (const float*)d_in[7]; a.conv_w = (const float*)d_in[8]; a.gate_b = (const float*)d_in[9];
    a.mnorm_g = (const float*)d_in[10]; a.qk_g = (const float*)d_in[11]; a.lam_p = (const float*)d_in[12]; a.subln_g = (const float*)d_in[13]; a.w_out = (const float*)d_in[14];
    a.w_router = (const float*)d_in[15]; a.w_gate = (const float*)d_in[16]; a.w_up = (const float*)d_in[17]; a.w_down = (const float*)d_in[18];
    a.out = (float*)d_out; a.ws = (unsigned char*)d_ws; a.ph_lo = 0; a.ph_hi = 12;
    void* args[] = {&a};
    hipError_t e = hipLaunchCooperativeKernel((const void*)fwd_kernel, dim3(grid_blocks), dim3(NTHR), args, LDS_BYTES, stream);
    if (e != hipSuccess) fprintf(stderr, "cooperative launch failed: %s (grid %d)\n", hipGetErrorString(e), grid_blocks);
}
```

```cpp
#include <hip/hip_runtime.h>
#include <hip/hip_cooperative_groups.h>
#include <cstdio>
#include <cstdint>
namespace cg = cooperative_groups;

#define LAS __attribute__((address_space(3)))
#define DI __device__ __forceinline__
typedef unsigned short bf16_t;
typedef short bf16x8 __attribute__((ext_vector_type(8)));
typedef short s16x4 __attribute__((ext_vector_type(4)));
typedef float f32x2 __attribute__((ext_vector_type(2)));
typedef float f32x4 __attribute__((ext_vector_type(4)));
typedef float f32x16 __attribute__((ext_vector_type(16)));
typedef unsigned u32x2 __attribute__((ext_vector_type(2)));
typedef unsigned u32x4 __attribute__((ext_vector_type(4)));
typedef __bf16 bf16x2_t __attribute__((ext_vector_type(2)));

constexpr int BATCH = 8, SEQ = 4096, DM = 1024, MTOK = BATCH * SEQ;
constexpr int DIN = 3600, PS = 3584;
constexpr int NEXP = 16, CAP = 512, DFF = 2048;
constexpr int NPAIR = BATCH * NEXP * CAP;
constexpr float EPS = 1e-6f;
constexpr int C_QM = 0, C_KM = 512, C_VM = 1024, C_OM = 1536, C_QA = 2048, C_KA = 2560, C_VA = 3072;

constexpr size_t MiB = 1u << 20;
constexpr size_t WS_CTL = 0;
constexpr int CTL_ZERO_BYTES = 65536;
constexpr size_t WS_MOD = 1 * MiB;
constexpr size_t WS_GATES = 2 * MiB;
constexpr size_t WS_AFF = 4 * MiB;
constexpr size_t WS_IDX = 6 * MiB;
constexpr size_t WS_VALS = 6 * MiB + 256 * 1024;
constexpr size_t WS_MSC = 6 * MiB + 512 * 1024;
constexpr size_t WS_SLOT = 7 * MiB;
constexpr size_t WS_NLOC = 9 * MiB;
constexpr size_t WS_WINT = 11 * MiB;
constexpr size_t WS_WGT = 18 * MiB;
constexpr size_t WS_WOUTT = 19 * MiB;
constexpr size_t WS_WGUT = 21 * MiB;
constexpr size_t WS_WDT = 85 * MiB;
constexpr size_t WS_Y = 117 * MiB;
constexpr size_t WS_PROJ = 213 * MiB;
constexpr size_t WS_YMIX = 117 * MiB;
constexpr size_t WS_KIMG = 437 * MiB;
constexpr size_t WS_VIMG = 469 * MiB;
constexpr size_t WS_HH = 245 * MiB;
constexpr size_t WS_H2 = 437 * MiB;
constexpr size_t WS_X1B = 373 * MiB;
constexpr size_t WS_END = 533 * MiB;

constexpr int LDS_BYTES = 163840;
constexpr int PROBE_MSEQ_W = -1;
constexpr int PROBE_PHASE = -1;
constexpr int REP_M1 = 1, REP_M3 = 1, REP_UP = 1, REP_P0 = 1, REP_SCAN = 1, REP_P7 = 1, REP_ATT = 1, REP_QKT = 1, REP_MSEQ = 1;
constexpr int NWAVES = 8, NTHR = 512;

DI unsigned pk2(float lo, float hi) { f32x2 v = {lo, hi}; bf16x2_t b = __builtin_convertvector(v, bf16x2_t); return __builtin_bit_cast(unsigned, b); }
DI float bflo(unsigned w) { return __uint_as_float(w << 16); }
DI float bfhi(unsigned w) { return __uint_as_float(w & 0xffff0000u); }
DI float bf2f(bf16_t v) { return __uint_as_float((unsigned)v << 16); }
template <int CTRL> DI float dpp_mov(float x) { return __builtin_bit_cast(float, __builtin_amdgcn_update_dpp(0, __builtin_bit_cast(int, x), CTRL, 0xf, 0xf, false)); }
#define DPP_XOR1 0xB1
#define DPP_XOR2 0x4E
#define DPP_ROR(n) (0x120 + (n))
DI float xor16_sum(float x) { const unsigned u = __builtin_bit_cast(unsigned, x); auto r = __builtin_amdgcn_permlane16_swap(u, u, false, false); return __builtin_bit_cast(float, (unsigned)r[0]) + __builtin_bit_cast(float, (unsigned)r[1]); }
DI float xor32_sum(float x) { const unsigned u = __builtin_bit_cast(unsigned, x); auto r = __builtin_amdgcn_permlane32_swap(u, u, false, false); return __builtin_bit_cast(float, (unsigned)r[0]) + __builtin_bit_cast(float, (unsigned)r[1]); }
DI float xor16_max(float x) { const unsigned u = __builtin_bit_cast(unsigned, x); auto r = __builtin_amdgcn_permlane16_swap(u, u, false, false); return fmaxf(__builtin_bit_cast(float, (unsigned)r[0]), __builtin_bit_cast(float, (unsigned)r[1])); }
DI float xor32_max(float x) { const unsigned u = __builtin_bit_cast(unsigned, x); auto r = __builtin_amdgcn_permlane32_swap(u, u, false, false); return fmaxf(__builtin_bit_cast(float, (unsigned)r[0]), __builtin_bit_cast(float, (unsigned)r[1])); }
template <int CTRL, int RM, int BM_> DI float dpp_mov_m(float oldv, float x) { return __builtin_bit_cast(float, __builtin_amdgcn_update_dpp(__builtin_bit_cast(int, oldv), __builtin_bit_cast(int, x), CTRL, RM, BM_, false)); }
DI float wave_prefix_sum(float v) {
    v += dpp_mov_m<0x111, 0xf, 0xf>(0.f, v); v += dpp_mov_m<0x112, 0xf, 0xf>(0.f, v); v += dpp_mov_m<0x114, 0xf, 0xe>(0.f, v); v += dpp_mov_m<0x118, 0xf, 0xc>(0.f, v);
    v += dpp_mov_m<0x142, 0xa, 0xf>(0.f, v); v += dpp_mov_m<0x143, 0xc, 0xf>(0.f, v);
    return v;
}
DI float wave_prefix_max(float v) {
    const float ninf = -__builtin_inff();
    v = fmaxf(v, dpp_mov_m<0x111, 0xf, 0xf>(ninf, v)); v = fmaxf(v, dpp_mov_m<0x112, 0xf, 0xf>(ninf, v)); v = fmaxf(v, dpp_mov_m<0x114, 0xf, 0xe>(ninf, v)); v = fmaxf(v, dpp_mov_m<0x118, 0xf, 0xc>(ninf, v));
    v = fmaxf(v, dpp_mov_m<0x142, 0xa, 0xf>(ninf, v)); v = fmaxf(v, dpp_mov_m<0x143, 0xc, 0xf>(ninf, v));
    return v;
}
DI float partner32(float x, int lane) { const unsigned u = __builtin_bit_cast(unsigned, x); auto r = __builtin_amdgcn_permlane32_swap(u, u, false, false); return __builtin_bit_cast(float, (unsigned)((lane & 32) ? r[0] : r[1])); }
DI float partner16(float x, int lane) { const unsigned u = __builtin_bit_cast(unsigned, x); auto r = __builtin_amdgcn_permlane16_swap(u, u, false, false); return __builtin_bit_cast(float, (unsigned)((lane & 16) ? r[0] : r[1])); }
DI float partner8(float x) { return dpp_mov<DPP_ROR(8)>(x); }
DI float partner4(float x, int lane) { const float a = dpp_mov<DPP_ROR(4)>(x), b = dpp_mov<DPP_ROR(12)>(x); return (lane & 4) ? a : b; }
DI float row_sum16(float v) { v += dpp_mov<DPP_XOR1>(v); v += dpp_mov<DPP_XOR2>(v); v += dpp_mov<DPP_ROR(4)>(v); v += dpp_mov<DPP_ROR(8)>(v); return v; }
DI float wave_sum(float v) { v = row_sum16(v); v = xor16_sum(v); return xor32_sum(v); }
DI float wave_max(float v) { v = fmaxf(v, dpp_mov<DPP_XOR1>(v)); v = fmaxf(v, dpp_mov<DPP_XOR2>(v)); v = fmaxf(v, dpp_mov<DPP_ROR(4)>(v)); v = fmaxf(v, dpp_mov<DPP_ROR(8)>(v)); v = xor16_max(v); return xor32_max(v); }
DI float sigmoid_f(float v) { return __builtin_amdgcn_rcpf(1.f + __builtin_amdgcn_exp2f(-1.4426950408889634f * v)); }
DI float silu_f(float v) { return v * sigmoid_f(v); }
DI float logsigmoid_f(float f) { return fminf(f, 0.f) - log1pf(__expf(-fabsf(f))); }
DI int swz16(int row) { return ((row & 3) << 2) | ((row >> 2) & 3); }
#define MFMA32(a, b, c) __builtin_amdgcn_mfma_f32_32x32x16_bf16((a), (b), (c), 0, 0, 0)
DI s16x4 trread(const LAS unsigned char* p) { return __builtin_bit_cast(s16x4, __builtin_amdgcn_ds_read_tr16_b64_v4i16((LAS s16x4*)p)); }
DI int crow(int r, int hh) { return (r & 3) + 8 * (r >> 2) + 4 * hh; }
DI bool hh_sel(int lane, int bit) { return (lane & bit) != 0; }

namespace pg8 {
constexpr int BM = 256, BK = 64, HALF = 128, HTB = HALF * BK * 2, STAGE_BYTES = 8 * HTB, NXCD = 8, WGM = 8;
DI int lds_byte(int r, int c) { const int st = (r >> 4) * 2 + (c >> 5), rr = r & 15, cc = c & 31, ob = rr * 64 + cc * 2; return st * 1024 + (ob ^ (((ob >> 9) & 1) << 5)); }
DI void stage_rc(int b, int& R, int& C) { const int st = b / 1024, sb = b % 1024, swz = sb ^ (((sb >> 9) & 1) << 5); R = (st >> 1) * 16 + swz / 64; C = (st & 1) * 32 + (swz % 64) / 2; }
DI int perm32(int rho) { const int n = rho >> 4, i = rho & 15; return 8 * (i >> 2) + 4 * n + (i & 3); }
struct Unit { int pm, pn; };
typedef int i32x4_t __attribute__((ext_vector_type(4)));
typedef int i32x8_t __attribute__((ext_vector_type(8)));
DI i32x8_t cat8(bf16x8 lo, bf16x8 hi) { const i32x4_t a = __builtin_bit_cast(i32x4_t, lo), b = __builtin_bit_cast(i32x4_t, hi); return __builtin_shufflevector(a, b, 0, 1, 2, 3, 4, 5, 6, 7); }
struct Gemm { const bf16_t* A; const bf16_t* Bt; int M, N, K, tpg; const int* gidx = nullptr; };
struct StaticOrder {
    int nM, nN, nwg, G, c;
    DI void init(int M, int N, int G_, int c_) { nM = M / BM; nN = N / BM; nwg = nM * nN; G = G_; c = c_; }
    DI bool next(int i, Unit& u) const {
        const long L = (long)i * G + c; if (L >= nwg) return false;
        int wgid = (int)L; { const int q = nwg / NXCD, r = nwg % NXCD, xcd = wgid % NXCD, off = wgid / NXCD; wgid = (xcd < r ? xcd * (q + 1) : r * (q + 1) + (xcd - r) * q) + off; }
        const int nig = WGM * nN, gid = wgid / nig, fm = gid * WGM, gsz = (nM - fm) < WGM ? (nM - fm) : WGM;
        u.pm = fm + ((wgid % nig) % gsz); u.pn = (wgid % nig) / gsz; return true;
    }
};

template <class Epi, bool ALIGN_EPI, bool SP2, bool FP8 = false, bool GATHER = false>
DI void gemm_phase(LAS unsigned char* lds, const Gemm g, const StaticOrder& S, const Epi& E) {
    const int tid = threadIdx.x, wid = __builtin_amdgcn_readfirstlane(tid >> 6), lane = tid & 63, wr = wid >> 2, wc = wid & 3, fr = lane & 15, fq = lane >> 4;
    const int KB = FP8 ? g.K : 2 * g.K, nt = KB / (BK * 2);
    unsigned voffA[2], voffB[2];
#pragma unroll
    for (int i = 0; i < 2; ++i) { int R, C; stage_rc(tid * 16 + i * 8192, R, C); const int Rb = Epi::PERM ? ((R & ~31) + perm32(R & 31)) : R;
        voffA[i] = (unsigned)(R * KB + C * 2); voffB[i] = (unsigned)(Rb * KB + C * 2); }
    int R0g, C0g; stage_rc(tid * 16, R0g, C0g);
    unsigned vgA[2][2], ngA[2][2];
    LAS int* gtab = (LAS int*)(lds + STAGE_BYTES);
    const size_t kstep = (size_t)(BK * 2);
    const size_t hstep = (size_t)HALF * KB;
    const size_t tstep = 2 * hstep;
    const size_t gstep = (size_t)g.N * KB;
    const unsigned ldsw = (unsigned)wid * 1024u;
    const int aoff = lds_byte(wr * 64 + fr, fq * 8), boff = lds_byte(wc * 32 + fr, fq * 8);
#define PG8_SA(b, h) (((b) * 2 + (h)) * HTB)
#define PG8_SB(b, h) ((4 + (b) * 2 + (h)) * HTB)
#define PG8_STAGE(bufoff, gbase, voff) do { _Pragma("unroll") for (int _i = 0; _i < 2; ++_i) \
        __builtin_amdgcn_global_load_lds((const unsigned*)((const char*)(gbase) + (voff)[_i]), (LAS unsigned*)(lds + (bufoff) + ldsw + _i * 8192), 16, 0, 0); } while (0)
#define PG8_STAGE_A(bufoff, gbase, h, nx) do { if constexpr (GATHER) { _Pragma("unroll") for (int _i = 0; _i < 2; ++_i) { const unsigned _o = (nx) ? ngA[h][_i] : vgA[h][_i]; \
        __builtin_amdgcn_global_load_lds((const unsigned*)((const char*)(gbase) + _o), (LAS unsigned*)(lds + (bufoff) + ldsw + _i * 8192), 16, 0, 0); } } \
        else PG8_STAGE(bufoff, (gbase) + (h) * hstep, voffA); } while (0)
#define PG8_LDA(dst, b, h) do { if constexpr (FP8) { _Pragma("unroll") for (int m = 0; m < 4; ++m) dst##8[m] = cat8(*(const LAS bf16x8*)(lds + PG8_SA(b, h) + aoff + m * 2048), *(const LAS bf16x8*)(lds + PG8_SA(b, h) + aoff + m * 2048 + 1024)); } \
        else { _Pragma("unroll") for (int m = 0; m < 4; ++m) _Pragma("unroll") for (int k = 0; k < 2; ++k) dst[m][k] = *(const LAS bf16x8*)(lds + PG8_SA(b, h) + aoff + m * 2048 + k * 1024); } } while (0)
#define PG8_LDB(dst, b, h) do { if constexpr (FP8) { _Pragma("unroll") for (int n = 0; n < 2; ++n) dst##8[n] = cat8(*(const LAS bf16x8*)(lds + PG8_SB(b, h) + boff + n * 2048), *(const LAS bf16x8*)(lds + PG8_SB(b, h) + boff + n * 2048 + 1024)); } \
        else { _Pragma("unroll") for (int n = 0; n < 2; ++n) _Pragma("unroll") for (int k = 0; k < 2; ++k) dst[n][k] = *(const LAS bf16x8*)(lds + PG8_SB(b, h) + boff + n * 2048 + k * 1024); } } while (0)
#define PG8_MMA(ai, bj, At, Bt) do { __builtin_amdgcn_s_setprio(1); \
        if constexpr (FP8) { _Pragma("unroll") for (int m = 0; m < 4; ++m) _Pragma("unroll") for (int n = 0; n < 2; ++n) \
            asm volatile("s_nop 1\n\tv_mfma_f32_16x16x128_f8f6f4 %0, %1, %2, %0" : "+v"(acc[ai][bj][m][n]) : "v"(Bt##8[n]), "v"(At##8[m])); } \
        else { _Pragma("unroll") for (int m = 0; m < 4; ++m) _Pragma("unroll") for (int n = 0; n < 2; ++n) _Pragma("unroll") for (int k = 0; k < 2; ++k) \
            acc[ai][bj][m][n] = __builtin_amdgcn_mfma_f32_16x16x32_bf16(Bt[n][k], At[m][k], acc[ai][bj][m][n], 0, 0, 0); } \
        __builtin_amdgcn_s_setprio(0); } while (0)
#define PG8_WAIT_V(n) asm volatile("s_waitcnt vmcnt(" #n ")" ::: "memory")
#define PG8_WAIT_L(n) asm volatile("s_waitcnt lgkmcnt(" #n ")" ::: "memory")
#define PG8_BAR __builtin_amdgcn_s_barrier()
#define PG8_SCHED __builtin_amdgcn_sched_barrier(0)
    Unit cur, nxt; int ui = 0;
    if (!S.next(0, cur)) return;
    f32x4 acc[2][2][4][2];
#pragma unroll
    for (int a = 0; a < 2; ++a)
#pragma unroll
        for (int b = 0; b < 2; ++b)
#pragma unroll
            for (int m = 0; m < 4; ++m)
#pragma unroll
                for (int n = 0; n < 2; ++n) acc[a][b][m][n] = (f32x4){0.f, 0.f, 0.f, 0.f};
    bf16x8 At[4][2], B0[2][2], B1[2][2]; i32x8_t At8[4], B08[2], B18[2];
    const char* cA = GATHER ? (const char*)g.A : (const char*)g.A + (size_t)cur.pm * tstep; const char* cB = (const char*)g.Bt + (size_t)(cur.pm / g.tpg) * gstep + (size_t)cur.pn * tstep;
    if constexpr (GATHER) {
#pragma unroll
        for (int h = 0; h < 2; ++h)
#pragma unroll
            for (int i = 0; i < 2; ++i) { vgA[h][i] = (unsigned)g.gidx[cur.pm * BM + h * HALF + R0g + 64 * i] * (unsigned)KB + (unsigned)(C0g * 2); ngA[h][i] = vgA[h][i]; }
    }
    if constexpr (SP2) {
        PG8_STAGE(PG8_SB(0, 0), cB, voffB); PG8_STAGE(PG8_SB(0, 1), cB + hstep, voffB); PG8_STAGE_A(PG8_SA(0, 0), cA, 0, false); PG8_STAGE_A(PG8_SA(0, 1), cA, 1, false);
        if (wr == 1) PG8_BAR;
        PG8_WAIT_V(2); PG8_BAR;
        PG8_STAGE(PG8_SB(1, 0), cB + kstep, voffB); PG8_STAGE_A(PG8_SA(1, 0), cA + kstep, 0, false); PG8_STAGE(PG8_SB(1, 1), cB + hstep + kstep, voffB);
        PG8_WAIT_V(6); PG8_BAR;
    } else {
        PG8_STAGE(PG8_SB(0, 0), cB, voffB); PG8_STAGE_A(PG8_SA(0, 0), cA, 0, false); PG8_STAGE(PG8_SB(0, 1), cB + hstep, voffB); PG8_STAGE_A(PG8_SA(0, 1), cA, 1, false);
        if (wr == 1) PG8_BAR;
        PG8_WAIT_V(4); PG8_BAR;
        PG8_STAGE(PG8_SB(1, 0), cB + kstep, voffB); PG8_STAGE_A(PG8_SA(1, 0), cA + kstep, 0, false); PG8_STAGE(PG8_SB(1, 1), cB + hstep + kstep, voffB);
        PG8_WAIT_V(6); PG8_BAR;
    }
    for (;;) {
        const bool has_next = S.next(ui + 1, nxt);
        if constexpr (GATHER) { if (has_next && wid < 4)
            __builtin_amdgcn_global_load_lds((const unsigned*)(g.gidx + nxt.pm * BM + wid * 64 + lane), (LAS unsigned*)(gtab + ((ui + 1) & 1) * 256 + wid * 64), 4, 0, 0); }
        const char* nA = GATHER ? (const char*)g.A : has_next ? (const char*)g.A + (size_t)nxt.pm * tstep : cA;
        const char* nB = has_next ? (const char*)g.Bt + (size_t)(nxt.pm / g.tpg) * gstep + (size_t)nxt.pn * tstep : cB;
        for (int t = 0; t < nt; t += 2) {
            const bool last = (t == nt - 2);
            const char* a1 = cA + (size_t)(t + 1) * kstep;
            const char* a2 = last ? nA : cA + (size_t)(t + 2) * kstep; const char* b2 = last ? nB : cB + (size_t)(t + 2) * kstep;
            const char* a3 = a2 + kstep; const char* b3 = b2 + kstep;
            if constexpr (GATHER) { if (last && has_next) { const LAS int* tb = gtab + ((ui + 1) & 1) * 256 + R0g;
#pragma unroll
                for (int h = 0; h < 2; ++h)
#pragma unroll
                    for (int i = 0; i < 2; ++i) ngA[h][i] = (unsigned)tb[h * HALF + 64 * i] * (unsigned)KB + (unsigned)(C0g * 2); } }
            if constexpr (SP2) {
            PG8_LDB(B0, 0, 0); PG8_LDB(B1, 0, 1); PG8_SCHED; PG8_LDA(At, 0, 0); PG8_STAGE_A(PG8_SA(1, 1), a1, 1, false);
            PG8_WAIT_V(8); PG8_WAIT_L(0); PG8_BAR; PG8_MMA(0, 0, At, B0); PG8_MMA(0, 1, At, B1); PG8_BAR; PG8_SCHED;
            PG8_LDA(At, 0, 1); PG8_STAGE(PG8_SB(0, 0), b2, voffB); PG8_STAGE(PG8_SB(0, 1), b2 + hstep, voffB); PG8_STAGE_A(PG8_SA(0, 0), a2, 0, last);
            PG8_WAIT_V(8); PG8_WAIT_L(0); PG8_BAR; PG8_MMA(1, 0, At, B0); PG8_MMA(1, 1, At, B1); PG8_BAR; PG8_SCHED;
            PG8_LDB(B0, 1, 0); PG8_LDB(B1, 1, 1); PG8_SCHED; PG8_LDA(At, 1, 0); PG8_STAGE_A(PG8_SA(0, 1), a2, 1, last);
            PG8_WAIT_V(8); PG8_WAIT_L(0); PG8_BAR; PG8_MMA(0, 0, At, B0); PG8_MMA(0, 1, At, B1); PG8_BAR; PG8_SCHED;
            PG8_LDA(At, 1, 1); PG8_STAGE(PG8_SB(1, 0), b3, voffB); PG8_STAGE(PG8_SB(1, 1), b3 + hstep, voffB); PG8_STAGE_A(PG8_SA(1, 0), a3, 0, last);
            PG8_WAIT_V(8); PG8_WAIT_L(0); PG8_BAR; PG8_MMA(1, 0, At, B0); PG8_MMA(1, 1, At, B1); PG8_BAR; PG8_SCHED;
            } else {
            PG8_LDB(B0, 0, 0); PG8_SCHED; PG8_LDA(At, 0, 0); PG8_STAGE_A(PG8_SA(1, 1), a1, 1, false);
            PG8_WAIT_L(8); PG8_BAR; PG8_WAIT_L(0); PG8_MMA(0, 0, At, B0); PG8_BAR; PG8_SCHED;
            PG8_LDB(B1, 0, 1); PG8_STAGE(PG8_SB(0, 0), b2, voffB);
            PG8_BAR; PG8_WAIT_L(0); PG8_MMA(0, 1, At, B1); PG8_BAR;
            PG8_LDA(At, 0, 1); PG8_STAGE_A(PG8_SA(0, 0), a2, 0, last);
            PG8_BAR; PG8_WAIT_L(0); PG8_MMA(1, 0, At, B0); PG8_BAR; PG8_SCHED;
            PG8_STAGE(PG8_SB(0, 1), b2 + hstep, voffB);
            PG8_WAIT_V(6); PG8_BAR; PG8_MMA(1, 1, At, B1); PG8_BAR;
            PG8_LDB(B0, 1, 0); PG8_SCHED; PG8_LDA(At, 1, 0); PG8_STAGE_A(PG8_SA(0, 1), a2, 1, last);
            PG8_WAIT_L(8); PG8_BAR; PG8_WAIT_L(0); PG8_MMA(0, 0, At, B0); PG8_BAR; PG8_SCHED;
            PG8_LDB(B1, 1, 1); PG8_STAGE(PG8_SB(1, 0), b3, voffB);
            PG8_BAR; PG8_WAIT_L(0); PG8_MMA(0, 1, At, B1); PG8_BAR;
            PG8_LDA(At, 1, 1); PG8_STAGE_A(PG8_SA(1, 0), a3, 0, last);
            PG8_BAR; PG8_WAIT_L(0); PG8_MMA(1, 0, At, B0); PG8_BAR; PG8_SCHED;
            PG8_STAGE(PG8_SB(1, 1), b3 + hstep, voffB);
            PG8_WAIT_V(6); PG8_BAR; PG8_MMA(1, 1, At, B1); PG8_BAR;
            }
        }
        if constexpr (ALIGN_EPI) { if (wr == 0) PG8_BAR; }
        if constexpr (FP8) asm volatile("s_nop 15\n\ts_nop 7" ::: "memory");
        E(acc, cur, wr, wc, fr, fq);
        if (!has_next) break;
#pragma unroll
        for (int a = 0; a < 2; ++a)
#pragma unroll
            for (int b = 0; b < 2; ++b)
#pragma unroll
                for (int m = 0; m < 4; ++m)
#pragma unroll
                    for (int n = 0; n < 2; ++n) acc[a][b][m][n] = (f32x4){0.f, 0.f, 0.f, 0.f};
        cur = nxt; cA = nA; cB = nB; ++ui;
        if constexpr (GATHER) {
#pragma unroll
            for (int h = 0; h < 2; ++h)
#pragma unroll
                for (int i = 0; i < 2; ++i) vgA[h][i] = ngA[h][i]; }
        if constexpr (ALIGN_EPI) { if (wr == 1) PG8_BAR; }
    }
    PG8_WAIT_V(0);
    if constexpr (!ALIGN_EPI) { if (wr == 0) PG8_BAR; }
    PG8_BAR;
#undef PG8_SA
#undef PG8_SB
#undef PG8_STAGE
#undef PG8_STAGE_A
#undef PG8_LDA
#undef PG8_LDB
#undef PG8_MMA
#undef PG8_WAIT_V
#undef PG8_WAIT_L
#undef PG8_BAR
#undef PG8_SCHED
}

struct EpiBf16 {
    static constexpr bool PERM = true;
    bf16_t* O; int ldc;
    DI void operator()(const f32x4 (&acc)[2][2][4][2], const Unit& u, int wr, int wc, int fr, int fq) const {
        const int row0 = u.pm * BM + wr * 64 + fr, col0 = u.pn * BM + wc * 32 + 8 * fq;
#pragma unroll
        for (int ai = 0; ai < 2; ++ai)
#pragma unroll
            for (int m = 0; m < 4; ++m) { bf16_t* rowp = O + (size_t)(row0 + ai * HALF + m * 16) * ldc + col0;
#pragma unroll
                for (int bj = 0; bj < 2; ++bj) { const f32x4 v0 = acc[ai][bj][m][0], v1 = acc[ai][bj][m][1];
                    u32x4 w; w.x = pk2(v0[0], v0[1]); w.y = pk2(v0[2], v0[3]); w.z = pk2(v1[0], v1[1]); w.w = pk2(v1[2], v1[3]);
                    *(u32x4*)(rowp + bj * HALF) = w; } }
    }
};
struct EpiProj {
    static constexpr bool PERM = true;
    bf16_t* O; const int* pos; const float* qk_g; bf16_t* kimg; bf16_t* vimg;
    DI void operator()(const f32x4 (&acc)[2][2][4][2], const Unit& u, int wr, int wc, int fr, int fq) const {
        const int row0 = u.pm * BM + wr * 64 + fr;
        if (u.pn < 8) {
            const int col0 = u.pn * BM + wc * 32 + 8 * fq;
#pragma unroll
            for (int ai = 0; ai < 2; ++ai)
#pragma unroll
                for (int m = 0; m < 4; ++m) { bf16_t* rowp = O + (size_t)(row0 + ai * HALF + m * 16) * PS + col0;
#pragma unroll
                    for (int bj = 0; bj < 2; ++bj) { const f32x4 v0 = acc[ai][bj][m][0], v1 = acc[ai][bj][m][1];
                        u32x4 w; w.x = pk2(v0[0], v0[1]); w.y = pk2(v0[2], v0[3]); w.z = pk2(v1[0], v1[1]); w.w = pk2(v1[2], v1[3]);
                        *(u32x4*)(rowp + bj * HALF) = w; } }
        } else if (u.pn < 12) {
            const int isk = (u.pn >= 10), hsub = 4 * (u.pn & 1) + wc, h = hsub >> 1, p = hsub & 1;
            const float* gp = qk_g + isk * 64 + 8 * fq;
            const f32x4 g00 = *(const f32x4*)gp, g01 = *(const f32x4*)(gp + 4), g10 = *(const f32x4*)(gp + 32), g11 = *(const f32x4*)(gp + 36);
            const float qs = isk ? 1.f : 0.125f * 1.4426950408889634f;
            const int lane = fr + 16 * fq;
#pragma unroll
            for (int ai = 0; ai < 2; ++ai)
#pragma unroll
                for (int m = 0; m < 4; ++m) { const int row = row0 + ai * HALF + m * 16;
                    f32x4 a0 = acc[ai][0][m][0], a1 = acc[ai][0][m][1], b0 = acc[ai][1][m][0], b1 = acc[ai][1][m][1];
                    float ss = (a0[0] * a0[0] + a0[1] * a0[1] + a0[2] * a0[2] + a0[3] * a0[3]) + (a1[0] * a1[0] + a1[1] * a1[1] + a1[2] * a1[2] + a1[3] * a1[3])
                             + (b0[0] * b0[0] + b0[1] * b0[1] + b0[2] * b0[2] + b0[3] * b0[3]) + (b1[0] * b1[0] + b1[1] * b1[1] + b1[2] * b1[2] + b1[3] * b1[3]);
                    ss = xor16_sum(ss); ss = xor32_sum(ss);
                    const float rstd = rsqrtf(ss * (1.f / 64.f) + EPS);
                    a0 = a0 * rstd * g00; a1 = a1 * rstd * g01; b0 = b0 * rstd * g10 * qs; b1 = b1 * rstd * g11 * qs;
                    const float pf = (float)pos[row];
                    f32x4 r0, r1;
#pragma unroll
                    for (int n = 0; n < 2; ++n)
#pragma unroll
                        for (int j = 0; j < 4; ++j) { const int i = 4 * n + j; const float own = n ? a1[j] : a0[j]; const float oth = partner16(own, lane);
                            const float frc = __builtin_amdgcn_fractf(pf * (exp2f(-(float)i * 0.125f * 18.931568569324174f) * 0.15915494309189535f));
                            const float sn = __builtin_amdgcn_sinf(frc), cs = __builtin_amdgcn_cosf(frc);
                            const float rot = (fq == 0) ? own * cs - oth * sn : own * cs + oth * sn;
                            const float o = (fq < 2) ? rot : own;
                            if (n) r1[j] = o; else r0[j] = o; }
                    r0 = r0 * qs; r1 = r1 * qs;
                    u32x4 w0, w1;
                    w0.x = pk2(r0[0], r0[1]); w0.y = pk2(r0[2], r0[3]); w0.z = pk2(r1[0], r1[1]); w0.w = pk2(r1[2], r1[3]);
                    w1.x = pk2(b0[0], b0[1]); w1.y = pk2(b0[2], b0[3]); w1.z = pk2(b1[0], b1[1]); w1.w = pk2(b1[2], b1[3]);
                    if (!isk) { bf16_t* rowp = O + (size_t)row * PS + C_QA + h * 128 + p * 64 + 8 * fq; *(u32x4*)rowp = w0; *(u32x4*)(rowp + 32) = w1; }
                    else { const int b = row / SEQ, t = row % SEQ; bf16_t* kp = kimg + ((size_t)((b * 4 + h) * 64 + (t >> 6))) * 8192 + (p * 8 + fq) * 512 + (t & 63) * 8;
                        *(u32x4*)kp = w0; *(u32x4*)(kp + 4 * 512) = w1; } }
        } else {
#pragma unroll
            for (int ai = 0; ai < 2; ++ai)
#pragma unroll
                for (int m = 0; m < 4; ++m) { const int row = row0 + ai * HALF + m * 16, b = row / SEQ, t = row % SEQ;
#pragma unroll
                    for (int bj = 0; bj < 2; ++bj) { const int h = 2 * (u.pn - 12) + bj; const f32x4 v0 = acc[ai][bj][m][0], v1 = acc[ai][bj][m][1];
                        u32x4 w; w.x = pk2(v0[0], v0[1]); w.y = pk2(v0[2], v0[3]); w.z = pk2(v1[0], v1[1]); w.w = pk2(v1[2], v1[3]);
                        *(u32x4*)(vimg + ((size_t)((b * 4 + h) * 64 + (t >> 6))) * 8192 + (wc * 4 + ((t & 63) >> 4)) * 512 + (t & 15) * 32 + fq * 8) = w; } }
        }
    }
};
struct EpiX1 {
    static constexpr bool PERM = true;
    const float* x; const float* mod; bf16_t* x1;
    DI void operator()(const f32x4 (&acc)[2][2][4][2], const Unit& u, int wr, int wc, int fr, int fq) const {
        const int row0 = u.pm * BM + wr * 64 + fr, col0 = u.pn * BM + wc * 32 + 8 * fq;
        const int b = (u.pm * BM) / SEQ;
        const float* gp = mod + (size_t)b * 6144 + 2048 + col0;
#pragma unroll
        for (int bj = 0; bj < 2; ++bj) { const f32x4 g0 = *(const f32x4*)(gp + bj * HALF), g1 = *(const f32x4*)(gp + bj * HALF + 4);
#pragma unroll
            for (int ai = 0; ai < 2; ++ai)
#pragma unroll
                for (int m = 0; m < 4; ++m) { const size_t off = (size_t)(row0 + ai * HALF + m * 16) * DM + col0 + bj * HALF;
                    const f32x4 r0 = *(const f32x4*)(x + off) + g0 * acc[ai][bj][m][0], r1 = *(const f32x4*)(x + off + 4) + g1 * acc[ai][bj][m][1];
                    u32x4 w; w.x = pk2(r0[0], r0[1]); w.y = pk2(r0[2], r0[3]); w.z = pk2(r1[0], r1[1]); w.w = pk2(r1[2], r1[3]);
                    *(u32x4*)(x1 + off) = w; } }
    }
};
DI unsigned pk4_fp8(float a, float b, float c, float d) { int w = __builtin_amdgcn_cvt_pk_fp8_f32(a, b, 0, false); w = __builtin_amdgcn_cvt_pk_fp8_f32(c, d, w, true); return (unsigned)w; }
constexpr float W_PRESCALE = 32.f, H_PRESCALE = 8.f;
struct EpiGU {
    static constexpr bool PERM = true;
    unsigned char* H;
    DI void operator()(const f32x4 (&acc)[2][2][4][2], const Unit& u, int wr, int wc, int fr, int fq) const {
        const int row0 = u.pm * BM + wr * 64 + fr, col0 = u.pn * HALF + wc * 32 + 8 * fq;
#pragma unroll
        for (int ai = 0; ai < 2; ++ai)
#pragma unroll
            for (int m = 0; m < 4; ++m) { unsigned char* rowp = H + (size_t)(row0 + ai * HALF + m * 16) * DFF + col0;
                float hv[8];
#pragma unroll
                for (int n = 0; n < 2; ++n)
#pragma unroll
                    for (int j = 0; j < 4; ++j) { const float gg = acc[ai][0][m][n][j] * (1.f / W_PRESCALE), uu = acc[ai][1][m][n][j] * (H_PRESCALE / W_PRESCALE); hv[n * 4 + j] = gg * __builtin_amdgcn_rcpf(1.f + __builtin_amdgcn_exp2f(-1.4426950408889634f * gg)) * uu; }
                u32x2 w; w.x = pk4_fp8(hv[0], hv[1], hv[2], hv[3]); w.y = pk4_fp8(hv[4], hv[5], hv[6], hv[7]);
                *(u32x2*)rowp = w; }
    }
};
constexpr float Y_PRESCALE = 64.f;
struct EpiDown {
    static constexpr bool PERM = true;
    unsigned char* Y; const float* vals;
    DI void operator()(const f32x4 (&acc)[2][2][4][2], const Unit& u, int wr, int wc, int fr, int fq) const {
        const int row0 = u.pm * BM + wr * 64 + fr, col0 = u.pn * BM + wc * 32 + 8 * fq;
#pragma unroll
        for (int ai = 0; ai < 2; ++ai)
#pragma unroll
            for (int m = 0; m < 4; ++m) { const int row = row0 + ai * HALF + m * 16; const float s = vals[row] * (Y_PRESCALE / (W_PRESCALE * H_PRESCALE)); unsigned char* rowp = Y + (size_t)row * DM + col0;
#pragma unroll
                for (int bj = 0; bj < 2; ++bj) { const f32x4 v0 = acc[ai][bj][m][0] * s, v1 = acc[ai][bj][m][1] * s;
                    u32x2 w; w.x = pk4_fp8(v0[0], v0[1], v0[2], v0[3]); w.y = pk4_fp8(v1[0], v1[1], v1[2], v1[3]);
                    *(u32x2*)(rowp + bj * HALF) = w; } }
    }
};
}

struct Args {
    const float* x; const float* c; const int* pos; const float* norm1_g; const float* norm2_g; const float* w_ada; const float* b_ada;
    const float* w_in; const float* conv_w; const float* gate_b; const float* mnorm_g; const float* qk_g; const float* lam_p; const float* subln_g;
    const float* w_out; const float* w_router; const float* w_gate; const float* w_up; const float* w_down;
    float* out; unsigned char* ws; int ph_lo, ph_hi;
};
struct Ctx {
    LAS unsigned char* lds; int tid, lane, wave, G, bid;
};
DI Args load_args() {
    typedef __attribute__((address_space(4))) const volatile unsigned long long* kp_t;
    kp_t kp = (kp_t)__builtin_amdgcn_kernarg_segment_ptr();
#define GP(T, i) ((T*)(__attribute__((address_space(1))) T*)kp[i])
    Args a;
    a.x = GP(const float, 0); a.c = GP(const float, 1); a.pos = GP(const int, 2); a.norm1_g = GP(const float, 3); a.norm2_g = GP(const float, 4);
    a.w_ada = GP(const float, 5); a.b_ada = GP(const float, 6); a.w_in = GP(const float, 7); a.conv_w = GP(const float, 8); a.gate_b = GP(const float, 9);
    a.mnorm_g = GP(const float, 10); a.qk_g = GP(const float, 11); a.lam_p = GP(const float, 12); a.subln_g = GP(const float, 13); a.w_out = GP(const float, 14);
    a.w_router = GP(const float, 15); a.w_gate = GP(const float, 16); a.w_up = GP(const float, 17); a.w_down = GP(const float, 18);
    a.out = GP(float, 19); a.ws = GP(unsigned char, 20);
#undef GP
    a.ph_lo = 0; a.ph_hi = 12;
    return a;
}

DI void tr_item64(const float* src, size_t ld_src, int k0, int c0, bf16_t* dst, size_t r0, int ld_dst, LAS float* scr  , int lane, size_t r1 = (size_t)-1) {
    const float* sp = src + (size_t)(k0 + (lane >> 4)) * ld_src + c0 + (lane & 15) * 4;
#pragma unroll 1
    for (int hf = 0; hf < 2; ++hf) {
        f32x4 v[8];
#pragma unroll
        for (int i = 0; i < 8; ++i) v[i] = *(const f32x4*)(sp + (size_t)(4 * (8 * hf + i)) * ld_src);
#pragma unroll
        for (int i = 0; i < 8; ++i) *(LAS f32x4*)(scr + (4 * (8 * hf + i) + (lane >> 4)) * 68 + (lane & 15) * 4) = v[i];
    }
    asm volatile("s_waitcnt lgkmcnt(0)" ::: "memory");
    const int c = lane & 7;
#pragma unroll
    for (int q = 0; q < 8; ++q) { const int n = 8 * q + (lane >> 3); const LAS float* s = scr + (8 * c) * 68 + n;
        u32x4 o; o.x = pk2(s[0 * 68], s[1 * 68]); o.y = pk2(s[2 * 68], s[3 * 68]); o.z = pk2(s[4 * 68], s[5 * 68]); o.w = pk2(s[6 * 68], s[7 * 68]);
        const size_t row = (r1 != (size_t)-1 && q >= 4) ? r1 + (n - 32) : r0 + n;
        *(u32x4*)(dst + row * ld_dst + k0 + 8 * c) = o; }
    asm volatile("s_waitcnt lgkmcnt(0)" ::: "memory");
}
DI void tr_item64_fp8(const float* src, size_t ld_src, int k0, int c0, unsigned char* dst, size_t r0, int ld_dst, float scale, LAS float* scr  , int lane) {
    const float* sp = src + (size_t)(k0 + (lane >> 4)) * ld_src + c0 + (lane & 15) * 4;
    {
        f32x4 v[16];
#pragma unroll
        for (int i = 0; i < 16; ++i) v[i] = __builtin_nontemporal_load((const f32x4*)(sp + (size_t)(4 * i) * ld_src));
#pragma unroll
        for (int i = 0; i < 16; ++i) *(LAS f32x4*)(scr + (4 * i + (lane >> 4)) * 68 + (lane & 15) * 4) = v[i] * scale;
    }
    asm volatile("s_waitcnt lgkmcnt(0)" ::: "memory");
    const int c = lane & 3;
#pragma unroll
    for (int q = 0; q < 4; ++q) { const int n = 16 * q + (lane >> 2); const LAS float* s = scr + (16 * c) * 68 + n;
        u32x4 o; o.x = pg8::pk4_fp8(s[0 * 68], s[1 * 68], s[2 * 68], s[3 * 68]); o.y = pg8::pk4_fp8(s[4 * 68], s[5 * 68], s[6 * 68], s[7 * 68]);
        o.z = pg8::pk4_fp8(s[8 * 68], s[9 * 68], s[10 * 68], s[11 * 68]); o.w = pg8::pk4_fp8(s[12 * 68], s[13 * 68], s[14 * 68], s[15 * 68]);
        *(u32x4*)(dst + (r0 + n) * ld_dst + k0 + 16 * c) = o; }
    asm volatile("s_waitcnt lgkmcnt(0)" ::: "memory");
}
DI void p0_phase(const Ctx& F, const Args& a) {
    if (F.bid < 96) {
        LAS float* sc = (LAS float*)F.lds; LAS float* part = (LAS float*)(F.lds + 32768);
        for (int i = F.tid; i < BATCH * DM; i += NTHR) sc[i] = silu_f(a.c[i]);
        __syncthreads();
        const int col = F.bid * 64 + F.lane;
        float acc[8];
#pragma unroll
        for (int b = 0; b < 8; ++b) acc[b] = 0.f;
        const int kb = F.wave * 128;
#pragma unroll 1
        for (int k0 = kb; k0 < kb + 128; k0 += 16) {
            float w[16];
            const float* wp = a.w_ada + (size_t)k0 * 6144 + col;
#pragma unroll
            for (int j = 0; j < 16; ++j) w[j] = wp[(size_t)j * 6144];
#pragma unroll
            for (int j = 0; j < 16; ++j)
#pragma unroll
                for (int b = 0; b < 8; ++b) acc[b] += sc[b * DM + k0 + j] * w[j];
        }
#pragma unroll
        for (int b = 0; b < 8; ++b) part[(F.wave * 8 + b) * 64 + F.lane] = acc[b];
        __syncthreads();
        { const int b = F.tid >> 6, l = F.tid & 63; float s = a.b_ada[F.bid * 64 + l];
#pragma unroll
          for (int w = 0; w < 8; ++w) s += part[(w * 8 + b) * 64 + l];
          ((float*)(a.ws + WS_MOD))[b * 6144 + F.bid * 64 + l] = s; }
        asm volatile("s_waitcnt vmcnt(0)" ::: "memory");
        __syncthreads();
        if (F.tid == 0) { __builtin_amdgcn_fence(__ATOMIC_RELEASE, "agent"); asm volatile("s_waitcnt vmcnt(0)" ::: "memory");
            __hip_atomic_fetch_add((unsigned*)(a.ws + WS_CTL) + 4096, 1u, __ATOMIC_RELAXED, __HIP_MEMORY_SCOPE_AGENT); }
    }
    LAS float* scr = (LAS float*)(F.lds + F.wave * 17408);
    const int gw = F.bid * NWAVES + F.wave, NGW = F.G * NWAVES;
    constexpr int I_IN = 16 * 56, I_OUT = 16 * 16, I_WG = 16, I_EX = 4096;
    constexpr int NITEMS = I_IN + I_OUT + I_EX + I_WG;
    bf16_t* WinT = (bf16_t*)(a.ws + WS_WINT); bf16_t* WgT = (bf16_t*)(a.ws + WS_WGT); bf16_t* WoutT = (bf16_t*)(a.ws + WS_WOUTT);
    for (int it = gw; it < NITEMS; it += NGW) {
        int r = it;
        if (r < I_IN) { const int kb = r / 56, nb = r % 56, n0 = nb * 64;
            if (n0 >= 2048 && n0 < 3072) { const int t0 = n0 & ~255, g = (n0 >> 6) & 3; tr_item64(a.w_in, DIN, kb * 64, n0 + 16, WinT, (size_t)(t0 + 32 * g), DM, scr, F.lane, (size_t)(t0 + 128 + 32 * g)); }
            else tr_item64(a.w_in, DIN, kb * 64, n0 + (n0 >= 2048 ? 16 : 0), WinT, n0, DM, scr, F.lane);
            continue; } r -= I_IN;
        if (r < I_OUT) { const int kb = r / 16, nb = r % 16; tr_item64(a.w_out, DM, kb * 64, nb * 64, WoutT, nb * 64, DM, scr, F.lane); continue; } r -= I_OUT;
        if (r < I_EX) { int e, mat, q;
            if (r < 1024) { e = 13; mat = 1 + (r >> 9); q = r & 511; } else { const int t = r - 1024; e = 14 + t / 1536; const int u = t % 1536; mat = u >> 9; q = u & 511; }
            if (mat < 2) { const int kb = q / 32, nb = q % 32, n0 = nb * 64; const float* src = (mat ? a.w_up : a.w_gate) + (size_t)e * DM * DFF;
                tr_item64_fp8(src, DFF, kb * 64, n0, a.ws + WS_WGUT + (size_t)e * 4096 * DM, (size_t)(n0 / 128) * 256 + (n0 % 128) + mat * 128, DM, pg8::W_PRESCALE, scr, F.lane); }
            else { const int kb = q / 16, nb = q % 16;
                tr_item64_fp8(a.w_down + (size_t)e * DFF * DM, DM, kb * 64, nb * 64, a.ws + WS_WDT + (size_t)e * DM * DFF, nb * 64, DFF, pg8::W_PRESCALE, scr, F.lane); }
            continue; } r -= I_EX;
        tr_item64(a.w_in, DIN, r * 64, 2048 - 48, WgT, 0, DM, scr, F.lane);
    }
    if (F.tid == 0) { unsigned* cnt = (unsigned*)(a.ws + WS_CTL) + 4096; unsigned sp = 0;
        while (__hip_atomic_load(cnt, __ATOMIC_RELAXED, __HIP_MEMORY_SCOPE_AGENT) < 96u && ++sp < (1u << 22)) __builtin_amdgcn_s_sleep(2);
        __builtin_amdgcn_fence(__ATOMIC_ACQUIRE, "agent"); asm volatile("s_waitcnt vmcnt(0)" ::: "memory"); }
    __syncthreads();
}

DI void p1_phase(const Ctx& F, const Args& a) {
    const int gw = F.bid * NWAVES + F.wave, NGW = F.G * NWAVES;
    const float* mod = (const float*)(a.ws + WS_MOD);
    bf16_t* H1 = (bf16_t*)a.out;
    for (int m0 = gw; m0 < MTOK; m0 += 2 * NGW) {
        const int m1 = m0 + NGW; const bool has1 = m1 < MTOK;
        const f32x4* xr0 = (const f32x4*)(a.x + (size_t)m0 * DM) + F.lane; const f32x4* xr1 = (const f32x4*)(a.x + (size_t)(has1 ? m1 : m0) * DM) + F.lane;
        f32x4 v0[4], v1[4]; float s0 = 0.f, s1 = 0.f;
#pragma unroll
        for (int j = 0; j < 4; ++j) { v0[j] = __builtin_nontemporal_load(xr0 + 64 * j); v1[j] = __builtin_nontemporal_load(xr1 + 64 * j); }
#pragma unroll
        for (int j = 0; j < 4; ++j) { s0 += (v0[j].x * v0[j].x + v0[j].y * v0[j].y) + (v0[j].z * v0[j].z + v0[j].w * v0[j].w); s1 += (v1[j].x * v1[j].x + v1[j].y * v1[j].y) + (v1[j].z * v1[j].z + v1[j].w * v1[j].w); }
#pragma unroll
        for (int o = 1; o < 64; o <<= 1) { s0 += __shfl_xor(s0, o); s1 += __shfl_xor(s1, o); }
        const float rstd0 = rsqrtf(s0 * (1.f / DM) + EPS), rstd1 = rsqrtf(s1 * (1.f / DM) + EPS);
        const int b0 = m0 / SEQ, b1 = (has1 ? m1 : m0) / SEQ;
        u32x2* o0 = (u32x2*)(H1 + (size_t)m0 * DM) + F.lane; u32x2* o1 = (u32x2*)(H1 + (size_t)m1 * DM) + F.lane;
#pragma unroll
        for (int j = 0; j < 4; ++j) {
            const f32x4 g = ((const f32x4*)a.norm1_g)[F.lane + 64 * j];
            { const f32x4 sh = ((const f32x4*)(mod + (size_t)b0 * 6144))[F.lane + 64 * j], sc = ((const f32x4*)(mod + (size_t)b0 * 6144 + 1024))[F.lane + 64 * j];
              const f32x4 h = v0[j] * rstd0 * g * (sc + 1.f) + sh; u32x2 w; w.x = pk2(h.x, h.y); w.y = pk2(h.z, h.w); o0[64 * j] = w; }
            if (has1) { const f32x4 sh = ((const f32x4*)(mod + (size_t)b1 * 6144))[F.lane + 64 * j], sc = ((const f32x4*)(mod + (size_t)b1 * 6144 + 1024))[F.lane + 64 * j];
              const f32x4 h = v1[j] * rstd1 * g * (sc + 1.f) + sh; u32x2 w; w.x = pk2(h.x, h.y); w.y = pk2(h.z, h.w); o1[64 * j] = w; }
        }
    }
}

DI void gates_tasks(const Ctx& F, const Args& a) {
    const int gw = F.bid * NWAVES + F.wave, NGW = F.G * NWAVES;
    const bf16_t* H1 = (const bf16_t*)a.out; const bf16_t* WgT = (const bf16_t*)(a.ws + WS_WGT) + 48 * DM; float* GT = (float*)(a.ws + WS_GATES);
    const float bias = a.gate_b[F.lane & 15];
    for (int task = gw; task < MTOK / 16; task += NGW) {
        const int row0 = task * 16;
        const bf16_t* ap = H1 + (size_t)(row0 + (F.lane & 15)) * DM + 8 * (F.lane >> 4);
        const bf16_t* bp = WgT + (size_t)(F.lane & 15) * DM + 8 * (F.lane >> 4);
        f32x4 acc = {0.f, 0.f, 0.f, 0.f};
        bf16x8 avs[32];
#pragma unroll
        for (int i = 0; i < 32; ++i) avs[i] = *(const bf16x8*)(ap + 32 * i);
#pragma unroll
        for (int i = 0; i < 32; ++i) { const bf16x8 bv = *(const bf16x8*)(bp + 32 * i); acc = __builtin_amdgcn_mfma_f32_16x16x32_bf16(avs[i], bv, acc, 0, 0, 0); }
#pragma unroll
        for (int r = 0; r < 4; ++r) GT[(size_t)(row0 + (F.lane >> 4) * 4 + r) * 16 + (F.lane & 15)] = acc[r] + bias;
    }
}

DI void qk_tile_task(const Ctx& F, const Args& a, int task) {
    const int b = task >> 6, tile = task & 63, r = F.lane, g = F.wave, h = g >> 1, p = g & 1;
    bf16_t* PROJ = (bf16_t*)(a.ws + WS_PROJ);
    const size_t tok = (size_t)b * SEQ + tile * 64 + r;
    float invf[8];
#pragma unroll
    for (int i = 0; i < 8; ++i) invf[i] = exp2f(-(float)i * 0.125f * 18.931568569324174f) * 0.15915494309189535f;
    const float pos = (float)a.pos[tok];
    float sn[8], cs[8];
#pragma unroll
    for (int i = 0; i < 8; ++i) { const float fr = __builtin_amdgcn_fractf(pos * invf[i]); sn[i] = __builtin_amdgcn_sinf(fr); cs[i] = __builtin_amdgcn_cosf(fr); }
#pragma unroll 1
    for (int isk = 0; isk < 2; ++isk) {
        u32x4* src = (u32x4*)(PROJ + tok * PS + (isk ? C_KA : C_QA) + g * 64);
        u32x4 w[8];
#pragma unroll
        for (int c = 0; c < 8; ++c) w[c] = src[c];
        float ss = 0.f;
#pragma unroll
        for (int c = 0; c < 8; ++c) { float t;
            t = bflo(w[c].x); ss += t * t; t = bfhi(w[c].x); ss += t * t; t = bflo(w[c].y); ss += t * t; t = bfhi(w[c].y); ss += t * t;
            t = bflo(w[c].z); ss += t * t; t = bfhi(w[c].z); ss += t * t; t = bflo(w[c].w); ss += t * t; t = bfhi(w[c].w); ss += t * t; }
        const float rstd = rsqrtf(ss * (1.f / 64.f) + EPS) * (isk ? 1.f : 0.125f * 1.4426950408889634f);
        const float* gp = a.qk_g + isk * 64;
        float v0[16];
        v0[0] = bflo(w[0].x); v0[1] = bfhi(w[0].x); v0[2] = bflo(w[0].y); v0[3] = bfhi(w[0].y); v0[4] = bflo(w[0].z); v0[5] = bfhi(w[0].z); v0[6] = bflo(w[0].w); v0[7] = bfhi(w[0].w);
        v0[8] = bflo(w[1].x); v0[9] = bfhi(w[1].x); v0[10] = bflo(w[1].y); v0[11] = bfhi(w[1].y); v0[12] = bflo(w[1].z); v0[13] = bfhi(w[1].z); v0[14] = bflo(w[1].w); v0[15] = bfhi(w[1].w);
#pragma unroll
        for (int i = 0; i < 16; ++i) v0[i] *= rstd * gp[i];
        float rr[16];
#pragma unroll
        for (int i = 0; i < 8; ++i) { rr[i] = v0[i] * cs[i] - v0[i + 8] * sn[i]; rr[i + 8] = v0[i + 8] * cs[i] + v0[i] * sn[i]; }
        u32x4 o[8];
        o[0].x = pk2(rr[0], rr[1]); o[0].y = pk2(rr[2], rr[3]); o[0].z = pk2(rr[4], rr[5]); o[0].w = pk2(rr[6], rr[7]);
        o[1].x = pk2(rr[8], rr[9]); o[1].y = pk2(rr[10], rr[11]); o[1].z = pk2(rr[12], rr[13]); o[1].w = pk2(rr[14], rr[15]);
#pragma unroll
        for (int c = 2; c < 8; ++c) { const f32x4 g0 = *(const f32x4*)(gp + c * 8), g1 = *(const f32x4*)(gp + c * 8 + 4);
            o[c].x = pk2(bflo(w[c].x) * rstd * g0.x, bfhi(w[c].x) * rstd * g0.y); o[c].y = pk2(bflo(w[c].y) * rstd * g0.z, bfhi(w[c].y) * rstd * g0.w);
            o[c].z = pk2(bflo(w[c].z) * rstd * g1.x, bfhi(w[c].z) * rstd * g1.y); o[c].w = pk2(bflo(w[c].w) * rstd * g1.z, bfhi(w[c].w) * rstd * g1.w); }
        if (isk == 0) {
#pragma unroll
            for (int c = 0; c < 8; ++c) src[c] = o[c];
        } else {
            u32x4* dst = (u32x4*)((bf16_t*)(a.ws + WS_KIMG) + ((size_t)((b * 4 + h) * 64 + tile)) * 8192) + r;
#pragma unroll
            for (int c = 0; c < 8; ++c) dst[(p * 8 + c) * 64] = o[c];
        }
    }
    {
        u32x4* dst = (u32x4*)((bf16_t*)(a.ws + WS_VIMG) + ((size_t)((b * 4 + h) * 64 + tile)) * 8192) + r;
#pragma unroll
        for (int cg = 2 * p; cg < 2 * p + 2; ++cg)
#pragma unroll
            for (int kg = 0; kg < 4; ++kg) {
                const u32x4 v = *(const u32x4*)(PROJ + ((size_t)b * SEQ + tile * 64 + 16 * kg + (r >> 2)) * PS + C_VA + h * 128 + 32 * cg + 8 * (r & 3));
                dst[(cg * 4 + kg) * 64] = v; }
    }
}

DI bf16x8 tr_frag_nat(const LAS unsigned char* img, int rowbase, int col0, int lane) {
    const int hh = lane >> 5, g16 = (lane >> 4) & 1, i = lane & 15;
    const int col = col0 + 16 * g16 + 4 * (i & 3), chunk = col >> 3, sub = (col & 7) * 2;
    const int r0 = rowbase + 8 * hh + (i >> 2), r1 = r0 + 4;
    const s16x4 lo = trread(img + r0 * 256 + ((chunk ^ swz16(r0)) << 4) + sub);
    const s16x4 hi = trread(img + r1 * 256 + ((chunk ^ swz16(r1)) << 4) + sub);
    return __builtin_shufflevector(lo, hi, 0, 1, 2, 3, 4, 5, 6, 7);
}
DI bf16x8 tr_frag_acc(const LAS unsigned char* img, int rowbase, int col0, int lane) {
    const int hh = lane >> 5, g16 = (lane >> 4) & 1, i = lane & 15;
    const int col = col0 + 16 * g16 + 4 * (i & 3), chunk = col >> 3, sub = (col & 7) * 2;
    const int r0 = rowbase + 4 * hh + (i >> 2), r1 = r0 + 8;
    const s16x4 lo = trread(img + r0 * 256 + ((chunk ^ swz16(r0)) << 4) + sub);
    const s16x4 hi = trread(img + r1 * 256 + ((chunk ^ swz16(r1)) << 4) + sub);
    return __builtin_shufflevector(lo, hi, 0, 1, 2, 3, 4, 5, 6, 7);
}
DI bf16x8 row_frag(const LAS unsigned char* img, int row, int chunk) { return *(const LAS bf16x8*)(img + row * 256 + ((chunk ^ swz16(row)) << 4)); }

DI void glds16_asm(const void* gsrc, unsigned lds_dst) { unsigned keep;
    asm volatile("s_mov_b32 %0, m0\n\ts_mov_b32 m0, %2\n\ts_nop 0\n\tglobal_load_lds_dwordx4 %1, off\n\ts_mov_b32 m0, %0" : "=&s"(keep) : "v"(gsrc), "s"(lds_dst) : "memory"); }
constexpr size_t DO_QC = 0, DO_KC = 32 * MiB, DO_HD = 64 * MiB;
constexpr size_t WS_SC = 7 * MiB;

DI void conv_task(const Ctx& F, const Args& a, int tw) {
    const int isk = tw & 1, tok0 = (tw >> 1) * 8, b = tok0 / SEQ, t0 = tok0 % SEQ, lane = F.lane;
    const bf16_t* src = (const bf16_t*)(a.ws + WS_PROJ) + (size_t)b * SEQ * PS + (isk ? C_KM : C_QM) + lane * 8;
    float cw[5][8];
#pragma unroll
    for (int j = 0; j < 5; ++j) { const f32x4 c0 = *(const f32x4*)(a.conv_w + j * 1024 + isk * 512 + lane * 8), c1 = *(const f32x4*)(a.conv_w + j * 1024 + isk * 512 + lane * 8 + 4);
        cw[j][0] = c0.x; cw[j][1] = c0.y; cw[j][2] = c0.z; cw[j][3] = c0.w; cw[j][4] = c1.x; cw[j][5] = c1.y; cw[j][6] = c1.z; cw[j][7] = c1.w; }
    u32x4 row[12];
#pragma unroll
    for (int r = 0; r < 12; ++r) { const int t = t0 + r - 2; row[r] = (u32x4){0u, 0u, 0u, 0u}; if (t >= 0 && t < SEQ) row[r] = *(const u32x4*)(src + (size_t)t * PS); }
    const int hd = lane >> 4, cc = lane & 15, cch = t0 >> 6, r0 = t0 & 63;
    bf16_t* tileb = (bf16_t*)((unsigned char*)a.out + (isk ? DO_KC : DO_QC)) + ((size_t)((b * 4 + hd) * 64 + cch)) * 8192;
    bf16_t* dst = isk ? tileb + ((cc >> 2) * 4 + (r0 >> 4)) * 512 + (r0 & 15) * 32 + (cc & 3) * 8 : tileb + cc * 512 + r0 * 8;
    const int dstride = isk ? 32 : 8;
    const float sc = isk ? 0.08838834764831845f : 1.f;
#pragma unroll
    for (int i = 0; i < 8; ++i) {
        float acc[8];
#pragma unroll
        for (int e = 0; e < 8; ++e) acc[e] = 0.f;
#pragma unroll
        for (int j = 0; j < 5; ++j) { const u32x4 w = row[i + j];
            acc[0] += bflo(w.x) * cw[j][0]; acc[1] += bfhi(w.x) * cw[j][1]; acc[2] += bflo(w.y) * cw[j][2]; acc[3] += bfhi(w.y) * cw[j][3];
            acc[4] += bflo(w.z) * cw[j][4]; acc[5] += bfhi(w.z) * cw[j][5]; acc[6] += bflo(w.w) * cw[j][6]; acc[7] += bfhi(w.w) * cw[j][7]; }
#pragma unroll
        for (int e = 0; e < 8; ++e) acc[e] = silu_f(acc[e]) * sc;
        u32x4 o; o.x = pk2(acc[0], acc[1]); o.y = pk2(acc[2], acc[3]); o.z = pk2(acc[4], acc[5]); o.w = pk2(acc[6], acc[7]);
        *(u32x4*)(dst + i * dstride) = o;
    }
}

DI void mscal_task(const Ctx& F, const Args& a, int chain) {
    const int b = chain >> 3, h = (chain >> 1) & 3, dir = chain & 1;
    const int s = dir ? 63 - F.lane : F.lane;
    const float* GT = (const float*)(a.ws + WS_GATES) + (size_t)b * SEQ * 16;
    float* SC = (float*)(a.ws + WS_SC) + (size_t)chain * 64 * 256; float* MSC = (float*)(a.ws + WS_MSC);
    LAS float* gl = (LAS float*)F.lds; LAS float* mll = gl + 64; LAS float* mpv = gl + 128; LAS float* mnw = gl + 192;
    float aa[8], ii[8];
#pragma unroll
    for (int i = 0; i < 8; ++i) { const int c = F.wave + 8 * i;
        const float ig = GT[(size_t)(c * 64 + s) * 16 + dir * 8 + h], fg = GT[(size_t)(c * 64 + s) * 16 + dir * 8 + 4 + h];
        const float av = wave_prefix_sum(logsigmoid_f(fg));
        aa[i] = av; ii[i] = ig;
        const float g = __builtin_bit_cast(float, __builtin_amdgcn_readlane(__builtin_bit_cast(int, av), 63)), ml = wave_max(g - av + ig);
        if (F.lane == 0) { gl[c] = g; mll[c] = ml; } }
    __syncthreads();
    if (F.tid == 0) { float m = 0.f;
        for (int st = 0; st < 64; ++st) { const int c = dir ? 63 - st : st; mpv[c] = m; const float mn = fmaxf(gl[c] + m, mll[c]); mnw[c] = mn; m = mn; } }
    __syncthreads();
#pragma unroll
    for (int i = 0; i < 8; ++i) { const int c = F.wave + 8 * i; const float mprev = mpv[c], mnew = mnw[c], g = gl[c];
        const float cterm = ii[i] - aa[i];
        const float cm = wave_prefix_max(cterm);
        const float il = aa[i] + mprev, mj = fmaxf(il, aa[i] + cm);
        float* o4 = SC + (size_t)c * 256 + s;
        o4[0] = (aa[i] - mj) * 1.4426950408889634f; o4[64] = cterm * 1.4426950408889634f; o4[128] = __expf(il - mj); o4[192] = __expf(-mj);
        if (F.lane == 0) { MSC[chain * 64 + c] = (g - mnew) * 1.4426950408889634f; MSC[4096 + chain * 64 + c] = __expf(g + mprev - mnew); } }
    __syncthreads();
}

DI const float* wsel3(int m, const float* p0, const float* p1, const float* p2) {
    const unsigned long long a0 = (unsigned long long)p0, a1 = (unsigned long long)p1, a2 = (unsigned long long)p2;
    const unsigned long long m1 = (unsigned long long)0 - (unsigned long long)(m == 1), m2 = (unsigned long long)0 - (unsigned long long)(m == 2);
    return (const float*)((a0 & ~(m1 | m2)) | (a1 & m1) | (a2 & m2));
}
DI void mseq_item(const Ctx& F, const Args& a, int item, int bh, int dir, int vs) {
    const int b = bh >> 2, h = bh & 3, chain = bh * 2 + dir, wid = F.wave, tid = F.tid, lane = F.lane, r32 = lane & 31, hh = lane >> 5;
    LAS unsigned char* QS = F.lds;
    LAS unsigned char* KS = F.lds + 32768;
    LAS unsigned char* VS = F.lds + 65536;
    LAS unsigned char* SCS = F.lds + 77824;
    LAS unsigned char* SD = F.lds + 80896;
    LAS unsigned char* CI = F.lds + 97280;
    LAS float* NV = (LAS float*)(F.lds + 113664);
    LAS float* gmv = NV + 256; LAS float* spv = gmv + 64;
    LAS unsigned char* HST = F.lds + 115712;
    const int cwi = wid < 4 ? wid : 4;
    const bool cwave = wid < 4 || wid == 7;
    const unsigned cscb = (unsigned)(uintptr_t)F.lds + 119808u + (unsigned)cwi * 8192u;
    const int cslot0 = (item * 5 + cwi) * 64;
    const float* const wg_ = a.w_gate; const float* const wu_ = a.w_up; const float* const wd_ = a.w_down;
    const bf16_t* QC = (const bf16_t*)((const unsigned char*)a.out + DO_QC) + (size_t)bh * 64 * 8192 + lane * 8;
    const bf16_t* KC = (const bf16_t*)((const unsigned char*)a.out + DO_KC) + (size_t)bh * 64 * 8192 + lane * 8;
    const bf16_t* VP = (const bf16_t*)(a.ws + WS_PROJ) + (size_t)b * SEQ * PS + C_VM + h * 128 + vs * 32 + (size_t)(16 * (wid & 3) + (lane >> 2)) * PS + 8 * (lane & 3);
    const float* SC = (const float*)(a.ws + WS_SC) + (size_t)chain * 64 * 256 + lane * 4;
    bf16_t* HD = (bf16_t*)((unsigned char*)a.out + DO_HD) + ((size_t)dir * MTOK + (size_t)b * SEQ) * 512 + h * 128 + vs * 32;
    if (tid < 64) { gmv[tid] = ((const float*)(a.ws + WS_MSC))[chain * 64 + tid]; spv[tid] = ((const float*)(a.ws + WS_MSC))[4096 + chain * 64 + tid]; }
    if (tid < 256) NV[tid] = 0.f;
    for (int i = tid; i < 4096; i += NTHR) ((LAS unsigned*)CI)[i] = 0u;
    const unsigned ldsb = (unsigned)(uintptr_t)F.lds;
#define MSEQ_ISSUE_QK(c, s2) do { const size_t _tb = (size_t)(c); \
        if (wid < 4) { _Pragma("unroll") for (int _i = 0; _i < 4; ++_i) \
                glds16_asm(QC + _tb * 8192 + (4 * wid + _i) * 512, (unsigned)__builtin_amdgcn_readfirstlane((int)(ldsb + (s2) * 16384 + (4 * wid + _i) * 1024))); } \
        else if (wid >= 6) { _Pragma("unroll") for (int _i = 0; _i < 8; ++_i) \
                glds16_asm(KC + _tb * 8192 + (8 * (wid - 6) + _i) * 512, (unsigned)__builtin_amdgcn_readfirstlane((int)(ldsb + 32768 + (s2) * 16384 + (8 * (wid - 6) + _i) * 1024))); } } while (0)
#define MSEQ_ISSUE_VS(c, s4) do { const size_t _tb = (size_t)(c); \
        if (wid < 4) glds16_asm(VP + _tb * 64 * PS, (unsigned)__builtin_amdgcn_readfirstlane((int)(ldsb + 65536 + (s4) * 4096 + wid * 1024))); \
        else if (wid == 6) glds16_asm(SC + _tb * 256, (unsigned)__builtin_amdgcn_readfirstlane((int)(ldsb + 77824 + (s4) * 1024))); } while (0)
    MSEQ_ISSUE_QK(dir ? 63 : 0, 0); MSEQ_ISSUE_VS(dir ? 63 : 0, 0);
#define MSEQ_CONV_ISSUE(id) do { const int _e = (id) / 6144, _r = (id) % 6144, _mat = _r >> 11, _rr = _r & 2047; \
        const int _N = _mat == 2 ? DM : DFF, _nb = _mat == 2 ? (_rr >> 7) : (_rr >> 6), _kb = _mat == 2 ? (_rr & 127) : (_rr & 63); \
        const float* _src = wsel3(_mat, wg_, wu_, wd_) + (size_t)_e * DM * DFF + (size_t)(16 * _kb + (lane >> 4)) * _N + 64 * _nb + 4 * (lane & 15); \
        _Pragma("unroll") for (int _i = 0; _i < 4; ++_i) glds16_asm(_src + (size_t)(4 * _i) * _N, (unsigned)__builtin_amdgcn_readfirstlane((int)(cscb + ((id) & 1) * 4096 + _i * 1024))); } while (0)
    if (cwave) MSEQ_CONV_ISSUE(cslot0);
    f32x16 Cacc[2];
#pragma unroll
    for (int i = 0; i < 16; ++i) { Cacc[0][i] = 0.f; Cacc[1][i] = 0.f; }
    const int qrd = hh * 1024 + r32 * 16;
    const int ktr = (8 * hh + ((lane & 15) >> 2)) * 64 + ((lane >> 4) & 1) * 32 + (lane & 3) * 8;
    f32x16 acc;
    float qn = 0.f;
#pragma unroll
    for (int i = 0; i < 16; ++i) acc[i] = 0.f;
    asm volatile("s_waitcnt vmcnt(0)" ::: "memory");
    __syncthreads();
    unsigned long long busy = 0, tb0 = 0; if (PROBE_MSEQ_W >= 0) tb0 = __builtin_amdgcn_s_memtime(); const unsigned long long titem0 = tb0;
#pragma unroll 1
    for (int st = 0; st <= 64; ++st) {
        const int c = dir ? 63 - st : st, s2 = st & 1; const int s3 = st % 3, s3p = (st + 2) % 3;
        if (st + 1 < 64) { MSEQ_ISSUE_QK(dir ? 62 - st : st + 1, s2 ^ 1); MSEQ_ISSUE_VS(dir ? 62 - st : st + 1, (st + 1) % 3);
            if (cwave) MSEQ_CONV_ISSUE(cslot0 + st + 1); }
        const LAS unsigned char* QT = QS + s2 * 16384; const LAS unsigned char* KT = KS + s2 * 16384; const LAS unsigned char* VT = VS + s3 * 4096;
        const LAS float* rt = (const LAS float*)(SCS + s3 * 1024); const LAS float* ct = rt + 64;
        if (wid < 4) {
            if (st < 64) {
                const int jt = wid >> 1, stt = wid & 1;
                const LAS unsigned char* qa = QT + qrd + jt * 512;
                const LAS unsigned char* kb = KT + (2 * stt + (r32 >> 4)) * 1024 + (r32 & 15) * 64 + hh * 16;
                const int j = 32 * jt + r32; const float rtj = rt[j];
                const LAS float* ctp = ct + 32 * stt + 4 * hh;
                f32x4 c4[4];
#pragma unroll
                for (int rg = 0; rg < 4; ++rg) c4[rg] = *(const LAS f32x4*)(ctp + 8 * rg);
                const float gm = gmv[c], sp = spv[c];
                const int ck = 4 * wid + (lane & 3), r0 = 4 * (lane >> 2);
                const LAS unsigned char* kr = KT + (ck >> 2) * 4096 + (r0 >> 4) * 1024 + (r0 & 15) * 64 + (ck & 3) * 16;
                u32x4 kw[4];
#pragma unroll
                for (int r = 0; r < 4; ++r) kw[r] = *(const LAS u32x4*)(kr + r * 64);
                const f32x4 ctn = *(const LAS f32x4*)(ct + r0);
                const LAS float* no = NV + s2 * 128 + 32 * wid + 8 * (lane & 3);
                const f32x4 o0 = *(const LAS f32x4*)no, o1 = *(const LAS f32x4*)(no + 4);
                f32x16 S;
                f32x16 S2;
#pragma unroll
                for (int i = 0; i < 16; ++i) { S[i] = 0.f; S2[i] = 0.f; }
#pragma unroll
                for (int ks = 0; ks < 8; ks += 2) { S = MFMA32(*(const LAS bf16x8*)(kb + (ks >> 1) * 4096), *(const LAS bf16x8*)(qa + ks * 2048), S);
                    S2 = MFMA32(*(const LAS bf16x8*)(kb + (ks >> 1) * 4096 + 32), *(const LAS bf16x8*)(qa + (ks + 1) * 2048), S2); }
#pragma unroll
                for (int i = 0; i < 16; ++i) S[i] += S2[i];
                float pa[8];
#pragma unroll
                for (int e = 0; e < 8; ++e) pa[e] = 0.f;
#pragma unroll
                for (int r = 0; r < 4; ++r) { const u32x4 w = kw[r]; const float ws_ = __builtin_amdgcn_exp2f(ctn[r] + gm);
                    pa[0] += ws_ * bflo(w.x); pa[1] += ws_ * bfhi(w.x); pa[2] += ws_ * bflo(w.y); pa[3] += ws_ * bfhi(w.y); pa[4] += ws_ * bflo(w.z); pa[5] += ws_ * bfhi(w.z); pa[6] += ws_ * bflo(w.w); pa[7] += ws_ * bfhi(w.w); }
#pragma unroll
                for (int e = 0; e < 8; ++e) { float t = pa[e]; t += dpp_mov<DPP_ROR(8)>(t); t += dpp_mov<DPP_ROR(4)>(t); t = xor16_sum(t); pa[e] = xor32_sum(t); }
                u32x2 sw2[4];
#pragma unroll
                for (int rg = 0; rg < 4; ++rg) { float v[4];
#pragma unroll
                    for (int e = 0; e < 4; ++e) { const int sc = 32 * stt + 8 * rg + 4 * hh + e; const bool ok = dir == 0 ? (sc <= j) : (sc >= j);
                        v[e] = S[4 * rg + e] * __builtin_amdgcn_exp2f(ok ? rtj + c4[rg][e] : -1.0e30f); }
                    sw2[rg].x = pk2(v[0], v[1]); sw2[rg].y = pk2(v[2], v[3]); }
                LAS unsigned char* sw = SD + s2 * 8192 + stt * 4096 + j * 16 + hh * 8;
#pragma unroll
                for (int rg = 0; rg < 4; ++rg) *(LAS u32x2*)(sw + rg * 1024) = sw2[rg];
                if (lane < 4) { LAS float* nn = NV + (s2 ^ 1) * 128 + 32 * wid + 8 * lane;
                    *(LAS f32x4*)nn = (f32x4){sp * o0.x + pa[0], sp * o0.y + pa[1], sp * o0.z + pa[2], sp * o0.w + pa[3]};
                    *(LAS f32x4*)(nn + 4) = (f32x4){sp * o1.x + pa[4], sp * o1.y + pa[5], sp * o1.z + pa[6], sp * o1.w + pa[7]}; }
            }
        } else if (wid < 6) {
            const int jt = wid - 4, jl = 32 * jt + r32;
            u32x2 hw[4]; bool have_h = false; int cp = 0;
            if (st > 0) {
                cp = dir ? 64 - st : st - 1; have_h = true;
                const LAS float* iw = (const LAS float*)(SCS + s3p * 1024) + 128; const LAS float* enm = iw + 64;
                const LAS unsigned char* SDp = SD + (s2 ^ 1) * 8192;
                const LAS unsigned char* sr = SDp + hh * 4096 + jl * 16;
                u32x4 w4[4];
#pragma unroll
                for (int ch = 0; ch < 4; ++ch) w4[ch] = *(const LAS u32x4*)(sr + ch * 1024);
                const float iwj = iw[jl], enj = enm[jl];
                const LAS unsigned char* sa = SDp + qrd + jt * 512; const LAS unsigned char* vb = VS + s3p * 4096 + ktr;
                float rsum = 0.f;
#pragma unroll
                for (int ch = 0; ch < 4; ++ch) { const u32x4 w = w4[ch];
                    rsum += (bflo(w.x) + bfhi(w.x)) + (bflo(w.y) + bfhi(w.y)) + (bflo(w.z) + bfhi(w.z)) + (bflo(w.w) + bfhi(w.w)); }
                rsum = xor32_sum(rsum);
                const float den = rsum + iwj * qn;
                const float rdj = 1.f / fmaxf(fabsf(den), enj);
#pragma unroll
                for (int i = 0; i < 16; ++i) acc[i] *= iwj;
#pragma unroll
                for (int ks = 0; ks < 4; ++ks) { const s16x4 lo = trread(vb + ks * 1024), hi = trread(vb + ks * 1024 + 256);
                    acc = MFMA32(__builtin_shufflevector(lo, hi, 0, 1, 2, 3, 4, 5, 6, 7), *(const LAS bf16x8*)(sa + ks * 2048), acc); }
#pragma unroll
                for (int rg = 0; rg < 4; ++rg) { hw[rg].x = pk2(acc[4 * rg] * rdj, acc[4 * rg + 1] * rdj); hw[rg].y = pk2(acc[4 * rg + 2] * rdj, acc[4 * rg + 3] * rdj); }
            }
            if (st < 64) {
                const LAS unsigned char* qa = QT + qrd + jt * 512;
                const LAS unsigned char* cb = CI + s2 * 8192 + hh * 512 + r32 * 16;
                const LAS unsigned char* qr = QT + hh * 8192 + jl * 16; const LAS float* np = NV + s2 * 128 + 64 * hh;
                f32x16 acc2;
#pragma unroll
                for (int i = 0; i < 16; ++i) { acc[i] = 0.f; acc2[i] = 0.f; }
#pragma unroll
                for (int ks = 0; ks < 8; ks += 2) { acc = MFMA32(*(const LAS bf16x8*)(cb + ks * 1024), *(const LAS bf16x8*)(qa + ks * 2048), acc);
                    acc2 = MFMA32(*(const LAS bf16x8*)(cb + (ks + 1) * 1024), *(const LAS bf16x8*)(qa + (ks + 1) * 2048), acc2); }
#pragma unroll
                for (int i = 0; i < 16; ++i) acc[i] += acc2[i];
                qn = 0.f;
#pragma unroll
                for (int ch = 0; ch < 8; ++ch) { const u32x4 w = *(const LAS u32x4*)(qr + ch * 1024); const f32x4 n0 = *(const LAS f32x4*)(np + ch * 8), n1 = *(const LAS f32x4*)(np + ch * 8 + 4);
                    qn += bflo(w.x) * n0.x + bfhi(w.x) * n0.y + bflo(w.y) * n0.z + bfhi(w.y) * n0.w + bflo(w.z) * n1.x + bfhi(w.z) * n1.y + bflo(w.w) * n1.z + bfhi(w.w) * n1.w; }
                qn = xor32_sum(qn);
            }
            if (have_h) {
                LAS unsigned char* hst = HST + jt * 2048;
#pragma unroll
                for (int rg = 0; rg < 4; ++rg) *(LAS u32x2*)(hst + r32 * 64 + (8 * rg + 4 * hh) * 2) = hw[rg];
                asm volatile("s_waitcnt lgkmcnt(0)" ::: "memory");
#pragma unroll
                for (int q = 0; q < 2; ++q) { const int row = 16 * q + (lane >> 2), part = lane & 3;
                    const u32x4 w = *(const LAS u32x4*)(hst + row * 64 + part * 16);
                    *(u32x4*)(HD + (size_t)(cp * 64 + 32 * jt + row) * 512 + part * 8) = w; }
            }
        } else if (st < 64) {
            const int u = wid - 6; const float gm = gmv[c], sp = spv[c];
            const LAS unsigned char* va = VT + ktr; const LAS unsigned char* ka = KT + ktr + (2 * u) * 4096;
            s16x4 vlo[4], vhi[4], k0l[4], k0h[4], k1l[4], k1h[4]; f32x4 cw0[4], cw1[4];
#pragma unroll
            for (int ks = 0; ks < 4; ++ks) { vlo[ks] = trread(va + ks * 1024); vhi[ks] = trread(va + ks * 1024 + 256);
                cw0[ks] = *(const LAS f32x4*)(ct + 16 * ks + 8 * hh); cw1[ks] = *(const LAS f32x4*)(ct + 16 * ks + 8 * hh + 4);
                k0l[ks] = trread(ka + ks * 1024); k0h[ks] = trread(ka + ks * 1024 + 256); k1l[ks] = trread(ka + 4096 + ks * 1024); k1h[ks] = trread(ka + 4096 + ks * 1024 + 256); }
#pragma unroll
            for (int i = 0; i < 16; ++i) { Cacc[0][i] *= sp; Cacc[1][i] *= sp; }
#pragma unroll
            for (int ks = 0; ks < 4; ++ks) {
                const s16x4 lo = vlo[ks], hi = vhi[ks]; const f32x4 e0 = cw0[ks], e1 = cw1[ks];
                u32x4 af;
                af.x = pk2(bf2f((bf16_t)lo[0]) * __builtin_amdgcn_exp2f(e0.x + gm), bf2f((bf16_t)lo[1]) * __builtin_amdgcn_exp2f(e0.y + gm));
                af.y = pk2(bf2f((bf16_t)lo[2]) * __builtin_amdgcn_exp2f(e0.z + gm), bf2f((bf16_t)lo[3]) * __builtin_amdgcn_exp2f(e0.w + gm));
                af.z = pk2(bf2f((bf16_t)hi[0]) * __builtin_amdgcn_exp2f(e1.x + gm), bf2f((bf16_t)hi[1]) * __builtin_amdgcn_exp2f(e1.y + gm));
                af.w = pk2(bf2f((bf16_t)hi[2]) * __builtin_amdgcn_exp2f(e1.z + gm), bf2f((bf16_t)hi[3]) * __builtin_amdgcn_exp2f(e1.w + gm));
                const bf16x8 afr = __builtin_bit_cast(bf16x8, af);
                Cacc[0] = MFMA32(__builtin_shufflevector(k0l[ks], k0h[ks], 0, 1, 2, 3, 4, 5, 6, 7), afr, Cacc[0]);
                Cacc[1] = MFMA32(__builtin_shufflevector(k1l[ks], k1h[ks], 0, 1, 2, 3, 4, 5, 6, 7), afr, Cacc[1]);
            }
            LAS unsigned char* cw = CI + (s2 ^ 1) * 8192 + (2 * u) * 2048 + r32 * 16 + hh * 8;
#pragma unroll
            for (int t2 = 0; t2 < 2; ++t2)
#pragma unroll
                for (int rg = 0; rg < 4; ++rg) { u32x2 w; w.x = pk2(Cacc[t2][4 * rg], Cacc[t2][4 * rg + 1]); w.y = pk2(Cacc[t2][4 * rg + 2], Cacc[t2][4 * rg + 3]); *(LAS u32x2*)(cw + t2 * 2048 + rg * 512) = w; }
        }
        if (PROBE_MSEQ_W >= 0) { asm volatile("s_waitcnt lgkmcnt(0)" ::: "memory"); busy += __builtin_amdgcn_s_memtime() - tb0; }
        if (cwave) {
            if (st + 1 < 64) asm volatile("s_waitcnt vmcnt(4)" ::: "memory"); else asm volatile("s_waitcnt vmcnt(0)" ::: "memory");
            if (st < 64) {
                const int id = cslot0 + st, e = id / 6144, r = id % 6144, mat = r >> 11, rr = r & 2047;
                const int nb = mat == 2 ? (rr >> 7) : (rr >> 6), kb = mat == 2 ? (rr & 127) : (rr & 63), n = 64 * nb + lane;
                unsigned char* dst = mat == 2 ? a.ws + WS_WDT + (size_t)e * DM * DFF + (size_t)n * DFF + 16 * kb
                                              : a.ws + WS_WGUT + (size_t)e * 4096 * DM + (size_t)((n >> 7) * 256 + (n & 127) + mat * 128) * DM + 16 * kb;
                const LAS float* CSC = (const LAS float*)(F.lds + 119808 + cwi * 8192 + (id & 1) * 4096);
                float cv[16];
#pragma unroll
                for (int k = 0; k < 16; ++k) cv[k] = CSC[k * 64 + lane] * pg8::W_PRESCALE;
                u32x4 o; o.x = pg8::pk4_fp8(cv[0], cv[1], cv[2], cv[3]); o.y = pg8::pk4_fp8(cv[4], cv[5], cv[6], cv[7]); o.z = pg8::pk4_fp8(cv[8], cv[9], cv[10], cv[11]); o.w = pg8::pk4_fp8(cv[12], cv[13], cv[14], cv[15]);
                *(u32x4*)dst = o;
            }
        } else if (wid == 6) asm volatile("s_waitcnt vmcnt(0)" ::: "memory");
        asm volatile("s_waitcnt lgkmcnt(0)" ::: "memory"); __builtin_amdgcn_s_barrier(); asm volatile("" ::: "memory");
        if (PROBE_MSEQ_W >= 0) tb0 = __builtin_amdgcn_s_memtime();
    }
    if (PROBE_MSEQ_W >= 0 && F.bid == 0 && lane == 0 && (wid == PROBE_MSEQ_W || (PROBE_MSEQ_W == 8 && wid == 0)))
        *(volatile LAS unsigned long long*)(F.lds + LDS_BYTES - 128) = (PROBE_MSEQ_W == 8) ? (__builtin_amdgcn_s_memtime() - titem0) : busy;
    asm volatile("s_waitcnt vmcnt(0)" ::: "memory");
#undef MSEQ_ISSUE_QK
#undef MSEQ_ISSUE_VS
#undef MSEQ_CONV_ISSUE
}

DI void glds16(const void* g, LAS unsigned char* l) { __builtin_amdgcn_global_load_lds((const unsigned*)g, (LAS unsigned*)l, 16, 0, 0); }
DI void attn_unit(const Ctx& F, const Args& a, int b, int h, int qb, float lam, float cshift) {
    const int lane = F.lane, wid = F.wave, r32 = lane & 31, hh = lane >> 5, rg = wid & 3, p = wid >> 2;
    const bf16_t* projb = (const bf16_t*)(a.ws + WS_PROJ) + (size_t)b * SEQ * PS;
    const int qrow = qb * 128 + rg * 32 + r32;
    bf16x8 qf[4];
    { const bf16_t* qp = projb + (size_t)qrow * PS + C_QA + h * 128 + p * 64 + hh * 8;
#pragma unroll
      for (int ks = 0; ks < 4; ++ks) qf[ks] = *(const bf16x8*)(qp + ks * 16); }
    const bf16_t* kimg = (const bf16_t*)(a.ws + WS_KIMG) + (size_t)(b * 4 + h) * 64 * 8192 + (4 * wid) * 512 + lane * 8;
    const bf16_t* vimg = (const bf16_t*)(a.ws + WS_VIMG) + (size_t)(b * 4 + h) * 64 * 8192 + (4 * wid) * 512 + lane * 8;
    const unsigned ldsw = (unsigned)__builtin_amdgcn_readfirstlane((int)(unsigned)(uintptr_t)F.lds + (4 * wid) * 1024);
#define ATT_ISSUE2(img, t0, ldsoff) do { const int _q0 = 4 * wid; const int _t = (t0) + (_q0 >> 4); const bf16_t* _tp = (img) + (size_t)(_t < 64 ? _t : 63) * 8192 - (size_t)(_q0 & 16) * 512; \
        const unsigned _d = (unsigned)__builtin_amdgcn_readfirstlane((int)(ldsw + (ldsoff))); \
        _Pragma("unroll") for (int _i = 0; _i < 4; ++_i) glds16_asm(_tp + _i * 512, _d + _i * 1024); } while (0)
    if (wid < 4) { const bf16_t* _tp = kimg; const unsigned _d = (unsigned)__builtin_amdgcn_readfirstlane((int)(ldsw + 32768));
#pragma unroll
        for (int _i = 0; _i < 4; ++_i) glds16_asm(_tp + _i * 512, _d + _i * 1024); }
    ATT_ISSUE2(kimg, 1, 0); ATT_ISSUE2(vimg, 0, 65536);
    f32x16 O[4];
#pragma unroll
    for (int vt = 0; vt < 4; ++vt)
#pragma unroll
        for (int i = 0; i < 16; ++i) O[vt][i] = 0.f;
    float lsum = 0.f;
    const int kfb = p * 8192 + hh * 1024 + r32 * 16;
    const int vfb = (4 * hh + ((lane & 15) >> 2)) * 64 + ((lane >> 4) & 1) * 32 + (lane & 3) * 8;
    bf16x8 pb[4], pc[4];
    asm volatile("s_waitcnt vmcnt(0)" ::: "memory");
    __syncthreads();
#define ATT_VLOAD(dst, Vb, kg) do { _Pragma("unroll") for (int vt = 0; vt < 4; ++vt) { \
        const s16x4 _lo = trread((Vb) + vt * 4096 + (kg) * 1024), _hi = trread((Vb) + vt * 4096 + (kg) * 1024 + 512); dst[vt] = __builtin_shufflevector(_lo, _hi, 0, 1, 2, 3, 4, 5, 6, 7); } } while (0)
#define ATT_PV(vf, kg, PIN) do { __builtin_amdgcn_s_setprio(1); _Pragma("unroll") for (int vt = 0; vt < 4; ++vt) O[vt] = MFMA32(vf[vt], PIN[kg], O[vt]); __builtin_amdgcn_s_setprio(0); } while (0)
#define ATT_EXPQ(S, o, dst) do { float _e[8]; _Pragma("unroll") for (int i = 0; i < 8; ++i) _e[i] = __builtin_amdgcn_exp2f(S[(o) + i]); \
        _Pragma("unroll") for (int i = 0; i < 8; ++i) ls = ls + _e[i]; \
        u32x4 _w; _w.x = pk2(_e[0], _e[1]); _w.y = pk2(_e[2], _e[3]); _w.z = pk2(_e[4], _e[5]); _w.w = pk2(_e[6], _e[7]); dst = __builtin_bit_cast(bf16x8, _w); } while (0)
#define ATT_STEP(Kb, Vb, on0, PIN, POUT) do { \
        bf16x8 kfa[4], kfb2[4], vA[4], vB[4]; float ls = 0.f; \
        _Pragma("unroll") for (int ks = 0; ks < 4; ++ks) { kfa[ks] = *(const LAS bf16x8*)((Kb) + ks * 2048); kfb2[ks] = *(const LAS bf16x8*)((Kb) + ks * 2048 + 512); } \
        ATT_VLOAD(vA, Vb, 0); \
        __builtin_amdgcn_s_setprio(1); \
        Sa = MFMA32(kfa[0], qf[0], negc); Sb = MFMA32(kfb2[0], qf[0], negc);        \
        _Pragma("unroll") for (int ks = 1; ks < 4; ++ks) { Sa = MFMA32(kfa[ks], qf[ks], Sa); Sb = MFMA32(kfb2[ks], qf[ks], Sb); } \
        __builtin_amdgcn_s_setprio(0); \
        ATT_VLOAD(vB, Vb, 1); ATT_PV(vA, 0, PIN); ATT_EXPQ(Sa, 0, POUT[0]); \
        ATT_VLOAD(vA, Vb, 2); ATT_PV(vB, 1, PIN); ATT_EXPQ(Sa, 8, POUT[1]); \
        ATT_VLOAD(vB, Vb, 3); ATT_PV(vA, 2, PIN); ATT_EXPQ(Sb, 0, POUT[2]); \
        ATT_PV(vB, 3, PIN); ATT_EXPQ(Sb, 8, POUT[3]); \
        lsum += (on0) ? ls : 0.f; } while (0)
    f32x16 Sa, Sb, negc;
#pragma unroll
    for (int i = 0; i < 16; ++i) negc[i] = -cshift;
    asm volatile("" : "+v"(negc));
    {
        const LAS unsigned char* Kb = F.lds + 32768 + kfb;
        Sa = MFMA32(*(const LAS bf16x8*)(Kb), qf[0], negc); Sb = MFMA32(*(const LAS bf16x8*)(Kb + 512), qf[0], negc);
#pragma unroll
        for (int ks = 1; ks < 4; ++ks) { Sa = MFMA32(*(const LAS bf16x8*)(Kb + ks * 2048), qf[ks], Sa); Sb = MFMA32(*(const LAS bf16x8*)(Kb + ks * 2048 + 512), qf[ks], Sb); }
        float ls = 0.f;
        ATT_EXPQ(Sa, 0, pb[0]); ATT_EXPQ(Sa, 8, pb[1]); ATT_EXPQ(Sb, 0, pb[2]); ATT_EXPQ(Sb, 8, pb[3]);
        lsum += ls;
    }
    __syncthreads();
#pragma unroll 1
    for (int T = 0; T < 32; ++T) {
        const int j = T & 1;
        ATT_ISSUE2(kimg, 2 * T + 3, (j ^ 1) * 32768);
        ATT_ISSUE2(vimg, 2 * T + 2, 65536 + (j ^ 1) * 32768);
        const LAS unsigned char* Ks = F.lds + j * 32768 + kfb; const LAS unsigned char* Vs = F.lds + 65536 + j * 32768 + vfb;
        ATT_STEP(Ks, Vs, true, pb, pc);
        ATT_STEP(Ks + 16384, Vs + 16384, T < 31, pc, pb);
        asm volatile("s_waitcnt vmcnt(0)" ::: "memory");
        __syncthreads();
    }
#undef ATT_EXPQ
#undef ATT_STEP
#undef ATT_VLOAD
#undef ATT_PV
#undef ATT_ISSUE2
    lsum += __shfl_xor(lsum, 32);
    LAS float* X = (LAS float*)(F.lds + 65536) + rg * 4096 + r32;
    if (p == 1) {
        const float sc = lam / lsum;
#pragma unroll
        for (int vt = 0; vt < 4; ++vt)
#pragma unroll
            for (int i = 0; i < 16; ++i) X[(32 * vt + crow(i, hh)) * 32] = O[vt][i] * sc;
    }
    __syncthreads();
    if (p == 0) {
        const float i0 = 1.f / lsum;
        float ssq = 0.f;
#pragma unroll
        for (int vt = 0; vt < 4; ++vt)
#pragma unroll
            for (int i = 0; i < 16; ++i) { const float o = O[vt][i] * i0 - X[(32 * vt + crow(i, hh)) * 32]; O[vt][i] = o; ssq += o * o; }
        ssq += __shfl_xor(ssq, 32);
        const float rs = rsqrtf(ssq * (1.f / 128.f) + EPS) * 0.8f;
        bf16_t* yp = (bf16_t*)(a.ws + WS_YMIX) + (size_t)(b * SEQ + qrow) * DM + 512 + h * 128;
#pragma unroll
        for (int vt = 0; vt < 4; ++vt)
#pragma unroll
            for (int rgi = 0; rgi < 4; ++rgi) { const int vd = 32 * vt + 8 * rgi + 4 * hh; const f32x4 g = *(const f32x4*)(a.subln_g + vd);
                u32x2 w; w.x = pk2(O[vt][4 * rgi] * rs * g.x, O[vt][4 * rgi + 1] * rs * g.y); w.y = pk2(O[vt][4 * rgi + 2] * rs * g.z, O[vt][4 * rgi + 3] * rs * g.w);
                *(u32x2*)(yp + vd) = w; }
    }
    __syncthreads();
}

DI void mcombine_phase(const Ctx& F, const Args& a) {
    const int gw = F.bid * NWAVES + F.wave, NGW = F.G * NWAVES, lane = F.lane;
    const bf16_t* HD = (const bf16_t*)((const unsigned char*)a.out + DO_HD);
    float g[8];
#pragma unroll
    for (int i = 0; i < 8; ++i) g[i] = a.mnorm_g[lane * 8 + i];
    for (int m = gw; m < MTOK; m += NGW) {
        const u32x4 f = *(const u32x4*)(HD + (size_t)m * 512 + lane * 8), bw = *(const u32x4*)(HD + ((size_t)MTOK + m) * 512 + lane * 8);
        const u32x4 om = *(const u32x4*)((const bf16_t*)(a.ws + WS_PROJ) + (size_t)m * PS + C_OM + lane * 8);
        float v[8];
        v[0] = bflo(f.x) + bflo(bw.x); v[1] = bfhi(f.x) + bfhi(bw.x); v[2] = bflo(f.y) + bflo(bw.y); v[3] = bfhi(f.y) + bfhi(bw.y);
        v[4] = bflo(f.z) + bflo(bw.z); v[5] = bfhi(f.z) + bfhi(bw.z); v[6] = bflo(f.w) + bflo(bw.w); v[7] = bfhi(f.w) + bfhi(bw.w);
        float ss = 0.f;
#pragma unroll
        for (int i = 0; i < 8; ++i) ss += v[i] * v[i];
        ss += __shfl_xor(ss, 1); ss += __shfl_xor(ss, 2); ss += __shfl_xor(ss, 4); ss += __shfl_xor(ss, 8);
        const float rstd = rsqrtf(ss * (1.f / 128.f) + EPS);
        float o[8];
        o[0] = bflo(om.x); o[1] = bfhi(om.x); o[2] = bflo(om.y); o[3] = bfhi(om.y); o[4] = bflo(om.z); o[5] = bfhi(om.z); o[6] = bflo(om.w); o[7] = bfhi(om.w);
#pragma unroll
        for (int i = 0; i < 8; ++i) v[i] = v[i] * rstd * g[i] * sigmoid_f(o[i]);
        u32x4 w; w.x = pk2(v[0], v[1]); w.y = pk2(v[2], v[3]); w.z = pk2(v[4], v[5]); w.w = pk2(v[6], v[7]);
        bf16_t* yp = (bf16_t*)(a.ws + WS_YMIX) + (size_t)m * DM + lane * 8;
        *(u32x4*)yp = w;
    }
}

DI void router_finish(const float (&lg)[16], int lane, float* affrow, bool store) {
    float r8[8];
#pragma unroll
    for (int i = 0; i < 8; ++i) { const float keep = hh_sel(lane, 32) ? lg[8 + i] : lg[i], send = hh_sel(lane, 32) ? lg[i] : lg[8 + i]; r8[i] = keep + partner32(send, lane); }
    float r4[4];
#pragma unroll
    for (int i = 0; i < 4; ++i) { const float keep = hh_sel(lane, 16) ? r8[4 + i] : r8[i], send = hh_sel(lane, 16) ? r8[i] : r8[4 + i]; r4[i] = keep + partner16(send, lane); }
    float r2[2];
#pragma unroll
    for (int i = 0; i < 2; ++i) { const float keep = hh_sel(lane, 8) ? r4[2 + i] : r4[i], send = hh_sel(lane, 8) ? r4[i] : r4[2 + i]; r2[i] = keep + partner8(send); }
    float lgt; { const float keep = hh_sel(lane, 4) ? r2[1] : r2[0], send = hh_sel(lane, 4) ? r2[0] : r2[1]; lgt = keep + partner4(send, lane); }
    lgt += dpp_mov<DPP_XOR2>(lgt); lgt += dpp_mov<DPP_XOR1>(lgt);
    float mx = lgt; mx = fmaxf(mx, dpp_mov<DPP_ROR(8)>(mx)); mx = fmaxf(mx, dpp_mov<DPP_ROR(4)>(mx)); mx = xor16_max(mx); mx = xor32_max(mx);
    const float ex = __expf(lgt - mx); float sm = ex; sm += dpp_mov<DPP_ROR(8)>(sm); sm += dpp_mov<DPP_ROR(4)>(sm); sm = xor16_sum(sm); sm = xor32_sum(sm);
    if ((lane & 3) == 0 && store) affrow[lane >> 2] = ex / sm;
}
DI void p7_phase(const Ctx& F, const Args& a) {
    LAS bf16_t* WH = (LAS bf16_t*)F.lds; LAS bf16_t* WL = (LAS bf16_t*)(F.lds + 33024);
    LAS float* GS = (LAS float*)(F.lds + 66048); LAS float* SH = GS + 1024;
    const float* mod = (const float*)(a.ws + WS_MOD);
    const int lane = F.lane, n = lane & 15, kg = lane >> 4;
    unsigned char* H2 = a.ws + WS_H2; float* AFF = (float*)(a.ws + WS_AFF);
#pragma unroll 1
    for (int grp = F.bid; grp < MTOK / 128; grp += F.G) {
        const int b = (grp * 128) / SEQ;
        const int m = grp * 128 + F.wave * 16 + n;
        const u32x4* xr = (const u32x4*)((const bf16_t*)(a.ws + WS_X1B) + (size_t)m * DM + 16 * kg);
        u32x4 xq[16][2];
#pragma unroll
        for (int i = 0; i < 16; ++i) { xq[i][0] = xr[8 * i]; xq[i][1] = xr[8 * i + 1]; }
        __syncthreads();
        if (grp == F.bid) {
        for (int q = F.tid; q < 16384; q += NTHR) { const int k = q >> 4, e = q & 15; const float w = a.w_router[q];
            const unsigned hi = pk2(w, 0.f) & 0xffffu; const float rem = w - __uint_as_float(hi << 16);
            ((LAS unsigned short*)WH)[e * 1032 + k] = (unsigned short)hi; ((LAS unsigned short*)WL)[e * 1032 + k] = (unsigned short)(pk2(rem, 0.f) & 0xffffu); }
        }
        for (int k = F.tid; k < DM; k += NTHR) { GS[k] = a.norm2_g[k] * (mod[(size_t)b * 6144 + 4096 + k] + 1.f); SH[k] = mod[(size_t)b * 6144 + 3072 + k]; }
        __syncthreads();
        float s = 0.f;
#pragma unroll
        for (int i = 0; i < 16; ++i)
#pragma unroll
            for (int c = 0; c < 2; ++c)
#pragma unroll
                for (int d = 0; d < 4; ++d) { const float lo = bflo(xq[i][c][d]), hi = bfhi(xq[i][c][d]); s += lo * lo + hi * hi; }
        s = xor16_sum(s); s = xor32_sum(s);
        const float rstd = rsqrtf(s * (1.f / DM) + EPS);
#pragma unroll
        for (int i = 0; i < 16; ++i) { asm volatile("" : "+v"(xq[i][0]), "+v"(xq[i][1])); }
        f32x4 lg = {0.f, 0.f, 0.f, 0.f};
        u32x4* hp = (u32x4*)(H2 + (size_t)m * DM + 16 * kg);
        const LAS unsigned char* whp = (const LAS unsigned char*)WH + n * 2064 + kg * 32; const LAS unsigned char* wlp = (const LAS unsigned char*)WL + n * 2064 + kg * 32;
        const LAS float* gsp = GS + 16 * kg; const LAS float* shp = SH + 16 * kg;
#pragma unroll
        for (int i = 0; i < 16; ++i) {
            u32x4 h8;
#pragma unroll
            for (int c = 0; c < 2; ++c) {
                const f32x4 g0 = *(const LAS f32x4*)(gsp + 64 * i + 8 * c), g1 = *(const LAS f32x4*)(gsp + 64 * i + 8 * c + 4);
                const f32x4 s0 = *(const LAS f32x4*)(shp + 64 * i + 8 * c), s1 = *(const LAS f32x4*)(shp + 64 * i + 8 * c + 4);
                const u32x4 xw = xq[i][c];
                float t[8];
                t[0] = bflo(xw.x) * rstd * g0.x + s0.x; t[1] = bfhi(xw.x) * rstd * g0.y + s0.y; t[2] = bflo(xw.y) * rstd * g0.z + s0.z; t[3] = bfhi(xw.y) * rstd * g0.w + s0.w;
                t[4] = bflo(xw.z) * rstd * g1.x + s1.x; t[5] = bfhi(xw.z) * rstd * g1.y + s1.y; t[6] = bflo(xw.w) * rstd * g1.z + s1.z; t[7] = bfhi(xw.w) * rstd * g1.w + s1.w;
                const unsigned f0 = pg8::pk4_fp8(t[0], t[1], t[2], t[3]), f1 = pg8::pk4_fp8(t[4], t[5], t[6], t[7]);
                if (c == 0) { h8.x = f0; h8.y = f1; } else { h8.z = f0; h8.w = f1; }
                u32x4 th, tl;
#pragma unroll
                for (int d = 0; d < 4; ++d) { const unsigned hw = pk2(t[2 * d], t[2 * d + 1]); th[d] = hw; tl[d] = pk2(t[2 * d] - bflo(hw), t[2 * d + 1] - bfhi(hw)); }
                const bf16x8 wh = *(const LAS bf16x8*)(whp + 128 * i + 16 * c), wl = *(const LAS bf16x8*)(wlp + 128 * i + 16 * c);
                const bf16x8 thv = __builtin_bit_cast(bf16x8, th), tlv = __builtin_bit_cast(bf16x8, tl);
                lg = __builtin_amdgcn_mfma_f32_16x16x32_bf16(wh, thv, lg, 0, 0, 0);
                lg = __builtin_amdgcn_mfma_f32_16x16x32_bf16(wh, tlv, lg, 0, 0, 0);
                lg = __builtin_amdgcn_mfma_f32_16x16x32_bf16(wl, thv, lg, 0, 0, 0);
            }
            hp[4 * i] = h8;
            __builtin_amdgcn_sched_barrier(0);
        }
        float mx = fmaxf(fmaxf(lg[0], lg[1]), fmaxf(lg[2], lg[3])); mx = xor16_max(mx); mx = xor32_max(mx);
        f32x4 ex; float sm = 0.f;
#pragma unroll
        for (int r = 0; r < 4; ++r) { ex[r] = __expf(lg[r] - mx); sm += ex[r]; }
        sm = xor16_sum(sm); sm = xor32_sum(sm);
        const float inv = 1.f / sm;
        *(f32x4*)(AFF + (size_t)m * 16 + 4 * kg) = ex * inv;
    }
    __syncthreads();
}

DI void topk_task(const Ctx& F, const Args& a, int task) {
    const int b = task >> 4, e = task & 15, tid = F.tid, lane = F.lane;
    const float* AFF = (const float*)(a.ws + WS_AFF) + (size_t)b * SEQ * 16 + e;
    LAS unsigned* hist = (LAS unsigned*)F.lds;
    LAS unsigned* sfx = hist + 256;
    LAS unsigned* misc = hist + 512;
    unsigned key[8];
#pragma unroll
    for (int i = 0; i < 8; ++i) key[i] = __float_as_uint(AFF[(size_t)(tid * 8 + i) * 16]);
    unsigned prefix = 0, krem = CAP;
#pragma unroll 1
    for (int pass = 0; pass < 4; ++pass) {
        const int shift = 24 - 8 * pass;
        if (tid < 256) hist[tid] = 0;
        __syncthreads();
#pragma unroll
        for (int i = 0; i < 8; ++i) { const bool in = pass == 0 ? true : ((key[i] >> (shift + 8)) == (prefix >> (shift + 8))); if (in) atomicAdd((unsigned*)&hist[(key[i] >> shift) & 255u], 1u); }
        __syncthreads();
        if (tid < 256) sfx[tid] = hist[tid];
        __syncthreads();
#pragma unroll 1
        for (int o = 1; o < 256; o <<= 1) { unsigned v = 0; if (tid < 256) v = sfx[tid] + (tid + o < 256 ? sfx[tid + o] : 0u); __syncthreads(); if (tid < 256) sfx[tid] = v; __syncthreads(); }
        if (tid < 256) { const unsigned incl = sfx[tid], excl = incl - hist[tid]; if (excl < krem && krem <= incl) { misc[0] = (unsigned)tid; misc[1] = krem - excl; } }
        __syncthreads();
        prefix |= misc[0] << shift; krem = misc[1];
        __syncthreads();
    }
    const unsigned T = prefix, need = krem;
    unsigned cg_ = 0, ce = 0;
#pragma unroll
    for (int i = 0; i < 8; ++i) { cg_ += key[i] > T; ce += key[i] == T; }
    unsigned sg = cg_, se = ce;
#pragma unroll
    for (int o = 1; o < 64; o <<= 1) { const unsigned tg = __shfl_up(sg, o), te = __shfl_up(se, o); if (lane >= o) { sg += tg; se += te; } }
    if (lane == 63) { misc[16 + F.wave] = sg; misc[32 + F.wave] = se; }
    __syncthreads();
    unsigned og = sg - cg_, oe = se - ce;
    for (int w = 0; w < F.wave; ++w) { og += misc[16 + w]; oe += misc[32 + w]; }
    int* SLOT = (int*)(a.ws + WS_SLOT) + (size_t)b * SEQ * 16 + e;
    float* VALS = (float*)(a.ws + WS_VALS) + (size_t)(e * 8 + b) * CAP;
    int* IDX = (int*)(a.ws + WS_IDX) + (size_t)(e * 8 + b) * CAP;
#pragma unroll
    for (int i = 0; i < 8; ++i) {
        const bool gt = key[i] > T, eq = key[i] == T; const bool sel = gt || (eq && oe < need);
        const unsigned pos = og + (oe < need ? oe : need);
        const int s = tid * 8 + i;
        SLOT[(size_t)s * 16] = sel ? (int)pos : -1;
        if (sel) { IDX[pos] = b * SEQ + s; VALS[pos] = __uint_as_float(key[i]); }
        og += gt; oe += eq;
    }
    __syncthreads();
}

DI void final_phase(const Ctx& F, const Args& a) {
    const int gw = F.bid * NWAVES + F.wave, NGW = F.G * NWAVES, lane = F.lane;
    const float* mod = (const float*)(a.ws + WS_MOD); const int* SLOT = (const int*)(a.ws + WS_SLOT); const unsigned char* Y = a.ws + WS_Y;
    for (int m = gw; m < MTOK; m += NGW) {
        const int b = m / SEQ;
        const int sl = SLOT[(size_t)m * 16 + (lane & 15)];
        f32x4* op = (f32x4*)(a.out + (size_t)m * DM + lane * 16);
        f32x4 xv[4];
        { const u32x4* xp = (const u32x4*)((const bf16_t*)(a.ws + WS_X1B) + (size_t)m * DM + lane * 16); const u32x4 w0 = xp[0], w1 = xp[1];
          xv[0].x = bflo(w0.x); xv[0].y = bfhi(w0.x); xv[0].z = bflo(w0.y); xv[0].w = bfhi(w0.y); xv[1].x = bflo(w0.z); xv[1].y = bfhi(w0.z); xv[1].z = bflo(w0.w); xv[1].w = bfhi(w0.w);
          xv[2].x = bflo(w1.x); xv[2].y = bfhi(w1.x); xv[2].z = bflo(w1.y); xv[2].w = bfhi(w1.y); xv[3].x = bflo(w1.z); xv[3].y = bfhi(w1.z); xv[3].z = bflo(w1.w); xv[3].w = bfhi(w1.w); }
        float acc[16];
#pragma unroll
        for (int i = 0; i < 16; ++i) acc[i] = 0.f;
#pragma unroll 1
        for (int e = 0; e < 16; ++e) { const int s = __shfl(sl, e);
            if (s >= 0) { const u32x4 w = *(const u32x4*)(Y + ((size_t)(e * 8 + b) * CAP + s) * DM + lane * 16);
#pragma unroll
                for (int q = 0; q < 4; ++q) { const unsigned ww = w[q];
                    const auto lo = __builtin_amdgcn_cvt_pk_f32_fp8((int)ww, false), hi = __builtin_amdgcn_cvt_pk_f32_fp8((int)ww, true);
                    acc[4 * q] += lo[0]; acc[4 * q + 1] += lo[1]; acc[4 * q + 2] += hi[0]; acc[4 * q + 3] += hi[1]; } } }
        const f32x4* gp = (const f32x4*)(mod + (size_t)b * 6144 + 5120 + lane * 16);
#pragma unroll
        for (int q = 0; q < 4; ++q) { const f32x4 g = gp[q] * (1.f / pg8::Y_PRESCALE); f32x4 o = xv[q]; o.x += g.x * acc[4 * q]; o.y += g.y * acc[4 * q + 1]; o.z += g.z * acc[4 * q + 2]; o.w += g.w * acc[4 * q + 3]; op[q] = o; }
    }
}

#define XB_TMO      128
#define XB_XCNT(j)  (256  + 64 * (j))
#define XB_XSUB(j)  (1280 + 64 * (j))
#define XB_XGEN(j)  (2304 + 64 * (j))
#define XB_TOP      3328
#define XB_TOPGEN   3392
#define XB_SPIN_CAP (1u << 18)
DI unsigned xb_ld(unsigned* p)              { return __hip_atomic_load(p, __ATOMIC_RELAXED, __HIP_MEMORY_SCOPE_AGENT); }
DI unsigned xb_add(unsigned* p, unsigned v) { return __hip_atomic_fetch_add(p, v, __ATOMIC_RELAXED, __HIP_MEMORY_SCOPE_AGENT); }
DI unsigned xb_xcc_id() { return (unsigned)__builtin_amdgcn_s_getreg((3 << 11) | 20) & 0xFu; }
#define XB_SPIN(cond, bar) do { unsigned _sp = 0; while (cond) { __builtin_amdgcn_s_sleep(1); \
    if ((++_sp & 255u) == 0u) { if (xb_ld(&(bar)[XB_TMO])) break; if (_sp > XB_SPIN_CAP) { atomicAdd(&(bar)[XB_TMO], 1u); break; } } } } while (0)
struct XcdBarrier { unsigned* bar; unsigned x; volatile LAS unsigned* st; };
DI XcdBarrier xcd_barrier_post(unsigned* bar, volatile LAS unsigned* st) {
    XcdBarrier b; b.bar = bar; b.x = xb_xcc_id(); b.st = st;
    if (threadIdx.x == 0) (void)xb_add(&bar[XB_XCNT(b.x)], 1u);
    return b;
}
DI void xcd_barrier_complete(unsigned* bar, unsigned x, unsigned& nloc, unsigned& nx) {
    const unsigned G = gridDim.x * gridDim.y * gridDim.z;
    unsigned sum, cnt, mine, sp = 0u;
    for (;;) {
        sum = 0u; cnt = 0u; mine = 0u;
#pragma unroll
        for (unsigned j = 0; j < 16; ++j) { const unsigned c = xb_ld(&bar[XB_XCNT(j)]); sum += c; cnt += (c > 0u) ? 1u : 0u; mine = (j == x) ? c : mine; }
        if (sum == G) break;
        __builtin_amdgcn_s_sleep(1);
        if ((++sp & 255u) == 0u) { if (xb_ld(&bar[XB_TMO])) break; if (sp > XB_SPIN_CAP) { atomicAdd(&bar[XB_TMO], 1u); break; } }
    }
    nloc = mine > 0u ? mine : 1u; nx = cnt > 0u ? cnt : 1u;
}
DI void xcd_barrier(const XcdBarrier& b) {
    asm volatile("s_waitcnt vmcnt(0)" ::: "memory");
    __syncthreads();
    if (threadIdx.x == 0) {
        unsigned* bar = b.bar;
        __builtin_amdgcn_s_waitcnt(0);
        unsigned nloc = b.st[0], nx = b.st[1];
        if (nloc == 0u) { xcd_barrier_complete(bar, b.x, nloc, nx); b.st[0] = nloc; b.st[1] = nx; }
        const unsigned old = xb_add(&bar[XB_XSUB(b.x)], 1u);
        const unsigned gen = old / nloc;
        if (old + 1u == (gen + 1u) * nloc) {
            __builtin_amdgcn_fence(__ATOMIC_RELEASE, "agent");
            asm volatile("s_waitcnt vmcnt(0)" ::: "memory");
            const unsigned og = xb_add(&bar[XB_TOP], 1u);
            const unsigned tg = og / nx;
            if (og + 1u == (tg + 1u) * nx) xb_add(&bar[XB_TOPGEN], 1u);
            else XB_SPIN(xb_ld(&bar[XB_TOPGEN]) == tg, bar);
            __builtin_amdgcn_fence(__ATOMIC_ACQUIRE, "agent");
            xb_add(&bar[XB_XGEN(b.x)], 1u);
            asm volatile("s_waitcnt vmcnt(0)" ::: "memory");
        } else {
            XB_SPIN(xb_ld(&bar[XB_XGEN(b.x)]) == gen, bar);
            __builtin_amdgcn_fence(__ATOMIC_ACQUIRE, "agent");
            asm volatile("s_waitcnt vmcnt(0)" ::: "memory");
        }
    }
    __syncthreads();
}

static_assert(sizeof(Args) == 22 * 8, "Args layout");
__global__ void __launch_bounds__(NTHR, 2) fwd_kernel(Args a_unused) {
    extern __shared__ __attribute__((aligned(16))) unsigned char lds_raw[];
    cg::grid_group grid = cg::this_grid();
    Ctx F; F.lds = (LAS unsigned char*)lds_raw; F.tid = threadIdx.x; F.lane = F.tid & 63; F.wave = __builtin_amdgcn_readfirstlane(F.tid >> 6); F.G = gridDim.x; F.bid = blockIdx.x;

    int lo, hi; { typedef __attribute__((address_space(4))) const volatile unsigned long long* kp_t; const unsigned long long ph = ((kp_t)__builtin_amdgcn_kernarg_segment_ptr())[21]; lo = (int)(unsigned)ph; hi = (int)(unsigned)(ph >> 32); }
#ifndef PHASE_MASK
#define PHASE_MASK 0xffff
#endif
#define IN(k) (((PHASE_MASK >> (k)) & 1) && lo <= (k) && (k) < hi)
    volatile LAS unsigned* bst = (volatile LAS unsigned*)(F.lds + LDS_BYTES - 64);
    if (F.tid < 2) bst[F.tid] = 0u;
    __syncthreads();
    XcdBarrier xbar;
    { const Args a0 = load_args(); xbar = xcd_barrier_post((unsigned*)(a0.ws + WS_CTL), bst); }
    volatile LAS unsigned long long* tsl = (volatile LAS unsigned long long*)(F.lds + LDS_BYTES - 256);
    if (PROBE_PHASE >= 0 && F.bid == 0 && F.tid == 0) tsl[0] = __builtin_amdgcn_s_memrealtime();
#define SEAM(k) do { if (IN(k) && IN((k) + 1)) { xcd_barrier(xbar); } \
        if (PROBE_PHASE >= 0 && F.bid == 0 && F.tid == 0) tsl[(k) + 1] = __builtin_amdgcn_s_memrealtime(); } while (0)
    grid.sync();
    if (IN(0)) { const Args a = load_args(); p0_phase(F, a); p1_phase(F, a); }
    if (PROBE_PHASE >= 0 && F.bid == 0 && F.tid == 0) tsl[1] = __builtin_amdgcn_s_memrealtime();
    SEAM(1);
    if (IN(2)) {
        const Args a = load_args();
        pg8::Gemm g{(const bf16_t*)a.out, (const bf16_t*)(a.ws + WS_WINT), MTOK, PS, DM, 1 << 30}; pg8::StaticOrder S; S.init(MTOK, PS, F.G, F.bid);
        pg8::EpiProj E{(bf16_t*)(a.ws + WS_PROJ), a.pos, a.qk_g, (bf16_t*)(a.ws + WS_KIMG), (bf16_t*)(a.ws + WS_VIMG)};
        pg8::gemm_phase<pg8::EpiProj, true, true>(F.lds, g, S, E);
        gates_tasks(F, a);
    }
    SEAM(2);
    if (IN(3)) {
        const Args a = load_args();
        for (int t = F.bid * NWAVES + F.wave; t < MTOK / 8 * 2; t += F.G * NWAVES) conv_task(F, a, t);
        for (int t = F.bid; t < 64; t += F.G) mscal_task(F, a, t);
    }
    SEAM(3);
    if (IN(4)) {
        const Args a = load_args();
        {
#pragma unroll 1
            for (int rep = 0; rep < REP_MSEQ; ++rep)
#pragma unroll 1
            for (int it = F.bid; it < 256; it += F.G) { const int xcd_ = it & 7, j_ = it >> 3; mseq_item(F, a, it, xcd_ * 4 + (j_ >> 3), (j_ >> 2) & 1, j_ & 3); }
        }
        float lam, cshift;
        { const float p01 = wave_sum(a.lam_p[F.lane] * a.lam_p[64 + F.lane]), p23 = wave_sum(a.lam_p[128 + F.lane] * a.lam_p[192 + F.lane]);
          lam = __expf(p01) - __expf(p23) + 0.2f;
          const float gq = wave_max(fabsf(a.qk_g[F.lane])), gk = wave_max(fabsf(a.qk_g[64 + F.lane]));
          cshift = 8.f * gq * gk * 1.4426950408889634f * 1.02f; }
        const int xcd = F.bid & 7, j = F.bid >> 3;
#pragma unroll 1
        for (int rep = 0; rep < REP_ATT; ++rep)
        for (int i = 0; i * F.G < 1024; ++i) {
            int u;
            if (F.G == 256) u = (xcd * 4 + i) * 32 + j; else u = i * F.G + F.bid;
            if (u < 1024) attn_unit(F, a, u >> 7, (u >> 5) & 3, u & 31, lam, cshift);
        }
    }
    SEAM(4);
    if (IN(5)) { const Args a = load_args(); mcombine_phase(F, a); }
    SEAM(5);
    if (IN(6)) {
        const Args a = load_args();
        pg8::Gemm g{(const bf16_t*)(a.ws + WS_YMIX), (const bf16_t*)(a.ws + WS_WOUTT), MTOK, DM, DM, 1 << 30}; pg8::StaticOrder S; S.init(MTOK, DM, F.G, F.bid);
        pg8::EpiX1 E{a.x, (const float*)(a.ws + WS_MOD), (bf16_t*)(a.ws + WS_X1B)};
        pg8::gemm_phase<pg8::EpiX1, true, true>(F.lds, g, S, E);
    }
    SEAM(6);
    if (IN(7)) { const Args a = load_args();
#pragma unroll 1
        for (int rep = 0; rep < REP_P7; ++rep) p7_phase(F, a); }
    SEAM(7);
    if (IN(8)) { const Args a = load_args(); for (int t = F.bid; t < BATCH * NEXP; t += F.G) topk_task(F, a, t); }
    SEAM(8);
    if (IN(9)) {
        const Args a = load_args();
        pg8::Gemm g{(const bf16_t*)(a.ws + WS_H2), (const bf16_t*)(a.ws + WS_WGUT), NPAIR, 4096, DM, 16, (const int*)(a.ws + WS_IDX)};
        pg8::StaticOrder S; S.init(NPAIR, 4096, F.G, F.bid);
        pg8::EpiGU E{a.ws + WS_HH};
#pragma unroll 1
        for (int rep = 0; rep < REP_UP; ++rep)
        pg8::gemm_phase<pg8::EpiGU, true, true, true, true>(F.lds, g, S, E);
    }
    SEAM(9);
    if (IN(10)) {
        const Args a = load_args();
        pg8::Gemm g{(const bf16_t*)(a.ws + WS_HH), (const bf16_t*)(a.ws + WS_WDT), NPAIR, DM, DFF, 16};
        pg8::StaticOrder S; S.init(NPAIR, DM, F.G, F.bid);
        pg8::EpiDown E{a.ws + WS_Y, (const float*)(a.ws + WS_VALS)};
        pg8::gemm_phase<pg8::EpiDown, true, true, true>(F.lds, g, S, E);
    }
    SEAM(10);
    if (IN(11)) { const Args a = load_args(); final_phase(F, a); }
    if (PROBE_MSEQ_W >= 0 && F.bid == 0 && F.tid == 0) {
        const unsigned long long d = *(volatile LAS unsigned long long*)(F.lds + LDS_BYTES - 128), t1 = __builtin_amdgcn_s_memtime();
        while (__builtin_amdgcn_s_memtime() - t1 < 3ull * d) __builtin_amdgcn_s_sleep(8);
    }
    if (PROBE_PHASE >= 0 && F.bid == 0 && F.tid == 0) {
        const unsigned long long t1 = __builtin_amdgcn_s_memrealtime();
        const unsigned long long d = (PROBE_PHASE == 11 ? t1 : tsl[PROBE_PHASE + 1]) - tsl[PROBE_PHASE];
        while (__builtin_amdgcn_s_memrealtime() - t1 < 3ull * d) __builtin_amdgcn_s_sleep(8);
    }
#undef IN
#undef SEAM
}

extern "C" void kernel_launch(void* const* d_in, const int* in_sizes, int n_in, void* d_out, int out_size, void* d_ws, size_t ws_size, hipStream_t stream) {
    static int grid_blocks = 0;
    if (!grid_blocks) {
        int dev = 0, cus = 0, per_cu = 0;
        (void)hipGetDevice(&dev);
        (void)hipDeviceGetAttribute(&cus, hipDeviceAttributeMultiprocessorCount, dev);
        (void)hipFuncSetAttribute((const void*)fwd_kernel, hipFuncAttributeMaxDynamicSharedMemorySize, LDS_BYTES);
        (void)hipOccupancyMaxActiveBlocksPerMultiprocessor(&per_cu, (const void*)fwd_kernel, NTHR, LDS_BYTES);
        if (per_cu < 1) per_cu = 1;
        grid_blocks = cus;
        if (ws_size < WS_END) fprintf(stderr, "kernel_launch: workspace too small: %zu < %zu\n", ws_size, (size_t)WS_END);
    }
    (void)hipMemsetAsync((char*)d_ws + WS_CTL, 0, CTL_ZERO_BYTES, stream);
    Args a{};
    a.x = (const float*)d_in[0]; a.c = (const float*)d_in[1]; a.pos = (const int*)d_in[2]; a.norm1_g = (const float*)d_in[3]; a.norm2_g = (const float*)d_in[4];
    a.w_ada = (const float*)d_in[5]; a.b_ada = (const float*)d_in[6]; a.w_in = (const float*)d_in[7]; a.conv_w = (const float*)d_in[8]; a.gate_b = (const float*)d_in[9];
    a.mnorm_g = (const float*)d_in[10]; a.qk_g = (const float*)d_in[11]; a.lam_p = (const float*)d_in[12]; a.subln_g = (const float*)d_in[13]; a.w_out = (const float*)d_in[14];
    a.w_router = (const float*)d_in[15]; a.w_gate = (const float*)d_in[16]; a.w_up = (const float*)d_in[17]; a.w_down = (const float*)d_in[18];
    a.out = (float*)d_out; a.ws = (unsigned char*)d_ws; a.ph_lo = 0; a.ph_hi = 12;
    void* args[] = {&a};
    hipError_t e = hipLaunchCooperativeKernel((const void*)fwd_kernel, dim3(grid_blocks), dim3(NTHR), args, LDS_BYTES, stream);
    if (e != hipSuccess) fprintf(stderr, "cooperative launch failed: %s (grid %d)\n", hipGetErrorString(e), grid_blocks);
}
```

```cpp
#include <hip/hip_runtime.h>
#include <hip/hip_cooperative_groups.h>
#include <cstdio>
#include <cstdint>
namespace cg = cooperative_groups;

#define LAS __attribute__((address_space(3)))
#define DI __device__ __forceinline__
typedef unsigned short bf16_t;
typedef short bf16x8 __attribute__((ext_vector_type(8)));
typedef short s16x4 __attribute__((ext_vector_type(4)));
typedef float f32x2 __attribute__((ext_vector_type(2)));
typedef float f32x4 __attribute__((ext_vector_type(4)));
typedef float f32x16 __attribute__((ext_vector_type(16)));
typedef unsigned u32x2 __attribute__((ext_vector_type(2)));
typedef unsigned u32x4 __attribute__((ext_vector_type(4)));
typedef __bf16 bf16x2_t __attribute__((ext_vector_type(2)));

constexpr int BATCH = 8, SEQ = 4096, DM = 1024, MTOK = BATCH * SEQ;
constexpr int DIN = 3600, PS = 3584;
constexpr int NEXP = 16, CAP = 512, DFF = 2048;
constexpr int NPAIR = BATCH * NEXP * CAP;
constexpr float EPS = 1e-6f;
constexpr int C_QM = 0, C_KM = 512, C_VM = 1024, C_OM = 1536, C_QA = 2048, C_KA = 2560, C_VA = 3072;

constexpr size_t MiB = 1u << 20;
constexpr size_t WS_CTL = 0;
constexpr int CTL_ZERO_BYTES = 65536;
constexpr size_t WS_MOD = 1 * MiB;
constexpr size_t WS_GATES = 2 * MiB;
constexpr size_t WS_AFF = 4 * MiB;
constexpr size_t WS_IDX = 6 * MiB;
constexpr size_t WS_VALS = 6 * MiB + 256 * 1024;
constexpr size_t WS_MSC = 6 * MiB + 512 * 1024;
constexpr size_t WS_SLOT = 7 * MiB;
constexpr size_t WS_NLOC = 9 * MiB;
constexpr size_t WS_WINT = 11 * MiB;
constexpr size_t WS_WGT = 18 * MiB;
constexpr size_t WS_WOUTT = 19 * MiB;
constexpr size_t WS_WGUT = 21 * MiB;
constexpr size_t WS_WDT = 85 * MiB;
constexpr size_t WS_Y = 117 * MiB;
constexpr size_t WS_PROJ = 213 * MiB;
constexpr size_t WS_YMIX = 117 * MiB;
constexpr size_t WS_KIMG = 437 * MiB;
constexpr size_t WS_VIMG = 469 * MiB;
constexpr size_t WS_HH = 245 * MiB;
constexpr size_t WS_H2 = 437 * MiB;
constexpr size_t WS_X1B = 373 * MiB;
constexpr size_t WS_END = 533 * MiB;

constexpr int LDS_BYTES = 163840;
constexpr int PROBE_MSEQ_W = -1;
constexpr int PROBE_PHASE = -1;
constexpr int REP_M1 = 1, REP_M3 = 1, REP_UP = 1, REP_P0 = 1, REP_SCAN = 1, REP_P7 = 1, REP_ATT = 1, REP_QKT = 1, REP_MSEQ = 1;
constexpr int NWAVES = 8, NTHR = 512;

DI unsigned pk2(float lo, float hi) { f32x2 v = {lo, hi}; bf16x2_t b = __builtin_convertvector(v, bf16x2_t); return __builtin_bit_cast(unsigned, b); }
DI float bflo(unsigned w) { return __uint_as_float(w << 16); }
DI float bfhi(unsigned w) { return __uint_as_float(w & 0xffff0000u); }
DI float bf2f(bf16_t v) { return __uint_as_float((unsigned)v << 16); }
template <int CTRL> DI float dpp_mov(float x) { return __builtin_bit_cast(float, __builtin_amdgcn_update_dpp(0, __builtin_bit_cast(int, x), CTRL, 0xf, 0xf, false)); }
#define DPP_XOR1 0xB1
#define DPP_XOR2 0x4E
#define DPP_ROR(n) (0x120 + (n))
DI float xor16_sum(float x) { const unsigned u = __builtin_bit_cast(unsigned, x); auto r = __builtin_amdgcn_permlane16_swap(u, u, false, false); return __builtin_bit_cast(float, (unsigned)r[0]) + __builtin_bit_cast(float, (unsigned)r[1]); }
DI float xor32_sum(float x) { const unsigned u = __builtin_bit_cast(unsigned, x); auto r = __builtin_amdgcn_permlane32_swap(u, u, false, false); return __builtin_bit_cast(float, (unsigned)r[0]) + __builtin_bit_cast(float, (unsigned)r[1]); }
DI float xor16_max(float x) { const unsigned u = __builtin_bit_cast(unsigned, x); auto r = __builtin_amdgcn_permlane16_swap(u, u, false, false); return fmaxf(__builtin_bit_cast(float, (unsigned)r[0]), __builtin_bit_cast(float, (unsigned)r[1])); }
DI float xor32_max(float x) { const unsigned u = __builtin_bit_cast(unsigned, x); auto r = __builtin_amdgcn_permlane32_swap(u, u, false, false); return fmaxf(__builtin_bit_cast(float, (unsigned)r[0]), __builtin_bit_cast(float, (unsigned)r[1])); }
template <int CTRL, int RM, int BM_> DI float dpp_mov_m(float oldv, float x) { return __builtin_bit_cast(float, __builtin_amdgcn_update_dpp(__builtin_bit_cast(int, oldv), __builtin_bit_cast(int, x), CTRL, RM, BM_, false)); }
DI float wave_prefix_sum(float v) {
    v += dpp_mov_m<0x111, 0xf, 0xf>(0.f, v); v += dpp_mov_m<0x112, 0xf, 0xf>(0.f, v); v += dpp_mov_m<0x114, 0xf, 0xe>(0.f, v); v += dpp_mov_m<0x118, 0xf, 0xc>(0.f, v);
    v += dpp_mov_m<0x142, 0xa, 0xf>(0.f, v); v += dpp_mov_m<0x143, 0xc, 0xf>(0.f, v);
    return v;
}
DI float wave_prefix_max(float v) {
    const float ninf = -__builtin_inff();
    v = fmaxf(v, dpp_mov_m<0x111, 0xf, 0xf>(ninf, v)); v = fmaxf(v, dpp_mov_m<0x112, 0xf, 0xf>(ninf, v)); v = fmaxf(v, dpp_mov_m<0x114, 0xf, 0xe>(ninf, v)); v = fmaxf(v, dpp_mov_m<0x118, 0xf, 0xc>(ninf, v));
    v = fmaxf(v, dpp_mov_m<0x142, 0xa, 0xf>(ninf, v)); v = fmaxf(v, dpp_mov_m<0x143, 0xc, 0xf>(ninf, v));
    return v;
}
DI float partner32(float x, int lane) { const unsigned u = __builtin_bit_cast(unsigned, x); auto r = __builtin_amdgcn_permlane32_swap(u, u, false, false); return __builtin_bit_cast(float, (unsigned)((lane & 32) ? r[0] : r[1])); }
DI float partner16(float x, int lane) { const unsigned u = __builtin_bit_cast(unsigned, x); auto r = __builtin_amdgcn_permlane16_swap(u, u, false, false); return __builtin_bit_cast(float, (unsigned)((lane & 16) ? r[0] : r[1])); }
DI float partner8(float x) { return dpp_mov<DPP_ROR(8)>(x); }
DI float partner4(float x, int lane) { const float a = dpp_mov<DPP_ROR(4)>(x), b = dpp_mov<DPP_ROR(12)>(x); return (lane & 4) ? a : b; }
DI float row_sum16(float v) { v += dpp_mov<DPP_XOR1>(v); v += dpp_mov<DPP_XOR2>(v); v += dpp_mov<DPP_ROR(4)>(v); v += dpp_mov<DPP_ROR(8)>(v); return v; }
DI float wave_sum(float v) { v = row_sum16(v); v = xor16_sum(v); return xor32_sum(v); }
DI float wave_max(float v) { v = fmaxf(v, dpp_mov<DPP_XOR1>(v)); v = fmaxf(v, dpp_mov<DPP_XOR2>(v)); v = fmaxf(v, dpp_mov<DPP_ROR(4)>(v)); v = fmaxf(v, dpp_mov<DPP_ROR(8)>(v)); v = xor16_max(v); return xor32_max(v); }
DI float sigmoid_f(float v) { return __builtin_amdgcn_rcpf(1.f + __builtin_amdgcn_exp2f(-1.4426950408889634f * v)); }
DI float silu_f(float v) { return v * sigmoid_f(v); }
DI float logsigmoid_f(float f) { return fminf(f, 0.f) - log1pf(__expf(-fabsf(f))); }
DI int swz16(int row) { return ((row & 3) << 2) | ((row >> 2) & 3); }
#define MFMA32(a, b, c) __builtin_amdgcn_mfma_f32_32x32x16_bf16((a), (b), (c), 0, 0, 0)
DI s16x4 trread(const LAS unsigned char* p) { return __builtin_bit_cast(s16x4, __builtin_amdgcn_ds_read_tr16_b64_v4i16((LAS s16x4*)p)); }
DI int crow(int r, int hh) { return (r & 3) + 8 * (r >> 2) + 4 * hh; }
DI bool hh_sel(int lane, int bit) { return (lane & bit) != 0; }

namespace pg8 {
constexpr int BM = 256, BK = 64, HALF = 128, HTB = HALF * BK * 2, STAGE_BYTES = 8 * HTB, NXCD = 8, WGM = 8;
DI int lds_byte(int r, int c) { const int st = (r >> 4) * 2 + (c >> 5), rr = r & 15, cc = c & 31, ob = rr * 64 + cc * 2; return st * 1024 + (ob ^ (((ob >> 9) & 1) << 5)); }
DI void stage_rc(int b, int& R, int& C) { const int st = b / 1024, sb = b % 1024, swz = sb ^ (((sb >> 9) & 1) << 5); R = (st >> 1) * 16 + swz / 64; C = (st & 1) * 32 + (swz % 64) / 2; }
DI int perm32(int rho) { const int n = rho >> 4, i = rho & 15; return 8 * (i >> 2) + 4 * n + (i & 3); }
struct Unit { int pm, pn; };
typedef int i32x4_t __attribute__((ext_vector_type(4)));
typedef int i32x8_t __attribute__((ext_vector_type(8)));
DI i32x8_t cat8(bf16x8 lo, bf16x8 hi) { const i32x4_t a = __builtin_bit_cast(i32x4_t, lo), b = __builtin_bit_cast(i32x4_t, hi); return __builtin_shufflevector(a, b, 0, 1, 2, 3, 4, 5, 6, 7); }
struct Gemm { const bf16_t* A; const bf16_t* Bt; int M, N, K, tpg; const int* gidx = nullptr; };
struct StaticOrder {
    int nM, nN, nwg, G, c;
    DI void init(int M, int N, int G_, int c_) { nM = M / BM; nN = N / BM; nwg = nM * nN; G = G_; c = c_; }
    DI bool next(int i, Unit& u) const {
        const long L = (long)i * G + c; if (L >= nwg) return false;
        int wgid = (int)L; { const int q = nwg / NXCD, r = nwg % NXCD, xcd = wgid % NXCD, off = wgid / NXCD; wgid = (xcd < r ? xcd * (q + 1) : r * (q + 1) + (xcd - r) * q) + off; }
        const int nig = WGM * nN, gid = wgid / nig, fm = gid * WGM, gsz = (nM - fm) < WGM ? (nM - fm) : WGM;
        u.pm = fm + ((wgid % nig) % gsz); u.pn = (wgid % nig) / gsz; return true;
    }
};

template <class Epi, bool ALIGN_EPI, bool SP2, bool FP8 = false, bool GATHER = false>
DI void gemm_phase(LAS unsigned char* lds, const Gemm g, const StaticOrder& S, const Epi& E) {
    const int tid = threadIdx.x, wid = __builtin_amdgcn_readfirstlane(tid >> 6), lane = tid & 63, wr = wid >> 2, wc = wid & 3, fr = lane & 15, fq = lane >> 4;
    const int KB = FP8 ? g.K : 2 * g.K, nt = KB / (BK * 2);
    unsigned voffA[2], voffB[2];
#pragma unroll
    for (int i = 0; i < 2; ++i) { int R, C; stage_rc(tid * 16 + i * 8192, R, C); const int Rb = Epi::PERM ? ((R & ~31) + perm32(R & 31)) : R;
        voffA[i] = (unsigned)(R * KB + C * 2); voffB[i] = (unsigned)(Rb * KB + C * 2); }
    int R0g, C0g; stage_rc(tid * 16, R0g, C0g);
    unsigned vgA[2][2], ngA[2][2];
    LAS int* gtab = (LAS int*)(lds + STAGE_BYTES);
    const size_t kstep = (size_t)(BK * 2);
    const size_t hstep = (size_t)HALF * KB;
    const size_t tstep = 2 * hstep;
    const size_t gstep = (size_t)g.N * KB;
    const unsigned ldsw = (unsigned)wid * 1024u;
    const int aoff = lds_byte(wr * 64 + fr, fq * 8), boff = lds_byte(wc * 32 + fr, fq * 8);
#define PG8_SA(b, h) (((b) * 2 + (h)) * HTB)
#define PG8_SB(b, h) ((4 + (b) * 2 + (h)) * HTB)
#define PG8_STAGE(bufoff, gbase, voff) do { _Pragma("unroll") for (int _i = 0; _i < 2; ++_i) \
        __builtin_amdgcn_global_load_lds((const unsigned*)((const char*)(gbase) + (voff)[_i]), (LAS unsigned*)(lds + (bufoff) + ldsw + _i * 8192), 16, 0, 0); } while (0)
#define PG8_STAGE_A(bufoff, gbase, h, nx) do { if constexpr (GATHER) { _Pragma("unroll") for (int _i = 0; _i < 2; ++_i) { const unsigned _o = (nx) ? ngA[h][_i] : vgA[h][_i]; \
        __builtin_amdgcn_global_load_lds((const unsigned*)((const char*)(gbase) + _o), (LAS unsigned*)(lds + (bufoff) + ldsw + _i * 8192), 16, 0, 0); } } \
        else PG8_STAGE(bufoff, (gbase) + (h) * hstep, voffA); } while (0)
#define PG8_LDA(dst, b, h) do { if constexpr (FP8) { _Pragma("unroll") for (int m = 0; m < 4; ++m) dst##8[m] = cat8(*(const LAS bf16x8*)(lds + PG8_SA(b, h) + aoff + m * 2048), *(const LAS bf16x8*)(lds + PG8_SA(b, h) + aoff + m * 2048 + 1024)); } \
        else { _Pragma("unroll") for (int m = 0; m < 4; ++m) _Pragma("unroll") for (int k = 0; k < 2; ++k) dst[m][k] = *(const LAS bf16x8*)(lds + PG8_SA(b, h) + aoff + m * 2048 + k * 1024); } } while (0)
#define PG8_LDB(dst, b, h) do { if constexpr (FP8) { _Pragma("unroll") for (int n = 0; n < 2; ++n) dst##8[n] = cat8(*(const LAS bf16x8*)(lds + PG8_SB(b, h) + boff + n * 2048), *(const LAS bf16x8*)(lds + PG8_SB(b, h) + boff + n * 2048 + 1024)); } \
        else { _Pragma("unroll") for (int n = 0; n < 2; ++n) _Pragma("unroll") for (int k = 0; k < 2; ++k) dst[n][k] = *(const LAS bf16x8*)(lds + PG8_SB(b, h) + boff + n * 2048 + k * 1024); } } while (0)
#define PG8_MMA(ai, bj, At, Bt) do { __builtin_amdgcn_s_setprio(1); \
        if constexpr (FP8) { _Pragma("unroll") for (int m = 0; m < 4; ++m) _Pragma("unroll") for (int n = 0; n < 2; ++n) \
            asm volatile("s_nop 1\n\tv_mfma_f32_16x16x128_f8f6f4 %0, %1, %2, %0" : "+v"(acc[ai][bj][m][n]) : "v"(Bt##8[n]), "v"(At##8[m])); } \
        else { _Pragma("unroll") for (int m = 0; m < 4; ++m) _Pragma("unroll") for (int n = 0; n < 2; ++n) _Pragma("unroll") for (int k = 0; k < 2; ++k) \
            acc[ai][bj][m][n] = __builtin_amdgcn_mfma_f32_16x16x32_bf16(Bt[n][k], At[m][k], acc[ai][bj][m][n], 0, 0, 0); } \
        __builtin_amdgcn_s_setprio(0); } while (0)
#define PG8_WAIT_V(n) asm volatile("s_waitcnt vmcnt(" #n ")" ::: "memory")
#define PG8_WAIT_L(n) asm volatile("s_waitcnt lgkmcnt(" #n ")" ::: "memory")
#define PG8_BAR __builtin_amdgcn_s_barrier()
#define PG8_SCHED __builtin_amdgcn_sched_barrier(0)
    Unit cur, nxt; int ui = 0;
    if (!S.next(0, cur)) return;
    f32x4 acc[2][2][4][2];
#pragma unroll
    for (int a = 0; a < 2; ++a)
#pragma unroll
        for (int b = 0; b < 2; ++b)
#pragma unroll
            for (int m = 0; m < 4; ++m)
#pragma unroll
                for (int n = 0; n < 2; ++n) acc[a][b][m][n] = (f32x4){0.f, 0.f, 0.f, 0.f};
    bf16x8 At[4][2], B0[2][2], B1[2][2]; i32x8_t At8[4], B08[2], B18[2];
    const char* cA = GATHER ? (const char*)g.A : (const char*)g.A + (size_t)cur.pm * tstep; const char* cB = (const char*)g.Bt + (size_t)(cur.pm / g.tpg) * gstep + (size_t)cur.pn * tstep;
    if constexpr (GATHER) {
#pragma unroll
        for (int h = 0; h < 2; ++h)
#pragma unroll
            for (int i = 0; i < 2; ++i) { vgA[h][i] = (unsigned)g.gidx[cur.pm * BM + h * HALF + R0g + 64 * i] * (unsigned)KB + (unsigned)(C0g * 2); ngA[h][i] = vgA[h][i]; }
    }
    if constexpr (SP2) {
        PG8_STAGE(PG8_SB(0, 0), cB, voffB); PG8_STAGE(PG8_SB(0, 1), cB + hstep, voffB); PG8_STAGE_A(PG8_SA(0, 0), cA, 0, false); PG8_STAGE_A(PG8_SA(0, 1), cA, 1, false);
        if (wr == 1) PG8_BAR;
        PG8_WAIT_V(2); PG8_BAR;
        PG8_STAGE(PG8_SB(1, 0), cB + kstep, voffB); PG8_STAGE_A(PG8_SA(1, 0), cA + kstep, 0, false); PG8_STAGE(PG8_SB(1, 1), cB + hstep + kstep, voffB);
        PG8_WAIT_V(6); PG8_BAR;
    } else {
        PG8_STAGE(PG8_SB(0, 0), cB, voffB); PG8_STAGE_A(PG8_SA(0, 0), cA, 0, false); PG8_STAGE(PG8_SB(0, 1), cB + hstep, voffB); PG8_STAGE_A(PG8_SA(0, 1), cA, 1, false);
        if (wr == 1) PG8_BAR;
        PG8_WAIT_V(4); PG8_BAR;
        PG8_STAGE(PG8_SB(1, 0), cB + kstep, voffB); PG8_STAGE_A(PG8_SA(1, 0), cA + kstep, 0, false); PG8_STAGE(PG8_SB(1, 1), cB + hstep + kstep, voffB);
        PG8_WAIT_V(6); PG8_BAR;
    }
    for (;;) {
        const bool has_next = S.next(ui + 1, nxt);
        if constexpr (GATHER) { if (has_next && wid < 4)
            __builtin_amdgcn_global_load_lds((const unsigned*)(g.gidx + nxt.pm * BM + wid * 64 + lane), (LAS unsigned*)(gtab + ((ui + 1) & 1) * 256 + wid * 64), 4, 0, 0); }
        const char* nA = GATHER ? (const char*)g.A : has_next ? (const char*)g.A + (size_t)nxt.pm * tstep : cA;
        const char* nB = has_next ? (const char*)g.Bt + (size_t)(nxt.pm / g.tpg) * gstep + (size_t)nxt.pn * tstep : cB;
        for (int t = 0; t < nt; t += 2) {
            const bool last = (t == nt - 2);
            const char* a1 = cA + (size_t)(t + 1) * kstep;
            const char* a2 = last ? nA : cA + (size_t)(t + 2) * kstep; const char* b2 = last ? nB : cB + (size_t)(t + 2) * kstep;
            const char* a3 = a2 + kstep; const char* b3 = b2 + kstep;
            if constexpr (GATHER) { if (last && has_next) { const LAS int* tb = gtab + ((ui + 1) & 1) * 256 + R0g;
#pragma unroll
                for (int h = 0; h < 2; ++h)
#pragma unroll
                    for (int i = 0; i < 2; ++i) ngA[h][i] = (unsigned)tb[h * HALF + 64 * i] * (unsigned)KB + (unsigned)(C0g * 2); } }
            if constexpr (SP2) {
            PG8_LDB(B0, 0, 0); PG8_LDB(B1, 0, 1); PG8_SCHED; PG8_LDA(At, 0, 0); PG8_STAGE_A(PG8_SA(1, 1), a1, 1, false);
            PG8_WAIT_V(8); PG8_WAIT_L(0); PG8_BAR; PG8_MMA(0, 0, At, B0); PG8_MMA(0, 1, At, B1); PG8_BAR; PG8_SCHED;
            PG8_LDA(At, 0, 1); PG8_STAGE(PG8_SB(0, 0), b2, voffB); PG8_STAGE(PG8_SB(0, 1), b2 + hstep, voffB); PG8_STAGE_A(PG8_SA(0, 0), a2, 0, last);
            PG8_WAIT_V(8); PG8_WAIT_L(0); PG8_BAR; PG8_MMA(1, 0, At, B0); PG8_MMA(1, 1, At, B1); PG8_BAR; PG8_SCHED;
            PG8_LDB(B0, 1, 0); PG8_LDB(B1, 1, 1); PG8_SCHED; PG8_LDA(At, 1, 0); PG8_STAGE_A(PG8_SA(0, 1), a2, 1, last);
            PG8_WAIT_V(8); PG8_WAIT_L(0); PG8_BAR; PG8_MMA(0, 0, At, B0); PG8_MMA(0, 1, At, B1); PG8_BAR; PG8_SCHED;
            PG8_LDA(At, 1, 1); PG8_STAGE(PG8_SB(1, 0), b3, voffB); PG8_STAGE(PG8_SB(1, 1), b3 + hstep, voffB); PG8_STAGE_A(PG8_SA(1, 0), a3, 0, last);
            PG8_WAIT_V(8); PG8_WAIT_L(0); PG8_BAR; PG8_MMA(1, 0, At, B0); PG8_MMA(1, 1, At, B1); PG8_BAR; PG8_SCHED;
            } else {
            PG8_LDB(B0, 0, 0); PG8_SCHED; PG8_LDA(At, 0, 0); PG8_STAGE_A(PG8_SA(1, 1), a1, 1, false);
            PG8_WAIT_L(8); PG8_BAR; PG8_WAIT_L(0); PG8_MMA(0, 0, At, B0); PG8_BAR; PG8_SCHED;
            PG8_LDB(B1, 0, 1); PG8_STAGE(PG8_SB(0, 0), b2, voffB);
            PG8_BAR; PG8_WAIT_L(0); PG8_MMA(0, 1, At, B1); PG8_BAR;
            PG8_LDA(At, 0, 1); PG8_STAGE_A(PG8_SA(0, 0), a2, 0, last);
            PG8_BAR; PG8_WAIT_L(0); PG8_MMA(1, 0, At, B0); PG8_BAR; PG8_SCHED;
            PG8_STAGE(PG8_SB(0, 1), b2 + hstep, voffB);
            PG8_WAIT_V(6); PG8_BAR; PG8_MMA(1, 1, At, B1); PG8_BAR;
            PG8_LDB(B0, 1, 0); PG8_SCHED; PG8_LDA(At, 1, 0); PG8_STAGE_A(PG8_SA(0, 1), a2, 1, last);
            PG8_WAIT_L(8); PG8_BAR; PG8_WAIT_L(0); PG8_MMA(0, 0, At, B0); PG8_BAR; PG8_SCHED;
            PG8_LDB(B1, 1, 1); PG8_STAGE(PG8_SB(1, 0), b3, voffB);
            PG8_BAR; PG8_WAIT_L(0); PG8_MMA(0, 1, At, B1); PG8_BAR;
            PG8_LDA(At, 1, 1); PG8_STAGE_A(PG8_SA(1, 0), a3, 0, last);
            PG8_BAR; PG8_WAIT_L(0); PG8_MMA(1, 0, At, B0); PG8_BAR; PG8_SCHED;
            PG8_STAGE(PG8_SB(1, 1), b3 + hstep, voffB);
            PG8_WAIT_V(6); PG8_BAR; PG8_MMA(1, 1, At, B1); PG8_BAR;
            }
        }
        if constexpr (ALIGN_EPI) { if (wr == 0) PG8_BAR; }
        if constexpr (FP8) asm volatile("s_nop 15\n\ts_nop 7" ::: "memory");
        E(acc, cur, wr, wc, fr, fq);
        if (!has_next) break;
#pragma unroll
        for (int a = 0; a < 2; ++a)
#pragma unroll
            for (int b = 0; b < 2; ++b)
#pragma unroll
                for (int m = 0; m < 4; ++m)
#pragma unroll
                    for (int n = 0; n < 2; ++n) acc[a][b][m][n] = (f32x4){0.f, 0.f, 0.f, 0.f};
        cur = nxt; cA = nA; cB = nB; ++ui;
        if constexpr (GATHER) {
#pragma unroll
            for (int h = 0; h < 2; ++h)
#pragma unroll
                for (int i = 0; i < 2; ++i) vgA[h][i] = ngA[h][i]; }
        if constexpr (ALIGN_EPI) { if (wr == 1) PG8_BAR; }
    }
    PG8_WAIT_V(0);
    if constexpr (!ALIGN_EPI) { if (wr == 0) PG8_BAR; }
    PG8_BAR;
#undef PG8_SA
#undef PG8_SB
#undef PG8_STAGE
#undef PG8_STAGE_A
#undef PG8_LDA
#undef PG8_LDB
#undef PG8_MMA
#undef PG8_WAIT_V
#undef PG8_WAIT_L
#undef PG8_BAR
#undef PG8_SCHED
}

struct EpiBf16 {
    static constexpr bool PERM = true;
    bf16_t* O; int ldc;
    DI void operator()(const f32x4 (&acc)[2][2][4][2], const Unit& u, int wr, int wc, int fr, int fq) const {
        const int row0 = u.pm * BM + wr * 64 + fr, col0 = u.pn * BM + wc * 32 + 8 * fq;
#pragma unroll
        for (int ai = 0; ai < 2; ++ai)
#pragma unroll
            for (int m = 0; m < 4; ++m) { bf16_t* rowp = O + (size_t)(row0 + ai * HALF + m * 16) * ldc + col0;
#pragma unroll
                for (int bj = 0; bj < 2; ++bj) { const f32x4 v0 = acc[ai][bj][m][0], v1 = acc[ai][bj][m][1];
                    u32x4 w; w.x = pk2(v0[0], v0[1]); w.y = pk2(v0[2], v0[3]); w.z = pk2(v1[0], v1[1]); w.w = pk2(v1[2], v1[3]);
                    *(u32x4*)(rowp + bj * HALF) = w; } }
    }
};
struct EpiProj {
    static constexpr bool PERM = true;
    bf16_t* O; const int* pos; const float* qk_g; bf16_t* kimg; bf16_t* vimg;
    DI void operator()(const f32x4 (&acc)[2][2][4][2], const Unit& u, int wr, int wc, int fr, int fq) const {
        const int row0 = u.pm * BM + wr * 64 + fr;
        if (u.pn < 8) {
            const int col0 = u.pn * BM + wc * 32 + 8 * fq;
#pragma unroll
            for (int ai = 0; ai < 2; ++ai)
#pragma unroll
                for (int m = 0; m < 4; ++m) { bf16_t* rowp = O + (size_t)(row0 + ai * HALF + m * 16) * PS + col0;
#pragma unroll
                    for (int bj = 0; bj < 2; ++bj) { const f32x4 v0 = acc[ai][bj][m][0], v1 = acc[ai][bj][m][1];
                        u32x4 w; w.x = pk2(v0[0], v0[1]); w.y = pk2(v0[2], v0[3]); w.z = pk2(v1[0], v1[1]); w.w = pk2(v1[2], v1[3]);
                        *(u32x4*)(rowp + bj * HALF) = w; } }
        } else if (u.pn < 12) {
            const int isk = (u.pn >= 10), hsub = 4 * (u.pn & 1) + wc, h = hsub >> 1, p = hsub & 1;
            const float* gp = qk_g + isk * 64 + 8 * fq;
            const f32x4 g00 = *(const f32x4*)gp, g01 = *(const f32x4*)(gp + 4), g10 = *(const f32x4*)(gp + 32), g11 = *(const f32x4*)(gp + 36);
            const float qs = isk ? 1.f : 0.125f * 1.4426950408889634f;
            const int lane = fr + 16 * fq;
#pragma unroll
            for (int ai = 0; ai < 2; ++ai)
#pragma unroll
                for (int m = 0; m < 4; ++m) { const int row = row0 + ai * HALF + m * 16;
                    f32x4 a0 = acc[ai][0][m][0], a1 = acc[ai][0][m][1], b0 = acc[ai][1][m][0], b1 = acc[ai][1][m][1];
                    float ss = (a0[0] * a0[0] + a0[1] * a0[1] + a0[2] * a0[2] + a0[3] * a0[3]) + (a1[0] * a1[0] + a1[1] * a1[1] + a1[2] * a1[2] + a1[3] * a1[3])
                             + (b0[0] * b0[0] + b0[1] * b0[1] + b0[2] * b0[2] + b0[3] * b0[3]) + (b1[0] * b1[0] + b1[1] * b1[1] + b1[2] * b1[2] + b1[3] * b1[3]);
                    ss = xor16_sum(ss); ss = xor32_sum(ss);
                    const float rstd = rsqrtf(ss * (1.f / 64.f) + EPS);
                    a0 = a0 * rstd * g00; a1 = a1 * rstd * g01; b0 = b0 * rstd * g10 * qs; b1 = b1 * rstd * g11 * qs;
                    const float pf = (float)pos[row];
                    f32x4 r0, r1;
#pragma unroll
                    for (int n = 0; n < 2; ++n)
#pragma unroll
                        for (int j = 0; j < 4; ++j) { const int i = 4 * n + j; const float own = n ? a1[j] : a0[j]; const float oth = partner16(own, lane);
                            const float frc = __builtin_amdgcn_fractf(pf * (exp2f(-(float)i * 0.125f * 18.931568569324174f) * 0.15915494309189535f));
                            const float sn = __builtin_amdgcn_sinf(frc), cs = __builtin_amdgcn_cosf(frc);
                            const float rot = (fq == 0) ? own * cs - oth * sn : own * cs + oth * sn;
                            const float o = (fq < 2) ? rot : own;
                            if (n) r1[j] = o; else r0[j] = o; }
                    r0 = r0 * qs; r1 = r1 * qs;
                    u32x4 w0, w1;
                    w0.x = pk2(r0[0], r0[1]); w0.y = pk2(r0[2], r0[3]); w0.z = pk2(r1[0], r1[1]); w0.w = pk2(r1[2], r1[3]);
                    w1.x = pk2(b0[0], b0[1]); w1.y = pk2(b0[2], b0[3]); w1.z = pk2(b1[0], b1[1]); w1.w = pk2(b1[2], b1[3]);
                    if (!isk) { bf16_t* rowp = O + (size_t)row * PS + C_QA + h * 128 + p * 64 + 8 * fq; *(u32x4*)rowp = w0; *(u32x4*)(rowp + 32) = w1; }
                    else { const int b = row / SEQ, t = row % SEQ; bf16_t* kp = kimg + ((size_t)((b * 4 + h) * 64 + (t >> 6))) * 8192 + (p * 8 + fq) * 512 + (t & 63) * 8;
                        *(u32x4*)kp = w0; *(u32x4*)(kp + 4 * 512) = w1; } }
        } else {
#pragma unroll
            for (int ai = 0; ai < 2; ++ai)
#pragma unroll
                for (int m = 0; m < 4; ++m) { const int row = row0 + ai * HALF + m * 16, b = row / SEQ, t = row % SEQ;
#pragma unroll
                    for (int bj = 0; bj < 2; ++bj) { const int h = 2 * (u.pn - 12) + bj; const f32x4 v0 = acc[ai][bj][m][0], v1 = acc[ai][bj][m][1];
                        u32x4 w; w.x = pk2(v0[0], v0[1]); w.y = pk2(v0[2], v0[3]); w.z = pk2(v1[0], v1[1]); w.w = pk2(v1[2], v1[3]);
                        *(u32x4*)(vimg + ((size_t)((b * 4 + h) * 64 + (t >> 6))) * 8192 + (wc * 4 + ((t & 63) >> 4)) * 512 + (t & 15) * 32 + fq * 8) = w; } }
        }
    }
};
struct EpiX1 {
    static constexpr bool PERM = true;
    const float* x; const float* mod; bf16_t* x1;
    DI void operator()(const f32x4 (&acc)[2][2][4][2], const Unit& u, int wr, int wc, int fr, int fq) const {
        const int row0 = u.pm * BM + wr * 64 + fr, col0 = u.pn * BM + wc * 32 + 8 * fq;
        const int b = (u.pm * BM) / SEQ;
        const float* gp = mod + (size_t)b * 6144 + 2048 + col0;
#pragma unroll
        for (int bj = 0; bj < 2; ++bj) { const f32x4 g0 = *(const f32x4*)(gp + bj * HALF), g1 = *(const f32x4*)(gp + bj * HALF + 4);
#pragma unroll
            for (int ai = 0; ai < 2; ++ai)
#pragma unroll
                for (int m = 0; m < 4; ++m) { const size_t off = (size_t)(row0 + ai * HALF + m * 16) * DM + col0 + bj * HALF;
                    const f32x4 r0 = *(const f32x4*)(x + off) + g0 * acc[ai][bj][m][0], r1 = *(const f32x4*)(x + off + 4) + g1 * acc[ai][bj][m][1];
                    u32x4 w; w.x = pk2(r0[0], r0[1]); w.y = pk2(r0[2], r0[3]); w.z = pk2(r1[0], r1[1]); w.w = pk2(r1[2], r1[3]);
                    *(u32x4*)(x1 + off) = w; } }
    }
};
DI unsigned pk4_fp8(float a, float b, float c, float d) { int w = __builtin_amdgcn_cvt_pk_fp8_f32(a, b, 0, false); w = __builtin_amdgcn_cvt_pk_fp8_f32(c, d, w, true); return (unsigned)w; }
constexpr float W_PRESCALE = 32.f, H_PRESCALE = 8.f;
struct EpiGU {
    static constexpr bool PERM = true;
    unsigned char* H;
    DI void operator()(const f32x4 (&acc)[2][2][4][2], const Unit& u, int wr, int wc, int fr, int fq) const {
        const int row0 = u.pm * BM + wr * 64 + fr, col0 = u.pn * HALF + wc * 32 + 8 * fq;
#pragma unroll
        for (int ai = 0; ai < 2; ++ai)
#pragma unroll
            for (int m = 0; m < 4; ++m) { unsigned char* rowp = H + (size_t)(row0 + ai * HALF + m * 16) * DFF + col0;
                float hv[8];
#pragma unroll
                for (int n = 0; n < 2; ++n)
#pragma unroll
                    for (int j = 0; j < 4; ++j) { const float gg = acc[ai][0][m][n][j] * (1.f / W_PRESCALE), uu = acc[ai][1][m][n][j] * (H_PRESCALE / W_PRESCALE); hv[n * 4 + j] = gg * __builtin_amdgcn_rcpf(1.f + __builtin_amdgcn_exp2f(-1.4426950408889634f * gg)) * uu; }
                u32x2 w; w.x = pk4_fp8(hv[0], hv[1], hv[2], hv[3]); w.y = pk4_fp8(hv[4], hv[5], hv[6], hv[7]);
                *(u32x2*)rowp = w; }
    }
};
constexpr float Y_PRESCALE = 64.f;
struct EpiDown {
    static constexpr bool PERM = true;
    unsigned char* Y; const float* vals;
    DI void operator()(const f32x4 (&acc)[2][2][4][2], const Unit& u, int wr, int wc, int fr, int fq) const {
        const int row0 = u.pm * BM + wr * 64 + fr, col0 = u.pn * BM + wc * 32 + 8 * fq;
#pragma unroll
        for (int ai = 0; ai < 2; ++ai)
#pragma unroll
            for (int m = 0; m < 4; ++m) { const int row = row0 + ai * HALF + m * 16; const float s = vals[row] * (Y_PRESCALE / (W_PRESCALE * H_PRESCALE)); unsigned char* rowp = Y + (size_t)row * DM + col0;
#pragma unroll
                for (int bj = 0; bj < 2; ++bj) { const f32x4 v0 = acc[ai][bj][m][0] * s, v1 = acc[ai][bj][m][1] * s;
                    u32x2 w; w.x = pk4_fp8(v0[0], v0[1], v0[2], v0[3]); w.y = pk4_fp8(v1[0], v1[1], v1[2], v1[3]);
                    *(u32x2*)(rowp + bj * HALF) = w; } }
    }
};
}

struct Args {
    const float* x; const float* c; const int* pos; const float* norm1_g; const float* norm2_g; const float* w_ada; const float* b_ada;
    const float* w_in; const float* conv_w; const float* gate_b; const float* mnorm_g; const float* qk_g; const float* lam_p; const float* subln_g;
    const float* w_out; const float* w_router; const float* w_gate; const float* w_up; const float* w_down;
    float* out; unsigned char* ws; int ph_lo, ph_hi;
};
struct Ctx {
    LAS unsigned char* lds; int tid, lane, wave, G, bid;
};
DI Args load_args() {
    typedef __attribute__((address_space(4))) const volatile unsigned long long* kp_t;
    kp_t kp = (kp_t)__builtin_amdgcn_kernarg_segment_ptr();
#define GP(T, i) ((T*)(__attribute__((address_space(1))) T*)kp[i])
    Args a;
    a.x = GP(const float, 0); a.c = GP(const float, 1); a.pos = GP(const int, 2); a.norm1_g = GP(const float, 3); a.norm2_g = GP(const float, 4);
    a.w_ada = GP(const float, 5); a.b_ada = GP(const float, 6); a.w_in = GP(const float, 7); a.conv_w = GP(const float, 8); a.gate_b = GP(const float, 9);
    a.mnorm_g = GP(const float, 10); a.qk_g = GP(const float, 11); a.lam_p = GP(const float, 12); a.subln_g = GP(const float, 13); a.w_out = GP(const float, 14);
    a.w_router = GP(const float, 15); a.w_gate = GP(const float, 16); a.w_up = GP(const float, 17); a.w_down = GP(const float, 18);
    a.out = GP(float, 19); a.ws = GP(unsigned char, 20);
#undef GP
    a.ph_lo = 0; a.ph_hi = 12;
    return a;
}

DI void tr_item64(const float* src, size_t ld_src, int k0, int c0, bf16_t* dst, size_t r0, int ld_dst, LAS float* scr  , int lane, size_t r1 = (size_t)-1) {
    const float* sp = src + (size_t)(k0 + (lane >> 4)) * ld_src + c0 + (lane & 15) * 4;
#pragma unroll 1
    for (int hf = 0; hf < 2; ++hf) {
        f32x4 v[8];
#pragma unroll
        for (int i = 0; i < 8; ++i) v[i] = *(const f32x4*)(sp + (size_t)(4 * (8 * hf + i)) * ld_src);
#pragma unroll
        for (int i = 0; i < 8; ++i) *(LAS f32x4*)(scr + (4 * (8 * hf + i) + (lane >> 4)) * 68 + (lane & 15) * 4) = v[i];
    }
    asm volatile("s_waitcnt lgkmcnt(0)" ::: "memory");
    const int c = lane & 7;
#pragma unroll
    for (int q = 0; q < 8; ++q) { const int n = 8 * q + (lane >> 3); const LAS float* s = scr + (8 * c) * 68 + n;
        u32x4 o; o.x = pk2(s[0 * 68], s[1 * 68]); o.y = pk2(s[2 * 68], s[3 * 68]); o.z = pk2(s[4 * 68], s[5 * 68]); o.w = pk2(s[6 * 68], s[7 * 68]);
        const size_t row = (r1 != (size_t)-1 && q >= 4) ? r1 + (n - 32) : r0 + n;
        *(u32x4*)(dst + row * ld_dst + k0 + 8 * c) = o; }
    asm volatile("s_waitcnt lgkmcnt(0)" ::: "memory");
}
DI void tr_item64_fp8(const float* src, size_t ld_src, int k0, int c0, unsigned char* dst, size_t r0, int ld_dst, float scale, LAS float* scr  , int lane) {
    const float* sp = src + (size_t)(k0 + (lane >> 4)) * ld_src + c0 + (lane & 15) * 4;
    {
        f32x4 v[16];
#pragma unroll
        for (int i = 0; i < 16; ++i) v[i] = __builtin_nontemporal_load((const f32x4*)(sp + (size_t)(4 * i) * ld_src));
#pragma unroll
        for (int i = 0; i < 16; ++i) *(LAS f32x4*)(scr + (4 * i + (lane >> 4)) * 68 + (lane & 15) * 4) = v[i] * scale;
    }
    asm volatile("s_waitcnt lgkmcnt(0)" ::: "memory");
    const int c = lane & 3;
#pragma unroll
    for (int q = 0; q < 4; ++q) { const int n = 16 * q + (lane >> 2); const LAS float* s = scr + (16 * c) * 68 + n;
        u32x4 o; o.x = pg8::pk4_fp8(s[0 * 68], s[1 * 68], s[2 * 68], s[3 * 68]); o.y = pg8::pk4_fp8(s[4 * 68], s[5 * 68], s[6 * 68], s[7 * 68]);
        o.z = pg8::pk4_fp8(s[8 * 68], s[9 * 68], s[10 * 68], s[11 * 68]); o.w = pg8::pk4_fp8(s[12 * 68], s[13 * 68], s[14 * 68], s[15 * 68]);
        *(u32x4*)(dst + (r0 + n) * ld_dst + k0 + 16 * c) = o; }
    asm volatile("s_waitcnt lgkmcnt(0)" ::: "memory");
}
DI void p0_phase(const Ctx& F, const Args& a) {
    if (F.bid < 96) {
        LAS float* sc = (LAS float*)F.lds; LAS float* part = (LAS float*)(F.lds + 32768);
        for (int i = F.tid; i < BATCH * DM; i += NTHR) sc[i] = silu_f(a.c[i]);
        __syncthreads();
        const int col = F.bid * 64 + F.lane;
        float acc[8];
#pragma unroll
        for (int b = 0; b < 8; ++b) acc[b] = 0.f;
        const int kb = F.wave * 128;
#pragma unroll 1
        for (int k0 = kb; k0 < kb + 128; k0 += 16) {
            float w[16];
            const float* wp = a.w_ada + (size_t)k0 * 6144 + col;
#pragma unroll
            for (int j = 0; j < 16; ++j) w[j] = wp[(size_t)j * 6144];
#pragma unroll
            for (int j = 0; j < 16; ++j)
#pragma unroll
                for (int b = 0; b < 8; ++b) acc[b] += sc[b * DM + k0 + j] * w[j];
        }
#pragma unroll
        for (int b = 0; b < 8; ++b) part[(F.wave * 8 + b) * 64 + F.lane] = acc[b];
        __syncthreads();
        { const int b = F.tid >> 6, l = F.tid & 63; float s = a.b_ada[F.bid * 64 + l];
#pragma unroll
          for (int w = 0; w < 8; ++w) s += part[(w * 8 + b) * 64 + l];
          ((float*)(a.ws + WS_MOD))[b * 6144 + F.bid * 64 + l] = s; }
        asm volatile("s_waitcnt vmcnt(0)" ::: "memory");
        __syncthreads();
        if (F.tid == 0) { __builtin_amdgcn_fence(__ATOMIC_RELEASE, "agent"); asm volatile("s_waitcnt vmcnt(0)" ::: "memory");
            __hip_atomic_fetch_add((unsigned*)(a.ws + WS_CTL) + 4096, 1u, __ATOMIC_RELAXED, __HIP_MEMORY_SCOPE_AGENT); }
    }
    LAS float* scr = (LAS float*)(F.lds + F.wave * 17408);
    const int gw = F.bid * NWAVES + F.wave, NGW = F.G * NWAVES;
    constexpr int I_IN = 16 * 56, I_OUT = 16 * 16, I_WG = 16, I_EX = 4096;
    constexpr int NITEMS = I_IN + I_OUT + I_EX + I_WG;
    bf16_t* WinT = (bf16_t*)(a.ws + WS_WINT); bf16_t* WgT = (bf16_t*)(a.ws + WS_WGT); bf16_t* WoutT = (bf16_t*)(a.ws + WS_WOUTT);
    for (int it = gw; it < NITEMS; it += NGW) {
        int r = it;
        if (r < I_IN) { const int kb = r / 56, nb = r % 56, n0 = nb * 64;
            if (n0 >= 2048 && n0 < 3072) { const int t0 = n0 & ~255, g = (n0 >> 6) & 3; tr_item64(a.w_in, DIN, kb * 64, n0 + 16, WinT, (size_t)(t0 + 32 * g), DM, scr, F.lane, (size_t)(t0 + 128 + 32 * g)); }
            else tr_item64(a.w_in, DIN, kb * 64, n0 + (n0 >= 2048 ? 16 : 0), WinT, n0, DM, scr, F.lane);
            continue; } r -= I_IN;
        if (r < I_OUT) { const int kb = r / 16, nb = r % 16; tr_item64(a.w_out, DM, kb * 64, nb * 64, WoutT, nb * 64, DM, scr, F.lane); continue; } r -= I_OUT;
        if (r < I_EX) { int e, mat, q;
            if (r < 1024) { e = 13; mat = 1 + (r >> 9); q = r & 511; } else { const int t = r - 1024; e = 14 + t / 1536; const int u = t % 1536; mat = u >> 9; q = u & 511; }
            if (mat < 2) { const int kb = q / 32, nb = q % 32, n0 = nb * 64; const float* src = (mat ? a.w_up : a.w_gate) + (size_t)e * DM * DFF;
                tr_item64_fp8(src, DFF, kb * 64, n0, a.ws + WS_WGUT + (size_t)e * 4096 * DM, (size_t)(n0 / 128) * 256 + (n0 % 128) + mat * 128, DM, pg8::W_PRESCALE, scr, F.lane); }
            else { const int kb = q / 16, nb = q % 16;
                tr_item64_fp8(a.w_down + (size_t)e * DFF * DM, DM, kb * 64, nb * 64, a.ws + WS_WDT + (size_t)e * DM * DFF, nb * 64, DFF, pg8::W_PRESCALE, scr, F.lane); }
            continue; } r -= I_EX;
        tr_item64(a.w_in, DIN, r * 64, 2048 - 48, WgT, 0, DM, scr, F.lane);
    }
    if (F.tid == 0) { unsigned* cnt = (unsigned*)(a.ws + WS_CTL) + 4096; unsigned sp = 0;
        while (__hip_atomic_load(cnt, __ATOMIC_RELAXED, __HIP_MEMORY_SCOPE_AGENT) < 96u && ++sp < (1u << 22)) __builtin_amdgcn_s_sleep(2);
        __builtin_amdgcn_fence(__ATOMIC_ACQUIRE, "agent"); asm volatile("s_waitcnt vmcnt(0)" ::: "memory"); }
    __syncthreads();
}

DI void p1_phase(const Ctx& F, const Args& a) {
    const int gw = F.bid * NWAVES + F.wave, NGW = F.G * NWAVES;
    const float* mod = (const float*)(a.ws + WS_MOD);
    bf16_t* H1 = (bf16_t*)a.out;
    for (int m0 = gw; m0 < MTOK; m0 += 2 * NGW) {
        const int m1 = m0 + NGW; const bool has1 = m1 < MTOK;
        const f32x4* xr0 = (const f32x4*)(a.x + (size_t)m0 * DM) + F.lane; const f32x4* xr1 = (const f32x4*)(a.x + (size_t)(has1 ? m1 : m0) * DM) + F.lane;
        f32x4 v0[4], v1[4]; float s0 = 0.f, s1 = 0.f;
#pragma unroll
        for (int j = 0; j < 4; ++j) { v0[j] = __builtin_nontemporal_load(xr0 + 64 * j); v1[j] = __builtin_nontemporal_load(xr1 + 64 * j); }
#pragma unroll
        for (int j = 0; j < 4; ++j) { s0 += (v0[j].x * v0[j].x + v0[j].y * v0[j].y) + (v0[j].z * v0[j].z + v0[j].w * v0[j].w); s1 += (v1[j].x * v1[j].x + v1[j].y * v1[j].y) + (v1[j].z * v1[j].z + v1[j].w * v1[j].w); }
#pragma unroll
        for (int o = 1; o < 64; o <<= 1) { s0 += __shfl_xor(s0, o); s1 += __shfl_xor(s1, o); }
        const float rstd0 = rsqrtf(s0 * (1.f / DM) + EPS), rstd1 = rsqrtf(s1 * (1.f / DM) + EPS);
        const int b0 = m0 / SEQ, b1 = (has1 ? m1 : m0) / SEQ;
        u32x2* o0 = (u32x2*)(H1 + (size_t)m0 * DM) + F.lane; u32x2* o1 = (u32x2*)(H1 + (size_t)m1 * DM) + F.lane;
#pragma unroll
        for (int j = 0; j < 4; ++j) {
            const f32x4 g = ((const f32x4*)a.norm1_g)[F.lane + 64 * j];
            { const f32x4 sh = ((const f32x4*)(mod + (size_t)b0 * 6144))[F.lane + 64 * j], sc = ((const f32x4*)(mod + (size_t)b0 * 6144 + 1024))[F.lane + 64 * j];
              const f32x4 h = v0[j] * rstd0 * g * (sc + 1.f) + sh; u32x2 w; w.x = pk2(h.x, h.y); w.y = pk2(h.z, h.w); o0[64 * j] = w; }
            if (has1) { const f32x4 sh = ((const f32x4*)(mod + (size_t)b1 * 6144))[F.lane + 64 * j], sc = ((const f32x4*)(mod + (size_t)b1 * 6144 + 1024))[F.lane + 64 * j];
              const f32x4 h = v1[j] * rstd1 * g * (sc + 1.f) + sh; u32x2 w; w.x = pk2(h.x, h.y); w.y = pk2(h.z, h.w); o1[64 * j] = w; }
        }
    }
}

DI void gates_tasks(const Ctx& F, const Args& a) {
    const int gw = F.bid * NWAVES + F.wave, NGW = F.G * NWAVES;
    const bf16_t* H1 = (const bf16_t*)a.out; const bf16_t* WgT = (const bf16_t*)(a.ws + WS_WGT) + 48 * DM; float* GT = (float*)(a.ws + WS_GATES);
    const float bias = a.gate_b[F.lane & 15];
    for (int task = gw; task < MTOK / 16; task += NGW) {
        const int row0 = task * 16;
        const bf16_t* ap = H1 + (size_t)(row0 + (F.lane & 15)) * DM + 8 * (F.lane >> 4);
        const bf16_t* bp = WgT + (size_t)(F.lane & 15) * DM + 8 * (F.lane >> 4);
        f32x4 acc = {0.f, 0.f, 0.f, 0.f};
        bf16x8 avs[32];
#pragma unroll
        for (int i = 0; i < 32; ++i) avs[i] = *(const bf16x8*)(ap + 32 * i);
#pragma unroll
        for (int i = 0; i < 32; ++i) { const bf16x8 bv = *(const bf16x8*)(bp + 32 * i); acc = __builtin_amdgcn_mfma_f32_16x16x32_bf16(avs[i], bv, acc, 0, 0, 0); }
#pragma unroll
        for (int r = 0; r < 4; ++r) GT[(size_t)(row0 + (F.lane >> 4) * 4 + r) * 16 + (F.lane & 15)] = acc[r] + bias;
    }
}

DI void qk_tile_task(const Ctx& F, const Args& a, int task) {
    const int b = task >> 6, tile = task & 63, r = F.lane, g = F.wave, h = g >> 1, p = g & 1;
    bf16_t* PROJ = (bf16_t*)(a.ws + WS_PROJ);
    const size_t tok = (size_t)b * SEQ + tile * 64 + r;
    float invf[8];
#pragma unroll
    for (int i = 0; i < 8; ++i) invf[i] = exp2f(-(float)i * 0.125f * 18.931568569324174f) * 0.15915494309189535f;
    const float pos = (float)a.pos[tok];
    float sn[8], cs[8];
#pragma unroll
    for (int i = 0; i < 8; ++i) { const float fr = __builtin_amdgcn_fractf(pos * invf[i]); sn[i] = __builtin_amdgcn_sinf(fr); cs[i] = __builtin_amdgcn_cosf(fr); }
#pragma unroll 1
    for (int isk = 0; isk < 2; ++isk) {
        u32x4* src = (u32x4*)(PROJ + tok * PS + (isk ? C_KA : C_QA) + g * 64);
        u32x4 w[8];
#pragma unroll
        for (int c = 0; c < 8; ++c) w[c] = src[c];
        float ss = 0.f;
#pragma unroll
        for (int c = 0; c < 8; ++c) { float t;
            t = bflo(w[c].x); ss += t * t; t = bfhi(w[c].x); ss += t * t; t = bflo(w[c].y); ss += t * t; t = bfhi(w[c].y); ss += t * t;
            t = bflo(w[c].z); ss += t * t; t = bfhi(w[c].z); ss += t * t; t = bflo(w[c].w); ss += t * t; t = bfhi(w[c].w); ss += t * t; }
        const float rstd = rsqrtf(ss * (1.f / 64.f) + EPS) * (isk ? 1.f : 0.125f * 1.4426950408889634f);
        const float* gp = a.qk_g + isk * 64;
        float v0[16];
        v0[0] = bflo(w[0].x); v0[1] = bfhi(w[0].x); v0[2] = bflo(w[0].y); v0[3] = bfhi(w[0].y); v0[4] = bflo(w[0].z); v0[5] = bfhi(w[0].z); v0[6] = bflo(w[0].w); v0[7] = bfhi(w[0].w);
        v0[8] = bflo(w[1].x); v0[9] = bfhi(w[1].x); v0[10] = bflo(w[1].y); v0[11] = bfhi(w[1].y); v0[12] = bflo(w[1].z); v0[13] = bfhi(w[1].z); v0[14] = bflo(w[1].w); v0[15] = bfhi(w[1].w);
#pragma unroll
        for (int i = 0; i < 16; ++i) v0[i] *= rstd * gp[i];
        float rr[16];
#pragma unroll
        for (int i = 0; i < 8; ++i) { rr[i] = v0[i] * cs[i] - v0[i + 8] * sn[i]; rr[i + 8] = v0[i + 8] * cs[i] + v0[i] * sn[i]; }
        u32x4 o[8];
        o[0].x = pk2(rr[0], rr[1]); o[0].y = pk2(rr[2], rr[3]); o[0].z = pk2(rr[4], rr[5]); o[0].w = pk2(rr[6], rr[7]);
        o[1].x = pk2(rr[8], rr[9]); o[1].y = pk2(rr[10], rr[11]); o[1].z = pk2(rr[12], rr[13]); o[1].w = pk2(rr[14], rr[15]);
#pragma unroll
        for (int c = 2; c < 8; ++c) { const f32x4 g0 = *(const f32x4*)(gp + c * 8), g1 = *(const f32x4*)(gp + c * 8 + 4);
            o[c].x = pk2(bflo(w[c].x) * rstd * g0.x, bfhi(w[c].x) * rstd * g0.y); o[c].y = pk2(bflo(w[c].y) * rstd * g0.z, bfhi(w[c].y) * rstd * g0.w);
            o[c].z = pk2(bflo(w[c].z) * rstd * g1.x, bfhi(w[c].z) * rstd * g1.y); o[c].w = pk2(bflo(w[c].w) * rstd * g1.z, bfhi(w[c].w) * rstd * g1.w); }
        if (isk == 0) {
#pragma unroll
            for (int c = 0; c < 8; ++c) src[c] = o[c];
        } else {
            u32x4* dst = (u32x4*)((bf16_t*)(a.ws + WS_KIMG) + ((size_t)((b * 4 + h) * 64 + tile)) * 8192) + r;
#pragma unroll
            for (int c = 0; c < 8; ++c) dst[(p * 8 + c) * 64] = o[c];
        }
    }
    {
        u32x4* dst = (u32x4*)((bf16_t*)(a.ws + WS_VIMG) + ((size_t)((b * 4 + h) * 64 + tile)) * 8192) + r;
#pragma unroll
        for (int cg = 2 * p; cg < 2 * p + 2; ++cg)
#pragma unroll
            for (int kg = 0; kg < 4; ++kg) {
                const u32x4 v = *(const u32x4*)(PROJ + ((size_t)b * SEQ + tile * 64 + 16 * kg + (r >> 2)) * PS + C_VA + h * 128 + 32 * cg + 8 * (r & 3));
                dst[(cg * 4 + kg) * 64] = v; }
    }
}

DI bf16x8 tr_frag_nat(const LAS unsigned char* img, int rowbase, int col0, int lane) {
    const int hh = lane >> 5, g16 = (lane >> 4) & 1, i = lane & 15;
    const int col = col0 + 16 * g16 + 4 * (i & 3), chunk = col >> 3, sub = (col & 7) * 2;
    const int r0 = rowbase + 8 * hh + (i >> 2), r1 = r0 + 4;
    const s16x4 lo = trread(img + r0 * 256 + ((chunk ^ swz16(r0)) << 4) + sub);
    const s16x4 hi = trread(img + r1 * 256 + ((chunk ^ swz16(r1)) << 4) + sub);
    return __builtin_shufflevector(lo, hi, 0, 1, 2, 3, 4, 5, 6, 7);
}
DI bf16x8 tr_frag_acc(const LAS unsigned char* img, int rowbase, int col0, int lane) {
    const int hh = lane >> 5, g16 = (lane >> 4) & 1, i = lane & 15;
    const int col = col0 + 16 * g16 + 4 * (i & 3), chunk = col >> 3, sub = (col & 7) * 2;
    const int r0 = rowbase + 4 * hh + (i >> 2), r1 = r0 + 8;
    const s16x4 lo = trread(img + r0 * 256 + ((chunk ^ swz16(r0)) << 4) + sub);
    const s16x4 hi = trread(img + r1 * 256 + ((chunk ^ swz16(r1)) << 4) + sub);
    return __builtin_shufflevector(lo, hi, 0, 1, 2, 3, 4, 5, 6, 7);
}
DI bf16x8 row_frag(const LAS unsigned char* img, int row, int chunk) { return *(const LAS bf16x8*)(img + row * 256 + ((chunk ^ swz16(row)) << 4)); }

DI void glds16_asm(const void* gsrc, unsigned lds_dst) { unsigned keep;
    asm volatile("s_mov_b32 %0, m0\n\ts_mov_b32 m0, %2\n\ts_nop 0\n\tglobal_load_lds_dwordx4 %1, off\n\ts_mov_b32 m0, %0" : "=&s"(keep) : "v"(gsrc), "s"(lds_dst) : "memory"); }
constexpr size_t DO_QC = 0, DO_KC = 32 * MiB, DO_HD = 64 * MiB;
constexpr size_t WS_SC = 7 * MiB;

DI void conv_load(const Args& a, int tw, int lane, u32x4 (&row)[12]) {
    const int isk = tw & 1, tok0 = (tw >> 1) * 8, b = tok0 / SEQ, t0 = tok0 % SEQ;
    const bf16_t* src = (const bf16_t*)(a.ws + WS_PROJ) + (size_t)b * SEQ * PS + (isk ? C_KM : C_QM) + lane * 8;
#pragma unroll
    for (int r = 0; r < 12; ++r) { const int t = t0 + r - 2; row[r] = (u32x4){0u, 0u, 0u, 0u}; if (t >= 0 && t < SEQ) row[r] = *(const u32x4*)(src + (size_t)t * PS); }
}
DI void conv_compute(const Args& a, int tw, int lane, const u32x4 (&row)[12], const float (&cw)[5][8]) {
    const int isk = tw & 1, tok0 = (tw >> 1) * 8, b = tok0 / SEQ, t0 = tok0 % SEQ;
    const int hd = lane >> 4, cc = lane & 15, cch = t0 >> 6, r0 = t0 & 63;
    bf16_t* tileb = (bf16_t*)((unsigned char*)a.out + (isk ? DO_KC : DO_QC)) + ((size_t)((b * 4 + hd) * 64 + cch)) * 8192;
    bf16_t* dst = isk ? tileb + ((cc >> 2) * 4 + (r0 >> 4)) * 512 + (r0 & 15) * 32 + (cc & 3) * 8 : tileb + cc * 512 + r0 * 8;
    const int dstride = isk ? 32 : 8;
    const float sc = isk ? 0.08838834764831845f : 1.f;
#pragma unroll
    for (int i = 0; i < 8; ++i) {
        float acc[8];
#pragma unroll
        for (int e = 0; e < 8; ++e) acc[e] = 0.f;
#pragma unroll
        for (int j = 0; j < 5; ++j) { const u32x4 w = row[i + j];
            acc[0] += bflo(w.x) * cw[j][0]; acc[1] += bfhi(w.x) * cw[j][1]; acc[2] += bflo(w.y) * cw[j][2]; acc[3] += bfhi(w.y) * cw[j][3];
            acc[4] += bflo(w.z) * cw[j][4]; acc[5] += bfhi(w.z) * cw[j][5]; acc[6] += bflo(w.w) * cw[j][6]; acc[7] += bfhi(w.w) * cw[j][7]; }
#pragma unroll
        for (int e = 0; e < 8; ++e) acc[e] = silu_f(acc[e]) * sc;
        u32x4 o; o.x = pk2(acc[0], acc[1]); o.y = pk2(acc[2], acc[3]); o.z = pk2(acc[4], acc[5]); o.w = pk2(acc[6], acc[7]);
        *(u32x4*)(dst + i * dstride) = o;
    }
}
DI void conv_phase(const Ctx& F, const Args& a) {
    const int lane = F.lane, NT = MTOK / 8 * 2, st = F.G * NWAVES;
    int t = F.bid * NWAVES + F.wave;
    if (t >= NT) return;
    const int isk = t & 1;
    float cw[5][8];
#pragma unroll
    for (int j = 0; j < 5; ++j) { const f32x4 c0 = *(const f32x4*)(a.conv_w + j * 1024 + isk * 512 + lane * 8), c1 = *(const f32x4*)(a.conv_w + j * 1024 + isk * 512 + lane * 8 + 4);
        cw[j][0] = c0.x; cw[j][1] = c0.y; cw[j][2] = c0.z; cw[j][3] = c0.w; cw[j][4] = c1.x; cw[j][5] = c1.y; cw[j][6] = c1.z; cw[j][7] = c1.w; }
    u32x4 rowA[12], rowB[12];
    conv_load(a, t, lane, rowA);
#pragma unroll 1
    for (;;) {
        const int tn = t + st;
        if (tn < NT) conv_load(a, tn, lane, rowB);
        conv_compute(a, t, lane, rowA, cw);
        if (tn >= NT) break;
        t = tn + st;
        if (t < NT) conv_load(a, t, lane, rowA);
        conv_compute(a, tn, lane, rowB, cw);
        if (t >= NT) break;
    }
}

DI void mscal_task(const Ctx& F, const Args& a, int chain) {
    const int b = chain >> 3, h = (chain >> 1) & 3, dir = chain & 1;
    const int s = dir ? 63 - F.lane : F.lane;
    const float* GT = (const float*)(a.ws + WS_GATES) + (size_t)b * SEQ * 16;
    float* SC = (float*)(a.ws + WS_SC) + (size_t)chain * 64 * 256; float* MSC = (float*)(a.ws + WS_MSC);
    LAS float* gl = (LAS float*)F.lds; LAS float* mll = gl + 64;
    float aa[8], ii[8];
#pragma unroll
    for (int i = 0; i < 8; ++i) { const int c = F.wave + 8 * i;
        const float ig = GT[(size_t)(c * 64 + s) * 16 + dir * 8 + h], fg = GT[(size_t)(c * 64 + s) * 16 + dir * 8 + 4 + h];
        const float av = wave_prefix_sum(logsigmoid_f(fg));
        aa[i] = av; ii[i] = ig;
        const float g = __builtin_bit_cast(float, __builtin_amdgcn_readlane(__builtin_bit_cast(int, av), 63)), ml = wave_max(g - av + ig);
        if (F.lane == 0) { gl[c] = g; mll[c] = ml; } }
    __syncthreads();
    float mnew_l, mprev_l;
    { const int cst = dir ? 63 - F.lane : F.lane;
      float A = gl[cst], B = mll[cst];
#pragma unroll
      for (int o = 1; o < 64; o <<= 1) { const float Ap = __shfl_up(A, o), Bp = __shfl_up(B, o); if (F.lane >= o) { B = fmaxf(Bp + A, B); A = Ap + A; } }
      mnew_l = fmaxf(A, B); mprev_l = __shfl_up(mnew_l, 1); if (F.lane == 0) mprev_l = 0.f; }
#pragma unroll
    for (int i = 0; i < 8; ++i) { const int c = F.wave + 8 * i; const int stc = dir ? 63 - c : c; const float mprev = __shfl(mprev_l, stc), mnew = __shfl(mnew_l, stc), g = gl[c];
        const float cterm = ii[i] - aa[i];
        const float cm = wave_prefix_max(cterm);
        const float il = aa[i] + mprev, mj = fmaxf(il, aa[i] + cm);
        float* o4 = SC + (size_t)c * 256 + s;
        o4[0] = (aa[i] - mj) * 1.4426950408889634f; o4[64] = cterm * 1.4426950408889634f; o4[128] = __expf(il - mj); o4[192] = __expf(-mj);
        if (F.lane == 0) { MSC[chain * 64 + c] = (g - mnew) * 1.4426950408889634f; MSC[4096 + chain * 64 + c] = __expf(g + mprev - mnew); } }
    __syncthreads();
}

DI const float* wsel3(int m, const float* p0, const float* p1, const float* p2) {
    const unsigned long long a0 = (unsigned long long)p0, a1 = (unsigned long long)p1, a2 = (unsigned long long)p2;
    const unsigned long long m1 = (unsigned long long)0 - (unsigned long long)(m == 1), m2 = (unsigned long long)0 - (unsigned long long)(m == 2);
    return (const float*)((a0 & ~(m1 | m2)) | (a1 & m1) | (a2 & m2));
}
DI void mseq_item(const Ctx& F, const Args& a, int item, int bh, int dir, int vs) {
    const int b = bh >> 2, h = bh & 3, chain = bh * 2 + dir, wid = F.wave, tid = F.tid, lane = F.lane, r32 = lane & 31, hh = lane >> 5;
    LAS unsigned char* QS = F.lds;
    LAS unsigned char* KS = F.lds + 32768;
    LAS unsigned char* VS = F.lds + 65536;
    LAS unsigned char* SCS = F.lds + 77824;
    LAS unsigned char* SD = F.lds + 80896;
    LAS unsigned char* CI = F.lds + 97280;
    LAS float* NV = (LAS float*)(F.lds + 113664);
    LAS float* gmv = NV + 256; LAS float* spv = gmv + 64;
    LAS unsigned char* HST = F.lds + 115712;
    const int cwi = wid < 4 ? wid : 4;
    const bool cwave = wid < 4 || wid == 7;
    const unsigned cscb = (unsigned)(uintptr_t)F.lds + 119808u + (unsigned)cwi * 8192u;
    const int cslot0 = (item * 5 + cwi) * 64;
    const float* const wg_ = a.w_gate; const float* const wu_ = a.w_up; const float* const wd_ = a.w_down;
    const bf16_t* QC = (const bf16_t*)((const unsigned char*)a.out + DO_QC) + (size_t)bh * 64 * 8192 + lane * 8;
    const bf16_t* KC = (const bf16_t*)((const unsigned char*)a.out + DO_KC) + (size_t)bh * 64 * 8192 + lane * 8;
    const bf16_t* VP = (const bf16_t*)(a.ws + WS_PROJ) + (size_t)b * SEQ * PS + C_VM + h * 128 + vs * 32 + (size_t)(16 * (wid & 3) + (lane >> 2)) * PS + 8 * (lane & 3);
    const float* SC = (const float*)(a.ws + WS_SC) + (size_t)chain * 64 * 256 + lane * 4;
    bf16_t* HD = (bf16_t*)((unsigned char*)a.out + DO_HD) + ((size_t)dir * MTOK + (size_t)b * SEQ) * 512 + h * 128 + vs * 32;
    if (tid < 64) { gmv[tid] = ((const float*)(a.ws + WS_MSC))[chain * 64 + tid]; spv[tid] = ((const float*)(a.ws + WS_MSC))[4096 + chain * 64 + tid]; }
    if (tid < 256) NV[tid] = 0.f;
    for (int i = tid; i < 4096; i += NTHR) ((LAS unsigned*)CI)[i] = 0u;
    const unsigned ldsb = (unsigned)(uintptr_t)F.lds;
#define MSEQ_ISSUE_QK(c, s2) do { const size_t _tb = (size_t)(c); \
        if (wid < 4) { _Pragma("unroll") for (int _i = 0; _i < 4; ++_i) \
                glds16_asm(QC + _tb * 8192 + (4 * wid + _i) * 512, (unsigned)__builtin_amdgcn_readfirstlane((int)(ldsb + (s2) * 16384 + (4 * wid + _i) * 1024))); } \
        else if (wid >= 6) { _Pragma("unroll") for (int _i = 0; _i < 8; ++_i) \
                glds16_asm(KC + _tb * 8192 + (8 * (wid - 6) + _i) * 512, (unsigned)__builtin_amdgcn_readfirstlane((int)(ldsb + 32768 + (s2) * 16384 + (8 * (wid - 6) + _i) * 1024))); } } while (0)
#define MSEQ_ISSUE_VS(c, s4) do { const size_t _tb = (size_t)(c); \
        if (wid < 4) glds16_asm(VP + _tb * 64 * PS, (unsigned)__builtin_amdgcn_readfirstlane((int)(ldsb + 65536 + (s4) * 4096 + wid * 1024))); \
        else if (wid == 6) glds16_asm(SC + _tb * 256, (unsigned)__builtin_amdgcn_readfirstlane((int)(ldsb + 77824 + (s4) * 1024))); } while (0)
    MSEQ_ISSUE_QK(dir ? 63 : 0, 0); MSEQ_ISSUE_VS(dir ? 63 : 0, 0);
#define MSEQ_CONV_ISSUE(id) do { const int _e = (id) / 6144, _r = (id) % 6144, _mat = _r >> 11, _rr = _r & 2047; \
        const int _N = _mat == 2 ? DM : DFF, _nb = _mat == 2 ? (_rr >> 7) : (_rr >> 6), _kb = _mat == 2 ? (_rr & 127) : (_rr & 63); \
        const float* _src = wsel3(_mat, wg_, wu_, wd_) + (size_t)_e * DM * DFF + (size_t)(16 * _kb + (lane >> 4)) * _N + 64 * _nb + 4 * (lane & 15); \
        _Pragma("unroll") for (int _i = 0; _i < 4; ++_i) glds16_asm(_src + (size_t)(4 * _i) * _N, (unsigned)__builtin_amdgcn_readfirstlane((int)(cscb + ((id) & 1) * 4096 + _i * 1024))); } while (0)
    if (cwave) MSEQ_CONV_ISSUE(cslot0);
    f32x16 Cacc[2];
#pragma unroll
    for (int i = 0; i < 16; ++i) { Cacc[0][i] = 0.f; Cacc[1][i] = 0.f; }
    const int qrd = hh * 1024 + r32 * 16;
    const int ktr = (8 * hh + ((lane & 15) >> 2)) * 64 + ((lane >> 4) & 1) * 32 + (lane & 3) * 8;
    f32x16 acc;
    float qn = 0.f;
#pragma unroll
    for (int i = 0; i < 16; ++i) acc[i] = 0.f;
    asm volatile("s_waitcnt vmcnt(0)" ::: "memory");
    __syncthreads();
    unsigned long long busy = 0, tb0 = 0; if (PROBE_MSEQ_W >= 0) tb0 = __builtin_amdgcn_s_memtime(); const unsigned long long titem0 = tb0;
#pragma unroll 1
    for (int st = 0; st <= 64; ++st) {
        const int c = dir ? 63 - st : st, s2 = st & 1; const int s3 = st % 3, s3p = (st + 2) % 3;
        if (st + 1 < 64) { MSEQ_ISSUE_QK(dir ? 62 - st : st + 1, s2 ^ 1); MSEQ_ISSUE_VS(dir ? 62 - st : st + 1, (st + 1) % 3);
            if (cwave) MSEQ_CONV_ISSUE(cslot0 + st + 1); }
        const LAS unsigned char* QT = QS + s2 * 16384; const LAS unsigned char* KT = KS + s2 * 16384; const LAS unsigned char* VT = VS + s3 * 4096;
        const LAS float* rt = (const LAS float*)(SCS + s3 * 1024); const LAS float* ct = rt + 64;
        if (wid < 4) {
            if (st < 64) {
                const int jt = wid >> 1, stt = wid & 1;
                const LAS unsigned char* qa = QT + qrd + jt * 512;
                const LAS unsigned char* kb = KT + (2 * stt + (r32 >> 4)) * 1024 + (r32 & 15) * 64 + hh * 16;
                const int j = 32 * jt + r32; const float rtj = rt[j];
                const LAS float* ctp = ct + 32 * stt + 4 * hh;
                f32x4 c4[4];
#pragma unroll
                for (int rg = 0; rg < 4; ++rg) c4[rg] = *(const LAS f32x4*)(ctp + 8 * rg);
                const float gm = gmv[c], sp = spv[c];
                const int ck = 4 * wid + (lane & 3), r0 = 4 * (lane >> 2);
                const LAS unsigned char* kr = KT + (ck >> 2) * 4096 + (r0 >> 4) * 1024 + (r0 & 15) * 64 + (ck & 3) * 16;
                u32x4 kw[4];
#pragma unroll
                for (int r = 0; r < 4; ++r) kw[r] = *(const LAS u32x4*)(kr + r * 64);
                const f32x4 ctn = *(const LAS f32x4*)(ct + r0);
                const LAS float* no = NV + s2 * 128 + 32 * wid + 8 * (lane & 3);
                const f32x4 o0 = *(const LAS f32x4*)no, o1 = *(const LAS f32x4*)(no + 4);
                f32x16 S;
                f32x16 S2;
#pragma unroll
                for (int i = 0; i < 16; ++i) { S[i] = 0.f; S2[i] = 0.f; }
#pragma unroll
                for (int ks = 0; ks < 8; ks += 2) { S = MFMA32(*(const LAS bf16x8*)(kb + (ks >> 1) * 4096), *(const LAS bf16x8*)(qa + ks * 2048), S);
                    S2 = MFMA32(*(const LAS bf16x8*)(kb + (ks >> 1) * 4096 + 32), *(const LAS bf16x8*)(qa + (ks + 1) * 2048), S2); }
#pragma unroll
                for (int i = 0; i < 16; ++i) S[i] += S2[i];
                float pa[8];
#pragma unroll
                for (int e = 0; e < 8; ++e) pa[e] = 0.f;
#pragma unroll
                for (int r = 0; r < 4; ++r) { const u32x4 w = kw[r]; const float ws_ = __builtin_amdgcn_exp2f(ctn[r] + gm);
                    pa[0] += ws_ * bflo(w.x); pa[1] += ws_ * bfhi(w.x); pa[2] += ws_ * bflo(w.y); pa[3] += ws_ * bfhi(w.y); pa[4] += ws_ * bflo(w.z); pa[5] += ws_ * bfhi(w.z); pa[6] += ws_ * bflo(w.w); pa[7] += ws_ * bfhi(w.w); }
#pragma unroll
                for (int e = 0; e < 8; ++e) { float t = pa[e]; t += dpp_mov<DPP_ROR(8)>(t); t += dpp_mov<DPP_ROR(4)>(t); t = xor16_sum(t); pa[e] = xor32_sum(t); }
                u32x2 sw2[4];
#pragma unroll
                for (int rg = 0; rg < 4; ++rg) { float v[4];
#pragma unroll
                    for (int e = 0; e < 4; ++e) { const int sc = 32 * stt + 8 * rg + 4 * hh + e; const bool ok = dir == 0 ? (sc <= j) : (sc >= j);
                        v[e] = S[4 * rg + e] * __builtin_amdgcn_exp2f(ok ? rtj + c4[rg][e] : -1.0e30f); }
                    sw2[rg].x = pk2(v[0], v[1]); sw2[rg].y = pk2(v[2], v[3]); }
                LAS unsigned char* sw = SD + s2 * 8192 + stt * 4096 + j * 16 + hh * 8;
#pragma unroll
                for (int rg = 0; rg < 4; ++rg) *(LAS u32x2*)(sw + rg * 1024) = sw2[rg];
                if (lane < 4) { LAS float* nn = NV + (s2 ^ 1) * 128 + 32 * wid + 8 * lane;
                    *(LAS f32x4*)nn = (f32x4){sp * o0.x + pa[0], sp * o0.y + pa[1], sp * o0.z + pa[2], sp * o0.w + pa[3]};
                    *(LAS f32x4*)(nn + 4) = (f32x4){sp * o1.x + pa[4], sp * o1.y + pa[5], sp * o1.z + pa[6], sp * o1.w + pa[7]}; }
            }
        } else if (wid < 6) {
            const int jt = wid - 4, jl = 32 * jt + r32;
            u32x2 hw[4]; bool have_h = false; int cp = 0;
            if (st > 0) {
                cp = dir ? 64 - st : st - 1; have_h = true;
                const LAS float* iw = (const LAS float*)(SCS + s3p * 1024) + 128; const LAS float* enm = iw + 64;
                const LAS unsigned char* SDp = SD + (s2 ^ 1) * 8192;
                const LAS unsigned char* sr = SDp + hh * 4096 + jl * 16;
                u32x4 w4[4];
#pragma unroll
                for (int ch = 0; ch < 4; ++ch) w4[ch] = *(const LAS u32x4*)(sr + ch * 1024);
                const float iwj = iw[jl], enj = enm[jl];
                const LAS unsigned char* sa = SDp + qrd + jt * 512; const LAS unsigned char* vb = VS + s3p * 4096 + ktr;
                float rsum = 0.f;
#pragma unroll
                for (int ch = 0; ch < 4; ++ch) { const u32x4 w = w4[ch];
                    rsum += (bflo(w.x) + bfhi(w.x)) + (bflo(w.y) + bfhi(w.y)) + (bflo(w.z) + bfhi(w.z)) + (bflo(w.w) + bfhi(w.w)); }
                rsum = xor32_sum(rsum);
                const float den = rsum + iwj * qn;
                const float rdj = 1.f / fmaxf(fabsf(den), enj);
#pragma unroll
                for (int i = 0; i < 16; ++i) acc[i] *= iwj;
#pragma unroll
                for (int ks = 0; ks < 4; ++ks) { const s16x4 lo = trread(vb + ks * 1024), hi = trread(vb + ks * 1024 + 256);
                    acc = MFMA32(__builtin_shufflevector(lo, hi, 0, 1, 2, 3, 4, 5, 6, 7), *(const LAS bf16x8*)(sa + ks * 2048), acc); }
#pragma unroll
                for (int rg = 0; rg < 4; ++rg) { hw[rg].x = pk2(acc[4 * rg] * rdj, acc[4 * rg + 1] * rdj); hw[rg].y = pk2(acc[4 * rg + 2] * rdj, acc[4 * rg + 3] * rdj); }
            }
            if (st < 64) {
                const LAS unsigned char* qa = QT + qrd + jt * 512;
                const LAS unsigned char* cb = CI + s2 * 8192 + hh * 512 + r32 * 16;
                const LAS unsigned char* qr = QT + hh * 8192 + jl * 16; const LAS float* np = NV + s2 * 128 + 64 * hh;
                f32x16 acc2;
#pragma unroll
                for (int i = 0; i < 16; ++i) { acc[i] = 0.f; acc2[i] = 0.f; }
#pragma unroll
                for (int ks = 0; ks < 8; ks += 2) { acc = MFMA32(*(const LAS bf16x8*)(cb + ks * 1024), *(const LAS bf16x8*)(qa + ks * 2048), acc);
                    acc2 = MFMA32(*(const LAS bf16x8*)(cb + (ks + 1) * 1024), *(const LAS bf16x8*)(qa + (ks + 1) * 2048), acc2); }
#pragma unroll
                for (int i = 0; i < 16; ++i) acc[i] += acc2[i];
                qn = 0.f;
#pragma unroll
                for (int ch = 0; ch < 8; ++ch) { const u32x4 w = *(const LAS u32x4*)(qr + ch * 1024); const f32x4 n0 = *(const LAS f32x4*)(np + ch * 8), n1 = *(const LAS f32x4*)(np + ch * 8 + 4);
                    qn += bflo(w.x) * n0.x + bfhi(w.x) * n0.y + bflo(w.y) * n0.z + bfhi(w.y) * n0.w + bflo(w.z) * n1.x + bfhi(w.z) * n1.y + bflo(w.w) * n1.z + bfhi(w.w) * n1.w; }
                qn = xor32_sum(qn);
            }
            if (have_h) {
                LAS unsigned char* hst = HST + jt * 2048;
#pragma unroll
                for (int rg = 0; rg < 4; ++rg) *(LAS u32x2*)(hst + r32 * 64 + (8 * rg + 4 * hh) * 2) = hw[rg];
                asm volatile("s_waitcnt lgkmcnt(0)" ::: "memory");
#pragma unroll
                for (int q = 0; q < 2; ++q) { const int row = 16 * q + (lane >> 2), part = lane & 3;
                    const u32x4 w = *(const LAS u32x4*)(hst + row * 64 + part * 16);
                    *(u32x4*)(HD + (size_t)(cp * 64 + 32 * jt + row) * 512 + part * 8) = w; }
            }
        } else if (st < 64) {
            const int u = wid - 6; const float gm = gmv[c], sp = spv[c];
            const LAS unsigned char* va = VT + ktr; const LAS unsigned char* ka = KT + ktr + (2 * u) * 4096;
            s16x4 vlo[4], vhi[4], k0l[4], k0h[4], k1l[4], k1h[4]; f32x4 cw0[4], cw1[4];
#pragma unroll
            for (int ks = 0; ks < 4; ++ks) { vlo[ks] = trread(va + ks * 1024); vhi[ks] = trread(va + ks * 1024 + 256);
                cw0[ks] = *(const LAS f32x4*)(ct + 16 * ks + 8 * hh); cw1[ks] = *(const LAS f32x4*)(ct + 16 * ks + 8 * hh + 4);
                k0l[ks] = trread(ka + ks * 1024); k0h[ks] = trread(ka + ks * 1024 + 256); k1l[ks] = trread(ka + 4096 + ks * 1024); k1h[ks] = trread(ka + 4096 + ks * 1024 + 256); }
#pragma unroll
            for (int i = 0; i < 16; ++i) { Cacc[0][i] *= sp; Cacc[1][i] *= sp; }
#pragma unroll
            for (int ks = 0; ks < 4; ++ks) {
                const s16x4 lo = vlo[ks], hi = vhi[ks]; const f32x4 e0 = cw0[ks], e1 = cw1[ks];
                u32x4 af;
                af.x = pk2(bf2f((bf16_t)lo[0]) * __builtin_amdgcn_exp2f(e0.x + gm), bf2f((bf16_t)lo[1]) * __builtin_amdgcn_exp2f(e0.y + gm));
                af.y = pk2(bf2f((bf16_t)lo[2]) * __builtin_amdgcn_exp2f(e0.z + gm), bf2f((bf16_t)lo[3]) * __builtin_amdgcn_exp2f(e0.w + gm));
                af.z = pk2(bf2f((bf16_t)hi[0]) * __builtin_amdgcn_exp2f(e1.x + gm), bf2f((bf16_t)hi[1]) * __builtin_amdgcn_exp2f(e1.y + gm));
                af.w = pk2(bf2f((bf16_t)hi[2]) * __builtin_amdgcn_exp2f(e1.z + gm), bf2f((bf16_t)hi[3]) * __builtin_amdgcn_exp2f(e1.w + gm));
                const bf16x8 afr = __builtin_bit_cast(bf16x8, af);
                Cacc[0] = MFMA32(__builtin_shufflevector(k0l[ks], k0h[ks], 0, 1, 2, 3, 4, 5, 6, 7), afr, Cacc[0]);
                Cacc[1] = MFMA32(__builtin_shufflevector(k1l[ks], k1h[ks], 0, 1, 2, 3, 4, 5, 6, 7), afr, Cacc[1]);
            }
            LAS unsigned char* cw = CI + (s2 ^ 1) * 8192 + (2 * u) * 2048 + r32 * 16 + hh * 8;
#pragma unroll
            for (int t2 = 0; t2 < 2; ++t2)
#pragma unroll
                for (int rg = 0; rg < 4; ++rg) { u32x2 w; w.x = pk2(Cacc[t2][4 * rg], Cacc[t2][4 * rg + 1]); w.y = pk2(Cacc[t2][4 * rg + 2], Cacc[t2][4 * rg + 3]); *(LAS u32x2*)(cw + t2 * 2048 + rg * 512) = w; }
        }
        if (PROBE_MSEQ_W >= 0) { asm volatile("s_waitcnt lgkmcnt(0)" ::: "memory"); busy += __builtin_amdgcn_s_memtime() - tb0; }
        if (cwave) {
            if (st + 1 < 64) asm volatile("s_waitcnt vmcnt(4)" ::: "memory"); else asm volatile("s_waitcnt vmcnt(0)" ::: "memory");
            if (st < 64) {
                const int id = cslot0 + st, e = id / 6144, r = id % 6144, mat = r >> 11, rr = r & 2047;
                const int nb = mat == 2 ? (rr >> 7) : (rr >> 6), kb = mat == 2 ? (rr & 127) : (rr & 63), n = 64 * nb + lane;
                unsigned char* dst = mat == 2 ? a.ws + WS_WDT + (size_t)e * DM * DFF + (size_t)n * DFF + 16 * kb
                                              : a.ws + WS_WGUT + (size_t)e * 4096 * DM + (size_t)((n >> 7) * 256 + (n & 127) + mat * 128) * DM + 16 * kb;
                const LAS float* CSC = (const LAS float*)(F.lds + 119808 + cwi * 8192 + (id & 1) * 4096);
                float cv[16];
#pragma unroll
                for (int k = 0; k < 16; ++k) cv[k] = CSC[k * 64 + lane] * pg8::W_PRESCALE;
                u32x4 o; o.x = pg8::pk4_fp8(cv[0], cv[1], cv[2], cv[3]); o.y = pg8::pk4_fp8(cv[4], cv[5], cv[6], cv[7]); o.z = pg8::pk4_fp8(cv[8], cv[9], cv[10], cv[11]); o.w = pg8::pk4_fp8(cv[12], cv[13], cv[14], cv[15]);
                *(u32x4*)dst = o;
            }
        } else if (wid == 6) asm volatile("s_waitcnt vmcnt(0)" ::: "memory");
        asm volatile("s_waitcnt lgkmcnt(0)" ::: "memory"); __builtin_amdgcn_s_barrier(); asm volatile("" ::: "memory");
        if (PROBE_MSEQ_W >= 0) tb0 = __builtin_amdgcn_s_memtime();
    }
    if (PROBE_MSEQ_W >= 0 && F.bid == 0 && lane == 0 && (wid == PROBE_MSEQ_W || (PROBE_MSEQ_W == 8 && wid == 0)))
        *(volatile LAS unsigned long long*)(F.lds + LDS_BYTES - 128) = (PROBE_MSEQ_W == 8) ? (__builtin_amdgcn_s_memtime() - titem0) : busy;
    asm volatile("s_waitcnt vmcnt(0)" ::: "memory");
#undef MSEQ_ISSUE_QK
#undef MSEQ_ISSUE_VS
#undef MSEQ_CONV_ISSUE
}

DI void glds16(const void* g, LAS unsigned char* l) { __builtin_amdgcn_global_load_lds((const unsigned*)g, (LAS unsigned*)l, 16, 0, 0); }
DI void attn_unit(const Ctx& F, const Args& a, int b, int h, int qb, float lam, float cshift) {
    const int lane = F.lane, wid = F.wave, r32 = lane & 31, hh = lane >> 5, rg = wid & 3, p = wid >> 2;
    const bf16_t* projb = (const bf16_t*)(a.ws + WS_PROJ) + (size_t)b * SEQ * PS;
    const int qrow = qb * 128 + rg * 32 + r32;
    bf16x8 qf[4];
    { const bf16_t* qp = projb + (size_t)qrow * PS + C_QA + h * 128 + p * 64 + hh * 8;
#pragma unroll
      for (int ks = 0; ks < 4; ++ks) qf[ks] = *(const bf16x8*)(qp + ks * 16); }
    const bf16_t* kimg = (const bf16_t*)(a.ws + WS_KIMG) + (size_t)(b * 4 + h) * 64 * 8192 + (4 * wid) * 512 + lane * 8;
    const bf16_t* vimg = (const bf16_t*)(a.ws + WS_VIMG) + (size_t)(b * 4 + h) * 64 * 8192 + (4 * wid) * 512 + lane * 8;
    const unsigned ldsw = (unsigned)__builtin_amdgcn_readfirstlane((int)(unsigned)(uintptr_t)F.lds + (4 * wid) * 1024);
#define ATT_ISSUE2(img, t0, ldsoff) do { const int _q0 = 4 * wid; const int _t = (t0) + (_q0 >> 4); const bf16_t* _tp = (img) + (size_t)(_t < 64 ? _t : 63) * 8192 - (size_t)(_q0 & 16) * 512; \
        const unsigned _d = (unsigned)__builtin_amdgcn_readfirstlane((int)(ldsw + (ldsoff))); \
        _Pragma("unroll") for (int _i = 0; _i < 4; ++_i) glds16_asm(_tp + _i * 512, _d + _i * 1024); } while (0)
    if (wid < 4) { const bf16_t* _tp = kimg; const unsigned _d = (unsigned)__builtin_amdgcn_readfirstlane((int)(ldsw + 32768));
#pragma unroll
        for (int _i = 0; _i < 4; ++_i) glds16_asm(_tp + _i * 512, _d + _i * 1024); }
    ATT_ISSUE2(kimg, 1, 0); ATT_ISSUE2(vimg, 0, 65536);
    f32x16 O[4];
#pragma unroll
    for (int vt = 0; vt < 4; ++vt)
#pragma unroll
        for (int i = 0; i < 16; ++i) O[vt][i] = 0.f;
    float lsum = 0.f;
    const int kfb = p * 8192 + hh * 1024 + r32 * 16;
    const int vfb = (4 * hh + ((lane & 15) >> 2)) * 64 + ((lane >> 4) & 1) * 32 + (lane & 3) * 8;
    bf16x8 pb[4], pc[4];
    asm volatile("s_waitcnt vmcnt(0)" ::: "memory");
    __syncthreads();
#define ATT_VLOAD(dst, Vb, kg) do { _Pragma("unroll") for (int vt = 0; vt < 4; ++vt) { \
        const s16x4 _lo = trread((Vb) + vt * 4096 + (kg) * 1024), _hi = trread((Vb) + vt * 4096 + (kg) * 1024 + 512); dst[vt] = __builtin_shufflevector(_lo, _hi, 0, 1, 2, 3, 4, 5, 6, 7); } } while (0)
#define ATT_PV(vf, kg, PIN) do { __builtin_amdgcn_s_setprio(1); _Pragma("unroll") for (int vt = 0; vt < 4; ++vt) O[vt] = MFMA32(vf[vt], PIN[kg], O[vt]); __builtin_amdgcn_s_setprio(0); } while (0)
#define ATT_EXPQ(S, o, dst) do { float _e[8]; _Pragma("unroll") for (int i = 0; i < 8; ++i) _e[i] = __builtin_amdgcn_exp2f(S[(o) + i]); \
        _Pragma("unroll") for (int i = 0; i < 8; ++i) ls = ls + _e[i]; \
        u32x4 _w; _w.x = pk2(_e[0], _e[1]); _w.y = pk2(_e[2], _e[3]); _w.z = pk2(_e[4], _e[5]); _w.w = pk2(_e[6], _e[7]); dst = __builtin_bit_cast(bf16x8, _w); } while (0)
#define ATT_STEP(Kb, Vb, on0, PIN, POUT) do { \
        bf16x8 kfa[4], kfb2[4], vA[4], vB[4]; float ls = 0.f; \
        _Pragma("unroll") for (int ks = 0; ks < 4; ++ks) { kfa[ks] = *(const LAS bf16x8*)((Kb) + ks * 2048); kfb2[ks] = *(const LAS bf16x8*)((Kb) + ks * 2048 + 512); } \
        ATT_VLOAD(vA, Vb, 0); \
        __builtin_amdgcn_s_setprio(1); \
        Sa = MFMA32(kfa[0], qf[0], negc); Sb = MFMA32(kfb2[0], qf[0], negc);        \
        _Pragma("unroll") for (int ks = 1; ks < 4; ++ks) { Sa = MFMA32(kfa[ks], qf[ks], Sa); Sb = MFMA32(kfb2[ks], qf[ks], Sb); } \
        __builtin_amdgcn_s_setprio(0); \
        ATT_VLOAD(vB, Vb, 1); ATT_PV(vA, 0, PIN); ATT_EXPQ(Sa, 0, POUT[0]); \
        ATT_VLOAD(vA, Vb, 2); ATT_PV(vB, 1, PIN); ATT_EXPQ(Sa, 8, POUT[1]); \
        ATT_VLOAD(vB, Vb, 3); ATT_PV(vA, 2, PIN); ATT_EXPQ(Sb, 0, POUT[2]); \
        ATT_PV(vB, 3, PIN); ATT_EXPQ(Sb, 8, POUT[3]); \
        lsum += (on0) ? ls : 0.f; } while (0)
    f32x16 Sa, Sb, negc;
#pragma unroll
    for (int i = 0; i < 16; ++i) negc[i] = -cshift;
    asm volatile("" : "+v"(negc));
    {
        const LAS unsigned char* Kb = F.lds + 32768 + kfb;
        Sa = MFMA32(*(const LAS bf16x8*)(Kb), qf[0], negc); Sb = MFMA32(*(const LAS bf16x8*)(Kb + 512), qf[0], negc);
#pragma unroll
        for (int ks = 1; ks < 4; ++ks) { Sa = MFMA32(*(const LAS bf16x8*)(Kb + ks * 2048), qf[ks], Sa); Sb = MFMA32(*(const LAS bf16x8*)(Kb + ks * 2048 + 512), qf[ks], Sb); }
        float ls = 0.f;
        ATT_EXPQ(Sa, 0, pb[0]); ATT_EXPQ(Sa, 8, pb[1]); ATT_EXPQ(Sb, 0, pb[2]); ATT_EXPQ(Sb, 8, pb[3]);
        lsum += ls;
    }
    __syncthreads();
#pragma unroll 1
    for (int T = 0; T < 32; ++T) {
        const int j = T & 1;
        ATT_ISSUE2(kimg, 2 * T + 3, (j ^ 1) * 32768);
        ATT_ISSUE2(vimg, 2 * T + 2, 65536 + (j ^ 1) * 32768);
        const LAS unsigned char* Ks = F.lds + j * 32768 + kfb; const LAS unsigned char* Vs = F.lds + 65536 + j * 32768 + vfb;
        ATT_STEP(Ks, Vs, true, pb, pc);
        ATT_STEP(Ks + 16384, Vs + 16384, T < 31, pc, pb);
        asm volatile("s_waitcnt vmcnt(0)" ::: "memory");
        __syncthreads();
    }
#undef ATT_EXPQ
#undef ATT_STEP
#undef ATT_VLOAD
#undef ATT_PV
#undef ATT_ISSUE2
    lsum += __shfl_xor(lsum, 32);
    LAS float* X = (LAS float*)(F.lds + 65536) + rg * 4096 + r32;
    if (p == 1) {
        const float sc = lam / lsum;
#pragma unroll
        for (int vt = 0; vt < 4; ++vt)
#pragma unroll
            for (int i = 0; i < 16; ++i) X[(32 * vt + crow(i, hh)) * 32] = O[vt][i] * sc;
    }
    __syncthreads();
    if (p == 0) {
        const float i0 = 1.f / lsum;
        float ssq = 0.f;
#pragma unroll
        for (int vt = 0; vt < 4; ++vt)
#pragma unroll
            for (int i = 0; i < 16; ++i) { const float o = O[vt][i] * i0 - X[(32 * vt + crow(i, hh)) * 32]; O[vt][i] = o; ssq += o * o; }
        ssq += __shfl_xor(ssq, 32);
        const float rs = rsqrtf(ssq * (1.f / 128.f) + EPS) * 0.8f;
        bf16_t* yp = (bf16_t*)(a.ws + WS_YMIX) + (size_t)(b * SEQ + qrow) * DM + 512 + h * 128;
#pragma unroll
        for (int vt = 0; vt < 4; ++vt)
#pragma unroll
            for (int rgi = 0; rgi < 4; ++rgi) { const int vd = 32 * vt + 8 * rgi + 4 * hh; const f32x4 g = *(const f32x4*)(a.subln_g + vd);
                u32x2 w; w.x = pk2(O[vt][4 * rgi] * rs * g.x, O[vt][4 * rgi + 1] * rs * g.y); w.y = pk2(O[vt][4 * rgi + 2] * rs * g.z, O[vt][4 * rgi + 3] * rs * g.w);
                *(u32x2*)(yp + vd) = w; }
    }
    __syncthreads();
}

DI void mcombine_phase(const Ctx& F, const Args& a) {
    const int gw = F.bid * NWAVES + F.wave, NGW = F.G * NWAVES, lane = F.lane;
    const bf16_t* HD = (const bf16_t*)((const unsigned char*)a.out + DO_HD);
    float g[8];
#pragma unroll
    for (int i = 0; i < 8; ++i) g[i] = a.mnorm_g[lane * 8 + i];
    for (int m = gw; m < MTOK; m += NGW) {
        const u32x4 f = *(const u32x4*)(HD + (size_t)m * 512 + lane * 8), bw = *(const u32x4*)(HD + ((size_t)MTOK + m) * 512 + lane * 8);
        const u32x4 om = *(const u32x4*)((const bf16_t*)(a.ws + WS_PROJ) + (size_t)m * PS + C_OM + lane * 8);
        float v[8];
        v[0] = bflo(f.x) + bflo(bw.x); v[1] = bfhi(f.x) + bfhi(bw.x); v[2] = bflo(f.y) + bflo(bw.y); v[3] = bfhi(f.y) + bfhi(bw.y);
        v[4] = bflo(f.z) + bflo(bw.z); v[5] = bfhi(f.z) + bfhi(bw.z); v[6] = bflo(f.w) + bflo(bw.w); v[7] = bfhi(f.w) + bfhi(bw.w);
        float ss = 0.f;
#pragma unroll
        for (int i = 0; i < 8; ++i) ss += v[i] * v[i];
        ss += __shfl_xor(ss, 1); ss += __shfl_xor(ss, 2); ss += __shfl_xor(ss, 4); ss += __shfl_xor(ss, 8);
        const float rstd = rsqrtf(ss * (1.f / 128.f) + EPS);
        float o[8];
        o[0] = bflo(om.x); o[1] = bfhi(om.x); o[2] = bflo(om.y); o[3] = bfhi(om.y); o[4] = bflo(om.z); o[5] = bfhi(om.z); o[6] = bflo(om.w); o[7] = bfhi(om.w);
#pragma unroll
        for (int i = 0; i < 8; ++i) v[i] = v[i] * rstd * g[i] * sigmoid_f(o[i]);
        u32x4 w; w.x = pk2(v[0], v[1]); w.y = pk2(v[2], v[3]); w.z = pk2(v[4], v[5]); w.w = pk2(v[6], v[7]);
        bf16_t* yp = (bf16_t*)(a.ws + WS_YMIX) + (size_t)m * DM + lane * 8;
        *(u32x4*)yp = w;
    }
}

DI void router_finish(const float (&lg)[16], int lane, float* affrow, bool store) {
    float r8[8];
#pragma unroll
    for (int i = 0; i < 8; ++i) { const float keep = hh_sel(lane, 32) ? lg[8 + i] : lg[i], send = hh_sel(lane, 32) ? lg[i] : lg[8 + i]; r8[i] = keep + partner32(send, lane); }
    float r4[4];
#pragma unroll
    for (int i = 0; i < 4; ++i) { const float keep = hh_sel(lane, 16) ? r8[4 + i] : r8[i], send = hh_sel(lane, 16) ? r8[i] : r8[4 + i]; r4[i] = keep + partner16(send, lane); }
    float r2[2];
#pragma unroll
    for (int i = 0; i < 2; ++i) { const float keep = hh_sel(lane, 8) ? r4[2 + i] : r4[i], send = hh_sel(lane, 8) ? r4[i] : r4[2 + i]; r2[i] = keep + partner8(send); }
    float lgt; { const float keep = hh_sel(lane, 4) ? r2[1] : r2[0], send = hh_sel(lane, 4) ? r2[0] : r2[1]; lgt = keep + partner4(send, lane); }
    lgt += dpp_mov<DPP_XOR2>(lgt); lgt += dpp_mov<DPP_XOR1>(lgt);
    float mx = lgt; mx = fmaxf(mx, dpp_mov<DPP_ROR(8)>(mx)); mx = fmaxf(mx, dpp_mov<DPP_ROR(4)>(mx)); mx = xor16_max(mx); mx = xor32_max(mx);
    const float ex = __expf(lgt - mx); float sm = ex; sm += dpp_mov<DPP_ROR(8)>(sm); sm += dpp_mov<DPP_ROR(4)>(sm); sm = xor16_sum(sm); sm = xor32_sum(sm);
    if ((lane & 3) == 0 && store) affrow[lane >> 2] = ex / sm;
}
DI void p7_phase(const Ctx& F, const Args& a) {
    LAS bf16_t* WH = (LAS bf16_t*)F.lds; LAS bf16_t* WL = (LAS bf16_t*)(F.lds + 33024);
    LAS float* GS = (LAS float*)(F.lds + 66048); LAS float* SH = GS + 1024;
    const float* mod = (const float*)(a.ws + WS_MOD);
    const int lane = F.lane, n = lane & 15, kg = lane >> 4;
    unsigned char* H2 = a.ws + WS_H2; float* AFF = (float*)(a.ws + WS_AFF);
#pragma unroll 1
    for (int grp = F.bid; grp < MTOK / 128; grp += F.G) {
        const int b = (grp * 128) / SEQ;
        const int m = grp * 128 + F.wave * 16 + n;
        const u32x4* xr = (const u32x4*)((const bf16_t*)(a.ws + WS_X1B) + (size_t)m * DM + 16 * kg);
        u32x4 xq[16][2];
#pragma unroll
        for (int i = 0; i < 16; ++i) { xq[i][0] = xr[8 * i]; xq[i][1] = xr[8 * i + 1]; }
        __syncthreads();
        if (grp == F.bid) {
        for (int q = F.tid; q < 16384; q += NTHR) { const int k = q >> 4, e = q & 15; const float w = a.w_router[q];
            const unsigned hi = pk2(w, 0.f) & 0xffffu; const float rem = w - __uint_as_float(hi << 16);
            ((LAS unsigned short*)WH)[e * 1032 + k] = (unsigned short)hi; ((LAS unsigned short*)WL)[e * 1032 + k] = (unsigned short)(pk2(rem, 0.f) & 0xffffu); }
        }
        for (int k = F.tid; k < DM; k += NTHR) { GS[k] = a.norm2_g[k] * (mod[(size_t)b * 6144 + 4096 + k] + 1.f); SH[k] = mod[(size_t)b * 6144 + 3072 + k]; }
        __syncthreads();
        float s = 0.f;
#pragma unroll
        for (int i = 0; i < 16; ++i)
#pragma unroll
            for (int c = 0; c < 2; ++c)
#pragma unroll
                for (int d = 0; d < 4; ++d) { const float lo = bflo(xq[i][c][d]), hi = bfhi(xq[i][c][d]); s += lo * lo + hi * hi; }
        s = xor16_sum(s); s = xor32_sum(s);
        const float rstd = rsqrtf(s * (1.f / DM) + EPS);
#pragma unroll
        for (int i = 0; i < 16; ++i) { asm volatile("" : "+v"(xq[i][0]), "+v"(xq[i][1])); }
        f32x4 lg = {0.f, 0.f, 0.f, 0.f};
        u32x4* hp = (u32x4*)(H2 + (size_t)m * DM + 16 * kg);
        const LAS unsigned char* whp = (const LAS unsigned char*)WH + n * 2064 + kg * 32; const LAS unsigned char* wlp = (const LAS unsigned char*)WL + n * 2064 + kg * 32;
        const LAS float* gsp = GS + 16 * kg; const LAS float* shp = SH + 16 * kg;
#pragma unroll
        for (int i = 0; i < 16; ++i) {
            u32x4 h8;
#pragma unroll
            for (int c = 0; c < 2; ++c) {
                const f32x4 g0 = *(const LAS f32x4*)(gsp + 64 * i + 8 * c), g1 = *(const LAS f32x4*)(gsp + 64 * i + 8 * c + 4);
                const f32x4 s0 = *(const LAS f32x4*)(shp + 64 * i + 8 * c), s1 = *(const LAS f32x4*)(shp + 64 * i + 8 * c + 4);
                const u32x4 xw = xq[i][c];
                float t[8];
                t[0] = bflo(xw.x) * rstd * g0.x + s0.x; t[1] = bfhi(xw.x) * rstd * g0.y + s0.y; t[2] = bflo(xw.y) * rstd * g0.z + s0.z; t[3] = bfhi(xw.y) * rstd * g0.w + s0.w;
                t[4] = bflo(xw.z) * rstd * g1.x + s1.x; t[5] = bfhi(xw.z) * rstd * g1.y + s1.y; t[6] = bflo(xw.w) * rstd * g1.z + s1.z; t[7] = bfhi(xw.w) * rstd * g1.w + s1.w;
                const unsigned f0 = pg8::pk4_fp8(t[0], t[1], t[2], t[3]), f1 = pg8::pk4_fp8(t[4], t[5], t[6], t[7]);
                if (c == 0) { h8.x = f0; h8.y = f1; } else { h8.z = f0; h8.w = f1; }
                u32x4 th, tl;
#pragma unroll
                for (int d = 0; d < 4; ++d) { const unsigned hw = pk2(t[2 * d], t[2 * d + 1]); th[d] = hw; tl[d] = pk2(t[2 * d] - bflo(hw), t[2 * d + 1] - bfhi(hw)); }
                const bf16x8 wh = *(const LAS bf16x8*)(whp + 128 * i + 16 * c), wl = *(const LAS bf16x8*)(wlp + 128 * i + 16 * c);
                const bf16x8 thv = __builtin_bit_cast(bf16x8, th), tlv = __builtin_bit_cast(bf16x8, tl);
                lg = __builtin_amdgcn_mfma_f32_16x16x32_bf16(wh, thv, lg, 0, 0, 0);
                lg = __builtin_amdgcn_mfma_f32_16x16x32_bf16(wh, tlv, lg, 0, 0, 0);
                lg = __builtin_amdgcn_mfma_f32_16x16x32_bf16(wl, thv, lg, 0, 0, 0);
            }
            hp[4 * i] = h8;
            __builtin_amdgcn_sched_barrier(0);
        }
        float mx = fmaxf(fmaxf(lg[0], lg[1]), fmaxf(lg[2], lg[3])); mx = xor16_max(mx); mx = xor32_max(mx);
        f32x4 ex; float sm = 0.f;
#pragma unroll
        for (int r = 0; r < 4; ++r) { ex[r] = __expf(lg[r] - mx); sm += ex[r]; }
        sm = xor16_sum(sm); sm = xor32_sum(sm);
        const float inv = 1.f / sm;
        *(f32x4*)(AFF + (size_t)m * 16 + 4 * kg) = ex * inv;
    }
    __syncthreads();
}

DI void topk_task(const Ctx& F, const Args& a, int task) {
    const int b = task >> 4, e = task & 15, tid = F.tid, lane = F.lane;
    const float* AFF = (const float*)(a.ws + WS_AFF) + (size_t)b * SEQ * 16 + e;
    LAS unsigned* hist = (LAS unsigned*)F.lds;
    LAS unsigned* sfx = hist + 256;
    LAS unsigned* misc = hist + 512;
    unsigned key[8];
#pragma unroll
    for (int i = 0; i < 8; ++i) key[i] = __float_as_uint(AFF[(size_t)(tid * 8 + i) * 16]);
    unsigned prefix = 0, krem = CAP;
#pragma unroll 1
    for (int pass = 0; pass < 4; ++pass) {
        const int shift = 24 - 8 * pass;
        if (tid < 256) hist[tid] = 0;
        __syncthreads();
#pragma unroll
        for (int i = 0; i < 8; ++i) { const bool in = pass == 0 ? true : ((key[i] >> (shift + 8)) == (prefix >> (shift + 8))); if (in) atomicAdd((unsigned*)&hist[(key[i] >> shift) & 255u], 1u); }
        __syncthreads();
        if (tid < 256) sfx[tid] = hist[tid];
        __syncthreads();
#pragma unroll 1
        for (int o = 1; o < 256; o <<= 1) { unsigned v = 0; if (tid < 256) v = sfx[tid] + (tid + o < 256 ? sfx[tid + o] : 0u); __syncthreads(); if (tid < 256) sfx[tid] = v; __syncthreads(); }
        if (tid < 256) { const unsigned incl = sfx[tid], excl = incl - hist[tid]; if (excl < krem && krem <= incl) { misc[0] = (unsigned)tid; misc[1] = krem - excl; } }
        __syncthreads();
        prefix |= misc[0] << shift; krem = misc[1];
        __syncthreads();
    }
    const unsigned T = prefix, need = krem;
    unsigned cg_ = 0, ce = 0;
#pragma unroll
    for (int i = 0; i < 8; ++i) { cg_ += key[i] > T; ce += key[i] == T; }
    unsigned sg = cg_, se = ce;
#pragma unroll
    for (int o = 1; o < 64; o <<= 1) { const unsigned tg = __shfl_up(sg, o), te = __shfl_up(se, o); if (lane >= o) { sg += tg; se += te; } }
    if (lane == 63) { misc[16 + F.wave] = sg; misc[32 + F.wave] = se; }
    __syncthreads();
    unsigned og = sg - cg_, oe = se - ce;
    for (int w = 0; w < F.wave; ++w) { og += misc[16 + w]; oe += misc[32 + w]; }
    int* SLOT = (int*)(a.ws + WS_SLOT) + (size_t)b * SEQ * 16 + e;
    float* VALS = (float*)(a.ws + WS_VALS) + (size_t)(e * 8 + b) * CAP;
    int* IDX = (int*)(a.ws + WS_IDX) + (size_t)(e * 8 + b) * CAP;
#pragma unroll
    for (int i = 0; i < 8; ++i) {
        const bool gt = key[i] > T, eq = key[i] == T; const bool sel = gt || (eq && oe < need);
        const unsigned pos = og + (oe < need ? oe : need);
        const int s = tid * 8 + i;
        SLOT[(size_t)s * 16] = sel ? (int)pos : -1;
        if (sel) { IDX[pos] = b * SEQ + s; VALS[pos] = __uint_as_float(key[i]); }
        og += gt; oe += eq;
    }
    __syncthreads();
}

DI void final_phase(const Ctx& F, const Args& a) {
    const int gw = F.bid * NWAVES + F.wave, NGW = F.G * NWAVES, lane = F.lane;
    const float* mod = (const float*)(a.ws + WS_MOD); const int* SLOT = (const int*)(a.ws + WS_SLOT); const unsigned char* Y = a.ws + WS_Y;
    for (int m = gw; m < MTOK; m += NGW) {
        const int b = m / SEQ;
        const int sl = SLOT[(size_t)m * 16 + (lane & 15)];
        f32x4* op = (f32x4*)(a.out + (size_t)m * DM + lane * 16);
        f32x4 xv[4];
        { const u32x4* xp = (const u32x4*)((const bf16_t*)(a.ws + WS_X1B) + (size_t)m * DM + lane * 16); const u32x4 w0 = xp[0], w1 = xp[1];
          xv[0].x = bflo(w0.x); xv[0].y = bfhi(w0.x); xv[0].z = bflo(w0.y); xv[0].w = bfhi(w0.y); xv[1].x = bflo(w0.z); xv[1].y = bfhi(w0.z); xv[1].z = bflo(w0.w); xv[1].w = bfhi(w0.w);
          xv[2].x = bflo(w1.x); xv[2].y = bfhi(w1.x); xv[2].z = bflo(w1.y); xv[2].w = bfhi(w1.y); xv[3].x = bflo(w1.z); xv[3].y = bfhi(w1.z); xv[3].z = bflo(w1.w); xv[3].w = bfhi(w1.w); }
        float acc[16];
#pragma unroll
        for (int i = 0; i < 16; ++i) acc[i] = 0.f;
#pragma unroll 1
        for (int e = 0; e < 16; ++e) { const int s = __shfl(sl, e);
            if (s >= 0) { const u32x4 w = *(const u32x4*)(Y + ((size_t)(e * 8 + b) * CAP + s) * DM + lane * 16);
#pragma unroll
                for (int q = 0; q < 4; ++q) { const unsigned ww = w[q];
                    const auto lo = __builtin_amdgcn_cvt_pk_f32_fp8((int)ww, false), hi = __builtin_amdgcn_cvt_pk_f32_fp8((int)ww, true);
                    acc[4 * q] += lo[0]; acc[4 * q + 1] += lo[1]; acc[4 * q + 2] += hi[0]; acc[4 * q + 3] += hi[1]; } } }
        const f32x4* gp = (const f32x4*)(mod + (size_t)b * 6144 + 5120 + lane * 16);
#pragma unroll
        for (int q = 0; q < 4; ++q) { const f32x4 g = gp[q] * (1.f / pg8::Y_PRESCALE); f32x4 o = xv[q]; o.x += g.x * acc[4 * q]; o.y += g.y * acc[4 * q + 1]; o.z += g.z * acc[4 * q + 2]; o.w += g.w * acc[4 * q + 3]; op[q] = o; }
    }
}

#define XB_TMO      128
#define XB_XCNT(j)  (256  + 64 * (j))
#define XB_XSUB(j)  (1280 + 64 * (j))
#define XB_XGEN(j)  (2304 + 64 * (j))
#define XB_TOP      3328
#define XB_TOPGEN   3392
#define XB_SPIN_CAP (1u << 18)
DI unsigned xb_ld(unsigned* p)              { return __hip_atomic_load(p, __ATOMIC_RELAXED, __HIP_MEMORY_SCOPE_AGENT); }
DI unsigned xb_add(unsigned* p, unsigned v) { return __hip_atomic_fetch_add(p, v, __ATOMIC_RELAXED, __HIP_MEMORY_SCOPE_AGENT); }
DI unsigned xb_xcc_id() { return (unsigned)__builtin_amdgcn_s_getreg((3 << 11) | 20) & 0xFu; }
#define XB_SPIN(cond, bar) do { unsigned _sp = 0; while (cond) { __builtin_amdgcn_s_sleep(1); \
    if ((++_sp & 255u) == 0u) { if (xb_ld(&(bar)[XB_TMO])) break; if (_sp > XB_SPIN_CAP) { atomicAdd(&(bar)[XB_TMO], 1u); break; } } } } while (0)
struct XcdBarrier { unsigned* bar; unsigned x; volatile LAS unsigned* st; };
DI XcdBarrier xcd_barrier_post(unsigned* bar, volatile LAS unsigned* st) {
    XcdBarrier b; b.bar = bar; b.x = xb_xcc_id(); b.st = st;
    if (threadIdx.x == 0) (void)xb_add(&bar[XB_XCNT(b.x)], 1u);
    return b;
}
DI void xcd_barrier_complete(unsigned* bar, unsigned x, unsigned& nloc, unsigned& nx) {
    const unsigned G = gridDim.x * gridDim.y * gridDim.z;
    unsigned sum, cnt, mine, sp = 0u;
    for (;;) {
        sum = 0u; cnt = 0u; mine = 0u;
#pragma unroll
        for (unsigned j = 0; j < 16; ++j) { const unsigned c = xb_ld(&bar[XB_XCNT(j)]); sum += c; cnt += (c > 0u) ? 1u : 0u; mine = (j == x) ? c : mine; }
        if (sum == G) break;
        __builtin_amdgcn_s_sleep(1);
        if ((++sp & 255u) == 0u) { if (xb_ld(&bar[XB_TMO])) break; if (sp > XB_SPIN_CAP) { atomicAdd(&bar[XB_TMO], 1u); break; } }
    }
    nloc = mine > 0u ? mine : 1u; nx = cnt > 0u ? cnt : 1u;
}
DI void xcd_barrier(const XcdBarrier& b) {
    asm volatile("s_waitcnt vmcnt(0)" ::: "memory");
    __syncthreads();
    if (threadIdx.x == 0) {
        unsigned* bar = b.bar;
        __builtin_amdgcn_s_waitcnt(0);
        unsigned nloc = b.st[0], nx = b.st[1];
        if (nloc == 0u) { xcd_barrier_complete(bar, b.x, nloc, nx); b.st[0] = nloc; b.st[1] = nx; }
        const unsigned old = xb_add(&bar[XB_XSUB(b.x)], 1u);
        const unsigned gen = old / nloc;
        if (old + 1u == (gen + 1u) * nloc) {
            __builtin_amdgcn_fence(__ATOMIC_RELEASE, "agent");
            asm volatile("s_waitcnt vmcnt(0)" ::: "memory");
            const unsigned og = xb_add(&bar[XB_TOP], 1u);
            const unsigned tg = og / nx;
            if (og + 1u == (tg + 1u) * nx) xb_add(&bar[XB_TOPGEN], 1u);
            else XB_SPIN(xb_ld(&bar[XB_TOPGEN]) == tg, bar);
            __builtin_amdgcn_fence(__ATOMIC_ACQUIRE, "agent");
            xb_add(&bar[XB_XGEN(b.x)], 1u);
            asm volatile("s_waitcnt vmcnt(0)" ::: "memory");
        } else {
            XB_SPIN(xb_ld(&bar[XB_XGEN(b.x)]) == gen, bar);
            __builtin_amdgcn_fence(__ATOMIC_ACQUIRE, "agent");
            asm volatile("s_waitcnt vmcnt(0)" ::: "memory");
        }
    }
    __syncthreads();
}

static_assert(sizeof(Args) == 22 * 8, "Args layout");
__global__ void __launch_bounds__(NTHR, 2) fwd_kernel(Args a_unused) {
    extern __shared__ __attribute__((aligned(16))) unsigned char lds_raw[];
    cg::grid_group grid = cg::this_grid();
    Ctx F; F.lds = (LAS unsigned char*)lds_raw; F.tid = threadIdx.x; F.lane = F.tid & 63; F.wave = __builtin_amdgcn_readfirstlane(F.tid >> 6); F.G = gridDim.x; F.bid = blockIdx.x;

    int lo, hi; { typedef __attribute__((address_space(4))) const volatile unsigned long long* kp_t; const unsigned long long ph = ((kp_t)__builtin_amdgcn_kernarg_segment_ptr())[21]; lo = (int)(unsigned)ph; hi = (int)(unsigned)(ph >> 32); }
#ifndef PHASE_MASK
#define PHASE_MASK 0xffff
#endif
#define IN(k) (((PHASE_MASK >> (k)) & 1) && lo <= (k) && (k) < hi)
    volatile LAS unsigned* bst = (volatile LAS unsigned*)(F.lds + LDS_BYTES - 64);
    if (F.tid < 2) bst[F.tid] = 0u;
    __syncthreads();
    XcdBarrier xbar;
    { const Args a0 = load_args(); xbar = xcd_barrier_post((unsigned*)(a0.ws + WS_CTL), bst); }
    volatile LAS unsigned long long* tsl = (volatile LAS unsigned long long*)(F.lds + LDS_BYTES - 256);
    if (PROBE_PHASE >= 0 && F.bid == 0 && F.tid == 0) tsl[0] = __builtin_amdgcn_s_memrealtime();
#define SEAM(k) do { if (IN(k) && IN((k) + 1)) { xcd_barrier(xbar); } \
        if (PROBE_PHASE >= 0 && F.bid == 0 && F.tid == 0) tsl[(k) + 1] = __builtin_amdgcn_s_memrealtime(); } while (0)
    grid.sync();
    if (IN(0)) { const Args a = load_args(); p0_phase(F, a); p1_phase(F, a); }
    if (PROBE_PHASE >= 0 && F.bid == 0 && F.tid == 0) tsl[1] = __builtin_amdgcn_s_memrealtime();
    SEAM(1);
    if (IN(2)) {
        const Args a = load_args();
        pg8::Gemm g{(const bf16_t*)a.out, (const bf16_t*)(a.ws + WS_WINT), MTOK, PS, DM, 1 << 30}; pg8::StaticOrder S; S.init(MTOK, PS, F.G, F.bid);
        pg8::EpiProj E{(bf16_t*)(a.ws + WS_PROJ), a.pos, a.qk_g, (bf16_t*)(a.ws + WS_KIMG), (bf16_t*)(a.ws + WS_VIMG)};
        pg8::gemm_phase<pg8::EpiProj, true, true>(F.lds, g, S, E);
        gates_tasks(F, a);
    }
    SEAM(2);
    if (IN(3)) {
        const Args a = load_args();
        conv_phase(F, a);
        for (int t = F.bid; t < 64; t += F.G) mscal_task(F, a, t);
    }
    SEAM(3);
    if (IN(4)) {
        const Args a = load_args();
        {
#pragma unroll 1
            for (int rep = 0; rep < REP_MSEQ; ++rep)
#pragma unroll 1
            for (int it = F.bid; it < 256; it += F.G) { const int xcd_ = it & 7, j_ = it >> 3; mseq_item(F, a, it, xcd_ * 4 + (j_ >> 3), (j_ >> 2) & 1, j_ & 3); }
        }
        float lam, cshift;
        { const float p01 = wave_sum(a.lam_p[F.lane] * a.lam_p[64 + F.lane]), p23 = wave_sum(a.lam_p[128 + F.lane] * a.lam_p[192 + F.lane]);
          lam = __expf(p01) - __expf(p23) + 0.2f;
          const float gq = wave_max(fabsf(a.qk_g[F.lane])), gk = wave_max(fabsf(a.qk_g[64 + F.lane]));
          cshift = 8.f * gq * gk * 1.4426950408889634f * 1.02f; }
        const int xcd = F.bid & 7, j = F.bid >> 3;
#pragma unroll 1
        for (int rep = 0; rep < REP_ATT; ++rep)
        for (int i = 0; i * F.G < 1024; ++i) {
            int u;
            if (F.G == 256) u = (xcd * 4 + i) * 32 + j; else u = i * F.G + F.bid;
            if (u < 1024) attn_unit(F, a, u >> 7, (u >> 5) & 3, u & 31, lam, cshift);
        }
    }
    SEAM(4);
    if (IN(5)) { const Args a = load_args(); mcombine_phase(F, a); }
    SEAM(5);
    if (IN(6)) {
        const Args a = load_args();
        pg8::Gemm g{(const bf16_t*)(a.ws + WS_YMIX), (const bf16_t*)(a.ws + WS_WOUTT), MTOK, DM, DM, 1 << 30}; pg8::StaticOrder S; S.init(MTOK, DM, F.G, F.bid);
        pg8::EpiX1 E{a.x, (const float*)(a.ws + WS_MOD), (bf16_t*)(a.ws + WS_X1B)};
        pg8::gemm_phase<pg8::EpiX1, true, true>(F.lds, g, S, E);
    }
    SEAM(6);
    if (IN(7)) { const Args a = load_args();
#pragma unroll 1
        for (int rep = 0; rep < REP_P7; ++rep) p7_phase(F, a); }
    SEAM(7);
    if (IN(8)) { const Args a = load_args(); for (int t = F.bid; t < BATCH * NEXP; t += F.G) topk_task(F, a, t); }
    SEAM(8);
    if (IN(9)) {
        const Args a = load_args();
        pg8::Gemm g{(const bf16_t*)(a.ws + WS_H2), (const bf16_t*)(a.ws + WS_WGUT), NPAIR, 4096, DM, 16, (const int*)(a.ws + WS_IDX)};
        pg8::StaticOrder S; S.init(NPAIR, 4096, F.G, F.bid);
        pg8::EpiGU E{a.ws + WS_HH};
#pragma unroll 1
        for (int rep = 0; rep < REP_UP; ++rep)
        pg8::gemm_phase<pg8::EpiGU, true, true, true, true>(F.lds, g, S, E);
    }
    SEAM(9);
    if (IN(10)) {
        const Args a = load_args();
        pg8::Gemm g{(const bf16_t*)(a.ws + WS_HH), (const bf16_t*)(a.ws + WS_WDT), NPAIR, DM, DFF, 16};
        pg8::StaticOrder S; S.init(NPAIR, DM, F.G, F.bid);
        pg8::EpiDown E{a.ws + WS_Y, (const float*)(a.ws + WS_VALS)};
        pg8::gemm_phase<pg8::EpiDown, true, true, true>(F.lds, g, S, E);
    }
    SEAM(10);
    if (IN(11)) { const Args a = load_args(); final_phase(F, a); }
    if (PROBE_MSEQ_W >= 0 && F.bid == 0 && F.tid == 0) {
        const unsigned long long d = *(volatile LAS unsigned long long*)(F.lds + LDS_BYTES - 128), t1 = __builtin_amdgcn_s_memtime();
        while (__builtin_amdgcn_s_memtime() - t1 < 3ull * d) __builtin_amdgcn_s_sleep(8);
    }
    if (PROBE_PHASE >= 0 && F.bid == 0 && F.tid == 0) {
        const unsigned long long t1 = __builtin_amdgcn_s_memrealtime();
        const unsigned long long d = (PROBE_PHASE == 11 ? t1 : tsl[PROBE_PHASE + 1]) - tsl[PROBE_PHASE];
        while (__builtin_amdgcn_s_memrealtime() - t1 < 3ull * d) __builtin_amdgcn_s_sleep(8);
    }
#undef IN
#undef SEAM
}

extern "C" void kernel_launch(void* const* d_in, const int* in_sizes, int n_in, void* d_out, int out_size, void* d_ws, size_t ws_size, hipStream_t stream) {
    static int grid_blocks = 0;
    if (!grid_blocks) {
        int dev = 0, cus = 0, per_cu = 0;
        (void)hipGetDevice(&dev);
        (void)hipDeviceGetAttribute(&cus, hipDeviceAttributeMultiprocessorCount, dev);
        (void)hipFuncSetAttribute((const void*)fwd_kernel, hipFuncAttributeMaxDynamicSharedMemorySize, LDS_BYTES);
        (void)hipOccupancyMaxActiveBlocksPerMultiprocessor(&per_cu, (const void*)fwd_kernel, NTHR, LDS_BYTES);
        if (per_cu < 1) per_cu = 1;
        grid_blocks = cus;
        if (ws_size < WS_END) fprintf(stderr, "kernel_launch: workspace too small: %zu < %zu\n", ws_size, (size_t)WS_END);
    }
    (void)hipMemsetAsync((char*)d_ws + WS_CTL, 0, CTL_ZERO_BYTES, stream);
    Args a{};
    a.x = (const float*)d_in[0]; a.c = (const float*)d_in[1]; a.pos = (const int*)d_in[2]; a.norm1_g = (const float*)d_in[3]; a.norm2_g = (const float*)d_in[4];
    a.w_ada = (const float*)d_in[5]; a.b_ada = (const float*)d_in[6]; a.w_in = (const float*)d_in[7]; a.conv_w = (const float*)d_in[8]; a.gate_b = (const float*)d_in[9];
    a.mnorm_g = (const float*)d_in[10]; a.qk_g = (const float*)d_in[11]; a.lam_p = (const float*)d_in[12]; a.subln_g = (const float*)d_in[13]; a.w_out = (const float*)d_in[14];
    a.w_router = (const float*)d_in[15]; a.w_gate = (const float*)d_in[16]; a.w_up = (const float*)d_in[17]; a.w_down = (const float*)d_in[18];
    a.out = (float*)d_out; a.ws = (unsigned char*)d_ws; a.ph_lo = 0; a.ph_hi = 12;
    void* args[] = {&a};
    hipError_t e = hipLaunchCooperativeKernel((const void*)fwd_kernel, dim3(grid_blocks), dim3(NTHR), args, LDS_BYTES, stream);
    if (e != hipSuccess) fprintf(stderr, "cooperative launch failed: %s (grid %d)\n", hipGetErrorString(e), grid_blocks);
}
```

```cpp
#include <hip/hip_runtime.h>
#include <hip/hip_cooperative_groups.h>
#include <cstdio>
#include <cstdint>
namespace cg = cooperative_groups;

#define LAS __attribute__((address_space(3)))
#define DI __device__ __forceinline__
typedef unsigned short bf16_t;
typedef short bf16x8 __attribute__((ext_vector_type(8)));
typedef short s16x4 __attribute__((ext_vector_type(4)));
typedef float f32x2 __attribute__((ext_vector_type(2)));
typedef float f32x4 __attribute__((ext_vector_type(4)));
typedef float f32x16 __attribute__((ext_vector_type(16)));
typedef unsigned u32x2 __attribute__((ext_vector_type(2)));
typedef unsigned u32x4 __attribute__((ext_vector_type(4)));
typedef __bf16 bf16x2_t __attribute__((ext_vector_type(2)));

constexpr int BATCH = 8, SEQ = 4096, DM = 1024, MTOK = BATCH * SEQ;
constexpr int DIN = 3600, PS = 3584;
constexpr int NEXP = 16, CAP = 512, DFF = 2048;
constexpr int NPAIR = BATCH * NEXP * CAP;
constexpr float EPS = 1e-6f;
constexpr int C_QM = 0, C_KM = 512, C_VM = 1024, C_OM = 1536, C_QA = 2048, C_KA = 2560, C_VA = 3072;

constexpr size_t MiB = 1u << 20;
constexpr size_t WS_CTL = 0;
constexpr int CTL_ZERO_BYTES = 65536;
constexpr size_t WS_MOD = 1 * MiB;
constexpr size_t WS_GATES = 2 * MiB;
constexpr size_t WS_AFF = 4 * MiB;
constexpr size_t WS_IDX = 6 * MiB;
constexpr size_t WS_VALS = 6 * MiB + 256 * 1024;
constexpr size_t WS_MSC = 6 * MiB + 512 * 1024;
constexpr size_t WS_SLOT = 7 * MiB;
constexpr size_t WS_NLOC = 9 * MiB;
constexpr size_t WS_WINT = 11 * MiB;
constexpr size_t WS_WGT = 18 * MiB;
constexpr size_t WS_WOUTT = 19 * MiB;
constexpr size_t WS_WGUT = 21 * MiB;
constexpr size_t WS_WDT = 85 * MiB;
constexpr size_t WS_Y = 117 * MiB;
constexpr size_t WS_PROJ = 213 * MiB;
constexpr size_t WS_YMIX = 117 * MiB;
constexpr size_t WS_KIMG = 437 * MiB;
constexpr size_t WS_VIMG = 469 * MiB;
constexpr size_t WS_HH = 245 * MiB;
constexpr size_t WS_H2 = 437 * MiB;
constexpr size_t WS_X1B = 373 * MiB;
constexpr size_t WS_END = 533 * MiB;

constexpr int LDS_BYTES = 163840;
constexpr int PROBE_MSEQ_W = -1;
constexpr int PROBE_PHASE = -1;
constexpr int REP_M1 = 1, REP_M3 = 1, REP_UP = 1, REP_P0 = 1, REP_SCAN = 1, REP_P7 = 1, REP_ATT = 1, REP_QKT = 1, REP_MSEQ = 1;
constexpr int NWAVES = 8, NTHR = 512;

DI unsigned pk2(float lo, float hi) { f32x2 v = {lo, hi}; bf16x2_t b = __builtin_convertvector(v, bf16x2_t); return __builtin_bit_cast(unsigned, b); }
DI float bflo(unsigned w) { return __uint_as_float(w << 16); }
DI float bfhi(unsigned w) { return __uint_as_float(w & 0xffff0000u); }
DI float bf2f(bf16_t v) { return __uint_as_float((unsigned)v << 16); }
template <int CTRL> DI float dpp_mov(float x) { return __builtin_bit_cast(float, __builtin_amdgcn_update_dpp(0, __builtin_bit_cast(int, x), CTRL, 0xf, 0xf, false)); }
#define DPP_XOR1 0xB1
#define DPP_XOR2 0x4E
#define DPP_ROR(n) (0x120 + (n))
DI float xor16_sum(float x) { const unsigned u = __builtin_bit_cast(unsigned, x); auto r = __builtin_amdgcn_permlane16_swap(u, u, false, false); return __builtin_bit_cast(float, (unsigned)r[0]) + __builtin_bit_cast(float, (unsigned)r[1]); }
DI float xor32_sum(float x) { const unsigned u = __builtin_bit_cast(unsigned, x); auto r = __builtin_amdgcn_permlane32_swap(u, u, false, false); return __builtin_bit_cast(float, (unsigned)r[0]) + __builtin_bit_cast(float, (unsigned)r[1]); }
DI float xor16_max(float x) { const unsigned u = __builtin_bit_cast(unsigned, x); auto r = __builtin_amdgcn_permlane16_swap(u, u, false, false); return fmaxf(__builtin_bit_cast(float, (unsigned)r[0]), __builtin_bit_cast(float, (unsigned)r[1])); }
DI float xor32_max(float x) { const unsigned u = __builtin_bit_cast(unsigned, x); auto r = __builtin_amdgcn_permlane32_swap(u, u, false, false); return fmaxf(__builtin_bit_cast(float, (unsigned)r[0]), __builtin_bit_cast(float, (unsigned)r[1])); }
template <int CTRL, int RM, int BM_> DI float dpp_mov_m(float oldv, float x) { return __builtin_bit_cast(float, __builtin_amdgcn_update_dpp(__builtin_bit_cast(int, oldv), __builtin_bit_cast(int, x), CTRL, RM, BM_, false)); }
DI float wave_prefix_sum(float v) {
    v += dpp_mov_m<0x111, 0xf, 0xf>(0.f, v); v += dpp_mov_m<0x112, 0xf, 0xf>(0.f, v); v += dpp_mov_m<0x114, 0xf, 0xe>(0.f, v); v += dpp_mov_m<0x118, 0xf, 0xc>(0.f, v);
    v += dpp_mov_m<0x142, 0xa, 0xf>(0.f, v); v += dpp_mov_m<0x143, 0xc, 0xf>(0.f, v);
    return v;
}
DI float wave_prefix_max(float v) {
    const float ninf = -__builtin_inff();
    v = fmaxf(v, dpp_mov_m<0x111, 0xf, 0xf>(ninf, v)); v = fmaxf(v, dpp_mov_m<0x112, 0xf, 0xf>(ninf, v)); v = fmaxf(v, dpp_mov_m<0x114, 0xf, 0xe>(ninf, v)); v = fmaxf(v, dpp_mov_m<0x118, 0xf, 0xc>(ninf, v));
    v = fmaxf(v, dpp_mov_m<0x142, 0xa, 0xf>(ninf, v)); v = fmaxf(v, dpp_mov_m<0x143, 0xc, 0xf>(ninf, v));
    return v;
}
DI float partner32(float x, int lane) { const unsigned u = __builtin_bit_cast(unsigned, x); auto r = __builtin_amdgcn_permlane32_swap(u, u, false, false); return __builtin_bit_cast(float, (unsigned)((lane & 32) ? r[0] : r[1])); }
DI float partner16(float x, int lane) { const unsigned u = __builtin_bit_cast(unsigned, x); auto r = __builtin_amdgcn_permlane16_swap(u, u, false, false); return __builtin_bit_cast(float, (unsigned)((lane & 16) ? r[0] : r[1])); }
DI float partner8(float x) { return dpp_mov<DPP_ROR(8)>(x); }
DI float partner4(float x, int lane) { const float a = dpp_mov<DPP_ROR(4)>(x), b = dpp_mov<DPP_ROR(12)>(x); return (lane & 4) ? a : b; }
DI float row_sum16(float v) { v += dpp_mov<DPP_XOR1>(v); v += dpp_mov<DPP_XOR2>(v); v += dpp_mov<DPP_ROR(4)>(v); v += dpp_mov<DPP_ROR(8)>(v); return v; }
DI float wave_sum(float v) { v = row_sum16(v); v = xor16_sum(v); return xor32_sum(v); }
DI float wave_max(float v) { v = fmaxf(v, dpp_mov<DPP_XOR1>(v)); v = fmaxf(v, dpp_mov<DPP_XOR2>(v)); v = fmaxf(v, dpp_mov<DPP_ROR(4)>(v)); v = fmaxf(v, dpp_mov<DPP_ROR(8)>(v)); v = xor16_max(v); return xor32_max(v); }
DI float sigmoid_f(float v) { return __builtin_amdgcn_rcpf(1.f + __builtin_amdgcn_exp2f(-1.4426950408889634f * v)); }
DI float silu_f(float v) { return v * sigmoid_f(v); }
DI float logsigmoid_f(float f) { return fminf(f, 0.f) - log1pf(__expf(-fabsf(f))); }
DI int swz16(int row) { return ((row & 3) << 2) | ((row >> 2) & 3); }
#define MFMA32(a, b, c) __builtin_amdgcn_mfma_f32_32x32x16_bf16((a), (b), (c), 0, 0, 0)
DI s16x4 trread(const LAS unsigned char* p) { return __builtin_bit_cast(s16x4, __builtin_amdgcn_ds_read_tr16_b64_v4i16((LAS s16x4*)p)); }
DI int crow(int r, int hh) { return (r & 3) + 8 * (r >> 2) + 4 * hh; }
DI bool hh_sel(int lane, int bit) { return (lane & bit) != 0; }

namespace pg8 {
constexpr int BM = 256, BK = 64, HALF = 128, HTB = HALF * BK * 2, STAGE_BYTES = 8 * HTB, NXCD = 8, WGM = 8;
DI int lds_byte(int r, int c) { const int st = (r >> 4) * 2 + (c >> 5), rr = r & 15, cc = c & 31, ob = rr * 64 + cc * 2; return st * 1024 + (ob ^ (((ob >> 9) & 1) << 5)); }
DI void stage_rc(int b, int& R, int& C) { const int st = b / 1024, sb = b % 1024, swz = sb ^ (((sb >> 9) & 1) << 5); R = (st >> 1) * 16 + swz / 64; C = (st & 1) * 32 + (swz % 64) / 2; }
DI int perm32(int rho) { const int n = rho >> 4, i = rho & 15; return 8 * (i >> 2) + 4 * n + (i & 3); }
struct Unit { int pm, pn; };
typedef int i32x4_t __attribute__((ext_vector_type(4)));
typedef int i32x8_t __attribute__((ext_vector_type(8)));
DI i32x8_t cat8(bf16x8 lo, bf16x8 hi) { const i32x4_t a = __builtin_bit_cast(i32x4_t, lo), b = __builtin_bit_cast(i32x4_t, hi); return __builtin_shufflevector(a, b, 0, 1, 2, 3, 4, 5, 6, 7); }
struct Gemm { const bf16_t* A; const bf16_t* Bt; int M, N, K, tpg; const int* gidx = nullptr; };
struct StaticOrder {
    int nM, nN, nwg, G, c;
    DI void init(int M, int N, int G_, int c_) { nM = M / BM; nN = N / BM; nwg = nM * nN; G = G_; c = c_; }
    DI bool next(int i, Unit& u) const {
        const long L = (long)i * G + c; if (L >= nwg) return false;
        int wgid = (int)L; { const int q = nwg / NXCD, r = nwg % NXCD, xcd = wgid % NXCD, off = wgid / NXCD; wgid = (xcd < r ? xcd * (q + 1) : r * (q + 1) + (xcd - r) * q) + off; }
        const int nig = WGM * nN, gid = wgid / nig, fm = gid * WGM, gsz = (nM - fm) < WGM ? (nM - fm) : WGM;
        u.pm = fm + ((wgid % nig) % gsz); u.pn = (wgid % nig) / gsz; return true;
    }
};

template <class Epi, bool ALIGN_EPI, bool SP2, bool FP8 = false, bool GATHER = false>
DI void gemm_phase(LAS unsigned char* lds, const Gemm g, const StaticOrder& S, const Epi& E) {
    const int tid = threadIdx.x, wid = __builtin_amdgcn_readfirstlane(tid >> 6), lane = tid & 63, wr = wid >> 2, wc = wid & 3, fr = lane & 15, fq = lane >> 4;
    const int KB = FP8 ? g.K : 2 * g.K, nt = KB / (BK * 2);
    unsigned voffA[2], voffB[2];
#pragma unroll
    for (int i = 0; i < 2; ++i) { int R, C; stage_rc(tid * 16 + i * 8192, R, C); const int Rb = Epi::PERM ? ((R & ~31) + perm32(R & 31)) : R;
        voffA[i] = (unsigned)(R * KB + C * 2); voffB[i] = (unsigned)(Rb * KB + C * 2); }
    int R0g, C0g; stage_rc(tid * 16, R0g, C0g);
    unsigned vgA[2][2], ngA[2][2];
    LAS int* gtab = (LAS int*)(lds + STAGE_BYTES);
    const size_t kstep = (size_t)(BK * 2);
    const size_t hstep = (size_t)HALF * KB;
    const size_t tstep = 2 * hstep;
    const size_t gstep = (size_t)g.N * KB;
    const unsigned ldsw = (unsigned)wid * 1024u;
    const int aoff = lds_byte(wr * 64 + fr, fq * 8), boff = lds_byte(wc * 32 + fr, fq * 8);
#define PG8_SA(b, h) (((b) * 2 + (h)) * HTB)
#define PG8_SB(b, h) ((4 + (b) * 2 + (h)) * HTB)
#define PG8_STAGE(bufoff, gbase, voff) do { _Pragma("unroll") for (int _i = 0; _i < 2; ++_i) \
        __builtin_amdgcn_global_load_lds((const unsigned*)((const char*)(gbase) + (voff)[_i]), (LAS unsigned*)(lds + (bufoff) + ldsw + _i * 8192), 16, 0, 0); } while (0)
#define PG8_STAGE_A(bufoff, gbase, h, nx) do { if constexpr (GATHER) { _Pragma("unroll") for (int _i = 0; _i < 2; ++_i) { const unsigned _o = (nx) ? ngA[h][_i] : vgA[h][_i]; \
        __builtin_amdgcn_global_load_lds((const unsigned*)((const char*)(gbase) + _o), (LAS unsigned*)(lds + (bufoff) + ldsw + _i * 8192), 16, 0, 0); } } \
        else PG8_STAGE(bufoff, (gbase) + (h) * hstep, voffA); } while (0)
#define PG8_LDA(dst, b, h) do { if constexpr (FP8) { _Pragma("unroll") for (int m = 0; m < 4; ++m) dst##8[m] = cat8(*(const LAS bf16x8*)(lds + PG8_SA(b, h) + aoff + m * 2048), *(const LAS bf16x8*)(lds + PG8_SA(b, h) + aoff + m * 2048 + 1024)); } \
        else { _Pragma("unroll") for (int m = 0; m < 4; ++m) _Pragma("unroll") for (int k = 0; k < 2; ++k) dst[m][k] = *(const LAS bf16x8*)(lds + PG8_SA(b, h) + aoff + m * 2048 + k * 1024); } } while (0)
#define PG8_LDB(dst, b, h) do { if constexpr (FP8) { _Pragma("unroll") for (int n = 0; n < 2; ++n) dst##8[n] = cat8(*(const LAS bf16x8*)(lds + PG8_SB(b, h) + boff + n * 2048), *(const LAS bf16x8*)(lds + PG8_SB(b, h) + boff + n * 2048 + 1024)); } \
        else { _Pragma("unroll") for (int n = 0; n < 2; ++n) _Pragma("unroll") for (int k = 0; k < 2; ++k) dst[n][k] = *(const LAS bf16x8*)(lds + PG8_SB(b, h) + boff + n * 2048 + k * 1024); } } while (0)
#define PG8_MMA(ai, bj, At, Bt) do { __builtin_amdgcn_s_setprio(1); \
        if constexpr (FP8) { _Pragma("unroll") for (int m = 0; m < 4; ++m) _Pragma("unroll") for (int n = 0; n < 2; ++n) \
            asm volatile("s_nop 1\n\tv_mfma_f32_16x16x128_f8f6f4 %0, %1, %2, %0" : "+v"(acc[ai][bj][m][n]) : "v"(Bt##8[n]), "v"(At##8[m])); } \
        else { _Pragma("unroll") for (int m = 0; m < 4; ++m) _Pragma("unroll") for (int n = 0; n < 2; ++n) _Pragma("unroll") for (int k = 0; k < 2; ++k) \
            acc[ai][bj][m][n] = __builtin_amdgcn_mfma_f32_16x16x32_bf16(Bt[n][k], At[m][k], acc[ai][bj][m][n], 0, 0, 0); } \
        __builtin_amdgcn_s_setprio(0); } while (0)
#define PG8_WAIT_V(n) asm volatile("s_waitcnt vmcnt(" #n ")" ::: "memory")
#define PG8_WAIT_L(n) asm volatile("s_waitcnt lgkmcnt(" #n ")" ::: "memory")
#define PG8_BAR __builtin_amdgcn_s_barrier()
#define PG8_SCHED __builtin_amdgcn_sched_barrier(0)
    Unit cur, nxt; int ui = 0;
    if (!S.next(0, cur)) return;
    f32x4 acc[2][2][4][2];
#pragma unroll
    for (int a = 0; a < 2; ++a)
#pragma unroll
        for (int b = 0; b < 2; ++b)
#pragma unroll
            for (int m = 0; m < 4; ++m)
#pragma unroll
                for (int n = 0; n < 2; ++n) acc[a][b][m][n] = (f32x4){0.f, 0.f, 0.f, 0.f};
    bf16x8 At[4][2], B0[2][2], B1[2][2]; i32x8_t At8[4], B08[2], B18[2];
    const char* cA = GATHER ? (const char*)g.A : (const char*)g.A + (size_t)cur.pm * tstep; const char* cB = (const char*)g.Bt + (size_t)(cur.pm / g.tpg) * gstep + (size_t)cur.pn * tstep;
    if constexpr (GATHER) {
#pragma unroll
        for (int h = 0; h < 2; ++h)
#pragma unroll
            for (int i = 0; i < 2; ++i) { vgA[h][i] = (unsigned)g.gidx[cur.pm * BM + h * HALF + R0g + 64 * i] * (unsigned)KB + (unsigned)(C0g * 2); ngA[h][i] = vgA[h][i]; }
    }
    if constexpr (SP2) {
        PG8_STAGE(PG8_SB(0, 0), cB, voffB); PG8_STAGE(PG8_SB(0, 1), cB + hstep, voffB); PG8_STAGE_A(PG8_SA(0, 0), cA, 0, false); PG8_STAGE_A(PG8_SA(0, 1), cA, 1, false);
        if (wr == 1) PG8_BAR;
        PG8_WAIT_V(2); PG8_BAR;
        PG8_STAGE(PG8_SB(1, 0), cB + kstep, voffB); PG8_STAGE_A(PG8_SA(1, 0), cA + kstep, 0, false); PG8_STAGE(PG8_SB(1, 1), cB + hstep + kstep, voffB);
        PG8_WAIT_V(6); PG8_BAR;
    } else {
        PG8_STAGE(PG8_SB(0, 0), cB, voffB); PG8_STAGE_A(PG8_SA(0, 0), cA, 0, false); PG8_STAGE(PG8_SB(0, 1), cB + hstep, voffB); PG8_STAGE_A(PG8_SA(0, 1), cA, 1, false);
        if (wr == 1) PG8_BAR;
        PG8_WAIT_V(4); PG8_BAR;
        PG8_STAGE(PG8_SB(1, 0), cB + kstep, voffB); PG8_STAGE_A(PG8_SA(1, 0), cA + kstep, 0, false); PG8_STAGE(PG8_SB(1, 1), cB + hstep + kstep, voffB);
        PG8_WAIT_V(6); PG8_BAR;
    }
    for (;;) {
        const bool has_next = S.next(ui + 1, nxt);
        if constexpr (GATHER) { if (has_next && wid < 4)
            __builtin_amdgcn_global_load_lds((const unsigned*)(g.gidx + nxt.pm * BM + wid * 64 + lane), (LAS unsigned*)(gtab + ((ui + 1) & 1) * 256 + wid * 64), 4, 0, 0); }
        const char* nA = GATHER ? (const char*)g.A : has_next ? (const char*)g.A + (size_t)nxt.pm * tstep : cA;
        const char* nB = has_next ? (const char*)g.Bt + (size_t)(nxt.pm / g.tpg) * gstep + (size_t)nxt.pn * tstep : cB;
        for (int t = 0; t < nt; t += 2) {
            const bool last = (t == nt - 2);
            const char* a1 = cA + (size_t)(t + 1) * kstep;
            const char* a2 = last ? nA : cA + (size_t)(t + 2) * kstep; const char* b2 = last ? nB : cB + (size_t)(t + 2) * kstep;
            const char* a3 = a2 + kstep; const char* b3 = b2 + kstep;
            if constexpr (GATHER) { if (last && has_next) { const LAS int* tb = gtab + ((ui + 1) & 1) * 256 + R0g;
#pragma unroll
                for (int h = 0; h < 2; ++h)
#pragma unroll
                    for (int i = 0; i < 2; ++i) ngA[h][i] = (unsigned)tb[h * HALF + 64 * i] * (unsigned)KB + (unsigned)(C0g * 2); } }
            if constexpr (SP2) {
            PG8_LDB(B0, 0, 0); PG8_LDB(B1, 0, 1); PG8_SCHED; PG8_LDA(At, 0, 0); PG8_STAGE_A(PG8_SA(1, 1), a1, 1, false);
            PG8_WAIT_V(8); PG8_WAIT_L(0); PG8_BAR; PG8_MMA(0, 0, At, B0); PG8_MMA(0, 1, At, B1); PG8_BAR; PG8_SCHED;
            PG8_LDA(At, 0, 1); PG8_STAGE(PG8_SB(0, 0), b2, voffB); PG8_STAGE(PG8_SB(0, 1), b2 + hstep, voffB); PG8_STAGE_A(PG8_SA(0, 0), a2, 0, last);
            PG8_WAIT_V(8); PG8_WAIT_L(0); PG8_BAR; PG8_MMA(1, 0, At, B0); PG8_MMA(1, 1, At, B1); PG8_BAR; PG8_SCHED;
            PG8_LDB(B0, 1, 0); PG8_LDB(B1, 1, 1); PG8_SCHED; PG8_LDA(At, 1, 0); PG8_STAGE_A(PG8_SA(0, 1), a2, 1, last);
            PG8_WAIT_V(8); PG8_WAIT_L(0); PG8_BAR; PG8_MMA(0, 0, At, B0); PG8_MMA(0, 1, At, B1); PG8_BAR; PG8_SCHED;
            PG8_LDA(At, 1, 1); PG8_STAGE(PG8_SB(1, 0), b3, voffB); PG8_STAGE(PG8_SB(1, 1), b3 + hstep, voffB); PG8_STAGE_A(PG8_SA(1, 0), a3, 0, last);
            PG8_WAIT_V(8); PG8_WAIT_L(0); PG8_BAR; PG8_MMA(1, 0, At, B0); PG8_MMA(1, 1, At, B1); PG8_BAR; PG8_SCHED;
            } else {
            PG8_LDB(B0, 0, 0); PG8_SCHED; PG8_LDA(At, 0, 0); PG8_STAGE_A(PG8_SA(1, 1), a1, 1, false);
            PG8_WAIT_L(8); PG8_BAR; PG8_WAIT_L(0); PG8_MMA(0, 0, At, B0); PG8_BAR; PG8_SCHED;
            PG8_LDB(B1, 0, 1); PG8_STAGE(PG8_SB(0, 0), b2, voffB);
            PG8_BAR; PG8_WAIT_L(0); PG8_MMA(0, 1, At, B1); PG8_BAR;
            PG8_LDA(At, 0, 1); PG8_STAGE_A(PG8_SA(0, 0), a2, 0, last);
            PG8_BAR; PG8_WAIT_L(0); PG8_MMA(1, 0, At, B0); PG8_BAR; PG8_SCHED;
            PG8_STAGE(PG8_SB(0, 1), b2 + hstep, voffB);
            PG8_WAIT_V(6); PG8_BAR; PG8_MMA(1, 1, At, B1); PG8_BAR;
            PG8_LDB(B0, 1, 0); PG8_SCHED; PG8_LDA(At, 1, 0); PG8_STAGE_A(PG8_SA(0, 1), a2, 1, last);
            PG8_WAIT_L(8); PG8_BAR; PG8_WAIT_L(0); PG8_MMA(0, 0, At, B0); PG8_BAR; PG8_SCHED;
            PG8_LDB(B1, 1, 1); PG8_STAGE(PG8_SB(1, 0), b3, voffB);
            PG8_BAR; PG8_WAIT_L(0); PG8_MMA(0, 1, At, B1); PG8_BAR;
            PG8_LDA(At, 1, 1); PG8_STAGE_A(PG8_SA(1, 0), a3, 0, last);
            PG8_BAR; PG8_WAIT_L(0); PG8_MMA(1, 0, At, B0); PG8_BAR; PG8_SCHED;
            PG8_STAGE(PG8_SB(1, 1), b3 + hstep, voffB);
            PG8_WAIT_V(6); PG8_BAR; PG8_MMA(1, 1, At, B1); PG8_BAR;
            }
        }
        if constexpr (ALIGN_EPI) { if (wr == 0) PG8_BAR; }
        if constexpr (FP8) asm volatile("s_nop 15\n\ts_nop 7" ::: "memory");
        E(acc, cur, wr, wc, fr, fq);
        if (!has_next) break;
#pragma unroll
        for (int a = 0; a < 2; ++a)
#pragma unroll
            for (int b = 0; b < 2; ++b)
#pragma unroll
                for (int m = 0; m < 4; ++m)
#pragma unroll
                    for (int n = 0; n < 2; ++n) acc[a][b][m][n] = (f32x4){0.f, 0.f, 0.f, 0.f};
        cur = nxt; cA = nA; cB = nB; ++ui;
        if constexpr (GATHER) {
#pragma unroll
            for (int h = 0; h < 2; ++h)
#pragma unroll
                for (int i = 0; i < 2; ++i) vgA[h][i] = ngA[h][i]; }
        if constexpr (ALIGN_EPI) { if (wr == 1) PG8_BAR; }
    }
    PG8_WAIT_V(0);
    if constexpr (!ALIGN_EPI) { if (wr == 0) PG8_BAR; }
    PG8_BAR;
#undef PG8_SA
#undef PG8_SB
#undef PG8_STAGE
#undef PG8_STAGE_A
#undef PG8_LDA
#undef PG8_LDB
#undef PG8_MMA
#undef PG8_WAIT_V
#undef PG8_WAIT_L
#undef PG8_BAR
#undef PG8_SCHED
}

struct EpiBf16 {
    static constexpr bool PERM = true;
    bf16_t* O; int ldc;
    DI void operator()(const f32x4 (&acc)[2][2][4][2], const Unit& u, int wr, int wc, int fr, int fq) const {
        const int row0 = u.pm * BM + wr * 64 + fr, col0 = u.pn * BM + wc * 32 + 8 * fq;
#pragma unroll
        for (int ai = 0; ai < 2; ++ai)
#pragma unroll
            for (int m = 0; m < 4; ++m) { bf16_t* rowp = O + (size_t)(row0 + ai * HALF + m * 16) * ldc + col0;
#pragma unroll
                for (int bj = 0; bj < 2; ++bj) { const f32x4 v0 = acc[ai][bj][m][0], v1 = acc[ai][bj][m][1];
                    u32x4 w; w.x = pk2(v0[0], v0[1]); w.y = pk2(v0[2], v0[3]); w.z = pk2(v1[0], v1[1]); w.w = pk2(v1[2], v1[3]);
                    *(u32x4*)(rowp + bj * HALF) = w; } }
    }
};
struct EpiProj {
    static constexpr bool PERM = true;
    bf16_t* O; const int* pos; const float* qk_g; bf16_t* kimg; bf16_t* vimg;
    DI void operator()(const f32x4 (&acc)[2][2][4][2], const Unit& u, int wr, int wc, int fr, int fq) const {
        const int row0 = u.pm * BM + wr * 64 + fr;
        if (u.pn < 8) {
            const int col0 = u.pn * BM + wc * 32 + 8 * fq;
#pragma unroll
            for (int ai = 0; ai < 2; ++ai)
#pragma unroll
                for (int m = 0; m < 4; ++m) { bf16_t* rowp = O + (size_t)(row0 + ai * HALF + m * 16) * PS + col0;
#pragma unroll
                    for (int bj = 0; bj < 2; ++bj) { const f32x4 v0 = acc[ai][bj][m][0], v1 = acc[ai][bj][m][1];
                        u32x4 w; w.x = pk2(v0[0], v0[1]); w.y = pk2(v0[2], v0[3]); w.z = pk2(v1[0], v1[1]); w.w = pk2(v1[2], v1[3]);
                        *(u32x4*)(rowp + bj * HALF) = w; } }
        } else if (u.pn < 12) {
            const int isk = (u.pn >= 10), hsub = 4 * (u.pn & 1) + wc, h = hsub >> 1, p = hsub & 1;
            const float* gp = qk_g + isk * 64 + 8 * fq;
            const f32x4 g00 = *(const f32x4*)gp, g01 = *(const f32x4*)(gp + 4), g10 = *(const f32x4*)(gp + 32), g11 = *(const f32x4*)(gp + 36);
            const float qs = isk ? 1.f : 0.125f * 1.4426950408889634f;
            const int lane = fr + 16 * fq;
#pragma unroll
            for (int ai = 0; ai < 2; ++ai)
#pragma unroll
                for (int m = 0; m < 4; ++m) { const int row = row0 + ai * HALF + m * 16;
                    f32x4 a0 = acc[ai][0][m][0], a1 = acc[ai][0][m][1], b0 = acc[ai][1][m][0], b1 = acc[ai][1][m][1];
                    float ss = (a0[0] * a0[0] + a0[1] * a0[1] + a0[2] * a0[2] + a0[3] * a0[3]) + (a1[0] * a1[0] + a1[1] * a1[1] + a1[2] * a1[2] + a1[3] * a1[3])
                             + (b0[0] * b0[0] + b0[1] * b0[1] + b0[2] * b0[2] + b0[3] * b0[3]) + (b1[0] * b1[0] + b1[1] * b1[1] + b1[2] * b1[2] + b1[3] * b1[3]);
                    ss = xor16_sum(ss); ss = xor32_sum(ss);
                    const float rstd = rsqrtf(ss * (1.f / 64.f) + EPS);
                    a0 = a0 * rstd * g00; a1 = a1 * rstd * g01; b0 = b0 * rstd * g10 * qs; b1 = b1 * rstd * g11 * qs;
                    const float pf = (float)pos[row];
                    f32x4 r0, r1;
#pragma unroll
                    for (int n = 0; n < 2; ++n)
#pragma unroll
                        for (int j = 0; j < 4; ++j) { const int i = 4 * n + j; const float own = n ? a1[j] : a0[j]; const float oth = partner16(own, lane);
                            const float frc = __builtin_amdgcn_fractf(pf * (exp2f(-(float)i * 0.125f * 18.931568569324174f) * 0.15915494309189535f));
                            const float sn = __builtin_amdgcn_sinf(frc), cs = __builtin_amdgcn_cosf(frc);
                            const float rot = (fq == 0) ? own * cs - oth * sn : own * cs + oth * sn;
                            const float o = (fq < 2) ? rot : own;
                            if (n) r1[j] = o; else r0[j] = o; }
                    r0 = r0 * qs; r1 = r1 * qs;
                    u32x4 w0, w1;
                    w0.x = pk2(r0[0], r0[1]); w0.y = pk2(r0[2], r0[3]); w0.z = pk2(r1[0], r1[1]); w0.w = pk2(r1[2], r1[3]);
                    w1.x = pk2(b0[0], b0[1]); w1.y = pk2(b0[2], b0[3]); w1.z = pk2(b1[0], b1[1]); w1.w = pk2(b1[2], b1[3]);
                    if (!isk) { bf16_t* rowp = O + (size_t)row * PS + C_QA + h * 128 + p * 64 + 8 * fq; *(u32x4*)rowp = w0; *(u32x4*)(rowp + 32) = w1; }
                    else { const int b = row / SEQ, t = row % SEQ; bf16_t* kp = kimg + ((size_t)((b * 4 + h) * 64 + (t >> 6))) * 8192 + (p * 8 + fq) * 512 + (t & 63) * 8;
                        *(u32x4*)kp = w0; *(u32x4*)(kp + 4 * 512) = w1; } }
        } else {
#pragma unroll
            for (int ai = 0; ai < 2; ++ai)
#pragma unroll
                for (int m = 0; m < 4; ++m) { const int row = row0 + ai * HALF + m * 16, b = row / SEQ, t = row % SEQ;
#pragma unroll
                    for (int bj = 0; bj < 2; ++bj) { const int h = 2 * (u.pn - 12) + bj; const f32x4 v0 = acc[ai][bj][m][0], v1 = acc[ai][bj][m][1];
                        u32x4 w; w.x = pk2(v0[0], v0[1]); w.y = pk2(v0[2], v0[3]); w.z = pk2(v1[0], v1[1]); w.w = pk2(v1[2], v1[3]);
                        *(u32x4*)(vimg + ((size_t)((b * 4 + h) * 64 + (t >> 6))) * 8192 + (wc * 4 + ((t & 63) >> 4)) * 512 + (t & 15) * 32 + fq * 8) = w; } }
        }
    }
};
struct EpiX1 {
    static constexpr bool PERM = true;
    const float* x; const float* mod; bf16_t* x1;
    DI void operator()(const f32x4 (&acc)[2][2][4][2], const Unit& u, int wr, int wc, int fr, int fq) const {
        const int row0 = u.pm * BM + wr * 64 + fr, col0 = u.pn * BM + wc * 32 + 8 * fq;
        const int b = (u.pm * BM) / SEQ;
        const float* gp = mod + (size_t)b * 6144 + 2048 + col0;
#pragma unroll
        for (int bj = 0; bj < 2; ++bj) { const f32x4 g0 = *(const f32x4*)(gp + bj * HALF), g1 = *(const f32x4*)(gp + bj * HALF + 4);
#pragma unroll
            for (int ai = 0; ai < 2; ++ai)
#pragma unroll
                for (int m = 0; m < 4; ++m) { const size_t off = (size_t)(row0 + ai * HALF + m * 16) * DM + col0 + bj * HALF;
                    const f32x4 r0 = *(const f32x4*)(x + off) + g0 * acc[ai][bj][m][0], r1 = *(const f32x4*)(x + off + 4) + g1 * acc[ai][bj][m][1];
                    u32x4 w; w.x = pk2(r0[0], r0[1]); w.y = pk2(r0[2], r0[3]); w.z = pk2(r1[0], r1[1]); w.w = pk2(r1[2], r1[3]);
                    *(u32x4*)(x1 + off) = w; } }
    }
};
DI unsigned pk4_fp8(float a, float b, float c, float d) { int w = __builtin_amdgcn_cvt_pk_fp8_f32(a, b, 0, false); w = __builtin_amdgcn_cvt_pk_fp8_f32(c, d, w, true); return (unsigned)w; }
constexpr float W_PRESCALE = 32.f, H_PRESCALE = 8.f;
struct EpiGU {
    static constexpr bool PERM = true;
    unsigned char* H;
    DI void operator()(const f32x4 (&acc)[2][2][4][2], const Unit& u, int wr, int wc, int fr, int fq) const {
        const int row0 = u.pm * BM + wr * 64 + fr, col0 = u.pn * HALF + wc * 32 + 8 * fq;
#pragma unroll
        for (int ai = 0; ai < 2; ++ai)
#pragma unroll
            for (int m = 0; m < 4; ++m) { unsigned char* rowp = H + (size_t)(row0 + ai * HALF + m * 16) * DFF + col0;
                float hv[8];
#pragma unroll
                for (int n = 0; n < 2; ++n)
#pragma unroll
                    for (int j = 0; j < 4; ++j) { const float gg = acc[ai][0][m][n][j] * (1.f / W_PRESCALE), uu = acc[ai][1][m][n][j] * (H_PRESCALE / W_PRESCALE); hv[n * 4 + j] = gg * __builtin_amdgcn_rcpf(1.f + __builtin_amdgcn_exp2f(-1.4426950408889634f * gg)) * uu; }
                u32x2 w; w.x = pk4_fp8(hv[0], hv[1], hv[2], hv[3]); w.y = pk4_fp8(hv[4], hv[5], hv[6], hv[7]);
                *(u32x2*)rowp = w; }
    }
};
constexpr float Y_PRESCALE = 64.f;
struct EpiDown {
    static constexpr bool PERM = true;
    unsigned char* Y; const float* vals;
    DI void operator()(const f32x4 (&acc)[2][2][4][2], const Unit& u, int wr, int wc, int fr, int fq) const {
        const int row0 = u.pm * BM + wr * 64 + fr, col0 = u.pn * BM + wc * 32 + 8 * fq;
#pragma unroll
        for (int ai = 0; ai < 2; ++ai)
#pragma unroll
            for (int m = 0; m < 4; ++m) { const int row = row0 + ai * HALF + m * 16; const float s = vals[row] * (Y_PRESCALE / (W_PRESCALE * H_PRESCALE)); unsigned char* rowp = Y + (size_t)row * DM + col0;
#pragma unroll
                for (int bj = 0; bj < 2; ++bj) { const f32x4 v0 = acc[ai][bj][m][0] * s, v1 = acc[ai][bj][m][1] * s;
                    u32x2 w; w.x = pk4_fp8(v0[0], v0[1], v0[2], v0[3]); w.y = pk4_fp8(v1[0], v1[1], v1[2], v1[3]);
                    *(u32x2*)(rowp + bj * HALF) = w; } }
    }
};
}

struct Args {
    const float* x; const float* c; const int* pos; const float* norm1_g; const float* norm2_g; const float* w_ada; const float* b_ada;
    const float* w_in; const float* conv_w; const float* gate_b; const float* mnorm_g; const float* qk_g; const float* lam_p; const float* subln_g;
    const float* w_out; const float* w_router; const float* w_gate; const float* w_up; const float* w_down;
    float* out; unsigned char* ws; int ph_lo, ph_hi;
};
struct Ctx {
    LAS unsigned char* lds; int tid, lane, wave, G, bid;
};
DI Args load_args() {
    typedef __attribute__((address_space(4))) const volatile unsigned long long* kp_t;
    kp_t kp = (kp_t)__builtin_amdgcn_kernarg_segment_ptr();
#define GP(T, i) ((T*)(__attribute__((address_space(1))) T*)kp[i])
    Args a;
    a.x = GP(const float, 0); a.c = GP(const float, 1); a.pos = GP(const int, 2); a.norm1_g = GP(const float, 3); a.norm2_g = GP(const float, 4);
    a.w_ada = GP(const float, 5); a.b_ada = GP(const float, 6); a.w_in = GP(const float, 7); a.conv_w = GP(const float, 8); a.gate_b = GP(const float, 9);
    a.mnorm_g = GP(const float, 10); a.qk_g = GP(const float, 11); a.lam_p = GP(const float, 12); a.subln_g = GP(const float, 13); a.w_out = GP(const float, 14);
    a.w_router = GP(const float, 15); a.w_gate = GP(const float, 16); a.w_up = GP(const float, 17); a.w_down = GP(const float, 18);
    a.out = GP(float, 19); a.ws = GP(unsigned char, 20);
#undef GP
    a.ph_lo = 0; a.ph_hi = 12;
    return a;
}

DI void tr_item64(const float* src, size_t ld_src, int k0, int c0, bf16_t* dst, size_t r0, int ld_dst, LAS float* scr  , int lane, size_t r1 = (size_t)-1) {
    const float* sp = src + (size_t)(k0 + (lane >> 4)) * ld_src + c0 + (lane & 15) * 4;
#pragma unroll 1
    for (int hf = 0; hf < 2; ++hf) {
        f32x4 v[8];
#pragma unroll
        for (int i = 0; i < 8; ++i) v[i] = *(const f32x4*)(sp + (size_t)(4 * (8 * hf + i)) * ld_src);
#pragma unroll
        for (int i = 0; i < 8; ++i) *(LAS f32x4*)(scr + (4 * (8 * hf + i) + (lane >> 4)) * 68 + (lane & 15) * 4) = v[i];
    }
    asm volatile("s_waitcnt lgkmcnt(0)" ::: "memory");
    const int c = lane & 7;
#pragma unroll
    for (int q = 0; q < 8; ++q) { const int n = 8 * q + (lane >> 3); const LAS float* s = scr + (8 * c) * 68 + n;
        u32x4 o; o.x = pk2(s[0 * 68], s[1 * 68]); o.y = pk2(s[2 * 68], s[3 * 68]); o.z = pk2(s[4 * 68], s[5 * 68]); o.w = pk2(s[6 * 68], s[7 * 68]);
        const size_t row = (r1 != (size_t)-1 && q >= 4) ? r1 + (n - 32) : r0 + n;
        *(u32x4*)(dst + row * ld_dst + k0 + 8 * c) = o; }
    asm volatile("s_waitcnt lgkmcnt(0)" ::: "memory");
}
DI void tr_item64_fp8(const float* src, size_t ld_src, int k0, int c0, unsigned char* dst, size_t r0, int ld_dst, float scale, LAS float* scr  , int lane) {
    const float* sp = src + (size_t)(k0 + (lane >> 4)) * ld_src + c0 + (lane & 15) * 4;
    {
        f32x4 v[16];
#pragma unroll
        for (int i = 0; i < 16; ++i) v[i] = __builtin_nontemporal_load((const f32x4*)(sp + (size_t)(4 * i) * ld_src));
#pragma unroll
        for (int i = 0; i < 16; ++i) *(LAS f32x4*)(scr + (4 * i + (lane >> 4)) * 68 + (lane & 15) * 4) = v[i] * scale;
    }
    asm volatile("s_waitcnt lgkmcnt(0)" ::: "memory");
    const int c = lane & 3;
#pragma unroll
    for (int q = 0; q < 4; ++q) { const int n = 16 * q + (lane >> 2); const LAS float* s = scr + (16 * c) * 68 + n;
        u32x4 o; o.x = pg8::pk4_fp8(s[0 * 68], s[1 * 68], s[2 * 68], s[3 * 68]); o.y = pg8::pk4_fp8(s[4 * 68], s[5 * 68], s[6 * 68], s[7 * 68]);
        o.z = pg8::pk4_fp8(s[8 * 68], s[9 * 68], s[10 * 68], s[11 * 68]); o.w = pg8::pk4_fp8(s[12 * 68], s[13 * 68], s[14 * 68], s[15 * 68]);
        *(u32x4*)(dst + (r0 + n) * ld_dst + k0 + 16 * c) = o; }
    asm volatile("s_waitcnt lgkmcnt(0)" ::: "memory");
}
DI void p0_phase(const Ctx& F, const Args& a) {
    if (F.bid < 96) {
        LAS float* sc = (LAS float*)F.lds; LAS float* part = (LAS float*)(F.lds + 32768);
        for (int i = F.tid; i < BATCH * DM; i += NTHR) sc[i] = silu_f(a.c[i]);
        __syncthreads();
        const int col = F.bid * 64 + F.lane;
        float acc[8];
#pragma unroll
        for (int b = 0; b < 8; ++b) acc[b] = 0.f;
        const int kb = F.wave * 128;
#pragma unroll 1
        for (int k0 = kb; k0 < kb + 128; k0 += 16) {
            float w[16];
            const float* wp = a.w_ada + (size_t)k0 * 6144 + col;
#pragma unroll
            for (int j = 0; j < 16; ++j) w[j] = wp[(size_t)j * 6144];
#pragma unroll
            for (int j = 0; j < 16; ++j)
#pragma unroll
                for (int b = 0; b < 8; ++b) acc[b] += sc[b * DM + k0 + j] * w[j];
        }
#pragma unroll
        for (int b = 0; b < 8; ++b) part[(F.wave * 8 + b) * 64 + F.lane] = acc[b];
        __syncthreads();
        { const int b = F.tid >> 6, l = F.tid & 63; float s = a.b_ada[F.bid * 64 + l];
#pragma unroll
          for (int w = 0; w < 8; ++w) s += part[(w * 8 + b) * 64 + l];
          ((float*)(a.ws + WS_MOD))[b * 6144 + F.bid * 64 + l] = s; }
        asm volatile("s_waitcnt vmcnt(0)" ::: "memory");
        __syncthreads();
        if (F.tid == 0) { __builtin_amdgcn_fence(__ATOMIC_RELEASE, "agent"); asm volatile("s_waitcnt vmcnt(0)" ::: "memory");
            __hip_atomic_fetch_add((unsigned*)(a.ws + WS_CTL) + 4096, 1u, __ATOMIC_RELAXED, __HIP_MEMORY_SCOPE_AGENT); }
    }
    LAS float* scr = (LAS float*)(F.lds + F.wave * 17408);
    const int gw = F.bid * NWAVES + F.wave, NGW = F.G * NWAVES;
    constexpr int I_IN = 16 * 56, I_OUT = 16 * 16, I_WG = 16, I_EX = 4096;
    constexpr int NITEMS = I_IN + I_OUT + I_EX + I_WG;
    bf16_t* WinT = (bf16_t*)(a.ws + WS_WINT); bf16_t* WgT = (bf16_t*)(a.ws + WS_WGT); bf16_t* WoutT = (bf16_t*)(a.ws + WS_WOUTT);
    for (int it = gw; it < NITEMS; it += NGW) {
        int r = it;
        if (r < I_IN) { const int kb = r / 56, nb = r % 56, n0 = nb * 64;
            if (n0 >= 2048 && n0 < 3072) { const int t0 = n0 & ~255, g = (n0 >> 6) & 3; tr_item64(a.w_in, DIN, kb * 64, n0 + 16, WinT, (size_t)(t0 + 32 * g), DM, scr, F.lane, (size_t)(t0 + 128 + 32 * g)); }
            else tr_item64(a.w_in, DIN, kb * 64, n0 + (n0 >= 2048 ? 16 : 0), WinT, n0, DM, scr, F.lane);
            continue; } r -= I_IN;
        if (r < I_OUT) { const int kb = r / 16, nb = r % 16; tr_item64(a.w_out, DM, kb * 64, nb * 64, WoutT, nb * 64, DM, scr, F.lane); continue; } r -= I_OUT;
        if (r < I_EX) { int e, mat, q;
            if (r < 1024) { e = 13; mat = 1 + (r >> 9); q = r & 511; } else { const int t = r - 1024; e = 14 + t / 1536; const int u = t % 1536; mat = u >> 9; q = u & 511; }
            if (mat < 2) { const int kb = q / 32, nb = q % 32, n0 = nb * 64; const float* src = (mat ? a.w_up : a.w_gate) + (size_t)e * DM * DFF;
                tr_item64_fp8(src, DFF, kb * 64, n0, a.ws + WS_WGUT + (size_t)e * 4096 * DM, (size_t)(n0 / 128) * 256 + (n0 % 128) + mat * 128, DM, pg8::W_PRESCALE, scr, F.lane); }
            else { const int kb = q / 16, nb = q % 16;
                tr_item64_fp8(a.w_down + (size_t)e * DFF * DM, DM, kb * 64, nb * 64, a.ws + WS_WDT + (size_t)e * DM * DFF, nb * 64, DFF, pg8::W_PRESCALE, scr, F.lane); }
            continue; } r -= I_EX;
        tr_item64(a.w_in, DIN, r * 64, 2048 - 48, WgT, 0, DM, scr, F.lane);
    }
    if (F.tid == 0) { unsigned* cnt = (unsigned*)(a.ws + WS_CTL) + 4096; unsigned sp = 0;
        while (__hip_atomic_load(cnt, __ATOMIC_RELAXED, __HIP_MEMORY_SCOPE_AGENT) < 96u && ++sp < (1u << 22)) __builtin_amdgcn_s_sleep(2);
        __builtin_amdgcn_fence(__ATOMIC_ACQUIRE, "agent"); asm volatile("s_waitcnt vmcnt(0)" ::: "memory"); }
    __syncthreads();
}

DI void p1_phase(const Ctx& F, const Args& a) {
    const int gw = F.bid * NWAVES + F.wave, NGW = F.G * NWAVES;
    const float* mod = (const float*)(a.ws + WS_MOD);
    bf16_t* H1 = (bf16_t*)a.out;
    for (int m0 = gw; m0 < MTOK; m0 += 2 * NGW) {
        const int m1 = m0 + NGW; const bool has1 = m1 < MTOK;
        const f32x4* xr0 = (const f32x4*)(a.x + (size_t)m0 * DM) + F.lane; const f32x4* xr1 = (const f32x4*)(a.x + (size_t)(has1 ? m1 : m0) * DM) + F.lane;
        f32x4 v0[4], v1[4]; float s0 = 0.f, s1 = 0.f;
#pragma unroll
        for (int j = 0; j < 4; ++j) { v0[j] = __builtin_nontemporal_load(xr0 + 64 * j); v1[j] = __builtin_nontemporal_load(xr1 + 64 * j); }
#pragma unroll
        for (int j = 0; j < 4; ++j) { s0 += (v0[j].x * v0[j].x + v0[j].y * v0[j].y) + (v0[j].z * v0[j].z + v0[j].w * v0[j].w); s1 += (v1[j].x * v1[j].x + v1[j].y * v1[j].y) + (v1[j].z * v1[j].z + v1[j].w * v1[j].w); }
#pragma unroll
        for (int o = 1; o < 64; o <<= 1) { s0 += __shfl_xor(s0, o); s1 += __shfl_xor(s1, o); }
        const float rstd0 = rsqrtf(s0 * (1.f / DM) + EPS), rstd1 = rsqrtf(s1 * (1.f / DM) + EPS);
        const int b0 = m0 / SEQ, b1 = (has1 ? m1 : m0) / SEQ;
        u32x2* o0 = (u32x2*)(H1 + (size_t)m0 * DM) + F.lane; u32x2* o1 = (u32x2*)(H1 + (size_t)m1 * DM) + F.lane;
#pragma unroll
        for (int j = 0; j < 4; ++j) {
            const f32x4 g = ((const f32x4*)a.norm1_g)[F.lane + 64 * j];
            { const f32x4 sh = ((const f32x4*)(mod + (size_t)b0 * 6144))[F.lane + 64 * j], sc = ((const f32x4*)(mod + (size_t)b0 * 6144 + 1024))[F.lane + 64 * j];
              const f32x4 h = v0[j] * rstd0 * g * (sc + 1.f) + sh; u32x2 w; w.x = pk2(h.x, h.y); w.y = pk2(h.z, h.w); o0[64 * j] = w; }
            if (has1) { const f32x4 sh = ((const f32x4*)(mod + (size_t)b1 * 6144))[F.lane + 64 * j], sc = ((const f32x4*)(mod + (size_t)b1 * 6144 + 1024))[F.lane + 64 * j];
              const f32x4 h = v1[j] * rstd1 * g * (sc + 1.f) + sh; u32x2 w; w.x = pk2(h.x, h.y); w.y = pk2(h.z, h.w); o1[64 * j] = w; }
        }
    }
}

DI void gates_tasks(const Ctx& F, const Args& a) {
    const int gw = F.bid * NWAVES + F.wave, NGW = F.G * NWAVES;
    const bf16_t* H1 = (const bf16_t*)a.out; const bf16_t* WgT = (const bf16_t*)(a.ws + WS_WGT) + 48 * DM; float* GT = (float*)(a.ws + WS_GATES);
    const float bias = a.gate_b[F.lane & 15];
    for (int task = gw; task < MTOK / 16; task += NGW) {
        const int row0 = task * 16;
        const bf16_t* ap = H1 + (size_t)(row0 + (F.lane & 15)) * DM + 8 * (F.lane >> 4);
        const bf16_t* bp = WgT + (size_t)(F.lane & 15) * DM + 8 * (F.lane >> 4);
        f32x4 acc = {0.f, 0.f, 0.f, 0.f};
        bf16x8 avs[32];
#pragma unroll
        for (int i = 0; i < 32; ++i) avs[i] = *(const bf16x8*)(ap + 32 * i);
#pragma unroll
        for (int i = 0; i < 32; ++i) { const bf16x8 bv = *(const bf16x8*)(bp + 32 * i); acc = __builtin_amdgcn_mfma_f32_16x16x32_bf16(avs[i], bv, acc, 0, 0, 0); }
#pragma unroll
        for (int r = 0; r < 4; ++r) GT[(size_t)(row0 + (F.lane >> 4) * 4 + r) * 16 + (F.lane & 15)] = acc[r] + bias;
    }
}

DI void qk_tile_task(const Ctx& F, const Args& a, int task) {
    const int b = task >> 6, tile = task & 63, r = F.lane, g = F.wave, h = g >> 1, p = g & 1;
    bf16_t* PROJ = (bf16_t*)(a.ws + WS_PROJ);
    const size_t tok = (size_t)b * SEQ + tile * 64 + r;
    float invf[8];
#pragma unroll
    for (int i = 0; i < 8; ++i) invf[i] = exp2f(-(float)i * 0.125f * 18.931568569324174f) * 0.15915494309189535f;
    const float pos = (float)a.pos[tok];
    float sn[8], cs[8];
#pragma unroll
    for (int i = 0; i < 8; ++i) { const float fr = __builtin_amdgcn_fractf(pos * invf[i]); sn[i] = __builtin_amdgcn_sinf(fr); cs[i] = __builtin_amdgcn_cosf(fr); }
#pragma unroll 1
    for (int isk = 0; isk < 2; ++isk) {
        u32x4* src = (u32x4*)(PROJ + tok * PS + (isk ? C_KA : C_QA) + g * 64);
        u32x4 w[8];
#pragma unroll
        for (int c = 0; c < 8; ++c) w[c] = src[c];
        float ss = 0.f;
#pragma unroll
        for (int c = 0; c < 8; ++c) { float t;
            t = bflo(w[c].x); ss += t * t; t = bfhi(w[c].x); ss += t * t; t = bflo(w[c].y); ss += t * t; t = bfhi(w[c].y); ss += t * t;
            t = bflo(w[c].z); ss += t * t; t = bfhi(w[c].z); ss += t * t; t = bflo(w[c].w); ss += t * t; t = bfhi(w[c].w); ss += t * t; }
        const float rstd = rsqrtf(ss * (1.f / 64.f) + EPS) * (isk ? 1.f : 0.125f * 1.4426950408889634f);
        const float* gp = a.qk_g + isk * 64;
        float v0[16];
        v0[0] = bflo(w[0].x); v0[1] = bfhi(w[0].x); v0[2] = bflo(w[0].y); v0[3] = bfhi(w[0].y); v0[4] = bflo(w[0].z); v0[5] = bfhi(w[0].z); v0[6] = bflo(w[0].w); v0[7] = bfhi(w[0].w);
        v0[8] = bflo(w[1].x); v0[9] = bfhi(w[1].x); v0[10] = bflo(w[1].y); v0[11] = bfhi(w[1].y); v0[12] = bflo(w[1].z); v0[13] = bfhi(w[1].z); v0[14] = bflo(w[1].w); v0[15] = bfhi(w[1].w);
#pragma unroll
        for (int i = 0; i < 16; ++i) v0[i] *= rstd * gp[i];
        float rr[16];
#pragma unroll
        for (int i = 0; i < 8; ++i) { rr[i] = v0[i] * cs[i] - v0[i + 8] * sn[i]; rr[i + 8] = v0[i + 8] * cs[i] + v0[i] * sn[i]; }
        u32x4 o[8];
        o[0].x = pk2(rr[0], rr[1]); o[0].y = pk2(rr[2], rr[3]); o[0].z = pk2(rr[4], rr[5]); o[0].w = pk2(rr[6], rr[7]);
        o[1].x = pk2(rr[8], rr[9]); o[1].y = pk2(rr[10], rr[11]); o[1].z = pk2(rr[12], rr[13]); o[1].w = pk2(rr[14], rr[15]);
#pragma unroll
        for (int c = 2; c < 8; ++c) { const f32x4 g0 = *(const f32x4*)(gp + c * 8), g1 = *(const f32x4*)(gp + c * 8 + 4);
            o[c].x = pk2(bflo(w[c].x) * rstd * g0.x, bfhi(w[c].x) * rstd * g0.y); o[c].y = pk2(bflo(w[c].y) * rstd * g0.z, bfhi(w[c].y) * rstd * g0.w);
            o[c].z = pk2(bflo(w[c].z) * rstd * g1.x, bfhi(w[c].z) * rstd * g1.y); o[c].w = pk2(bflo(w[c].w) * rstd * g1.z, bfhi(w[c].w) * rstd * g1.w); }
        if (isk == 0) {
#pragma unroll
            for (int c = 0; c < 8; ++c) src[c] = o[c];
        } else {
            u32x4* dst = (u32x4*)((bf16_t*)(a.ws + WS_KIMG) + ((size_t)((b * 4 + h) * 64 + tile)) * 8192) + r;
#pragma unroll
            for (int c = 0; c < 8; ++c) dst[(p * 8 + c) * 64] = o[c];
        }
    }
    {
        u32x4* dst = (u32x4*)((bf16_t*)(a.ws + WS_VIMG) + ((size_t)((b * 4 + h) * 64 + tile)) * 8192) + r;
#pragma unroll
        for (int cg = 2 * p; cg < 2 * p + 2; ++cg)
#pragma unroll
            for (int kg = 0; kg < 4; ++kg) {
                const u32x4 v = *(const u32x4*)(PROJ + ((size_t)b * SEQ + tile * 64 + 16 * kg + (r >> 2)) * PS + C_VA + h * 128 + 32 * cg + 8 * (r & 3));
                dst[(cg * 4 + kg) * 64] = v; }
    }
}

DI bf16x8 tr_frag_nat(const LAS unsigned char* img, int rowbase, int col0, int lane) {
    const int hh = lane >> 5, g16 = (lane >> 4) & 1, i = lane & 15;
    const int col = col0 + 16 * g16 + 4 * (i & 3), chunk = col >> 3, sub = (col & 7) * 2;
    const int r0 = rowbase + 8 * hh + (i >> 2), r1 = r0 + 4;
    const s16x4 lo = trread(img + r0 * 256 + ((chunk ^ swz16(r0)) << 4) + sub);
    const s16x4 hi = trread(img + r1 * 256 + ((chunk ^ swz16(r1)) << 4) + sub);
    return __builtin_shufflevector(lo, hi, 0, 1, 2, 3, 4, 5, 6, 7);
}
DI bf16x8 tr_frag_acc(const LAS unsigned char* img, int rowbase, int col0, int lane) {
    const int hh = lane >> 5, g16 = (lane >> 4) & 1, i = lane & 15;
    const int col = col0 + 16 * g16 + 4 * (i & 3), chunk = col >> 3, sub = (col & 7) * 2;
    const int r0 = rowbase + 4 * hh + (i >> 2), r1 = r0 + 8;
    const s16x4 lo = trread(img + r0 * 256 + ((chunk ^ swz16(r0)) << 4) + sub);
    const s16x4 hi = trread(img + r1 * 256 + ((chunk ^ swz16(r1)) << 4) + sub);
    return __builtin_shufflevector(lo, hi, 0, 1, 2, 3, 4, 5, 6, 7);
}
DI bf16x8 row_frag(const LAS unsigned char* img, int row, int chunk) { return *(const LAS bf16x8*)(img + row * 256 + ((chunk ^ swz16(row)) << 4)); }

DI void glds16_asm(const void* gsrc, unsigned lds_dst) { unsigned keep;
    asm volatile("s_mov_b32 %0, m0\n\ts_mov_b32 m0, %2\n\ts_nop 0\n\tglobal_load_lds_dwordx4 %1, off\n\ts_mov_b32 m0, %0" : "=&s"(keep) : "v"(gsrc), "s"(lds_dst) : "memory"); }
constexpr size_t DO_QC = 0, DO_KC = 32 * MiB, DO_HD = 64 * MiB;
constexpr size_t WS_SC = 7 * MiB;

DI void conv_load(const Args& a, int tw, int lane, u32x4 (&row)[12]) {
    const int isk = tw & 1, tok0 = (tw >> 1) * 8, b = tok0 / SEQ, t0 = tok0 % SEQ;
    const bf16_t* src = (const bf16_t*)(a.ws + WS_PROJ) + (size_t)b * SEQ * PS + (isk ? C_KM : C_QM) + lane * 8;
#pragma unroll
    for (int r = 0; r < 12; ++r) { const int t = t0 + r - 2; row[r] = (u32x4){0u, 0u, 0u, 0u}; if (t >= 0 && t < SEQ) row[r] = *(const u32x4*)(src + (size_t)t * PS); }
}
DI void conv_compute(const Args& a, int tw, int lane, const u32x4 (&row)[12], const float (&cw)[5][8]) {
    const int isk = tw & 1, tok0 = (tw >> 1) * 8, b = tok0 / SEQ, t0 = tok0 % SEQ;
    const int hd = lane >> 4, cc = lane & 15, cch = t0 >> 6, r0 = t0 & 63;
    bf16_t* tileb = (bf16_t*)((unsigned char*)a.out + (isk ? DO_KC : DO_QC)) + ((size_t)((b * 4 + hd) * 64 + cch)) * 8192;
    bf16_t* dst = isk ? tileb + ((cc >> 2) * 4 + (r0 >> 4)) * 512 + (r0 & 15) * 32 + (cc & 3) * 8 : tileb + cc * 512 + r0 * 8;
    const int dstride = isk ? 32 : 8;
    const float sc = isk ? 0.08838834764831845f : 1.f;
#pragma unroll
    for (int i = 0; i < 8; ++i) {
        float acc[8];
#pragma unroll
        for (int e = 0; e < 8; ++e) acc[e] = 0.f;
#pragma unroll
        for (int j = 0; j < 5; ++j) { const u32x4 w = row[i + j];
            acc[0] += bflo(w.x) * cw[j][0]; acc[1] += bfhi(w.x) * cw[j][1]; acc[2] += bflo(w.y) * cw[j][2]; acc[3] += bfhi(w.y) * cw[j][3];
            acc[4] += bflo(w.z) * cw[j][4]; acc[5] += bfhi(w.z) * cw[j][5]; acc[6] += bflo(w.w) * cw[j][6]; acc[7] += bfhi(w.w) * cw[j][7]; }
#pragma unroll
        for (int e = 0; e < 8; ++e) acc[e] = silu_f(acc[e]) * sc;
        u32x4 o; o.x = pk2(acc[0], acc[1]); o.y = pk2(acc[2], acc[3]); o.z = pk2(acc[4], acc[5]); o.w = pk2(acc[6], acc[7]);
        *(u32x4*)(dst + i * dstride) = o;
    }
}
DI void conv_phase(const Ctx& F, const Args& a) {
    const int lane = F.lane, NT = MTOK / 8 * 2, st = F.G * NWAVES;
    int t = F.bid * NWAVES + F.wave;
    if (t >= NT) return;
    const int isk = t & 1;
    float cw[5][8];
#pragma unroll
    for (int j = 0; j < 5; ++j) { const f32x4 c0 = *(const f32x4*)(a.conv_w + j * 1024 + isk * 512 + lane * 8), c1 = *(const f32x4*)(a.conv_w + j * 1024 + isk * 512 + lane * 8 + 4);
        cw[j][0] = c0.x; cw[j][1] = c0.y; cw[j][2] = c0.z; cw[j][3] = c0.w; cw[j][4] = c1.x; cw[j][5] = c1.y; cw[j][6] = c1.z; cw[j][7] = c1.w; }
    u32x4 rowA[12], rowB[12];
    conv_load(a, t, lane, rowA);
#pragma unroll 1
    for (;;) {
        const int tn = t + st;
        if (tn < NT) conv_load(a, tn, lane, rowB);
        conv_compute(a, t, lane, rowA, cw);
        if (tn >= NT) break;
        t = tn + st;
        if (t < NT) conv_load(a, t, lane, rowA);
        conv_compute(a, tn, lane, rowB, cw);
        if (t >= NT) break;
    }
}

DI void mscal_task(const Ctx& F, const Args& a, int chain) {
    const int b = chain >> 3, h = (chain >> 1) & 3, dir = chain & 1;
    const int s = dir ? 63 - F.lane : F.lane;
    const float* GT = (const float*)(a.ws + WS_GATES) + (size_t)b * SEQ * 16;
    float* SC = (float*)(a.ws + WS_SC) + (size_t)chain * 64 * 256; float* MSC = (float*)(a.ws + WS_MSC);
    LAS float* gl = (LAS float*)F.lds; LAS float* mll = gl + 64;
    float aa[8], ii[8];
#pragma unroll
    for (int i = 0; i < 8; ++i) { const int c = F.wave + 8 * i;
        const float ig = GT[(size_t)(c * 64 + s) * 16 + dir * 8 + h], fg = GT[(size_t)(c * 64 + s) * 16 + dir * 8 + 4 + h];
        const float av = wave_prefix_sum(logsigmoid_f(fg));
        aa[i] = av; ii[i] = ig;
        const float g = __builtin_bit_cast(float, __builtin_amdgcn_readlane(__builtin_bit_cast(int, av), 63)), ml = wave_max(g - av + ig);
        if (F.lane == 0) { gl[c] = g; mll[c] = ml; } }
    __syncthreads();
    float mnew_l, mprev_l;
    { const int cst = dir ? 63 - F.lane : F.lane;
      float A = gl[cst], B = mll[cst];
#pragma unroll
      for (int o = 1; o < 64; o <<= 1) { const float Ap = __shfl_up(A, o), Bp = __shfl_up(B, o); if (F.lane >= o) { B = fmaxf(Bp + A, B); A = Ap + A; } }
      mnew_l = fmaxf(A, B); mprev_l = __shfl_up(mnew_l, 1); if (F.lane == 0) mprev_l = 0.f; }
#pragma unroll
    for (int i = 0; i < 8; ++i) { const int c = F.wave + 8 * i; const int stc = dir ? 63 - c : c; const float mprev = __shfl(mprev_l, stc), mnew = __shfl(mnew_l, stc), g = gl[c];
        const float cterm = ii[i] - aa[i];
        const float cm = wave_prefix_max(cterm);
        const float il = aa[i] + mprev, mj = fmaxf(il, aa[i] + cm);
        float* o4 = SC + (size_t)c * 256 + s;
        o4[0] = (aa[i] - mj) * 1.4426950408889634f; o4[64] = cterm * 1.4426950408889634f; o4[128] = __expf(il - mj); o4[192] = __expf(-mj);
        if (F.lane == 0) { MSC[chain * 64 + c] = (g - mnew) * 1.4426950408889634f; MSC[4096 + chain * 64 + c] = __expf(g + mprev - mnew); } }
    __syncthreads();
}

DI const float* wsel3(int m, const float* p0, const float* p1, const float* p2) {
    const unsigned long long a0 = (unsigned long long)p0, a1 = (unsigned long long)p1, a2 = (unsigned long long)p2;
    const unsigned long long m1 = (unsigned long long)0 - (unsigned long long)(m == 1), m2 = (unsigned long long)0 - (unsigned long long)(m == 2);
    return (const float*)((a0 & ~(m1 | m2)) | (a1 & m1) | (a2 & m2));
}
DI void mseq_item(const Ctx& F, const Args& a, int item, int bh, int dir, int vs) {
    const int b = bh >> 2, h = bh & 3, chain = bh * 2 + dir, wid = F.wave, tid = F.tid, lane = F.lane, r32 = lane & 31, hh = lane >> 5;
    LAS unsigned char* QS = F.lds;
    LAS unsigned char* KS = F.lds + 32768;
    LAS unsigned char* VS = F.lds + 65536;
    LAS unsigned char* SCS = F.lds + 77824;
    LAS unsigned char* SD = F.lds + 80896;
    LAS unsigned char* CI = F.lds + 97280;
    LAS float* NV = (LAS float*)(F.lds + 113664);
    LAS float* gmv = NV + 256; LAS float* spv = gmv + 64;
    LAS unsigned char* HST = F.lds + 115712;
    const int cwi = wid < 4 ? wid : 4;
    const bool cwave = wid < 4;
    const unsigned cscb = (unsigned)(uintptr_t)F.lds + 119808u + (unsigned)cwi * 8192u;
    const unsigned xscb = (unsigned)(uintptr_t)F.lds + 119808u + 4u * 8192u;
    const int cslot0 = (item * 5 + cwi) * 64;
    const int xslot0 = (item * 5 + 4) * 64;
    const float* const wg_ = a.w_gate; const float* const wu_ = a.w_up; const float* const wd_ = a.w_down;
    const bf16_t* QC = (const bf16_t*)((const unsigned char*)a.out + DO_QC) + (size_t)bh * 64 * 8192 + lane * 8;
    const bf16_t* KC = (const bf16_t*)((const unsigned char*)a.out + DO_KC) + (size_t)bh * 64 * 8192 + lane * 8;
    const bf16_t* VP = (const bf16_t*)(a.ws + WS_PROJ) + (size_t)b * SEQ * PS + C_VM + h * 128 + vs * 32 + (size_t)(16 * (wid & 3) + (lane >> 2)) * PS + 8 * (lane & 3);
    const float* SC = (const float*)(a.ws + WS_SC) + (size_t)chain * 64 * 256 + lane * 4;
    bf16_t* HD = (bf16_t*)((unsigned char*)a.out + DO_HD) + ((size_t)dir * MTOK + (size_t)b * SEQ) * 512 + h * 128 + vs * 32;
    if (tid < 64) { gmv[tid] = ((const float*)(a.ws + WS_MSC))[chain * 64 + tid]; spv[tid] = ((const float*)(a.ws + WS_MSC))[4096 + chain * 64 + tid]; }
    if (tid < 256) NV[tid] = 0.f;
    for (int i = tid; i < 4096; i += NTHR) ((LAS unsigned*)CI)[i] = 0u;
    const unsigned ldsb = (unsigned)(uintptr_t)F.lds;
#define MSEQ_ISSUE_QK(c, s2) do { const size_t _tb = (size_t)(c); \
        if (wid < 4) { _Pragma("unroll") for (int _i = 0; _i < 4; ++_i) \
                glds16_asm(QC + _tb * 8192 + (4 * wid + _i) * 512, (unsigned)__builtin_amdgcn_readfirstlane((int)(ldsb + (s2) * 16384 + (4 * wid + _i) * 1024))); } \
        else if (wid >= 6) { _Pragma("unroll") for (int _i = 0; _i < 8; ++_i) \
                glds16_asm(KC + _tb * 8192 + (8 * (wid - 6) + _i) * 512, (unsigned)__builtin_amdgcn_readfirstlane((int)(ldsb + 32768 + (s2) * 16384 + (8 * (wid - 6) + _i) * 1024))); } } while (0)
#define MSEQ_ISSUE_VS(c, s4) do { const size_t _tb = (size_t)(c); \
        if (wid < 4) glds16_asm(VP + _tb * 64 * PS, (unsigned)__builtin_amdgcn_readfirstlane((int)(ldsb + 65536 + (s4) * 4096 + wid * 1024))); \
        else if (wid == 6) glds16_asm(SC + _tb * 256, (unsigned)__builtin_amdgcn_readfirstlane((int)(ldsb + 77824 + (s4) * 1024))); } while (0)
    MSEQ_ISSUE_QK(dir ? 63 : 0, 0); MSEQ_ISSUE_VS(dir ? 63 : 0, 0);
#define MSEQ_CONV_ISSUE(id, bufb) do { const int _e = (id) / 6144, _r = (id) % 6144, _mat = _r >> 11, _rr = _r & 2047; \
        const int _N = _mat == 2 ? DM : DFF, _nb = _mat == 2 ? (_rr >> 7) : (_rr >> 6), _kb = _mat == 2 ? (_rr & 127) : (_rr & 63); \
        const float* _src = wsel3(_mat, wg_, wu_, wd_) + (size_t)_e * DM * DFF + (size_t)(16 * _kb + (lane >> 4)) * _N + 64 * _nb + 4 * (lane & 15); \
        _Pragma("unroll") for (int _i = 0; _i < 4; ++_i) glds16_asm(_src + (size_t)(4 * _i) * _N, (unsigned)__builtin_amdgcn_readfirstlane((int)((bufb) + ((id) & 1) * 4096 + _i * 1024))); } while (0)
    if (cwave) MSEQ_CONV_ISSUE(cslot0, cscb);
    if (wid == 0) MSEQ_CONV_ISSUE(xslot0, xscb);
    f32x16 Cacc[2];
#pragma unroll
    for (int i = 0; i < 16; ++i) { Cacc[0][i] = 0.f; Cacc[1][i] = 0.f; }
    const int qrd = hh * 1024 + r32 * 16;
    const int ktr = (8 * hh + ((lane & 15) >> 2)) * 64 + ((lane >> 4) & 1) * 32 + (lane & 3) * 8;
    f32x16& acc = Cacc[1];
    float qn = 0.f;
#pragma unroll
    for (int i = 0; i < 16; ++i) acc[i] = 0.f;
    asm volatile("s_waitcnt vmcnt(0)" ::: "memory");
    __syncthreads();
    unsigned long long busy = 0, tb0 = 0; if (PROBE_MSEQ_W >= 0) tb0 = __builtin_amdgcn_s_memtime(); const unsigned long long titem0 = tb0;
#pragma unroll 1
    for (int st = 0; st <= 64; ++st) {
        const int c = dir ? 63 - st : st, s2 = st & 1; const int s3 = st % 3, s3p = (st + 2) % 3;
        if (st + 1 < 64) { MSEQ_ISSUE_QK(dir ? 62 - st : st + 1, s2 ^ 1); MSEQ_ISSUE_VS(dir ? 62 - st : st + 1, (st + 1) % 3);
            if (cwave) { MSEQ_CONV_ISSUE(cslot0 + st + 1, cscb); if (((st + 1) & 3) == wid) MSEQ_CONV_ISSUE(xslot0 + st + 1, xscb); } }
        const LAS unsigned char* QT = QS + s2 * 16384; const LAS unsigned char* KT = KS + s2 * 16384; const LAS unsigned char* VT = VS + s3 * 4096;
        const LAS float* rt = (const LAS float*)(SCS + s3 * 1024); const LAS float* ct = rt + 64;
        if (wid < 4) {
            if (st < 64) {
                const int jt = wid >> 1, stt = wid & 1;
                const LAS unsigned char* qa = QT + qrd + jt * 512;
                const LAS unsigned char* kb = KT + (2 * stt + (r32 >> 4)) * 1024 + (r32 & 15) * 64 + hh * 16;
                const int j = 32 * jt + r32; const float rtj = rt[j];
                const LAS float* ctp = ct + 32 * stt + 4 * hh;
                f32x4 c4[4];
#pragma unroll
                for (int rg = 0; rg < 4; ++rg) c4[rg] = *(const LAS f32x4*)(ctp + 8 * rg);
                const float gm = gmv[c], sp = spv[c];
                const int ck = 4 * wid + (lane & 3), r0 = 4 * (lane >> 2);
                const LAS unsigned char* kr = KT + (ck >> 2) * 4096 + (r0 >> 4) * 1024 + (r0 & 15) * 64 + (ck & 3) * 16;
                u32x4 kw[4];
#pragma unroll
                for (int r = 0; r < 4; ++r) kw[r] = *(const LAS u32x4*)(kr + r * 64);
                const f32x4 ctn = *(const LAS f32x4*)(ct + r0);
                const LAS float* no = NV + s2 * 128 + 32 * wid + 8 * (lane & 3);
                const f32x4 o0 = *(const LAS f32x4*)no, o1 = *(const LAS f32x4*)(no + 4);
                f32x16 S;
                f32x16 S2;
#pragma unroll
                for (int i = 0; i < 16; ++i) { S[i] = 0.f; S2[i] = 0.f; }
#pragma unroll
                for (int ks = 0; ks < 8; ks += 2) { S = MFMA32(*(const LAS bf16x8*)(kb + (ks >> 1) * 4096), *(const LAS bf16x8*)(qa + ks * 2048), S);
                    S2 = MFMA32(*(const LAS bf16x8*)(kb + (ks >> 1) * 4096 + 32), *(const LAS bf16x8*)(qa + (ks + 1) * 2048), S2); }
#pragma unroll
                for (int i = 0; i < 16; ++i) S[i] += S2[i];
                float pa[8];
#pragma unroll
                for (int e = 0; e < 8; ++e) pa[e] = 0.f;
#pragma unroll
                for (int r = 0; r < 4; ++r) { const u32x4 w = kw[r]; const float ws_ = __builtin_amdgcn_exp2f(ctn[r] + gm);
                    pa[0] += ws_ * bflo(w.x); pa[1] += ws_ * bfhi(w.x); pa[2] += ws_ * bflo(w.y); pa[3] += ws_ * bfhi(w.y); pa[4] += ws_ * bflo(w.z); pa[5] += ws_ * bfhi(w.z); pa[6] += ws_ * bflo(w.w); pa[7] += ws_ * bfhi(w.w); }
#pragma unroll
                for (int e = 0; e < 8; ++e) { float t = pa[e]; t += dpp_mov<DPP_ROR(8)>(t); t += dpp_mov<DPP_ROR(4)>(t); t = xor16_sum(t); pa[e] = xor32_sum(t); }
                u32x2 sw2[4];
#pragma unroll
                for (int rg = 0; rg < 4; ++rg) { float v[4];
#pragma unroll
                    for (int e = 0; e < 4; ++e) { const int sc = 32 * stt + 8 * rg + 4 * hh + e; const bool ok = dir == 0 ? (sc <= j) : (sc >= j);
                        v[e] = S[4 * rg + e] * __builtin_amdgcn_exp2f(ok ? rtj + c4[rg][e] : -1.0e30f); }
                    sw2[rg].x = pk2(v[0], v[1]); sw2[rg].y = pk2(v[2], v[3]); }
                LAS unsigned char* sw = SD + s2 * 8192 + stt * 4096 + j * 16 + hh * 8;
#pragma unroll
                for (int rg = 0; rg < 4; ++rg) *(LAS u32x2*)(sw + rg * 1024) = sw2[rg];
                if (lane < 4) { LAS float* nn = NV + (s2 ^ 1) * 128 + 32 * wid + 8 * lane;
                    *(LAS f32x4*)nn = (f32x4){sp * o0.x + pa[0], sp * o0.y + pa[1], sp * o0.z + pa[2], sp * o0.w + pa[3]};
                    *(LAS f32x4*)(nn + 4) = (f32x4){sp * o1.x + pa[4], sp * o1.y + pa[5], sp * o1.z + pa[6], sp * o1.w + pa[7]}; }
            }
        } else if (wid < 6) {
            const int jt = wid - 4, jl = 32 * jt + r32;
            u32x2 hw[4]; const bool have_h = st > 0; const int cp = dir ? 64 - st : st - 1;
            const LAS float* iw = (const LAS float*)(SCS + s3p * 1024) + 128; const LAS float* enm = iw + 64;
            const LAS unsigned char* SDp = SD + (s2 ^ 1) * 8192;
            const LAS unsigned char* sr = SDp + hh * 4096 + jl * 16;
            const LAS unsigned char* sa = SDp + qrd + jt * 512; const LAS unsigned char* vb = VS + s3p * 4096 + ktr;
            const LAS unsigned char* qa = QT + qrd + jt * 512;
            const LAS unsigned char* cb = CI + s2 * 8192 + hh * 512 + r32 * 16;
            const LAS unsigned char* qr = QT + hh * 8192 + jl * 16; const LAS float* np = NV + s2 * 128 + 64 * hh;
            f32x16 an;
#pragma unroll
            for (int i = 0; i < 16; ++i) an[i] = 0.f;
            float iwj, enj, rdj, qnn;
            {
                bf16x8 vfr[2], sfr[2], cfr[4], qfr[4];
#pragma unroll
                for (int ks = 0; ks < 2; ++ks) { const s16x4 lo = trread(vb + ks * 1024), hi = trread(vb + ks * 1024 + 256); vfr[ks] = __builtin_shufflevector(lo, hi, 0, 1, 2, 3, 4, 5, 6, 7); sfr[ks] = *(const LAS bf16x8*)(sa + ks * 2048);
                    cfr[ks] = *(const LAS bf16x8*)(cb + ks * 1024); qfr[ks] = *(const LAS bf16x8*)(qa + ks * 2048); }
                iwj = iw[jl]; enj = enm[jl];
                __builtin_amdgcn_sched_barrier(0);
#pragma unroll
                for (int i = 0; i < 16; ++i) acc[i] *= iwj;
                an = MFMA32(cfr[0], qfr[0], an); acc = MFMA32(vfr[0], sfr[0], acc); an = MFMA32(cfr[1], qfr[1], an); acc = MFMA32(vfr[1], sfr[1], acc);
                __builtin_amdgcn_sched_barrier(0);
#pragma unroll
                for (int ks = 0; ks < 2; ++ks) { const s16x4 lo = trread(vb + (ks + 2) * 1024), hi = trread(vb + (ks + 2) * 1024 + 256); vfr[ks] = __builtin_shufflevector(lo, hi, 0, 1, 2, 3, 4, 5, 6, 7); sfr[ks] = *(const LAS bf16x8*)(sa + (ks + 2) * 2048);
                    cfr[ks] = *(const LAS bf16x8*)(cb + (ks + 2) * 1024); qfr[ks] = *(const LAS bf16x8*)(qa + (ks + 2) * 2048); }
                __builtin_amdgcn_sched_barrier(0);
                an = MFMA32(cfr[0], qfr[0], an); acc = MFMA32(vfr[0], sfr[0], acc); an = MFMA32(cfr[1], qfr[1], an); acc = MFMA32(vfr[1], sfr[1], acc);
                __builtin_amdgcn_sched_barrier(0);
#pragma unroll
                for (int ks = 0; ks < 4; ++ks) { cfr[ks] = *(const LAS bf16x8*)(cb + (ks + 4) * 1024); qfr[ks] = *(const LAS bf16x8*)(qa + (ks + 4) * 2048); }
                u32x4 w4[4];
#pragma unroll
                for (int ch = 0; ch < 4; ++ch) w4[ch] = *(const LAS u32x4*)(sr + ch * 1024);
                __builtin_amdgcn_sched_barrier(0);
                an = MFMA32(cfr[0], qfr[0], an); an = MFMA32(cfr[1], qfr[1], an); an = MFMA32(cfr[2], qfr[2], an); an = MFMA32(cfr[3], qfr[3], an);
                float r0, r1, r2, r3;
                { const u32x4 w = w4[0]; r0 = (bflo(w.x) + bfhi(w.x)) + (bflo(w.y) + bfhi(w.y)) + (bflo(w.z) + bfhi(w.z)) + (bflo(w.w) + bfhi(w.w)); }
                { const u32x4 w = w4[1]; r1 = (bflo(w.x) + bfhi(w.x)) + (bflo(w.y) + bfhi(w.y)) + (bflo(w.z) + bfhi(w.z)) + (bflo(w.w) + bfhi(w.w)); }
                { const u32x4 w = w4[2]; r2 = (bflo(w.x) + bfhi(w.x)) + (bflo(w.y) + bfhi(w.y)) + (bflo(w.z) + bfhi(w.z)) + (bflo(w.w) + bfhi(w.w)); }
                { const u32x4 w = w4[3]; r3 = (bflo(w.x) + bfhi(w.x)) + (bflo(w.y) + bfhi(w.y)) + (bflo(w.z) + bfhi(w.z)) + (bflo(w.w) + bfhi(w.w)); }
                const float rsum = xor32_sum((r0 + r1) + (r2 + r3));
                const float den = rsum + iwj * qn;
                rdj = 1.f / fmaxf(fabsf(den), enj);
            }
            __builtin_amdgcn_sched_barrier(0);
            {
                u32x4 qw[4]; f32x4 nv0[4], nv1[4];
#pragma unroll
                for (int ch = 0; ch < 4; ++ch) { qw[ch] = *(const LAS u32x4*)(qr + ch * 1024); nv0[ch] = *(const LAS f32x4*)(np + ch * 8); nv1[ch] = *(const LAS f32x4*)(np + ch * 8 + 4); }
                __builtin_amdgcn_sched_barrier(0);
#pragma unroll
                for (int rg = 0; rg < 4; ++rg) { hw[rg].x = pk2(acc[4 * rg] * rdj, acc[4 * rg + 1] * rdj); hw[rg].y = pk2(acc[4 * rg + 2] * rdj, acc[4 * rg + 3] * rdj); }
#pragma unroll
                for (int i = 0; i < 16; ++i) acc[i] = an[i];
                float q0 = 0.f, q1 = 0.f, q2 = 0.f, q3 = 0.f;
#pragma unroll
                for (int ch = 0; ch < 4; ++ch) { const u32x4 w = qw[ch]; const f32x4 n0 = nv0[ch], n1 = nv1[ch];
                    q0 += bflo(w.x) * n0.x + bfhi(w.x) * n0.y; q1 += bflo(w.y) * n0.z + bfhi(w.y) * n0.w; q2 += bflo(w.z) * n1.x + bfhi(w.z) * n1.y; q3 += bflo(w.w) * n1.z + bfhi(w.w) * n1.w; }
                __builtin_amdgcn_sched_barrier(0);
#pragma unroll
                for (int ch = 0; ch < 4; ++ch) { qw[ch] = *(const LAS u32x4*)(qr + (ch + 4) * 1024); nv0[ch] = *(const LAS f32x4*)(np + (ch + 4) * 8); nv1[ch] = *(const LAS f32x4*)(np + (ch + 4) * 8 + 4); }
                __builtin_amdgcn_sched_barrier(0);
#pragma unroll
                for (int ch = 0; ch < 4; ++ch) { const u32x4 w = qw[ch]; const f32x4 n0 = nv0[ch], n1 = nv1[ch];
                    q0 += bflo(w.x) * n0.x + bfhi(w.x) * n0.y; q1 += bflo(w.y) * n0.z + bfhi(w.y) * n0.w; q2 += bflo(w.z) * n1.x + bfhi(w.z) * n1.y; q3 += bflo(w.w) * n1.z + bfhi(w.w) * n1.w; }
                qnn = xor32_sum((q0 + q1) + (q2 + q3));
            }
            qn = qnn;
            if (have_h) {
                LAS unsigned char* hst = HST + jt * 2048;
#pragma unroll
                for (int rg = 0; rg < 4; ++rg) *(LAS u32x2*)(hst + r32 * 64 + (8 * rg + 4 * hh) * 2) = hw[rg];
                asm volatile("s_waitcnt lgkmcnt(0)" ::: "memory");
#pragma unroll
                for (int q = 0; q < 2; ++q) { const int row = 16 * q + (lane >> 2), part = lane & 3;
                    const u32x4 w = *(const LAS u32x4*)(hst + row * 64 + part * 16);
                    *(u32x4*)(HD + (size_t)(cp * 64 + 32 * jt + row) * 512 + part * 8) = w; }
            }
        } else if (st < 64) {
            const int u = wid - 6; const float gm = gmv[c], sp = spv[c];
            const LAS unsigned char* va = VT + ktr; const LAS unsigned char* ka = KT + ktr + (2 * u) * 4096;
            s16x4 vlo[4], vhi[4], k0l[4], k0h[4], k1l[4], k1h[4]; f32x4 cw0[4], cw1[4];
#pragma unroll
            for (int ks = 0; ks < 4; ++ks) { vlo[ks] = trread(va + ks * 1024); vhi[ks] = trread(va + ks * 1024 + 256);
                cw0[ks] = *(const LAS f32x4*)(ct + 16 * ks + 8 * hh); cw1[ks] = *(const LAS f32x4*)(ct + 16 * ks + 8 * hh + 4);
                k0l[ks] = trread(ka + ks * 1024); k0h[ks] = trread(ka + ks * 1024 + 256); k1l[ks] = trread(ka + 4096 + ks * 1024); k1h[ks] = trread(ka + 4096 + ks * 1024 + 256); }
#pragma unroll
            for (int i = 0; i < 16; ++i) { Cacc[0][i] *= sp; Cacc[1][i] *= sp; }
#pragma unroll
            for (int ks = 0; ks < 4; ++ks) {
                const s16x4 lo = vlo[ks], hi = vhi[ks]; const f32x4 e0 = cw0[ks], e1 = cw1[ks];
                u32x4 af;
                af.x = pk2(bf2f((bf16_t)lo[0]) * __builtin_amdgcn_exp2f(e0.x + gm), bf2f((bf16_t)lo[1]) * __builtin_amdgcn_exp2f(e0.y + gm));
                af.y = pk2(bf2f((bf16_t)lo[2]) * __builtin_amdgcn_exp2f(e0.z + gm), bf2f((bf16_t)lo[3]) * __builtin_amdgcn_exp2f(e0.w + gm));
                af.z = pk2(bf2f((bf16_t)hi[0]) * __builtin_amdgcn_exp2f(e1.x + gm), bf2f((bf16_t)hi[1]) * __builtin_amdgcn_exp2f(e1.y + gm));
                af.w = pk2(bf2f((bf16_t)hi[2]) * __builtin_amdgcn_exp2f(e1.z + gm), bf2f((bf16_t)hi[3]) * __builtin_amdgcn_exp2f(e1.w + gm));
                const bf16x8 afr = __builtin_bit_cast(bf16x8, af);
                Cacc[0] = MFMA32(__builtin_shufflevector(k0l[ks], k0h[ks], 0, 1, 2, 3, 4, 5, 6, 7), afr, Cacc[0]);
                Cacc[1] = MFMA32(__builtin_shufflevector(k1l[ks], k1h[ks], 0, 1, 2, 3, 4, 5, 6, 7), afr, Cacc[1]);
            }
            LAS unsigned char* cw = CI + (s2 ^ 1) * 8192 + (2 * u) * 2048 + r32 * 16 + hh * 8;
#pragma unroll
            for (int t2 = 0; t2 < 2; ++t2)
#pragma unroll
                for (int rg = 0; rg < 4; ++rg) { u32x2 w; w.x = pk2(Cacc[t2][4 * rg], Cacc[t2][4 * rg + 1]); w.y = pk2(Cacc[t2][4 * rg + 2], Cacc[t2][4 * rg + 3]); *(LAS u32x2*)(cw + t2 * 2048 + rg * 512) = w; }
        }
        if (PROBE_MSEQ_W >= 0) { asm volatile("s_waitcnt lgkmcnt(0)" ::: "memory"); busy += __builtin_amdgcn_s_memtime() - tb0; }
#define MSEQ_CONVERT(id_, bufoff) do { const int id = (id_), e = id / 6144, r = id % 6144, mat = r >> 11, rr = r & 2047; \
            const int nb = mat == 2 ? (rr >> 7) : (rr >> 6), kb = mat == 2 ? (rr & 127) : (rr & 63), n = 64 * nb + lane; \
            unsigned char* dst = mat == 2 ? a.ws + WS_WDT + (size_t)e * DM * DFF + (size_t)n * DFF + 16 * kb \
                                          : a.ws + WS_WGUT + (size_t)e * 4096 * DM + (size_t)((n >> 7) * 256 + (n & 127) + mat * 128) * DM + 16 * kb; \
            const LAS float* CSC = (const LAS float*)(F.lds + (bufoff) + (id & 1) * 4096); \
            float cv[16]; \
            _Pragma("unroll") for (int k = 0; k < 16; ++k) cv[k] = CSC[k * 64 + lane] * pg8::W_PRESCALE; \
            u32x4 o; o.x = pg8::pk4_fp8(cv[0], cv[1], cv[2], cv[3]); o.y = pg8::pk4_fp8(cv[4], cv[5], cv[6], cv[7]); o.z = pg8::pk4_fp8(cv[8], cv[9], cv[10], cv[11]); o.w = pg8::pk4_fp8(cv[12], cv[13], cv[14], cv[15]); \
            *(u32x4*)dst = o; } while (0)
        if (cwave) {
            if (st + 1 < 64) { if (((st + 1) & 3) == wid) asm volatile("s_waitcnt vmcnt(8)" ::: "memory"); else asm volatile("s_waitcnt vmcnt(4)" ::: "memory"); }
            else asm volatile("s_waitcnt vmcnt(0)" ::: "memory");
            if (st < 64) {
                MSEQ_CONVERT(cslot0 + st, 119808 + cwi * 8192);
                if ((st & 3) == wid) MSEQ_CONVERT(xslot0 + st, 119808 + 4 * 8192);
            }
        } else if (wid >= 6) asm volatile("s_waitcnt vmcnt(0)" ::: "memory");
        asm volatile("s_waitcnt lgkmcnt(0)" ::: "memory"); __builtin_amdgcn_s_barrier(); asm volatile("" ::: "memory");
        if (PROBE_MSEQ_W >= 0) tb0 = __builtin_amdgcn_s_memtime();
    }
    if (PROBE_MSEQ_W >= 0 && F.bid == 0 && lane == 0 && (wid == PROBE_MSEQ_W || (PROBE_MSEQ_W == 8 && wid == 0)))
        *(volatile LAS unsigned long long*)(F.lds + LDS_BYTES - 128) = (PROBE_MSEQ_W == 8) ? (__builtin_amdgcn_s_memtime() - titem0) : busy;
    asm volatile("s_waitcnt vmcnt(0)" ::: "memory");
#undef MSEQ_ISSUE_QK
#undef MSEQ_ISSUE_VS
#undef MSEQ_CONV_ISSUE
#undef MSEQ_CONVERT
}

DI void glds16(const void* g, LAS unsigned char* l) { __builtin_amdgcn_global_load_lds((const unsigned*)g, (LAS unsigned*)l, 16, 0, 0); }
DI void attn_unit(const Ctx& F, const Args& a, int b, int h, int qb, float lam, float cshift) {
    const int lane = F.lane, wid = F.wave, r32 = lane & 31, hh = lane >> 5, rg = wid & 3, p = wid >> 2;
    const bf16_t* projb = (const bf16_t*)(a.ws + WS_PROJ) + (size_t)b * SEQ * PS;
    const int qrow = qb * 128 + rg * 32 + r32;
    bf16x8 qf[4];
    { const bf16_t* qp = projb + (size_t)qrow * PS + C_QA + h * 128 + p * 64 + hh * 8;
#pragma unroll
      for (int ks = 0; ks < 4; ++ks) qf[ks] = *(const bf16x8*)(qp + ks * 16); }
    const bf16_t* kimg = (const bf16_t*)(a.ws + WS_KIMG) + (size_t)(b * 4 + h) * 64 * 8192 + (4 * wid) * 512 + lane * 8;
    const bf16_t* vimg = (const bf16_t*)(a.ws + WS_VIMG) + (size_t)(b * 4 + h) * 64 * 8192 + (4 * wid) * 512 + lane * 8;
    const unsigned ldsw = (unsigned)__builtin_amdgcn_readfirstlane((int)(unsigned)(uintptr_t)F.lds + (4 * wid) * 1024);
#define ATT_ISSUE2(img, t0, ldsoff) do { const int _q0 = 4 * wid; const int _t = (t0) + (_q0 >> 4); const bf16_t* _tp = (img) + (size_t)(_t < 64 ? _t : 63) * 8192 - (size_t)(_q0 & 16) * 512; \
        const unsigned _d = (unsigned)__builtin_amdgcn_readfirstlane((int)(ldsw + (ldsoff))); \
        _Pragma("unroll") for (int _i = 0; _i < 4; ++_i) glds16_asm(_tp + _i * 512, _d + _i * 1024); } while (0)
    if (wid < 4) { const bf16_t* _tp = kimg; const unsigned _d = (unsigned)__builtin_amdgcn_readfirstlane((int)(ldsw + 32768));
#pragma unroll
        for (int _i = 0; _i < 4; ++_i) glds16_asm(_tp + _i * 512, _d + _i * 1024); }
    ATT_ISSUE2(kimg, 1, 0); ATT_ISSUE2(vimg, 0, 65536);
    f32x16 O[4];
#pragma unroll
    for (int vt = 0; vt < 4; ++vt)
#pragma unroll
        for (int i = 0; i < 16; ++i) O[vt][i] = 0.f;
    float lsum = 0.f;
    const int kfb = p * 8192 + hh * 1024 + r32 * 16;
    const int vfb = (4 * hh + ((lane & 15) >> 2)) * 64 + ((lane >> 4) & 1) * 32 + (lane & 3) * 8;
    bf16x8 pb[4], pc[4];
    asm volatile("s_waitcnt vmcnt(0)" ::: "memory");
    __syncthreads();
#define ATT_VLOAD(dst, Vb, kg) do { _Pragma("unroll") for (int vt = 0; vt < 4; ++vt) { \
        const s16x4 _lo = trread((Vb) + vt * 4096 + (kg) * 1024), _hi = trread((Vb) + vt * 4096 + (kg) * 1024 + 512); dst[vt] = __builtin_shufflevector(_lo, _hi, 0, 1, 2, 3, 4, 5, 6, 7); } } while (0)
#define ATT_PV(vf, kg, PIN) do { __builtin_amdgcn_s_setprio(1); _Pragma("unroll") for (int vt = 0; vt < 4; ++vt) O[vt] = MFMA32(vf[vt], PIN[kg], O[vt]); __builtin_amdgcn_s_setprio(0); } while (0)
#define ATT_EXPQ(S, o, dst) do { float _e[8]; _Pragma("unroll") for (int i = 0; i < 8; ++i) _e[i] = __builtin_amdgcn_exp2f(S[(o) + i]); \
        _Pragma("unroll") for (int i = 0; i < 8; ++i) ls = ls + _e[i]; \
        u32x4 _w; _w.x = pk2(_e[0], _e[1]); _w.y = pk2(_e[2], _e[3]); _w.z = pk2(_e[4], _e[5]); _w.w = pk2(_e[6], _e[7]); dst = __builtin_bit_cast(bf16x8, _w); } while (0)
#define ATT_STEP(Kb, Vb, on0, PIN, POUT) do { \
        bf16x8 kfa[4], kfb2[4], vA[4], vB[4]; float ls = 0.f; \
        _Pragma("unroll") for (int ks = 0; ks < 4; ++ks) { kfa[ks] = *(const LAS bf16x8*)((Kb) + ks * 2048); kfb2[ks] = *(const LAS bf16x8*)((Kb) + ks * 2048 + 512); } \
        ATT_VLOAD(vA, Vb, 0); \
        __builtin_amdgcn_s_setprio(1); \
        Sa = MFMA32(kfa[0], qf[0], negc); Sb = MFMA32(kfb2[0], qf[0], negc);        \
        _Pragma("unroll") for (int ks = 1; ks < 4; ++ks) { Sa = MFMA32(kfa[ks], qf[ks], Sa); Sb = MFMA32(kfb2[ks], qf[ks], Sb); } \
        __builtin_amdgcn_s_setprio(0); \
        ATT_VLOAD(vB, Vb, 1); ATT_PV(vA, 0, PIN); ATT_EXPQ(Sa, 0, POUT[0]); \
        ATT_VLOAD(vA, Vb, 2); ATT_PV(vB, 1, PIN); ATT_EXPQ(Sa, 8, POUT[1]); \
        ATT_VLOAD(vB, Vb, 3); ATT_PV(vA, 2, PIN); ATT_EXPQ(Sb, 0, POUT[2]); \
        ATT_PV(vB, 3, PIN); ATT_EXPQ(Sb, 8, POUT[3]); \
        lsum += (on0) ? ls : 0.f; } while (0)
    f32x16 Sa, Sb, negc;
#pragma unroll
    for (int i = 0; i < 16; ++i) negc[i] = -cshift;
    asm volatile("" : "+v"(negc));
    {
        const LAS unsigned char* Kb = F.lds + 32768 + kfb;
        Sa = MFMA32(*(const LAS bf16x8*)(Kb), qf[0], negc); Sb = MFMA32(*(const LAS bf16x8*)(Kb + 512), qf[0], negc);
#pragma unroll
        for (int ks = 1; ks < 4; ++ks) { Sa = MFMA32(*(const LAS bf16x8*)(Kb + ks * 2048), qf[ks], Sa); Sb = MFMA32(*(const LAS bf16x8*)(Kb + ks * 2048 + 512), qf[ks], Sb); }
        float ls = 0.f;
        ATT_EXPQ(Sa, 0, pb[0]); ATT_EXPQ(Sa, 8, pb[1]); ATT_EXPQ(Sb, 0, pb[2]); ATT_EXPQ(Sb, 8, pb[3]);
        lsum += ls;
    }
    __syncthreads();
#pragma unroll 1
    for (int T = 0; T < 32; ++T) {
        const int j = T & 1;
        ATT_ISSUE2(kimg, 2 * T + 3, (j ^ 1) * 32768);
        ATT_ISSUE2(vimg, 2 * T + 2, 65536 + (j ^ 1) * 32768);
        const LAS unsigned char* Ks = F.lds + j * 32768 + kfb; const LAS unsigned char* Vs = F.lds + 65536 + j * 32768 + vfb;
        ATT_STEP(Ks, Vs, true, pb, pc);
        ATT_STEP(Ks + 16384, Vs + 16384, T < 31, pc, pb);
        asm volatile("s_waitcnt vmcnt(0)" ::: "memory");
        __syncthreads();
    }
#undef ATT_EXPQ
#undef ATT_STEP
#undef ATT_VLOAD
#undef ATT_PV
#undef ATT_ISSUE2
    lsum += __shfl_xor(lsum, 32);
    LAS float* X = (LAS float*)(F.lds + 65536) + rg * 4096 + r32;
    if (p == 1) {
        const float sc = lam / lsum;
#pragma unroll
        for (int vt = 0; vt < 4; ++vt)
#pragma unroll
            for (int i = 0; i < 16; ++i) X[(32 * vt + crow(i, hh)) * 32] = O[vt][i] * sc;
    }
    __syncthreads();
    if (p == 0) {
        const float i0 = 1.f / lsum;
        float ssq = 0.f;
#pragma unroll
        for (int vt = 0; vt < 4; ++vt)
#pragma unroll
            for (int i = 0; i < 16; ++i) { const float o = O[vt][i] * i0 - X[(32 * vt + crow(i, hh)) * 32]; O[vt][i] = o; ssq += o * o; }
        ssq += __shfl_xor(ssq, 32);
        const float rs = rsqrtf(ssq * (1.f / 128.f) + EPS) * 0.8f;
        bf16_t* yp = (bf16_t*)(a.ws + WS_YMIX) + (size_t)(b * SEQ + qrow) * DM + 512 + h * 128;
#pragma unroll
        for (int vt = 0; vt < 4; ++vt)
#pragma unroll
            for (int rgi = 0; rgi < 4; ++rgi) { const int vd = 32 * vt + 8 * rgi + 4 * hh; const f32x4 g = *(const f32x4*)(a.subln_g + vd);
                u32x2 w; w.x = pk2(O[vt][4 * rgi] * rs * g.x, O[vt][4 * rgi + 1] * rs * g.y); w.y = pk2(O[vt][4 * rgi + 2] * rs * g.z, O[vt][4 * rgi + 3] * rs * g.w);
                *(u32x2*)(yp + vd) = w; }
    }
    __syncthreads();
}

DI void mcombine_phase(const Ctx& F, const Args& a) {
    const int gw = F.bid * NWAVES + F.wave, NGW = F.G * NWAVES, lane = F.lane;
    const bf16_t* HD = (const bf16_t*)((const unsigned char*)a.out + DO_HD);
    float g[8];
#pragma unroll
    for (int i = 0; i < 8; ++i) g[i] = a.mnorm_g[lane * 8 + i];
    for (int m = gw; m < MTOK; m += NGW) {
        const u32x4 f = *(const u32x4*)(HD + (size_t)m * 512 + lane * 8), bw = *(const u32x4*)(HD + ((size_t)MTOK + m) * 512 + lane * 8);
        const u32x4 om = *(const u32x4*)((const bf16_t*)(a.ws + WS_PROJ) + (size_t)m * PS + C_OM + lane * 8);
        float v[8];
        v[0] = bflo(f.x) + bflo(bw.x); v[1] = bfhi(f.x) + bfhi(bw.x); v[2] = bflo(f.y) + bflo(bw.y); v[3] = bfhi(f.y) + bfhi(bw.y);
        v[4] = bflo(f.z) + bflo(bw.z); v[5] = bfhi(f.z) + bfhi(bw.z); v[6] = bflo(f.w) + bflo(bw.w); v[7] = bfhi(f.w) + bfhi(bw.w);
        float ss = 0.f;
#pragma unroll
        for (int i = 0; i < 8; ++i) ss += v[i] * v[i];
        ss += __shfl_xor(ss, 1); ss += __shfl_xor(ss, 2); ss += __shfl_xor(ss, 4); ss += __shfl_xor(ss, 8);
        const float rstd = rsqrtf(ss * (1.f / 128.f) + EPS);
        float o[8];
        o[0] = bflo(om.x); o[1] = bfhi(om.x); o[2] = bflo(om.y); o[3] = bfhi(om.y); o[4] = bflo(om.z); o[5] = bfhi(om.z); o[6] = bflo(om.w); o[7] = bfhi(om.w);
#pragma unroll
        for (int i = 0; i < 8; ++i) v[i] = v[i] * rstd * g[i] * sigmoid_f(o[i]);
        u32x4 w; w.x = pk2(v[0], v[1]); w.y = pk2(v[2], v[3]); w.z = pk2(v[4], v[5]); w.w = pk2(v[6], v[7]);
        bf16_t* yp = (bf16_t*)(a.ws + WS_YMIX) + (size_t)m * DM + lane * 8;
        *(u32x4*)yp = w;
    }
}

DI void router_finish(const float (&lg)[16], int lane, float* affrow, bool store) {
    float r8[8];
#pragma unroll
    for (int i = 0; i < 8; ++i) { const float keep = hh_sel(lane, 32) ? lg[8 + i] : lg[i], send = hh_sel(lane, 32) ? lg[i] : lg[8 + i]; r8[i] = keep + partner32(send, lane); }
    float r4[4];
#pragma unroll
    for (int i = 0; i < 4; ++i) { const float keep = hh_sel(lane, 16) ? r8[4 + i] : r8[i], send = hh_sel(lane, 16) ? r8[i] : r8[4 + i]; r4[i] = keep + partner16(send, lane); }
    float r2[2];
#pragma unroll
    for (int i = 0; i < 2; ++i) { const float keep = hh_sel(lane, 8) ? r4[2 + i] : r4[i], send = hh_sel(lane, 8) ? r4[i] : r4[2 + i]; r2[i] = keep + partner8(send); }
    float lgt; { const float keep = hh_sel(lane, 4) ? r2[1] : r2[0], send = hh_sel(lane, 4) ? r2[0] : r2[1]; lgt = keep + partner4(send, lane); }
    lgt += dpp_mov<DPP_XOR2>(lgt); lgt += dpp_mov<DPP_XOR1>(lgt);
    float mx = lgt; mx = fmaxf(mx, dpp_mov<DPP_ROR(8)>(mx)); mx = fmaxf(mx, dpp_mov<DPP_ROR(4)>(mx)); mx = xor16_max(mx); mx = xor32_max(mx);
    const float ex = __expf(lgt - mx); float sm = ex; sm += dpp_mov<DPP_ROR(8)>(sm); sm += dpp_mov<DPP_ROR(4)>(sm); sm = xor16_sum(sm); sm = xor32_sum(sm);
    if ((lane & 3) == 0 && store) affrow[lane >> 2] = ex / sm;
}
DI void p7_phase(const Ctx& F, const Args& a) {
    LAS bf16_t* WH = (LAS bf16_t*)F.lds; LAS bf16_t* WL = (LAS bf16_t*)(F.lds + 33024);
    LAS float* GS = (LAS float*)(F.lds + 66048); LAS float* SH = GS + 1024;
    const float* mod = (const float*)(a.ws + WS_MOD);
    const int lane = F.lane, n = lane & 15, kg = lane >> 4;
    unsigned char* H2 = a.ws + WS_H2; float* AFF = (float*)(a.ws + WS_AFF);
#pragma unroll 1
    for (int grp = F.bid; grp < MTOK / 128; grp += F.G) {
        const int b = (grp * 128) / SEQ;
        const int m = grp * 128 + F.wave * 16 + n;
        const u32x4* xr = (const u32x4*)((const bf16_t*)(a.ws + WS_X1B) + (size_t)m * DM + 16 * kg);
        u32x4 xq[16][2];
#pragma unroll
        for (int i = 0; i < 16; ++i) { xq[i][0] = xr[8 * i]; xq[i][1] = xr[8 * i + 1]; }
        __syncthreads();
        if (grp == F.bid) {
        for (int q = F.tid; q < 16384; q += NTHR) { const int k = q >> 4, e = q & 15; const float w = a.w_router[q];
            const unsigned hi = pk2(w, 0.f) & 0xffffu; const float rem = w - __uint_as_float(hi << 16);
            ((LAS unsigned short*)WH)[e * 1032 + k] = (unsigned short)hi; ((LAS unsigned short*)WL)[e * 1032 + k] = (unsigned short)(pk2(rem, 0.f) & 0xffffu); }
        }
        for (int k = F.tid; k < DM; k += NTHR) { GS[k] = a.norm2_g[k] * (mod[(size_t)b * 6144 + 4096 + k] + 1.f); SH[k] = mod[(size_t)b * 6144 + 3072 + k]; }
        __syncthreads();
        float s = 0.f;
#pragma unroll
        for (int i = 0; i < 16; ++i)
#pragma unroll
            for (int c = 0; c < 2; ++c)
#pragma unroll
                for (int d = 0; d < 4; ++d) { const float lo = bflo(xq[i][c][d]), hi = bfhi(xq[i][c][d]); s += lo * lo + hi * hi; }
        s = xor16_sum(s); s = xor32_sum(s);
        const float rstd = rsqrtf(s * (1.f / DM) + EPS);
#pragma unroll
        for (int i = 0; i < 16; ++i) { asm volatile("" : "+v"(xq[i][0]), "+v"(xq[i][1])); }
        f32x4 lg = {0.f, 0.f, 0.f, 0.f};
        u32x4* hp = (u32x4*)(H2 + (size_t)m * DM + 16 * kg);
        const LAS unsigned char* whp = (const LAS unsigned char*)WH + n * 2064 + kg * 32; const LAS unsigned char* wlp = (const LAS unsigned char*)WL + n * 2064 + kg * 32;
        const LAS float* gsp = GS + 16 * kg; const LAS float* shp = SH + 16 * kg;
#pragma unroll
        for (int i = 0; i < 16; ++i) {
            u32x4 h8;
#pragma unroll
            for (int c = 0; c < 2; ++c) {
                const f32x4 g0 = *(const LAS f32x4*)(gsp + 64 * i + 8 * c), g1 = *(const LAS f32x4*)(gsp + 64 * i + 8 * c + 4);
                const f32x4 s0 = *(const LAS f32x4*)(shp + 64 * i + 8 * c), s1 = *(const LAS f32x4*)(shp + 64 * i + 8 * c + 4);
                const u32x4 xw = xq[i][c];
                float t[8];
                t[0] = bflo(xw.x) * rstd * g0.x + s0.x; t[1] = bfhi(xw.x) * rstd * g0.y + s0.y; t[2] = bflo(xw.y) * rstd * g0.z + s0.z; t[3] = bfhi(xw.y) * rstd * g0.w + s0.w;
                t[4] = bflo(xw.z) * rstd * g1.x + s1.x; t[5] = bfhi(xw.z) * rstd * g1.y + s1.y; t[6] = bflo(xw.w) * rstd * g1.z + s1.z; t[7] = bfhi(xw.w) * rstd * g1.w + s1.w;
                const unsigned f0 = pg8::pk4_fp8(t[0], t[1], t[2], t[3]), f1 = pg8::pk4_fp8(t[4], t[5], t[6], t[7]);
                if (c == 0) { h8.x = f0; h8.y = f1; } else { h8.z = f0; h8.w = f1; }
                u32x4 th, tl;
#pragma unroll
                for (int d = 0; d < 4; ++d) { const unsigned hw = pk2(t[2 * d], t[2 * d + 1]); th[d] = hw; tl[d] = pk2(t[2 * d] - bflo(hw), t[2 * d + 1] - bfhi(hw)); }
                const bf16x8 wh = *(const LAS bf16x8*)(whp + 128 * i + 16 * c), wl = *(const LAS bf16x8*)(wlp + 128 * i + 16 * c);
                const bf16x8 thv = __builtin_bit_cast(bf16x8, th), tlv = __builtin_bit_cast(bf16x8, tl);
                lg = __builtin_amdgcn_mfma_f32_16x16x32_bf16(wh, thv, lg, 0, 0, 0);
                lg = __builtin_amdgcn_mfma_f32_16x16x32_bf16(wh, tlv, lg, 0, 0, 0);
                lg = __builtin_amdgcn_mfma_f32_16x16x32_bf16(wl, thv, lg, 0, 0, 0);
            }
            hp[4 * i] = h8;
            __builtin_amdgcn_sched_barrier(0);
        }
        float mx = fmaxf(fmaxf(lg[0], lg[1]), fmaxf(lg[2], lg[3])); mx = xor16_max(mx); mx = xor32_max(mx);
        f32x4 ex; float sm = 0.f;
#pragma unroll
        for (int r = 0; r < 4; ++r) { ex[r] = __expf(lg[r] - mx); sm += ex[r]; }
        sm = xor16_sum(sm); sm = xor32_sum(sm);
        const float inv = 1.f / sm;
        *(f32x4*)(AFF + (size_t)m * 16 + 4 * kg) = ex * inv;
    }
    __syncthreads();
}

DI void topk_task(const Ctx& F, const Args& a, int task) {
    const int b = task >> 4, e = task & 15, tid = F.tid, lane = F.lane;
    const float* AFF = (const float*)(a.ws + WS_AFF) + (size_t)b * SEQ * 16 + e;
    LAS unsigned* hist = (LAS unsigned*)F.lds;
    LAS unsigned* sfx = hist + 256;
    LAS unsigned* misc = hist + 512;
    unsigned key[8];
#pragma unroll
    for (int i = 0; i < 8; ++i) key[i] = __float_as_uint(AFF[(size_t)(tid * 8 + i) * 16]);
    unsigned prefix = 0, krem = CAP;
#pragma unroll 1
    for (int pass = 0; pass < 4; ++pass) {
        const int shift = 24 - 8 * pass;
        if (tid < 256) hist[tid] = 0;
        __syncthreads();
        {
            unsigned d0 = 0xffffffffu, n0 = 0;
#pragma unroll
            for (int i = 0; i < 8; ++i) { const bool in = pass == 0 ? true : ((key[i] >> (shift + 8)) == (prefix >> (shift + 8)));
                if (in) { const unsigned d = (key[i] >> shift) & 255u; if (d0 == 0xffffffffu) d0 = d; if (d == d0) ++n0; else atomicAdd((unsigned*)&hist[d], 1u); } }
            if (n0) atomicAdd((unsigned*)&hist[d0], n0);
        }
        __syncthreads();
        if (F.wave == 0) {
            const unsigned h0 = hist[4 * lane], h1 = hist[4 * lane + 1], h2 = hist[4 * lane + 2], h3 = hist[4 * lane + 3];
            const unsigned sl = h0 + h1 + h2 + h3; unsigned t = sl;
#pragma unroll
            for (int o = 1; o < 64; o <<= 1) { const unsigned u = __shfl_down(t, o); if (lane + o < 64) t += u; }
            const unsigned i3 = (t - sl) + h3, i2 = i3 + h2, i1 = i2 + h1, i0 = i1 + h0;
            if (i3 - h3 < krem && krem <= i3) { misc[0] = 4u * lane + 3u; misc[1] = krem - (i3 - h3); }
            if (i2 - h2 < krem && krem <= i2) { misc[0] = 4u * lane + 2u; misc[1] = krem - (i2 - h2); }
            if (i1 - h1 < krem && krem <= i1) { misc[0] = 4u * lane + 1u; misc[1] = krem - (i1 - h1); }
            if (i0 - h0 < krem && krem <= i0) { misc[0] = 4u * lane;      misc[1] = krem - (i0 - h0); }
        }
        __syncthreads();
        prefix |= misc[0] << shift; krem = misc[1];
    }
    const unsigned T = prefix, need = krem;
    unsigned cg_ = 0, ce = 0;
#pragma unroll
    for (int i = 0; i < 8; ++i) { cg_ += key[i] > T; ce += key[i] == T; }
    unsigned sg = cg_, se = ce;
#pragma unroll
    for (int o = 1; o < 64; o <<= 1) { const unsigned tg = __shfl_up(sg, o), te = __shfl_up(se, o); if (lane >= o) { sg += tg; se += te; } }
    if (lane == 63) { misc[16 + F.wave] = sg; misc[32 + F.wave] = se; }
    __syncthreads();
    unsigned og = sg - cg_, oe = se - ce;
    for (int w = 0; w < F.wave; ++w) { og += misc[16 + w]; oe += misc[32 + w]; }
    int* SLOT = (int*)(a.ws + WS_SLOT) + (size_t)b * SEQ * 16 + e;
    float* VALS = (float*)(a.ws + WS_VALS) + (size_t)(e * 8 + b) * CAP;
    int* IDX = (int*)(a.ws + WS_IDX) + (size_t)(e * 8 + b) * CAP;
#pragma unroll
    for (int i = 0; i < 8; ++i) {
        const bool gt = key[i] > T, eq = key[i] == T; const bool sel = gt || (eq && oe < need);
        const unsigned pos = og + (oe < need ? oe : need);
        const int s = tid * 8 + i;
        SLOT[(size_t)s * 16] = sel ? (int)pos : -1;
        if (sel) { IDX[pos] = b * SEQ + s; VALS[pos] = __uint_as_float(key[i]); }
        og += gt; oe += eq;
    }
    __syncthreads();
}

DI void final_phase(const Ctx& F, const Args& a) {
    const int gw = F.bid * NWAVES + F.wave, NGW = F.G * NWAVES, lane = F.lane;
    const float* mod = (const float*)(a.ws + WS_MOD); const int* SLOT = (const int*)(a.ws + WS_SLOT); const unsigned char* Y = a.ws + WS_Y;
    for (int m = gw; m < MTOK; m += NGW) {
        const int b = m / SEQ;
        const int sl = SLOT[(size_t)m * 16 + (lane & 15)];
        f32x4* op = (f32x4*)(a.out + (size_t)m * DM + lane * 16);
        f32x4 xv[4];
        { const u32x4* xp = (const u32x4*)((const bf16_t*)(a.ws + WS_X1B) + (size_t)m * DM + lane * 16); const u32x4 w0 = xp[0], w1 = xp[1];
          xv[0].x = bflo(w0.x); xv[0].y = bfhi(w0.x); xv[0].z = bflo(w0.y); xv[0].w = bfhi(w0.y); xv[1].x = bflo(w0.z); xv[1].y = bfhi(w0.z); xv[1].z = bflo(w0.w); xv[1].w = bfhi(w0.w);
          xv[2].x = bflo(w1.x); xv[2].y = bfhi(w1.x); xv[2].z = bflo(w1.y); xv[2].w = bfhi(w1.y); xv[3].x = bflo(w1.z); xv[3].y = bfhi(w1.z); xv[3].z = bflo(w1.w); xv[3].w = bfhi(w1.w); }
        float acc[16];
#pragma unroll
        for (int i = 0; i < 16; ++i) acc[i] = 0.f;
#pragma unroll 1
        for (int e = 0; e < 16; ++e) { const int s = __shfl(sl, e);
            if (s >= 0) { const u32x4 w = *(const u32x4*)(Y + ((size_t)(e * 8 + b) * CAP + s) * DM + lane * 16);
#pragma unroll
                for (int q = 0; q < 4; ++q) { const unsigned ww = w[q];
                    const auto lo = __builtin_amdgcn_cvt_pk_f32_fp8((int)ww, false), hi = __builtin_amdgcn_cvt_pk_f32_fp8((int)ww, true);
                    acc[4 * q] += lo[0]; acc[4 * q + 1] += lo[1]; acc[4 * q + 2] += hi[0]; acc[4 * q + 3] += hi[1]; } } }
        const f32x4* gp = (const f32x4*)(mod + (size_t)b * 6144 + 5120 + lane * 16);
#pragma unroll
        for (int q = 0; q < 4; ++q) { const f32x4 g = gp[q] * (1.f / pg8::Y_PRESCALE); f32x4 o = xv[q]; o.x += g.x * acc[4 * q]; o.y += g.y * acc[4 * q + 1]; o.z += g.z * acc[4 * q + 2]; o.w += g.w * acc[4 * q + 3]; op[q] = o; }
    }
}

#define XB_TMO      128
#define XB_XCNT(j)  (256  + 64 * (j))
#define XB_XSUB(j)  (1280 + 64 * (j))
#define XB_XGEN(j)  (2304 + 64 * (j))
#define XB_TOP      3328
#define XB_TOPGEN   3392
#define XB_SPIN_CAP (1u << 18)
DI unsigned xb_ld(unsigned* p)              { return __hip_atomic_load(p, __ATOMIC_RELAXED, __HIP_MEMORY_SCOPE_AGENT); }
DI unsigned xb_add(unsigned* p, unsigned v) { return __hip_atomic_fetch_add(p, v, __ATOMIC_RELAXED, __HIP_MEMORY_SCOPE_AGENT); }
DI unsigned xb_xcc_id() { return (unsigned)__builtin_amdgcn_s_getreg((3 << 11) | 20) & 0xFu; }
#define XB_SPIN(cond, bar) do { unsigned _sp = 0; while (cond) { __builtin_amdgcn_s_sleep(1); \
    if ((++_sp & 255u) == 0u) { if (xb_ld(&(bar)[XB_TMO])) break; if (_sp > XB_SPIN_CAP) { atomicAdd(&(bar)[XB_TMO], 1u); break; } } } } while (0)
struct XcdBarrier { unsigned* bar; unsigned x; volatile LAS unsigned* st; };
DI XcdBarrier xcd_barrier_post(unsigned* bar, volatile LAS unsigned* st) {
    XcdBarrier b; b.bar = bar; b.x = xb_xcc_id(); b.st = st;
    if (threadIdx.x == 0) (void)xb_add(&bar[XB_XCNT(b.x)], 1u);
    return b;
}
DI void xcd_barrier_complete(unsigned* bar, unsigned x, unsigned& nloc, unsigned& nx) {
    const unsigned G = gridDim.x * gridDim.y * gridDim.z;
    unsigned sum, cnt, mine, sp = 0u;
    for (;;) {
        sum = 0u; cnt = 0u; mine = 0u;
#pragma unroll
        for (unsigned j = 0; j < 16; ++j) { const unsigned c = xb_ld(&bar[XB_XCNT(j)]); sum += c; cnt += (c > 0u) ? 1u : 0u; mine = (j == x) ? c : mine; }
        if (sum == G) break;
        __builtin_amdgcn_s_sleep(1);
        if ((++sp & 255u) == 0u) { if (xb_ld(&bar[XB_TMO])) break; if (sp > XB_SPIN_CAP) { atomicAdd(&bar[XB_TMO], 1u); break; } }
    }
    nloc = mine > 0u ? mine : 1u; nx = cnt > 0u ? cnt : 1u;
}
DI void xcd_barrier(const XcdBarrier& b) {
    asm volatile("s_waitcnt vmcnt(0)" ::: "memory");
    __syncthreads();
    if (threadIdx.x == 0) {
        unsigned* bar = b.bar;
        __builtin_amdgcn_s_waitcnt(0);
        unsigned nloc = b.st[0], nx = b.st[1];
        if (nloc == 0u) { xcd_barrier_complete(bar, b.x, nloc, nx); b.st[0] = nloc; b.st[1] = nx; }
        const unsigned old = xb_add(&bar[XB_XSUB(b.x)], 1u);
        const unsigned gen = old / nloc;
        if (old + 1u == (gen + 1u) * nloc) {
            __builtin_amdgcn_fence(__ATOMIC_RELEASE, "agent");
            asm volatile("s_waitcnt vmcnt(0)" ::: "memory");
            const unsigned og = xb_add(&bar[XB_TOP], 1u);
            const unsigned tg = og / nx;
            if (og + 1u == (tg + 1u) * nx) xb_add(&bar[XB_TOPGEN], 1u);
            else XB_SPIN(xb_ld(&bar[XB_TOPGEN]) == tg, bar);
            __builtin_amdgcn_fence(__ATOMIC_ACQUIRE, "agent");
            xb_add(&bar[XB_XGEN(b.x)], 1u);
            asm volatile("s_waitcnt vmcnt(0)" ::: "memory");
        } else {
            XB_SPIN(xb_ld(&bar[XB_XGEN(b.x)]) == gen, bar);
            __builtin_amdgcn_fence(__ATOMIC_ACQUIRE, "agent");
            asm volatile("s_waitcnt vmcnt(0)" ::: "memory");
        }
    }
    __syncthreads();
}

static_assert(sizeof(Args) == 22 * 8, "Args layout");
__global__ void __launch_bounds__(NTHR, 2) fwd_kernel(Args a_unused) {
    extern __shared__ __attribute__((aligned(16))) unsigned char lds_raw[];
    cg::grid_group grid = cg::this_grid();
    Ctx F; F.lds = (LAS unsigned char*)lds_raw; F.tid = threadIdx.x; F.lane = F.tid & 63; F.wave = __builtin_amdgcn_readfirstlane(F.tid >> 6); F.G = gridDim.x; F.bid = blockIdx.x;

    int lo, hi; { typedef __attribute__((address_space(4))) const volatile unsigned long long* kp_t; const unsigned long long ph = ((kp_t)__builtin_amdgcn_kernarg_segment_ptr())[21]; lo = (int)(unsigned)ph; hi = (int)(unsigned)(ph >> 32); }
#ifndef PHASE_MASK
#define PHASE_MASK 0xffff
#endif
#define IN(k) (((PHASE_MASK >> (k)) & 1) && lo <= (k) && (k) < hi)
    volatile LAS unsigned* bst = (volatile LAS unsigned*)(F.lds + LDS_BYTES - 64);
    if (F.tid < 2) bst[F.tid] = 0u;
    __syncthreads();
    XcdBarrier xbar;
    { const Args a0 = load_args(); xbar = xcd_barrier_post((unsigned*)(a0.ws + WS_CTL), bst); }
    volatile LAS unsigned long long* tsl = (volatile LAS unsigned long long*)(F.lds + LDS_BYTES - 256);
    if (PROBE_PHASE >= 0 && F.bid == 0 && F.tid == 0) tsl[0] = __builtin_amdgcn_s_memrealtime();
#define SEAM(k) do { if (IN(k) && IN((k) + 1)) { xcd_barrier(xbar); } \
        if (PROBE_PHASE >= 0 && F.bid == 0 && F.tid == 0) tsl[(k) + 1] = __builtin_amdgcn_s_memrealtime(); } while (0)
    grid.sync();
    if (IN(0)) { const Args a = load_args(); p0_phase(F, a); p1_phase(F, a); }
    if (PROBE_PHASE >= 0 && F.bid == 0 && F.tid == 0) tsl[1] = __builtin_amdgcn_s_memrealtime();
    SEAM(1);
    if (IN(2)) {
        const Args a = load_args();
        pg8::Gemm g{(const bf16_t*)a.out, (const bf16_t*)(a.ws + WS_WINT), MTOK, PS, DM, 1 << 30}; pg8::StaticOrder S; S.init(MTOK, PS, F.G, F.bid);
        pg8::EpiProj E{(bf16_t*)(a.ws + WS_PROJ), a.pos, a.qk_g, (bf16_t*)(a.ws + WS_KIMG), (bf16_t*)(a.ws + WS_VIMG)};
        pg8::gemm_phase<pg8::EpiProj, true, true>(F.lds, g, S, E);
        gates_tasks(F, a);
    }
    SEAM(2);
    if (IN(3)) {
        const Args a = load_args();
        conv_phase(F, a);
        for (int t = F.bid; t < 64; t += F.G) mscal_task(F, a, t);
    }
    SEAM(3);
    if (IN(4)) {
        const Args a = load_args();
        {
#pragma unroll 1
            for (int rep = 0; rep < REP_MSEQ; ++rep)
#pragma unroll 1
            for (int it = F.bid; it < 256; it += F.G) { const int xcd_ = it & 7, j_ = it >> 3; mseq_item(F, a, it, xcd_ * 4 + (j_ >> 3), (j_ >> 2) & 1, j_ & 3); }
        }
        float lam, cshift;
        { const float p01 = wave_sum(a.lam_p[F.lane] * a.lam_p[64 + F.lane]), p23 = wave_sum(a.lam_p[128 + F.lane] * a.lam_p[192 + F.lane]);
          lam = __expf(p01) - __expf(p23) + 0.2f;
          const float gq = wave_max(fabsf(a.qk_g[F.lane])), gk = wave_max(fabsf(a.qk_g[64 + F.lane]));
          cshift = 8.f * gq * gk * 1.4426950408889634f * 1.02f; }
        const int xcd = F.bid & 7, j = F.bid >> 3;
#pragma unroll 1
        for (int rep = 0; rep < REP_ATT; ++rep)
        for (int i = 0; i * F.G < 1024; ++i) {
            int u;
            if (F.G == 256) u = (xcd * 4 + i) * 32 + j; else u = i * F.G + F.bid;
            if (u < 1024) attn_unit(F, a, u >> 7, (u >> 5) & 3, u & 31, lam, cshift);
        }
    }
    SEAM(4);
    if (IN(5)) { const Args a = load_args(); mcombine_phase(F, a); }
    SEAM(5);
    if (IN(6)) {
        const Args a = load_args();
        pg8::Gemm g{(const bf16_t*)(a.ws + WS_YMIX), (const bf16_t*)(a.ws + WS_WOUTT), MTOK, DM, DM, 1 << 30}; pg8::StaticOrder S; S.init(MTOK, DM, F.G, F.bid);
        pg8::EpiX1 E{a.x, (const float*)(a.ws + WS_MOD), (bf16_t*)(a.ws + WS_X1B)};
        pg8::gemm_phase<pg8::EpiX1, true, true>(F.lds, g, S, E);
    }
    SEAM(6);
    if (IN(7)) { const Args a = load_args();
#pragma unroll 1
        for (int rep = 0; rep < REP_P7; ++rep) p7_phase(F, a); }
    SEAM(7);
    if (IN(8)) { const Args a = load_args(); for (int t = F.bid; t < BATCH * NEXP; t += F.G) topk_task(F, a, t); }
    SEAM(8);
    if (IN(9)) {
        const Args a = load_args();
        pg8::Gemm g{(const bf16_t*)(a.ws + WS_H2), (const bf16_t*)(a.ws + WS_WGUT), NPAIR, 4096, DM, 16, (const int*)(a.ws + WS_IDX)};
        pg8::StaticOrder S; S.init(NPAIR, 4096, F.G, F.bid);
        pg8::EpiGU E{a.ws + WS_HH};
#pragma unroll 1
        for (int rep = 0; rep < REP_UP; ++rep)
        pg8::gemm_phase<pg8::EpiGU, true, true, true, true>(F.lds, g, S, E);
    }
    SEAM(9);
    if (IN(10)) {
        const Args a = load_args();
        pg8::Gemm g{(const bf16_t*)(a.ws + WS_HH), (const bf16_t*)(a.ws + WS_WDT), NPAIR, DM, DFF, 16};
        pg8::StaticOrder S; S.init(NPAIR, DM, F.G, F.bid);
        pg8::EpiDown E{a.ws + WS_Y, (const float*)(a.ws + WS_VALS)};
        pg8::gemm_phase<pg8::EpiDown, true, true, true>(F.lds, g, S, E);
    }
    SEAM(10);
    if (IN(11)) { const Args a = load_args(); final_phase(F, a); }
    if (PROBE_MSEQ_W >= 0 && F.bid == 0 && F.tid == 0) {
        const unsigned long long d = *(volatile LAS unsigned long long*)(F.lds + LDS_BYTES - 128), t1 = __builtin_amdgcn_s_memtime();
        while (__builtin_amdgcn_s_memtime() - t1 < 3ull * d) __builtin_amdgcn_s_sleep(8);
    }
    if (PROBE_PHASE >= 0 && F.bid == 0 && F.tid == 0) {
        const unsigned long long t1 = __builtin_amdgcn_s_memrealtime();
        const unsigned long long d = (PROBE_PHASE == 11 ? t1 : tsl[PROBE_PHASE + 1]) - tsl[PROBE_PHASE];
        while (__builtin_amdgcn_s_memrealtime() - t1 < 3ull * d) __builtin_amdgcn_s_sleep(8);
    }
#undef IN
#undef SEAM
}

extern "C" void kernel_launch(void* const* d_in, const int* in_sizes, int n_in, void* d_out, int out_size, void* d_ws, size_t ws_size, hipStream_t stream) {
    static int grid_blocks = 0;
    if (!grid_blocks) {
        int dev = 0, cus = 0, per_cu = 0;
        (void)hipGetDevice(&dev);
        (void)hipDeviceGetAttribute(&cus, hipDeviceAttributeMultiprocessorCount, dev);
        (void)hipFuncSetAttribute((const void*)fwd_kernel, hipFuncAttributeMaxDynamicSharedMemorySize, LDS_BYTES);
        (void)hipOccupancyMaxActiveBlocksPerMultiprocessor(&per_cu, (const void*)fwd_kernel, NTHR, LDS_BYTES);
        if (per_cu < 1) per_cu = 1;
        grid_blocks = cus;
        if (ws_size < WS_END) fprintf(stderr, "kernel_launch: workspace too small: %zu < %zu\n", ws_size, (size_t)WS_END);
    }
    (void)hipMemsetAsync((char*)d_ws + WS_CTL, 0, CTL_ZERO_BYTES, stream);
    Args a{};
    a.x = (const float*)d_in[0]; a.c = (const float*)d_in[1]; a.pos = (const int*)d_in[2]; a.norm1_g = (const float*)d_in[3]; a.norm2_g = (const float*)d_in[4];
    a.w_ada = (const float*)d_in[5]; a.b_ada = (const float*)d_in[6]; a.w_in = (const float*)d_in[7]; a.conv_w = (const float*)d_in[8]; a.gate_b = (const float*)d_in[9];
    a.mnorm_g = (const float*)d_in[10]; a.qk_g = (const float*)d_in[11]; a.lam_p = (const float*)d_in[12]; a.subln_g = (const float*)d_in[13]; a.w_out = (const float*)d_in[14];
    a.w_router = (const float*)d_in[15]; a.w_gate = (const float*)d_in[16]; a.w_up = (const float*)d_in[17]; a.w_down = (const float*)d_in[18];
    a.out = (float*)d_out; a.ws = (unsigned char*)d_ws; a.ph_lo = 0; a.ph_hi = 12;
    void* args[] = {&a};
    hipError_t e = hipLaunchCooperativeKernel((const void*)fwd_kernel, dim3(grid_blocks), dim3(NTHR), args, LDS_BYTES, stream);
    if (e != hipSuccess) fprintf(stderr, "cooperative launch failed: %s (grid %d)\n", hipGetErrorString(e), grid_blocks);
}
```
